# Optimizing an MI355X kernel written in HIP

```python
import math
import jax, jax.numpy as jnp
from jax import lax
import numpy as np

D_MODEL = 1024
BATCH = 1
SEQ = 16384
DEPTH = 2

MLSTM_HEADS = 4
MLSTM_HEAD_DIM = 128
MLSTM_WIDTH = MLSTM_HEADS * MLSTM_HEAD_DIM
MLSTM_CONV = 4
MLSTM_CHUNK = 64
S5_WIDTH = 512
S5_GROUP = 16
S5_GROUPS = S5_WIDTH // S5_GROUP
S5_STATE = 64
S5_DT_MIN = 1e-3
S5_DT_MAX = 1e-1
S5_MAX_REAL = -1e-4
HGRN_HEADS = 4
HGRN_KEY_DIM = 128
HGRN_VAL_DIM = 128
HGRN_KEY_WIDTH = HGRN_HEADS * HGRN_KEY_DIM
HGRN_VAL_WIDTH = HGRN_HEADS * HGRN_VAL_DIM
HGRN_CHUNK = 64
N_BRANCHES = 3
IN_WIDTH = 2 * MLSTM_WIDTH + 2 * MLSTM_HEADS + S5_WIDTH + 2 * HGRN_KEY_WIDTH + 2 * HGRN_VAL_WIDTH + N_BRANCHES * D_MODEL
N_EXPERTS = 32
N_GROUPS = 8
EXPERTS_PER_GROUP = N_EXPERTS // N_GROUPS
GROUP_SCORE_K = 2
TOP_K = 2
D_EXPERT = 256
DN_ALPHA = (2 * DEPTH) ** 0.25
DN_BETA = (8 * DEPTH) ** -0.25
LN_EPS = 1e-5
NORM_EPS = 1e-6

kernel_name = "hybrid_mlstm_s5_hgrn2_gmoe"


def layer_norm(x, g, b):
    xf = x.astype(jnp.float32)
    mu = xf.mean(-1, keepdims=True)
    var = jnp.square(xf - mu).mean(-1, keepdims=True)
    return ((xf - mu) * lax.rsqrt(var + LN_EPS)).astype(x.dtype) * g + b


def split_in(z):
    sizes = (MLSTM_WIDTH, MLSTM_WIDTH, MLSTM_HEADS, MLSTM_HEADS, S5_WIDTH,
             HGRN_KEY_WIDTH, HGRN_KEY_WIDTH, HGRN_VAL_WIDTH, HGRN_VAL_WIDTH, N_BRANCHES * D_MODEL)
    parts, off = [], 0
    for s in sizes:
        parts.append(z[..., off:off + s])
        off += s
    return parts


def causal_depthwise_conv(x, w, b):
    k = w.shape[0]
    y = lax.conv_general_dilated(x, w[:, None, :], window_strides=(1,), padding=[(k - 1, 0)],
                                 dimension_numbers=('NWC', 'WIO', 'NWC'), feature_group_count=x.shape[-1])
    return y + b


def mlstm_chunkwise(q, k, v, log_i, log_f):
    bsz, nh, seq, dh = q.shape
    L = MLSTM_CHUNK
    nc = seq // L
    f32 = jnp.float32
    q = (q.astype(f32) * (dh ** -0.5)).reshape(bsz, nh, nc, L, dh)
    k = k.astype(f32).reshape(bsz, nh, nc, L, dh)
    v = v.astype(f32).reshape(bsz, nh, nc, L, dh)
    li = log_i.reshape(bsz, nh, nc, L)
    b = jnp.cumsum(log_f.reshape(bsz, nh, nc, L), axis=-1)
    b_tot = b[..., -1]
    a = b_tot[..., None] - b + li
    a_max = a.max(-1)
    w = jnp.exp(a - a_max[..., None])
    c_loc = jnp.einsum('bhcl,bhcld,bhcle->bhcde', w, k, v)
    n_loc = jnp.einsum('bhcl,bhcld->bhcd', w, k)

    def step(carry, inp):
        c_st, n_st, m_st = carry
        c_l, n_l, am, bt = inp
        m_new = jnp.maximum(bt + m_st, am)
        g_old = jnp.exp(bt + m_st - m_new)
        g_loc = jnp.exp(am - m_new)
        c_new = g_old[..., None, None] * c_st + g_loc[..., None, None] * c_l
        n_new = g_old[..., None] * n_st + g_loc[..., None] * n_l
        return (c_new, n_new, m_new), (c_st, n_st, m_st)

    init = (jnp.zeros((bsz, nh, dh, dh), f32), jnp.zeros((bsz, nh, dh), f32), jnp.zeros((bsz, nh), f32))
    xs = (jnp.moveaxis(c_loc, 2, 0), jnp.moveaxis(n_loc, 2, 0), jnp.moveaxis(a_max, 2, 0), jnp.moveaxis(b_tot, 2, 0))
    _, (c_prev, n_prev, m_prev) = lax.scan(step, init, xs)
    c_prev = jnp.moveaxis(c_prev, 0, 2)
    n_prev = jnp.moveaxis(n_prev, 0, 2)
    m_prev = jnp.moveaxis(m_prev, 0, 2)

    causal = jnp.tril(jnp.ones((L, L), bool))
    d_mat = jnp.where(causal, b[..., :, None] - b[..., None, :] + li[..., None, :], -jnp.inf)
    m_inter = b + m_prev[..., None]
    m_j = jnp.maximum(m_inter, d_mat.max(-1))
    scores = jnp.einsum('bhcjd,bhcsd->bhcjs', q, k) * jnp.exp(d_mat - m_j[..., None])
    g_inter = jnp.exp(m_inter - m_j)
    num = g_inter[..., None] * jnp.einsum('bhcjd,bhcde->bhcje', q, c_prev) + jnp.einsum('bhcjs,bhcse->bhcje', scores, v)
    den = g_inter * jnp.einsum('bhcjd,bhcd->bhcj', q, n_prev) + scores.sum(-1)
    h = num / jnp.maximum(jnp.abs(den), jnp.exp(-m_j))[..., None]
    return h.reshape(bsz, nh, seq, dh)


def mlstm_branch(xm, o_pre, i_pre, f_pre, conv_w, conv_b, wq, wk, wv, b_i, b_f, skip):
    bsz, seq, _ = xm.shape
    xc = jax.nn.silu(causal_depthwise_conv(xm, conv_w, conv_b))
    xc_h = xc.reshape(bsz, seq, MLSTM_HEADS, MLSTM_HEAD_DIM)
    xm_h = xm.reshape(bsz, seq, MLSTM_HEADS, MLSTM_HEAD_DIM)
    q = jnp.einsum('bshd,hde->bhse', xc_h, wq)
    k = jnp.einsum('bshd,hde->bhse', xc_h, wk)
    v = jnp.einsum('bshd,hde->bhse', xm_h, wv)
    log_i = jnp.swapaxes(i_pre + b_i, 1, 2).astype(jnp.float32)
    log_f = jax.nn.log_sigmoid(jnp.swapaxes(f_pre + b_f, 1, 2).astype(jnp.float32))
    h = mlstm_chunkwise(q, k, v, log_i, log_f)
    h = jnp.swapaxes(h, 1, 2).reshape(bsz, seq, MLSTM_WIDTH)
    return (jax.nn.sigmoid(o_pre) * h + skip * xc).astype(xm.dtype)


def s5_branch(u, lam_re, lam_im, log_dt, b_re, b_im, c_re, c_im, d_skip, w_glu):
    bsz, seq, _ = u.shape
    f32 = jnp.float32
    lr = jnp.minimum(lam_re.astype(f32), S5_MAX_REAL)
    li = lam_im.astype(f32)
    dt = jnp.exp(log_dt.astype(f32))[:, None]
    mag = jnp.exp(lr * dt)
    ab_re = mag * jnp.cos(li * dt)
    ab_im = mag * jnp.sin(li * dt)
    nr = ab_re - 1.0
    den = lr * lr + li * li
    cr = (nr * lr + ab_im * li) / den
    ci = (ab_im * lr - nr * li) / den
    bb_re = cr[..., None] * b_re - ci[..., None] * b_im
    bb_im = cr[..., None] * b_im + ci[..., None] * b_re
    ug = u.reshape(bsz, seq, S5_GROUPS, S5_GROUP).astype(f32)
    bu_re = jnp.einsum('blgc,gpc->blgp', ug, bb_re)
    bu_im = jnp.einsum('blgc,gpc->blgp', ug, bb_im)
    a_re = jnp.broadcast_to(ab_re, bu_re.shape)
    a_im = jnp.broadcast_to(ab_im, bu_im.shape)

    def combine(e1, e2):
        a1r, a1i, b1r, b1i = e1
        a2r, a2i, b2r, b2i = e2
        return (a2r * a1r - a2i * a1i, a2r * a1i + a2i * a1r,
                a2r * b1r - a2i * b1i + b2r, a2r * b1i + a2i * b1r + b2i)

    _, _, x_re, x_im = lax.associative_scan(combine, (a_re, a_im, bu_re, bu_im), axis=1)
    y = jnp.einsum('blgp,gcp->blgc', x_re, c_re) - jnp.einsum('blgp,gcp->blgc', x_im, c_im)
    y = jax.nn.gelu(y.reshape(bsz, seq, S5_WIDTH) + d_skip * u)
    return (y * jax.nn.sigmoid(y @ w_glu)).astype(u.dtype)


def hgrn2_chunkwise(q, k, v, log_f):
    bsz, nh, seq, dk = q.shape
    dv = v.shape[-1]
    L = HGRN_CHUNK
    nc = seq // L

    def chunks(t):
        return jnp.moveaxis(t.reshape(bsz, nh, nc, L, t.shape[-1]), 2, 0)

    causal = jnp.tril(jnp.ones((L, L), bool))[:, :, None]

    def step(state, inp):
        qc, kc, vc, lfc = inp
        b = jnp.cumsum(lfc, axis=-2)
        o_inter = jnp.einsum('bhld,bhde->bhle', qc * jnp.exp(b), state)
        rel = jnp.where(causal, b[:, :, :, None, :] - b[:, :, None, :, :], -jnp.inf)
        attn = jnp.einsum('bhjd,bhsd,bhjsd->bhjs', qc, kc, jnp.exp(rel))
        o = o_inter + jnp.einsum('bhjs,bhse->bhje', attn, vc)
        b_last = b[:, :, -1:, :]
        new_state = jnp.exp(b_last[:, :, 0, :])[..., None] * state + jnp.einsum('bhsd,bhse->bhde', kc * jnp.exp(b_last - b), vc)
        return new_state, o

    init = jnp.zeros((bsz, nh, dk, dv), jnp.float32)
    _, o = lax.scan(step, init, (chunks(q), chunks(k), chunks(v), chunks(log_f)))
    return jnp.moveaxis(o, 0, 2).reshape(bsz, nh, seq, dv)


def hgrn2_branch(q_pre, f_pre, i_pre, g_pre, lower_bound, norm_w):
    bsz, seq, _ = q_pre.shape
    f32 = jnp.float32

    def heads(t, dim):
        return jnp.swapaxes(t.reshape(bsz, seq, HGRN_HEADS, dim), 1, 2).astype(f32)

    lb = lower_bound.reshape(HGRN_HEADS, 1, HGRN_KEY_DIM)
    f = lb + (1.0 - lb) * jax.nn.sigmoid(heads(f_pre, HGRN_KEY_DIM))
    q = jax.nn.silu(heads(q_pre, HGRN_KEY_DIM))
    v = heads(i_pre, HGRN_VAL_DIM)
    o = hgrn2_chunkwise(q, 1.0 - f, v, jnp.log(f))
    o = o * lax.rsqrt(jnp.mean(o * o, -1, keepdims=True) + NORM_EPS)
    o = jnp.swapaxes(o, 1, 2).reshape(bsz, seq, HGRN_VAL_WIDTH)
    return (o * norm_w * jax.nn.silu(g_pre)).astype(q_pre.dtype)


def grouped_moe(x, router_w, router_bias, w_gate, w_up, w_down):
    bsz, seq, d = x.shape
    f32 = jnp.float32
    xt = x.reshape(bsz * seq, d)
    s = jax.nn.sigmoid((xt @ router_w).astype(f32))
    sb = s + router_bias
    t = sb.shape[0]
    grp = sb.reshape(t, N_GROUPS, EXPERTS_PER_GROUP)
    g_score = lax.top_k(grp, GROUP_SCORE_K)[0].sum(-1)
    g_idx = jnp.argmax(g_score, axis=-1)
    in_grp = jax.nn.one_hot(g_idx, N_GROUPS, dtype=f32)[:, :, None] > 0
    masked = jnp.where(in_grp, grp, -jnp.inf).reshape(t, N_EXPERTS)
    _, e_idx = lax.top_k(masked, TOP_K)
    s_sel = jnp.take_along_axis(s, e_idx, axis=1)
    gates = s_sel / s_sel.sum(-1, keepdims=True)
    combine = jnp.sum(jax.nn.one_hot(e_idx, N_EXPERTS, dtype=f32) * gates[..., None], axis=1)
    y = jnp.zeros((t, d), f32)
    for g in range(N_GROUPS):
        sl = slice(g * EXPERTS_PER_GROUP, (g + 1) * EXPERTS_PER_GROUP)
        h = jax.nn.silu(jnp.einsum('td,edf->tef', xt, w_gate[sl])) * jnp.einsum('td,edf->tef', xt, w_up[sl])
        y = y + jnp.einsum('tef,efd->td', h * combine[:, sl, None], w_down[sl])
    return y.astype(x.dtype).reshape(bsz, seq, d)


def setup_inputs(seed: int = 0) -> dict:
    key = jax.random.key(seed)
    ks = jax.random.split(key, 40)
    f32 = jnp.float32
    L = DEPTH
    H, Dh = MLSTM_HEADS, MLSTM_HEAD_DIM
    G, P, GC = S5_GROUPS, S5_STATE, S5_GROUP

    def nrm(i, shape, scale):
        return jax.random.normal(ks[i], shape, f32) * scale

    return {
        'x': nrm(0, (BATCH, SEQ, D_MODEL), 1.0),
        'w_in': nrm(1, (L, D_MODEL, IN_WIDTH), D_MODEL ** -0.5),
        'mlstm_conv_w': nrm(2, (L, MLSTM_CONV, MLSTM_WIDTH), MLSTM_CONV ** -0.5),
        'mlstm_conv_b': nrm(3, (L, MLSTM_WIDTH), 0.01),
        'mlstm_wq': nrm(4, (L, H, Dh, Dh), Dh ** -0.5),
        'mlstm_wk': nrm(5, (L, H, Dh, Dh), Dh ** -0.5),
        'mlstm_wv': nrm(6, (L, H, Dh, Dh), Dh ** -0.5),
        'mlstm_b_i': nrm(7, (L, H), 0.1),
        'mlstm_b_f': jnp.linspace(3.0, 6.0, H, dtype=f32)[None, :] + nrm(8, (L, H), 0.01),
        'mlstm_skip': 1.0 + nrm(9, (L, MLSTM_WIDTH), 0.01),
        's5_lambda_re': -0.5 * jnp.exp(nrm(10, (L, G, P), 0.02)),
        's5_lambda_im': math.pi * jnp.arange(P, dtype=f32) + nrm(11, (L, G, P), 0.01),
        's5_log_dt': jax.random.uniform(ks[12], (L, G), f32, math.log(S5_DT_MIN), math.log(S5_DT_MAX)),
        's5_b_re': nrm(13, (L, G, P, GC), (2 * GC) ** -0.5),
        's5_b_im': nrm(14, (L, G, P, GC), (2 * GC) ** -0.5),
        's5_c_re': nrm(15, (L, G, GC, P), 0.5),
        's5_c_im': nrm(16, (L, G, GC, P), 0.5),
        's5_d': nrm(17, (L, S5_WIDTH), 1.0),
        's5_w_glu': nrm(18, (L, S5_WIDTH, S5_WIDTH), S5_WIDTH ** -0.5),
        'hgrn_lower_bounds': nrm(19, (L, HGRN_KEY_WIDTH), 0.1),
        'hgrn_norm_w': 1.0 + nrm(20, (L, HGRN_VAL_WIDTH), 0.01),
        'w_branch_mlstm': nrm(21, (L, MLSTM_WIDTH, D_MODEL), MLSTM_WIDTH ** -0.5 * DN_BETA),
        'w_branch_s5': nrm(22, (L, S5_WIDTH, D_MODEL), S5_WIDTH ** -0.5 * DN_BETA),
        'w_branch_hgrn': nrm(23, (L, HGRN_VAL_WIDTH, D_MODEL), HGRN_VAL_WIDTH ** -0.5 * DN_BETA),
        'w_out': nrm(24, (L, D_MODEL, D_MODEL), D_MODEL ** -0.5 * DN_BETA),
        'ln1_g': 1.0 + nrm(25, (L, D_MODEL), 0.01),
        'ln1_b': nrm(26, (L, D_MODEL), 0.01),
        'ln2_g': 1.0 + nrm(27, (L, D_MODEL), 0.01),
        'ln2_b': nrm(28, (L, D_MODEL), 0.01),
        'router_w': nrm(29, (D_MODEL, N_EXPERTS), D_MODEL ** -0.5),
        'router_bias': nrm(30, (N_EXPERTS,), 0.01),
        'exp_w_gate': nrm(31, (L, N_EXPERTS, D_MODEL, D_EXPERT), D_MODEL ** -0.5),
        'exp_w_up': nrm(32, (L, N_EXPERTS, D_MODEL, D_EXPERT), D_MODEL ** -0.5),
        'exp_w_down': nrm(33, (L, N_EXPERTS, D_EXPERT, D_MODEL), D_EXPERT ** -0.5 * DN_BETA),
    }


def reference(x, w_in, mlstm_conv_w, mlstm_conv_b, mlstm_wq, mlstm_wk, mlstm_wv, mlstm_b_i, mlstm_b_f,
              mlstm_skip, s5_lambda_re, s5_lambda_im, s5_log_dt, s5_b_re, s5_b_im, s5_c_re, s5_c_im, s5_d,
              s5_w_glu, hgrn_lower_bounds, hgrn_norm_w, w_branch_mlstm, w_branch_s5, w_branch_hgrn, w_out,
              ln1_g, ln1_b, ln2_g, ln2_b, router_w, router_bias, exp_w_gate, exp_w_up, exp_w_down):
    lb_cum = jnp.cumsum(jax.nn.softmax(hgrn_lower_bounds.astype(jnp.float32), axis=0), axis=0)
    lb_layers = lb_cum - lb_cum[0]
    for l in range(DEPTH):
        z = x @ w_in[l]
        xm, o_m, i_m, f_m, u_s, q_h, f_h, i_h, g_h, gate_pre = split_in(z)
        y_m = mlstm_branch(xm, o_m, i_m, f_m, mlstm_conv_w[l], mlstm_conv_b[l], mlstm_wq[l], mlstm_wk[l],
                           mlstm_wv[l], mlstm_b_i[l], mlstm_b_f[l], mlstm_skip[l])
        y_s = s5_branch(u_s, s5_lambda_re[l], s5_lambda_im[l], s5_log_dt[l], s5_b_re[l], s5_b_im[l],
                        s5_c_re[l], s5_c_im[l], s5_d[l], s5_w_glu[l])
        y_h = hgrn2_branch(q_h, f_h, i_h, g_h, lb_layers[l], hgrn_norm_w[l])
        gates = jax.nn.sigmoid(gate_pre.reshape(gate_pre.shape[:-1] + (N_BRANCHES, D_MODEL)))
        merged = (gates[..., 0, :] * (y_m @ w_branch_mlstm[l])
                  + gates[..., 1, :] * (y_s @ w_branch_s5[l])
                  + gates[..., 2, :] * (y_h @ w_branch_hgrn[l]))
        x = layer_norm(DN_ALPHA * x + (merged @ w_out[l]).astype(x.dtype), ln1_g[l], ln1_b[l])
        ffn = grouped_moe(x, router_w, router_bias, exp_w_gate[l], exp_w_up[l], exp_w_down[l])
        x = layer_norm(DN_ALPHA * x + ffn, ln2_g[l], ln2_b[l])
    return x
```

```cpp
#include <hip/hip_runtime.h>
#include <hip/hip_cooperative_groups.h>
#include <cstdio>
#include <cstdint>
namespace cg = cooperative_groups;

typedef unsigned short bf16_t;
typedef short bf16x8 __attribute__((ext_vector_type(8)));
typedef short bf16x4 __attribute__((ext_vector_type(4)));
typedef float f32x4 __attribute__((ext_vector_type(4)));
typedef unsigned u32x4 __attribute__((ext_vector_type(4)));
typedef unsigned u32x2 __attribute__((ext_vector_type(2)));

constexpr int T = 16384, D = 1024, NZ = 3584, NWIN = 6912, INW = 6664;
constexpr int NPH = 15, NLAYER = 2;
constexpr int GSEG = 32, GSEGLEN = 512;
constexpr int SSEG = 64, SSEGLEN = 256;
constexpr int SLOTS = 32768 + 2048;
constexpr float DN_ALPHA = 1.41421356237f;
constexpr int LDS_BYTES = 131072;

constexpr size_t AL(size_t x) { return (x + 255) & ~(size_t)255; }
constexpr size_t OFF_WIN = 0;
constexpr size_t OFF_WQKV = OFF_WIN + AL((size_t)NWIN * 1024 * 2);
constexpr size_t OFF_WGLU = OFF_WQKV + AL((size_t)12 * 128 * 128 * 2);
constexpr size_t OFF_WB = OFF_WGLU + AL((size_t)512 * 512 * 2);
constexpr size_t OFF_WOUT = OFF_WB + AL((size_t)3 * 1024 * 512 * 2);
constexpr size_t OFF_ABAR = OFF_WOUT + AL((size_t)1024 * 1024 * 2);
constexpr size_t OFF_BBT = OFF_ABAR + AL((size_t)32 * 64 * 2 * 4);
constexpr size_t OFF_CCT = OFF_BBT + AL((size_t)32 * 128 * 16 * 2);
constexpr size_t OFF_CTL = OFF_CCT + AL((size_t)32 * 16 * 128 * 2);
constexpr size_t OFF_TOKE = OFF_CTL + 4096;
constexpr size_t OFF_TOKG = OFF_TOKE + AL((size_t)T * 2 * 4);
constexpr size_t OFF_TOKS = OFF_TOKG + AL((size_t)T * 2 * 4);
constexpr size_t OFF_SLOTT = OFF_TOKS + AL((size_t)T * 2 * 4);
constexpr size_t OFF_XB = OFF_SLOTT + AL((size_t)SLOTS * 4);
constexpr size_t OFF_R1 = OFF_XB + AL((size_t)T * 1024 * 2);
constexpr size_t SZ_ACT = (size_t)T * 512 * 2;
constexpr size_t OFF_XC = OFF_R1, OFF_Q = OFF_R1 + SZ_ACT, OFF_KH = OFF_R1 + 2 * SZ_ACT, OFF_V = OFF_R1 + 3 * SZ_ACT;
constexpr size_t OFF_WGU = OFF_R1, OFF_WD = OFF_R1 + (size_t)32 * 512 * 1024 * 2;
constexpr size_t OFF_Z = OFF_R1 + 4 * SZ_ACT;
constexpr size_t OFF_MERGED = OFF_Z, OFF_H = OFF_Z + (size_t)T * 1024 * 2;
constexpr size_t OFF_ZS = OFF_Z + AL((size_t)T * NZ * 2);
constexpr size_t OFF_LF = OFF_ZS + AL((size_t)T * 8 * 4);
constexpr size_t OFF_LI = OFF_LF + AL((size_t)T * 4 * 4);
constexpr size_t OFF_E = OFF_LI + AL((size_t)T * 4 * 4);
constexpr size_t OFF_OM = OFF_E, OFF_OH = OFF_E + SZ_ACT, OFF_YPRE = OFF_E + 2 * SZ_ACT, OFF_YSG = OFF_E + 3 * SZ_ACT;
constexpr size_t OFF_DEN = OFF_E + 4 * SZ_ACT;
constexpr size_t OFF_EM = OFF_DEN + AL((size_t)T * 4 * 4);
constexpr size_t OFF_EMX = OFF_EM + AL((size_t)GSEG * 4 * 128 * 128 * 4);
constexpr size_t OFF_GM = OFF_EMX + AL((size_t)GSEG * 4 * 128 * 16 * 4);
constexpr size_t OFF_EH = OFF_GM + AL((size_t)GSEG * 4 * 128 * 4);
constexpr size_t OFF_GH = OFF_EH + AL((size_t)GSEG * 4 * 128 * 128 * 4);
constexpr size_t OFF_ES = OFF_GH + AL((size_t)GSEG * 4 * 128 * 4);
constexpr size_t WS_END = OFF_ES + AL((size_t)SSEG * 32 * 64 * 2 * 4);
constexpr size_t OFF_YS = OFF_E;
static_assert(OFF_YS + (size_t)SLOTS * 1024 * 2 <= WS_END, "YS must fit in the dead region");
static_assert(OFF_H + (size_t)SLOTS * 256 * 2 <= OFF_ZS, "H must fit in the dead Z region");
static_assert(OFF_WD + (size_t)32 * 1024 * 256 * 2 <= OFF_Z, "expert weights must fit in R1");

struct Args { const float* in[34]; float* out; unsigned char* ws; int ph_lo, ph_hi; };

extern __shared__ __attribute__((aligned(16))) unsigned char smem[];

__device__ __forceinline__ bf16_t f2bf(float f) { unsigned u = __float_as_uint(f); u += 0x7FFFu + ((u >> 16) & 1u); return (bf16_t)(u >> 16); }
__device__ __forceinline__ float bf2f(bf16_t b) { return __uint_as_float(((unsigned)b) << 16); }
__device__ __forceinline__ unsigned pack2(float lo, float hi) { return (unsigned)f2bf(lo) | ((unsigned)f2bf(hi) << 16); }
__device__ __forceinline__ float sigmoidf_(float x) { return 1.0f / (1.0f + expf(-x)); }
__device__ __forceinline__ float siluf_(float x) { return x / (1.0f + expf(-x)); }
__device__ __forceinline__ float logsigmoidf_(float x) { return fminf(x, 0.f) - log1pf(expf(-fabsf(x))); }
__device__ __forceinline__ float gelu_tanh(float y) { const float z = 0.7978845608028654f * (y + 0.044715f * y * y * y); const float th = 1.0f - 2.0f / (expf(2.0f * z) + 1.0f); return 0.5f * y * (1.0f + th); }
__device__ __forceinline__ void wave_sync() { __builtin_amdgcn_wave_barrier(); asm volatile("s_waitcnt lgkmcnt(0)" ::: "memory"); __builtin_amdgcn_wave_barrier(); }

#define MFMA16(a, b, c) __builtin_amdgcn_mfma_f32_16x16x32_bf16((a), (b), (c), 0, 0, 0)

template <int MT, int NT, class FA, class FB>
__device__ __forceinline__ void wave_gemm(f32x4 (&acc)[MT][NT], int K, FA arow, FB brow, int lane) {
    const int r = lane & 15, q = lane >> 4;
    const bf16_t* ap[MT]; const bf16_t* bp[NT];
#pragma unroll
    for (int m = 0; m < MT; ++m) ap[m] = arow(m * 16 + r) + 8 * q;
#pragma unroll
    for (int n = 0; n < NT; ++n) bp[n] = brow(n * 16 + r) + 8 * q;
#pragma unroll 1
    for (int k = 0; k < K; k += 32) {
        bf16x8 a[MT], b[NT];
#pragma unroll
        for (int m = 0; m < MT; ++m) a[m] = *(const bf16x8*)(ap[m] + k);
#pragma unroll
        for (int n = 0; n < NT; ++n) b[n] = *(const bf16x8*)(bp[n] + k);
#pragma unroll
        for (int m = 0; m < MT; ++m)
#pragma unroll
            for (int n = 0; n < NT; ++n) acc[m][n] = MFMA16(a[m], b[n], acc[m][n]);
    }
}
template <int MT, int NT> __device__ __forceinline__ void zero_acc(f32x4 (&acc)[MT][NT]) {
#pragma unroll
    for (int m = 0; m < MT; ++m)
#pragma unroll
        for (int n = 0; n < NT; ++n) acc[m][n] = (f32x4){0.f, 0.f, 0.f, 0.f};
}

__device__ __forceinline__ void tconv_tile(const float* src, int ld_src, int nvalid, bf16_t* dst, int ld_dst, int tid) {
    float* t = (float*)smem;
    { const int r = tid >> 3, c0 = (tid & 7) * 8;
#pragma unroll
      for (int j = 0; j < 8; ++j) { const int c = c0 + j; const float v = (c < nvalid) ? src[(size_t)r * ld_src + c] : 0.f; t[c * 65 + r] = v; } }
    __syncthreads();
    { const int n = tid >> 3, k0 = (tid & 7) * 8; const float* p = t + n * 65 + k0;
      u32x4 w; w.x = pack2(p[0], p[1]); w.y = pack2(p[2], p[3]); w.z = pack2(p[4], p[5]); w.w = pack2(p[6], p[7]);
      *(u32x4*)(dst + (size_t)n * ld_dst + k0) = w; }
    __syncthreads();
}

__device__ __forceinline__ void phase_prep(const Args& a, int l, int tid, int bid, int G) {
    unsigned char* ws = a.ws;
    bf16_t* WIN = (bf16_t*)(ws + OFF_WIN); bf16_t* WQKV = (bf16_t*)(ws + OFF_WQKV); bf16_t* WGLU = (bf16_t*)(ws + OFF_WGLU);
    bf16_t* WB = (bf16_t*)(ws + OFF_WB); bf16_t* WOUT = (bf16_t*)(ws + OFF_WOUT);
    for (int u = bid; u < 2480; u += G) {
        const float* src; int lds_ = 0, nvalid = 64, ldd = 0; bf16_t* dst;
        if (u < 1728) { const int nt = u / 16, kt = u % 16, p0 = nt * 64; int sc;
            if (p0 < 1024) sc = p0; else if (p0 < 6656) sc = p0 + 8; else if (p0 == 6656) { sc = 1024; nvalid = 8; } else { sc = 0; nvalid = 0; }
            src = a.in[1] + (size_t)l * 1024 * INW + (size_t)(kt * 64) * INW + sc; lds_ = INW; dst = WIN + (size_t)p0 * 1024 + kt * 64; ldd = 1024; }
        else if (u < 1776) { const int v = u - 1728, m = v / 4, tt = v % 4, nt = tt >> 1, kt = tt & 1, which = m / 4, h = m % 4;
            src = a.in[4 + which] + (size_t)(l * 4 + h) * 128 * 128 + (kt * 64) * 128 + nt * 64; lds_ = 128; dst = WQKV + (size_t)m * 128 * 128 + (nt * 64) * 128 + kt * 64; ldd = 128; }
        else if (u < 1840) { const int v = u - 1776, nt = v / 8, kt = v % 8;
            src = a.in[18] + (size_t)l * 512 * 512 + (kt * 64) * 512 + nt * 64; lds_ = 512; dst = WGLU + (size_t)(nt * 64) * 512 + kt * 64; ldd = 512; }
        else if (u < 2224) { const int v = u - 1840, b = v / 128, w = v % 128, nt = w / 8, kt = w % 8;
            src = a.in[21 + b] + (size_t)l * 512 * 1024 + (size_t)(kt * 64) * 1024 + nt * 64; lds_ = 1024; dst = WB + (size_t)b * 1024 * 512 + (size_t)(nt * 64) * 512 + kt * 64; ldd = 512; }
        else { const int v = u - 2224, nt = v / 16, kt = v % 16;
            src = a.in[24] + (size_t)l * 1024 * 1024 + (size_t)(kt * 64) * 1024 + nt * 64; lds_ = 1024; dst = WOUT + (size_t)(nt * 64) * 1024 + kt * 64; ldd = 1024; }
        tconv_tile(src, lds_, nvalid, dst, ldd, tid);
    }
    float* ABAR = (float*)(ws + OFF_ABAR); bf16_t* BBT = (bf16_t*)(ws + OFF_BBT); bf16_t* CCT = (bf16_t*)(ws + OFF_CCT);
    for (int i = bid * 512 + tid; i < 2048; i += G * 512) {
        const int g = i / 64, p = i % 64; const size_t gp = (size_t)(l * 32 + g) * 64 + p;
        const float lr = fminf(a.in[10][gp], -1e-4f), li = a.in[11][gp], dt = expf(a.in[12][l * 32 + g]);
        const float mag = expf(lr * dt), abr = mag * cosf(li * dt), abi = mag * sinf(li * dt);
        const float nr = abr - 1.0f, den = lr * lr + li * li, cr = (nr * lr + abi * li) / den, ci = (abi * lr - nr * li) / den;
        ABAR[(g * 64 + p) * 2] = abr; ABAR[(g * 64 + p) * 2 + 1] = abi;
        for (int c = 0; c < 16; ++c) { const float br = a.in[13][gp * 16 + c], bi = a.in[14][gp * 16 + c];
            BBT[(size_t)(g * 128 + p) * 16 + c] = f2bf(cr * br - ci * bi); BBT[(size_t)(g * 128 + 64 + p) * 16 + c] = f2bf(cr * bi + ci * br);
            const size_t ci_ = ((size_t)(l * 32 + g) * 16 + c) * 64 + p;
            CCT[(size_t)(g * 16 + c) * 128 + p] = f2bf(a.in[15][ci_]); CCT[(size_t)(g * 16 + c) * 128 + 64 + p] = f2bf(-a.in[16][ci_]); }
    }
    if (bid == 0 && tid < 128) ((unsigned*)(ws + OFF_CTL))[tid] = 0u;
    if (l == 0) { bf16_t* XB = (bf16_t*)(ws + OFF_XB); const float* x = a.in[0];
        for (size_t i = (size_t)bid * 512 + tid; i < (size_t)T * 1024 / 8; i += (size_t)G * 512) {
            const f32x4 v0 = *(const f32x4*)(x + i * 8), v1 = *(const f32x4*)(x + i * 8 + 4);
            u32x4 w; w.x = pack2(v0[0], v0[1]); w.y = pack2(v0[2], v0[3]); w.z = pack2(v1[0], v1[1]); w.w = pack2(v1[2], v1[3]); *(u32x4*)(XB + i * 8) = w; } }
}

__device__ __forceinline__ void phase_prepx(const Args& a, int l, int tid, int bid, int G) {
    bf16_t* WGU = (bf16_t*)(a.ws + OFF_WGU); bf16_t* WD = (bf16_t*)(a.ws + OFF_WD);
    for (int u = bid; u < 6144; u += G) {
        const float* src; int lds_, ldd; bf16_t* dst;
        if (u < 4096) { const int up = u >= 2048, v = u & 2047, e = v / 64, w = v % 64, nt = w / 16, kt = w % 16, j0 = nt * 64, drow = (j0 / 128) * 256 + (j0 % 128) + up * 128;
            src = a.in[31 + up] + ((size_t)(l * 32 + e) * 1024 + kt * 64) * 256 + nt * 64; lds_ = 256; dst = WGU + ((size_t)e * 512 + drow) * 1024 + kt * 64; ldd = 1024; }
        else { const int v = u - 4096, e = v / 64, w = v % 64, nt = w / 4, kt = w % 4;
            src = a.in[33] + ((size_t)(l * 32 + e) * 256 + kt * 64) * 1024 + nt * 64; lds_ = 1024; dst = WD + ((size_t)e * 1024 + nt * 64) * 256 + kt * 64; ldd = 256; }
        tconv_tile(src, lds_, 64, dst, ldd, tid);
    }
}

__device__ __forceinline__ void phase_zgemm(const Args& a, int lane, int gw, int GW) {
    const bf16_t* XB = (const bf16_t*)(a.ws + OFF_XB); const bf16_t* WIN = (const bf16_t*)(a.ws + OFF_WIN);
    bf16_t* Z = (bf16_t*)(a.ws + OFF_Z); float* ZS = (float*)(a.ws + OFF_ZS);
    const int r = lane & 15, q = lane >> 4;
    for (int u = gw; u < 256 * 57; u += GW) {
        const int mt = u / 57, nt = u % 57, nc0 = nt < 56 ? nt * 64 : 6656;
        f32x4 acc[4][4]; zero_acc(acc);
        wave_gemm<4, 4>(acc, 1024, [=](int i) { return XB + (size_t)(mt * 64 + i) * 1024; }, [=](int j) { return WIN + (size_t)(nc0 + j) * 1024; }, lane);
#pragma unroll
        for (int m = 0; m < 4; ++m)
#pragma unroll
            for (int n = 0; n < 4; ++n)
#pragma unroll
                for (int g = 0; g < 4; ++g) { const int row = mt * 64 + m * 16 + 4 * q + g, col = n * 16 + r;
                    if (nt < 56) Z[(size_t)row * NZ + nt * 64 + col] = f2bf(acc[m][n][g]); else if (n == 0 && r < 8) ZS[row * 8 + r] = acc[m][n][g]; }
    }
}

__device__ __forceinline__ void phase_mprep(const Args& a, int l, int tid, int bid, int G) {
    const bf16_t* Z = (const bf16_t*)(a.ws + OFF_Z); bf16_t* XC = (bf16_t*)(a.ws + OFF_XC);
    const float* cw = a.in[2] + (size_t)l * 4 * 512; const float* cb = a.in[3] + (size_t)l * 512;
    for (int idx = bid * 512 + tid; idx < T * 64; idx += G * 512) {
        const int t = idx / 64, c0 = (idx % 64) * 8; float acc[8];
#pragma unroll
        for (int j = 0; j < 8; ++j) acc[j] = cb[c0 + j];
#pragma unroll
        for (int k = 0; k < 4; ++k) { const int ts = t - 3 + k; if (ts >= 0) { const bf16x8 v = *(const bf16x8*)(Z + (size_t)ts * NZ + c0);
#pragma unroll
                for (int j = 0; j < 8; ++j) acc[j] += cw[k * 512 + c0 + j] * bf2f((bf16_t)v[j]); } }
        u32x4 w; w.x = pack2(siluf_(acc[0]), siluf_(acc[1])); w.y = pack2(siluf_(acc[2]), siluf_(acc[3])); w.z = pack2(siluf_(acc[4]), siluf_(acc[5])); w.w = pack2(siluf_(acc[6]), siluf_(acc[7]));
        *(u32x4*)(XC + (size_t)t * 512 + c0) = w;
    }
    const float* ZS = (const float*)(a.ws + OFF_ZS); float* LF = (float*)(a.ws + OFF_LF); float* LI = (float*)(a.ws + OFF_LI);
    for (int idx = bid * 512 + tid; idx < T * 4; idx += G * 512) { const int t = idx >> 2, h = idx & 3;
        LI[idx] = ZS[t * 8 + h] + a.in[7][l * 4 + h]; LF[idx] = logsigmoidf_(ZS[t * 8 + 4 + h] + a.in[8][l * 4 + h]); }
}

__device__ __forceinline__ void phase_mqkv(const Args& a, int lane, int gw, int GW) {
    const bf16_t* Z = (const bf16_t*)(a.ws + OFF_Z); const bf16_t* XC = (const bf16_t*)(a.ws + OFF_XC); const bf16_t* WQKV = (const bf16_t*)(a.ws + OFF_WQKV);
    const float* LI = (const float*)(a.ws + OFF_LI);
    const int r = lane & 15, q = lane >> 4;
    for (int u = gw; u < 256 * 24; u += GW) {
        const int mt = u / 24, v = u % 24, which = v / 8, h = (v % 8) / 2, nh = v % 2;
        const bf16_t* A = which < 2 ? XC + h * 128 : Z + h * 128; const int lda = which < 2 ? 512 : NZ;
        f32x4 acc[4][4]; zero_acc(acc);
        wave_gemm<4, 4>(acc, 128, [=](int i) { return A + (size_t)(mt * 64 + i) * lda; }, [=](int j) { return WQKV + (size_t)((which * 4 + h) * 128 + nh * 64 + j) * 128; }, lane);
        bf16_t* O = (bf16_t*)(a.ws + (which == 0 ? OFF_Q : which == 1 ? OFF_KH : OFF_V));
#pragma unroll
        for (int m = 0; m < 4; ++m)
#pragma unroll
            for (int g = 0; g < 4; ++g) { const int row = mt * 64 + m * 16 + 4 * q + g;
                const float sc = which == 0 ? 0.08838834764831845f : which == 1 ? expf(LI[row * 4 + h]) : 1.0f;
#pragma unroll
                for (int n = 0; n < 4; ++n) O[(size_t)row * 512 + h * 128 + nh * 64 + n * 16 + r] = f2bf(acc[m][n][g] * sc); }
    }
}

constexpr int GL_QS = 0, GL_KS = 8704, GL_KT = 17408, GL_VT = 27648, GL_PS = 39168, GL_SC1 = 41728, GL_SC2 = 42240, GL_GT = 42752, GL_OS = 44800;
template <int MODE, int PASS>
__device__ __forceinline__ void gla_item(const Args& a, int l, int h, int sg, int tid, int lane, int wave) {
    unsigned char* ws = a.ws;
    const bf16_t* Z = (const bf16_t*)(ws + OFF_Z); const bf16_t* Qg = (const bf16_t*)(ws + OFF_Q); const bf16_t* Kg = (const bf16_t*)(ws + OFF_KH); const bf16_t* Vg = (const bf16_t*)(ws + OFF_V);
    const float* LF = (const float*)(ws + OFF_LF);
    float* Eg = (float*)(ws + (MODE == 0 ? OFF_EM : OFF_EH)); float* Gg = (float*)(ws + (MODE == 0 ? OFF_GM : OFF_GH)); float* EX = (float*)(ws + OFF_EMX);
    bf16_t* Og = (bf16_t*)(ws + (MODE == 0 ? OFF_OM : OFF_OH)); float* DEN = (float*)(ws + OFF_DEN);
    bf16_t* QS = (bf16_t*)(smem + GL_QS); bf16_t* KS = (bf16_t*)(smem + GL_KS); bf16_t* KT = (bf16_t*)(smem + GL_KT); bf16_t* VT = (bf16_t*)(smem + GL_VT); bf16_t* PS = (bf16_t*)(smem + GL_PS);
    float* SC1 = (float*)(smem + GL_SC1); float* SC2 = (float*)(smem + GL_SC2); float* GT = (float*)(smem + GL_GT); bf16_t* OS = (bf16_t*)(smem + GL_OS);
    const int r = lane & 15, q = lane >> 4, grp = tid >> 7, d = tid & 127;
    const bool xw = (MODE == 0) && (wave == 0);
    float lb = 0.f;
    if (MODE == 1 && l == 1) { const float h0 = a.in[19][h * 128 + d], h1 = a.in[19][512 + h * 128 + d]; lb = 1.0f / (1.0f + expf(h0 - h1)); }
    f32x4 S[8], SX[8];
#pragma unroll
    for (int i = 0; i < 8; ++i) { S[i] = (f32x4){0.f, 0.f, 0.f, 0.f}; SX[i] = (f32x4){0.f, 0.f, 0.f, 0.f}; }
    if (PASS == 2) {
        for (int j = 0; j < sg; ++j) {
#pragma unroll
            for (int i = 0; i < 8; ++i) { const f32x4 gv = *(const f32x4*)(Gg + (size_t)(j * 4 + h) * 128 + 16 * i + 4 * q);
#pragma unroll
                for (int g = 0; g < 4; ++g) { const size_t row = (size_t)(j * 4 + h) * 128 + 16 * i + 4 * q + g;
                    S[i][g] = gv[g] * S[i][g] + Eg[row * 128 + 16 * wave + r];
                    if (xw) SX[i][g] = gv[g] * SX[i][g] + EX[row * 16 + r]; } }
        }
    }
    __syncthreads();
    if (MODE == 0) { for (int i = tid; i < 16 * 40; i += 512) VT[128 * 40 + i] = (i < 32) ? (bf16_t)0x3F80 : (bf16_t)0; }
    float runb = 0.f;
    for (int ci = 0; ci < GSEGLEN / 32; ++ci) {
        const int t0 = sg * GSEGLEN + ci * 32, tb = t0 + grp * 8;
        float lg[8], qv[8], kv[8]; bf16_t vv[8];
#pragma unroll
        for (int j = 0; j < 8; ++j) {
            if (MODE == 1) { const size_t zo = (size_t)(tb + j) * NZ + h * 128 + d; const float qp = bf2f(Z[zo + 1536]), fp = bf2f(Z[zo + 2048]);
                const float f = lb + (1.0f - lb) * sigmoidf_(fp); lg[j] = logf(f); qv[j] = siluf_(qp); kv[j] = 1.0f - f; vv[j] = Z[zo + 2560]; }
            else { const size_t o = (size_t)(tb + j) * 512 + h * 128 + d; qv[j] = bf2f(Qg[o]); kv[j] = bf2f(Kg[o]); vv[j] = Vg[o]; lg[j] = LF[(tb + j) * 4 + h]; }
        }
        float cs[8]; cs[0] = lg[0];
#pragma unroll
        for (int j = 1; j < 8; ++j) cs[j] = cs[j - 1] + lg[j];
        GT[grp * 128 + d] = cs[7];
        __syncthreads();
        if (PASS == 2 && ci > 0) { const int row = tid >> 4, c8 = (tid & 15) * 8; *(u32x4*)(Og + (size_t)(t0 - 32 + row) * 512 + h * 128 + c8) = *(const u32x4*)(OS + row * 136 + c8); }
        const float g0 = GT[d], g1 = GT[128 + d], g2 = GT[256 + d], g3 = GT[384 + d];
        const float off = grp == 0 ? 0.f : grp == 1 ? g0 : grp == 2 ? g0 + g1 : g0 + g1 + g2;
        const float bmid = g0 + g1, bL = bmid + g2 + g3;
        bf16_t ktv[8];
#pragma unroll
        for (int j = 0; j < 8; ++j) { const float bt = off + cs[j]; const bf16_t kt = f2bf(kv[j] * expf(bmid - bt)); ktv[j] = kt;
            if (PASS == 2) { QS[(grp * 8 + j) * 136 + d] = f2bf(qv[j] * expf(bt - bmid)); KS[(grp * 8 + j) * 136 + d] = kt; } }
        { u32x4 w; w.x = ktv[0] | ((unsigned)ktv[1] << 16); w.y = ktv[2] | ((unsigned)ktv[3] << 16); w.z = ktv[4] | ((unsigned)ktv[5] << 16); w.w = ktv[6] | ((unsigned)ktv[7] << 16); *(u32x4*)(KT + d * 40 + grp * 8) = w;
          u32x4 x; x.x = vv[0] | ((unsigned)vv[1] << 16); x.y = vv[2] | ((unsigned)vv[3] << 16); x.z = vv[4] | ((unsigned)vv[5] << 16); x.w = vv[6] | ((unsigned)vv[7] << 16); *(u32x4*)(VT + d * 40 + grp * 8) = x; }
        if (grp == 0) { SC1[d] = expf(bmid); SC2[d] = expf(bL - bmid); runb += bL; }
        __syncthreads();
        if (PASS == 2) {
            if (wave < 4) {
                const int ti = (wave == 1 || wave == 2) ? 1 : 0, tj = (wave >= 2) ? 1 : 0;
                f32x4 p = (f32x4){0.f, 0.f, 0.f, 0.f};
                if (wave < 3) {
#pragma unroll
                    for (int kk = 0; kk < 4; ++kk) { const bf16x8 av = *(const bf16x8*)(QS + (16 * ti + r) * 136 + 32 * kk + 8 * q); const bf16x8 bv = *(const bf16x8*)(KS + (16 * tj + r) * 136 + 32 * kk + 8 * q); p = MFMA16(av, bv, p); }
                }
#pragma unroll
                for (int g = 0; g < 4; ++g) { const int t = 16 * ti + 4 * q + g, s = 16 * tj + r; PS[t * 40 + s] = (wave < 3 && s <= t) ? f2bf(p[g]) : (bf16_t)0; }
            }
            __syncthreads();
        }
        const bf16x8 bV = *(const bf16x8*)(VT + (16 * wave + r) * 40 + 8 * q);
        bf16x8 bV1 = bV; if (xw) bV1 = *(const bf16x8*)(VT + (128 + r) * 40 + 8 * q);
        f32x4 o[2], ox[2];
        o[0] = o[1] = ox[0] = ox[1] = (f32x4){0.f, 0.f, 0.f, 0.f};
#pragma unroll
        for (int kk = 0; kk < 4; ++kk) {
            const f32x4 sa = *(const f32x4*)(SC1 + 32 * kk + 4 * q), sb = *(const f32x4*)(SC1 + 32 * kk + 16 + 4 * q);
            S[2 * kk] *= sa; S[2 * kk + 1] *= sb;
            if (xw) { SX[2 * kk] *= sa; SX[2 * kk + 1] *= sb; }
            if (PASS == 2) {
                bf16x8 bS, bX;
#pragma unroll
                for (int g = 0; g < 4; ++g) { bS[g] = (short)f2bf(S[2 * kk][g]); bS[4 + g] = (short)f2bf(S[2 * kk + 1][g]); bX[g] = (short)f2bf(SX[2 * kk][g]); bX[4 + g] = (short)f2bf(SX[2 * kk + 1][g]); }
#pragma unroll
                for (int mt = 0; mt < 2; ++mt) { const bf16x4 lo = *(const bf16x4*)(QS + (16 * mt + r) * 136 + 32 * kk + 4 * q), hi = *(const bf16x4*)(QS + (16 * mt + r) * 136 + 32 * kk + 16 + 4 * q);
                    bf16x8 av; av[0] = lo[0]; av[1] = lo[1]; av[2] = lo[2]; av[3] = lo[3]; av[4] = hi[0]; av[5] = hi[1]; av[6] = hi[2]; av[7] = hi[3];
                    o[mt] = MFMA16(av, bS, o[mt]); if (xw) ox[mt] = MFMA16(av, bX, ox[mt]); }
            }
        }
        if (PASS == 2) {
#pragma unroll
            for (int mt = 0; mt < 2; ++mt) { const bf16x8 av = *(const bf16x8*)(PS + (16 * mt + r) * 40 + 8 * q); o[mt] = MFMA16(av, bV, o[mt]); if (xw) ox[mt] = MFMA16(av, bV1, ox[mt]);
#pragma unroll
                for (int g = 0; g < 4; ++g) { const int t = t0 + 16 * mt + 4 * q + g; OS[(16 * mt + 4 * q + g) * 136 + 16 * wave + r] = f2bf(o[mt][g]); if (xw && r == 0) DEN[h * T + t] = ox[mt][g]; } }
        }
#pragma unroll
        for (int i = 0; i < 8; ++i) { const bf16x8 av = *(const bf16x8*)(KT + (16 * i + r) * 40 + 8 * q); const f32x4 s2 = *(const f32x4*)(SC2 + 16 * i + 4 * q);
            S[i] = MFMA16(av, bV, S[i]); S[i] *= s2;
            if (xw) { SX[i] = MFMA16(av, bV1, SX[i]); SX[i] *= s2; } }
    }
    if (PASS == 2) { __syncthreads(); const int row = tid >> 4, c8 = (tid & 15) * 8; *(u32x4*)(Og + (size_t)(sg * GSEGLEN + GSEGLEN - 32 + row) * 512 + h * 128 + c8) = *(const u32x4*)(OS + row * 136 + c8); }
    if (PASS == 1) {
        float* ST = (float*)smem;
        __syncthreads();
#pragma unroll
        for (int i = 0; i < 8; ++i)
#pragma unroll
            for (int g = 0; g < 4; ++g) { ST[(16 * i + 4 * q + g) * 132 + 16 * wave + r] = S[i][g]; if (xw) EX[((size_t)(sg * 4 + h) * 128 + 16 * i + 4 * q + g) * 16 + r] = SX[i][g]; }
        __syncthreads();
#pragma unroll
        for (int k = 0; k < 8; ++k) { const int idx = tid + 512 * k, row = idx >> 5, c4 = (idx & 31) * 4; *(f32x4*)(Eg + ((size_t)(sg * 4 + h) * 128 + row) * 128 + c4) = *(const f32x4*)(ST + row * 132 + c4); }
        if (grp == 0) Gg[(size_t)(sg * 4 + h) * 128 + d] = expf(runb);
    }
}

template <int PASS>
__device__ __forceinline__ void s5_item(const Args& a, int l, int g, int sg, int g0, int tid, int lane, int wave, int hsel) {
    unsigned char* ws = a.ws;
    const bf16_t* Z = (const bf16_t*)(ws + OFF_Z); const float* ABAR = (const float*)(ws + OFF_ABAR); const bf16_t* BBT = (const bf16_t*)(ws + OFF_BBT); const bf16_t* CCT = (const bf16_t*)(ws + OFF_CCT);
    float* ES = (float*)(ws + OFF_ES); bf16_t* YPRE = (bf16_t*)(ws + OFF_YPRE);
    float* BU = (float*)(smem + 70000 + (wave & 3) * 12800); bf16_t* X = (bf16_t*)(smem + 70000 + (wave & 3) * 12800 + 8448); bf16_t* YT = (bf16_t*)(smem + 70000 + 51200);
    const int r = lane & 15, q = lane >> 4, p = lane; const bool act = (wave >> 2) == hsel;
    const float ar = ABAR[(g * 64 + p) * 2], ai = ABAR[(g * 64 + p) * 2 + 1];
    const bf16x8 zero8 = (bf16x8){0, 0, 0, 0, 0, 0, 0, 0};
    bf16x8 bB[8], cB[4];
#pragma unroll
    for (int nt = 0; nt < 8; ++nt) bB[nt] = (q < 2) ? *(const bf16x8*)(BBT + (size_t)(g * 128 + 16 * nt + r) * 16 + 8 * q) : zero8;
#pragma unroll
    for (int kk = 0; kk < 4; ++kk) cB[kk] = (PASS == 2) ? *(const bf16x8*)(CCT + (size_t)(g * 16 + r) * 128 + 32 * kk + 8 * q) : zero8;
    float xr = 0.f, xi = 0.f;
    if (PASS == 2 && sg > 0) {
        float pr = ar, pi = ai;
#pragma unroll
        for (int s = 0; s < 8; ++s) { const float nr = pr * pr - pi * pi, ni = 2.0f * pr * pi; pr = nr; pi = ni; }
        for (int j = 0; j < sg; ++j) { const float er = ES[((size_t)(j * 32 + g) * 64 + p) * 2], ei = ES[((size_t)(j * 32 + g) * 64 + p) * 2 + 1];
            const float nr = pr * xr - pi * xi + er, ni = pr * xi + pi * xr + ei; xr = nr; xi = ni; }
    }
    const float dsk = a.in[17][l * 512 + 16 * g + r];
    for (int ci = 0; ci < SSEGLEN / 16; ++ci) {
        const int t0 = sg * SSEGLEN + ci * 16;
        if (act) {
            const bf16x8 av = (q < 2) ? *(const bf16x8*)(Z + (size_t)(t0 + r) * NZ + 1024 + 16 * g + 8 * q) : zero8;
#pragma unroll
            for (int nt = 0; nt < 8; ++nt) { f32x4 acc = (f32x4){0.f, 0.f, 0.f, 0.f}; acc = MFMA16(av, bB[nt], acc);
#pragma unroll
                for (int gg = 0; gg < 4; ++gg) BU[(4 * q + gg) * 132 + 16 * nt + r] = acc[gg]; }
            wave_sync();
#pragma unroll
            for (int t = 0; t < 16; ++t) { const float br = BU[t * 132 + p], bi = BU[t * 132 + 64 + p];
                const float nr = ar * xr - ai * xi + br, ni = ar * xi + ai * xr + bi; xr = nr; xi = ni;
                if (PASS == 2) { X[t * 136 + p] = f2bf(xr); X[t * 136 + 64 + p] = f2bf(xi); } }
            wave_sync();
            if (PASS == 2) {
                f32x4 acc = (f32x4){0.f, 0.f, 0.f, 0.f};
#pragma unroll
                for (int kk = 0; kk < 4; ++kk) { const bf16x8 xv = *(const bf16x8*)(X + r * 136 + 32 * kk + 8 * q); acc = MFMA16(xv, cB[kk], acc); }
#pragma unroll
                for (int gg = 0; gg < 4; ++gg) { const int t = t0 + 4 * q + gg, c = 16 * g + r; const float u = bf2f(Z[(size_t)t * NZ + 1024 + c]);
                    YT[(4 * q + gg) * 136 + 16 * wave + r] = f2bf(gelu_tanh(acc[gg] + dsk * u)); }
            }
        }
        if (PASS == 2) {
            __syncthreads();
            if (tid < 128) { const int row = tid >> 3, c8 = (tid & 7) * 8; *(u32x4*)(YPRE + (size_t)(t0 + row) * 512 + 16 * g0 + 64 * hsel + c8) = *(const u32x4*)(YT + row * 136 + 64 * hsel + c8); }
            __syncthreads();
        }
    }
    if (PASS == 1 && act) { ES[((size_t)(sg * 32 + g) * 64 + p) * 2] = xr; ES[((size_t)(sg * 32 + g) * 64 + p) * 2 + 1] = xi; }
}

template <int PASS>
__device__ __forceinline__ void phase_mixers(const Args& a, int l, int tid, int lane, int wave, int bid, int G) {
    for (int it = bid; it < 4 * GSEG; it += G) gla_item<0, PASS>(a, l, it % 4, it / 4, tid, lane, wave);
    asm volatile("" ::: "memory");
    for (int it = bid + ((4 * GSEG - bid % G) % G + G) % G * 0; it < 2 * 4 * GSEG; it += G) { if (it >= 4 * GSEG) gla_item<1, PASS>(a, l, (it - 4 * GSEG) % 4, (it - 4 * GSEG) / 4, tid, lane, wave); }
    __syncthreads();
    for (int it0 = bid * 8; it0 < 32 * SSEG; it0 += G * 8)
        for (int half = 0; half < 2; ++half) { const int it = it0 + wave; s5_item<PASS>(a, l, it % 32, it / 32, it0 % 32, tid, lane, wave, half); __syncthreads(); }
}

__device__ __forceinline__ void phase_post(const Args& a, int l, int lane, int gw, int GW) {
    const bf16_t* Z = (const bf16_t*)(a.ws + OFF_Z); const bf16_t* XC = (const bf16_t*)(a.ws + OFF_XC);
    bf16_t* OM = (bf16_t*)(a.ws + OFF_OM); bf16_t* OH = (bf16_t*)(a.ws + OFF_OH); const float* DEN = (const float*)(a.ws + OFF_DEN);
    const int c0 = lane * 8, hd = lane >> 4;
    for (int t = gw; t < T; t += GW) {
        { const bf16x8 o = *(const bf16x8*)(OM + (size_t)t * 512 + c0), op = *(const bf16x8*)(Z + (size_t)t * NZ + 512 + c0), xc = *(const bf16x8*)(XC + (size_t)t * 512 + c0);
          const float dn = 1.0f / fmaxf(fabsf(DEN[hd * T + t]), 1.0f); float y[8];
#pragma unroll
          for (int j = 0; j < 8; ++j) y[j] = sigmoidf_(bf2f((bf16_t)op[j])) * (bf2f((bf16_t)o[j]) * dn) + a.in[9][l * 512 + c0 + j] * bf2f((bf16_t)xc[j]);
          u32x4 w; w.x = pack2(y[0], y[1]); w.y = pack2(y[2], y[3]); w.z = pack2(y[4], y[5]); w.w = pack2(y[6], y[7]); *(u32x4*)(OM + (size_t)t * 512 + c0) = w; }
        { const bf16x8 o = *(const bf16x8*)(OH + (size_t)t * 512 + c0), gp = *(const bf16x8*)(Z + (size_t)t * NZ + 3072 + c0);
          float ov[8], ss = 0.f;
#pragma unroll
          for (int j = 0; j < 8; ++j) { ov[j] = bf2f((bf16_t)o[j]); ss += ov[j] * ov[j]; }
          ss += __shfl_xor(ss, 1); ss += __shfl_xor(ss, 2); ss += __shfl_xor(ss, 4); ss += __shfl_xor(ss, 8);
          const float rinv = rsqrtf(ss * (1.0f / 128.0f) + 1e-6f); float y[8];
#pragma unroll
          for (int j = 0; j < 8; ++j) y[j] = ov[j] * rinv * a.in[20][l * 512 + c0 + j] * siluf_(bf2f((bf16_t)gp[j]));
          u32x4 w; w.x = pack2(y[0], y[1]); w.y = pack2(y[2], y[3]); w.z = pack2(y[4], y[5]); w.w = pack2(y[6], y[7]); *(u32x4*)(OH + (size_t)t * 512 + c0) = w; }
    }
}

__device__ __forceinline__ void phase_glu(const Args& a, int lane, int gw, int GW) {
    const bf16_t* YPRE = (const bf16_t*)(a.ws + OFF_YPRE); const bf16_t* WGLU = (const bf16_t*)(a.ws + OFF_WGLU); bf16_t* YSG = (bf16_t*)(a.ws + OFF_YSG);
    const int r = lane & 15, q = lane >> 4;
    for (int u = gw; u < 256 * 8; u += GW) {
        const int mt = u / 8, nt = u % 8;
        f32x4 acc[4][4]; zero_acc(acc);
        wave_gemm<4, 4>(acc, 512, [=](int i) { return YPRE + (size_t)(mt * 64 + i) * 512; }, [=](int j) { return WGLU + (size_t)(nt * 64 + j) * 512; }, lane);
#pragma unroll
        for (int m = 0; m < 4; ++m)
#pragma unroll
            for (int n = 0; n < 4; ++n)
#pragma unroll
                for (int g = 0; g < 4; ++g) { const size_t o = (size_t)(mt * 64 + m * 16 + 4 * q + g) * 512 + nt * 64 + n * 16 + r; YSG[o] = f2bf(bf2f(YPRE[o]) * sigmoidf_(acc[m][n][g])); }
    }
}

__device__ __forceinline__ void phase_merge(const Args& a, int lane, int gw, int GW) {
    const bf16_t* XB = (const bf16_t*)(a.ws + OFF_XB); const bf16_t* WIN = (const bf16_t*)(a.ws + OFF_WIN); const bf16_t* WB = (const bf16_t*)(a.ws + OFF_WB);
    bf16_t* MG = (bf16_t*)(a.ws + OFF_MERGED);
    const int r = lane & 15, q = lane >> 4;
    for (int u = gw; u < 512 * 16; u += GW) {
        const int mt = u / 16, nt = u % 16;
        f32x4 tot[2][4]; zero_acc(tot);
#pragma unroll 1
        for (int b = 0; b < 3; ++b) {
            const bf16_t* Y = (const bf16_t*)(a.ws + (b == 0 ? OFF_OM : b == 1 ? OFF_YSG : OFF_OH));
            f32x4 ag[2][4], ap[2][4]; zero_acc(ag); zero_acc(ap);
            wave_gemm<2, 4>(ag, 1024, [=](int i) { return XB + (size_t)(mt * 32 + i) * 1024; }, [=](int j) { return WIN + (size_t)(NZ + b * 1024 + nt * 64 + j) * 1024; }, lane);
            wave_gemm<2, 4>(ap, 512, [=](int i) { return Y + (size_t)(mt * 32 + i) * 512; }, [=](int j) { return WB + (size_t)(b * 1024 + nt * 64 + j) * 512; }, lane);
#pragma unroll
            for (int m = 0; m < 2; ++m)
#pragma unroll
                for (int n = 0; n < 4; ++n)
#pragma unroll
                    for (int g = 0; g < 4; ++g) tot[m][n][g] += sigmoidf_(ag[m][n][g]) * ap[m][n][g];
        }
#pragma unroll
        for (int m = 0; m < 2; ++m)
#pragma unroll
            for (int n = 0; n < 4; ++n)
#pragma unroll
                for (int g = 0; g < 4; ++g) MG[(size_t)(mt * 32 + m * 16 + 4 * q + g) * 1024 + nt * 64 + n * 16 + r] = f2bf(tot[m][n][g]);
    }
}

__device__ __forceinline__ void phase_wout(const Args& a, int l, int lane, int gw, int GW) {
    const bf16_t* MG = (const bf16_t*)(a.ws + OFF_MERGED); const bf16_t* WOUT = (const bf16_t*)(a.ws + OFF_WOUT);
    const float* xin = (l == 0) ? a.in[0] : a.out; float* XF = a.out;
    const int r = lane & 15, q = lane >> 4;
    for (int u = gw; u < 256 * 16; u += GW) {
        const int mt = u / 16, nt = u % 16;
        f32x4 acc[4][4]; zero_acc(acc);
        wave_gemm<4, 4>(acc, 1024, [=](int i) { return MG + (size_t)(mt * 64 + i) * 1024; }, [=](int j) { return WOUT + (size_t)(nt * 64 + j) * 1024; }, lane);
#pragma unroll
        for (int m = 0; m < 4; ++m)
#pragma unroll
            for (int n = 0; n < 4; ++n)
#pragma unroll
                for (int g = 0; g < 4; ++g) { const size_t o = (size_t)(mt * 64 + m * 16 + 4 * q + g) * 1024 + nt * 64 + n * 16 + r; XF[o] = DN_ALPHA * xin[o] + acc[m][n][g]; }
    }
}

__device__ __forceinline__ void ln_row(f32x4 (&v)[4], const float* gam, const float* bet, int lane) {
    float s = 0.f;
#pragma unroll
    for (int j = 0; j < 4; ++j) s += (v[j][0] + v[j][1]) + (v[j][2] + v[j][3]);
#pragma unroll
    for (int o = 32; o >= 1; o >>= 1) s += __shfl_xor(s, o);
    const float mean = s * (1.0f / 1024.0f); float qv = 0.f;
#pragma unroll
    for (int j = 0; j < 4; ++j) { const f32x4 dd = v[j] - mean; qv += (dd[0] * dd[0] + dd[1] * dd[1]) + (dd[2] * dd[2] + dd[3] * dd[3]); }
#pragma unroll
    for (int o = 32; o >= 1; o >>= 1) qv += __shfl_xor(qv, o);
    const float rstd = rsqrtf(qv * (1.0f / 1024.0f) + 1e-5f);
#pragma unroll
    for (int j = 0; j < 4; ++j) { const f32x4 gg = *(const f32x4*)(gam + 256 * j + 4 * lane), bb = *(const f32x4*)(bet + 256 * j + 4 * lane); v[j] = (v[j] - mean) * rstd * gg + bb; }
}

__device__ __forceinline__ void phase_ln1r(const Args& a, int l, int tid, int lane, int wave, int bid, int G) {
    float* XF = a.out; bf16_t* XB = (bf16_t*)(a.ws + OFF_XB);
    int* TOKE = (int*)(a.ws + OFF_TOKE); float* TOKG = (float*)(a.ws + OFF_TOKG); unsigned* CNT = (unsigned*)(a.ws + OFF_CTL);
    const float* RW = a.in[29]; const float* RB = a.in[30];
    float* XR = (float*)(smem + wave * 8192);
    unsigned* lh = (unsigned*)(smem + 65536);
    if (tid < 32) lh[tid] = 0u;
    __syncthreads();
    const int rs = lane >> 5, e = lane & 31;
    int* TE = (int*)(smem + 66048 + wave * 256); float* TG = (float*)(smem + 66048 + wave * 256 + 128);
    for (int tw = bid * 8 + wave; tw < T / 16; tw += G * 8)
    for (int t0 = tw * 16; t0 < tw * 16 + 16; t0 += 2) {
#pragma unroll
        for (int rr = 0; rr < 2; ++rr) { const int t = t0 + rr; f32x4 v[4];
#pragma unroll
            for (int j = 0; j < 4; ++j) v[j] = *(const f32x4*)(XF + (size_t)t * 1024 + 256 * j + 4 * lane);
            ln_row(v, a.in[25] + l * 1024, a.in[26] + l * 1024, lane);
#pragma unroll
            for (int j = 0; j < 4; ++j) { *(f32x4*)(XF + (size_t)t * 1024 + 256 * j + 4 * lane) = v[j]; *(f32x4*)(XR + rr * 1024 + 256 * j + 4 * lane) = v[j];
                u32x2 w; w.x = pack2(v[j][0], v[j][1]); w.y = pack2(v[j][2], v[j][3]); *(u32x2*)(XB + (size_t)t * 1024 + 256 * j + 4 * lane) = w; } }
        wave_sync();
        float acc = 0.f;
        for (int k = 0; k < 1024; k += 4) { const f32x4 xv = *(const f32x4*)(XR + rs * 1024 + k);
            acc += xv[0] * RW[(k + 0) * 32 + e]; acc += xv[1] * RW[(k + 1) * 32 + e]; acc += xv[2] * RW[(k + 2) * 32 + e]; acc += xv[3] * RW[(k + 3) * 32 + e]; }
        wave_sync();
        const float s = sigmoidf_(acc), sb = s + RB[e];
        float v4[4];
#pragma unroll
        for (int i = 0; i < 4; ++i) v4[i] = __shfl(sb, (lane & ~3) + i);
        int i1 = 0;
#pragma unroll
        for (int i = 1; i < 4; ++i) if (v4[i] > v4[i1]) i1 = i;
        int i2 = (i1 == 0) ? 1 : 0;
#pragma unroll
        for (int i = 0; i < 4; ++i) if (i != i1 && i != i2 && v4[i] > v4[i2]) i2 = i;
        float gs = v4[i1] + v4[i2]; int gid = e >> 2;
#pragma unroll
        for (int o = 4; o <= 16; o <<= 1) { const float os = __shfl_xor(gs, o); const int og = __shfl_xor(gid, o); if (os > gs || (os == gs && og < gid)) { gs = os; gid = og; } }
        float sv[4], sbv[4];
#pragma unroll
        for (int i = 0; i < 4; ++i) { sbv[i] = __shfl(sb, (lane & 32) + gid * 4 + i); sv[i] = __shfl(s, (lane & 32) + gid * 4 + i); }
        int j1 = 0;
#pragma unroll
        for (int i = 1; i < 4; ++i) if (sbv[i] > sbv[j1]) j1 = i;
        int j2 = (j1 == 0) ? 1 : 0;
#pragma unroll
        for (int i = 0; i < 4; ++i) if (i != j1 && i != j2 && sbv[i] > sbv[j2]) j2 = i;
        float s1 = sv[0], s2 = sv[0];
#pragma unroll
        for (int i = 1; i < 4; ++i) { if (i == j1) s1 = sv[i]; if (i == j2) s2 = sv[i]; }
        if (e == 0) { const int t = t0 + rs; const float inv = 1.0f / (s1 + s2);
            const int ti = t & 15; TE[ti * 2] = gid * 4 + j1; TE[ti * 2 + 1] = gid * 4 + j2; TG[ti * 2] = s1 * inv; TG[ti * 2 + 1] = s2 * inv;
            atomicAdd(&lh[gid * 4 + j1], 1u); atomicAdd(&lh[gid * 4 + j2], 1u); }
        if ((t0 & 15) == 14) { wave_sync(); if (lane < 32) { TOKE[(t0 - 14) * 2 + lane] = TE[lane]; TOKG[(t0 - 14) * 2 + lane] = TG[lane]; } wave_sync(); }
    }
    __syncthreads();
    if (tid < 32 && lh[tid]) atomicAdd(&CNT[tid], lh[tid]);
}

__device__ __forceinline__ void phase_slot(const Args& a, int tid, int bid, int G) {
    const int* TOKE = (const int*)(a.ws + OFF_TOKE); int* TOKS = (int*)(a.ws + OFF_TOKS); int* SLOTT = (int*)(a.ws + OFF_SLOTT);
    unsigned* CNT = (unsigned*)(a.ws + OFF_CTL); unsigned* BASE = CNT + 64;
    unsigned* base = (unsigned*)smem; unsigned* lc = base + 40; int* el = (int*)(base + 80);
    if (tid == 0) { unsigned s = 0; for (int e = 0; e < 32; ++e) { base[e] = s; s += (CNT[e] + 63u) & ~63u; } base[32] = s; }
    __syncthreads();
    if (bid == 0 && tid < 33) BASE[tid] = base[tid];
    for (int e = bid; e < 32; e += G) { const unsigned c = CNT[e]; for (unsigned s = base[e] + c + tid; s < base[e + 1]; s += 512) __hip_atomic_store(&SLOTT[s], 0, __ATOMIC_RELAXED, __HIP_MEMORY_SCOPE_AGENT); }
    for (int c = bid; c < T / 64; c += G) {
        if (tid < 32) lc[tid] = 0u;
        __syncthreads();
        for (int i = tid; i < c * 128; i += 512) atomicAdd(&lc[TOKE[i]], 1u);
        int e = 0;
        if (tid < 128) { e = TOKE[c * 128 + tid]; el[tid] = e; }
        __syncthreads();
        if (tid < 128) { unsigned rank = 0; for (int i = 0; i < tid; ++i) rank += (el[i] == e) ? 1u : 0u;
            const unsigned s = base[e] + lc[e] + rank; const int t = c * 64 + (tid >> 1);
            __hip_atomic_store(&SLOTT[s], t, __ATOMIC_RELAXED, __HIP_MEMORY_SCOPE_AGENT); TOKS[t * 2 + (tid & 1)] = (int)s; }
        __syncthreads();
    }
}

__device__ __forceinline__ void phase_moe_gu(const Args& a, int lane, int gw, int GW) {
    const bf16_t* XB = (const bf16_t*)(a.ws + OFF_XB); const bf16_t* WGU = (const bf16_t*)(a.ws + OFF_WGU); bf16_t* H = (bf16_t*)(a.ws + OFF_H);
    const int* SLOTT = (const int*)(a.ws + OFF_SLOTT); const unsigned* BASE = (const unsigned*)(a.ws + OFF_CTL) + 64;
    const int r = lane & 15, q = lane >> 4; const int ntile = (int)(BASE[32] >> 5);
    for (int u = gw; u < ntile * 4; u += GW) {
        const int rt = u / 4, hc = u % 4; int e = 0; while (e < 31 && BASE[e + 1] <= (unsigned)(rt * 32)) ++e;
        f32x4 acc[2][8]; zero_acc(acc);
        wave_gemm<2, 8>(acc, 1024, [=](int i) { return XB + (size_t)SLOTT[rt * 32 + i] * 1024; },
            [=](int j) { const int hid = hc * 64 + (j & 63), row = (hid >> 7) * 256 + (hid & 127) + (j >> 6) * 128; return WGU + ((size_t)e * 512 + row) * 1024; }, lane);
#pragma unroll
        for (int m = 0; m < 2; ++m)
#pragma unroll
            for (int n = 0; n < 4; ++n)
#pragma unroll
                for (int g = 0; g < 4; ++g) H[(size_t)(rt * 32 + m * 16 + 4 * q + g) * 256 + hc * 64 + n * 16 + r] = f2bf(siluf_(acc[m][n][g]) * acc[m][n + 4][g]);
    }
}
__device__ __forceinline__ void phase_moe_dn(const Args& a, int lane, int gw, int GW) {
    const bf16_t* H = (const bf16_t*)(a.ws + OFF_H); const bf16_t* WD = (const bf16_t*)(a.ws + OFF_WD); bf16_t* YS = (bf16_t*)(a.ws + OFF_YS);
    const unsigned* BASE = (const unsigned*)(a.ws + OFF_CTL) + 64;
    const int r = lane & 15, q = lane >> 4; const int ntile = (int)(BASE[32] >> 6);
    for (int u = gw; u < ntile * 16; u += GW) {
        const int rt = u / 16, nc = u % 16; int e = 0; while (e < 31 && BASE[e + 1] <= (unsigned)(rt * 64)) ++e;
        f32x4 acc[4][4]; zero_acc(acc);
        wave_gemm<4, 4>(acc, 256, [=](int i) { return H + (size_t)(rt * 64 + i) * 256; }, [=](int j) { return WD + ((size_t)e * 1024 + nc * 64 + j) * 256; }, lane);
#pragma unroll
        for (int m = 0; m < 4; ++m)
#pragma unroll
            for (int n = 0; n < 4; ++n)
#pragma unroll
                for (int g = 0; g < 4; ++g) YS[(size_t)(rt * 64 + m * 16 + 4 * q + g) * 1024 + nc * 64 + n * 16 + r] = f2bf(acc[m][n][g]);
    }
}

__device__ __forceinline__ void phase_ln2(const Args& a, int l, int lane, int gw, int GW) {
    float* XF = a.out; bf16_t* XB = (bf16_t*)(a.ws + OFF_XB); const bf16_t* YS = (const bf16_t*)(a.ws + OFF_YS);
    const int* TOKS = (const int*)(a.ws + OFF_TOKS); const float* TOKG = (const float*)(a.ws + OFF_TOKG);
    for (int t = gw; t < T; t += GW) {
        const int s0 = TOKS[t * 2], s1 = TOKS[t * 2 + 1]; const float g0 = TOKG[t * 2], g1 = TOKG[t * 2 + 1];
        f32x4 v[4];
#pragma unroll
        for (int j = 0; j < 4; ++j) { const f32x4 x1 = *(const f32x4*)(XF + (size_t)t * 1024 + 256 * j + 4 * lane);
            const bf16x4 y0 = *(const bf16x4*)(YS + (size_t)s0 * 1024 + 256 * j + 4 * lane), y1 = *(const bf16x4*)(YS + (size_t)s1 * 1024 + 256 * j + 4 * lane);
#pragma unroll
            for (int g = 0; g < 4; ++g) v[j][g] = DN_ALPHA * x1[g] + g0 * bf2f((bf16_t)y0[g]) + g1 * bf2f((bf16_t)y1[g]); }
        ln_row(v, a.in[27] + l * 1024, a.in[28] + l * 1024, lane);
#pragma unroll
        for (int j = 0; j < 4; ++j) { *(f32x4*)(XF + (size_t)t * 1024 + 256 * j + 4 * lane) = v[j];
            u32x2 w; w.x = pack2(v[j][0], v[j][1]); w.y = pack2(v[j][2], v[j][3]); *(u32x2*)(XB + (size_t)t * 1024 + 256 * j + 4 * lane) = w; }
    }
}

__device__ __forceinline__ const Args& fresh_args() { const void* p = (const void*)__builtin_amdgcn_kernarg_segment_ptr(); asm volatile("" : "+s"(p)); return *(const Args*)p; }
__global__ void __launch_bounds__(512) fwd(Args a_unused) {
    cg::grid_group grid = cg::this_grid();
#define GSYNC() do { asm volatile("" ::: "memory"); grid.sync(); asm volatile("" ::: "memory"); } while (0)
#define PH(body) do { int tid = threadIdx.x; asm volatile("" : "+v"(tid)); int bid = blockIdx.x, G = gridDim.x; asm volatile("" : "+s"(bid), "+s"(G)); \
        const int lane = tid & 63, wave = __builtin_amdgcn_readfirstlane(tid >> 6), gw = bid * 8 + wave, GW = G * 8; (void)lane; (void)wave; (void)gw; (void)GW; const Args& a = fresh_args(); body; } while (0)
#pragma unroll 1
    for (int l = 0; l < NLAYER; ++l) {
        PH(phase_prep(a, l, tid, bid, G)); GSYNC();
        PH(phase_zgemm(a, lane, gw, GW)); GSYNC();
        PH(phase_mprep(a, l, tid, bid, G)); GSYNC();
        PH(phase_mqkv(a, lane, gw, GW)); GSYNC();
        PH(phase_mixers<1>(a, l, tid, lane, wave, bid, G)); GSYNC();
        PH(phase_mixers<2>(a, l, tid, lane, wave, bid, G)); GSYNC();
        PH(phase_post(a, l, lane, gw, GW)); GSYNC();
        PH(phase_glu(a, lane, gw, GW)); PH(phase_prepx(a, l, tid, bid, G)); GSYNC();
        PH(phase_merge(a, lane, gw, GW)); GSYNC();
        PH(phase_wout(a, l, lane, gw, GW)); GSYNC();
        PH(phase_ln1r(a, l, tid, lane, wave, bid, G)); GSYNC();
        PH(phase_slot(a, tid, bid, G)); GSYNC();
        PH(phase_moe_gu(a, lane, gw, GW)); GSYNC();
        PH(phase_moe_dn(a, lane, gw, GW)); GSYNC();
        PH(phase_ln2(a, l, lane, gw, GW)); if (l + 1 < NLAYER) GSYNC();
    }
}

extern "C" void kernel_launch(void* const* d_in, const int* in_sizes, int n_in, void* d_out, int out_size, void* d_ws, size_t ws_size, hipStream_t stream) {
    static int grid = 0;
    if (grid == 0) {
        if (n_in != 34 || out_size != T * D || ws_size < WS_END) { fprintf(stderr, "kernel_launch: unexpected shapes (n_in %d, out %d, ws %zu, need %zu)\n", n_in, out_size, ws_size, (size_t)WS_END); grid = -1; return; }
        int dev = 0, cus = 0, per_cu = 0;
        (void)hipGetDevice(&dev); (void)hipDeviceGetAttribute(&cus, hipDeviceAttributeMultiprocessorCount, dev);
        (void)hipFuncSetAttribute((const void*)fwd, hipFuncAttributeMaxDynamicSharedMemorySize, LDS_BYTES);
        (void)hipOccupancyMaxActiveBlocksPerMultiprocessor(&per_cu, (const void*)fwd, 512, LDS_BYTES);
        if (per_cu < 1) { fprintf(stderr, "kernel_launch: occupancy query says %d blocks per CU\n", per_cu); per_cu = 1; }
        grid = (cus > 0 ? cus : 256) * 1;
        (void)hipGetLastError();
    }
    if (grid < 0) return;
    Args a{};
    for (int i = 0; i < 34; ++i) a.in[i] = (const float*)d_in[i];
    a.out = (float*)d_out; a.ws = (unsigned char*)d_ws; a.ph_lo = 0; a.ph_hi = NLAYER * NPH;
    void* args[] = {&a};
    hipError_t e = hipLaunchCooperativeKernel((const void*)fwd, dim3(grid), dim3(512), args, LDS_BYTES, stream);
    if (e != hipSuccess) fprintf(stderr, "kernel_launch: cooperative launch failed: %s (grid %d)\n", hipGetErrorString(e), grid);
}
```

```cpp
#include <hip/hip_runtime.h>
#include <hip/hip_cooperative_groups.h>
#include <cstdio>
#include <cstdint>
namespace cg = cooperative_groups;

typedef unsigned short bf16_t;
typedef short bf16x8 __attribute__((ext_vector_type(8)));
typedef short bf16x4 __attribute__((ext_vector_type(4)));
typedef float f32x4 __attribute__((ext_vector_type(4)));
typedef unsigned u32x4 __attribute__((ext_vector_type(4)));
typedef unsigned u32x2 __attribute__((ext_vector_type(2)));

constexpr int T = 16384, D = 1024, NZ = 3584, NWIN = 6912, INW = 6664;
constexpr int NPH = 15, NLAYER = 2;
constexpr int GSEG = 32, GSEGLEN = 512;
constexpr int SSEG = 64, SSEGLEN = 256;
constexpr int SLOTS = 32768 + 2048;
constexpr float DN_ALPHA = 1.41421356237f;
constexpr int LDS_BYTES = 131072;

constexpr size_t AL(size_t x) { return (x + 255) & ~(size_t)255; }
constexpr size_t OFF_WIN = 0;
constexpr size_t OFF_WQKV = OFF_WIN + AL((size_t)NWIN * 1024 * 2);
constexpr size_t OFF_WGLU = OFF_WQKV + AL((size_t)12 * 128 * 128 * 2);
constexpr size_t OFF_WB = OFF_WGLU + AL((size_t)512 * 512 * 2);
constexpr size_t OFF_WOUT = OFF_WB + AL((size_t)3 * 1024 * 512 * 2);
constexpr size_t OFF_ABAR = OFF_WOUT + AL((size_t)1024 * 1024 * 2);
constexpr size_t OFF_BBT = OFF_ABAR + AL((size_t)32 * 64 * 2 * 4);
constexpr size_t OFF_CCT = OFF_BBT + AL((size_t)32 * 128 * 16 * 2);
constexpr size_t OFF_CTL = OFF_CCT + AL((size_t)32 * 16 * 128 * 2);
constexpr size_t OFF_TOKE = OFF_CTL + 4096;
constexpr size_t OFF_TOKG = OFF_TOKE + AL((size_t)T * 2 * 4);
constexpr size_t OFF_TOKS = OFF_TOKG + AL((size_t)T * 2 * 4);
constexpr size_t OFF_SLOTT = OFF_TOKS + AL((size_t)T * 2 * 4);
constexpr size_t OFF_XB = OFF_SLOTT + AL((size_t)SLOTS * 4);
constexpr size_t OFF_R1 = OFF_XB + AL((size_t)T * 1024 * 2);
constexpr size_t SZ_ACT = (size_t)T * 512 * 2;
constexpr size_t OFF_XC = OFF_R1, OFF_Q = OFF_R1 + SZ_ACT, OFF_KH = OFF_R1 + 2 * SZ_ACT, OFF_V = OFF_R1 + 3 * SZ_ACT;
constexpr size_t OFF_WGU = OFF_R1, OFF_WD = OFF_R1 + (size_t)32 * 512 * 1024 * 2;
constexpr size_t OFF_Z = OFF_R1 + 4 * SZ_ACT;
constexpr size_t OFF_MERGED = OFF_Z, OFF_H = OFF_Z + (size_t)T * 1024 * 2;
constexpr size_t OFF_ZS = OFF_Z + AL((size_t)T * NZ * 2);
constexpr size_t OFF_LF = OFF_ZS + AL((size_t)T * 8 * 4);
constexpr size_t OFF_LI = OFF_LF + AL((size_t)T * 4 * 4);
constexpr size_t OFF_E = OFF_LI + AL((size_t)T * 4 * 4);
constexpr size_t OFF_OM = OFF_E, OFF_OH = OFF_E + SZ_ACT, OFF_YPRE = OFF_E + 2 * SZ_ACT, OFF_YSG = OFF_E + 3 * SZ_ACT;
constexpr size_t OFF_DEN = OFF_E + 4 * SZ_ACT;
constexpr size_t OFF_EM = OFF_DEN + AL((size_t)T * 4 * 4);
constexpr size_t OFF_EMX = OFF_EM + AL((size_t)GSEG * 4 * 128 * 128 * 4);
constexpr size_t OFF_GM = OFF_EMX + AL((size_t)GSEG * 4 * 128 * 16 * 4);
constexpr size_t OFF_EH = OFF_GM + AL((size_t)GSEG * 4 * 128 * 4);
constexpr size_t OFF_GH = OFF_EH + AL((size_t)GSEG * 4 * 128 * 128 * 4);
constexpr size_t OFF_ES = OFF_GH + AL((size_t)GSEG * 4 * 128 * 4);
constexpr size_t WS_END = OFF_ES + AL((size_t)SSEG * 32 * 64 * 2 * 4);
constexpr size_t OFF_YS = OFF_E;
static_assert(OFF_YS + (size_t)SLOTS * 1024 * 2 <= WS_END, "YS must fit in the dead region");
static_assert(OFF_H + (size_t)SLOTS * 256 * 2 <= OFF_ZS, "H must fit in the dead Z region");
static_assert(OFF_WD + (size_t)32 * 1024 * 256 * 2 <= OFF_Z, "expert weights must fit in R1");

struct Args { const float* in[34]; float* out; unsigned char* ws; int ph_lo, ph_hi; };
typedef const __attribute__((address_space(4))) Args& ArgsRef;

extern __shared__ __attribute__((aligned(16))) unsigned char smem[];

__device__ __forceinline__ bf16_t f2bf(float f) { unsigned u = __float_as_uint(f); u += 0x7FFFu + ((u >> 16) & 1u); return (bf16_t)(u >> 16); }
__device__ __forceinline__ float bf2f(bf16_t b) { return __uint_as_float(((unsigned)b) << 16); }
__device__ __forceinline__ unsigned pack2(float lo, float hi) { return (unsigned)f2bf(lo) | ((unsigned)f2bf(hi) << 16); }
__device__ __forceinline__ float sigmoidf_(float x) { return 1.0f / (1.0f + expf(-x)); }
__device__ __forceinline__ float siluf_(float x) { return x / (1.0f + expf(-x)); }
__device__ __forceinline__ float logsigmoidf_(float x) { return fminf(x, 0.f) - log1pf(expf(-fabsf(x))); }
__device__ __forceinline__ float gelu_tanh(float y) { const float z = 0.7978845608028654f * (y + 0.044715f * y * y * y); const float th = 1.0f - 2.0f / (expf(2.0f * z) + 1.0f); return 0.5f * y * (1.0f + th); }
__device__ __forceinline__ void wave_sync() { __builtin_amdgcn_wave_barrier(); asm volatile("s_waitcnt lgkmcnt(0)" ::: "memory"); __builtin_amdgcn_wave_barrier(); }

#define MFMA16(a, b, c) __builtin_amdgcn_mfma_f32_16x16x32_bf16((a), (b), (c), 0, 0, 0)

template <int MT, int NT, class FA, class FB>
__device__ __forceinline__ void wave_gemm(f32x4 (&acc)[MT][NT], int K, FA arow, FB brow, int lane) {
    const int r = lane & 15, q = lane >> 4;
    const bf16_t* ap[MT]; const bf16_t* bp[NT];
#pragma unroll
    for (int m = 0; m < MT; ++m) ap[m] = arow(m * 16 + r) + 8 * q;
#pragma unroll
    for (int n = 0; n < NT; ++n) bp[n] = brow(n * 16 + r) + 8 * q;
#pragma unroll 1
    for (int k = 0; k < K; k += 32) {
        bf16x8 a[MT], b[NT];
#pragma unroll
        for (int m = 0; m < MT; ++m) a[m] = *(const bf16x8*)(ap[m] + k);
#pragma unroll
        for (int n = 0; n < NT; ++n) b[n] = *(const bf16x8*)(bp[n] + k);
#pragma unroll
        for (int m = 0; m < MT; ++m)
#pragma unroll
            for (int n = 0; n < NT; ++n) acc[m][n] = MFMA16(a[m], b[n], acc[m][n]);
    }
}
template <int MT, int NT> __device__ __forceinline__ void zero_acc(f32x4 (&acc)[MT][NT]) {
#pragma unroll
    for (int m = 0; m < MT; ++m)
#pragma unroll
        for (int n = 0; n < NT; ++n) acc[m][n] = (f32x4){0.f, 0.f, 0.f, 0.f};
}

namespace pg8 {
#define PG8_LAS __attribute__((address_space(3)))
constexpr int BM = 256, BK = 64, HALF = 128, HTB = HALF * BK * 2, STAGE_BYTES = 8 * HTB;
__device__ __forceinline__ int lds_byte(int r, int c) { const int st = (r >> 4) * 2 + (c >> 5), rr = r & 15, cc = c & 31, ob = rr * 64 + cc * 2; return st * 1024 + (ob ^ (((ob >> 9) & 1) << 5)); }
__device__ __forceinline__ void stage_rc(int b, int& R, int& C) { const int st = b / 1024, sb = b % 1024, swz = sb ^ (((sb >> 9) & 1) << 5); R = (st >> 1) * 16 + swz / 64; C = (st & 1) * 32 + (swz % 64) / 2; }
__device__ __forceinline__ int perm32(int rho) { const int n = rho >> 4, i = rho & 15; return 8 * (i >> 2) + 4 * n + (i & 3); }
struct Unit { int pm, pn, tag; const char* A; const char* B; };
__device__ __forceinline__ unsigned cvt_pk_bf16(float lo, float hi) { unsigned r; asm volatile("v_cvt_pk_bf16_f32 %0, %1, %2" : "=v"(r) : "v"(lo), "v"(hi)); return r; }
__device__ __forceinline__ bool tile_order(int L, int nM, int nN, int& pm, int& pn) {
    const int nwg = nM * nN; if (L >= nwg) return false;
    int wgid = L; { const int q = nwg / 8, r = nwg % 8, xcd = wgid % 8, off = wgid / 8; wgid = (xcd < r ? xcd * (q + 1) : r * (q + 1) + (xcd - r) * q) + off; }
    const int nig = 8 * nN, gid = wgid / nig, fm = gid * 8, gsz = (nM - fm) < 8 ? (nM - fm) : 8;
    pm = fm + ((wgid % nig) % gsz); pn = (wgid % nig) / gsz; return true;
}
template <class Epi, class Sched>
__device__ __forceinline__ void gemm_phase(PG8_LAS unsigned char* lds, const int tid, const int K, const int lda, const int ldb, const Sched& S, const Epi& E) {
    const int wid = __builtin_amdgcn_readfirstlane(tid >> 6), lane = tid & 63, wr = wid >> 2, wc = wid & 3, fr = lane & 15, fq = lane >> 4;
    const int nt = K / BK;
    unsigned voffA[2], voffB[2];
#pragma unroll
    for (int i = 0; i < 2; ++i) { int R, C; stage_rc(tid * 16 + i * 8192, R, C); const int Rb = Epi::PERM ? ((R & ~31) + perm32(R & 31)) : R;
        voffA[i] = (unsigned)(R * lda + C) * 2u; voffB[i] = (unsigned)(Rb * ldb + C) * 2u; }
    const size_t kstep = (size_t)(BK * 2), hstepA = (size_t)HALF * lda * 2, hstepB = (size_t)HALF * ldb * 2;
    const unsigned ldsw = (unsigned)wid * 1024u;
    const int aoff = lds_byte(wr * 64 + fr, fq * 8), boff = lds_byte(wc * 32 + fr, fq * 8);
#define PG8_SA(b, h) (((b) * 2 + (h)) * HTB)
#define PG8_SB(b, h) ((4 + (b) * 2 + (h)) * HTB)
#define PG8_STAGE(bufoff, gbase, voff) do { _Pragma("unroll") for (int _i = 0; _i < 2; ++_i) \
        __builtin_amdgcn_global_load_lds((const unsigned*)((const char*)(gbase) + (voff)[_i]), (PG8_LAS unsigned*)(lds + (bufoff) + ldsw + _i * 8192), 16, 0, 0); } while (0)
#define PG8_LDA(dst, b, h) do { _Pragma("unroll") for (int m = 0; m < 4; ++m) _Pragma("unroll") for (int k = 0; k < 2; ++k) dst[m][k] = *(const PG8_LAS bf16x8*)(lds + PG8_SA(b, h) + aoff + m * 2048 + k * 1024); } while (0)
#define PG8_LDB(dst, b, h) do { _Pragma("unroll") for (int n = 0; n < 2; ++n) _Pragma("unroll") for (int k = 0; k < 2; ++k) dst[n][k] = *(const PG8_LAS bf16x8*)(lds + PG8_SB(b, h) + boff + n * 2048 + k * 1024); } while (0)
#define PG8_MMA(ai, bj, At, Bt) do { __builtin_amdgcn_s_setprio(1); _Pragma("unroll") for (int m = 0; m < 4; ++m) _Pragma("unroll") for (int n = 0; n < 2; ++n) _Pragma("unroll") for (int k = 0; k < 2; ++k) \
        acc[ai][bj][m][n] = __builtin_amdgcn_mfma_f32_16x16x32_bf16(Bt[n][k], At[m][k], acc[ai][bj][m][n], 0, 0, 0); __builtin_amdgcn_s_setprio(0); } while (0)
#define PG8_WAIT_V(n) asm volatile("s_waitcnt vmcnt(" #n ")" ::: "memory")
#define PG8_WAIT_L(n) asm volatile("s_waitcnt lgkmcnt(" #n ")" ::: "memory")
#define PG8_BAR __builtin_amdgcn_s_barrier()
#define PG8_SCHED __builtin_amdgcn_sched_barrier(0)
    Unit cur, nxt; int ui = 0;
    if (!S.next(0, cur)) return;
    f32x4 acc[2][2][4][2];
#pragma unroll
    for (int a = 0; a < 2; ++a)
#pragma unroll
        for (int b = 0; b < 2; ++b)
#pragma unroll
            for (int m = 0; m < 4; ++m)
#pragma unroll
                for (int n = 0; n < 2; ++n) acc[a][b][m][n] = (f32x4){0.f, 0.f, 0.f, 0.f};
    bf16x8 At[4][2], B0[2][2], B1[2][2];
    const char* cA = cur.A; const char* cB = cur.B;
    PG8_STAGE(PG8_SB(0, 0), cB, voffB); PG8_STAGE(PG8_SA(0, 0), cA, voffA); PG8_STAGE(PG8_SB(0, 1), cB + hstepB, voffB); PG8_STAGE(PG8_SA(0, 1), cA + hstepA, voffA);
    if (wr == 1) PG8_BAR;
    PG8_WAIT_V(4); PG8_BAR;
    PG8_STAGE(PG8_SB(1, 0), cB + kstep, voffB); PG8_STAGE(PG8_SA(1, 0), cA + kstep, voffA); PG8_STAGE(PG8_SB(1, 1), cB + hstepB + kstep, voffB);
    PG8_WAIT_V(6); PG8_BAR;
    for (;;) {
        const bool has_next = S.next(ui + 1, nxt);
        const char* nA = has_next ? nxt.A : cA; const char* nB = has_next ? nxt.B : cB;
        for (int t = 0; t < nt; t += 2) {
            const bool last = (t == nt - 2);
            const char* a1 = cA + (size_t)(t + 1) * kstep;
            const char* a2 = last ? nA : cA + (size_t)(t + 2) * kstep; const char* b2 = last ? nB : cB + (size_t)(t + 2) * kstep;
            const char* a3 = a2 + kstep; const char* b3 = b2 + kstep;
            PG8_LDB(B0, 0, 0); PG8_SCHED; PG8_LDA(At, 0, 0); PG8_STAGE(PG8_SA(1, 1), a1 + hstepA, voffA);
            PG8_WAIT_L(8); PG8_BAR; PG8_WAIT_L(0); PG8_MMA(0, 0, At, B0); PG8_BAR; PG8_SCHED;
            PG8_LDB(B1, 0, 1); PG8_STAGE(PG8_SB(0, 0), b2, voffB);
            PG8_BAR; PG8_WAIT_L(0); PG8_MMA(0, 1, At, B1); PG8_BAR;
            PG8_LDA(At, 0, 1); PG8_STAGE(PG8_SA(0, 0), a2, voffA);
            PG8_BAR; PG8_WAIT_L(0); PG8_MMA(1, 0, At, B0); PG8_BAR; PG8_SCHED;
            PG8_STAGE(PG8_SB(0, 1), b2 + hstepB, voffB);
            PG8_WAIT_V(6); PG8_BAR; PG8_MMA(1, 1, At, B1); PG8_BAR;
            PG8_LDB(B0, 1, 0); PG8_SCHED; PG8_LDA(At, 1, 0); PG8_STAGE(PG8_SA(0, 1), a2 + hstepA, voffA);
            PG8_WAIT_L(8); PG8_BAR; PG8_WAIT_L(0); PG8_MMA(0, 0, At, B0); PG8_BAR; PG8_SCHED;
            PG8_LDB(B1, 1, 1); PG8_STAGE(PG8_SB(1, 0), b3, voffB);
            PG8_BAR; PG8_WAIT_L(0); PG8_MMA(0, 1, At, B1); PG8_BAR;
            PG8_LDA(At, 1, 1); PG8_STAGE(PG8_SA(1, 0), a3, voffA);
            PG8_BAR; PG8_WAIT_L(0); PG8_MMA(1, 0, At, B0); PG8_BAR; PG8_SCHED;
            PG8_STAGE(PG8_SB(1, 1), b3 + hstepB, voffB);
            PG8_WAIT_V(6); PG8_BAR; PG8_MMA(1, 1, At, B1); PG8_BAR;
        }
        const bool keep = E(acc, cur, wr, wc, fr, fq);
        if (!has_next) break;
        if (!keep) {
#pragma unroll
            for (int a = 0; a < 2; ++a)
#pragma unroll
                for (int b = 0; b < 2; ++b)
#pragma unroll
                    for (int m = 0; m < 4; ++m)
#pragma unroll
                        for (int n = 0; n < 2; ++n) acc[a][b][m][n] = (f32x4){0.f, 0.f, 0.f, 0.f};
        }
        cur = nxt; cA = nA; cB = nB; ++ui;
    }
    PG8_WAIT_V(0);
    if (wr == 0) PG8_BAR;
    PG8_BAR;
#undef PG8_SA
#undef PG8_SB
#undef PG8_STAGE
#undef PG8_LDA
#undef PG8_LDB
#undef PG8_MMA
#undef PG8_WAIT_V
#undef PG8_WAIT_L
#undef PG8_BAR
#undef PG8_SCHED
}
}

__device__ __forceinline__ void tconv_tile(const float* src, int ld_src, int nvalid, bf16_t* dst, int ld_dst, int tid) {
    float* t = (float*)smem;
    { const int r = tid >> 3, c0 = (tid & 7) * 8;
#pragma unroll
      for (int j = 0; j < 8; ++j) { const int c = c0 + j; const float v = (c < nvalid) ? src[(size_t)r * ld_src + c] : 0.f; t[c * 65 + r] = v; } }
    __syncthreads();
    { const int n = tid >> 3, k0 = (tid & 7) * 8; const float* p = t + n * 65 + k0;
      u32x4 w; w.x = pack2(p[0], p[1]); w.y = pack2(p[2], p[3]); w.z = pack2(p[4], p[5]); w.w = pack2(p[6], p[7]);
      *(u32x4*)(dst + (size_t)n * ld_dst + k0) = w; }
    __syncthreads();
}

__device__ __forceinline__ void phase_prep(ArgsRef a, int l, int tid, int bid, int G) {
    unsigned char* ws = a.ws;
    bf16_t* WIN = (bf16_t*)(ws + OFF_WIN); bf16_t* WQKV = (bf16_t*)(ws + OFF_WQKV); bf16_t* WGLU = (bf16_t*)(ws + OFF_WGLU);
    bf16_t* WB = (bf16_t*)(ws + OFF_WB); bf16_t* WOUT = (bf16_t*)(ws + OFF_WOUT);
    for (int u = bid; u < 2480; u += G) {
        const float* src; int lds_ = 0, nvalid = 64, ldd = 0; bf16_t* dst;
        if (u < 1728) { const int nt = u / 16, kt = u % 16, p0 = nt * 64; int sc;
            if (p0 < 1024) sc = p0; else if (p0 < 6656) sc = p0 + 8; else if (p0 == 6656) { sc = 1024; nvalid = 8; } else { sc = 0; nvalid = 0; }
            src = a.in[1] + (size_t)l * 1024 * INW + (size_t)(kt * 64) * INW + sc; lds_ = INW; dst = WIN + (size_t)p0 * 1024 + kt * 64; ldd = 1024; }
        else if (u < 1776) { const int v = u - 1728, m = v / 4, tt = v % 4, nt = tt >> 1, kt = tt & 1, which = m / 4, h = m % 4;
            src = a.in[4 + which] + (size_t)(l * 4 + h) * 128 * 128 + (kt * 64) * 128 + nt * 64; lds_ = 128; dst = WQKV + (size_t)m * 128 * 128 + (nt * 64) * 128 + kt * 64; ldd = 128; }
        else if (u < 1840) { const int v = u - 1776, nt = v / 8, kt = v % 8;
            src = a.in[18] + (size_t)l * 512 * 512 + (kt * 64) * 512 + nt * 64; lds_ = 512; dst = WGLU + (size_t)(nt * 64) * 512 + kt * 64; ldd = 512; }
        else if (u < 2224) { const int v = u - 1840, b = v / 128, w = v % 128, nt = w / 8, kt = w % 8;
            src = a.in[21 + b] + (size_t)l * 512 * 1024 + (size_t)(kt * 64) * 1024 + nt * 64; lds_ = 1024; dst = WB + (size_t)b * 1024 * 512 + (size_t)(nt * 64) * 512 + kt * 64; ldd = 512; }
        else { const int v = u - 2224, nt = v / 16, kt = v % 16;
            src = a.in[24] + (size_t)l * 1024 * 1024 + (size_t)(kt * 64) * 1024 + nt * 64; lds_ = 1024; dst = WOUT + (size_t)(nt * 64) * 1024 + kt * 64; ldd = 1024; }
        tconv_tile(src, lds_, nvalid, dst, ldd, tid);
    }
    float* ABAR = (float*)(ws + OFF_ABAR); bf16_t* BBT = (bf16_t*)(ws + OFF_BBT); bf16_t* CCT = (bf16_t*)(ws + OFF_CCT);
    for (int i = bid * 512 + tid; i < 2048; i += G * 512) {
        const int g = i / 64, p = i % 64; const size_t gp = (size_t)(l * 32 + g) * 64 + p;
        const float lr = fminf(a.in[10][gp], -1e-4f), li = a.in[11][gp], dt = expf(a.in[12][l * 32 + g]);
        const float mag = expf(lr * dt), abr = mag * cosf(li * dt), abi = mag * sinf(li * dt);
        const float nr = abr - 1.0f, den = lr * lr + li * li, cr = (nr * lr + abi * li) / den, ci = (abi * lr - nr * li) / den;
        ABAR[(g * 64 + p) * 2] = abr; ABAR[(g * 64 + p) * 2 + 1] = abi;
        for (int c = 0; c < 16; ++c) { const float br = a.in[13][gp * 16 + c], bi = a.in[14][gp * 16 + c];
            BBT[(size_t)(g * 128 + p) * 16 + c] = f2bf(cr * br - ci * bi); BBT[(size_t)(g * 128 + 64 + p) * 16 + c] = f2bf(cr * bi + ci * br);
            const size_t ci_ = ((size_t)(l * 32 + g) * 16 + c) * 64 + p;
            CCT[(size_t)(g * 16 + c) * 128 + p] = f2bf(a.in[15][ci_]); CCT[(size_t)(g * 16 + c) * 128 + 64 + p] = f2bf(-a.in[16][ci_]); }
    }
    if (bid == 0 && tid < 128) ((unsigned*)(ws + OFF_CTL))[tid] = 0u;
    if (l == 0) { bf16_t* XB = (bf16_t*)(ws + OFF_XB); const float* x = a.in[0];
        for (size_t i = (size_t)bid * 512 + tid; i < (size_t)T * 1024 / 8; i += (size_t)G * 512) {
            const f32x4 v0 = *(const f32x4*)(x + i * 8), v1 = *(const f32x4*)(x + i * 8 + 4);
            u32x4 w; w.x = pack2(v0[0], v0[1]); w.y = pack2(v0[2], v0[3]); w.z = pack2(v1[0], v1[1]); w.w = pack2(v1[2], v1[3]); *(u32x4*)(XB + i * 8) = w; } }
}

__device__ __forceinline__ void phase_prepx(ArgsRef a, int l, int tid, int bid, int G) {
    bf16_t* WGU = (bf16_t*)(a.ws + OFF_WGU); bf16_t* WD = (bf16_t*)(a.ws + OFF_WD);
    for (int u = bid; u < 6144; u += G) {
        const float* src; int lds_, ldd; bf16_t* dst;
        if (u < 4096) { const int up = u >= 2048, v = u & 2047, e = v / 64, w = v % 64, nt = w / 16, kt = w % 16, j0 = nt * 64, drow = (j0 / 128) * 256 + (j0 % 128) + up * 128;
            src = a.in[31 + up] + ((size_t)(l * 32 + e) * 1024 + kt * 64) * 256 + nt * 64; lds_ = 256; dst = WGU + ((size_t)e * 512 + drow) * 1024 + kt * 64; ldd = 1024; }
        else { const int v = u - 4096, e = v / 64, w = v % 64, nt = w / 4, kt = w % 4;
            src = a.in[33] + ((size_t)(l * 32 + e) * 256 + kt * 64) * 1024 + nt * 64; lds_ = 1024; dst = WD + ((size_t)e * 1024 + nt * 64) * 256 + kt * 64; ldd = 256; }
        tconv_tile(src, lds_, 64, dst, ldd, tid);
    }
}

__device__ __forceinline__ void phase_zgemm(ArgsRef a, int lane, int gw, int GW) {
    const bf16_t* XB = (const bf16_t*)(a.ws + OFF_XB); const bf16_t* WIN = (const bf16_t*)(a.ws + OFF_WIN);
    bf16_t* Z = (bf16_t*)(a.ws + OFF_Z); float* ZS = (float*)(a.ws + OFF_ZS);
    const int r = lane & 15, q = lane >> 4;
    for (int u = gw; u < 256 * 57; u += GW) {
        const int mt = u / 57, nt = u % 57, nc0 = nt < 56 ? nt * 64 : 6656;
        f32x4 acc[4][4]; zero_acc(acc);
        wave_gemm<4, 4>(acc, 1024, [=](int i) { return XB + (size_t)(mt * 64 + i) * 1024; }, [=](int j) { return WIN + (size_t)(nc0 + j) * 1024; }, lane);
#pragma unroll
        for (int m = 0; m < 4; ++m)
#pragma unroll
            for (int n = 0; n < 4; ++n)
#pragma unroll
                for (int g = 0; g < 4; ++g) { const int row = mt * 64 + m * 16 + 4 * q + g, col = n * 16 + r;
                    if (nt < 56) Z[(size_t)row * NZ + nt * 64 + col] = f2bf(acc[m][n][g]); else if (n == 0 && r < 8) ZS[row * 8 + r] = acc[m][n][g]; }
    }
}

__device__ __forceinline__ void phase_mprep(ArgsRef a, int l, int tid, int bid, int G) {
    const bf16_t* Z = (const bf16_t*)(a.ws + OFF_Z); bf16_t* XC = (bf16_t*)(a.ws + OFF_XC);
    const float* cw = a.in[2] + (size_t)l * 4 * 512; const float* cb = a.in[3] + (size_t)l * 512;
    for (int idx = bid * 512 + tid; idx < T * 64; idx += G * 512) {
        const int t = idx / 64, c0 = (idx % 64) * 8; float acc[8];
#pragma unroll
        for (int j = 0; j < 8; ++j) acc[j] = cb[c0 + j];
#pragma unroll
        for (int k = 0; k < 4; ++k) { const int ts = t - 3 + k; if (ts >= 0) { const bf16x8 v = *(const bf16x8*)(Z + (size_t)ts * NZ + c0);
#pragma unroll
                for (int j = 0; j < 8; ++j) acc[j] += cw[k * 512 + c0 + j] * bf2f((bf16_t)v[j]); } }
        u32x4 w; w.x = pack2(siluf_(acc[0]), siluf_(acc[1])); w.y = pack2(siluf_(acc[2]), siluf_(acc[3])); w.z = pack2(siluf_(acc[4]), siluf_(acc[5])); w.w = pack2(siluf_(acc[6]), siluf_(acc[7]));
        *(u32x4*)(XC + (size_t)t * 512 + c0) = w;
    }
    const float* ZS = (const float*)(a.ws + OFF_ZS); float* LF = (float*)(a.ws + OFF_LF); float* LI = (float*)(a.ws + OFF_LI);
    for (int idx = bid * 512 + tid; idx < T * 4; idx += G * 512) { const int t = idx >> 2, h = idx & 3;
        LI[idx] = ZS[t * 8 + h] + a.in[7][l * 4 + h]; LF[idx] = logsigmoidf_(ZS[t * 8 + 4 + h] + a.in[8][l * 4 + h]); }
}

__device__ __forceinline__ void phase_mqkv(ArgsRef a, int lane, int gw, int GW) {
    const bf16_t* Z = (const bf16_t*)(a.ws + OFF_Z); const bf16_t* XC = (const bf16_t*)(a.ws + OFF_XC); const bf16_t* WQKV = (const bf16_t*)(a.ws + OFF_WQKV);
    const float* LI = (const float*)(a.ws + OFF_LI);
    const int r = lane & 15, q = lane >> 4;
    for (int u = gw; u < 256 * 24; u += GW) {
        const int mt = u / 24, v = u % 24, which = v / 8, h = (v % 8) / 2, nh = v % 2;
        const bf16_t* A = which < 2 ? XC + h * 128 : Z + h * 128; const int lda = which < 2 ? 512 : NZ;
        f32x4 acc[4][4]; zero_acc(acc);
        wave_gemm<4, 4>(acc, 128, [=](int i) { return A + (size_t)(mt * 64 + i) * lda; }, [=](int j) { return WQKV + (size_t)((which * 4 + h) * 128 + nh * 64 + j) * 128; }, lane);
        bf16_t* O = (bf16_t*)(a.ws + (which == 0 ? OFF_Q : which == 1 ? OFF_KH : OFF_V));
#pragma unroll
        for (int m = 0; m < 4; ++m)
#pragma unroll
            for (int g = 0; g < 4; ++g) { const int row = mt * 64 + m * 16 + 4 * q + g;
                const float sc = which == 0 ? 0.08838834764831845f : which == 1 ? expf(LI[row * 4 + h]) : 1.0f;
#pragma unroll
                for (int n = 0; n < 4; ++n) O[(size_t)row * 512 + h * 128 + nh * 64 + n * 16 + r] = f2bf(acc[m][n][g] * sc); }
    }
}

constexpr int GL_QS = 0, GL_KS = 8704, GL_KT = 17408, GL_VT = 27648, GL_PS = 39168, GL_SC1 = 41728, GL_SC2 = 42240, GL_GT = 42752, GL_OS = 44800;
template <int MODE, int PASS>
__device__ __forceinline__ void gla_item(ArgsRef a, int l, int h, int sg, int tid, int lane, int wave) {
    unsigned char* ws = a.ws;
    const bf16_t* Z = (const bf16_t*)(ws + OFF_Z); const bf16_t* Qg = (const bf16_t*)(ws + OFF_Q); const bf16_t* Kg = (const bf16_t*)(ws + OFF_KH); const bf16_t* Vg = (const bf16_t*)(ws + OFF_V);
    const float* LF = (const float*)(ws + OFF_LF);
    float* Eg = (float*)(ws + (MODE == 0 ? OFF_EM : OFF_EH)); float* Gg = (float*)(ws + (MODE == 0 ? OFF_GM : OFF_GH)); float* EX = (float*)(ws + OFF_EMX);
    bf16_t* Og = (bf16_t*)(ws + (MODE == 0 ? OFF_OM : OFF_OH)); float* DEN = (float*)(ws + OFF_DEN);
    bf16_t* QS = (bf16_t*)(smem + GL_QS); bf16_t* KS = (bf16_t*)(smem + GL_KS); bf16_t* KT = (bf16_t*)(smem + GL_KT); bf16_t* VT = (bf16_t*)(smem + GL_VT); bf16_t* PS = (bf16_t*)(smem + GL_PS);
    float* SC1 = (float*)(smem + GL_SC1); float* SC2 = (float*)(smem + GL_SC2); float* GT = (float*)(smem + GL_GT); bf16_t* OS = (bf16_t*)(smem + GL_OS);
    const int r = lane & 15, q = lane >> 4, grp = tid >> 7, d = tid & 127;
    const bool xw = (MODE == 0) && (wave == 0);
    float lb = 0.f;
    if (MODE == 1 && l == 1) { const float h0 = a.in[19][h * 128 + d], h1 = a.in[19][512 + h * 128 + d]; lb = 1.0f / (1.0f + expf(h0 - h1)); }
    f32x4 S[8], SX[8];
#pragma unroll
    for (int i = 0; i < 8; ++i) { S[i] = (f32x4){0.f, 0.f, 0.f, 0.f}; SX[i] = (f32x4){0.f, 0.f, 0.f, 0.f}; }
    if (PASS == 2) {
        for (int j = 0; j < sg; ++j) {
#pragma unroll
            for (int i = 0; i < 8; ++i) { const f32x4 gv = *(const f32x4*)(Gg + (size_t)(j * 4 + h) * 128 + 16 * i + 4 * q);
#pragma unroll
                for (int g = 0; g < 4; ++g) { const size_t row = (size_t)(j * 4 + h) * 128 + 16 * i + 4 * q + g;
                    S[i][g] = gv[g] * S[i][g] + Eg[row * 128 + 16 * wave + r];
                    if (xw) SX[i][g] = gv[g] * SX[i][g] + EX[row * 16 + r]; } }
        }
    }
    __syncthreads();
    if (MODE == 0) { for (int i = tid; i < 16 * 40; i += 512) VT[128 * 40 + i] = (i < 32) ? (bf16_t)0x3F80 : (bf16_t)0; }
    float runb = 0.f;
    for (int ci = 0; ci < GSEGLEN / 32; ++ci) {
        const int t0 = sg * GSEGLEN + ci * 32, tb = t0 + grp * 8;
        float lg[8], qv[8], kv[8]; bf16_t vv[8];
#pragma unroll
        for (int j = 0; j < 8; ++j) {
            if (MODE == 1) { const size_t zo = (size_t)(tb + j) * NZ + h * 128 + d; const float qp = bf2f(Z[zo + 1536]), fp = bf2f(Z[zo + 2048]);
                const float f = lb + (1.0f - lb) * sigmoidf_(fp); lg[j] = logf(f); qv[j] = siluf_(qp); kv[j] = 1.0f - f; vv[j] = Z[zo + 2560]; }
            else { const size_t o = (size_t)(tb + j) * 512 + h * 128 + d; qv[j] = bf2f(Qg[o]); kv[j] = bf2f(Kg[o]); vv[j] = Vg[o]; lg[j] = LF[(tb + j) * 4 + h]; }
        }
        float cs[8]; cs[0] = lg[0];
#pragma unroll
        for (int j = 1; j < 8; ++j) cs[j] = cs[j - 1] + lg[j];
        GT[grp * 128 + d] = cs[7];
        __syncthreads();
        if (PASS == 2 && ci > 0) { const int row = tid >> 4, c8 = (tid & 15) * 8; *(u32x4*)(Og + (size_t)(t0 - 32 + row) * 512 + h * 128 + c8) = *(const u32x4*)(OS + row * 136 + c8); }
        const float g0 = GT[d], g1 = GT[128 + d], g2 = GT[256 + d], g3 = GT[384 + d];
        const float off = grp == 0 ? 0.f : grp == 1 ? g0 : grp == 2 ? g0 + g1 : g0 + g1 + g2;
        const float bmid = g0 + g1, bL = bmid + g2 + g3;
        bf16_t ktv[8];
#pragma unroll
        for (int j = 0; j < 8; ++j) { const float bt = off + cs[j]; const bf16_t kt = f2bf(kv[j] * expf(bmid - bt)); ktv[j] = kt;
            if (PASS == 2) { QS[(grp * 8 + j) * 136 + d] = f2bf(qv[j] * expf(bt - bmid)); KS[(grp * 8 + j) * 136 + d] = kt; } }
        { u32x4 w; w.x = ktv[0] | ((unsigned)ktv[1] << 16); w.y = ktv[2] | ((unsigned)ktv[3] << 16); w.z = ktv[4] | ((unsigned)ktv[5] << 16); w.w = ktv[6] | ((unsigned)ktv[7] << 16); *(u32x4*)(KT + d * 40 + grp * 8) = w;
          u32x4 x; x.x = vv[0] | ((unsigned)vv[1] << 16); x.y = vv[2] | ((unsigned)vv[3] << 16); x.z = vv[4] | ((unsigned)vv[5] << 16); x.w = vv[6] | ((unsigned)vv[7] << 16); *(u32x4*)(VT + d * 40 + grp * 8) = x; }
        if (grp == 0) { SC1[d] = expf(bmid); SC2[d] = expf(bL - bmid); runb += bL; }
        __syncthreads();
        if (PASS == 2) {
            if (wave < 4) {
                const int ti = (wave == 1 || wave == 2) ? 1 : 0, tj = (wave >= 2) ? 1 : 0;
                f32x4 p = (f32x4){0.f, 0.f, 0.f, 0.f};
                if (wave < 3) {
#pragma unroll
                    for (int kk = 0; kk < 4; ++kk) { const bf16x8 av = *(const bf16x8*)(QS + (16 * ti + r) * 136 + 32 * kk + 8 * q); const bf16x8 bv = *(const bf16x8*)(KS + (16 * tj + r) * 136 + 32 * kk + 8 * q); p = MFMA16(av, bv, p); }
                }
#pragma unroll
                for (int g = 0; g < 4; ++g) { const int t = 16 * ti + 4 * q + g, s = 16 * tj + r; PS[t * 40 + s] = (wave < 3 && s <= t) ? f2bf(p[g]) : (bf16_t)0; }
            }
            __syncthreads();
        }
        const bf16x8 bV = *(const bf16x8*)(VT + (16 * wave + r) * 40 + 8 * q);
        bf16x8 bV1 = bV; if (xw) bV1 = *(const bf16x8*)(VT + (128 + r) * 40 + 8 * q);
        f32x4 o[2], ox[2];
        o[0] = o[1] = ox[0] = ox[1] = (f32x4){0.f, 0.f, 0.f, 0.f};
#pragma unroll
        for (int kk = 0; kk < 4; ++kk) {
            const f32x4 sa = *(const f32x4*)(SC1 + 32 * kk + 4 * q), sb = *(const f32x4*)(SC1 + 32 * kk + 16 + 4 * q);
            S[2 * kk] *= sa; S[2 * kk + 1] *= sb;
            if (xw) { SX[2 * kk] *= sa; SX[2 * kk + 1] *= sb; }
            if (PASS == 2) {
                bf16x8 bS, bX;
#pragma unroll
                for (int g = 0; g < 4; ++g) { bS[g] = (short)f2bf(S[2 * kk][g]); bS[4 + g] = (short)f2bf(S[2 * kk + 1][g]); bX[g] = (short)f2bf(SX[2 * kk][g]); bX[4 + g] = (short)f2bf(SX[2 * kk + 1][g]); }
#pragma unroll
                for (int mt = 0; mt < 2; ++mt) { const bf16x4 lo = *(const bf16x4*)(QS + (16 * mt + r) * 136 + 32 * kk + 4 * q), hi = *(const bf16x4*)(QS + (16 * mt + r) * 136 + 32 * kk + 16 + 4 * q);
                    bf16x8 av; av[0] = lo[0]; av[1] = lo[1]; av[2] = lo[2]; av[3] = lo[3]; av[4] = hi[0]; av[5] = hi[1]; av[6] = hi[2]; av[7] = hi[3];
                    o[mt] = MFMA16(av, bS, o[mt]); if (xw) ox[mt] = MFMA16(av, bX, ox[mt]); }
            }
        }
        if (PASS == 2) {
#pragma unroll
            for (int mt = 0; mt < 2; ++mt) { const bf16x8 av = *(const bf16x8*)(PS + (16 * mt + r) * 40 + 8 * q); o[mt] = MFMA16(av, bV, o[mt]); if (xw) ox[mt] = MFMA16(av, bV1, ox[mt]);
#pragma unroll
                for (int g = 0; g < 4; ++g) { const int t = t0 + 16 * mt + 4 * q + g; OS[(16 * mt + 4 * q + g) * 136 + 16 * wave + r] = f2bf(o[mt][g]); if (xw && r == 0) DEN[h * T + t] = ox[mt][g]; } }
        }
#pragma unroll
        for (int i = 0; i < 8; ++i) { const bf16x8 av = *(const bf16x8*)(KT + (16 * i + r) * 40 + 8 * q); const f32x4 s2 = *(const f32x4*)(SC2 + 16 * i + 4 * q);
            S[i] = MFMA16(av, bV, S[i]); S[i] *= s2;
            if (xw) { SX[i] = MFMA16(av, bV1, SX[i]); SX[i] *= s2; } }
    }
    if (PASS == 2) { __syncthreads(); const int row = tid >> 4, c8 = (tid & 15) * 8; *(u32x4*)(Og + (size_t)(sg * GSEGLEN + GSEGLEN - 32 + row) * 512 + h * 128 + c8) = *(const u32x4*)(OS + row * 136 + c8); }
    if (PASS == 1) {
        float* ST = (float*)smem;
        __syncthreads();
#pragma unroll
        for (int i = 0; i < 8; ++i)
#pragma unroll
            for (int g = 0; g < 4; ++g) { ST[(16 * i + 4 * q + g) * 132 + 16 * wave + r] = S[i][g]; if (xw) EX[((size_t)(sg * 4 + h) * 128 + 16 * i + 4 * q + g) * 16 + r] = SX[i][g]; }
        __syncthreads();
#pragma unroll
        for (int k = 0; k < 8; ++k) { const int idx = tid + 512 * k, row = idx >> 5, c4 = (idx & 31) * 4; *(f32x4*)(Eg + ((size_t)(sg * 4 + h) * 128 + row) * 128 + c4) = *(const f32x4*)(ST + row * 132 + c4); }
        if (grp == 0) Gg[(size_t)(sg * 4 + h) * 128 + d] = expf(runb);
    }
}

template <int PASS>
__device__ __forceinline__ void s5_item(ArgsRef a, int l, int g, int sg, int g0, int tid, int lane, int wave, int hsel) {
    unsigned char* ws = a.ws;
    const bf16_t* Z = (const bf16_t*)(ws + OFF_Z); const float* ABAR = (const float*)(ws + OFF_ABAR); const bf16_t* BBT = (const bf16_t*)(ws + OFF_BBT); const bf16_t* CCT = (const bf16_t*)(ws + OFF_CCT);
    float* ES = (float*)(ws + OFF_ES); bf16_t* YPRE = (bf16_t*)(ws + OFF_YPRE);
    float* BU = (float*)(smem + 70000 + (wave & 3) * 12800); bf16_t* X = (bf16_t*)(smem + 70000 + (wave & 3) * 12800 + 8448); bf16_t* YT = (bf16_t*)(smem + 70000 + 51200);
    const int r = lane & 15, q = lane >> 4, p = lane; const bool act = (wave >> 2) == hsel;
    const float ar = ABAR[(g * 64 + p) * 2], ai = ABAR[(g * 64 + p) * 2 + 1];
    const bf16x8 zero8 = (bf16x8){0, 0, 0, 0, 0, 0, 0, 0};
    bf16x8 bB[8], cB[4];
#pragma unroll
    for (int nt = 0; nt < 8; ++nt) bB[nt] = (q < 2) ? *(const bf16x8*)(BBT + (size_t)(g * 128 + 16 * nt + r) * 16 + 8 * q) : zero8;
#pragma unroll
    for (int kk = 0; kk < 4; ++kk) cB[kk] = (PASS == 2) ? *(const bf16x8*)(CCT + (size_t)(g * 16 + r) * 128 + 32 * kk + 8 * q) : zero8;
    float xr = 0.f, xi = 0.f;
    if (PASS == 2 && sg > 0) {
        float pr = ar, pi = ai;
#pragma unroll
        for (int s = 0; s < 8; ++s) { const float nr = pr * pr - pi * pi, ni = 2.0f * pr * pi; pr = nr; pi = ni; }
        for (int j = 0; j < sg; ++j) { const float er = ES[((size_t)(j * 32 + g) * 64 + p) * 2], ei = ES[((size_t)(j * 32 + g) * 64 + p) * 2 + 1];
            const float nr = pr * xr - pi * xi + er, ni = pr * xi + pi * xr + ei; xr = nr; xi = ni; }
    }
    const float dsk = a.in[17][l * 512 + 16 * g + r];
    for (int ci = 0; ci < SSEGLEN / 16; ++ci) {
        const int t0 = sg * SSEGLEN + ci * 16;
        if (act) {
            const bf16x8 av = (q < 2) ? *(const bf16x8*)(Z + (size_t)(t0 + r) * NZ + 1024 + 16 * g + 8 * q) : zero8;
#pragma unroll
            for (int nt = 0; nt < 8; ++nt) { f32x4 acc = (f32x4){0.f, 0.f, 0.f, 0.f}; acc = MFMA16(av, bB[nt], acc);
#pragma unroll
                for (int gg = 0; gg < 4; ++gg) BU[(4 * q + gg) * 132 + 16 * nt + r] = acc[gg]; }
            wave_sync();
#pragma unroll
            for (int t = 0; t < 16; ++t) { const float br = BU[t * 132 + p], bi = BU[t * 132 + 64 + p];
                const float nr = ar * xr - ai * xi + br, ni = ar * xi + ai * xr + bi; xr = nr; xi = ni;
                if (PASS == 2) { X[t * 136 + p] = f2bf(xr); X[t * 136 + 64 + p] = f2bf(xi); } }
            wave_sync();
            if (PASS == 2) {
                f32x4 acc = (f32x4){0.f, 0.f, 0.f, 0.f};
#pragma unroll
                for (int kk = 0; kk < 4; ++kk) { const bf16x8 xv = *(const bf16x8*)(X + r * 136 + 32 * kk + 8 * q); acc = MFMA16(xv, cB[kk], acc); }
#pragma unroll
                for (int gg = 0; gg < 4; ++gg) { const int t = t0 + 4 * q + gg, c = 16 * g + r; const float u = bf2f(Z[(size_t)t * NZ + 1024 + c]);
                    YT[(4 * q + gg) * 136 + 16 * wave + r] = f2bf(gelu_tanh(acc[gg] + dsk * u)); }
            }
        }
        if (PASS == 2) {
            __syncthreads();
            if (tid < 128) { const int row = tid >> 3, c8 = (tid & 7) * 8; *(u32x4*)(YPRE + (size_t)(t0 + row) * 512 + 16 * g0 + 64 * hsel + c8) = *(const u32x4*)(YT + row * 136 + 64 * hsel + c8); }
            __syncthreads();
        }
    }
    if (PASS == 1 && act) { ES[((size_t)(sg * 32 + g) * 64 + p) * 2] = xr; ES[((size_t)(sg * 32 + g) * 64 + p) * 2 + 1] = xi; }
}

template <int PASS>
__device__ __forceinline__ void phase_mixers(ArgsRef a, int l, int tid, int lane, int wave, int bid, int G) {
    for (int it = bid; it < 4 * GSEG; it += G) gla_item<0, PASS>(a, l, it % 4, it / 4, tid, lane, wave);
    asm volatile("" ::: "memory");
    for (int it = bid + ((4 * GSEG - bid % G) % G + G) % G * 0; it < 2 * 4 * GSEG; it += G) { if (it >= 4 * GSEG) gla_item<1, PASS>(a, l, (it - 4 * GSEG) % 4, (it - 4 * GSEG) / 4, tid, lane, wave); }
    __syncthreads();
    for (int it0 = bid * 8; it0 < 32 * SSEG; it0 += G * 8)
        for (int half = 0; half < 2; ++half) { const int it = it0 + wave; s5_item<PASS>(a, l, it % 32, it / 32, it0 % 32, tid, lane, wave, half); __syncthreads(); }
}

__device__ __forceinline__ void phase_post(ArgsRef a, int l, int lane, int gw, int GW) {
    const bf16_t* Z = (const bf16_t*)(a.ws + OFF_Z); const bf16_t* XC = (const bf16_t*)(a.ws + OFF_XC);
    bf16_t* OM = (bf16_t*)(a.ws + OFF_OM); bf16_t* OH = (bf16_t*)(a.ws + OFF_OH); const float* DEN = (const float*)(a.ws + OFF_DEN);
    const int c0 = lane * 8, hd = lane >> 4;
    for (int t = gw; t < T; t += GW) {
        { const bf16x8 o = *(const bf16x8*)(OM + (size_t)t * 512 + c0), op = *(const bf16x8*)(Z + (size_t)t * NZ + 512 + c0), xc = *(const bf16x8*)(XC + (size_t)t * 512 + c0);
          const float dn = 1.0f / fmaxf(fabsf(DEN[hd * T + t]), 1.0f); float y[8];
#pragma unroll
          for (int j = 0; j < 8; ++j) y[j] = sigmoidf_(bf2f((bf16_t)op[j])) * (bf2f((bf16_t)o[j]) * dn) + a.in[9][l * 512 + c0 + j] * bf2f((bf16_t)xc[j]);
          u32x4 w; w.x = pack2(y[0], y[1]); w.y = pack2(y[2], y[3]); w.z = pack2(y[4], y[5]); w.w = pack2(y[6], y[7]); *(u32x4*)(OM + (size_t)t * 512 + c0) = w; }
        { const bf16x8 o = *(const bf16x8*)(OH + (size_t)t * 512 + c0), gp = *(const bf16x8*)(Z + (size_t)t * NZ + 3072 + c0);
          float ov[8], ss = 0.f;
#pragma unroll
          for (int j = 0; j < 8; ++j) { ov[j] = bf2f((bf16_t)o[j]); ss += ov[j] * ov[j]; }
          ss += __shfl_xor(ss, 1); ss += __shfl_xor(ss, 2); ss += __shfl_xor(ss, 4); ss += __shfl_xor(ss, 8);
          const float rinv = rsqrtf(ss * (1.0f / 128.0f) + 1e-6f); float y[8];
#pragma unroll
          for (int j = 0; j < 8; ++j) y[j] = ov[j] * rinv * a.in[20][l * 512 + c0 + j] * siluf_(bf2f((bf16_t)gp[j]));
          u32x4 w; w.x = pack2(y[0], y[1]); w.y = pack2(y[2], y[3]); w.z = pack2(y[4], y[5]); w.w = pack2(y[6], y[7]); *(u32x4*)(OH + (size_t)t * 512 + c0) = w; }
    }
}

__device__ __forceinline__ void phase_glu(ArgsRef a, int lane, int gw, int GW) {
    const bf16_t* YPRE = (const bf16_t*)(a.ws + OFF_YPRE); const bf16_t* WGLU = (const bf16_t*)(a.ws + OFF_WGLU); bf16_t* YSG = (bf16_t*)(a.ws + OFF_YSG);
    const int r = lane & 15, q = lane >> 4;
    for (int u = gw; u < 256 * 8; u += GW) {
        const int mt = u / 8, nt = u % 8;
        f32x4 acc[4][4]; zero_acc(acc);
        wave_gemm<4, 4>(acc, 512, [=](int i) { return YPRE + (size_t)(mt * 64 + i) * 512; }, [=](int j) { return WGLU + (size_t)(nt * 64 + j) * 512; }, lane);
#pragma unroll
        for (int m = 0; m < 4; ++m)
#pragma unroll
            for (int n = 0; n < 4; ++n)
#pragma unroll
                for (int g = 0; g < 4; ++g) { const size_t o = (size_t)(mt * 64 + m * 16 + 4 * q + g) * 512 + nt * 64 + n * 16 + r; YSG[o] = f2bf(bf2f(YPRE[o]) * sigmoidf_(acc[m][n][g])); }
    }
}

__device__ __forceinline__ void phase_merge(ArgsRef a, int lane, int gw, int GW) {
    const bf16_t* XB = (const bf16_t*)(a.ws + OFF_XB); const bf16_t* WIN = (const bf16_t*)(a.ws + OFF_WIN); const bf16_t* WB = (const bf16_t*)(a.ws + OFF_WB);
    bf16_t* MG = (bf16_t*)(a.ws + OFF_MERGED);
    const int r = lane & 15, q = lane >> 4;
    for (int u = gw; u < 512 * 16; u += GW) {
        const int mt = u / 16, nt = u % 16;
        f32x4 tot[2][4]; zero_acc(tot);
#pragma unroll 1
        for (int b = 0; b < 3; ++b) {
            const bf16_t* Y = (const bf16_t*)(a.ws + (b == 0 ? OFF_OM : b == 1 ? OFF_YSG : OFF_OH));
            f32x4 ag[2][4], ap[2][4]; zero_acc(ag); zero_acc(ap);
            wave_gemm<2, 4>(ag, 1024, [=](int i) { return XB + (size_t)(mt * 32 + i) * 1024; }, [=](int j) { return WIN + (size_t)(NZ + b * 1024 + nt * 64 + j) * 1024; }, lane);
            wave_gemm<2, 4>(ap, 512, [=](int i) { return Y + (size_t)(mt * 32 + i) * 512; }, [=](int j) { return WB + (size_t)(b * 1024 + nt * 64 + j) * 512; }, lane);
#pragma unroll
            for (int m = 0; m < 2; ++m)
#pragma unroll
                for (int n = 0; n < 4; ++n)
#pragma unroll
                    for (int g = 0; g < 4; ++g) tot[m][n][g] += sigmoidf_(ag[m][n][g]) * ap[m][n][g];
        }
#pragma unroll
        for (int m = 0; m < 2; ++m)
#pragma unroll
            for (int n = 0; n < 4; ++n)
#pragma unroll
                for (int g = 0; g < 4; ++g) MG[(size_t)(mt * 32 + m * 16 + 4 * q + g) * 1024 + nt * 64 + n * 16 + r] = f2bf(tot[m][n][g]);
    }
}

__device__ __forceinline__ void phase_wout(ArgsRef a, int l, int lane, int gw, int GW) {
    const bf16_t* MG = (const bf16_t*)(a.ws + OFF_MERGED); const bf16_t* WOUT = (const bf16_t*)(a.ws + OFF_WOUT);
    const float* xin = (l == 0) ? a.in[0] : a.out; float* XF = a.out;
    const int r = lane & 15, q = lane >> 4;
    for (int u = gw; u < 256 * 16; u += GW) {
        const int mt = u / 16, nt = u % 16;
        f32x4 acc[4][4]; zero_acc(acc);
        wave_gemm<4, 4>(acc, 1024, [=](int i) { return MG + (size_t)(mt * 64 + i) * 1024; }, [=](int j) { return WOUT + (size_t)(nt * 64 + j) * 1024; }, lane);
#pragma unroll
        for (int m = 0; m < 4; ++m)
#pragma unroll
            for (int n = 0; n < 4; ++n)
#pragma unroll
                for (int g = 0; g < 4; ++g) { const size_t o = (size_t)(mt * 64 + m * 16 + 4 * q + g) * 1024 + nt * 64 + n * 16 + r; XF[o] = DN_ALPHA * xin[o] + acc[m][n][g]; }
    }
}

__device__ __forceinline__ void ln_row(f32x4 (&v)[4], const float* gam, const float* bet, int lane) {
    float s = 0.f;
#pragma unroll
    for (int j = 0; j < 4; ++j) s += (v[j][0] + v[j][1]) + (v[j][2] + v[j][3]);
#pragma unroll
    for (int o = 32; o >= 1; o >>= 1) s += __shfl_xor(s, o);
    const float mean = s * (1.0f / 1024.0f); float qv = 0.f;
#pragma unroll
    for (int j = 0; j < 4; ++j) { const f32x4 dd = v[j] - mean; qv += (dd[0] * dd[0] + dd[1] * dd[1]) + (dd[2] * dd[2] + dd[3] * dd[3]); }
#pragma unroll
    for (int o = 32; o >= 1; o >>= 1) qv += __shfl_xor(qv, o);
    const float rstd = rsqrtf(qv * (1.0f / 1024.0f) + 1e-5f);
#pragma unroll
    for (int j = 0; j < 4; ++j) { const f32x4 gg = *(const f32x4*)(gam + 256 * j + 4 * lane), bb = *(const f32x4*)(bet + 256 * j + 4 * lane); v[j] = (v[j] - mean) * rstd * gg + bb; }
}

__device__ __forceinline__ void phase_ln1r(ArgsRef a, int l, int tid, int lane, int wave, int bid, int G) {
    float* XF = a.out; bf16_t* XB = (bf16_t*)(a.ws + OFF_XB);
    int* TOKE = (int*)(a.ws + OFF_TOKE); float* TOKG = (float*)(a.ws + OFF_TOKG); unsigned* CNT = (unsigned*)(a.ws + OFF_CTL);
    const float* RW = a.in[29]; const float* RB = a.in[30];
    float* XR = (float*)(smem + wave * 8192);
    unsigned* lh = (unsigned*)(smem + 65536);
    if (tid < 32) lh[tid] = 0u;
    __syncthreads();
    const int rs = lane >> 5, e = lane & 31;
    int* TE = (int*)(smem + 66048 + wave * 256); float* TG = (float*)(smem + 66048 + wave * 256 + 128);
    for (int tw = bid * 8 + wave; tw < T / 16; tw += G * 8)
    for (int t0 = tw * 16; t0 < tw * 16 + 16; t0 += 2) {
#pragma unroll
        for (int rr = 0; rr < 2; ++rr) { const int t = t0 + rr; f32x4 v[4];
#pragma unroll
            for (int j = 0; j < 4; ++j) v[j] = *(const f32x4*)(XF + (size_t)t * 1024 + 256 * j + 4 * lane);
            ln_row(v, a.in[25] + l * 1024, a.in[26] + l * 1024, lane);
#pragma unroll
            for (int j = 0; j < 4; ++j) { *(f32x4*)(XF + (size_t)t * 1024 + 256 * j + 4 * lane) = v[j]; *(f32x4*)(XR + rr * 1024 + 256 * j + 4 * lane) = v[j];
                u32x2 w; w.x = pack2(v[j][0], v[j][1]); w.y = pack2(v[j][2], v[j][3]); *(u32x2*)(XB + (size_t)t * 1024 + 256 * j + 4 * lane) = w; } }
        wave_sync();
        float acc = 0.f;
        for (int k = 0; k < 1024; k += 4) { const f32x4 xv = *(const f32x4*)(XR + rs * 1024 + k);
            acc += xv[0] * RW[(k + 0) * 32 + e]; acc += xv[1] * RW[(k + 1) * 32 + e]; acc += xv[2] * RW[(k + 2) * 32 + e]; acc += xv[3] * RW[(k + 3) * 32 + e]; }
        wave_sync();
        const float s = sigmoidf_(acc), sb = s + RB[e];
        float v4[4];
#pragma unroll
        for (int i = 0; i < 4; ++i) v4[i] = __shfl(sb, (lane & ~3) + i);
        int i1 = 0;
#pragma unroll
        for (int i = 1; i < 4; ++i) if (v4[i] > v4[i1]) i1 = i;
        int i2 = (i1 == 0) ? 1 : 0;
#pragma unroll
        for (int i = 0; i < 4; ++i) if (i != i1 && i != i2 && v4[i] > v4[i2]) i2 = i;
        float gs = v4[i1] + v4[i2]; int gid = e >> 2;
#pragma unroll
        for (int o = 4; o <= 16; o <<= 1) { const float os = __shfl_xor(gs, o); const int og = __shfl_xor(gid, o); if (os > gs || (os == gs && og < gid)) { gs = os; gid = og; } }
        float sv[4], sbv[4];
#pragma unroll
        for (int i = 0; i < 4; ++i) { sbv[i] = __shfl(sb, (lane & 32) + gid * 4 + i); sv[i] = __shfl(s, (lane & 32) + gid * 4 + i); }
        int j1 = 0;
#pragma unroll
        for (int i = 1; i < 4; ++i) if (sbv[i] > sbv[j1]) j1 = i;
        int j2 = (j1 == 0) ? 1 : 0;
#pragma unroll
        for (int i = 0; i < 4; ++i) if (i != j1 && i != j2 && sbv[i] > sbv[j2]) j2 = i;
        float s1 = sv[0], s2 = sv[0];
#pragma unroll
        for (int i = 1; i < 4; ++i) { if (i == j1) s1 = sv[i]; if (i == j2) s2 = sv[i]; }
        if (e == 0) { const int t = t0 + rs; const float inv = 1.0f / (s1 + s2);
            const int ti = t & 15; TE[ti * 2] = gid * 4 + j1; TE[ti * 2 + 1] = gid * 4 + j2; TG[ti * 2] = s1 * inv; TG[ti * 2 + 1] = s2 * inv;
            atomicAdd(&lh[gid * 4 + j1], 1u); atomicAdd(&lh[gid * 4 + j2], 1u); }
        if ((t0 & 15) == 14) { wave_sync(); if (lane < 32) { TOKE[(t0 - 14) * 2 + lane] = TE[lane]; TOKG[(t0 - 14) * 2 + lane] = TG[lane]; } wave_sync(); }
    }
    __syncthreads();
    if (tid < 32 && lh[tid]) atomicAdd(&CNT[tid], lh[tid]);
}

__device__ __forceinline__ void phase_slot(ArgsRef a, int tid, int bid, int G) {
    const int* TOKE = (const int*)(a.ws + OFF_TOKE); int* TOKS = (int*)(a.ws + OFF_TOKS); int* SLOTT = (int*)(a.ws + OFF_SLOTT);
    unsigned* CNT = (unsigned*)(a.ws + OFF_CTL); unsigned* BASE = CNT + 64;
    unsigned* base = (unsigned*)smem; unsigned* lc = base + 40; int* el = (int*)(base + 80);
    if (tid == 0) { unsigned s = 0; for (int e = 0; e < 32; ++e) { base[e] = s; s += (CNT[e] + 63u) & ~63u; } base[32] = s; }
    __syncthreads();
    if (bid == 0 && tid < 33) BASE[tid] = base[tid];
    for (int e = bid; e < 32; e += G) { const unsigned c = CNT[e]; for (unsigned s = base[e] + c + tid; s < base[e + 1]; s += 512) __hip_atomic_store(&SLOTT[s], 0, __ATOMIC_RELAXED, __HIP_MEMORY_SCOPE_AGENT); }
    for (int c = bid; c < T / 64; c += G) {
        if (tid < 32) lc[tid] = 0u;
        __syncthreads();
        for (int i = tid; i < c * 128; i += 512) atomicAdd(&lc[TOKE[i]], 1u);
        int e = 0;
        if (tid < 128) { e = TOKE[c * 128 + tid]; el[tid] = e; }
        __syncthreads();
        if (tid < 128) { unsigned rank = 0; for (int i = 0; i < tid; ++i) rank += (el[i] == e) ? 1u : 0u;
            const unsigned s = base[e] + lc[e] + rank; const int t = c * 64 + (tid >> 1);
            __hip_atomic_store(&SLOTT[s], t, __ATOMIC_RELAXED, __HIP_MEMORY_SCOPE_AGENT); TOKS[t * 2 + (tid & 1)] = (int)s; }
        __syncthreads();
    }
}

__device__ __forceinline__ void phase_moe_gu(ArgsRef a, int lane, int gw, int GW) {
    const bf16_t* XB = (const bf16_t*)(a.ws + OFF_XB); const bf16_t* WGU = (const bf16_t*)(a.ws + OFF_WGU); bf16_t* H = (bf16_t*)(a.ws + OFF_H);
    const int* SLOTT = (const int*)(a.ws + OFF_SLOTT); const unsigned* BASE = (const unsigned*)(a.ws + OFF_CTL) + 64;
    const int r = lane & 15, q = lane >> 4; const int ntile = (int)(BASE[32] >> 5);
    for (int u = gw; u < ntile * 4; u += GW) {
        const int rt = u / 4, hc = u % 4; int e = 0; while (e < 31 && BASE[e + 1] <= (unsigned)(rt * 32)) ++e;
        f32x4 acc[2][8]; zero_acc(acc);
        wave_gemm<2, 8>(acc, 1024, [=](int i) { return XB + (size_t)SLOTT[rt * 32 + i] * 1024; },
            [=](int j) { const int hid = hc * 64 + (j & 63), row = (hid >> 7) * 256 + (hid & 127) + (j >> 6) * 128; return WGU + ((size_t)e * 512 + row) * 1024; }, lane);
#pragma unroll
        for (int m = 0; m < 2; ++m)
#pragma unroll
            for (int n = 0; n < 4; ++n)
#pragma unroll
                for (int g = 0; g < 4; ++g) H[(size_t)(rt * 32 + m * 16 + 4 * q + g) * 256 + hc * 64 + n * 16 + r] = f2bf(siluf_(acc[m][n][g]) * acc[m][n + 4][g]);
    }
}
__device__ __forceinline__ void phase_moe_dn(ArgsRef a, int lane, int gw, int GW) {
    const bf16_t* H = (const bf16_t*)(a.ws + OFF_H); const bf16_t* WD = (const bf16_t*)(a.ws + OFF_WD); bf16_t* YS = (bf16_t*)(a.ws + OFF_YS);
    const unsigned* BASE = (const unsigned*)(a.ws + OFF_CTL) + 64;
    const int r = lane & 15, q = lane >> 4; const int ntile = (int)(BASE[32] >> 6);
    for (int u = gw; u < ntile * 16; u += GW) {
        const int rt = u / 16, nc = u % 16; int e = 0; while (e < 31 && BASE[e + 1] <= (unsigned)(rt * 64)) ++e;
        f32x4 acc[4][4]; zero_acc(acc);
        wave_gemm<4, 4>(acc, 256, [=](int i) { return H + (size_t)(rt * 64 + i) * 256; }, [=](int j) { return WD + ((size_t)e * 1024 + nc * 64 + j) * 256; }, lane);
#pragma unroll
        for (int m = 0; m < 4; ++m)
#pragma unroll
            for (int n = 0; n < 4; ++n)
#pragma unroll
                for (int g = 0; g < 4; ++g) YS[(size_t)(rt * 64 + m * 16 + 4 * q + g) * 1024 + nc * 64 + n * 16 + r] = f2bf(acc[m][n][g]);
    }
}

__device__ __forceinline__ void phase_ln2(ArgsRef a, int l, int lane, int gw, int GW) {
    float* XF = a.out; bf16_t* XB = (bf16_t*)(a.ws + OFF_XB); const bf16_t* YS = (const bf16_t*)(a.ws + OFF_YS);
    const int* TOKS = (const int*)(a.ws + OFF_TOKS); const float* TOKG = (const float*)(a.ws + OFF_TOKG);
    for (int t = gw; t < T; t += GW) {
        const int s0 = TOKS[t * 2], s1 = TOKS[t * 2 + 1]; const float g0 = TOKG[t * 2], g1 = TOKG[t * 2 + 1];
        f32x4 v[4];
#pragma unroll
        for (int j = 0; j < 4; ++j) { const f32x4 x1 = *(const f32x4*)(XF + (size_t)t * 1024 + 256 * j + 4 * lane);
            const bf16x4 y0 = *(const bf16x4*)(YS + (size_t)s0 * 1024 + 256 * j + 4 * lane), y1 = *(const bf16x4*)(YS + (size_t)s1 * 1024 + 256 * j + 4 * lane);
#pragma unroll
            for (int g = 0; g < 4; ++g) v[j][g] = DN_ALPHA * x1[g] + g0 * bf2f((bf16_t)y0[g]) + g1 * bf2f((bf16_t)y1[g]); }
        ln_row(v, a.in[27] + l * 1024, a.in[28] + l * 1024, lane);
#pragma unroll
        for (int j = 0; j < 4; ++j) { *(f32x4*)(XF + (size_t)t * 1024 + 256 * j + 4 * lane) = v[j];
            u32x2 w; w.x = pack2(v[j][0], v[j][1]); w.y = pack2(v[j][2], v[j][3]); *(u32x2*)(XB + (size_t)t * 1024 + 256 * j + 4 * lane) = w; }
    }
}

struct SchedGrid {
    int nM, nN, G, c; const char* A; const char* B; size_t strideA, strideB;
    __device__ __forceinline__ bool next(int i, pg8::Unit& u) const { int pm, pn; if (!pg8::tile_order(i * G + c, nM, nN, pm, pn)) return false;
        u.pm = pm; u.pn = pn; u.tag = 0; u.A = A + (size_t)pm * strideA; u.B = B + (size_t)pn * strideB; return true; }
};
constexpr int GATES_LD = 3072;
template <int MODE> struct EpiBf16 {
    static constexpr bool PERM = true;
    bf16_t* O; int ldo; const bf16_t* Y; int ldy;
    __device__ __forceinline__ bool operator()(f32x4 (&acc)[2][2][4][2], const pg8::Unit& u, int wr, int wc, int fr, int fq) const {
#pragma unroll
        for (int ai = 0; ai < 2; ++ai)
#pragma unroll
            for (int m = 0; m < 4; ++m) { const size_t row = (size_t)u.pm * 256 + ai * 128 + wr * 64 + m * 16 + fr;
#pragma unroll
                for (int bj = 0; bj < 2; ++bj) { const int col = u.pn * 256 + bj * 128 + wc * 32 + 8 * fq; f32x4 v0 = acc[ai][bj][m][0], v1 = acc[ai][bj][m][1];
                    if (MODE == 1) {
#pragma unroll
                        for (int j = 0; j < 4; ++j) { v0[j] = fmaxf(sigmoidf_(v0[j]), 1e-30f); v1[j] = fmaxf(sigmoidf_(v1[j]), 1e-30f); } }
                    if (MODE == 2) { const bf16x8 y = *(const bf16x8*)(Y + row * ldy + col);
#pragma unroll
                        for (int j = 0; j < 4; ++j) { v0[j] = bf2f((bf16_t)y[j]) * sigmoidf_(v0[j]); v1[j] = bf2f((bf16_t)y[4 + j]) * sigmoidf_(v1[j]); } }
                    u32x4 w; w.x = pg8::cvt_pk_bf16(v0[0], v0[1]); w.y = pg8::cvt_pk_bf16(v0[2], v0[3]); w.z = pg8::cvt_pk_bf16(v1[0], v1[1]); w.w = pg8::cvt_pk_bf16(v1[2], v1[3]);
                    *(u32x4*)(O + row * ldo + col) = w; } }
        return false;
    }
};
__device__ __forceinline__ void phase_zgemm2(ArgsRef a, int tid, int bid, int G) {
    SchedGrid S{T / 256, NZ / 256, G, bid, (const char*)(a.ws + OFF_XB), (const char*)(a.ws + OFF_WIN), (size_t)256 * 1024 * 2, (size_t)256 * 1024 * 2};
    EpiBf16<0> E{(bf16_t*)(a.ws + OFF_Z), NZ, nullptr, 0};
    pg8::gemm_phase((PG8_LAS unsigned char*)smem, tid, 1024, 1024, 1024, S, E);
}
__device__ __forceinline__ void phase_glu_gates(ArgsRef a, int tid, int bid, int G) {
    { SchedGrid S{T / 256, 2, G, bid, (const char*)(a.ws + OFF_YPRE), (const char*)(a.ws + OFF_WGLU), (size_t)256 * 512 * 2, (size_t)256 * 512 * 2};
      EpiBf16<2> E{(bf16_t*)(a.ws + OFF_YSG), 512, (const bf16_t*)(a.ws + OFF_YPRE), 512};
      pg8::gemm_phase((PG8_LAS unsigned char*)smem, tid, 512, 512, 512, S, E); }
    asm volatile("" : "+v"(tid), "+s"(bid), "+s"(G));
    { SchedGrid S{T / 256, 12, G, (bid + G / 2) % G, (const char*)(a.ws + OFF_XB), (const char*)(a.ws + OFF_WIN + (size_t)NZ * 1024 * 2), (size_t)256 * 1024 * 2, (size_t)256 * 1024 * 2};
      EpiBf16<1> E{(bf16_t*)(a.ws + OFF_Z), GATES_LD, nullptr, 0};
      pg8::gemm_phase((PG8_LAS unsigned char*)smem, tid, 1024, 1024, 1024, S, E); }
}
struct SchedMerge {
    int G, c; const unsigned char* ws;
    __device__ __forceinline__ bool next(int i, pg8::Unit& u) const { const int b = i % 3; int pm, pn; if (!pg8::tile_order((i / 3) * G + c, T / 256, 4, pm, pn)) return false;
        u.pm = pm; u.pn = pn; u.tag = b; u.A = (const char*)(ws + (b == 0 ? OFF_OM : b == 1 ? OFF_YSG : OFF_OH)) + (size_t)pm * 256 * 512 * 2;
        u.B = (const char*)(ws + OFF_WB) + ((size_t)b * 1024 + pn * 256) * 512 * 2; return true; }
};
struct EpiMerge {
    static constexpr bool PERM = true;
    const bf16_t* GT; bf16_t* O;
    __device__ __forceinline__ bool operator()(f32x4 (&acc)[2][2][4][2], const pg8::Unit& u, int wr, int wc, int fr, int fq) const {
        const int b = u.tag;
#pragma unroll
        for (int ai = 0; ai < 2; ++ai)
#pragma unroll
            for (int m = 0; m < 4; ++m) { const size_t row = (size_t)u.pm * 256 + ai * 128 + wr * 64 + m * 16 + fr;
#pragma unroll
                for (int bj = 0; bj < 2; ++bj) { const int col = u.pn * 256 + bj * 128 + wc * 32 + 8 * fq;
                    const bf16x8 gb = *(const bf16x8*)(GT + row * GATES_LD + b * 1024 + col);
                    if (b < 2) { const bf16x8 gn = *(const bf16x8*)(GT + row * GATES_LD + (b + 1) * 1024 + col);
#pragma unroll
                        for (int j = 0; j < 4; ++j) { acc[ai][bj][m][0][j] *= bf2f((bf16_t)gb[j]) / bf2f((bf16_t)gn[j]); acc[ai][bj][m][1][j] *= bf2f((bf16_t)gb[4 + j]) / bf2f((bf16_t)gn[4 + j]); } }
                    else { f32x4 v0 = acc[ai][bj][m][0], v1 = acc[ai][bj][m][1];
#pragma unroll
                        for (int j = 0; j < 4; ++j) { v0[j] *= bf2f((bf16_t)gb[j]); v1[j] *= bf2f((bf16_t)gb[4 + j]); }
                        u32x4 w; w.x = pg8::cvt_pk_bf16(v0[0], v0[1]); w.y = pg8::cvt_pk_bf16(v0[2], v0[3]); w.z = pg8::cvt_pk_bf16(v1[0], v1[1]); w.w = pg8::cvt_pk_bf16(v1[2], v1[3]);
                        *(u32x4*)(O + row * 1024 + col) = w; } } }
        return b < 2;
    }
};
__device__ __forceinline__ void phase_merge2(ArgsRef a, int tid, int bid, int G) {
    SchedMerge S{G, bid, a.ws}; EpiMerge E{(const bf16_t*)(a.ws + OFF_Z), (bf16_t*)(a.ws + OFF_XB)};
    pg8::gemm_phase((PG8_LAS unsigned char*)smem, tid, 512, 512, 512, S, E);
}
struct EpiResid {
    static constexpr bool PERM = false;
    const float* xin; float* XF;
    __device__ __forceinline__ bool operator()(f32x4 (&acc)[2][2][4][2], const pg8::Unit& u, int wr, int wc, int fr, int fq) const {
#pragma unroll
        for (int ai = 0; ai < 2; ++ai)
#pragma unroll
            for (int m = 0; m < 4; ++m) { const size_t row = (size_t)u.pm * 256 + ai * 128 + wr * 64 + m * 16 + fr;
#pragma unroll
                for (int bj = 0; bj < 2; ++bj)
#pragma unroll
                    for (int n = 0; n < 2; ++n) { const size_t o = row * 1024 + u.pn * 256 + bj * 128 + wc * 32 + 16 * n + 4 * fq; const f32x4 x = *(const f32x4*)(xin + o); *(f32x4*)(XF + o) = DN_ALPHA * x + acc[ai][bj][m][n]; } }
        return false;
    }
};
__device__ __forceinline__ void phase_wout2(ArgsRef a, int l, int tid, int bid, int G) {
    SchedGrid S{T / 256, 4, G, bid, (const char*)(a.ws + OFF_XB), (const char*)(a.ws + OFF_WOUT), (size_t)256 * 1024 * 2, (size_t)256 * 1024 * 2};
    EpiResid E{(l == 0) ? a.in[0] : a.out, a.out};
    pg8::gemm_phase((PG8_LAS unsigned char*)smem, tid, 1024, 1024, 1024, S, E);
}
__device__ __forceinline__ void phase_mprep2(ArgsRef a, int l, int tid, int lane, int wave, int bid, int G) {
    const bf16_t* Z = (const bf16_t*)(a.ws + OFF_Z); bf16_t* XC = (bf16_t*)(a.ws + OFF_XC);
    const float* cw = a.in[2] + (size_t)l * 4 * 512; const float* cb = a.in[3] + (size_t)l * 512;
    for (int idx = bid * 512 + tid; idx < T * 64; idx += G * 512) {
        const int t = idx / 64, c0 = (idx % 64) * 8; float acc[8];
#pragma unroll
        for (int j = 0; j < 8; ++j) acc[j] = cb[c0 + j];
#pragma unroll
        for (int k = 0; k < 4; ++k) { const int ts = t - 3 + k; if (ts >= 0) { const bf16x8 v = *(const bf16x8*)(Z + (size_t)ts * NZ + c0);
#pragma unroll
                for (int j = 0; j < 8; ++j) acc[j] += cw[k * 512 + c0 + j] * bf2f((bf16_t)v[j]); } }
        u32x4 w; w.x = pack2(siluf_(acc[0]), siluf_(acc[1])); w.y = pack2(siluf_(acc[2]), siluf_(acc[3])); w.z = pack2(siluf_(acc[4]), siluf_(acc[5])); w.w = pack2(siluf_(acc[6]), siluf_(acc[7]));
        *(u32x4*)(XC + (size_t)t * 512 + c0) = w;
    }
    float* W8 = (float*)smem;
    const float* wsrc = a.in[1] + (size_t)l * 1024 * INW + 1024;
    __syncthreads();
    for (int i = tid; i < 8192; i += 512) W8[i] = wsrc[(size_t)(i >> 3) * INW + (i & 7)];
    __syncthreads();
    const bf16_t* XB = (const bf16_t*)(a.ws + OFF_XB); float* LF = (float*)(a.ws + OFF_LF); float* LI = (float*)(a.ws + OFF_LI);
    for (int tw = bid * 8 + wave; tw < T / 8; tw += G * 8) {
        float myli = 0.f, mylf = 0.f;
        for (int tt = 0; tt < 8; ++tt) { const int t = tw * 8 + tt; float sacc[8];
#pragma unroll
            for (int j = 0; j < 8; ++j) sacc[j] = 0.f;
#pragma unroll 4
            for (int kk = 0; kk < 16; ++kk) { const int k = lane + 64 * kk; const float x = bf2f(XB[(size_t)t * 1024 + k]);
                const f32x4 w0 = *(const f32x4*)(W8 + k * 8), w1 = *(const f32x4*)(W8 + k * 8 + 4);
#pragma unroll
                for (int j = 0; j < 4; ++j) { sacc[j] += x * w0[j]; sacc[4 + j] += x * w1[j]; } }
#pragma unroll
            for (int j = 0; j < 8; ++j) {
#pragma unroll
                for (int o = 32; o >= 1; o >>= 1) sacc[j] += __shfl_xor(sacc[j], o); }
            const int hh = lane & 3;
            const float ipre = hh == 0 ? sacc[0] : hh == 1 ? sacc[1] : hh == 2 ? sacc[2] : sacc[3], fpre = hh == 0 ? sacc[4] : hh == 1 ? sacc[5] : hh == 2 ? sacc[6] : sacc[7];
            if ((lane >> 2) == tt) { myli = ipre + a.in[7][l * 4 + hh]; mylf = logsigmoidf_(fpre + a.in[8][l * 4 + hh]); }
        }
        if (lane < 32) { LI[tw * 32 + lane] = myli; LF[tw * 32 + lane] = mylf; }
    }
}

__device__ __forceinline__ ArgsRef fresh_args() { unsigned long long p = (unsigned long long)__builtin_amdgcn_kernarg_segment_ptr(); asm volatile("" : "+s"(p)); return *(const __attribute__((address_space(4))) Args*)p; }
__global__ void __launch_bounds__(512) fwd(Args a_unused) {
    cg::grid_group grid = cg::this_grid();
#define GSYNC() do { asm volatile("" ::: "memory"); grid.sync(); asm volatile("" ::: "memory"); } while (0)
    const int wave_s = __builtin_amdgcn_readfirstlane((int)threadIdx.x >> 6);
#define PH(body) do { int wave = wave_s; asm volatile("" : "+s"(wave)); int lane; asm volatile("v_mbcnt_lo_u32_b32 %0, -1, 0\n\tv_mbcnt_hi_u32_b32 %0, -1, %0" : "=v"(lane)); \
        int bid = blockIdx.x, G = gridDim.x; asm volatile("" : "+s"(bid), "+s"(G)); \
        const int tid = wave * 64 + lane, gw = bid * 8 + wave, GW = G * 8; (void)tid; (void)gw; (void)GW; ArgsRef a = fresh_args(); body; } while (0)
#pragma unroll 1
    for (int l = 0; l < NLAYER; ++l) {
        PH(phase_prep(a, l, tid, bid, G)); GSYNC();
        PH(phase_zgemm2(a, tid, bid, G)); GSYNC();
        PH(phase_mprep2(a, l, tid, lane, wave, bid, G)); GSYNC();
        PH(phase_mqkv(a, lane, gw, GW)); GSYNC();
        PH(phase_mixers<1>(a, l, tid, lane, wave, bid, G)); GSYNC();
        PH(phase_mixers<2>(a, l, tid, lane, wave, bid, G)); GSYNC();
        PH(phase_post(a, l, lane, gw, GW)); GSYNC();
        PH(phase_glu_gates(a, tid, bid, G)); PH(phase_prepx(a, l, tid, bid, G)); GSYNC();
        PH(phase_merge2(a, tid, bid, G)); GSYNC();
        PH(phase_wout2(a, l, tid, bid, G)); GSYNC();
        PH(phase_ln1r(a, l, tid, lane, wave, bid, G)); GSYNC();
        PH(phase_slot(a, tid, bid, G)); GSYNC();
        PH(phase_moe_gu(a, lane, gw, GW)); GSYNC();
        PH(phase_moe_dn(a, lane, gw, GW)); GSYNC();
        PH(phase_ln2(a, l, lane, gw, GW)); if (l + 1 < NLAYER) GSYNC();
    }
}

extern "C" void kernel_launch(void* const* d_in, const int* in_sizes, int n_in, void* d_out, int out_size, void* d_ws, size_t ws_size, hipStream_t stream) {
    static int grid = 0;
    if (grid == 0) {
        if (n_in != 34 || out_size != T * D || ws_size < WS_END) { fprintf(stderr, "kernel_launch: unexpected shapes (n_in %d, out %d, ws %zu, need %zu)\n", n_in, out_size, ws_size, (size_t)WS_END); grid = -1; return; }
        int dev = 0, cus = 0, per_cu = 0;
        (void)hipGetDevice(&dev); (void)hipDeviceGetAttribute(&cus, hipDeviceAttributeMultiprocessorCount, dev);
        (void)hipFuncSetAttribute((const void*)fwd, hipFuncAttributeMaxDynamicSharedMemorySize, LDS_BYTES);
        (void)hipOccupancyMaxActiveBlocksPerMultiprocessor(&per_cu, (const void*)fwd, 512, LDS_BYTES);
        if (per_cu < 1) { fprintf(stderr, "kernel_launch: occupancy query says %d blocks per CU\n", per_cu); per_cu = 1; }
        grid = (cus > 0 ? cus : 256) * 1;
        (void)hipGetLastError();
    }
    if (grid < 0) return;
    Args a{};
    for (int i = 0; i < 34; ++i) a.in[i] = (const float*)d_in[i];
    a.out = (float*)d_out; a.ws = (unsigned char*)d_ws; a.ph_lo = 0; a.ph_hi = NLAYER * NPH;
    void* args[] = {&a};
    hipError_t e = hipLaunchCooperativeKernel((const void*)fwd, dim3(grid), dim3(512), args, LDS_BYTES, stream);
    if (e != hipSuccess) fprintf(stderr, "kernel_launch: cooperative launch failed: %s (grid %d)\n", hipGetErrorString(e), grid);
}
```

```cpp
#include <hip/hip_runtime.h>
#include <hip/hip_cooperative_groups.h>
#include <cstdio>
#include <cstdint>
namespace cg = cooperative_groups;

typedef unsigned short bf16_t;
typedef short bf16x8 __attribute__((ext_vector_type(8)));
typedef short bf16x4 __attribute__((ext_vector_type(4)));
typedef float f32x4 __attribute__((ext_vector_type(4)));
typedef unsigned u32x4 __attribute__((ext_vector_type(4)));
typedef unsigned u32x2 __attribute__((ext_vector_type(2)));

constexpr int T = 16384, D = 1024, NZ = 3584, NWIN = 6912, INW = 6664;
constexpr int NPH = 15, NLAYER = 2;
constexpr int GSEG = 32, GSEGLEN = 512;
constexpr int SSEG = 64, SSEGLEN = 256;
constexpr int SLOTS = 32768 + 2048;
constexpr float DN_ALPHA = 1.41421356237f;
constexpr int LDS_BYTES = 131072 + 256;

constexpr size_t AL(size_t x) { return (x + 255) & ~(size_t)255; }
constexpr size_t OFF_WIN = 0;
constexpr size_t OFF_WQKV = OFF_WIN + AL((size_t)NWIN * 1024 * 2);
constexpr size_t OFF_WGLU = OFF_WQKV + AL((size_t)12 * 128 * 128 * 2);
constexpr size_t OFF_WB = OFF_WGLU + AL((size_t)512 * 512 * 2);
constexpr size_t OFF_WOUT = OFF_WB + AL((size_t)3 * 1024 * 512 * 2);
constexpr size_t OFF_ABAR = OFF_WOUT + AL((size_t)1024 * 1024 * 2);
constexpr size_t OFF_BBT = OFF_ABAR + AL((size_t)32 * 64 * 2 * 4);
constexpr size_t OFF_CCT = OFF_BBT + AL((size_t)32 * 128 * 16 * 2);
constexpr size_t OFF_CTL = OFF_CCT + AL((size_t)32 * 16 * 128 * 2);
constexpr size_t OFF_TOKE = OFF_CTL + 4096;
constexpr size_t OFF_TOKG = OFF_TOKE + AL((size_t)T * 2 * 4);
constexpr size_t OFF_TOKS = OFF_TOKG + AL((size_t)T * 2 * 4);
constexpr size_t OFF_SLOTT = OFF_TOKS + AL((size_t)T * 2 * 4);
constexpr size_t OFF_XB = OFF_SLOTT + AL((size_t)SLOTS * 4);
constexpr size_t OFF_R1 = OFF_XB + AL((size_t)T * 1024 * 2);
constexpr size_t SZ_ACT = (size_t)T * 512 * 2;
constexpr size_t OFF_XC = OFF_R1, OFF_Q = OFF_R1 + SZ_ACT, OFF_KH = OFF_R1 + 2 * SZ_ACT, OFF_V = OFF_R1 + 3 * SZ_ACT;
constexpr size_t OFF_WGU = OFF_R1, OFF_WD = OFF_R1 + (size_t)32 * 512 * 1024 * 2;
constexpr size_t OFF_Z = OFF_R1 + 4 * SZ_ACT;
constexpr size_t OFF_MERGED = OFF_Z, OFF_H = OFF_Z + (size_t)T * 1024 * 2;
constexpr size_t OFF_ZS = OFF_Z + AL((size_t)T * NZ * 2);
constexpr size_t OFF_LF = OFF_ZS + AL((size_t)T * 8 * 4);
constexpr size_t OFF_LI = OFF_LF + AL((size_t)T * 4 * 4);
constexpr size_t OFF_E = OFF_LI + AL((size_t)T * 4 * 4);
constexpr size_t OFF_OM = OFF_E, OFF_OH = OFF_E + SZ_ACT, OFF_YPRE = OFF_E + 2 * SZ_ACT, OFF_YSG = OFF_E + 3 * SZ_ACT;
constexpr size_t OFF_DEN = OFF_E + 4 * SZ_ACT;
constexpr size_t OFF_EM = OFF_DEN + AL((size_t)T * 4 * 4);
constexpr size_t OFF_EMX = OFF_EM + AL((size_t)GSEG * 4 * 128 * 128 * 4);
constexpr size_t OFF_GM = OFF_EMX + AL((size_t)GSEG * 4 * 128 * 16 * 4);
constexpr size_t OFF_EH = OFF_GM + AL((size_t)GSEG * 4 * 128 * 4);
constexpr size_t OFF_GH = OFF_EH + AL((size_t)GSEG * 4 * 128 * 128 * 4);
constexpr size_t OFF_ES = OFF_GH + AL((size_t)GSEG * 4 * 128 * 4);
constexpr size_t WS_END = OFF_ES + AL((size_t)SSEG * 32 * 64 * 2 * 4);
constexpr size_t OFF_YS = OFF_E;
constexpr size_t OFF_BAR = WS_END;
constexpr size_t WS_TOTAL = OFF_BAR + 16384;
static_assert(OFF_YS + (size_t)SLOTS * 1024 * 2 <= WS_END, "YS must fit in the dead region");
static_assert(OFF_H + (size_t)SLOTS * 256 * 2 <= OFF_ZS, "H must fit in the dead Z region");
static_assert(OFF_WD + (size_t)32 * 1024 * 256 * 2 <= OFF_Z, "expert weights must fit in R1");

struct Args { const float* in[34]; float* out; unsigned char* ws; int ph_lo, ph_hi; };
typedef const __attribute__((address_space(4))) Args& ArgsRef;

extern __shared__ __attribute__((aligned(16))) unsigned char smem[];

__device__ __forceinline__ bf16_t f2bf(float f) { unsigned u = __float_as_uint(f); u += 0x7FFFu + ((u >> 16) & 1u); return (bf16_t)(u >> 16); }
__device__ __forceinline__ float bf2f(bf16_t b) { return __uint_as_float(((unsigned)b) << 16); }
__device__ __forceinline__ unsigned pack2(float lo, float hi) { return (unsigned)f2bf(lo) | ((unsigned)f2bf(hi) << 16); }
__device__ __forceinline__ float sigmoidf_(float x) { return 1.0f / (1.0f + expf(-x)); }
__device__ __forceinline__ float siluf_(float x) { return x / (1.0f + expf(-x)); }
__device__ __forceinline__ float logsigmoidf_(float x) { return fminf(x, 0.f) - log1pf(expf(-fabsf(x))); }
__device__ __forceinline__ float gelu_tanh(float y) { const float z = 0.7978845608028654f * (y + 0.044715f * y * y * y); const float th = 1.0f - 2.0f / (expf(2.0f * z) + 1.0f); return 0.5f * y * (1.0f + th); }
__device__ __forceinline__ void wave_sync() { __builtin_amdgcn_wave_barrier(); asm volatile("s_waitcnt lgkmcnt(0)" ::: "memory"); __builtin_amdgcn_wave_barrier(); }

#define MFMA16(a, b, c) __builtin_amdgcn_mfma_f32_16x16x32_bf16((a), (b), (c), 0, 0, 0)

template <int MT, int NT, class FA, class FB>
__device__ __forceinline__ void wave_gemm(f32x4 (&acc)[MT][NT], int K, FA arow, FB brow, int lane) {
    const int r = lane & 15, q = lane >> 4;
    const bf16_t* ap[MT]; const bf16_t* bp[NT];
#pragma unroll
    for (int m = 0; m < MT; ++m) ap[m] = arow(m * 16 + r) + 8 * q;
#pragma unroll
    for (int n = 0; n < NT; ++n) bp[n] = brow(n * 16 + r) + 8 * q;
#pragma unroll 1
    for (int k = 0; k < K; k += 32) {
        bf16x8 a[MT], b[NT];
#pragma unroll
        for (int m = 0; m < MT; ++m) a[m] = *(const bf16x8*)(ap[m] + k);
#pragma unroll
        for (int n = 0; n < NT; ++n) b[n] = *(const bf16x8*)(bp[n] + k);
#pragma unroll
        for (int m = 0; m < MT; ++m)
#pragma unroll
            for (int n = 0; n < NT; ++n) acc[m][n] = MFMA16(a[m], b[n], acc[m][n]);
    }
}
template <int MT, int NT> __device__ __forceinline__ void zero_acc(f32x4 (&acc)[MT][NT]) {
#pragma unroll
    for (int m = 0; m < MT; ++m)
#pragma unroll
        for (int n = 0; n < NT; ++n) acc[m][n] = (f32x4){0.f, 0.f, 0.f, 0.f};
}

namespace pg8 {
#define PG8_LAS __attribute__((address_space(3)))
constexpr int BM = 256, BK = 64, HALF = 128, HTB = HALF * BK * 2, STAGE_BYTES = 8 * HTB;
__device__ __forceinline__ int lds_byte(int r, int c) { const int st = (r >> 4) * 2 + (c >> 5), rr = r & 15, cc = c & 31, ob = rr * 64 + cc * 2; return st * 1024 + (ob ^ (((ob >> 9) & 1) << 5)); }
__device__ __forceinline__ void stage_rc(int b, int& R, int& C) { const int st = b / 1024, sb = b % 1024, swz = sb ^ (((sb >> 9) & 1) << 5); R = (st >> 1) * 16 + swz / 64; C = (st & 1) * 32 + (swz % 64) / 2; }
__device__ __forceinline__ int perm32(int rho) { const int n = rho >> 4, i = rho & 15; return 8 * (i >> 2) + 4 * n + (i & 3); }
struct Unit { int pm, pn, tag; const char* A; const char* B; };
__device__ __forceinline__ unsigned cvt_pk_bf16(float lo, float hi) { unsigned r; asm volatile("v_cvt_pk_bf16_f32 %0, %1, %2" : "=v"(r) : "v"(lo), "v"(hi)); return r; }
__device__ __forceinline__ bool tile_order(int L, int nM, int nN, int& pm, int& pn) {
    const int nwg = nM * nN; if (L >= nwg) return false;
    int wgid = L; { const int q = nwg / 8, r = nwg % 8, xcd = wgid % 8, off = wgid / 8; wgid = (xcd < r ? xcd * (q + 1) : r * (q + 1) + (xcd - r) * q) + off; }
    const int nig = 8 * nN, gid = wgid / nig, fm = gid * 8, gsz = (nM - fm) < 8 ? (nM - fm) : 8;
    pm = fm + ((wgid % nig) % gsz); pn = (wgid % nig) / gsz; return true;
}
template <class Epi, class Sched>
__device__ __forceinline__ void gemm_phase(PG8_LAS unsigned char* lds, const int tid, const int K, const int lda, const int ldb, const Sched& S, const Epi& E) {
    const int wid = __builtin_amdgcn_readfirstlane(tid >> 6), lane = tid & 63, wr = wid >> 2, wc = wid & 3, fr = lane & 15, fq = lane >> 4;
    const int nt = K / BK;
    unsigned voffA[2], voffB[2];
#pragma unroll
    for (int i = 0; i < 2; ++i) { int R, C; stage_rc(tid * 16 + i * 8192, R, C); const int Rb = Epi::PERM ? ((R & ~31) + perm32(R & 31)) : R;
        voffA[i] = (unsigned)(R * lda + C) * 2u; voffB[i] = (unsigned)(Rb * ldb + C) * 2u; }
    const size_t kstep = (size_t)(BK * 2), hstepA = (size_t)HALF * lda * 2, hstepB = (size_t)HALF * ldb * 2;
    const unsigned ldsw = (unsigned)wid * 1024u;
    const int aoff = lds_byte(wr * 64 + fr, fq * 8), boff = lds_byte(wc * 32 + fr, fq * 8);
#define PG8_SA(b, h) (((b) * 2 + (h)) * HTB)
#define PG8_SB(b, h) ((4 + (b) * 2 + (h)) * HTB)
#define PG8_STAGE(bufoff, gbase, voff) do { _Pragma("unroll") for (int _i = 0; _i < 2; ++_i) \
        __builtin_amdgcn_global_load_lds((const unsigned*)((const char*)(gbase) + (voff)[_i]), (PG8_LAS unsigned*)(lds + (bufoff) + ldsw + _i * 8192), 16, 0, 0); } while (0)
#define PG8_LDA(dst, b, h) do { _Pragma("unroll") for (int m = 0; m < 4; ++m) _Pragma("unroll") for (int k = 0; k < 2; ++k) dst[m][k] = *(const PG8_LAS bf16x8*)(lds + PG8_SA(b, h) + aoff + m * 2048 + k * 1024); } while (0)
#define PG8_LDB(dst, b, h) do { _Pragma("unroll") for (int n = 0; n < 2; ++n) _Pragma("unroll") for (int k = 0; k < 2; ++k) dst[n][k] = *(const PG8_LAS bf16x8*)(lds + PG8_SB(b, h) + boff + n * 2048 + k * 1024); } while (0)
#define PG8_MMA(ai, bj, At, Bt) do { __builtin_amdgcn_s_setprio(1); _Pragma("unroll") for (int m = 0; m < 4; ++m) _Pragma("unroll") for (int n = 0; n < 2; ++n) _Pragma("unroll") for (int k = 0; k < 2; ++k) \
        acc[ai][bj][m][n] = __builtin_amdgcn_mfma_f32_16x16x32_bf16(Bt[n][k], At[m][k], acc[ai][bj][m][n], 0, 0, 0); __builtin_amdgcn_s_setprio(0); } while (0)
#define PG8_WAIT_V(n) asm volatile("s_waitcnt vmcnt(" #n ")" ::: "memory")
#define PG8_WAIT_L(n) asm volatile("s_waitcnt lgkmcnt(" #n ")" ::: "memory")
#define PG8_BAR __builtin_amdgcn_s_barrier()
#define PG8_SCHED __builtin_amdgcn_sched_barrier(0)
    Unit cur, nxt; int ui = 0;
    if (!S.next(0, cur)) return;
    f32x4 acc[2][2][4][2];
#pragma unroll
    for (int a = 0; a < 2; ++a)
#pragma unroll
        for (int b = 0; b < 2; ++b)
#pragma unroll
            for (int m = 0; m < 4; ++m)
#pragma unroll
                for (int n = 0; n < 2; ++n) acc[a][b][m][n] = (f32x4){0.f, 0.f, 0.f, 0.f};
    bf16x8 At[4][2], B0[2][2], B1[2][2];
    const char* cA = cur.A; const char* cB = cur.B;
    PG8_STAGE(PG8_SB(0, 0), cB, voffB); PG8_STAGE(PG8_SA(0, 0), cA, voffA); PG8_STAGE(PG8_SB(0, 1), cB + hstepB, voffB); PG8_STAGE(PG8_SA(0, 1), cA + hstepA, voffA);
    if (wr == 1) PG8_BAR;
    PG8_WAIT_V(4); PG8_BAR;
    PG8_STAGE(PG8_SB(1, 0), cB + kstep, voffB); PG8_STAGE(PG8_SA(1, 0), cA + kstep, voffA); PG8_STAGE(PG8_SB(1, 1), cB + hstepB + kstep, voffB);
    PG8_WAIT_V(6); PG8_BAR;
    for (;;) {
        const bool has_next = S.next(ui + 1, nxt);
        const char* nA = has_next ? nxt.A : cA; const char* nB = has_next ? nxt.B : cB;
        for (int t = 0; t < nt; t += 2) {
            const bool last = (t == nt - 2);
            const char* a1 = cA + (size_t)(t + 1) * kstep;
            const char* a2 = last ? nA : cA + (size_t)(t + 2) * kstep; const char* b2 = last ? nB : cB + (size_t)(t + 2) * kstep;
            const char* a3 = a2 + kstep; const char* b3 = b2 + kstep;
            PG8_LDB(B0, 0, 0); PG8_SCHED; PG8_LDA(At, 0, 0); PG8_STAGE(PG8_SA(1, 1), a1 + hstepA, voffA);
            PG8_WAIT_L(8); PG8_BAR; PG8_WAIT_L(0); PG8_MMA(0, 0, At, B0); PG8_BAR; PG8_SCHED;
            PG8_LDB(B1, 0, 1); PG8_STAGE(PG8_SB(0, 0), b2, voffB);
            PG8_BAR; PG8_WAIT_L(0); PG8_MMA(0, 1, At, B1); PG8_BAR;
            PG8_LDA(At, 0, 1); PG8_STAGE(PG8_SA(0, 0), a2, voffA);
            PG8_BAR; PG8_WAIT_L(0); PG8_MMA(1, 0, At, B0); PG8_BAR; PG8_SCHED;
            PG8_STAGE(PG8_SB(0, 1), b2 + hstepB, voffB);
            PG8_WAIT_V(6); PG8_BAR; PG8_MMA(1, 1, At, B1); PG8_BAR;
            PG8_LDB(B0, 1, 0); PG8_SCHED; PG8_LDA(At, 1, 0); PG8_STAGE(PG8_SA(0, 1), a2 + hstepA, voffA);
            PG8_WAIT_L(8); PG8_BAR; PG8_WAIT_L(0); PG8_MMA(0, 0, At, B0); PG8_BAR; PG8_SCHED;
            PG8_LDB(B1, 1, 1); PG8_STAGE(PG8_SB(1, 0), b3, voffB);
            PG8_BAR; PG8_WAIT_L(0); PG8_MMA(0, 1, At, B1); PG8_BAR;
            PG8_LDA(At, 1, 1); PG8_STAGE(PG8_SA(1, 0), a3, voffA);
            PG8_BAR; PG8_WAIT_L(0); PG8_MMA(1, 0, At, B0); PG8_BAR; PG8_SCHED;
            PG8_STAGE(PG8_SB(1, 1), b3 + hstepB, voffB);
            PG8_WAIT_V(6); PG8_BAR; PG8_MMA(1, 1, At, B1); PG8_BAR;
        }
        const bool keep = E(acc, cur, wr, wc, fr, fq);
        if (!has_next) break;
        if (!keep) {
#pragma unroll
            for (int a = 0; a < 2; ++a)
#pragma unroll
                for (int b = 0; b < 2; ++b)
#pragma unroll
                    for (int m = 0; m < 4; ++m)
#pragma unroll
                        for (int n = 0; n < 2; ++n) acc[a][b][m][n] = (f32x4){0.f, 0.f, 0.f, 0.f};
        }
        cur = nxt; cA = nA; cB = nB; ++ui;
    }
    PG8_WAIT_V(0);
    if (wr == 0) PG8_BAR;
    PG8_BAR;
#undef PG8_SA
#undef PG8_SB
#undef PG8_STAGE
#undef PG8_LDA
#undef PG8_LDB
#undef PG8_MMA
#undef PG8_WAIT_V
#undef PG8_WAIT_L
#undef PG8_BAR
#undef PG8_SCHED
}
}

__device__ __forceinline__ void tconv_tile(const float* src, int ld_src, int nvalid, bf16_t* dst, int ld_dst, int tid) {
    float* t = (float*)smem;
    { const int r = tid >> 3, c0 = (tid & 7) * 8;
#pragma unroll
      for (int j = 0; j < 8; ++j) { const int c = c0 + j; const float v = (c < nvalid) ? src[(size_t)r * ld_src + c] : 0.f; t[c * 65 + r] = v; } }
    __syncthreads();
    { const int n = tid >> 3, k0 = (tid & 7) * 8; const float* p = t + n * 65 + k0;
      u32x4 w; w.x = pack2(p[0], p[1]); w.y = pack2(p[2], p[3]); w.z = pack2(p[4], p[5]); w.w = pack2(p[6], p[7]);
      *(u32x4*)(dst + (size_t)n * ld_dst + k0) = w; }
    __syncthreads();
}

__device__ __forceinline__ void phase_prep(ArgsRef a, int l, int tid, int bid, int G) {
    unsigned char* ws = a.ws;
    bf16_t* WIN = (bf16_t*)(ws + OFF_WIN); bf16_t* WQKV = (bf16_t*)(ws + OFF_WQKV); bf16_t* WGLU = (bf16_t*)(ws + OFF_WGLU);
    bf16_t* WB = (bf16_t*)(ws + OFF_WB); bf16_t* WOUT = (bf16_t*)(ws + OFF_WOUT);
    for (int u = bid; u < 2480; u += G) {
        const float* src; int lds_ = 0, nvalid = 64, ldd = 0; bf16_t* dst;
        if (u < 1728) { const int nt = u / 16, kt = u % 16, p0 = nt * 64; int sc;
            if (p0 < 1024) sc = p0; else if (p0 < 6656) sc = p0 + 8; else if (p0 == 6656) { sc = 1024; nvalid = 8; } else { sc = 0; nvalid = 0; }
            src = a.in[1] + (size_t)l * 1024 * INW + (size_t)(kt * 64) * INW + sc; lds_ = INW; dst = WIN + (size_t)p0 * 1024 + kt * 64; ldd = 1024; }
        else if (u < 1776) { const int v = u - 1728, m = v / 4, tt = v % 4, nt = tt >> 1, kt = tt & 1, which = m / 4, h = m % 4;
            src = a.in[4 + which] + (size_t)(l * 4 + h) * 128 * 128 + (kt * 64) * 128 + nt * 64; lds_ = 128; dst = WQKV + (size_t)m * 128 * 128 + (nt * 64) * 128 + kt * 64; ldd = 128; }
        else if (u < 1840) { const int v = u - 1776, nt = v / 8, kt = v % 8;
            src = a.in[18] + (size_t)l * 512 * 512 + (kt * 64) * 512 + nt * 64; lds_ = 512; dst = WGLU + (size_t)(nt * 64) * 512 + kt * 64; ldd = 512; }
        else if (u < 2224) { const int v = u - 1840, b = v / 128, w = v % 128, nt = w / 8, kt = w % 8;
            src = a.in[21 + b] + (size_t)l * 512 * 1024 + (size_t)(kt * 64) * 1024 + nt * 64; lds_ = 1024; dst = WB + (size_t)b * 1024 * 512 + (size_t)(nt * 64) * 512 + kt * 64; ldd = 512; }
        else { const int v = u - 2224, nt = v / 16, kt = v % 16;
            src = a.in[24] + (size_t)l * 1024 * 1024 + (size_t)(kt * 64) * 1024 + nt * 64; lds_ = 1024; dst = WOUT + (size_t)(nt * 64) * 1024 + kt * 64; ldd = 1024; }
        tconv_tile(src, lds_, nvalid, dst, ldd, tid);
    }
    float* ABAR = (float*)(ws + OFF_ABAR); bf16_t* BBT = (bf16_t*)(ws + OFF_BBT); bf16_t* CCT = (bf16_t*)(ws + OFF_CCT);
    for (int i = bid * 512 + tid; i < 2048; i += G * 512) {
        const int g = i / 64, p = i % 64; const size_t gp = (size_t)(l * 32 + g) * 64 + p;
        const float lr = fminf(a.in[10][gp], -1e-4f), li = a.in[11][gp], dt = expf(a.in[12][l * 32 + g]);
        const float mag = expf(lr * dt), abr = mag * cosf(li * dt), abi = mag * sinf(li * dt);
        const float nr = abr - 1.0f, den = lr * lr + li * li, cr = (nr * lr + abi * li) / den, ci = (abi * lr - nr * li) / den;
        ABAR[(g * 64 + p) * 2] = abr; ABAR[(g * 64 + p) * 2 + 1] = abi;
        for (int c = 0; c < 16; ++c) { const float br = a.in[13][gp * 16 + c], bi = a.in[14][gp * 16 + c];
            BBT[(size_t)(g * 128 + p) * 16 + c] = f2bf(cr * br - ci * bi); BBT[(size_t)(g * 128 + 64 + p) * 16 + c] = f2bf(cr * bi + ci * br);
            const size_t ci_ = ((size_t)(l * 32 + g) * 16 + c) * 64 + p;
            CCT[(size_t)(g * 16 + c) * 128 + p] = f2bf(a.in[15][ci_]); CCT[(size_t)(g * 16 + c) * 128 + 64 + p] = f2bf(-a.in[16][ci_]); }
    }
    if (bid == 0 && tid < 128) ((unsigned*)(ws + OFF_CTL))[tid] = 0u;
    if (l == 0) { bf16_t* XB = (bf16_t*)(ws + OFF_XB); const float* x = a.in[0];
        for (size_t i = (size_t)bid * 512 + tid; i < (size_t)T * 1024 / 8; i += (size_t)G * 512) {
            const f32x4 v0 = *(const f32x4*)(x + i * 8), v1 = *(const f32x4*)(x + i * 8 + 4);
            u32x4 w; w.x = pack2(v0[0], v0[1]); w.y = pack2(v0[2], v0[3]); w.z = pack2(v1[0], v1[1]); w.w = pack2(v1[2], v1[3]); *(u32x4*)(XB + i * 8) = w; } }
}

__device__ __forceinline__ void phase_prepx(ArgsRef a, int l, int tid, int bid, int G) {
    bf16_t* WGU = (bf16_t*)(a.ws + OFF_WGU); bf16_t* WD = (bf16_t*)(a.ws + OFF_WD);
    for (int u = bid; u < 6144; u += G) {
        const float* src; int lds_, ldd; bf16_t* dst;
        if (u < 4096) { const int up = u >= 2048, v = u & 2047, e = v / 64, w = v % 64, nt = w / 16, kt = w % 16, j0 = nt * 64, drow = (j0 / 128) * 256 + (j0 % 128) + up * 128;
            src = a.in[31 + up] + ((size_t)(l * 32 + e) * 1024 + kt * 64) * 256 + nt * 64; lds_ = 256; dst = WGU + ((size_t)e * 512 + drow) * 1024 + kt * 64; ldd = 1024; }
        else { const int v = u - 4096, e = v / 64, w = v % 64, nt = w / 4, kt = w % 4;
            src = a.in[33] + ((size_t)(l * 32 + e) * 256 + kt * 64) * 1024 + nt * 64; lds_ = 1024; dst = WD + ((size_t)e * 1024 + nt * 64) * 256 + kt * 64; ldd = 256; }
        tconv_tile(src, lds_, 64, dst, ldd, tid);
    }
}

__device__ __forceinline__ void phase_zgemm(ArgsRef a, int lane, int gw, int GW) {
    const bf16_t* XB = (const bf16_t*)(a.ws + OFF_XB); const bf16_t* WIN = (const bf16_t*)(a.ws + OFF_WIN);
    bf16_t* Z = (bf16_t*)(a.ws + OFF_Z); float* ZS = (float*)(a.ws + OFF_ZS);
    const int r = lane & 15, q = lane >> 4;
    for (int u = gw; u < 256 * 57; u += GW) {
        const int mt = u / 57, nt = u % 57, nc0 = nt < 56 ? nt * 64 : 6656;
        f32x4 acc[4][4]; zero_acc(acc);
        wave_gemm<4, 4>(acc, 1024, [=](int i) { return XB + (size_t)(mt * 64 + i) * 1024; }, [=](int j) { return WIN + (size_t)(nc0 + j) * 1024; }, lane);
#pragma unroll
        for (int m = 0; m < 4; ++m)
#pragma unroll
            for (int n = 0; n < 4; ++n)
#pragma unroll
                for (int g = 0; g < 4; ++g) { const int row = mt * 64 + m * 16 + 4 * q + g, col = n * 16 + r;
                    if (nt < 56) Z[(size_t)row * NZ + nt * 64 + col] = f2bf(acc[m][n][g]); else if (n == 0 && r < 8) ZS[row * 8 + r] = acc[m][n][g]; }
    }
}

__device__ __forceinline__ void phase_mprep(ArgsRef a, int l, int tid, int bid, int G) {
    const bf16_t* Z = (const bf16_t*)(a.ws + OFF_Z); bf16_t* XC = (bf16_t*)(a.ws + OFF_XC);
    const float* cw = a.in[2] + (size_t)l * 4 * 512; const float* cb = a.in[3] + (size_t)l * 512;
    for (int idx = bid * 512 + tid; idx < T * 64; idx += G * 512) {
        const int t = idx / 64, c0 = (idx % 64) * 8; float acc[8];
#pragma unroll
        for (int j = 0; j < 8; ++j) acc[j] = cb[c0 + j];
#pragma unroll
        for (int k = 0; k < 4; ++k) { const int ts = t - 3 + k; if (ts >= 0) { const bf16x8 v = *(const bf16x8*)(Z + (size_t)ts * NZ + c0);
#pragma unroll
                for (int j = 0; j < 8; ++j) acc[j] += cw[k * 512 + c0 + j] * bf2f((bf16_t)v[j]); } }
        u32x4 w; w.x = pack2(siluf_(acc[0]), siluf_(acc[1])); w.y = pack2(siluf_(acc[2]), siluf_(acc[3])); w.z = pack2(siluf_(acc[4]), siluf_(acc[5])); w.w = pack2(siluf_(acc[6]), siluf_(acc[7]));
        *(u32x4*)(XC + (size_t)t * 512 + c0) = w;
    }
    const float* ZS = (const float*)(a.ws + OFF_ZS); float* LF = (float*)(a.ws + OFF_LF); float* LI = (float*)(a.ws + OFF_LI);
    for (int idx = bid * 512 + tid; idx < T * 4; idx += G * 512) { const int t = idx >> 2, h = idx & 3;
        LI[idx] = ZS[t * 8 + h] + a.in[7][l * 4 + h]; LF[idx] = logsigmoidf_(ZS[t * 8 + 4 + h] + a.in[8][l * 4 + h]); }
}

__device__ __forceinline__ void phase_mqkv(ArgsRef a, int lane, int gw, int GW) {
    const bf16_t* Z = (const bf16_t*)(a.ws + OFF_Z); const bf16_t* XC = (const bf16_t*)(a.ws + OFF_XC); const bf16_t* WQKV = (const bf16_t*)(a.ws + OFF_WQKV);
    const float* LI = (const float*)(a.ws + OFF_LI);
    const int r = lane & 15, q = lane >> 4;
    for (int u = gw; u < 256 * 24; u += GW) {
        const int mt = u / 24, v = u % 24, which = v / 8, h = (v % 8) / 2, nh = v % 2;
        const bf16_t* A = which < 2 ? XC + h * 128 : Z + h * 128; const int lda = which < 2 ? 512 : NZ;
        f32x4 acc[4][4]; zero_acc(acc);
        wave_gemm<4, 4>(acc, 128, [=](int i) { return A + (size_t)(mt * 64 + i) * lda; }, [=](int j) { return WQKV + (size_t)((which * 4 + h) * 128 + nh * 64 + j) * 128; }, lane);
        bf16_t* O = (bf16_t*)(a.ws + (which == 0 ? OFF_Q : which == 1 ? OFF_KH : OFF_V));
#pragma unroll
        for (int m = 0; m < 4; ++m)
#pragma unroll
            for (int g = 0; g < 4; ++g) { const int row = mt * 64 + m * 16 + 4 * q + g;
                const float sc = which == 0 ? 0.08838834764831845f : which == 1 ? expf(LI[row * 4 + h]) : 1.0f;
#pragma unroll
                for (int n = 0; n < 4; ++n) O[(size_t)row * 512 + h * 128 + nh * 64 + n * 16 + r] = f2bf(acc[m][n][g] * sc); }
    }
}

constexpr int GL_QS = 0, GL_KS = 8704, GL_KT = 17408, GL_VT = 27648, GL_PS = 39168, GL_SC1 = 41728, GL_SC2 = 42240, GL_GT = 42752, GL_OS = 44800;
template <int MODE, int PASS>
__device__ __forceinline__ void gla_item(ArgsRef a, int l, int h, int sg, int tid, int lane, int wave) {
    unsigned char* ws = a.ws;
    const bf16_t* Z = (const bf16_t*)(ws + OFF_Z); const bf16_t* Qg = (const bf16_t*)(ws + OFF_Q); const bf16_t* Kg = (const bf16_t*)(ws + OFF_KH); const bf16_t* Vg = (const bf16_t*)(ws + OFF_V);
    const float* LF = (const float*)(ws + OFF_LF);
    float* Eg = (float*)(ws + (MODE == 0 ? OFF_EM : OFF_EH)); float* Gg = (float*)(ws + (MODE == 0 ? OFF_GM : OFF_GH)); float* EX = (float*)(ws + OFF_EMX);
    bf16_t* Og = (bf16_t*)(ws + (MODE == 0 ? OFF_OM : OFF_OH)); float* DEN = (float*)(ws + OFF_DEN);
    bf16_t* QS = (bf16_t*)(smem + GL_QS); bf16_t* KS = (bf16_t*)(smem + GL_KS); bf16_t* KT = (bf16_t*)(smem + GL_KT); bf16_t* VT = (bf16_t*)(smem + GL_VT); bf16_t* PS = (bf16_t*)(smem + GL_PS);
    float* SC1 = (float*)(smem + GL_SC1); float* SC2 = (float*)(smem + GL_SC2); float* GT = (float*)(smem + GL_GT); bf16_t* OS = (bf16_t*)(smem + GL_OS);
    const int r = lane & 15, q = lane >> 4, grp = tid >> 7, d = tid & 127;
    const bool xw = (MODE == 0) && (wave == 0);
    float lb = 0.f;
    if (MODE == 1 && l == 1) { const float h0 = a.in[19][h * 128 + d], h1 = a.in[19][512 + h * 128 + d]; lb = 1.0f / (1.0f + expf(h0 - h1)); }
    f32x4 S[8], SX[8];
#pragma unroll
    for (int i = 0; i < 8; ++i) { S[i] = (f32x4){0.f, 0.f, 0.f, 0.f}; SX[i] = (f32x4){0.f, 0.f, 0.f, 0.f}; }
    if (PASS == 2) {
        for (int j = 0; j < sg; ++j) {
#pragma unroll
            for (int i = 0; i < 8; ++i) { const f32x4 gv = *(const f32x4*)(Gg + (size_t)(j * 4 + h) * 128 + 16 * i + 4 * q);
#pragma unroll
                for (int g = 0; g < 4; ++g) { const size_t row = (size_t)(j * 4 + h) * 128 + 16 * i + 4 * q + g;
                    S[i][g] = gv[g] * S[i][g] + Eg[row * 128 + 16 * wave + r];
                    if (xw) SX[i][g] = gv[g] * SX[i][g] + EX[row * 16 + r]; } }
        }
    }
    __syncthreads();
    if (MODE == 0) { for (int i = tid; i < 16 * 40; i += 512) VT[128 * 40 + i] = (i < 32) ? (bf16_t)0x3F80 : (bf16_t)0; }
    float runb = 0.f;
    for (int ci = 0; ci < GSEGLEN / 32; ++ci) {
        const int t0 = sg * GSEGLEN + ci * 32, tb = t0 + grp * 8;
        float lg[8], qv[8], kv[8]; bf16_t vv[8];
#pragma unroll
        for (int j = 0; j < 8; ++j) {
            if (MODE == 1) { const size_t zo = (size_t)(tb + j) * NZ + h * 128 + d; const float qp = bf2f(Z[zo + 1536]), fp = bf2f(Z[zo + 2048]);
                const float f = lb + (1.0f - lb) * sigmoidf_(fp); lg[j] = logf(f); qv[j] = siluf_(qp); kv[j] = 1.0f - f; vv[j] = Z[zo + 2560]; }
            else { const size_t o = (size_t)(tb + j) * 512 + h * 128 + d; qv[j] = bf2f(Qg[o]); kv[j] = bf2f(Kg[o]); vv[j] = Vg[o]; lg[j] = LF[(tb + j) * 4 + h]; }
        }
        float cs[8]; cs[0] = lg[0];
#pragma unroll
        for (int j = 1; j < 8; ++j) cs[j] = cs[j - 1] + lg[j];
        GT[grp * 128 + d] = cs[7];
        __syncthreads();
        if (PASS == 2 && ci > 0) { const int row = tid >> 4, c8 = (tid & 15) * 8; *(u32x4*)(Og + (size_t)(t0 - 32 + row) * 512 + h * 128 + c8) = *(const u32x4*)(OS + row * 136 + c8); }
        const float g0 = GT[d], g1 = GT[128 + d], g2 = GT[256 + d], g3 = GT[384 + d];
        const float off = grp == 0 ? 0.f : grp == 1 ? g0 : grp == 2 ? g0 + g1 : g0 + g1 + g2;
        const float bmid = g0 + g1, bL = bmid + g2 + g3;
        bf16_t ktv[8];
#pragma unroll
        for (int j = 0; j < 8; ++j) { const float bt = off + cs[j]; const bf16_t kt = f2bf(kv[j] * expf(bmid - bt)); ktv[j] = kt;
            if (PASS == 2) { QS[(grp * 8 + j) * 136 + d] = f2bf(qv[j] * expf(bt - bmid)); KS[(grp * 8 + j) * 136 + d] = kt; } }
        { u32x4 w; w.x = ktv[0] | ((unsigned)ktv[1] << 16); w.y = ktv[2] | ((unsigned)ktv[3] << 16); w.z = ktv[4] | ((unsigned)ktv[5] << 16); w.w = ktv[6] | ((unsigned)ktv[7] << 16); *(u32x4*)(KT + d * 40 + grp * 8) = w;
          u32x4 x; x.x = vv[0] | ((unsigned)vv[1] << 16); x.y = vv[2] | ((unsigned)vv[3] << 16); x.z = vv[4] | ((unsigned)vv[5] << 16); x.w = vv[6] | ((unsigned)vv[7] << 16); *(u32x4*)(VT + d * 40 + grp * 8) = x; }
        if (grp == 0) { SC1[d] = expf(bmid); SC2[d] = expf(bL - bmid); runb += bL; }
        __syncthreads();
        if (PASS == 2) {
            if (wave < 4) {
                const int ti = (wave == 1 || wave == 2) ? 1 : 0, tj = (wave >= 2) ? 1 : 0;
                f32x4 p = (f32x4){0.f, 0.f, 0.f, 0.f};
                if (wave < 3) {
#pragma unroll
                    for (int kk = 0; kk < 4; ++kk) { const bf16x8 av = *(const bf16x8*)(QS + (16 * ti + r) * 136 + 32 * kk + 8 * q); const bf16x8 bv = *(const bf16x8*)(KS + (16 * tj + r) * 136 + 32 * kk + 8 * q); p = MFMA16(av, bv, p); }
                }
#pragma unroll
                for (int g = 0; g < 4; ++g) { const int t = 16 * ti + 4 * q + g, s = 16 * tj + r; PS[t * 40 + s] = (wave < 3 && s <= t) ? f2bf(p[g]) : (bf16_t)0; }
            }
            __syncthreads();
        }
        const bf16x8 bV = *(const bf16x8*)(VT + (16 * wave + r) * 40 + 8 * q);
        bf16x8 bV1 = bV; if (xw) bV1 = *(const bf16x8*)(VT + (128 + r) * 40 + 8 * q);
        f32x4 o[2], ox[2];
        o[0] = o[1] = ox[0] = ox[1] = (f32x4){0.f, 0.f, 0.f, 0.f};
#pragma unroll
        for (int kk = 0; kk < 4; ++kk) {
            const f32x4 sa = *(const f32x4*)(SC1 + 32 * kk + 4 * q), sb = *(const f32x4*)(SC1 + 32 * kk + 16 + 4 * q);
            S[2 * kk] *= sa; S[2 * kk + 1] *= sb;
            if (xw) { SX[2 * kk] *= sa; SX[2 * kk + 1] *= sb; }
            if (PASS == 2) {
                bf16x8 bS, bX;
#pragma unroll
                for (int g = 0; g < 4; ++g) { bS[g] = (short)f2bf(S[2 * kk][g]); bS[4 + g] = (short)f2bf(S[2 * kk + 1][g]); bX[g] = (short)f2bf(SX[2 * kk][g]); bX[4 + g] = (short)f2bf(SX[2 * kk + 1][g]); }
#pragma unroll
                for (int mt = 0; mt < 2; ++mt) { const bf16x4 lo = *(const bf16x4*)(QS + (16 * mt + r) * 136 + 32 * kk + 4 * q), hi = *(const bf16x4*)(QS + (16 * mt + r) * 136 + 32 * kk + 16 + 4 * q);
                    bf16x8 av; av[0] = lo[0]; av[1] = lo[1]; av[2] = lo[2]; av[3] = lo[3]; av[4] = hi[0]; av[5] = hi[1]; av[6] = hi[2]; av[7] = hi[3];
                    o[mt] = MFMA16(av, bS, o[mt]); if (xw) ox[mt] = MFMA16(av, bX, ox[mt]); }
            }
        }
        if (PASS == 2) {
#pragma unroll
            for (int mt = 0; mt < 2; ++mt) { const bf16x8 av = *(const bf16x8*)(PS + (16 * mt + r) * 40 + 8 * q); o[mt] = MFMA16(av, bV, o[mt]); if (xw) ox[mt] = MFMA16(av, bV1, ox[mt]);
#pragma unroll
                for (int g = 0; g < 4; ++g) { const int t = t0 + 16 * mt + 4 * q + g; OS[(16 * mt + 4 * q + g) * 136 + 16 * wave + r] = f2bf(o[mt][g]); if (xw && r == 0) DEN[h * T + t] = ox[mt][g]; } }
        }
#pragma unroll
        for (int i = 0; i < 8; ++i) { const bf16x8 av = *(const bf16x8*)(KT + (16 * i + r) * 40 + 8 * q); const f32x4 s2 = *(const f32x4*)(SC2 + 16 * i + 4 * q);
            S[i] = MFMA16(av, bV, S[i]); S[i] *= s2;
            if (xw) { SX[i] = MFMA16(av, bV1, SX[i]); SX[i] *= s2; } }
    }
    if (PASS == 2) { __syncthreads(); const int row = tid >> 4, c8 = (tid & 15) * 8; *(u32x4*)(Og + (size_t)(sg * GSEGLEN + GSEGLEN - 32 + row) * 512 + h * 128 + c8) = *(const u32x4*)(OS + row * 136 + c8); }
    if (PASS == 1) {
        float* ST = (float*)smem;
        __syncthreads();
#pragma unroll
        for (int i = 0; i < 8; ++i)
#pragma unroll
            for (int g = 0; g < 4; ++g) { ST[(16 * i + 4 * q + g) * 132 + 16 * wave + r] = S[i][g]; if (xw) EX[((size_t)(sg * 4 + h) * 128 + 16 * i + 4 * q + g) * 16 + r] = SX[i][g]; }
        __syncthreads();
#pragma unroll
        for (int k = 0; k < 8; ++k) { const int idx = tid + 512 * k, row = idx >> 5, c4 = (idx & 31) * 4; *(f32x4*)(Eg + ((size_t)(sg * 4 + h) * 128 + row) * 128 + c4) = *(const f32x4*)(ST + row * 132 + c4); }
        if (grp == 0) Gg[(size_t)(sg * 4 + h) * 128 + d] = expf(runb);
    }
}

template <int PASS>
__device__ __forceinline__ void s5_item(ArgsRef a, int l, int g, int sg, int g0, int tid, int lane, int wave, int hsel) {
    unsigned char* ws = a.ws;
    const bf16_t* Z = (const bf16_t*)(ws + OFF_Z); const float* ABAR = (const float*)(ws + OFF_ABAR); const bf16_t* BBT = (const bf16_t*)(ws + OFF_BBT); const bf16_t* CCT = (const bf16_t*)(ws + OFF_CCT);
    float* ES = (float*)(ws + OFF_ES); bf16_t* YPRE = (bf16_t*)(ws + OFF_YPRE);
    float* BU = (float*)(smem + 70000 + (wave & 3) * 12800); bf16_t* X = (bf16_t*)(smem + 70000 + (wave & 3) * 12800 + 8448); bf16_t* YT = (bf16_t*)(smem + 70000 + 51200);
    const int r = lane & 15, q = lane >> 4, p = lane; const bool act = (wave >> 2) == hsel;
    const float ar = ABAR[(g * 64 + p) * 2], ai = ABAR[(g * 64 + p) * 2 + 1];
    const bf16x8 zero8 = (bf16x8){0, 0, 0, 0, 0, 0, 0, 0};
    bf16x8 bB[8], cB[4];
#pragma unroll
    for (int nt = 0; nt < 8; ++nt) bB[nt] = (q < 2) ? *(const bf16x8*)(BBT + (size_t)(g * 128 + 16 * nt + r) * 16 + 8 * q) : zero8;
#pragma unroll
    for (int kk = 0; kk < 4; ++kk) cB[kk] = (PASS == 2) ? *(const bf16x8*)(CCT + (size_t)(g * 16 + r) * 128 + 32 * kk + 8 * q) : zero8;
    float xr = 0.f, xi = 0.f;
    if (PASS == 2 && sg > 0) {
        float pr = ar, pi = ai;
#pragma unroll
        for (int s = 0; s < 8; ++s) { const float nr = pr * pr - pi * pi, ni = 2.0f * pr * pi; pr = nr; pi = ni; }
        for (int j = 0; j < sg; ++j) { const float er = ES[((size_t)(j * 32 + g) * 64 + p) * 2], ei = ES[((size_t)(j * 32 + g) * 64 + p) * 2 + 1];
            const float nr = pr * xr - pi * xi + er, ni = pr * xi + pi * xr + ei; xr = nr; xi = ni; }
    }
    const float dsk = a.in[17][l * 512 + 16 * g + r];
    for (int ci = 0; ci < SSEGLEN / 16; ++ci) {
        const int t0 = sg * SSEGLEN + ci * 16;
        if (act) {
            const bf16x8 av = (q < 2) ? *(const bf16x8*)(Z + (size_t)(t0 + r) * NZ + 1024 + 16 * g + 8 * q) : zero8;
#pragma unroll
            for (int nt = 0; nt < 8; ++nt) { f32x4 acc = (f32x4){0.f, 0.f, 0.f, 0.f}; acc = MFMA16(av, bB[nt], acc);
#pragma unroll
                for (int gg = 0; gg < 4; ++gg) BU[(4 * q + gg) * 132 + 16 * nt + r] = acc[gg]; }
            wave_sync();
#pragma unroll
            for (int t = 0; t < 16; ++t) { const float br = BU[t * 132 + p], bi = BU[t * 132 + 64 + p];
                const float nr = ar * xr - ai * xi + br, ni = ar * xi + ai * xr + bi; xr = nr; xi = ni;
                if (PASS == 2) { X[t * 136 + p] = f2bf(xr); X[t * 136 + 64 + p] = f2bf(xi); } }
            wave_sync();
            if (PASS == 2) {
                f32x4 acc = (f32x4){0.f, 0.f, 0.f, 0.f};
#pragma unroll
                for (int kk = 0; kk < 4; ++kk) { const bf16x8 xv = *(const bf16x8*)(X + r * 136 + 32 * kk + 8 * q); acc = MFMA16(xv, cB[kk], acc); }
#pragma unroll
                for (int gg = 0; gg < 4; ++gg) { const int t = t0 + 4 * q + gg, c = 16 * g + r; const float u = bf2f(Z[(size_t)t * NZ + 1024 + c]);
                    YT[(4 * q + gg) * 136 + 16 * wave + r] = f2bf(gelu_tanh(acc[gg] + dsk * u)); }
            }
        }
        if (PASS == 2) {
            __syncthreads();
            if (tid < 128) { const int row = tid >> 3, c8 = (tid & 7) * 8; *(u32x4*)(YPRE + (size_t)(t0 + row) * 512 + 16 * g0 + 64 * hsel + c8) = *(const u32x4*)(YT + row * 136 + 64 * hsel + c8); }
            __syncthreads();
        }
    }
    if (PASS == 1 && act) { ES[((size_t)(sg * 32 + g) * 64 + p) * 2] = xr; ES[((size_t)(sg * 32 + g) * 64 + p) * 2 + 1] = xi; }
}

template <int PASS>
__device__ __forceinline__ void phase_mixers(ArgsRef a, int l, int tid, int lane, int wave, int bid, int G) {
    for (int it = bid; it < 4 * GSEG; it += G) gla_item<0, PASS>(a, l, it % 4, it / 4, tid, lane, wave);
    asm volatile("" ::: "memory");
    for (int it = bid + ((4 * GSEG - bid % G) % G + G) % G * 0; it < 2 * 4 * GSEG; it += G) { if (it >= 4 * GSEG) gla_item<1, PASS>(a, l, (it - 4 * GSEG) % 4, (it - 4 * GSEG) / 4, tid, lane, wave); }
    __syncthreads();
    for (int it0 = bid * 8; it0 < 32 * SSEG; it0 += G * 8)
        for (int half = 0; half < 2; ++half) { const int it = it0 + wave; s5_item<PASS>(a, l, it % 32, it / 32, it0 % 32, tid, lane, wave, half); __syncthreads(); }
}

__device__ __forceinline__ void phase_post(ArgsRef a, int l, int lane, int gw, int GW) {
    const bf16_t* Z = (const bf16_t*)(a.ws + OFF_Z); const bf16_t* XC = (const bf16_t*)(a.ws + OFF_XC);
    bf16_t* OM = (bf16_t*)(a.ws + OFF_OM); bf16_t* OH = (bf16_t*)(a.ws + OFF_OH); const float* DEN = (const float*)(a.ws + OFF_DEN);
    const int c0 = lane * 8, hd = lane >> 4;
    for (int t = gw; t < T; t += GW) {
        { const bf16x8 o = *(const bf16x8*)(OM + (size_t)t * 512 + c0), op = *(const bf16x8*)(Z + (size_t)t * NZ + 512 + c0), xc = *(const bf16x8*)(XC + (size_t)t * 512 + c0);
          const float dn = 1.0f / fmaxf(fabsf(DEN[hd * T + t]), 1.0f); float y[8];
#pragma unroll
          for (int j = 0; j < 8; ++j) y[j] = sigmoidf_(bf2f((bf16_t)op[j])) * (bf2f((bf16_t)o[j]) * dn) + a.in[9][l * 512 + c0 + j] * bf2f((bf16_t)xc[j]);
          u32x4 w; w.x = pack2(y[0], y[1]); w.y = pack2(y[2], y[3]); w.z = pack2(y[4], y[5]); w.w = pack2(y[6], y[7]); *(u32x4*)(OM + (size_t)t * 512 + c0) = w; }
        { const bf16x8 o = *(const bf16x8*)(OH + (size_t)t * 512 + c0), gp = *(const bf16x8*)(Z + (size_t)t * NZ + 3072 + c0);
          float ov[8], ss = 0.f;
#pragma unroll
          for (int j = 0; j < 8; ++j) { ov[j] = bf2f((bf16_t)o[j]); ss += ov[j] * ov[j]; }
          ss += __shfl_xor(ss, 1); ss += __shfl_xor(ss, 2); ss += __shfl_xor(ss, 4); ss += __shfl_xor(ss, 8);
          const float rinv = rsqrtf(ss * (1.0f / 128.0f) + 1e-6f); float y[8];
#pragma unroll
          for (int j = 0; j < 8; ++j) y[j] = ov[j] * rinv * a.in[20][l * 512 + c0 + j] * siluf_(bf2f((bf16_t)gp[j]));
          u32x4 w; w.x = pack2(y[0], y[1]); w.y = pack2(y[2], y[3]); w.z = pack2(y[4], y[5]); w.w = pack2(y[6], y[7]); *(u32x4*)(OH + (size_t)t * 512 + c0) = w; }
    }
}

__device__ __forceinline__ void phase_glu(ArgsRef a, int lane, int gw, int GW) {
    const bf16_t* YPRE = (const bf16_t*)(a.ws + OFF_YPRE); const bf16_t* WGLU = (const bf16_t*)(a.ws + OFF_WGLU); bf16_t* YSG = (bf16_t*)(a.ws + OFF_YSG);
    const int r = lane & 15, q = lane >> 4;
    for (int u = gw; u < 256 * 8; u += GW) {
        const int mt = u / 8, nt = u % 8;
        f32x4 acc[4][4]; zero_acc(acc);
        wave_gemm<4, 4>(acc, 512, [=](int i) { return YPRE + (size_t)(mt * 64 + i) * 512; }, [=](int j) { return WGLU + (size_t)(nt * 64 + j) * 512; }, lane);
#pragma unroll
        for (int m = 0; m < 4; ++m)
#pragma unroll
            for (int n = 0; n < 4; ++n)
#pragma unroll
                for (int g = 0; g < 4; ++g) { const size_t o = (size_t)(mt * 64 + m * 16 + 4 * q + g) * 512 + nt * 64 + n * 16 + r; YSG[o] = f2bf(bf2f(YPRE[o]) * sigmoidf_(acc[m][n][g])); }
    }
}

__device__ __forceinline__ void phase_merge(ArgsRef a, int lane, int gw, int GW) {
    const bf16_t* XB = (const bf16_t*)(a.ws + OFF_XB); const bf16_t* WIN = (const bf16_t*)(a.ws + OFF_WIN); const bf16_t* WB = (const bf16_t*)(a.ws + OFF_WB);
    bf16_t* MG = (bf16_t*)(a.ws + OFF_MERGED);
    const int r = lane & 15, q = lane >> 4;
    for (int u = gw; u < 512 * 16; u += GW) {
        const int mt = u / 16, nt = u % 16;
        f32x4 tot[2][4]; zero_acc(tot);
#pragma unroll 1
        for (int b = 0; b < 3; ++b) {
            const bf16_t* Y = (const bf16_t*)(a.ws + (b == 0 ? OFF_OM : b == 1 ? OFF_YSG : OFF_OH));
            f32x4 ag[2][4], ap[2][4]; zero_acc(ag); zero_acc(ap);
            wave_gemm<2, 4>(ag, 1024, [=](int i) { return XB + (size_t)(mt * 32 + i) * 1024; }, [=](int j) { return WIN + (size_t)(NZ + b * 1024 + nt * 64 + j) * 1024; }, lane);
            wave_gemm<2, 4>(ap, 512, [=](int i) { return Y + (size_t)(mt * 32 + i) * 512; }, [=](int j) { return WB + (size_t)(b * 1024 + nt * 64 + j) * 512; }, lane);
#pragma unroll
            for (int m = 0; m < 2; ++m)
#pragma unroll
                for (int n = 0; n < 4; ++n)
#pragma unroll
                    for (int g = 0; g < 4; ++g) tot[m][n][g] += sigmoidf_(ag[m][n][g]) * ap[m][n][g];
        }
#pragma unroll
        for (int m = 0; m < 2; ++m)
#pragma unroll
            for (int n = 0; n < 4; ++n)
#pragma unroll
                for (int g = 0; g < 4; ++g) MG[(size_t)(mt * 32 + m * 16 + 4 * q + g) * 1024 + nt * 64 + n * 16 + r] = f2bf(tot[m][n][g]);
    }
}

__device__ __forceinline__ void phase_wout(ArgsRef a, int l, int lane, int gw, int GW) {
    const bf16_t* MG = (const bf16_t*)(a.ws + OFF_MERGED); const bf16_t* WOUT = (const bf16_t*)(a.ws + OFF_WOUT);
    const float* xin = (l == 0) ? a.in[0] : a.out; float* XF = a.out;
    const int r = lane & 15, q = lane >> 4;
    for (int u = gw; u < 256 * 16; u += GW) {
        const int mt = u / 16, nt = u % 16;
        f32x4 acc[4][4]; zero_acc(acc);
        wave_gemm<4, 4>(acc, 1024, [=](int i) { return MG + (size_t)(mt * 64 + i) * 1024; }, [=](int j) { return WOUT + (size_t)(nt * 64 + j) * 1024; }, lane);
#pragma unroll
        for (int m = 0; m < 4; ++m)
#pragma unroll
            for (int n = 0; n < 4; ++n)
#pragma unroll
                for (int g = 0; g < 4; ++g) { const size_t o = (size_t)(mt * 64 + m * 16 + 4 * q + g) * 1024 + nt * 64 + n * 16 + r; XF[o] = DN_ALPHA * xin[o] + acc[m][n][g]; }
    }
}

__device__ __forceinline__ void ln_row(f32x4 (&v)[4], const float* gam, const float* bet, int lane) {
    float s = 0.f;
#pragma unroll
    for (int j = 0; j < 4; ++j) s += (v[j][0] + v[j][1]) + (v[j][2] + v[j][3]);
#pragma unroll
    for (int o = 32; o >= 1; o >>= 1) s += __shfl_xor(s, o);
    const float mean = s * (1.0f / 1024.0f); float qv = 0.f;
#pragma unroll
    for (int j = 0; j < 4; ++j) { const f32x4 dd = v[j] - mean; qv += (dd[0] * dd[0] + dd[1] * dd[1]) + (dd[2] * dd[2] + dd[3] * dd[3]); }
#pragma unroll
    for (int o = 32; o >= 1; o >>= 1) qv += __shfl_xor(qv, o);
    const float rstd = rsqrtf(qv * (1.0f / 1024.0f) + 1e-5f);
#pragma unroll
    for (int j = 0; j < 4; ++j) { const f32x4 gg = *(const f32x4*)(gam + 256 * j + 4 * lane), bb = *(const f32x4*)(bet + 256 * j + 4 * lane); v[j] = (v[j] - mean) * rstd * gg + bb; }
}

__device__ __forceinline__ void phase_ln1r(ArgsRef a, int l, int tid, int lane, int wave, int bid, int G) {
    float* XF = a.out; bf16_t* XB = (bf16_t*)(a.ws + OFF_XB);
    int* TOKE = (int*)(a.ws + OFF_TOKE); float* TOKG = (float*)(a.ws + OFF_TOKG); unsigned* CNT = (unsigned*)(a.ws + OFF_CTL);
    const float* RW = a.in[29]; const float* RB = a.in[30];
    float* XR = (float*)(smem + wave * 8192);
    unsigned* lh = (unsigned*)(smem + 65536);
    if (tid < 32) lh[tid] = 0u;
    __syncthreads();
    const int rs = lane >> 5, e = lane & 31;
    int* TE = (int*)(smem + 66048 + wave * 256); float* TG = (float*)(smem + 66048 + wave * 256 + 128);
    for (int tw = bid * 8 + wave; tw < T / 16; tw += G * 8)
    for (int t0 = tw * 16; t0 < tw * 16 + 16; t0 += 2) {
#pragma unroll
        for (int rr = 0; rr < 2; ++rr) { const int t = t0 + rr; f32x4 v[4];
#pragma unroll
            for (int j = 0; j < 4; ++j) v[j] = *(const f32x4*)(XF + (size_t)t * 1024 + 256 * j + 4 * lane);
            ln_row(v, a.in[25] + l * 1024, a.in[26] + l * 1024, lane);
#pragma unroll
            for (int j = 0; j < 4; ++j) { *(f32x4*)(XF + (size_t)t * 1024 + 256 * j + 4 * lane) = v[j]; *(f32x4*)(XR + rr * 1024 + 256 * j + 4 * lane) = v[j];
                u32x2 w; w.x = pack2(v[j][0], v[j][1]); w.y = pack2(v[j][2], v[j][3]); *(u32x2*)(XB + (size_t)t * 1024 + 256 * j + 4 * lane) = w; } }
        wave_sync();
        float acc = 0.f;
        for (int k = 0; k < 1024; k += 4) { const f32x4 xv = *(const f32x4*)(XR + rs * 1024 + k);
            acc += xv[0] * RW[(k + 0) * 32 + e]; acc += xv[1] * RW[(k + 1) * 32 + e]; acc += xv[2] * RW[(k + 2) * 32 + e]; acc += xv[3] * RW[(k + 3) * 32 + e]; }
        wave_sync();
        const float s = sigmoidf_(acc), sb = s + RB[e];
        float v4[4];
#pragma unroll
        for (int i = 0; i < 4; ++i) v4[i] = __shfl(sb, (lane & ~3) + i);
        int i1 = 0;
#pragma unroll
        for (int i = 1; i < 4; ++i) if (v4[i] > v4[i1]) i1 = i;
        int i2 = (i1 == 0) ? 1 : 0;
#pragma unroll
        for (int i = 0; i < 4; ++i) if (i != i1 && i != i2 && v4[i] > v4[i2]) i2 = i;
        float gs = v4[i1] + v4[i2]; int gid = e >> 2;
#pragma unroll
        for (int o = 4; o <= 16; o <<= 1) { const float os = __shfl_xor(gs, o); const int og = __shfl_xor(gid, o); if (os > gs || (os == gs && og < gid)) { gs = os; gid = og; } }
        float sv[4], sbv[4];
#pragma unroll
        for (int i = 0; i < 4; ++i) { sbv[i] = __shfl(sb, (lane & 32) + gid * 4 + i); sv[i] = __shfl(s, (lane & 32) + gid * 4 + i); }
        int j1 = 0;
#pragma unroll
        for (int i = 1; i < 4; ++i) if (sbv[i] > sbv[j1]) j1 = i;
        int j2 = (j1 == 0) ? 1 : 0;
#pragma unroll
        for (int i = 0; i < 4; ++i) if (i != j1 && i != j2 && sbv[i] > sbv[j2]) j2 = i;
        float s1 = sv[0], s2 = sv[0];
#pragma unroll
        for (int i = 1; i < 4; ++i) { if (i == j1) s1 = sv[i]; if (i == j2) s2 = sv[i]; }
        if (e == 0) { const int t = t0 + rs; const float inv = 1.0f / (s1 + s2);
            const int ti = t & 15; TE[ti * 2] = gid * 4 + j1; TE[ti * 2 + 1] = gid * 4 + j2; TG[ti * 2] = s1 * inv; TG[ti * 2 + 1] = s2 * inv;
            atomicAdd(&lh[gid * 4 + j1], 1u); atomicAdd(&lh[gid * 4 + j2], 1u); }
        if ((t0 & 15) == 14) { wave_sync(); if (lane < 32) { TOKE[(t0 - 14) * 2 + lane] = TE[lane]; TOKG[(t0 - 14) * 2 + lane] = TG[lane]; } wave_sync(); }
    }
    __syncthreads();
    if (tid < 32 && lh[tid]) atomicAdd(&CNT[tid], lh[tid]);
}

__device__ __forceinline__ void phase_slot(ArgsRef a, int tid, int bid, int G) {
    const int* TOKE = (const int*)(a.ws + OFF_TOKE); int* TOKS = (int*)(a.ws + OFF_TOKS); int* SLOTT = (int*)(a.ws + OFF_SLOTT);
    unsigned* CNT = (unsigned*)(a.ws + OFF_CTL); unsigned* BASE = CNT + 64;
    unsigned* base = (unsigned*)smem; unsigned* lc = base + 40; int* el = (int*)(base + 80);
    if (tid == 0) { unsigned s = 0; for (int e = 0; e < 32; ++e) { base[e] = s; s += (CNT[e] + 63u) & ~63u; } base[32] = s; }
    __syncthreads();
    if (bid == 0 && tid < 33) BASE[tid] = base[tid];
    for (int e = bid; e < 32; e += G) { const unsigned c = CNT[e]; for (unsigned s = base[e] + c + tid; s < base[e + 1]; s += 512) __hip_atomic_store(&SLOTT[s], 0, __ATOMIC_RELAXED, __HIP_MEMORY_SCOPE_AGENT); }
    for (int c = bid; c < T / 64; c += G) {
        if (tid < 32) lc[tid] = 0u;
        __syncthreads();
        for (int i = tid; i < c * 128; i += 512) atomicAdd(&lc[TOKE[i]], 1u);
        int e = 0;
        if (tid < 128) { e = TOKE[c * 128 + tid]; el[tid] = e; }
        __syncthreads();
        if (tid < 128) { unsigned rank = 0; for (int i = 0; i < tid; ++i) rank += (el[i] == e) ? 1u : 0u;
            const unsigned s = base[e] + lc[e] + rank; const int t = c * 64 + (tid >> 1);
            __hip_atomic_store(&SLOTT[s], t, __ATOMIC_RELAXED, __HIP_MEMORY_SCOPE_AGENT); TOKS[t * 2 + (tid & 1)] = (int)s; }
        __syncthreads();
    }
}

__device__ __forceinline__ void phase_moe_gu(ArgsRef a, int lane, int gw, int GW) {
    const bf16_t* XB = (const bf16_t*)(a.ws + OFF_XB); const bf16_t* WGU = (const bf16_t*)(a.ws + OFF_WGU); bf16_t* H = (bf16_t*)(a.ws + OFF_H);
    const int* SLOTT = (const int*)(a.ws + OFF_SLOTT); const unsigned* BASE = (const unsigned*)(a.ws + OFF_CTL) + 64;
    const int r = lane & 15, q = lane >> 4; const int ntile = (int)(BASE[32] >> 5);
    for (int u = gw; u < ntile * 4; u += GW) {
        const int rt = u / 4, hc = u % 4; int e = 0; while (e < 31 && BASE[e + 1] <= (unsigned)(rt * 32)) ++e;
        f32x4 acc[2][8]; zero_acc(acc);
        wave_gemm<2, 8>(acc, 1024, [=](int i) { return XB + (size_t)SLOTT[rt * 32 + i] * 1024; },
            [=](int j) { const int hid = hc * 64 + (j & 63), row = (hid >> 7) * 256 + (hid & 127) + (j >> 6) * 128; return WGU + ((size_t)e * 512 + row) * 1024; }, lane);
#pragma unroll
        for (int m = 0; m < 2; ++m)
#pragma unroll
            for (int n = 0; n < 4; ++n)
#pragma unroll
                for (int g = 0; g < 4; ++g) H[(size_t)(rt * 32 + m * 16 + 4 * q + g) * 256 + hc * 64 + n * 16 + r] = f2bf(siluf_(acc[m][n][g]) * acc[m][n + 4][g]);
    }
}
__device__ __forceinline__ void phase_moe_dn(ArgsRef a, int lane, int gw, int GW) {
    const bf16_t* H = (const bf16_t*)(a.ws + OFF_H); const bf16_t* WD = (const bf16_t*)(a.ws + OFF_WD); bf16_t* YS = (bf16_t*)(a.ws + OFF_YS);
    const unsigned* BASE = (const unsigned*)(a.ws + OFF_CTL) + 64;
    const int r = lane & 15, q = lane >> 4; const int ntile = (int)(BASE[32] >> 6);
    for (int u = gw; u < ntile * 16; u += GW) {
        const int rt = u / 16, nc = u % 16; int e = 0; while (e < 31 && BASE[e + 1] <= (unsigned)(rt * 64)) ++e;
        f32x4 acc[4][4]; zero_acc(acc);
        wave_gemm<4, 4>(acc, 256, [=](int i) { return H + (size_t)(rt * 64 + i) * 256; }, [=](int j) { return WD + ((size_t)e * 1024 + nc * 64 + j) * 256; }, lane);
#pragma unroll
        for (int m = 0; m < 4; ++m)
#pragma unroll
            for (int n = 0; n < 4; ++n)
#pragma unroll
                for (int g = 0; g < 4; ++g) YS[(size_t)(rt * 64 + m * 16 + 4 * q + g) * 1024 + nc * 64 + n * 16 + r] = f2bf(acc[m][n][g]);
    }
}

__device__ __forceinline__ void phase_ln2(ArgsRef a, int l, int lane, int gw, int GW) {
    float* XF = a.out; bf16_t* XB = (bf16_t*)(a.ws + OFF_XB); const bf16_t* YS = (const bf16_t*)(a.ws + OFF_YS);
    const int* TOKS = (const int*)(a.ws + OFF_TOKS); const float* TOKG = (const float*)(a.ws + OFF_TOKG);
    for (int t = gw; t < T; t += GW) {
        const int s0 = TOKS[t * 2], s1 = TOKS[t * 2 + 1]; const float g0 = TOKG[t * 2], g1 = TOKG[t * 2 + 1];
        f32x4 v[4];
#pragma unroll
        for (int j = 0; j < 4; ++j) { const f32x4 x1 = *(const f32x4*)(XF + (size_t)t * 1024 + 256 * j + 4 * lane);
            const bf16x4 y0 = *(const bf16x4*)(YS + (size_t)s0 * 1024 + 256 * j + 4 * lane), y1 = *(const bf16x4*)(YS + (size_t)s1 * 1024 + 256 * j + 4 * lane);
#pragma unroll
            for (int g = 0; g < 4; ++g) v[j][g] = DN_ALPHA * x1[g] + g0 * bf2f((bf16_t)y0[g]) + g1 * bf2f((bf16_t)y1[g]); }
        ln_row(v, a.in[27] + l * 1024, a.in[28] + l * 1024, lane);
#pragma unroll
        for (int j = 0; j < 4; ++j) { *(f32x4*)(XF + (size_t)t * 1024 + 256 * j + 4 * lane) = v[j];
            u32x2 w; w.x = pack2(v[j][0], v[j][1]); w.y = pack2(v[j][2], v[j][3]); *(u32x2*)(XB + (size_t)t * 1024 + 256 * j + 4 * lane) = w; }
    }
}

struct SchedGrid {
    int nM, nN, G, c; const char* A; const char* B; size_t strideA, strideB;
    __device__ __forceinline__ bool next(int i, pg8::Unit& u) const { int pm, pn; if (!pg8::tile_order(i * G + c, nM, nN, pm, pn)) return false;
        u.pm = pm; u.pn = pn; u.tag = 0; u.A = A + (size_t)pm * strideA; u.B = B + (size_t)pn * strideB; return true; }
};
constexpr int GATES_LD = 3072;
template <int MODE> struct EpiBf16 {
    static constexpr bool PERM = true;
    bf16_t* O; int ldo; const bf16_t* Y; int ldy;
    __device__ __forceinline__ bool operator()(f32x4 (&acc)[2][2][4][2], const pg8::Unit& u, int wr, int wc, int fr, int fq) const {
#pragma unroll
        for (int ai = 0; ai < 2; ++ai)
#pragma unroll
            for (int m = 0; m < 4; ++m) { const size_t row = (size_t)u.pm * 256 + ai * 128 + wr * 64 + m * 16 + fr;
#pragma unroll
                for (int bj = 0; bj < 2; ++bj) { const int col = u.pn * 256 + bj * 128 + wc * 32 + 8 * fq; f32x4 v0 = acc[ai][bj][m][0], v1 = acc[ai][bj][m][1];
                    if (MODE == 1) {
#pragma unroll
                        for (int j = 0; j < 4; ++j) { v0[j] = fmaxf(sigmoidf_(v0[j]), 1e-30f); v1[j] = fmaxf(sigmoidf_(v1[j]), 1e-30f); } }
                    if (MODE == 2) { const bf16x8 y = *(const bf16x8*)(Y + row * ldy + col);
#pragma unroll
                        for (int j = 0; j < 4; ++j) { v0[j] = bf2f((bf16_t)y[j]) * sigmoidf_(v0[j]); v1[j] = bf2f((bf16_t)y[4 + j]) * sigmoidf_(v1[j]); } }
                    u32x4 w; w.x = pg8::cvt_pk_bf16(v0[0], v0[1]); w.y = pg8::cvt_pk_bf16(v0[2], v0[3]); w.z = pg8::cvt_pk_bf16(v1[0], v1[1]); w.w = pg8::cvt_pk_bf16(v1[2], v1[3]);
                    *(u32x4*)(O + row * ldo + col) = w; } }
        return false;
    }
};
__device__ __forceinline__ void phase_zgemm2(ArgsRef a, int tid, int bid, int G) {
    SchedGrid S{T / 256, NZ / 256, G, bid, (const char*)(a.ws + OFF_XB), (const char*)(a.ws + OFF_WIN), (size_t)256 * 1024 * 2, (size_t)256 * 1024 * 2};
    EpiBf16<0> E{(bf16_t*)(a.ws + OFF_Z), NZ, nullptr, 0};
    pg8::gemm_phase((PG8_LAS unsigned char*)smem, tid, 1024, 1024, 1024, S, E);
}
__device__ __forceinline__ void phase_glu_gates(ArgsRef a, int tid, int bid, int G) {
    { SchedGrid S{T / 256, 2, G, bid, (const char*)(a.ws + OFF_YPRE), (const char*)(a.ws + OFF_WGLU), (size_t)256 * 512 * 2, (size_t)256 * 512 * 2};
      EpiBf16<2> E{(bf16_t*)(a.ws + OFF_YSG), 512, (const bf16_t*)(a.ws + OFF_YPRE), 512};
      pg8::gemm_phase((PG8_LAS unsigned char*)smem, tid, 512, 512, 512, S, E); }
    asm volatile("" : "+v"(tid), "+s"(bid), "+s"(G));
    { SchedGrid S{T / 256, 12, G, (bid + G / 2) % G, (const char*)(a.ws + OFF_XB), (const char*)(a.ws + OFF_WIN + (size_t)NZ * 1024 * 2), (size_t)256 * 1024 * 2, (size_t)256 * 1024 * 2};
      EpiBf16<1> E{(bf16_t*)(a.ws + OFF_Z), GATES_LD, nullptr, 0};
      pg8::gemm_phase((PG8_LAS unsigned char*)smem, tid, 1024, 1024, 1024, S, E); }
}
struct SchedMerge {
    int G, c; const unsigned char* ws;
    __device__ __forceinline__ bool next(int i, pg8::Unit& u) const { const int b = i % 3; int pm, pn; if (!pg8::tile_order((i / 3) * G + c, T / 256, 4, pm, pn)) return false;
        u.pm = pm; u.pn = pn; u.tag = b; u.A = (const char*)(ws + (b == 0 ? OFF_OM : b == 1 ? OFF_YSG : OFF_OH)) + (size_t)pm * 256 * 512 * 2;
        u.B = (const char*)(ws + OFF_WB) + ((size_t)b * 1024 + pn * 256) * 512 * 2; return true; }
};
struct EpiMerge {
    static constexpr bool PERM = true;
    const bf16_t* GT; bf16_t* O;
    __device__ __forceinline__ bool operator()(f32x4 (&acc)[2][2][4][2], const pg8::Unit& u, int wr, int wc, int fr, int fq) const {
        const int b = u.tag;
#pragma unroll
        for (int ai = 0; ai < 2; ++ai)
#pragma unroll
            for (int m = 0; m < 4; ++m) { const size_t row = (size_t)u.pm * 256 + ai * 128 + wr * 64 + m * 16 + fr;
#pragma unroll
                for (int bj = 0; bj < 2; ++bj) { const int col = u.pn * 256 + bj * 128 + wc * 32 + 8 * fq;
                    const bf16x8 gb = *(const bf16x8*)(GT + row * GATES_LD + b * 1024 + col);
                    if (b < 2) { const bf16x8 gn = *(const bf16x8*)(GT + row * GATES_LD + (b + 1) * 1024 + col);
#pragma unroll
                        for (int j = 0; j < 4; ++j) { acc[ai][bj][m][0][j] *= bf2f((bf16_t)gb[j]) / bf2f((bf16_t)gn[j]); acc[ai][bj][m][1][j] *= bf2f((bf16_t)gb[4 + j]) / bf2f((bf16_t)gn[4 + j]); } }
                    else { f32x4 v0 = acc[ai][bj][m][0], v1 = acc[ai][bj][m][1];
#pragma unroll
                        for (int j = 0; j < 4; ++j) { v0[j] *= bf2f((bf16_t)gb[j]); v1[j] *= bf2f((bf16_t)gb[4 + j]); }
                        u32x4 w; w.x = pg8::cvt_pk_bf16(v0[0], v0[1]); w.y = pg8::cvt_pk_bf16(v0[2], v0[3]); w.z = pg8::cvt_pk_bf16(v1[0], v1[1]); w.w = pg8::cvt_pk_bf16(v1[2], v1[3]);
                        *(u32x4*)(O + row * 1024 + col) = w; } } }
        return b < 2;
    }
};
__device__ __forceinline__ void phase_merge2(ArgsRef a, int tid, int bid, int G) {
    SchedMerge S{G, bid, a.ws}; EpiMerge E{(const bf16_t*)(a.ws + OFF_Z), (bf16_t*)(a.ws + OFF_XB)};
    pg8::gemm_phase((PG8_LAS unsigned char*)smem, tid, 512, 512, 512, S, E);
}
struct EpiResid {
    static constexpr bool PERM = false;
    const float* xin; float* XF;
    __device__ __forceinline__ bool operator()(f32x4 (&acc)[2][2][4][2], const pg8::Unit& u, int wr, int wc, int fr, int fq) const {
#pragma unroll
        for (int ai = 0; ai < 2; ++ai)
#pragma unroll
            for (int m = 0; m < 4; ++m) { const size_t row = (size_t)u.pm * 256 + ai * 128 + wr * 64 + m * 16 + fr;
#pragma unroll
                for (int bj = 0; bj < 2; ++bj)
#pragma unroll
                    for (int n = 0; n < 2; ++n) { const size_t o = row * 1024 + u.pn * 256 + bj * 128 + wc * 32 + 16 * n + 4 * fq; const f32x4 x = *(const f32x4*)(xin + o); *(f32x4*)(XF + o) = DN_ALPHA * x + acc[ai][bj][m][n]; } }
        return false;
    }
};
__device__ __forceinline__ void phase_wout2(ArgsRef a, int l, int tid, int bid, int G) {
    SchedGrid S{T / 256, 4, G, bid, (const char*)(a.ws + OFF_XB), (const char*)(a.ws + OFF_WOUT), (size_t)256 * 1024 * 2, (size_t)256 * 1024 * 2};
    EpiResid E{(l == 0) ? a.in[0] : a.out, a.out};
    pg8::gemm_phase((PG8_LAS unsigned char*)smem, tid, 1024, 1024, 1024, S, E);
}
__device__ __forceinline__ void phase_mprep2(ArgsRef a, int l, int tid, int lane, int wave, int bid, int G) {
    const bf16_t* Z = (const bf16_t*)(a.ws + OFF_Z); bf16_t* XC = (bf16_t*)(a.ws + OFF_XC);
    const float* cw = a.in[2] + (size_t)l * 4 * 512; const float* cb = a.in[3] + (size_t)l * 512;
    for (int idx = bid * 512 + tid; idx < T * 64; idx += G * 512) {
        const int t = idx / 64, c0 = (idx % 64) * 8; float acc[8];
#pragma unroll
        for (int j = 0; j < 8; ++j) acc[j] = cb[c0 + j];
#pragma unroll
        for (int k = 0; k < 4; ++k) { const int ts = t - 3 + k; if (ts >= 0) { const bf16x8 v = *(const bf16x8*)(Z + (size_t)ts * NZ + c0);
#pragma unroll
                for (int j = 0; j < 8; ++j) acc[j] += cw[k * 512 + c0 + j] * bf2f((bf16_t)v[j]); } }
        u32x4 w; w.x = pack2(siluf_(acc[0]), siluf_(acc[1])); w.y = pack2(siluf_(acc[2]), siluf_(acc[3])); w.z = pack2(siluf_(acc[4]), siluf_(acc[5])); w.w = pack2(siluf_(acc[6]), siluf_(acc[7]));
        *(u32x4*)(XC + (size_t)t * 512 + c0) = w;
    }
    float* W8 = (float*)smem;
    const float* wsrc = a.in[1] + (size_t)l * 1024 * INW + 1024;
    __syncthreads();
    for (int i = tid; i < 8192; i += 512) W8[i] = wsrc[(size_t)(i >> 3) * INW + (i & 7)];
    __syncthreads();
    const bf16_t* XB = (const bf16_t*)(a.ws + OFF_XB); float* LF = (float*)(a.ws + OFF_LF); float* LI = (float*)(a.ws + OFF_LI);
    for (int tw = bid * 8 + wave; tw < T / 8; tw += G * 8) {
        float myli = 0.f, mylf = 0.f;
        for (int tt = 0; tt < 8; ++tt) { const int t = tw * 8 + tt; float sacc[8];
#pragma unroll
            for (int j = 0; j < 8; ++j) sacc[j] = 0.f;
#pragma unroll 4
            for (int kk = 0; kk < 16; ++kk) { const int k = lane + 64 * kk; const float x = bf2f(XB[(size_t)t * 1024 + k]);
                const f32x4 w0 = *(const f32x4*)(W8 + k * 8), w1 = *(const f32x4*)(W8 + k * 8 + 4);
#pragma unroll
                for (int j = 0; j < 4; ++j) { sacc[j] += x * w0[j]; sacc[4 + j] += x * w1[j]; } }
#pragma unroll
            for (int j = 0; j < 8; ++j) {
#pragma unroll
                for (int o = 32; o >= 1; o >>= 1) sacc[j] += __shfl_xor(sacc[j], o); }
            const int hh = lane & 3;
            const float ipre = hh == 0 ? sacc[0] : hh == 1 ? sacc[1] : hh == 2 ? sacc[2] : sacc[3], fpre = hh == 0 ? sacc[4] : hh == 1 ? sacc[5] : hh == 2 ? sacc[6] : sacc[7];
            if ((lane >> 2) == tt) { myli = ipre + a.in[7][l * 4 + hh]; mylf = logsigmoidf_(fpre + a.in[8][l * 4 + hh]); }
        }
        if (lane < 32) { LI[tw * 32 + lane] = myli; LF[tw * 32 + lane] = mylf; }
    }
}

#define XB_TMO      128
#define XB_XCNT(j)  (256  + 64 * (j))
#define XB_XSUB(j)  (1280 + 64 * (j))
#define XB_XGEN(j)  (2304 + 64 * (j))
#define XB_TOP      3328
#define XB_TOPGEN   3392
#define XCD_BAR_WORDS 3456
#define XB_SPIN_CAP (1u << 22)
__device__ __forceinline__ unsigned xb_ld(unsigned* p)              { return __hip_atomic_load(p, __ATOMIC_RELAXED, __HIP_MEMORY_SCOPE_AGENT); }
__device__ __forceinline__ unsigned xb_add(unsigned* p, unsigned v) { return __hip_atomic_fetch_add(p, v, __ATOMIC_RELAXED, __HIP_MEMORY_SCOPE_AGENT); }
__device__ __forceinline__ unsigned xb_xcc_id() { return (unsigned)__builtin_amdgcn_s_getreg((3 << 11) | 20) & 0xFu; }
#define XB_SPIN(cond, bar) do { unsigned _sp = 0; while (cond) { __builtin_amdgcn_s_sleep(1); \
    if ((++_sp & 255u) == 0u) { if (xb_ld(&(bar)[XB_TMO])) break; if (_sp > XB_SPIN_CAP) { atomicAdd(&(bar)[XB_TMO], 1u); break; } } } } while (0)
__device__ __forceinline__ void xcd_barrier_complete(unsigned* bar, unsigned x, unsigned& nloc, unsigned& nx) {
    const unsigned G = gridDim.x; unsigned sum, cnt, mine, sp = 0u;
    for (;;) { sum = 0u; cnt = 0u; mine = 0u;
#pragma unroll
        for (unsigned j = 0; j < 16; ++j) { const unsigned c = xb_ld(&bar[XB_XCNT(j)]); sum += c; cnt += (c > 0u) ? 1u : 0u; mine = (j == x) ? c : mine; }
        if (sum == G) break;
        __builtin_amdgcn_s_sleep(1);
        if ((++sp & 255u) == 0u) { if (xb_ld(&bar[XB_TMO])) break; if (sp > XB_SPIN_CAP) { atomicAdd(&bar[XB_TMO], 1u); break; } } }
    nloc = mine > 0u ? mine : 1u; nx = cnt > 0u ? cnt : 1u;
}
__device__ __forceinline__ void xcd_barrier(unsigned* bar, volatile __attribute__((address_space(3))) unsigned* st) {
    asm volatile("s_waitcnt vmcnt(0)" ::: "memory");
    __syncthreads();
    if (threadIdx.x == 0) {
        __builtin_amdgcn_s_waitcnt(0);
        const unsigned x = xb_xcc_id();
        unsigned nloc = st[0], nx = st[1];
        if (nloc == 0u) { xcd_barrier_complete(bar, x, nloc, nx); st[0] = nloc; st[1] = nx; }
        const unsigned old = xb_add(&bar[XB_XSUB(x)], 1u);
        const unsigned gen = old / nloc;
        if (old + 1u == (gen + 1u) * nloc) {
            __builtin_amdgcn_fence(__ATOMIC_RELEASE, "agent");
            asm volatile("s_waitcnt vmcnt(0)" ::: "memory");
            const unsigned og = xb_add(&bar[XB_TOP], 1u);
            const unsigned tg = og / nx;
            if (og + 1u == (tg + 1u) * nx) xb_add(&bar[XB_TOPGEN], 1u);
            else XB_SPIN(xb_ld(&bar[XB_TOPGEN]) == tg, bar);
            __builtin_amdgcn_fence(__ATOMIC_ACQUIRE, "agent");
            xb_add(&bar[XB_XGEN(x)], 1u);
            asm volatile("s_waitcnt vmcnt(0)" ::: "memory");
        } else {
            XB_SPIN(xb_ld(&bar[XB_XGEN(x)]) == gen, bar);
            __builtin_amdgcn_fence(__ATOMIC_ACQUIRE, "agent");
            asm volatile("s_waitcnt vmcnt(0)" ::: "memory");
        }
    }
    __syncthreads();
}

__device__ __forceinline__ ArgsRef fresh_args() { unsigned long long p = (unsigned long long)__builtin_amdgcn_kernarg_segment_ptr(); asm volatile("" : "+s"(p)); return *(const __attribute__((address_space(4))) Args*)p; }
__global__ void __launch_bounds__(512) fwd(Args a_unused) {
    cg::grid_group grid = cg::this_grid();
    volatile __attribute__((address_space(3))) unsigned* bst = (volatile __attribute__((address_space(3))) unsigned*)((__attribute__((address_space(3))) unsigned char*)smem + 131072);
    if (threadIdx.x < 4) bst[threadIdx.x] = 0u;
    __syncthreads();
    { ArgsRef a0 = fresh_args(); if (threadIdx.x == 0) (void)xb_add(&((unsigned*)(a0.ws + OFF_BAR))[XB_XCNT(xb_xcc_id())], 1u); }
#define GSYNC() do { asm volatile("" ::: "memory"); { ArgsRef ab = fresh_args(); xcd_barrier((unsigned*)(ab.ws + OFF_BAR), bst); } asm volatile("" ::: "memory"); } while (0)
#define GSYNC_CG() do { asm volatile("" ::: "memory"); grid.sync(); asm volatile("" ::: "memory"); } while (0)
    const int wave_s = __builtin_amdgcn_readfirstlane((int)threadIdx.x >> 6);
#define PH(body) do { int wave = wave_s; asm volatile("" : "+s"(wave)); int lane; asm volatile("v_mbcnt_lo_u32_b32 %0, -1, 0\n\tv_mbcnt_hi_u32_b32 %0, -1, %0" : "=v"(lane)); \
        int bid = blockIdx.x, G = gridDim.x; asm volatile("" : "+s"(bid), "+s"(G)); \
        const int tid = wave * 64 + lane, gw = bid * 8 + wave, GW = G * 8; (void)tid; (void)gw; (void)GW; ArgsRef a = fresh_args(); body; } while (0)
#pragma unroll 1
    for (int l = 0; l < NLAYER; ++l) {
        PH(phase_prep(a, l, tid, bid, G)); if (l == 0) GSYNC_CG(); else GSYNC();
        PH(phase_zgemm2(a, tid, bid, G)); GSYNC();
        PH(phase_mprep2(a, l, tid, lane, wave, bid, G)); GSYNC();
        PH(phase_mqkv(a, lane, gw, GW)); GSYNC();
        PH(phase_mixers<1>(a, l, tid, lane, wave, bid, G)); GSYNC();
        PH(phase_mixers<2>(a, l, tid, lane, wave, bid, G)); GSYNC();
        PH(phase_post(a, l, lane, gw, GW)); GSYNC();
        PH(phase_glu_gates(a, tid, bid, G)); PH(phase_prepx(a, l, tid, bid, G)); GSYNC();
        PH(phase_merge2(a, tid, bid, G)); GSYNC();
        PH(phase_wout2(a, l, tid, bid, G)); GSYNC();
        PH(phase_ln1r(a, l, tid, lane, wave, bid, G)); GSYNC();
        PH(phase_slot(a, tid, bid, G)); GSYNC();
        PH(phase_moe_gu(a, lane, gw, GW)); GSYNC();
        PH(phase_moe_dn(a, lane, gw, GW)); GSYNC();
        PH(phase_ln2(a, l, lane, gw, GW)); if (l + 1 < NLAYER) GSYNC();
    }
}

extern "C" void kernel_launch(void* const* d_in, const int* in_sizes, int n_in, void* d_out, int out_size, void* d_ws, size_t ws_size, hipStream_t stream) {
    static int grid = 0;
    if (grid == 0) {
        if (n_in != 34 || out_size != T * D || ws_size < WS_TOTAL) { fprintf(stderr, "kernel_launch: unexpected shapes (n_in %d, out %d, ws %zu, need %zu)\n", n_in, out_size, ws_size, (size_t)WS_TOTAL); grid = -1; return; }
        int dev = 0, cus = 0, per_cu = 0;
        (void)hipGetDevice(&dev); (void)hipDeviceGetAttribute(&cus, hipDeviceAttributeMultiprocessorCount, dev);
        (void)hipFuncSetAttribute((const void*)fwd, hipFuncAttributeMaxDynamicSharedMemorySize, LDS_BYTES);
        (void)hipOccupancyMaxActiveBlocksPerMultiprocessor(&per_cu, (const void*)fwd, 512, LDS_BYTES);
        if (per_cu < 1) { fprintf(stderr, "kernel_launch: occupancy query says %d blocks per CU\n", per_cu); per_cu = 1; }
        grid = (cus > 0 ? cus : 256) * 1;
        (void)hipGetLastError();
    }
    if (grid < 0) return;
    Args a{};
    for (int i = 0; i < 34; ++i) a.in[i] = (const float*)d_in[i];
    a.out = (float*)d_out; a.ws = (unsigned char*)d_ws; a.ph_lo = 0; a.ph_hi = NLAYER * NPH;
    (void)hipMemsetAsync((unsigned char*)d_ws + OFF_BAR, 0, 16384, stream);
    void* args[] = {&a};
    hipError_t e = hipLaunchCooperativeKernel((const void*)fwd, dim3(grid), dim3(512), args, LDS_BYTES, stream);
    if (e != hipSuccess) fprintf(stderr, "kernel_launch: cooperative launch failed: %s (grid %d)\n", hipGetErrorString(e), grid);
}
```

```cpp
#include <hip/hip_runtime.h>
#include <hip/hip_cooperative_groups.h>
#include <cstdio>
#include <cstdint>
namespace cg = cooperative_groups;

typedef unsigned short bf16_t;
typedef short bf16x8 __attribute__((ext_vector_type(8)));
typedef short bf16x4 __attribute__((ext_vector_type(4)));
typedef float f32x4 __attribute__((ext_vector_type(4)));
typedef unsigned u32x4 __attribute__((ext_vector_type(4)));
typedef unsigned u32x2 __attribute__((ext_vector_type(2)));

constexpr int T = 16384, D = 1024, NZ = 3584, NWIN = 6912, INW = 6664;
constexpr int NPH = 15, NLAYER = 2;
constexpr int GSEG = 32, GSEGLEN = 512;
constexpr int SSEG = 64, SSEGLEN = 256;
constexpr int SLOTS = 40960;
constexpr float DN_ALPHA = 1.41421356237f;
constexpr int LDS_BYTES = 131072 + 256;

constexpr size_t AL(size_t x) { return (x + 255) & ~(size_t)255; }
constexpr size_t OFF_WIN = 0;
constexpr size_t OFF_WQKV = OFF_WIN + AL((size_t)NWIN * 1024 * 2);
constexpr size_t OFF_WGLU = OFF_WQKV + AL((size_t)1536 * 512 * 2);
constexpr size_t OFF_WB = OFF_WGLU + AL((size_t)512 * 512 * 2);
constexpr size_t OFF_WOUT = OFF_WB + AL((size_t)3 * 1024 * 512 * 2);
constexpr size_t OFF_ABAR = OFF_WOUT + AL((size_t)1024 * 1024 * 2);
constexpr size_t OFF_BBT = OFF_ABAR + AL((size_t)32 * 64 * 2 * 4);
constexpr size_t OFF_CCT = OFF_BBT + AL((size_t)32 * 128 * 16 * 2);
constexpr size_t OFF_CTL = OFF_CCT + AL((size_t)32 * 16 * 128 * 2);
constexpr size_t OFF_TOKE = OFF_CTL + 4096;
constexpr size_t OFF_TOKG = OFF_TOKE + AL((size_t)T * 2 * 4);
constexpr size_t OFF_TOKS = OFF_TOKG + AL((size_t)T * 2 * 4);
constexpr size_t OFF_SLOTT = OFF_TOKS + AL((size_t)T * 2 * 4);
constexpr size_t OFF_XB = OFF_SLOTT + AL((size_t)SLOTS * 4);
constexpr size_t OFF_R1 = OFF_XB + AL((size_t)T * 1024 * 2);
constexpr size_t SZ_ACT = (size_t)T * 512 * 2;
constexpr size_t OFF_XC = OFF_R1, OFF_Q = OFF_R1 + SZ_ACT, OFF_KH = OFF_R1 + 2 * SZ_ACT, OFF_V = OFF_R1 + 3 * SZ_ACT;
constexpr size_t OFF_WGU = OFF_R1, OFF_WD = OFF_R1 + (size_t)32 * 512 * 1024 * 2;
constexpr size_t OFF_Z = OFF_R1 + 4 * SZ_ACT;
constexpr size_t OFF_XG = OFF_Z, OFF_H = OFF_Z + (size_t)SLOTS * 1024 * 2;
constexpr size_t OFF_ZS = OFF_Z + AL((size_t)T * NZ * 2);
constexpr size_t OFF_LF = OFF_ZS + AL((size_t)T * 8 * 4);
constexpr size_t OFF_LI = OFF_LF + AL((size_t)T * 4 * 4);
constexpr size_t OFF_E = OFF_LI + AL((size_t)T * 4 * 4);
constexpr size_t OFF_OM = OFF_E, OFF_OH = OFF_E + SZ_ACT, OFF_YPRE = OFF_E + 2 * SZ_ACT, OFF_YSG = OFF_E + 3 * SZ_ACT;
constexpr size_t OFF_DEN = OFF_E + 4 * SZ_ACT;
constexpr size_t OFF_EM = OFF_DEN + AL((size_t)T * 4 * 4);
constexpr size_t OFF_EMX = OFF_EM + AL((size_t)GSEG * 4 * 128 * 128 * 4);
constexpr size_t OFF_GM = OFF_EMX + AL((size_t)GSEG * 4 * 128 * 16 * 4);
constexpr size_t OFF_EH = OFF_GM + AL((size_t)GSEG * 4 * 128 * 4);
constexpr size_t OFF_GH = OFF_EH + AL((size_t)GSEG * 4 * 128 * 128 * 4);
constexpr size_t OFF_ES = OFF_GH + AL((size_t)GSEG * 4 * 128 * 4);
constexpr size_t WS_END = OFF_ES + AL((size_t)SSEG * 32 * 64 * 2 * 4);
constexpr size_t OFF_YS = OFF_E;
constexpr size_t OFF_BAR = WS_END;
constexpr size_t WS_TOTAL = OFF_BAR + 16384;
static_assert(OFF_YS + (size_t)SLOTS * 1024 * 2 <= WS_END, "YS must fit in the dead region");
static_assert(OFF_H + (size_t)SLOTS * 256 * 2 <= OFF_ZS, "H must fit in the dead Z region");
static_assert(OFF_WD + (size_t)32 * 1024 * 256 * 2 <= OFF_Z, "expert weights must fit in R1");

struct Args { const float* in[34]; float* out; unsigned char* ws; int ph_lo, ph_hi; };
typedef const __attribute__((address_space(4))) Args& ArgsRef;

extern __shared__ __attribute__((aligned(16))) unsigned char smem[];

__device__ __forceinline__ bf16_t f2bf(float f) { unsigned u = __float_as_uint(f); u += 0x7FFFu + ((u >> 16) & 1u); return (bf16_t)(u >> 16); }
__device__ __forceinline__ float bf2f(bf16_t b) { return __uint_as_float(((unsigned)b) << 16); }
__device__ __forceinline__ unsigned pack2(float lo, float hi) { return (unsigned)f2bf(lo) | ((unsigned)f2bf(hi) << 16); }
__device__ __forceinline__ float sigmoidf_(float x) { return 1.0f / (1.0f + expf(-x)); }
__device__ __forceinline__ float siluf_(float x) { return x / (1.0f + expf(-x)); }
__device__ __forceinline__ float logsigmoidf_(float x) { return fminf(x, 0.f) - log1pf(expf(-fabsf(x))); }
__device__ __forceinline__ float gelu_tanh(float y) { const float z = 0.7978845608028654f * (y + 0.044715f * y * y * y); const float th = 1.0f - 2.0f / (expf(2.0f * z) + 1.0f); return 0.5f * y * (1.0f + th); }
__device__ __forceinline__ void wave_sync() { __builtin_amdgcn_wave_barrier(); asm volatile("s_waitcnt lgkmcnt(0)" ::: "memory"); __builtin_amdgcn_wave_barrier(); }

#define MFMA16(a, b, c) __builtin_amdgcn_mfma_f32_16x16x32_bf16((a), (b), (c), 0, 0, 0)

template <int MT, int NT, class FA, class FB>
__device__ __forceinline__ void wave_gemm(f32x4 (&acc)[MT][NT], int K, FA arow, FB brow, int lane) {
    const int r = lane & 15, q = lane >> 4;
    const bf16_t* ap[MT]; const bf16_t* bp[NT];
#pragma unroll
    for (int m = 0; m < MT; ++m) ap[m] = arow(m * 16 + r) + 8 * q;
#pragma unroll
    for (int n = 0; n < NT; ++n) bp[n] = brow(n * 16 + r) + 8 * q;
#pragma unroll 1
    for (int k = 0; k < K; k += 32) {
        bf16x8 a[MT], b[NT];
#pragma unroll
        for (int m = 0; m < MT; ++m) a[m] = *(const bf16x8*)(ap[m] + k);
#pragma unroll
        for (int n = 0; n < NT; ++n) b[n] = *(const bf16x8*)(bp[n] + k);
#pragma unroll
        for (int m = 0; m < MT; ++m)
#pragma unroll
            for (int n = 0; n < NT; ++n) acc[m][n] = MFMA16(a[m], b[n], acc[m][n]);
    }
}
template <int MT, int NT> __device__ __forceinline__ void zero_acc(f32x4 (&acc)[MT][NT]) {
#pragma unroll
    for (int m = 0; m < MT; ++m)
#pragma unroll
        for (int n = 0; n < NT; ++n) acc[m][n] = (f32x4){0.f, 0.f, 0.f, 0.f};
}

namespace pg8 {
#define PG8_LAS __attribute__((address_space(3)))
constexpr int BM = 256, BK = 64, HALF = 128, HTB = HALF * BK * 2, STAGE_BYTES = 8 * HTB;
__device__ __forceinline__ int lds_byte(int r, int c) { const int st = (r >> 4) * 2 + (c >> 5), rr = r & 15, cc = c & 31, ob = rr * 64 + cc * 2; return st * 1024 + (ob ^ (((ob >> 9) & 1) << 5)); }
__device__ __forceinline__ void stage_rc(int b, int& R, int& C) { const int st = b / 1024, sb = b % 1024, swz = sb ^ (((sb >> 9) & 1) << 5); R = (st >> 1) * 16 + swz / 64; C = (st & 1) * 32 + (swz % 64) / 2; }
__device__ __forceinline__ int perm32(int rho) { const int n = rho >> 4, i = rho & 15; return 8 * (i >> 2) + 4 * n + (i & 3); }
struct Unit { int pm, pn, tag; const char* A; const char* B; };
__device__ __forceinline__ unsigned cvt_pk_bf16(float lo, float hi) { unsigned r; asm volatile("v_cvt_pk_bf16_f32 %0, %1, %2" : "=v"(r) : "v"(lo), "v"(hi)); return r; }
__device__ __forceinline__ bool tile_order(int L, int nM, int nN, int& pm, int& pn) {
    const int nwg = nM * nN; if (L >= nwg) return false;
    int wgid = L; { const int q = nwg / 8, r = nwg % 8, xcd = wgid % 8, off = wgid / 8; wgid = (xcd < r ? xcd * (q + 1) : r * (q + 1) + (xcd - r) * q) + off; }
    const int nig = 8 * nN, gid = wgid / nig, fm = gid * 8, gsz = (nM - fm) < 8 ? (nM - fm) : 8;
    pm = fm + ((wgid % nig) % gsz); pn = (wgid % nig) / gsz; return true;
}
template <class Epi, class Sched>
__device__ __forceinline__ void gemm_phase(PG8_LAS unsigned char* lds, const int tid, const int K, const int lda, const int ldb, const Sched& S, const Epi& E) {
    const int wid = __builtin_amdgcn_readfirstlane(tid >> 6), lane = tid & 63, wr = wid >> 2, wc = wid & 3, fr = lane & 15, fq = lane >> 4;
    const int nt = K / BK;
    unsigned voffA[2], voffB[2];
#pragma unroll
    for (int i = 0; i < 2; ++i) { int R, C; stage_rc(tid * 16 + i * 8192, R, C); const int Rb = Epi::PERM ? ((R & ~31) + perm32(R & 31)) : R;
        voffA[i] = (unsigned)(R * lda + C) * 2u; voffB[i] = (unsigned)(Rb * ldb + C) * 2u; }
    const size_t kstep = (size_t)(BK * 2), hstepA = (size_t)HALF * lda * 2, hstepB = (size_t)HALF * ldb * 2;
    const unsigned ldsw = (unsigned)wid * 1024u;
    const int aoff = lds_byte(wr * 64 + fr, fq * 8), boff = lds_byte(wc * 32 + fr, fq * 8);
#define PG8_SA(b, h) (((b) * 2 + (h)) * HTB)
#define PG8_SB(b, h) ((4 + (b) * 2 + (h)) * HTB)
#define PG8_STAGE(bufoff, gbase, voff) do { _Pragma("unroll") for (int _i = 0; _i < 2; ++_i) \
        __builtin_amdgcn_global_load_lds((const unsigned*)((const char*)(gbase) + (voff)[_i]), (PG8_LAS unsigned*)(lds + (bufoff) + ldsw + _i * 8192), 16, 0, 0); } while (0)
#define PG8_LDA(dst, b, h) do { _Pragma("unroll") for (int m = 0; m < 4; ++m) _Pragma("unroll") for (int k = 0; k < 2; ++k) dst[m][k] = *(const PG8_LAS bf16x8*)(lds + PG8_SA(b, h) + aoff + m * 2048 + k * 1024); } while (0)
#define PG8_LDB(dst, b, h) do { _Pragma("unroll") for (int n = 0; n < 2; ++n) _Pragma("unroll") for (int k = 0; k < 2; ++k) dst[n][k] = *(const PG8_LAS bf16x8*)(lds + PG8_SB(b, h) + boff + n * 2048 + k * 1024); } while (0)
#define PG8_MMA(ai, bj, At, Bt) do { __builtin_amdgcn_s_setprio(1); _Pragma("unroll") for (int m = 0; m < 4; ++m) _Pragma("unroll") for (int n = 0; n < 2; ++n) _Pragma("unroll") for (int k = 0; k < 2; ++k) \
        acc[ai][bj][m][n] = __builtin_amdgcn_mfma_f32_16x16x32_bf16(Bt[n][k], At[m][k], acc[ai][bj][m][n], 0, 0, 0); __builtin_amdgcn_s_setprio(0); } while (0)
#define PG8_WAIT_V(n) asm volatile("s_waitcnt vmcnt(" #n ")" ::: "memory")
#define PG8_WAIT_L(n) asm volatile("s_waitcnt lgkmcnt(" #n ")" ::: "memory")
#define PG8_BAR __builtin_amdgcn_s_barrier()
#define PG8_SCHED __builtin_amdgcn_sched_barrier(0)
    Unit cur, nxt; int ui = 0;
    if (!S.next(0, cur)) return;
    f32x4 acc[2][2][4][2];
#pragma unroll
    for (int a = 0; a < 2; ++a)
#pragma unroll
        for (int b = 0; b < 2; ++b)
#pragma unroll
            for (int m = 0; m < 4; ++m)
#pragma unroll
                for (int n = 0; n < 2; ++n) acc[a][b][m][n] = (f32x4){0.f, 0.f, 0.f, 0.f};
    bf16x8 At[4][2], B0[2][2], B1[2][2];
    const char* cA = cur.A; const char* cB = cur.B;
    PG8_STAGE(PG8_SB(0, 0), cB, voffB); PG8_STAGE(PG8_SA(0, 0), cA, voffA); PG8_STAGE(PG8_SB(0, 1), cB + hstepB, voffB); PG8_STAGE(PG8_SA(0, 1), cA + hstepA, voffA);
    if (wr == 1) PG8_BAR;
    PG8_WAIT_V(4); PG8_BAR;
    PG8_STAGE(PG8_SB(1, 0), cB + kstep, voffB); PG8_STAGE(PG8_SA(1, 0), cA + kstep, voffA); PG8_STAGE(PG8_SB(1, 1), cB + hstepB + kstep, voffB);
    PG8_WAIT_V(6); PG8_BAR;
    for (;;) {
        const bool has_next = S.next(ui + 1, nxt);
        const char* nA = has_next ? nxt.A : cA; const char* nB = has_next ? nxt.B : cB;
        for (int t = 0; t < nt; t += 2) {
            const bool last = (t == nt - 2);
            const char* a1 = cA + (size_t)(t + 1) * kstep;
            const char* a2 = last ? nA : cA + (size_t)(t + 2) * kstep; const char* b2 = last ? nB : cB + (size_t)(t + 2) * kstep;
            const char* a3 = a2 + kstep; const char* b3 = b2 + kstep;
            PG8_LDB(B0, 0, 0); PG8_SCHED; PG8_LDA(At, 0, 0); PG8_STAGE(PG8_SA(1, 1), a1 + hstepA, voffA);
            PG8_WAIT_L(8); PG8_BAR; PG8_WAIT_L(0); PG8_MMA(0, 0, At, B0); PG8_BAR; PG8_SCHED;
            PG8_LDB(B1, 0, 1); PG8_STAGE(PG8_SB(0, 0), b2, voffB);
            PG8_BAR; PG8_WAIT_L(0); PG8_MMA(0, 1, At, B1); PG8_BAR;
            PG8_LDA(At, 0, 1); PG8_STAGE(PG8_SA(0, 0), a2, voffA);
            PG8_BAR; PG8_WAIT_L(0); PG8_MMA(1, 0, At, B0); PG8_BAR; PG8_SCHED;
            PG8_STAGE(PG8_SB(0, 1), b2 + hstepB, voffB);
            PG8_WAIT_V(6); PG8_BAR; PG8_MMA(1, 1, At, B1); PG8_BAR;
            PG8_LDB(B0, 1, 0); PG8_SCHED; PG8_LDA(At, 1, 0); PG8_STAGE(PG8_SA(0, 1), a2 + hstepA, voffA);
            PG8_WAIT_L(8); PG8_BAR; PG8_WAIT_L(0); PG8_MMA(0, 0, At, B0); PG8_BAR; PG8_SCHED;
            PG8_LDB(B1, 1, 1); PG8_STAGE(PG8_SB(1, 0), b3, voffB);
            PG8_BAR; PG8_WAIT_L(0); PG8_MMA(0, 1, At, B1); PG8_BAR;
            PG8_LDA(At, 1, 1); PG8_STAGE(PG8_SA(1, 0), a3, voffA);
            PG8_BAR; PG8_WAIT_L(0); PG8_MMA(1, 0, At, B0); PG8_BAR; PG8_SCHED;
            PG8_STAGE(PG8_SB(1, 1), b3 + hstepB, voffB);
            PG8_WAIT_V(6); PG8_BAR; PG8_MMA(1, 1, At, B1); PG8_BAR;
        }
        const bool keep = E(acc, cur, wr, wc, fr, fq);
        if (!has_next) break;
        if (!keep) {
#pragma unroll
            for (int a = 0; a < 2; ++a)
#pragma unroll
                for (int b = 0; b < 2; ++b)
#pragma unroll
                    for (int m = 0; m < 4; ++m)
#pragma unroll
                        for (int n = 0; n < 2; ++n) acc[a][b][m][n] = (f32x4){0.f, 0.f, 0.f, 0.f};
        }
        cur = nxt; cA = nA; cB = nB; ++ui;
    }
    PG8_WAIT_V(0);
    if (wr == 0) PG8_BAR;
    PG8_BAR;
#undef PG8_SA
#undef PG8_SB
#undef PG8_STAGE
#undef PG8_LDA
#undef PG8_LDB
#undef PG8_MMA
#undef PG8_WAIT_V
#undef PG8_WAIT_L
#undef PG8_BAR
#undef PG8_SCHED
}
}

__device__ __forceinline__ void tconv_tile(const float* src, int ld_src, int nvalid, bf16_t* dst, int ld_dst, int tid) {
    float* t = (float*)smem;
    { const int r = tid >> 3, c0 = (tid & 7) * 8;
#pragma unroll
      for (int j = 0; j < 8; ++j) { const int c = c0 + j; const float v = (c < nvalid) ? src[(size_t)r * ld_src + c] : 0.f; t[c * 65 + r] = v; } }
    __syncthreads();
    { const int n = tid >> 3, k0 = (tid & 7) * 8; const float* p = t + n * 65 + k0;
      u32x4 w; w.x = pack2(p[0], p[1]); w.y = pack2(p[2], p[3]); w.z = pack2(p[4], p[5]); w.w = pack2(p[6], p[7]);
      *(u32x4*)(dst + (size_t)n * ld_dst + k0) = w; }
    __syncthreads();
}

__device__ __forceinline__ void phase_prep(ArgsRef a, int l, int tid, int bid, int G) {
    unsigned char* ws = a.ws;
    bf16_t* WIN = (bf16_t*)(ws + OFF_WIN); bf16_t* WQKV = (bf16_t*)(ws + OFF_WQKV); bf16_t* WGLU = (bf16_t*)(ws + OFF_WGLU);
    bf16_t* WB = (bf16_t*)(ws + OFF_WB); bf16_t* WOUT = (bf16_t*)(ws + OFF_WOUT);
    for (int u = bid; u < 2624; u += G) {
        const float* src; int lds_ = 0, nvalid = 64, ldd = 0; bf16_t* dst;
        if (u < 1728) { const int nt = u / 16, kt = u % 16, p0 = nt * 64; int sc;
            if (p0 < 1024) sc = p0; else if (p0 < 6656) sc = p0 + 8; else if (p0 == 6656) { sc = 1024; nvalid = 8; } else { sc = 0; nvalid = 0; }
            src = a.in[1] + (size_t)l * 1024 * INW + (size_t)(kt * 64) * INW + sc; lds_ = INW; dst = WIN + (size_t)p0 * 1024 + kt * 64; ldd = 1024; }
        else if (u < 1920) { const int v = u - 1728, nt = v / 8, kt = v % 8, which = nt / 8, h = (nt % 8) / 2;
            if ((kt >> 1) != h) nvalid = 0;
            src = a.in[4 + which] + (size_t)(l * 4 + h) * 128 * 128 + ((kt & 1) * 64) * 128 + (nt & 1) * 64; lds_ = 128; dst = WQKV + (size_t)(nt * 64) * 512 + kt * 64; ldd = 512; }
        else if (u < 1984) { const int v = u - 1920, nt = v / 8, kt = v % 8;
            src = a.in[18] + (size_t)l * 512 * 512 + (kt * 64) * 512 + nt * 64; lds_ = 512; dst = WGLU + (size_t)(nt * 64) * 512 + kt * 64; ldd = 512; }
        else if (u < 2368) { const int v = u - 1984, b = v / 128, w = v % 128, nt = w / 8, kt = w % 8;
            src = a.in[21 + b] + (size_t)l * 512 * 1024 + (size_t)(kt * 64) * 1024 + nt * 64; lds_ = 1024; dst = WB + (size_t)b * 1024 * 512 + (size_t)(nt * 64) * 512 + kt * 64; ldd = 512; }
        else { const int v = u - 2368, nt = v / 16, kt = v % 16;
            src = a.in[24] + (size_t)l * 1024 * 1024 + (size_t)(kt * 64) * 1024 + nt * 64; lds_ = 1024; dst = WOUT + (size_t)(nt * 64) * 1024 + kt * 64; ldd = 1024; }
        tconv_tile(src, lds_, nvalid, dst, ldd, tid);
    }
    float* ABAR = (float*)(ws + OFF_ABAR); bf16_t* BBT = (bf16_t*)(ws + OFF_BBT); bf16_t* CCT = (bf16_t*)(ws + OFF_CCT);
    for (int i = bid * 512 + tid; i < 2048; i += G * 512) {
        const int g = i / 64, p = i % 64; const size_t gp = (size_t)(l * 32 + g) * 64 + p;
        const float lr = fminf(a.in[10][gp], -1e-4f), li = a.in[11][gp], dt = expf(a.in[12][l * 32 + g]);
        const float mag = expf(lr * dt), abr = mag * cosf(li * dt), abi = mag * sinf(li * dt);
        const float nr = abr - 1.0f, den = lr * lr + li * li, cr = (nr * lr + abi * li) / den, ci = (abi * lr - nr * li) / den;
        ABAR[(g * 64 + p) * 2] = abr; ABAR[(g * 64 + p) * 2 + 1] = abi;
        for (int c = 0; c < 16; ++c) { const float br = a.in[13][gp * 16 + c], bi = a.in[14][gp * 16 + c];
            BBT[(size_t)(g * 128 + p) * 16 + c] = f2bf(cr * br - ci * bi); BBT[(size_t)(g * 128 + 64 + p) * 16 + c] = f2bf(cr * bi + ci * br);
            const size_t ci_ = ((size_t)(l * 32 + g) * 16 + c) * 64 + p;
            CCT[(size_t)(g * 16 + c) * 128 + p] = f2bf(a.in[15][ci_]); CCT[(size_t)(g * 16 + c) * 128 + 64 + p] = f2bf(-a.in[16][ci_]); }
    }
    if (bid == 0 && tid < 128) ((unsigned*)(ws + OFF_CTL))[tid] = 0u;
    if (l == 0) { bf16_t* XB = (bf16_t*)(ws + OFF_XB); const float* x = a.in[0];
        for (size_t i = (size_t)bid * 512 + tid; i < (size_t)T * 1024 / 8; i += (size_t)G * 512) {
            const f32x4 v0 = *(const f32x4*)(x + i * 8), v1 = *(const f32x4*)(x + i * 8 + 4);
            u32x4 w; w.x = pack2(v0[0], v0[1]); w.y = pack2(v0[2], v0[3]); w.z = pack2(v1[0], v1[1]); w.w = pack2(v1[2], v1[3]); *(u32x4*)(XB + i * 8) = w; } }
}

__device__ __forceinline__ void phase_prepx(ArgsRef a, int l, int tid, int bid, int G) {
    bf16_t* WGU = (bf16_t*)(a.ws + OFF_WGU); bf16_t* WD = (bf16_t*)(a.ws + OFF_WD);
    for (int u = bid; u < 6144; u += G) {
        const float* src; int lds_, ldd; bf16_t* dst;
        if (u < 4096) { const int up = u >= 2048, v = u & 2047, e = v / 64, w = v % 64, nt = w / 16, kt = w % 16, j0 = nt * 64, drow = (j0 / 128) * 256 + (j0 % 128) + up * 128;
            src = a.in[31 + up] + ((size_t)(l * 32 + e) * 1024 + kt * 64) * 256 + nt * 64; lds_ = 256; dst = WGU + ((size_t)e * 512 + drow) * 1024 + kt * 64; ldd = 1024; }
        else { const int v = u - 4096, e = v / 64, w = v % 64, nt = w / 4, kt = w % 4;
            src = a.in[33] + ((size_t)(l * 32 + e) * 256 + kt * 64) * 1024 + nt * 64; lds_ = 1024; dst = WD + ((size_t)e * 1024 + nt * 64) * 256 + kt * 64; ldd = 256; }
        tconv_tile(src, lds_, 64, dst, ldd, tid);
    }
}

constexpr int GL_QS = 0, GL_KS = 8704, GL_KT = 17408, GL_VT = 27648, GL_PS = 39168, GL_SC1 = 41728, GL_SC2 = 42240, GL_GT = 42752, GL_OS = 44800;
template <int MODE, int PASS>
__device__ __forceinline__ void gla_item(ArgsRef a, int l, int h, int sg, int tid, int lane, int wave) {
    unsigned char* ws = a.ws;
    const bf16_t* Z = (const bf16_t*)(ws + OFF_Z); const bf16_t* Qg = (const bf16_t*)(ws + OFF_Q); const bf16_t* Kg = (const bf16_t*)(ws + OFF_KH); const bf16_t* Vg = (const bf16_t*)(ws + OFF_V);
    const float* LF = (const float*)(ws + OFF_LF);
    float* Eg = (float*)(ws + (MODE == 0 ? OFF_EM : OFF_EH)); float* Gg = (float*)(ws + (MODE == 0 ? OFF_GM : OFF_GH)); float* EX = (float*)(ws + OFF_EMX);
    bf16_t* Og = (bf16_t*)(ws + (MODE == 0 ? OFF_OM : OFF_OH)); float* DEN = (float*)(ws + OFF_DEN);
    bf16_t* QS = (bf16_t*)(smem + GL_QS); bf16_t* KS = (bf16_t*)(smem + GL_KS); bf16_t* KT = (bf16_t*)(smem + GL_KT); bf16_t* VT = (bf16_t*)(smem + GL_VT); bf16_t* PS = (bf16_t*)(smem + GL_PS);
    float* SC1 = (float*)(smem + GL_SC1); float* SC2 = (float*)(smem + GL_SC2); float* GT = (float*)(smem + GL_GT); bf16_t* OS = (bf16_t*)(smem + GL_OS);
    const int r = lane & 15, q = lane >> 4, grp = tid >> 7, d = tid & 127;
    const bool xw = (MODE == 0) && (wave == 0);
    float lb = 0.f;
    if (MODE == 1 && l == 1) { const float h0 = a.in[19][h * 128 + d], h1 = a.in[19][512 + h * 128 + d]; lb = 1.0f / (1.0f + expf(h0 - h1)); }
    f32x4 S[8], SX[8];
#pragma unroll
    for (int i = 0; i < 8; ++i) { S[i] = (f32x4){0.f, 0.f, 0.f, 0.f}; SX[i] = (f32x4){0.f, 0.f, 0.f, 0.f}; }
    if (PASS == 2) {
        for (int j = 0; j < sg; ++j) {
#pragma unroll
            for (int i = 0; i < 8; ++i) { const f32x4 gv = *(const f32x4*)(Gg + (size_t)(j * 4 + h) * 128 + 16 * i + 4 * q);
#pragma unroll
                for (int g = 0; g < 4; ++g) { const size_t row = (size_t)(j * 4 + h) * 128 + 16 * i + 4 * q + g;
                    S[i][g] = gv[g] * S[i][g] + Eg[row * 128 + 16 * wave + r];
                    if (xw) SX[i][g] = gv[g] * SX[i][g] + EX[row * 16 + r]; } }
        }
    }
    __syncthreads();
    if (MODE == 0) { for (int i = tid; i < 16 * 40; i += 512) VT[128 * 40 + i] = (i < 32) ? (bf16_t)0x3F80 : (bf16_t)0; }
    float runb = 0.f;
    for (int ci = 0; ci < GSEGLEN / 32; ++ci) {
        const int t0 = sg * GSEGLEN + ci * 32, tb = t0 + grp * 8;
        float lg[8], qv[8], kv[8]; bf16_t vv[8];
#pragma unroll
        for (int j = 0; j < 8; ++j) {
            if (MODE == 1) { const size_t zo = (size_t)(tb + j) * NZ + h * 128 + d; const float qp = bf2f(Z[zo + 1536]), fp = bf2f(Z[zo + 2048]);
                const float f = lb + (1.0f - lb) * sigmoidf_(fp); lg[j] = logf(f); qv[j] = siluf_(qp); kv[j] = 1.0f - f; vv[j] = Z[zo + 2560]; }
            else { const size_t o = (size_t)(tb + j) * 512 + h * 128 + d; qv[j] = bf2f(Qg[o]); kv[j] = bf2f(Kg[o]); vv[j] = Vg[o]; lg[j] = LF[(tb + j) * 4 + h]; }
        }
        float cs[8]; cs[0] = lg[0];
#pragma unroll
        for (int j = 1; j < 8; ++j) cs[j] = cs[j - 1] + lg[j];
        GT[grp * 128 + d] = cs[7];
        __syncthreads();
        if (PASS == 2 && ci > 0) { const int row = tid >> 4, c8 = (tid & 15) * 8; *(u32x4*)(Og + (size_t)(t0 - 32 + row) * 512 + h * 128 + c8) = *(const u32x4*)(OS + row * 136 + c8); }
        const float g0 = GT[d], g1 = GT[128 + d], g2 = GT[256 + d], g3 = GT[384 + d];
        const float off = grp == 0 ? 0.f : grp == 1 ? g0 : grp == 2 ? g0 + g1 : g0 + g1 + g2;
        const float bmid = g0 + g1, bL = bmid + g2 + g3;
        bf16_t ktv[8];
#pragma unroll
        for (int j = 0; j < 8; ++j) { const float bt = off + cs[j]; const bf16_t kt = f2bf(kv[j] * expf(bmid - bt)); ktv[j] = kt;
            if (PASS == 2) { QS[(grp * 8 + j) * 136 + d] = f2bf(qv[j] * expf(bt - bmid)); KS[(grp * 8 + j) * 136 + d] = kt; } }
        { u32x4 w; w.x = ktv[0] | ((unsigned)ktv[1] << 16); w.y = ktv[2] | ((unsigned)ktv[3] << 16); w.z = ktv[4] | ((unsigned)ktv[5] << 16); w.w = ktv[6] | ((unsigned)ktv[7] << 16); *(u32x4*)(KT + d * 40 + grp * 8) = w;
          u32x4 x; x.x = vv[0] | ((unsigned)vv[1] << 16); x.y = vv[2] | ((unsigned)vv[3] << 16); x.z = vv[4] | ((unsigned)vv[5] << 16); x.w = vv[6] | ((unsigned)vv[7] << 16); *(u32x4*)(VT + d * 40 + grp * 8) = x; }
        if (grp == 0) { SC1[d] = expf(bmid); SC2[d] = expf(bL - bmid); runb += bL; }
        __syncthreads();
        if (PASS == 2) {
            if (wave < 4) {
                const int ti = (wave == 1 || wave == 2) ? 1 : 0, tj = (wave >= 2) ? 1 : 0;
                f32x4 p = (f32x4){0.f, 0.f, 0.f, 0.f};
                if (wave < 3) {
#pragma unroll
                    for (int kk = 0; kk < 4; ++kk) { const bf16x8 av = *(const bf16x8*)(QS + (16 * ti + r) * 136 + 32 * kk + 8 * q); const bf16x8 bv = *(const bf16x8*)(KS + (16 * tj + r) * 136 + 32 * kk + 8 * q); p = MFMA16(av, bv, p); }
                }
#pragma unroll
                for (int g = 0; g < 4; ++g) { const int t = 16 * ti + 4 * q + g, s = 16 * tj + r; PS[t * 40 + s] = (wave < 3 && s <= t) ? f2bf(p[g]) : (bf16_t)0; }
            }
            __syncthreads();
        }
        const bf16x8 bV = *(const bf16x8*)(VT + (16 * wave + r) * 40 + 8 * q);
        bf16x8 bV1 = bV; if (xw) bV1 = *(const bf16x8*)(VT + (128 + r) * 40 + 8 * q);
        f32x4 o[2], ox[2];
        o[0] = o[1] = ox[0] = ox[1] = (f32x4){0.f, 0.f, 0.f, 0.f};
#pragma unroll
        for (int kk = 0; kk < 4; ++kk) {
            const f32x4 sa = *(const f32x4*)(SC1 + 32 * kk + 4 * q), sb = *(const f32x4*)(SC1 + 32 * kk + 16 + 4 * q);
            S[2 * kk] *= sa; S[2 * kk + 1] *= sb;
            if (xw) { SX[2 * kk] *= sa; SX[2 * kk + 1] *= sb; }
            if (PASS == 2) {
                bf16x8 bS, bX;
#pragma unroll
                for (int g = 0; g < 4; ++g) { bS[g] = (short)f2bf(S[2 * kk][g]); bS[4 + g] = (short)f2bf(S[2 * kk + 1][g]); bX[g] = (short)f2bf(SX[2 * kk][g]); bX[4 + g] = (short)f2bf(SX[2 * kk + 1][g]); }
#pragma unroll
                for (int mt = 0; mt < 2; ++mt) { const bf16x4 lo = *(const bf16x4*)(QS + (16 * mt + r) * 136 + 32 * kk + 4 * q), hi = *(const bf16x4*)(QS + (16 * mt + r) * 136 + 32 * kk + 16 + 4 * q);
                    bf16x8 av; av[0] = lo[0]; av[1] = lo[1]; av[2] = lo[2]; av[3] = lo[3]; av[4] = hi[0]; av[5] = hi[1]; av[6] = hi[2]; av[7] = hi[3];
                    o[mt] = MFMA16(av, bS, o[mt]); if (xw) ox[mt] = MFMA16(av, bX, ox[mt]); }
            }
        }
        if (PASS == 2) {
#pragma unroll
            for (int mt = 0; mt < 2; ++mt) { const bf16x8 av = *(const bf16x8*)(PS + (16 * mt + r) * 40 + 8 * q); o[mt] = MFMA16(av, bV, o[mt]); if (xw) ox[mt] = MFMA16(av, bV1, ox[mt]);
#pragma unroll
                for (int g = 0; g < 4; ++g) { const int t = t0 + 16 * mt + 4 * q + g; OS[(16 * mt + 4 * q + g) * 136 + 16 * wave + r] = f2bf(o[mt][g]); if (xw && r == 0) DEN[h * T + t] = ox[mt][g]; } }
        }
#pragma unroll
        for (int i = 0; i < 8; ++i) { const bf16x8 av = *(const bf16x8*)(KT + (16 * i + r) * 40 + 8 * q); const f32x4 s2 = *(const f32x4*)(SC2 + 16 * i + 4 * q);
            S[i] = MFMA16(av, bV, S[i]); S[i] *= s2;
            if (xw) { SX[i] = MFMA16(av, bV1, SX[i]); SX[i] *= s2; } }
    }
    if (PASS == 2) { __syncthreads(); const int row = tid >> 4, c8 = (tid & 15) * 8; *(u32x4*)(Og + (size_t)(sg * GSEGLEN + GSEGLEN - 32 + row) * 512 + h * 128 + c8) = *(const u32x4*)(OS + row * 136 + c8); }
    if (PASS == 1) {
        float* ST = (float*)smem;
        __syncthreads();
#pragma unroll
        for (int i = 0; i < 8; ++i)
#pragma unroll
            for (int g = 0; g < 4; ++g) { ST[(16 * i + 4 * q + g) * 132 + 16 * wave + r] = S[i][g]; if (xw) EX[((size_t)(sg * 4 + h) * 128 + 16 * i + 4 * q + g) * 16 + r] = SX[i][g]; }
        __syncthreads();
#pragma unroll
        for (int k = 0; k < 8; ++k) { const int idx = tid + 512 * k, row = idx >> 5, c4 = (idx & 31) * 4; *(f32x4*)(Eg + ((size_t)(sg * 4 + h) * 128 + row) * 128 + c4) = *(const f32x4*)(ST + row * 132 + c4); }
        if (grp == 0) Gg[(size_t)(sg * 4 + h) * 128 + d] = expf(runb);
    }
}

template <int PASS>
__device__ __forceinline__ void s5_item(ArgsRef a, int l, int g, int sg, int g0, int tid, int lane, int wave, int hsel) {
    unsigned char* ws = a.ws;
    const bf16_t* Z = (const bf16_t*)(ws + OFF_Z); const float* ABAR = (const float*)(ws + OFF_ABAR); const bf16_t* BBT = (const bf16_t*)(ws + OFF_BBT); const bf16_t* CCT = (const bf16_t*)(ws + OFF_CCT);
    float* ES = (float*)(ws + OFF_ES); bf16_t* YPRE = (bf16_t*)(ws + OFF_YPRE);
    float* BU = (float*)(smem + 70000 + (wave & 3) * 12800); bf16_t* X = (bf16_t*)(smem + 70000 + (wave & 3) * 12800 + 8448); bf16_t* YT = (bf16_t*)(smem + 70000 + 51200);
    const int r = lane & 15, q = lane >> 4, p = lane; const bool act = (wave >> 2) == hsel;
    const float ar = ABAR[(g * 64 + p) * 2], ai = ABAR[(g * 64 + p) * 2 + 1];
    const bf16x8 zero8 = (bf16x8){0, 0, 0, 0, 0, 0, 0, 0};
    bf16x8 bB[8], cB[4];
#pragma unroll
    for (int nt = 0; nt < 8; ++nt) bB[nt] = (q < 2) ? *(const bf16x8*)(BBT + (size_t)(g * 128 + 16 * nt + r) * 16 + 8 * q) : zero8;
#pragma unroll
    for (int kk = 0; kk < 4; ++kk) cB[kk] = (PASS == 2) ? *(const bf16x8*)(CCT + (size_t)(g * 16 + r) * 128 + 32 * kk + 8 * q) : zero8;
    float xr = 0.f, xi = 0.f;
    if (PASS == 2 && sg > 0) {
        float pr = ar, pi = ai;
#pragma unroll
        for (int s = 0; s < 8; ++s) { const float nr = pr * pr - pi * pi, ni = 2.0f * pr * pi; pr = nr; pi = ni; }
        for (int j = 0; j < sg; ++j) { const float er = ES[((size_t)(j * 32 + g) * 64 + p) * 2], ei = ES[((size_t)(j * 32 + g) * 64 + p) * 2 + 1];
            const float nr = pr * xr - pi * xi + er, ni = pr * xi + pi * xr + ei; xr = nr; xi = ni; }
    }
    const float dsk = a.in[17][l * 512 + 16 * g + r];
    for (int ci = 0; ci < SSEGLEN / 16; ++ci) {
        const int t0 = sg * SSEGLEN + ci * 16;
        if (act) {
            const bf16x8 av = (q < 2) ? *(const bf16x8*)(Z + (size_t)(t0 + r) * NZ + 1024 + 16 * g + 8 * q) : zero8;
#pragma unroll
            for (int nt = 0; nt < 8; ++nt) { f32x4 acc = (f32x4){0.f, 0.f, 0.f, 0.f}; acc = MFMA16(av, bB[nt], acc);
#pragma unroll
                for (int gg = 0; gg < 4; ++gg) BU[(4 * q + gg) * 132 + 16 * nt + r] = acc[gg]; }
            wave_sync();
#pragma unroll
            for (int t = 0; t < 16; ++t) { const float br = BU[t * 132 + p], bi = BU[t * 132 + 64 + p];
                const float nr = ar * xr - ai * xi + br, ni = ar * xi + ai * xr + bi; xr = nr; xi = ni;
                if (PASS == 2) { X[t * 136 + p] = f2bf(xr); X[t * 136 + 64 + p] = f2bf(xi); } }
            wave_sync();
            if (PASS == 2) {
                f32x4 acc = (f32x4){0.f, 0.f, 0.f, 0.f};
#pragma unroll
                for (int kk = 0; kk < 4; ++kk) { const bf16x8 xv = *(const bf16x8*)(X + r * 136 + 32 * kk + 8 * q); acc = MFMA16(xv, cB[kk], acc); }
#pragma unroll
                for (int gg = 0; gg < 4; ++gg) { const int t = t0 + 4 * q + gg, c = 16 * g + r; const float u = bf2f(Z[(size_t)t * NZ + 1024 + c]);
                    YT[(4 * q + gg) * 136 + 16 * wave + r] = f2bf(gelu_tanh(acc[gg] + dsk * u)); }
            }
        }
        if (PASS == 2) {
            __syncthreads();
            if (tid < 128) { const int row = tid >> 3, c8 = (tid & 7) * 8; *(u32x4*)(YPRE + (size_t)(t0 + row) * 512 + 16 * g0 + 64 * hsel + c8) = *(const u32x4*)(YT + row * 136 + 64 * hsel + c8); }
            __syncthreads();
        }
    }
    if (PASS == 1 && act) { ES[((size_t)(sg * 32 + g) * 64 + p) * 2] = xr; ES[((size_t)(sg * 32 + g) * 64 + p) * 2 + 1] = xi; }
}

template <int PASS>
__device__ __forceinline__ void phase_mixers(ArgsRef a, int l, int tid, int lane, int wave, int bid, int G) {
    for (int it = bid; it < 4 * GSEG; it += G) gla_item<0, PASS>(a, l, it % 4, it / 4, tid, lane, wave);
    asm volatile("" ::: "memory");
    for (int it = bid + ((4 * GSEG - bid % G) % G + G) % G * 0; it < 2 * 4 * GSEG; it += G) { if (it >= 4 * GSEG) gla_item<1, PASS>(a, l, (it - 4 * GSEG) % 4, (it - 4 * GSEG) / 4, tid, lane, wave); }
    __syncthreads();
    for (int it0 = bid * 8; it0 < 32 * SSEG; it0 += G * 8)
        for (int half = 0; half < 2; ++half) { const int it = it0 + wave; s5_item<PASS>(a, l, it % 32, it / 32, it0 % 32, tid, lane, wave, half); __syncthreads(); }
}

__device__ __forceinline__ void phase_post(ArgsRef a, int l, int lane, int gw, int GW) {
    const bf16_t* Z = (const bf16_t*)(a.ws + OFF_Z); const bf16_t* XC = (const bf16_t*)(a.ws + OFF_XC);
    bf16_t* OM = (bf16_t*)(a.ws + OFF_OM); bf16_t* OH = (bf16_t*)(a.ws + OFF_OH); const float* DEN = (const float*)(a.ws + OFF_DEN);
    const int c0 = lane * 8, hd = lane >> 4;
    for (int t = gw; t < T; t += GW) {
        { const bf16x8 o = *(const bf16x8*)(OM + (size_t)t * 512 + c0), op = *(const bf16x8*)(Z + (size_t)t * NZ + 512 + c0), xc = *(const bf16x8*)(XC + (size_t)t * 512 + c0);
          const float dn = 1.0f / fmaxf(fabsf(DEN[hd * T + t]), 1.0f); float y[8];
#pragma unroll
          for (int j = 0; j < 8; ++j) y[j] = sigmoidf_(bf2f((bf16_t)op[j])) * (bf2f((bf16_t)o[j]) * dn) + a.in[9][l * 512 + c0 + j] * bf2f((bf16_t)xc[j]);
          u32x4 w; w.x = pack2(y[0], y[1]); w.y = pack2(y[2], y[3]); w.z = pack2(y[4], y[5]); w.w = pack2(y[6], y[7]); *(u32x4*)(OM + (size_t)t * 512 + c0) = w; }
        { const bf16x8 o = *(const bf16x8*)(OH + (size_t)t * 512 + c0), gp = *(const bf16x8*)(Z + (size_t)t * NZ + 3072 + c0);
          float ov[8], ss = 0.f;
#pragma unroll
          for (int j = 0; j < 8; ++j) { ov[j] = bf2f((bf16_t)o[j]); ss += ov[j] * ov[j]; }
          ss += __shfl_xor(ss, 1); ss += __shfl_xor(ss, 2); ss += __shfl_xor(ss, 4); ss += __shfl_xor(ss, 8);
          const float rinv = rsqrtf(ss * (1.0f / 128.0f) + 1e-6f); float y[8];
#pragma unroll
          for (int j = 0; j < 8; ++j) y[j] = ov[j] * rinv * a.in[20][l * 512 + c0 + j] * siluf_(bf2f((bf16_t)gp[j]));
          u32x4 w; w.x = pack2(y[0], y[1]); w.y = pack2(y[2], y[3]); w.z = pack2(y[4], y[5]); w.w = pack2(y[6], y[7]); *(u32x4*)(OH + (size_t)t * 512 + c0) = w; }
    }
}

__device__ __forceinline__ void ln_row(f32x4 (&v)[4], const float* gam, const float* bet, int lane) {
    float s = 0.f;
#pragma unroll
    for (int j = 0; j < 4; ++j) s += (v[j][0] + v[j][1]) + (v[j][2] + v[j][3]);
#pragma unroll
    for (int o = 32; o >= 1; o >>= 1) s += __shfl_xor(s, o);
    const float mean = s * (1.0f / 1024.0f); float qv = 0.f;
#pragma unroll
    for (int j = 0; j < 4; ++j) { const f32x4 dd = v[j] - mean; qv += (dd[0] * dd[0] + dd[1] * dd[1]) + (dd[2] * dd[2] + dd[3] * dd[3]); }
#pragma unroll
    for (int o = 32; o >= 1; o >>= 1) qv += __shfl_xor(qv, o);
    const float rstd = rsqrtf(qv * (1.0f / 1024.0f) + 1e-5f);
#pragma unroll
    for (int j = 0; j < 4; ++j) { const f32x4 gg = *(const f32x4*)(gam + 256 * j + 4 * lane), bb = *(const f32x4*)(bet + 256 * j + 4 * lane); v[j] = (v[j] - mean) * rstd * gg + bb; }
}

__device__ __forceinline__ void phase_ln1r(ArgsRef a, int l, int tid, int lane, int wave, int bid, int G) {
    float* XF = a.out; bf16_t* XB = (bf16_t*)(a.ws + OFF_XB);
    int* TOKE = (int*)(a.ws + OFF_TOKE); float* TOKG = (float*)(a.ws + OFF_TOKG); unsigned* CNT = (unsigned*)(a.ws + OFF_CTL);
    const float* RW = a.in[29]; const float* RB = a.in[30];
    float* XR = (float*)(smem + wave * 8192);
    unsigned* lh = (unsigned*)(smem + 65536);
    if (tid < 32) lh[tid] = 0u;
    __syncthreads();
    const int rs = lane >> 5, e = lane & 31;
    int* TE = (int*)(smem + 66048 + wave * 256); float* TG = (float*)(smem + 66048 + wave * 256 + 128);
    for (int tw = bid * 8 + wave; tw < T / 16; tw += G * 8)
    for (int t0 = tw * 16; t0 < tw * 16 + 16; t0 += 2) {
#pragma unroll
        for (int rr = 0; rr < 2; ++rr) { const int t = t0 + rr; f32x4 v[4];
#pragma unroll
            for (int j = 0; j < 4; ++j) v[j] = *(const f32x4*)(XF + (size_t)t * 1024 + 256 * j + 4 * lane);
            ln_row(v, a.in[25] + l * 1024, a.in[26] + l * 1024, lane);
#pragma unroll
            for (int j = 0; j < 4; ++j) { *(f32x4*)(XF + (size_t)t * 1024 + 256 * j + 4 * lane) = v[j]; *(f32x4*)(XR + rr * 1024 + 256 * j + 4 * lane) = v[j];
                u32x2 w; w.x = pack2(v[j][0], v[j][1]); w.y = pack2(v[j][2], v[j][3]); *(u32x2*)(XB + (size_t)t * 1024 + 256 * j + 4 * lane) = w; } }
        wave_sync();
        float acc = 0.f;
        for (int k = 0; k < 1024; k += 4) { const f32x4 xv = *(const f32x4*)(XR + rs * 1024 + k);
            acc += xv[0] * RW[(k + 0) * 32 + e]; acc += xv[1] * RW[(k + 1) * 32 + e]; acc += xv[2] * RW[(k + 2) * 32 + e]; acc += xv[3] * RW[(k + 3) * 32 + e]; }
        wave_sync();
        const float s = sigmoidf_(acc), sb = s + RB[e];
        float v4[4];
#pragma unroll
        for (int i = 0; i < 4; ++i) v4[i] = __shfl(sb, (lane & ~3) + i);
        int i1 = 0;
#pragma unroll
        for (int i = 1; i < 4; ++i) if (v4[i] > v4[i1]) i1 = i;
        int i2 = (i1 == 0) ? 1 : 0;
#pragma unroll
        for (int i = 0; i < 4; ++i) if (i != i1 && i != i2 && v4[i] > v4[i2]) i2 = i;
        float gs = v4[i1] + v4[i2]; int gid = e >> 2;
#pragma unroll
        for (int o = 4; o <= 16; o <<= 1) { const float os = __shfl_xor(gs, o); const int og = __shfl_xor(gid, o); if (os > gs || (os == gs && og < gid)) { gs = os; gid = og; } }
        float sv[4], sbv[4];
#pragma unroll
        for (int i = 0; i < 4; ++i) { sbv[i] = __shfl(sb, (lane & 32) + gid * 4 + i); sv[i] = __shfl(s, (lane & 32) + gid * 4 + i); }
        int j1 = 0;
#pragma unroll
        for (int i = 1; i < 4; ++i) if (sbv[i] > sbv[j1]) j1 = i;
        int j2 = (j1 == 0) ? 1 : 0;
#pragma unroll
        for (int i = 0; i < 4; ++i) if (i != j1 && i != j2 && sbv[i] > sbv[j2]) j2 = i;
        float s1 = sv[0], s2 = sv[0];
#pragma unroll
        for (int i = 1; i < 4; ++i) { if (i == j1) s1 = sv[i]; if (i == j2) s2 = sv[i]; }
        if (e == 0) { const int t = t0 + rs; const float inv = 1.0f / (s1 + s2);
            const int ti = t & 15; TE[ti * 2] = gid * 4 + j1; TE[ti * 2 + 1] = gid * 4 + j2; TG[ti * 2] = s1 * inv; TG[ti * 2 + 1] = s2 * inv;
            atomicAdd(&lh[gid * 4 + j1], 1u); atomicAdd(&lh[gid * 4 + j2], 1u); }
        if ((t0 & 15) == 14) { wave_sync(); if (lane < 32) { TOKE[(t0 - 14) * 2 + lane] = TE[lane]; TOKG[(t0 - 14) * 2 + lane] = TG[lane]; } wave_sync(); }
    }
    __syncthreads();
    if (tid < 32 && lh[tid]) atomicAdd(&CNT[tid], lh[tid]);
}

__device__ __forceinline__ void phase_slot(ArgsRef a, int tid, int lane, int wave, int bid, int G) {
    const int* TOKE = (const int*)(a.ws + OFF_TOKE); int* TOKS = (int*)(a.ws + OFF_TOKS);
    unsigned* CNT = (unsigned*)(a.ws + OFF_CTL); unsigned* BASE = CNT + 64;
    const bf16_t* XB = (const bf16_t*)(a.ws + OFF_XB); bf16_t* XG = (bf16_t*)(a.ws + OFF_XG);
    unsigned* base = (unsigned*)smem; unsigned* lc = base + 40; int* el = (int*)(base + 80); int* sl = (int*)(base + 208);
    if (tid == 0) { unsigned s = 0; for (int e = 0; e < 32; ++e) { base[e] = s; s += (CNT[e] + 255u) & ~255u; } base[32] = s; }
    __syncthreads();
    if (bid == 0 && tid < 33) BASE[tid] = base[tid];
    for (int c = bid; c < T / 64; c += G) {
        if (tid < 32) lc[tid] = 0u;
        __syncthreads();
        for (int i = tid; i < c * 128; i += 512) atomicAdd(&lc[TOKE[i]], 1u);
        int e = 0;
        if (tid < 128) { e = TOKE[c * 128 + tid]; el[tid] = e; }
        __syncthreads();
        if (tid < 128) { unsigned rank = 0; for (int i = 0; i < tid; ++i) rank += (el[i] == e) ? 1u : 0u;
            const unsigned s = base[e] + lc[e] + rank; sl[tid] = (int)s; TOKS[c * 128 + tid] = (int)s; }
        __syncthreads();
        for (int i = wave; i < 128; i += 8) { const int t = c * 64 + (i >> 1); const size_t so = (size_t)sl[i] * 1024;
            *(u32x4*)(XG + so + lane * 8) = *(const u32x4*)(XB + (size_t)t * 1024 + lane * 8); *(u32x4*)(XG + so + 512 + lane * 8) = *(const u32x4*)(XB + (size_t)t * 1024 + 512 + lane * 8); }
        __syncthreads();
    }
}

__device__ __forceinline__ void phase_ln2(ArgsRef a, int l, int lane, int gw, int GW) {
    float* XF = a.out; bf16_t* XB = (bf16_t*)(a.ws + OFF_XB); const bf16_t* YS = (const bf16_t*)(a.ws + OFF_YS);
    const int* TOKS = (const int*)(a.ws + OFF_TOKS); const float* TOKG = (const float*)(a.ws + OFF_TOKG);
    for (int t = gw; t < T; t += GW) {
        const int s0 = TOKS[t * 2], s1 = TOKS[t * 2 + 1]; const float g0 = TOKG[t * 2], g1 = TOKG[t * 2 + 1];
        f32x4 v[4];
#pragma unroll
        for (int j = 0; j < 4; ++j) { const f32x4 x1 = *(const f32x4*)(XF + (size_t)t * 1024 + 256 * j + 4 * lane);
            const bf16x4 y0 = *(const bf16x4*)(YS + (size_t)s0 * 1024 + 256 * j + 4 * lane), y1 = *(const bf16x4*)(YS + (size_t)s1 * 1024 + 256 * j + 4 * lane);
#pragma unroll
            for (int g = 0; g < 4; ++g) v[j][g] = DN_ALPHA * x1[g] + g0 * bf2f((bf16_t)y0[g]) + g1 * bf2f((bf16_t)y1[g]); }
        ln_row(v, a.in[27] + l * 1024, a.in[28] + l * 1024, lane);
#pragma unroll
        for (int j = 0; j < 4; ++j) { *(f32x4*)(XF + (size_t)t * 1024 + 256 * j + 4 * lane) = v[j];
            u32x2 w; w.x = pack2(v[j][0], v[j][1]); w.y = pack2(v[j][2], v[j][3]); *(u32x2*)(XB + (size_t)t * 1024 + 256 * j + 4 * lane) = w; }
    }
}

struct SchedGrid {
    int nM, nN, G, c; const char* A; const char* B; size_t strideA, strideB;
    __device__ __forceinline__ bool next(int i, pg8::Unit& u) const { int pm, pn; if (!pg8::tile_order(i * G + c, nM, nN, pm, pn)) return false;
        u.pm = pm; u.pn = pn; u.tag = 0; u.A = A + (size_t)pm * strideA; u.B = B + (size_t)pn * strideB; return true; }
};
constexpr int GATES_LD = 3072;
template <int MODE> struct EpiBf16 {
    static constexpr bool PERM = true;
    bf16_t* O; int ldo; const bf16_t* Y; int ldy;
    __device__ __forceinline__ bool operator()(f32x4 (&acc)[2][2][4][2], const pg8::Unit& u, int wr, int wc, int fr, int fq) const {
#pragma unroll
        for (int ai = 0; ai < 2; ++ai)
#pragma unroll
            for (int m = 0; m < 4; ++m) { const size_t row = (size_t)u.pm * 256 + ai * 128 + wr * 64 + m * 16 + fr;
#pragma unroll
                for (int bj = 0; bj < 2; ++bj) { const int col = u.pn * 256 + bj * 128 + wc * 32 + 8 * fq; f32x4 v0 = acc[ai][bj][m][0], v1 = acc[ai][bj][m][1];
                    if (MODE == 1) {
#pragma unroll
                        for (int j = 0; j < 4; ++j) { v0[j] = fmaxf(sigmoidf_(v0[j]), 1e-30f); v1[j] = fmaxf(sigmoidf_(v1[j]), 1e-30f); } }
                    if (MODE == 2) { const bf16x8 y = *(const bf16x8*)(Y + row * ldy + col);
#pragma unroll
                        for (int j = 0; j < 4; ++j) { v0[j] = bf2f((bf16_t)y[j]) * sigmoidf_(v0[j]); v1[j] = bf2f((bf16_t)y[4 + j]) * sigmoidf_(v1[j]); } }
                    u32x4 w; w.x = pg8::cvt_pk_bf16(v0[0], v0[1]); w.y = pg8::cvt_pk_bf16(v0[2], v0[3]); w.z = pg8::cvt_pk_bf16(v1[0], v1[1]); w.w = pg8::cvt_pk_bf16(v1[2], v1[3]);
                    *(u32x4*)(O + row * ldo + col) = w; } }
        return false;
    }
};
__device__ __forceinline__ void phase_zgemm2(ArgsRef a, int tid, int bid, int G) {
    SchedGrid S{T / 256, NZ / 256, G, bid, (const char*)(a.ws + OFF_XB), (const char*)(a.ws + OFF_WIN), (size_t)256 * 1024 * 2, (size_t)256 * 1024 * 2};
    EpiBf16<0> E{(bf16_t*)(a.ws + OFF_Z), NZ, nullptr, 0};
    pg8::gemm_phase((PG8_LAS unsigned char*)smem, tid, 1024, 1024, 1024, S, E);
}
__device__ __forceinline__ void phase_glu_gates(ArgsRef a, int tid, int bid, int G) {
    { SchedGrid S{T / 256, 2, G, bid, (const char*)(a.ws + OFF_YPRE), (const char*)(a.ws + OFF_WGLU), (size_t)256 * 512 * 2, (size_t)256 * 512 * 2};
      EpiBf16<2> E{(bf16_t*)(a.ws + OFF_YSG), 512, (const bf16_t*)(a.ws + OFF_YPRE), 512};
      pg8::gemm_phase((PG8_LAS unsigned char*)smem, tid, 512, 512, 512, S, E); }
    asm volatile("" : "+v"(tid), "+s"(bid), "+s"(G));
    { SchedGrid S{T / 256, 12, G, (bid + G / 2) % G, (const char*)(a.ws + OFF_XB), (const char*)(a.ws + OFF_WIN + (size_t)NZ * 1024 * 2), (size_t)256 * 1024 * 2, (size_t)256 * 1024 * 2};
      EpiBf16<1> E{(bf16_t*)(a.ws + OFF_Z), GATES_LD, nullptr, 0};
      pg8::gemm_phase((PG8_LAS unsigned char*)smem, tid, 1024, 1024, 1024, S, E); }
}
struct SchedMerge {
    int G, c; const unsigned char* ws;
    __device__ __forceinline__ bool next(int i, pg8::Unit& u) const { const int b = i % 3; int pm, pn; if (!pg8::tile_order((i / 3) * G + c, T / 256, 4, pm, pn)) return false;
        u.pm = pm; u.pn = pn; u.tag = b; u.A = (const char*)(ws + (b == 0 ? OFF_OM : b == 1 ? OFF_YSG : OFF_OH)) + (size_t)pm * 256 * 512 * 2;
        u.B = (const char*)(ws + OFF_WB) + ((size_t)b * 1024 + pn * 256) * 512 * 2; return true; }
};
struct EpiMerge {
    static constexpr bool PERM = true;
    const bf16_t* GT; bf16_t* O;
    __device__ __forceinline__ bool operator()(f32x4 (&acc)[2][2][4][2], const pg8::Unit& u, int wr, int wc, int fr, int fq) const {
        const int b = u.tag;
#pragma unroll
        for (int ai = 0; ai < 2; ++ai)
#pragma unroll
            for (int m = 0; m < 4; ++m) { const size_t row = (size_t)u.pm * 256 + ai * 128 + wr * 64 + m * 16 + fr;
#pragma unroll
                for (int bj = 0; bj < 2; ++bj) { const int col = u.pn * 256 + bj * 128 + wc * 32 + 8 * fq;
                    const bf16x8 gb = *(const bf16x8*)(GT + row * GATES_LD + b * 1024 + col);
                    if (b < 2) { const bf16x8 gn = *(const bf16x8*)(GT + row * GATES_LD + (b + 1) * 1024 + col);
#pragma unroll
                        for (int j = 0; j < 4; ++j) { acc[ai][bj][m][0][j] *= bf2f((bf16_t)gb[j]) / bf2f((bf16_t)gn[j]); acc[ai][bj][m][1][j] *= bf2f((bf16_t)gb[4 + j]) / bf2f((bf16_t)gn[4 + j]); } }
                    else { f32x4 v0 = acc[ai][bj][m][0], v1 = acc[ai][bj][m][1];
#pragma unroll
                        for (int j = 0; j < 4; ++j) { v0[j] *= bf2f((bf16_t)gb[j]); v1[j] *= bf2f((bf16_t)gb[4 + j]); }
                        u32x4 w; w.x = pg8::cvt_pk_bf16(v0[0], v0[1]); w.y = pg8::cvt_pk_bf16(v0[2], v0[3]); w.z = pg8::cvt_pk_bf16(v1[0], v1[1]); w.w = pg8::cvt_pk_bf16(v1[2], v1[3]);
                        *(u32x4*)(O + row * 1024 + col) = w; } } }
        return b < 2;
    }
};
__device__ __forceinline__ void phase_merge2(ArgsRef a, int tid, int bid, int G) {
    SchedMerge S{G, bid, a.ws}; EpiMerge E{(const bf16_t*)(a.ws + OFF_Z), (bf16_t*)(a.ws + OFF_XB)};
    pg8::gemm_phase((PG8_LAS unsigned char*)smem, tid, 512, 512, 512, S, E);
}
struct EpiResid {
    static constexpr bool PERM = false;
    const float* xin; float* XF;
    __device__ __forceinline__ bool operator()(f32x4 (&acc)[2][2][4][2], const pg8::Unit& u, int wr, int wc, int fr, int fq) const {
#pragma unroll
        for (int ai = 0; ai < 2; ++ai)
#pragma unroll
            for (int m = 0; m < 4; ++m) { const size_t row = (size_t)u.pm * 256 + ai * 128 + wr * 64 + m * 16 + fr;
#pragma unroll
                for (int bj = 0; bj < 2; ++bj)
#pragma unroll
                    for (int n = 0; n < 2; ++n) { const size_t o = row * 1024 + u.pn * 256 + bj * 128 + wc * 32 + 16 * n + 4 * fq; const f32x4 x = *(const f32x4*)(xin + o); *(f32x4*)(XF + o) = DN_ALPHA * x + acc[ai][bj][m][n]; } }
        return false;
    }
};
__device__ __forceinline__ void phase_wout2(ArgsRef a, int l, int tid, int bid, int G) {
    SchedGrid S{T / 256, 4, G, bid, (const char*)(a.ws + OFF_XB), (const char*)(a.ws + OFF_WOUT), (size_t)256 * 1024 * 2, (size_t)256 * 1024 * 2};
    EpiResid E{(l == 0) ? a.in[0] : a.out, a.out};
    pg8::gemm_phase((PG8_LAS unsigned char*)smem, tid, 1024, 1024, 1024, S, E);
}
struct EpiQKV {
    static constexpr bool PERM = true;
    int vcall; bf16_t* Q; bf16_t* KH; bf16_t* V; const float* LI;
    __device__ __forceinline__ bool operator()(f32x4 (&acc)[2][2][4][2], const pg8::Unit& u, int wr, int wc, int fr, int fq) const {
        const int which = vcall ? 2 : (u.pn >> 1); bf16_t* O = which == 0 ? Q : which == 1 ? KH : V;
#pragma unroll
        for (int ai = 0; ai < 2; ++ai)
#pragma unroll
            for (int m = 0; m < 4; ++m) { const size_t row = (size_t)u.pm * 256 + ai * 128 + wr * 64 + m * 16 + fr;
#pragma unroll
                for (int bj = 0; bj < 2; ++bj) { const int hd = (u.pn & 1) * 2 + bj, col = hd * 128 + wc * 32 + 8 * fq;
                    const float sc = which == 0 ? 0.08838834764831845f : which == 1 ? expf(LI[row * 4 + hd]) : 1.0f;
                    const f32x4 v0 = acc[ai][bj][m][0] * sc, v1 = acc[ai][bj][m][1] * sc;
                    u32x4 w; w.x = pg8::cvt_pk_bf16(v0[0], v0[1]); w.y = pg8::cvt_pk_bf16(v0[2], v0[3]); w.z = pg8::cvt_pk_bf16(v1[0], v1[1]); w.w = pg8::cvt_pk_bf16(v1[2], v1[3]);
                    *(u32x4*)(O + row * 512 + col) = w; } }
        return false;
    }
};
__device__ __forceinline__ void phase_mqkv2(ArgsRef a, int tid, int bid, int G) {
    { SchedGrid S{T / 256, 4, G, bid, (const char*)(a.ws + OFF_XC), (const char*)(a.ws + OFF_WQKV), (size_t)256 * 512 * 2, (size_t)256 * 512 * 2};
      EpiQKV E{0, (bf16_t*)(a.ws + OFF_Q), (bf16_t*)(a.ws + OFF_KH), (bf16_t*)(a.ws + OFF_V), (const float*)(a.ws + OFF_LI)};
      pg8::gemm_phase((PG8_LAS unsigned char*)smem, tid, 512, 512, 512, S, E); }
    asm volatile("" : "+v"(tid), "+s"(bid), "+s"(G));
    { SchedGrid S{T / 256, 2, G, (bid + G / 2) % G, (const char*)(a.ws + OFF_Z), (const char*)(a.ws + OFF_WQKV + (size_t)1024 * 512 * 2), (size_t)256 * NZ * 2, (size_t)256 * 512 * 2};
      EpiQKV E{1, (bf16_t*)(a.ws + OFF_Q), (bf16_t*)(a.ws + OFF_KH), (bf16_t*)(a.ws + OFF_V), (const float*)(a.ws + OFF_LI)};
      pg8::gemm_phase((PG8_LAS unsigned char*)smem, tid, 512, NZ, 512, S, E); }
}
struct SchedMoE {
    int down, G, c; const unsigned char* ws; const unsigned* BASE;
    __device__ __forceinline__ bool next(int i, pg8::Unit& u) const { const int per = down ? 4 : 2, L = i * G + c, ntile = (int)(BASE[32] >> 8); if (L >= ntile * per) return false;
        const int tile = L / per, sub = L % per; int e = 0; while (e < 31 && BASE[e + 1] <= (unsigned)(tile * 256)) ++e;
        u.pm = tile; u.pn = sub; u.tag = e;
        if (!down) { u.A = (const char*)(ws + OFF_XG) + (size_t)tile * 256 * 1024 * 2; u.B = (const char*)(ws + OFF_WGU) + ((size_t)e * 512 + sub * 256) * 1024 * 2; }
        else { u.A = (const char*)(ws + OFF_H) + (size_t)tile * 256 * 256 * 2; u.B = (const char*)(ws + OFF_WD) + ((size_t)e * 1024 + sub * 256) * 256 * 2; }
        return true; }
};
struct EpiH {
    static constexpr bool PERM = true;
    bf16_t* H;
    __device__ __forceinline__ bool operator()(f32x4 (&acc)[2][2][4][2], const pg8::Unit& u, int wr, int wc, int fr, int fq) const {
#pragma unroll
        for (int ai = 0; ai < 2; ++ai)
#pragma unroll
            for (int m = 0; m < 4; ++m) { const size_t row = (size_t)u.pm * 256 + ai * 128 + wr * 64 + m * 16 + fr; f32x4 v0, v1;
#pragma unroll
                for (int j = 0; j < 4; ++j) { v0[j] = siluf_(acc[ai][0][m][0][j]) * acc[ai][1][m][0][j]; v1[j] = siluf_(acc[ai][0][m][1][j]) * acc[ai][1][m][1][j]; }
                u32x4 w; w.x = pg8::cvt_pk_bf16(v0[0], v0[1]); w.y = pg8::cvt_pk_bf16(v0[2], v0[3]); w.z = pg8::cvt_pk_bf16(v1[0], v1[1]); w.w = pg8::cvt_pk_bf16(v1[2], v1[3]);
                *(u32x4*)(H + row * 256 + u.pn * 128 + wc * 32 + 8 * fq) = w; }
        return false;
    }
};
__device__ __forceinline__ void phase_moe_gu2(ArgsRef a, int tid, int bid, int G) {
    SchedMoE S{0, G, bid, a.ws, (const unsigned*)(a.ws + OFF_CTL) + 64}; EpiH E{(bf16_t*)(a.ws + OFF_H)};
    pg8::gemm_phase((PG8_LAS unsigned char*)smem, tid, 1024, 1024, 1024, S, E);
}
__device__ __forceinline__ void phase_moe_dn2(ArgsRef a, int tid, int bid, int G) {
    SchedMoE S{1, G, bid, a.ws, (const unsigned*)(a.ws + OFF_CTL) + 64}; EpiBf16<0> E{(bf16_t*)(a.ws + OFF_YS), 1024, nullptr, 0};
    pg8::gemm_phase((PG8_LAS unsigned char*)smem, tid, 256, 256, 256, S, E);
}
__device__ __forceinline__ void phase_mprep2(ArgsRef a, int l, int tid, int lane, int wave, int bid, int G) {
    const bf16_t* Z = (const bf16_t*)(a.ws + OFF_Z); bf16_t* XC = (bf16_t*)(a.ws + OFF_XC);
    const float* cw = a.in[2] + (size_t)l * 4 * 512; const float* cb = a.in[3] + (size_t)l * 512;
    for (int idx = bid * 512 + tid; idx < T * 64; idx += G * 512) {
        const int t = idx / 64, c0 = (idx % 64) * 8; float acc[8];
#pragma unroll
        for (int j = 0; j < 8; ++j) acc[j] = cb[c0 + j];
#pragma unroll
        for (int k = 0; k < 4; ++k) { const int ts = t - 3 + k; if (ts >= 0) { const bf16x8 v = *(const bf16x8*)(Z + (size_t)ts * NZ + c0);
#pragma unroll
                for (int j = 0; j < 8; ++j) acc[j] += cw[k * 512 + c0 + j] * bf2f((bf16_t)v[j]); } }
        u32x4 w; w.x = pack2(siluf_(acc[0]), siluf_(acc[1])); w.y = pack2(siluf_(acc[2]), siluf_(acc[3])); w.z = pack2(siluf_(acc[4]), siluf_(acc[5])); w.w = pack2(siluf_(acc[6]), siluf_(acc[7]));
        *(u32x4*)(XC + (size_t)t * 512 + c0) = w;
    }
    float* W8 = (float*)smem;
    const float* wsrc = a.in[1] + (size_t)l * 1024 * INW + 1024;
    __syncthreads();
    for (int i = tid; i < 8192; i += 512) W8[i] = wsrc[(size_t)(i >> 3) * INW + (i & 7)];
    __syncthreads();
    const bf16_t* XB = (const bf16_t*)(a.ws + OFF_XB); float* LF = (float*)(a.ws + OFF_LF); float* LI = (float*)(a.ws + OFF_LI);
    for (int tw = bid * 8 + wave; tw < T / 8; tw += G * 8) {
        float myli = 0.f, mylf = 0.f;
        for (int tt = 0; tt < 8; ++tt) { const int t = tw * 8 + tt; float sacc[8];
#pragma unroll
            for (int j = 0; j < 8; ++j) sacc[j] = 0.f;
#pragma unroll 4
            for (int kk = 0; kk < 16; ++kk) { const int k = lane + 64 * kk; const float x = bf2f(XB[(size_t)t * 1024 + k]);
                const f32x4 w0 = *(const f32x4*)(W8 + k * 8), w1 = *(const f32x4*)(W8 + k * 8 + 4);
#pragma unroll
                for (int j = 0; j < 4; ++j) { sacc[j] += x * w0[j]; sacc[4 + j] += x * w1[j]; } }
#pragma unroll
            for (int j = 0; j < 8; ++j) {
#pragma unroll
                for (int o = 32; o >= 1; o >>= 1) sacc[j] += __shfl_xor(sacc[j], o); }
            const int hh = lane & 3;
            const float ipre = hh == 0 ? sacc[0] : hh == 1 ? sacc[1] : hh == 2 ? sacc[2] : sacc[3], fpre = hh == 0 ? sacc[4] : hh == 1 ? sacc[5] : hh == 2 ? sacc[6] : sacc[7];
            if ((lane >> 2) == tt) { myli = ipre + a.in[7][l * 4 + hh]; mylf = logsigmoidf_(fpre + a.in[8][l * 4 + hh]); }
        }
        if (lane < 32) { LI[tw * 32 + lane] = myli; LF[tw * 32 + lane] = mylf; }
    }
}

#define XB_TMO      128
#define XB_XCNT(j)  (256  + 64 * (j))
#define XB_XSUB(j)  (1280 + 64 * (j))
#define XB_XGEN(j)  (2304 + 64 * (j))
#define XB_TOP      3328
#define XB_TOPGEN   3392
#define XCD_BAR_WORDS 3456
#define XB_SPIN_CAP (1u << 22)
__device__ __forceinline__ unsigned xb_ld(unsigned* p)              { return __hip_atomic_load(p, __ATOMIC_RELAXED, __HIP_MEMORY_SCOPE_AGENT); }
__device__ __forceinline__ unsigned xb_add(unsigned* p, unsigned v) { return __hip_atomic_fetch_add(p, v, __ATOMIC_RELAXED, __HIP_MEMORY_SCOPE_AGENT); }
__device__ __forceinline__ unsigned xb_xcc_id() { return (unsigned)__builtin_amdgcn_s_getreg((3 << 11) | 20) & 0xFu; }
#define XB_SPIN(cond, bar) do { unsigned _sp = 0; while (cond) { __builtin_amdgcn_s_sleep(1); \
    if ((++_sp & 255u) == 0u) { if (xb_ld(&(bar)[XB_TMO])) break; if (_sp > XB_SPIN_CAP) { atomicAdd(&(bar)[XB_TMO], 1u); break; } } } } while (0)
__device__ __forceinline__ void xcd_barrier_complete(unsigned* bar, unsigned x, unsigned& nloc, unsigned& nx) {
    const unsigned G = gridDim.x; unsigned sum, cnt, mine, sp = 0u;
    for (;;) { sum = 0u; cnt = 0u; mine = 0u;
#pragma unroll
        for (unsigned j = 0; j < 16; ++j) { const unsigned c = xb_ld(&bar[XB_XCNT(j)]); sum += c; cnt += (c > 0u) ? 1u : 0u; mine = (j == x) ? c : mine; }
        if (sum == G) break;
        __builtin_amdgcn_s_sleep(1);
        if ((++sp & 255u) == 0u) { if (xb_ld(&bar[XB_TMO])) break; if (sp > XB_SPIN_CAP) { atomicAdd(&bar[XB_TMO], 1u); break; } } }
    nloc = mine > 0u ? mine : 1u; nx = cnt > 0u ? cnt : 1u;
}
__device__ __forceinline__ void xcd_barrier(unsigned* bar, volatile __attribute__((address_space(3))) unsigned* st) {
    asm volatile("s_waitcnt vmcnt(0)" ::: "memory");
    __syncthreads();
    if (threadIdx.x == 0) {
        __builtin_amdgcn_s_waitcnt(0);
        const unsigned x = xb_xcc_id();
        unsigned nloc = st[0], nx = st[1];
        if (nloc == 0u) { xcd_barrier_complete(bar, x, nloc, nx); st[0] = nloc; st[1] = nx; }
        const unsigned old = xb_add(&bar[XB_XSUB(x)], 1u);
        const unsigned gen = old / nloc;
        if (old + 1u == (gen + 1u) * nloc) {
            __builtin_amdgcn_fence(__ATOMIC_RELEASE, "agent");
            asm volatile("s_waitcnt vmcnt(0)" ::: "memory");
            const unsigned og = xb_add(&bar[XB_TOP], 1u);
            const unsigned tg = og / nx;
            if (og + 1u == (tg + 1u) * nx) xb_add(&bar[XB_TOPGEN], 1u);
            else XB_SPIN(xb_ld(&bar[XB_TOPGEN]) == tg, bar);
            __builtin_amdgcn_fence(__ATOMIC_ACQUIRE, "agent");
            xb_add(&bar[XB_XGEN(x)], 1u);
            asm volatile("s_waitcnt vmcnt(0)" ::: "memory");
        } else {
            XB_SPIN(xb_ld(&bar[XB_XGEN(x)]) == gen, bar);
            __builtin_amdgcn_fence(__ATOMIC_ACQUIRE, "agent");
            asm volatile("s_waitcnt vmcnt(0)" ::: "memory");
        }
    }
    __syncthreads();
}

__device__ __forceinline__ ArgsRef fresh_args() { unsigned long long p = (unsigned long long)__builtin_amdgcn_kernarg_segment_ptr(); asm volatile("" : "+s"(p)); return *(const __attribute__((address_space(4))) Args*)p; }
__global__ void __launch_bounds__(512) fwd(Args a_unused) {
    cg::grid_group grid = cg::this_grid();
    volatile __attribute__((address_space(3))) unsigned* bst = (volatile __attribute__((address_space(3))) unsigned*)((__attribute__((address_space(3))) unsigned char*)smem + 131072);
    if (threadIdx.x < 4) bst[threadIdx.x] = 0u;
    __syncthreads();
    { ArgsRef a0 = fresh_args(); if (threadIdx.x == 0) (void)xb_add(&((unsigned*)(a0.ws + OFF_BAR))[XB_XCNT(xb_xcc_id())], 1u); }
#define GSYNC() do { asm volatile("" ::: "memory"); { ArgsRef ab = fresh_args(); xcd_barrier((unsigned*)(ab.ws + OFF_BAR), bst); } asm volatile("" ::: "memory"); } while (0)
#define GSYNC_CG() do { asm volatile("" ::: "memory"); grid.sync(); asm volatile("" ::: "memory"); } while (0)
    const int wave_s = __builtin_amdgcn_readfirstlane((int)threadIdx.x >> 6);
#define PH(body) do { int wave = wave_s; asm volatile("" : "+s"(wave)); int lane; asm volatile("v_mbcnt_lo_u32_b32 %0, -1, 0\n\tv_mbcnt_hi_u32_b32 %0, -1, %0" : "=v"(lane)); \
        int bid = blockIdx.x, G = gridDim.x; asm volatile("" : "+s"(bid), "+s"(G)); \
        const int tid = wave * 64 + lane, gw = bid * 8 + wave, GW = G * 8; (void)tid; (void)gw; (void)GW; ArgsRef a = fresh_args(); body; } while (0)
#pragma unroll 1
    for (int l = 0; l < NLAYER; ++l) {
        PH(phase_prep(a, l, tid, bid, G)); if (l == 0) GSYNC_CG(); else GSYNC();
        PH(phase_zgemm2(a, tid, bid, G)); GSYNC();
        PH(phase_mprep2(a, l, tid, lane, wave, bid, G)); GSYNC();
        PH(phase_mqkv2(a, tid, bid, G)); GSYNC();
        PH(phase_mixers<1>(a, l, tid, lane, wave, bid, G)); GSYNC();
        PH(phase_mixers<2>(a, l, tid, lane, wave, bid, G)); GSYNC();
        PH(phase_post(a, l, lane, gw, GW)); GSYNC();
        PH(phase_glu_gates(a, tid, bid, G)); PH(phase_prepx(a, l, tid, bid, G)); GSYNC();
        PH(phase_merge2(a, tid, bid, G)); GSYNC();
        PH(phase_wout2(a, l, tid, bid, G)); GSYNC();
        PH(phase_ln1r(a, l, tid, lane, wave, bid, G)); GSYNC();
        PH(phase_slot(a, tid, lane, wave, bid, G)); GSYNC();
        PH(phase_moe_gu2(a, tid, bid, G)); GSYNC();
        PH(phase_moe_dn2(a, tid, bid, G)); GSYNC();
        PH(phase_ln2(a, l, lane, gw, GW)); if (l + 1 < NLAYER) GSYNC();
    }
}

extern "C" void kernel_launch(void* const* d_in, const int* in_sizes, int n_in, void* d_out, int out_size, void* d_ws, size_t ws_size, hipStream_t stream) {
    static int grid = 0;
    if (grid == 0) {
        if (n_in != 34 || out_size != T * D || ws_size < WS_TOTAL) { fprintf(stderr, "kernel_launch: unexpected shapes (n_in %d, out %d, ws %zu, need %zu)\n", n_in, out_size, ws_size, (size_t)WS_TOTAL); grid = -1; return; }
        int dev = 0, cus = 0, per_cu = 0;
        (void)hipGetDevice(&dev); (void)hipDeviceGetAttribute(&cus, hipDeviceAttributeMultiprocessorCount, dev);
        (void)hipFuncSetAttribute((const void*)fwd, hipFuncAttributeMaxDynamicSharedMemorySize, LDS_BYTES);
        (void)hipOccupancyMaxActiveBlocksPerMultiprocessor(&per_cu, (const void*)fwd, 512, LDS_BYTES);
        if (per_cu < 1) { fprintf(stderr, "kernel_launch: occupancy query says %d blocks per CU\n", per_cu); per_cu = 1; }
        grid = (cus > 0 ? cus : 256) * 1;
        (void)hipGetLastError();
    }
    if (grid < 0) return;
    Args a{};
    for (int i = 0; i < 34; ++i) a.in[i] = (const float*)d_in[i];
    a.out = (float*)d_out; a.ws = (unsigned char*)d_ws; a.ph_lo = 0; a.ph_hi = NLAYER * NPH;
    (void)hipMemsetAsync((unsigned char*)d_ws + OFF_BAR, 0, 16384, stream);
    void* args[] = {&a};
    hipError_t e = hipLaunchCooperativeKernel((const void*)fwd, dim3(grid), dim3(512), args, LDS_BYTES, stream);
    if (e != hipSuccess) fprintf(stderr, "kernel_launch: cooperative launch failed: %s (grid %d)\n", hipGetErrorString(e), grid);
}
```

```cpp
#include <hip/hip_runtime.h>
#include <hip/hip_cooperative_groups.h>
#include <cstdio>
#include <cstdint>
namespace cg = cooperative_groups;

typedef unsigned short bf16_t;
typedef short bf16x8 __attribute__((ext_vector_type(8)));
typedef short bf16x4 __attribute__((ext_vector_type(4)));
typedef float f32x4 __attribute__((ext_vector_type(4)));
typedef unsigned u32x4 __attribute__((ext_vector_type(4)));
typedef unsigned u32x2 __attribute__((ext_vector_type(2)));

constexpr int T = 16384, D = 1024, NZ = 3584, NWIN = 6912, INW = 6664;
constexpr int NPH = 15, NLAYER = 2;
constexpr int GSEG = 32, GSEGLEN = 512;
constexpr int SSEG = 64, SSEGLEN = 256;
constexpr int SLOTS = 40960;
constexpr float DN_ALPHA = 1.41421356237f;
constexpr int LDS_BYTES = 131072 + 256;

constexpr size_t AL(size_t x) { return (x + 255) & ~(size_t)255; }
constexpr size_t OFF_WIN = 0;
constexpr size_t OFF_WQKV = OFF_WIN + AL((size_t)NWIN * 1024 * 2);
constexpr size_t OFF_WGLU = OFF_WQKV + AL((size_t)1536 * 512 * 2);
constexpr size_t OFF_WB = OFF_WGLU + AL((size_t)512 * 512 * 2);
constexpr size_t OFF_WOUT = OFF_WB + AL((size_t)3 * 1024 * 512 * 2);
constexpr size_t OFF_ABAR = OFF_WOUT + AL((size_t)1024 * 1024 * 2);
constexpr size_t OFF_BBT = OFF_ABAR + AL((size_t)32 * 64 * 2 * 4);
constexpr size_t OFF_CCT = OFF_BBT + AL((size_t)32 * 128 * 16 * 2);
constexpr size_t OFF_CTL = OFF_CCT + AL((size_t)32 * 16 * 128 * 2);
constexpr size_t OFF_TOKE = OFF_CTL + 4096;
constexpr size_t OFF_TOKG = OFF_TOKE + AL((size_t)T * 2 * 4);
constexpr size_t OFF_TOKS = OFF_TOKG + AL((size_t)T * 2 * 4);
constexpr size_t OFF_SLOTT = OFF_TOKS + AL((size_t)T * 2 * 4);
constexpr size_t OFF_XB = OFF_SLOTT + AL((size_t)SLOTS * 4);
constexpr size_t OFF_R1 = OFF_XB + AL((size_t)T * 1024 * 2);
constexpr size_t SZ_ACT = (size_t)T * 512 * 2;
constexpr size_t OFF_XC = OFF_R1, OFF_Q = OFF_R1 + SZ_ACT, OFF_KH = OFF_R1 + 2 * SZ_ACT, OFF_V = OFF_R1 + 3 * SZ_ACT;
constexpr size_t OFF_WGU = OFF_R1, OFF_WD = OFF_R1 + (size_t)32 * 512 * 1024 * 2;
constexpr size_t OFF_Z = OFF_R1 + 4 * SZ_ACT;
constexpr size_t OFF_XG = OFF_Z, OFF_H = OFF_Z + (size_t)SLOTS * 1024 * 2;
constexpr size_t OFF_ZS = OFF_Z + AL((size_t)T * NZ * 2);
constexpr size_t OFF_LF = OFF_ZS + AL((size_t)T * 8 * 4);
constexpr size_t OFF_LI = OFF_LF + AL((size_t)T * 4 * 4);
constexpr size_t OFF_E = OFF_LI + AL((size_t)T * 4 * 4);
constexpr size_t OFF_OM = OFF_E, OFF_OH = OFF_E + SZ_ACT, OFF_YPRE = OFF_E + 2 * SZ_ACT, OFF_YSG = OFF_E + 3 * SZ_ACT;
constexpr size_t OFF_DEN = OFF_E + 4 * SZ_ACT;
constexpr size_t OFF_EM = OFF_DEN + AL((size_t)T * 4 * 4);
constexpr size_t OFF_EMX = OFF_EM + AL((size_t)GSEG * 4 * 128 * 128 * 4);
constexpr size_t OFF_GM = OFF_EMX + AL((size_t)GSEG * 4 * 128 * 16 * 4);
constexpr size_t OFF_EH = OFF_GM + AL((size_t)GSEG * 4 * 128 * 4);
constexpr size_t OFF_GH = OFF_EH + AL((size_t)GSEG * 4 * 128 * 128 * 4);
constexpr size_t OFF_ES = OFF_GH + AL((size_t)GSEG * 4 * 128 * 4);
constexpr size_t WS_END = OFF_ES + AL((size_t)SSEG * 32 * 64 * 2 * 4);
constexpr size_t OFF_YS = OFF_E;
constexpr size_t OFF_RWT = WS_END;
constexpr size_t OFF_HIST = OFF_RWT + 32 * 1024 * 4;
constexpr size_t OFF_BAR = OFF_HIST + 1024 * 32 * 4;
constexpr size_t WS_TOTAL = OFF_BAR + 16384;
static_assert(OFF_YS + (size_t)SLOTS * 1024 * 2 <= WS_END, "YS must fit in the dead region");
static_assert(OFF_H + (size_t)SLOTS * 256 * 2 <= OFF_ZS, "H must fit in the dead Z region");
static_assert(OFF_WD + (size_t)32 * 1024 * 256 * 2 <= OFF_Z, "expert weights must fit in R1");

struct Args { const float* in[34]; float* out; unsigned char* ws; int ph_lo, ph_hi; };
typedef const __attribute__((address_space(4))) Args& ArgsRef;

extern __shared__ __attribute__((aligned(16))) unsigned char smem[];

__device__ __forceinline__ bf16_t f2bf(float f) { unsigned u = __float_as_uint(f); u += 0x7FFFu + ((u >> 16) & 1u); return (bf16_t)(u >> 16); }
__device__ __forceinline__ float bf2f(bf16_t b) { return __uint_as_float(((unsigned)b) << 16); }
__device__ __forceinline__ unsigned pack2(float lo, float hi) { return (unsigned)f2bf(lo) | ((unsigned)f2bf(hi) << 16); }
__device__ __forceinline__ float sigmoidf_(float x) { return 1.0f / (1.0f + expf(-x)); }
__device__ __forceinline__ float siluf_(float x) { return x / (1.0f + expf(-x)); }
__device__ __forceinline__ float logsigmoidf_(float x) { return fminf(x, 0.f) - log1pf(expf(-fabsf(x))); }
__device__ __forceinline__ float gelu_tanh(float y) { const float z = 0.7978845608028654f * (y + 0.044715f * y * y * y); const float th = 1.0f - 2.0f / (expf(2.0f * z) + 1.0f); return 0.5f * y * (1.0f + th); }
__device__ __forceinline__ void wave_sync() { __builtin_amdgcn_wave_barrier(); asm volatile("s_waitcnt lgkmcnt(0)" ::: "memory"); __builtin_amdgcn_wave_barrier(); }

#define MFMA16(a, b, c) __builtin_amdgcn_mfma_f32_16x16x32_bf16((a), (b), (c), 0, 0, 0)

template <int MT, int NT, class FA, class FB>
__device__ __forceinline__ void wave_gemm(f32x4 (&acc)[MT][NT], int K, FA arow, FB brow, int lane) {
    const int r = lane & 15, q = lane >> 4;
    const bf16_t* ap[MT]; const bf16_t* bp[NT];
#pragma unroll
    for (int m = 0; m < MT; ++m) ap[m] = arow(m * 16 + r) + 8 * q;
#pragma unroll
    for (int n = 0; n < NT; ++n) bp[n] = brow(n * 16 + r) + 8 * q;
#pragma unroll 1
    for (int k = 0; k < K; k += 32) {
        bf16x8 a[MT], b[NT];
#pragma unroll
        for (int m = 0; m < MT; ++m) a[m] = *(const bf16x8*)(ap[m] + k);
#pragma unroll
        for (int n = 0; n < NT; ++n) b[n] = *(const bf16x8*)(bp[n] + k);
#pragma unroll
        for (int m = 0; m < MT; ++m)
#pragma unroll
            for (int n = 0; n < NT; ++n) acc[m][n] = MFMA16(a[m], b[n], acc[m][n]);
    }
}
template <int MT, int NT> __device__ __forceinline__ void zero_acc(f32x4 (&acc)[MT][NT]) {
#pragma unroll
    for (int m = 0; m < MT; ++m)
#pragma unroll
        for (int n = 0; n < NT; ++n) acc[m][n] = (f32x4){0.f, 0.f, 0.f, 0.f};
}

namespace pg8 {
#define PG8_LAS __attribute__((address_space(3)))
constexpr int BM = 256, BK = 64, HALF = 128, HTB = HALF * BK * 2, STAGE_BYTES = 8 * HTB;
__device__ __forceinline__ int lds_byte(int r, int c) { const int st = (r >> 4) * 2 + (c >> 5), rr = r & 15, cc = c & 31, ob = rr * 64 + cc * 2; return st * 1024 + (ob ^ (((ob >> 9) & 1) << 5)); }
__device__ __forceinline__ void stage_rc(int b, int& R, int& C) { const int st = b / 1024, sb = b % 1024, swz = sb ^ (((sb >> 9) & 1) << 5); R = (st >> 1) * 16 + swz / 64; C = (st & 1) * 32 + (swz % 64) / 2; }
__device__ __forceinline__ int perm32(int rho) { const int n = rho >> 4, i = rho & 15; return 8 * (i >> 2) + 4 * n + (i & 3); }
struct Unit { int pm, pn, tag; const char* A; const char* B; };
__device__ __forceinline__ unsigned cvt_pk_bf16(float lo, float hi) { unsigned r; asm volatile("v_cvt_pk_bf16_f32 %0, %1, %2" : "=v"(r) : "v"(lo), "v"(hi)); return r; }
__device__ __forceinline__ bool tile_order(int L, int nM, int nN, int& pm, int& pn) {
    const int nwg = nM * nN; if (L >= nwg) return false;
    int wgid = L; { const int q = nwg / 8, r = nwg % 8, xcd = wgid % 8, off = wgid / 8; wgid = (xcd < r ? xcd * (q + 1) : r * (q + 1) + (xcd - r) * q) + off; }
    const int nig = 8 * nN, gid = wgid / nig, fm = gid * 8, gsz = (nM - fm) < 8 ? (nM - fm) : 8;
    pm = fm + ((wgid % nig) % gsz); pn = (wgid % nig) / gsz; return true;
}
template <class Epi, class Sched>
__device__ __forceinline__ void gemm_phase(PG8_LAS unsigned char* lds, const int tid, const int K, const int lda, const int ldb, const Sched& S, const Epi& E) {
    const int wid = __builtin_amdgcn_readfirstlane(tid >> 6), lane = tid & 63, wr = wid >> 2, wc = wid & 3, fr = lane & 15, fq = lane >> 4;
    const int nt = K / BK;
    unsigned voffA[2], voffB[2];
#pragma unroll
    for (int i = 0; i < 2; ++i) { int R, C; stage_rc(tid * 16 + i * 8192, R, C); const int Rb = Epi::PERM ? ((R & ~31) + perm32(R & 31)) : R;
        voffA[i] = (unsigned)(R * lda + C) * 2u; voffB[i] = (unsigned)(Rb * ldb + C) * 2u; }
    const size_t kstep = (size_t)(BK * 2), hstepA = (size_t)HALF * lda * 2, hstepB = (size_t)HALF * ldb * 2;
    const unsigned ldsw = (unsigned)wid * 1024u;
    const int aoff = lds_byte(wr * 64 + fr, fq * 8), boff = lds_byte(wc * 32 + fr, fq * 8);
#define PG8_SA(b, h) (((b) * 2 + (h)) * HTB)
#define PG8_SB(b, h) ((4 + (b) * 2 + (h)) * HTB)
#define PG8_STAGE(bufoff, gbase, voff) do { _Pragma("unroll") for (int _i = 0; _i < 2; ++_i) \
        __builtin_amdgcn_global_load_lds((const unsigned*)((const char*)(gbase) + (voff)[_i]), (PG8_LAS unsigned*)(lds + (bufoff) + ldsw + _i * 8192), 16, 0, 0); } while (0)
#define PG8_LDA(dst, b, h) do { _Pragma("unroll") for (int m = 0; m < 4; ++m) _Pragma("unroll") for (int k = 0; k < 2; ++k) dst[m][k] = *(const PG8_LAS bf16x8*)(lds + PG8_SA(b, h) + aoff + m * 2048 + k * 1024); } while (0)
#define PG8_LDB(dst, b, h) do { _Pragma("unroll") for (int n = 0; n < 2; ++n) _Pragma("unroll") for (int k = 0; k < 2; ++k) dst[n][k] = *(const PG8_LAS bf16x8*)(lds + PG8_SB(b, h) + boff + n * 2048 + k * 1024); } while (0)
#define PG8_MMA(ai, bj, At, Bt) do { __builtin_amdgcn_s_setprio(1); _Pragma("unroll") for (int m = 0; m < 4; ++m) _Pragma("unroll") for (int n = 0; n < 2; ++n) _Pragma("unroll") for (int k = 0; k < 2; ++k) \
        acc[ai][bj][m][n] = __builtin_amdgcn_mfma_f32_16x16x32_bf16(Bt[n][k], At[m][k], acc[ai][bj][m][n], 0, 0, 0); __builtin_amdgcn_s_setprio(0); } while (0)
#define PG8_WAIT_V(n) asm volatile("s_waitcnt vmcnt(" #n ")" ::: "memory")
#define PG8_WAIT_L(n) asm volatile("s_waitcnt lgkmcnt(" #n ")" ::: "memory")
#define PG8_BAR __builtin_amdgcn_s_barrier()
#define PG8_SCHED __builtin_amdgcn_sched_barrier(0)
    Unit cur, nxt; int ui = 0;
    if (!S.next(0, cur)) return;
    f32x4 acc[2][2][4][2];
#pragma unroll
    for (int a = 0; a < 2; ++a)
#pragma unroll
        for (int b = 0; b < 2; ++b)
#pragma unroll
            for (int m = 0; m < 4; ++m)
#pragma unroll
                for (int n = 0; n < 2; ++n) acc[a][b][m][n] = (f32x4){0.f, 0.f, 0.f, 0.f};
    bf16x8 At[4][2], B0[2][2], B1[2][2];
    const char* cA = cur.A; const char* cB = cur.B;
    PG8_STAGE(PG8_SB(0, 0), cB, voffB); PG8_STAGE(PG8_SA(0, 0), cA, voffA); PG8_STAGE(PG8_SB(0, 1), cB + hstepB, voffB); PG8_STAGE(PG8_SA(0, 1), cA + hstepA, voffA);
    if (wr == 1) PG8_BAR;
    PG8_WAIT_V(4); PG8_BAR;
    PG8_STAGE(PG8_SB(1, 0), cB + kstep, voffB); PG8_STAGE(PG8_SA(1, 0), cA + kstep, voffA); PG8_STAGE(PG8_SB(1, 1), cB + hstepB + kstep, voffB);
    PG8_WAIT_V(6); PG8_BAR;
    for (;;) {
        const bool has_next = S.next(ui + 1, nxt);
        const char* nA = has_next ? nxt.A : cA; const char* nB = has_next ? nxt.B : cB;
        for (int t = 0; t < nt; t += 2) {
            const bool last = (t == nt - 2);
            const char* a1 = cA + (size_t)(t + 1) * kstep;
            const char* a2 = last ? nA : cA + (size_t)(t + 2) * kstep; const char* b2 = last ? nB : cB + (size_t)(t + 2) * kstep;
            const char* a3 = a2 + kstep; const char* b3 = b2 + kstep;
            PG8_LDB(B0, 0, 0); PG8_SCHED; PG8_LDA(At, 0, 0); PG8_STAGE(PG8_SA(1, 1), a1 + hstepA, voffA);
            PG8_WAIT_L(8); PG8_BAR; PG8_WAIT_L(0); PG8_MMA(0, 0, At, B0); PG8_BAR; PG8_SCHED;
            PG8_LDB(B1, 0, 1); PG8_STAGE(PG8_SB(0, 0), b2, voffB);
            PG8_BAR; PG8_WAIT_L(0); PG8_MMA(0, 1, At, B1); PG8_BAR;
            PG8_LDA(At, 0, 1); PG8_STAGE(PG8_SA(0, 0), a2, voffA);
            PG8_BAR; PG8_WAIT_L(0); PG8_MMA(1, 0, At, B0); PG8_BAR; PG8_SCHED;
            PG8_STAGE(PG8_SB(0, 1), b2 + hstepB, voffB);
            PG8_WAIT_V(6); PG8_BAR; PG8_MMA(1, 1, At, B1); PG8_BAR;
            PG8_LDB(B0, 1, 0); PG8_SCHED; PG8_LDA(At, 1, 0); PG8_STAGE(PG8_SA(0, 1), a2 + hstepA, voffA);
            PG8_WAIT_L(8); PG8_BAR; PG8_WAIT_L(0); PG8_MMA(0, 0, At, B0); PG8_BAR; PG8_SCHED;
            PG8_LDB(B1, 1, 1); PG8_STAGE(PG8_SB(1, 0), b3, voffB);
            PG8_BAR; PG8_WAIT_L(0); PG8_MMA(0, 1, At, B1); PG8_BAR;
            PG8_LDA(At, 1, 1); PG8_STAGE(PG8_SA(1, 0), a3, voffA);
            PG8_BAR; PG8_WAIT_L(0); PG8_MMA(1, 0, At, B0); PG8_BAR; PG8_SCHED;
            PG8_STAGE(PG8_SB(1, 1), b3 + hstepB, voffB);
            PG8_WAIT_V(6); PG8_BAR; PG8_MMA(1, 1, At, B1); PG8_BAR;
        }
        const bool keep = E(acc, cur, wr, wc, fr, fq);
        if (!has_next) break;
        if (!keep) {
#pragma unroll
            for (int a = 0; a < 2; ++a)
#pragma unroll
                for (int b = 0; b < 2; ++b)
#pragma unroll
                    for (int m = 0; m < 4; ++m)
#pragma unroll
                        for (int n = 0; n < 2; ++n) acc[a][b][m][n] = (f32x4){0.f, 0.f, 0.f, 0.f};
        }
        cur = nxt; cA = nA; cB = nB; ++ui;
    }
    PG8_WAIT_V(0);
    if (wr == 0) PG8_BAR;
    PG8_BAR;
#undef PG8_SA
#undef PG8_SB
#undef PG8_STAGE
#undef PG8_LDA
#undef PG8_LDB
#undef PG8_MMA
#undef PG8_WAIT_V
#undef PG8_WAIT_L
#undef PG8_BAR
#undef PG8_SCHED
}
}

__device__ __forceinline__ void tconv_tile(const float* src, int ld_src, int nvalid, bf16_t* dst, int ld_dst, int tid) {
    float* t = (float*)smem;
    { const int r = tid >> 3, c0 = (tid & 7) * 8;
#pragma unroll
      for (int j = 0; j < 8; ++j) { const int c = c0 + j; const float v = (c < nvalid) ? src[(size_t)r * ld_src + c] : 0.f; t[c * 65 + r] = v; } }
    __syncthreads();
    { const int n = tid >> 3, k0 = (tid & 7) * 8; const float* p = t + n * 65 + k0;
      u32x4 w; w.x = pack2(p[0], p[1]); w.y = pack2(p[2], p[3]); w.z = pack2(p[4], p[5]); w.w = pack2(p[6], p[7]);
      *(u32x4*)(dst + (size_t)n * ld_dst + k0) = w; }
    __syncthreads();
}

__device__ __forceinline__ void phase_prep(ArgsRef a, int l, int tid, int bid, int G) {
    unsigned char* ws = a.ws;
    bf16_t* WIN = (bf16_t*)(ws + OFF_WIN); bf16_t* WQKV = (bf16_t*)(ws + OFF_WQKV); bf16_t* WGLU = (bf16_t*)(ws + OFF_WGLU);
    bf16_t* WB = (bf16_t*)(ws + OFF_WB); bf16_t* WOUT = (bf16_t*)(ws + OFF_WOUT);
    for (int u = bid; u < 2624; u += G) {
        const float* src; int lds_ = 0, nvalid = 64, ldd = 0; bf16_t* dst;
        if (u < 1728) { const int nt = u / 16, kt = u % 16, p0 = nt * 64; int sc;
            if (p0 < 1024) sc = p0; else if (p0 < 6656) sc = p0 + 8; else if (p0 == 6656) { sc = 1024; nvalid = 8; } else { sc = 0; nvalid = 0; }
            src = a.in[1] + (size_t)l * 1024 * INW + (size_t)(kt * 64) * INW + sc; lds_ = INW; dst = WIN + (size_t)p0 * 1024 + kt * 64; ldd = 1024; }
        else if (u < 1920) { const int v = u - 1728, nt = v / 8, kt = v % 8, which = nt / 8, h = (nt % 8) / 2;
            if ((kt >> 1) != h) nvalid = 0;
            src = a.in[4 + which] + (size_t)(l * 4 + h) * 128 * 128 + ((kt & 1) * 64) * 128 + (nt & 1) * 64; lds_ = 128; dst = WQKV + (size_t)(nt * 64) * 512 + kt * 64; ldd = 512; }
        else if (u < 1984) { const int v = u - 1920, nt = v / 8, kt = v % 8;
            src = a.in[18] + (size_t)l * 512 * 512 + (kt * 64) * 512 + nt * 64; lds_ = 512; dst = WGLU + (size_t)(nt * 64) * 512 + kt * 64; ldd = 512; }
        else if (u < 2368) { const int v = u - 1984, b = v / 128, w = v % 128, nt = w / 8, kt = w % 8;
            src = a.in[21 + b] + (size_t)l * 512 * 1024 + (size_t)(kt * 64) * 1024 + nt * 64; lds_ = 1024; dst = WB + (size_t)b * 1024 * 512 + (size_t)(nt * 64) * 512 + kt * 64; ldd = 512; }
        else { const int v = u - 2368, nt = v / 16, kt = v % 16;
            src = a.in[24] + (size_t)l * 1024 * 1024 + (size_t)(kt * 64) * 1024 + nt * 64; lds_ = 1024; dst = WOUT + (size_t)(nt * 64) * 1024 + kt * 64; ldd = 1024; }
        tconv_tile(src, lds_, nvalid, dst, ldd, tid);
    }
    float* ABAR = (float*)(ws + OFF_ABAR); bf16_t* BBT = (bf16_t*)(ws + OFF_BBT); bf16_t* CCT = (bf16_t*)(ws + OFF_CCT);
    for (int i = bid * 512 + tid; i < 2048; i += G * 512) {
        const int g = i / 64, p = i % 64; const size_t gp = (size_t)(l * 32 + g) * 64 + p;
        const float lr = fminf(a.in[10][gp], -1e-4f), li = a.in[11][gp], dt = expf(a.in[12][l * 32 + g]);
        const float mag = expf(lr * dt), abr = mag * cosf(li * dt), abi = mag * sinf(li * dt);
        const float nr = abr - 1.0f, den = lr * lr + li * li, cr = (nr * lr + abi * li) / den, ci = (abi * lr - nr * li) / den;
        ABAR[(g * 64 + p) * 2] = abr; ABAR[(g * 64 + p) * 2 + 1] = abi;
        for (int c = 0; c < 16; ++c) { const float br = a.in[13][gp * 16 + c], bi = a.in[14][gp * 16 + c];
            BBT[(size_t)(g * 128 + p) * 16 + c] = f2bf(cr * br - ci * bi); BBT[(size_t)(g * 128 + 64 + p) * 16 + c] = f2bf(cr * bi + ci * br);
            const size_t ci_ = ((size_t)(l * 32 + g) * 16 + c) * 64 + p;
            CCT[(size_t)(g * 16 + c) * 128 + p] = f2bf(a.in[15][ci_]); CCT[(size_t)(g * 16 + c) * 128 + 64 + p] = f2bf(-a.in[16][ci_]); }
    }
    { float* RWT = (float*)(ws + OFF_RWT); const float* RW = a.in[29]; for (int i = bid * 512 + tid; i < 32 * 1024; i += G * 512) RWT[i] = RW[(i & 1023) * 32 + (i >> 10)]; }
    if (bid == 0 && tid < 128) ((unsigned*)(ws + OFF_CTL))[tid] = 0u;
    if (l == 0) { bf16_t* XB = (bf16_t*)(ws + OFF_XB); const float* x = a.in[0];
        for (size_t i = (size_t)bid * 512 + tid; i < (size_t)T * 1024 / 8; i += (size_t)G * 512) {
            const f32x4 v0 = *(const f32x4*)(x + i * 8), v1 = *(const f32x4*)(x + i * 8 + 4);
            u32x4 w; w.x = pack2(v0[0], v0[1]); w.y = pack2(v0[2], v0[3]); w.z = pack2(v1[0], v1[1]); w.w = pack2(v1[2], v1[3]); *(u32x4*)(XB + i * 8) = w; } }
}

__device__ __forceinline__ void phase_prepx(ArgsRef a, int l, int tid, int bid, int G) {
    bf16_t* WGU = (bf16_t*)(a.ws + OFF_WGU); bf16_t* WD = (bf16_t*)(a.ws + OFF_WD);
    for (int u = bid; u < 6144; u += G) {
        const float* src; int lds_, ldd; bf16_t* dst;
        if (u < 4096) { const int up = u >= 2048, v = u & 2047, e = v / 64, w = v % 64, nt = w / 16, kt = w % 16, j0 = nt * 64, drow = (j0 / 128) * 256 + (j0 % 128) + up * 128;
            src = a.in[31 + up] + ((size_t)(l * 32 + e) * 1024 + kt * 64) * 256 + nt * 64; lds_ = 256; dst = WGU + ((size_t)e * 512 + drow) * 1024 + kt * 64; ldd = 1024; }
        else { const int v = u - 4096, e = v / 64, w = v % 64, nt = w / 4, kt = w % 4;
            src = a.in[33] + ((size_t)(l * 32 + e) * 256 + kt * 64) * 1024 + nt * 64; lds_ = 1024; dst = WD + ((size_t)e * 1024 + nt * 64) * 256 + kt * 64; ldd = 256; }
        tconv_tile(src, lds_, 64, dst, ldd, tid);
    }
}

constexpr int GL_QS = 0, GL_KS = 8704, GL_KT = 17408, GL_VT = 27648, GL_PS = 39168, GL_SC1 = 41728, GL_SC2 = 42240, GL_GT = 42752, GL_OS = 44800;
template <int MODE, int PASS>
__device__ __forceinline__ void gla_item(ArgsRef a, int l, int h, int sg, int tid, int lane, int wave) {
    unsigned char* ws = a.ws;
    const bf16_t* Z = (const bf16_t*)(ws + OFF_Z); const bf16_t* Qg = (const bf16_t*)(ws + OFF_Q); const bf16_t* Kg = (const bf16_t*)(ws + OFF_KH); const bf16_t* Vg = (const bf16_t*)(ws + OFF_V);
    const float* LF = (const float*)(ws + OFF_LF);
    float* Eg = (float*)(ws + (MODE == 0 ? OFF_EM : OFF_EH)); float* Gg = (float*)(ws + (MODE == 0 ? OFF_GM : OFF_GH)); float* EX = (float*)(ws + OFF_EMX);
    bf16_t* Og = (bf16_t*)(ws + (MODE == 0 ? OFF_OM : OFF_OH)); float* DEN = (float*)(ws + OFF_DEN);
    bf16_t* QS = (bf16_t*)(smem + GL_QS); bf16_t* KS = (bf16_t*)(smem + GL_KS); bf16_t* KT = (bf16_t*)(smem + GL_KT); bf16_t* VT = (bf16_t*)(smem + GL_VT); bf16_t* PS = (bf16_t*)(smem + GL_PS);
    float* SC1 = (float*)(smem + GL_SC1); float* SC2 = (float*)(smem + GL_SC2); float* GT = (float*)(smem + GL_GT); bf16_t* OS = (bf16_t*)(smem + GL_OS);
    const int r = lane & 15, q = lane >> 4, grp = tid >> 7, d = tid & 127;
    const bool xw = (MODE == 0) && (wave == 0);
    float lb = 0.f;
    if (MODE == 1 && l == 1) { const float h0 = a.in[19][h * 128 + d], h1 = a.in[19][512 + h * 128 + d]; lb = 1.0f / (1.0f + expf(h0 - h1)); }
    f32x4 S[8], SX[8];
#pragma unroll
    for (int i = 0; i < 8; ++i) { S[i] = (f32x4){0.f, 0.f, 0.f, 0.f}; SX[i] = (f32x4){0.f, 0.f, 0.f, 0.f}; }
    if (PASS == 2) {
        for (int j = 0; j < sg; ++j) {
#pragma unroll
            for (int i = 0; i < 8; ++i) { const f32x4 gv = *(const f32x4*)(Gg + (size_t)(j * 4 + h) * 128 + 16 * i + 4 * q);
#pragma unroll
                for (int g = 0; g < 4; ++g) { const size_t row = (size_t)(j * 4 + h) * 128 + 16 * i + 4 * q + g;
                    S[i][g] = gv[g] * S[i][g] + Eg[row * 128 + 16 * wave + r];
                    if (xw) SX[i][g] = gv[g] * SX[i][g] + EX[row * 16 + r]; } }
        }
    }
    __syncthreads();
    if (MODE == 0) { for (int i = tid; i < 16 * 40; i += 512) VT[128 * 40 + i] = (i < 32) ? (bf16_t)0x3F80 : (bf16_t)0; }
    float runb = 0.f;
    for (int ci = 0; ci < GSEGLEN / 32; ++ci) {
        const int t0 = sg * GSEGLEN + ci * 32, tb = t0 + grp * 8;
        float lg[8], qv[8], kv[8]; bf16_t vv[8];
#pragma unroll
        for (int j = 0; j < 8; ++j) {
            if (MODE == 1) { const size_t zo = (size_t)(tb + j) * NZ + h * 128 + d; const float qp = bf2f(Z[zo + 1536]), fp = bf2f(Z[zo + 2048]);
                const float f = lb + (1.0f - lb) * sigmoidf_(fp); lg[j] = logf(f); qv[j] = siluf_(qp); kv[j] = 1.0f - f; vv[j] = Z[zo + 2560]; }
            else { const size_t o = (size_t)(tb + j) * 512 + h * 128 + d; qv[j] = bf2f(Qg[o]); kv[j] = bf2f(Kg[o]); vv[j] = Vg[o]; lg[j] = LF[(tb + j) * 4 + h]; }
        }
        float cs[8]; cs[0] = lg[0];
#pragma unroll
        for (int j = 1; j < 8; ++j) cs[j] = cs[j - 1] + lg[j];
        GT[grp * 128 + d] = cs[7];
        __syncthreads();
        if (PASS == 2 && ci > 0) { const int row = tid >> 4, c8 = (tid & 15) * 8; *(u32x4*)(Og + (size_t)(t0 - 32 + row) * 512 + h * 128 + c8) = *(const u32x4*)(OS + row * 136 + c8); }
        const float g0 = GT[d], g1 = GT[128 + d], g2 = GT[256 + d], g3 = GT[384 + d];
        const float off = grp == 0 ? 0.f : grp == 1 ? g0 : grp == 2 ? g0 + g1 : g0 + g1 + g2;
        const float bmid = g0 + g1, bL = bmid + g2 + g3;
        bf16_t ktv[8];
#pragma unroll
        for (int j = 0; j < 8; ++j) { const float bt = off + cs[j]; const bf16_t kt = f2bf(kv[j] * expf(bmid - bt)); ktv[j] = kt;
            if (PASS == 2) { QS[(grp * 8 + j) * 136 + d] = f2bf(qv[j] * expf(bt - bmid)); KS[(grp * 8 + j) * 136 + d] = kt; } }
        { u32x4 w; w.x = ktv[0] | ((unsigned)ktv[1] << 16); w.y = ktv[2] | ((unsigned)ktv[3] << 16); w.z = ktv[4] | ((unsigned)ktv[5] << 16); w.w = ktv[6] | ((unsigned)ktv[7] << 16); *(u32x4*)(KT + d * 40 + grp * 8) = w;
          u32x4 x; x.x = vv[0] | ((unsigned)vv[1] << 16); x.y = vv[2] | ((unsigned)vv[3] << 16); x.z = vv[4] | ((unsigned)vv[5] << 16); x.w = vv[6] | ((unsigned)vv[7] << 16); *(u32x4*)(VT + d * 40 + grp * 8) = x; }
        if (grp == 0) { SC1[d] = expf(bmid); SC2[d] = expf(bL - bmid); runb += bL; }
        __syncthreads();
        if (PASS == 2) {
            if (wave < 4) {
                const int ti = (wave == 1 || wave == 2) ? 1 : 0, tj = (wave >= 2) ? 1 : 0;
                f32x4 p = (f32x4){0.f, 0.f, 0.f, 0.f};
                if (wave < 3) {
#pragma unroll
                    for (int kk = 0; kk < 4; ++kk) { const bf16x8 av = *(const bf16x8*)(QS + (16 * ti + r) * 136 + 32 * kk + 8 * q); const bf16x8 bv = *(const bf16x8*)(KS + (16 * tj + r) * 136 + 32 * kk + 8 * q); p = MFMA16(av, bv, p); }
                }
#pragma unroll
                for (int g = 0; g < 4; ++g) { const int t = 16 * ti + 4 * q + g, s = 16 * tj + r; PS[t * 40 + s] = (wave < 3 && s <= t) ? f2bf(p[g]) : (bf16_t)0; }
            }
            __syncthreads();
        }
        const bf16x8 bV = *(const bf16x8*)(VT + (16 * wave + r) * 40 + 8 * q);
        bf16x8 bV1 = bV; if (xw) bV1 = *(const bf16x8*)(VT + (128 + r) * 40 + 8 * q);
        f32x4 o[2], ox[2];
        o[0] = o[1] = ox[0] = ox[1] = (f32x4){0.f, 0.f, 0.f, 0.f};
#pragma unroll
        for (int kk = 0; kk < 4; ++kk) {
            const f32x4 sa = *(const f32x4*)(SC1 + 32 * kk + 4 * q), sb = *(const f32x4*)(SC1 + 32 * kk + 16 + 4 * q);
            S[2 * kk] *= sa; S[2 * kk + 1] *= sb;
            if (xw) { SX[2 * kk] *= sa; SX[2 * kk + 1] *= sb; }
            if (PASS == 2) {
                bf16x8 bS, bX;
#pragma unroll
                for (int g = 0; g < 4; ++g) { bS[g] = (short)f2bf(S[2 * kk][g]); bS[4 + g] = (short)f2bf(S[2 * kk + 1][g]); bX[g] = (short)f2bf(SX[2 * kk][g]); bX[4 + g] = (short)f2bf(SX[2 * kk + 1][g]); }
#pragma unroll
                for (int mt = 0; mt < 2; ++mt) { const bf16x4 lo = *(const bf16x4*)(QS + (16 * mt + r) * 136 + 32 * kk + 4 * q), hi = *(const bf16x4*)(QS + (16 * mt + r) * 136 + 32 * kk + 16 + 4 * q);
                    bf16x8 av; av[0] = lo[0]; av[1] = lo[1]; av[2] = lo[2]; av[3] = lo[3]; av[4] = hi[0]; av[5] = hi[1]; av[6] = hi[2]; av[7] = hi[3];
                    o[mt] = MFMA16(av, bS, o[mt]); if (xw) ox[mt] = MFMA16(av, bX, ox[mt]); }
            }
        }
        if (PASS == 2) {
#pragma unroll
            for (int mt = 0; mt < 2; ++mt) { const bf16x8 av = *(const bf16x8*)(PS + (16 * mt + r) * 40 + 8 * q); o[mt] = MFMA16(av, bV, o[mt]); if (xw) ox[mt] = MFMA16(av, bV1, ox[mt]);
#pragma unroll
                for (int g = 0; g < 4; ++g) { const int t = t0 + 16 * mt + 4 * q + g; OS[(16 * mt + 4 * q + g) * 136 + 16 * wave + r] = f2bf(o[mt][g]); if (xw && r == 0) DEN[h * T + t] = ox[mt][g]; } }
        }
#pragma unroll
        for (int i = 0; i < 8; ++i) { const bf16x8 av = *(const bf16x8*)(KT + (16 * i + r) * 40 + 8 * q); const f32x4 s2 = *(const f32x4*)(SC2 + 16 * i + 4 * q);
            S[i] = MFMA16(av, bV, S[i]); S[i] *= s2;
            if (xw) { SX[i] = MFMA16(av, bV1, SX[i]); SX[i] *= s2; } }
    }
    if (PASS == 2) { __syncthreads(); const int row = tid >> 4, c8 = (tid & 15) * 8; *(u32x4*)(Og + (size_t)(sg * GSEGLEN + GSEGLEN - 32 + row) * 512 + h * 128 + c8) = *(const u32x4*)(OS + row * 136 + c8); }
    if (PASS == 1) {
        float* ST = (float*)smem;
        __syncthreads();
#pragma unroll
        for (int i = 0; i < 8; ++i)
#pragma unroll
            for (int g = 0; g < 4; ++g) { ST[(16 * i + 4 * q + g) * 132 + 16 * wave + r] = S[i][g]; if (xw) EX[((size_t)(sg * 4 + h) * 128 + 16 * i + 4 * q + g) * 16 + r] = SX[i][g]; }
        __syncthreads();
#pragma unroll
        for (int k = 0; k < 8; ++k) { const int idx = tid + 512 * k, row = idx >> 5, c4 = (idx & 31) * 4; *(f32x4*)(Eg + ((size_t)(sg * 4 + h) * 128 + row) * 128 + c4) = *(const f32x4*)(ST + row * 132 + c4); }
        if (grp == 0) Gg[(size_t)(sg * 4 + h) * 128 + d] = expf(runb);
    }
}

template <int PASS>
__device__ __forceinline__ void s5_item(ArgsRef a, int l, int g, int sg, int g0, int tid, int lane, int wave, int hsel) {
    unsigned char* ws = a.ws;
    const bf16_t* Z = (const bf16_t*)(ws + OFF_Z); const float* ABAR = (const float*)(ws + OFF_ABAR); const bf16_t* BBT = (const bf16_t*)(ws + OFF_BBT); const bf16_t* CCT = (const bf16_t*)(ws + OFF_CCT);
    float* ES = (float*)(ws + OFF_ES); bf16_t* YPRE = (bf16_t*)(ws + OFF_YPRE);
    float* BU = (float*)(smem + 70000 + (wave & 3) * 12800); bf16_t* X = (bf16_t*)(smem + 70000 + (wave & 3) * 12800 + 8448); bf16_t* YT = (bf16_t*)(smem + 70000 + 51200);
    const int r = lane & 15, q = lane >> 4, p = lane; const bool act = (wave >> 2) == hsel;
    const float ar = ABAR[(g * 64 + p) * 2], ai = ABAR[(g * 64 + p) * 2 + 1];
    const bf16x8 zero8 = (bf16x8){0, 0, 0, 0, 0, 0, 0, 0};
    bf16x8 bB[8], cB[4];
#pragma unroll
    for (int nt = 0; nt < 8; ++nt) bB[nt] = (q < 2) ? *(const bf16x8*)(BBT + (size_t)(g * 128 + 16 * nt + r) * 16 + 8 * q) : zero8;
#pragma unroll
    for (int kk = 0; kk < 4; ++kk) cB[kk] = (PASS == 2) ? *(const bf16x8*)(CCT + (size_t)(g * 16 + r) * 128 + 32 * kk + 8 * q) : zero8;
    float xr = 0.f, xi = 0.f;
    if (PASS == 2 && sg > 0) {
        float pr = ar, pi = ai;
#pragma unroll
        for (int s = 0; s < 8; ++s) { const float nr = pr * pr - pi * pi, ni = 2.0f * pr * pi; pr = nr; pi = ni; }
        for (int j = 0; j < sg; ++j) { const float er = ES[((size_t)(j * 32 + g) * 64 + p) * 2], ei = ES[((size_t)(j * 32 + g) * 64 + p) * 2 + 1];
            const float nr = pr * xr - pi * xi + er, ni = pr * xi + pi * xr + ei; xr = nr; xi = ni; }
    }
    const float dsk = a.in[17][l * 512 + 16 * g + r];
    for (int ci = 0; ci < SSEGLEN / 16; ++ci) {
        const int t0 = sg * SSEGLEN + ci * 16;
        if (act) {
            const bf16x8 av = (q < 2) ? *(const bf16x8*)(Z + (size_t)(t0 + r) * NZ + 1024 + 16 * g + 8 * q) : zero8;
#pragma unroll
            for (int nt = 0; nt < 8; ++nt) { f32x4 acc = (f32x4){0.f, 0.f, 0.f, 0.f}; acc = MFMA16(av, bB[nt], acc);
#pragma unroll
                for (int gg = 0; gg < 4; ++gg) BU[(4 * q + gg) * 132 + 16 * nt + r] = acc[gg]; }
            wave_sync();
#pragma unroll
            for (int t = 0; t < 16; ++t) { const float br = BU[t * 132 + p], bi = BU[t * 132 + 64 + p];
                const float nr = ar * xr - ai * xi + br, ni = ar * xi + ai * xr + bi; xr = nr; xi = ni;
                if (PASS == 2) { X[t * 136 + p] = f2bf(xr); X[t * 136 + 64 + p] = f2bf(xi); } }
            wave_sync();
            if (PASS == 2) {
                f32x4 acc = (f32x4){0.f, 0.f, 0.f, 0.f};
#pragma unroll
                for (int kk = 0; kk < 4; ++kk) { const bf16x8 xv = *(const bf16x8*)(X + r * 136 + 32 * kk + 8 * q); acc = MFMA16(xv, cB[kk], acc); }
#pragma unroll
                for (int gg = 0; gg < 4; ++gg) { const int t = t0 + 4 * q + gg, c = 16 * g + r; const float u = bf2f(Z[(size_t)t * NZ + 1024 + c]);
                    YT[(4 * q + gg) * 136 + 16 * wave + r] = f2bf(gelu_tanh(acc[gg] + dsk * u)); }
            }
        }
        if (PASS == 2) {
            __syncthreads();
            if (tid < 128) { const int row = tid >> 3, c8 = (tid & 7) * 8; *(u32x4*)(YPRE + (size_t)(t0 + row) * 512 + 16 * g0 + 64 * hsel + c8) = *(const u32x4*)(YT + row * 136 + 64 * hsel + c8); }
            __syncthreads();
        }
    }
    if (PASS == 1 && act) { ES[((size_t)(sg * 32 + g) * 64 + p) * 2] = xr; ES[((size_t)(sg * 32 + g) * 64 + p) * 2 + 1] = xi; }
}

template <int PASS>
__device__ __forceinline__ void phase_mixers(ArgsRef a, int l, int tid, int lane, int wave, int bid, int G) {
    for (int it = bid; it < 4 * GSEG; it += G) gla_item<0, PASS>(a, l, it % 4, it / 4, tid, lane, wave);
    asm volatile("" ::: "memory");
    for (int it = bid + ((4 * GSEG - bid % G) % G + G) % G * 0; it < 2 * 4 * GSEG; it += G) { if (it >= 4 * GSEG) gla_item<1, PASS>(a, l, (it - 4 * GSEG) % 4, (it - 4 * GSEG) / 4, tid, lane, wave); }
    __syncthreads();
    for (int it0 = bid * 8; it0 < 32 * SSEG; it0 += G * 8)
        for (int half = 0; half < 2; ++half) { const int it = it0 + wave; s5_item<PASS>(a, l, it % 32, it / 32, it0 % 32, tid, lane, wave, half); __syncthreads(); }
}

__device__ __forceinline__ void phase_post(ArgsRef a, int l, int lane, int gw, int GW) {
    const bf16_t* Z = (const bf16_t*)(a.ws + OFF_Z); const bf16_t* XC = (const bf16_t*)(a.ws + OFF_XC);
    bf16_t* OM = (bf16_t*)(a.ws + OFF_OM); bf16_t* OH = (bf16_t*)(a.ws + OFF_OH); const float* DEN = (const float*)(a.ws + OFF_DEN);
    const int c0 = lane * 8, hd = lane >> 4;
    for (int t = gw; t < T; t += GW) {
        { const bf16x8 o = *(const bf16x8*)(OM + (size_t)t * 512 + c0), op = *(const bf16x8*)(Z + (size_t)t * NZ + 512 + c0), xc = *(const bf16x8*)(XC + (size_t)t * 512 + c0);
          const float dn = 1.0f / fmaxf(fabsf(DEN[hd * T + t]), 1.0f); float y[8];
#pragma unroll
          for (int j = 0; j < 8; ++j) y[j] = sigmoidf_(bf2f((bf16_t)op[j])) * (bf2f((bf16_t)o[j]) * dn) + a.in[9][l * 512 + c0 + j] * bf2f((bf16_t)xc[j]);
          u32x4 w; w.x = pack2(y[0], y[1]); w.y = pack2(y[2], y[3]); w.z = pack2(y[4], y[5]); w.w = pack2(y[6], y[7]); *(u32x4*)(OM + (size_t)t * 512 + c0) = w; }
        { const bf16x8 o = *(const bf16x8*)(OH + (size_t)t * 512 + c0), gp = *(const bf16x8*)(Z + (size_t)t * NZ + 3072 + c0);
          float ov[8], ss = 0.f;
#pragma unroll
          for (int j = 0; j < 8; ++j) { ov[j] = bf2f((bf16_t)o[j]); ss += ov[j] * ov[j]; }
          ss += __shfl_xor(ss, 1); ss += __shfl_xor(ss, 2); ss += __shfl_xor(ss, 4); ss += __shfl_xor(ss, 8);
          const float rinv = rsqrtf(ss * (1.0f / 128.0f) + 1e-6f); float y[8];
#pragma unroll
          for (int j = 0; j < 8; ++j) y[j] = ov[j] * rinv * a.in[20][l * 512 + c0 + j] * siluf_(bf2f((bf16_t)gp[j]));
          u32x4 w; w.x = pack2(y[0], y[1]); w.y = pack2(y[2], y[3]); w.z = pack2(y[4], y[5]); w.w = pack2(y[6], y[7]); *(u32x4*)(OH + (size_t)t * 512 + c0) = w; }
    }
}

__device__ __forceinline__ void ln_row(f32x4 (&v)[4], const float* gam, const float* bet, int lane) {
    float s = 0.f;
#pragma unroll
    for (int j = 0; j < 4; ++j) s += (v[j][0] + v[j][1]) + (v[j][2] + v[j][3]);
#pragma unroll
    for (int o = 32; o >= 1; o >>= 1) s += __shfl_xor(s, o);
    const float mean = s * (1.0f / 1024.0f); float qv = 0.f;
#pragma unroll
    for (int j = 0; j < 4; ++j) { const f32x4 dd = v[j] - mean; qv += (dd[0] * dd[0] + dd[1] * dd[1]) + (dd[2] * dd[2] + dd[3] * dd[3]); }
#pragma unroll
    for (int o = 32; o >= 1; o >>= 1) qv += __shfl_xor(qv, o);
    const float rstd = rsqrtf(qv * (1.0f / 1024.0f) + 1e-5f);
#pragma unroll
    for (int j = 0; j < 4; ++j) { const f32x4 gg = *(const f32x4*)(gam + 256 * j + 4 * lane), bb = *(const f32x4*)(bet + 256 * j + 4 * lane); v[j] = (v[j] - mean) * rstd * gg + bb; }
}

__device__ __forceinline__ void phase_ln1r(ArgsRef a, int l, int tid, int lane, int wave, int bid, int G) {
    float* XF = a.out; bf16_t* XB = (bf16_t*)(a.ws + OFF_XB);
    int* TOKE = (int*)(a.ws + OFF_TOKE); float* TOKG = (float*)(a.ws + OFF_TOKG); unsigned* HIST = (unsigned*)(a.ws + OFF_HIST);
    const float* RWT = (const float*)(a.ws + OFF_RWT); const float* RB = a.in[30];
    float* LG = (float*)(smem + wave * 4096);
    int* TE = (int*)(smem + wave * 4096 + 2304); float* TG = (float*)(smem + wave * 4096 + 2432); unsigned* HS = (unsigned*)(smem + wave * 4096 + 2560);
    const int r = lane & 15, q = lane >> 4, rs = lane >> 5, e = lane & 31;
    for (int tw = bid * 8 + wave; tw < T / 16; tw += G * 8) {
        const int t0 = tw * 16;
        for (int rr = 0; rr < 16; ++rr) { const int t = t0 + rr; f32x4 v[4];
#pragma unroll
            for (int j = 0; j < 4; ++j) v[j] = *(const f32x4*)(XF + (size_t)t * 1024 + 256 * j + 4 * lane);
            ln_row(v, a.in[25] + l * 1024, a.in[26] + l * 1024, lane);
#pragma unroll
            for (int j = 0; j < 4; ++j) { *(f32x4*)(XF + (size_t)t * 1024 + 256 * j + 4 * lane) = v[j];
                u32x2 w; w.x = pack2(v[j][0], v[j][1]); w.y = pack2(v[j][2], v[j][3]); *(u32x2*)(XB + (size_t)t * 1024 + 256 * j + 4 * lane) = w; } }
        if (lane < 32) HS[lane] = 0u;
        asm volatile("s_waitcnt vmcnt(0) lgkmcnt(0)" ::: "memory"); __builtin_amdgcn_wave_barrier();
        f32x4 acc0 = (f32x4){0.f, 0.f, 0.f, 0.f}, acc1 = acc0;
        const float* xa = XF + (size_t)(t0 + r) * 1024 + 4 * q; const float* w0 = RWT + (size_t)r * 1024 + 4 * q; const float* w1 = RWT + (size_t)(16 + r) * 1024 + 4 * q;
#pragma unroll 4
        for (int s = 0; s < 64; ++s) { const f32x4 av = *(const f32x4*)(xa + 16 * s), b0 = *(const f32x4*)(w0 + 16 * s), b1 = *(const f32x4*)(w1 + 16 * s);
#pragma unroll
            for (int j = 0; j < 4; ++j) { acc0 = __builtin_amdgcn_mfma_f32_16x16x4f32(av[j], b0[j], acc0, 0, 0, 0); acc1 = __builtin_amdgcn_mfma_f32_16x16x4f32(av[j], b1[j], acc1, 0, 0, 0); } }
#pragma unroll
        for (int g = 0; g < 4; ++g) { LG[(4 * q + g) * 33 + r] = acc0[g]; LG[(4 * q + g) * 33 + 16 + r] = acc1[g]; }
        wave_sync();
        for (int pp = 0; pp < 8; ++pp) {
            const float lg = LG[(2 * pp + rs) * 33 + e];
            const float s = sigmoidf_(lg), sb = s + RB[e];
            float v4[4];
#pragma unroll
            for (int i = 0; i < 4; ++i) v4[i] = __shfl(sb, (lane & ~3) + i);
            int i1 = 0;
#pragma unroll
            for (int i = 1; i < 4; ++i) if (v4[i] > v4[i1]) i1 = i;
            int i2 = (i1 == 0) ? 1 : 0;
#pragma unroll
            for (int i = 0; i < 4; ++i) if (i != i1 && i != i2 && v4[i] > v4[i2]) i2 = i;
            float gs = v4[i1] + v4[i2]; int gid = e >> 2;
#pragma unroll
            for (int o = 4; o <= 16; o <<= 1) { const float os = __shfl_xor(gs, o); const int og = __shfl_xor(gid, o); if (os > gs || (os == gs && og < gid)) { gs = os; gid = og; } }
            float sv[4], sbv[4];
#pragma unroll
            for (int i = 0; i < 4; ++i) { sbv[i] = __shfl(sb, (lane & 32) + gid * 4 + i); sv[i] = __shfl(s, (lane & 32) + gid * 4 + i); }
            int j1 = 0;
#pragma unroll
            for (int i = 1; i < 4; ++i) if (sbv[i] > sbv[j1]) j1 = i;
            int j2 = (j1 == 0) ? 1 : 0;
#pragma unroll
            for (int i = 0; i < 4; ++i) if (i != j1 && i != j2 && sbv[i] > sbv[j2]) j2 = i;
            float s1 = sv[0], s2 = sv[0];
#pragma unroll
            for (int i = 1; i < 4; ++i) { if (i == j1) s1 = sv[i]; if (i == j2) s2 = sv[i]; }
            if (e == 0) { const int ti = 2 * pp + rs; const float inv = 1.0f / (s1 + s2);
                TE[ti * 2] = gid * 4 + j1; TE[ti * 2 + 1] = gid * 4 + j2; TG[ti * 2] = s1 * inv; TG[ti * 2 + 1] = s2 * inv;
                atomicAdd(&HS[gid * 4 + j1], 1u); atomicAdd(&HS[gid * 4 + j2], 1u); }
        }
        wave_sync();
        if (lane < 32) { TOKE[t0 * 2 + lane] = TE[lane]; TOKG[t0 * 2 + lane] = TG[lane]; HIST[tw * 32 + lane] = HS[lane]; }
        wave_sync();
    }
}

__device__ __forceinline__ void phase_slot(ArgsRef a, int tid, int lane, int wave, int bid, int G) {
    const int* TOKE = (const int*)(a.ws + OFF_TOKE); int* TOKS = (int*)(a.ws + OFF_TOKS); const unsigned* HIST = (const unsigned*)(a.ws + OFF_HIST);
    unsigned* BASE = (unsigned*)(a.ws + OFF_CTL) + 64;
    const bf16_t* XB = (const bf16_t*)(a.ws + OFF_XB); bf16_t* XG = (bf16_t*)(a.ws + OFF_XG);
    unsigned* base = (unsigned*)smem; unsigned* pre = base + 40; int* el = (int*)(base + 80); int* sl = (int*)(base + 208); unsigned* red = base + 336;
    const int e = tid & 31, part = tid >> 5;
    for (int c = bid; c < T / 64; c += G) {
        unsigned tot = 0u, pr = 0u;
#pragma unroll 8
        for (int it = part; it < 1024; it += 16) { const unsigned v = HIST[it * 32 + e]; tot += v; pr += (it < 4 * c) ? v : 0u; }
        red[part * 32 + e] = tot; red[512 + part * 32 + e] = pr;
        __syncthreads();
        if (tid < 32) { unsigned t2 = 0u, p2 = 0u; for (int k = 0; k < 16; ++k) { t2 += red[k * 32 + tid]; p2 += red[512 + k * 32 + tid]; } pre[tid] = p2; red[tid] = (t2 + 255u) & ~255u; }
        __syncthreads();
        if (tid == 0) { unsigned sacc = 0; for (int k = 0; k < 32; ++k) { base[k] = sacc; sacc += red[k]; } base[32] = sacc; }
        int ee = 0;
        if (tid < 128) { ee = TOKE[c * 128 + tid]; el[tid] = ee; }
        __syncthreads();
        if (c == 0 && tid < 33) BASE[tid] = base[tid];
        if (tid < 128) { unsigned rank = 0; for (int i = 0; i < tid; ++i) rank += (el[i] == ee) ? 1u : 0u;
            const unsigned sidx = base[ee] + pre[ee] + rank; sl[tid] = (int)sidx; TOKS[c * 128 + tid] = (int)sidx; }
        __syncthreads();
        for (int i = wave; i < 128; i += 8) { const int t = c * 64 + (i >> 1); const size_t so = (size_t)sl[i] * 1024;
            *(u32x4*)(XG + so + lane * 8) = *(const u32x4*)(XB + (size_t)t * 1024 + lane * 8); *(u32x4*)(XG + so + 512 + lane * 8) = *(const u32x4*)(XB + (size_t)t * 1024 + 512 + lane * 8); }
        __syncthreads();
    }
}

__device__ __forceinline__ void phase_ln2(ArgsRef a, int l, int lane, int gw, int GW) {
    float* XF = a.out; bf16_t* XB = (bf16_t*)(a.ws + OFF_XB); const bf16_t* YS = (const bf16_t*)(a.ws + OFF_YS);
    const int* TOKS = (const int*)(a.ws + OFF_TOKS); const float* TOKG = (const float*)(a.ws + OFF_TOKG);
    for (int t = gw; t < T; t += GW) {
        const int s0 = TOKS[t * 2], s1 = TOKS[t * 2 + 1]; const float g0 = TOKG[t * 2], g1 = TOKG[t * 2 + 1];
        f32x4 v[4];
#pragma unroll
        for (int j = 0; j < 4; ++j) { const f32x4 x1 = *(const f32x4*)(XF + (size_t)t * 1024 + 256 * j + 4 * lane);
            const bf16x4 y0 = *(const bf16x4*)(YS + (size_t)s0 * 1024 + 256 * j + 4 * lane), y1 = *(const bf16x4*)(YS + (size_t)s1 * 1024 + 256 * j + 4 * lane);
#pragma unroll
            for (int g = 0; g < 4; ++g) v[j][g] = DN_ALPHA * x1[g] + g0 * bf2f((bf16_t)y0[g]) + g1 * bf2f((bf16_t)y1[g]); }
        ln_row(v, a.in[27] + l * 1024, a.in[28] + l * 1024, lane);
#pragma unroll
        for (int j = 0; j < 4; ++j) { *(f32x4*)(XF + (size_t)t * 1024 + 256 * j + 4 * lane) = v[j];
            u32x2 w; w.x = pack2(v[j][0], v[j][1]); w.y = pack2(v[j][2], v[j][3]); *(u32x2*)(XB + (size_t)t * 1024 + 256 * j + 4 * lane) = w; }
    }
}

struct SchedGrid {
    int nM, nN, G, c; const char* A; const char* B; size_t strideA, strideB;
    __device__ __forceinline__ bool next(int i, pg8::Unit& u) const { int pm, pn; if (!pg8::tile_order(i * G + c, nM, nN, pm, pn)) return false;
        u.pm = pm; u.pn = pn; u.tag = 0; u.A = A + (size_t)pm * strideA; u.B = B + (size_t)pn * strideB; return true; }
};
constexpr int GATES_LD = 3072;
template <int MODE> struct EpiBf16 {
    static constexpr bool PERM = true;
    bf16_t* O; int ldo; const bf16_t* Y; int ldy;
    __device__ __forceinline__ bool operator()(f32x4 (&acc)[2][2][4][2], const pg8::Unit& u, int wr, int wc, int fr, int fq) const {
#pragma unroll
        for (int ai = 0; ai < 2; ++ai)
#pragma unroll
            for (int m = 0; m < 4; ++m) { const size_t row = (size_t)u.pm * 256 + ai * 128 + wr * 64 + m * 16 + fr;
#pragma unroll
                for (int bj = 0; bj < 2; ++bj) { const int col = u.pn * 256 + bj * 128 + wc * 32 + 8 * fq; f32x4 v0 = acc[ai][bj][m][0], v1 = acc[ai][bj][m][1];
                    if (MODE == 1) {
#pragma unroll
                        for (int j = 0; j < 4; ++j) { v0[j] = fmaxf(sigmoidf_(v0[j]), 1e-30f); v1[j] = fmaxf(sigmoidf_(v1[j]), 1e-30f); } }
                    if (MODE == 2) { const bf16x8 y = *(const bf16x8*)(Y + row * ldy + col);
#pragma unroll
                        for (int j = 0; j < 4; ++j) { v0[j] = bf2f((bf16_t)y[j]) * sigmoidf_(v0[j]); v1[j] = bf2f((bf16_t)y[4 + j]) * sigmoidf_(v1[j]); } }
                    u32x4 w; w.x = pg8::cvt_pk_bf16(v0[0], v0[1]); w.y = pg8::cvt_pk_bf16(v0[2], v0[3]); w.z = pg8::cvt_pk_bf16(v1[0], v1[1]); w.w = pg8::cvt_pk_bf16(v1[2], v1[3]);
                    *(u32x4*)(O + row * ldo + col) = w; } }
        return false;
    }
};
__device__ __forceinline__ void phase_zgemm2(ArgsRef a, int tid, int bid, int G) {
    SchedGrid S{T / 256, NZ / 256, G, bid, (const char*)(a.ws + OFF_XB), (const char*)(a.ws + OFF_WIN), (size_t)256 * 1024 * 2, (size_t)256 * 1024 * 2};
    EpiBf16<0> E{(bf16_t*)(a.ws + OFF_Z), NZ, nullptr, 0};
    pg8::gemm_phase((PG8_LAS unsigned char*)smem, tid, 1024, 1024, 1024, S, E);
}
__device__ __forceinline__ void phase_glu_gates(ArgsRef a, int tid, int bid, int G) {
    { SchedGrid S{T / 256, 2, G, bid, (const char*)(a.ws + OFF_YPRE), (const char*)(a.ws + OFF_WGLU), (size_t)256 * 512 * 2, (size_t)256 * 512 * 2};
      EpiBf16<2> E{(bf16_t*)(a.ws + OFF_YSG), 512, (const bf16_t*)(a.ws + OFF_YPRE), 512};
      pg8::gemm_phase((PG8_LAS unsigned char*)smem, tid, 512, 512, 512, S, E); }
    asm volatile("" : "+v"(tid), "+s"(bid), "+s"(G));
    { SchedGrid S{T / 256, 12, G, (bid + G / 2) % G, (const char*)(a.ws + OFF_XB), (const char*)(a.ws + OFF_WIN + (size_t)NZ * 1024 * 2), (size_t)256 * 1024 * 2, (size_t)256 * 1024 * 2};
      EpiBf16<1> E{(bf16_t*)(a.ws + OFF_Z), GATES_LD, nullptr, 0};
      pg8::gemm_phase((PG8_LAS unsigned char*)smem, tid, 1024, 1024, 1024, S, E); }
}
struct SchedMerge {
    int G, c; const unsigned char* ws;
    __device__ __forceinline__ bool next(int i, pg8::Unit& u) const { const int b = i % 3; int pm, pn; if (!pg8::tile_order((i / 3) * G + c, T / 256, 4, pm, pn)) return false;
        u.pm = pm; u.pn = pn; u.tag = b; u.A = (const char*)(ws + (b == 0 ? OFF_OM : b == 1 ? OFF_YSG : OFF_OH)) + (size_t)pm * 256 * 512 * 2;
        u.B = (const char*)(ws + OFF_WB) + ((size_t)b * 1024 + pn * 256) * 512 * 2; return true; }
};
struct EpiMerge {
    static constexpr bool PERM = true;
    const bf16_t* GT; bf16_t* O;
    __device__ __forceinline__ bool operator()(f32x4 (&acc)[2][2][4][2], const pg8::Unit& u, int wr, int wc, int fr, int fq) const {
        const int b = u.tag;
#pragma unroll
        for (int ai = 0; ai < 2; ++ai)
#pragma unroll
            for (int m = 0; m < 4; ++m) { const size_t row = (size_t)u.pm * 256 + ai * 128 + wr * 64 + m * 16 + fr;
#pragma unroll
                for (int bj = 0; bj < 2; ++bj) { const int col = u.pn * 256 + bj * 128 + wc * 32 + 8 * fq;
                    const bf16x8 gb = *(const bf16x8*)(GT + row * GATES_LD + b * 1024 + col);
                    if (b < 2) { const bf16x8 gn = *(const bf16x8*)(GT + row * GATES_LD + (b + 1) * 1024 + col);
#pragma unroll
                        for (int j = 0; j < 4; ++j) { acc[ai][bj][m][0][j] *= bf2f((bf16_t)gb[j]) / bf2f((bf16_t)gn[j]); acc[ai][bj][m][1][j] *= bf2f((bf16_t)gb[4 + j]) / bf2f((bf16_t)gn[4 + j]); } }
                    else { f32x4 v0 = acc[ai][bj][m][0], v1 = acc[ai][bj][m][1];
#pragma unroll
                        for (int j = 0; j < 4; ++j) { v0[j] *= bf2f((bf16_t)gb[j]); v1[j] *= bf2f((bf16_t)gb[4 + j]); }
                        u32x4 w; w.x = pg8::cvt_pk_bf16(v0[0], v0[1]); w.y = pg8::cvt_pk_bf16(v0[2], v0[3]); w.z = pg8::cvt_pk_bf16(v1[0], v1[1]); w.w = pg8::cvt_pk_bf16(v1[2], v1[3]);
                        *(u32x4*)(O + row * 1024 + col) = w; } } }
        return b < 2;
    }
};
__device__ __forceinline__ void phase_merge2(ArgsRef a, int tid, int bid, int G) {
    SchedMerge S{G, bid, a.ws}; EpiMerge E{(const bf16_t*)(a.ws + OFF_Z), (bf16_t*)(a.ws + OFF_XB)};
    pg8::gemm_phase((PG8_LAS unsigned char*)smem, tid, 512, 512, 512, S, E);
}
struct EpiResid {
    static constexpr bool PERM = false;
    const float* xin; float* XF;
    __device__ __forceinline__ bool operator()(f32x4 (&acc)[2][2][4][2], const pg8::Unit& u, int wr, int wc, int fr, int fq) const {
#pragma unroll
        for (int ai = 0; ai < 2; ++ai)
#pragma unroll
            for (int m = 0; m < 4; ++m) { const size_t row = (size_t)u.pm * 256 + ai * 128 + wr * 64 + m * 16 + fr;
#pragma unroll
                for (int bj = 0; bj < 2; ++bj)
#pragma unroll
                    for (int n = 0; n < 2; ++n) { const size_t o = row * 1024 + u.pn * 256 + bj * 128 + wc * 32 + 16 * n + 4 * fq; const f32x4 x = *(const f32x4*)(xin + o); *(f32x4*)(XF + o) = DN_ALPHA * x + acc[ai][bj][m][n]; } }
        return false;
    }
};
__device__ __forceinline__ void phase_wout2(ArgsRef a, int l, int tid, int bid, int G) {
    SchedGrid S{T / 256, 4, G, bid, (const char*)(a.ws + OFF_XB), (const char*)(a.ws + OFF_WOUT), (size_t)256 * 1024 * 2, (size_t)256 * 1024 * 2};
    EpiResid E{(l == 0) ? a.in[0] : a.out, a.out};
    pg8::gemm_phase((PG8_LAS unsigned char*)smem, tid, 1024, 1024, 1024, S, E);
}
struct EpiQKV {
    static constexpr bool PERM = true;
    int vcall; bf16_t* Q; bf16_t* KH; bf16_t* V; const float* LI;
    __device__ __forceinline__ bool operator()(f32x4 (&acc)[2][2][4][2], const pg8::Unit& u, int wr, int wc, int fr, int fq) const {
        const int which = vcall ? 2 : (u.pn >> 1); bf16_t* O = which == 0 ? Q : which == 1 ? KH : V;
#pragma unroll
        for (int ai = 0; ai < 2; ++ai)
#pragma unroll
            for (int m = 0; m < 4; ++m) { const size_t row = (size_t)u.pm * 256 + ai * 128 + wr * 64 + m * 16 + fr;
#pragma unroll
                for (int bj = 0; bj < 2; ++bj) { const int hd = (u.pn & 1) * 2 + bj, col = hd * 128 + wc * 32 + 8 * fq;
                    const float sc = which == 0 ? 0.08838834764831845f : which == 1 ? expf(LI[row * 4 + hd]) : 1.0f;
                    const f32x4 v0 = acc[ai][bj][m][0] * sc, v1 = acc[ai][bj][m][1] * sc;
                    u32x4 w; w.x = pg8::cvt_pk_bf16(v0[0], v0[1]); w.y = pg8::cvt_pk_bf16(v0[2], v0[3]); w.z = pg8::cvt_pk_bf16(v1[0], v1[1]); w.w = pg8::cvt_pk_bf16(v1[2], v1[3]);
                    *(u32x4*)(O + row * 512 + col) = w; } }
        return false;
    }
};
__device__ __forceinline__ void phase_mqkv2(ArgsRef a, int tid, int bid, int G) {
    { SchedGrid S{T / 256, 4, G, bid, (const char*)(a.ws + OFF_XC), (const char*)(a.ws + OFF_WQKV), (size_t)256 * 512 * 2, (size_t)256 * 512 * 2};
      EpiQKV E{0, (bf16_t*)(a.ws + OFF_Q), (bf16_t*)(a.ws + OFF_KH), (bf16_t*)(a.ws + OFF_V), (const float*)(a.ws + OFF_LI)};
      pg8::gemm_phase((PG8_LAS unsigned char*)smem, tid, 512, 512, 512, S, E); }
    asm volatile("" : "+v"(tid), "+s"(bid), "+s"(G));
    { SchedGrid S{T / 256, 2, G, (bid + G / 2) % G, (const char*)(a.ws + OFF_Z), (const char*)(a.ws + OFF_WQKV + (size_t)1024 * 512 * 2), (size_t)256 * NZ * 2, (size_t)256 * 512 * 2};
      EpiQKV E{1, (bf16_t*)(a.ws + OFF_Q), (bf16_t*)(a.ws + OFF_KH), (bf16_t*)(a.ws + OFF_V), (const float*)(a.ws + OFF_LI)};
      pg8::gemm_phase((PG8_LAS unsigned char*)smem, tid, 512, NZ, 512, S, E); }
}
struct SchedMoE {
    int down, G, c; const unsigned char* ws; const unsigned* BASE;
    __device__ __forceinline__ bool next(int i, pg8::Unit& u) const { const int per = down ? 4 : 2, L = i * G + c, ntile = (int)(BASE[32] >> 8); if (L >= ntile * per) return false;
        const int tile = L / per, sub = L % per; int e = 0; while (e < 31 && BASE[e + 1] <= (unsigned)(tile * 256)) ++e;
        u.pm = tile; u.pn = sub; u.tag = e;
        if (!down) { u.A = (const char*)(ws + OFF_XG) + (size_t)tile * 256 * 1024 * 2; u.B = (const char*)(ws + OFF_WGU) + ((size_t)e * 512 + sub * 256) * 1024 * 2; }
        else { u.A = (const char*)(ws + OFF_H) + (size_t)tile * 256 * 256 * 2; u.B = (const char*)(ws + OFF_WD) + ((size_t)e * 1024 + sub * 256) * 256 * 2; }
        return true; }
};
struct EpiH {
    static constexpr bool PERM = true;
    bf16_t* H;
    __device__ __forceinline__ bool operator()(f32x4 (&acc)[2][2][4][2], const pg8::Unit& u, int wr, int wc, int fr, int fq) const {
#pragma unroll
        for (int ai = 0; ai < 2; ++ai)
#pragma unroll
            for (int m = 0; m < 4; ++m) { const size_t row = (size_t)u.pm * 256 + ai * 128 + wr * 64 + m * 16 + fr; f32x4 v0, v1;
#pragma unroll
                for (int j = 0; j < 4; ++j) { v0[j] = siluf_(acc[ai][0][m][0][j]) * acc[ai][1][m][0][j]; v1[j] = siluf_(acc[ai][0][m][1][j]) * acc[ai][1][m][1][j]; }
                u32x4 w; w.x = pg8::cvt_pk_bf16(v0[0], v0[1]); w.y = pg8::cvt_pk_bf16(v0[2], v0[3]); w.z = pg8::cvt_pk_bf16(v1[0], v1[1]); w.w = pg8::cvt_pk_bf16(v1[2], v1[3]);
                *(u32x4*)(H + row * 256 + u.pn * 128 + wc * 32 + 8 * fq) = w; }
        return false;
    }
};
__device__ __forceinline__ void phase_moe_gu2(ArgsRef a, int tid, int bid, int G) {
    SchedMoE S{0, G, bid, a.ws, (const unsigned*)(a.ws + OFF_CTL) + 64}; EpiH E{(bf16_t*)(a.ws + OFF_H)};
    pg8::gemm_phase((PG8_LAS unsigned char*)smem, tid, 1024, 1024, 1024, S, E);
}
__device__ __forceinline__ void phase_moe_dn2(ArgsRef a, int tid, int bid, int G) {
    SchedMoE S{1, G, bid, a.ws, (const unsigned*)(a.ws + OFF_CTL) + 64}; EpiBf16<0> E{(bf16_t*)(a.ws + OFF_YS), 1024, nullptr, 0};
    pg8::gemm_phase((PG8_LAS unsigned char*)smem, tid, 256, 256, 256, S, E);
}
__device__ __forceinline__ void phase_mprep2(ArgsRef a, int l, int tid, int lane, int wave, int bid, int G) {
    const bf16_t* Z = (const bf16_t*)(a.ws + OFF_Z); bf16_t* XC = (bf16_t*)(a.ws + OFF_XC);
    const float* cw = a.in[2] + (size_t)l * 4 * 512; const float* cb = a.in[3] + (size_t)l * 512;
    for (int idx = bid * 512 + tid; idx < T * 64; idx += G * 512) {
        const int t = idx / 64, c0 = (idx % 64) * 8; float acc[8];
#pragma unroll
        for (int j = 0; j < 8; ++j) acc[j] = cb[c0 + j];
#pragma unroll
        for (int k = 0; k < 4; ++k) { const int ts = t - 3 + k; if (ts >= 0) { const bf16x8 v = *(const bf16x8*)(Z + (size_t)ts * NZ + c0);
#pragma unroll
                for (int j = 0; j < 8; ++j) acc[j] += cw[k * 512 + c0 + j] * bf2f((bf16_t)v[j]); } }
        u32x4 w; w.x = pack2(siluf_(acc[0]), siluf_(acc[1])); w.y = pack2(siluf_(acc[2]), siluf_(acc[3])); w.z = pack2(siluf_(acc[4]), siluf_(acc[5])); w.w = pack2(siluf_(acc[6]), siluf_(acc[7]));
        *(u32x4*)(XC + (size_t)t * 512 + c0) = w;
    }
    float* W8 = (float*)smem;
    const float* wsrc = a.in[1] + (size_t)l * 1024 * INW + 1024;
    __syncthreads();
    for (int i = tid; i < 8192; i += 512) W8[i] = wsrc[(size_t)(i >> 3) * INW + (i & 7)];
    __syncthreads();
    const bf16_t* XB = (const bf16_t*)(a.ws + OFF_XB); float* LF = (float*)(a.ws + OFF_LF); float* LI = (float*)(a.ws + OFF_LI);
    for (int tw = bid * 8 + wave; tw < T / 8; tw += G * 8) {
        float myli = 0.f, mylf = 0.f;
        for (int tt = 0; tt < 8; ++tt) { const int t = tw * 8 + tt; float sacc[8];
#pragma unroll
            for (int j = 0; j < 8; ++j) sacc[j] = 0.f;
#pragma unroll 4
            for (int kk = 0; kk < 16; ++kk) { const int k = lane + 64 * kk; const float x = bf2f(XB[(size_t)t * 1024 + k]);
                const f32x4 w0 = *(const f32x4*)(W8 + k * 8), w1 = *(const f32x4*)(W8 + k * 8 + 4);
#pragma unroll
                for (int j = 0; j < 4; ++j) { sacc[j] += x * w0[j]; sacc[4 + j] += x * w1[j]; } }
#pragma unroll
            for (int j = 0; j < 8; ++j) {
#pragma unroll
                for (int o = 32; o >= 1; o >>= 1) sacc[j] += __shfl_xor(sacc[j], o); }
            const int hh = lane & 3;
            const float ipre = hh == 0 ? sacc[0] : hh == 1 ? sacc[1] : hh == 2 ? sacc[2] : sacc[3], fpre = hh == 0 ? sacc[4] : hh == 1 ? sacc[5] : hh == 2 ? sacc[6] : sacc[7];
            if ((lane >> 2) == tt) { myli = ipre + a.in[7][l * 4 + hh]; mylf = logsigmoidf_(fpre + a.in[8][l * 4 + hh]); }
        }
        if (lane < 32) { LI[tw * 32 + lane] = myli; LF[tw * 32 + lane] = mylf; }
    }
}

#define XB_TMO      128
#define XB_XCNT(j)  (256  + 64 * (j))
#define XB_XSUB(j)  (1280 + 64 * (j))
#define XB_XGEN(j)  (2304 + 64 * (j))
#define XB_TOP      3328
#define XB_TOPGEN   3392
#define XCD_BAR_WORDS 3456
#define XB_SPIN_CAP (1u << 22)
__device__ __forceinline__ unsigned xb_ld(unsigned* p)              { return __hip_atomic_load(p, __ATOMIC_RELAXED, __HIP_MEMORY_SCOPE_AGENT); }
__device__ __forceinline__ unsigned xb_add(unsigned* p, unsigned v) { return __hip_atomic_fetch_add(p, v, __ATOMIC_RELAXED, __HIP_MEMORY_SCOPE_AGENT); }
__device__ __forceinline__ unsigned xb_xcc_id() { return (unsigned)__builtin_amdgcn_s_getreg((3 << 11) | 20) & 0xFu; }
#define XB_SPIN(cond, bar) do { unsigned _sp = 0; while (cond) { __builtin_amdgcn_s_sleep(1); \
    if ((++_sp & 255u) == 0u) { if (xb_ld(&(bar)[XB_TMO])) break; if (_sp > XB_SPIN_CAP) { atomicAdd(&(bar)[XB_TMO], 1u); break; } } } } while (0)
__device__ __forceinline__ void xcd_barrier_complete(unsigned* bar, unsigned x, unsigned& nloc, unsigned& nx) {
    const unsigned G = gridDim.x; unsigned sum, cnt, mine, sp = 0u;
    for (;;) { sum = 0u; cnt = 0u; mine = 0u;
#pragma unroll
        for (unsigned j = 0; j < 16; ++j) { const unsigned c = xb_ld(&bar[XB_XCNT(j)]); sum += c; cnt += (c > 0u) ? 1u : 0u; mine = (j == x) ? c : mine; }
        if (sum == G) break;
        __builtin_amdgcn_s_sleep(1);
        if ((++sp & 255u) == 0u) { if (xb_ld(&bar[XB_TMO])) break; if (sp > XB_SPIN_CAP) { atomicAdd(&bar[XB_TMO], 1u); break; } } }
    nloc = mine > 0u ? mine : 1u; nx = cnt > 0u ? cnt : 1u;
}
__device__ __forceinline__ void xcd_barrier(unsigned* bar, volatile __attribute__((address_space(3))) unsigned* st) {
    asm volatile("s_waitcnt vmcnt(0)" ::: "memory");
    __syncthreads();
    if (threadIdx.x == 0) {
        __builtin_amdgcn_s_waitcnt(0);
        const unsigned x = xb_xcc_id();
        unsigned nloc = st[0], nx = st[1];
        if (nloc == 0u) { xcd_barrier_complete(bar, x, nloc, nx); st[0] = nloc; st[1] = nx; }
        const unsigned old = xb_add(&bar[XB_XSUB(x)], 1u);
        const unsigned gen = old / nloc;
        if (old + 1u == (gen + 1u) * nloc) {
            __builtin_amdgcn_fence(__ATOMIC_RELEASE, "agent");
            asm volatile("s_waitcnt vmcnt(0)" ::: "memory");
            const unsigned og = xb_add(&bar[XB_TOP], 1u);
            const unsigned tg = og / nx;
            if (og + 1u == (tg + 1u) * nx) xb_add(&bar[XB_TOPGEN], 1u);
            else XB_SPIN(xb_ld(&bar[XB_TOPGEN]) == tg, bar);
            __builtin_amdgcn_fence(__ATOMIC_ACQUIRE, "agent");
            xb_add(&bar[XB_XGEN(x)], 1u);
            asm volatile("s_waitcnt vmcnt(0)" ::: "memory");
        } else {
            XB_SPIN(xb_ld(&bar[XB_XGEN(x)]) == gen, bar);
            __builtin_amdgcn_fence(__ATOMIC_ACQUIRE, "agent");
            asm volatile("s_waitcnt vmcnt(0)" ::: "memory");
        }
    }
    __syncthreads();
}

__device__ __forceinline__ ArgsRef fresh_args() { unsigned long long p = (unsigned long long)__builtin_amdgcn_kernarg_segment_ptr(); asm volatile("" : "+s"(p)); return *(const __attribute__((address_space(4))) Args*)p; }
__global__ void __launch_bounds__(512) fwd(Args a_unused) {
    cg::grid_group grid = cg::this_grid();
    volatile __attribute__((address_space(3))) unsigned* bst = (volatile __attribute__((address_space(3))) unsigned*)((__attribute__((address_space(3))) unsigned char*)smem + 131072);
    if (threadIdx.x < 4) bst[threadIdx.x] = 0u;
    __syncthreads();
    { ArgsRef a0 = fresh_args(); if (threadIdx.x == 0) (void)xb_add(&((unsigned*)(a0.ws + OFF_BAR))[XB_XCNT(xb_xcc_id())], 1u); }
#define GSYNC() do { asm volatile("" ::: "memory"); { ArgsRef ab = fresh_args(); xcd_barrier((unsigned*)(ab.ws + OFF_BAR), bst); } asm volatile("" ::: "memory"); } while (0)
#define GSYNC_CG() do { asm volatile("" ::: "memory"); grid.sync(); asm volatile("" ::: "memory"); } while (0)
    const int wave_s = __builtin_amdgcn_readfirstlane((int)threadIdx.x >> 6);
#define PH(body) do { int wave = wave_s; asm volatile("" : "+s"(wave)); int lane; asm volatile("v_mbcnt_lo_u32_b32 %0, -1, 0\n\tv_mbcnt_hi_u32_b32 %0, -1, %0" : "=v"(lane)); \
        int bid = blockIdx.x, G = gridDim.x; asm volatile("" : "+s"(bid), "+s"(G)); \
        const int tid = wave * 64 + lane, gw = bid * 8 + wave, GW = G * 8; (void)tid; (void)gw; (void)GW; ArgsRef a = fresh_args(); body; } while (0)
#pragma unroll 1
    for (int l = 0; l < NLAYER; ++l) {
        PH(phase_prep(a, l, tid, bid, G)); if (l == 0) GSYNC_CG(); else GSYNC();
        PH(phase_zgemm2(a, tid, bid, G)); GSYNC();
        PH(phase_mprep2(a, l, tid, lane, wave, bid, G)); GSYNC();
        PH(phase_mqkv2(a, tid, bid, G)); GSYNC();
        PH(phase_mixers<1>(a, l, tid, lane, wave, bid, G)); GSYNC();
        PH(phase_mixers<2>(a, l, tid, lane, wave, bid, G)); GSYNC();
        PH(phase_post(a, l, lane, gw, GW)); GSYNC();
        PH(phase_glu_gates(a, tid, bid, G)); PH(phase_prepx(a, l, tid, bid, G)); GSYNC();
        PH(phase_merge2(a, tid, bid, G)); GSYNC();
        PH(phase_wout2(a, l, tid, bid, G)); GSYNC();
        PH(phase_ln1r(a, l, tid, lane, wave, bid, G)); GSYNC();
        PH(phase_slot(a, tid, lane, wave, bid, G)); GSYNC();
        PH(phase_moe_gu2(a, tid, bid, G)); GSYNC();
        PH(phase_moe_dn2(a, tid, bid, G)); GSYNC();
        PH(phase_ln2(a, l, lane, gw, GW)); if (l + 1 < NLAYER) GSYNC();
    }
}

extern "C" void kernel_launch(void* const* d_in, const int* in_sizes, int n_in, void* d_out, int out_size, void* d_ws, size_t ws_size, hipStream_t stream) {
    static int grid = 0;
    if (grid == 0) {
        if (n_in != 34 || out_size != T * D || ws_size < WS_TOTAL) { fprintf(stderr, "kernel_launch: unexpected shapes (n_in %d, out %d, ws %zu, need %zu)\n", n_in, out_size, ws_size, (size_t)WS_TOTAL); grid = -1; return; }
        int dev = 0, cus = 0, per_cu = 0;
        (void)hipGetDevice(&dev); (void)hipDeviceGetAttribute(&cus, hipDeviceAttributeMultiprocessorCount, dev);
        (void)hipFuncSetAttribute((const void*)fwd, hipFuncAttributeMaxDynamicSharedMemorySize, LDS_BYTES);
        (void)hipOccupancyMaxActiveBlocksPerMultiprocessor(&per_cu, (const void*)fwd, 512, LDS_BYTES);
        if (per_cu < 1) { fprintf(stderr, "kernel_launch: occupancy query says %d blocks per CU\n", per_cu); per_cu = 1; }
        grid = (cus > 0 ? cus : 256) * 1;
        (void)hipGetLastError();
    }
    if (grid < 0) return;
    Args a{};
    for (int i = 0; i < 34; ++i) a.in[i] = (const float*)d_in[i];
    a.out = (float*)d_out; a.ws = (unsigned char*)d_ws; a.ph_lo = 0; a.ph_hi = NLAYER * NPH;
    (void)hipMemsetAsync((unsigned char*)d_ws + OFF_BAR, 0, 16384, stream);
    void* args[] = {&a};
    hipError_t e = hipLaunchCooperativeKernel((const void*)fwd, dim3(grid), dim3(512), args, LDS_BYTES, stream);
    if (e != hipSuccess) fprintf(stderr, "kernel_launch: cooperative launch failed: %s (grid %d)\n", hipGetErrorString(e), grid);
}
```

```cpp
#include <hip/hip_runtime.h>
#include <hip/hip_cooperative_groups.h>
#include <cstdio>
#include <cstdint>
namespace cg = cooperative_groups;

typedef unsigned short bf16_t;
typedef short bf16x8 __attribute__((ext_vector_type(8)));
typedef short bf16x4 __attribute__((ext_vector_type(4)));
typedef float f32x4 __attribute__((ext_vector_type(4)));
typedef unsigned u32x4 __attribute__((ext_vector_type(4)));
typedef unsigned u32x2 __attribute__((ext_vector_type(2)));

constexpr int T = 16384, D = 1024, NZ = 3584, NWIN = 6912, INW = 6664;
constexpr int NPH = 15, NLAYER = 2;
constexpr int GSEG = 32, GSEGLEN = 512;
constexpr int SSEG = 64, SSEGLEN = 256;
constexpr int SLOTS = 40960;
constexpr float DN_ALPHA = 1.41421356237f;
constexpr int LDS_BYTES = 131072 + 256;

constexpr size_t AL(size_t x) { return (x + 255) & ~(size_t)255; }
constexpr size_t OFF_WIN = 0;
constexpr size_t OFF_WQKV = OFF_WIN + AL((size_t)NWIN * 1024 * 2);
constexpr size_t OFF_WGLU = OFF_WQKV + AL((size_t)1536 * 512 * 2);
constexpr size_t OFF_WB = OFF_WGLU + AL((size_t)512 * 512 * 2);
constexpr size_t OFF_WOUT = OFF_WB + AL((size_t)3 * 1024 * 512 * 2);
constexpr size_t OFF_ABAR = OFF_WOUT + AL((size_t)1024 * 1024 * 2);
constexpr size_t OFF_BBT = OFF_ABAR + AL((size_t)32 * 64 * 2 * 4);
constexpr size_t OFF_CCT = OFF_BBT + AL((size_t)32 * 128 * 16 * 2);
constexpr size_t OFF_CTL = OFF_CCT + AL((size_t)32 * 16 * 128 * 2);
constexpr size_t OFF_TOKE = OFF_CTL + 4096;
constexpr size_t OFF_TOKG = OFF_TOKE + AL((size_t)T * 2 * 4);
constexpr size_t OFF_TOKS = OFF_TOKG + AL((size_t)T * 2 * 4);
constexpr size_t OFF_SLOTT = OFF_TOKS + AL((size_t)T * 2 * 4);
constexpr size_t OFF_XB = OFF_SLOTT + AL((size_t)SLOTS * 4);
constexpr size_t OFF_R1 = OFF_XB + AL((size_t)T * 1024 * 2);
constexpr size_t SZ_ACT = (size_t)T * 512 * 2;
constexpr size_t OFF_XC = OFF_R1, OFF_Q = OFF_R1 + SZ_ACT, OFF_KH = OFF_R1 + 2 * SZ_ACT, OFF_V = OFF_R1 + 3 * SZ_ACT;
constexpr size_t OFF_WGU = OFF_R1, OFF_WD = OFF_R1 + (size_t)32 * 512 * 1024 * 2;
constexpr size_t OFF_Z = OFF_R1 + 4 * SZ_ACT;
constexpr size_t OFF_XG = OFF_Z, OFF_H = OFF_Z + (size_t)SLOTS * 1024 * 2;
constexpr size_t OFF_ZS = OFF_Z + AL((size_t)T * NZ * 2);
constexpr size_t OFF_LF = OFF_ZS + AL((size_t)T * 8 * 4);
constexpr size_t OFF_LI = OFF_LF + AL((size_t)T * 4 * 4);
constexpr size_t OFF_E = OFF_LI + AL((size_t)T * 4 * 4);
constexpr size_t OFF_OM = OFF_E, OFF_OH = OFF_E + SZ_ACT, OFF_YPRE = OFF_E + 2 * SZ_ACT, OFF_YSG = OFF_E + 3 * SZ_ACT;
constexpr size_t OFF_DEN = OFF_E + 4 * SZ_ACT;
constexpr size_t OFF_EM = OFF_DEN + AL((size_t)T * 4 * 4);
constexpr size_t OFF_EMX = OFF_EM + AL((size_t)GSEG * 4 * 128 * 128 * 4);
constexpr size_t OFF_GM = OFF_EMX + AL((size_t)GSEG * 4 * 128 * 16 * 4);
constexpr size_t OFF_EH = OFF_GM + AL((size_t)GSEG * 4 * 128 * 4);
constexpr size_t OFF_GH = OFF_EH + AL((size_t)GSEG * 4 * 128 * 128 * 4);
constexpr size_t OFF_ES = OFF_GH + AL((size_t)GSEG * 4 * 128 * 4);
constexpr size_t WS_END = OFF_ES + AL((size_t)SSEG * 32 * 64 * 2 * 4);
constexpr size_t OFF_YS = OFF_E;
constexpr size_t OFF_RWT = WS_END;
constexpr size_t OFF_HIST = OFF_RWT + 32 * 1024 * 4;
constexpr size_t OFF_BAR = OFF_HIST + 1024 * 32 * 4;
constexpr size_t WS_TOTAL = OFF_BAR + 16384;
static_assert(OFF_YS + (size_t)SLOTS * 1024 * 2 <= WS_END, "YS must fit in the dead region");
static_assert(OFF_H + (size_t)SLOTS * 256 * 2 <= OFF_ZS, "H must fit in the dead Z region");
static_assert(OFF_WD + (size_t)32 * 1024 * 256 * 2 <= OFF_Z, "expert weights must fit in R1");

struct Args { const float* in[34]; float* out; unsigned char* ws; int ph_lo, ph_hi; };
typedef const __attribute__((address_space(4))) Args& ArgsRef;

extern __shared__ __attribute__((aligned(16))) unsigned char smem[];

__device__ __forceinline__ bf16_t f2bf(float f) { unsigned u = __float_as_uint(f); u += 0x7FFFu + ((u >> 16) & 1u); return (bf16_t)(u >> 16); }
__device__ __forceinline__ float bf2f(bf16_t b) { return __uint_as_float(((unsigned)b) << 16); }
__device__ __forceinline__ unsigned pack2(float lo, float hi) { return (unsigned)f2bf(lo) | ((unsigned)f2bf(hi) << 16); }
__device__ __forceinline__ float fexp(float x) { return __builtin_amdgcn_exp2f(x * 1.4426950408889634f); }
__device__ __forceinline__ float flog(float x) { return __builtin_amdgcn_logf(x) * 0.6931471805599453f; }
__device__ __forceinline__ float sigmoidf_(float x) { return __builtin_amdgcn_rcpf(1.0f + fexp(-x)); }
__device__ __forceinline__ float siluf_(float x) { return x * __builtin_amdgcn_rcpf(1.0f + fexp(-x)); }
__device__ __forceinline__ float logsigmoidf_(float x) { return fminf(x, 0.f) - log1pf(expf(-fabsf(x))); }
__device__ __forceinline__ float gelu_tanh(float y) { const float z = 0.7978845608028654f * (y + 0.044715f * y * y * y); const float th = 1.0f - 2.0f * __builtin_amdgcn_rcpf(fexp(2.0f * z) + 1.0f); return 0.5f * y * (1.0f + th); }
__device__ __forceinline__ void wave_sync() { __builtin_amdgcn_wave_barrier(); asm volatile("s_waitcnt lgkmcnt(0)" ::: "memory"); __builtin_amdgcn_wave_barrier(); }

#define MFMA16(a, b, c) __builtin_amdgcn_mfma_f32_16x16x32_bf16((a), (b), (c), 0, 0, 0)

template <int MT, int NT, class FA, class FB>
__device__ __forceinline__ void wave_gemm(f32x4 (&acc)[MT][NT], int K, FA arow, FB brow, int lane) {
    const int r = lane & 15, q = lane >> 4;
    const bf16_t* ap[MT]; const bf16_t* bp[NT];
#pragma unroll
    for (int m = 0; m < MT; ++m) ap[m] = arow(m * 16 + r) + 8 * q;
#pragma unroll
    for (int n = 0; n < NT; ++n) bp[n] = brow(n * 16 + r) + 8 * q;
#pragma unroll 1
    for (int k = 0; k < K; k += 32) {
        bf16x8 a[MT], b[NT];
#pragma unroll
        for (int m = 0; m < MT; ++m) a[m] = *(const bf16x8*)(ap[m] + k);
#pragma unroll
        for (int n = 0; n < NT; ++n) b[n] = *(const bf16x8*)(bp[n] + k);
#pragma unroll
        for (int m = 0; m < MT; ++m)
#pragma unroll
            for (int n = 0; n < NT; ++n) acc[m][n] = MFMA16(a[m], b[n], acc[m][n]);
    }
}
template <int MT, int NT> __device__ __forceinline__ void zero_acc(f32x4 (&acc)[MT][NT]) {
#pragma unroll
    for (int m = 0; m < MT; ++m)
#pragma unroll
        for (int n = 0; n < NT; ++n) acc[m][n] = (f32x4){0.f, 0.f, 0.f, 0.f};
}

namespace pg8 {
#define PG8_LAS __attribute__((address_space(3)))
constexpr int BM = 256, BK = 64, HALF = 128, HTB = HALF * BK * 2, STAGE_BYTES = 8 * HTB;
__device__ __forceinline__ int lds_byte(int r, int c) { const int st = (r >> 4) * 2 + (c >> 5), rr = r & 15, cc = c & 31, ob = rr * 64 + cc * 2; return st * 1024 + (ob ^ (((ob >> 9) & 1) << 5)); }
__device__ __forceinline__ void stage_rc(int b, int& R, int& C) { const int st = b / 1024, sb = b % 1024, swz = sb ^ (((sb >> 9) & 1) << 5); R = (st >> 1) * 16 + swz / 64; C = (st & 1) * 32 + (swz % 64) / 2; }
__device__ __forceinline__ int perm32(int rho) { const int n = rho >> 4, i = rho & 15; return 8 * (i >> 2) + 4 * n + (i & 3); }
struct Unit { int pm, pn, tag; const char* A; const char* B; };
__device__ __forceinline__ unsigned cvt_pk_bf16(float lo, float hi) { unsigned r; asm volatile("v_cvt_pk_bf16_f32 %0, %1, %2" : "=v"(r) : "v"(lo), "v"(hi)); return r; }
__device__ __forceinline__ bool tile_order(int L, int nM, int nN, int& pm, int& pn) {
    const int nwg = nM * nN; if (L >= nwg) return false;
    int wgid = L; { const int q = nwg / 8, r = nwg % 8, xcd = wgid % 8, off = wgid / 8; wgid = (xcd < r ? xcd * (q + 1) : r * (q + 1) + (xcd - r) * q) + off; }
    const int nig = 8 * nN, gid = wgid / nig, fm = gid * 8, gsz = (nM - fm) < 8 ? (nM - fm) : 8;
    pm = fm + ((wgid % nig) % gsz); pn = (wgid % nig) / gsz; return true;
}
template <class Epi, class Sched>
__device__ __forceinline__ void gemm_phase(PG8_LAS unsigned char* lds, const int tid, const int K, const int lda, const int ldb, const Sched& S, const Epi& E) {
    const int wid = __builtin_amdgcn_readfirstlane(tid >> 6), lane = tid & 63, wr = wid >> 2, wc = wid & 3, fr = lane & 15, fq = lane >> 4;
    const int nt = K / BK;
    unsigned voffA[2], voffB[2];
#pragma unroll
    for (int i = 0; i < 2; ++i) { int R, C; stage_rc(tid * 16 + i * 8192, R, C); const int Rb = Epi::PERM ? ((R & ~31) + perm32(R & 31)) : R;
        voffA[i] = (unsigned)(R * lda + C) * 2u; voffB[i] = (unsigned)(Rb * ldb + C) * 2u; }
    const size_t kstep = (size_t)(BK * 2), hstepA = (size_t)HALF * lda * 2, hstepB = (size_t)HALF * ldb * 2;
    const unsigned ldsw = (unsigned)wid * 1024u;
    const int aoff = lds_byte(wr * 64 + fr, fq * 8), boff = lds_byte(wc * 32 + fr, fq * 8);
#define PG8_SA(b, h) (((b) * 2 + (h)) * HTB)
#define PG8_SB(b, h) ((4 + (b) * 2 + (h)) * HTB)
#define PG8_STAGE(bufoff, gbase, voff) do { _Pragma("unroll") for (int _i = 0; _i < 2; ++_i) \
        __builtin_amdgcn_global_load_lds((const unsigned*)((const char*)(gbase) + (voff)[_i]), (PG8_LAS unsigned*)(lds + (bufoff) + ldsw + _i * 8192), 16, 0, 0); } while (0)
#define PG8_LDA(dst, b, h) do { _Pragma("unroll") for (int m = 0; m < 4; ++m) _Pragma("unroll") for (int k = 0; k < 2; ++k) dst[m][k] = *(const PG8_LAS bf16x8*)(lds + PG8_SA(b, h) + aoff + m * 2048 + k * 1024); } while (0)
#define PG8_LDB(dst, b, h) do { _Pragma("unroll") for (int n = 0; n < 2; ++n) _Pragma("unroll") for (int k = 0; k < 2; ++k) dst[n][k] = *(const PG8_LAS bf16x8*)(lds + PG8_SB(b, h) + boff + n * 2048 + k * 1024); } while (0)
#define PG8_MMA(ai, bj, At, Bt) do { __builtin_amdgcn_s_setprio(1); _Pragma("unroll") for (int m = 0; m < 4; ++m) _Pragma("unroll") for (int n = 0; n < 2; ++n) _Pragma("unroll") for (int k = 0; k < 2; ++k) \
        acc[ai][bj][m][n] = __builtin_amdgcn_mfma_f32_16x16x32_bf16(Bt[n][k], At[m][k], acc[ai][bj][m][n], 0, 0, 0); __builtin_amdgcn_s_setprio(0); } while (0)
#define PG8_WAIT_V(n) asm volatile("s_waitcnt vmcnt(" #n ")" ::: "memory")
#define PG8_WAIT_L(n) asm volatile("s_waitcnt lgkmcnt(" #n ")" ::: "memory")
#define PG8_BAR __builtin_amdgcn_s_barrier()
#define PG8_SCHED __builtin_amdgcn_sched_barrier(0)
    Unit cur, nxt; int ui = 0;
    if (!S.next(0, cur)) return;
    f32x4 acc[2][2][4][2];
#pragma unroll
    for (int a = 0; a < 2; ++a)
#pragma unroll
        for (int b = 0; b < 2; ++b)
#pragma unroll
            for (int m = 0; m < 4; ++m)
#pragma unroll
                for (int n = 0; n < 2; ++n) acc[a][b][m][n] = (f32x4){0.f, 0.f, 0.f, 0.f};
    bf16x8 At[4][2], B0[2][2], B1[2][2];
    const char* cA = cur.A; const char* cB = cur.B;
    PG8_STAGE(PG8_SB(0, 0), cB, voffB); PG8_STAGE(PG8_SA(0, 0), cA, voffA); PG8_STAGE(PG8_SB(0, 1), cB + hstepB, voffB); PG8_STAGE(PG8_SA(0, 1), cA + hstepA, voffA);
    if (wr == 1) PG8_BAR;
    PG8_WAIT_V(4); PG8_BAR;
    PG8_STAGE(PG8_SB(1, 0), cB + kstep, voffB); PG8_STAGE(PG8_SA(1, 0), cA + kstep, voffA); PG8_STAGE(PG8_SB(1, 1), cB + hstepB + kstep, voffB);
    PG8_WAIT_V(6); PG8_BAR;
    for (;;) {
        const bool has_next = S.next(ui + 1, nxt);
        const char* nA = has_next ? nxt.A : cA; const char* nB = has_next ? nxt.B : cB;
        for (int t = 0; t < nt; t += 2) {
            const bool last = (t == nt - 2);
            const char* a1 = cA + (size_t)(t + 1) * kstep;
            const char* a2 = last ? nA : cA + (size_t)(t + 2) * kstep; const char* b2 = last ? nB : cB + (size_t)(t + 2) * kstep;
            const char* a3 = a2 + kstep; const char* b3 = b2 + kstep;
            PG8_LDB(B0, 0, 0); PG8_SCHED; PG8_LDA(At, 0, 0); PG8_STAGE(PG8_SA(1, 1), a1 + hstepA, voffA);
            PG8_WAIT_L(8); PG8_BAR; PG8_WAIT_L(0); PG8_MMA(0, 0, At, B0); PG8_BAR; PG8_SCHED;
            PG8_LDB(B1, 0, 1); PG8_STAGE(PG8_SB(0, 0), b2, voffB);
            PG8_BAR; PG8_WAIT_L(0); PG8_MMA(0, 1, At, B1); PG8_BAR;
            PG8_LDA(At, 0, 1); PG8_STAGE(PG8_SA(0, 0), a2, voffA);
            PG8_BAR; PG8_WAIT_L(0); PG8_MMA(1, 0, At, B0); PG8_BAR; PG8_SCHED;
            PG8_STAGE(PG8_SB(0, 1), b2 + hstepB, voffB);
            PG8_WAIT_V(6); PG8_BAR; PG8_MMA(1, 1, At, B1); PG8_BAR;
            PG8_LDB(B0, 1, 0); PG8_SCHED; PG8_LDA(At, 1, 0); PG8_STAGE(PG8_SA(0, 1), a2 + hstepA, voffA);
            PG8_WAIT_L(8); PG8_BAR; PG8_WAIT_L(0); PG8_MMA(0, 0, At, B0); PG8_BAR; PG8_SCHED;
            PG8_LDB(B1, 1, 1); PG8_STAGE(PG8_SB(1, 0), b3, voffB);
            PG8_BAR; PG8_WAIT_L(0); PG8_MMA(0, 1, At, B1); PG8_BAR;
            PG8_LDA(At, 1, 1); PG8_STAGE(PG8_SA(1, 0), a3, voffA);
            PG8_BAR; PG8_WAIT_L(0); PG8_MMA(1, 0, At, B0); PG8_BAR; PG8_SCHED;
            PG8_STAGE(PG8_SB(1, 1), b3 + hstepB, voffB);
            PG8_WAIT_V(6); PG8_BAR; PG8_MMA(1, 1, At, B1); PG8_BAR;
        }
        const bool keep = E(acc, cur, wr, wc, fr, fq);
        if (!has_next) break;
        if (!keep) {
#pragma unroll
            for (int a = 0; a < 2; ++a)
#pragma unroll
                for (int b = 0; b < 2; ++b)
#pragma unroll
                    for (int m = 0; m < 4; ++m)
#pragma unroll
                        for (int n = 0; n < 2; ++n) acc[a][b][m][n] = (f32x4){0.f, 0.f, 0.f, 0.f};
        }
        cur = nxt; cA = nA; cB = nB; ++ui;
    }
    PG8_WAIT_V(0);
    if (wr == 0) PG8_BAR;
    PG8_BAR;
#undef PG8_SA
#undef PG8_SB
#undef PG8_STAGE
#undef PG8_LDA
#undef PG8_LDB
#undef PG8_MMA
#undef PG8_WAIT_V
#undef PG8_WAIT_L
#undef PG8_BAR
#undef PG8_SCHED
}
}

__device__ __forceinline__ void tconv_tile(const float* src, int ld_src, int nvalid, bf16_t* dst, int ld_dst, int tid) {
    float* t = (float*)smem;
    { const int r = tid >> 3, c0 = (tid & 7) * 8;
#pragma unroll
      for (int j = 0; j < 8; ++j) { const int c = c0 + j; const float v = (c < nvalid) ? src[(size_t)r * ld_src + c] : 0.f; t[c * 65 + r] = v; } }
    __syncthreads();
    { const int n = tid >> 3, k0 = (tid & 7) * 8; const float* p = t + n * 65 + k0;
      u32x4 w; w.x = pack2(p[0], p[1]); w.y = pack2(p[2], p[3]); w.z = pack2(p[4], p[5]); w.w = pack2(p[6], p[7]);
      *(u32x4*)(dst + (size_t)n * ld_dst + k0) = w; }
    __syncthreads();
}

__device__ __forceinline__ void phase_prep(ArgsRef a, int l, int tid, int bid, int G) {
    unsigned char* ws = a.ws;
    bf16_t* WIN = (bf16_t*)(ws + OFF_WIN); bf16_t* WQKV = (bf16_t*)(ws + OFF_WQKV); bf16_t* WGLU = (bf16_t*)(ws + OFF_WGLU);
    bf16_t* WB = (bf16_t*)(ws + OFF_WB); bf16_t* WOUT = (bf16_t*)(ws + OFF_WOUT);
    for (int u = bid; u < 2624; u += G) {
        const float* src; int lds_ = 0, nvalid = 64, ldd = 0; bf16_t* dst;
        if (u < 1728) { const int nt = u / 16, kt = u % 16, p0 = nt * 64; int sc;
            if (p0 < 1024) sc = p0; else if (p0 < 6656) sc = p0 + 8; else if (p0 == 6656) { sc = 1024; nvalid = 8; } else { sc = 0; nvalid = 0; }
            src = a.in[1] + (size_t)l * 1024 * INW + (size_t)(kt * 64) * INW + sc; lds_ = INW; dst = WIN + (size_t)p0 * 1024 + kt * 64; ldd = 1024; }
        else if (u < 1920) { const int v = u - 1728, nt = v / 8, kt = v % 8, which = nt / 8, h = (nt % 8) / 2;
            if ((kt >> 1) != h) nvalid = 0;
            src = a.in[4 + which] + (size_t)(l * 4 + h) * 128 * 128 + ((kt & 1) * 64) * 128 + (nt & 1) * 64; lds_ = 128; dst = WQKV + (size_t)(nt * 64) * 512 + kt * 64; ldd = 512; }
        else if (u < 1984) { const int v = u - 1920, nt = v / 8, kt = v % 8;
            src = a.in[18] + (size_t)l * 512 * 512 + (kt * 64) * 512 + nt * 64; lds_ = 512; dst = WGLU + (size_t)(nt * 64) * 512 + kt * 64; ldd = 512; }
        else if (u < 2368) { const int v = u - 1984, b = v / 128, w = v % 128, nt = w / 8, kt = w % 8;
            src = a.in[21 + b] + (size_t)l * 512 * 1024 + (size_t)(kt * 64) * 1024 + nt * 64; lds_ = 1024; dst = WB + (size_t)b * 1024 * 512 + (size_t)(nt * 64) * 512 + kt * 64; ldd = 512; }
        else { const int v = u - 2368, nt = v / 16, kt = v % 16;
            src = a.in[24] + (size_t)l * 1024 * 1024 + (size_t)(kt * 64) * 1024 + nt * 64; lds_ = 1024; dst = WOUT + (size_t)(nt * 64) * 1024 + kt * 64; ldd = 1024; }
        tconv_tile(src, lds_, nvalid, dst, ldd, tid);
    }
    float* ABAR = (float*)(ws + OFF_ABAR); bf16_t* BBT = (bf16_t*)(ws + OFF_BBT); bf16_t* CCT = (bf16_t*)(ws + OFF_CCT);
    for (int i = bid * 512 + tid; i < 2048; i += G * 512) {
        const int g = i / 64, p = i % 64; const size_t gp = (size_t)(l * 32 + g) * 64 + p;
        const float lr = fminf(a.in[10][gp], -1e-4f), li = a.in[11][gp], dt = expf(a.in[12][l * 32 + g]);
        const float mag = expf(lr * dt), abr = mag * cosf(li * dt), abi = mag * sinf(li * dt);
        const float nr = abr - 1.0f, den = lr * lr + li * li, cr = (nr * lr + abi * li) / den, ci = (abi * lr - nr * li) / den;
        ABAR[(g * 64 + p) * 2] = abr; ABAR[(g * 64 + p) * 2 + 1] = abi;
        for (int c = 0; c < 16; ++c) { const float br = a.in[13][gp * 16 + c], bi = a.in[14][gp * 16 + c];
            BBT[(size_t)(g * 128 + p) * 16 + c] = f2bf(cr * br - ci * bi); BBT[(size_t)(g * 128 + 64 + p) * 16 + c] = f2bf(cr * bi + ci * br);
            const size_t ci_ = ((size_t)(l * 32 + g) * 16 + c) * 64 + p;
            CCT[(size_t)(g * 16 + c) * 128 + p] = f2bf(a.in[15][ci_]); CCT[(size_t)(g * 16 + c) * 128 + 64 + p] = f2bf(-a.in[16][ci_]); }
    }
    { float* RWT = (float*)(ws + OFF_RWT); const float* RW = a.in[29]; for (int i = bid * 512 + tid; i < 32 * 1024; i += G * 512) RWT[i] = RW[(i & 1023) * 32 + (i >> 10)]; }
    if (bid == 0 && tid < 128) ((unsigned*)(ws + OFF_CTL))[tid] = 0u;
    if (l == 0) { bf16_t* XB = (bf16_t*)(ws + OFF_XB); const float* x = a.in[0];
        for (size_t i = (size_t)bid * 512 + tid; i < (size_t)T * 1024 / 8; i += (size_t)G * 512) {
            const f32x4 v0 = *(const f32x4*)(x + i * 8), v1 = *(const f32x4*)(x + i * 8 + 4);
            u32x4 w; w.x = pack2(v0[0], v0[1]); w.y = pack2(v0[2], v0[3]); w.z = pack2(v1[0], v1[1]); w.w = pack2(v1[2], v1[3]); *(u32x4*)(XB + i * 8) = w; } }
}

__device__ __forceinline__ void phase_prepx(ArgsRef a, int l, int tid, int bid, int G) {
    bf16_t* WGU = (bf16_t*)(a.ws + OFF_WGU); bf16_t* WD = (bf16_t*)(a.ws + OFF_WD);
    for (int u = bid; u < 6144; u += G) {
        const float* src; int lds_, ldd; bf16_t* dst;
        if (u < 4096) { const int up = u >= 2048, v = u & 2047, e = v / 64, w = v % 64, nt = w / 16, kt = w % 16, j0 = nt * 64, drow = (j0 / 128) * 256 + (j0 % 128) + up * 128;
            src = a.in[31 + up] + ((size_t)(l * 32 + e) * 1024 + kt * 64) * 256 + nt * 64; lds_ = 256; dst = WGU + ((size_t)e * 512 + drow) * 1024 + kt * 64; ldd = 1024; }
        else { const int v = u - 4096, e = v / 64, w = v % 64, nt = w / 4, kt = w % 4;
            src = a.in[33] + ((size_t)(l * 32 + e) * 256 + kt * 64) * 1024 + nt * 64; lds_ = 1024; dst = WD + ((size_t)e * 1024 + nt * 64) * 256 + kt * 64; ldd = 256; }
        tconv_tile(src, lds_, 64, dst, ldd, tid);
    }
}

constexpr int GL_QS = 0, GL_KS = 8704, GL_KT = 17408, GL_VT = 27648, GL_PS = 39168, GL_SC1 = 41728, GL_SC2 = 42240, GL_GT = 42752, GL_OS = 44800;
template <int MODE, int PASS>
__device__ __forceinline__ void gla_item(ArgsRef a, int l, int h, int sg, int tid, int lane, int wave) {
    unsigned char* ws = a.ws;
    const bf16_t* Z = (const bf16_t*)(ws + OFF_Z); const bf16_t* Qg = (const bf16_t*)(ws + OFF_Q); const bf16_t* Kg = (const bf16_t*)(ws + OFF_KH); const bf16_t* Vg = (const bf16_t*)(ws + OFF_V);
    const float* LF = (const float*)(ws + OFF_LF);
    float* Eg = (float*)(ws + (MODE == 0 ? OFF_EM : OFF_EH)); float* Gg = (float*)(ws + (MODE == 0 ? OFF_GM : OFF_GH)); float* EX = (float*)(ws + OFF_EMX);
    bf16_t* Og = (bf16_t*)(ws + (MODE == 0 ? OFF_OM : OFF_OH)); float* DEN = (float*)(ws + OFF_DEN);
    bf16_t* QS = (bf16_t*)(smem + GL_QS); bf16_t* KS = (bf16_t*)(smem + GL_KS); bf16_t* KT = (bf16_t*)(smem + GL_KT); bf16_t* VT = (bf16_t*)(smem + GL_VT); bf16_t* PS = (bf16_t*)(smem + GL_PS);
    float* SC1 = (float*)(smem + GL_SC1); float* SC2 = (float*)(smem + GL_SC2); float* GT = (float*)(smem + GL_GT); bf16_t* OS = (bf16_t*)(smem + GL_OS);
    const int r = lane & 15, q = lane >> 4, grp = tid >> 7, d = tid & 127;
    const bool xw = (MODE == 0) && (wave == 0);
    float lb = 0.f;
    if (MODE == 1 && l == 1) { const float h0 = a.in[19][h * 128 + d], h1 = a.in[19][512 + h * 128 + d]; lb = 1.0f / (1.0f + expf(h0 - h1)); }
    f32x4 S[8], SX[8];
#pragma unroll
    for (int i = 0; i < 8; ++i) { S[i] = (f32x4){0.f, 0.f, 0.f, 0.f}; SX[i] = (f32x4){0.f, 0.f, 0.f, 0.f}; }
    if (PASS == 2) {
#pragma unroll
        for (int i = 0; i < 8; ++i)
#pragma unroll
            for (int g = 0; g < 4; ++g) { const size_t row = (size_t)(sg * 4 + h) * 128 + 16 * i + 4 * q + g; S[i][g] = Eg[row * 128 + 16 * wave + r]; if (xw) SX[i][g] = EX[row * 16 + r]; }
    }
    __syncthreads();
    if (MODE == 0) { for (int i = tid; i < 16 * 40; i += 512) VT[128 * 40 + i] = (i < 32) ? (bf16_t)0x3F80 : (bf16_t)0; }
    float runb = 0.f;
    for (int ci = 0; ci < GSEGLEN / 32; ++ci) {
        const int t0 = sg * GSEGLEN + ci * 32, tb = t0 + grp * 8;
        float lg[8], qv[8], kv[8]; bf16_t vv[8];
#pragma unroll
        for (int j = 0; j < 8; ++j) {
            if (MODE == 1) { const size_t zo = (size_t)(tb + j) * NZ + h * 128 + d; const float qp = bf2f(Z[zo + 1536]), fp = bf2f(Z[zo + 2048]);
                const float f = lb + (1.0f - lb) * sigmoidf_(fp); lg[j] = flog(f); qv[j] = siluf_(qp); kv[j] = 1.0f - f; vv[j] = Z[zo + 2560]; }
            else { const size_t o = (size_t)(tb + j) * 512 + h * 128 + d; qv[j] = bf2f(Qg[o]); kv[j] = bf2f(Kg[o]); vv[j] = Vg[o]; lg[j] = LF[(tb + j) * 4 + h]; }
        }
        float cs[8]; cs[0] = lg[0];
#pragma unroll
        for (int j = 1; j < 8; ++j) cs[j] = cs[j - 1] + lg[j];
        GT[grp * 128 + d] = cs[7];
        __syncthreads();
        if (PASS == 2 && ci > 0) { const int row = tid >> 4, c8 = (tid & 15) * 8; *(u32x4*)(Og + (size_t)(t0 - 32 + row) * 512 + h * 128 + c8) = *(const u32x4*)(OS + row * 136 + c8); }
        const float g0 = GT[d], g1 = GT[128 + d], g2 = GT[256 + d], g3 = GT[384 + d];
        const float off = grp == 0 ? 0.f : grp == 1 ? g0 : grp == 2 ? g0 + g1 : g0 + g1 + g2;
        const float bmid = g0 + g1, bL = bmid + g2 + g3;
        bf16_t ktv[8];
#pragma unroll
        for (int j = 0; j < 8; ++j) { const float bt = off + cs[j]; const bf16_t kt = f2bf(kv[j] * fexp(bmid - bt)); ktv[j] = kt;
            if (PASS == 2) { QS[(grp * 8 + j) * 136 + d] = f2bf(qv[j] * fexp(bt - bmid)); KS[(grp * 8 + j) * 136 + d] = kt; } }
        { u32x4 w; w.x = ktv[0] | ((unsigned)ktv[1] << 16); w.y = ktv[2] | ((unsigned)ktv[3] << 16); w.z = ktv[4] | ((unsigned)ktv[5] << 16); w.w = ktv[6] | ((unsigned)ktv[7] << 16); *(u32x4*)(KT + d * 40 + grp * 8) = w;
          u32x4 x; x.x = vv[0] | ((unsigned)vv[1] << 16); x.y = vv[2] | ((unsigned)vv[3] << 16); x.z = vv[4] | ((unsigned)vv[5] << 16); x.w = vv[6] | ((unsigned)vv[7] << 16); *(u32x4*)(VT + d * 40 + grp * 8) = x; }
        if (grp == 0) { SC1[d] = fexp(bmid); SC2[d] = fexp(bL - bmid); runb += bL; }
        __syncthreads();
        if (PASS == 2) {
            if (wave < 4) {
                const int ti = (wave == 1 || wave == 2) ? 1 : 0, tj = (wave >= 2) ? 1 : 0;
                f32x4 p = (f32x4){0.f, 0.f, 0.f, 0.f};
                if (wave < 3) {
#pragma unroll
                    for (int kk = 0; kk < 4; ++kk) { const bf16x8 av = *(const bf16x8*)(QS + (16 * ti + r) * 136 + 32 * kk + 8 * q); const bf16x8 bv = *(const bf16x8*)(KS + (16 * tj + r) * 136 + 32 * kk + 8 * q); p = MFMA16(av, bv, p); }
                }
#pragma unroll
                for (int g = 0; g < 4; ++g) { const int t = 16 * ti + 4 * q + g, s = 16 * tj + r; PS[t * 40 + s] = (wave < 3 && s <= t) ? f2bf(p[g]) : (bf16_t)0; }
            }
            __syncthreads();
        }
        const bf16x8 bV = *(const bf16x8*)(VT + (16 * wave + r) * 40 + 8 * q);
        bf16x8 bV1 = bV; if (xw) bV1 = *(const bf16x8*)(VT + (128 + r) * 40 + 8 * q);
        f32x4 o[2], ox[2];
        o[0] = o[1] = ox[0] = ox[1] = (f32x4){0.f, 0.f, 0.f, 0.f};
#pragma unroll
        for (int kk = 0; kk < 4; ++kk) {
            const f32x4 sa = *(const f32x4*)(SC1 + 32 * kk + 4 * q), sb = *(const f32x4*)(SC1 + 32 * kk + 16 + 4 * q);
            S[2 * kk] *= sa; S[2 * kk + 1] *= sb;
            if (xw) { SX[2 * kk] *= sa; SX[2 * kk + 1] *= sb; }
            if (PASS == 2) {
                bf16x8 bS, bX;
#pragma unroll
                for (int g = 0; g < 4; ++g) { bS[g] = (short)f2bf(S[2 * kk][g]); bS[4 + g] = (short)f2bf(S[2 * kk + 1][g]); bX[g] = (short)f2bf(SX[2 * kk][g]); bX[4 + g] = (short)f2bf(SX[2 * kk + 1][g]); }
#pragma unroll
                for (int mt = 0; mt < 2; ++mt) { const bf16x4 lo = *(const bf16x4*)(QS + (16 * mt + r) * 136 + 32 * kk + 4 * q), hi = *(const bf16x4*)(QS + (16 * mt + r) * 136 + 32 * kk + 16 + 4 * q);
                    bf16x8 av; av[0] = lo[0]; av[1] = lo[1]; av[2] = lo[2]; av[3] = lo[3]; av[4] = hi[0]; av[5] = hi[1]; av[6] = hi[2]; av[7] = hi[3];
                    o[mt] = MFMA16(av, bS, o[mt]); if (xw) ox[mt] = MFMA16(av, bX, ox[mt]); }
            }
        }
        if (PASS == 2) {
#pragma unroll
            for (int mt = 0; mt < 2; ++mt) { const bf16x8 av = *(const bf16x8*)(PS + (16 * mt + r) * 40 + 8 * q); o[mt] = MFMA16(av, bV, o[mt]); if (xw) ox[mt] = MFMA16(av, bV1, ox[mt]);
#pragma unroll
                for (int g = 0; g < 4; ++g) { const int t = t0 + 16 * mt + 4 * q + g; OS[(16 * mt + 4 * q + g) * 136 + 16 * wave + r] = f2bf(o[mt][g]); if (xw && r == 0) DEN[h * T + t] = ox[mt][g]; } }
        }
#pragma unroll
        for (int i = 0; i < 8; ++i) { const bf16x8 av = *(const bf16x8*)(KT + (16 * i + r) * 40 + 8 * q); const f32x4 s2 = *(const f32x4*)(SC2 + 16 * i + 4 * q);
            S[i] = MFMA16(av, bV, S[i]); S[i] *= s2;
            if (xw) { SX[i] = MFMA16(av, bV1, SX[i]); SX[i] *= s2; } }
    }
    if (PASS == 2) { __syncthreads(); const int row = tid >> 4, c8 = (tid & 15) * 8; *(u32x4*)(Og + (size_t)(sg * GSEGLEN + GSEGLEN - 32 + row) * 512 + h * 128 + c8) = *(const u32x4*)(OS + row * 136 + c8); }
    if (PASS == 1) {
        float* ST = (float*)smem;
        __syncthreads();
#pragma unroll
        for (int i = 0; i < 8; ++i)
#pragma unroll
            for (int g = 0; g < 4; ++g) { ST[(16 * i + 4 * q + g) * 132 + 16 * wave + r] = S[i][g]; if (xw) EX[((size_t)(sg * 4 + h) * 128 + 16 * i + 4 * q + g) * 16 + r] = SX[i][g]; }
        __syncthreads();
#pragma unroll
        for (int k = 0; k < 8; ++k) { const int idx = tid + 512 * k, row = idx >> 5, c4 = (idx & 31) * 4; *(f32x4*)(Eg + ((size_t)(sg * 4 + h) * 128 + row) * 128 + c4) = *(const f32x4*)(ST + row * 132 + c4); }
        if (grp == 0) Gg[(size_t)(sg * 4 + h) * 128 + d] = expf(runb);
    }
}

template <int PASS>
__device__ __forceinline__ void s5_item(ArgsRef a, int l, int g, int sg, int g0, int tid, int lane, int wave, int hsel) {
    unsigned char* ws = a.ws;
    const bf16_t* Z = (const bf16_t*)(ws + OFF_Z); const float* ABAR = (const float*)(ws + OFF_ABAR); const bf16_t* BBT = (const bf16_t*)(ws + OFF_BBT); const bf16_t* CCT = (const bf16_t*)(ws + OFF_CCT);
    float* ES = (float*)(ws + OFF_ES); bf16_t* YPRE = (bf16_t*)(ws + OFF_YPRE);
    float* BU = (float*)(smem + 70000 + (wave & 3) * 12800); bf16_t* X = (bf16_t*)(smem + 70000 + (wave & 3) * 12800 + 8448); bf16_t* YT = (bf16_t*)(smem + 70000 + 51200);
    const int r = lane & 15, q = lane >> 4, p = lane; const bool act = (wave >> 2) == hsel;
    const float ar = ABAR[(g * 64 + p) * 2], ai = ABAR[(g * 64 + p) * 2 + 1];
    const bf16x8 zero8 = (bf16x8){0, 0, 0, 0, 0, 0, 0, 0};
    bf16x8 bB[8], cB[4];
#pragma unroll
    for (int nt = 0; nt < 8; ++nt) bB[nt] = (q < 2) ? *(const bf16x8*)(BBT + (size_t)(g * 128 + 16 * nt + r) * 16 + 8 * q) : zero8;
#pragma unroll
    for (int kk = 0; kk < 4; ++kk) cB[kk] = (PASS == 2) ? *(const bf16x8*)(CCT + (size_t)(g * 16 + r) * 128 + 32 * kk + 8 * q) : zero8;
    float xr = 0.f, xi = 0.f;
    if (PASS == 2) { xr = ES[((size_t)(sg * 32 + g) * 64 + p) * 2]; xi = ES[((size_t)(sg * 32 + g) * 64 + p) * 2 + 1]; }
    const float dsk = a.in[17][l * 512 + 16 * g + r];
    for (int ci = 0; ci < SSEGLEN / 16; ++ci) {
        const int t0 = sg * SSEGLEN + ci * 16;
        if (act) {
            const bf16x8 av = (q < 2) ? *(const bf16x8*)(Z + (size_t)(t0 + r) * NZ + 1024 + 16 * g + 8 * q) : zero8;
#pragma unroll
            for (int nt = 0; nt < 8; ++nt) { f32x4 acc = (f32x4){0.f, 0.f, 0.f, 0.f}; acc = MFMA16(av, bB[nt], acc);
#pragma unroll
                for (int gg = 0; gg < 4; ++gg) BU[(4 * q + gg) * 132 + 16 * nt + r] = acc[gg]; }
            wave_sync();
#pragma unroll
            for (int t = 0; t < 16; ++t) { const float br = BU[t * 132 + p], bi = BU[t * 132 + 64 + p];
                const float nr = ar * xr - ai * xi + br, ni = ar * xi + ai * xr + bi; xr = nr; xi = ni;
                if (PASS == 2) { X[t * 136 + p] = f2bf(xr); X[t * 136 + 64 + p] = f2bf(xi); } }
            wave_sync();
            if (PASS == 2) {
                f32x4 acc = (f32x4){0.f, 0.f, 0.f, 0.f};
#pragma unroll
                for (int kk = 0; kk < 4; ++kk) { const bf16x8 xv = *(const bf16x8*)(X + r * 136 + 32 * kk + 8 * q); acc = MFMA16(xv, cB[kk], acc); }
#pragma unroll
                for (int gg = 0; gg < 4; ++gg) { const int t = t0 + 4 * q + gg, c = 16 * g + r; const float u = bf2f(Z[(size_t)t * NZ + 1024 + c]);
                    YT[(4 * q + gg) * 136 + 16 * wave + r] = f2bf(gelu_tanh(acc[gg] + dsk * u)); }
            }
        }
        if (PASS == 2) {
            __syncthreads();
            if (tid < 128) { const int row = tid >> 3, c8 = (tid & 7) * 8; *(u32x4*)(YPRE + (size_t)(t0 + row) * 512 + 16 * g0 + 64 * hsel + c8) = *(const u32x4*)(YT + row * 136 + 64 * hsel + c8); }
            __syncthreads();
        }
    }
    if (PASS == 1 && act) { ES[((size_t)(sg * 32 + g) * 64 + p) * 2] = xr; ES[((size_t)(sg * 32 + g) * 64 + p) * 2 + 1] = xi; }
}

__device__ __forceinline__ void phase_scan(ArgsRef a, int tid, int bid, int G) {
    unsigned char* ws = a.ws;
    const int NT = G * 512, gt = bid * 512 + tid;
    for (int i = gt; i < 2 * 65536 + 8192 + 2048; i += NT) {
        if (i < 2 * 65536) { const int m = i >> 16, el = i & 65535, hrow = el >> 7;
            float* E = (float*)(ws + (m == 0 ? OFF_EM : OFF_EH)); const float* Gd = (const float*)(ws + (m == 0 ? OFF_GM : OFF_GH));
            float cur = 0.f;
#pragma unroll 8
            for (int sg = 0; sg < GSEG; ++sg) { const float e = E[(size_t)sg * 65536 + el], g = Gd[sg * 512 + hrow]; E[(size_t)sg * 65536 + el] = cur; cur = g * cur + e; } }
        else if (i < 2 * 65536 + 8192) { const int el = i - 2 * 65536, hrow = el >> 4; float* E = (float*)(ws + OFF_EMX); const float* Gd = (const float*)(ws + OFF_GM);
            float cur = 0.f;
#pragma unroll 8
            for (int sg = 0; sg < GSEG; ++sg) { const float e = E[(size_t)sg * 8192 + el], g = Gd[sg * 512 + hrow]; E[(size_t)sg * 8192 + el] = cur; cur = g * cur + e; } }
        else { const int el = i - 2 * 65536 - 8192; float* E = (float*)(ws + OFF_ES); const float* ABAR = (const float*)(ws + OFF_ABAR);
            float pr = ABAR[el * 2], pi = ABAR[el * 2 + 1];
#pragma unroll
            for (int k = 0; k < 8; ++k) { const float nr = pr * pr - pi * pi, ni = 2.0f * pr * pi; pr = nr; pi = ni; }
            float xr = 0.f, xi = 0.f;
#pragma unroll 8
            for (int sg = 0; sg < SSEG; ++sg) { const float er = E[((size_t)sg * 2048 + el) * 2], ei = E[((size_t)sg * 2048 + el) * 2 + 1];
                E[((size_t)sg * 2048 + el) * 2] = xr; E[((size_t)sg * 2048 + el) * 2 + 1] = xi;
                const float nr = pr * xr - pi * xi + er, ni = pr * xi + pi * xr + ei; xr = nr; xi = ni; } }
    }
}

template <int PASS>
__device__ __forceinline__ void phase_mixers(ArgsRef a, int l, int tid, int lane, int wave, int bid, int G) {
    for (int it = bid; it < 4 * GSEG; it += G) gla_item<0, PASS>(a, l, it % 4, it / 4, tid, lane, wave);
    asm volatile("" ::: "memory");
    for (int it = bid + ((4 * GSEG - bid % G) % G + G) % G * 0; it < 2 * 4 * GSEG; it += G) { if (it >= 4 * GSEG) gla_item<1, PASS>(a, l, (it - 4 * GSEG) % 4, (it - 4 * GSEG) / 4, tid, lane, wave); }
    __syncthreads();
    for (int it0 = bid * 8; it0 < 32 * SSEG; it0 += G * 8)
        for (int half = 0; half < 2; ++half) { const int it = it0 + wave; s5_item<PASS>(a, l, it % 32, it / 32, it0 % 32, tid, lane, wave, half); __syncthreads(); }
}

__device__ __forceinline__ void phase_post(ArgsRef a, int l, int lane, int gw, int GW) {
    const bf16_t* Z = (const bf16_t*)(a.ws + OFF_Z); const bf16_t* XC = (const bf16_t*)(a.ws + OFF_XC);
    bf16_t* OM = (bf16_t*)(a.ws + OFF_OM); bf16_t* OH = (bf16_t*)(a.ws + OFF_OH); const float* DEN = (const float*)(a.ws + OFF_DEN);
    const int c0 = lane * 8, hd = lane >> 4;
    for (int t = gw; t < T; t += GW) {
        { const bf16x8 o = *(const bf16x8*)(OM + (size_t)t * 512 + c0), op = *(const bf16x8*)(Z + (size_t)t * NZ + 512 + c0), xc = *(const bf16x8*)(XC + (size_t)t * 512 + c0);
          const float dn = 1.0f / fmaxf(fabsf(DEN[hd * T + t]), 1.0f); float y[8];
#pragma unroll
          for (int j = 0; j < 8; ++j) y[j] = sigmoidf_(bf2f((bf16_t)op[j])) * (bf2f((bf16_t)o[j]) * dn) + a.in[9][l * 512 + c0 + j] * bf2f((bf16_t)xc[j]);
          u32x4 w; w.x = pack2(y[0], y[1]); w.y = pack2(y[2], y[3]); w.z = pack2(y[4], y[5]); w.w = pack2(y[6], y[7]); *(u32x4*)(OM + (size_t)t * 512 + c0) = w; }
        { const bf16x8 o = *(const bf16x8*)(OH + (size_t)t * 512 + c0), gp = *(const bf16x8*)(Z + (size_t)t * NZ + 3072 + c0);
          float ov[8], ss = 0.f;
#pragma unroll
          for (int j = 0; j < 8; ++j) { ov[j] = bf2f((bf16_t)o[j]); ss += ov[j] * ov[j]; }
          ss += __shfl_xor(ss, 1); ss += __shfl_xor(ss, 2); ss += __shfl_xor(ss, 4); ss += __shfl_xor(ss, 8);
          const float rinv = rsqrtf(ss * (1.0f / 128.0f) + 1e-6f); float y[8];
#pragma unroll
          for (int j = 0; j < 8; ++j) y[j] = ov[j] * rinv * a.in[20][l * 512 + c0 + j] * siluf_(bf2f((bf16_t)gp[j]));
          u32x4 w; w.x = pack2(y[0], y[1]); w.y = pack2(y[2], y[3]); w.z = pack2(y[4], y[5]); w.w = pack2(y[6], y[7]); *(u32x4*)(OH + (size_t)t * 512 + c0) = w; }
    }
}

__device__ __forceinline__ void ln_row(f32x4 (&v)[4], const float* gam, const float* bet, int lane) {
    float s = 0.f;
#pragma unroll
    for (int j = 0; j < 4; ++j) s += (v[j][0] + v[j][1]) + (v[j][2] + v[j][3]);
#pragma unroll
    for (int o = 32; o >= 1; o >>= 1) s += __shfl_xor(s, o);
    const float mean = s * (1.0f / 1024.0f); float qv = 0.f;
#pragma unroll
    for (int j = 0; j < 4; ++j) { const f32x4 dd = v[j] - mean; qv += (dd[0] * dd[0] + dd[1] * dd[1]) + (dd[2] * dd[2] + dd[3] * dd[3]); }
#pragma unroll
    for (int o = 32; o >= 1; o >>= 1) qv += __shfl_xor(qv, o);
    const float rstd = rsqrtf(qv * (1.0f / 1024.0f) + 1e-5f);
#pragma unroll
    for (int j = 0; j < 4; ++j) { const f32x4 gg = *(const f32x4*)(gam + 256 * j + 4 * lane), bb = *(const f32x4*)(bet + 256 * j + 4 * lane); v[j] = (v[j] - mean) * rstd * gg + bb; }
}

__device__ __forceinline__ void phase_ln1r(ArgsRef a, int l, int tid, int lane, int wave, int bid, int G) {
    float* XF = a.out; bf16_t* XB = (bf16_t*)(a.ws + OFF_XB);
    int* TOKE = (int*)(a.ws + OFF_TOKE); float* TOKG = (float*)(a.ws + OFF_TOKG); unsigned* HIST = (unsigned*)(a.ws + OFF_HIST);
    const float* RWT = (const float*)(a.ws + OFF_RWT); const float* RB = a.in[30];
    float* LG = (float*)(smem + wave * 4096);
    int* TE = (int*)(smem + wave * 4096 + 2304); float* TG = (float*)(smem + wave * 4096 + 2432); unsigned* HS = (unsigned*)(smem + wave * 4096 + 2560);
    const int r = lane & 15, q = lane >> 4, rs = lane >> 5, e = lane & 31;
    for (int tw = bid * 8 + wave; tw < T / 16; tw += G * 8) {
        const int t0 = tw * 16;
        for (int rr = 0; rr < 16; ++rr) { const int t = t0 + rr; f32x4 v[4];
#pragma unroll
            for (int j = 0; j < 4; ++j) v[j] = *(const f32x4*)(XF + (size_t)t * 1024 + 256 * j + 4 * lane);
            ln_row(v, a.in[25] + l * 1024, a.in[26] + l * 1024, lane);
#pragma unroll
            for (int j = 0; j < 4; ++j) { *(f32x4*)(XF + (size_t)t * 1024 + 256 * j + 4 * lane) = v[j];
                u32x2 w; w.x = pack2(v[j][0], v[j][1]); w.y = pack2(v[j][2], v[j][3]); *(u32x2*)(XB + (size_t)t * 1024 + 256 * j + 4 * lane) = w; } }
        if (lane < 32) HS[lane] = 0u;
        asm volatile("s_waitcnt vmcnt(0) lgkmcnt(0)" ::: "memory"); __builtin_amdgcn_wave_barrier();
        f32x4 acc0 = (f32x4){0.f, 0.f, 0.f, 0.f}, acc1 = acc0;
        const float* xa = XF + (size_t)(t0 + r) * 1024 + 4 * q; const float* w0 = RWT + (size_t)r * 1024 + 4 * q; const float* w1 = RWT + (size_t)(16 + r) * 1024 + 4 * q;
#pragma unroll 4
        for (int s = 0; s < 64; ++s) { const f32x4 av = *(const f32x4*)(xa + 16 * s), b0 = *(const f32x4*)(w0 + 16 * s), b1 = *(const f32x4*)(w1 + 16 * s);
#pragma unroll
            for (int j = 0; j < 4; ++j) { acc0 = __builtin_amdgcn_mfma_f32_16x16x4f32(av[j], b0[j], acc0, 0, 0, 0); acc1 = __builtin_amdgcn_mfma_f32_16x16x4f32(av[j], b1[j], acc1, 0, 0, 0); } }
#pragma unroll
        for (int g = 0; g < 4; ++g) { LG[(4 * q + g) * 33 + r] = acc0[g]; LG[(4 * q + g) * 33 + 16 + r] = acc1[g]; }
        wave_sync();
        for (int pp = 0; pp < 8; ++pp) {
            const float lg = LG[(2 * pp + rs) * 33 + e];
            const float s = sigmoidf_(lg), sb = s + RB[e];
            float v4[4];
#pragma unroll
            for (int i = 0; i < 4; ++i) v4[i] = __shfl(sb, (lane & ~3) + i);
            int i1 = 0;
#pragma unroll
            for (int i = 1; i < 4; ++i) if (v4[i] > v4[i1]) i1 = i;
            int i2 = (i1 == 0) ? 1 : 0;
#pragma unroll
            for (int i = 0; i < 4; ++i) if (i != i1 && i != i2 && v4[i] > v4[i2]) i2 = i;
            float gs = v4[i1] + v4[i2]; int gid = e >> 2;
#pragma unroll
            for (int o = 4; o <= 16; o <<= 1) { const float os = __shfl_xor(gs, o); const int og = __shfl_xor(gid, o); if (os > gs || (os == gs && og < gid)) { gs = os; gid = og; } }
            float sv[4], sbv[4];
#pragma unroll
            for (int i = 0; i < 4; ++i) { sbv[i] = __shfl(sb, (lane & 32) + gid * 4 + i); sv[i] = __shfl(s, (lane & 32) + gid * 4 + i); }
            int j1 = 0;
#pragma unroll
            for (int i = 1; i < 4; ++i) if (sbv[i] > sbv[j1]) j1 = i;
            int j2 = (j1 == 0) ? 1 : 0;
#pragma unroll
            for (int i = 0; i < 4; ++i) if (i != j1 && i != j2 && sbv[i] > sbv[j2]) j2 = i;
            float s1 = sv[0], s2 = sv[0];
#pragma unroll
            for (int i = 1; i < 4; ++i) { if (i == j1) s1 = sv[i]; if (i == j2) s2 = sv[i]; }
            if (e == 0) { const int ti = 2 * pp + rs; const float inv = 1.0f / (s1 + s2);
                TE[ti * 2] = gid * 4 + j1; TE[ti * 2 + 1] = gid * 4 + j2; TG[ti * 2] = s1 * inv; TG[ti * 2 + 1] = s2 * inv;
                atomicAdd(&HS[gid * 4 + j1], 1u); atomicAdd(&HS[gid * 4 + j2], 1u); }
        }
        wave_sync();
        if (lane < 32) { TOKE[t0 * 2 + lane] = TE[lane]; TOKG[t0 * 2 + lane] = TG[lane]; HIST[tw * 32 + lane] = HS[lane]; }
        wave_sync();
    }
}

__device__ __forceinline__ void phase_slot(ArgsRef a, int tid, int lane, int wave, int bid, int G) {
    const int* TOKE = (const int*)(a.ws + OFF_TOKE); int* TOKS = (int*)(a.ws + OFF_TOKS); const unsigned* HIST = (const unsigned*)(a.ws + OFF_HIST);
    unsigned* BASE = (unsigned*)(a.ws + OFF_CTL) + 64;
    const bf16_t* XB = (const bf16_t*)(a.ws + OFF_XB); bf16_t* XG = (bf16_t*)(a.ws + OFF_XG);
    unsigned* base = (unsigned*)smem; unsigned* pre = base + 40; int* el = (int*)(base + 80); int* sl = (int*)(base + 208); unsigned* red = base + 336;
    const int e = tid & 31, part = tid >> 5;
    for (int c = bid; c < T / 64; c += G) {
        unsigned tot = 0u, pr = 0u;
#pragma unroll 8
        for (int it = part; it < 1024; it += 16) { const unsigned v = HIST[it * 32 + e]; tot += v; pr += (it < 4 * c) ? v : 0u; }
        red[part * 32 + e] = tot; red[512 + part * 32 + e] = pr;
        __syncthreads();
        if (tid < 32) { unsigned t2 = 0u, p2 = 0u; for (int k = 0; k < 16; ++k) { t2 += red[k * 32 + tid]; p2 += red[512 + k * 32 + tid]; } pre[tid] = p2; red[tid] = (t2 + 255u) & ~255u; }
        __syncthreads();
        if (tid == 0) { unsigned sacc = 0; for (int k = 0; k < 32; ++k) { base[k] = sacc; sacc += red[k]; } base[32] = sacc; }
        int ee = 0;
        if (tid < 128) { ee = TOKE[c * 128 + tid]; el[tid] = ee; }
        __syncthreads();
        if (c == 0 && tid < 33) BASE[tid] = base[tid];
        if (tid < 128) { unsigned rank = 0; for (int i = 0; i < tid; ++i) rank += (el[i] == ee) ? 1u : 0u;
            const unsigned sidx = base[ee] + pre[ee] + rank; sl[tid] = (int)sidx; TOKS[c * 128 + tid] = (int)sidx; }
        __syncthreads();
        for (int i = wave; i < 128; i += 8) { const int t = c * 64 + (i >> 1); const size_t so = (size_t)sl[i] * 1024;
            *(u32x4*)(XG + so + lane * 8) = *(const u32x4*)(XB + (size_t)t * 1024 + lane * 8); *(u32x4*)(XG + so + 512 + lane * 8) = *(const u32x4*)(XB + (size_t)t * 1024 + 512 + lane * 8); }
        __syncthreads();
    }
}

__device__ __forceinline__ void phase_ln2(ArgsRef a, int l, int lane, int gw, int GW) {
    float* XF = a.out; bf16_t* XB = (bf16_t*)(a.ws + OFF_XB); const bf16_t* YS = (const bf16_t*)(a.ws + OFF_YS);
    const int* TOKS = (const int*)(a.ws + OFF_TOKS); const float* TOKG = (const float*)(a.ws + OFF_TOKG);
    for (int t = gw; t < T; t += GW) {
        const int s0 = TOKS[t * 2], s1 = TOKS[t * 2 + 1]; const float g0 = TOKG[t * 2], g1 = TOKG[t * 2 + 1];
        f32x4 v[4];
#pragma unroll
        for (int j = 0; j < 4; ++j) { const f32x4 x1 = *(const f32x4*)(XF + (size_t)t * 1024 + 256 * j + 4 * lane);
            const bf16x4 y0 = *(const bf16x4*)(YS + (size_t)s0 * 1024 + 256 * j + 4 * lane), y1 = *(const bf16x4*)(YS + (size_t)s1 * 1024 + 256 * j + 4 * lane);
#pragma unroll
            for (int g = 0; g < 4; ++g) v[j][g] = DN_ALPHA * x1[g] + g0 * bf2f((bf16_t)y0[g]) + g1 * bf2f((bf16_t)y1[g]); }
        ln_row(v, a.in[27] + l * 1024, a.in[28] + l * 1024, lane);
#pragma unroll
        for (int j = 0; j < 4; ++j) { *(f32x4*)(XF + (size_t)t * 1024 + 256 * j + 4 * lane) = v[j];
            u32x2 w; w.x = pack2(v[j][0], v[j][1]); w.y = pack2(v[j][2], v[j][3]); *(u32x2*)(XB + (size_t)t * 1024 + 256 * j + 4 * lane) = w; }
    }
}

struct SchedGrid {
    int nM, nN, G, c; const char* A; const char* B; size_t strideA, strideB;
    __device__ __forceinline__ bool next(int i, pg8::Unit& u) const { int pm, pn; if (!pg8::tile_order(i * G + c, nM, nN, pm, pn)) return false;
        u.pm = pm; u.pn = pn; u.tag = 0; u.A = A + (size_t)pm * strideA; u.B = B + (size_t)pn * strideB; return true; }
};
constexpr int GATES_LD = 3072;
template <int MODE> struct EpiBf16 {
    static constexpr bool PERM = true;
    bf16_t* O; int ldo; const bf16_t* Y; int ldy;
    __device__ __forceinline__ bool operator()(f32x4 (&acc)[2][2][4][2], const pg8::Unit& u, int wr, int wc, int fr, int fq) const {
#pragma unroll
        for (int ai = 0; ai < 2; ++ai)
#pragma unroll
            for (int m = 0; m < 4; ++m) { const size_t row = (size_t)u.pm * 256 + ai * 128 + wr * 64 + m * 16 + fr;
#pragma unroll
                for (int bj = 0; bj < 2; ++bj) { const int col = u.pn * 256 + bj * 128 + wc * 32 + 8 * fq; f32x4 v0 = acc[ai][bj][m][0], v1 = acc[ai][bj][m][1];
                    if (MODE == 1) {
#pragma unroll
                        for (int j = 0; j < 4; ++j) { v0[j] = fmaxf(sigmoidf_(v0[j]), 1e-30f); v1[j] = fmaxf(sigmoidf_(v1[j]), 1e-30f); } }
                    if (MODE == 2) { const bf16x8 y = *(const bf16x8*)(Y + row * ldy + col);
#pragma unroll
                        for (int j = 0; j < 4; ++j) { v0[j] = bf2f((bf16_t)y[j]) * sigmoidf_(v0[j]); v1[j] = bf2f((bf16_t)y[4 + j]) * sigmoidf_(v1[j]); } }
                    u32x4 w; w.x = pg8::cvt_pk_bf16(v0[0], v0[1]); w.y = pg8::cvt_pk_bf16(v0[2], v0[3]); w.z = pg8::cvt_pk_bf16(v1[0], v1[1]); w.w = pg8::cvt_pk_bf16(v1[2], v1[3]);
                    *(u32x4*)(O + row * ldo + col) = w; } }
        return false;
    }
};
__device__ __forceinline__ void phase_zgemm2(ArgsRef a, int tid, int bid, int G) {
    SchedGrid S{T / 256, NZ / 256, G, bid, (const char*)(a.ws + OFF_XB), (const char*)(a.ws + OFF_WIN), (size_t)256 * 1024 * 2, (size_t)256 * 1024 * 2};
    EpiBf16<0> E{(bf16_t*)(a.ws + OFF_Z), NZ, nullptr, 0};
    pg8::gemm_phase((PG8_LAS unsigned char*)smem, tid, 1024, 1024, 1024, S, E);
}
__device__ __forceinline__ void phase_glu_gates(ArgsRef a, int tid, int bid, int G) {
    { SchedGrid S{T / 256, 2, G, bid, (const char*)(a.ws + OFF_YPRE), (const char*)(a.ws + OFF_WGLU), (size_t)256 * 512 * 2, (size_t)256 * 512 * 2};
      EpiBf16<2> E{(bf16_t*)(a.ws + OFF_YSG), 512, (const bf16_t*)(a.ws + OFF_YPRE), 512};
      pg8::gemm_phase((PG8_LAS unsigned char*)smem, tid, 512, 512, 512, S, E); }
    asm volatile("" : "+v"(tid), "+s"(bid), "+s"(G));
    { SchedGrid S{T / 256, 12, G, (bid + G / 2) % G, (const char*)(a.ws + OFF_XB), (const char*)(a.ws + OFF_WIN + (size_t)NZ * 1024 * 2), (size_t)256 * 1024 * 2, (size_t)256 * 1024 * 2};
      EpiBf16<1> E{(bf16_t*)(a.ws + OFF_Z), GATES_LD, nullptr, 0};
      pg8::gemm_phase((PG8_LAS unsigned char*)smem, tid, 1024, 1024, 1024, S, E); }
}
struct SchedMerge {
    int G, c; const unsigned char* ws;
    __device__ __forceinline__ bool next(int i, pg8::Unit& u) const { const int b = i % 3; int pm, pn; if (!pg8::tile_order((i / 3) * G + c, T / 256, 4, pm, pn)) return false;
        u.pm = pm; u.pn = pn; u.tag = b; u.A = (const char*)(ws + (b == 0 ? OFF_OM : b == 1 ? OFF_YSG : OFF_OH)) + (size_t)pm * 256 * 512 * 2;
        u.B = (const char*)(ws + OFF_WB) + ((size_t)b * 1024 + pn * 256) * 512 * 2; return true; }
};
struct EpiMerge {
    static constexpr bool PERM = true;
    const bf16_t* GT; bf16_t* O;
    __device__ __forceinline__ bool operator()(f32x4 (&acc)[2][2][4][2], const pg8::Unit& u, int wr, int wc, int fr, int fq) const {
        const int b = u.tag;
#pragma unroll
        for (int ai = 0; ai < 2; ++ai)
#pragma unroll
            for (int m = 0; m < 4; ++m) { const size_t row = (size_t)u.pm * 256 + ai * 128 + wr * 64 + m * 16 + fr;
#pragma unroll
                for (int bj = 0; bj < 2; ++bj) { const int col = u.pn * 256 + bj * 128 + wc * 32 + 8 * fq;
                    const bf16x8 gb = *(const bf16x8*)(GT + row * GATES_LD + b * 1024 + col);
                    if (b < 2) { const bf16x8 gn = *(const bf16x8*)(GT + row * GATES_LD + (b + 1) * 1024 + col);
#pragma unroll
                        for (int j = 0; j < 4; ++j) { acc[ai][bj][m][0][j] *= bf2f((bf16_t)gb[j]) / bf2f((bf16_t)gn[j]); acc[ai][bj][m][1][j] *= bf2f((bf16_t)gb[4 + j]) / bf2f((bf16_t)gn[4 + j]); } }
                    else { f32x4 v0 = acc[ai][bj][m][0], v1 = acc[ai][bj][m][1];
#pragma unroll
                        for (int j = 0; j < 4; ++j) { v0[j] *= bf2f((bf16_t)gb[j]); v1[j] *= bf2f((bf16_t)gb[4 + j]); }
                        u32x4 w; w.x = pg8::cvt_pk_bf16(v0[0], v0[1]); w.y = pg8::cvt_pk_bf16(v0[2], v0[3]); w.z = pg8::cvt_pk_bf16(v1[0], v1[1]); w.w = pg8::cvt_pk_bf16(v1[2], v1[3]);
                        *(u32x4*)(O + row * 1024 + col) = w; } } }
        return b < 2;
    }
};
__device__ __forceinline__ void phase_merge2(ArgsRef a, int tid, int bid, int G) {
    SchedMerge S{G, bid, a.ws}; EpiMerge E{(const bf16_t*)(a.ws + OFF_Z), (bf16_t*)(a.ws + OFF_XB)};
    pg8::gemm_phase((PG8_LAS unsigned char*)smem, tid, 512, 512, 512, S, E);
}
struct EpiResid {
    static constexpr bool PERM = false;
    const float* xin; float* XF;
    __device__ __forceinline__ bool operator()(f32x4 (&acc)[2][2][4][2], const pg8::Unit& u, int wr, int wc, int fr, int fq) const {
#pragma unroll
        for (int ai = 0; ai < 2; ++ai)
#pragma unroll
            for (int m = 0; m < 4; ++m) { const size_t row = (size_t)u.pm * 256 + ai * 128 + wr * 64 + m * 16 + fr;
#pragma unroll
                for (int bj = 0; bj < 2; ++bj)
#pragma unroll
                    for (int n = 0; n < 2; ++n) { const size_t o = row * 1024 + u.pn * 256 + bj * 128 + wc * 32 + 16 * n + 4 * fq; const f32x4 x = *(const f32x4*)(xin + o); *(f32x4*)(XF + o) = DN_ALPHA * x + acc[ai][bj][m][n]; } }
        return false;
    }
};
__device__ __forceinline__ void phase_wout2(ArgsRef a, int l, int tid, int bid, int G) {
    SchedGrid S{T / 256, 4, G, bid, (const char*)(a.ws + OFF_XB), (const char*)(a.ws + OFF_WOUT), (size_t)256 * 1024 * 2, (size_t)256 * 1024 * 2};
    EpiResid E{(l == 0) ? a.in[0] : a.out, a.out};
    pg8::gemm_phase((PG8_LAS unsigned char*)smem, tid, 1024, 1024, 1024, S, E);
}
struct EpiQKV {
    static constexpr bool PERM = true;
    int vcall; bf16_t* Q; bf16_t* KH; bf16_t* V; const float* LI;
    __device__ __forceinline__ bool operator()(f32x4 (&acc)[2][2][4][2], const pg8::Unit& u, int wr, int wc, int fr, int fq) const {
        const int which = vcall ? 2 : (u.pn >> 1); bf16_t* O = which == 0 ? Q : which == 1 ? KH : V;
#pragma unroll
        for (int ai = 0; ai < 2; ++ai)
#pragma unroll
            for (int m = 0; m < 4; ++m) { const size_t row = (size_t)u.pm * 256 + ai * 128 + wr * 64 + m * 16 + fr;
#pragma unroll
                for (int bj = 0; bj < 2; ++bj) { const int hd = (u.pn & 1) * 2 + bj, col = hd * 128 + wc * 32 + 8 * fq;
                    const float sc = which == 0 ? 0.08838834764831845f : which == 1 ? fexp(LI[row * 4 + hd]) : 1.0f;
                    const f32x4 v0 = acc[ai][bj][m][0] * sc, v1 = acc[ai][bj][m][1] * sc;
                    u32x4 w; w.x = pg8::cvt_pk_bf16(v0[0], v0[1]); w.y = pg8::cvt_pk_bf16(v0[2], v0[3]); w.z = pg8::cvt_pk_bf16(v1[0], v1[1]); w.w = pg8::cvt_pk_bf16(v1[2], v1[3]);
                    *(u32x4*)(O + row * 512 + col) = w; } }
        return false;
    }
};
__device__ __forceinline__ void phase_mqkv2(ArgsRef a, int tid, int bid, int G) {
    { SchedGrid S{T / 256, 4, G, bid, (const char*)(a.ws + OFF_XC), (const char*)(a.ws + OFF_WQKV), (size_t)256 * 512 * 2, (size_t)256 * 512 * 2};
      EpiQKV E{0, (bf16_t*)(a.ws + OFF_Q), (bf16_t*)(a.ws + OFF_KH), (bf16_t*)(a.ws + OFF_V), (const float*)(a.ws + OFF_LI)};
      pg8::gemm_phase((PG8_LAS unsigned char*)smem, tid, 512, 512, 512, S, E); }
    asm volatile("" : "+v"(tid), "+s"(bid), "+s"(G));
    { SchedGrid S{T / 256, 2, G, (bid + G / 2) % G, (const char*)(a.ws + OFF_Z), (const char*)(a.ws + OFF_WQKV + (size_t)1024 * 512 * 2), (size_t)256 * NZ * 2, (size_t)256 * 512 * 2};
      EpiQKV E{1, (bf16_t*)(a.ws + OFF_Q), (bf16_t*)(a.ws + OFF_KH), (bf16_t*)(a.ws + OFF_V), (const float*)(a.ws + OFF_LI)};
      pg8::gemm_phase((PG8_LAS unsigned char*)smem, tid, 512, NZ, 512, S, E); }
}
struct SchedMoE {
    int down, G, c; const unsigned char* ws; const unsigned* BASE;
    __device__ __forceinline__ bool next(int i, pg8::Unit& u) const { const int per = down ? 4 : 2, L = i * G + c, ntile = (int)(BASE[32] >> 8); if (L >= ntile * per) return false;
        const int tile = L / per, sub = L % per; int e = 0; while (e < 31 && BASE[e + 1] <= (unsigned)(tile * 256)) ++e;
        u.pm = tile; u.pn = sub; u.tag = e;
        if (!down) { u.A = (const char*)(ws + OFF_XG) + (size_t)tile * 256 * 1024 * 2; u.B = (const char*)(ws + OFF_WGU) + ((size_t)e * 512 + sub * 256) * 1024 * 2; }
        else { u.A = (const char*)(ws + OFF_H) + (size_t)tile * 256 * 256 * 2; u.B = (const char*)(ws + OFF_WD) + ((size_t)e * 1024 + sub * 256) * 256 * 2; }
        return true; }
};
struct EpiH {
    static constexpr bool PERM = true;
    bf16_t* H;
    __device__ __forceinline__ bool operator()(f32x4 (&acc)[2][2][4][2], const pg8::Unit& u, int wr, int wc, int fr, int fq) const {
#pragma unroll
        for (int ai = 0; ai < 2; ++ai)
#pragma unroll
            for (int m = 0; m < 4; ++m) { const size_t row = (size_t)u.pm * 256 + ai * 128 + wr * 64 + m * 16 + fr; f32x4 v0, v1;
#pragma unroll
                for (int j = 0; j < 4; ++j) { v0[j] = siluf_(acc[ai][0][m][0][j]) * acc[ai][1][m][0][j]; v1[j] = siluf_(acc[ai][0][m][1][j]) * acc[ai][1][m][1][j]; }
                u32x4 w; w.x = pg8::cvt_pk_bf16(v0[0], v0[1]); w.y = pg8::cvt_pk_bf16(v0[2], v0[3]); w.z = pg8::cvt_pk_bf16(v1[0], v1[1]); w.w = pg8::cvt_pk_bf16(v1[2], v1[3]);
                *(u32x4*)(H + row * 256 + u.pn * 128 + wc * 32 + 8 * fq) = w; }
        return false;
    }
};
__device__ __forceinline__ void phase_moe_gu2(ArgsRef a, int tid, int bid, int G) {
    SchedMoE S{0, G, bid, a.ws, (const unsigned*)(a.ws + OFF_CTL) + 64}; EpiH E{(bf16_t*)(a.ws + OFF_H)};
    pg8::gemm_phase((PG8_LAS unsigned char*)smem, tid, 1024, 1024, 1024, S, E);
}
__device__ __forceinline__ void phase_moe_dn2(ArgsRef a, int tid, int bid, int G) {
    SchedMoE S{1, G, bid, a.ws, (const unsigned*)(a.ws + OFF_CTL) + 64}; EpiBf16<0> E{(bf16_t*)(a.ws + OFF_YS), 1024, nullptr, 0};
    pg8::gemm_phase((PG8_LAS unsigned char*)smem, tid, 256, 256, 256, S, E);
}
__device__ __forceinline__ void phase_mprep2(ArgsRef a, int l, int tid, int lane, int wave, int bid, int G) {
    const bf16_t* Z = (const bf16_t*)(a.ws + OFF_Z); bf16_t* XC = (bf16_t*)(a.ws + OFF_XC);
    const float* cw = a.in[2] + (size_t)l * 4 * 512; const float* cb = a.in[3] + (size_t)l * 512;
    for (int idx = bid * 512 + tid; idx < T * 64; idx += G * 512) {
        const int t = idx / 64, c0 = (idx % 64) * 8; float acc[8];
#pragma unroll
        for (int j = 0; j < 8; ++j) acc[j] = cb[c0 + j];
#pragma unroll
        for (int k = 0; k < 4; ++k) { const int ts = t - 3 + k; if (ts >= 0) { const bf16x8 v = *(const bf16x8*)(Z + (size_t)ts * NZ + c0);
#pragma unroll
                for (int j = 0; j < 8; ++j) acc[j] += cw[k * 512 + c0 + j] * bf2f((bf16_t)v[j]); } }
        u32x4 w; w.x = pack2(siluf_(acc[0]), siluf_(acc[1])); w.y = pack2(siluf_(acc[2]), siluf_(acc[3])); w.z = pack2(siluf_(acc[4]), siluf_(acc[5])); w.w = pack2(siluf_(acc[6]), siluf_(acc[7]));
        *(u32x4*)(XC + (size_t)t * 512 + c0) = w;
    }
    float* W8 = (float*)smem;
    const float* wsrc = a.in[1] + (size_t)l * 1024 * INW + 1024;
    __syncthreads();
    for (int i = tid; i < 8192; i += 512) W8[i] = wsrc[(size_t)(i >> 3) * INW + (i & 7)];
    __syncthreads();
    const bf16_t* XB = (const bf16_t*)(a.ws + OFF_XB); float* LF = (float*)(a.ws + OFF_LF); float* LI = (float*)(a.ws + OFF_LI);
    for (int tw = bid * 8 + wave; tw < T / 8; tw += G * 8) {
        float myli = 0.f, mylf = 0.f;
        for (int tt = 0; tt < 8; ++tt) { const int t = tw * 8 + tt; float sacc[8];
#pragma unroll
            for (int j = 0; j < 8; ++j) sacc[j] = 0.f;
#pragma unroll 4
            for (int kk = 0; kk < 16; ++kk) { const int k = lane + 64 * kk; const float x = bf2f(XB[(size_t)t * 1024 + k]);
                const f32x4 w0 = *(const f32x4*)(W8 + k * 8), w1 = *(const f32x4*)(W8 + k * 8 + 4);
#pragma unroll
                for (int j = 0; j < 4; ++j) { sacc[j] += x * w0[j]; sacc[4 + j] += x * w1[j]; } }
#pragma unroll
            for (int j = 0; j < 8; ++j) {
#pragma unroll
                for (int o = 32; o >= 1; o >>= 1) sacc[j] += __shfl_xor(sacc[j], o); }
            const int hh = lane & 3;
            const float ipre = hh == 0 ? sacc[0] : hh == 1 ? sacc[1] : hh == 2 ? sacc[2] : sacc[3], fpre = hh == 0 ? sacc[4] : hh == 1 ? sacc[5] : hh == 2 ? sacc[6] : sacc[7];
            if ((lane >> 2) == tt) { myli = ipre + a.in[7][l * 4 + hh]; mylf = logsigmoidf_(fpre + a.in[8][l * 4 + hh]); }
        }
        if (lane < 32) { LI[tw * 32 + lane] = myli; LF[tw * 32 + lane] = mylf; }
    }
}

#define XB_TMO      128
#define XB_XCNT(j)  (256  + 64 * (j))
#define XB_XSUB(j)  (1280 + 64 * (j))
#define XB_XGEN(j)  (2304 + 64 * (j))
#define XB_TOP      3328
#define XB_TOPGEN   3392
#define XCD_BAR_WORDS 3456
#define XB_SPIN_CAP (1u << 22)
__device__ __forceinline__ unsigned xb_ld(unsigned* p)              { return __hip_atomic_load(p, __ATOMIC_RELAXED, __HIP_MEMORY_SCOPE_AGENT); }
__device__ __forceinline__ unsigned xb_add(unsigned* p, unsigned v) { return __hip_atomic_fetch_add(p, v, __ATOMIC_RELAXED, __HIP_MEMORY_SCOPE_AGENT); }
__device__ __forceinline__ unsigned xb_xcc_id() { return (unsigned)__builtin_amdgcn_s_getreg((3 << 11) | 20) & 0xFu; }
#define XB_SPIN(cond, bar) do { unsigned _sp = 0; while (cond) { __builtin_amdgcn_s_sleep(1); \
    if ((++_sp & 255u) == 0u) { if (xb_ld(&(bar)[XB_TMO])) break; if (_sp > XB_SPIN_CAP) { atomicAdd(&(bar)[XB_TMO], 1u); break; } } } } while (0)
__device__ __forceinline__ void xcd_barrier_complete(unsigned* bar, unsigned x, unsigned& nloc, unsigned& nx) {
    const unsigned G = gridDim.x; unsigned sum, cnt, mine, sp = 0u;
    for (;;) { sum = 0u; cnt = 0u; mine = 0u;
#pragma unroll
        for (unsigned j = 0; j < 16; ++j) { const unsigned c = xb_ld(&bar[XB_XCNT(j)]); sum += c; cnt += (c > 0u) ? 1u : 0u; mine = (j == x) ? c : mine; }
        if (sum == G) break;
        __builtin_amdgcn_s_sleep(1);
        if ((++sp & 255u) == 0u) { if (xb_ld(&bar[XB_TMO])) break; if (sp > XB_SPIN_CAP) { atomicAdd(&bar[XB_TMO], 1u); break; } } }
    nloc = mine > 0u ? mine : 1u; nx = cnt > 0u ? cnt : 1u;
}
__device__ __forceinline__ void xcd_barrier(unsigned* bar, volatile __attribute__((address_space(3))) unsigned* st) {
    asm volatile("s_waitcnt vmcnt(0)" ::: "memory");
    __syncthreads();
    if (threadIdx.x == 0) {
        __builtin_amdgcn_s_waitcnt(0);
        const unsigned x = xb_xcc_id();
        unsigned nloc = st[0], nx = st[1];
        if (nloc == 0u) { xcd_barrier_complete(bar, x, nloc, nx); st[0] = nloc; st[1] = nx; }
        const unsigned old = xb_add(&bar[XB_XSUB(x)], 1u);
        const unsigned gen = old / nloc;
        if (old + 1u == (gen + 1u) * nloc) {
            __builtin_amdgcn_fence(__ATOMIC_RELEASE, "agent");
            asm volatile("s_waitcnt vmcnt(0)" ::: "memory");
            const unsigned og = xb_add(&bar[XB_TOP], 1u);
            const unsigned tg = og / nx;
            if (og + 1u == (tg + 1u) * nx) xb_add(&bar[XB_TOPGEN], 1u);
            else XB_SPIN(xb_ld(&bar[XB_TOPGEN]) == tg, bar);
            __builtin_amdgcn_fence(__ATOMIC_ACQUIRE, "agent");
            xb_add(&bar[XB_XGEN(x)], 1u);
            asm volatile("s_waitcnt vmcnt(0)" ::: "memory");
        } else {
            XB_SPIN(xb_ld(&bar[XB_XGEN(x)]) == gen, bar);
            __builtin_amdgcn_fence(__ATOMIC_ACQUIRE, "agent");
            asm volatile("s_waitcnt vmcnt(0)" ::: "memory");
        }
    }
    __syncthreads();
}

__device__ __forceinline__ ArgsRef fresh_args() { unsigned long long p = (unsigned long long)__builtin_amdgcn_kernarg_segment_ptr(); asm volatile("" : "+s"(p)); return *(const __attribute__((address_space(4))) Args*)p; }
__global__ void __launch_bounds__(512) fwd(Args a_unused) {
    cg::grid_group grid = cg::this_grid();
    volatile __attribute__((address_space(3))) unsigned* bst = (volatile __attribute__((address_space(3))) unsigned*)((__attribute__((address_space(3))) unsigned char*)smem + 131072);
    if (threadIdx.x < 4) bst[threadIdx.x] = 0u;
    __syncthreads();
    { ArgsRef a0 = fresh_args(); if (threadIdx.x == 0) (void)xb_add(&((unsigned*)(a0.ws + OFF_BAR))[XB_XCNT(xb_xcc_id())], 1u); }
#define GSYNC() do { asm volatile("" ::: "memory"); { ArgsRef ab = fresh_args(); xcd_barrier((unsigned*)(ab.ws + OFF_BAR), bst); } asm volatile("" ::: "memory"); } while (0)
#define GSYNC_CG() do { asm volatile("" ::: "memory"); grid.sync(); asm volatile("" ::: "memory"); } while (0)
    const int wave_s = __builtin_amdgcn_readfirstlane((int)threadIdx.x >> 6);
#define PH(body) do { int wave = wave_s; asm volatile("" : "+s"(wave)); int lane; asm volatile("v_mbcnt_lo_u32_b32 %0, -1, 0\n\tv_mbcnt_hi_u32_b32 %0, -1, %0" : "=v"(lane)); \
        int bid = blockIdx.x, G = gridDim.x; asm volatile("" : "+s"(bid), "+s"(G)); \
        const int tid = wave * 64 + lane, gw = bid * 8 + wave, GW = G * 8; (void)tid; (void)gw; (void)GW; ArgsRef a = fresh_args(); body; } while (0)
#pragma unroll 1
    for (int l = 0; l < NLAYER; ++l) {
        PH(phase_prep(a, l, tid, bid, G)); if (l == 0) GSYNC_CG(); else GSYNC();
        PH(phase_zgemm2(a, tid, bid, G)); GSYNC();
        PH(phase_mprep2(a, l, tid, lane, wave, bid, G)); GSYNC();
        PH(phase_mqkv2(a, tid, bid, G)); GSYNC();
        PH(phase_mixers<1>(a, l, tid, lane, wave, bid, G)); GSYNC();
        PH(phase_scan(a, tid, bid, G)); GSYNC();
        PH(phase_mixers<2>(a, l, tid, lane, wave, bid, G)); GSYNC();
        PH(phase_post(a, l, lane, gw, GW)); GSYNC();
        PH(phase_glu_gates(a, tid, bid, G)); PH(phase_prepx(a, l, tid, bid, G)); GSYNC();
        PH(phase_merge2(a, tid, bid, G)); GSYNC();
        PH(phase_wout2(a, l, tid, bid, G)); GSYNC();
        PH(phase_ln1r(a, l, tid, lane, wave, bid, G)); GSYNC();
        PH(phase_slot(a, tid, lane, wave, bid, G)); GSYNC();
        PH(phase_moe_gu2(a, tid, bid, G)); GSYNC();
        PH(phase_moe_dn2(a, tid, bid, G)); GSYNC();
        PH(phase_ln2(a, l, lane, gw, GW)); if (l + 1 < NLAYER) GSYNC();
    }
}

extern "C" void kernel_launch(void* const* d_in, const int* in_sizes, int n_in, void* d_out, int out_size, void* d_ws, size_t ws_size, hipStream_t stream) {
    static int grid = 0;
    if (grid == 0) {
        if (n_in != 34 || out_size != T * D || ws_size < WS_TOTAL) { fprintf(stderr, "kernel_launch: unexpected shapes (n_in %d, out %d, ws %zu, need %zu)\n", n_in, out_size, ws_size, (size_t)WS_TOTAL); grid = -1; return; }
        int dev = 0, cus = 0, per_cu = 0;
        (void)hipGetDevice(&dev); (void)hipDeviceGetAttribute(&cus, hipDeviceAttributeMultiprocessorCount, dev);
        (void)hipFuncSetAttribute((const void*)fwd, hipFuncAttributeMaxDynamicSharedMemorySize, LDS_BYTES);
        (void)hipOccupancyMaxActiveBlocksPerMultiprocessor(&per_cu, (const void*)fwd, 512, LDS_BYTES);
        if (per_cu < 1) { fprintf(stderr, "kernel_launch: occupancy query says %d blocks per CU\n", per_cu); per_cu = 1; }
        grid = (cus > 0 ? cus : 256) * 1;
        (void)hipGetLastError();
    }
    if (grid < 0) return;
    Args a{};
    for (int i = 0; i < 34; ++i) a.in[i] = (const float*)d_in[i];
    a.out = (float*)d_out; a.ws = (unsigned char*)d_ws; a.ph_lo = 0; a.ph_hi = NLAYER * NPH;
    (void)hipMemsetAsync((unsigned char*)d_ws + OFF_BAR, 0, 16384, stream);
    void* args[] = {&a};
    hipError_t e = hipLaunchCooperativeKernel((const void*)fwd, dim3(grid), dim3(512), args, LDS_BYTES, stream);
    if (e != hipSuccess) fprintf(stderr, "kernel_launch: cooperative launch failed: %s (grid %d)\n", hipGetErrorString(e), grid);
}
```

```cpp
#include <hip/hip_runtime.h>
#include <hip/hip_cooperative_groups.h>
#include <cstdio>
#include <cstdint>
namespace cg = cooperative_groups;

typedef unsigned short bf16_t;
typedef short bf16x8 __attribute__((ext_vector_type(8)));
typedef short bf16x4 __attribute__((ext_vector_type(4)));
typedef float f32x4 __attribute__((ext_vector_type(4)));
typedef unsigned u32x4 __attribute__((ext_vector_type(4)));
typedef unsigned u32x2 __attribute__((ext_vector_type(2)));

constexpr int T = 16384, D = 1024, NZ = 3584, NWIN = 6912, INW = 6664;
constexpr int NPH = 15, NLAYER = 2;
constexpr int GSEG = 32, GSEGLEN = 512;
constexpr int SSEG = 64, SSEGLEN = 256;
constexpr int SLOTS = 40960;
constexpr float DN_ALPHA = 1.41421356237f;
constexpr int LDS_BYTES = 131072 + 256;

constexpr size_t AL(size_t x) { return (x + 255) & ~(size_t)255; }
constexpr size_t OFF_WIN = 0;
constexpr size_t OFF_WQKV = OFF_WIN + AL((size_t)NWIN * 1024 * 2);
constexpr size_t OFF_WGLU = OFF_WQKV + AL((size_t)1536 * 512 * 2);
constexpr size_t OFF_WB = OFF_WGLU + AL((size_t)512 * 512 * 2);
constexpr size_t OFF_WOUT = OFF_WB + AL((size_t)3 * 1024 * 512 * 2);
constexpr size_t OFF_ABAR = OFF_WOUT + AL((size_t)1024 * 1024 * 2);
constexpr size_t OFF_BBT = OFF_ABAR + AL((size_t)32 * 64 * 2 * 4);
constexpr size_t OFF_CCT = OFF_BBT + AL((size_t)32 * 128 * 16 * 2);
constexpr size_t OFF_CTL = OFF_CCT + AL((size_t)32 * 16 * 128 * 2);
constexpr size_t OFF_TOKE = OFF_CTL + 4096;
constexpr size_t OFF_TOKG = OFF_TOKE + AL((size_t)T * 2 * 4);
constexpr size_t OFF_TOKS = OFF_TOKG + AL((size_t)T * 2 * 4);
constexpr size_t OFF_SLOTT = OFF_TOKS + AL((size_t)T * 2 * 4);
constexpr size_t OFF_XB = OFF_SLOTT + AL((size_t)SLOTS * 4);
constexpr size_t OFF_R1 = OFF_XB + AL((size_t)T * 1024 * 2);
constexpr size_t SZ_ACT = (size_t)T * 512 * 2;
constexpr size_t OFF_XC = OFF_R1, OFF_Q = OFF_R1 + SZ_ACT, OFF_KH = OFF_R1 + 2 * SZ_ACT, OFF_V = OFF_R1 + 3 * SZ_ACT;
constexpr size_t OFF_WGU = OFF_R1, OFF_WD = OFF_R1 + (size_t)32 * 512 * 1024 * 2;
constexpr size_t OFF_Z = OFF_R1 + 4 * SZ_ACT;
constexpr size_t OFF_XG = OFF_Z, OFF_H = OFF_Z + (size_t)SLOTS * 1024 * 2;
constexpr size_t OFF_ZS = OFF_Z + AL((size_t)T * NZ * 2);
constexpr size_t OFF_LF = OFF_ZS + AL((size_t)T * 8 * 4);
constexpr size_t OFF_LI = OFF_LF + AL((size_t)T * 4 * 4);
constexpr size_t OFF_E = OFF_LI + AL((size_t)T * 4 * 4);
constexpr size_t OFF_OM = OFF_E, OFF_OH = OFF_E + SZ_ACT, OFF_YPRE = OFF_E + 2 * SZ_ACT, OFF_YSG = OFF_E + 3 * SZ_ACT;
constexpr size_t OFF_DEN = OFF_E + 4 * SZ_ACT;
constexpr size_t OFF_EM = OFF_DEN + AL((size_t)T * 4 * 4);
constexpr size_t OFF_EMX = OFF_EM + AL((size_t)GSEG * 4 * 128 * 128 * 4);
constexpr size_t OFF_GM = OFF_EMX + AL((size_t)GSEG * 4 * 128 * 16 * 4);
constexpr size_t OFF_EH = OFF_GM + AL((size_t)GSEG * 4 * 128 * 4);
constexpr size_t OFF_GH = OFF_EH + AL((size_t)GSEG * 4 * 128 * 128 * 4);
constexpr size_t OFF_ES = OFF_GH + AL((size_t)GSEG * 4 * 128 * 4);
constexpr size_t WS_END = OFF_ES + AL((size_t)SSEG * 32 * 64 * 2 * 4);
constexpr size_t OFF_YS = OFF_E;
constexpr size_t OFF_RWT = WS_END;
constexpr size_t OFF_HIST = OFF_RWT + 32 * 1024 * 4;
constexpr size_t OFF_BAR = OFF_HIST + 1024 * 32 * 4;
constexpr size_t WS_TOTAL = OFF_BAR + 16384;
static_assert(OFF_YS + (size_t)SLOTS * 1024 * 2 <= WS_END, "YS must fit in the dead region");
static_assert(OFF_H + (size_t)SLOTS * 256 * 2 <= OFF_ZS, "H must fit in the dead Z region");
static_assert(OFF_WD + (size_t)32 * 1024 * 256 * 2 <= OFF_Z, "expert weights must fit in R1");

struct Args { const float* in[34]; float* out; unsigned char* ws; int ph_lo, ph_hi; };
typedef const __attribute__((address_space(4))) Args& ArgsRef;

extern __shared__ __attribute__((aligned(16))) unsigned char smem[];

__device__ __forceinline__ bf16_t f2bf(float f) { unsigned u = __float_as_uint(f); u += 0x7FFFu + ((u >> 16) & 1u); return (bf16_t)(u >> 16); }
__device__ __forceinline__ float bf2f(bf16_t b) { return __uint_as_float(((unsigned)b) << 16); }
__device__ __forceinline__ unsigned pack2(float lo, float hi) { return (unsigned)f2bf(lo) | ((unsigned)f2bf(hi) << 16); }
__device__ __forceinline__ float fexp(float x) { return __builtin_amdgcn_exp2f(x * 1.4426950408889634f); }
__device__ __forceinline__ float flog(float x) { return __builtin_amdgcn_logf(x) * 0.6931471805599453f; }
__device__ __forceinline__ float sigmoidf_(float x) { return __builtin_amdgcn_rcpf(1.0f + fexp(-x)); }
__device__ __forceinline__ float siluf_(float x) { return x * __builtin_amdgcn_rcpf(1.0f + fexp(-x)); }
__device__ __forceinline__ float logsigmoidf_(float x) { return fminf(x, 0.f) - log1pf(expf(-fabsf(x))); }
__device__ __forceinline__ float gelu_tanh(float y) { const float z = 0.7978845608028654f * (y + 0.044715f * y * y * y); const float th = 1.0f - 2.0f * __builtin_amdgcn_rcpf(fexp(2.0f * z) + 1.0f); return 0.5f * y * (1.0f + th); }
__device__ __forceinline__ void wave_sync() { __builtin_amdgcn_wave_barrier(); asm volatile("s_waitcnt lgkmcnt(0)" ::: "memory"); __builtin_amdgcn_wave_barrier(); }

#define MFMA16(a, b, c) __builtin_amdgcn_mfma_f32_16x16x32_bf16((a), (b), (c), 0, 0, 0)

template <int MT, int NT, class FA, class FB>
__device__ __forceinline__ void wave_gemm(f32x4 (&acc)[MT][NT], int K, FA arow, FB brow, int lane) {
    const int r = lane & 15, q = lane >> 4;
    const bf16_t* ap[MT]; const bf16_t* bp[NT];
#pragma unroll
    for (int m = 0; m < MT; ++m) ap[m] = arow(m * 16 + r) + 8 * q;
#pragma unroll
    for (int n = 0; n < NT; ++n) bp[n] = brow(n * 16 + r) + 8 * q;
#pragma unroll 1
    for (int k = 0; k < K; k += 32) {
        bf16x8 a[MT], b[NT];
#pragma unroll
        for (int m = 0; m < MT; ++m) a[m] = *(const bf16x8*)(ap[m] + k);
#pragma unroll
        for (int n = 0; n < NT; ++n) b[n] = *(const bf16x8*)(bp[n] + k);
#pragma unroll
        for (int m = 0; m < MT; ++m)
#pragma unroll
            for (int n = 0; n < NT; ++n) acc[m][n] = MFMA16(a[m], b[n], acc[m][n]);
    }
}
template <int MT, int NT> __device__ __forceinline__ void zero_acc(f32x4 (&acc)[MT][NT]) {
#pragma unroll
    for (int m = 0; m < MT; ++m)
#pragma unroll
        for (int n = 0; n < NT; ++n) acc[m][n] = (f32x4){0.f, 0.f, 0.f, 0.f};
}

namespace pg8 {
#define PG8_LAS __attribute__((address_space(3)))
constexpr int BM = 256, BK = 64, HALF = 128, HTB = HALF * BK * 2, STAGE_BYTES = 8 * HTB;
__device__ __forceinline__ int lds_byte(int r, int c) { const int st = (r >> 4) * 2 + (c >> 5), rr = r & 15, cc = c & 31, ob = rr * 64 + cc * 2; return st * 1024 + (ob ^ (((ob >> 9) & 1) << 5)); }
__device__ __forceinline__ void stage_rc(int b, int& R, int& C) { const int st = b / 1024, sb = b % 1024, swz = sb ^ (((sb >> 9) & 1) << 5); R = (st >> 1) * 16 + swz / 64; C = (st & 1) * 32 + (swz % 64) / 2; }
__device__ __forceinline__ int perm32(int rho) { const int n = rho >> 4, i = rho & 15; return 8 * (i >> 2) + 4 * n + (i & 3); }
struct Unit { int pm, pn, tag; const char* A; const char* B; };
__device__ __forceinline__ unsigned cvt_pk_bf16(float lo, float hi) { unsigned r; asm volatile("v_cvt_pk_bf16_f32 %0, %1, %2" : "=v"(r) : "v"(lo), "v"(hi)); return r; }
__device__ __forceinline__ bool tile_order(int L, int nM, int nN, int& pm, int& pn) {
    const int nwg = nM * nN; if (L >= nwg) return false;
    int wgid = L; { const int q = nwg / 8, r = nwg % 8, xcd = wgid % 8, off = wgid / 8; wgid = (xcd < r ? xcd * (q + 1) : r * (q + 1) + (xcd - r) * q) + off; }
    const int nig = 8 * nN, gid = wgid / nig, fm = gid * 8, gsz = (nM - fm) < 8 ? (nM - fm) : 8;
    pm = fm + ((wgid % nig) % gsz); pn = (wgid % nig) / gsz; return true;
}
template <class Epi, class Sched>
__device__ __forceinline__ void gemm_phase(PG8_LAS unsigned char* lds, const int tid, const int K, const int lda, const int ldb, const Sched& S, const Epi& E) {
    const int wid = __builtin_amdgcn_readfirstlane(tid >> 6), lane = tid & 63, wr = wid >> 2, wc = wid & 3, fr = lane & 15, fq = lane >> 4;
    const int nt = K / BK;
    unsigned voffA[2], voffB[2];
#pragma unroll
    for (int i = 0; i < 2; ++i) { int R, C; stage_rc(tid * 16 + i * 8192, R, C); const int Rb = Epi::PERM ? ((R & ~31) + perm32(R & 31)) : R;
        voffA[i] = (unsigned)(R * lda + C) * 2u; voffB[i] = (unsigned)(Rb * ldb + C) * 2u; }
    const size_t kstep = (size_t)(BK * 2), hstepA = (size_t)HALF * lda * 2, hstepB = (size_t)HALF * ldb * 2;
    const unsigned ldsw = (unsigned)wid * 1024u;
    const int aoff = lds_byte(wr * 64 + fr, fq * 8), boff = lds_byte(wc * 32 + fr, fq * 8);
#define PG8_SA(b, h) (((b) * 2 + (h)) * HTB)
#define PG8_SB(b, h) ((4 + (b) * 2 + (h)) * HTB)
#define PG8_STAGE(bufoff, gbase, voff) do { _Pragma("unroll") for (int _i = 0; _i < 2; ++_i) \
        __builtin_amdgcn_global_load_lds((const unsigned*)((const char*)(gbase) + (voff)[_i]), (PG8_LAS unsigned*)(lds + (bufoff) + ldsw + _i * 8192), 16, 0, 0); } while (0)
#define PG8_LDA(dst, b, h) do { _Pragma("unroll") for (int m = 0; m < 4; ++m) _Pragma("unroll") for (int k = 0; k < 2; ++k) dst[m][k] = *(const PG8_LAS bf16x8*)(lds + PG8_SA(b, h) + aoff + m * 2048 + k * 1024); } while (0)
#define PG8_LDB(dst, b, h) do { _Pragma("unroll") for (int n = 0; n < 2; ++n) _Pragma("unroll") for (int k = 0; k < 2; ++k) dst[n][k] = *(const PG8_LAS bf16x8*)(lds + PG8_SB(b, h) + boff + n * 2048 + k * 1024); } while (0)
#define PG8_MMA(ai, bj, At, Bt) do { __builtin_amdgcn_s_setprio(1); _Pragma("unroll") for (int m = 0; m < 4; ++m) _Pragma("unroll") for (int n = 0; n < 2; ++n) _Pragma("unroll") for (int k = 0; k < 2; ++k) \
        acc[ai][bj][m][n] = __builtin_amdgcn_mfma_f32_16x16x32_bf16(Bt[n][k], At[m][k], acc[ai][bj][m][n], 0, 0, 0); __builtin_amdgcn_s_setprio(0); } while (0)
#define PG8_WAIT_V(n) asm volatile("s_waitcnt vmcnt(" #n ")" ::: "memory")
#define PG8_WAIT_L(n) asm volatile("s_waitcnt lgkmcnt(" #n ")" ::: "memory")
#define PG8_BAR __builtin_amdgcn_s_barrier()
#define PG8_SCHED __builtin_amdgcn_sched_barrier(0)
    Unit cur, nxt; int ui = 0;
    if (!S.next(0, cur)) return;
    f32x4 acc[2][2][4][2];
#pragma unroll
    for (int a = 0; a < 2; ++a)
#pragma unroll
        for (int b = 0; b < 2; ++b)
#pragma unroll
            for (int m = 0; m < 4; ++m)
#pragma unroll
                for (int n = 0; n < 2; ++n) acc[a][b][m][n] = (f32x4){0.f, 0.f, 0.f, 0.f};
    bf16x8 At[4][2], B0[2][2], B1[2][2];
    const char* cA = cur.A; const char* cB = cur.B;
    PG8_STAGE(PG8_SB(0, 0), cB, voffB); PG8_STAGE(PG8_SA(0, 0), cA, voffA); PG8_STAGE(PG8_SB(0, 1), cB + hstepB, voffB); PG8_STAGE(PG8_SA(0, 1), cA + hstepA, voffA);
    if (wr == 1) PG8_BAR;
    PG8_WAIT_V(4); PG8_BAR;
    PG8_STAGE(PG8_SB(1, 0), cB + kstep, voffB); PG8_STAGE(PG8_SA(1, 0), cA + kstep, voffA); PG8_STAGE(PG8_SB(1, 1), cB + hstepB + kstep, voffB);
    PG8_WAIT_V(6); PG8_BAR;
    for (;;) {
        const bool has_next = S.next(ui + 1, nxt);
        const char* nA = has_next ? nxt.A : cA; const char* nB = has_next ? nxt.B : cB;
        for (int t = 0; t < nt; t += 2) {
            const bool last = (t == nt - 2);
            const char* a1 = cA + (size_t)(t + 1) * kstep;
            const char* a2 = last ? nA : cA + (size_t)(t + 2) * kstep; const char* b2 = last ? nB : cB + (size_t)(t + 2) * kstep;
            const char* a3 = a2 + kstep; const char* b3 = b2 + kstep;
            PG8_LDB(B0, 0, 0); PG8_SCHED; PG8_LDA(At, 0, 0); PG8_STAGE(PG8_SA(1, 1), a1 + hstepA, voffA);
            PG8_WAIT_L(8); PG8_BAR; PG8_WAIT_L(0); PG8_MMA(0, 0, At, B0); PG8_BAR; PG8_SCHED;
            PG8_LDB(B1, 0, 1); PG8_STAGE(PG8_SB(0, 0), b2, voffB);
            PG8_BAR; PG8_WAIT_L(0); PG8_MMA(0, 1, At, B1); PG8_BAR;
            PG8_LDA(At, 0, 1); PG8_STAGE(PG8_SA(0, 0), a2, voffA);
            PG8_BAR; PG8_WAIT_L(0); PG8_MMA(1, 0, At, B0); PG8_BAR; PG8_SCHED;
            PG8_STAGE(PG8_SB(0, 1), b2 + hstepB, voffB);
            PG8_WAIT_V(6); PG8_BAR; PG8_MMA(1, 1, At, B1); PG8_BAR;
            PG8_LDB(B0, 1, 0); PG8_SCHED; PG8_LDA(At, 1, 0); PG8_STAGE(PG8_SA(0, 1), a2 + hstepA, voffA);
            PG8_WAIT_L(8); PG8_BAR; PG8_WAIT_L(0); PG8_MMA(0, 0, At, B0); PG8_BAR; PG8_SCHED;
            PG8_LDB(B1, 1, 1); PG8_STAGE(PG8_SB(1, 0), b3, voffB);
            PG8_BAR; PG8_WAIT_L(0); PG8_MMA(0, 1, At, B1); PG8_BAR;
            PG8_LDA(At, 1, 1); PG8_STAGE(PG8_SA(1, 0), a3, voffA);
            PG8_BAR; PG8_WAIT_L(0); PG8_MMA(1, 0, At, B0); PG8_BAR; PG8_SCHED;
            PG8_STAGE(PG8_SB(1, 1), b3 + hstepB, voffB);
            PG8_WAIT_V(6); PG8_BAR; PG8_MMA(1, 1, At, B1); PG8_BAR;
        }
        const bool keep = E(acc, cur, wr, wc, fr, fq);
        if (!has_next) break;
        if (!keep) {
#pragma unroll
            for (int a = 0; a < 2; ++a)
#pragma unroll
                for (int b = 0; b < 2; ++b)
#pragma unroll
                    for (int m = 0; m < 4; ++m)
#pragma unroll
                        for (int n = 0; n < 2; ++n) acc[a][b][m][n] = (f32x4){0.f, 0.f, 0.f, 0.f};
        }
        cur = nxt; cA = nA; cB = nB; ++ui;
    }
    PG8_WAIT_V(0);
    if (wr == 0) PG8_BAR;
    PG8_BAR;
#undef PG8_SA
#undef PG8_SB
#undef PG8_STAGE
#undef PG8_LDA
#undef PG8_LDB
#undef PG8_MMA
#undef PG8_WAIT_V
#undef PG8_WAIT_L
#undef PG8_BAR
#undef PG8_SCHED
}
}

__device__ __forceinline__ void tconv_tile(const float* src, int ld_src, int nvalid, bf16_t* dst, int ld_dst, int tid) {
    float* t = (float*)smem;
    { const int r = tid >> 3, c0 = (tid & 7) * 8;
#pragma unroll
      for (int j = 0; j < 8; ++j) { const int c = c0 + j; const float v = (c < nvalid) ? src[(size_t)r * ld_src + c] : 0.f; t[c * 65 + r] = v; } }
    __syncthreads();
    { const int n = tid >> 3, k0 = (tid & 7) * 8; const float* p = t + n * 65 + k0;
      u32x4 w; w.x = pack2(p[0], p[1]); w.y = pack2(p[2], p[3]); w.z = pack2(p[4], p[5]); w.w = pack2(p[6], p[7]);
      *(u32x4*)(dst + (size_t)n * ld_dst + k0) = w; }
    __syncthreads();
}

__device__ __forceinline__ void phase_prep(ArgsRef a, int l, int tid, int bid, int G) {
    unsigned char* ws = a.ws;
    bf16_t* WIN = (bf16_t*)(ws + OFF_WIN); bf16_t* WQKV = (bf16_t*)(ws + OFF_WQKV); bf16_t* WGLU = (bf16_t*)(ws + OFF_WGLU);
    bf16_t* WB = (bf16_t*)(ws + OFF_WB); bf16_t* WOUT = (bf16_t*)(ws + OFF_WOUT);
    for (int u = bid; u < 2624; u += G) {
        const float* src; int lds_ = 0, nvalid = 64, ldd = 0; bf16_t* dst;
        if (u < 1728) { const int nt = u / 16, kt = u % 16, p0 = nt * 64; int sc;
            if (p0 < 1024) sc = p0; else if (p0 < 6656) sc = p0 + 8; else if (p0 == 6656) { sc = 1024; nvalid = 8; } else { sc = 0; nvalid = 0; }
            src = a.in[1] + (size_t)l * 1024 * INW + (size_t)(kt * 64) * INW + sc; lds_ = INW; dst = WIN + (size_t)p0 * 1024 + kt * 64; ldd = 1024; }
        else if (u < 1920) { const int v = u - 1728, nt = v / 8, kt = v % 8, which = nt / 8, h = (nt % 8) / 2;
            if ((kt >> 1) != h) nvalid = 0;
            src = a.in[4 + which] + (size_t)(l * 4 + h) * 128 * 128 + ((kt & 1) * 64) * 128 + (nt & 1) * 64; lds_ = 128; dst = WQKV + (size_t)(nt * 64) * 512 + kt * 64; ldd = 512; }
        else if (u < 1984) { const int v = u - 1920, nt = v / 8, kt = v % 8;
            src = a.in[18] + (size_t)l * 512 * 512 + (kt * 64) * 512 + nt * 64; lds_ = 512; dst = WGLU + (size_t)(nt * 64) * 512 + kt * 64; ldd = 512; }
        else if (u < 2368) { const int v = u - 1984, b = v / 128, w = v % 128, nt = w / 8, kt = w % 8;
            src = a.in[21 + b] + (size_t)l * 512 * 1024 + (size_t)(kt * 64) * 1024 + nt * 64; lds_ = 1024; dst = WB + (size_t)b * 1024 * 512 + (size_t)(nt * 64) * 512 + kt * 64; ldd = 512; }
        else { const int v = u - 2368, nt = v / 16, kt = v % 16;
            src = a.in[24] + (size_t)l * 1024 * 1024 + (size_t)(kt * 64) * 1024 + nt * 64; lds_ = 1024; dst = WOUT + (size_t)(nt * 64) * 1024 + kt * 64; ldd = 1024; }
        tconv_tile(src, lds_, nvalid, dst, ldd, tid);
    }
    float* ABAR = (float*)(ws + OFF_ABAR); bf16_t* BBT = (bf16_t*)(ws + OFF_BBT); bf16_t* CCT = (bf16_t*)(ws + OFF_CCT);
    for (int i = bid * 512 + tid; i < 2048; i += G * 512) {
        const int g = i / 64, p = i % 64; const size_t gp = (size_t)(l * 32 + g) * 64 + p;
        const float lr = fminf(a.in[10][gp], -1e-4f), li = a.in[11][gp], dt = expf(a.in[12][l * 32 + g]);
        const float mag = expf(lr * dt), abr = mag * cosf(li * dt), abi = mag * sinf(li * dt);
        const float nr = abr - 1.0f, den = lr * lr + li * li, cr = (nr * lr + abi * li) / den, ci = (abi * lr - nr * li) / den;
        ABAR[(g * 64 + p) * 2] = abr; ABAR[(g * 64 + p) * 2 + 1] = abi;
        for (int c = 0; c < 16; ++c) { const float br = a.in[13][gp * 16 + c], bi = a.in[14][gp * 16 + c];
            BBT[(size_t)(g * 128 + p) * 16 + c] = f2bf(cr * br - ci * bi); BBT[(size_t)(g * 128 + 64 + p) * 16 + c] = f2bf(cr * bi + ci * br);
            const size_t ci_ = ((size_t)(l * 32 + g) * 16 + c) * 64 + p;
            CCT[(size_t)(g * 16 + c) * 128 + p] = f2bf(a.in[15][ci_]); CCT[(size_t)(g * 16 + c) * 128 + 64 + p] = f2bf(-a.in[16][ci_]); }
    }
    { float* RWT = (float*)(ws + OFF_RWT); const float* RW = a.in[29]; for (int i = bid * 512 + tid; i < 32 * 1024; i += G * 512) RWT[i] = RW[(i & 1023) * 32 + (i >> 10)]; }
    if (bid == 0 && tid < 128) ((unsigned*)(ws + OFF_CTL))[tid] = 0u;
    if (l == 0) { bf16_t* XB = (bf16_t*)(ws + OFF_XB); const float* x = a.in[0];
        for (size_t i = (size_t)bid * 512 + tid; i < (size_t)T * 1024 / 8; i += (size_t)G * 512) {
            const f32x4 v0 = *(const f32x4*)(x + i * 8), v1 = *(const f32x4*)(x + i * 8 + 4);
            u32x4 w; w.x = pack2(v0[0], v0[1]); w.y = pack2(v0[2], v0[3]); w.z = pack2(v1[0], v1[1]); w.w = pack2(v1[2], v1[3]); *(u32x4*)(XB + i * 8) = w; } }
}

__device__ __forceinline__ void phase_prepx(ArgsRef a, int l, int tid, int bid, int G) {
    bf16_t* WGU = (bf16_t*)(a.ws + OFF_WGU); bf16_t* WD = (bf16_t*)(a.ws + OFF_WD);
    for (int u = bid; u < 6144; u += G) {
        const float* src; int lds_, ldd; bf16_t* dst;
        if (u < 4096) { const int up = u >= 2048, v = u & 2047, e = v / 64, w = v % 64, nt = w / 16, kt = w % 16, j0 = nt * 64, drow = (j0 / 128) * 256 + (j0 % 128) + up * 128;
            src = a.in[31 + up] + ((size_t)(l * 32 + e) * 1024 + kt * 64) * 256 + nt * 64; lds_ = 256; dst = WGU + ((size_t)e * 512 + drow) * 1024 + kt * 64; ldd = 1024; }
        else { const int v = u - 4096, e = v / 64, w = v % 64, nt = w / 4, kt = w % 4;
            src = a.in[33] + ((size_t)(l * 32 + e) * 256 + kt * 64) * 1024 + nt * 64; lds_ = 1024; dst = WD + ((size_t)e * 1024 + nt * 64) * 256 + kt * 64; ldd = 256; }
        tconv_tile(src, lds_, 64, dst, ldd, tid);
    }
}

constexpr int GL_QS = 0, GL_KS = 8704, GL_KT = 17408, GL_VT = 27648, GL_PS = 39168, GL_SC1 = 41728, GL_SC2 = 42240, GL_GT = 42752, GL_OS = 44800;
template <int MODE, int PASS>
__device__ __forceinline__ void gla_item(ArgsRef a, int l, int h, int sg, int tid, int lane, int wave) {
    unsigned char* ws = a.ws;
    const bf16_t* Z = (const bf16_t*)(ws + OFF_Z); const bf16_t* Qg = (const bf16_t*)(ws + OFF_Q); const bf16_t* Kg = (const bf16_t*)(ws + OFF_KH); const bf16_t* Vg = (const bf16_t*)(ws + OFF_V);
    const float* LF = (const float*)(ws + OFF_LF);
    float* Eg = (float*)(ws + (MODE == 0 ? OFF_EM : OFF_EH)); float* Gg = (float*)(ws + (MODE == 0 ? OFF_GM : OFF_GH)); float* EX = (float*)(ws + OFF_EMX);
    bf16_t* Og = (bf16_t*)(ws + (MODE == 0 ? OFF_OM : OFF_OH)); float* DEN = (float*)(ws + OFF_DEN);
    bf16_t* QS = (bf16_t*)(smem + GL_QS); bf16_t* KS = (bf16_t*)(smem + GL_KS); bf16_t* KT = (bf16_t*)(smem + GL_KT); bf16_t* VT = (bf16_t*)(smem + GL_VT); bf16_t* PS = (bf16_t*)(smem + GL_PS);
    float* SC1 = (float*)(smem + GL_SC1); float* SC2 = (float*)(smem + GL_SC2); float* GT = (float*)(smem + GL_GT); bf16_t* OS = (bf16_t*)(smem + GL_OS);
    const int r = lane & 15, q = lane >> 4, grp = tid >> 7, d = tid & 127;
    const bool xw = (MODE == 0) && (wave == 0);
    float lb = 0.f;
    if (MODE == 1 && l == 1) { const float h0 = a.in[19][h * 128 + d], h1 = a.in[19][512 + h * 128 + d]; lb = 1.0f / (1.0f + expf(h0 - h1)); }
    f32x4 S[8], SX[8];
#pragma unroll
    for (int i = 0; i < 8; ++i) { S[i] = (f32x4){0.f, 0.f, 0.f, 0.f}; SX[i] = (f32x4){0.f, 0.f, 0.f, 0.f}; }
    if (PASS == 2) {
#pragma unroll
        for (int i = 0; i < 8; ++i)
#pragma unroll
            for (int g = 0; g < 4; ++g) { const size_t row = (size_t)(sg * 4 + h) * 128 + 16 * i + 4 * q + g; S[i][g] = Eg[row * 128 + 16 * wave + r]; if (xw) SX[i][g] = EX[row * 16 + r]; }
    }
    __syncthreads();
    if (MODE == 0) { for (int i = tid; i < 16 * 40; i += 512) VT[128 * 40 + i] = (i < 32) ? (bf16_t)0x3F80 : (bf16_t)0; }
    float runb = 0.f;
    for (int ci = 0; ci < GSEGLEN / 32; ++ci) {
        const int t0 = sg * GSEGLEN + ci * 32, tb = t0 + grp * 8;
        float lg[8], qv[8], kv[8]; bf16_t vv[8];
#pragma unroll
        for (int j = 0; j < 8; ++j) {
            if (MODE == 1) { const size_t zo = (size_t)(tb + j) * NZ + h * 128 + d; const float qp = bf2f(Z[zo + 1536]), fp = bf2f(Z[zo + 2048]);
                const float f = lb + (1.0f - lb) * sigmoidf_(fp); lg[j] = flog(f); qv[j] = siluf_(qp); kv[j] = 1.0f - f; vv[j] = Z[zo + 2560]; }
            else { const size_t o = (size_t)(tb + j) * 512 + h * 128 + d; qv[j] = bf2f(Qg[o]); kv[j] = bf2f(Kg[o]); vv[j] = Vg[o]; lg[j] = LF[(tb + j) * 4 + h]; }
        }
        float cs[8]; cs[0] = lg[0];
#pragma unroll
        for (int j = 1; j < 8; ++j) cs[j] = cs[j - 1] + lg[j];
        GT[grp * 128 + d] = cs[7];
        __syncthreads();
        if (PASS == 2 && ci > 0) { const int row = tid >> 4, c8 = (tid & 15) * 8; *(u32x4*)(Og + (size_t)(t0 - 32 + row) * 512 + h * 128 + c8) = *(const u32x4*)(OS + row * 136 + c8); }
        const float g0 = GT[d], g1 = GT[128 + d], g2 = GT[256 + d], g3 = GT[384 + d];
        const float off = grp == 0 ? 0.f : grp == 1 ? g0 : grp == 2 ? g0 + g1 : g0 + g1 + g2;
        const float bmid = g0 + g1, bL = bmid + g2 + g3;
        bf16_t ktv[8];
#pragma unroll
        for (int j = 0; j < 8; ++j) { const float bt = off + cs[j]; const bf16_t kt = f2bf(kv[j] * fexp(bmid - bt)); ktv[j] = kt;
            if (PASS == 2) { QS[(grp * 8 + j) * 136 + d] = f2bf(qv[j] * fexp(bt - bmid)); KS[(grp * 8 + j) * 136 + d] = kt; } }
        { u32x4 w; w.x = ktv[0] | ((unsigned)ktv[1] << 16); w.y = ktv[2] | ((unsigned)ktv[3] << 16); w.z = ktv[4] | ((unsigned)ktv[5] << 16); w.w = ktv[6] | ((unsigned)ktv[7] << 16); *(u32x4*)(KT + d * 40 + grp * 8) = w;
          u32x4 x; x.x = vv[0] | ((unsigned)vv[1] << 16); x.y = vv[2] | ((unsigned)vv[3] << 16); x.z = vv[4] | ((unsigned)vv[5] << 16); x.w = vv[6] | ((unsigned)vv[7] << 16); *(u32x4*)(VT + d * 40 + grp * 8) = x; }
        if (grp == 0) { SC1[d] = fexp(bmid); SC2[d] = fexp(bL - bmid); runb += bL; }
        __syncthreads();
        if (PASS == 2) {
            if (wave < 4) {
                const int ti = (wave == 1 || wave == 2) ? 1 : 0, tj = (wave >= 2) ? 1 : 0;
                f32x4 p = (f32x4){0.f, 0.f, 0.f, 0.f};
                if (wave < 3) {
#pragma unroll
                    for (int kk = 0; kk < 4; ++kk) { const bf16x8 av = *(const bf16x8*)(QS + (16 * ti + r) * 136 + 32 * kk + 8 * q); const bf16x8 bv = *(const bf16x8*)(KS + (16 * tj + r) * 136 + 32 * kk + 8 * q); p = MFMA16(av, bv, p); }
                }
#pragma unroll
                for (int g = 0; g < 4; ++g) { const int t = 16 * ti + 4 * q + g, s = 16 * tj + r; PS[t * 40 + s] = (wave < 3 && s <= t) ? f2bf(p[g]) : (bf16_t)0; }
            }
            __syncthreads();
        }
        const bf16x8 bV = *(const bf16x8*)(VT + (16 * wave + r) * 40 + 8 * q);
        bf16x8 bV1 = bV; if (xw) bV1 = *(const bf16x8*)(VT + (128 + r) * 40 + 8 * q);
        f32x4 o[2], ox[2];
        o[0] = o[1] = ox[0] = ox[1] = (f32x4){0.f, 0.f, 0.f, 0.f};
#pragma unroll
        for (int kk = 0; kk < 4; ++kk) {
            const f32x4 sa = *(const f32x4*)(SC1 + 32 * kk + 4 * q), sb = *(const f32x4*)(SC1 + 32 * kk + 16 + 4 * q);
            S[2 * kk] *= sa; S[2 * kk + 1] *= sb;
            if (xw) { SX[2 * kk] *= sa; SX[2 * kk + 1] *= sb; }
            if (PASS == 2) {
                bf16x8 bS, bX;
#pragma unroll
                for (int g = 0; g < 4; ++g) { bS[g] = (short)f2bf(S[2 * kk][g]); bS[4 + g] = (short)f2bf(S[2 * kk + 1][g]); bX[g] = (short)f2bf(SX[2 * kk][g]); bX[4 + g] = (short)f2bf(SX[2 * kk + 1][g]); }
#pragma unroll
                for (int mt = 0; mt < 2; ++mt) { const bf16x4 lo = *(const bf16x4*)(QS + (16 * mt + r) * 136 + 32 * kk + 4 * q), hi = *(const bf16x4*)(QS + (16 * mt + r) * 136 + 32 * kk + 16 + 4 * q);
                    bf16x8 av; av[0] = lo[0]; av[1] = lo[1]; av[2] = lo[2]; av[3] = lo[3]; av[4] = hi[0]; av[5] = hi[1]; av[6] = hi[2]; av[7] = hi[3];
                    o[mt] = MFMA16(av, bS, o[mt]); if (xw) ox[mt] = MFMA16(av, bX, ox[mt]); }
            }
        }
        if (PASS == 2) {
#pragma unroll
            for (int mt = 0; mt < 2; ++mt) { const bf16x8 av = *(const bf16x8*)(PS + (16 * mt + r) * 40 + 8 * q); o[mt] = MFMA16(av, bV, o[mt]); if (xw) ox[mt] = MFMA16(av, bV1, ox[mt]);
#pragma unroll
                for (int g = 0; g < 4; ++g) { const int t = t0 + 16 * mt + 4 * q + g; OS[(16 * mt + 4 * q + g) * 136 + 16 * wave + r] = f2bf(o[mt][g]); if (xw && r == 0) DEN[h * T + t] = ox[mt][g]; } }
        }
#pragma unroll
        for (int i = 0; i < 8; ++i) { const bf16x8 av = *(const bf16x8*)(KT + (16 * i + r) * 40 + 8 * q); const f32x4 s2 = *(const f32x4*)(SC2 + 16 * i + 4 * q);
            S[i] = MFMA16(av, bV, S[i]); S[i] *= s2;
            if (xw) { SX[i] = MFMA16(av, bV1, SX[i]); SX[i] *= s2; } }
    }
    if (PASS == 2) { __syncthreads(); const int row = tid >> 4, c8 = (tid & 15) * 8; *(u32x4*)(Og + (size_t)(sg * GSEGLEN + GSEGLEN - 32 + row) * 512 + h * 128 + c8) = *(const u32x4*)(OS + row * 136 + c8); }
    if (PASS == 1) {
        float* ST = (float*)smem;
        __syncthreads();
#pragma unroll
        for (int i = 0; i < 8; ++i)
#pragma unroll
            for (int g = 0; g < 4; ++g) { ST[(16 * i + 4 * q + g) * 132 + 16 * wave + r] = S[i][g]; if (xw) EX[((size_t)(sg * 4 + h) * 128 + 16 * i + 4 * q + g) * 16 + r] = SX[i][g]; }
        __syncthreads();
#pragma unroll
        for (int k = 0; k < 8; ++k) { const int idx = tid + 512 * k, row = idx >> 5, c4 = (idx & 31) * 4; *(f32x4*)(Eg + ((size_t)(sg * 4 + h) * 128 + row) * 128 + c4) = *(const f32x4*)(ST + row * 132 + c4); }
        if (grp == 0) Gg[(size_t)(sg * 4 + h) * 128 + d] = expf(runb);
    }
}

template <int PASS>
__device__ __forceinline__ void s5_item(ArgsRef a, int l, int g, int sg, int g0, int tid, int lane, int wave, int hsel) {
    unsigned char* ws = a.ws;
    const bf16_t* Z = (const bf16_t*)(ws + OFF_Z); const float* ABAR = (const float*)(ws + OFF_ABAR); const bf16_t* BBT = (const bf16_t*)(ws + OFF_BBT); const bf16_t* CCT = (const bf16_t*)(ws + OFF_CCT);
    float* ES = (float*)(ws + OFF_ES); bf16_t* YPRE = (bf16_t*)(ws + OFF_YPRE);
    float* BU = (float*)(smem + 70000 + (wave & 3) * 12800); bf16_t* X = (bf16_t*)(smem + 70000 + (wave & 3) * 12800 + 8448); bf16_t* YT = (bf16_t*)(smem + 70000 + 51200);
    const int r = lane & 15, q = lane >> 4, p = lane; const bool act = (wave >> 2) == hsel;
    const float ar = ABAR[(g * 64 + p) * 2], ai = ABAR[(g * 64 + p) * 2 + 1];
    const bf16x8 zero8 = (bf16x8){0, 0, 0, 0, 0, 0, 0, 0};
    bf16x8 bB[8], cB[4];
#pragma unroll
    for (int nt = 0; nt < 8; ++nt) bB[nt] = (q < 2) ? *(const bf16x8*)(BBT + (size_t)(g * 128 + 16 * nt + r) * 16 + 8 * q) : zero8;
#pragma unroll
    for (int kk = 0; kk < 4; ++kk) cB[kk] = (PASS == 2) ? *(const bf16x8*)(CCT + (size_t)(g * 16 + r) * 128 + 32 * kk + 8 * q) : zero8;
    float xr = 0.f, xi = 0.f;
    if (PASS == 2) { xr = ES[((size_t)(sg * 32 + g) * 64 + p) * 2]; xi = ES[((size_t)(sg * 32 + g) * 64 + p) * 2 + 1]; }
    const float dsk = a.in[17][l * 512 + 16 * g + r];
    for (int ci = 0; ci < SSEGLEN / 16; ++ci) {
        const int t0 = sg * SSEGLEN + ci * 16;
        if (act) {
            const bf16x8 av = (q < 2) ? *(const bf16x8*)(Z + (size_t)(t0 + r) * NZ + 1024 + 16 * g + 8 * q) : zero8;
#pragma unroll
            for (int nt = 0; nt < 8; ++nt) { f32x4 acc = (f32x4){0.f, 0.f, 0.f, 0.f}; acc = MFMA16(av, bB[nt], acc);
#pragma unroll
                for (int gg = 0; gg < 4; ++gg) BU[(4 * q + gg) * 132 + 16 * nt + r] = acc[gg]; }
            wave_sync();
#pragma unroll
            for (int t = 0; t < 16; ++t) { const float br = BU[t * 132 + p], bi = BU[t * 132 + 64 + p];
                const float nr = ar * xr - ai * xi + br, ni = ar * xi + ai * xr + bi; xr = nr; xi = ni;
                if (PASS == 2) { X[t * 136 + p] = f2bf(xr); X[t * 136 + 64 + p] = f2bf(xi); } }
            wave_sync();
            if (PASS == 2) {
                f32x4 acc = (f32x4){0.f, 0.f, 0.f, 0.f};
#pragma unroll
                for (int kk = 0; kk < 4; ++kk) { const bf16x8 xv = *(const bf16x8*)(X + r * 136 + 32 * kk + 8 * q); acc = MFMA16(xv, cB[kk], acc); }
#pragma unroll
                for (int gg = 0; gg < 4; ++gg) { const int t = t0 + 4 * q + gg, c = 16 * g + r; const float u = bf2f(Z[(size_t)t * NZ + 1024 + c]);
                    YT[(4 * q + gg) * 136 + 16 * wave + r] = f2bf(gelu_tanh(acc[gg] + dsk * u)); }
            }
        }
        if (PASS == 2) {
            __syncthreads();
            if (tid < 128) { const int row = tid >> 3, c8 = (tid & 7) * 8; *(u32x4*)(YPRE + (size_t)(t0 + row) * 512 + 16 * g0 + 64 * hsel + c8) = *(const u32x4*)(YT + row * 136 + 64 * hsel + c8); }
            __syncthreads();
        }
    }
    if (PASS == 1 && act) { ES[((size_t)(sg * 32 + g) * 64 + p) * 2] = xr; ES[((size_t)(sg * 32 + g) * 64 + p) * 2 + 1] = xi; }
}

__device__ __forceinline__ void phase_scan(ArgsRef a, int tid, int bid, int G) {
    unsigned char* ws = a.ws;
    const int NT = G * 512, gt = bid * 512 + tid;
    for (int i = gt; i < 2 * 65536 + 8192 + 2048; i += NT) {
        if (i < 2 * 65536) { const int m = i >> 16, el = i & 65535, hrow = el >> 7;
            float* E = (float*)(ws + (m == 0 ? OFF_EM : OFF_EH)); const float* Gd = (const float*)(ws + (m == 0 ? OFF_GM : OFF_GH));
            float cur = 0.f;
#pragma unroll 8
            for (int sg = 0; sg < GSEG; ++sg) { const float e = E[(size_t)sg * 65536 + el], g = Gd[sg * 512 + hrow]; E[(size_t)sg * 65536 + el] = cur; cur = g * cur + e; } }
        else if (i < 2 * 65536 + 8192) { const int el = i - 2 * 65536, hrow = el >> 4; float* E = (float*)(ws + OFF_EMX); const float* Gd = (const float*)(ws + OFF_GM);
            float cur = 0.f;
#pragma unroll 8
            for (int sg = 0; sg < GSEG; ++sg) { const float e = E[(size_t)sg * 8192 + el], g = Gd[sg * 512 + hrow]; E[(size_t)sg * 8192 + el] = cur; cur = g * cur + e; } }
        else { const int el = i - 2 * 65536 - 8192; float* E = (float*)(ws + OFF_ES); const float* ABAR = (const float*)(ws + OFF_ABAR);
            float pr = ABAR[el * 2], pi = ABAR[el * 2 + 1];
#pragma unroll
            for (int k = 0; k < 8; ++k) { const float nr = pr * pr - pi * pi, ni = 2.0f * pr * pi; pr = nr; pi = ni; }
            float xr = 0.f, xi = 0.f;
#pragma unroll 8
            for (int sg = 0; sg < SSEG; ++sg) { const float er = E[((size_t)sg * 2048 + el) * 2], ei = E[((size_t)sg * 2048 + el) * 2 + 1];
                E[((size_t)sg * 2048 + el) * 2] = xr; E[((size_t)sg * 2048 + el) * 2 + 1] = xi;
                const float nr = pr * xr - pi * xi + er, ni = pr * xi + pi * xr + ei; xr = nr; xi = ni; } }
    }
}

template <int PASS>
__device__ __forceinline__ void phase_mixers(ArgsRef a, int l, int tid, int lane, int wave, int bid, int G) {
    for (int it = bid; it < 4 * GSEG; it += G) gla_item<0, PASS>(a, l, it % 4, it / 4, tid, lane, wave);
    asm volatile("" ::: "memory");
    for (int it = bid + ((4 * GSEG - bid % G) % G + G) % G * 0; it < 2 * 4 * GSEG; it += G) { if (it >= 4 * GSEG) gla_item<1, PASS>(a, l, (it - 4 * GSEG) % 4, (it - 4 * GSEG) / 4, tid, lane, wave); }
    __syncthreads();
    for (int it0 = bid * 8; it0 < 32 * SSEG; it0 += G * 8)
        for (int half = 0; half < 2; ++half) { const int it = it0 + wave; s5_item<PASS>(a, l, it % 32, it / 32, it0 % 32, tid, lane, wave, half); __syncthreads(); }
}

__device__ __forceinline__ void phase_post(ArgsRef a, int l, int lane, int gw, int GW) {
    const bf16_t* Z = (const bf16_t*)(a.ws + OFF_Z); const bf16_t* XC = (const bf16_t*)(a.ws + OFF_XC);
    bf16_t* OM = (bf16_t*)(a.ws + OFF_OM); bf16_t* OH = (bf16_t*)(a.ws + OFF_OH); const float* DEN = (const float*)(a.ws + OFF_DEN);
    const int c0 = lane * 8, hd = lane >> 4;
    float skp[8], nw[8];
#pragma unroll
    for (int j = 0; j < 8; ++j) { skp[j] = a.in[9][l * 512 + c0 + j]; nw[j] = a.in[20][l * 512 + c0 + j]; }
    for (int tb = gw * 4; tb < T; tb += GW * 4) {
        bf16x8 om[4], op[4], xc[4], oh[4], gp[4]; float dn[4];
#pragma unroll
        for (int k = 0; k < 4; ++k) { const size_t t = tb + k; om[k] = *(const bf16x8*)(OM + t * 512 + c0); op[k] = *(const bf16x8*)(Z + t * NZ + 512 + c0); xc[k] = *(const bf16x8*)(XC + t * 512 + c0);
            oh[k] = *(const bf16x8*)(OH + t * 512 + c0); gp[k] = *(const bf16x8*)(Z + t * NZ + 3072 + c0); dn[k] = DEN[hd * T + t]; }
#pragma unroll
        for (int k = 0; k < 4; ++k) { const size_t t = tb + k; const float di = __builtin_amdgcn_rcpf(fmaxf(fabsf(dn[k]), 1.0f)); float y[8], ov[8], ss = 0.f;
#pragma unroll
            for (int j = 0; j < 8; ++j) { y[j] = sigmoidf_(bf2f((bf16_t)op[k][j])) * (bf2f((bf16_t)om[k][j]) * di) + skp[j] * bf2f((bf16_t)xc[k][j]); ov[j] = bf2f((bf16_t)oh[k][j]); ss += ov[j] * ov[j]; }
            u32x4 w; w.x = pack2(y[0], y[1]); w.y = pack2(y[2], y[3]); w.z = pack2(y[4], y[5]); w.w = pack2(y[6], y[7]); *(u32x4*)(OM + t * 512 + c0) = w;
            ss += __shfl_xor(ss, 1); ss += __shfl_xor(ss, 2); ss += __shfl_xor(ss, 4); ss += __shfl_xor(ss, 8);
            const float rinv = rsqrtf(ss * (1.0f / 128.0f) + 1e-6f);
#pragma unroll
            for (int j = 0; j < 8; ++j) y[j] = ov[j] * rinv * nw[j] * siluf_(bf2f((bf16_t)gp[k][j]));
            u32x4 x; x.x = pack2(y[0], y[1]); x.y = pack2(y[2], y[3]); x.z = pack2(y[4], y[5]); x.w = pack2(y[6], y[7]); *(u32x4*)(OH + t * 512 + c0) = x; }
    }
}

__device__ __forceinline__ void ln_row(f32x4 (&v)[4], const float* gam, const float* bet, int lane) {
    float s = 0.f;
#pragma unroll
    for (int j = 0; j < 4; ++j) s += (v[j][0] + v[j][1]) + (v[j][2] + v[j][3]);
#pragma unroll
    for (int o = 32; o >= 1; o >>= 1) s += __shfl_xor(s, o);
    const float mean = s * (1.0f / 1024.0f); float qv = 0.f;
#pragma unroll
    for (int j = 0; j < 4; ++j) { const f32x4 dd = v[j] - mean; qv += (dd[0] * dd[0] + dd[1] * dd[1]) + (dd[2] * dd[2] + dd[3] * dd[3]); }
#pragma unroll
    for (int o = 32; o >= 1; o >>= 1) qv += __shfl_xor(qv, o);
    const float rstd = rsqrtf(qv * (1.0f / 1024.0f) + 1e-5f);
#pragma unroll
    for (int j = 0; j < 4; ++j) { const f32x4 gg = *(const f32x4*)(gam + 256 * j + 4 * lane), bb = *(const f32x4*)(bet + 256 * j + 4 * lane); v[j] = (v[j] - mean) * rstd * gg + bb; }
}

__device__ __forceinline__ void phase_ln1r(ArgsRef a, int l, int tid, int lane, int wave, int bid, int G) {
    float* XF = a.out; bf16_t* XB = (bf16_t*)(a.ws + OFF_XB);
    int* TOKE = (int*)(a.ws + OFF_TOKE); float* TOKG = (float*)(a.ws + OFF_TOKG); unsigned* HIST = (unsigned*)(a.ws + OFF_HIST);
    const float* RWT = (const float*)(a.ws + OFF_RWT); const float* RB = a.in[30];
    float* LG = (float*)(smem + wave * 4096);
    int* TE = (int*)(smem + wave * 4096 + 2304); float* TG = (float*)(smem + wave * 4096 + 2432); unsigned* HS = (unsigned*)(smem + wave * 4096 + 2560);
    const int r = lane & 15, q = lane >> 4, rs = lane >> 5, e = lane & 31;
    for (int tw = bid * 8 + wave; tw < T / 16; tw += G * 8) {
        const int t0 = tw * 16;
        for (int rb = 0; rb < 16; rb += 4) { f32x4 v[4][4];
#pragma unroll
            for (int k = 0; k < 4; ++k)
#pragma unroll
                for (int j = 0; j < 4; ++j) v[k][j] = *(const f32x4*)(XF + (size_t)(t0 + rb + k) * 1024 + 256 * j + 4 * lane);
#pragma unroll
            for (int k = 0; k < 4; ++k) { const int t = t0 + rb + k; ln_row(v[k], a.in[25] + l * 1024, a.in[26] + l * 1024, lane);
#pragma unroll
                for (int j = 0; j < 4; ++j) { *(f32x4*)(XF + (size_t)t * 1024 + 256 * j + 4 * lane) = v[k][j];
                    u32x2 w; w.x = pack2(v[k][j][0], v[k][j][1]); w.y = pack2(v[k][j][2], v[k][j][3]); *(u32x2*)(XB + (size_t)t * 1024 + 256 * j + 4 * lane) = w; } } }
        if (lane < 32) HS[lane] = 0u;
        asm volatile("s_waitcnt vmcnt(0) lgkmcnt(0)" ::: "memory"); __builtin_amdgcn_wave_barrier();
        f32x4 acc0 = (f32x4){0.f, 0.f, 0.f, 0.f}, acc1 = acc0;
        const float* xa = XF + (size_t)(t0 + r) * 1024 + 4 * q; const float* w0 = RWT + (size_t)r * 1024 + 4 * q; const float* w1 = RWT + (size_t)(16 + r) * 1024 + 4 * q;
#pragma unroll 4
        for (int s = 0; s < 64; ++s) { const f32x4 av = *(const f32x4*)(xa + 16 * s), b0 = *(const f32x4*)(w0 + 16 * s), b1 = *(const f32x4*)(w1 + 16 * s);
#pragma unroll
            for (int j = 0; j < 4; ++j) { acc0 = __builtin_amdgcn_mfma_f32_16x16x4f32(av[j], b0[j], acc0, 0, 0, 0); acc1 = __builtin_amdgcn_mfma_f32_16x16x4f32(av[j], b1[j], acc1, 0, 0, 0); } }
#pragma unroll
        for (int g = 0; g < 4; ++g) { LG[(4 * q + g) * 33 + r] = acc0[g]; LG[(4 * q + g) * 33 + 16 + r] = acc1[g]; }
        wave_sync();
        for (int pp = 0; pp < 8; ++pp) {
            const float lg = LG[(2 * pp + rs) * 33 + e];
            const float s = sigmoidf_(lg), sb = s + RB[e];
            float v4[4];
#pragma unroll
            for (int i = 0; i < 4; ++i) v4[i] = __shfl(sb, (lane & ~3) + i);
            int i1 = 0;
#pragma unroll
            for (int i = 1; i < 4; ++i) if (v4[i] > v4[i1]) i1 = i;
            int i2 = (i1 == 0) ? 1 : 0;
#pragma unroll
            for (int i = 0; i < 4; ++i) if (i != i1 && i != i2 && v4[i] > v4[i2]) i2 = i;
            float gs = v4[i1] + v4[i2]; int gid = e >> 2;
#pragma unroll
            for (int o = 4; o <= 16; o <<= 1) { const float os = __shfl_xor(gs, o); const int og = __shfl_xor(gid, o); if (os > gs || (os == gs && og < gid)) { gs = os; gid = og; } }
            float sv[4], sbv[4];
#pragma unroll
            for (int i = 0; i < 4; ++i) { sbv[i] = __shfl(sb, (lane & 32) + gid * 4 + i); sv[i] = __shfl(s, (lane & 32) + gid * 4 + i); }
            int j1 = 0;
#pragma unroll
            for (int i = 1; i < 4; ++i) if (sbv[i] > sbv[j1]) j1 = i;
            int j2 = (j1 == 0) ? 1 : 0;
#pragma unroll
            for (int i = 0; i < 4; ++i) if (i != j1 && i != j2 && sbv[i] > sbv[j2]) j2 = i;
            float s1 = sv[0], s2 = sv[0];
#pragma unroll
            for (int i = 1; i < 4; ++i) { if (i == j1) s1 = sv[i]; if (i == j2) s2 = sv[i]; }
            if (e == 0) { const int ti = 2 * pp + rs; const float inv = 1.0f / (s1 + s2);
                TE[ti * 2] = gid * 4 + j1; TE[ti * 2 + 1] = gid * 4 + j2; TG[ti * 2] = s1 * inv; TG[ti * 2 + 1] = s2 * inv;
                atomicAdd(&HS[gid * 4 + j1], 1u); atomicAdd(&HS[gid * 4 + j2], 1u); }
        }
        wave_sync();
        if (lane < 32) { TOKE[t0 * 2 + lane] = TE[lane]; TOKG[t0 * 2 + lane] = TG[lane]; HIST[tw * 32 + lane] = HS[lane]; }
        wave_sync();
    }
}

__device__ __forceinline__ void phase_slot(ArgsRef a, int tid, int lane, int wave, int bid, int G) {
    const int* TOKE = (const int*)(a.ws + OFF_TOKE); int* TOKS = (int*)(a.ws + OFF_TOKS); const unsigned* HIST = (const unsigned*)(a.ws + OFF_HIST);
    unsigned* BASE = (unsigned*)(a.ws + OFF_CTL) + 64;
    const bf16_t* XB = (const bf16_t*)(a.ws + OFF_XB); bf16_t* XG = (bf16_t*)(a.ws + OFF_XG);
    unsigned* base = (unsigned*)smem; unsigned* pre = base + 40; int* el = (int*)(base + 80); int* sl = (int*)(base + 208); unsigned* red = base + 336;
    const int e = tid & 31, part = tid >> 5;
    for (int c = bid; c < T / 64; c += G) {
        unsigned tot = 0u, pr = 0u;
#pragma unroll 8
        for (int it = part; it < 1024; it += 16) { const unsigned v = HIST[it * 32 + e]; tot += v; pr += (it < 4 * c) ? v : 0u; }
        red[part * 32 + e] = tot; red[512 + part * 32 + e] = pr;
        __syncthreads();
        if (tid < 32) { unsigned t2 = 0u, p2 = 0u; for (int k = 0; k < 16; ++k) { t2 += red[k * 32 + tid]; p2 += red[512 + k * 32 + tid]; } pre[tid] = p2; red[tid] = (t2 + 255u) & ~255u; }
        __syncthreads();
        if (tid == 0) { unsigned sacc = 0; for (int k = 0; k < 32; ++k) { base[k] = sacc; sacc += red[k]; } base[32] = sacc; }
        int ee = 0;
        if (tid < 128) { ee = TOKE[c * 128 + tid]; el[tid] = ee; }
        __syncthreads();
        if (c == 0 && tid < 33) BASE[tid] = base[tid];
        if (tid < 128) { unsigned rank = 0; for (int i = 0; i < tid; ++i) rank += (el[i] == ee) ? 1u : 0u;
            const unsigned sidx = base[ee] + pre[ee] + rank; sl[tid] = (int)sidx; TOKS[c * 128 + tid] = (int)sidx; }
        __syncthreads();
        for (int i = wave; i < 128; i += 8) { const int t = c * 64 + (i >> 1); const size_t so = (size_t)sl[i] * 1024;
            *(u32x4*)(XG + so + lane * 8) = *(const u32x4*)(XB + (size_t)t * 1024 + lane * 8); *(u32x4*)(XG + so + 512 + lane * 8) = *(const u32x4*)(XB + (size_t)t * 1024 + 512 + lane * 8); }
        __syncthreads();
    }
}

__device__ __forceinline__ void phase_ln2(ArgsRef a, int l, int lane, int gw, int GW) {
    float* XF = a.out; bf16_t* XB = (bf16_t*)(a.ws + OFF_XB); const bf16_t* YS = (const bf16_t*)(a.ws + OFF_YS);
    const int* TOKS = (const int*)(a.ws + OFF_TOKS); const float* TOKG = (const float*)(a.ws + OFF_TOKG);
    for (int tb = gw * 4; tb < T; tb += GW * 4) {
        int sv = 0; float gv = 0.f; if (lane < 8) { sv = TOKS[tb * 2 + lane]; gv = TOKG[tb * 2 + lane]; }
        f32x4 v[4][4]; bf16x4 y0[4][4], y1[4][4]; float g0[4], g1[4];
#pragma unroll
        for (int k = 0; k < 4; ++k) { const int s0 = __shfl(sv, 2 * k), s1 = __shfl(sv, 2 * k + 1); g0[k] = __shfl(gv, 2 * k); g1[k] = __shfl(gv, 2 * k + 1);
#pragma unroll
            for (int j = 0; j < 4; ++j) { v[k][j] = *(const f32x4*)(XF + (size_t)(tb + k) * 1024 + 256 * j + 4 * lane);
                y0[k][j] = *(const bf16x4*)(YS + (size_t)s0 * 1024 + 256 * j + 4 * lane); y1[k][j] = *(const bf16x4*)(YS + (size_t)s1 * 1024 + 256 * j + 4 * lane); } }
#pragma unroll
        for (int k = 0; k < 4; ++k) {
#pragma unroll
            for (int j = 0; j < 4; ++j)
#pragma unroll
                for (int g = 0; g < 4; ++g) v[k][j][g] = DN_ALPHA * v[k][j][g] + g0[k] * bf2f((bf16_t)y0[k][j][g]) + g1[k] * bf2f((bf16_t)y1[k][j][g]);
            ln_row(v[k], a.in[27] + l * 1024, a.in[28] + l * 1024, lane);
#pragma unroll
            for (int j = 0; j < 4; ++j) { *(f32x4*)(XF + (size_t)(tb + k) * 1024 + 256 * j + 4 * lane) = v[k][j];
                u32x2 w; w.x = pack2(v[k][j][0], v[k][j][1]); w.y = pack2(v[k][j][2], v[k][j][3]); *(u32x2*)(XB + (size_t)(tb + k) * 1024 + 256 * j + 4 * lane) = w; } }
    }
}

struct SchedGrid {
    int nM, nN, G, c; const char* A; const char* B; size_t strideA, strideB;
    __device__ __forceinline__ bool next(int i, pg8::Unit& u) const { int pm, pn; if (!pg8::tile_order(i * G + c, nM, nN, pm, pn)) return false;
        u.pm = pm; u.pn = pn; u.tag = 0; u.A = A + (size_t)pm * strideA; u.B = B + (size_t)pn * strideB; return true; }
};
constexpr int GATES_LD = 3072;
template <int MODE> struct EpiBf16 {
    static constexpr bool PERM = true;
    bf16_t* O; int ldo; const bf16_t* Y; int ldy;
    __device__ __forceinline__ bool operator()(f32x4 (&acc)[2][2][4][2], const pg8::Unit& u, int wr, int wc, int fr, int fq) const {
#pragma unroll
        for (int ai = 0; ai < 2; ++ai)
#pragma unroll
            for (int m = 0; m < 4; ++m) { const size_t row = (size_t)u.pm * 256 + ai * 128 + wr * 64 + m * 16 + fr;
#pragma unroll
                for (int bj = 0; bj < 2; ++bj) { const int col = u.pn * 256 + bj * 128 + wc * 32 + 8 * fq; f32x4 v0 = acc[ai][bj][m][0], v1 = acc[ai][bj][m][1];
                    if (MODE == 1) {
#pragma unroll
                        for (int j = 0; j < 4; ++j) { v0[j] = fmaxf(sigmoidf_(v0[j]), 1e-30f); v1[j] = fmaxf(sigmoidf_(v1[j]), 1e-30f); } }
                    if (MODE == 2) { const bf16x8 y = *(const bf16x8*)(Y + row * ldy + col);
#pragma unroll
                        for (int j = 0; j < 4; ++j) { v0[j] = bf2f((bf16_t)y[j]) * sigmoidf_(v0[j]); v1[j] = bf2f((bf16_t)y[4 + j]) * sigmoidf_(v1[j]); } }
                    u32x4 w; w.x = pg8::cvt_pk_bf16(v0[0], v0[1]); w.y = pg8::cvt_pk_bf16(v0[2], v0[3]); w.z = pg8::cvt_pk_bf16(v1[0], v1[1]); w.w = pg8::cvt_pk_bf16(v1[2], v1[3]);
                    *(u32x4*)(O + row * ldo + col) = w; } }
        return false;
    }
};
struct SchedZ {
    int G, c; const unsigned char* ws;
    __device__ __forceinline__ bool next(int i, pg8::Unit& u) const { int pm, pn; if (!pg8::tile_order(i * G + c, T / 256, 15, pm, pn)) return false;
        u.pm = pm; u.pn = pn; u.tag = 0; u.A = (const char*)(ws + OFF_XB) + (size_t)pm * 256 * 1024 * 2;
        u.B = (const char*)(ws + OFF_WIN) + (size_t)(pn < 14 ? pn * 256 : 6656) * 1024 * 2; return true; }
};
struct EpiZ {
    static constexpr bool PERM = true;
    bf16_t* Z; float* LI; float* LF; const float* bi; const float* bf;
    __device__ __forceinline__ bool operator()(f32x4 (&acc)[2][2][4][2], const pg8::Unit& u, int wr, int wc, int fr, int fq) const {
        if (u.pn < 14) {
#pragma unroll
            for (int ai = 0; ai < 2; ++ai)
#pragma unroll
                for (int m = 0; m < 4; ++m) { const size_t row = (size_t)u.pm * 256 + ai * 128 + wr * 64 + m * 16 + fr;
#pragma unroll
                    for (int bj = 0; bj < 2; ++bj) { const int col = u.pn * 256 + bj * 128 + wc * 32 + 8 * fq; const f32x4 v0 = acc[ai][bj][m][0], v1 = acc[ai][bj][m][1];
                        u32x4 w; w.x = pg8::cvt_pk_bf16(v0[0], v0[1]); w.y = pg8::cvt_pk_bf16(v0[2], v0[3]); w.z = pg8::cvt_pk_bf16(v1[0], v1[1]); w.w = pg8::cvt_pk_bf16(v1[2], v1[3]);
                        *(u32x4*)(Z + row * NZ + col) = w; } }
        } else if (wc == 0 && fq == 0) {
            const f32x4 b_i = *(const f32x4*)bi, b_f = *(const f32x4*)bf;
#pragma unroll
            for (int ai = 0; ai < 2; ++ai)
#pragma unroll
                for (int m = 0; m < 4; ++m) { const size_t row = (size_t)u.pm * 256 + ai * 128 + wr * 64 + m * 16 + fr; const f32x4 v0 = acc[ai][0][m][0] + b_i, v1 = acc[ai][0][m][1] + b_f;
                    f32x4 lf; lf[0] = logsigmoidf_(v1[0]); lf[1] = logsigmoidf_(v1[1]); lf[2] = logsigmoidf_(v1[2]); lf[3] = logsigmoidf_(v1[3]);
                    *(f32x4*)(LI + row * 4) = v0; *(f32x4*)(LF + row * 4) = lf; }
        }
        return false;
    }
};
__device__ __forceinline__ void phase_zgemm2(ArgsRef a, int l, int tid, int bid, int G) {
    SchedZ S{G, bid, a.ws}; EpiZ E{(bf16_t*)(a.ws + OFF_Z), (float*)(a.ws + OFF_LI), (float*)(a.ws + OFF_LF), a.in[7] + l * 4, a.in[8] + l * 4};
    pg8::gemm_phase((PG8_LAS unsigned char*)smem, tid, 1024, 1024, 1024, S, E);
}
__device__ __forceinline__ void phase_glu_gates(ArgsRef a, int tid, int bid, int G) {
    { SchedGrid S{T / 256, 2, G, bid, (const char*)(a.ws + OFF_YPRE), (const char*)(a.ws + OFF_WGLU), (size_t)256 * 512 * 2, (size_t)256 * 512 * 2};
      EpiBf16<2> E{(bf16_t*)(a.ws + OFF_YSG), 512, (const bf16_t*)(a.ws + OFF_YPRE), 512};
      pg8::gemm_phase((PG8_LAS unsigned char*)smem, tid, 512, 512, 512, S, E); }
    asm volatile("" : "+v"(tid), "+s"(bid), "+s"(G));
    { SchedGrid S{T / 256, 12, G, (bid + G / 2) % G, (const char*)(a.ws + OFF_XB), (const char*)(a.ws + OFF_WIN + (size_t)NZ * 1024 * 2), (size_t)256 * 1024 * 2, (size_t)256 * 1024 * 2};
      EpiBf16<1> E{(bf16_t*)(a.ws + OFF_Z), GATES_LD, nullptr, 0};
      pg8::gemm_phase((PG8_LAS unsigned char*)smem, tid, 1024, 1024, 1024, S, E); }
}
struct SchedMerge {
    int G, c; const unsigned char* ws;
    __device__ __forceinline__ bool next(int i, pg8::Unit& u) const { const int b = i % 3; int pm, pn; if (!pg8::tile_order((i / 3) * G + c, T / 256, 4, pm, pn)) return false;
        u.pm = pm; u.pn = pn; u.tag = b; u.A = (const char*)(ws + (b == 0 ? OFF_OM : b == 1 ? OFF_YSG : OFF_OH)) + (size_t)pm * 256 * 512 * 2;
        u.B = (const char*)(ws + OFF_WB) + ((size_t)b * 1024 + pn * 256) * 512 * 2; return true; }
};
struct EpiMerge {
    static constexpr bool PERM = true;
    const bf16_t* GT; bf16_t* O;
    __device__ __forceinline__ bool operator()(f32x4 (&acc)[2][2][4][2], const pg8::Unit& u, int wr, int wc, int fr, int fq) const {
        const int b = u.tag;
#pragma unroll
        for (int ai = 0; ai < 2; ++ai)
#pragma unroll
            for (int m = 0; m < 4; ++m) { const size_t row = (size_t)u.pm * 256 + ai * 128 + wr * 64 + m * 16 + fr;
#pragma unroll
                for (int bj = 0; bj < 2; ++bj) { const int col = u.pn * 256 + bj * 128 + wc * 32 + 8 * fq;
                    const bf16x8 gb = *(const bf16x8*)(GT + row * GATES_LD + b * 1024 + col);
                    if (b < 2) { const bf16x8 gn = *(const bf16x8*)(GT + row * GATES_LD + (b + 1) * 1024 + col);
#pragma unroll
                        for (int j = 0; j < 4; ++j) { acc[ai][bj][m][0][j] *= bf2f((bf16_t)gb[j]) / bf2f((bf16_t)gn[j]); acc[ai][bj][m][1][j] *= bf2f((bf16_t)gb[4 + j]) / bf2f((bf16_t)gn[4 + j]); } }
                    else { f32x4 v0 = acc[ai][bj][m][0], v1 = acc[ai][bj][m][1];
#pragma unroll
                        for (int j = 0; j < 4; ++j) { v0[j] *= bf2f((bf16_t)gb[j]); v1[j] *= bf2f((bf16_t)gb[4 + j]); }
                        u32x4 w; w.x = pg8::cvt_pk_bf16(v0[0], v0[1]); w.y = pg8::cvt_pk_bf16(v0[2], v0[3]); w.z = pg8::cvt_pk_bf16(v1[0], v1[1]); w.w = pg8::cvt_pk_bf16(v1[2], v1[3]);
                        *(u32x4*)(O + row * 1024 + col) = w; } } }
        return b < 2;
    }
};
__device__ __forceinline__ void phase_merge2(ArgsRef a, int tid, int bid, int G) {
    SchedMerge S{G, bid, a.ws}; EpiMerge E{(const bf16_t*)(a.ws + OFF_Z), (bf16_t*)(a.ws + OFF_XB)};
    pg8::gemm_phase((PG8_LAS unsigned char*)smem, tid, 512, 512, 512, S, E);
}
struct EpiResid {
    static constexpr bool PERM = false;
    const float* xin; float* XF;
    __device__ __forceinline__ bool operator()(f32x4 (&acc)[2][2][4][2], const pg8::Unit& u, int wr, int wc, int fr, int fq) const {
#pragma unroll
        for (int ai = 0; ai < 2; ++ai)
#pragma unroll
            for (int m = 0; m < 4; ++m) { const size_t row = (size_t)u.pm * 256 + ai * 128 + wr * 64 + m * 16 + fr;
#pragma unroll
                for (int bj = 0; bj < 2; ++bj)
#pragma unroll
                    for (int n = 0; n < 2; ++n) { const size_t o = row * 1024 + u.pn * 256 + bj * 128 + wc * 32 + 16 * n + 4 * fq; const f32x4 x = *(const f32x4*)(xin + o); *(f32x4*)(XF + o) = DN_ALPHA * x + acc[ai][bj][m][n]; } }
        return false;
    }
};
__device__ __forceinline__ void phase_wout2(ArgsRef a, int l, int tid, int bid, int G) {
    SchedGrid S{T / 256, 4, G, bid, (const char*)(a.ws + OFF_XB), (const char*)(a.ws + OFF_WOUT), (size_t)256 * 1024 * 2, (size_t)256 * 1024 * 2};
    EpiResid E{(l == 0) ? a.in[0] : a.out, a.out};
    pg8::gemm_phase((PG8_LAS unsigned char*)smem, tid, 1024, 1024, 1024, S, E);
}
struct EpiQKV {
    static constexpr bool PERM = true;
    int vcall; bf16_t* Q; bf16_t* KH; bf16_t* V; const float* LI;
    __device__ __forceinline__ bool operator()(f32x4 (&acc)[2][2][4][2], const pg8::Unit& u, int wr, int wc, int fr, int fq) const {
        const int which = vcall ? 2 : (u.pn >> 1); bf16_t* O = which == 0 ? Q : which == 1 ? KH : V;
#pragma unroll
        for (int ai = 0; ai < 2; ++ai)
#pragma unroll
            for (int m = 0; m < 4; ++m) { const size_t row = (size_t)u.pm * 256 + ai * 128 + wr * 64 + m * 16 + fr;
#pragma unroll
                for (int bj = 0; bj < 2; ++bj) { const int hd = (u.pn & 1) * 2 + bj, col = hd * 128 + wc * 32 + 8 * fq;
                    const float sc = which == 0 ? 0.08838834764831845f : which == 1 ? fexp(LI[row * 4 + hd]) : 1.0f;
                    const f32x4 v0 = acc[ai][bj][m][0] * sc, v1 = acc[ai][bj][m][1] * sc;
                    u32x4 w; w.x = pg8::cvt_pk_bf16(v0[0], v0[1]); w.y = pg8::cvt_pk_bf16(v0[2], v0[3]); w.z = pg8::cvt_pk_bf16(v1[0], v1[1]); w.w = pg8::cvt_pk_bf16(v1[2], v1[3]);
                    *(u32x4*)(O + row * 512 + col) = w; } }
        return false;
    }
};
__device__ __forceinline__ void phase_mqkv2(ArgsRef a, int tid, int bid, int G) {
    { SchedGrid S{T / 256, 4, G, bid, (const char*)(a.ws + OFF_XC), (const char*)(a.ws + OFF_WQKV), (size_t)256 * 512 * 2, (size_t)256 * 512 * 2};
      EpiQKV E{0, (bf16_t*)(a.ws + OFF_Q), (bf16_t*)(a.ws + OFF_KH), (bf16_t*)(a.ws + OFF_V), (const float*)(a.ws + OFF_LI)};
      pg8::gemm_phase((PG8_LAS unsigned char*)smem, tid, 512, 512, 512, S, E); }
    asm volatile("" : "+v"(tid), "+s"(bid), "+s"(G));
    { SchedGrid S{T / 256, 2, G, (bid + G / 2) % G, (const char*)(a.ws + OFF_Z), (const char*)(a.ws + OFF_WQKV + (size_t)1024 * 512 * 2), (size_t)256 * NZ * 2, (size_t)256 * 512 * 2};
      EpiQKV E{1, (bf16_t*)(a.ws + OFF_Q), (bf16_t*)(a.ws + OFF_KH), (bf16_t*)(a.ws + OFF_V), (const float*)(a.ws + OFF_LI)};
      pg8::gemm_phase((PG8_LAS unsigned char*)smem, tid, 512, NZ, 512, S, E); }
}
struct SchedMoE {
    int down, G, c; const unsigned char* ws; const unsigned* BASE;
    __device__ __forceinline__ bool next(int i, pg8::Unit& u) const { const int per = down ? 4 : 2, L = i * G + c, ntile = (int)(BASE[32] >> 8); if (L >= ntile * per) return false;
        const int tile = L / per, sub = L % per; int e = 0; while (e < 31 && BASE[e + 1] <= (unsigned)(tile * 256)) ++e;
        u.pm = tile; u.pn = sub; u.tag = e;
        if (!down) { u.A = (const char*)(ws + OFF_XG) + (size_t)tile * 256 * 1024 * 2; u.B = (const char*)(ws + OFF_WGU) + ((size_t)e * 512 + sub * 256) * 1024 * 2; }
        else { u.A = (const char*)(ws + OFF_H) + (size_t)tile * 256 * 256 * 2; u.B = (const char*)(ws + OFF_WD) + ((size_t)e * 1024 + sub * 256) * 256 * 2; }
        return true; }
};
struct EpiH {
    static constexpr bool PERM = true;
    bf16_t* H;
    __device__ __forceinline__ bool operator()(f32x4 (&acc)[2][2][4][2], const pg8::Unit& u, int wr, int wc, int fr, int fq) const {
#pragma unroll
        for (int ai = 0; ai < 2; ++ai)
#pragma unroll
            for (int m = 0; m < 4; ++m) { const size_t row = (size_t)u.pm * 256 + ai * 128 + wr * 64 + m * 16 + fr; f32x4 v0, v1;
#pragma unroll
                for (int j = 0; j < 4; ++j) { v0[j] = siluf_(acc[ai][0][m][0][j]) * acc[ai][1][m][0][j]; v1[j] = siluf_(acc[ai][0][m][1][j]) * acc[ai][1][m][1][j]; }
                u32x4 w; w.x = pg8::cvt_pk_bf16(v0[0], v0[1]); w.y = pg8::cvt_pk_bf16(v0[2], v0[3]); w.z = pg8::cvt_pk_bf16(v1[0], v1[1]); w.w = pg8::cvt_pk_bf16(v1[2], v1[3]);
                *(u32x4*)(H + row * 256 + u.pn * 128 + wc * 32 + 8 * fq) = w; }
        return false;
    }
};
__device__ __forceinline__ void phase_moe_gu2(ArgsRef a, int tid, int bid, int G) {
    SchedMoE S{0, G, bid, a.ws, (const unsigned*)(a.ws + OFF_CTL) + 64}; EpiH E{(bf16_t*)(a.ws + OFF_H)};
    pg8::gemm_phase((PG8_LAS unsigned char*)smem, tid, 1024, 1024, 1024, S, E);
}
__device__ __forceinline__ void phase_moe_dn2(ArgsRef a, int tid, int bid, int G) {
    SchedMoE S{1, G, bid, a.ws, (const unsigned*)(a.ws + OFF_CTL) + 64}; EpiBf16<0> E{(bf16_t*)(a.ws + OFF_YS), 1024, nullptr, 0};
    pg8::gemm_phase((PG8_LAS unsigned char*)smem, tid, 256, 256, 256, S, E);
}
__device__ __forceinline__ void phase_mprep2(ArgsRef a, int l, int tid, int lane, int wave, int bid, int G) {
    const bf16_t* Z = (const bf16_t*)(a.ws + OFF_Z); bf16_t* XC = (bf16_t*)(a.ws + OFF_XC);
    const float* cw = a.in[2] + (size_t)l * 4 * 512; const float* cb = a.in[3] + (size_t)l * 512;
    for (int idx = bid * 512 + tid; idx < (T / 8) * 64; idx += G * 512) {
        const int tb = (idx / 64) * 8, c0 = (idx % 64) * 8;
        bf16x8 xr[11];
#pragma unroll
        for (int k = 0; k < 11; ++k) { const int ts = tb - 3 + k; xr[k] = (ts >= 0) ? *(const bf16x8*)(Z + (size_t)ts * NZ + c0) : (bf16x8){0, 0, 0, 0, 0, 0, 0, 0}; }
        float w[4][8], b[8];
#pragma unroll
        for (int j = 0; j < 8; ++j) { b[j] = cb[c0 + j];
#pragma unroll
            for (int k = 0; k < 4; ++k) w[k][j] = cw[k * 512 + c0 + j]; }
#pragma unroll
        for (int tt = 0; tt < 8; ++tt) { float acc[8];
#pragma unroll
            for (int j = 0; j < 8; ++j) { acc[j] = b[j];
#pragma unroll
                for (int k = 0; k < 4; ++k) acc[j] += w[k][j] * bf2f((bf16_t)xr[tt + k][j]); }
            u32x4 o; o.x = pack2(siluf_(acc[0]), siluf_(acc[1])); o.y = pack2(siluf_(acc[2]), siluf_(acc[3])); o.z = pack2(siluf_(acc[4]), siluf_(acc[5])); o.w = pack2(siluf_(acc[6]), siluf_(acc[7]));
            *(u32x4*)(XC + (size_t)(tb + tt) * 512 + c0) = o; }
    }
}

#define XB_TMO      128
#define XB_XCNT(j)  (256  + 64 * (j))
#define XB_XSUB(j)  (1280 + 64 * (j))
#define XB_XGEN(j)  (2304 + 64 * (j))
#define XB_TOP      3328
#define XB_TOPGEN   3392
#define XCD_BAR_WORDS 3456
#define XB_SPIN_CAP (1u << 22)
__device__ __forceinline__ unsigned xb_ld(unsigned* p)              { return __hip_atomic_load(p, __ATOMIC_RELAXED, __HIP_MEMORY_SCOPE_AGENT); }
__device__ __forceinline__ unsigned xb_add(unsigned* p, unsigned v) { return __hip_atomic_fetch_add(p, v, __ATOMIC_RELAXED, __HIP_MEMORY_SCOPE_AGENT); }
__device__ __forceinline__ unsigned xb_xcc_id() { return (unsigned)__builtin_amdgcn_s_getreg((3 << 11) | 20) & 0xFu; }
#define XB_SPIN(cond, bar) do { unsigned _sp = 0; while (cond) { __builtin_amdgcn_s_sleep(1); \
    if ((++_sp & 255u) == 0u) { if (xb_ld(&(bar)[XB_TMO])) break; if (_sp > XB_SPIN_CAP) { atomicAdd(&(bar)[XB_TMO], 1u); break; } } } } while (0)
__device__ __forceinline__ void xcd_barrier_complete(unsigned* bar, unsigned x, unsigned& nloc, unsigned& nx) {
    const unsigned G = gridDim.x; unsigned sum, cnt, mine, sp = 0u;
    for (;;) { sum = 0u; cnt = 0u; mine = 0u;
#pragma unroll
        for (unsigned j = 0; j < 16; ++j) { const unsigned c = xb_ld(&bar[XB_XCNT(j)]); sum += c; cnt += (c > 0u) ? 1u : 0u; mine = (j == x) ? c : mine; }
        if (sum == G) break;
        __builtin_amdgcn_s_sleep(1);
        if ((++sp & 255u) == 0u) { if (xb_ld(&bar[XB_TMO])) break; if (sp > XB_SPIN_CAP) { atomicAdd(&bar[XB_TMO], 1u); break; } } }
    nloc = mine > 0u ? mine : 1u; nx = cnt > 0u ? cnt : 1u;
}
__device__ __forceinline__ void xcd_barrier(unsigned* bar, volatile __attribute__((address_space(3))) unsigned* st) {
    asm volatile("s_waitcnt vmcnt(0)" ::: "memory");
    __syncthreads();
    if (threadIdx.x == 0) {
        __builtin_amdgcn_s_waitcnt(0);
        const unsigned x = xb_xcc_id();
        unsigned nloc = st[0], nx = st[1];
        if (nloc == 0u) { xcd_barrier_complete(bar, x, nloc, nx); st[0] = nloc; st[1] = nx; }
        const unsigned old = xb_add(&bar[XB_XSUB(x)], 1u);
        const unsigned gen = old / nloc;
        if (old + 1u == (gen + 1u) * nloc) {
            __builtin_amdgcn_fence(__ATOMIC_RELEASE, "agent");
            asm volatile("s_waitcnt vmcnt(0)" ::: "memory");
            const unsigned og = xb_add(&bar[XB_TOP], 1u);
            const unsigned tg = og / nx;
            if (og + 1u == (tg + 1u) * nx) xb_add(&bar[XB_TOPGEN], 1u);
            else XB_SPIN(xb_ld(&bar[XB_TOPGEN]) == tg, bar);
            __builtin_amdgcn_fence(__ATOMIC_ACQUIRE, "agent");
            xb_add(&bar[XB_XGEN(x)], 1u);
            asm volatile("s_waitcnt vmcnt(0)" ::: "memory");
        } else {
            XB_SPIN(xb_ld(&bar[XB_XGEN(x)]) == gen, bar);
            __builtin_amdgcn_fence(__ATOMIC_ACQUIRE, "agent");
            asm volatile("s_waitcnt vmcnt(0)" ::: "memory");
        }
    }
    __syncthreads();
}

__device__ __forceinline__ ArgsRef fresh_args() { unsigned long long p = (unsigned long long)__builtin_amdgcn_kernarg_segment_ptr(); asm volatile("" : "+s"(p)); return *(const __attribute__((address_space(4))) Args*)p; }
__global__ void __launch_bounds__(512) fwd(Args a_unused) {
    cg::grid_group grid = cg::this_grid();
    volatile __attribute__((address_space(3))) unsigned* bst = (volatile __attribute__((address_space(3))) unsigned*)((__attribute__((address_space(3))) unsigned char*)smem + 131072);
    if (threadIdx.x < 4) bst[threadIdx.x] = 0u;
    __syncthreads();
    { ArgsRef a0 = fresh_args(); if (threadIdx.x == 0) (void)xb_add(&((unsigned*)(a0.ws + OFF_BAR))[XB_XCNT(xb_xcc_id())], 1u); }
#define GSYNC() do { asm volatile("" ::: "memory"); { ArgsRef ab = fresh_args(); xcd_barrier((unsigned*)(ab.ws + OFF_BAR), bst); } asm volatile("" ::: "memory"); } while (0)
#define GSYNC_CG() do { asm volatile("" ::: "memory"); grid.sync(); asm volatile("" ::: "memory"); } while (0)
    const int wave_s = __builtin_amdgcn_readfirstlane((int)threadIdx.x >> 6);
#define PH(body) do { int wave = wave_s; asm volatile("" : "+s"(wave)); int lane; asm volatile("v_mbcnt_lo_u32_b32 %0, -1, 0\n\tv_mbcnt_hi_u32_b32 %0, -1, %0" : "=v"(lane)); \
        int bid = blockIdx.x, G = gridDim.x; asm volatile("" : "+s"(bid), "+s"(G)); \
        const int tid = wave * 64 + lane, gw = bid * 8 + wave, GW = G * 8; (void)tid; (void)gw; (void)GW; ArgsRef a = fresh_args(); body; } while (0)
#pragma unroll 1
    for (int l = 0; l < NLAYER; ++l) {
        PH(phase_prep(a, l, tid, bid, G)); if (l == 0) GSYNC_CG(); else GSYNC();
        PH(phase_zgemm2(a, l, tid, bid, G)); GSYNC();
        PH(phase_mprep2(a, l, tid, lane, wave, bid, G)); GSYNC();
        PH(phase_mqkv2(a, tid, bid, G)); GSYNC();
        PH(phase_mixers<1>(a, l, tid, lane, wave, bid, G)); GSYNC();
        PH(phase_scan(a, tid, bid, G)); GSYNC();
        PH(phase_mixers<2>(a, l, tid, lane, wave, bid, G)); GSYNC();
        PH(phase_post(a, l, lane, gw, GW)); GSYNC();
        PH(phase_glu_gates(a, tid, bid, G)); PH(phase_prepx(a, l, tid, bid, G)); GSYNC();
        PH(phase_merge2(a, tid, bid, G)); GSYNC();
        PH(phase_wout2(a, l, tid, bid, G)); GSYNC();
        PH(phase_ln1r(a, l, tid, lane, wave, bid, G)); GSYNC();
        PH(phase_slot(a, tid, lane, wave, bid, G)); GSYNC();
        PH(phase_moe_gu2(a, tid, bid, G)); GSYNC();
        PH(phase_moe_dn2(a, tid, bid, G)); GSYNC();
        PH(phase_ln2(a, l, lane, gw, GW)); if (l + 1 < NLAYER) GSYNC();
    }
}

extern "C" void kernel_launch(void* const* d_in, const int* in_sizes, int n_in, void* d_out, int out_size, void* d_ws, size_t ws_size, hipStream_t stream) {
    static int grid = 0;
    if (grid == 0) {
        if (n_in != 34 || out_size != T * D || ws_size < WS_TOTAL) { fprintf(stderr, "kernel_launch: unexpected shapes (n_in %d, out %d, ws %zu, need %zu)\n", n_in, out_size, ws_size, (size_t)WS_TOTAL); grid = -1; return; }
        int dev = 0, cus = 0, per_cu = 0;
        (void)hipGetDevice(&dev); (void)hipDeviceGetAttribute(&cus, hipDeviceAttributeMultiprocessorCount, dev);
        (void)hipFuncSetAttribute((const void*)fwd, hipFuncAttributeMaxDynamicSharedMemorySize, LDS_BYTES);
        (void)hipOccupancyMaxActiveBlocksPerMultiprocessor(&per_cu, (const void*)fwd, 512, LDS_BYTES);
        if (per_cu < 1) { fprintf(stderr, "kernel_launch: occupancy query says %d blocks per CU\n", per_cu); per_cu = 1; }
        grid = (cus > 0 ? cus : 256) * 1;
        (void)hipGetLastError();
    }
    if (grid < 0) return;
    Args a{};
    for (int i = 0; i < 34; ++i) a.in[i] = (const float*)d_in[i];
    a.out = (float*)d_out; a.ws = (unsigned char*)d_ws; a.ph_lo = 0; a.ph_hi = NLAYER * NPH;
    (void)hipMemsetAsync((unsigned char*)d_ws + OFF_BAR, 0, 16384, stream);
    void* args[] = {&a};
    hipError_t e = hipLaunchCooperativeKernel((const void*)fwd, dim3(grid), dim3(512), args, LDS_BYTES, stream);
    if (e != hipSuccess) fprintf(stderr, "kernel_launch: cooperative launch failed: %s (grid %d)\n", hipGetErrorString(e), grid);
}
```

```cpp
#include <hip/hip_runtime.h>
#include <hip/hip_cooperative_groups.h>
#include <cstdio>
#include <cstdint>
namespace cg = cooperative_groups;

typedef unsigned short bf16_t;
typedef short bf16x8 __attribute__((ext_vector_type(8)));
typedef short bf16x4 __attribute__((ext_vector_type(4)));
typedef float f32x4 __attribute__((ext_vector_type(4)));
typedef unsigned u32x4 __attribute__((ext_vector_type(4)));
typedef unsigned u32x2 __attribute__((ext_vector_type(2)));

constexpr int T = 16384, D = 1024, NZ = 3584, NWIN = 6912, INW = 6664;
constexpr int NPH = 15, NLAYER = 2;
constexpr int GSEG = 32, GSEGLEN = 512;
constexpr int SSEG = 64, SSEGLEN = 256;
constexpr int SLOTS = 40960;
constexpr float DN_ALPHA = 1.41421356237f;
constexpr int LDS_BYTES = 131072 + 256;

constexpr size_t AL(size_t x) { return (x + 255) & ~(size_t)255; }
constexpr size_t OFF_WIN = 0;
constexpr size_t OFF_WQKV = OFF_WIN + AL((size_t)NWIN * 1024 * 2);
constexpr size_t OFF_WGLU = OFF_WQKV + AL((size_t)1536 * 512 * 2);
constexpr size_t OFF_WB = OFF_WGLU + AL((size_t)512 * 512 * 2);
constexpr size_t OFF_WOUT = OFF_WB + AL((size_t)3 * 1024 * 512 * 2);
constexpr size_t OFF_ABAR = OFF_WOUT + AL((size_t)1024 * 1024 * 2);
constexpr size_t OFF_BBT = OFF_ABAR + AL((size_t)32 * 64 * 2 * 4);
constexpr size_t OFF_CCT = OFF_BBT + AL((size_t)32 * 128 * 16 * 2);
constexpr size_t OFF_CTL = OFF_CCT + AL((size_t)32 * 16 * 128 * 2);
constexpr size_t OFF_TOKE = OFF_CTL + 4096;
constexpr size_t OFF_TOKG = OFF_TOKE + AL((size_t)T * 2 * 4);
constexpr size_t OFF_TOKS = OFF_TOKG + AL((size_t)T * 2 * 4);
constexpr size_t OFF_SLOTT = OFF_TOKS + AL((size_t)T * 2 * 4);
constexpr size_t OFF_XB = OFF_SLOTT + AL((size_t)SLOTS * 4);
constexpr size_t OFF_R1 = OFF_XB + AL((size_t)T * 1024 * 2);
constexpr size_t SZ_ACT = (size_t)T * 512 * 2;
constexpr size_t OFF_XC = OFF_R1, OFF_Q = OFF_R1 + SZ_ACT, OFF_KH = OFF_R1 + 2 * SZ_ACT, OFF_V = OFF_R1 + 3 * SZ_ACT;
constexpr size_t OFF_WGU = OFF_R1, OFF_WD = OFF_R1 + (size_t)32 * 512 * 1024 * 2;
constexpr size_t OFF_Z = OFF_R1 + 4 * SZ_ACT;
constexpr size_t OFF_XG = OFF_Z, OFF_H = OFF_Z + (size_t)SLOTS * 1024 * 2;
constexpr size_t OFF_ZS = OFF_Z + AL((size_t)T * NZ * 2);
constexpr size_t OFF_LF = OFF_ZS + AL((size_t)T * 8 * 4);
constexpr size_t OFF_LI = OFF_LF + AL((size_t)T * 4 * 4);
constexpr size_t OFF_E = OFF_LI + AL((size_t)T * 4 * 4);
constexpr size_t OFF_OM = OFF_E, OFF_OH = OFF_E + SZ_ACT, OFF_YPRE = OFF_E + 2 * SZ_ACT, OFF_YSG = OFF_E + 3 * SZ_ACT;
constexpr size_t OFF_DEN = OFF_E + 4 * SZ_ACT;
constexpr size_t OFF_EM = OFF_DEN + AL((size_t)T * 4 * 4);
constexpr size_t OFF_EMX = OFF_EM + AL((size_t)GSEG * 4 * 128 * 128 * 4);
constexpr size_t OFF_GM = OFF_EMX + AL((size_t)GSEG * 4 * 128 * 16 * 4);
constexpr size_t OFF_EH = OFF_GM + AL((size_t)GSEG * 4 * 128 * 4);
constexpr size_t OFF_GH = OFF_EH + AL((size_t)GSEG * 4 * 128 * 128 * 4);
constexpr size_t OFF_ES = OFF_GH + AL((size_t)GSEG * 4 * 128 * 4);
constexpr size_t WS_END = OFF_ES + AL((size_t)SSEG * 32 * 64 * 2 * 4);
constexpr size_t OFF_YS = OFF_E;
constexpr size_t OFF_RWT = WS_END;
constexpr size_t OFF_HIST = OFF_RWT + 32 * 1024 * 4;
constexpr size_t OFF_BAR = OFF_HIST + 1024 * 32 * 4;
constexpr size_t WS_TOTAL = OFF_BAR + 16384;
static_assert(OFF_YS + (size_t)SLOTS * 1024 * 2 <= WS_END, "YS must fit in the dead region");
static_assert(OFF_H + (size_t)SLOTS * 256 * 2 <= OFF_ZS, "H must fit in the dead Z region");
static_assert(OFF_WD + (size_t)32 * 1024 * 256 * 2 <= OFF_Z, "expert weights must fit in R1");

struct Args { const float* in[34]; float* out; unsigned char* ws; int ph_lo, ph_hi; };
typedef const __attribute__((address_space(4))) Args& ArgsRef;

extern __shared__ __attribute__((aligned(16))) unsigned char smem[];

__device__ __forceinline__ bf16_t f2bf(float f) { unsigned u = __float_as_uint(f); u += 0x7FFFu + ((u >> 16) & 1u); return (bf16_t)(u >> 16); }
__device__ __forceinline__ float bf2f(bf16_t b) { return __uint_as_float(((unsigned)b) << 16); }
__device__ __forceinline__ unsigned pack2(float lo, float hi) { return (unsigned)f2bf(lo) | ((unsigned)f2bf(hi) << 16); }
__device__ __forceinline__ float fexp(float x) { return __builtin_amdgcn_exp2f(x * 1.4426950408889634f); }
__device__ __forceinline__ float flog(float x) { return __builtin_amdgcn_logf(x) * 0.6931471805599453f; }
__device__ __forceinline__ float sigmoidf_(float x) { return __builtin_amdgcn_rcpf(1.0f + fexp(-x)); }
__device__ __forceinline__ float siluf_(float x) { return x * __builtin_amdgcn_rcpf(1.0f + fexp(-x)); }
__device__ __forceinline__ float logsigmoidf_(float x) { return fminf(x, 0.f) - log1pf(expf(-fabsf(x))); }
__device__ __forceinline__ float gelu_tanh(float y) { const float z = 0.7978845608028654f * (y + 0.044715f * y * y * y); const float th = 1.0f - 2.0f * __builtin_amdgcn_rcpf(fexp(2.0f * z) + 1.0f); return 0.5f * y * (1.0f + th); }
__device__ __forceinline__ void wave_sync() { __builtin_amdgcn_wave_barrier(); asm volatile("s_waitcnt lgkmcnt(0)" ::: "memory"); __builtin_amdgcn_wave_barrier(); }

#define MFMA16(a, b, c) __builtin_amdgcn_mfma_f32_16x16x32_bf16((a), (b), (c), 0, 0, 0)

template <int MT, int NT, class FA, class FB>
__device__ __forceinline__ void wave_gemm(f32x4 (&acc)[MT][NT], int K, FA arow, FB brow, int lane) {
    const int r = lane & 15, q = lane >> 4;
    const bf16_t* ap[MT]; const bf16_t* bp[NT];
#pragma unroll
    for (int m = 0; m < MT; ++m) ap[m] = arow(m * 16 + r) + 8 * q;
#pragma unroll
    for (int n = 0; n < NT; ++n) bp[n] = brow(n * 16 + r) + 8 * q;
#pragma unroll 1
    for (int k = 0; k < K; k += 32) {
        bf16x8 a[MT], b[NT];
#pragma unroll
        for (int m = 0; m < MT; ++m) a[m] = *(const bf16x8*)(ap[m] + k);
#pragma unroll
        for (int n = 0; n < NT; ++n) b[n] = *(const bf16x8*)(bp[n] + k);
#pragma unroll
        for (int m = 0; m < MT; ++m)
#pragma unroll
            for (int n = 0; n < NT; ++n) acc[m][n] = MFMA16(a[m], b[n], acc[m][n]);
    }
}
template <int MT, int NT> __device__ __forceinline__ void zero_acc(f32x4 (&acc)[MT][NT]) {
#pragma unroll
    for (int m = 0; m < MT; ++m)
#pragma unroll
        for (int n = 0; n < NT; ++n) acc[m][n] = (f32x4){0.f, 0.f, 0.f, 0.f};
}

namespace pg8 {
#define PG8_LAS __attribute__((address_space(3)))
constexpr int BM = 256, BK = 64, HALF = 128, HTB = HALF * BK * 2, STAGE_BYTES = 8 * HTB;
__device__ __forceinline__ int lds_byte(int r, int c) { const int st = (r >> 4) * 2 + (c >> 5), rr = r & 15, cc = c & 31, ob = rr * 64 + cc * 2; return st * 1024 + (ob ^ (((ob >> 9) & 1) << 5)); }
__device__ __forceinline__ void stage_rc(int b, int& R, int& C) { const int st = b / 1024, sb = b % 1024, swz = sb ^ (((sb >> 9) & 1) << 5); R = (st >> 1) * 16 + swz / 64; C = (st & 1) * 32 + (swz % 64) / 2; }
__device__ __forceinline__ int perm32(int rho) { const int n = rho >> 4, i = rho & 15; return 8 * (i >> 2) + 4 * n + (i & 3); }
struct Unit { int pm, pn, tag; const char* A; const char* B; };
__device__ __forceinline__ unsigned cvt_pk_bf16(float lo, float hi) { unsigned r; asm volatile("v_cvt_pk_bf16_f32 %0, %1, %2" : "=v"(r) : "v"(lo), "v"(hi)); return r; }
__device__ __forceinline__ bool tile_order(int L, int nM, int nN, int& pm, int& pn) {
    const int nwg = nM * nN; if (L >= nwg) return false;
    int wgid = L; { const int q = nwg / 8, r = nwg % 8, xcd = wgid % 8, off = wgid / 8; wgid = (xcd < r ? xcd * (q + 1) : r * (q + 1) + (xcd - r) * q) + off; }
    const int nig = 8 * nN, gid = wgid / nig, fm = gid * 8, gsz = (nM - fm) < 8 ? (nM - fm) : 8;
    pm = fm + ((wgid % nig) % gsz); pn = (wgid % nig) / gsz; return true;
}
template <class Epi, class Sched>
__device__ __forceinline__ void gemm_phase(PG8_LAS unsigned char* lds, const int tid, const int K, const int lda, const int ldb, const Sched& S, const Epi& E) {
    const int wid = __builtin_amdgcn_readfirstlane(tid >> 6), lane = tid & 63, wr = wid >> 2, wc = wid & 3, fr = lane & 15, fq = lane >> 4;
    const int nt = K / BK;
    unsigned voffA[2], voffB[2];
#pragma unroll
    for (int i = 0; i < 2; ++i) { int R, C; stage_rc(tid * 16 + i * 8192, R, C); const int Rb = Epi::PERM ? ((R & ~31) + perm32(R & 31)) : R;
        voffA[i] = (unsigned)(R * lda + C) * 2u; voffB[i] = (unsigned)(Rb * ldb + C) * 2u; }
    const size_t kstep = (size_t)(BK * 2), hstepA = (size_t)HALF * lda * 2, hstepB = (size_t)HALF * ldb * 2;
    const unsigned ldsw = (unsigned)wid * 1024u;
    const int aoff = lds_byte(wr * 64 + fr, fq * 8), boff = lds_byte(wc * 32 + fr, fq * 8);
#define PG8_SA(b, h) (((b) * 2 + (h)) * HTB)
#define PG8_SB(b, h) ((4 + (b) * 2 + (h)) * HTB)
#define PG8_STAGE(bufoff, gbase, voff) do { _Pragma("unroll") for (int _i = 0; _i < 2; ++_i) \
        __builtin_amdgcn_global_load_lds((const unsigned*)((const char*)(gbase) + (voff)[_i]), (PG8_LAS unsigned*)(lds + (bufoff) + ldsw + _i * 8192), 16, 0, 0); } while (0)
#define PG8_LDA(dst, b, h) do { _Pragma("unroll") for (int m = 0; m < 4; ++m) _Pragma("unroll") for (int k = 0; k < 2; ++k) dst[m][k] = *(const PG8_LAS bf16x8*)(lds + PG8_SA(b, h) + aoff + m * 2048 + k * 1024); } while (0)
#define PG8_LDB(dst, b, h) do { _Pragma("unroll") for (int n = 0; n < 2; ++n) _Pragma("unroll") for (int k = 0; k < 2; ++k) dst[n][k] = *(const PG8_LAS bf16x8*)(lds + PG8_SB(b, h) + boff + n * 2048 + k * 1024); } while (0)
#define PG8_MMA(ai, bj, At, Bt) do { __builtin_amdgcn_s_setprio(1); _Pragma("unroll") for (int m = 0; m < 4; ++m) _Pragma("unroll") for (int n = 0; n < 2; ++n) _Pragma("unroll") for (int k = 0; k < 2; ++k) \
        acc[ai][bj][m][n] = __builtin_amdgcn_mfma_f32_16x16x32_bf16(Bt[n][k], At[m][k], acc[ai][bj][m][n], 0, 0, 0); __builtin_amdgcn_s_setprio(0); } while (0)
#define PG8_WAIT_V(n) asm volatile("s_waitcnt vmcnt(" #n ")" ::: "memory")
#define PG8_WAIT_L(n) asm volatile("s_waitcnt lgkmcnt(" #n ")" ::: "memory")
#define PG8_BAR __builtin_amdgcn_s_barrier()
#define PG8_SCHED __builtin_amdgcn_sched_barrier(0)
    Unit cur, nxt; int ui = 0;
    if (!S.next(0, cur)) return;
    f32x4 acc[2][2][4][2];
#pragma unroll
    for (int a = 0; a < 2; ++a)
#pragma unroll
        for (int b = 0; b < 2; ++b)
#pragma unroll
            for (int m = 0; m < 4; ++m)
#pragma unroll
                for (int n = 0; n < 2; ++n) acc[a][b][m][n] = (f32x4){0.f, 0.f, 0.f, 0.f};
    bf16x8 At[4][2], B0[2][2], B1[2][2];
    const char* cA = cur.A; const char* cB = cur.B;
    PG8_STAGE(PG8_SB(0, 0), cB, voffB); PG8_STAGE(PG8_SA(0, 0), cA, voffA); PG8_STAGE(PG8_SB(0, 1), cB + hstepB, voffB); PG8_STAGE(PG8_SA(0, 1), cA + hstepA, voffA);
    if (wr == 1) PG8_BAR;
    PG8_WAIT_V(4); PG8_BAR;
    PG8_STAGE(PG8_SB(1, 0), cB + kstep, voffB); PG8_STAGE(PG8_SA(1, 0), cA + kstep, voffA); PG8_STAGE(PG8_SB(1, 1), cB + hstepB + kstep, voffB);
    PG8_WAIT_V(6); PG8_BAR;
    for (;;) {
        const bool has_next = S.next(ui + 1, nxt);
        const char* nA = has_next ? nxt.A : cA; const char* nB = has_next ? nxt.B : cB;
        for (int t = 0; t < nt; t += 2) {
            const bool last = (t == nt - 2);
            const char* a1 = cA + (size_t)(t + 1) * kstep;
            const char* a2 = last ? nA : cA + (size_t)(t + 2) * kstep; const char* b2 = last ? nB : cB + (size_t)(t + 2) * kstep;
            const char* a3 = a2 + kstep; const char* b3 = b2 + kstep;
            PG8_LDB(B0, 0, 0); PG8_SCHED; PG8_LDA(At, 0, 0); PG8_STAGE(PG8_SA(1, 1), a1 + hstepA, voffA);
            PG8_WAIT_L(8); PG8_BAR; PG8_WAIT_L(0); PG8_MMA(0, 0, At, B0); PG8_BAR; PG8_SCHED;
            PG8_LDB(B1, 0, 1); PG8_STAGE(PG8_SB(0, 0), b2, voffB);
            PG8_BAR; PG8_WAIT_L(0); PG8_MMA(0, 1, At, B1); PG8_BAR;
            PG8_LDA(At, 0, 1); PG8_STAGE(PG8_SA(0, 0), a2, voffA);
            PG8_BAR; PG8_WAIT_L(0); PG8_MMA(1, 0, At, B0); PG8_BAR; PG8_SCHED;
            PG8_STAGE(PG8_SB(0, 1), b2 + hstepB, voffB);
            PG8_WAIT_V(6); PG8_BAR; PG8_MMA(1, 1, At, B1); PG8_BAR;
            PG8_LDB(B0, 1, 0); PG8_SCHED; PG8_LDA(At, 1, 0); PG8_STAGE(PG8_SA(0, 1), a2 + hstepA, voffA);
            PG8_WAIT_L(8); PG8_BAR; PG8_WAIT_L(0); PG8_MMA(0, 0, At, B0); PG8_BAR; PG8_SCHED;
            PG8_LDB(B1, 1, 1); PG8_STAGE(PG8_SB(1, 0), b3, voffB);
            PG8_BAR; PG8_WAIT_L(0); PG8_MMA(0, 1, At, B1); PG8_BAR;
            PG8_LDA(At, 1, 1); PG8_STAGE(PG8_SA(1, 0), a3, voffA);
            PG8_BAR; PG8_WAIT_L(0); PG8_MMA(1, 0, At, B0); PG8_BAR; PG8_SCHED;
            PG8_STAGE(PG8_SB(1, 1), b3 + hstepB, voffB);
            PG8_WAIT_V(6); PG8_BAR; PG8_MMA(1, 1, At, B1); PG8_BAR;
        }
        const bool keep = E(acc, cur, wr, wc, fr, fq);
        if (!has_next) break;
        if (!keep) {
#pragma unroll
            for (int a = 0; a < 2; ++a)
#pragma unroll
                for (int b = 0; b < 2; ++b)
#pragma unroll
                    for (int m = 0; m < 4; ++m)
#pragma unroll
                        for (int n = 0; n < 2; ++n) acc[a][b][m][n] = (f32x4){0.f, 0.f, 0.f, 0.f};
        }
        cur = nxt; cA = nA; cB = nB; ++ui;
    }
    PG8_WAIT_V(0);
    if (wr == 0) PG8_BAR;
    PG8_BAR;
#undef PG8_SA
#undef PG8_SB
#undef PG8_STAGE
#undef PG8_LDA
#undef PG8_LDB
#undef PG8_MMA
#undef PG8_WAIT_V
#undef PG8_WAIT_L
#undef PG8_BAR
#undef PG8_SCHED
}
}

__device__ __forceinline__ void tconv_tile(const float* src, int ld_src, int nvalid, bf16_t* dst, int ld_dst, int tid) {
    float* t = (float*)smem;
    { const int r = tid >> 3, c0 = (tid & 7) * 8;
#pragma unroll
      for (int j = 0; j < 8; ++j) { const int c = c0 + j; const float v = (c < nvalid) ? src[(size_t)r * ld_src + c] : 0.f; t[c * 65 + r] = v; } }
    __syncthreads();
    { const int n = tid >> 3, k0 = (tid & 7) * 8; const float* p = t + n * 65 + k0;
      u32x4 w; w.x = pack2(p[0], p[1]); w.y = pack2(p[2], p[3]); w.z = pack2(p[4], p[5]); w.w = pack2(p[6], p[7]);
      *(u32x4*)(dst + (size_t)n * ld_dst + k0) = w; }
    __syncthreads();
}

__device__ __forceinline__ void phase_prep(ArgsRef a, int l, int tid, int bid, int G) {
    unsigned char* ws = a.ws;
    bf16_t* WIN = (bf16_t*)(ws + OFF_WIN); bf16_t* WQKV = (bf16_t*)(ws + OFF_WQKV); bf16_t* WGLU = (bf16_t*)(ws + OFF_WGLU);
    bf16_t* WB = (bf16_t*)(ws + OFF_WB); bf16_t* WOUT = (bf16_t*)(ws + OFF_WOUT);
    for (int u = bid; u < 2624; u += G) {
        const float* src; int lds_ = 0, nvalid = 64, ldd = 0; bf16_t* dst;
        if (u < 1728) { const int nt = u / 16, kt = u % 16, p0 = nt * 64; int sc;
            if (p0 < 1024) sc = p0; else if (p0 < 6656) sc = p0 + 8; else if (p0 == 6656) { sc = 1024; nvalid = 8; } else { sc = 0; nvalid = 0; }
            src = a.in[1] + (size_t)l * 1024 * INW + (size_t)(kt * 64) * INW + sc; lds_ = INW; dst = WIN + (size_t)p0 * 1024 + kt * 64; ldd = 1024; }
        else if (u < 1920) { const int v = u - 1728, nt = v / 8, kt = v % 8, which = nt / 8, h = (nt % 8) / 2;
            if ((kt >> 1) != h) nvalid = 0;
            src = a.in[4 + which] + (size_t)(l * 4 + h) * 128 * 128 + ((kt & 1) * 64) * 128 + (nt & 1) * 64; lds_ = 128; dst = WQKV + (size_t)(nt * 64) * 512 + kt * 64; ldd = 512; }
        else if (u < 1984) { const int v = u - 1920, nt = v / 8, kt = v % 8;
            src = a.in[18] + (size_t)l * 512 * 512 + (kt * 64) * 512 + nt * 64; lds_ = 512; dst = WGLU + (size_t)(nt * 64) * 512 + kt * 64; ldd = 512; }
        else if (u < 2368) { const int v = u - 1984, b = v / 128, w = v % 128, nt = w / 8, kt = w % 8;
            src = a.in[21 + b] + (size_t)l * 512 * 1024 + (size_t)(kt * 64) * 1024 + nt * 64; lds_ = 1024; dst = WB + (size_t)b * 1024 * 512 + (size_t)(nt * 64) * 512 + kt * 64; ldd = 512; }
        else { const int v = u - 2368, nt = v / 16, kt = v % 16;
            src = a.in[24] + (size_t)l * 1024 * 1024 + (size_t)(kt * 64) * 1024 + nt * 64; lds_ = 1024; dst = WOUT + (size_t)(nt * 64) * 1024 + kt * 64; ldd = 1024; }
        tconv_tile(src, lds_, nvalid, dst, ldd, tid);
    }
    float* ABAR = (float*)(ws + OFF_ABAR); bf16_t* BBT = (bf16_t*)(ws + OFF_BBT); bf16_t* CCT = (bf16_t*)(ws + OFF_CCT);
    for (int i = bid * 512 + tid; i < 2048; i += G * 512) {
        const int g = i / 64, p = i % 64; const size_t gp = (size_t)(l * 32 + g) * 64 + p;
        const float lr = fminf(a.in[10][gp], -1e-4f), li = a.in[11][gp], dt = expf(a.in[12][l * 32 + g]);
        const float mag = expf(lr * dt), abr = mag * cosf(li * dt), abi = mag * sinf(li * dt);
        const float nr = abr - 1.0f, den = lr * lr + li * li, cr = (nr * lr + abi * li) / den, ci = (abi * lr - nr * li) / den;
        ABAR[(g * 64 + p) * 2] = abr; ABAR[(g * 64 + p) * 2 + 1] = abi;
        for (int c = 0; c < 16; ++c) { const float br = a.in[13][gp * 16 + c], bi = a.in[14][gp * 16 + c];
            BBT[(size_t)(g * 128 + p) * 16 + c] = f2bf(cr * br - ci * bi); BBT[(size_t)(g * 128 + 64 + p) * 16 + c] = f2bf(cr * bi + ci * br);
            const size_t ci_ = ((size_t)(l * 32 + g) * 16 + c) * 64 + p;
            CCT[(size_t)(g * 16 + c) * 128 + p] = f2bf(a.in[15][ci_]); CCT[(size_t)(g * 16 + c) * 128 + 64 + p] = f2bf(-a.in[16][ci_]); }
    }
    { float* RWT = (float*)(ws + OFF_RWT); const float* RW = a.in[29]; for (int i = bid * 512 + tid; i < 32 * 1024; i += G * 512) RWT[i] = RW[(i & 1023) * 32 + (i >> 10)]; }
    if (bid == 0 && tid < 128) ((unsigned*)(ws + OFF_CTL))[tid] = 0u;
    if (l == 0) { bf16_t* XB = (bf16_t*)(ws + OFF_XB); const float* x = a.in[0];
        for (size_t i = (size_t)bid * 512 + tid; i < (size_t)T * 1024 / 8; i += (size_t)G * 512) {
            const f32x4 v0 = *(const f32x4*)(x + i * 8), v1 = *(const f32x4*)(x + i * 8 + 4);
            u32x4 w; w.x = pack2(v0[0], v0[1]); w.y = pack2(v0[2], v0[3]); w.z = pack2(v1[0], v1[1]); w.w = pack2(v1[2], v1[3]); *(u32x4*)(XB + i * 8) = w; } }
}

__device__ __forceinline__ void phase_prepx(ArgsRef a, int l, int tid, int bid, int G) {
    bf16_t* WGU = (bf16_t*)(a.ws + OFF_WGU); bf16_t* WD = (bf16_t*)(a.ws + OFF_WD);
    for (int u = bid; u < 6144; u += G) {
        const float* src; int lds_, ldd; bf16_t* dst;
        if (u < 4096) { const int up = u >= 2048, v = u & 2047, e = v / 64, w = v % 64, nt = w / 16, kt = w % 16, j0 = nt * 64, drow = (j0 / 128) * 256 + (j0 % 128) + up * 128;
            src = a.in[31 + up] + ((size_t)(l * 32 + e) * 1024 + kt * 64) * 256 + nt * 64; lds_ = 256; dst = WGU + ((size_t)e * 512 + drow) * 1024 + kt * 64; ldd = 1024; }
        else { const int v = u - 4096, e = v / 64, w = v % 64, nt = w / 4, kt = w % 4;
            src = a.in[33] + ((size_t)(l * 32 + e) * 256 + kt * 64) * 1024 + nt * 64; lds_ = 1024; dst = WD + ((size_t)e * 1024 + nt * 64) * 256 + kt * 64; ldd = 256; }
        tconv_tile(src, lds_, 64, dst, ldd, tid);
    }
}

constexpr int GL_RQ = 0, GL_RK = 17408, GL_VT = 34816, GL_RO = 57856, GL_RX = 75264, GL_KT = 92672, GL_PS = 102912, GL_SC1 = 105472, GL_SC2 = 105984, GL_GT = 106496, GL_OS = 108544, GL_LFS = 117248, GL_DNS = 117504;
template <int MODE, int PASS>
__device__ __forceinline__ void gla_item(ArgsRef a, int l, int h, int sg, int tid, int lane, int wave) {
    unsigned char* ws = a.ws;
    const bf16_t* Z = (const bf16_t*)(ws + OFF_Z); const bf16_t* Qg = (const bf16_t*)(ws + OFF_Q); const bf16_t* Kg = (const bf16_t*)(ws + OFF_KH); const bf16_t* Vg = (const bf16_t*)(ws + OFF_V); const bf16_t* XCg = (const bf16_t*)(ws + OFF_XC);
    const float* LF = (const float*)(ws + OFF_LF);
    float* Eg = (float*)(ws + (MODE == 0 ? OFF_EM : OFF_EH)); float* Gg = (float*)(ws + (MODE == 0 ? OFF_GM : OFF_GH)); float* EX = (float*)(ws + OFF_EMX);
    bf16_t* Yg = (bf16_t*)(ws + (MODE == 0 ? OFF_OM : OFF_OH));
    bf16_t* KT = (bf16_t*)(smem + GL_KT); bf16_t* PS = (bf16_t*)(smem + GL_PS);
    float* SC1 = (float*)(smem + GL_SC1); float* SC2 = (float*)(smem + GL_SC2); float* GT = (float*)(smem + GL_GT); bf16_t* OS = (bf16_t*)(smem + GL_OS); float* DNS = (float*)(smem + GL_DNS);
    const int r = lane & 15, q = lane >> 4, grp = tid >> 7, d = tid & 127, tok = tid >> 4, c8 = (tid & 15) * 8;
    const bool xw = (MODE == 0) && (wave == 0);
    float lb = 0.f;
    if (MODE == 1 && l == 1) { const float h0 = a.in[19][h * 128 + d], h1 = a.in[19][512 + h * 128 + d]; lb = 1.0f / (1.0f + expf(h0 - h1)); }
    f32x4 S[8], SX[8];
#pragma unroll
    for (int i = 0; i < 8; ++i) { S[i] = (f32x4){0.f, 0.f, 0.f, 0.f}; SX[i] = (f32x4){0.f, 0.f, 0.f, 0.f}; }
    if (PASS == 2) {
#pragma unroll
        for (int i = 0; i < 8; ++i)
#pragma unroll
            for (int g = 0; g < 4; ++g) { const size_t row = (size_t)(sg * 4 + h) * 128 + 16 * i + 4 * q + g; S[i][g] = Eg[row * 128 + 16 * wave + r]; if (xw) SX[i][g] = EX[row * 16 + r]; }
    }
    const bf16x8 z8 = (bf16x8){0, 0, 0, 0, 0, 0, 0, 0};
    bf16x8 rq = z8, rk = z8, rv = z8, ro = z8, rx = z8; float lfv = 0.f;
#define GLA_FETCH(t0_) do { const size_t tk = (size_t)((t0_) + tok); \
        if (MODE == 1) { const bf16_t* zp = Z + tk * NZ + h * 128 + c8; if (PASS == 2) { rq = *(const bf16x8*)(zp + 1536); ro = *(const bf16x8*)(zp + 3072); } rk = *(const bf16x8*)(zp + 2048); rv = *(const bf16x8*)(zp + 2560); } \
        else { const size_t o_ = tk * 512 + h * 128 + c8; if (PASS == 2) { rq = *(const bf16x8*)(Qg + o_); ro = *(const bf16x8*)(Z + tk * NZ + 512 + h * 128 + c8); rx = *(const bf16x8*)(XCg + o_); } \
               rk = *(const bf16x8*)(Kg + o_); rv = *(const bf16x8*)(Vg + o_); if (tid < 32) lfv = LF[((t0_) + tid) * 4 + h]; } } while (0)
    GLA_FETCH(sg * GSEGLEN);
    float sk8[8], nw8[8];
#pragma unroll
    for (int j = 0; j < 8; ++j) { sk8[j] = (MODE == 0 && PASS == 2) ? a.in[9][l * 512 + h * 128 + c8 + j] : 0.f; nw8[j] = (MODE == 1 && PASS == 2) ? a.in[20][l * 512 + h * 128 + c8 + j] : 0.f; }
    __syncthreads();
    if (MODE == 0) { for (int i = tid; i < 2 * 16 * 40; i += 512) { const int b = i / 640, k = i % 640; ((bf16_t*)(smem + GL_VT + b * 11520))[128 * 40 + k] = (k < 32) ? (bf16_t)0x3F80 : (bf16_t)0; } }
#define GLA_STORE(tprev, pb) do { const bf16x8 o8 = *(const bf16x8*)(OS + tok * 136 + c8); const bf16x8 p8 = *(const bf16x8*)((const bf16_t*)(smem + GL_RO + (pb) * 8704) + tok * 136 + c8); float y[8]; \
        if (MODE == 0) { const bf16x8 x8 = *(const bf16x8*)((const bf16_t*)(smem + GL_RX + (pb) * 8704) + tok * 136 + c8); const float di = __builtin_amdgcn_rcpf(fmaxf(fabsf(DNS[tok]), 1.0f)); \
            _Pragma("unroll") for (int j = 0; j < 8; ++j) y[j] = sigmoidf_(bf2f((bf16_t)p8[j])) * (bf2f((bf16_t)o8[j]) * di) + sk8[j] * bf2f((bf16_t)x8[j]); } \
        else { float ov[8], ss = 0.f; _Pragma("unroll") for (int j = 0; j < 8; ++j) { ov[j] = bf2f((bf16_t)o8[j]); ss += ov[j] * ov[j]; } \
            ss += __shfl_xor(ss, 1); ss += __shfl_xor(ss, 2); ss += __shfl_xor(ss, 4); ss += __shfl_xor(ss, 8); const float rinv = rsqrtf(ss * (1.0f / 128.0f) + 1e-6f); \
            _Pragma("unroll") for (int j = 0; j < 8; ++j) y[j] = ov[j] * rinv * nw8[j] * siluf_(bf2f((bf16_t)p8[j])); } \
        u32x4 w_; w_.x = pack2(y[0], y[1]); w_.y = pack2(y[2], y[3]); w_.z = pack2(y[4], y[5]); w_.w = pack2(y[6], y[7]); *(u32x4*)(Yg + (size_t)((tprev) + tok) * 512 + h * 128 + c8) = w_; } while (0)
    float runb = 0.f;
    for (int ci = 0; ci < GSEGLEN / 32; ++ci) {
        const int t0 = sg * GSEGLEN + ci * 32, buf = ci & 1;
        bf16_t* RQ = (bf16_t*)(smem + GL_RQ + buf * 8704); bf16_t* RK = (bf16_t*)(smem + GL_RK + buf * 8704); bf16_t* VT = (bf16_t*)(smem + GL_VT + buf * 11520);
        float* LFS = (float*)(smem + GL_LFS + buf * 128);
        if (PASS == 2) { *(bf16x8*)(RQ + tok * 136 + c8) = rq; *(bf16x8*)((bf16_t*)(smem + GL_RO + buf * 8704) + tok * 136 + c8) = ro; if (MODE == 0) *(bf16x8*)((bf16_t*)(smem + GL_RX + buf * 8704) + tok * 136 + c8) = rx; }
        *(bf16x8*)(RK + tok * 136 + c8) = rk;
#pragma unroll
        for (int j = 0; j < 8; ++j) VT[(c8 + j) * 40 + tok] = (bf16_t)rv[j];
        if (MODE == 0 && tid < 32) LFS[tid] = lfv;
        if (ci + 1 < GSEGLEN / 32) GLA_FETCH(t0 + 32);
        __syncthreads();
        float lg[8], kv[8];
#pragma unroll
        for (int j = 0; j < 8; ++j) { const float kr = bf2f(RK[(grp * 8 + j) * 136 + d]);
            if (MODE == 1) { const float f = lb + (1.0f - lb) * sigmoidf_(kr); lg[j] = flog(f); kv[j] = 1.0f - f; } else { lg[j] = LFS[grp * 8 + j]; kv[j] = kr; } }
        float cs[8]; cs[0] = lg[0];
#pragma unroll
        for (int j = 1; j < 8; ++j) cs[j] = cs[j - 1] + lg[j];
        GT[grp * 128 + d] = cs[7];
        __syncthreads();
        if (PASS == 2 && ci > 0) GLA_STORE(t0 - 32, buf ^ 1);
        const float g0 = GT[d], g1 = GT[128 + d], g2 = GT[256 + d], g3 = GT[384 + d];
        const float off = grp == 0 ? 0.f : grp == 1 ? g0 : grp == 2 ? g0 + g1 : g0 + g1 + g2;
        const float bmid = g0 + g1, bL = bmid + g2 + g3;
        bf16_t ktv[8];
#pragma unroll
        for (int j = 0; j < 8; ++j) { const float bt = off + cs[j], ek = fexp(bmid - bt); const bf16_t kt = f2bf(kv[j] * ek); ktv[j] = kt;
            if (PASS == 2) { const float qr = bf2f(RQ[(grp * 8 + j) * 136 + d]); const float qq = (MODE == 1) ? siluf_(qr) : qr; RQ[(grp * 8 + j) * 136 + d] = f2bf(qq * __builtin_amdgcn_rcpf(ek)); RK[(grp * 8 + j) * 136 + d] = kt; } }
        { u32x4 w; w.x = ktv[0] | ((unsigned)ktv[1] << 16); w.y = ktv[2] | ((unsigned)ktv[3] << 16); w.z = ktv[4] | ((unsigned)ktv[5] << 16); w.w = ktv[6] | ((unsigned)ktv[7] << 16); *(u32x4*)(KT + d * 40 + grp * 8) = w; }
        if (grp == 0) { SC1[d] = fexp(bmid); SC2[d] = fexp(bL - bmid); runb += bL; }
        __syncthreads();
        if (PASS == 2) {
            if (wave < 4) {
                const int ti = (wave == 1 || wave == 2) ? 1 : 0, tj = (wave >= 2) ? 1 : 0;
                f32x4 p = (f32x4){0.f, 0.f, 0.f, 0.f};
                if (wave < 3) {
#pragma unroll
                    for (int kk = 0; kk < 4; ++kk) { const bf16x8 av = *(const bf16x8*)(RQ + (16 * ti + r) * 136 + 32 * kk + 8 * q); const bf16x8 bv = *(const bf16x8*)(RK + (16 * tj + r) * 136 + 32 * kk + 8 * q); p = MFMA16(av, bv, p); }
                }
#pragma unroll
                for (int g = 0; g < 4; ++g) { const int t = 16 * ti + 4 * q + g, s_ = 16 * tj + r; PS[t * 40 + s_] = (wave < 3 && s_ <= t) ? f2bf(p[g]) : (bf16_t)0; }
            }
            __syncthreads();
        }
        const bf16x8 bV = *(const bf16x8*)(VT + (16 * wave + r) * 40 + 8 * q);
        bf16x8 bV1 = bV; if (xw) bV1 = *(const bf16x8*)(VT + (128 + r) * 40 + 8 * q);
        f32x4 o[2], ox[2];
        o[0] = o[1] = ox[0] = ox[1] = (f32x4){0.f, 0.f, 0.f, 0.f};
#pragma unroll
        for (int kk = 0; kk < 4; ++kk) {
            const f32x4 sa = *(const f32x4*)(SC1 + 32 * kk + 4 * q), sb = *(const f32x4*)(SC1 + 32 * kk + 16 + 4 * q);
            S[2 * kk] *= sa; S[2 * kk + 1] *= sb;
            if (xw) { SX[2 * kk] *= sa; SX[2 * kk + 1] *= sb; }
            if (PASS == 2) {
                bf16x8 bS, bX;
#pragma unroll
                for (int g = 0; g < 4; ++g) { bS[g] = (short)f2bf(S[2 * kk][g]); bS[4 + g] = (short)f2bf(S[2 * kk + 1][g]); bX[g] = (short)f2bf(SX[2 * kk][g]); bX[4 + g] = (short)f2bf(SX[2 * kk + 1][g]); }
#pragma unroll
                for (int mt = 0; mt < 2; ++mt) { const bf16x4 lo = *(const bf16x4*)(RQ + (16 * mt + r) * 136 + 32 * kk + 4 * q), hi = *(const bf16x4*)(RQ + (16 * mt + r) * 136 + 32 * kk + 16 + 4 * q);
                    bf16x8 av; av[0] = lo[0]; av[1] = lo[1]; av[2] = lo[2]; av[3] = lo[3]; av[4] = hi[0]; av[5] = hi[1]; av[6] = hi[2]; av[7] = hi[3];
                    o[mt] = MFMA16(av, bS, o[mt]); if (xw) ox[mt] = MFMA16(av, bX, ox[mt]); }
            }
        }
        if (PASS == 2) {
#pragma unroll
            for (int mt = 0; mt < 2; ++mt) { const bf16x8 av = *(const bf16x8*)(PS + (16 * mt + r) * 40 + 8 * q); o[mt] = MFMA16(av, bV, o[mt]); if (xw) ox[mt] = MFMA16(av, bV1, ox[mt]);
#pragma unroll
                for (int g = 0; g < 4; ++g) { OS[(16 * mt + 4 * q + g) * 136 + 16 * wave + r] = f2bf(o[mt][g]); if (xw && r == 0) DNS[16 * mt + 4 * q + g] = ox[mt][g]; } }
        }
#pragma unroll
        for (int i = 0; i < 8; ++i) { const bf16x8 av = *(const bf16x8*)(KT + (16 * i + r) * 40 + 8 * q); const f32x4 s2 = *(const f32x4*)(SC2 + 16 * i + 4 * q);
            S[i] = MFMA16(av, bV, S[i]); S[i] *= s2;
            if (xw) { SX[i] = MFMA16(av, bV1, SX[i]); SX[i] *= s2; } }
    }
    if (PASS == 2) { __syncthreads(); GLA_STORE(sg * GSEGLEN + GSEGLEN - 32, 1); }
    if (PASS == 1) {
        float* ST = (float*)smem;
        __syncthreads();
#pragma unroll
        for (int i = 0; i < 8; ++i)
#pragma unroll
            for (int g = 0; g < 4; ++g) { ST[(16 * i + 4 * q + g) * 132 + 16 * wave + r] = S[i][g]; if (xw) EX[((size_t)(sg * 4 + h) * 128 + 16 * i + 4 * q + g) * 16 + r] = SX[i][g]; }
        __syncthreads();
#pragma unroll
        for (int k = 0; k < 8; ++k) { const int idx = tid + 512 * k, row = idx >> 5, c4 = (idx & 31) * 4; *(f32x4*)(Eg + ((size_t)(sg * 4 + h) * 128 + row) * 128 + c4) = *(const f32x4*)(ST + row * 132 + c4); }
        if (grp == 0) Gg[(size_t)(sg * 4 + h) * 128 + d] = expf(runb);
    }
#undef GLA_FETCH
#undef GLA_STORE
}

template <int PASS>
__device__ __forceinline__ void s5_item(ArgsRef a, int l, int g, int sg, int g0, int tid, int lane, int wave, int hsel) {
    unsigned char* ws = a.ws;
    const bf16_t* Z = (const bf16_t*)(ws + OFF_Z); const float* ABAR = (const float*)(ws + OFF_ABAR); const bf16_t* BBT = (const bf16_t*)(ws + OFF_BBT); const bf16_t* CCT = (const bf16_t*)(ws + OFF_CCT);
    float* ES = (float*)(ws + OFF_ES); bf16_t* YPRE = (bf16_t*)(ws + OFF_YPRE);
    float* BU = (float*)(smem + 70000 + (wave & 3) * 12800); bf16_t* X = (bf16_t*)(smem + 70000 + (wave & 3) * 12800 + 8448); bf16_t* YT = (bf16_t*)(smem + 70000 + 51200);
    const int r = lane & 15, q = lane >> 4, p = lane; const bool act = (wave >> 2) == hsel;
    const float ar = ABAR[(g * 64 + p) * 2], ai = ABAR[(g * 64 + p) * 2 + 1];
    const bf16x8 zero8 = (bf16x8){0, 0, 0, 0, 0, 0, 0, 0};
    bf16x8 bB[8], cB[4];
#pragma unroll
    for (int nt = 0; nt < 8; ++nt) bB[nt] = (q < 2) ? *(const bf16x8*)(BBT + (size_t)(g * 128 + 16 * nt + r) * 16 + 8 * q) : zero8;
#pragma unroll
    for (int kk = 0; kk < 4; ++kk) cB[kk] = (PASS == 2) ? *(const bf16x8*)(CCT + (size_t)(g * 16 + r) * 128 + 32 * kk + 8 * q) : zero8;
    float xr = 0.f, xi = 0.f;
    if (PASS == 2) { xr = ES[((size_t)(sg * 32 + g) * 64 + p) * 2]; xi = ES[((size_t)(sg * 32 + g) * 64 + p) * 2 + 1]; }
    const float dsk = a.in[17][l * 512 + 16 * g + r];
    for (int ci = 0; ci < SSEGLEN / 16; ++ci) {
        const int t0 = sg * SSEGLEN + ci * 16;
        if (act) {
            const bf16x8 av = (q < 2) ? *(const bf16x8*)(Z + (size_t)(t0 + r) * NZ + 1024 + 16 * g + 8 * q) : zero8;
#pragma unroll
            for (int nt = 0; nt < 8; ++nt) { f32x4 acc = (f32x4){0.f, 0.f, 0.f, 0.f}; acc = MFMA16(av, bB[nt], acc);
#pragma unroll
                for (int gg = 0; gg < 4; ++gg) BU[(4 * q + gg) * 132 + 16 * nt + r] = acc[gg]; }
            wave_sync();
#pragma unroll
            for (int t = 0; t < 16; ++t) { const float br = BU[t * 132 + p], bi = BU[t * 132 + 64 + p];
                const float nr = ar * xr - ai * xi + br, ni = ar * xi + ai * xr + bi; xr = nr; xi = ni;
                if (PASS == 2) { X[t * 136 + p] = f2bf(xr); X[t * 136 + 64 + p] = f2bf(xi); } }
            wave_sync();
            if (PASS == 2) {
                f32x4 acc = (f32x4){0.f, 0.f, 0.f, 0.f};
#pragma unroll
                for (int kk = 0; kk < 4; ++kk) { const bf16x8 xv = *(const bf16x8*)(X + r * 136 + 32 * kk + 8 * q); acc = MFMA16(xv, cB[kk], acc); }
#pragma unroll
                for (int gg = 0; gg < 4; ++gg) { const int t = t0 + 4 * q + gg, c = 16 * g + r; const float u = bf2f(Z[(size_t)t * NZ + 1024 + c]);
                    YT[(4 * q + gg) * 136 + 16 * wave + r] = f2bf(gelu_tanh(acc[gg] + dsk * u)); }
            }
        }
        if (PASS == 2) {
            __syncthreads();
            if (tid < 128) { const int row = tid >> 3, c8 = (tid & 7) * 8; *(u32x4*)(YPRE + (size_t)(t0 + row) * 512 + 16 * g0 + 64 * hsel + c8) = *(const u32x4*)(YT + row * 136 + 64 * hsel + c8); }
            __syncthreads();
        }
    }
    if (PASS == 1 && act) { ES[((size_t)(sg * 32 + g) * 64 + p) * 2] = xr; ES[((size_t)(sg * 32 + g) * 64 + p) * 2 + 1] = xi; }
}

__device__ __forceinline__ void phase_scan(ArgsRef a, int tid, int bid, int G) {
    unsigned char* ws = a.ws;
    const int NT = G * 512, gt = bid * 512 + tid;
    for (int i = gt; i < 2 * 65536 + 8192 + 2048; i += NT) {
        if (i < 2 * 65536) { const int m = i >> 16, el = i & 65535, hrow = el >> 7;
            float* E = (float*)(ws + (m == 0 ? OFF_EM : OFF_EH)); const float* Gd = (const float*)(ws + (m == 0 ? OFF_GM : OFF_GH));
            float cur = 0.f;
#pragma unroll 8
            for (int sg = 0; sg < GSEG; ++sg) { const float e = E[(size_t)sg * 65536 + el], g = Gd[sg * 512 + hrow]; E[(size_t)sg * 65536 + el] = cur; cur = g * cur + e; } }
        else if (i < 2 * 65536 + 8192) { const int el = i - 2 * 65536, hrow = el >> 4; float* E = (float*)(ws + OFF_EMX); const float* Gd = (const float*)(ws + OFF_GM);
            float cur = 0.f;
#pragma unroll 8
            for (int sg = 0; sg < GSEG; ++sg) { const float e = E[(size_t)sg * 8192 + el], g = Gd[sg * 512 + hrow]; E[(size_t)sg * 8192 + el] = cur; cur = g * cur + e; } }
        else { const int el = i - 2 * 65536 - 8192; float* E = (float*)(ws + OFF_ES); const float* ABAR = (const float*)(ws + OFF_ABAR);
            float pr = ABAR[el * 2], pi = ABAR[el * 2 + 1];
#pragma unroll
            for (int k = 0; k < 8; ++k) { const float nr = pr * pr - pi * pi, ni = 2.0f * pr * pi; pr = nr; pi = ni; }
            float xr = 0.f, xi = 0.f;
#pragma unroll 8
            for (int sg = 0; sg < SSEG; ++sg) { const float er = E[((size_t)sg * 2048 + el) * 2], ei = E[((size_t)sg * 2048 + el) * 2 + 1];
                E[((size_t)sg * 2048 + el) * 2] = xr; E[((size_t)sg * 2048 + el) * 2 + 1] = xi;
                const float nr = pr * xr - pi * xi + er, ni = pr * xi + pi * xr + ei; xr = nr; xi = ni; } }
    }
}

template <int PASS>
__device__ __forceinline__ void phase_mixers(ArgsRef a, int l, int tid, int lane, int wave, int bid, int G) {
    for (int it = bid; it < 4 * GSEG; it += G) gla_item<0, PASS>(a, l, it % 4, it / 4, tid, lane, wave);
    asm volatile("" ::: "memory");
    for (int it = bid + ((4 * GSEG - bid % G) % G + G) % G * 0; it < 2 * 4 * GSEG; it += G) { if (it >= 4 * GSEG) gla_item<1, PASS>(a, l, (it - 4 * GSEG) % 4, (it - 4 * GSEG) / 4, tid, lane, wave); }
    __syncthreads();
    for (int it0 = bid * 8; it0 < 32 * SSEG; it0 += G * 8)
        for (int half = 0; half < 2; ++half) { const int it = it0 + wave; s5_item<PASS>(a, l, it % 32, it / 32, it0 % 32, tid, lane, wave, half); __syncthreads(); }
}

__device__ __forceinline__ void phase_post(ArgsRef a, int l, int lane, int gw, int GW) {
    const bf16_t* Z = (const bf16_t*)(a.ws + OFF_Z); const bf16_t* XC = (const bf16_t*)(a.ws + OFF_XC);
    bf16_t* OM = (bf16_t*)(a.ws + OFF_OM); bf16_t* OH = (bf16_t*)(a.ws + OFF_OH); const float* DEN = (const float*)(a.ws + OFF_DEN);
    const int c0 = lane * 8, hd = lane >> 4;
    float skp[8], nw[8];
#pragma unroll
    for (int j = 0; j < 8; ++j) { skp[j] = a.in[9][l * 512 + c0 + j]; nw[j] = a.in[20][l * 512 + c0 + j]; }
    for (int tb = gw * 4; tb < T; tb += GW * 4) {
        bf16x8 om[4], op[4], xc[4], oh[4], gp[4]; float dn[4];
#pragma unroll
        for (int k = 0; k < 4; ++k) { const size_t t = tb + k; om[k] = *(const bf16x8*)(OM + t * 512 + c0); op[k] = *(const bf16x8*)(Z + t * NZ + 512 + c0); xc[k] = *(const bf16x8*)(XC + t * 512 + c0);
            oh[k] = *(const bf16x8*)(OH + t * 512 + c0); gp[k] = *(const bf16x8*)(Z + t * NZ + 3072 + c0); dn[k] = DEN[hd * T + t]; }
#pragma unroll
        for (int k = 0; k < 4; ++k) { const size_t t = tb + k; const float di = __builtin_amdgcn_rcpf(fmaxf(fabsf(dn[k]), 1.0f)); float y[8], ov[8], ss = 0.f;
#pragma unroll
            for (int j = 0; j < 8; ++j) { y[j] = sigmoidf_(bf2f((bf16_t)op[k][j])) * (bf2f((bf16_t)om[k][j]) * di) + skp[j] * bf2f((bf16_t)xc[k][j]); ov[j] = bf2f((bf16_t)oh[k][j]); ss += ov[j] * ov[j]; }
            u32x4 w; w.x = pack2(y[0], y[1]); w.y = pack2(y[2], y[3]); w.z = pack2(y[4], y[5]); w.w = pack2(y[6], y[7]); *(u32x4*)(OM + t * 512 + c0) = w;
            ss += __shfl_xor(ss, 1); ss += __shfl_xor(ss, 2); ss += __shfl_xor(ss, 4); ss += __shfl_xor(ss, 8);
            const float rinv = rsqrtf(ss * (1.0f / 128.0f) + 1e-6f);
#pragma unroll
            for (int j = 0; j < 8; ++j) y[j] = ov[j] * rinv * nw[j] * siluf_(bf2f((bf16_t)gp[k][j]));
            u32x4 x; x.x = pack2(y[0], y[1]); x.y = pack2(y[2], y[3]); x.z = pack2(y[4], y[5]); x.w = pack2(y[6], y[7]); *(u32x4*)(OH + t * 512 + c0) = x; }
    }
}

__device__ __forceinline__ void ln_row(f32x4 (&v)[4], const float* gam, const float* bet, int lane) {
    float s = 0.f;
#pragma unroll
    for (int j = 0; j < 4; ++j) s += (v[j][0] + v[j][1]) + (v[j][2] + v[j][3]);
#pragma unroll
    for (int o = 32; o >= 1; o >>= 1) s += __shfl_xor(s, o);
    const float mean = s * (1.0f / 1024.0f); float qv = 0.f;
#pragma unroll
    for (int j = 0; j < 4; ++j) { const f32x4 dd = v[j] - mean; qv += (dd[0] * dd[0] + dd[1] * dd[1]) + (dd[2] * dd[2] + dd[3] * dd[3]); }
#pragma unroll
    for (int o = 32; o >= 1; o >>= 1) qv += __shfl_xor(qv, o);
    const float rstd = rsqrtf(qv * (1.0f / 1024.0f) + 1e-5f);
#pragma unroll
    for (int j = 0; j < 4; ++j) { const f32x4 gg = *(const f32x4*)(gam + 256 * j + 4 * lane), bb = *(const f32x4*)(bet + 256 * j + 4 * lane); v[j] = (v[j] - mean) * rstd * gg + bb; }
}

__device__ __forceinline__ void phase_ln1r(ArgsRef a, int l, int tid, int lane, int wave, int bid, int G) {
    float* XF = a.out; bf16_t* XB = (bf16_t*)(a.ws + OFF_XB);
    int* TOKE = (int*)(a.ws + OFF_TOKE); float* TOKG = (float*)(a.ws + OFF_TOKG); unsigned* HIST = (unsigned*)(a.ws + OFF_HIST);
    const float* RWT = (const float*)(a.ws + OFF_RWT); const float* RB = a.in[30];
    float* LG = (float*)(smem + wave * 4096);
    int* TE = (int*)(smem + wave * 4096 + 2304); float* TG = (float*)(smem + wave * 4096 + 2432); unsigned* HS = (unsigned*)(smem + wave * 4096 + 2560);
    const int r = lane & 15, q = lane >> 4, rs = lane >> 5, e = lane & 31;
    for (int tw = bid * 8 + wave; tw < T / 16; tw += G * 8) {
        const int t0 = tw * 16;
        for (int rb = 0; rb < 16; rb += 4) { f32x4 v[4][4];
#pragma unroll
            for (int k = 0; k < 4; ++k)
#pragma unroll
                for (int j = 0; j < 4; ++j) v[k][j] = *(const f32x4*)(XF + (size_t)(t0 + rb + k) * 1024 + 256 * j + 4 * lane);
#pragma unroll
            for (int k = 0; k < 4; ++k) { const int t = t0 + rb + k; ln_row(v[k], a.in[25] + l * 1024, a.in[26] + l * 1024, lane);
#pragma unroll
                for (int j = 0; j < 4; ++j) { *(f32x4*)(XF + (size_t)t * 1024 + 256 * j + 4 * lane) = v[k][j];
                    u32x2 w; w.x = pack2(v[k][j][0], v[k][j][1]); w.y = pack2(v[k][j][2], v[k][j][3]); *(u32x2*)(XB + (size_t)t * 1024 + 256 * j + 4 * lane) = w; } } }
        if (lane < 32) HS[lane] = 0u;
        asm volatile("s_waitcnt vmcnt(0) lgkmcnt(0)" ::: "memory"); __builtin_amdgcn_wave_barrier();
        f32x4 acc0 = (f32x4){0.f, 0.f, 0.f, 0.f}, acc1 = acc0;
        const float* xa = XF + (size_t)(t0 + r) * 1024 + 4 * q; const float* w0 = RWT + (size_t)r * 1024 + 4 * q; const float* w1 = RWT + (size_t)(16 + r) * 1024 + 4 * q;
#pragma unroll 4
        for (int s = 0; s < 64; ++s) { const f32x4 av = *(const f32x4*)(xa + 16 * s), b0 = *(const f32x4*)(w0 + 16 * s), b1 = *(const f32x4*)(w1 + 16 * s);
#pragma unroll
            for (int j = 0; j < 4; ++j) { acc0 = __builtin_amdgcn_mfma_f32_16x16x4f32(av[j], b0[j], acc0, 0, 0, 0); acc1 = __builtin_amdgcn_mfma_f32_16x16x4f32(av[j], b1[j], acc1, 0, 0, 0); } }
#pragma unroll
        for (int g = 0; g < 4; ++g) { LG[(4 * q + g) * 33 + r] = acc0[g]; LG[(4 * q + g) * 33 + 16 + r] = acc1[g]; }
        wave_sync();
        for (int pp = 0; pp < 8; ++pp) {
            const float lg = LG[(2 * pp + rs) * 33 + e];
            const float s = sigmoidf_(lg), sb = s + RB[e];
            float v4[4];
#pragma unroll
            for (int i = 0; i < 4; ++i) v4[i] = __shfl(sb, (lane & ~3) + i);
            int i1 = 0;
#pragma unroll
            for (int i = 1; i < 4; ++i) if (v4[i] > v4[i1]) i1 = i;
            int i2 = (i1 == 0) ? 1 : 0;
#pragma unroll
            for (int i = 0; i < 4; ++i) if (i != i1 && i != i2 && v4[i] > v4[i2]) i2 = i;
            float gs = v4[i1] + v4[i2]; int gid = e >> 2;
#pragma unroll
            for (int o = 4; o <= 16; o <<= 1) { const float os = __shfl_xor(gs, o); const int og = __shfl_xor(gid, o); if (os > gs || (os == gs && og < gid)) { gs = os; gid = og; } }
            float sv[4], sbv[4];
#pragma unroll
            for (int i = 0; i < 4; ++i) { sbv[i] = __shfl(sb, (lane & 32) + gid * 4 + i); sv[i] = __shfl(s, (lane & 32) + gid * 4 + i); }
            int j1 = 0;
#pragma unroll
            for (int i = 1; i < 4; ++i) if (sbv[i] > sbv[j1]) j1 = i;
            int j2 = (j1 == 0) ? 1 : 0;
#pragma unroll
            for (int i = 0; i < 4; ++i) if (i != j1 && i != j2 && sbv[i] > sbv[j2]) j2 = i;
            float s1 = sv[0], s2 = sv[0];
#pragma unroll
            for (int i = 1; i < 4; ++i) { if (i == j1) s1 = sv[i]; if (i == j2) s2 = sv[i]; }
            if (e == 0) { const int ti = 2 * pp + rs; const float inv = 1.0f / (s1 + s2);
                TE[ti * 2] = gid * 4 + j1; TE[ti * 2 + 1] = gid * 4 + j2; TG[ti * 2] = s1 * inv; TG[ti * 2 + 1] = s2 * inv;
                atomicAdd(&HS[gid * 4 + j1], 1u); atomicAdd(&HS[gid * 4 + j2], 1u); }
        }
        wave_sync();
        if (lane < 32) { TOKE[t0 * 2 + lane] = TE[lane]; TOKG[t0 * 2 + lane] = TG[lane]; HIST[tw * 32 + lane] = HS[lane]; }
        wave_sync();
    }
}

__device__ __forceinline__ void phase_slot(ArgsRef a, int tid, int lane, int wave, int bid, int G) {
    const int* TOKE = (const int*)(a.ws + OFF_TOKE); int* TOKS = (int*)(a.ws + OFF_TOKS); const unsigned* HIST = (const unsigned*)(a.ws + OFF_HIST);
    unsigned* BASE = (unsigned*)(a.ws + OFF_CTL) + 64;
    const bf16_t* XB = (const bf16_t*)(a.ws + OFF_XB); bf16_t* XG = (bf16_t*)(a.ws + OFF_XG);
    unsigned* base = (unsigned*)smem; unsigned* pre = base + 40; int* el = (int*)(base + 80); int* sl = (int*)(base + 208); unsigned* red = base + 336;
    const int e = tid & 31, part = tid >> 5;
    for (int c = bid; c < T / 64; c += G) {
        unsigned tot = 0u, pr = 0u;
#pragma unroll 8
        for (int it = part; it < 1024; it += 16) { const unsigned v = HIST[it * 32 + e]; tot += v; pr += (it < 4 * c) ? v : 0u; }
        red[part * 32 + e] = tot; red[512 + part * 32 + e] = pr;
        __syncthreads();
        if (tid < 32) { unsigned t2 = 0u, p2 = 0u; for (int k = 0; k < 16; ++k) { t2 += red[k * 32 + tid]; p2 += red[512 + k * 32 + tid]; } pre[tid] = p2; red[tid] = (t2 + 255u) & ~255u; }
        __syncthreads();
        if (tid == 0) { unsigned sacc = 0; for (int k = 0; k < 32; ++k) { base[k] = sacc; sacc += red[k]; } base[32] = sacc; }
        int ee = 0;
        if (tid < 128) { ee = TOKE[c * 128 + tid]; el[tid] = ee; }
        __syncthreads();
        if (c == 0 && tid < 33) BASE[tid] = base[tid];
        if (tid < 128) { unsigned rank = 0; for (int i = 0; i < tid; ++i) rank += (el[i] == ee) ? 1u : 0u;
            const unsigned sidx = base[ee] + pre[ee] + rank; sl[tid] = (int)sidx; TOKS[c * 128 + tid] = (int)sidx; }
        __syncthreads();
        for (int i = wave; i < 128; i += 8) { const int t = c * 64 + (i >> 1); const size_t so = (size_t)sl[i] * 1024;
            *(u32x4*)(XG + so + lane * 8) = *(const u32x4*)(XB + (size_t)t * 1024 + lane * 8); *(u32x4*)(XG + so + 512 + lane * 8) = *(const u32x4*)(XB + (size_t)t * 1024 + 512 + lane * 8); }
        __syncthreads();
    }
}

__device__ __forceinline__ void phase_ln2(ArgsRef a, int l, int lane, int gw, int GW) {
    float* XF = a.out; bf16_t* XB = (bf16_t*)(a.ws + OFF_XB); const bf16_t* YS = (const bf16_t*)(a.ws + OFF_YS);
    const int* TOKS = (const int*)(a.ws + OFF_TOKS); const float* TOKG = (const float*)(a.ws + OFF_TOKG);
    for (int tb = gw * 4; tb < T; tb += GW * 4) {
        int sv = 0; float gv = 0.f; if (lane < 8) { sv = TOKS[tb * 2 + lane]; gv = TOKG[tb * 2 + lane]; }
        f32x4 v[4][4]; bf16x4 y0[4][4], y1[4][4]; float g0[4], g1[4];
#pragma unroll
        for (int k = 0; k < 4; ++k) { const int s0 = __shfl(sv, 2 * k), s1 = __shfl(sv, 2 * k + 1); g0[k] = __shfl(gv, 2 * k); g1[k] = __shfl(gv, 2 * k + 1);
#pragma unroll
            for (int j = 0; j < 4; ++j) { v[k][j] = *(const f32x4*)(XF + (size_t)(tb + k) * 1024 + 256 * j + 4 * lane);
                y0[k][j] = *(const bf16x4*)(YS + (size_t)s0 * 1024 + 256 * j + 4 * lane); y1[k][j] = *(const bf16x4*)(YS + (size_t)s1 * 1024 + 256 * j + 4 * lane); } }
#pragma unroll
        for (int k = 0; k < 4; ++k) {
#pragma unroll
            for (int j = 0; j < 4; ++j)
#pragma unroll
                for (int g = 0; g < 4; ++g) v[k][j][g] = DN_ALPHA * v[k][j][g] + g0[k] * bf2f((bf16_t)y0[k][j][g]) + g1[k] * bf2f((bf16_t)y1[k][j][g]);
            ln_row(v[k], a.in[27] + l * 1024, a.in[28] + l * 1024, lane);
#pragma unroll
            for (int j = 0; j < 4; ++j) { *(f32x4*)(XF + (size_t)(tb + k) * 1024 + 256 * j + 4 * lane) = v[k][j];
                u32x2 w; w.x = pack2(v[k][j][0], v[k][j][1]); w.y = pack2(v[k][j][2], v[k][j][3]); *(u32x2*)(XB + (size_t)(tb + k) * 1024 + 256 * j + 4 * lane) = w; } }
    }
}

struct SchedGrid {
    int nM, nN, G, c; const char* A; const char* B; size_t strideA, strideB;
    __device__ __forceinline__ bool next(int i, pg8::Unit& u) const { int pm, pn; if (!pg8::tile_order(i * G + c, nM, nN, pm, pn)) return false;
        u.pm = pm; u.pn = pn; u.tag = 0; u.A = A + (size_t)pm * strideA; u.B = B + (size_t)pn * strideB; return true; }
};
constexpr int GATES_LD = 3072;
template <int MODE> struct EpiBf16 {
    static constexpr bool PERM = true;
    bf16_t* O; int ldo; const bf16_t* Y; int ldy;
    __device__ __forceinline__ bool operator()(f32x4 (&acc)[2][2][4][2], const pg8::Unit& u, int wr, int wc, int fr, int fq) const {
#pragma unroll
        for (int ai = 0; ai < 2; ++ai)
#pragma unroll
            for (int m = 0; m < 4; ++m) { const size_t row = (size_t)u.pm * 256 + ai * 128 + wr * 64 + m * 16 + fr;
#pragma unroll
                for (int bj = 0; bj < 2; ++bj) { const int col = u.pn * 256 + bj * 128 + wc * 32 + 8 * fq; f32x4 v0 = acc[ai][bj][m][0], v1 = acc[ai][bj][m][1];
                    if (MODE == 1) {
#pragma unroll
                        for (int j = 0; j < 4; ++j) { v0[j] = fmaxf(sigmoidf_(v0[j]), 1e-30f); v1[j] = fmaxf(sigmoidf_(v1[j]), 1e-30f); } }
                    if (MODE == 2) { const bf16x8 y = *(const bf16x8*)(Y + row * ldy + col);
#pragma unroll
                        for (int j = 0; j < 4; ++j) { v0[j] = bf2f((bf16_t)y[j]) * sigmoidf_(v0[j]); v1[j] = bf2f((bf16_t)y[4 + j]) * sigmoidf_(v1[j]); } }
                    u32x4 w; w.x = pg8::cvt_pk_bf16(v0[0], v0[1]); w.y = pg8::cvt_pk_bf16(v0[2], v0[3]); w.z = pg8::cvt_pk_bf16(v1[0], v1[1]); w.w = pg8::cvt_pk_bf16(v1[2], v1[3]);
                    *(u32x4*)(O + row * ldo + col) = w; } }
        return false;
    }
};
struct SchedZ {
    int G, c; const unsigned char* ws;
    __device__ __forceinline__ bool next(int i, pg8::Unit& u) const { int pm, pn; if (!pg8::tile_order(i * G + c, T / 256, 15, pm, pn)) return false;
        u.pm = pm; u.pn = pn; u.tag = 0; u.A = (const char*)(ws + OFF_XB) + (size_t)pm * 256 * 1024 * 2;
        u.B = (const char*)(ws + OFF_WIN) + (size_t)(pn < 14 ? pn * 256 : 6656) * 1024 * 2; return true; }
};
struct EpiZ {
    static constexpr bool PERM = true;
    bf16_t* Z; float* LI; float* LF; const float* bi; const float* bf;
    __device__ __forceinline__ bool operator()(f32x4 (&acc)[2][2][4][2], const pg8::Unit& u, int wr, int wc, int fr, int fq) const {
        if (u.pn < 14) {
#pragma unroll
            for (int ai = 0; ai < 2; ++ai)
#pragma unroll
                for (int m = 0; m < 4; ++m) { const size_t row = (size_t)u.pm * 256 + ai * 128 + wr * 64 + m * 16 + fr;
#pragma unroll
                    for (int bj = 0; bj < 2; ++bj) { const int col = u.pn * 256 + bj * 128 + wc * 32 + 8 * fq; const f32x4 v0 = acc[ai][bj][m][0], v1 = acc[ai][bj][m][1];
                        u32x4 w; w.x = pg8::cvt_pk_bf16(v0[0], v0[1]); w.y = pg8::cvt_pk_bf16(v0[2], v0[3]); w.z = pg8::cvt_pk_bf16(v1[0], v1[1]); w.w = pg8::cvt_pk_bf16(v1[2], v1[3]);
                        *(u32x4*)(Z + row * NZ + col) = w; } }
        } else if (wc == 0 && fq == 0) {
            const f32x4 b_i = *(const f32x4*)bi, b_f = *(const f32x4*)bf;
#pragma unroll
            for (int ai = 0; ai < 2; ++ai)
#pragma unroll
                for (int m = 0; m < 4; ++m) { const size_t row = (size_t)u.pm * 256 + ai * 128 + wr * 64 + m * 16 + fr; const f32x4 v0 = acc[ai][0][m][0] + b_i, v1 = acc[ai][0][m][1] + b_f;
                    f32x4 lf; lf[0] = logsigmoidf_(v1[0]); lf[1] = logsigmoidf_(v1[1]); lf[2] = logsigmoidf_(v1[2]); lf[3] = logsigmoidf_(v1[3]);
                    *(f32x4*)(LI + row * 4) = v0; *(f32x4*)(LF + row * 4) = lf; }
        }
        return false;
    }
};
__device__ __forceinline__ void phase_zgemm2(ArgsRef a, int l, int tid, int bid, int G) {
    SchedZ S{G, bid, a.ws}; EpiZ E{(bf16_t*)(a.ws + OFF_Z), (float*)(a.ws + OFF_LI), (float*)(a.ws + OFF_LF), a.in[7] + l * 4, a.in[8] + l * 4};
    pg8::gemm_phase((PG8_LAS unsigned char*)smem, tid, 1024, 1024, 1024, S, E);
}
__device__ __forceinline__ void phase_glu_gates(ArgsRef a, int tid, int bid, int G) {
    { SchedGrid S{T / 256, 2, G, bid, (const char*)(a.ws + OFF_YPRE), (const char*)(a.ws + OFF_WGLU), (size_t)256 * 512 * 2, (size_t)256 * 512 * 2};
      EpiBf16<2> E{(bf16_t*)(a.ws + OFF_YSG), 512, (const bf16_t*)(a.ws + OFF_YPRE), 512};
      pg8::gemm_phase((PG8_LAS unsigned char*)smem, tid, 512, 512, 512, S, E); }
    asm volatile("" : "+v"(tid), "+s"(bid), "+s"(G));
    { SchedGrid S{T / 256, 12, G, (bid + G / 2) % G, (const char*)(a.ws + OFF_XB), (const char*)(a.ws + OFF_WIN + (size_t)NZ * 1024 * 2), (size_t)256 * 1024 * 2, (size_t)256 * 1024 * 2};
      EpiBf16<1> E{(bf16_t*)(a.ws + OFF_Z), GATES_LD, nullptr, 0};
      pg8::gemm_phase((PG8_LAS unsigned char*)smem, tid, 1024, 1024, 1024, S, E); }
}
struct SchedMerge {
    int G, c; const unsigned char* ws;
    __device__ __forceinline__ bool next(int i, pg8::Unit& u) const { const int b = i % 3; int pm, pn; if (!pg8::tile_order((i / 3) * G + c, T / 256, 4, pm, pn)) return false;
        u.pm = pm; u.pn = pn; u.tag = b; u.A = (const char*)(ws + (b == 0 ? OFF_OM : b == 1 ? OFF_YSG : OFF_OH)) + (size_t)pm * 256 * 512 * 2;
        u.B = (const char*)(ws + OFF_WB) + ((size_t)b * 1024 + pn * 256) * 512 * 2; return true; }
};
struct EpiMerge {
    static constexpr bool PERM = true;
    const bf16_t* GT; bf16_t* O;
    __device__ __forceinline__ bool operator()(f32x4 (&acc)[2][2][4][2], const pg8::Unit& u, int wr, int wc, int fr, int fq) const {
        const int b = u.tag;
#pragma unroll
        for (int ai = 0; ai < 2; ++ai)
#pragma unroll
            for (int m = 0; m < 4; ++m) { const size_t row = (size_t)u.pm * 256 + ai * 128 + wr * 64 + m * 16 + fr;
#pragma unroll
                for (int bj = 0; bj < 2; ++bj) { const int col = u.pn * 256 + bj * 128 + wc * 32 + 8 * fq;
                    const bf16x8 gb = *(const bf16x8*)(GT + row * GATES_LD + b * 1024 + col);
                    if (b < 2) { const bf16x8 gn = *(const bf16x8*)(GT + row * GATES_LD + (b + 1) * 1024 + col);
#pragma unroll
                        for (int j = 0; j < 4; ++j) { acc[ai][bj][m][0][j] *= bf2f((bf16_t)gb[j]) / bf2f((bf16_t)gn[j]); acc[ai][bj][m][1][j] *= bf2f((bf16_t)gb[4 + j]) / bf2f((bf16_t)gn[4 + j]); } }
                    else { f32x4 v0 = acc[ai][bj][m][0], v1 = acc[ai][bj][m][1];
#pragma unroll
                        for (int j = 0; j < 4; ++j) { v0[j] *= bf2f((bf16_t)gb[j]); v1[j] *= bf2f((bf16_t)gb[4 + j]); }
                        u32x4 w; w.x = pg8::cvt_pk_bf16(v0[0], v0[1]); w.y = pg8::cvt_pk_bf16(v0[2], v0[3]); w.z = pg8::cvt_pk_bf16(v1[0], v1[1]); w.w = pg8::cvt_pk_bf16(v1[2], v1[3]);
                        *(u32x4*)(O + row * 1024 + col) = w; } } }
        return b < 2;
    }
};
__device__ __forceinline__ void phase_merge2(ArgsRef a, int tid, int bid, int G) {
    SchedMerge S{G, bid, a.ws}; EpiMerge E{(const bf16_t*)(a.ws + OFF_Z), (bf16_t*)(a.ws + OFF_XB)};
    pg8::gemm_phase((PG8_LAS unsigned char*)smem, tid, 512, 512, 512, S, E);
}
struct EpiResid {
    static constexpr bool PERM = false;
    const float* xin; float* XF;
    __device__ __forceinline__ bool operator()(f32x4 (&acc)[2][2][4][2], const pg8::Unit& u, int wr, int wc, int fr, int fq) const {
#pragma unroll
        for (int ai = 0; ai < 2; ++ai)
#pragma unroll
            for (int m = 0; m < 4; ++m) { const size_t row = (size_t)u.pm * 256 + ai * 128 + wr * 64 + m * 16 + fr;
#pragma unroll
                for (int bj = 0; bj < 2; ++bj)
#pragma unroll
                    for (int n = 0; n < 2; ++n) { const size_t o = row * 1024 + u.pn * 256 + bj * 128 + wc * 32 + 16 * n + 4 * fq; const f32x4 x = *(const f32x4*)(xin + o); *(f32x4*)(XF + o) = DN_ALPHA * x + acc[ai][bj][m][n]; } }
        return false;
    }
};
__device__ __forceinline__ void phase_wout2(ArgsRef a, int l, int tid, int bid, int G) {
    SchedGrid S{T / 256, 4, G, bid, (const char*)(a.ws + OFF_XB), (const char*)(a.ws + OFF_WOUT), (size_t)256 * 1024 * 2, (size_t)256 * 1024 * 2};
    EpiResid E{(l == 0) ? a.in[0] : a.out, a.out};
    pg8::gemm_phase((PG8_LAS unsigned char*)smem, tid, 1024, 1024, 1024, S, E);
}
struct EpiQKV {
    static constexpr bool PERM = true;
    int vcall; bf16_t* Q; bf16_t* KH; bf16_t* V; const float* LI;
    __device__ __forceinline__ bool operator()(f32x4 (&acc)[2][2][4][2], const pg8::Unit& u, int wr, int wc, int fr, int fq) const {
        const int which = vcall ? 2 : (u.pn >> 1); bf16_t* O = which == 0 ? Q : which == 1 ? KH : V;
#pragma unroll
        for (int ai = 0; ai < 2; ++ai)
#pragma unroll
            for (int m = 0; m < 4; ++m) { const size_t row = (size_t)u.pm * 256 + ai * 128 + wr * 64 + m * 16 + fr;
#pragma unroll
                for (int bj = 0; bj < 2; ++bj) { const int hd = (u.pn & 1) * 2 + bj, col = hd * 128 + wc * 32 + 8 * fq;
                    const float sc = which == 0 ? 0.08838834764831845f : which == 1 ? fexp(LI[row * 4 + hd]) : 1.0f;
                    const f32x4 v0 = acc[ai][bj][m][0] * sc, v1 = acc[ai][bj][m][1] * sc;
                    u32x4 w; w.x = pg8::cvt_pk_bf16(v0[0], v0[1]); w.y = pg8::cvt_pk_bf16(v0[2], v0[3]); w.z = pg8::cvt_pk_bf16(v1[0], v1[1]); w.w = pg8::cvt_pk_bf16(v1[2], v1[3]);
                    *(u32x4*)(O + row * 512 + col) = w; } }
        return false;
    }
};
__device__ __forceinline__ void phase_mqkv2(ArgsRef a, int tid, int bid, int G) {
    { SchedGrid S{T / 256, 4, G, bid, (const char*)(a.ws + OFF_XC), (const char*)(a.ws + OFF_WQKV), (size_t)256 * 512 * 2, (size_t)256 * 512 * 2};
      EpiQKV E{0, (bf16_t*)(a.ws + OFF_Q), (bf16_t*)(a.ws + OFF_KH), (bf16_t*)(a.ws + OFF_V), (const float*)(a.ws + OFF_LI)};
      pg8::gemm_phase((PG8_LAS unsigned char*)smem, tid, 512, 512, 512, S, E); }
    asm volatile("" : "+v"(tid), "+s"(bid), "+s"(G));
    { SchedGrid S{T / 256, 2, G, (bid + G / 2) % G, (const char*)(a.ws + OFF_Z), (const char*)(a.ws + OFF_WQKV + (size_t)1024 * 512 * 2), (size_t)256 * NZ * 2, (size_t)256 * 512 * 2};
      EpiQKV E{1, (bf16_t*)(a.ws + OFF_Q), (bf16_t*)(a.ws + OFF_KH), (bf16_t*)(a.ws + OFF_V), (const float*)(a.ws + OFF_LI)};
      pg8::gemm_phase((PG8_LAS unsigned char*)smem, tid, 512, NZ, 512, S, E); }
}
struct SchedMoE {
    int down, G, c; const unsigned char* ws; const unsigned* BASE;
    __device__ __forceinline__ bool next(int i, pg8::Unit& u) const { const int per = down ? 4 : 2, L = i * G + c, ntile = (int)(BASE[32] >> 8); if (L >= ntile * per) return false;
        const int tile = L / per, sub = L % per; int e = 0; while (e < 31 && BASE[e + 1] <= (unsigned)(tile * 256)) ++e;
        u.pm = tile; u.pn = sub; u.tag = e;
        if (!down) { u.A = (const char*)(ws + OFF_XG) + (size_t)tile * 256 * 1024 * 2; u.B = (const char*)(ws + OFF_WGU) + ((size_t)e * 512 + sub * 256) * 1024 * 2; }
        else { u.A = (const char*)(ws + OFF_H) + (size_t)tile * 256 * 256 * 2; u.B = (const char*)(ws + OFF_WD) + ((size_t)e * 1024 + sub * 256) * 256 * 2; }
        return true; }
};
struct EpiH {
    static constexpr bool PERM = true;
    bf16_t* H;
    __device__ __forceinline__ bool operator()(f32x4 (&acc)[2][2][4][2], const pg8::Unit& u, int wr, int wc, int fr, int fq) const {
#pragma unroll
        for (int ai = 0; ai < 2; ++ai)
#pragma unroll
            for (int m = 0; m < 4; ++m) { const size_t row = (size_t)u.pm * 256 + ai * 128 + wr * 64 + m * 16 + fr; f32x4 v0, v1;
#pragma unroll
                for (int j = 0; j < 4; ++j) { v0[j] = siluf_(acc[ai][0][m][0][j]) * acc[ai][1][m][0][j]; v1[j] = siluf_(acc[ai][0][m][1][j]) * acc[ai][1][m][1][j]; }
                u32x4 w; w.x = pg8::cvt_pk_bf16(v0[0], v0[1]); w.y = pg8::cvt_pk_bf16(v0[2], v0[3]); w.z = pg8::cvt_pk_bf16(v1[0], v1[1]); w.w = pg8::cvt_pk_bf16(v1[2], v1[3]);
                *(u32x4*)(H + row * 256 + u.pn * 128 + wc * 32 + 8 * fq) = w; }
        return false;
    }
};
__device__ __forceinline__ void phase_moe_gu2(ArgsRef a, int tid, int bid, int G) {
    SchedMoE S{0, G, bid, a.ws, (const unsigned*)(a.ws + OFF_CTL) + 64}; EpiH E{(bf16_t*)(a.ws + OFF_H)};
    pg8::gemm_phase((PG8_LAS unsigned char*)smem, tid, 1024, 1024, 1024, S, E);
}
__device__ __forceinline__ void phase_moe_dn2(ArgsRef a, int tid, int bid, int G) {
    SchedMoE S{1, G, bid, a.ws, (const unsigned*)(a.ws + OFF_CTL) + 64}; EpiBf16<0> E{(bf16_t*)(a.ws + OFF_YS), 1024, nullptr, 0};
    pg8::gemm_phase((PG8_LAS unsigned char*)smem, tid, 256, 256, 256, S, E);
}
__device__ __forceinline__ void phase_mprep2(ArgsRef a, int l, int tid, int lane, int wave, int bid, int G) {
    const bf16_t* Z = (const bf16_t*)(a.ws + OFF_Z); bf16_t* XC = (bf16_t*)(a.ws + OFF_XC);
    const float* cw = a.in[2] + (size_t)l * 4 * 512; const float* cb = a.in[3] + (size_t)l * 512;
    for (int idx = bid * 512 + tid; idx < (T / 8) * 64; idx += G * 512) {
        const int tb = (idx / 64) * 8, c0 = (idx % 64) * 8;
        bf16x8 xr[11];
#pragma unroll
        for (int k = 0; k < 11; ++k) { const int ts = tb - 3 + k; xr[k] = (ts >= 0) ? *(const bf16x8*)(Z + (size_t)ts * NZ + c0) : (bf16x8){0, 0, 0, 0, 0, 0, 0, 0}; }
        float w[4][8], b[8];
#pragma unroll
        for (int j = 0; j < 8; ++j) { b[j] = cb[c0 + j];
#pragma unroll
            for (int k = 0; k < 4; ++k) w[k][j] = cw[k * 512 + c0 + j]; }
#pragma unroll
        for (int tt = 0; tt < 8; ++tt) { float acc[8];
#pragma unroll
            for (int j = 0; j < 8; ++j) { acc[j] = b[j];
#pragma unroll
                for (int k = 0; k < 4; ++k) acc[j] += w[k][j] * bf2f((bf16_t)xr[tt + k][j]); }
            u32x4 o; o.x = pack2(siluf_(acc[0]), siluf_(acc[1])); o.y = pack2(siluf_(acc[2]), siluf_(acc[3])); o.z = pack2(siluf_(acc[4]), siluf_(acc[5])); o.w = pack2(siluf_(acc[6]), siluf_(acc[7]));
            *(u32x4*)(XC + (size_t)(tb + tt) * 512 + c0) = o; }
    }
}

#define XB_TMO      128
#define XB_XCNT(j)  (256  + 64 * (j))
#define XB_XSUB(j)  (1280 + 64 * (j))
#define XB_XGEN(j)  (2304 + 64 * (j))
#define XB_TOP      3328
#define XB_TOPGEN   3392
#define XCD_BAR_WORDS 3456
#define XB_SPIN_CAP (1u << 22)
__device__ __forceinline__ unsigned xb_ld(unsigned* p)              { return __hip_atomic_load(p, __ATOMIC_RELAXED, __HIP_MEMORY_SCOPE_AGENT); }
__device__ __forceinline__ unsigned xb_add(unsigned* p, unsigned v) { return __hip_atomic_fetch_add(p, v, __ATOMIC_RELAXED, __HIP_MEMORY_SCOPE_AGENT); }
__device__ __forceinline__ unsigned xb_xcc_id() { return (unsigned)__builtin_amdgcn_s_getreg((3 << 11) | 20) & 0xFu; }
#define XB_SPIN(cond, bar) do { unsigned _sp = 0; while (cond) { __builtin_amdgcn_s_sleep(1); \
    if ((++_sp & 255u) == 0u) { if (xb_ld(&(bar)[XB_TMO])) break; if (_sp > XB_SPIN_CAP) { atomicAdd(&(bar)[XB_TMO], 1u); break; } } } } while (0)
__device__ __forceinline__ void xcd_barrier_complete(unsigned* bar, unsigned x, unsigned& nloc, unsigned& nx) {
    const unsigned G = gridDim.x; unsigned sum, cnt, mine, sp = 0u;
    for (;;) { sum = 0u; cnt = 0u; mine = 0u;
#pragma unroll
        for (unsigned j = 0; j < 16; ++j) { const unsigned c = xb_ld(&bar[XB_XCNT(j)]); sum += c; cnt += (c > 0u) ? 1u : 0u; mine = (j == x) ? c : mine; }
        if (sum == G) break;
        __builtin_amdgcn_s_sleep(1);
        if ((++sp & 255u) == 0u) { if (xb_ld(&bar[XB_TMO])) break; if (sp > XB_SPIN_CAP) { atomicAdd(&bar[XB_TMO], 1u); break; } } }
    nloc = mine > 0u ? mine : 1u; nx = cnt > 0u ? cnt : 1u;
}
__device__ __forceinline__ void xcd_barrier(unsigned* bar, volatile __attribute__((address_space(3))) unsigned* st) {
    asm volatile("s_waitcnt vmcnt(0)" ::: "memory");
    __syncthreads();
    if (threadIdx.x == 0) {
        __builtin_amdgcn_s_waitcnt(0);
        const unsigned x = xb_xcc_id();
        unsigned nloc = st[0], nx = st[1];
        if (nloc == 0u) { xcd_barrier_complete(bar, x, nloc, nx); st[0] = nloc; st[1] = nx; }
        const unsigned old = xb_add(&bar[XB_XSUB(x)], 1u);
        const unsigned gen = old / nloc;
        if (old + 1u == (gen + 1u) * nloc) {
            __builtin_amdgcn_fence(__ATOMIC_RELEASE, "agent");
            asm volatile("s_waitcnt vmcnt(0)" ::: "memory");
            const unsigned og = xb_add(&bar[XB_TOP], 1u);
            const unsigned tg = og / nx;
            if (og + 1u == (tg + 1u) * nx) xb_add(&bar[XB_TOPGEN], 1u);
            else XB_SPIN(xb_ld(&bar[XB_TOPGEN]) == tg, bar);
            __builtin_amdgcn_fence(__ATOMIC_ACQUIRE, "agent");
            xb_add(&bar[XB_XGEN(x)], 1u);
            asm volatile("s_waitcnt vmcnt(0)" ::: "memory");
        } else {
            XB_SPIN(xb_ld(&bar[XB_XGEN(x)]) == gen, bar);
            __builtin_amdgcn_fence(__ATOMIC_ACQUIRE, "agent");
            asm volatile("s_waitcnt vmcnt(0)" ::: "memory");
        }
    }
    __syncthreads();
}

__device__ __forceinline__ ArgsRef fresh_args() { unsigned long long p = (unsigned long long)__builtin_amdgcn_kernarg_segment_ptr(); asm volatile("" : "+s"(p)); return *(const __attribute__((address_space(4))) Args*)p; }
__global__ void __launch_bounds__(512) fwd(Args a_unused) {
    cg::grid_group grid = cg::this_grid();
    volatile __attribute__((address_space(3))) unsigned* bst = (volatile __attribute__((address_space(3))) unsigned*)((__attribute__((address_space(3))) unsigned char*)smem + 131072);
    if (threadIdx.x < 4) bst[threadIdx.x] = 0u;
    __syncthreads();
    { ArgsRef a0 = fresh_args(); if (threadIdx.x == 0) (void)xb_add(&((unsigned*)(a0.ws + OFF_BAR))[XB_XCNT(xb_xcc_id())], 1u); }
#define GSYNC() do { asm volatile("" ::: "memory"); { ArgsRef ab = fresh_args(); xcd_barrier((unsigned*)(ab.ws + OFF_BAR), bst); } asm volatile("" ::: "memory"); } while (0)
#define GSYNC_CG() do { asm volatile("" ::: "memory"); grid.sync(); asm volatile("" ::: "memory"); } while (0)
    const int wave_s = __builtin_amdgcn_readfirstlane((int)threadIdx.x >> 6);
#define PH(body) do { int wave = wave_s; asm volatile("" : "+s"(wave)); int lane; asm volatile("v_mbcnt_lo_u32_b32 %0, -1, 0\n\tv_mbcnt_hi_u32_b32 %0, -1, %0" : "=v"(lane)); \
        int bid = blockIdx.x, G = gridDim.x; asm volatile("" : "+s"(bid), "+s"(G)); \
        const int tid = wave * 64 + lane, gw = bid * 8 + wave, GW = G * 8; (void)tid; (void)gw; (void)GW; ArgsRef a = fresh_args(); body; } while (0)
#pragma unroll 1
    for (int l = 0; l < NLAYER; ++l) {
        PH(phase_prep(a, l, tid, bid, G)); if (l == 0) GSYNC_CG(); else GSYNC();
        PH(phase_zgemm2(a, l, tid, bid, G)); GSYNC();
        PH(phase_mprep2(a, l, tid, lane, wave, bid, G)); GSYNC();
        PH(phase_mqkv2(a, tid, bid, G)); GSYNC();
        PH(phase_mixers<1>(a, l, tid, lane, wave, bid, G)); GSYNC();
        PH(phase_scan(a, tid, bid, G)); GSYNC();
        PH(phase_mixers<2>(a, l, tid, lane, wave, bid, G)); GSYNC();
        PH(phase_glu_gates(a, tid, bid, G)); PH(phase_prepx(a, l, tid, bid, G)); GSYNC();
        PH(phase_merge2(a, tid, bid, G)); GSYNC();
        PH(phase_wout2(a, l, tid, bid, G)); GSYNC();
        PH(phase_ln1r(a, l, tid, lane, wave, bid, G)); GSYNC();
        PH(phase_slot(a, tid, lane, wave, bid, G)); GSYNC();
        PH(phase_moe_gu2(a, tid, bid, G)); GSYNC();
        PH(phase_moe_dn2(a, tid, bid, G)); GSYNC();
        PH(phase_ln2(a, l, lane, gw, GW)); if (l + 1 < NLAYER) GSYNC();
    }
}

extern "C" void kernel_launch(void* const* d_in, const int* in_sizes, int n_in, void* d_out, int out_size, void* d_ws, size_t ws_size, hipStream_t stream) {
    static int grid = 0;
    if (grid == 0) {
        if (n_in != 34 || out_size != T * D || ws_size < WS_TOTAL) { fprintf(stderr, "kernel_launch: unexpected shapes (n_in %d, out %d, ws %zu, need %zu)\n", n_in, out_size, ws_size, (size_t)WS_TOTAL); grid = -1; return; }
        int dev = 0, cus = 0, per_cu = 0;
        (void)hipGetDevice(&dev); (void)hipDeviceGetAttribute(&cus, hipDeviceAttributeMultiprocessorCount, dev);
        (void)hipFuncSetAttribute((const void*)fwd, hipFuncAttributeMaxDynamicSharedMemorySize, LDS_BYTES);
        (void)hipOccupancyMaxActiveBlocksPerMultiprocessor(&per_cu, (const void*)fwd, 512, LDS_BYTES);
        if (per_cu < 1) { fprintf(stderr, "kernel_launch: occupancy query says %d blocks per CU\n", per_cu); per_cu = 1; }
        grid = (cus > 0 ? cus : 256) * 1;
        (void)hipGetLastError();
    }
    if (grid < 0) return;
    Args a{};
    for (int i = 0; i < 34; ++i) a.in[i] = (const float*)d_in[i];
    a.out = (float*)d_out; a.ws = (unsigned char*)d_ws; a.ph_lo = 0; a.ph_hi = NLAYER * NPH;
    (void)hipMemsetAsync((unsigned char*)d_ws + OFF_BAR, 0, 16384, stream);
    void* args[] = {&a};
    hipError_t e = hipLaunchCooperativeKernel((const void*)fwd, dim3(grid), dim3(512), args, LDS_BYTES, stream);
    if (e != hipSuccess) fprintf(stderr, "kernel_launch: cooperative launch failed: %s (grid %d)\n", hipGetErrorString(e), grid);
}
```

```cpp
#include <hip/hip_runtime.h>
#include <hip/hip_cooperative_groups.h>
#include <cstdio>
#include <cstdint>
namespace cg = cooperative_groups;

typedef unsigned short bf16_t;
typedef short bf16x8 __attribute__((ext_vector_type(8)));
typedef short bf16x4 __attribute__((ext_vector_type(4)));
typedef float f32x4 __attribute__((ext_vector_type(4)));
typedef unsigned u32x4 __attribute__((ext_vector_type(4)));
typedef unsigned u32x2 __attribute__((ext_vector_type(2)));

constexpr int T = 16384, D = 1024, NZ = 3584, NWIN = 6912, INW = 6664;
constexpr int NPH = 15, NLAYER = 2;
constexpr int GSEG = 32, GSEGLEN = 512;
constexpr int SSEG = 64, SSEGLEN = 256;
constexpr int SLOTS = 40960;
constexpr float DN_ALPHA = 1.41421356237f;
constexpr int LDS_BYTES = 131072 + 256;

constexpr size_t AL(size_t x) { return (x + 255) & ~(size_t)255; }
constexpr size_t OFF_WIN = 0;
constexpr size_t OFF_WQKV = OFF_WIN + AL((size_t)NWIN * 1024 * 2);
constexpr size_t OFF_WGLU = OFF_WQKV + AL((size_t)1536 * 512 * 2);
constexpr size_t OFF_WB = OFF_WGLU + AL((size_t)512 * 512 * 2);
constexpr size_t OFF_WOUT = OFF_WB + AL((size_t)3 * 1024 * 512 * 2);
constexpr size_t OFF_ABAR = OFF_WOUT + AL((size_t)1024 * 1024 * 2);
constexpr size_t OFF_BBT = OFF_ABAR + AL((size_t)32 * 64 * 2 * 4);
constexpr size_t OFF_CCT = OFF_BBT + AL((size_t)32 * 128 * 16 * 2);
constexpr size_t OFF_CTL = OFF_CCT + AL((size_t)32 * 16 * 128 * 2);
constexpr size_t OFF_TOKE = OFF_CTL + 4096;
constexpr size_t OFF_TOKG = OFF_TOKE + AL((size_t)T * 2 * 4);
constexpr size_t OFF_TOKS = OFF_TOKG + AL((size_t)T * 2 * 4);
constexpr size_t OFF_SLOTT = OFF_TOKS + AL((size_t)T * 2 * 4);
constexpr size_t OFF_XB = OFF_SLOTT + AL((size_t)SLOTS * 4);
constexpr size_t OFF_R1 = OFF_XB + AL((size_t)T * 1024 * 2);
constexpr size_t SZ_ACT = (size_t)T * 512 * 2;
constexpr size_t OFF_XC = OFF_R1, OFF_Q = OFF_R1 + SZ_ACT, OFF_KH = OFF_R1 + 2 * SZ_ACT, OFF_V = OFF_R1 + 3 * SZ_ACT;
constexpr size_t OFF_WGU = OFF_R1, OFF_WD = OFF_R1 + (size_t)32 * 512 * 1024 * 2;
constexpr size_t OFF_Z = OFF_R1 + 4 * SZ_ACT;
constexpr size_t OFF_XG = OFF_Z, OFF_H = OFF_Z + (size_t)SLOTS * 1024 * 2;
constexpr size_t OFF_ZS = OFF_Z + AL((size_t)T * NZ * 2);
constexpr size_t OFF_LF = OFF_ZS + AL((size_t)T * 8 * 4);
constexpr size_t OFF_LI = OFF_LF + AL((size_t)T * 4 * 4);
constexpr size_t OFF_E = OFF_LI + AL((size_t)T * 4 * 4);
constexpr size_t OFF_OM = OFF_E, OFF_OH = OFF_E + SZ_ACT, OFF_YPRE = OFF_E + 2 * SZ_ACT, OFF_YSG = OFF_E + 3 * SZ_ACT;
constexpr size_t OFF_DEN = OFF_E + 4 * SZ_ACT;
constexpr size_t OFF_EM = OFF_DEN + AL((size_t)T * 4 * 4);
constexpr size_t OFF_EMX = OFF_EM + AL((size_t)GSEG * 4 * 128 * 128 * 4);
constexpr size_t OFF_GM = OFF_EMX + AL((size_t)GSEG * 4 * 128 * 16 * 4);
constexpr size_t OFF_EH = OFF_GM + AL((size_t)GSEG * 4 * 128 * 4);
constexpr size_t OFF_GH = OFF_EH + AL((size_t)GSEG * 4 * 128 * 128 * 4);
constexpr size_t OFF_ES = OFF_GH + AL((size_t)GSEG * 4 * 128 * 4);
constexpr size_t WS_END = OFF_ES + AL((size_t)SSEG * 32 * 64 * 2 * 4);
constexpr size_t OFF_YS = OFF_E;
constexpr size_t OFF_RWT = WS_END;
constexpr size_t OFF_HIST = OFF_RWT + 32 * 1024 * 4;
constexpr size_t OFF_BAR = OFF_HIST + 1024 * 32 * 4;
constexpr size_t WS_TOTAL = OFF_BAR + 16384;
static_assert(OFF_YS + (size_t)SLOTS * 1024 * 2 <= WS_END, "YS must fit in the dead region");
static_assert(OFF_H + (size_t)SLOTS * 256 * 2 <= OFF_ZS, "H must fit in the dead Z region");
static_assert(OFF_WD + (size_t)32 * 1024 * 256 * 2 <= OFF_Z, "expert weights must fit in R1");

struct Args { const float* in[34]; float* out; unsigned char* ws; int ph_lo, ph_hi; };
typedef const __attribute__((address_space(4))) Args& ArgsRef;

extern __shared__ __attribute__((aligned(16))) unsigned char smem[];

__device__ __forceinline__ bf16_t f2bf(float f) { unsigned u = __float_as_uint(f); u += 0x7FFFu + ((u >> 16) & 1u); return (bf16_t)(u >> 16); }
__device__ __forceinline__ float bf2f(bf16_t b) { return __uint_as_float(((unsigned)b) << 16); }
__device__ __forceinline__ unsigned pack2(float lo, float hi) { return (unsigned)f2bf(lo) | ((unsigned)f2bf(hi) << 16); }
__device__ __forceinline__ float fexp(float x) { return __builtin_amdgcn_exp2f(x * 1.4426950408889634f); }
__device__ __forceinline__ float flog(float x) { return __builtin_amdgcn_logf(x) * 0.6931471805599453f; }
__device__ __forceinline__ float sigmoidf_(float x) { return __builtin_amdgcn_rcpf(1.0f + fexp(-x)); }
__device__ __forceinline__ float siluf_(float x) { return x * __builtin_amdgcn_rcpf(1.0f + fexp(-x)); }
__device__ __forceinline__ float logsigmoidf_(float x) { return fminf(x, 0.f) - log1pf(expf(-fabsf(x))); }
__device__ __forceinline__ float gelu_tanh(float y) { const float z = 0.7978845608028654f * (y + 0.044715f * y * y * y); const float th = 1.0f - 2.0f * __builtin_amdgcn_rcpf(fexp(2.0f * z) + 1.0f); return 0.5f * y * (1.0f + th); }
__device__ __forceinline__ void wave_sync() { __builtin_amdgcn_wave_barrier(); asm volatile("s_waitcnt lgkmcnt(0)" ::: "memory"); __builtin_amdgcn_wave_barrier(); }

#define MFMA16(a, b, c) __builtin_amdgcn_mfma_f32_16x16x32_bf16((a), (b), (c), 0, 0, 0)

template <int MT, int NT, class FA, class FB>
__device__ __forceinline__ void wave_gemm(f32x4 (&acc)[MT][NT], int K, FA arow, FB brow, int lane) {
    const int r = lane & 15, q = lane >> 4;
    const bf16_t* ap[MT]; const bf16_t* bp[NT];
#pragma unroll
    for (int m = 0; m < MT; ++m) ap[m] = arow(m * 16 + r) + 8 * q;
#pragma unroll
    for (int n = 0; n < NT; ++n) bp[n] = brow(n * 16 + r) + 8 * q;
#pragma unroll 1
    for (int k = 0; k < K; k += 32) {
        bf16x8 a[MT], b[NT];
#pragma unroll
        for (int m = 0; m < MT; ++m) a[m] = *(const bf16x8*)(ap[m] + k);
#pragma unroll
        for (int n = 0; n < NT; ++n) b[n] = *(const bf16x8*)(bp[n] + k);
#pragma unroll
        for (int m = 0; m < MT; ++m)
#pragma unroll
            for (int n = 0; n < NT; ++n) acc[m][n] = MFMA16(a[m], b[n], acc[m][n]);
    }
}
template <int MT, int NT> __device__ __forceinline__ void zero_acc(f32x4 (&acc)[MT][NT]) {
#pragma unroll
    for (int m = 0; m < MT; ++m)
#pragma unroll
        for (int n = 0; n < NT; ++n) acc[m][n] = (f32x4){0.f, 0.f, 0.f, 0.f};
}

namespace pg8 {
#define PG8_LAS __attribute__((address_space(3)))
constexpr int BM = 256, BK = 64, HALF = 128, HTB = HALF * BK * 2, STAGE_BYTES = 8 * HTB;
__device__ __forceinline__ int lds_byte(int r, int c) { const int st = (r >> 4) * 2 + (c >> 5), rr = r & 15, cc = c & 31, ob = rr * 64 + cc * 2; return st * 1024 + (ob ^ (((ob >> 9) & 1) << 5)); }
__device__ __forceinline__ void stage_rc(int b, int& R, int& C) { const int st = b / 1024, sb = b % 1024, swz = sb ^ (((sb >> 9) & 1) << 5); R = (st >> 1) * 16 + swz / 64; C = (st & 1) * 32 + (swz % 64) / 2; }
__device__ __forceinline__ int perm32(int rho) { const int n = rho >> 4, i = rho & 15; return 8 * (i >> 2) + 4 * n + (i & 3); }
struct Unit { int pm, pn, tag; const char* A; const char* B; };
__device__ __forceinline__ unsigned cvt_pk_bf16(float lo, float hi) { unsigned r; asm volatile("v_cvt_pk_bf16_f32 %0, %1, %2" : "=v"(r) : "v"(lo), "v"(hi)); return r; }
__device__ __forceinline__ bool tile_order(int L, int nM, int nN, int& pm, int& pn) {
    const int nwg = nM * nN; if (L >= nwg) return false;
    int wgid = L; { const int q = nwg / 8, r = nwg % 8, xcd = wgid % 8, off = wgid / 8; wgid = (xcd < r ? xcd * (q + 1) : r * (q + 1) + (xcd - r) * q) + off; }
    const int nig = 8 * nN, gid = wgid / nig, fm = gid * 8, gsz = (nM - fm) < 8 ? (nM - fm) : 8;
    pm = fm + ((wgid % nig) % gsz); pn = (wgid % nig) / gsz; return true;
}
template <class Epi, class Sched>
__device__ __forceinline__ void gemm_phase(PG8_LAS unsigned char* lds, const int tid, const int K, const int lda, const int ldb, const Sched& S, const Epi& E) {
    const int wid = __builtin_amdgcn_readfirstlane(tid >> 6), lane = tid & 63, wr = wid >> 2, wc = wid & 3, fr = lane & 15, fq = lane >> 4;
    const int nt = K / BK;
    unsigned voffA[2], voffB[2];
#pragma unroll
    for (int i = 0; i < 2; ++i) { int R, C; stage_rc(tid * 16 + i * 8192, R, C); const int Rb = Epi::PERM ? ((R & ~31) + perm32(R & 31)) : R;
        voffA[i] = (unsigned)(R * lda + C) * 2u; voffB[i] = (unsigned)(Rb * ldb + C) * 2u; }
    const size_t kstep = (size_t)(BK * 2), hstepA = (size_t)HALF * lda * 2, hstepB = (size_t)HALF * ldb * 2;
    const unsigned ldsw = (unsigned)wid * 1024u;
    const int aoff = lds_byte(wr * 64 + fr, fq * 8), boff = lds_byte(wc * 32 + fr, fq * 8);
#define PG8_SA(b, h) (((b) * 2 + (h)) * HTB)
#define PG8_SB(b, h) ((4 + (b) * 2 + (h)) * HTB)
#define PG8_STAGE(bufoff, gbase, voff) do { _Pragma("unroll") for (int _i = 0; _i < 2; ++_i) \
        __builtin_amdgcn_global_load_lds((const unsigned*)((const char*)(gbase) + (voff)[_i]), (PG8_LAS unsigned*)(lds + (bufoff) + ldsw + _i * 8192), 16, 0, 0); } while (0)
#define PG8_LDA(dst, b, h) do { _Pragma("unroll") for (int m = 0; m < 4; ++m) _Pragma("unroll") for (int k = 0; k < 2; ++k) dst[m][k] = *(const PG8_LAS bf16x8*)(lds + PG8_SA(b, h) + aoff + m * 2048 + k * 1024); } while (0)
#define PG8_LDB(dst, b, h) do { _Pragma("unroll") for (int n = 0; n < 2; ++n) _Pragma("unroll") for (int k = 0; k < 2; ++k) dst[n][k] = *(const PG8_LAS bf16x8*)(lds + PG8_SB(b, h) + boff + n * 2048 + k * 1024); } while (0)
#define PG8_MMA(ai, bj, At, Bt) do { __builtin_amdgcn_s_setprio(1); _Pragma("unroll") for (int m = 0; m < 4; ++m) _Pragma("unroll") for (int n = 0; n < 2; ++n) _Pragma("unroll") for (int k = 0; k < 2; ++k) \
        acc[ai][bj][m][n] = __builtin_amdgcn_mfma_f32_16x16x32_bf16(Bt[n][k], At[m][k], acc[ai][bj][m][n], 0, 0, 0); __builtin_amdgcn_s_setprio(0); } while (0)
#define PG8_WAIT_V(n) asm volatile("s_waitcnt vmcnt(" #n ")" ::: "memory")
#define PG8_WAIT_L(n) asm volatile("s_waitcnt lgkmcnt(" #n ")" ::: "memory")
#define PG8_BAR __builtin_amdgcn_s_barrier()
#define PG8_SCHED __builtin_amdgcn_sched_barrier(0)
    Unit cur, nxt; int ui = 0;
    if (!S.next(0, cur)) return;
    f32x4 acc[2][2][4][2];
#pragma unroll
    for (int a = 0; a < 2; ++a)
#pragma unroll
        for (int b = 0; b < 2; ++b)
#pragma unroll
            for (int m = 0; m < 4; ++m)
#pragma unroll
                for (int n = 0; n < 2; ++n) acc[a][b][m][n] = (f32x4){0.f, 0.f, 0.f, 0.f};
    bf16x8 At[4][2], B0[2][2], B1[2][2];
    const char* cA = cur.A; const char* cB = cur.B;
    PG8_STAGE(PG8_SB(0, 0), cB, voffB); PG8_STAGE(PG8_SA(0, 0), cA, voffA); PG8_STAGE(PG8_SB(0, 1), cB + hstepB, voffB); PG8_STAGE(PG8_SA(0, 1), cA + hstepA, voffA);
    if (wr == 1) PG8_BAR;
    PG8_WAIT_V(4); PG8_BAR;
    PG8_STAGE(PG8_SB(1, 0), cB + kstep, voffB); PG8_STAGE(PG8_SA(1, 0), cA + kstep, voffA); PG8_STAGE(PG8_SB(1, 1), cB + hstepB + kstep, voffB);
    PG8_WAIT_V(6); PG8_BAR;
    for (;;) {
        const bool has_next = S.next(ui + 1, nxt);
        const char* nA = has_next ? nxt.A : cA; const char* nB = has_next ? nxt.B : cB;
        for (int t = 0; t < nt; t += 2) {
            const bool last = (t == nt - 2);
            const char* a1 = cA + (size_t)(t + 1) * kstep;
            const char* a2 = last ? nA : cA + (size_t)(t + 2) * kstep; const char* b2 = last ? nB : cB + (size_t)(t + 2) * kstep;
            const char* a3 = a2 + kstep; const char* b3 = b2 + kstep;
            PG8_LDB(B0, 0, 0); PG8_SCHED; PG8_LDA(At, 0, 0); PG8_STAGE(PG8_SA(1, 1), a1 + hstepA, voffA);
            PG8_WAIT_L(8); PG8_BAR; PG8_WAIT_L(0); PG8_MMA(0, 0, At, B0); PG8_BAR; PG8_SCHED;
            PG8_LDB(B1, 0, 1); PG8_STAGE(PG8_SB(0, 0), b2, voffB);
            PG8_BAR; PG8_WAIT_L(0); PG8_MMA(0, 1, At, B1); PG8_BAR;
            PG8_LDA(At, 0, 1); PG8_STAGE(PG8_SA(0, 0), a2, voffA);
            PG8_BAR; PG8_WAIT_L(0); PG8_MMA(1, 0, At, B0); PG8_BAR; PG8_SCHED;
            PG8_STAGE(PG8_SB(0, 1), b2 + hstepB, voffB);
            PG8_WAIT_V(6); PG8_BAR; PG8_MMA(1, 1, At, B1); PG8_BAR;
            PG8_LDB(B0, 1, 0); PG8_SCHED; PG8_LDA(At, 1, 0); PG8_STAGE(PG8_SA(0, 1), a2 + hstepA, voffA);
            PG8_WAIT_L(8); PG8_BAR; PG8_WAIT_L(0); PG8_MMA(0, 0, At, B0); PG8_BAR; PG8_SCHED;
            PG8_LDB(B1, 1, 1); PG8_STAGE(PG8_SB(1, 0), b3, voffB);
            PG8_BAR; PG8_WAIT_L(0); PG8_MMA(0, 1, At, B1); PG8_BAR;
            PG8_LDA(At, 1, 1); PG8_STAGE(PG8_SA(1, 0), a3, voffA);
            PG8_BAR; PG8_WAIT_L(0); PG8_MMA(1, 0, At, B0); PG8_BAR; PG8_SCHED;
            PG8_STAGE(PG8_SB(1, 1), b3 + hstepB, voffB);
            PG8_WAIT_V(6); PG8_BAR; PG8_MMA(1, 1, At, B1); PG8_BAR;
        }
        const bool keep = E(acc, cur, wr, wc, fr, fq);
        if (!has_next) break;
        if (!keep) {
#pragma unroll
            for (int a = 0; a < 2; ++a)
#pragma unroll
                for (int b = 0; b < 2; ++b)
#pragma unroll
                    for (int m = 0; m < 4; ++m)
#pragma unroll
                        for (int n = 0; n < 2; ++n) acc[a][b][m][n] = (f32x4){0.f, 0.f, 0.f, 0.f};
        }
        cur = nxt; cA = nA; cB = nB; ++ui;
    }
    PG8_WAIT_V(0);
    if (wr == 0) PG8_BAR;
    PG8_BAR;
#undef PG8_SA
#undef PG8_SB
#undef PG8_STAGE
#undef PG8_LDA
#undef PG8_LDB
#undef PG8_MMA
#undef PG8_WAIT_V
#undef PG8_WAIT_L
#undef PG8_BAR
#undef PG8_SCHED
}
}

__device__ __forceinline__ void tconv_tile(const float* src, int ld_src, int nvalid, bf16_t* dst, int ld_dst, int tid) {
    float* t = (float*)smem;
    { const int r = tid >> 3, c0 = (tid & 7) * 8; float v[8];
      if (nvalid == 64) { const f32x4 a0 = *(const f32x4*)(src + (size_t)r * ld_src + c0), a1 = *(const f32x4*)(src + (size_t)r * ld_src + c0 + 4);
          v[0] = a0[0]; v[1] = a0[1]; v[2] = a0[2]; v[3] = a0[3]; v[4] = a1[0]; v[5] = a1[1]; v[6] = a1[2]; v[7] = a1[3]; }
      else {
#pragma unroll
          for (int j = 0; j < 8; ++j) { const int c = c0 + j; v[j] = (c < nvalid) ? src[(size_t)r * ld_src + c] : 0.f; } }
#pragma unroll
      for (int j = 0; j < 8; ++j) t[(c0 + j) * 65 + r] = v[j]; }
    __syncthreads();
    { const int n = tid >> 3, k0 = (tid & 7) * 8; const float* p = t + n * 65 + k0;
      u32x4 w; w.x = pack2(p[0], p[1]); w.y = pack2(p[2], p[3]); w.z = pack2(p[4], p[5]); w.w = pack2(p[6], p[7]);
      *(u32x4*)(dst + (size_t)n * ld_dst + k0) = w; }
    __syncthreads();
}

__device__ __forceinline__ void phase_prep(ArgsRef a, int l, int tid, int bid, int G) {
    unsigned char* ws = a.ws;
    bf16_t* WIN = (bf16_t*)(ws + OFF_WIN); bf16_t* WQKV = (bf16_t*)(ws + OFF_WQKV); bf16_t* WGLU = (bf16_t*)(ws + OFF_WGLU);
    bf16_t* WB = (bf16_t*)(ws + OFF_WB); bf16_t* WOUT = (bf16_t*)(ws + OFF_WOUT);
    for (int u = bid; u < 2624; u += G) {
        const float* src; int lds_ = 0, nvalid = 64, ldd = 0; bf16_t* dst;
        if (u < 1728) { const int nt = u / 16, kt = u % 16, p0 = nt * 64; int sc;
            if (p0 < 1024) sc = p0; else if (p0 < 6656) sc = p0 + 8; else if (p0 == 6656) { sc = 1024; nvalid = 8; } else { sc = 0; nvalid = 0; }
            src = a.in[1] + (size_t)l * 1024 * INW + (size_t)(kt * 64) * INW + sc; lds_ = INW; dst = WIN + (size_t)p0 * 1024 + kt * 64; ldd = 1024; }
        else if (u < 1920) { const int v = u - 1728, nt = v / 8, kt = v % 8, which = nt / 8, h = (nt % 8) / 2;
            if ((kt >> 1) != h) nvalid = 0;
            src = a.in[4 + which] + (size_t)(l * 4 + h) * 128 * 128 + ((kt & 1) * 64) * 128 + (nt & 1) * 64; lds_ = 128; dst = WQKV + (size_t)(nt * 64) * 512 + kt * 64; ldd = 512; }
        else if (u < 1984) { const int v = u - 1920, nt = v / 8, kt = v % 8;
            src = a.in[18] + (size_t)l * 512 * 512 + (kt * 64) * 512 + nt * 64; lds_ = 512; dst = WGLU + (size_t)(nt * 64) * 512 + kt * 64; ldd = 512; }
        else if (u < 2368) { const int v = u - 1984, b = v / 128, w = v % 128, nt = w / 8, kt = w % 8;
            src = a.in[21 + b] + (size_t)l * 512 * 1024 + (size_t)(kt * 64) * 1024 + nt * 64; lds_ = 1024; dst = WB + (size_t)b * 1024 * 512 + (size_t)(nt * 64) * 512 + kt * 64; ldd = 512; }
        else { const int v = u - 2368, nt = v / 16, kt = v % 16;
            src = a.in[24] + (size_t)l * 1024 * 1024 + (size_t)(kt * 64) * 1024 + nt * 64; lds_ = 1024; dst = WOUT + (size_t)(nt * 64) * 1024 + kt * 64; ldd = 1024; }
        tconv_tile(src, lds_, nvalid, dst, ldd, tid);
    }
    float* ABAR = (float*)(ws + OFF_ABAR); bf16_t* BBT = (bf16_t*)(ws + OFF_BBT); bf16_t* CCT = (bf16_t*)(ws + OFF_CCT);
    for (int i = bid * 512 + tid; i < 2048; i += G * 512) {
        const int g = i / 64, p = i % 64; const size_t gp = (size_t)(l * 32 + g) * 64 + p;
        const float lr = fminf(a.in[10][gp], -1e-4f), li = a.in[11][gp], dt = expf(a.in[12][l * 32 + g]);
        const float mag = expf(lr * dt), abr = mag * cosf(li * dt), abi = mag * sinf(li * dt);
        const float nr = abr - 1.0f, den = lr * lr + li * li, cr = (nr * lr + abi * li) / den, ci = (abi * lr - nr * li) / den;
        ABAR[(g * 64 + p) * 2] = abr; ABAR[(g * 64 + p) * 2 + 1] = abi;
        for (int c = 0; c < 16; ++c) { const float br = a.in[13][gp * 16 + c], bi = a.in[14][gp * 16 + c];
            BBT[(size_t)(g * 128 + p) * 16 + c] = f2bf(cr * br - ci * bi); BBT[(size_t)(g * 128 + 64 + p) * 16 + c] = f2bf(cr * bi + ci * br);
            const size_t ci_ = ((size_t)(l * 32 + g) * 16 + c) * 64 + p;
            CCT[(size_t)(g * 16 + c) * 128 + p] = f2bf(a.in[15][ci_]); CCT[(size_t)(g * 16 + c) * 128 + 64 + p] = f2bf(-a.in[16][ci_]); }
    }
    if (l == 0) { float* RWT = (float*)(ws + OFF_RWT); const float* RW = a.in[29]; for (int i = bid * 512 + tid; i < 32 * 1024; i += G * 512) RWT[i] = RW[(i & 1023) * 32 + (i >> 10)]; }
    if (l == 0) { bf16_t* XB = (bf16_t*)(ws + OFF_XB); const float* x = a.in[0];
        for (size_t i = (size_t)bid * 512 + tid; i < (size_t)T * 1024 / 8; i += (size_t)G * 512) {
            const f32x4 v0 = *(const f32x4*)(x + i * 8), v1 = *(const f32x4*)(x + i * 8 + 4);
            u32x4 w; w.x = pack2(v0[0], v0[1]); w.y = pack2(v0[2], v0[3]); w.z = pack2(v1[0], v1[1]); w.w = pack2(v1[2], v1[3]); *(u32x4*)(XB + i * 8) = w; } }
}

__device__ __forceinline__ void phase_prepx(ArgsRef a, int l, int tid, int bid, int G, int u_lo, int u_hi) {
    bf16_t* WGU = (bf16_t*)(a.ws + OFF_WGU); bf16_t* WD = (bf16_t*)(a.ws + OFF_WD);
    for (int u = u_lo + bid; u < u_hi; u += G) {
        const float* src; int lds_, ldd; bf16_t* dst;
        if (u < 4096) { const int up = u >= 2048, v = u & 2047, e = v / 64, w = v % 64, nt = w / 16, kt = w % 16, j0 = nt * 64, drow = (j0 / 128) * 256 + (j0 % 128) + up * 128;
            src = a.in[31 + up] + ((size_t)(l * 32 + e) * 1024 + kt * 64) * 256 + nt * 64; lds_ = 256; dst = WGU + ((size_t)e * 512 + drow) * 1024 + kt * 64; ldd = 1024; }
        else { const int v = u - 4096, e = v / 64, w = v % 64, nt = w / 4, kt = w % 4;
            src = a.in[33] + ((size_t)(l * 32 + e) * 256 + kt * 64) * 1024 + nt * 64; lds_ = 1024; dst = WD + ((size_t)e * 1024 + nt * 64) * 256 + kt * 64; ldd = 256; }
        tconv_tile(src, lds_, 64, dst, ldd, tid);
    }
}

constexpr int GL_RQ = 0, GL_RK = 17408, GL_VT = 34816, GL_RO = 57856, GL_RX = 75264, GL_KT = 92672, GL_PS = 102912, GL_SC1 = 105472, GL_SC2 = 105984, GL_GT = 106496, GL_OS = 108544, GL_LFS = 117248, GL_DNS = 117504;
template <int MODE, int PASS>
__device__ __forceinline__ void gla_item(ArgsRef a, int l, int h, int sg, int tid, int lane, int wave) {
    unsigned char* ws = a.ws;
    const bf16_t* Z = (const bf16_t*)(ws + OFF_Z); const bf16_t* Qg = (const bf16_t*)(ws + OFF_Q); const bf16_t* Kg = (const bf16_t*)(ws + OFF_KH); const bf16_t* Vg = (const bf16_t*)(ws + OFF_V); const bf16_t* XCg = (const bf16_t*)(ws + OFF_XC);
    const float* LF = (const float*)(ws + OFF_LF);
    float* Eg = (float*)(ws + (MODE == 0 ? OFF_EM : OFF_EH)); float* Gg = (float*)(ws + (MODE == 0 ? OFF_GM : OFF_GH)); float* EX = (float*)(ws + OFF_EMX);
    bf16_t* Yg = (bf16_t*)(ws + (MODE == 0 ? OFF_OM : OFF_OH));
    bf16_t* KT = (bf16_t*)(smem + GL_KT); bf16_t* PS = (bf16_t*)(smem + GL_PS);
    float* SC1 = (float*)(smem + GL_SC1); float* SC2 = (float*)(smem + GL_SC2); float* GT = (float*)(smem + GL_GT); bf16_t* OS = (bf16_t*)(smem + GL_OS); float* DNS = (float*)(smem + GL_DNS);
    const int r = lane & 15, q = lane >> 4, grp = tid >> 7, d = tid & 127, tok = tid >> 4, c8 = (tid & 15) * 8;
    const bool xw = (MODE == 0) && (wave == 0);
    float lb = 0.f;
    if (MODE == 1 && l == 1) { const float h0 = a.in[19][h * 128 + d], h1 = a.in[19][512 + h * 128 + d]; lb = 1.0f / (1.0f + expf(h0 - h1)); }
    f32x4 S[8], SX[8];
#pragma unroll
    for (int i = 0; i < 8; ++i) { S[i] = (f32x4){0.f, 0.f, 0.f, 0.f}; SX[i] = (f32x4){0.f, 0.f, 0.f, 0.f}; }
    if (PASS == 2) {
#pragma unroll
        for (int i = 0; i < 8; ++i)
#pragma unroll
            for (int g = 0; g < 4; ++g) { const size_t row = (size_t)(sg * 4 + h) * 128 + 16 * i + 4 * q + g; S[i][g] = Eg[row * 128 + 16 * wave + r]; if (xw) SX[i][g] = EX[row * 16 + r]; }
    }
    const bf16x8 z8 = (bf16x8){0, 0, 0, 0, 0, 0, 0, 0};
    bf16x8 rq = z8, rk = z8, rv = z8, ro = z8, rx = z8; float lfv = 0.f;
#define GLA_FETCH(t0_) do { const size_t tk = (size_t)((t0_) + tok); \
        if (MODE == 1) { const bf16_t* zp = Z + tk * NZ + h * 128 + c8; if (PASS == 2) { rq = *(const bf16x8*)(zp + 1536); ro = *(const bf16x8*)(zp + 3072); } rk = *(const bf16x8*)(zp + 2048); rv = *(const bf16x8*)(zp + 2560); } \
        else { const size_t o_ = tk * 512 + h * 128 + c8; if (PASS == 2) { rq = *(const bf16x8*)(Qg + o_); ro = *(const bf16x8*)(Z + tk * NZ + 512 + h * 128 + c8); rx = *(const bf16x8*)(XCg + o_); } \
               rk = *(const bf16x8*)(Kg + o_); rv = *(const bf16x8*)(Vg + o_); if (tid < 32) lfv = LF[((t0_) + tid) * 4 + h]; } } while (0)
    GLA_FETCH(sg * GSEGLEN);
    float sk8[8], nw8[8];
#pragma unroll
    for (int j = 0; j < 8; ++j) { sk8[j] = (MODE == 0 && PASS == 2) ? a.in[9][l * 512 + h * 128 + c8 + j] : 0.f; nw8[j] = (MODE == 1 && PASS == 2) ? a.in[20][l * 512 + h * 128 + c8 + j] : 0.f; }
    __syncthreads();
    if (MODE == 0) { for (int i = tid; i < 2 * 16 * 40; i += 512) { const int b = i / 640, k = i % 640; ((bf16_t*)(smem + GL_VT + b * 11520))[128 * 40 + k] = (k < 32) ? (bf16_t)0x3F80 : (bf16_t)0; } }
#define GLA_STORE(tprev, pb) do { const bf16x8 o8 = *(const bf16x8*)(OS + tok * 136 + c8); const bf16x8 p8 = *(const bf16x8*)((const bf16_t*)(smem + GL_RO + (pb) * 8704) + tok * 136 + c8); float y[8]; \
        if (MODE == 0) { const bf16x8 x8 = *(const bf16x8*)((const bf16_t*)(smem + GL_RX + (pb) * 8704) + tok * 136 + c8); const float di = __builtin_amdgcn_rcpf(fmaxf(fabsf(DNS[tok]), 1.0f)); \
            _Pragma("unroll") for (int j = 0; j < 8; ++j) y[j] = sigmoidf_(bf2f((bf16_t)p8[j])) * (bf2f((bf16_t)o8[j]) * di) + sk8[j] * bf2f((bf16_t)x8[j]); } \
        else { float ov[8], ss = 0.f; _Pragma("unroll") for (int j = 0; j < 8; ++j) { ov[j] = bf2f((bf16_t)o8[j]); ss += ov[j] * ov[j]; } \
            ss += __shfl_xor(ss, 1); ss += __shfl_xor(ss, 2); ss += __shfl_xor(ss, 4); ss += __shfl_xor(ss, 8); const float rinv = rsqrtf(ss * (1.0f / 128.0f) + 1e-6f); \
            _Pragma("unroll") for (int j = 0; j < 8; ++j) y[j] = ov[j] * rinv * nw8[j] * siluf_(bf2f((bf16_t)p8[j])); } \
        u32x4 w_; w_.x = pack2(y[0], y[1]); w_.y = pack2(y[2], y[3]); w_.z = pack2(y[4], y[5]); w_.w = pack2(y[6], y[7]); *(u32x4*)(Yg + (size_t)((tprev) + tok) * 512 + h * 128 + c8) = w_; } while (0)
    float runb = 0.f;
    for (int ci = 0; ci < GSEGLEN / 32; ++ci) {
        const int t0 = sg * GSEGLEN + ci * 32, buf = ci & 1;
        bf16_t* RQ = (bf16_t*)(smem + GL_RQ + buf * 8704); bf16_t* RK = (bf16_t*)(smem + GL_RK + buf * 8704); bf16_t* VT = (bf16_t*)(smem + GL_VT + buf * 11520);
        float* LFS = (float*)(smem + GL_LFS + buf * 128);
        if (PASS == 2) { *(bf16x8*)(RQ + tok * 136 + c8) = rq; *(bf16x8*)((bf16_t*)(smem + GL_RO + buf * 8704) + tok * 136 + c8) = ro; if (MODE == 0) *(bf16x8*)((bf16_t*)(smem + GL_RX + buf * 8704) + tok * 136 + c8) = rx; }
        *(bf16x8*)(RK + tok * 136 + c8) = rk;
#pragma unroll
        for (int j = 0; j < 8; ++j) VT[(c8 + j) * 40 + tok] = (bf16_t)rv[j];
        if (MODE == 0 && tid < 32) LFS[tid] = lfv;
        if (ci + 1 < GSEGLEN / 32) GLA_FETCH(t0 + 32);
        __syncthreads();
        float lg[8], kv[8];
#pragma unroll
        for (int j = 0; j < 8; ++j) { const float kr = bf2f(RK[(grp * 8 + j) * 136 + d]);
            if (MODE == 1) { const float f = lb + (1.0f - lb) * sigmoidf_(kr); lg[j] = flog(f); kv[j] = 1.0f - f; } else { lg[j] = LFS[grp * 8 + j]; kv[j] = kr; } }
        float cs[8]; cs[0] = lg[0];
#pragma unroll
        for (int j = 1; j < 8; ++j) cs[j] = cs[j - 1] + lg[j];
        GT[grp * 128 + d] = cs[7];
        __syncthreads();
        if (PASS == 2 && ci > 0) GLA_STORE(t0 - 32, buf ^ 1);
        const float g0 = GT[d], g1 = GT[128 + d], g2 = GT[256 + d], g3 = GT[384 + d];
        const float off = grp == 0 ? 0.f : grp == 1 ? g0 : grp == 2 ? g0 + g1 : g0 + g1 + g2;
        const float bmid = g0 + g1, bL = bmid + g2 + g3;
        bf16_t ktv[8];
#pragma unroll
        for (int j = 0; j < 8; ++j) { const float bt = off + cs[j], ek = fexp(bmid - bt); const bf16_t kt = f2bf(kv[j] * ek); ktv[j] = kt;
            if (PASS == 2) { const float qr = bf2f(RQ[(grp * 8 + j) * 136 + d]); const float qq = (MODE == 1) ? siluf_(qr) : qr; RQ[(grp * 8 + j) * 136 + d] = f2bf(qq * __builtin_amdgcn_rcpf(ek)); RK[(grp * 8 + j) * 136 + d] = kt; } }
        { u32x4 w; w.x = ktv[0] | ((unsigned)ktv[1] << 16); w.y = ktv[2] | ((unsigned)ktv[3] << 16); w.z = ktv[4] | ((unsigned)ktv[5] << 16); w.w = ktv[6] | ((unsigned)ktv[7] << 16); *(u32x4*)(KT + d * 40 + grp * 8) = w; }
        if (grp == 0) { SC1[d] = fexp(bmid); SC2[d] = fexp(bL - bmid); runb += bL; }
        __syncthreads();
        if (PASS == 2) {
            if (wave < 4) {
                const int ti = (wave == 1 || wave == 2) ? 1 : 0, tj = (wave >= 2) ? 1 : 0;
                f32x4 p = (f32x4){0.f, 0.f, 0.f, 0.f};
                if (wave < 3) {
#pragma unroll
                    for (int kk = 0; kk < 4; ++kk) { const bf16x8 av = *(const bf16x8*)(RQ + (16 * ti + r) * 136 + 32 * kk + 8 * q); const bf16x8 bv = *(const bf16x8*)(RK + (16 * tj + r) * 136 + 32 * kk + 8 * q); p = MFMA16(av, bv, p); }
                }
#pragma unroll
                for (int g = 0; g < 4; ++g) { const int t = 16 * ti + 4 * q + g, s_ = 16 * tj + r; PS[t * 40 + s_] = (wave < 3 && s_ <= t) ? f2bf(p[g]) : (bf16_t)0; }
            }
            __syncthreads();
        }
        const bf16x8 bV = *(const bf16x8*)(VT + (16 * wave + r) * 40 + 8 * q);
        bf16x8 bV1 = bV; if (xw) bV1 = *(const bf16x8*)(VT + (128 + r) * 40 + 8 * q);
        f32x4 o[2], ox[2];
        o[0] = o[1] = ox[0] = ox[1] = (f32x4){0.f, 0.f, 0.f, 0.f};
#pragma unroll
        for (int kk = 0; kk < 4; ++kk) {
            const f32x4 sa = *(const f32x4*)(SC1 + 32 * kk + 4 * q), sb = *(const f32x4*)(SC1 + 32 * kk + 16 + 4 * q);
            S[2 * kk] *= sa; S[2 * kk + 1] *= sb;
            if (xw) { SX[2 * kk] *= sa; SX[2 * kk + 1] *= sb; }
            if (PASS == 2) {
                bf16x8 bS, bX;
#pragma unroll
                for (int g = 0; g < 4; ++g) { bS[g] = (short)f2bf(S[2 * kk][g]); bS[4 + g] = (short)f2bf(S[2 * kk + 1][g]); bX[g] = (short)f2bf(SX[2 * kk][g]); bX[4 + g] = (short)f2bf(SX[2 * kk + 1][g]); }
#pragma unroll
                for (int mt = 0; mt < 2; ++mt) { const bf16x4 lo = *(const bf16x4*)(RQ + (16 * mt + r) * 136 + 32 * kk + 4 * q), hi = *(const bf16x4*)(RQ + (16 * mt + r) * 136 + 32 * kk + 16 + 4 * q);
                    bf16x8 av; av[0] = lo[0]; av[1] = lo[1]; av[2] = lo[2]; av[3] = lo[3]; av[4] = hi[0]; av[5] = hi[1]; av[6] = hi[2]; av[7] = hi[3];
                    o[mt] = MFMA16(av, bS, o[mt]); if (xw) ox[mt] = MFMA16(av, bX, ox[mt]); }
            }
        }
        if (PASS == 2) {
#pragma unroll
            for (int mt = 0; mt < 2; ++mt) { const bf16x8 av = *(const bf16x8*)(PS + (16 * mt + r) * 40 + 8 * q); o[mt] = MFMA16(av, bV, o[mt]); if (xw) ox[mt] = MFMA16(av, bV1, ox[mt]);
#pragma unroll
                for (int g = 0; g < 4; ++g) { OS[(16 * mt + 4 * q + g) * 136 + 16 * wave + r] = f2bf(o[mt][g]); if (xw && r == 0) DNS[16 * mt + 4 * q + g] = ox[mt][g]; } }
        }
#pragma unroll
        for (int i = 0; i < 8; ++i) { const bf16x8 av = *(const bf16x8*)(KT + (16 * i + r) * 40 + 8 * q); const f32x4 s2 = *(const f32x4*)(SC2 + 16 * i + 4 * q);
            S[i] = MFMA16(av, bV, S[i]); S[i] *= s2;
            if (xw) { SX[i] = MFMA16(av, bV1, SX[i]); SX[i] *= s2; } }
    }
    if (PASS == 2) { __syncthreads(); GLA_STORE(sg * GSEGLEN + GSEGLEN - 32, 1); }
    if (PASS == 1) {
        float* ST = (float*)smem;
        __syncthreads();
#pragma unroll
        for (int i = 0; i < 8; ++i)
#pragma unroll
            for (int g = 0; g < 4; ++g) { ST[(16 * i + 4 * q + g) * 132 + 16 * wave + r] = S[i][g]; if (xw) EX[((size_t)(sg * 4 + h) * 128 + 16 * i + 4 * q + g) * 16 + r] = SX[i][g]; }
        __syncthreads();
#pragma unroll
        for (int k = 0; k < 8; ++k) { const int idx = tid + 512 * k, row = idx >> 5, c4 = (idx & 31) * 4; *(f32x4*)(Eg + ((size_t)(sg * 4 + h) * 128 + row) * 128 + c4) = *(const f32x4*)(ST + row * 132 + c4); }
        if (grp == 0) Gg[(size_t)(sg * 4 + h) * 128 + d] = expf(runb);
    }
#undef GLA_FETCH
#undef GLA_STORE
}

template <int PASS>
__device__ __forceinline__ void s5_item(ArgsRef a, int l, int g, int sg, int g0, int tid, int lane, int wave, int hsel) {
    unsigned char* ws = a.ws;
    const bf16_t* Z = (const bf16_t*)(ws + OFF_Z); const float* ABAR = (const float*)(ws + OFF_ABAR); const bf16_t* BBT = (const bf16_t*)(ws + OFF_BBT); const bf16_t* CCT = (const bf16_t*)(ws + OFF_CCT);
    float* ES = (float*)(ws + OFF_ES); bf16_t* YPRE = (bf16_t*)(ws + OFF_YPRE);
    float* BU = (float*)(smem + 70000 + (wave & 3) * 12800); bf16_t* X = (bf16_t*)(smem + 70000 + (wave & 3) * 12800 + 8448); bf16_t* YT = (bf16_t*)(smem + 70000 + 51200);
    const int r = lane & 15, q = lane >> 4, p = lane; const bool act = (wave >> 2) == hsel;
    const float ar = ABAR[(g * 64 + p) * 2], ai = ABAR[(g * 64 + p) * 2 + 1];
    const bf16x8 zero8 = (bf16x8){0, 0, 0, 0, 0, 0, 0, 0};
    bf16x8 bB[8], cB[4];
#pragma unroll
    for (int nt = 0; nt < 8; ++nt) bB[nt] = (q < 2) ? *(const bf16x8*)(BBT + (size_t)(g * 128 + 16 * nt + r) * 16 + 8 * q) : zero8;
#pragma unroll
    for (int kk = 0; kk < 4; ++kk) cB[kk] = (PASS == 2) ? *(const bf16x8*)(CCT + (size_t)(g * 16 + r) * 128 + 32 * kk + 8 * q) : zero8;
    float xr = 0.f, xi = 0.f;
    if (PASS == 2) { xr = ES[((size_t)(sg * 32 + g) * 64 + p) * 2]; xi = ES[((size_t)(sg * 32 + g) * 64 + p) * 2 + 1]; }
    const float dsk = a.in[17][l * 512 + 16 * g + r];
    for (int ci = 0; ci < SSEGLEN / 16; ++ci) {
        const int t0 = sg * SSEGLEN + ci * 16;
        if (act) {
            const bf16x8 av = (q < 2) ? *(const bf16x8*)(Z + (size_t)(t0 + r) * NZ + 1024 + 16 * g + 8 * q) : zero8;
#pragma unroll
            for (int nt = 0; nt < 8; ++nt) { f32x4 acc = (f32x4){0.f, 0.f, 0.f, 0.f}; acc = MFMA16(av, bB[nt], acc);
#pragma unroll
                for (int gg = 0; gg < 4; ++gg) BU[(4 * q + gg) * 132 + 16 * nt + r] = acc[gg]; }
            wave_sync();
#pragma unroll
            for (int t = 0; t < 16; ++t) { const float br = BU[t * 132 + p], bi = BU[t * 132 + 64 + p];
                const float nr = ar * xr - ai * xi + br, ni = ar * xi + ai * xr + bi; xr = nr; xi = ni;
                if (PASS == 2) { X[t * 136 + p] = f2bf(xr); X[t * 136 + 64 + p] = f2bf(xi); } }
            wave_sync();
            if (PASS == 2) {
                f32x4 acc = (f32x4){0.f, 0.f, 0.f, 0.f};
#pragma unroll
                for (int kk = 0; kk < 4; ++kk) { const bf16x8 xv = *(const bf16x8*)(X + r * 136 + 32 * kk + 8 * q); acc = MFMA16(xv, cB[kk], acc); }
#pragma unroll
                for (int gg = 0; gg < 4; ++gg) { const int t = t0 + 4 * q + gg, c = 16 * g + r; const float u = bf2f(Z[(size_t)t * NZ + 1024 + c]);
                    YT[(4 * q + gg) * 136 + 16 * wave + r] = f2bf(gelu_tanh(acc[gg] + dsk * u)); }
            }
        }
        if (PASS == 2) {
            __syncthreads();
            if (tid < 128) { const int row = tid >> 3, c8 = (tid & 7) * 8; *(u32x4*)(YPRE + (size_t)(t0 + row) * 512 + 16 * g0 + 64 * hsel + c8) = *(const u32x4*)(YT + row * 136 + 64 * hsel + c8); }
            __syncthreads();
        }
    }
    if (PASS == 1 && act) { ES[((size_t)(sg * 32 + g) * 64 + p) * 2] = xr; ES[((size_t)(sg * 32 + g) * 64 + p) * 2 + 1] = xi; }
}

__device__ __forceinline__ void phase_scan(ArgsRef a, int tid, int bid, int G) {
    unsigned char* ws = a.ws;
    const int NT = G * 512, gt = bid * 512 + tid;
    for (int i = gt; i < 2 * 65536 + 8192 + 2048; i += NT) {
        if (i < 2 * 65536) { const int m = i >> 16, el = i & 65535, hrow = el >> 7;
            float* E = (float*)(ws + (m == 0 ? OFF_EM : OFF_EH)); const float* Gd = (const float*)(ws + (m == 0 ? OFF_GM : OFF_GH));
            float cur = 0.f;
#pragma unroll 8
            for (int sg = 0; sg < GSEG; ++sg) { const float e = E[(size_t)sg * 65536 + el], g = Gd[sg * 512 + hrow]; E[(size_t)sg * 65536 + el] = cur; cur = g * cur + e; } }
        else if (i < 2 * 65536 + 8192) { const int el = i - 2 * 65536, hrow = el >> 4; float* E = (float*)(ws + OFF_EMX); const float* Gd = (const float*)(ws + OFF_GM);
            float cur = 0.f;
#pragma unroll 8
            for (int sg = 0; sg < GSEG; ++sg) { const float e = E[(size_t)sg * 8192 + el], g = Gd[sg * 512 + hrow]; E[(size_t)sg * 8192 + el] = cur; cur = g * cur + e; } }
        else { const int el = i - 2 * 65536 - 8192; float* E = (float*)(ws + OFF_ES); const float* ABAR = (const float*)(ws + OFF_ABAR);
            float pr = ABAR[el * 2], pi = ABAR[el * 2 + 1];
#pragma unroll
            for (int k = 0; k < 8; ++k) { const float nr = pr * pr - pi * pi, ni = 2.0f * pr * pi; pr = nr; pi = ni; }
            float xr = 0.f, xi = 0.f;
#pragma unroll 8
            for (int sg = 0; sg < SSEG; ++sg) { const float er = E[((size_t)sg * 2048 + el) * 2], ei = E[((size_t)sg * 2048 + el) * 2 + 1];
                E[((size_t)sg * 2048 + el) * 2] = xr; E[((size_t)sg * 2048 + el) * 2 + 1] = xi;
                const float nr = pr * xr - pi * xi + er, ni = pr * xi + pi * xr + ei; xr = nr; xi = ni; } }
    }
}

template <int PASS>
__device__ __forceinline__ void phase_mixers(ArgsRef a, int l, int tid, int lane, int wave, int bid, int G) {
    for (int it = bid; it < 4 * GSEG; it += G) gla_item<0, PASS>(a, l, it % 4, it / 4, tid, lane, wave);
    asm volatile("" ::: "memory");
    for (int it = bid + ((4 * GSEG - bid % G) % G + G) % G * 0; it < 2 * 4 * GSEG; it += G) { if (it >= 4 * GSEG) gla_item<1, PASS>(a, l, (it - 4 * GSEG) % 4, (it - 4 * GSEG) / 4, tid, lane, wave); }
    __syncthreads();
    for (int it0 = bid * 8; it0 < 32 * SSEG; it0 += G * 8)
        for (int half = 0; half < 2; ++half) { const int it = it0 + wave; s5_item<PASS>(a, l, it % 32, it / 32, it0 % 32, tid, lane, wave, half); __syncthreads(); }
}

__device__ __forceinline__ void phase_post(ArgsRef a, int l, int lane, int gw, int GW) {
    const bf16_t* Z = (const bf16_t*)(a.ws + OFF_Z); const bf16_t* XC = (const bf16_t*)(a.ws + OFF_XC);
    bf16_t* OM = (bf16_t*)(a.ws + OFF_OM); bf16_t* OH = (bf16_t*)(a.ws + OFF_OH); const float* DEN = (const float*)(a.ws + OFF_DEN);
    const int c0 = lane * 8, hd = lane >> 4;
    float skp[8], nw[8];
#pragma unroll
    for (int j = 0; j < 8; ++j) { skp[j] = a.in[9][l * 512 + c0 + j]; nw[j] = a.in[20][l * 512 + c0 + j]; }
    for (int tb = gw * 4; tb < T; tb += GW * 4) {
        bf16x8 om[4], op[4], xc[4], oh[4], gp[4]; float dn[4];
#pragma unroll
        for (int k = 0; k < 4; ++k) { const size_t t = tb + k; om[k] = *(const bf16x8*)(OM + t * 512 + c0); op[k] = *(const bf16x8*)(Z + t * NZ + 512 + c0); xc[k] = *(const bf16x8*)(XC + t * 512 + c0);
            oh[k] = *(const bf16x8*)(OH + t * 512 + c0); gp[k] = *(const bf16x8*)(Z + t * NZ + 3072 + c0); dn[k] = DEN[hd * T + t]; }
#pragma unroll
        for (int k = 0; k < 4; ++k) { const size_t t = tb + k; const float di = __builtin_amdgcn_rcpf(fmaxf(fabsf(dn[k]), 1.0f)); float y[8], ov[8], ss = 0.f;
#pragma unroll
            for (int j = 0; j < 8; ++j) { y[j] = sigmoidf_(bf2f((bf16_t)op[k][j])) * (bf2f((bf16_t)om[k][j]) * di) + skp[j] * bf2f((bf16_t)xc[k][j]); ov[j] = bf2f((bf16_t)oh[k][j]); ss += ov[j] * ov[j]; }
            u32x4 w; w.x = pack2(y[0], y[1]); w.y = pack2(y[2], y[3]); w.z = pack2(y[4], y[5]); w.w = pack2(y[6], y[7]); *(u32x4*)(OM + t * 512 + c0) = w;
            ss += __shfl_xor(ss, 1); ss += __shfl_xor(ss, 2); ss += __shfl_xor(ss, 4); ss += __shfl_xor(ss, 8);
            const float rinv = rsqrtf(ss * (1.0f / 128.0f) + 1e-6f);
#pragma unroll
            for (int j = 0; j < 8; ++j) y[j] = ov[j] * rinv * nw[j] * siluf_(bf2f((bf16_t)gp[k][j]));
            u32x4 x; x.x = pack2(y[0], y[1]); x.y = pack2(y[2], y[3]); x.z = pack2(y[4], y[5]); x.w = pack2(y[6], y[7]); *(u32x4*)(OH + t * 512 + c0) = x; }
    }
}

__device__ __forceinline__ void ln_row(f32x4 (&v)[4], const float* gam, const float* bet, int lane) {
    float s = 0.f;
#pragma unroll
    for (int j = 0; j < 4; ++j) s += (v[j][0] + v[j][1]) + (v[j][2] + v[j][3]);
#pragma unroll
    for (int o = 32; o >= 1; o >>= 1) s += __shfl_xor(s, o);
    const float mean = s * (1.0f / 1024.0f); float qv = 0.f;
#pragma unroll
    for (int j = 0; j < 4; ++j) { const f32x4 dd = v[j] - mean; qv += (dd[0] * dd[0] + dd[1] * dd[1]) + (dd[2] * dd[2] + dd[3] * dd[3]); }
#pragma unroll
    for (int o = 32; o >= 1; o >>= 1) qv += __shfl_xor(qv, o);
    const float rstd = rsqrtf(qv * (1.0f / 1024.0f) + 1e-5f);
#pragma unroll
    for (int j = 0; j < 4; ++j) { const f32x4 gg = *(const f32x4*)(gam + 256 * j + 4 * lane), bb = *(const f32x4*)(bet + 256 * j + 4 * lane); v[j] = (v[j] - mean) * rstd * gg + bb; }
}

__device__ __forceinline__ void phase_ln1r(ArgsRef a, int l, int tid, int lane, int wave, int bid, int G) {
    float* XF = a.out; bf16_t* XB = (bf16_t*)(a.ws + OFF_XB);
    int* TOKE = (int*)(a.ws + OFF_TOKE); float* TOKG = (float*)(a.ws + OFF_TOKG); unsigned* HIST = (unsigned*)(a.ws + OFF_HIST);
    const float* RWT = (const float*)(a.ws + OFF_RWT); const float* RB = a.in[30];
    float* LG = (float*)(smem + wave * 4096);
    int* TE = (int*)(smem + wave * 4096 + 2304); float* TG = (float*)(smem + wave * 4096 + 2432); unsigned* HS = (unsigned*)(smem + wave * 4096 + 2560);
    const int r = lane & 15, q = lane >> 4, rs = lane >> 5, e = lane & 31;
    for (int tw = bid * 8 + wave; tw < T / 16; tw += G * 8) {
        const int t0 = tw * 16;
        for (int rb = 0; rb < 16; rb += 4) { f32x4 v[4][4];
#pragma unroll
            for (int k = 0; k < 4; ++k)
#pragma unroll
                for (int j = 0; j < 4; ++j) v[k][j] = *(const f32x4*)(XF + (size_t)(t0 + rb + k) * 1024 + 256 * j + 4 * lane);
#pragma unroll
            for (int k = 0; k < 4; ++k) { const int t = t0 + rb + k; ln_row(v[k], a.in[25] + l * 1024, a.in[26] + l * 1024, lane);
#pragma unroll
                for (int j = 0; j < 4; ++j) { *(f32x4*)(XF + (size_t)t * 1024 + 256 * j + 4 * lane) = v[k][j];
                    u32x2 w; w.x = pack2(v[k][j][0], v[k][j][1]); w.y = pack2(v[k][j][2], v[k][j][3]); *(u32x2*)(XB + (size_t)t * 1024 + 256 * j + 4 * lane) = w; } } }
        if (lane < 32) HS[lane] = 0u;
        asm volatile("s_waitcnt vmcnt(0) lgkmcnt(0)" ::: "memory"); __builtin_amdgcn_wave_barrier();
        f32x4 acc0 = (f32x4){0.f, 0.f, 0.f, 0.f}, acc1 = acc0;
        const float* xa = XF + (size_t)(t0 + r) * 1024 + 4 * q; const float* w0 = RWT + (size_t)r * 1024 + 4 * q; const float* w1 = RWT + (size_t)(16 + r) * 1024 + 4 * q;
#pragma unroll 4
        for (int s = 0; s < 64; ++s) { const f32x4 av = *(const f32x4*)(xa + 16 * s), b0 = *(const f32x4*)(w0 + 16 * s), b1 = *(const f32x4*)(w1 + 16 * s);
#pragma unroll
            for (int j = 0; j < 4; ++j) { acc0 = __builtin_amdgcn_mfma_f32_16x16x4f32(av[j], b0[j], acc0, 0, 0, 0); acc1 = __builtin_amdgcn_mfma_f32_16x16x4f32(av[j], b1[j], acc1, 0, 0, 0); } }
#pragma unroll
        for (int g = 0; g < 4; ++g) { LG[(4 * q + g) * 33 + r] = acc0[g]; LG[(4 * q + g) * 33 + 16 + r] = acc1[g]; }
        wave_sync();
        for (int pp = 0; pp < 8; ++pp) {
            const float lg = LG[(2 * pp + rs) * 33 + e];
            const float s = sigmoidf_(lg), sb = s + RB[e];
            float v4[4];
#pragma unroll
            for (int i = 0; i < 4; ++i) v4[i] = __shfl(sb, (lane & ~3) + i);
            int i1 = 0;
#pragma unroll
            for (int i = 1; i < 4; ++i) if (v4[i] > v4[i1]) i1 = i;
            int i2 = (i1 == 0) ? 1 : 0;
#pragma unroll
            for (int i = 0; i < 4; ++i) if (i != i1 && i != i2 && v4[i] > v4[i2]) i2 = i;
            float gs = v4[i1] + v4[i2]; int gid = e >> 2;
#pragma unroll
            for (int o = 4; o <= 16; o <<= 1) { const float os = __shfl_xor(gs, o); const int og = __shfl_xor(gid, o); if (os > gs || (os == gs && og < gid)) { gs = os; gid = og; } }
            float sv[4], sbv[4];
#pragma unroll
            for (int i = 0; i < 4; ++i) { sbv[i] = __shfl(sb, (lane & 32) + gid * 4 + i); sv[i] = __shfl(s, (lane & 32) + gid * 4 + i); }
            int j1 = 0;
#pragma unroll
            for (int i = 1; i < 4; ++i) if (sbv[i] > sbv[j1]) j1 = i;
            int j2 = (j1 == 0) ? 1 : 0;
#pragma unroll
            for (int i = 0; i < 4; ++i) if (i != j1 && i != j2 && sbv[i] > sbv[j2]) j2 = i;
            float s1 = sv[0], s2 = sv[0];
#pragma unroll
            for (int i = 1; i < 4; ++i) { if (i == j1) s1 = sv[i]; if (i == j2) s2 = sv[i]; }
            if (e == 0) { const int ti = 2 * pp + rs; const float inv = 1.0f / (s1 + s2);
                TE[ti * 2] = gid * 4 + j1; TE[ti * 2 + 1] = gid * 4 + j2; TG[ti * 2] = s1 * inv; TG[ti * 2 + 1] = s2 * inv;
                atomicAdd(&HS[gid * 4 + j1], 1u); atomicAdd(&HS[gid * 4 + j2], 1u); }
        }
        wave_sync();
        if (lane < 32) { TOKE[t0 * 2 + lane] = TE[lane]; TOKG[t0 * 2 + lane] = TG[lane]; HIST[tw * 32 + lane] = HS[lane]; }
        wave_sync();
    }
}

__device__ __forceinline__ void phase_slot(ArgsRef a, int tid, int lane, int wave, int bid, int G) {
    const int* TOKE = (const int*)(a.ws + OFF_TOKE); int* TOKS = (int*)(a.ws + OFF_TOKS); const unsigned* HIST = (const unsigned*)(a.ws + OFF_HIST);
    unsigned* BASE = (unsigned*)(a.ws + OFF_CTL) + 64;
    const bf16_t* XB = (const bf16_t*)(a.ws + OFF_XB); bf16_t* XG = (bf16_t*)(a.ws + OFF_XG);
    unsigned* base = (unsigned*)smem; unsigned* pre = base + 40; int* el = (int*)(base + 80); int* sl = (int*)(base + 208); unsigned* red = base + 336;
    const int e = tid & 31, part = tid >> 5;
    for (int c = bid; c < T / 64; c += G) {
        unsigned tot = 0u, pr = 0u;
#pragma unroll 8
        for (int it = part; it < 1024; it += 16) { const unsigned v = HIST[it * 32 + e]; tot += v; pr += (it < 4 * c) ? v : 0u; }
        red[part * 32 + e] = tot; red[512 + part * 32 + e] = pr;
        __syncthreads();
        if (tid < 32) { unsigned t2 = 0u, p2 = 0u; for (int k = 0; k < 16; ++k) { t2 += red[k * 32 + tid]; p2 += red[512 + k * 32 + tid]; } pre[tid] = p2; red[tid] = (t2 + 255u) & ~255u; }
        __syncthreads();
        if (tid == 0) { unsigned sacc = 0; for (int k = 0; k < 32; ++k) { base[k] = sacc; sacc += red[k]; } base[32] = sacc; }
        int ee = 0;
        if (tid < 128) { ee = TOKE[c * 128 + tid]; el[tid] = ee; }
        __syncthreads();
        if (c == 0 && tid < 33) BASE[tid] = base[tid];
        if (tid < 128) { unsigned rank = 0; for (int i = 0; i < tid; ++i) rank += (el[i] == ee) ? 1u : 0u;
            const unsigned sidx = base[ee] + pre[ee] + rank; sl[tid] = (int)sidx; TOKS[c * 128 + tid] = (int)sidx; }
        __syncthreads();
        for (int i = wave; i < 128; i += 8) { const int t = c * 64 + (i >> 1); const size_t so = (size_t)sl[i] * 1024;
            *(u32x4*)(XG + so + lane * 8) = *(const u32x4*)(XB + (size_t)t * 1024 + lane * 8); *(u32x4*)(XG + so + 512 + lane * 8) = *(const u32x4*)(XB + (size_t)t * 1024 + 512 + lane * 8); }
        __syncthreads();
    }
}

__device__ __forceinline__ void phase_ln2(ArgsRef a, int l, int lane, int gw, int GW) {
    float* XF = a.out; bf16_t* XB = (bf16_t*)(a.ws + OFF_XB); const bf16_t* YS = (const bf16_t*)(a.ws + OFF_YS);
    const int* TOKS = (const int*)(a.ws + OFF_TOKS); const float* TOKG = (const float*)(a.ws + OFF_TOKG);
    for (int tb = gw * 4; tb < T; tb += GW * 4) {
        int sv = 0; float gv = 0.f; if (lane < 8) { sv = TOKS[tb * 2 + lane]; gv = TOKG[tb * 2 + lane]; }
        f32x4 v[4][4]; bf16x4 y0[4][4], y1[4][4]; float g0[4], g1[4];
#pragma unroll
        for (int k = 0; k < 4; ++k) { const int s0 = __shfl(sv, 2 * k), s1 = __shfl(sv, 2 * k + 1); g0[k] = __shfl(gv, 2 * k); g1[k] = __shfl(gv, 2 * k + 1);
#pragma unroll
            for (int j = 0; j < 4; ++j) { v[k][j] = *(const f32x4*)(XF + (size_t)(tb + k) * 1024 + 256 * j + 4 * lane);
                y0[k][j] = *(const bf16x4*)(YS + (size_t)s0 * 1024 + 256 * j + 4 * lane); y1[k][j] = *(const bf16x4*)(YS + (size_t)s1 * 1024 + 256 * j + 4 * lane); } }
#pragma unroll
        for (int k = 0; k < 4; ++k) {
#pragma unroll
            for (int j = 0; j < 4; ++j)
#pragma unroll
                for (int g = 0; g < 4; ++g) v[k][j][g] = DN_ALPHA * v[k][j][g] + g0[k] * bf2f((bf16_t)y0[k][j][g]) + g1[k] * bf2f((bf16_t)y1[k][j][g]);
            ln_row(v[k], a.in[27] + l * 1024, a.in[28] + l * 1024, lane);
#pragma unroll
            for (int j = 0; j < 4; ++j) { *(f32x4*)(XF + (size_t)(tb + k) * 1024 + 256 * j + 4 * lane) = v[k][j];
                u32x2 w; w.x = pack2(v[k][j][0], v[k][j][1]); w.y = pack2(v[k][j][2], v[k][j][3]); *(u32x2*)(XB + (size_t)(tb + k) * 1024 + 256 * j + 4 * lane) = w; } }
    }
}

struct SchedGrid {
    int nM, nN, G, c; const char* A; const char* B; size_t strideA, strideB;
    __device__ __forceinline__ bool next(int i, pg8::Unit& u) const { int pm, pn; if (!pg8::tile_order(i * G + c, nM, nN, pm, pn)) return false;
        u.pm = pm; u.pn = pn; u.tag = 0; u.A = A + (size_t)pm * strideA; u.B = B + (size_t)pn * strideB; return true; }
};
constexpr int GATES_LD = 3072;
template <int MODE> struct EpiBf16 {
    static constexpr bool PERM = true;
    bf16_t* O; int ldo; const bf16_t* Y; int ldy;
    __device__ __forceinline__ bool operator()(f32x4 (&acc)[2][2][4][2], const pg8::Unit& u, int wr, int wc, int fr, int fq) const {
#pragma unroll
        for (int ai = 0; ai < 2; ++ai)
#pragma unroll
            for (int m = 0; m < 4; ++m) { const size_t row = (size_t)u.pm * 256 + ai * 128 + wr * 64 + m * 16 + fr;
#pragma unroll
                for (int bj = 0; bj < 2; ++bj) { const int col = u.pn * 256 + bj * 128 + wc * 32 + 8 * fq; f32x4 v0 = acc[ai][bj][m][0], v1 = acc[ai][bj][m][1];
                    if (MODE == 1) {
#pragma unroll
                        for (int j = 0; j < 4; ++j) { v0[j] = fmaxf(sigmoidf_(v0[j]), 1e-30f); v1[j] = fmaxf(sigmoidf_(v1[j]), 1e-30f); } }
                    if (MODE == 2) { const bf16x8 y = *(const bf16x8*)(Y + row * ldy + col);
#pragma unroll
                        for (int j = 0; j < 4; ++j) { v0[j] = bf2f((bf16_t)y[j]) * sigmoidf_(v0[j]); v1[j] = bf2f((bf16_t)y[4 + j]) * sigmoidf_(v1[j]); } }
                    u32x4 w; w.x = pg8::cvt_pk_bf16(v0[0], v0[1]); w.y = pg8::cvt_pk_bf16(v0[2], v0[3]); w.z = pg8::cvt_pk_bf16(v1[0], v1[1]); w.w = pg8::cvt_pk_bf16(v1[2], v1[3]);
                    *(u32x4*)(O + row * ldo + col) = w; } }
        return false;
    }
};
struct SchedZ {
    int G, c; const unsigned char* ws;
    __device__ __forceinline__ bool next(int i, pg8::Unit& u) const { int pm, pn; if (!pg8::tile_order(i * G + c, T / 256, 15, pm, pn)) return false;
        u.pm = pm; u.pn = pn; u.tag = 0; u.A = (const char*)(ws + OFF_XB) + (size_t)pm * 256 * 1024 * 2;
        u.B = (const char*)(ws + OFF_WIN) + (size_t)(pn < 14 ? pn * 256 : 6656) * 1024 * 2; return true; }
};
struct EpiZ {
    static constexpr bool PERM = true;
    bf16_t* Z; float* LI; float* LF; const float* bi; const float* bf;
    __device__ __forceinline__ bool operator()(f32x4 (&acc)[2][2][4][2], const pg8::Unit& u, int wr, int wc, int fr, int fq) const {
        if (u.pn < 14) {
#pragma unroll
            for (int ai = 0; ai < 2; ++ai)
#pragma unroll
                for (int m = 0; m < 4; ++m) { const size_t row = (size_t)u.pm * 256 + ai * 128 + wr * 64 + m * 16 + fr;
#pragma unroll
                    for (int bj = 0; bj < 2; ++bj) { const int col = u.pn * 256 + bj * 128 + wc * 32 + 8 * fq; const f32x4 v0 = acc[ai][bj][m][0], v1 = acc[ai][bj][m][1];
                        u32x4 w; w.x = pg8::cvt_pk_bf16(v0[0], v0[1]); w.y = pg8::cvt_pk_bf16(v0[2], v0[3]); w.z = pg8::cvt_pk_bf16(v1[0], v1[1]); w.w = pg8::cvt_pk_bf16(v1[2], v1[3]);
                        *(u32x4*)(Z + row * NZ + col) = w; } }
        } else if (wc == 0 && fq == 0) {
            const f32x4 b_i = *(const f32x4*)bi, b_f = *(const f32x4*)bf;
#pragma unroll
            for (int ai = 0; ai < 2; ++ai)
#pragma unroll
                for (int m = 0; m < 4; ++m) { const size_t row = (size_t)u.pm * 256 + ai * 128 + wr * 64 + m * 16 + fr; const f32x4 v0 = acc[ai][0][m][0] + b_i, v1 = acc[ai][0][m][1] + b_f;
                    f32x4 lf; lf[0] = logsigmoidf_(v1[0]); lf[1] = logsigmoidf_(v1[1]); lf[2] = logsigmoidf_(v1[2]); lf[3] = logsigmoidf_(v1[3]);
                    *(f32x4*)(LI + row * 4) = v0; *(f32x4*)(LF + row * 4) = lf; }
        }
        return false;
    }
};
__device__ __forceinline__ void phase_zgemm2(ArgsRef a, int l, int tid, int bid, int G) {
    SchedZ S{G, bid, a.ws}; EpiZ E{(bf16_t*)(a.ws + OFF_Z), (float*)(a.ws + OFF_LI), (float*)(a.ws + OFF_LF), a.in[7] + l * 4, a.in[8] + l * 4};
    pg8::gemm_phase((PG8_LAS unsigned char*)smem, tid, 1024, 1024, 1024, S, E);
}
__device__ __forceinline__ void phase_glu_gates(ArgsRef a, int l, int tid, int bid, int G) {
    { SchedGrid S{T / 256, 2, G, bid, (const char*)(a.ws + OFF_YPRE), (const char*)(a.ws + OFF_WGLU), (size_t)256 * 512 * 2, (size_t)256 * 512 * 2};
      EpiBf16<2> E{(bf16_t*)(a.ws + OFF_YSG), 512, (const bf16_t*)(a.ws + OFF_YPRE), 512};
      pg8::gemm_phase((PG8_LAS unsigned char*)smem, tid, 512, 512, 512, S, E); }
    asm volatile("" : "+v"(tid), "+s"(bid), "+s"(G));
    if (G > 128) { if (bid >= 128) phase_prepx(a, l, tid, bid - 128, G - 128, 0, 896); } else phase_prepx(a, l, tid, bid, G, 0, 896);
    asm volatile("" : "+v"(tid), "+s"(bid), "+s"(G));
    { SchedGrid S{T / 256, 12, G, (bid + G / 2) % G, (const char*)(a.ws + OFF_XB), (const char*)(a.ws + OFF_WIN + (size_t)NZ * 1024 * 2), (size_t)256 * 1024 * 2, (size_t)256 * 1024 * 2};
      EpiBf16<1> E{(bf16_t*)(a.ws + OFF_Z), GATES_LD, nullptr, 0};
      pg8::gemm_phase((PG8_LAS unsigned char*)smem, tid, 1024, 1024, 1024, S, E); }
}
struct SchedMerge {
    int G, c; const unsigned char* ws;
    __device__ __forceinline__ bool next(int i, pg8::Unit& u) const { const int b = i % 3; int pm, pn; if (!pg8::tile_order((i / 3) * G + c, T / 256, 4, pm, pn)) return false;
        u.pm = pm; u.pn = pn; u.tag = b; u.A = (const char*)(ws + (b == 0 ? OFF_OM : b == 1 ? OFF_YSG : OFF_OH)) + (size_t)pm * 256 * 512 * 2;
        u.B = (const char*)(ws + OFF_WB) + ((size_t)b * 1024 + pn * 256) * 512 * 2; return true; }
};
struct EpiMerge {
    static constexpr bool PERM = true;
    const bf16_t* GT; bf16_t* O;
    __device__ __forceinline__ bool operator()(f32x4 (&acc)[2][2][4][2], const pg8::Unit& u, int wr, int wc, int fr, int fq) const {
        const int b = u.tag;
#pragma unroll
        for (int ai = 0; ai < 2; ++ai)
#pragma unroll
            for (int m = 0; m < 4; ++m) { const size_t row = (size_t)u.pm * 256 + ai * 128 + wr * 64 + m * 16 + fr;
#pragma unroll
                for (int bj = 0; bj < 2; ++bj) { const int col = u.pn * 256 + bj * 128 + wc * 32 + 8 * fq;
                    const bf16x8 gb = *(const bf16x8*)(GT + row * GATES_LD + b * 1024 + col);
                    if (b < 2) { const bf16x8 gn = *(const bf16x8*)(GT + row * GATES_LD + (b + 1) * 1024 + col);
#pragma unroll
                        for (int j = 0; j < 4; ++j) { acc[ai][bj][m][0][j] *= bf2f((bf16_t)gb[j]) / bf2f((bf16_t)gn[j]); acc[ai][bj][m][1][j] *= bf2f((bf16_t)gb[4 + j]) / bf2f((bf16_t)gn[4 + j]); } }
                    else { f32x4 v0 = acc[ai][bj][m][0], v1 = acc[ai][bj][m][1];
#pragma unroll
                        for (int j = 0; j < 4; ++j) { v0[j] *= bf2f((bf16_t)gb[j]); v1[j] *= bf2f((bf16_t)gb[4 + j]); }
                        u32x4 w; w.x = pg8::cvt_pk_bf16(v0[0], v0[1]); w.y = pg8::cvt_pk_bf16(v0[2], v0[3]); w.z = pg8::cvt_pk_bf16(v1[0], v1[1]); w.w = pg8::cvt_pk_bf16(v1[2], v1[3]);
                        *(u32x4*)(O + row * 1024 + col) = w; } } }
        return b < 2;
    }
};
__device__ __forceinline__ void phase_merge2(ArgsRef a, int tid, int bid, int G) {
    SchedMerge S{G, bid, a.ws}; EpiMerge E{(const bf16_t*)(a.ws + OFF_Z), (bf16_t*)(a.ws + OFF_XB)};
    pg8::gemm_phase((PG8_LAS unsigned char*)smem, tid, 512, 512, 512, S, E);
}
struct EpiResid {
    static constexpr bool PERM = false;
    const float* xin; float* XF;
    __device__ __forceinline__ bool operator()(f32x4 (&acc)[2][2][4][2], const pg8::Unit& u, int wr, int wc, int fr, int fq) const {
#pragma unroll
        for (int ai = 0; ai < 2; ++ai)
#pragma unroll
            for (int m = 0; m < 4; ++m) { const size_t row = (size_t)u.pm * 256 + ai * 128 + wr * 64 + m * 16 + fr;
#pragma unroll
                for (int bj = 0; bj < 2; ++bj)
#pragma unroll
                    for (int n = 0; n < 2; ++n) { const size_t o = row * 1024 + u.pn * 256 + bj * 128 + wc * 32 + 16 * n + 4 * fq; const f32x4 x = *(const f32x4*)(xin + o); *(f32x4*)(XF + o) = DN_ALPHA * x + acc[ai][bj][m][n]; } }
        return false;
    }
};
__device__ __forceinline__ void phase_wout2(ArgsRef a, int l, int tid, int bid, int G) {
    SchedGrid S{T / 256, 4, G, bid, (const char*)(a.ws + OFF_XB), (const char*)(a.ws + OFF_WOUT), (size_t)256 * 1024 * 2, (size_t)256 * 1024 * 2};
    EpiResid E{(l == 0) ? a.in[0] : a.out, a.out};
    pg8::gemm_phase((PG8_LAS unsigned char*)smem, tid, 1024, 1024, 1024, S, E);
}
struct EpiQKV {
    static constexpr bool PERM = true;
    int vcall; bf16_t* Q; bf16_t* KH; bf16_t* V; const float* LI;
    __device__ __forceinline__ bool operator()(f32x4 (&acc)[2][2][4][2], const pg8::Unit& u, int wr, int wc, int fr, int fq) const {
        const int which = vcall ? 2 : (u.pn >> 1); bf16_t* O = which == 0 ? Q : which == 1 ? KH : V;
#pragma unroll
        for (int ai = 0; ai < 2; ++ai)
#pragma unroll
            for (int m = 0; m < 4; ++m) { const size_t row = (size_t)u.pm * 256 + ai * 128 + wr * 64 + m * 16 + fr;
#pragma unroll
                for (int bj = 0; bj < 2; ++bj) { const int hd = (u.pn & 1) * 2 + bj, col = hd * 128 + wc * 32 + 8 * fq;
                    const float sc = which == 0 ? 0.08838834764831845f : which == 1 ? fexp(LI[row * 4 + hd]) : 1.0f;
                    const f32x4 v0 = acc[ai][bj][m][0] * sc, v1 = acc[ai][bj][m][1] * sc;
                    u32x4 w; w.x = pg8::cvt_pk_bf16(v0[0], v0[1]); w.y = pg8::cvt_pk_bf16(v0[2], v0[3]); w.z = pg8::cvt_pk_bf16(v1[0], v1[1]); w.w = pg8::cvt_pk_bf16(v1[2], v1[3]);
                    *(u32x4*)(O + row * 512 + col) = w; } }
        return false;
    }
};
__device__ __forceinline__ void phase_mqkv2(ArgsRef a, int tid, int bid, int G) {
    { SchedGrid S{T / 256, 4, G, bid, (const char*)(a.ws + OFF_XC), (const char*)(a.ws + OFF_WQKV), (size_t)256 * 512 * 2, (size_t)256 * 512 * 2};
      EpiQKV E{0, (bf16_t*)(a.ws + OFF_Q), (bf16_t*)(a.ws + OFF_KH), (bf16_t*)(a.ws + OFF_V), (const float*)(a.ws + OFF_LI)};
      pg8::gemm_phase((PG8_LAS unsigned char*)smem, tid, 512, 512, 512, S, E); }
    asm volatile("" : "+v"(tid), "+s"(bid), "+s"(G));
    { SchedGrid S{T / 256, 2, G, (bid + G / 2) % G, (const char*)(a.ws + OFF_Z), (const char*)(a.ws + OFF_WQKV + (size_t)1024 * 512 * 2), (size_t)256 * NZ * 2, (size_t)256 * 512 * 2};
      EpiQKV E{1, (bf16_t*)(a.ws + OFF_Q), (bf16_t*)(a.ws + OFF_KH), (bf16_t*)(a.ws + OFF_V), (const float*)(a.ws + OFF_LI)};
      pg8::gemm_phase((PG8_LAS unsigned char*)smem, tid, 512, NZ, 512, S, E); }
}
struct SchedMoE {
    int down, G, c; const unsigned char* ws; const unsigned* BASE;
    __device__ __forceinline__ bool next(int i, pg8::Unit& u) const { const int per = down ? 4 : 2, L = i * G + c, ntile = (int)(BASE[32] >> 8); if (L >= ntile * per) return false;
        const int tile = L / per, sub = L % per; int e = 0; while (e < 31 && BASE[e + 1] <= (unsigned)(tile * 256)) ++e;
        u.pm = tile; u.pn = sub; u.tag = e;
        if (!down) { u.A = (const char*)(ws + OFF_XG) + (size_t)tile * 256 * 1024 * 2; u.B = (const char*)(ws + OFF_WGU) + ((size_t)e * 512 + sub * 256) * 1024 * 2; }
        else { u.A = (const char*)(ws + OFF_H) + (size_t)tile * 256 * 256 * 2; u.B = (const char*)(ws + OFF_WD) + ((size_t)e * 1024 + sub * 256) * 256 * 2; }
        return true; }
};
struct EpiH {
    static constexpr bool PERM = true;
    bf16_t* H;
    __device__ __forceinline__ bool operator()(f32x4 (&acc)[2][2][4][2], const pg8::Unit& u, int wr, int wc, int fr, int fq) const {
#pragma unroll
        for (int ai = 0; ai < 2; ++ai)
#pragma unroll
            for (int m = 0; m < 4; ++m) { const size_t row = (size_t)u.pm * 256 + ai * 128 + wr * 64 + m * 16 + fr; f32x4 v0, v1;
#pragma unroll
                for (int j = 0; j < 4; ++j) { v0[j] = siluf_(acc[ai][0][m][0][j]) * acc[ai][1][m][0][j]; v1[j] = siluf_(acc[ai][0][m][1][j]) * acc[ai][1][m][1][j]; }
                u32x4 w; w.x = pg8::cvt_pk_bf16(v0[0], v0[1]); w.y = pg8::cvt_pk_bf16(v0[2], v0[3]); w.z = pg8::cvt_pk_bf16(v1[0], v1[1]); w.w = pg8::cvt_pk_bf16(v1[2], v1[3]);
                *(u32x4*)(H + row * 256 + u.pn * 128 + wc * 32 + 8 * fq) = w; }
        return false;
    }
};
__device__ __forceinline__ void phase_moe_gu2(ArgsRef a, int l, int tid, int bid, int G) {
    { SchedMoE S{0, G, bid, a.ws, (const unsigned*)(a.ws + OFF_CTL) + 64}; EpiH E{(bf16_t*)(a.ws + OFF_H)};
      pg8::gemm_phase((PG8_LAS unsigned char*)smem, tid, 1024, 1024, 1024, S, E); }
    if (l + 1 < NLAYER) {
        asm volatile("" : "+v"(tid), "+s"(bid), "+s"(G));
        const int ntile = (int)(((const unsigned*)(a.ws + OFF_CTL))[64 + 32] >> 8); int nb = ntile * 2 - G; nb = nb < 0 ? 0 : (nb > G - 1 ? G - 1 : nb);
        if (bid >= nb) phase_prep(a, l + 1, tid, bid - nb, G - nb);
    }
}
__device__ __forceinline__ void phase_moe_dn2(ArgsRef a, int tid, int bid, int G) {
    SchedMoE S{1, G, bid, a.ws, (const unsigned*)(a.ws + OFF_CTL) + 64}; EpiBf16<0> E{(bf16_t*)(a.ws + OFF_YS), 1024, nullptr, 0};
    pg8::gemm_phase((PG8_LAS unsigned char*)smem, tid, 256, 256, 256, S, E);
}
__device__ __forceinline__ void phase_mprep2(ArgsRef a, int l, int tid, int lane, int wave, int bid, int G) {
    const bf16_t* Z = (const bf16_t*)(a.ws + OFF_Z); bf16_t* XC = (bf16_t*)(a.ws + OFF_XC);
    const float* cw = a.in[2] + (size_t)l * 4 * 512; const float* cb = a.in[3] + (size_t)l * 512;
    for (int idx = bid * 512 + tid; idx < (T / 8) * 64; idx += G * 512) {
        const int tb = (idx / 64) * 8, c0 = (idx % 64) * 8;
        bf16x8 xr[11];
#pragma unroll
        for (int k = 0; k < 11; ++k) { const int ts = tb - 3 + k; xr[k] = (ts >= 0) ? *(const bf16x8*)(Z + (size_t)ts * NZ + c0) : (bf16x8){0, 0, 0, 0, 0, 0, 0, 0}; }
        float w[4][8], b[8];
#pragma unroll
        for (int j = 0; j < 8; ++j) { b[j] = cb[c0 + j];
#pragma unroll
            for (int k = 0; k < 4; ++k) w[k][j] = cw[k * 512 + c0 + j]; }
#pragma unroll
        for (int tt = 0; tt < 8; ++tt) { float acc[8];
#pragma unroll
            for (int j = 0; j < 8; ++j) { acc[j] = b[j];
#pragma unroll
                for (int k = 0; k < 4; ++k) acc[j] += w[k][j] * bf2f((bf16_t)xr[tt + k][j]); }
            u32x4 o; o.x = pack2(siluf_(acc[0]), siluf_(acc[1])); o.y = pack2(siluf_(acc[2]), siluf_(acc[3])); o.z = pack2(siluf_(acc[4]), siluf_(acc[5])); o.w = pack2(siluf_(acc[6]), siluf_(acc[7]));
            *(u32x4*)(XC + (size_t)(tb + tt) * 512 + c0) = o; }
    }
}

#define XB_TMO      128
#define XB_XCNT(j)  (256  + 64 * (j))
#define XB_XSUB(j)  (1280 + 64 * (j))
#define XB_XGEN(j)  (2304 + 64 * (j))
#define XB_TOP      3328
#define XB_TOPGEN   3392
#define XCD_BAR_WORDS 3456
#define XB_SPIN_CAP (1u << 22)
__device__ __forceinline__ unsigned xb_ld(unsigned* p)              { return __hip_atomic_load(p, __ATOMIC_RELAXED, __HIP_MEMORY_SCOPE_AGENT); }
__device__ __forceinline__ unsigned xb_add(unsigned* p, unsigned v) { return __hip_atomic_fetch_add(p, v, __ATOMIC_RELAXED, __HIP_MEMORY_SCOPE_AGENT); }
__device__ __forceinline__ unsigned xb_xcc_id() { return (unsigned)__builtin_amdgcn_s_getreg((3 << 11) | 20) & 0xFu; }
#define XB_SPIN(cond, bar) do { unsigned _sp = 0; while (cond) { __builtin_amdgcn_s_sleep(1); \
    if ((++_sp & 255u) == 0u) { if (xb_ld(&(bar)[XB_TMO])) break; if (_sp > XB_SPIN_CAP) { atomicAdd(&(bar)[XB_TMO], 1u); break; } } } } while (0)
__device__ __forceinline__ void xcd_barrier_complete(unsigned* bar, unsigned x, unsigned& nloc, unsigned& nx) {
    const unsigned G = gridDim.x; unsigned sum, cnt, mine, sp = 0u;
    for (;;) { sum = 0u; cnt = 0u; mine = 0u;
#pragma unroll
        for (unsigned j = 0; j < 16; ++j) { const unsigned c = xb_ld(&bar[XB_XCNT(j)]); sum += c; cnt += (c > 0u) ? 1u : 0u; mine = (j == x) ? c : mine; }
        if (sum == G) break;
        __builtin_amdgcn_s_sleep(1);
        if ((++sp & 255u) == 0u) { if (xb_ld(&bar[XB_TMO])) break; if (sp > XB_SPIN_CAP) { atomicAdd(&bar[XB_TMO], 1u); break; } } }
    nloc = mine > 0u ? mine : 1u; nx = cnt > 0u ? cnt : 1u;
}
__device__ __forceinline__ void xcd_barrier(unsigned* bar, volatile __attribute__((address_space(3))) unsigned* st) {
    asm volatile("s_waitcnt vmcnt(0)" ::: "memory");
    __syncthreads();
    if (threadIdx.x == 0) {
        __builtin_amdgcn_s_waitcnt(0);
        const unsigned x = xb_xcc_id();
        unsigned nloc = st[0], nx = st[1];
        if (nloc == 0u) { xcd_barrier_complete(bar, x, nloc, nx); st[0] = nloc; st[1] = nx; }
        const unsigned old = xb_add(&bar[XB_XSUB(x)], 1u);
        const unsigned gen = old / nloc;
        if (old + 1u == (gen + 1u) * nloc) {
            __builtin_amdgcn_fence(__ATOMIC_RELEASE, "agent");
            asm volatile("s_waitcnt vmcnt(0)" ::: "memory");
            const unsigned og = xb_add(&bar[XB_TOP], 1u);
            const unsigned tg = og / nx;
            if (og + 1u == (tg + 1u) * nx) xb_add(&bar[XB_TOPGEN], 1u);
            else XB_SPIN(xb_ld(&bar[XB_TOPGEN]) == tg, bar);
            __builtin_amdgcn_fence(__ATOMIC_ACQUIRE, "agent");
            xb_add(&bar[XB_XGEN(x)], 1u);
            asm volatile("s_waitcnt vmcnt(0)" ::: "memory");
        } else {
            XB_SPIN(xb_ld(&bar[XB_XGEN(x)]) == gen, bar);
            __builtin_amdgcn_fence(__ATOMIC_ACQUIRE, "agent");
            asm volatile("s_waitcnt vmcnt(0)" ::: "memory");
        }
    }
    __syncthreads();
}

__device__ __forceinline__ ArgsRef fresh_args() { unsigned long long p = (unsigned long long)__builtin_amdgcn_kernarg_segment_ptr(); asm volatile("" : "+s"(p)); return *(const __attribute__((address_space(4))) Args*)p; }
__global__ void __launch_bounds__(512) fwd(Args a_unused) {
    cg::grid_group grid = cg::this_grid();
    volatile __attribute__((address_space(3))) unsigned* bst = (volatile __attribute__((address_space(3))) unsigned*)((__attribute__((address_space(3))) unsigned char*)smem + 131072);
    if (threadIdx.x < 4) bst[threadIdx.x] = 0u;
    __syncthreads();
    { ArgsRef a0 = fresh_args(); if (threadIdx.x == 0) (void)xb_add(&((unsigned*)(a0.ws + OFF_BAR))[XB_XCNT(xb_xcc_id())], 1u); }
#define GSYNC() do { asm volatile("" ::: "memory"); { ArgsRef ab = fresh_args(); xcd_barrier((unsigned*)(ab.ws + OFF_BAR), bst); } asm volatile("" ::: "memory"); } while (0)
#define GSYNC_CG() do { asm volatile("" ::: "memory"); grid.sync(); asm volatile("" ::: "memory"); } while (0)
    const int wave_s = __builtin_amdgcn_readfirstlane((int)threadIdx.x >> 6);
#define PH(body) do { int wave = wave_s; asm volatile("" : "+s"(wave)); int lane; asm volatile("v_mbcnt_lo_u32_b32 %0, -1, 0\n\tv_mbcnt_hi_u32_b32 %0, -1, %0" : "=v"(lane)); \
        int bid = blockIdx.x, G = gridDim.x; asm volatile("" : "+s"(bid), "+s"(G)); \
        const int tid = wave * 64 + lane, gw = bid * 8 + wave, GW = G * 8; (void)tid; (void)gw; (void)GW; ArgsRef a = fresh_args(); body; } while (0)
#pragma unroll 1
    for (int l = 0; l < NLAYER; ++l) {
        if (l == 0) { PH(phase_prep(a, 0, tid, bid, G)); GSYNC_CG(); }
        PH(phase_zgemm2(a, l, tid, bid, G)); GSYNC();
        PH(phase_mprep2(a, l, tid, lane, wave, bid, G)); GSYNC();
        PH(phase_mqkv2(a, tid, bid, G)); GSYNC();
        PH(phase_mixers<1>(a, l, tid, lane, wave, bid, G)); GSYNC();
        PH(phase_scan(a, tid, bid, G)); GSYNC();
        PH(phase_mixers<2>(a, l, tid, lane, wave, bid, G)); GSYNC();
        PH(phase_glu_gates(a, l, tid, bid, G)); PH(phase_prepx(a, l, tid, bid, G, 896, 4608)); GSYNC();
        PH(phase_merge2(a, tid, bid, G)); GSYNC();
        PH(phase_wout2(a, l, tid, bid, G)); GSYNC();
        PH(phase_ln1r(a, l, tid, lane, wave, bid, G)); PH(if (G > 128) { if (bid >= 128) phase_prepx(a, l, tid, bid - 128, G - 128, 4608, 6144); } else phase_prepx(a, l, tid, bid, G, 4608, 6144)); GSYNC();
        PH(phase_slot(a, tid, lane, wave, bid, G)); GSYNC();
        PH(phase_moe_gu2(a, l, tid, bid, G)); GSYNC();
        PH(phase_moe_dn2(a, tid, bid, G)); GSYNC();
        PH(phase_ln2(a, l, lane, gw, GW)); if (l + 1 < NLAYER) GSYNC();
    }
}

extern "C" void kernel_launch(void* const* d_in, const int* in_sizes, int n_in, void* d_out, int out_size, void* d_ws, size_t ws_size, hipStream_t stream) {
    static int grid = 0;
    if (grid == 0) {
        if (n_in != 34 || out_size != T * D || ws_size < WS_TOTAL) { fprintf(stderr, "kernel_launch: unexpected shapes (n_in %d, out %d, ws %zu, need %zu)\n", n_in, out_size, ws_size, (size_t)WS_TOTAL); grid = -1; return; }
        int dev = 0, cus = 0, per_cu = 0;
        (void)hipGetDevice(&dev); (void)hipDeviceGetAttribute(&cus, hipDeviceAttributeMultiprocessorCount, dev);
        (void)hipFuncSetAttribute((const void*)fwd, hipFuncAttributeMaxDynamicSharedMemorySize, LDS_BYTES);
        (void)hipOccupancyMaxActiveBlocksPerMultiprocessor(&per_cu, (const void*)fwd, 512, LDS_BYTES);
        if (per_cu < 1) { fprintf(stderr, "kernel_launch: occupancy query says %d blocks per CU\n", per_cu); per_cu = 1; }
        grid = (cus > 0 ? cus : 256) * 1;
        (void)hipGetLastError();
    }
    if (grid < 0) return;
    Args a{};
    for (int i = 0; i < 34; ++i) a.in[i] = (const float*)d_in[i];
    a.out = (float*)d_out; a.ws = (unsigned char*)d_ws; a.ph_lo = 0; a.ph_hi = NLAYER * NPH;
    (void)hipMemsetAsync((unsigned char*)d_ws + OFF_BAR, 0, 16384, stream);
    void* args[] = {&a};
    hipError_t e = hipLaunchCooperativeKernel((const void*)fwd, dim3(grid), dim3(512), args, LDS_BYTES, stream);
    if (e != hipSuccess) fprintf(stderr, "kernel_launch: cooperative launch failed: %s (grid %d)\n", hipGetErrorString(e), grid);
}
```

```cpp
#include <hip/hip_runtime.h>
#include <hip/hip_cooperative_groups.h>
#include <cstdio>
#include <cstdint>
namespace cg = cooperative_groups;

typedef unsigned short bf16_t;
typedef short bf16x8 __attribute__((ext_vector_type(8)));
typedef short bf16x4 __attribute__((ext_vector_type(4)));
typedef float f32x4 __attribute__((ext_vector_type(4)));
typedef unsigned u32x4 __attribute__((ext_vector_type(4)));
typedef unsigned u32x2 __attribute__((ext_vector_type(2)));

constexpr int T = 16384, D = 1024, NZ = 3584, NWIN = 6912, INW = 6664;
constexpr int NPH = 15, NLAYER = 2;
constexpr int GSEG = 32, GSEGLEN = 512;
constexpr int SSEG = 64, SSEGLEN = 256;
constexpr int SLOTS = 40960;
constexpr float DN_ALPHA = 1.41421356237f;
constexpr int LDS_BYTES = 131072 + 256;

constexpr size_t AL(size_t x) { return (x + 255) & ~(size_t)255; }
constexpr size_t OFF_WIN = 0;
constexpr size_t OFF_WQKV = OFF_WIN + AL((size_t)NWIN * 1024 * 2);
constexpr size_t OFF_WGLU = OFF_WQKV + AL((size_t)1536 * 512 * 2);
constexpr size_t OFF_WB = OFF_WGLU + AL((size_t)512 * 512 * 2);
constexpr size_t OFF_WOUT = OFF_WB + AL((size_t)3 * 1024 * 512 * 2);
constexpr size_t OFF_ABAR = OFF_WOUT + AL((size_t)1024 * 1024 * 2);
constexpr size_t OFF_BBT = OFF_ABAR + AL((size_t)32 * 64 * 2 * 4);
constexpr size_t OFF_CCT = OFF_BBT + AL((size_t)32 * 128 * 16 * 2);
constexpr size_t OFF_CTL = OFF_CCT + AL((size_t)32 * 16 * 128 * 2);
constexpr size_t OFF_TOKE = OFF_CTL + 4096;
constexpr size_t OFF_TOKG = OFF_TOKE + AL((size_t)T * 2 * 4);
constexpr size_t OFF_TOKS = OFF_TOKG + AL((size_t)T * 2 * 4);
constexpr size_t OFF_SLOTT = OFF_TOKS + AL((size_t)T * 2 * 4);
constexpr size_t OFF_XB = OFF_SLOTT + AL((size_t)SLOTS * 4);
constexpr size_t OFF_R1 = OFF_XB + AL((size_t)T * 1024 * 2);
constexpr size_t SZ_ACT = (size_t)T * 512 * 2;
constexpr size_t OFF_XC = OFF_R1, OFF_Q = OFF_R1 + SZ_ACT, OFF_KH = OFF_R1 + 2 * SZ_ACT, OFF_V = OFF_R1 + 3 * SZ_ACT;
constexpr size_t OFF_WGU = OFF_R1, OFF_WD = OFF_R1 + (size_t)32 * 512 * 1024 * 2;
constexpr size_t OFF_Z = OFF_R1 + 4 * SZ_ACT;
constexpr size_t OFF_XG = OFF_Z, OFF_H = OFF_Z + (size_t)SLOTS * 1024 * 2;
constexpr size_t OFF_ZS = OFF_Z + AL((size_t)T * NZ * 2);
constexpr size_t OFF_LF = OFF_ZS + AL((size_t)T * 8 * 4);
constexpr size_t OFF_LI = OFF_LF + AL((size_t)T * 4 * 4);
constexpr size_t OFF_E = OFF_LI + AL((size_t)T * 4 * 4);
constexpr size_t OFF_OM = OFF_E, OFF_OH = OFF_E + SZ_ACT, OFF_YPRE = OFF_E + 2 * SZ_ACT, OFF_YSG = OFF_E + 3 * SZ_ACT;
constexpr size_t OFF_DEN = OFF_E + 4 * SZ_ACT;
constexpr size_t OFF_EM = OFF_DEN + AL((size_t)T * 4 * 4);
constexpr size_t OFF_EMX = OFF_EM + AL((size_t)GSEG * 4 * 128 * 128 * 4);
constexpr size_t OFF_GM = OFF_EMX + AL((size_t)GSEG * 4 * 128 * 16 * 4);
constexpr size_t OFF_EH = OFF_GM + AL((size_t)GSEG * 4 * 128 * 4);
constexpr size_t OFF_GH = OFF_EH + AL((size_t)GSEG * 4 * 128 * 128 * 4);
constexpr size_t OFF_ES = OFF_GH + AL((size_t)GSEG * 4 * 128 * 4);
constexpr size_t WS_END = OFF_ES + AL((size_t)SSEG * 32 * 64 * 2 * 4);
constexpr size_t OFF_YS = OFF_E;
constexpr size_t OFF_RWT = WS_END;
constexpr size_t OFF_HIST = OFF_RWT + 32 * 1024 * 4;
constexpr size_t OFF_BAR = OFF_HIST + 1024 * 32 * 4;
constexpr size_t WS_TOTAL = OFF_BAR + 16384;
static_assert(OFF_YS + (size_t)SLOTS * 1024 * 2 <= WS_END, "YS must fit in the dead region");
static_assert(OFF_H + (size_t)SLOTS * 256 * 2 <= OFF_ZS, "H must fit in the dead Z region");
static_assert(OFF_WD + (size_t)32 * 1024 * 256 * 2 <= OFF_Z, "expert weights must fit in R1");

struct Args { const float* in[34]; float* out; unsigned char* ws; int ph_lo, ph_hi; };
typedef const __attribute__((address_space(4))) Args& ArgsRef;

extern __shared__ __attribute__((aligned(16))) unsigned char smem[];

__device__ __forceinline__ bf16_t f2bf(float f) { unsigned u = __float_as_uint(f); u += 0x7FFFu + ((u >> 16) & 1u); return (bf16_t)(u >> 16); }
__device__ __forceinline__ float bf2f(bf16_t b) { return __uint_as_float(((unsigned)b) << 16); }
__device__ __forceinline__ unsigned pack2(float lo, float hi) { return (unsigned)f2bf(lo) | ((unsigned)f2bf(hi) << 16); }
__device__ __forceinline__ float fexp(float x) { return __builtin_amdgcn_exp2f(x * 1.4426950408889634f); }
__device__ __forceinline__ float flog(float x) { return __builtin_amdgcn_logf(x) * 0.6931471805599453f; }
__device__ __forceinline__ float sigmoidf_(float x) { return __builtin_amdgcn_rcpf(1.0f + fexp(-x)); }
__device__ __forceinline__ float siluf_(float x) { return x * __builtin_amdgcn_rcpf(1.0f + fexp(-x)); }
__device__ __forceinline__ float logsigmoidf_(float x) { return fminf(x, 0.f) - log1pf(expf(-fabsf(x))); }
__device__ __forceinline__ float gelu_tanh(float y) { const float z = 0.7978845608028654f * (y + 0.044715f * y * y * y); const float th = 1.0f - 2.0f * __builtin_amdgcn_rcpf(fexp(2.0f * z) + 1.0f); return 0.5f * y * (1.0f + th); }
__device__ __forceinline__ void wave_sync() { __builtin_amdgcn_wave_barrier(); asm volatile("s_waitcnt lgkmcnt(0)" ::: "memory"); __builtin_amdgcn_wave_barrier(); }

#define MFMA16(a, b, c) __builtin_amdgcn_mfma_f32_16x16x32_bf16((a), (b), (c), 0, 0, 0)

template <int MT, int NT, class FA, class FB>
__device__ __forceinline__ void wave_gemm(f32x4 (&acc)[MT][NT], int K, FA arow, FB brow, int lane) {
    const int r = lane & 15, q = lane >> 4;
    const bf16_t* ap[MT]; const bf16_t* bp[NT];
#pragma unroll
    for (int m = 0; m < MT; ++m) ap[m] = arow(m * 16 + r) + 8 * q;
#pragma unroll
    for (int n = 0; n < NT; ++n) bp[n] = brow(n * 16 + r) + 8 * q;
#pragma unroll 1
    for (int k = 0; k < K; k += 32) {
        bf16x8 a[MT], b[NT];
#pragma unroll
        for (int m = 0; m < MT; ++m) a[m] = *(const bf16x8*)(ap[m] + k);
#pragma unroll
        for (int n = 0; n < NT; ++n) b[n] = *(const bf16x8*)(bp[n] + k);
#pragma unroll
        for (int m = 0; m < MT; ++m)
#pragma unroll
            for (int n = 0; n < NT; ++n) acc[m][n] = MFMA16(a[m], b[n], acc[m][n]);
    }
}
template <int MT, int NT> __device__ __forceinline__ void zero_acc(f32x4 (&acc)[MT][NT]) {
#pragma unroll
    for (int m = 0; m < MT; ++m)
#pragma unroll
        for (int n = 0; n < NT; ++n) acc[m][n] = (f32x4){0.f, 0.f, 0.f, 0.f};
}

namespace pg8 {
#define PG8_LAS __attribute__((address_space(3)))
constexpr int BM = 256, BK = 64, HALF = 128, HTB = HALF * BK * 2, STAGE_BYTES = 8 * HTB;
__device__ __forceinline__ int lds_byte(int r, int c) { const int st = (r >> 4) * 2 + (c >> 5), rr = r & 15, cc = c & 31, ob = rr * 64 + cc * 2; return st * 1024 + (ob ^ (((ob >> 9) & 1) << 5)); }
__device__ __forceinline__ void stage_rc(int b, int& R, int& C) { const int st = b / 1024, sb = b % 1024, swz = sb ^ (((sb >> 9) & 1) << 5); R = (st >> 1) * 16 + swz / 64; C = (st & 1) * 32 + (swz % 64) / 2; }
__device__ __forceinline__ int perm32(int rho) { const int n = rho >> 4, i = rho & 15; return 8 * (i >> 2) + 4 * n + (i & 3); }
struct Unit { int pm, pn, tag; const char* A; const char* B; };
__device__ __forceinline__ unsigned cvt_pk_bf16(float lo, float hi) { unsigned r; asm volatile("v_cvt_pk_bf16_f32 %0, %1, %2" : "=v"(r) : "v"(lo), "v"(hi)); return r; }
__device__ __forceinline__ bool tile_order(int L, int nM, int nN, int& pm, int& pn) {
    const int nwg = nM * nN; if (L >= nwg) return false;
    int wgid = L; { const int q = nwg / 8, r = nwg % 8, xcd = wgid % 8, off = wgid / 8; wgid = (xcd < r ? xcd * (q + 1) : r * (q + 1) + (xcd - r) * q) + off; }
    const int nig = 8 * nN, gid = wgid / nig, fm = gid * 8, gsz = (nM - fm) < 8 ? (nM - fm) : 8;
    pm = fm + ((wgid % nig) % gsz); pn = (wgid % nig) / gsz; return true;
}
template <class Epi, class Sched>
__device__ __forceinline__ void gemm_phase(PG8_LAS unsigned char* lds, const int tid, const int K, const int lda, const int ldb, const Sched& S, const Epi& E) {
    const int wid = __builtin_amdgcn_readfirstlane(tid >> 6), lane = tid & 63, wr = wid >> 2, wc = wid & 3, fr = lane & 15, fq = lane >> 4;
    const int nt = K / BK;
    unsigned voffA[2], voffB[2];
#pragma unroll
    for (int i = 0; i < 2; ++i) { int R, C; stage_rc(tid * 16 + i * 8192, R, C); const int Rb = Epi::PERM ? ((R & ~31) + perm32(R & 31)) : R;
        voffA[i] = (unsigned)(R * lda + C) * 2u; voffB[i] = (unsigned)(Rb * ldb + C) * 2u; }
    const size_t kstep = (size_t)(BK * 2), hstepA = (size_t)HALF * lda * 2, hstepB = (size_t)HALF * ldb * 2;
    const unsigned ldsw = (unsigned)wid * 1024u;
    const int aoff = lds_byte(wr * 64 + fr, fq * 8), boff = lds_byte(wc * 32 + fr, fq * 8);
#define PG8_SA(b, h) (((b) * 2 + (h)) * HTB)
#define PG8_SB(b, h) ((4 + (b) * 2 + (h)) * HTB)
#define PG8_STAGE(bufoff, gbase, voff) do { _Pragma("unroll") for (int _i = 0; _i < 2; ++_i) \
        __builtin_amdgcn_global_load_lds((const unsigned*)((const char*)(gbase) + (voff)[_i]), (PG8_LAS unsigned*)(lds + (bufoff) + ldsw + _i * 8192), 16, 0, 0); } while (0)
#define PG8_LDA(dst, b, h) do { _Pragma("unroll") for (int m = 0; m < 4; ++m) _Pragma("unroll") for (int k = 0; k < 2; ++k) dst[m][k] = *(const PG8_LAS bf16x8*)(lds + PG8_SA(b, h) + aoff + m * 2048 + k * 1024); } while (0)
#define PG8_LDB(dst, b, h) do { _Pragma("unroll") for (int n = 0; n < 2; ++n) _Pragma("unroll") for (int k = 0; k < 2; ++k) dst[n][k] = *(const PG8_LAS bf16x8*)(lds + PG8_SB(b, h) + boff + n * 2048 + k * 1024); } while (0)
#define PG8_MMA(ai, bj, At, Bt) do { __builtin_amdgcn_s_setprio(1); _Pragma("unroll") for (int m = 0; m < 4; ++m) _Pragma("unroll") for (int n = 0; n < 2; ++n) _Pragma("unroll") for (int k = 0; k < 2; ++k) \
        acc[ai][bj][m][n] = __builtin_amdgcn_mfma_f32_16x16x32_bf16(Bt[n][k], At[m][k], acc[ai][bj][m][n], 0, 0, 0); __builtin_amdgcn_s_setprio(0); } while (0)
#define PG8_WAIT_V(n) asm volatile("s_waitcnt vmcnt(" #n ")" ::: "memory")
#define PG8_WAIT_L(n) asm volatile("s_waitcnt lgkmcnt(" #n ")" ::: "memory")
#define PG8_BAR __builtin_amdgcn_s_barrier()
#define PG8_SCHED __builtin_amdgcn_sched_barrier(0)
    Unit cur, nxt; int ui = 0;
    if (!S.next(0, cur)) return;
    f32x4 acc[2][2][4][2];
#pragma unroll
    for (int a = 0; a < 2; ++a)
#pragma unroll
        for (int b = 0; b < 2; ++b)
#pragma unroll
            for (int m = 0; m < 4; ++m)
#pragma unroll
                for (int n = 0; n < 2; ++n) acc[a][b][m][n] = (f32x4){0.f, 0.f, 0.f, 0.f};
    bf16x8 At[4][2], B0[2][2], B1[2][2];
    const char* cA = cur.A; const char* cB = cur.B;
    PG8_STAGE(PG8_SB(0, 0), cB, voffB); PG8_STAGE(PG8_SA(0, 0), cA, voffA); PG8_STAGE(PG8_SB(0, 1), cB + hstepB, voffB); PG8_STAGE(PG8_SA(0, 1), cA + hstepA, voffA);
    if (wr == 1) PG8_BAR;
    PG8_WAIT_V(4); PG8_BAR;
    PG8_STAGE(PG8_SB(1, 0), cB + kstep, voffB); PG8_STAGE(PG8_SA(1, 0), cA + kstep, voffA); PG8_STAGE(PG8_SB(1, 1), cB + hstepB + kstep, voffB);
    PG8_WAIT_V(6); PG8_BAR;
    for (;;) {
        const bool has_next = S.next(ui + 1, nxt);
        const char* nA = has_next ? nxt.A : cA; const char* nB = has_next ? nxt.B : cB;
        for (int t = 0; t < nt; t += 2) {
            const bool last = (t == nt - 2);
            const char* a1 = cA + (size_t)(t + 1) * kstep;
            const char* a2 = last ? nA : cA + (size_t)(t + 2) * kstep; const char* b2 = last ? nB : cB + (size_t)(t + 2) * kstep;
            const char* a3 = a2 + kstep; const char* b3 = b2 + kstep;
            PG8_LDB(B0, 0, 0); PG8_SCHED; PG8_LDA(At, 0, 0); PG8_STAGE(PG8_SA(1, 1), a1 + hstepA, voffA);
            PG8_WAIT_L(8); PG8_BAR; PG8_WAIT_L(0); PG8_MMA(0, 0, At, B0); PG8_BAR; PG8_SCHED;
            PG8_LDB(B1, 0, 1); PG8_STAGE(PG8_SB(0, 0), b2, voffB);
            PG8_BAR; PG8_WAIT_L(0); PG8_MMA(0, 1, At, B1); PG8_BAR;
            PG8_LDA(At, 0, 1); PG8_STAGE(PG8_SA(0, 0), a2, voffA);
            PG8_BAR; PG8_WAIT_L(0); PG8_MMA(1, 0, At, B0); PG8_BAR; PG8_SCHED;
            PG8_STAGE(PG8_SB(0, 1), b2 + hstepB, voffB);
            PG8_WAIT_V(6); PG8_BAR; PG8_MMA(1, 1, At, B1); PG8_BAR;
            PG8_LDB(B0, 1, 0); PG8_SCHED; PG8_LDA(At, 1, 0); PG8_STAGE(PG8_SA(0, 1), a2 + hstepA, voffA);
            PG8_WAIT_L(8); PG8_BAR; PG8_WAIT_L(0); PG8_MMA(0, 0, At, B0); PG8_BAR; PG8_SCHED;
            PG8_LDB(B1, 1, 1); PG8_STAGE(PG8_SB(1, 0), b3, voffB);
            PG8_BAR; PG8_WAIT_L(0); PG8_MMA(0, 1, At, B1); PG8_BAR;
            PG8_LDA(At, 1, 1); PG8_STAGE(PG8_SA(1, 0), a3, voffA);
            PG8_BAR; PG8_WAIT_L(0); PG8_MMA(1, 0, At, B0); PG8_BAR; PG8_SCHED;
            PG8_STAGE(PG8_SB(1, 1), b3 + hstepB, voffB);
            PG8_WAIT_V(6); PG8_BAR; PG8_MMA(1, 1, At, B1); PG8_BAR;
        }
        const bool keep = E(acc, cur, wr, wc, fr, fq);
        if (!has_next) break;
        if (!keep) {
#pragma unroll
            for (int a = 0; a < 2; ++a)
#pragma unroll
                for (int b = 0; b < 2; ++b)
#pragma unroll
                    for (int m = 0; m < 4; ++m)
#pragma unroll
                        for (int n = 0; n < 2; ++n) acc[a][b][m][n] = (f32x4){0.f, 0.f, 0.f, 0.f};
        }
        cur = nxt; cA = nA; cB = nB; ++ui;
    }
    PG8_WAIT_V(0);
    if (wr == 0) PG8_BAR;
    PG8_BAR;
#undef PG8_SA
#undef PG8_SB
#undef PG8_STAGE
#undef PG8_LDA
#undef PG8_LDB
#undef PG8_MMA
#undef PG8_WAIT_V
#undef PG8_WAIT_L
#undef PG8_BAR
#undef PG8_SCHED
}
}

__device__ __forceinline__ void tconv_tile(const float* src, int ld_src, int nvalid, bf16_t* dst, int ld_dst, int tid) {
    float* t = (float*)smem;
    { const int r = tid >> 3, c0 = (tid & 7) * 8; float v[8];
      if (nvalid == 64) { const f32x4 a0 = *(const f32x4*)(src + (size_t)r * ld_src + c0), a1 = *(const f32x4*)(src + (size_t)r * ld_src + c0 + 4);
          v[0] = a0[0]; v[1] = a0[1]; v[2] = a0[2]; v[3] = a0[3]; v[4] = a1[0]; v[5] = a1[1]; v[6] = a1[2]; v[7] = a1[3]; }
      else {
#pragma unroll
          for (int j = 0; j < 8; ++j) { const int c = c0 + j; v[j] = (c < nvalid) ? src[(size_t)r * ld_src + c] : 0.f; } }
#pragma unroll
      for (int j = 0; j < 8; ++j) t[(c0 + j) * 65 + r] = v[j]; }
    __syncthreads();
    { const int n = tid >> 3, k0 = (tid & 7) * 8; const float* p = t + n * 65 + k0;
      u32x4 w; w.x = pack2(p[0], p[1]); w.y = pack2(p[2], p[3]); w.z = pack2(p[4], p[5]); w.w = pack2(p[6], p[7]);
      *(u32x4*)(dst + (size_t)n * ld_dst + k0) = w; }
    __syncthreads();
}

__device__ __forceinline__ void phase_prep(ArgsRef a, int l, int tid, int bid, int G) {
    unsigned char* ws = a.ws;
    bf16_t* WIN = (bf16_t*)(ws + OFF_WIN); bf16_t* WQKV = (bf16_t*)(ws + OFF_WQKV); bf16_t* WGLU = (bf16_t*)(ws + OFF_WGLU);
    bf16_t* WB = (bf16_t*)(ws + OFF_WB); bf16_t* WOUT = (bf16_t*)(ws + OFF_WOUT);
    for (int u = bid; u < 2624; u += G) {
        const float* src; int lds_ = 0, nvalid = 64, ldd = 0; bf16_t* dst;
        if (u < 1728) { const int nt = u / 16, kt = u % 16, p0 = nt * 64; int sc;
            if (p0 < 1024) sc = p0; else if (p0 < 6656) sc = p0 + 8; else if (p0 == 6656) { sc = 1024; nvalid = 8; } else { sc = 0; nvalid = 0; }
            src = a.in[1] + (size_t)l * 1024 * INW + (size_t)(kt * 64) * INW + sc; lds_ = INW; dst = WIN + (size_t)p0 * 1024 + kt * 64; ldd = 1024; }
        else if (u < 1920) { const int v = u - 1728, nt = v / 8, kt = v % 8, which = nt / 8, h = (nt % 8) / 2;
            if ((kt >> 1) != h) nvalid = 0;
            src = a.in[4 + which] + (size_t)(l * 4 + h) * 128 * 128 + ((kt & 1) * 64) * 128 + (nt & 1) * 64; lds_ = 128; dst = WQKV + (size_t)(nt * 64) * 512 + kt * 64; ldd = 512; }
        else if (u < 1984) { const int v = u - 1920, nt = v / 8, kt = v % 8;
            src = a.in[18] + (size_t)l * 512 * 512 + (kt * 64) * 512 + nt * 64; lds_ = 512; dst = WGLU + (size_t)(nt * 64) * 512 + kt * 64; ldd = 512; }
        else if (u < 2368) { const int v = u - 1984, b = v / 128, w = v % 128, nt = w / 8, kt = w % 8;
            src = a.in[21 + b] + (size_t)l * 512 * 1024 + (size_t)(kt * 64) * 1024 + nt * 64; lds_ = 1024; dst = WB + (size_t)b * 1024 * 512 + (size_t)(nt * 64) * 512 + kt * 64; ldd = 512; }
        else { const int v = u - 2368, nt = v / 16, kt = v % 16;
            src = a.in[24] + (size_t)l * 1024 * 1024 + (size_t)(kt * 64) * 1024 + nt * 64; lds_ = 1024; dst = WOUT + (size_t)(nt * 64) * 1024 + kt * 64; ldd = 1024; }
        tconv_tile(src, lds_, nvalid, dst, ldd, tid);
    }
    float* ABAR = (float*)(ws + OFF_ABAR); bf16_t* BBT = (bf16_t*)(ws + OFF_BBT); bf16_t* CCT = (bf16_t*)(ws + OFF_CCT);
    for (int i = bid * 512 + tid; i < 2048; i += G * 512) {
        const int g = i / 64, p = i % 64; const size_t gp = (size_t)(l * 32 + g) * 64 + p;
        const float lr = fminf(a.in[10][gp], -1e-4f), li = a.in[11][gp], dt = expf(a.in[12][l * 32 + g]);
        const float mag = expf(lr * dt), abr = mag * cosf(li * dt), abi = mag * sinf(li * dt);
        const float nr = abr - 1.0f, den = lr * lr + li * li, cr = (nr * lr + abi * li) / den, ci = (abi * lr - nr * li) / den;
        ABAR[(g * 64 + p) * 2] = abr; ABAR[(g * 64 + p) * 2 + 1] = abi;
        for (int c = 0; c < 16; ++c) { const float br = a.in[13][gp * 16 + c], bi = a.in[14][gp * 16 + c];
            BBT[(size_t)(g * 128 + p) * 16 + c] = f2bf(cr * br - ci * bi); BBT[(size_t)(g * 128 + 64 + p) * 16 + c] = f2bf(cr * bi + ci * br);
            const size_t ci_ = ((size_t)(l * 32 + g) * 16 + c) * 64 + p;
            CCT[(size_t)(g * 16 + c) * 128 + p] = f2bf(a.in[15][ci_]); CCT[(size_t)(g * 16 + c) * 128 + 64 + p] = f2bf(-a.in[16][ci_]); }
    }
    if (l == 0) { float* RWT = (float*)(ws + OFF_RWT); const float* RW = a.in[29]; for (int i = bid * 512 + tid; i < 32 * 1024; i += G * 512) RWT[i] = RW[(i & 1023) * 32 + (i >> 10)]; }
    if (l == 0) { bf16_t* XB = (bf16_t*)(ws + OFF_XB); const float* x = a.in[0];
        for (size_t i = (size_t)bid * 512 + tid; i < (size_t)T * 1024 / 8; i += (size_t)G * 512) {
            const f32x4 v0 = *(const f32x4*)(x + i * 8), v1 = *(const f32x4*)(x + i * 8 + 4);
            u32x4 w; w.x = pack2(v0[0], v0[1]); w.y = pack2(v0[2], v0[3]); w.z = pack2(v1[0], v1[1]); w.w = pack2(v1[2], v1[3]); *(u32x4*)(XB + i * 8) = w; } }
}

__device__ __forceinline__ void phase_prepx(ArgsRef a, int l, int tid, int bid, int G, int u_lo, int u_hi) {
    bf16_t* WGU = (bf16_t*)(a.ws + OFF_WGU); bf16_t* WD = (bf16_t*)(a.ws + OFF_WD);
    for (int u = u_lo + bid; u < u_hi; u += G) {
        const float* src; int lds_, ldd; bf16_t* dst;
        if (u < 4096) { const int up = u >= 2048, v = u & 2047, e = v / 64, w = v % 64, nt = w / 16, kt = w % 16, j0 = nt * 64, drow = (j0 / 128) * 256 + (j0 % 128) + up * 128;
            src = a.in[31 + up] + ((size_t)(l * 32 + e) * 1024 + kt * 64) * 256 + nt * 64; lds_ = 256; dst = WGU + ((size_t)e * 512 + drow) * 1024 + kt * 64; ldd = 1024; }
        else { const int v = u - 4096, e = v / 64, w = v % 64, nt = w / 4, kt = w % 4;
            src = a.in[33] + ((size_t)(l * 32 + e) * 256 + kt * 64) * 1024 + nt * 64; lds_ = 1024; dst = WD + ((size_t)e * 1024 + nt * 64) * 256 + kt * 64; ldd = 256; }
        tconv_tile(src, lds_, 64, dst, ldd, tid);
    }
}

constexpr int GL_RQ = 0, GL_RK = 17408, GL_VT = 34816, GL_RO = 57856, GL_RX = 75264, GL_KT = 92672, GL_PS = 102912, GL_SC1 = 105472, GL_SC2 = 105984, GL_GT = 106496, GL_OS = 108544, GL_LFS = 117248, GL_DNS = 117504;
template <int MODE, int PASS>
__device__ __forceinline__ void gla_item(ArgsRef a, int l, int h, int sg, int tid, int lane, int wave) {
    unsigned char* ws = a.ws;
    const bf16_t* Z = (const bf16_t*)(ws + OFF_Z); const bf16_t* Qg = (const bf16_t*)(ws + OFF_Q); const bf16_t* Kg = (const bf16_t*)(ws + OFF_KH); const bf16_t* Vg = (const bf16_t*)(ws + OFF_V); const bf16_t* XCg = (const bf16_t*)(ws + OFF_XC);
    const float* LF = (const float*)(ws + OFF_LF);
    float* Eg = (float*)(ws + (MODE == 0 ? OFF_EM : OFF_EH)); float* Gg = (float*)(ws + (MODE == 0 ? OFF_GM : OFF_GH)); float* EX = (float*)(ws + OFF_EMX);
    bf16_t* Yg = (bf16_t*)(ws + (MODE == 0 ? OFF_OM : OFF_OH));
    bf16_t* KT = (bf16_t*)(smem + GL_KT); bf16_t* PS = (bf16_t*)(smem + GL_PS);
    float* SC1 = (float*)(smem + GL_SC1); float* SC2 = (float*)(smem + GL_SC2); float* GT = (float*)(smem + GL_GT); bf16_t* OS = (bf16_t*)(smem + GL_OS); float* DNS = (float*)(smem + GL_DNS);
    const int r = lane & 15, q = lane >> 4, grp = tid >> 7, d = tid & 127, tok = tid >> 4, c8 = (tid & 15) * 8;
    const bool xw = (MODE == 0) && (wave == 0);
    float lb = 0.f;
    if (MODE == 1 && l == 1) { const float h0 = a.in[19][h * 128 + d], h1 = a.in[19][512 + h * 128 + d]; lb = 1.0f / (1.0f + expf(h0 - h1)); }
    f32x4 S[8], SX[8];
#pragma unroll
    for (int i = 0; i < 8; ++i) { S[i] = (f32x4){0.f, 0.f, 0.f, 0.f}; SX[i] = (f32x4){0.f, 0.f, 0.f, 0.f}; }
    if (PASS == 2) {
#pragma unroll
        for (int i = 0; i < 8; ++i)
#pragma unroll
            for (int g = 0; g < 4; ++g) { const size_t row = (size_t)(sg * 4 + h) * 128 + 16 * i + 4 * q + g; S[i][g] = Eg[row * 128 + 16 * wave + r]; if (xw) SX[i][g] = EX[row * 16 + r]; }
    }
    const bf16x8 z8 = (bf16x8){0, 0, 0, 0, 0, 0, 0, 0};
    bf16x8 rq = z8, rk = z8, rv = z8, ro = z8, rx = z8; float lfv = 0.f;
#define GLA_FETCH(t0_) do { const size_t tk = (size_t)((t0_) + tok); \
        if (MODE == 1) { const bf16_t* zp = Z + tk * NZ + h * 128 + c8; if (PASS == 2) { rq = *(const bf16x8*)(zp + 1536); ro = *(const bf16x8*)(zp + 3072); } rk = *(const bf16x8*)(zp + 2048); rv = *(const bf16x8*)(zp + 2560); } \
        else { const size_t o_ = tk * 512 + h * 128 + c8; if (PASS == 2) { rq = *(const bf16x8*)(Qg + o_); ro = *(const bf16x8*)(Z + tk * NZ + 512 + h * 128 + c8); rx = *(const bf16x8*)(XCg + o_); } \
               rk = *(const bf16x8*)(Kg + o_); rv = *(const bf16x8*)(Vg + o_); if (tid < 32) lfv = LF[((t0_) + tid) * 4 + h]; } } while (0)
    GLA_FETCH(sg * GSEGLEN);
    float sk8[8], nw8[8];
#pragma unroll
    for (int j = 0; j < 8; ++j) { sk8[j] = (MODE == 0 && PASS == 2) ? a.in[9][l * 512 + h * 128 + c8 + j] : 0.f; nw8[j] = (MODE == 1 && PASS == 2) ? a.in[20][l * 512 + h * 128 + c8 + j] : 0.f; }
    __syncthreads();
    if (MODE == 0) { for (int i = tid; i < 2 * 16 * 40; i += 512) { const int b = i / 640, k = i % 640; ((bf16_t*)(smem + GL_VT + b * 11520))[128 * 40 + k] = (k < 32) ? (bf16_t)0x3F80 : (bf16_t)0; } }
#define GLA_STORE(tprev, pb) do { const bf16x8 o8 = *(const bf16x8*)(OS + tok * 136 + c8); const bf16x8 p8 = *(const bf16x8*)((const bf16_t*)(smem + GL_RO + (pb) * 8704) + tok * 136 + c8); float y[8]; \
        if (MODE == 0) { const bf16x8 x8 = *(const bf16x8*)((const bf16_t*)(smem + GL_RX + (pb) * 8704) + tok * 136 + c8); const float di = __builtin_amdgcn_rcpf(fmaxf(fabsf(DNS[tok]), 1.0f)); \
            _Pragma("unroll") for (int j = 0; j < 8; ++j) y[j] = sigmoidf_(bf2f((bf16_t)p8[j])) * (bf2f((bf16_t)o8[j]) * di) + sk8[j] * bf2f((bf16_t)x8[j]); } \
        else { float ov[8], ss = 0.f; _Pragma("unroll") for (int j = 0; j < 8; ++j) { ov[j] = bf2f((bf16_t)o8[j]); ss += ov[j] * ov[j]; } \
            ss += __shfl_xor(ss, 1); ss += __shfl_xor(ss, 2); ss += __shfl_xor(ss, 4); ss += __shfl_xor(ss, 8); const float rinv = rsqrtf(ss * (1.0f / 128.0f) + 1e-6f); \
            _Pragma("unroll") for (int j = 0; j < 8; ++j) y[j] = ov[j] * rinv * nw8[j] * siluf_(bf2f((bf16_t)p8[j])); } \
        u32x4 w_; w_.x = pack2(y[0], y[1]); w_.y = pack2(y[2], y[3]); w_.z = pack2(y[4], y[5]); w_.w = pack2(y[6], y[7]); *(u32x4*)(Yg + (size_t)((tprev) + tok) * 512 + h * 128 + c8) = w_; } while (0)
    float runb = 0.f;
    for (int ci = 0; ci < GSEGLEN / 32; ++ci) {
        const int t0 = sg * GSEGLEN + ci * 32, buf = ci & 1;
        bf16_t* RQ = (bf16_t*)(smem + GL_RQ + buf * 8704); bf16_t* RK = (bf16_t*)(smem + GL_RK + buf * 8704); bf16_t* VT = (bf16_t*)(smem + GL_VT + buf * 11520);
        float* LFS = (float*)(smem + GL_LFS + buf * 128);
        if (PASS == 2) { *(bf16x8*)(RQ + tok * 136 + c8) = rq; *(bf16x8*)((bf16_t*)(smem + GL_RO + buf * 8704) + tok * 136 + c8) = ro; if (MODE == 0) *(bf16x8*)((bf16_t*)(smem + GL_RX + buf * 8704) + tok * 136 + c8) = rx; }
        *(bf16x8*)(RK + tok * 136 + c8) = rk;
#pragma unroll
        for (int j = 0; j < 8; ++j) VT[(c8 + j) * 40 + tok] = (bf16_t)rv[j];
        if (MODE == 0 && tid < 32) LFS[tid] = lfv;
        if (ci + 1 < GSEGLEN / 32) GLA_FETCH(t0 + 32);
        __syncthreads();
        float lg[8], kv[8];
#pragma unroll
        for (int j = 0; j < 8; ++j) { const float kr = bf2f(RK[(grp * 8 + j) * 136 + d]);
            if (MODE == 1) { const float f = lb + (1.0f - lb) * sigmoidf_(kr); lg[j] = flog(f); kv[j] = 1.0f - f; } else { lg[j] = LFS[grp * 8 + j]; kv[j] = kr; } }
        float cs[8]; cs[0] = lg[0];
#pragma unroll
        for (int j = 1; j < 8; ++j) cs[j] = cs[j - 1] + lg[j];
        GT[grp * 128 + d] = cs[7];
        __syncthreads();
        if (PASS == 2 && ci > 0) GLA_STORE(t0 - 32, buf ^ 1);
        const float g0 = GT[d], g1 = GT[128 + d], g2 = GT[256 + d], g3 = GT[384 + d];
        const float off = grp == 0 ? 0.f : grp == 1 ? g0 : grp == 2 ? g0 + g1 : g0 + g1 + g2;
        const float bmid = g0 + g1, bL = bmid + g2 + g3;
        bf16_t ktv[8];
#pragma unroll
        for (int j = 0; j < 8; ++j) { const float bt = off + cs[j], ek = fexp(bmid - bt); const bf16_t kt = f2bf(kv[j] * ek); ktv[j] = kt;
            if (PASS == 2) { const float qr = bf2f(RQ[(grp * 8 + j) * 136 + d]); const float qq = (MODE == 1) ? siluf_(qr) : qr; RQ[(grp * 8 + j) * 136 + d] = f2bf(qq * __builtin_amdgcn_rcpf(ek)); RK[(grp * 8 + j) * 136 + d] = kt; } }
        { u32x4 w; w.x = ktv[0] | ((unsigned)ktv[1] << 16); w.y = ktv[2] | ((unsigned)ktv[3] << 16); w.z = ktv[4] | ((unsigned)ktv[5] << 16); w.w = ktv[6] | ((unsigned)ktv[7] << 16); *(u32x4*)(KT + d * 40 + grp * 8) = w; }
        if (grp == 0) { SC1[d] = fexp(bmid); SC2[d] = fexp(bL - bmid); runb += bL; }
        __syncthreads();
        if (PASS == 2) {
            if (wave < 4) {
                const int ti = (wave == 1 || wave == 2) ? 1 : 0, tj = (wave >= 2) ? 1 : 0;
                f32x4 p = (f32x4){0.f, 0.f, 0.f, 0.f};
                if (wave < 3) {
#pragma unroll
                    for (int kk = 0; kk < 4; ++kk) { const bf16x8 av = *(const bf16x8*)(RQ + (16 * ti + r) * 136 + 32 * kk + 8 * q); const bf16x8 bv = *(const bf16x8*)(RK + (16 * tj + r) * 136 + 32 * kk + 8 * q); p = MFMA16(av, bv, p); }
                }
#pragma unroll
                for (int g = 0; g < 4; ++g) { const int t = 16 * ti + 4 * q + g, s_ = 16 * tj + r; PS[t * 40 + s_] = (wave < 3 && s_ <= t) ? f2bf(p[g]) : (bf16_t)0; }
            }
            __syncthreads();
        }
        const bf16x8 bV = *(const bf16x8*)(VT + (16 * wave + r) * 40 + 8 * q);
        bf16x8 bV1 = bV; if (xw) bV1 = *(const bf16x8*)(VT + (128 + r) * 40 + 8 * q);
        f32x4 o[2], ox[2];
        o[0] = o[1] = ox[0] = ox[1] = (f32x4){0.f, 0.f, 0.f, 0.f};
#pragma unroll
        for (int kk = 0; kk < 4; ++kk) {
            const f32x4 sa = *(const f32x4*)(SC1 + 32 * kk + 4 * q), sb = *(const f32x4*)(SC1 + 32 * kk + 16 + 4 * q);
            S[2 * kk] *= sa; S[2 * kk + 1] *= sb;
            if (xw) { SX[2 * kk] *= sa; SX[2 * kk + 1] *= sb; }
            if (PASS == 2) {
                bf16x8 bS, bX;
#pragma unroll
                for (int g = 0; g < 4; ++g) { bS[g] = (short)f2bf(S[2 * kk][g]); bS[4 + g] = (short)f2bf(S[2 * kk + 1][g]); bX[g] = (short)f2bf(SX[2 * kk][g]); bX[4 + g] = (short)f2bf(SX[2 * kk + 1][g]); }
#pragma unroll
                for (int mt = 0; mt < 2; ++mt) { const bf16x4 lo = *(const bf16x4*)(RQ + (16 * mt + r) * 136 + 32 * kk + 4 * q), hi = *(const bf16x4*)(RQ + (16 * mt + r) * 136 + 32 * kk + 16 + 4 * q);
                    bf16x8 av; av[0] = lo[0]; av[1] = lo[1]; av[2] = lo[2]; av[3] = lo[3]; av[4] = hi[0]; av[5] = hi[1]; av[6] = hi[2]; av[7] = hi[3];
                    o[mt] = MFMA16(av, bS, o[mt]); if (xw) ox[mt] = MFMA16(av, bX, ox[mt]); }
            }
        }
        if (PASS == 2) {
#pragma unroll
            for (int mt = 0; mt < 2; ++mt) { const bf16x8 av = *(const bf16x8*)(PS + (16 * mt + r) * 40 + 8 * q); o[mt] = MFMA16(av, bV, o[mt]); if (xw) ox[mt] = MFMA16(av, bV1, ox[mt]);
#pragma unroll
                for (int g = 0; g < 4; ++g) { OS[(16 * mt + 4 * q + g) * 136 + 16 * wave + r] = f2bf(o[mt][g]); if (xw && r == 0) DNS[16 * mt + 4 * q + g] = ox[mt][g]; } }
        }
#pragma unroll
        for (int i = 0; i < 8; ++i) { const bf16x8 av = *(const bf16x8*)(KT + (16 * i + r) * 40 + 8 * q); const f32x4 s2 = *(const f32x4*)(SC2 + 16 * i + 4 * q);
            S[i] = MFMA16(av, bV, S[i]); S[i] *= s2;
            if (xw) { SX[i] = MFMA16(av, bV1, SX[i]); SX[i] *= s2; } }
    }
    if (PASS == 2) { __syncthreads(); GLA_STORE(sg * GSEGLEN + GSEGLEN - 32, 1); }
    if (PASS == 1) {
        float* ST = (float*)smem;
        __syncthreads();
#pragma unroll
        for (int i = 0; i < 8; ++i)
#pragma unroll
            for (int g = 0; g < 4; ++g) { ST[(16 * i + 4 * q + g) * 132 + 16 * wave + r] = S[i][g]; if (xw) EX[((size_t)(sg * 4 + h) * 128 + 16 * i + 4 * q + g) * 16 + r] = SX[i][g]; }
        __syncthreads();
#pragma unroll
        for (int k = 0; k < 8; ++k) { const int idx = tid + 512 * k, row = idx >> 5, c4 = (idx & 31) * 4; *(f32x4*)(Eg + ((size_t)(sg * 4 + h) * 128 + row) * 128 + c4) = *(const f32x4*)(ST + row * 132 + c4); }
        if (grp == 0) Gg[(size_t)(sg * 4 + h) * 128 + d] = expf(runb);
    }
#undef GLA_FETCH
#undef GLA_STORE
}

template <int PASS>
__device__ __forceinline__ void s5_item(ArgsRef a, int l, int g, int sg, int g0, int tid, int lane, int wave, int hsel) {
    unsigned char* ws = a.ws;
    const bf16_t* Z = (const bf16_t*)(ws + OFF_Z); const float* ABAR = (const float*)(ws + OFF_ABAR); const bf16_t* BBT = (const bf16_t*)(ws + OFF_BBT); const bf16_t* CCT = (const bf16_t*)(ws + OFF_CCT);
    float* ES = (float*)(ws + OFF_ES); bf16_t* YPRE = (bf16_t*)(ws + OFF_YPRE);
    float* BU = (float*)(smem + 70000 + (wave & 3) * 12800); bf16_t* X = (bf16_t*)(smem + 70000 + (wave & 3) * 12800 + 8448); bf16_t* YT = (bf16_t*)(smem + 70000 + 51200);
    const int r = lane & 15, q = lane >> 4, p = lane; const bool act = (wave >> 2) == hsel;
    const float ar = ABAR[(g * 64 + p) * 2], ai = ABAR[(g * 64 + p) * 2 + 1];
    const bf16x8 zero8 = (bf16x8){0, 0, 0, 0, 0, 0, 0, 0};
    bf16x8 bB[8], cB[4];
#pragma unroll
    for (int nt = 0; nt < 8; ++nt) bB[nt] = (q < 2) ? *(const bf16x8*)(BBT + (size_t)(g * 128 + 16 * nt + r) * 16 + 8 * q) : zero8;
#pragma unroll
    for (int kk = 0; kk < 4; ++kk) cB[kk] = (PASS == 2) ? *(const bf16x8*)(CCT + (size_t)(g * 16 + r) * 128 + 32 * kk + 8 * q) : zero8;
    float xr = 0.f, xi = 0.f;
    if (PASS == 2) { xr = ES[((size_t)(sg * 32 + g) * 64 + p) * 2]; xi = ES[((size_t)(sg * 32 + g) * 64 + p) * 2 + 1]; }
    const float dsk = a.in[17][l * 512 + 16 * g + r];
    for (int ci = 0; ci < SSEGLEN / 16; ++ci) {
        const int t0 = sg * SSEGLEN + ci * 16;
        if (act) {
            const bf16x8 av = (q < 2) ? *(const bf16x8*)(Z + (size_t)(t0 + r) * NZ + 1024 + 16 * g + 8 * q) : zero8;
#pragma unroll
            for (int nt = 0; nt < 8; ++nt) { f32x4 acc = (f32x4){0.f, 0.f, 0.f, 0.f}; acc = MFMA16(av, bB[nt], acc);
#pragma unroll
                for (int gg = 0; gg < 4; ++gg) BU[(4 * q + gg) * 132 + 16 * nt + r] = acc[gg]; }
            wave_sync();
#pragma unroll
            for (int t = 0; t < 16; ++t) { const float br = BU[t * 132 + p], bi = BU[t * 132 + 64 + p];
                const float nr = ar * xr - ai * xi + br, ni = ar * xi + ai * xr + bi; xr = nr; xi = ni;
                if (PASS == 2) { X[t * 136 + p] = f2bf(xr); X[t * 136 + 64 + p] = f2bf(xi); } }
            wave_sync();
            if (PASS == 2) {
                f32x4 acc = (f32x4){0.f, 0.f, 0.f, 0.f};
#pragma unroll
                for (int kk = 0; kk < 4; ++kk) { const bf16x8 xv = *(const bf16x8*)(X + r * 136 + 32 * kk + 8 * q); acc = MFMA16(xv, cB[kk], acc); }
#pragma unroll
                for (int gg = 0; gg < 4; ++gg) { const int t = t0 + 4 * q + gg, c = 16 * g + r; const float u = bf2f(Z[(size_t)t * NZ + 1024 + c]);
                    YT[(4 * q + gg) * 136 + 16 * wave + r] = f2bf(gelu_tanh(acc[gg] + dsk * u)); }
            }
        }
        if (PASS == 2) {
            __syncthreads();
            if (tid < 128) { const int row = tid >> 3, c8 = (tid & 7) * 8; *(u32x4*)(YPRE + (size_t)(t0 + row) * 512 + 16 * g0 + 64 * hsel + c8) = *(const u32x4*)(YT + row * 136 + 64 * hsel + c8); }
            __syncthreads();
        }
    }
    if (PASS == 1 && act) { ES[((size_t)(sg * 32 + g) * 64 + p) * 2] = xr; ES[((size_t)(sg * 32 + g) * 64 + p) * 2 + 1] = xi; }
}

__device__ __forceinline__ void phase_scan(ArgsRef a, int tid, int bid, int G) {
    unsigned char* ws = a.ws;
    const int NT = G * 512, gt = bid * 512 + tid;
    for (int i = gt; i < 2 * 65536 + 8192 + 2048; i += NT) {
        if (i < 2 * 65536) { const int m = i >> 16, el = i & 65535, hrow = el >> 7;
            float* E = (float*)(ws + (m == 0 ? OFF_EM : OFF_EH)); const float* Gd = (const float*)(ws + (m == 0 ? OFF_GM : OFF_GH));
            float cur = 0.f;
#pragma unroll 8
            for (int sg = 0; sg < GSEG; ++sg) { const float e = E[(size_t)sg * 65536 + el], g = Gd[sg * 512 + hrow]; E[(size_t)sg * 65536 + el] = cur; cur = g * cur + e; } }
        else if (i < 2 * 65536 + 8192) { const int el = i - 2 * 65536, hrow = el >> 4; float* E = (float*)(ws + OFF_EMX); const float* Gd = (const float*)(ws + OFF_GM);
            float cur = 0.f;
#pragma unroll 8
            for (int sg = 0; sg < GSEG; ++sg) { const float e = E[(size_t)sg * 8192 + el], g = Gd[sg * 512 + hrow]; E[(size_t)sg * 8192 + el] = cur; cur = g * cur + e; } }
        else { const int el = i - 2 * 65536 - 8192; float* E = (float*)(ws + OFF_ES); const float* ABAR = (const float*)(ws + OFF_ABAR);
            float pr = ABAR[el * 2], pi = ABAR[el * 2 + 1];
#pragma unroll
            for (int k = 0; k < 8; ++k) { const float nr = pr * pr - pi * pi, ni = 2.0f * pr * pi; pr = nr; pi = ni; }
            float xr = 0.f, xi = 0.f;
#pragma unroll 8
            for (int sg = 0; sg < SSEG; ++sg) { const float er = E[((size_t)sg * 2048 + el) * 2], ei = E[((size_t)sg * 2048 + el) * 2 + 1];
                E[((size_t)sg * 2048 + el) * 2] = xr; E[((size_t)sg * 2048 + el) * 2 + 1] = xi;
                const float nr = pr * xr - pi * xi + er, ni = pr * xi + pi * xr + ei; xr = nr; xi = ni; } }
    }
}

template <int PASS>
__device__ __forceinline__ void phase_mixers(ArgsRef a, int l, int tid, int lane, int wave, int bid, int G) {
    for (int it = bid; it < 4 * GSEG; it += G) gla_item<0, PASS>(a, l, it % 4, it / 4, tid, lane, wave);
    asm volatile("" ::: "memory");
    for (int it = bid + ((4 * GSEG - bid % G) % G + G) % G * 0; it < 2 * 4 * GSEG; it += G) { if (it >= 4 * GSEG) gla_item<1, PASS>(a, l, (it - 4 * GSEG) % 4, (it - 4 * GSEG) / 4, tid, lane, wave); }
    __syncthreads();
    for (int it0 = bid * 8; it0 < 32 * SSEG; it0 += G * 8)
        for (int half = 0; half < 2; ++half) { const int it = it0 + wave; s5_item<PASS>(a, l, it % 32, it / 32, it0 % 32, tid, lane, wave, half); __syncthreads(); }
}

__device__ __forceinline__ void phase_post(ArgsRef a, int l, int lane, int gw, int GW) {
    const bf16_t* Z = (const bf16_t*)(a.ws + OFF_Z); const bf16_t* XC = (const bf16_t*)(a.ws + OFF_XC);
    bf16_t* OM = (bf16_t*)(a.ws + OFF_OM); bf16_t* OH = (bf16_t*)(a.ws + OFF_OH); const float* DEN = (const float*)(a.ws + OFF_DEN);
    const int c0 = lane * 8, hd = lane >> 4;
    float skp[8], nw[8];
#pragma unroll
    for (int j = 0; j < 8; ++j) { skp[j] = a.in[9][l * 512 + c0 + j]; nw[j] = a.in[20][l * 512 + c0 + j]; }
    for (int tb = gw * 4; tb < T; tb += GW * 4) {
        bf16x8 om[4], op[4], xc[4], oh[4], gp[4]; float dn[4];
#pragma unroll
        for (int k = 0; k < 4; ++k) { const size_t t = tb + k; om[k] = *(const bf16x8*)(OM + t * 512 + c0); op[k] = *(const bf16x8*)(Z + t * NZ + 512 + c0); xc[k] = *(const bf16x8*)(XC + t * 512 + c0);
            oh[k] = *(const bf16x8*)(OH + t * 512 + c0); gp[k] = *(const bf16x8*)(Z + t * NZ + 3072 + c0); dn[k] = DEN[hd * T + t]; }
#pragma unroll
        for (int k = 0; k < 4; ++k) { const size_t t = tb + k; const float di = __builtin_amdgcn_rcpf(fmaxf(fabsf(dn[k]), 1.0f)); float y[8], ov[8], ss = 0.f;
#pragma unroll
            for (int j = 0; j < 8; ++j) { y[j] = sigmoidf_(bf2f((bf16_t)op[k][j])) * (bf2f((bf16_t)om[k][j]) * di) + skp[j] * bf2f((bf16_t)xc[k][j]); ov[j] = bf2f((bf16_t)oh[k][j]); ss += ov[j] * ov[j]; }
            u32x4 w; w.x = pack2(y[0], y[1]); w.y = pack2(y[2], y[3]); w.z = pack2(y[4], y[5]); w.w = pack2(y[6], y[7]); *(u32x4*)(OM + t * 512 + c0) = w;
            ss += __shfl_xor(ss, 1); ss += __shfl_xor(ss, 2); ss += __shfl_xor(ss, 4); ss += __shfl_xor(ss, 8);
            const float rinv = rsqrtf(ss * (1.0f / 128.0f) + 1e-6f);
#pragma unroll
            for (int j = 0; j < 8; ++j) y[j] = ov[j] * rinv * nw[j] * siluf_(bf2f((bf16_t)gp[k][j]));
            u32x4 x; x.x = pack2(y[0], y[1]); x.y = pack2(y[2], y[3]); x.z = pack2(y[4], y[5]); x.w = pack2(y[6], y[7]); *(u32x4*)(OH + t * 512 + c0) = x; }
    }
}

__device__ __forceinline__ void ln_row(f32x4 (&v)[4], const float* gam, const float* bet, int lane) {
    float s = 0.f;
#pragma unroll
    for (int j = 0; j < 4; ++j) s += (v[j][0] + v[j][1]) + (v[j][2] + v[j][3]);
#pragma unroll
    for (int o = 32; o >= 1; o >>= 1) s += __shfl_xor(s, o);
    const float mean = s * (1.0f / 1024.0f); float qv = 0.f;
#pragma unroll
    for (int j = 0; j < 4; ++j) { const f32x4 dd = v[j] - mean; qv += (dd[0] * dd[0] + dd[1] * dd[1]) + (dd[2] * dd[2] + dd[3] * dd[3]); }
#pragma unroll
    for (int o = 32; o >= 1; o >>= 1) qv += __shfl_xor(qv, o);
    const float rstd = rsqrtf(qv * (1.0f / 1024.0f) + 1e-5f);
#pragma unroll
    for (int j = 0; j < 4; ++j) { const f32x4 gg = *(const f32x4*)(gam + 256 * j + 4 * lane), bb = *(const f32x4*)(bet + 256 * j + 4 * lane); v[j] = (v[j] - mean) * rstd * gg + bb; }
}

__device__ __forceinline__ void phase_ln1r(ArgsRef a, int l, int tid, int lane, int wave, int bid, int G) {
    float* XF = a.out; bf16_t* XB = (bf16_t*)(a.ws + OFF_XB);
    int* TOKE = (int*)(a.ws + OFF_TOKE); float* TOKG = (float*)(a.ws + OFF_TOKG); unsigned* HIST = (unsigned*)(a.ws + OFF_HIST);
    const float* RWT = (const float*)(a.ws + OFF_RWT); const float* RB = a.in[30];
    float* LG = (float*)(smem + wave * 4096);
    int* TE = (int*)(smem + wave * 4096 + 2304); float* TG = (float*)(smem + wave * 4096 + 2432); unsigned* HS = (unsigned*)(smem + wave * 4096 + 2560);
    const int r = lane & 15, q = lane >> 4, rs = lane >> 5, e = lane & 31;
    for (int tw = bid * 8 + wave; tw < T / 16; tw += G * 8) {
        const int t0 = tw * 16;
        for (int rb = 0; rb < 16; rb += 4) { f32x4 v[4][4];
#pragma unroll
            for (int k = 0; k < 4; ++k)
#pragma unroll
                for (int j = 0; j < 4; ++j) v[k][j] = *(const f32x4*)(XF + (size_t)(t0 + rb + k) * 1024 + 256 * j + 4 * lane);
#pragma unroll
            for (int k = 0; k < 4; ++k) { const int t = t0 + rb + k; ln_row(v[k], a.in[25] + l * 1024, a.in[26] + l * 1024, lane);
#pragma unroll
                for (int j = 0; j < 4; ++j) { *(f32x4*)(XF + (size_t)t * 1024 + 256 * j + 4 * lane) = v[k][j];
                    u32x2 w; w.x = pack2(v[k][j][0], v[k][j][1]); w.y = pack2(v[k][j][2], v[k][j][3]); *(u32x2*)(XB + (size_t)t * 1024 + 256 * j + 4 * lane) = w; } } }
        if (lane < 32) HS[lane] = 0u;
        asm volatile("s_waitcnt vmcnt(0) lgkmcnt(0)" ::: "memory"); __builtin_amdgcn_wave_barrier();
        f32x4 acc0 = (f32x4){0.f, 0.f, 0.f, 0.f}, acc1 = acc0;
        const float* xa = XF + (size_t)(t0 + r) * 1024 + 4 * q; const float* w0 = RWT + (size_t)r * 1024 + 4 * q; const float* w1 = RWT + (size_t)(16 + r) * 1024 + 4 * q;
#pragma unroll 4
        for (int s = 0; s < 64; ++s) { const f32x4 av = *(const f32x4*)(xa + 16 * s), b0 = *(const f32x4*)(w0 + 16 * s), b1 = *(const f32x4*)(w1 + 16 * s);
#pragma unroll
            for (int j = 0; j < 4; ++j) { acc0 = __builtin_amdgcn_mfma_f32_16x16x4f32(av[j], b0[j], acc0, 0, 0, 0); acc1 = __builtin_amdgcn_mfma_f32_16x16x4f32(av[j], b1[j], acc1, 0, 0, 0); } }
#pragma unroll
        for (int g = 0; g < 4; ++g) { LG[(4 * q + g) * 33 + r] = acc0[g]; LG[(4 * q + g) * 33 + 16 + r] = acc1[g]; }
        wave_sync();
        for (int pp = 0; pp < 8; ++pp) {
            const float lg = LG[(2 * pp + rs) * 33 + e];
            const float s = sigmoidf_(lg), sb = s + RB[e];
            float v4[4];
#pragma unroll
            for (int i = 0; i < 4; ++i) v4[i] = __shfl(sb, (lane & ~3) + i);
            int i1 = 0;
#pragma unroll
            for (int i = 1; i < 4; ++i) if (v4[i] > v4[i1]) i1 = i;
            int i2 = (i1 == 0) ? 1 : 0;
#pragma unroll
            for (int i = 0; i < 4; ++i) if (i != i1 && i != i2 && v4[i] > v4[i2]) i2 = i;
            float gs = v4[i1] + v4[i2]; int gid = e >> 2;
#pragma unroll
            for (int o = 4; o <= 16; o <<= 1) { const float os = __shfl_xor(gs, o); const int og = __shfl_xor(gid, o); if (os > gs || (os == gs && og < gid)) { gs = os; gid = og; } }
            float sv[4], sbv[4];
#pragma unroll
            for (int i = 0; i < 4; ++i) { sbv[i] = __shfl(sb, (lane & 32) + gid * 4 + i); sv[i] = __shfl(s, (lane & 32) + gid * 4 + i); }
            int j1 = 0;
#pragma unroll
            for (int i = 1; i < 4; ++i) if (sbv[i] > sbv[j1]) j1 = i;
            int j2 = (j1 == 0) ? 1 : 0;
#pragma unroll
            for (int i = 0; i < 4; ++i) if (i != j1 && i != j2 && sbv[i] > sbv[j2]) j2 = i;
            float s1 = sv[0], s2 = sv[0];
#pragma unroll
            for (int i = 1; i < 4; ++i) { if (i == j1) s1 = sv[i]; if (i == j2) s2 = sv[i]; }
            if (e == 0) { const int ti = 2 * pp + rs; const float inv = 1.0f / (s1 + s2);
                TE[ti * 2] = gid * 4 + j1; TE[ti * 2 + 1] = gid * 4 + j2; TG[ti * 2] = s1 * inv; TG[ti * 2 + 1] = s2 * inv;
                atomicAdd(&HS[gid * 4 + j1], 1u); atomicAdd(&HS[gid * 4 + j2], 1u); }
        }
        wave_sync();
        if (lane < 32) { TOKE[t0 * 2 + lane] = TE[lane]; TOKG[t0 * 2 + lane] = TG[lane]; HIST[tw * 32 + lane] = HS[lane]; }
        wave_sync();
    }
}

__device__ __forceinline__ void phase_slot(ArgsRef a, int tid, int lane, int wave, int bid, int G) {
    const int* TOKE = (const int*)(a.ws + OFF_TOKE); int* TOKS = (int*)(a.ws + OFF_TOKS); const unsigned* HIST = (const unsigned*)(a.ws + OFF_HIST);
    unsigned* BASE = (unsigned*)(a.ws + OFF_CTL) + 64;
    const bf16_t* XB = (const bf16_t*)(a.ws + OFF_XB); bf16_t* XG = (bf16_t*)(a.ws + OFF_XG);
    unsigned* base = (unsigned*)smem; unsigned* pre = base + 40; int* el = (int*)(base + 80); int* sl = (int*)(base + 208); unsigned* red = base + 336;
    const int e = tid & 31, part = tid >> 5;
    for (int c = bid; c < T / 64; c += G) {
        unsigned tot = 0u, pr = 0u;
#pragma unroll 8
        for (int it = part; it < 1024; it += 16) { const unsigned v = HIST[it * 32 + e]; tot += v; pr += (it < 4 * c) ? v : 0u; }
        red[part * 32 + e] = tot; red[512 + part * 32 + e] = pr;
        __syncthreads();
        if (tid < 32) { unsigned t2 = 0u, p2 = 0u; for (int k = 0; k < 16; ++k) { t2 += red[k * 32 + tid]; p2 += red[512 + k * 32 + tid]; } pre[tid] = p2; red[tid] = (t2 + 255u) & ~255u; }
        __syncthreads();
        if (tid == 0) { unsigned sacc = 0; for (int k = 0; k < 32; ++k) { base[k] = sacc; sacc += red[k]; } base[32] = sacc; }
        int ee = 0;
        if (tid < 128) { ee = TOKE[c * 128 + tid]; el[tid] = ee; }
        __syncthreads();
        if (c == 0 && tid < 33) BASE[tid] = base[tid];
        if (tid < 128) { unsigned rank = 0; for (int i = 0; i < tid; ++i) rank += (el[i] == ee) ? 1u : 0u;
            const unsigned sidx = base[ee] + pre[ee] + rank; sl[tid] = (int)sidx; TOKS[c * 128 + tid] = (int)sidx; }
        __syncthreads();
        for (int i = wave; i < 128; i += 8) { const int t = c * 64 + (i >> 1); const size_t so = (size_t)sl[i] * 1024;
            *(u32x4*)(XG + so + lane * 8) = *(const u32x4*)(XB + (size_t)t * 1024 + lane * 8); *(u32x4*)(XG + so + 512 + lane * 8) = *(const u32x4*)(XB + (size_t)t * 1024 + 512 + lane * 8); }
        __syncthreads();
    }
}

__device__ __forceinline__ void phase_ln2(ArgsRef a, int l, int lane, int gw, int GW) {
    float* XF = a.out; bf16_t* XB = (bf16_t*)(a.ws + OFF_XB); const bf16_t* YS = (const bf16_t*)(a.ws + OFF_YS);
    const int* TOKS = (const int*)(a.ws + OFF_TOKS); const float* TOKG = (const float*)(a.ws + OFF_TOKG);
    for (int tb = gw * 4; tb < T; tb += GW * 4) {
        int sv = 0; float gv = 0.f; if (lane < 8) { sv = TOKS[tb * 2 + lane]; gv = TOKG[tb * 2 + lane]; }
        f32x4 v[4][4]; bf16x4 y0[4][4], y1[4][4]; float g0[4], g1[4];
#pragma unroll
        for (int k = 0; k < 4; ++k) { const int s0 = __shfl(sv, 2 * k), s1 = __shfl(sv, 2 * k + 1); g0[k] = __shfl(gv, 2 * k); g1[k] = __shfl(gv, 2 * k + 1);
#pragma unroll
            for (int j = 0; j < 4; ++j) { v[k][j] = *(const f32x4*)(XF + (size_t)(tb + k) * 1024 + 256 * j + 4 * lane);
                y0[k][j] = *(const bf16x4*)(YS + (size_t)s0 * 1024 + 256 * j + 4 * lane); y1[k][j] = *(const bf16x4*)(YS + (size_t)s1 * 1024 + 256 * j + 4 * lane); } }
#pragma unroll
        for (int k = 0; k < 4; ++k) {
#pragma unroll
            for (int j = 0; j < 4; ++j)
#pragma unroll
                for (int g = 0; g < 4; ++g) v[k][j][g] = DN_ALPHA * v[k][j][g] + g0[k] * bf2f((bf16_t)y0[k][j][g]) + g1[k] * bf2f((bf16_t)y1[k][j][g]);
            ln_row(v[k], a.in[27] + l * 1024, a.in[28] + l * 1024, lane);
#pragma unroll
            for (int j = 0; j < 4; ++j) { *(f32x4*)(XF + (size_t)(tb + k) * 1024 + 256 * j + 4 * lane) = v[k][j];
                u32x2 w; w.x = pack2(v[k][j][0], v[k][j][1]); w.y = pack2(v[k][j][2], v[k][j][3]); *(u32x2*)(XB + (size_t)(tb + k) * 1024 + 256 * j + 4 * lane) = w; } }
    }
}

struct SchedGrid {
    int nM, nN, G, c; const char* A; const char* B; size_t strideA, strideB;
    __device__ __forceinline__ bool next(int i, pg8::Unit& u) const { int pm, pn; if (!pg8::tile_order(i * G + c, nM, nN, pm, pn)) return false;
        u.pm = pm; u.pn = pn; u.tag = 0; u.A = A + (size_t)pm * strideA; u.B = B + (size_t)pn * strideB; return true; }
};
constexpr int GATES_LD = 3072;
template <int MODE> struct EpiBf16 {
    static constexpr bool PERM = true;
    bf16_t* O; int ldo; const bf16_t* Y; int ldy;
    __device__ __forceinline__ bool operator()(f32x4 (&acc)[2][2][4][2], const pg8::Unit& u, int wr, int wc, int fr, int fq) const {
#pragma unroll
        for (int ai = 0; ai < 2; ++ai) {
            bf16x8 yv[4][2];
            if (MODE == 2) {
#pragma unroll
                for (int m = 0; m < 4; ++m)
#pragma unroll
                    for (int bj = 0; bj < 2; ++bj) yv[m][bj] = *(const bf16x8*)(Y + ((size_t)u.pm * 256 + ai * 128 + wr * 64 + m * 16 + fr) * ldy + u.pn * 256 + bj * 128 + wc * 32 + 8 * fq);
            }
#pragma unroll
            for (int m = 0; m < 4; ++m) { const size_t row = (size_t)u.pm * 256 + ai * 128 + wr * 64 + m * 16 + fr;
#pragma unroll
                for (int bj = 0; bj < 2; ++bj) { const int col = u.pn * 256 + bj * 128 + wc * 32 + 8 * fq; f32x4 v0 = acc[ai][bj][m][0], v1 = acc[ai][bj][m][1];
                    if (MODE == 1) {
#pragma unroll
                        for (int j = 0; j < 4; ++j) { v0[j] = fmaxf(sigmoidf_(v0[j]), 1e-30f); v1[j] = fmaxf(sigmoidf_(v1[j]), 1e-30f); } }
                    if (MODE == 2) {
#pragma unroll
                        for (int j = 0; j < 4; ++j) { v0[j] = bf2f((bf16_t)yv[m][bj][j]) * sigmoidf_(v0[j]); v1[j] = bf2f((bf16_t)yv[m][bj][4 + j]) * sigmoidf_(v1[j]); } }
                    u32x4 w; w.x = pg8::cvt_pk_bf16(v0[0], v0[1]); w.y = pg8::cvt_pk_bf16(v0[2], v0[3]); w.z = pg8::cvt_pk_bf16(v1[0], v1[1]); w.w = pg8::cvt_pk_bf16(v1[2], v1[3]);
                    *(u32x4*)(O + row * ldo + col) = w; } }
        }
        return false;
    }
};
struct SchedZ {
    int G, c; const unsigned char* ws;
    __device__ __forceinline__ bool next(int i, pg8::Unit& u) const { int pm, pn; if (!pg8::tile_order(i * G + c, T / 256, 15, pm, pn)) return false;
        u.pm = pm; u.pn = pn; u.tag = 0; u.A = (const char*)(ws + OFF_XB) + (size_t)pm * 256 * 1024 * 2;
        u.B = (const char*)(ws + OFF_WIN) + (size_t)(pn < 14 ? pn * 256 : 6656) * 1024 * 2; return true; }
};
struct EpiZ {
    static constexpr bool PERM = true;
    bf16_t* Z; float* LI; float* LF; const float* bi; const float* bf;
    __device__ __forceinline__ bool operator()(f32x4 (&acc)[2][2][4][2], const pg8::Unit& u, int wr, int wc, int fr, int fq) const {
        if (u.pn < 14) {
#pragma unroll
            for (int ai = 0; ai < 2; ++ai)
#pragma unroll
                for (int m = 0; m < 4; ++m) { const size_t row = (size_t)u.pm * 256 + ai * 128 + wr * 64 + m * 16 + fr;
#pragma unroll
                    for (int bj = 0; bj < 2; ++bj) { const int col = u.pn * 256 + bj * 128 + wc * 32 + 8 * fq; const f32x4 v0 = acc[ai][bj][m][0], v1 = acc[ai][bj][m][1];
                        u32x4 w; w.x = pg8::cvt_pk_bf16(v0[0], v0[1]); w.y = pg8::cvt_pk_bf16(v0[2], v0[3]); w.z = pg8::cvt_pk_bf16(v1[0], v1[1]); w.w = pg8::cvt_pk_bf16(v1[2], v1[3]);
                        *(u32x4*)(Z + row * NZ + col) = w; } }
        } else if (wc == 0 && fq == 0) {
            const f32x4 b_i = *(const f32x4*)bi, b_f = *(const f32x4*)bf;
#pragma unroll
            for (int ai = 0; ai < 2; ++ai)
#pragma unroll
                for (int m = 0; m < 4; ++m) { const size_t row = (size_t)u.pm * 256 + ai * 128 + wr * 64 + m * 16 + fr; const f32x4 v0 = acc[ai][0][m][0] + b_i, v1 = acc[ai][0][m][1] + b_f;
                    f32x4 lf; lf[0] = logsigmoidf_(v1[0]); lf[1] = logsigmoidf_(v1[1]); lf[2] = logsigmoidf_(v1[2]); lf[3] = logsigmoidf_(v1[3]);
                    *(f32x4*)(LI + row * 4) = v0; *(f32x4*)(LF + row * 4) = lf; }
        }
        return false;
    }
};
__device__ __forceinline__ void phase_zgemm2(ArgsRef a, int l, int tid, int bid, int G) {
    SchedZ S{G, bid, a.ws}; EpiZ E{(bf16_t*)(a.ws + OFF_Z), (float*)(a.ws + OFF_LI), (float*)(a.ws + OFF_LF), a.in[7] + l * 4, a.in[8] + l * 4};
    pg8::gemm_phase((PG8_LAS unsigned char*)smem, tid, 1024, 1024, 1024, S, E);
}
__device__ __forceinline__ void phase_glu_gates(ArgsRef a, int l, int tid, int bid, int G) {
    { SchedGrid S{T / 256, 2, G, bid, (const char*)(a.ws + OFF_YPRE), (const char*)(a.ws + OFF_WGLU), (size_t)256 * 512 * 2, (size_t)256 * 512 * 2};
      EpiBf16<2> E{(bf16_t*)(a.ws + OFF_YSG), 512, (const bf16_t*)(a.ws + OFF_YPRE), 512};
      pg8::gemm_phase((PG8_LAS unsigned char*)smem, tid, 512, 512, 512, S, E); }
    asm volatile("" : "+v"(tid), "+s"(bid), "+s"(G));
    if (G > 128) { if (bid >= 128) phase_prepx(a, l, tid, bid - 128, G - 128, 0, 896); } else phase_prepx(a, l, tid, bid, G, 0, 896);
    asm volatile("" : "+v"(tid), "+s"(bid), "+s"(G));
    { SchedGrid S{T / 256, 12, G, (bid + G / 2) % G, (const char*)(a.ws + OFF_XB), (const char*)(a.ws + OFF_WIN + (size_t)NZ * 1024 * 2), (size_t)256 * 1024 * 2, (size_t)256 * 1024 * 2};
      EpiBf16<1> E{(bf16_t*)(a.ws + OFF_Z), GATES_LD, nullptr, 0};
      pg8::gemm_phase((PG8_LAS unsigned char*)smem, tid, 1024, 1024, 1024, S, E); }
}
struct SchedMerge {
    int G, c; const unsigned char* ws;
    __device__ __forceinline__ bool next(int i, pg8::Unit& u) const { const int b = i % 3; int pm, pn; if (!pg8::tile_order((i / 3) * G + c, T / 256, 4, pm, pn)) return false;
        u.pm = pm; u.pn = pn; u.tag = b; u.A = (const char*)(ws + (b == 0 ? OFF_OM : b == 1 ? OFF_YSG : OFF_OH)) + (size_t)pm * 256 * 512 * 2;
        u.B = (const char*)(ws + OFF_WB) + ((size_t)b * 1024 + pn * 256) * 512 * 2; return true; }
};
struct EpiMerge {
    static constexpr bool PERM = true;
    const bf16_t* GT; bf16_t* O;
    __device__ __forceinline__ bool operator()(f32x4 (&acc)[2][2][4][2], const pg8::Unit& u, int wr, int wc, int fr, int fq) const {
        const int b = u.tag;
#pragma unroll
        for (int ai = 0; ai < 2; ++ai)
#pragma unroll
        for (int mh = 0; mh < 2; ++mh) {
            bf16x8 gb[2][2], gn[2][2];
#pragma unroll
            for (int mm = 0; mm < 2; ++mm)
#pragma unroll
                for (int bj = 0; bj < 2; ++bj) { const bf16_t* gp = GT + ((size_t)u.pm * 256 + ai * 128 + wr * 64 + (2 * mh + mm) * 16 + fr) * GATES_LD + u.pn * 256 + bj * 128 + wc * 32 + 8 * fq;
                    gb[mm][bj] = *(const bf16x8*)(gp + b * 1024); gn[mm][bj] = (b < 2) ? *(const bf16x8*)(gp + (b + 1) * 1024) : gb[mm][bj]; }
#pragma unroll
            for (int mm = 0; mm < 2; ++mm) { const int m = 2 * mh + mm; const size_t row = (size_t)u.pm * 256 + ai * 128 + wr * 64 + m * 16 + fr;
#pragma unroll
                for (int bj = 0; bj < 2; ++bj) { const int col = u.pn * 256 + bj * 128 + wc * 32 + 8 * fq;
                    if (b < 2) {
#pragma unroll
                        for (int j = 0; j < 4; ++j) { acc[ai][bj][m][0][j] *= bf2f((bf16_t)gb[mm][bj][j]) * __builtin_amdgcn_rcpf(bf2f((bf16_t)gn[mm][bj][j])); acc[ai][bj][m][1][j] *= bf2f((bf16_t)gb[mm][bj][4 + j]) * __builtin_amdgcn_rcpf(bf2f((bf16_t)gn[mm][bj][4 + j])); } }
                    else { f32x4 v0 = acc[ai][bj][m][0], v1 = acc[ai][bj][m][1];
#pragma unroll
                        for (int j = 0; j < 4; ++j) { v0[j] *= bf2f((bf16_t)gb[mm][bj][j]); v1[j] *= bf2f((bf16_t)gb[mm][bj][4 + j]); }
                        u32x4 w; w.x = pg8::cvt_pk_bf16(v0[0], v0[1]); w.y = pg8::cvt_pk_bf16(v0[2], v0[3]); w.z = pg8::cvt_pk_bf16(v1[0], v1[1]); w.w = pg8::cvt_pk_bf16(v1[2], v1[3]);
                        *(u32x4*)(O + row * 1024 + col) = w; } } }
        }
        return b < 2;
    }
};
__device__ __forceinline__ void phase_merge2(ArgsRef a, int tid, int bid, int G) {
    SchedMerge S{G, bid, a.ws}; EpiMerge E{(const bf16_t*)(a.ws + OFF_Z), (bf16_t*)(a.ws + OFF_XB)};
    pg8::gemm_phase((PG8_LAS unsigned char*)smem, tid, 512, 512, 512, S, E);
}
struct EpiResid {
    static constexpr bool PERM = false;
    const float* xin; float* XF;
    __device__ __forceinline__ bool operator()(f32x4 (&acc)[2][2][4][2], const pg8::Unit& u, int wr, int wc, int fr, int fq) const {
#pragma unroll
        for (int ai = 0; ai < 2; ++ai)
#pragma unroll
        for (int mh = 0; mh < 2; ++mh) {
            f32x4 xv[2][2][2];
#pragma unroll
            for (int mm = 0; mm < 2; ++mm)
#pragma unroll
                for (int bj = 0; bj < 2; ++bj)
#pragma unroll
                    for (int n = 0; n < 2; ++n) xv[mm][bj][n] = *(const f32x4*)(xin + ((size_t)u.pm * 256 + ai * 128 + wr * 64 + (2 * mh + mm) * 16 + fr) * 1024 + u.pn * 256 + bj * 128 + wc * 32 + 16 * n + 4 * fq);
#pragma unroll
            for (int mm = 0; mm < 2; ++mm)
#pragma unroll
                for (int bj = 0; bj < 2; ++bj)
#pragma unroll
                    for (int n = 0; n < 2; ++n) { const int m = 2 * mh + mm; const size_t o = ((size_t)u.pm * 256 + ai * 128 + wr * 64 + m * 16 + fr) * 1024 + u.pn * 256 + bj * 128 + wc * 32 + 16 * n + 4 * fq; *(f32x4*)(XF + o) = DN_ALPHA * xv[mm][bj][n] + acc[ai][bj][m][n]; }
        }
        return false;
    }
};
__device__ __forceinline__ void phase_wout2(ArgsRef a, int l, int tid, int bid, int G) {
    SchedGrid S{T / 256, 4, G, bid, (const char*)(a.ws + OFF_XB), (const char*)(a.ws + OFF_WOUT), (size_t)256 * 1024 * 2, (size_t)256 * 1024 * 2};
    EpiResid E{(l == 0) ? a.in[0] : a.out, a.out};
    pg8::gemm_phase((PG8_LAS unsigned char*)smem, tid, 1024, 1024, 1024, S, E);
}
struct EpiQKV {
    static constexpr bool PERM = true;
    int vcall; bf16_t* Q; bf16_t* KH; bf16_t* V; const float* LI;
    __device__ __forceinline__ bool operator()(f32x4 (&acc)[2][2][4][2], const pg8::Unit& u, int wr, int wc, int fr, int fq) const {
        const int which = vcall ? 2 : (u.pn >> 1); bf16_t* O = Q + (size_t)which * (SZ_ACT / 2);
        float liv[2][4][2];
#pragma unroll
        for (int ai = 0; ai < 2; ++ai)
#pragma unroll
            for (int m = 0; m < 4; ++m)
#pragma unroll
                for (int bj = 0; bj < 2; ++bj) liv[ai][m][bj] = (which == 1) ? LI[((size_t)u.pm * 256 + ai * 128 + wr * 64 + m * 16 + fr) * 4 + (u.pn & 1) * 2 + bj] : 0.f;
#pragma unroll
        for (int ai = 0; ai < 2; ++ai)
#pragma unroll
            for (int m = 0; m < 4; ++m) { const size_t row = (size_t)u.pm * 256 + ai * 128 + wr * 64 + m * 16 + fr;
#pragma unroll
                for (int bj = 0; bj < 2; ++bj) { const int hd = (u.pn & 1) * 2 + bj, col = hd * 128 + wc * 32 + 8 * fq;
                    const float sc = which == 0 ? 0.08838834764831845f : which == 1 ? fexp(liv[ai][m][bj]) : 1.0f;
                    const f32x4 v0 = acc[ai][bj][m][0] * sc, v1 = acc[ai][bj][m][1] * sc;
                    u32x4 w; w.x = pg8::cvt_pk_bf16(v0[0], v0[1]); w.y = pg8::cvt_pk_bf16(v0[2], v0[3]); w.z = pg8::cvt_pk_bf16(v1[0], v1[1]); w.w = pg8::cvt_pk_bf16(v1[2], v1[3]);
                    *(u32x4*)(O + row * 512 + col) = w; } }
        return false;
    }
};
__device__ __forceinline__ void phase_mqkv2(ArgsRef a, int tid, int bid, int G) {
    { SchedGrid S{T / 256, 4, G, bid, (const char*)(a.ws + OFF_XC), (const char*)(a.ws + OFF_WQKV), (size_t)256 * 512 * 2, (size_t)256 * 512 * 2};
      EpiQKV E{0, (bf16_t*)(a.ws + OFF_Q), (bf16_t*)(a.ws + OFF_KH), (bf16_t*)(a.ws + OFF_V), (const float*)(a.ws + OFF_LI)};
      pg8::gemm_phase((PG8_LAS unsigned char*)smem, tid, 512, 512, 512, S, E); }
    asm volatile("" : "+v"(tid), "+s"(bid), "+s"(G));
    { SchedGrid S{T / 256, 2, G, (bid + G / 2) % G, (const char*)(a.ws + OFF_Z), (const char*)(a.ws + OFF_WQKV + (size_t)1024 * 512 * 2), (size_t)256 * NZ * 2, (size_t)256 * 512 * 2};
      EpiQKV E{1, (bf16_t*)(a.ws + OFF_Q), (bf16_t*)(a.ws + OFF_KH), (bf16_t*)(a.ws + OFF_V), (const float*)(a.ws + OFF_LI)};
      pg8::gemm_phase((PG8_LAS unsigned char*)smem, tid, 512, NZ, 512, S, E); }
}
struct SchedMoE {
    int down, G, c; const unsigned char* ws; const unsigned* BASE;
    __device__ __forceinline__ bool next(int i, pg8::Unit& u) const { const int per = down ? 4 : 2, L = i * G + c, ntile = (int)(BASE[32] >> 8); if (L >= ntile * per) return false;
        const int tile = L / per, sub = L % per; int e = 0; while (e < 31 && BASE[e + 1] <= (unsigned)(tile * 256)) ++e;
        u.pm = tile; u.pn = sub; u.tag = e;
        if (!down) { u.A = (const char*)(ws + OFF_XG) + (size_t)tile * 256 * 1024 * 2; u.B = (const char*)(ws + OFF_WGU) + ((size_t)e * 512 + sub * 256) * 1024 * 2; }
        else { u.A = (const char*)(ws + OFF_H) + (size_t)tile * 256 * 256 * 2; u.B = (const char*)(ws + OFF_WD) + ((size_t)e * 1024 + sub * 256) * 256 * 2; }
        return true; }
};
struct EpiH {
    static constexpr bool PERM = true;
    bf16_t* H;
    __device__ __forceinline__ bool operator()(f32x4 (&acc)[2][2][4][2], const pg8::Unit& u, int wr, int wc, int fr, int fq) const {
#pragma unroll
        for (int ai = 0; ai < 2; ++ai)
#pragma unroll
            for (int m = 0; m < 4; ++m) { const size_t row = (size_t)u.pm * 256 + ai * 128 + wr * 64 + m * 16 + fr; f32x4 v0, v1;
#pragma unroll
                for (int j = 0; j < 4; ++j) { v0[j] = siluf_(acc[ai][0][m][0][j]) * acc[ai][1][m][0][j]; v1[j] = siluf_(acc[ai][0][m][1][j]) * acc[ai][1][m][1][j]; }
                u32x4 w; w.x = pg8::cvt_pk_bf16(v0[0], v0[1]); w.y = pg8::cvt_pk_bf16(v0[2], v0[3]); w.z = pg8::cvt_pk_bf16(v1[0], v1[1]); w.w = pg8::cvt_pk_bf16(v1[2], v1[3]);
                *(u32x4*)(H + row * 256 + u.pn * 128 + wc * 32 + 8 * fq) = w; }
        return false;
    }
};
__device__ __forceinline__ void phase_moe_gu2(ArgsRef a, int l, int tid, int bid, int G) {
    { SchedMoE S{0, G, bid, a.ws, (const unsigned*)(a.ws + OFF_CTL) + 64}; EpiH E{(bf16_t*)(a.ws + OFF_H)};
      pg8::gemm_phase((PG8_LAS unsigned char*)smem, tid, 1024, 1024, 1024, S, E); }
    if (l + 1 < NLAYER) {
        asm volatile("" : "+v"(tid), "+s"(bid), "+s"(G));
        const int ntile = (int)(((const unsigned*)(a.ws + OFF_CTL))[64 + 32] >> 8); int nb = ntile * 2 - G; nb = nb < 0 ? 0 : (nb > G - 1 ? G - 1 : nb);
        if (bid >= nb) phase_prep(a, l + 1, tid, bid - nb, G - nb);
    }
}
__device__ __forceinline__ void phase_moe_dn2(ArgsRef a, int tid, int bid, int G) {
    SchedMoE S{1, G, bid, a.ws, (const unsigned*)(a.ws + OFF_CTL) + 64}; EpiBf16<0> E{(bf16_t*)(a.ws + OFF_YS), 1024, nullptr, 0};
    pg8::gemm_phase((PG8_LAS unsigned char*)smem, tid, 256, 256, 256, S, E);
}
__device__ __forceinline__ void phase_mprep2(ArgsRef a, int l, int tid, int lane, int wave, int bid, int G) {
    const bf16_t* Z = (const bf16_t*)(a.ws + OFF_Z); bf16_t* XC = (bf16_t*)(a.ws + OFF_XC);
    const float* cw = a.in[2] + (size_t)l * 4 * 512; const float* cb = a.in[3] + (size_t)l * 512;
    for (int idx = bid * 512 + tid; idx < (T / 8) * 64; idx += G * 512) {
        const int tb = (idx / 64) * 8, c0 = (idx % 64) * 8;
        bf16x8 xr[11];
#pragma unroll
        for (int k = 0; k < 11; ++k) { const int ts = tb - 3 + k; xr[k] = (ts >= 0) ? *(const bf16x8*)(Z + (size_t)ts * NZ + c0) : (bf16x8){0, 0, 0, 0, 0, 0, 0, 0}; }
        float w[4][8], b[8];
#pragma unroll
        for (int j = 0; j < 8; ++j) { b[j] = cb[c0 + j];
#pragma unroll
            for (int k = 0; k < 4; ++k) w[k][j] = cw[k * 512 + c0 + j]; }
#pragma unroll
        for (int tt = 0; tt < 8; ++tt) { float acc[8];
#pragma unroll
            for (int j = 0; j < 8; ++j) { acc[j] = b[j];
#pragma unroll
                for (int k = 0; k < 4; ++k) acc[j] += w[k][j] * bf2f((bf16_t)xr[tt + k][j]); }
            u32x4 o; o.x = pack2(siluf_(acc[0]), siluf_(acc[1])); o.y = pack2(siluf_(acc[2]), siluf_(acc[3])); o.z = pack2(siluf_(acc[4]), siluf_(acc[5])); o.w = pack2(siluf_(acc[6]), siluf_(acc[7]));
            *(u32x4*)(XC + (size_t)(tb + tt) * 512 + c0) = o; }
    }
}

#define XB_TMO      128
#define XB_XCNT(j)  (256  + 64 * (j))
#define XB_XSUB(j)  (1280 + 64 * (j))
#define XB_XGEN(j)  (2304 + 64 * (j))
#define XB_TOP      3328
#define XB_TOPGEN   3392
#define XCD_BAR_WORDS 3456
#define XB_SPIN_CAP (1u << 22)
__device__ __forceinline__ unsigned xb_ld(unsigned* p)              { return __hip_atomic_load(p, __ATOMIC_RELAXED, __HIP_MEMORY_SCOPE_AGENT); }
__device__ __forceinline__ unsigned xb_add(unsigned* p, unsigned v) { return __hip_atomic_fetch_add(p, v, __ATOMIC_RELAXED, __HIP_MEMORY_SCOPE_AGENT); }
__device__ __forceinline__ unsigned xb_xcc_id() { return (unsigned)__builtin_amdgcn_s_getreg((3 << 11) | 20) & 0xFu; }
#define XB_SPIN(cond, bar) do { unsigned _sp = 0; while (cond) { __builtin_amdgcn_s_sleep(1); \
    if ((++_sp & 255u) == 0u) { if (xb_ld(&(bar)[XB_TMO])) break; if (_sp > XB_SPIN_CAP) { atomicAdd(&(bar)[XB_TMO], 1u); break; } } } } while (0)
__device__ __forceinline__ void xcd_barrier_complete(unsigned* bar, unsigned x, unsigned& nloc, unsigned& nx) {
    const unsigned G = gridDim.x; unsigned sum, cnt, mine, sp = 0u;
    for (;;) { sum = 0u; cnt = 0u; mine = 0u;
#pragma unroll
        for (unsigned j = 0; j < 16; ++j) { const unsigned c = xb_ld(&bar[XB_XCNT(j)]); sum += c; cnt += (c > 0u) ? 1u : 0u; mine = (j == x) ? c : mine; }
        if (sum == G) break;
        __builtin_amdgcn_s_sleep(1);
        if ((++sp & 255u) == 0u) { if (xb_ld(&bar[XB_TMO])) break; if (sp > XB_SPIN_CAP) { atomicAdd(&bar[XB_TMO], 1u); break; } } }
    nloc = mine > 0u ? mine : 1u; nx = cnt > 0u ? cnt : 1u;
}
__device__ __forceinline__ void xcd_barrier(unsigned* bar, volatile __attribute__((address_space(3))) unsigned* st) {
    asm volatile("s_waitcnt vmcnt(0)" ::: "memory");
    __syncthreads();
    if (threadIdx.x == 0) {
        __builtin_amdgcn_s_waitcnt(0);
        const unsigned x = xb_xcc_id();
        unsigned nloc = st[0], nx = st[1];
        if (nloc == 0u) { xcd_barrier_complete(bar, x, nloc, nx); st[0] = nloc; st[1] = nx; }
        const unsigned old = xb_add(&bar[XB_XSUB(x)], 1u);
        const unsigned gen = old / nloc;
        if (old + 1u == (gen + 1u) * nloc) {
            __builtin_amdgcn_fence(__ATOMIC_RELEASE, "agent");
            asm volatile("s_waitcnt vmcnt(0)" ::: "memory");
            const unsigned og = xb_add(&bar[XB_TOP], 1u);
            const unsigned tg = og / nx;
            if (og + 1u == (tg + 1u) * nx) xb_add(&bar[XB_TOPGEN], 1u);
            else XB_SPIN(xb_ld(&bar[XB_TOPGEN]) == tg, bar);
            __builtin_amdgcn_fence(__ATOMIC_ACQUIRE, "agent");
            xb_add(&bar[XB_XGEN(x)], 1u);
            asm volatile("s_waitcnt vmcnt(0)" ::: "memory");
        } else {
            XB_SPIN(xb_ld(&bar[XB_XGEN(x)]) == gen, bar);
            __builtin_amdgcn_fence(__ATOMIC_ACQUIRE, "agent");
            asm volatile("s_waitcnt vmcnt(0)" ::: "memory");
        }
    }
    __syncthreads();
}

__device__ __forceinline__ ArgsRef fresh_args() { unsigned long long p = (unsigned long long)__builtin_amdgcn_kernarg_segment_ptr(); asm volatile("" : "+s"(p)); return *(const __attribute__((address_space(4))) Args*)p; }
__global__ void __launch_bounds__(512) fwd(Args a_unused) {
    cg::grid_group grid = cg::this_grid();
    volatile __attribute__((address_space(3))) unsigned* bst = (volatile __attribute__((address_space(3))) unsigned*)((__attribute__((address_space(3))) unsigned char*)smem + 131072);
    if (threadIdx.x < 4) bst[threadIdx.x] = 0u;
    __syncthreads();
    { ArgsRef a0 = fresh_args(); if (threadIdx.x == 0) (void)xb_add(&((unsigned*)(a0.ws + OFF_BAR))[XB_XCNT(xb_xcc_id())], 1u); }
#define GSYNC() do { asm volatile("" ::: "memory"); { ArgsRef ab = fresh_args(); xcd_barrier((unsigned*)(ab.ws + OFF_BAR), bst); } asm volatile("" ::: "memory"); } while (0)
#define GSYNC_CG() do { asm volatile("" ::: "memory"); grid.sync(); asm volatile("" ::: "memory"); } while (0)
    const int wave_s = __builtin_amdgcn_readfirstlane((int)threadIdx.x >> 6);
#define PH(body) do { int wave = wave_s; asm volatile("" : "+s"(wave)); int lane; asm volatile("v_mbcnt_lo_u32_b32 %0, -1, 0\n\tv_mbcnt_hi_u32_b32 %0, -1, %0" : "=v"(lane)); \
        int bid = blockIdx.x, G = gridDim.x; asm volatile("" : "+s"(bid), "+s"(G)); \
        const int tid = wave * 64 + lane, gw = bid * 8 + wave, GW = G * 8; (void)tid; (void)gw; (void)GW; ArgsRef a = fresh_args(); body; } while (0)
#pragma unroll 1
    for (int l = 0; l < NLAYER; ++l) {
        if (l == 0) { PH(phase_prep(a, 0, tid, bid, G)); GSYNC_CG(); }
        PH(phase_zgemm2(a, l, tid, bid, G)); GSYNC();
        PH(phase_mprep2(a, l, tid, lane, wave, bid, G)); GSYNC();
        PH(phase_mqkv2(a, tid, bid, G)); GSYNC();
        PH(phase_mixers<1>(a, l, tid, lane, wave, bid, G)); GSYNC();
        PH(phase_scan(a, tid, bid, G)); GSYNC();
        PH(phase_mixers<2>(a, l, tid, lane, wave, bid, G)); GSYNC();
        PH(phase_glu_gates(a, l, tid, bid, G)); PH(phase_prepx(a, l, tid, bid, G, 896, 4608)); GSYNC();
        PH(phase_merge2(a, tid, bid, G)); GSYNC();
        PH(phase_wout2(a, l, tid, bid, G)); GSYNC();
        PH(phase_ln1r(a, l, tid, lane, wave, bid, G)); PH(if (G > 128) { if (bid >= 128) phase_prepx(a, l, tid, bid - 128, G - 128, 4608, 6144); } else phase_prepx(a, l, tid, bid, G, 4608, 6144)); GSYNC();
        PH(phase_slot(a, tid, lane, wave, bid, G)); GSYNC();
        PH(phase_moe_gu2(a, l, tid, bid, G)); GSYNC();
        PH(phase_moe_dn2(a, tid, bid, G)); GSYNC();
        PH(phase_ln2(a, l, lane, gw, GW)); if (l + 1 < NLAYER) GSYNC();
    }
}

extern "C" void kernel_launch(void* const* d_in, const int* in_sizes, int n_in, void* d_out, int out_size, void* d_ws, size_t ws_size, hipStream_t stream) {
    static int grid = 0;
    if (grid == 0) {
        if (n_in != 34 || out_size != T * D || ws_size < WS_TOTAL) { fprintf(stderr, "kernel_launch: unexpected shapes (n_in %d, out %d, ws %zu, need %zu)\n", n_in, out_size, ws_size, (size_t)WS_TOTAL); grid = -1; return; }
        int dev = 0, cus = 0, per_cu = 0;
        (void)hipGetDevice(&dev); (void)hipDeviceGetAttribute(&cus, hipDeviceAttributeMultiprocessorCount, dev);
        (void)hipFuncSetAttribute((const void*)fwd, hipFuncAttributeMaxDynamicSharedMemorySize, LDS_BYTES);
        (void)hipOccupancyMaxActiveBlocksPerMultiprocessor(&per_cu, (const void*)fwd, 512, LDS_BYTES);
        if (per_cu < 1) { fprintf(stderr, "kernel_launch: occupancy query says %d blocks per CU\n", per_cu); per_cu = 1; }
        grid = (cus > 0 ? cus : 256) * 1;
        (void)hipGetLastError();
    }
    if (grid < 0) return;
    Args a{};
    for (int i = 0; i < 34; ++i) a.in[i] = (const float*)d_in[i];
    a.out = (float*)d_out; a.ws = (unsigned char*)d_ws; a.ph_lo = 0; a.ph_hi = NLAYER * NPH;
    (void)hipMemsetAsync((unsigned char*)d_ws + OFF_BAR, 0, 16384, stream);
    void* args[] = {&a};
    hipError_t e = hipLaunchCooperativeKernel((const void*)fwd, dim3(grid), dim3(512), args, LDS_BYTES, stream);
    if (e != hipSuccess) fprintf(stderr, "kernel_launch: cooperative launch failed: %s (grid %d)\n", hipGetErrorString(e), grid);
}
```

```cpp
#include <hip/hip_runtime.h>
#include <hip/hip_cooperative_groups.h>
#include <cstdio>
#include <cstdint>
namespace cg = cooperative_groups;

typedef unsigned short bf16_t;
typedef short bf16x8 __attribute__((ext_vector_type(8)));
typedef short bf16x4 __attribute__((ext_vector_type(4)));
typedef float f32x4 __attribute__((ext_vector_type(4)));
typedef unsigned u32x4 __attribute__((ext_vector_type(4)));
typedef unsigned u32x2 __attribute__((ext_vector_type(2)));

constexpr int T = 16384, D = 1024, NZ = 3584, NWIN = 6912, INW = 6664;
constexpr int NPH = 15, NLAYER = 2;
constexpr int GSEG = 32, GSEGLEN = 512;
constexpr int SSEG = 64, SSEGLEN = 256;
constexpr int SLOTS = 40960;
constexpr float DN_ALPHA = 1.41421356237f;
constexpr int LDS_BYTES = 131072 + 256;

constexpr size_t AL(size_t x) { return (x + 255) & ~(size_t)255; }
constexpr size_t OFF_WIN = 0;
constexpr size_t OFF_WQKV = OFF_WIN + AL((size_t)NWIN * 1024 * 2);
constexpr size_t OFF_WGLU = OFF_WQKV + AL((size_t)1536 * 512 * 2);
constexpr size_t OFF_WB = OFF_WGLU + AL((size_t)512 * 512 * 2);
constexpr size_t OFF_WOUT = OFF_WB + AL((size_t)3 * 1024 * 512 * 2);
constexpr size_t OFF_ABAR = OFF_WOUT + AL((size_t)1024 * 1024 * 2);
constexpr size_t OFF_BBT = OFF_ABAR + AL((size_t)32 * 64 * 2 * 4);
constexpr size_t OFF_CCT = OFF_BBT + AL((size_t)32 * 128 * 16 * 2);
constexpr size_t OFF_CTL = OFF_CCT + AL((size_t)32 * 16 * 128 * 2);
constexpr size_t OFF_TOKE = OFF_CTL + 4096;
constexpr size_t OFF_TOKG = OFF_TOKE + AL((size_t)T * 2 * 4);
constexpr size_t OFF_TOKS = OFF_TOKG + AL((size_t)T * 2 * 4);
constexpr size_t OFF_SLOTT = OFF_TOKS + AL((size_t)T * 2 * 4);
constexpr size_t OFF_XB = OFF_SLOTT + AL((size_t)SLOTS * 4);
constexpr size_t OFF_R1 = OFF_XB + AL((size_t)T * 1024 * 2);
constexpr size_t SZ_ACT = (size_t)T * 512 * 2;
constexpr size_t OFF_XC = OFF_R1, OFF_Q = OFF_R1 + SZ_ACT, OFF_KH = OFF_R1 + 2 * SZ_ACT, OFF_V = OFF_R1 + 3 * SZ_ACT;
constexpr size_t OFF_WGU = OFF_R1, OFF_WD = OFF_R1 + (size_t)32 * 512 * 1024 * 2;
constexpr size_t OFF_Z = OFF_R1 + 4 * SZ_ACT;
constexpr size_t OFF_XG = OFF_Z, OFF_H = OFF_Z + (size_t)SLOTS * 1024 * 2;
constexpr size_t OFF_ZS = OFF_Z + AL((size_t)T * NZ * 2);
constexpr size_t OFF_LF = OFF_ZS + AL((size_t)T * 8 * 4);
constexpr size_t OFF_LI = OFF_LF + AL((size_t)T * 4 * 4);
constexpr size_t OFF_E = OFF_LI + AL((size_t)T * 4 * 4);
constexpr size_t OFF_OM = OFF_E, OFF_OH = OFF_E + SZ_ACT, OFF_YPRE = OFF_E + 2 * SZ_ACT, OFF_YSG = OFF_E + 3 * SZ_ACT;
constexpr size_t OFF_DEN = OFF_E + 4 * SZ_ACT;
constexpr size_t OFF_EM = OFF_DEN + AL((size_t)T * 4 * 4);
constexpr size_t OFF_EMX = OFF_EM + AL((size_t)GSEG * 4 * 128 * 128 * 4);
constexpr size_t OFF_GM = OFF_EMX + AL((size_t)GSEG * 4 * 128 * 16 * 4);
constexpr size_t OFF_EH = OFF_GM + AL((size_t)GSEG * 4 * 128 * 4);
constexpr size_t OFF_GH = OFF_EH + AL((size_t)GSEG * 4 * 128 * 128 * 4);
constexpr size_t OFF_ES = OFF_GH + AL((size_t)GSEG * 4 * 128 * 4);
constexpr size_t WS_END = OFF_ES + AL((size_t)SSEG * 32 * 64 * 2 * 4);
constexpr size_t OFF_YS = OFF_E;
constexpr size_t OFF_RWT = WS_END;
constexpr size_t OFF_HIST = OFF_RWT + 32 * 1024 * 4;
constexpr size_t OFF_BAR = OFF_HIST + 1024 * 32 * 4;
constexpr size_t WS_TOTAL = OFF_BAR + 16384;
static_assert(OFF_YS + (size_t)SLOTS * 1024 * 2 <= WS_END, "YS must fit in the dead region");
static_assert(OFF_H + (size_t)SLOTS * 256 * 2 <= OFF_ZS, "H must fit in the dead Z region");
static_assert(OFF_WD + (size_t)32 * 1024 * 256 * 2 <= OFF_Z, "expert weights must fit in R1");

struct Args { const float* in[34]; float* out; unsigned char* ws; int ph_lo, ph_hi; };
typedef const __attribute__((address_space(4))) Args& ArgsRef;

extern __shared__ __attribute__((aligned(16))) unsigned char smem[];

__device__ __forceinline__ bf16_t f2bf(float f) { unsigned u = __float_as_uint(f); u += 0x7FFFu + ((u >> 16) & 1u); return (bf16_t)(u >> 16); }
__device__ __forceinline__ float bf2f(bf16_t b) { return __uint_as_float(((unsigned)b) << 16); }
__device__ __forceinline__ unsigned pack2(float lo, float hi) { return (unsigned)f2bf(lo) | ((unsigned)f2bf(hi) << 16); }
__device__ __forceinline__ float fexp(float x) { return __builtin_amdgcn_exp2f(x * 1.4426950408889634f); }
__device__ __forceinline__ float flog(float x) { return __builtin_amdgcn_logf(x) * 0.6931471805599453f; }
__device__ __forceinline__ float sigmoidf_(float x) { return __builtin_amdgcn_rcpf(1.0f + fexp(-x)); }
__device__ __forceinline__ float siluf_(float x) { return x * __builtin_amdgcn_rcpf(1.0f + fexp(-x)); }
__device__ __forceinline__ float logsigmoidf_(float x) { return fminf(x, 0.f) - log1pf(expf(-fabsf(x))); }
__device__ __forceinline__ float gelu_tanh(float y) { const float z = 0.7978845608028654f * (y + 0.044715f * y * y * y); const float th = 1.0f - 2.0f * __builtin_amdgcn_rcpf(fexp(2.0f * z) + 1.0f); return 0.5f * y * (1.0f + th); }
__device__ __forceinline__ void wave_sync() { __builtin_amdgcn_wave_barrier(); asm volatile("s_waitcnt lgkmcnt(0)" ::: "memory"); __builtin_amdgcn_wave_barrier(); }

#define MFMA16(a, b, c) __builtin_amdgcn_mfma_f32_16x16x32_bf16((a), (b), (c), 0, 0, 0)

template <int MT, int NT, class FA, class FB>
__device__ __forceinline__ void wave_gemm(f32x4 (&acc)[MT][NT], int K, FA arow, FB brow, int lane) {
    const int r = lane & 15, q = lane >> 4;
    const bf16_t* ap[MT]; const bf16_t* bp[NT];
#pragma unroll
    for (int m = 0; m < MT; ++m) ap[m] = arow(m * 16 + r) + 8 * q;
#pragma unroll
    for (int n = 0; n < NT; ++n) bp[n] = brow(n * 16 + r) + 8 * q;
#pragma unroll 1
    for (int k = 0; k < K; k += 32) {
        bf16x8 a[MT], b[NT];
#pragma unroll
        for (int m = 0; m < MT; ++m) a[m] = *(const bf16x8*)(ap[m] + k);
#pragma unroll
        for (int n = 0; n < NT; ++n) b[n] = *(const bf16x8*)(bp[n] + k);
#pragma unroll
        for (int m = 0; m < MT; ++m)
#pragma unroll
            for (int n = 0; n < NT; ++n) acc[m][n] = MFMA16(a[m], b[n], acc[m][n]);
    }
}
template <int MT, int NT> __device__ __forceinline__ void zero_acc(f32x4 (&acc)[MT][NT]) {
#pragma unroll
    for (int m = 0; m < MT; ++m)
#pragma unroll
        for (int n = 0; n < NT; ++n) acc[m][n] = (f32x4){0.f, 0.f, 0.f, 0.f};
}

namespace pg8 {
#define PG8_LAS __attribute__((address_space(3)))
constexpr int BM = 256, BK = 64, HALF = 128, HTB = HALF * BK * 2, STAGE_BYTES = 8 * HTB;
__device__ __forceinline__ int lds_byte(int r, int c) { const int st = (r >> 4) * 2 + (c >> 5), rr = r & 15, cc = c & 31, ob = rr * 64 + cc * 2; return st * 1024 + (ob ^ (((ob >> 9) & 1) << 5)); }
__device__ __forceinline__ void stage_rc(int b, int& R, int& C) { const int st = b / 1024, sb = b % 1024, swz = sb ^ (((sb >> 9) & 1) << 5); R = (st >> 1) * 16 + swz / 64; C = (st & 1) * 32 + (swz % 64) / 2; }
__device__ __forceinline__ int perm32(int rho) { const int n = rho >> 4, i = rho & 15; return 8 * (i >> 2) + 4 * n + (i & 3); }
struct Unit { int pm, pn, tag; const char* A; const char* B; };
__device__ __forceinline__ unsigned cvt_pk_bf16(float lo, float hi) { unsigned r; asm volatile("v_cvt_pk_bf16_f32 %0, %1, %2" : "=v"(r) : "v"(lo), "v"(hi)); return r; }
__device__ __forceinline__ bool tile_order(int L, int nM, int nN, int& pm, int& pn) {
    const int nwg = nM * nN; if (L >= nwg) return false;
    int wgid = L; { const int q = nwg / 8, r = nwg % 8, xcd = wgid % 8, off = wgid / 8; wgid = (xcd < r ? xcd * (q + 1) : r * (q + 1) + (xcd - r) * q) + off; }
    const int nig = 8 * nN, gid = wgid / nig, fm = gid * 8, gsz = (nM - fm) < 8 ? (nM - fm) : 8;
    pm = fm + ((wgid % nig) % gsz); pn = (wgid % nig) / gsz; return true;
}
template <class Epi, class Sched>
__device__ __forceinline__ void gemm_phase(PG8_LAS unsigned char* lds, const int tid, const int K, const int lda, const int ldb, const Sched& S, const Epi& E) {
    const int wid = __builtin_amdgcn_readfirstlane(tid >> 6), lane = tid & 63, wr = wid >> 2, wc = wid & 3, fr = lane & 15, fq = lane >> 4;
    const int nt = K / BK;
    unsigned voffA[2], voffB[2];
#pragma unroll
    for (int i = 0; i < 2; ++i) { int R, C; stage_rc(tid * 16 + i * 8192, R, C); const int Rb = Epi::PERM ? ((R & ~31) + perm32(R & 31)) : R;
        voffA[i] = (unsigned)(R * lda + C) * 2u; voffB[i] = (unsigned)(Rb * ldb + C) * 2u; }
    const size_t kstep = (size_t)(BK * 2), hstepA = (size_t)HALF * lda * 2, hstepB = (size_t)HALF * ldb * 2;
    const unsigned ldsw = (unsigned)wid * 1024u;
    const int aoff = lds_byte(wr * 64 + fr, fq * 8), boff = lds_byte(wc * 32 + fr, fq * 8);
#define PG8_SA(b, h) (((b) * 2 + (h)) * HTB)
#define PG8_SB(b, h) ((4 + (b) * 2 + (h)) * HTB)
#define PG8_STAGE(bufoff, gbase, voff) do { _Pragma("unroll") for (int _i = 0; _i < 2; ++_i) \
        __builtin_amdgcn_global_load_lds((const unsigned*)((const char*)(gbase) + (voff)[_i]), (PG8_LAS unsigned*)(lds + (bufoff) + ldsw + _i * 8192), 16, 0, 0); } while (0)
#define PG8_LDA(dst, b, h) do { _Pragma("unroll") for (int m = 0; m < 4; ++m) _Pragma("unroll") for (int k = 0; k < 2; ++k) dst[m][k] = *(const PG8_LAS bf16x8*)(lds + PG8_SA(b, h) + aoff + m * 2048 + k * 1024); } while (0)
#define PG8_LDB(dst, b, h) do { _Pragma("unroll") for (int n = 0; n < 2; ++n) _Pragma("unroll") for (int k = 0; k < 2; ++k) dst[n][k] = *(const PG8_LAS bf16x8*)(lds + PG8_SB(b, h) + boff + n * 2048 + k * 1024); } while (0)
#define PG8_MMA(ai, bj, At, Bt) do { __builtin_amdgcn_s_setprio(1); _Pragma("unroll") for (int m = 0; m < 4; ++m) _Pragma("unroll") for (int n = 0; n < 2; ++n) _Pragma("unroll") for (int k = 0; k < 2; ++k) \
        acc[ai][bj][m][n] = __builtin_amdgcn_mfma_f32_16x16x32_bf16(Bt[n][k], At[m][k], acc[ai][bj][m][n], 0, 0, 0); __builtin_amdgcn_s_setprio(0); } while (0)
#define PG8_WAIT_V(n) asm volatile("s_waitcnt vmcnt(" #n ")" ::: "memory")
#define PG8_WAIT_L(n) asm volatile("s_waitcnt lgkmcnt(" #n ")" ::: "memory")
#define PG8_BAR __builtin_amdgcn_s_barrier()
#define PG8_SCHED __builtin_amdgcn_sched_barrier(0)
    Unit cur, nxt; int ui = 0;
    if (!S.next(0, cur)) return;
    f32x4 acc[2][2][4][2];
#pragma unroll
    for (int a = 0; a < 2; ++a)
#pragma unroll
        for (int b = 0; b < 2; ++b)
#pragma unroll
            for (int m = 0; m < 4; ++m)
#pragma unroll
                for (int n = 0; n < 2; ++n) acc[a][b][m][n] = (f32x4){0.f, 0.f, 0.f, 0.f};
    bf16x8 At[4][2], B0[2][2], B1[2][2];
    const char* cA = cur.A; const char* cB = cur.B;
    PG8_STAGE(PG8_SB(0, 0), cB, voffB); PG8_STAGE(PG8_SA(0, 0), cA, voffA); PG8_STAGE(PG8_SB(0, 1), cB + hstepB, voffB); PG8_STAGE(PG8_SA(0, 1), cA + hstepA, voffA);
    if (wr == 1) PG8_BAR;
    PG8_WAIT_V(4); PG8_BAR;
    PG8_STAGE(PG8_SB(1, 0), cB + kstep, voffB); PG8_STAGE(PG8_SA(1, 0), cA + kstep, voffA); PG8_STAGE(PG8_SB(1, 1), cB + hstepB + kstep, voffB);
    PG8_WAIT_V(6); PG8_BAR;
    for (;;) {
        const bool has_next = S.next(ui + 1, nxt);
        const char* nA = has_next ? nxt.A : cA; const char* nB = has_next ? nxt.B : cB;
        for (int t = 0; t < nt; t += 2) {
            const bool last = (t == nt - 2);
            const char* a1 = cA + (size_t)(t + 1) * kstep;
            const char* a2 = last ? nA : cA + (size_t)(t + 2) * kstep; const char* b2 = last ? nB : cB + (size_t)(t + 2) * kstep;
            const char* a3 = a2 + kstep; const char* b3 = b2 + kstep;
            PG8_LDB(B0, 0, 0); PG8_SCHED; PG8_LDA(At, 0, 0); PG8_STAGE(PG8_SA(1, 1), a1 + hstepA, voffA);
            PG8_WAIT_L(8); PG8_BAR; PG8_WAIT_L(0); PG8_MMA(0, 0, At, B0); PG8_BAR; PG8_SCHED;
            PG8_LDB(B1, 0, 1); PG8_STAGE(PG8_SB(0, 0), b2, voffB);
            PG8_BAR; PG8_WAIT_L(0); PG8_MMA(0, 1, At, B1); PG8_BAR;
            PG8_LDA(At, 0, 1); PG8_STAGE(PG8_SA(0, 0), a2, voffA);
            PG8_BAR; PG8_WAIT_L(0); PG8_MMA(1, 0, At, B0); PG8_BAR; PG8_SCHED;
            PG8_STAGE(PG8_SB(0, 1), b2 + hstepB, voffB);
            PG8_WAIT_V(6); PG8_BAR; PG8_MMA(1, 1, At, B1); PG8_BAR;
            PG8_LDB(B0, 1, 0); PG8_SCHED; PG8_LDA(At, 1, 0); PG8_STAGE(PG8_SA(0, 1), a2 + hstepA, voffA);
            PG8_WAIT_L(8); PG8_BAR; PG8_WAIT_L(0); PG8_MMA(0, 0, At, B0); PG8_BAR; PG8_SCHED;
            PG8_LDB(B1, 1, 1); PG8_STAGE(PG8_SB(1, 0), b3, voffB);
            PG8_BAR; PG8_WAIT_L(0); PG8_MMA(0, 1, At, B1); PG8_BAR;
            PG8_LDA(At, 1, 1); PG8_STAGE(PG8_SA(1, 0), a3, voffA);
            PG8_BAR; PG8_WAIT_L(0); PG8_MMA(1, 0, At, B0); PG8_BAR; PG8_SCHED;
            PG8_STAGE(PG8_SB(1, 1), b3 + hstepB, voffB);
            PG8_WAIT_V(6); PG8_BAR; PG8_MMA(1, 1, At, B1); PG8_BAR;
        }
        const bool keep = E(acc, cur, wr, wc, fr, fq);
        if (!has_next) break;
        if (!keep) {
#pragma unroll
            for (int a = 0; a < 2; ++a)
#pragma unroll
                for (int b = 0; b < 2; ++b)
#pragma unroll
                    for (int m = 0; m < 4; ++m)
#pragma unroll
                        for (int n = 0; n < 2; ++n) acc[a][b][m][n] = (f32x4){0.f, 0.f, 0.f, 0.f};
        }
        cur = nxt; cA = nA; cB = nB; ++ui;
    }
    PG8_WAIT_V(0);
    if (wr == 0) PG8_BAR;
    PG8_BAR;
#undef PG8_SA
#undef PG8_SB
#undef PG8_STAGE
#undef PG8_LDA
#undef PG8_LDB
#undef PG8_MMA
#undef PG8_WAIT_V
#undef PG8_WAIT_L
#undef PG8_BAR
#undef PG8_SCHED
}
}

__device__ __forceinline__ void tconv_tile(const float* src, int ld_src, int nvalid, bf16_t* dst, int ld_dst, int tid) {
    float* t = (float*)smem;
    { const int r = tid >> 3, c0 = (tid & 7) * 8; float v[8];
      if (nvalid == 64) { const f32x4 a0 = *(const f32x4*)(src + (size_t)r * ld_src + c0), a1 = *(const f32x4*)(src + (size_t)r * ld_src + c0 + 4);
          v[0] = a0[0]; v[1] = a0[1]; v[2] = a0[2]; v[3] = a0[3]; v[4] = a1[0]; v[5] = a1[1]; v[6] = a1[2]; v[7] = a1[3]; }
      else {
#pragma unroll
          for (int j = 0; j < 8; ++j) { const int c = c0 + j; v[j] = (c < nvalid) ? src[(size_t)r * ld_src + c] : 0.f; } }
#pragma unroll
      for (int j = 0; j < 8; ++j) t[(c0 + j) * 65 + r] = v[j]; }
    __syncthreads();
    { const int n = tid >> 3, k0 = (tid & 7) * 8; const float* p = t + n * 65 + k0;
      u32x4 w; w.x = pack2(p[0], p[1]); w.y = pack2(p[2], p[3]); w.z = pack2(p[4], p[5]); w.w = pack2(p[6], p[7]);
      *(u32x4*)(dst + (size_t)n * ld_dst + k0) = w; }
    __syncthreads();
}

__device__ __forceinline__ void phase_prep(ArgsRef a, int l, int tid, int bid, int G) {
    unsigned char* ws = a.ws;
    bf16_t* WIN = (bf16_t*)(ws + OFF_WIN); bf16_t* WQKV = (bf16_t*)(ws + OFF_WQKV); bf16_t* WGLU = (bf16_t*)(ws + OFF_WGLU);
    bf16_t* WB = (bf16_t*)(ws + OFF_WB); bf16_t* WOUT = (bf16_t*)(ws + OFF_WOUT);
    for (int u = bid; u < 2624; u += G) {
        const float* src; int lds_ = 0, nvalid = 64, ldd = 0; bf16_t* dst;
        if (u < 1728) { const int nt = u / 16, kt = u % 16, p0 = nt * 64; int sc;
            if (p0 < 1024) sc = p0; else if (p0 < 6656) sc = p0 + 8; else if (p0 == 6656) { sc = 1024; nvalid = 8; } else { sc = 0; nvalid = 0; }
            src = a.in[1] + (size_t)l * 1024 * INW + (size_t)(kt * 64) * INW + sc; lds_ = INW; dst = WIN + (size_t)p0 * 1024 + kt * 64; ldd = 1024; }
        else if (u < 1920) { const int v = u - 1728, nt = v / 8, kt = v % 8, which = nt / 8, h = (nt % 8) / 2;
            if ((kt >> 1) != h) nvalid = 0;
            src = a.in[4 + which] + (size_t)(l * 4 + h) * 128 * 128 + ((kt & 1) * 64) * 128 + (nt & 1) * 64; lds_ = 128; dst = WQKV + (size_t)(nt * 64) * 512 + kt * 64; ldd = 512; }
        else if (u < 1984) { const int v = u - 1920, nt = v / 8, kt = v % 8;
            src = a.in[18] + (size_t)l * 512 * 512 + (kt * 64) * 512 + nt * 64; lds_ = 512; dst = WGLU + (size_t)(nt * 64) * 512 + kt * 64; ldd = 512; }
        else if (u < 2368) { const int v = u - 1984, b = v / 128, w = v % 128, nt = w / 8, kt = w % 8;
            src = a.in[21 + b] + (size_t)l * 512 * 1024 + (size_t)(kt * 64) * 1024 + nt * 64; lds_ = 1024; dst = WB + (size_t)b * 1024 * 512 + (size_t)(nt * 64) * 512 + kt * 64; ldd = 512; }
        else { const int v = u - 2368, nt = v / 16, kt = v % 16;
            src = a.in[24] + (size_t)l * 1024 * 1024 + (size_t)(kt * 64) * 1024 + nt * 64; lds_ = 1024; dst = WOUT + (size_t)(nt * 64) * 1024 + kt * 64; ldd = 1024; }
        tconv_tile(src, lds_, nvalid, dst, ldd, tid);
    }
    float* ABAR = (float*)(ws + OFF_ABAR); bf16_t* BBT = (bf16_t*)(ws + OFF_BBT); bf16_t* CCT = (bf16_t*)(ws + OFF_CCT);
    for (int i = bid * 512 + tid; i < 2048; i += G * 512) {
        const int g = i / 64, p = i % 64; const size_t gp = (size_t)(l * 32 + g) * 64 + p;
        const float lr = fminf(a.in[10][gp], -1e-4f), li = a.in[11][gp], dt = expf(a.in[12][l * 32 + g]);
        const float mag = expf(lr * dt), abr = mag * cosf(li * dt), abi = mag * sinf(li * dt);
        const float nr = abr - 1.0f, den = lr * lr + li * li, cr = (nr * lr + abi * li) / den, ci = (abi * lr - nr * li) / den;
        ABAR[(g * 64 + p) * 2] = abr; ABAR[(g * 64 + p) * 2 + 1] = abi;
        for (int c = 0; c < 16; ++c) { const float br = a.in[13][gp * 16 + c], bi = a.in[14][gp * 16 + c];
            BBT[(size_t)(g * 128 + p) * 16 + c] = f2bf(cr * br - ci * bi); BBT[(size_t)(g * 128 + 64 + p) * 16 + c] = f2bf(cr * bi + ci * br);
            const size_t ci_ = ((size_t)(l * 32 + g) * 16 + c) * 64 + p;
            CCT[(size_t)(g * 16 + c) * 128 + p] = f2bf(a.in[15][ci_]); CCT[(size_t)(g * 16 + c) * 128 + 64 + p] = f2bf(-a.in[16][ci_]); }
    }
    if (l == 0) { float* RWT = (float*)(ws + OFF_RWT); const float* RW = a.in[29]; for (int i = bid * 512 + tid; i < 32 * 1024; i += G * 512) RWT[i] = RW[(i & 1023) * 32 + (i >> 10)]; }
    if (l == 0) { bf16_t* XB = (bf16_t*)(ws + OFF_XB); const float* x = a.in[0];
        for (size_t i = (size_t)bid * 512 + tid; i < (size_t)T * 1024 / 8; i += (size_t)G * 512) {
            const f32x4 v0 = *(const f32x4*)(x + i * 8), v1 = *(const f32x4*)(x + i * 8 + 4);
            u32x4 w; w.x = pack2(v0[0], v0[1]); w.y = pack2(v0[2], v0[3]); w.z = pack2(v1[0], v1[1]); w.w = pack2(v1[2], v1[3]); *(u32x4*)(XB + i * 8) = w; } }
}

__device__ __forceinline__ void phase_prepx(ArgsRef a, int l, int tid, int bid, int G, int u_lo, int u_hi) {
    bf16_t* WGU = (bf16_t*)(a.ws + OFF_WGU); bf16_t* WD = (bf16_t*)(a.ws + OFF_WD);
    for (int u = u_lo + bid; u < u_hi; u += G) {
        const float* src; int lds_, ldd; bf16_t* dst;
        if (u < 4096) { const int up = u >= 2048, v = u & 2047, e = v / 64, w = v % 64, nt = w / 16, kt = w % 16, j0 = nt * 64, drow = (j0 / 128) * 256 + (j0 % 128) + up * 128;
            src = a.in[31 + up] + ((size_t)(l * 32 + e) * 1024 + kt * 64) * 256 + nt * 64; lds_ = 256; dst = WGU + ((size_t)e * 512 + drow) * 1024 + kt * 64; ldd = 1024; }
        else { const int v = u - 4096, e = v / 64, w = v % 64, nt = w / 4, kt = w % 4;
            src = a.in[33] + ((size_t)(l * 32 + e) * 256 + kt * 64) * 1024 + nt * 64; lds_ = 1024; dst = WD + ((size_t)e * 1024 + nt * 64) * 256 + kt * 64; ldd = 256; }
        tconv_tile(src, lds_, 64, dst, ldd, tid);
    }
}

constexpr int GL_RQ = 0, GL_RK = 17408, GL_VT = 34816, GL_RO = 57856, GL_RX = 75264, GL_KT = 92672, GL_PS = 102912, GL_SC1 = 105472, GL_SC2 = 105984, GL_GT = 106496, GL_OS = 108544, GL_LFS = 117248, GL_DNS = 117504;
template <int MODE, int PASS>
__device__ __forceinline__ void gla_item(ArgsRef a, int l, int h, int sg, int tid, int lane, int wave) {
    unsigned char* ws = a.ws;
    const bf16_t* Z = (const bf16_t*)(ws + OFF_Z); const bf16_t* Qg = (const bf16_t*)(ws + OFF_Q); const bf16_t* Kg = (const bf16_t*)(ws + OFF_KH); const bf16_t* Vg = (const bf16_t*)(ws + OFF_V); const bf16_t* XCg = (const bf16_t*)(ws + OFF_XC);
    const float* LF = (const float*)(ws + OFF_LF);
    float* Eg = (float*)(ws + (MODE == 0 ? OFF_EM : OFF_EH)); float* Gg = (float*)(ws + (MODE == 0 ? OFF_GM : OFF_GH)); float* EX = (float*)(ws + OFF_EMX);
    bf16_t* Yg = (bf16_t*)(ws + (MODE == 0 ? OFF_OM : OFF_OH));
    bf16_t* KT = (bf16_t*)(smem + GL_KT); bf16_t* PS = (bf16_t*)(smem + GL_PS);
    float* SC1 = (float*)(smem + GL_SC1); float* SC2 = (float*)(smem + GL_SC2); float* GT = (float*)(smem + GL_GT); bf16_t* OS = (bf16_t*)(smem + GL_OS); float* DNS = (float*)(smem + GL_DNS);
    const int r = lane & 15, q = lane >> 4, grp = tid >> 7, d = tid & 127, tok = tid >> 4, c8 = (tid & 15) * 8;
    const bool xw = (MODE == 0) && (wave == 0);
    float lb = 0.f;
    if (MODE == 1 && l == 1) { const float h0 = a.in[19][h * 128 + d], h1 = a.in[19][512 + h * 128 + d]; lb = 1.0f / (1.0f + expf(h0 - h1)); }
    f32x4 S[8], SX[8];
#pragma unroll
    for (int i = 0; i < 8; ++i) { S[i] = (f32x4){0.f, 0.f, 0.f, 0.f}; SX[i] = (f32x4){0.f, 0.f, 0.f, 0.f}; }
    if (PASS == 2) {
#pragma unroll
        for (int i = 0; i < 8; ++i)
#pragma unroll
            for (int g = 0; g < 4; ++g) { const size_t row = (size_t)(sg * 4 + h) * 128 + 16 * i + 4 * q + g; S[i][g] = Eg[row * 128 + 16 * wave + r]; if (xw) SX[i][g] = EX[row * 16 + r]; }
    }
    const bf16x8 z8 = (bf16x8){0, 0, 0, 0, 0, 0, 0, 0};
    bf16x8 rq = z8, rk = z8, rv = z8, ro = z8, rx = z8; float lfv = 0.f;
#define GLA_FETCH(t0_) do { const size_t tk = (size_t)((t0_) + tok); \
        if (MODE == 1) { const bf16_t* zp = Z + tk * NZ + h * 128 + c8; if (PASS == 2) { rq = *(const bf16x8*)(zp + 1536); ro = *(const bf16x8*)(zp + 3072); } rk = *(const bf16x8*)(zp + 2048); rv = *(const bf16x8*)(zp + 2560); } \
        else { const size_t o_ = tk * 512 + h * 128 + c8; if (PASS == 2) { rq = *(const bf16x8*)(Qg + o_); ro = *(const bf16x8*)(Z + tk * NZ + 512 + h * 128 + c8); rx = *(const bf16x8*)(XCg + o_); } \
               rk = *(const bf16x8*)(Kg + o_); rv = *(const bf16x8*)(Vg + o_); if (tid < 32) lfv = LF[((t0_) + tid) * 4 + h]; } } while (0)
    GLA_FETCH(sg * GSEGLEN);
    float sk8[8], nw8[8];
#pragma unroll
    for (int j = 0; j < 8; ++j) { sk8[j] = (MODE == 0 && PASS == 2) ? a.in[9][l * 512 + h * 128 + c8 + j] : 0.f; nw8[j] = (MODE == 1 && PASS == 2) ? a.in[20][l * 512 + h * 128 + c8 + j] : 0.f; }
    __syncthreads();
    if (MODE == 0) { for (int i = tid; i < 2 * 16 * 40; i += 512) { const int b = i / 640, k = i % 640; ((bf16_t*)(smem + GL_VT + b * 11520))[128 * 40 + k] = (k < 32) ? (bf16_t)0x3F80 : (bf16_t)0; } }
#define GLA_STORE(tprev, pb) do { const bf16x8 o8 = *(const bf16x8*)(OS + tok * 136 + c8); const bf16x8 p8 = *(const bf16x8*)((const bf16_t*)(smem + GL_RO + (pb) * 8704) + tok * 136 + c8); float y[8]; \
        if (MODE == 0) { const bf16x8 x8 = *(const bf16x8*)((const bf16_t*)(smem + GL_RX + (pb) * 8704) + tok * 136 + c8); const float di = __builtin_amdgcn_rcpf(fmaxf(fabsf(DNS[tok]), 1.0f)); \
            _Pragma("unroll") for (int j = 0; j < 8; ++j) y[j] = sigmoidf_(bf2f((bf16_t)p8[j])) * (bf2f((bf16_t)o8[j]) * di) + sk8[j] * bf2f((bf16_t)x8[j]); } \
        else { float ov[8], ss = 0.f; _Pragma("unroll") for (int j = 0; j < 8; ++j) { ov[j] = bf2f((bf16_t)o8[j]); ss += ov[j] * ov[j]; } \
            ss += __shfl_xor(ss, 1); ss += __shfl_xor(ss, 2); ss += __shfl_xor(ss, 4); ss += __shfl_xor(ss, 8); const float rinv = rsqrtf(ss * (1.0f / 128.0f) + 1e-6f); \
            _Pragma("unroll") for (int j = 0; j < 8; ++j) y[j] = ov[j] * rinv * nw8[j] * siluf_(bf2f((bf16_t)p8[j])); } \
        u32x4 w_; w_.x = pack2(y[0], y[1]); w_.y = pack2(y[2], y[3]); w_.z = pack2(y[4], y[5]); w_.w = pack2(y[6], y[7]); *(u32x4*)(Yg + (size_t)((tprev) + tok) * 512 + h * 128 + c8) = w_; } while (0)
    float runb = 0.f;
    for (int ci = 0; ci < GSEGLEN / 32; ++ci) {
        const int t0 = sg * GSEGLEN + ci * 32, buf = ci & 1;
        bf16_t* RQ = (bf16_t*)(smem + GL_RQ + buf * 8704); bf16_t* RK = (bf16_t*)(smem + GL_RK + buf * 8704); bf16_t* VT = (bf16_t*)(smem + GL_VT + buf * 11520);
        float* LFS = (float*)(smem + GL_LFS + buf * 128);
        if (PASS == 2) { *(bf16x8*)(RQ + tok * 136 + c8) = rq; *(bf16x8*)((bf16_t*)(smem + GL_RO + buf * 8704) + tok * 136 + c8) = ro; if (MODE == 0) *(bf16x8*)((bf16_t*)(smem + GL_RX + buf * 8704) + tok * 136 + c8) = rx; }
        *(bf16x8*)(RK + tok * 136 + c8) = rk;
#pragma unroll
        for (int j = 0; j < 8; ++j) VT[(c8 + j) * 40 + tok] = (bf16_t)rv[j];
        if (MODE == 0 && tid < 32) LFS[tid] = lfv;
        if (ci + 1 < GSEGLEN / 32) GLA_FETCH(t0 + 32);
        __syncthreads();
        float lg[8], kv[8];
#pragma unroll
        for (int j = 0; j < 8; ++j) { const float kr = bf2f(RK[(grp * 8 + j) * 136 + d]);
            if (MODE == 1) { const float f = lb + (1.0f - lb) * sigmoidf_(kr); lg[j] = flog(f); kv[j] = 1.0f - f; } else { lg[j] = LFS[grp * 8 + j]; kv[j] = kr; } }
        float cs[8]; cs[0] = lg[0];
#pragma unroll
        for (int j = 1; j < 8; ++j) cs[j] = cs[j - 1] + lg[j];
        GT[grp * 128 + d] = cs[7];
        __syncthreads();
        if (PASS == 2 && ci > 0) GLA_STORE(t0 - 32, buf ^ 1);
        const float g0 = GT[d], g1 = GT[128 + d], g2 = GT[256 + d], g3 = GT[384 + d];
        const float off = grp == 0 ? 0.f : grp == 1 ? g0 : grp == 2 ? g0 + g1 : g0 + g1 + g2;
        const float bmid = g0 + g1, bL = bmid + g2 + g3;
        bf16_t ktv[8];
#pragma unroll
        for (int j = 0; j < 8; ++j) { const float bt = off + cs[j], ek = fexp(bmid - bt); const bf16_t kt = f2bf(kv[j] * ek); ktv[j] = kt;
            if (PASS == 2) { const float qr = bf2f(RQ[(grp * 8 + j) * 136 + d]); const float qq = (MODE == 1) ? siluf_(qr) : qr; RQ[(grp * 8 + j) * 136 + d] = f2bf(qq * __builtin_amdgcn_rcpf(ek)); RK[(grp * 8 + j) * 136 + d] = kt; } }
        { u32x4 w; w.x = ktv[0] | ((unsigned)ktv[1] << 16); w.y = ktv[2] | ((unsigned)ktv[3] << 16); w.z = ktv[4] | ((unsigned)ktv[5] << 16); w.w = ktv[6] | ((unsigned)ktv[7] << 16); *(u32x4*)(KT + d * 40 + grp * 8) = w; }
        if (grp == 0) { SC1[d] = fexp(bmid); SC2[d] = fexp(bL - bmid); runb += bL; }
        __syncthreads();
        if (PASS == 2) {
            if (wave < 4) {
                const int ti = (wave == 1 || wave == 2) ? 1 : 0, tj = (wave >= 2) ? 1 : 0;
                f32x4 p = (f32x4){0.f, 0.f, 0.f, 0.f};
                if (wave < 3) {
#pragma unroll
                    for (int kk = 0; kk < 4; ++kk) { const bf16x8 av = *(const bf16x8*)(RQ + (16 * ti + r) * 136 + 32 * kk + 8 * q); const bf16x8 bv = *(const bf16x8*)(RK + (16 * tj + r) * 136 + 32 * kk + 8 * q); p = MFMA16(av, bv, p); }
                }
#pragma unroll
                for (int g = 0; g < 4; ++g) { const int t = 16 * ti + 4 * q + g, s_ = 16 * tj + r; PS[t * 40 + s_] = (wave < 3 && s_ <= t) ? f2bf(p[g]) : (bf16_t)0; }
            }
            __syncthreads();
        }
        const bf16x8 bV = *(const bf16x8*)(VT + (16 * wave + r) * 40 + 8 * q);
        bf16x8 bV1 = bV; if (xw) bV1 = *(const bf16x8*)(VT + (128 + r) * 40 + 8 * q);
        f32x4 o[2], ox[2];
        o[0] = o[1] = ox[0] = ox[1] = (f32x4){0.f, 0.f, 0.f, 0.f};
#pragma unroll
        for (int kk = 0; kk < 4; ++kk) {
            const f32x4 sa = *(const f32x4*)(SC1 + 32 * kk + 4 * q), sb = *(const f32x4*)(SC1 + 32 * kk + 16 + 4 * q);
            S[2 * kk] *= sa; S[2 * kk + 1] *= sb;
            if (xw) { SX[2 * kk] *= sa; SX[2 * kk + 1] *= sb; }
            if (PASS == 2) {
                bf16x8 bS, bX;
#pragma unroll
                for (int g = 0; g < 4; ++g) { bS[g] = (short)f2bf(S[2 * kk][g]); bS[4 + g] = (short)f2bf(S[2 * kk + 1][g]); bX[g] = (short)f2bf(SX[2 * kk][g]); bX[4 + g] = (short)f2bf(SX[2 * kk + 1][g]); }
#pragma unroll
                for (int mt = 0; mt < 2; ++mt) { const bf16x4 lo = *(const bf16x4*)(RQ + (16 * mt + r) * 136 + 32 * kk + 4 * q), hi = *(const bf16x4*)(RQ + (16 * mt + r) * 136 + 32 * kk + 16 + 4 * q);
                    bf16x8 av; av[0] = lo[0]; av[1] = lo[1]; av[2] = lo[2]; av[3] = lo[3]; av[4] = hi[0]; av[5] = hi[1]; av[6] = hi[2]; av[7] = hi[3];
                    o[mt] = MFMA16(av, bS, o[mt]); if (xw) ox[mt] = MFMA16(av, bX, ox[mt]); }
            }
        }
        if (PASS == 2) {
#pragma unroll
            for (int mt = 0; mt < 2; ++mt) { const bf16x8 av = *(const bf16x8*)(PS + (16 * mt + r) * 40 + 8 * q); o[mt] = MFMA16(av, bV, o[mt]); if (xw) ox[mt] = MFMA16(av, bV1, ox[mt]);
#pragma unroll
                for (int g = 0; g < 4; ++g) { OS[(16 * mt + 4 * q + g) * 136 + 16 * wave + r] = f2bf(o[mt][g]); if (xw && r == 0) DNS[16 * mt + 4 * q + g] = ox[mt][g]; } }
        }
#pragma unroll
        for (int i = 0; i < 8; ++i) { const bf16x8 av = *(const bf16x8*)(KT + (16 * i + r) * 40 + 8 * q); const f32x4 s2 = *(const f32x4*)(SC2 + 16 * i + 4 * q);
            S[i] = MFMA16(av, bV, S[i]); S[i] *= s2;
            if (xw) { SX[i] = MFMA16(av, bV1, SX[i]); SX[i] *= s2; } }
    }
    if (PASS == 2) { __syncthreads(); GLA_STORE(sg * GSEGLEN + GSEGLEN - 32, 1); }
    if (PASS == 1) {
        float* ST = (float*)smem;
        __syncthreads();
#pragma unroll
        for (int i = 0; i < 8; ++i)
#pragma unroll
            for (int g = 0; g < 4; ++g) { ST[(16 * i + 4 * q + g) * 132 + 16 * wave + r] = S[i][g]; if (xw) EX[((size_t)(sg * 4 + h) * 128 + 16 * i + 4 * q + g) * 16 + r] = SX[i][g]; }
        __syncthreads();
#pragma unroll
        for (int k = 0; k < 8; ++k) { const int idx = tid + 512 * k, row = idx >> 5, c4 = (idx & 31) * 4; *(f32x4*)(Eg + ((size_t)(sg * 4 + h) * 128 + row) * 128 + c4) = *(const f32x4*)(ST + row * 132 + c4); }
        if (grp == 0) Gg[(size_t)(sg * 4 + h) * 128 + d] = expf(runb);
    }
#undef GLA_FETCH
#undef GLA_STORE
}

template <int PASS>
__device__ __forceinline__ void s5_item(ArgsRef a, int l, int g, int sg, int g0, int tid, int lane, int wave, int hsel) {
    unsigned char* ws = a.ws;
    const bf16_t* Z = (const bf16_t*)(ws + OFF_Z); const float* ABAR = (const float*)(ws + OFF_ABAR); const bf16_t* BBT = (const bf16_t*)(ws + OFF_BBT); const bf16_t* CCT = (const bf16_t*)(ws + OFF_CCT);
    float* ES = (float*)(ws + OFF_ES); bf16_t* YPRE = (bf16_t*)(ws + OFF_YPRE);
    float* BU = (float*)(smem + 70000 + (wave & 3) * 12800); bf16_t* X = (bf16_t*)(smem + 70000 + (wave & 3) * 12800 + 8448); bf16_t* YT = (bf16_t*)(smem + 70000 + 51200);
    const int r = lane & 15, q = lane >> 4, p = lane; const bool act = (wave >> 2) == hsel;
    const float ar = ABAR[(g * 64 + p) * 2], ai = ABAR[(g * 64 + p) * 2 + 1];
    const bf16x8 zero8 = (bf16x8){0, 0, 0, 0, 0, 0, 0, 0};
    bf16x8 bB[8], cB[4];
#pragma unroll
    for (int nt = 0; nt < 8; ++nt) bB[nt] = (q < 2) ? *(const bf16x8*)(BBT + (size_t)(g * 128 + 16 * nt + r) * 16 + 8 * q) : zero8;
#pragma unroll
    for (int kk = 0; kk < 4; ++kk) cB[kk] = (PASS == 2) ? *(const bf16x8*)(CCT + (size_t)(g * 16 + r) * 128 + 32 * kk + 8 * q) : zero8;
    float xr = 0.f, xi = 0.f;
    if (PASS == 2) { xr = ES[((size_t)(sg * 32 + g) * 64 + p) * 2]; xi = ES[((size_t)(sg * 32 + g) * 64 + p) * 2 + 1]; }
    const float dsk = a.in[17][l * 512 + 16 * g + r];
    for (int ci = 0; ci < SSEGLEN / 16; ++ci) {
        const int t0 = sg * SSEGLEN + ci * 16;
        if (act) {
            const bf16x8 av = (q < 2) ? *(const bf16x8*)(Z + (size_t)(t0 + r) * NZ + 1024 + 16 * g + 8 * q) : zero8;
#pragma unroll
            for (int nt = 0; nt < 8; ++nt) { f32x4 acc = (f32x4){0.f, 0.f, 0.f, 0.f}; acc = MFMA16(av, bB[nt], acc);
#pragma unroll
                for (int gg = 0; gg < 4; ++gg) BU[(4 * q + gg) * 132 + 16 * nt + r] = acc[gg]; }
            wave_sync();
#pragma unroll
            for (int t = 0; t < 16; ++t) { const float br = BU[t * 132 + p], bi = BU[t * 132 + 64 + p];
                const float nr = ar * xr - ai * xi + br, ni = ar * xi + ai * xr + bi; xr = nr; xi = ni;
                if (PASS == 2) { X[t * 136 + p] = f2bf(xr); X[t * 136 + 64 + p] = f2bf(xi); } }
            wave_sync();
            if (PASS == 2) {
                f32x4 acc = (f32x4){0.f, 0.f, 0.f, 0.f};
#pragma unroll
                for (int kk = 0; kk < 4; ++kk) { const bf16x8 xv = *(const bf16x8*)(X + r * 136 + 32 * kk + 8 * q); acc = MFMA16(xv, cB[kk], acc); }
#pragma unroll
                for (int gg = 0; gg < 4; ++gg) { const int t = t0 + 4 * q + gg, c = 16 * g + r; const float u = bf2f(Z[(size_t)t * NZ + 1024 + c]);
                    YT[(4 * q + gg) * 136 + 16 * wave + r] = f2bf(gelu_tanh(acc[gg] + dsk * u)); }
            }
        }
        if (PASS == 2) {
            __syncthreads();
            if (tid < 128) { const int row = tid >> 3, c8 = (tid & 7) * 8; *(u32x4*)(YPRE + (size_t)(t0 + row) * 512 + 16 * g0 + 64 * hsel + c8) = *(const u32x4*)(YT + row * 136 + 64 * hsel + c8); }
            __syncthreads();
        }
    }
    if (PASS == 1 && act) { ES[((size_t)(sg * 32 + g) * 64 + p) * 2] = xr; ES[((size_t)(sg * 32 + g) * 64 + p) * 2 + 1] = xi; }
}

__device__ __forceinline__ void phase_scan(ArgsRef a, int tid, int bid, int G) {
    unsigned char* ws = a.ws;
    const int NT = G * 512, gt = bid * 512 + tid;
    for (int i = gt; i < 2 * 65536 + 8192 + 2048; i += NT) {
        if (i < 2 * 65536) { const int m = i >> 16, el = i & 65535, hrow = el >> 7;
            float* E = (float*)(ws + (m == 0 ? OFF_EM : OFF_EH)); const float* Gd = (const float*)(ws + (m == 0 ? OFF_GM : OFF_GH));
            float cur = 0.f;
#pragma unroll 8
            for (int sg = 0; sg < GSEG; ++sg) { const float e = E[(size_t)sg * 65536 + el], g = Gd[sg * 512 + hrow]; E[(size_t)sg * 65536 + el] = cur; cur = g * cur + e; } }
        else if (i < 2 * 65536 + 8192) { const int el = i - 2 * 65536, hrow = el >> 4; float* E = (float*)(ws + OFF_EMX); const float* Gd = (const float*)(ws + OFF_GM);
            float cur = 0.f;
#pragma unroll 8
            for (int sg = 0; sg < GSEG; ++sg) { const float e = E[(size_t)sg * 8192 + el], g = Gd[sg * 512 + hrow]; E[(size_t)sg * 8192 + el] = cur; cur = g * cur + e; } }
        else { const int el = i - 2 * 65536 - 8192; float* E = (float*)(ws + OFF_ES); const float* ABAR = (const float*)(ws + OFF_ABAR);
            float pr = ABAR[el * 2], pi = ABAR[el * 2 + 1];
#pragma unroll
            for (int k = 0; k < 8; ++k) { const float nr = pr * pr - pi * pi, ni = 2.0f * pr * pi; pr = nr; pi = ni; }
            float xr = 0.f, xi = 0.f;
#pragma unroll 8
            for (int sg = 0; sg < SSEG; ++sg) { const float er = E[((size_t)sg * 2048 + el) * 2], ei = E[((size_t)sg * 2048 + el) * 2 + 1];
                E[((size_t)sg * 2048 + el) * 2] = xr; E[((size_t)sg * 2048 + el) * 2 + 1] = xi;
                const float nr = pr * xr - pi * xi + er, ni = pr * xi + pi * xr + ei; xr = nr; xi = ni; } }
    }
}

template <int PASS>
__device__ __forceinline__ void phase_mixers(ArgsRef a, int l, int tid, int lane, int wave, int bid, int G) {
    for (int it = bid; it < 4 * GSEG; it += G) gla_item<0, PASS>(a, l, it % 4, it / 4, tid, lane, wave);
    asm volatile("" ::: "memory");
    for (int it = bid + ((4 * GSEG - bid % G) % G + G) % G * 0; it < 2 * 4 * GSEG; it += G) { if (it >= 4 * GSEG) gla_item<1, PASS>(a, l, (it - 4 * GSEG) % 4, (it - 4 * GSEG) / 4, tid, lane, wave); }
    __syncthreads();
    for (int it0 = bid * 8; it0 < 32 * SSEG; it0 += G * 8)
        for (int half = 0; half < 2; ++half) { const int it = it0 + wave; s5_item<PASS>(a, l, it % 32, it / 32, it0 % 32, tid, lane, wave, half); __syncthreads(); }
}

__device__ __forceinline__ void phase_post(ArgsRef a, int l, int lane, int gw, int GW) {
    const bf16_t* Z = (const bf16_t*)(a.ws + OFF_Z); const bf16_t* XC = (const bf16_t*)(a.ws + OFF_XC);
    bf16_t* OM = (bf16_t*)(a.ws + OFF_OM); bf16_t* OH = (bf16_t*)(a.ws + OFF_OH); const float* DEN = (const float*)(a.ws + OFF_DEN);
    const int c0 = lane * 8, hd = lane >> 4;
    float skp[8], nw[8];
#pragma unroll
    for (int j = 0; j < 8; ++j) { skp[j] = a.in[9][l * 512 + c0 + j]; nw[j] = a.in[20][l * 512 + c0 + j]; }
    for (int tb = gw * 4; tb < T; tb += GW * 4) {
        bf16x8 om[4], op[4], xc[4], oh[4], gp[4]; float dn[4];
#pragma unroll
        for (int k = 0; k < 4; ++k) { const size_t t = tb + k; om[k] = *(const bf16x8*)(OM + t * 512 + c0); op[k] = *(const bf16x8*)(Z + t * NZ + 512 + c0); xc[k] = *(const bf16x8*)(XC + t * 512 + c0);
            oh[k] = *(const bf16x8*)(OH + t * 512 + c0); gp[k] = *(const bf16x8*)(Z + t * NZ + 3072 + c0); dn[k] = DEN[hd * T + t]; }
#pragma unroll
        for (int k = 0; k < 4; ++k) { const size_t t = tb + k; const float di = __builtin_amdgcn_rcpf(fmaxf(fabsf(dn[k]), 1.0f)); float y[8], ov[8], ss = 0.f;
#pragma unroll
            for (int j = 0; j < 8; ++j) { y[j] = sigmoidf_(bf2f((bf16_t)op[k][j])) * (bf2f((bf16_t)om[k][j]) * di) + skp[j] * bf2f((bf16_t)xc[k][j]); ov[j] = bf2f((bf16_t)oh[k][j]); ss += ov[j] * ov[j]; }
            u32x4 w; w.x = pack2(y[0], y[1]); w.y = pack2(y[2], y[3]); w.z = pack2(y[4], y[5]); w.w = pack2(y[6], y[7]); *(u32x4*)(OM + t * 512 + c0) = w;
            ss += __shfl_xor(ss, 1); ss += __shfl_xor(ss, 2); ss += __shfl_xor(ss, 4); ss += __shfl_xor(ss, 8);
            const float rinv = rsqrtf(ss * (1.0f / 128.0f) + 1e-6f);
#pragma unroll
            for (int j = 0; j < 8; ++j) y[j] = ov[j] * rinv * nw[j] * siluf_(bf2f((bf16_t)gp[k][j]));
            u32x4 x; x.x = pack2(y[0], y[1]); x.y = pack2(y[2], y[3]); x.z = pack2(y[4], y[5]); x.w = pack2(y[6], y[7]); *(u32x4*)(OH + t * 512 + c0) = x; }
    }
}

__device__ __forceinline__ void ln_row(f32x4 (&v)[4], const float* gam, const float* bet, int lane) {
    float s = 0.f;
#pragma unroll
    for (int j = 0; j < 4; ++j) s += (v[j][0] + v[j][1]) + (v[j][2] + v[j][3]);
#pragma unroll
    for (int o = 32; o >= 1; o >>= 1) s += __shfl_xor(s, o);
    const float mean = s * (1.0f / 1024.0f); float qv = 0.f;
#pragma unroll
    for (int j = 0; j < 4; ++j) { const f32x4 dd = v[j] - mean; qv += (dd[0] * dd[0] + dd[1] * dd[1]) + (dd[2] * dd[2] + dd[3] * dd[3]); }
#pragma unroll
    for (int o = 32; o >= 1; o >>= 1) qv += __shfl_xor(qv, o);
    const float rstd = rsqrtf(qv * (1.0f / 1024.0f) + 1e-5f);
#pragma unroll
    for (int j = 0; j < 4; ++j) { const f32x4 gg = *(const f32x4*)(gam + 256 * j + 4 * lane), bb = *(const f32x4*)(bet + 256 * j + 4 * lane); v[j] = (v[j] - mean) * rstd * gg + bb; }
}

__device__ __forceinline__ void phase_ln1r(ArgsRef a, int l, int tid, int lane, int wave, int bid, int G) {
    float* XF = a.out; bf16_t* XB = (bf16_t*)(a.ws + OFF_XB);
    int* TOKE = (int*)(a.ws + OFF_TOKE); float* TOKG = (float*)(a.ws + OFF_TOKG); unsigned* HIST = (unsigned*)(a.ws + OFF_HIST);
    const float* RWT = (const float*)(a.ws + OFF_RWT); const float* RB = a.in[30];
    float* LG = (float*)(smem + wave * 4096);
    int* TE = (int*)(smem + wave * 4096 + 2304); float* TG = (float*)(smem + wave * 4096 + 2432); unsigned* HS = (unsigned*)(smem + wave * 4096 + 2560);
    const int r = lane & 15, q = lane >> 4, rs = lane >> 5, e = lane & 31;
    for (int tw = bid * 8 + wave; tw < T / 16; tw += G * 8) {
        const int t0 = tw * 16;
        for (int rb = 0; rb < 16; rb += 4) { f32x4 v[4][4];
#pragma unroll
            for (int k = 0; k < 4; ++k)
#pragma unroll
                for (int j = 0; j < 4; ++j) v[k][j] = *(const f32x4*)(XF + (size_t)(t0 + rb + k) * 1024 + 256 * j + 4 * lane);
#pragma unroll
            for (int k = 0; k < 4; ++k) { const int t = t0 + rb + k; ln_row(v[k], a.in[25] + l * 1024, a.in[26] + l * 1024, lane);
#pragma unroll
                for (int j = 0; j < 4; ++j) { *(f32x4*)(XF + (size_t)t * 1024 + 256 * j + 4 * lane) = v[k][j];
                    u32x2 w; w.x = pack2(v[k][j][0], v[k][j][1]); w.y = pack2(v[k][j][2], v[k][j][3]); *(u32x2*)(XB + (size_t)t * 1024 + 256 * j + 4 * lane) = w; } } }
        if (lane < 32) HS[lane] = 0u;
        asm volatile("s_waitcnt vmcnt(0) lgkmcnt(0)" ::: "memory"); __builtin_amdgcn_wave_barrier();
        f32x4 acc0 = (f32x4){0.f, 0.f, 0.f, 0.f}, acc1 = acc0;
        const float* xa = XF + (size_t)(t0 + r) * 1024 + 4 * q; const float* w0 = RWT + (size_t)r * 1024 + 4 * q; const float* w1 = RWT + (size_t)(16 + r) * 1024 + 4 * q;
#pragma unroll 4
        for (int s = 0; s < 64; ++s) { const f32x4 av = *(const f32x4*)(xa + 16 * s), b0 = *(const f32x4*)(w0 + 16 * s), b1 = *(const f32x4*)(w1 + 16 * s);
#pragma unroll
            for (int j = 0; j < 4; ++j) { acc0 = __builtin_amdgcn_mfma_f32_16x16x4f32(av[j], b0[j], acc0, 0, 0, 0); acc1 = __builtin_amdgcn_mfma_f32_16x16x4f32(av[j], b1[j], acc1, 0, 0, 0); } }
#pragma unroll
        for (int g = 0; g < 4; ++g) { LG[(4 * q + g) * 33 + r] = acc0[g]; LG[(4 * q + g) * 33 + 16 + r] = acc1[g]; }
        wave_sync();
        for (int pp = 0; pp < 8; ++pp) {
            const float lg = LG[(2 * pp + rs) * 33 + e];
            const float s = sigmoidf_(lg), sb = s + RB[e];
            float v4[4];
#pragma unroll
            for (int i = 0; i < 4; ++i) v4[i] = __shfl(sb, (lane & ~3) + i);
            int i1 = 0;
#pragma unroll
            for (int i = 1; i < 4; ++i) if (v4[i] > v4[i1]) i1 = i;
            int i2 = (i1 == 0) ? 1 : 0;
#pragma unroll
            for (int i = 0; i < 4; ++i) if (i != i1 && i != i2 && v4[i] > v4[i2]) i2 = i;
            float gs = v4[i1] + v4[i2]; int gid = e >> 2;
#pragma unroll
            for (int o = 4; o <= 16; o <<= 1) { const float os = __shfl_xor(gs, o); const int og = __shfl_xor(gid, o); if (os > gs || (os == gs && og < gid)) { gs = os; gid = og; } }
            float sv[4], sbv[4];
#pragma unroll
            for (int i = 0; i < 4; ++i) { sbv[i] = __shfl(sb, (lane & 32) + gid * 4 + i); sv[i] = __shfl(s, (lane & 32) + gid * 4 + i); }
            int j1 = 0;
#pragma unroll
            for (int i = 1; i < 4; ++i) if (sbv[i] > sbv[j1]) j1 = i;
            int j2 = (j1 == 0) ? 1 : 0;
#pragma unroll
            for (int i = 0; i < 4; ++i) if (i != j1 && i != j2 && sbv[i] > sbv[j2]) j2 = i;
            float s1 = sv[0], s2 = sv[0];
#pragma unroll
            for (int i = 1; i < 4; ++i) { if (i == j1) s1 = sv[i]; if (i == j2) s2 = sv[i]; }
            if (e == 0) { const int ti = 2 * pp + rs; const float inv = 1.0f / (s1 + s2);
                TE[ti * 2] = gid * 4 + j1; TE[ti * 2 + 1] = gid * 4 + j2; TG[ti * 2] = s1 * inv; TG[ti * 2 + 1] = s2 * inv;
                atomicAdd(&HS[gid * 4 + j1], 1u); atomicAdd(&HS[gid * 4 + j2], 1u); }
        }
        wave_sync();
        if (lane < 32) { TOKE[t0 * 2 + lane] = TE[lane]; TOKG[t0 * 2 + lane] = TG[lane]; HIST[tw * 32 + lane] = HS[lane]; }
        wave_sync();
    }
}

__device__ __forceinline__ void phase_slot(ArgsRef a, int tid, int lane, int wave, int bid, int G) {
    const int* TOKE = (const int*)(a.ws + OFF_TOKE); int* TOKS = (int*)(a.ws + OFF_TOKS); const unsigned* HIST = (const unsigned*)(a.ws + OFF_HIST);
    unsigned* BASE = (unsigned*)(a.ws + OFF_CTL) + 64;
    const bf16_t* XB = (const bf16_t*)(a.ws + OFF_XB); bf16_t* XG = (bf16_t*)(a.ws + OFF_XG);
    unsigned* base = (unsigned*)smem; unsigned* pre = base + 40; int* el = (int*)(base + 80); int* sl = (int*)(base + 208); unsigned* red = base + 336;
    const int e = tid & 31, part = tid >> 5;
    for (int c = bid; c < T / 64; c += G) {
        unsigned tot = 0u, pr = 0u;
#pragma unroll 8
        for (int it = part; it < 1024; it += 16) { const unsigned v = HIST[it * 32 + e]; tot += v; pr += (it < 4 * c) ? v : 0u; }
        red[part * 32 + e] = tot; red[512 + part * 32 + e] = pr;
        __syncthreads();
        if (tid < 32) { unsigned t2 = 0u, p2 = 0u; for (int k = 0; k < 16; ++k) { t2 += red[k * 32 + tid]; p2 += red[512 + k * 32 + tid]; } pre[tid] = p2; red[tid] = (t2 + 255u) & ~255u; }
        __syncthreads();
        if (tid == 0) { unsigned sacc = 0; for (int k = 0; k < 32; ++k) { base[k] = sacc; sacc += red[k]; } base[32] = sacc; }
        int ee = 0;
        if (tid < 128) { ee = TOKE[c * 128 + tid]; el[tid] = ee; }
        __syncthreads();
        if (c == 0 && tid < 33) BASE[tid] = base[tid];
        if (tid < 128) { unsigned rank = 0; for (int i = 0; i < tid; ++i) rank += (el[i] == ee) ? 1u : 0u;
            const unsigned sidx = base[ee] + pre[ee] + rank; sl[tid] = (int)sidx; TOKS[c * 128 + tid] = (int)sidx; }
        __syncthreads();
        for (int i = wave; i < 128; i += 8) { const int t = c * 64 + (i >> 1); const size_t so = (size_t)sl[i] * 1024;
            *(u32x4*)(XG + so + lane * 8) = *(const u32x4*)(XB + (size_t)t * 1024 + lane * 8); *(u32x4*)(XG + so + 512 + lane * 8) = *(const u32x4*)(XB + (size_t)t * 1024 + 512 + lane * 8); }
        __syncthreads();
    }
}

__device__ __forceinline__ void phase_ln2(ArgsRef a, int l, int lane, int gw, int GW) {
    float* XF = a.out; bf16_t* XB = (bf16_t*)(a.ws + OFF_XB); const bf16_t* YS = (const bf16_t*)(a.ws + OFF_YS);
    const int* TOKS = (const int*)(a.ws + OFF_TOKS); const float* TOKG = (const float*)(a.ws + OFF_TOKG);
    for (int tb = gw * 4; tb < T; tb += GW * 4) {
        int sv = 0; float gv = 0.f; if (lane < 8) { sv = TOKS[tb * 2 + lane]; gv = TOKG[tb * 2 + lane]; }
        f32x4 v[4][4]; bf16x4 y0[4][4], y1[4][4]; float g0[4], g1[4];
#pragma unroll
        for (int k = 0; k < 4; ++k) { const int s0 = __shfl(sv, 2 * k), s1 = __shfl(sv, 2 * k + 1); g0[k] = __shfl(gv, 2 * k); g1[k] = __shfl(gv, 2 * k + 1);
#pragma unroll
            for (int j = 0; j < 4; ++j) { v[k][j] = *(const f32x4*)(XF + (size_t)(tb + k) * 1024 + 256 * j + 4 * lane);
                y0[k][j] = *(const bf16x4*)(YS + (size_t)s0 * 1024 + 256 * j + 4 * lane); y1[k][j] = *(const bf16x4*)(YS + (size_t)s1 * 1024 + 256 * j + 4 * lane); } }
#pragma unroll
        for (int k = 0; k < 4; ++k) {
#pragma unroll
            for (int j = 0; j < 4; ++j)
#pragma unroll
                for (int g = 0; g < 4; ++g) v[k][j][g] = DN_ALPHA * v[k][j][g] + g0[k] * bf2f((bf16_t)y0[k][j][g]) + g1[k] * bf2f((bf16_t)y1[k][j][g]);
            ln_row(v[k], a.in[27] + l * 1024, a.in[28] + l * 1024, lane);
#pragma unroll
            for (int j = 0; j < 4; ++j) { *(f32x4*)(XF + (size_t)(tb + k) * 1024 + 256 * j + 4 * lane) = v[k][j];
                u32x2 w; w.x = pack2(v[k][j][0], v[k][j][1]); w.y = pack2(v[k][j][2], v[k][j][3]); *(u32x2*)(XB + (size_t)(tb + k) * 1024 + 256 * j + 4 * lane) = w; } }
    }
}

struct SchedGrid {
    int nM, nN, G, c; const char* A; const char* B; size_t strideA, strideB;
    __device__ __forceinline__ bool next(int i, pg8::Unit& u) const { int pm, pn; if (!pg8::tile_order(i * G + c, nM, nN, pm, pn)) return false;
        u.pm = pm; u.pn = pn; u.tag = 0; u.A = A + (size_t)pm * strideA; u.B = B + (size_t)pn * strideB; return true; }
};
constexpr int GATES_LD = 3072;
template <int MODE> struct EpiBf16 {
    static constexpr bool PERM = true;
    bf16_t* O; int ldo; const bf16_t* Y; int ldy;
    __device__ __forceinline__ bool operator()(f32x4 (&acc)[2][2][4][2], const pg8::Unit& u, int wr, int wc, int fr, int fq) const {
#pragma unroll
        for (int ai = 0; ai < 2; ++ai) {
            bf16x8 yv[4][2];
            if (MODE == 2) {
#pragma unroll
                for (int m = 0; m < 4; ++m)
#pragma unroll
                    for (int bj = 0; bj < 2; ++bj) yv[m][bj] = *(const bf16x8*)(Y + ((size_t)u.pm * 256 + ai * 128 + wr * 64 + m * 16 + fr) * ldy + u.pn * 256 + bj * 128 + wc * 32 + 8 * fq);
            }
#pragma unroll
            for (int m = 0; m < 4; ++m) { const size_t row = (size_t)u.pm * 256 + ai * 128 + wr * 64 + m * 16 + fr;
#pragma unroll
                for (int bj = 0; bj < 2; ++bj) { const int col = u.pn * 256 + bj * 128 + wc * 32 + 8 * fq; f32x4 v0 = acc[ai][bj][m][0], v1 = acc[ai][bj][m][1];
                    if (MODE == 1) {
#pragma unroll
                        for (int j = 0; j < 4; ++j) { v0[j] = fmaxf(sigmoidf_(v0[j]), 1e-30f); v1[j] = fmaxf(sigmoidf_(v1[j]), 1e-30f); } }
                    if (MODE == 2) {
#pragma unroll
                        for (int j = 0; j < 4; ++j) { v0[j] = bf2f((bf16_t)yv[m][bj][j]) * sigmoidf_(v0[j]); v1[j] = bf2f((bf16_t)yv[m][bj][4 + j]) * sigmoidf_(v1[j]); } }
                    u32x4 w; w.x = pg8::cvt_pk_bf16(v0[0], v0[1]); w.y = pg8::cvt_pk_bf16(v0[2], v0[3]); w.z = pg8::cvt_pk_bf16(v1[0], v1[1]); w.w = pg8::cvt_pk_bf16(v1[2], v1[3]);
                    if (MODE == 1) *(u32x4*)(O + ((((size_t)u.pm * 12 + u.pn) * 16 + (ai * 8 + m * 2 + bj)) * 512 + ((wr * 4 + wc) * 64 + fq * 16 + fr)) * 8) = w;
                    else *(u32x4*)(O + row * ldo + col) = w; } }
        }
        return false;
    }
};
struct SchedZ {
    int G, c; const unsigned char* ws;
    __device__ __forceinline__ bool next(int i, pg8::Unit& u) const { int pm, pn; if (!pg8::tile_order(i * G + c, T / 256, 15, pm, pn)) return false;
        u.pm = pm; u.pn = pn; u.tag = 0; u.A = (const char*)(ws + OFF_XB) + (size_t)pm * 256 * 1024 * 2;
        u.B = (const char*)(ws + OFF_WIN) + (size_t)(pn < 14 ? pn * 256 : 6656) * 1024 * 2; return true; }
};
struct EpiZ {
    static constexpr bool PERM = true;
    bf16_t* Z; float* LI; float* LF; const float* bi; const float* bf;
    __device__ __forceinline__ bool operator()(f32x4 (&acc)[2][2][4][2], const pg8::Unit& u, int wr, int wc, int fr, int fq) const {
        if (u.pn < 14) {
#pragma unroll
            for (int ai = 0; ai < 2; ++ai)
#pragma unroll
                for (int m = 0; m < 4; ++m) { const size_t row = (size_t)u.pm * 256 + ai * 128 + wr * 64 + m * 16 + fr;
#pragma unroll
                    for (int bj = 0; bj < 2; ++bj) { const int col = u.pn * 256 + bj * 128 + wc * 32 + 8 * fq; const f32x4 v0 = acc[ai][bj][m][0], v1 = acc[ai][bj][m][1];
                        u32x4 w; w.x = pg8::cvt_pk_bf16(v0[0], v0[1]); w.y = pg8::cvt_pk_bf16(v0[2], v0[3]); w.z = pg8::cvt_pk_bf16(v1[0], v1[1]); w.w = pg8::cvt_pk_bf16(v1[2], v1[3]);
                        *(u32x4*)(Z + row * NZ + col) = w; } }
        } else if (wc == 0 && fq == 0) {
            const f32x4 b_i = *(const f32x4*)bi, b_f = *(const f32x4*)bf;
#pragma unroll
            for (int ai = 0; ai < 2; ++ai)
#pragma unroll
                for (int m = 0; m < 4; ++m) { const size_t row = (size_t)u.pm * 256 + ai * 128 + wr * 64 + m * 16 + fr; const f32x4 v0 = acc[ai][0][m][0] + b_i, v1 = acc[ai][0][m][1] + b_f;
                    f32x4 lf; lf[0] = logsigmoidf_(v1[0]); lf[1] = logsigmoidf_(v1[1]); lf[2] = logsigmoidf_(v1[2]); lf[3] = logsigmoidf_(v1[3]);
                    *(f32x4*)(LI + row * 4) = v0; *(f32x4*)(LF + row * 4) = lf; }
        }
        return false;
    }
};
__device__ __forceinline__ void phase_zgemm2(ArgsRef a, int l, int tid, int bid, int G) {
    SchedZ S{G, bid, a.ws}; EpiZ E{(bf16_t*)(a.ws + OFF_Z), (float*)(a.ws + OFF_LI), (float*)(a.ws + OFF_LF), a.in[7] + l * 4, a.in[8] + l * 4};
    pg8::gemm_phase((PG8_LAS unsigned char*)smem, tid, 1024, 1024, 1024, S, E);
}
__device__ __forceinline__ void phase_glu_gates(ArgsRef a, int l, int tid, int bid, int G) {
    { SchedGrid S{T / 256, 2, G, bid, (const char*)(a.ws + OFF_YPRE), (const char*)(a.ws + OFF_WGLU), (size_t)256 * 512 * 2, (size_t)256 * 512 * 2};
      EpiBf16<2> E{(bf16_t*)(a.ws + OFF_YSG), 512, (const bf16_t*)(a.ws + OFF_YPRE), 512};
      pg8::gemm_phase((PG8_LAS unsigned char*)smem, tid, 512, 512, 512, S, E); }
    asm volatile("" : "+v"(tid), "+s"(bid), "+s"(G));
    if (G > 128) { if (bid >= 128) phase_prepx(a, l, tid, bid - 128, G - 128, 0, 896); } else phase_prepx(a, l, tid, bid, G, 0, 896);
    asm volatile("" : "+v"(tid), "+s"(bid), "+s"(G));
    { SchedGrid S{T / 256, 12, G, (bid + G / 2) % G, (const char*)(a.ws + OFF_XB), (const char*)(a.ws + OFF_WIN + (size_t)NZ * 1024 * 2), (size_t)256 * 1024 * 2, (size_t)256 * 1024 * 2};
      EpiBf16<1> E{(bf16_t*)(a.ws + OFF_Z), GATES_LD, nullptr, 0};
      pg8::gemm_phase((PG8_LAS unsigned char*)smem, tid, 1024, 1024, 1024, S, E); }
}
struct SchedMerge {
    int G, c; const unsigned char* ws;
    __device__ __forceinline__ bool next(int i, pg8::Unit& u) const { const int b = i % 3; int pm, pn; if (!pg8::tile_order((i / 3) * G + c, T / 256, 4, pm, pn)) return false;
        u.pm = pm; u.pn = pn; u.tag = b; u.A = (const char*)(ws + (b == 0 ? OFF_OM : b == 1 ? OFF_YSG : OFF_OH)) + (size_t)pm * 256 * 512 * 2;
        u.B = (const char*)(ws + OFF_WB) + ((size_t)b * 1024 + pn * 256) * 512 * 2; return true; }
};
struct EpiMerge {
    static constexpr bool PERM = true;
    const bf16_t* GT; bf16_t* O;
    __device__ __forceinline__ bool operator()(f32x4 (&acc)[2][2][4][2], const pg8::Unit& u, int wr, int wc, int fr, int fq) const {
        const int b = u.tag;
#pragma unroll
        for (int ai = 0; ai < 2; ++ai)
#pragma unroll
        for (int mh = 0; mh < 2; ++mh) {
            bf16x8 gb[2][2], gn[2][2];
#pragma unroll
            for (int mm = 0; mm < 2; ++mm)
#pragma unroll
                for (int bj = 0; bj < 2; ++bj) { const bf16_t* gp = GT + ((((size_t)u.pm * 12 + b * 4 + u.pn) * 16 + (ai * 8 + (2 * mh + mm) * 2 + bj)) * 512 + ((wr * 4 + wc) * 64 + fq * 16 + fr)) * 8;
                    gb[mm][bj] = *(const bf16x8*)gp; gn[mm][bj] = (b < 2) ? *(const bf16x8*)(gp + (size_t)4 * 16 * 512 * 8) : gb[mm][bj]; }
#pragma unroll
            for (int mm = 0; mm < 2; ++mm) { const int m = 2 * mh + mm; const size_t row = (size_t)u.pm * 256 + ai * 128 + wr * 64 + m * 16 + fr;
#pragma unroll
                for (int bj = 0; bj < 2; ++bj) { const int col = u.pn * 256 + bj * 128 + wc * 32 + 8 * fq;
                    if (b < 2) {
#pragma unroll
                        for (int j = 0; j < 4; ++j) { acc[ai][bj][m][0][j] *= bf2f((bf16_t)gb[mm][bj][j]) * __builtin_amdgcn_rcpf(bf2f((bf16_t)gn[mm][bj][j])); acc[ai][bj][m][1][j] *= bf2f((bf16_t)gb[mm][bj][4 + j]) * __builtin_amdgcn_rcpf(bf2f((bf16_t)gn[mm][bj][4 + j])); } }
                    else { f32x4 v0 = acc[ai][bj][m][0], v1 = acc[ai][bj][m][1];
#pragma unroll
                        for (int j = 0; j < 4; ++j) { v0[j] *= bf2f((bf16_t)gb[mm][bj][j]); v1[j] *= bf2f((bf16_t)gb[mm][bj][4 + j]); }
                        u32x4 w; w.x = pg8::cvt_pk_bf16(v0[0], v0[1]); w.y = pg8::cvt_pk_bf16(v0[2], v0[3]); w.z = pg8::cvt_pk_bf16(v1[0], v1[1]); w.w = pg8::cvt_pk_bf16(v1[2], v1[3]);
                        *(u32x4*)(O + row * 1024 + col) = w; } } }
        }
        return b < 2;
    }
};
__device__ __forceinline__ void phase_merge2(ArgsRef a, int tid, int bid, int G) {
    SchedMerge S{G, bid, a.ws}; EpiMerge E{(const bf16_t*)(a.ws + OFF_Z), (bf16_t*)(a.ws + OFF_XB)};
    pg8::gemm_phase((PG8_LAS unsigned char*)smem, tid, 512, 512, 512, S, E);
}
struct EpiResid {
    static constexpr bool PERM = false;
    const float* xin; float* XF;
    __device__ __forceinline__ bool operator()(f32x4 (&acc)[2][2][4][2], const pg8::Unit& u, int wr, int wc, int fr, int fq) const {
#pragma unroll
        for (int ai = 0; ai < 2; ++ai)
#pragma unroll
        for (int mh = 0; mh < 2; ++mh) {
            f32x4 xv[2][2][2];
#pragma unroll
            for (int mm = 0; mm < 2; ++mm)
#pragma unroll
                for (int bj = 0; bj < 2; ++bj)
#pragma unroll
                    for (int n = 0; n < 2; ++n) xv[mm][bj][n] = *(const f32x4*)(xin + ((size_t)u.pm * 256 + ai * 128 + wr * 64 + (2 * mh + mm) * 16 + fr) * 1024 + u.pn * 256 + bj * 128 + wc * 32 + 16 * n + 4 * fq);
#pragma unroll
            for (int mm = 0; mm < 2; ++mm)
#pragma unroll
                for (int bj = 0; bj < 2; ++bj)
#pragma unroll
                    for (int n = 0; n < 2; ++n) { const int m = 2 * mh + mm; const size_t o = ((size_t)u.pm * 256 + ai * 128 + wr * 64 + m * 16 + fr) * 1024 + u.pn * 256 + bj * 128 + wc * 32 + 16 * n + 4 * fq; *(f32x4*)(XF + o) = DN_ALPHA * xv[mm][bj][n] + acc[ai][bj][m][n]; }
        }
        return false;
    }
};
__device__ __forceinline__ void phase_wout2(ArgsRef a, int l, int tid, int bid, int G) {
    SchedGrid S{T / 256, 4, G, bid, (const char*)(a.ws + OFF_XB), (const char*)(a.ws + OFF_WOUT), (size_t)256 * 1024 * 2, (size_t)256 * 1024 * 2};
    EpiResid E{(l == 0) ? a.in[0] : a.out, a.out};
    pg8::gemm_phase((PG8_LAS unsigned char*)smem, tid, 1024, 1024, 1024, S, E);
}
struct EpiQKV {
    static constexpr bool PERM = true;
    int vcall; bf16_t* Q; bf16_t* KH; bf16_t* V; const float* LI;
    __device__ __forceinline__ bool operator()(f32x4 (&acc)[2][2][4][2], const pg8::Unit& u, int wr, int wc, int fr, int fq) const {
        const int which = vcall ? 2 : (u.pn >> 1); bf16_t* O = Q + (size_t)which * (SZ_ACT / 2);
        float liv[2][4][2];
#pragma unroll
        for (int ai = 0; ai < 2; ++ai)
#pragma unroll
            for (int m = 0; m < 4; ++m)
#pragma unroll
                for (int bj = 0; bj < 2; ++bj) liv[ai][m][bj] = (which == 1) ? LI[((size_t)u.pm * 256 + ai * 128 + wr * 64 + m * 16 + fr) * 4 + (u.pn & 1) * 2 + bj] : 0.f;
#pragma unroll
        for (int ai = 0; ai < 2; ++ai)
#pragma unroll
            for (int m = 0; m < 4; ++m) { const size_t row = (size_t)u.pm * 256 + ai * 128 + wr * 64 + m * 16 + fr;
#pragma unroll
                for (int bj = 0; bj < 2; ++bj) { const int hd = (u.pn & 1) * 2 + bj, col = hd * 128 + wc * 32 + 8 * fq;
                    const float sc = which == 0 ? 0.08838834764831845f : which == 1 ? fexp(liv[ai][m][bj]) : 1.0f;
                    const f32x4 v0 = acc[ai][bj][m][0] * sc, v1 = acc[ai][bj][m][1] * sc;
                    u32x4 w; w.x = pg8::cvt_pk_bf16(v0[0], v0[1]); w.y = pg8::cvt_pk_bf16(v0[2], v0[3]); w.z = pg8::cvt_pk_bf16(v1[0], v1[1]); w.w = pg8::cvt_pk_bf16(v1[2], v1[3]);
                    *(u32x4*)(O + row * 512 + col) = w; } }
        return false;
    }
};
__device__ __forceinline__ void phase_mqkv2(ArgsRef a, int tid, int bid, int G) {
    { SchedGrid S{T / 256, 4, G, bid, (const char*)(a.ws + OFF_XC), (const char*)(a.ws + OFF_WQKV), (size_t)256 * 512 * 2, (size_t)256 * 512 * 2};
      EpiQKV E{0, (bf16_t*)(a.ws + OFF_Q), (bf16_t*)(a.ws + OFF_KH), (bf16_t*)(a.ws + OFF_V), (const float*)(a.ws + OFF_LI)};
      pg8::gemm_phase((PG8_LAS unsigned char*)smem, tid, 512, 512, 512, S, E); }
    asm volatile("" : "+v"(tid), "+s"(bid), "+s"(G));
    { SchedGrid S{T / 256, 2, G, (bid + G / 2) % G, (const char*)(a.ws + OFF_Z), (const char*)(a.ws + OFF_WQKV + (size_t)1024 * 512 * 2), (size_t)256 * NZ * 2, (size_t)256 * 512 * 2};
      EpiQKV E{1, (bf16_t*)(a.ws + OFF_Q), (bf16_t*)(a.ws + OFF_KH), (bf16_t*)(a.ws + OFF_V), (const float*)(a.ws + OFF_LI)};
      pg8::gemm_phase((PG8_LAS unsigned char*)smem, tid, 512, NZ, 512, S, E); }
}
struct SchedMoE {
    int down, G, c; const unsigned char* ws; const unsigned* BASE;
    __device__ __forceinline__ bool next(int i, pg8::Unit& u) const { const int per = down ? 4 : 2, L = i * G + c, ntile = (int)(BASE[32] >> 8); if (L >= ntile * per) return false;
        const int tile = L / per, sub = L % per; int e = 0; while (e < 31 && BASE[e + 1] <= (unsigned)(tile * 256)) ++e;
        u.pm = tile; u.pn = sub; u.tag = e;
        if (!down) { u.A = (const char*)(ws + OFF_XG) + (size_t)tile * 256 * 1024 * 2; u.B = (const char*)(ws + OFF_WGU) + ((size_t)e * 512 + sub * 256) * 1024 * 2; }
        else { u.A = (const char*)(ws + OFF_H) + (size_t)tile * 256 * 256 * 2; u.B = (const char*)(ws + OFF_WD) + ((size_t)e * 1024 + sub * 256) * 256 * 2; }
        return true; }
};
struct EpiH {
    static constexpr bool PERM = true;
    bf16_t* H;
    __device__ __forceinline__ bool operator()(f32x4 (&acc)[2][2][4][2], const pg8::Unit& u, int wr, int wc, int fr, int fq) const {
#pragma unroll
        for (int ai = 0; ai < 2; ++ai)
#pragma unroll
            for (int m = 0; m < 4; ++m) { const size_t row = (size_t)u.pm * 256 + ai * 128 + wr * 64 + m * 16 + fr; f32x4 v0, v1;
#pragma unroll
                for (int j = 0; j < 4; ++j) { v0[j] = siluf_(acc[ai][0][m][0][j]) * acc[ai][1][m][0][j]; v1[j] = siluf_(acc[ai][0][m][1][j]) * acc[ai][1][m][1][j]; }
                u32x4 w; w.x = pg8::cvt_pk_bf16(v0[0], v0[1]); w.y = pg8::cvt_pk_bf16(v0[2], v0[3]); w.z = pg8::cvt_pk_bf16(v1[0], v1[1]); w.w = pg8::cvt_pk_bf16(v1[2], v1[3]);
                *(u32x4*)(H + row * 256 + u.pn * 128 + wc * 32 + 8 * fq) = w; }
        return false;
    }
};
__device__ __forceinline__ void phase_moe_gu2(ArgsRef a, int l, int tid, int bid, int G) {
    { SchedMoE S{0, G, bid, a.ws, (const unsigned*)(a.ws + OFF_CTL) + 64}; EpiH E{(bf16_t*)(a.ws + OFF_H)};
      pg8::gemm_phase((PG8_LAS unsigned char*)smem, tid, 1024, 1024, 1024, S, E); }
    if (l + 1 < NLAYER) {
        asm volatile("" : "+v"(tid), "+s"(bid), "+s"(G));
        const int ntile = (int)(((const unsigned*)(a.ws + OFF_CTL))[64 + 32] >> 8); int nb = ntile * 2 - G; nb = nb < 0 ? 0 : (nb > G - 1 ? G - 1 : nb);
        if (bid >= nb) phase_prep(a, l + 1, tid, bid - nb, G - nb);
    }
}
__device__ __forceinline__ void phase_moe_dn2(ArgsRef a, int tid, int bid, int G) {
    SchedMoE S{1, G, bid, a.ws, (const unsigned*)(a.ws + OFF_CTL) + 64}; EpiBf16<0> E{(bf16_t*)(a.ws + OFF_YS), 1024, nullptr, 0};
    pg8::gemm_phase((PG8_LAS unsigned char*)smem, tid, 256, 256, 256, S, E);
}
__device__ __forceinline__ void phase_mprep2(ArgsRef a, int l, int tid, int lane, int wave, int bid, int G) {
    const bf16_t* Z = (const bf16_t*)(a.ws + OFF_Z); bf16_t* XC = (bf16_t*)(a.ws + OFF_XC);
    const float* cw = a.in[2] + (size_t)l * 4 * 512; const float* cb = a.in[3] + (size_t)l * 512;
    for (int idx = bid * 512 + tid; idx < (T / 8) * 64; idx += G * 512) {
        const int tb = (idx / 64) * 8, c0 = (idx % 64) * 8;
        bf16x8 xr[11];
#pragma unroll
        for (int k = 0; k < 11; ++k) { const int ts = tb - 3 + k; xr[k] = (ts >= 0) ? *(const bf16x8*)(Z + (size_t)ts * NZ + c0) : (bf16x8){0, 0, 0, 0, 0, 0, 0, 0}; }
        float w[4][8], b[8];
#pragma unroll
        for (int j = 0; j < 8; ++j) { b[j] = cb[c0 + j];
#pragma unroll
            for (int k = 0; k < 4; ++k) w[k][j] = cw[k * 512 + c0 + j]; }
#pragma unroll
        for (int tt = 0; tt < 8; ++tt) { float acc[8];
#pragma unroll
            for (int j = 0; j < 8; ++j) { acc[j] = b[j];
#pragma unroll
                for (int k = 0; k < 4; ++k) acc[j] += w[k][j] * bf2f((bf16_t)xr[tt + k][j]); }
            u32x4 o; o.x = pack2(siluf_(acc[0]), siluf_(acc[1])); o.y = pack2(siluf_(acc[2]), siluf_(acc[3])); o.z = pack2(siluf_(acc[4]), siluf_(acc[5])); o.w = pack2(siluf_(acc[6]), siluf_(acc[7]));
            *(u32x4*)(XC + (size_t)(tb + tt) * 512 + c0) = o; }
    }
}

#define XB_TMO      128
#define XB_XCNT(j)  (256  + 64 * (j))
#define XB_XSUB(j)  (1280 + 64 * (j))
#define XB_XGEN(j)  (2304 + 64 * (j))
#define XB_TOP      3328
#define XB_TOPGEN   3392
#define XCD_BAR_WORDS 3456
#define XB_SPIN_CAP (1u << 22)
__device__ __forceinline__ unsigned xb_ld(unsigned* p)              { return __hip_atomic_load(p, __ATOMIC_RELAXED, __HIP_MEMORY_SCOPE_AGENT); }
__device__ __forceinline__ unsigned xb_add(unsigned* p, unsigned v) { return __hip_atomic_fetch_add(p, v, __ATOMIC_RELAXED, __HIP_MEMORY_SCOPE_AGENT); }
__device__ __forceinline__ unsigned xb_xcc_id() { return (unsigned)__builtin_amdgcn_s_getreg((3 << 11) | 20) & 0xFu; }
#define XB_SPIN(cond, bar) do { unsigned _sp = 0; while (cond) { __builtin_amdgcn_s_sleep(1); \
    if ((++_sp & 255u) == 0u) { if (xb_ld(&(bar)[XB_TMO])) break; if (_sp > XB_SPIN_CAP) { atomicAdd(&(bar)[XB_TMO], 1u); break; } } } } while (0)
__device__ __forceinline__ void xcd_barrier_complete(unsigned* bar, unsigned x, unsigned& nloc, unsigned& nx) {
    const unsigned G = gridDim.x; unsigned sum, cnt, mine, sp = 0u;
    for (;;) { sum = 0u; cnt = 0u; mine = 0u;
#pragma unroll
        for (unsigned j = 0; j < 16; ++j) { const unsigned c = xb_ld(&bar[XB_XCNT(j)]); sum += c; cnt += (c > 0u) ? 1u : 0u; mine = (j == x) ? c : mine; }
        if (sum == G) break;
        __builtin_amdgcn_s_sleep(1);
        if ((++sp & 255u) == 0u) { if (xb_ld(&bar[XB_TMO])) break; if (sp > XB_SPIN_CAP) { atomicAdd(&bar[XB_TMO], 1u); break; } } }
    nloc = mine > 0u ? mine : 1u; nx = cnt > 0u ? cnt : 1u;
}
__device__ __forceinline__ void xcd_barrier(unsigned* bar, volatile __attribute__((address_space(3))) unsigned* st) {
    asm volatile("s_waitcnt vmcnt(0)" ::: "memory");
    __syncthreads();
    if (threadIdx.x == 0) {
        __builtin_amdgcn_s_waitcnt(0);
        const unsigned x = xb_xcc_id();
        unsigned nloc = st[0], nx = st[1];
        if (nloc == 0u) { xcd_barrier_complete(bar, x, nloc, nx); st[0] = nloc; st[1] = nx; }
        const unsigned old = xb_add(&bar[XB_XSUB(x)], 1u);
        const unsigned gen = old / nloc;
        if (old + 1u == (gen + 1u) * nloc) {
            __builtin_amdgcn_fence(__ATOMIC_RELEASE, "agent");
            asm volatile("s_waitcnt vmcnt(0)" ::: "memory");
            const unsigned og = xb_add(&bar[XB_TOP], 1u);
            const unsigned tg = og / nx;
            if (og + 1u == (tg + 1u) * nx) xb_add(&bar[XB_TOPGEN], 1u);
            else XB_SPIN(xb_ld(&bar[XB_TOPGEN]) == tg, bar);
            __builtin_amdgcn_fence(__ATOMIC_ACQUIRE, "agent");
            xb_add(&bar[XB_XGEN(x)], 1u);
            asm volatile("s_waitcnt vmcnt(0)" ::: "memory");
        } else {
            XB_SPIN(xb_ld(&bar[XB_XGEN(x)]) == gen, bar);
            __builtin_amdgcn_fence(__ATOMIC_ACQUIRE, "agent");
            asm volatile("s_waitcnt vmcnt(0)" ::: "memory");
        }
    }
    __syncthreads();
}

__device__ __forceinline__ ArgsRef fresh_args() { unsigned long long p = (unsigned long long)__builtin_amdgcn_kernarg_segment_ptr(); asm volatile("" : "+s"(p)); return *(const __attribute__((address_space(4))) Args*)p; }
__global__ void __launch_bounds__(512) fwd(Args a_unused) {
    cg::grid_group grid = cg::this_grid();
    volatile __attribute__((address_space(3))) unsigned* bst = (volatile __attribute__((address_space(3))) unsigned*)((__attribute__((address_space(3))) unsigned char*)smem + 131072);
    if (threadIdx.x < 4) bst[threadIdx.x] = 0u;
    __syncthreads();
    { ArgsRef a0 = fresh_args(); if (threadIdx.x == 0) (void)xb_add(&((unsigned*)(a0.ws + OFF_BAR))[XB_XCNT(xb_xcc_id())], 1u); }
#define GSYNC() do { asm volatile("" ::: "memory"); { ArgsRef ab = fresh_args(); xcd_barrier((unsigned*)(ab.ws + OFF_BAR), bst); } asm volatile("" ::: "memory"); } while (0)
#define GSYNC_CG() do { asm volatile("" ::: "memory"); grid.sync(); asm volatile("" ::: "memory"); } while (0)
    const int wave_s = __builtin_amdgcn_readfirstlane((int)threadIdx.x >> 6);
#define PH(body) do { int wave = wave_s; asm volatile("" : "+s"(wave)); int lane; asm volatile("v_mbcnt_lo_u32_b32 %0, -1, 0\n\tv_mbcnt_hi_u32_b32 %0, -1, %0" : "=v"(lane)); \
        int bid = blockIdx.x, G = gridDim.x; asm volatile("" : "+s"(bid), "+s"(G)); \
        const int tid = wave * 64 + lane, gw = bid * 8 + wave, GW = G * 8; (void)tid; (void)gw; (void)GW; ArgsRef a = fresh_args(); body; } while (0)
#pragma unroll 1
    for (int l = 0; l < NLAYER; ++l) {
        if (l == 0) { PH(phase_prep(a, 0, tid, bid, G)); GSYNC_CG(); }
        PH(phase_zgemm2(a, l, tid, bid, G)); GSYNC();
        PH(phase_mprep2(a, l, tid, lane, wave, bid, G)); GSYNC();
        PH(phase_mqkv2(a, tid, bid, G)); GSYNC();
        PH(phase_mixers<1>(a, l, tid, lane, wave, bid, G)); GSYNC();
        PH(phase_scan(a, tid, bid, G)); GSYNC();
        PH(phase_mixers<2>(a, l, tid, lane, wave, bid, G)); GSYNC();
        PH(phase_glu_gates(a, l, tid, bid, G)); PH(phase_prepx(a, l, tid, bid, G, 896, 4608)); GSYNC();
        PH(phase_merge2(a, tid, bid, G)); GSYNC();
        PH(phase_wout2(a, l, tid, bid, G)); GSYNC();
        PH(phase_ln1r(a, l, tid, lane, wave, bid, G)); PH(if (G > 128) { if (bid >= 128) phase_prepx(a, l, tid, bid - 128, G - 128, 4608, 6144); } else phase_prepx(a, l, tid, bid, G, 4608, 6144)); GSYNC();
        PH(phase_slot(a, tid, lane, wave, bid, G)); GSYNC();
        PH(phase_moe_gu2(a, l, tid, bid, G)); GSYNC();
        PH(phase_moe_dn2(a, tid, bid, G)); GSYNC();
        PH(phase_ln2(a, l, lane, gw, GW)); if (l + 1 < NLAYER) GSYNC();
    }
}

extern "C" void kernel_launch(void* const* d_in, const int* in_sizes, int n_in, void* d_out, int out_size, void* d_ws, size_t ws_size, hipStream_t stream) {
    static int grid = 0;
    if (grid == 0) {
        if (n_in != 34 || out_size != T * D || ws_size < WS_TOTAL) { fprintf(stderr, "kernel_launch: unexpected shapes (n_in %d, out %d, ws %zu, need %zu)\n", n_in, out_size, ws_size, (size_t)WS_TOTAL); grid = -1; return; }
        int dev = 0, cus = 0, per_cu = 0;
        (void)hipGetDevice(&dev); (void)hipDeviceGetAttribute(&cus, hipDeviceAttributeMultiprocessorCount, dev);
        (void)hipFuncSetAttribute((const void*)fwd, hipFuncAttributeMaxDynamicSharedMemorySize, LDS_BYTES);
        (void)hipOccupancyMaxActiveBlocksPerMultiprocessor(&per_cu, (const void*)fwd, 512, LDS_BYTES);
        if (per_cu < 1) { fprintf(stderr, "kernel_launch: occupancy query says %d blocks per CU\n", per_cu); per_cu = 1; }
        grid = (cus > 0 ? cus : 256) * 1;
        (void)hipGetLastError();
    }
    if (grid < 0) return;
    Args a{};
    for (int i = 0; i < 34; ++i) a.in[i] = (const float*)d_in[i];
    a.out = (float*)d_out; a.ws = (unsigned char*)d_ws; a.ph_lo = 0; a.ph_hi = NLAYER * NPH;
    (void)hipMemsetAsync((unsigned char*)d_ws + OFF_BAR, 0, 16384, stream);
    void* args[] = {&a};
    hipError_t e = hipLaunchCooperativeKernel((const void*)fwd, dim3(grid), dim3(512), args, LDS_BYTES, stream);
    if (e != hipSuccess) fprintf(stderr, "kernel_launch: cooperative launch failed: %s (grid %d)\n", hipGetErrorString(e), grid);
}
```

```cpp
#include <hip/hip_runtime.h>
#include <hip/hip_cooperative_groups.h>
#include <cstdio>
#include <cstdint>
namespace cg = cooperative_groups;

typedef unsigned short bf16_t;
typedef short bf16x8 __attribute__((ext_vector_type(8)));
typedef short bf16x4 __attribute__((ext_vector_type(4)));
typedef float f32x4 __attribute__((ext_vector_type(4)));
typedef unsigned u32x4 __attribute__((ext_vector_type(4)));
typedef unsigned u32x2 __attribute__((ext_vector_type(2)));

constexpr int T = 16384, D = 1024, NZ = 3584, NWIN = 6912, INW = 6664;
constexpr int NPH = 15, NLAYER = 2;
constexpr int GSEG = 32, GSEGLEN = 512;
constexpr int SSEG = 64, SSEGLEN = 256;
constexpr int SLOTS = 40960;
constexpr float DN_ALPHA = 1.41421356237f;
constexpr int LDS_BYTES = 131072 + 256;

constexpr size_t AL(size_t x) { return (x + 255) & ~(size_t)255; }
constexpr size_t OFF_WIN = 0;
constexpr size_t OFF_WQKV = OFF_WIN + AL((size_t)NWIN * 1024 * 2);
constexpr size_t OFF_WGLU = OFF_WQKV + AL((size_t)1536 * 512 * 2);
constexpr size_t OFF_WB = OFF_WGLU + AL((size_t)512 * 512 * 2);
constexpr size_t OFF_WOUT = OFF_WB + AL((size_t)3 * 1024 * 512 * 2);
constexpr size_t OFF_ABAR = OFF_WOUT + AL((size_t)1024 * 1024 * 2);
constexpr size_t OFF_BBT = OFF_ABAR + AL((size_t)32 * 64 * 2 * 4);
constexpr size_t OFF_CCT = OFF_BBT + AL((size_t)32 * 128 * 16 * 2);
constexpr size_t OFF_CTL = OFF_CCT + AL((size_t)32 * 16 * 128 * 2);
constexpr size_t OFF_TOKE = OFF_CTL + 4096;
constexpr size_t OFF_TOKG = OFF_TOKE + AL((size_t)T * 2 * 4);
constexpr size_t OFF_TOKS = OFF_TOKG + AL((size_t)T * 2 * 4);
constexpr size_t OFF_SLOTT = OFF_TOKS + AL((size_t)T * 2 * 4);
constexpr size_t OFF_XB = OFF_SLOTT + AL((size_t)SLOTS * 4);
constexpr size_t OFF_R1 = OFF_XB + AL((size_t)T * 1024 * 2);
constexpr size_t SZ_ACT = (size_t)T * 512 * 2;
constexpr size_t OFF_XC = OFF_R1, OFF_Q = OFF_R1 + SZ_ACT, OFF_KH = OFF_R1 + 2 * SZ_ACT, OFF_V = OFF_R1 + 3 * SZ_ACT;
constexpr size_t OFF_WGU = OFF_R1, OFF_WD = OFF_R1 + (size_t)32 * 512 * 1024 * 2;
constexpr size_t OFF_Z = OFF_R1 + 4 * SZ_ACT;
constexpr size_t OFF_XG = OFF_Z, OFF_H = OFF_Z + (size_t)SLOTS * 1024 * 2;
constexpr size_t OFF_ZS = OFF_Z + AL((size_t)T * NZ * 2);
constexpr size_t OFF_LF = OFF_ZS + AL((size_t)T * 8 * 4);
constexpr size_t OFF_LI = OFF_LF + AL((size_t)T * 4 * 4);
constexpr size_t OFF_E = OFF_LI + AL((size_t)T * 4 * 4);
constexpr size_t OFF_OM = OFF_E, OFF_OH = OFF_E + SZ_ACT, OFF_YPRE = OFF_E + 2 * SZ_ACT, OFF_YSG = OFF_E + 3 * SZ_ACT;
constexpr size_t OFF_DEN = OFF_E + 4 * SZ_ACT;
constexpr size_t OFF_EM = OFF_DEN + AL((size_t)T * 4 * 4);
constexpr size_t OFF_EMX = OFF_EM + AL((size_t)GSEG * 4 * 128 * 128 * 4);
constexpr size_t OFF_GM = OFF_EMX + AL((size_t)GSEG * 4 * 128 * 16 * 4);
constexpr size_t OFF_EH = OFF_GM + AL((size_t)GSEG * 4 * 128 * 4);
constexpr size_t OFF_GH = OFF_EH + AL((size_t)GSEG * 4 * 128 * 128 * 4);
constexpr size_t OFF_ES = OFF_GH + AL((size_t)GSEG * 4 * 128 * 4);
constexpr size_t WS_END = OFF_ES + AL((size_t)SSEG * 32 * 64 * 2 * 4);
constexpr size_t OFF_YS = OFF_E;
constexpr size_t OFF_RWT = WS_END;
constexpr size_t OFF_HIST = OFF_RWT + 32 * 1024 * 4;
constexpr size_t OFF_BAR = OFF_HIST + 1024 * 32 * 4;
constexpr size_t WS_TOTAL = OFF_BAR + 16384;
static_assert(OFF_YS + (size_t)SLOTS * 1024 * 2 <= WS_END, "YS must fit in the dead region");
static_assert(OFF_H + (size_t)SLOTS * 256 * 2 <= OFF_ZS, "H must fit in the dead Z region");
static_assert(OFF_WD + (size_t)32 * 1024 * 256 * 2 <= OFF_Z, "expert weights must fit in R1");

struct Args { const float* in[34]; float* out; unsigned char* ws; int ph_lo, ph_hi; };
typedef const __attribute__((address_space(4))) Args& ArgsRef;

extern __shared__ __attribute__((aligned(16))) unsigned char smem[];

__device__ __forceinline__ bf16_t f2bf(float f) { unsigned u = __float_as_uint(f); u += 0x7FFFu + ((u >> 16) & 1u); return (bf16_t)(u >> 16); }
__device__ __forceinline__ float bf2f(bf16_t b) { return __uint_as_float(((unsigned)b) << 16); }
__device__ __forceinline__ unsigned pack2(float lo, float hi) { return (unsigned)f2bf(lo) | ((unsigned)f2bf(hi) << 16); }
__device__ __forceinline__ float fexp(float x) { return __builtin_amdgcn_exp2f(x * 1.4426950408889634f); }
__device__ __forceinline__ float flog(float x) { return __builtin_amdgcn_logf(x) * 0.6931471805599453f; }
__device__ __forceinline__ float sigmoidf_(float x) { return __builtin_amdgcn_rcpf(1.0f + fexp(-x)); }
__device__ __forceinline__ float siluf_(float x) { return x * __builtin_amdgcn_rcpf(1.0f + fexp(-x)); }
__device__ __forceinline__ float logsigmoidf_(float x) { return fminf(x, 0.f) - log1pf(expf(-fabsf(x))); }
__device__ __forceinline__ float gelu_tanh(float y) { const float z = 0.7978845608028654f * (y + 0.044715f * y * y * y); const float th = 1.0f - 2.0f * __builtin_amdgcn_rcpf(fexp(2.0f * z) + 1.0f); return 0.5f * y * (1.0f + th); }
__device__ __forceinline__ void wave_sync() { __builtin_amdgcn_wave_barrier(); asm volatile("s_waitcnt lgkmcnt(0)" ::: "memory"); __builtin_amdgcn_wave_barrier(); }

#define MFMA16(a, b, c) __builtin_amdgcn_mfma_f32_16x16x32_bf16((a), (b), (c), 0, 0, 0)

template <int MT, int NT, class FA, class FB>
__device__ __forceinline__ void wave_gemm(f32x4 (&acc)[MT][NT], int K, FA arow, FB brow, int lane) {
    const int r = lane & 15, q = lane >> 4;
    const bf16_t* ap[MT]; const bf16_t* bp[NT];
#pragma unroll
    for (int m = 0; m < MT; ++m) ap[m] = arow(m * 16 + r) + 8 * q;
#pragma unroll
    for (int n = 0; n < NT; ++n) bp[n] = brow(n * 16 + r) + 8 * q;
#pragma unroll 1
    for (int k = 0; k < K; k += 32) {
        bf16x8 a[MT], b[NT];
#pragma unroll
        for (int m = 0; m < MT; ++m) a[m] = *(const bf16x8*)(ap[m] + k);
#pragma unroll
        for (int n = 0; n < NT; ++n) b[n] = *(const bf16x8*)(bp[n] + k);
#pragma unroll
        for (int m = 0; m < MT; ++m)
#pragma unroll
            for (int n = 0; n < NT; ++n) acc[m][n] = MFMA16(a[m], b[n], acc[m][n]);
    }
}
template <int MT, int NT> __device__ __forceinline__ void zero_acc(f32x4 (&acc)[MT][NT]) {
#pragma unroll
    for (int m = 0; m < MT; ++m)
#pragma unroll
        for (int n = 0; n < NT; ++n) acc[m][n] = (f32x4){0.f, 0.f, 0.f, 0.f};
}

namespace pg8 {
#define PG8_LAS __attribute__((address_space(3)))
constexpr int BM = 256, BK = 64, HALF = 128, HTB = HALF * BK * 2, STAGE_BYTES = 8 * HTB;
__device__ __forceinline__ int lds_byte(int r, int c) { const int st = (r >> 4) * 2 + (c >> 5), rr = r & 15, cc = c & 31, ob = rr * 64 + cc * 2; return st * 1024 + (ob ^ (((ob >> 9) & 1) << 5)); }
__device__ __forceinline__ void stage_rc(int b, int& R, int& C) { const int st = b / 1024, sb = b % 1024, swz = sb ^ (((sb >> 9) & 1) << 5); R = (st >> 1) * 16 + swz / 64; C = (st & 1) * 32 + (swz % 64) / 2; }
__device__ __forceinline__ int perm32(int rho) { const int n = rho >> 4, i = rho & 15; return 8 * (i >> 2) + 4 * n + (i & 3); }
struct Unit { int pm, pn, tag; const char* A; const char* B; };
__device__ __forceinline__ unsigned cvt_pk_bf16(float lo, float hi) { unsigned r; asm volatile("v_cvt_pk_bf16_f32 %0, %1, %2" : "=v"(r) : "v"(lo), "v"(hi)); return r; }
__device__ __forceinline__ bool tile_order(int L, int nM, int nN, int& pm, int& pn) {
    const int nwg = nM * nN; if (L >= nwg) return false;
    int wgid = L; { const int q = nwg / 8, r = nwg % 8, xcd = wgid % 8, off = wgid / 8; wgid = (xcd < r ? xcd * (q + 1) : r * (q + 1) + (xcd - r) * q) + off; }
    const int nig = 8 * nN, gid = wgid / nig, fm = gid * 8, gsz = (nM - fm) < 8 ? (nM - fm) : 8;
    pm = fm + ((wgid % nig) % gsz); pn = (wgid % nig) / gsz; return true;
}
template <class Epi, class Sched>
__device__ __forceinline__ void gemm_phase(PG8_LAS unsigned char* lds, const int tid, const int K, const int lda, const int ldb, const Sched& S, const Epi& E) {
    const int wid = __builtin_amdgcn_readfirstlane(tid >> 6), lane = tid & 63, wr = wid >> 2, wc = wid & 3, fr = lane & 15, fq = lane >> 4;
    const int nt = K / BK;
    unsigned voffA[2], voffB[2];
#pragma unroll
    for (int i = 0; i < 2; ++i) { int R, C; stage_rc(tid * 16 + i * 8192, R, C); const int Rb = Epi::PERM ? ((R & ~31) + perm32(R & 31)) : R;
        voffA[i] = (unsigned)(R * lda + C) * 2u; voffB[i] = (unsigned)(Rb * ldb + C) * 2u; }
    const size_t kstep = (size_t)(BK * 2), hstepA = (size_t)HALF * lda * 2, hstepB = (size_t)HALF * ldb * 2;
    const unsigned ldsw = (unsigned)wid * 1024u;
    const int aoff = lds_byte(wr * 64 + fr, fq * 8), boff = lds_byte(wc * 32 + fr, fq * 8);
#define PG8_SA(b, h) (((b) * 2 + (h)) * HTB)
#define PG8_SB(b, h) ((4 + (b) * 2 + (h)) * HTB)
#define PG8_STAGE(bufoff, gbase, voff) do { _Pragma("unroll") for (int _i = 0; _i < 2; ++_i) \
        __builtin_amdgcn_global_load_lds((const unsigned*)((const char*)(gbase) + (voff)[_i]), (PG8_LAS unsigned*)(lds + (bufoff) + ldsw + _i * 8192), 16, 0, 0); } while (0)
#define PG8_LDA(dst, b, h) do { _Pragma("unroll") for (int m = 0; m < 4; ++m) _Pragma("unroll") for (int k = 0; k < 2; ++k) dst[m][k] = *(const PG8_LAS bf16x8*)(lds + PG8_SA(b, h) + aoff + m * 2048 + k * 1024); } while (0)
#define PG8_LDB(dst, b, h) do { _Pragma("unroll") for (int n = 0; n < 2; ++n) _Pragma("unroll") for (int k = 0; k < 2; ++k) dst[n][k] = *(const PG8_LAS bf16x8*)(lds + PG8_SB(b, h) + boff + n * 2048 + k * 1024); } while (0)
#define PG8_MMA(ai, bj, At, Bt) do { __builtin_amdgcn_s_setprio(1); _Pragma("unroll") for (int m = 0; m < 4; ++m) _Pragma("unroll") for (int n = 0; n < 2; ++n) _Pragma("unroll") for (int k = 0; k < 2; ++k) \
        acc[ai][bj][m][n] = __builtin_amdgcn_mfma_f32_16x16x32_bf16(Bt[n][k], At[m][k], acc[ai][bj][m][n], 0, 0, 0); __builtin_amdgcn_s_setprio(0); } while (0)
#define PG8_WAIT_V(n) asm volatile("s_waitcnt vmcnt(" #n ")" ::: "memory")
#define PG8_WAIT_L(n) asm volatile("s_waitcnt lgkmcnt(" #n ")" ::: "memory")
#define PG8_BAR __builtin_amdgcn_s_barrier()
#define PG8_SCHED __builtin_amdgcn_sched_barrier(0)
    Unit cur, nxt; int ui = 0;
    if (!S.next(0, cur)) return;
    f32x4 acc[2][2][4][2];
#pragma unroll
    for (int a = 0; a < 2; ++a)
#pragma unroll
        for (int b = 0; b < 2; ++b)
#pragma unroll
            for (int m = 0; m < 4; ++m)
#pragma unroll
                for (int n = 0; n < 2; ++n) acc[a][b][m][n] = (f32x4){0.f, 0.f, 0.f, 0.f};
    bf16x8 At[4][2], B0[2][2], B1[2][2];
    const char* cA = cur.A; const char* cB = cur.B;
    PG8_STAGE(PG8_SB(0, 0), cB, voffB); PG8_STAGE(PG8_SA(0, 0), cA, voffA); PG8_STAGE(PG8_SB(0, 1), cB + hstepB, voffB); PG8_STAGE(PG8_SA(0, 1), cA + hstepA, voffA);
    if (wr == 1) PG8_BAR;
    PG8_WAIT_V(4); PG8_BAR;
    PG8_STAGE(PG8_SB(1, 0), cB + kstep, voffB); PG8_STAGE(PG8_SA(1, 0), cA + kstep, voffA); PG8_STAGE(PG8_SB(1, 1), cB + hstepB + kstep, voffB);
    PG8_WAIT_V(6); PG8_BAR;
    for (;;) {
        const bool has_next = S.next(ui + 1, nxt);
        const char* nA = has_next ? nxt.A : cA; const char* nB = has_next ? nxt.B : cB;
        for (int t = 0; t < nt; t += 2) {
            const bool last = (t == nt - 2);
            const char* a1 = cA + (size_t)(t + 1) * kstep;
            const char* a2 = last ? nA : cA + (size_t)(t + 2) * kstep; const char* b2 = last ? nB : cB + (size_t)(t + 2) * kstep;
            const char* a3 = a2 + kstep; const char* b3 = b2 + kstep;
            PG8_LDB(B0, 0, 0); PG8_SCHED; PG8_LDA(At, 0, 0); PG8_STAGE(PG8_SA(1, 1), a1 + hstepA, voffA);
            PG8_WAIT_L(8); PG8_BAR; PG8_WAIT_L(0); PG8_MMA(0, 0, At, B0); PG8_BAR; PG8_SCHED;
            PG8_LDB(B1, 0, 1); PG8_STAGE(PG8_SB(0, 0), b2, voffB);
            PG8_BAR; PG8_WAIT_L(0); PG8_MMA(0, 1, At, B1); PG8_BAR;
            PG8_LDA(At, 0, 1); PG8_STAGE(PG8_SA(0, 0), a2, voffA);
            PG8_BAR; PG8_WAIT_L(0); PG8_MMA(1, 0, At, B0); PG8_BAR; PG8_SCHED;
            PG8_STAGE(PG8_SB(0, 1), b2 + hstepB, voffB);
            PG8_WAIT_V(6); PG8_BAR; PG8_MMA(1, 1, At, B1); PG8_BAR;
            PG8_LDB(B0, 1, 0); PG8_SCHED; PG8_LDA(At, 1, 0); PG8_STAGE(PG8_SA(0, 1), a2 + hstepA, voffA);
            PG8_WAIT_L(8); PG8_BAR; PG8_WAIT_L(0); PG8_MMA(0, 0, At, B0); PG8_BAR; PG8_SCHED;
            PG8_LDB(B1, 1, 1); PG8_STAGE(PG8_SB(1, 0), b3, voffB);
            PG8_BAR; PG8_WAIT_L(0); PG8_MMA(0, 1, At, B1); PG8_BAR;
            PG8_LDA(At, 1, 1); PG8_STAGE(PG8_SA(1, 0), a3, voffA);
            PG8_BAR; PG8_WAIT_L(0); PG8_MMA(1, 0, At, B0); PG8_BAR; PG8_SCHED;
            PG8_STAGE(PG8_SB(1, 1), b3 + hstepB, voffB);
            PG8_WAIT_V(6); PG8_BAR; PG8_MMA(1, 1, At, B1); PG8_BAR;
        }
        const bool keep = E(acc, cur, wr, wc, fr, fq);
        if (!has_next) break;
        if (!keep) {
#pragma unroll
            for (int a = 0; a < 2; ++a)
#pragma unroll
                for (int b = 0; b < 2; ++b)
#pragma unroll
                    for (int m = 0; m < 4; ++m)
#pragma unroll
                        for (int n = 0; n < 2; ++n) acc[a][b][m][n] = (f32x4){0.f, 0.f, 0.f, 0.f};
        }
        cur = nxt; cA = nA; cB = nB; ++ui;
    }
    PG8_WAIT_V(0);
    if (wr == 0) PG8_BAR;
    PG8_BAR;
#undef PG8_SA
#undef PG8_SB
#undef PG8_STAGE
#undef PG8_LDA
#undef PG8_LDB
#undef PG8_MMA
#undef PG8_WAIT_V
#undef PG8_WAIT_L
#undef PG8_BAR
#undef PG8_SCHED
}
}

__device__ __forceinline__ void tconv_tile(const float* src, int ld_src, int nvalid, bf16_t* dst, int ld_dst, int tid) {
    float* t = (float*)smem;
    { const int r = tid >> 3, c0 = (tid & 7) * 8; float v[8];
      if (nvalid == 64) { const f32x4 a0 = *(const f32x4*)(src + (size_t)r * ld_src + c0), a1 = *(const f32x4*)(src + (size_t)r * ld_src + c0 + 4);
          v[0] = a0[0]; v[1] = a0[1]; v[2] = a0[2]; v[3] = a0[3]; v[4] = a1[0]; v[5] = a1[1]; v[6] = a1[2]; v[7] = a1[3]; }
      else {
#pragma unroll
          for (int j = 0; j < 8; ++j) { const int c = c0 + j; v[j] = (c < nvalid) ? src[(size_t)r * ld_src + c] : 0.f; } }
#pragma unroll
      for (int j = 0; j < 8; ++j) t[(c0 + j) * 65 + r] = v[j]; }
    __syncthreads();
    { const int n = tid >> 3, k0 = (tid & 7) * 8; const float* p = t + n * 65 + k0;
      u32x4 w; w.x = pack2(p[0], p[1]); w.y = pack2(p[2], p[3]); w.z = pack2(p[4], p[5]); w.w = pack2(p[6], p[7]);
      *(u32x4*)(dst + (size_t)n * ld_dst + k0) = w; }
    __syncthreads();
}

__device__ __forceinline__ void phase_prep(ArgsRef a, int l, int tid, int bid, int G) {
    unsigned char* ws = a.ws;
    bf16_t* WIN = (bf16_t*)(ws + OFF_WIN); bf16_t* WQKV = (bf16_t*)(ws + OFF_WQKV); bf16_t* WGLU = (bf16_t*)(ws + OFF_WGLU);
    bf16_t* WB = (bf16_t*)(ws + OFF_WB); bf16_t* WOUT = (bf16_t*)(ws + OFF_WOUT);
    for (int u = bid; u < 2624; u += G) {
        const float* src; int lds_ = 0, nvalid = 64, ldd = 0; bf16_t* dst;
        if (u < 1728) { const int nt = u / 16, kt = u % 16, p0 = nt * 64; int sc;
            if (p0 < 1024) sc = p0; else if (p0 < 6656) sc = p0 + 8; else if (p0 == 6656) { sc = 1024; nvalid = 8; } else { sc = 0; nvalid = 0; }
            src = a.in[1] + (size_t)l * 1024 * INW + (size_t)(kt * 64) * INW + sc; lds_ = INW; dst = WIN + (size_t)p0 * 1024 + kt * 64; ldd = 1024; }
        else if (u < 1920) { const int v = u - 1728, nt = v / 8, kt = v % 8, which = nt / 8, h = (nt % 8) / 2;
            if ((kt >> 1) != h) nvalid = 0;
            src = a.in[4 + which] + (size_t)(l * 4 + h) * 128 * 128 + ((kt & 1) * 64) * 128 + (nt & 1) * 64; lds_ = 128; dst = WQKV + (size_t)(nt * 64) * 512 + kt * 64; ldd = 512; }
        else if (u < 1984) { const int v = u - 1920, nt = v / 8, kt = v % 8;
            src = a.in[18] + (size_t)l * 512 * 512 + (kt * 64) * 512 + nt * 64; lds_ = 512; dst = WGLU + (size_t)(nt * 64) * 512 + kt * 64; ldd = 512; }
        else if (u < 2368) { const int v = u - 1984, b = v / 128, w = v % 128, nt = w / 8, kt = w % 8;
            src = a.in[21 + b] + (size_t)l * 512 * 1024 + (size_t)(kt * 64) * 1024 + nt * 64; lds_ = 1024; dst = WB + (size_t)b * 1024 * 512 + (size_t)(nt * 64) * 512 + kt * 64; ldd = 512; }
        else { const int v = u - 2368, nt = v / 16, kt = v % 16;
            src = a.in[24] + (size_t)l * 1024 * 1024 + (size_t)(kt * 64) * 1024 + nt * 64; lds_ = 1024; dst = WOUT + (size_t)(nt * 64) * 1024 + kt * 64; ldd = 1024; }
        tconv_tile(src, lds_, nvalid, dst, ldd, tid);
    }
    float* ABAR = (float*)(ws + OFF_ABAR); bf16_t* BBT = (bf16_t*)(ws + OFF_BBT); bf16_t* CCT = (bf16_t*)(ws + OFF_CCT);
    for (int i = bid * 512 + tid; i < 2048; i += G * 512) {
        const int g = i / 64, p = i % 64; const size_t gp = (size_t)(l * 32 + g) * 64 + p;
        const float lr = fminf(a.in[10][gp], -1e-4f), li = a.in[11][gp], dt = expf(a.in[12][l * 32 + g]);
        const float mag = expf(lr * dt), abr = mag * cosf(li * dt), abi = mag * sinf(li * dt);
        const float nr = abr - 1.0f, den = lr * lr + li * li, cr = (nr * lr + abi * li) / den, ci = (abi * lr - nr * li) / den;
        ABAR[(g * 64 + p) * 2] = abr; ABAR[(g * 64 + p) * 2 + 1] = abi;
        for (int c = 0; c < 16; ++c) { const float br = a.in[13][gp * 16 + c], bi = a.in[14][gp * 16 + c];
            BBT[(size_t)(g * 128 + p) * 16 + c] = f2bf(cr * br - ci * bi); BBT[(size_t)(g * 128 + 64 + p) * 16 + c] = f2bf(cr * bi + ci * br);
            const size_t ci_ = ((size_t)(l * 32 + g) * 16 + c) * 64 + p;
            CCT[(size_t)(g * 16 + c) * 128 + p] = f2bf(a.in[15][ci_]); CCT[(size_t)(g * 16 + c) * 128 + 64 + p] = f2bf(-a.in[16][ci_]); }
    }
    if (l == 0) { float* RWT = (float*)(ws + OFF_RWT); const float* RW = a.in[29]; for (int i = bid * 512 + tid; i < 32 * 1024; i += G * 512) RWT[i] = RW[(i & 1023) * 32 + (i >> 10)]; }
    if (l == 0) { bf16_t* XB = (bf16_t*)(ws + OFF_XB); const float* x = a.in[0];
        for (size_t i = (size_t)bid * 512 + tid; i < (size_t)T * 1024 / 8; i += (size_t)G * 512) {
            const f32x4 v0 = *(const f32x4*)(x + i * 8), v1 = *(const f32x4*)(x + i * 8 + 4);
            u32x4 w; w.x = pack2(v0[0], v0[1]); w.y = pack2(v0[2], v0[3]); w.z = pack2(v1[0], v1[1]); w.w = pack2(v1[2], v1[3]); *(u32x4*)(XB + i * 8) = w; } }
}

__device__ __forceinline__ void phase_prepx(ArgsRef a, int l, int tid, int bid, int G, int u_lo, int u_hi) {
    bf16_t* WGU = (bf16_t*)(a.ws + OFF_WGU); bf16_t* WD = (bf16_t*)(a.ws + OFF_WD);
    for (int u = u_lo + bid; u < u_hi; u += G) {
        const float* src; int lds_, ldd; bf16_t* dst;
        if (u < 4096) { const int up = u >= 2048, v = u & 2047, e = v / 64, w = v % 64, nt = w / 16, kt = w % 16, j0 = nt * 64, drow = (j0 / 128) * 256 + (j0 % 128) + up * 128;
            src = a.in[31 + up] + ((size_t)(l * 32 + e) * 1024 + kt * 64) * 256 + nt * 64; lds_ = 256; dst = WGU + ((size_t)e * 512 + drow) * 1024 + kt * 64; ldd = 1024; }
        else { const int v = u - 4096, e = v / 64, w = v % 64, nt = w / 4, kt = w % 4;
            src = a.in[33] + ((size_t)(l * 32 + e) * 256 + kt * 64) * 1024 + nt * 64; lds_ = 1024; dst = WD + ((size_t)e * 1024 + nt * 64) * 256 + kt * 64; ldd = 256; }
        tconv_tile(src, lds_, 64, dst, ldd, tid);
    }
}

constexpr int GL_RQ = 0, GL_RK = 17408, GL_VT = 34816, GL_RO = 57856, GL_RX = 75264, GL_KT = 92672, GL_PS = 102912, GL_SC1 = 105472, GL_SC2 = 105984, GL_GT = 106496, GL_OS = 108544, GL_LFS = 117248, GL_DNS = 117504;
template <int MODE, int PASS>
__device__ __forceinline__ void gla_item(ArgsRef a, int l, int h, int sg, int tid, int lane, int wave) {
    unsigned char* ws = a.ws;
    const bf16_t* Z = (const bf16_t*)(ws + OFF_Z); const bf16_t* Qg = (const bf16_t*)(ws + OFF_Q); const bf16_t* Kg = (const bf16_t*)(ws + OFF_KH); const bf16_t* Vg = (const bf16_t*)(ws + OFF_V); const bf16_t* XCg = (const bf16_t*)(ws + OFF_XC);
    const float* LF = (const float*)(ws + OFF_LF);
    float* Eg = (float*)(ws + (MODE == 0 ? OFF_EM : OFF_EH)); float* Gg = (float*)(ws + (MODE == 0 ? OFF_GM : OFF_GH)); float* EX = (float*)(ws + OFF_EMX);
    bf16_t* Yg = (bf16_t*)(ws + (MODE == 0 ? OFF_OM : OFF_OH));
    bf16_t* KT = (bf16_t*)(smem + GL_KT); bf16_t* PS = (bf16_t*)(smem + GL_PS);
    float* SC1 = (float*)(smem + GL_SC1); float* SC2 = (float*)(smem + GL_SC2); float* GT = (float*)(smem + GL_GT); bf16_t* OS = (bf16_t*)(smem + GL_OS); float* DNS = (float*)(smem + GL_DNS);
    const int r = lane & 15, q = lane >> 4, grp = tid >> 7, d = tid & 127, tok = tid >> 4, c8 = (tid & 15) * 8;
    const bool xw = (MODE == 0) && (wave == 0);
    float lb = 0.f;
    if (MODE == 1 && l == 1) { const float h0 = a.in[19][h * 128 + d], h1 = a.in[19][512 + h * 128 + d]; lb = 1.0f / (1.0f + expf(h0 - h1)); }
    f32x4 S[8], SX[8];
#pragma unroll
    for (int i = 0; i < 8; ++i) { S[i] = (f32x4){0.f, 0.f, 0.f, 0.f}; SX[i] = (f32x4){0.f, 0.f, 0.f, 0.f}; }
    if (PASS == 2) {
#pragma unroll
        for (int i = 0; i < 8; ++i)
#pragma unroll
            for (int g = 0; g < 4; ++g) { const size_t row = (size_t)(sg * 4 + h) * 128 + 16 * i + 4 * q + g; S[i][g] = Eg[row * 128 + 16 * wave + r]; if (xw) SX[i][g] = EX[row * 16 + r]; }
    }
    const bf16x8 z8 = (bf16x8){0, 0, 0, 0, 0, 0, 0, 0};
    bf16x8 rq = z8, rk = z8, rv = z8, ro = z8, rx = z8; float lfv = 0.f;
#define GLA_FETCH(t0_) do { const size_t tk = (size_t)((t0_) + tok); \
        if (MODE == 1) { const bf16_t* zp = Z + tk * NZ + h * 128 + c8; if (PASS == 2) { rq = *(const bf16x8*)(zp + 1536); ro = *(const bf16x8*)(zp + 3072); } rk = *(const bf16x8*)(zp + 2048); rv = *(const bf16x8*)(zp + 2560); } \
        else { const size_t o_ = tk * 512 + h * 128 + c8; if (PASS == 2) { rq = *(const bf16x8*)(Qg + o_); ro = *(const bf16x8*)(Z + tk * NZ + 512 + h * 128 + c8); rx = *(const bf16x8*)(XCg + o_); } \
               rk = *(const bf16x8*)(Kg + o_); rv = *(const bf16x8*)(Vg + o_); if (tid < 32) lfv = LF[((t0_) + tid) * 4 + h]; } } while (0)
    GLA_FETCH(sg * GSEGLEN);
    float sk8[8], nw8[8];
#pragma unroll
    for (int j = 0; j < 8; ++j) { sk8[j] = (MODE == 0 && PASS == 2) ? a.in[9][l * 512 + h * 128 + c8 + j] : 0.f; nw8[j] = (MODE == 1 && PASS == 2) ? a.in[20][l * 512 + h * 128 + c8 + j] : 0.f; }
    __syncthreads();
    if (MODE == 0) { for (int i = tid; i < 2 * 16 * 40; i += 512) { const int b = i / 640, k = i % 640; ((bf16_t*)(smem + GL_VT + b * 11520))[128 * 40 + k] = (k < 32) ? (bf16_t)0x3F80 : (bf16_t)0; } }
#define GLA_STORE(tprev, pb) do { const bf16x8 o8 = *(const bf16x8*)(OS + tok * 136 + c8); const bf16x8 p8 = *(const bf16x8*)((const bf16_t*)(smem + GL_RO + (pb) * 8704) + tok * 136 + c8); float y[8]; \
        if (MODE == 0) { const bf16x8 x8 = *(const bf16x8*)((const bf16_t*)(smem + GL_RX + (pb) * 8704) + tok * 136 + c8); const float di = __builtin_amdgcn_rcpf(fmaxf(fabsf(DNS[tok]), 1.0f)); \
            _Pragma("unroll") for (int j = 0; j < 8; ++j) y[j] = sigmoidf_(bf2f((bf16_t)p8[j])) * (bf2f((bf16_t)o8[j]) * di) + sk8[j] * bf2f((bf16_t)x8[j]); } \
        else { float ov[8], ss = 0.f; _Pragma("unroll") for (int j = 0; j < 8; ++j) { ov[j] = bf2f((bf16_t)o8[j]); ss += ov[j] * ov[j]; } \
            ss += __shfl_xor(ss, 1); ss += __shfl_xor(ss, 2); ss += __shfl_xor(ss, 4); ss += __shfl_xor(ss, 8); const float rinv = rsqrtf(ss * (1.0f / 128.0f) + 1e-6f); \
            _Pragma("unroll") for (int j = 0; j < 8; ++j) y[j] = ov[j] * rinv * nw8[j] * siluf_(bf2f((bf16_t)p8[j])); } \
        u32x4 w_; w_.x = pack2(y[0], y[1]); w_.y = pack2(y[2], y[3]); w_.z = pack2(y[4], y[5]); w_.w = pack2(y[6], y[7]); *(u32x4*)(Yg + (size_t)((tprev) + tok) * 512 + h * 128 + c8) = w_; } while (0)
    float runb = 0.f;
    for (int ci = 0; ci < GSEGLEN / 32; ++ci) {
        const int t0 = sg * GSEGLEN + ci * 32, buf = ci & 1;
        bf16_t* RQ = (bf16_t*)(smem + GL_RQ + buf * 8704); bf16_t* RK = (bf16_t*)(smem + GL_RK + buf * 8704); bf16_t* VT = (bf16_t*)(smem + GL_VT + buf * 11520);
        float* LFS = (float*)(smem + GL_LFS + buf * 128);
        if (PASS == 2) { *(bf16x8*)(RQ + tok * 136 + c8) = rq; *(bf16x8*)((bf16_t*)(smem + GL_RO + buf * 8704) + tok * 136 + c8) = ro; if (MODE == 0) *(bf16x8*)((bf16_t*)(smem + GL_RX + buf * 8704) + tok * 136 + c8) = rx; }
        *(bf16x8*)(RK + tok * 136 + c8) = rk;
#pragma unroll
        for (int j = 0; j < 8; ++j) VT[(c8 + j) * 40 + tok] = (bf16_t)rv[j];
        if (MODE == 0 && tid < 32) LFS[tid] = lfv;
        if (ci + 1 < GSEGLEN / 32) GLA_FETCH(t0 + 32);
        __syncthreads();
        float lg[8], kv[8];
#pragma unroll
        for (int j = 0; j < 8; ++j) { const float kr = bf2f(RK[(grp * 8 + j) * 136 + d]);
            if (MODE == 1) { const float f = lb + (1.0f - lb) * sigmoidf_(kr); lg[j] = flog(f); kv[j] = 1.0f - f; } else { lg[j] = LFS[grp * 8 + j]; kv[j] = kr; } }
        float cs[8]; cs[0] = lg[0];
#pragma unroll
        for (int j = 1; j < 8; ++j) cs[j] = cs[j - 1] + lg[j];
        GT[grp * 128 + d] = cs[7];
        __syncthreads();
        if (PASS == 2 && ci > 0) GLA_STORE(t0 - 32, buf ^ 1);
        const float g0 = GT[d], g1 = GT[128 + d], g2 = GT[256 + d], g3 = GT[384 + d];
        const float off = grp == 0 ? 0.f : grp == 1 ? g0 : grp == 2 ? g0 + g1 : g0 + g1 + g2;
        const float bmid = g0 + g1, bL = bmid + g2 + g3;
        bf16_t ktv[8];
#pragma unroll
        for (int j = 0; j < 8; ++j) { const float bt = off + cs[j], ek = fexp(bmid - bt); const bf16_t kt = f2bf(kv[j] * ek); ktv[j] = kt;
            if (PASS == 2) { const float qr = bf2f(RQ[(grp * 8 + j) * 136 + d]); const float qq = (MODE == 1) ? siluf_(qr) : qr; RQ[(grp * 8 + j) * 136 + d] = f2bf(qq * __builtin_amdgcn_rcpf(ek)); RK[(grp * 8 + j) * 136 + d] = kt; } }
        { u32x4 w; w.x = ktv[0] | ((unsigned)ktv[1] << 16); w.y = ktv[2] | ((unsigned)ktv[3] << 16); w.z = ktv[4] | ((unsigned)ktv[5] << 16); w.w = ktv[6] | ((unsigned)ktv[7] << 16); *(u32x4*)(KT + d * 40 + grp * 8) = w; }
        if (grp == 0) { SC1[d] = fexp(bmid); SC2[d] = fexp(bL - bmid); runb += bL; }
        __syncthreads();
        if (PASS == 2) {
            if (wave < 4) {
                const int ti = (wave == 1 || wave == 2) ? 1 : 0, tj = (wave >= 2) ? 1 : 0;
                f32x4 p = (f32x4){0.f, 0.f, 0.f, 0.f};
                if (wave < 3) {
#pragma unroll
                    for (int kk = 0; kk < 4; ++kk) { const bf16x8 av = *(const bf16x8*)(RQ + (16 * ti + r) * 136 + 32 * kk + 8 * q); const bf16x8 bv = *(const bf16x8*)(RK + (16 * tj + r) * 136 + 32 * kk + 8 * q); p = MFMA16(av, bv, p); }
                }
#pragma unroll
                for (int g = 0; g < 4; ++g) { const int t = 16 * ti + 4 * q + g, s_ = 16 * tj + r; PS[t * 40 + s_] = (wave < 3 && s_ <= t) ? f2bf(p[g]) : (bf16_t)0; }
            }
            __syncthreads();
        }
        const bf16x8 bV = *(const bf16x8*)(VT + (16 * wave + r) * 40 + 8 * q);
        bf16x8 bV1 = bV; if (xw) bV1 = *(const bf16x8*)(VT + (128 + r) * 40 + 8 * q);
        f32x4 o[2], ox[2];
        o[0] = o[1] = ox[0] = ox[1] = (f32x4){0.f, 0.f, 0.f, 0.f};
#pragma unroll
        for (int kk = 0; kk < 4; ++kk) {
            const f32x4 sa = *(const f32x4*)(SC1 + 32 * kk + 4 * q), sb = *(const f32x4*)(SC1 + 32 * kk + 16 + 4 * q);
            S[2 * kk] *= sa; S[2 * kk + 1] *= sb;
            if (xw) { SX[2 * kk] *= sa; SX[2 * kk + 1] *= sb; }
            if (PASS == 2) {
                bf16x8 bS, bX;
#pragma unroll
                for (int g = 0; g < 4; ++g) { bS[g] = (short)f2bf(S[2 * kk][g]); bS[4 + g] = (short)f2bf(S[2 * kk + 1][g]); bX[g] = (short)f2bf(SX[2 * kk][g]); bX[4 + g] = (short)f2bf(SX[2 * kk + 1][g]); }
#pragma unroll
                for (int mt = 0; mt < 2; ++mt) { const bf16x4 lo = *(const bf16x4*)(RQ + (16 * mt + r) * 136 + 32 * kk + 4 * q), hi = *(const bf16x4*)(RQ + (16 * mt + r) * 136 + 32 * kk + 16 + 4 * q);
                    bf16x8 av; av[0] = lo[0]; av[1] = lo[1]; av[2] = lo[2]; av[3] = lo[3]; av[4] = hi[0]; av[5] = hi[1]; av[6] = hi[2]; av[7] = hi[3];
                    o[mt] = MFMA16(av, bS, o[mt]); if (xw) ox[mt] = MFMA16(av, bX, ox[mt]); }
            }
        }
        if (PASS == 2) {
#pragma unroll
            for (int mt = 0; mt < 2; ++mt) { const bf16x8 av = *(const bf16x8*)(PS + (16 * mt + r) * 40 + 8 * q); o[mt] = MFMA16(av, bV, o[mt]); if (xw) ox[mt] = MFMA16(av, bV1, ox[mt]);
#pragma unroll
                for (int g = 0; g < 4; ++g) { OS[(16 * mt + 4 * q + g) * 136 + 16 * wave + r] = f2bf(o[mt][g]); if (xw && r == 0) DNS[16 * mt + 4 * q + g] = ox[mt][g]; } }
        }
#pragma unroll
        for (int i = 0; i < 8; ++i) { const bf16x8 av = *(const bf16x8*)(KT + (16 * i + r) * 40 + 8 * q); const f32x4 s2 = *(const f32x4*)(SC2 + 16 * i + 4 * q);
            S[i] = MFMA16(av, bV, S[i]); S[i] *= s2;
            if (xw) { SX[i] = MFMA16(av, bV1, SX[i]); SX[i] *= s2; } }
    }
    if (PASS == 2) { __syncthreads(); GLA_STORE(sg * GSEGLEN + GSEGLEN - 32, 1); }
    if (PASS == 1) {
        float* ST = (float*)smem;
        __syncthreads();
#pragma unroll
        for (int i = 0; i < 8; ++i)
#pragma unroll
            for (int g = 0; g < 4; ++g) { ST[(16 * i + 4 * q + g) * 132 + 16 * wave + r] = S[i][g]; if (xw) EX[((size_t)(sg * 4 + h) * 128 + 16 * i + 4 * q + g) * 16 + r] = SX[i][g]; }
        __syncthreads();
#pragma unroll
        for (int k = 0; k < 8; ++k) { const int idx = tid + 512 * k, row = idx >> 5, c4 = (idx & 31) * 4; *(f32x4*)(Eg + ((size_t)(sg * 4 + h) * 128 + row) * 128 + c4) = *(const f32x4*)(ST + row * 132 + c4); }
        if (grp == 0) Gg[(size_t)(sg * 4 + h) * 128 + d] = expf(runb);
    }
#undef GLA_FETCH
#undef GLA_STORE
}

template <int PASS>
__device__ __forceinline__ void s5_item(ArgsRef a, int l, int g, int sg, int g0, int tid, int lane, int wave, int hsel) {
    unsigned char* ws = a.ws;
    const bf16_t* Z = (const bf16_t*)(ws + OFF_Z); const float* ABAR = (const float*)(ws + OFF_ABAR); const bf16_t* BBT = (const bf16_t*)(ws + OFF_BBT); const bf16_t* CCT = (const bf16_t*)(ws + OFF_CCT);
    float* ES = (float*)(ws + OFF_ES); bf16_t* YPRE = (bf16_t*)(ws + OFF_YPRE);
    float* BU = (float*)(smem + 70000 + (wave & 3) * 12800); bf16_t* X = (bf16_t*)(smem + 70000 + (wave & 3) * 12800 + 8448); bf16_t* YT = (bf16_t*)(smem + 70000 + 51200);
    const int r = lane & 15, q = lane >> 4, p = lane; const bool act = (wave >> 2) == hsel;
    const float ar = ABAR[(g * 64 + p) * 2], ai = ABAR[(g * 64 + p) * 2 + 1];
    const bf16x8 zero8 = (bf16x8){0, 0, 0, 0, 0, 0, 0, 0};
    bf16x8 bB[8], cB[4];
#pragma unroll
    for (int nt = 0; nt < 8; ++nt) bB[nt] = (q < 2) ? *(const bf16x8*)(BBT + (size_t)(g * 128 + 16 * nt + r) * 16 + 8 * q) : zero8;
#pragma unroll
    for (int kk = 0; kk < 4; ++kk) cB[kk] = (PASS == 2) ? *(const bf16x8*)(CCT + (size_t)(g * 16 + r) * 128 + 32 * kk + 8 * q) : zero8;
    float xr = 0.f, xi = 0.f;
    if (PASS == 2) { xr = ES[((size_t)(sg * 32 + g) * 64 + p) * 2]; xi = ES[((size_t)(sg * 32 + g) * 64 + p) * 2 + 1]; }
    const float dsk = a.in[17][l * 512 + 16 * g + r];
    for (int ci = 0; ci < SSEGLEN / 16; ++ci) {
        const int t0 = sg * SSEGLEN + ci * 16;
        if (act) {
            const bf16x8 av = (q < 2) ? *(const bf16x8*)(Z + (size_t)(t0 + r) * NZ + 1024 + 16 * g + 8 * q) : zero8;
#pragma unroll
            for (int nt = 0; nt < 8; ++nt) { f32x4 acc = (f32x4){0.f, 0.f, 0.f, 0.f}; acc = MFMA16(av, bB[nt], acc);
#pragma unroll
                for (int gg = 0; gg < 4; ++gg) BU[(4 * q + gg) * 132 + 16 * nt + r] = acc[gg]; }
            wave_sync();
#pragma unroll
            for (int t = 0; t < 16; ++t) { const float br = BU[t * 132 + p], bi = BU[t * 132 + 64 + p];
                const float nr = ar * xr - ai * xi + br, ni = ar * xi + ai * xr + bi; xr = nr; xi = ni;
                if (PASS == 2) { X[t * 136 + p] = f2bf(xr); X[t * 136 + 64 + p] = f2bf(xi); } }
            wave_sync();
            if (PASS == 2) {
                f32x4 acc = (f32x4){0.f, 0.f, 0.f, 0.f};
#pragma unroll
                for (int kk = 0; kk < 4; ++kk) { const bf16x8 xv = *(const bf16x8*)(X + r * 136 + 32 * kk + 8 * q); acc = MFMA16(xv, cB[kk], acc); }
#pragma unroll
                for (int gg = 0; gg < 4; ++gg) { const int t = t0 + 4 * q + gg, c = 16 * g + r; const float u = bf2f(Z[(size_t)t * NZ + 1024 + c]);
                    YT[(4 * q + gg) * 136 + 16 * wave + r] = f2bf(gelu_tanh(acc[gg] + dsk * u)); }
            }
        }
        if (PASS == 2) {
            __syncthreads();
            if (tid < 128) { const int row = tid >> 3, c8 = (tid & 7) * 8; *(u32x4*)(YPRE + (size_t)(t0 + row) * 512 + 16 * g0 + 64 * hsel + c8) = *(const u32x4*)(YT + row * 136 + 64 * hsel + c8); }
            __syncthreads();
        }
    }
    if (PASS == 1 && act) { ES[((size_t)(sg * 32 + g) * 64 + p) * 2] = xr; ES[((size_t)(sg * 32 + g) * 64 + p) * 2 + 1] = xi; }
}

__device__ __forceinline__ void phase_scan(ArgsRef a, int tid, int bid, int G) {
    unsigned char* ws = a.ws;
    const int NT = G * 512, gt = bid * 512 + tid;
    for (int i = gt; i < 2 * 65536 + 8192 + 2048; i += NT) {
        if (i < 2 * 65536 + 8192) { const bool nx = i >= 2 * 65536; const int m = i >> 16, el = nx ? i - 2 * 65536 : (i & 65535), hrow = nx ? (el >> 4) : (el >> 7); const size_t str = nx ? 8192 : 65536;
            float* E = (float*)(ws + (nx ? OFF_EMX : (m == 0 ? OFF_EM : OFF_EH))); const float* Gd = (const float*)(ws + ((nx || m == 0) ? OFF_GM : OFF_GH));
            float ev[GSEG], gv[GSEG];
#pragma unroll
            for (int sg = 0; sg < GSEG; ++sg) { ev[sg] = E[(size_t)sg * str + el]; gv[sg] = Gd[sg * 512 + hrow]; }
            float cur = 0.f;
#pragma unroll
            for (int sg = 0; sg < GSEG; ++sg) { E[(size_t)sg * str + el] = cur; cur = gv[sg] * cur + ev[sg]; } }
        else { const int el = i - 2 * 65536 - 8192; float* E = (float*)(ws + OFF_ES); const float* ABAR = (const float*)(ws + OFF_ABAR);
            float pr = ABAR[el * 2], pi = ABAR[el * 2 + 1];
#pragma unroll
            for (int k = 0; k < 8; ++k) { const float nr = pr * pr - pi * pi, ni = 2.0f * pr * pi; pr = nr; pi = ni; }
            float xr = 0.f, xi = 0.f;
            for (int sb = 0; sb < SSEG; sb += 16) { float er[16], ei[16];
#pragma unroll
                for (int k = 0; k < 16; ++k) { er[k] = E[((size_t)(sb + k) * 2048 + el) * 2]; ei[k] = E[((size_t)(sb + k) * 2048 + el) * 2 + 1]; }
#pragma unroll
                for (int k = 0; k < 16; ++k) { E[((size_t)(sb + k) * 2048 + el) * 2] = xr; E[((size_t)(sb + k) * 2048 + el) * 2 + 1] = xi;
                    const float nr = pr * xr - pi * xi + er[k], ni = pr * xi + pi * xr + ei[k]; xr = nr; xi = ni; } } }
    }
}

template <int PASS>
__device__ __forceinline__ void phase_mixers(ArgsRef a, int l, int tid, int lane, int wave, int bid, int G) {
    for (int it = bid; it < 4 * GSEG; it += G) gla_item<0, PASS>(a, l, it % 4, it / 4, tid, lane, wave);
    asm volatile("" ::: "memory");
    for (int it = bid + ((4 * GSEG - bid % G) % G + G) % G * 0; it < 2 * 4 * GSEG; it += G) { if (it >= 4 * GSEG) gla_item<1, PASS>(a, l, (it - 4 * GSEG) % 4, (it - 4 * GSEG) / 4, tid, lane, wave); }
    __syncthreads();
    for (int it0 = bid * 8; it0 < 32 * SSEG; it0 += G * 8)
        for (int half = 0; half < 2; ++half) { const int it = it0 + wave; s5_item<PASS>(a, l, it % 32, it / 32, it0 % 32, tid, lane, wave, half); __syncthreads(); }
}

__device__ __forceinline__ void phase_post(ArgsRef a, int l, int lane, int gw, int GW) {
    const bf16_t* Z = (const bf16_t*)(a.ws + OFF_Z); const bf16_t* XC = (const bf16_t*)(a.ws + OFF_XC);
    bf16_t* OM = (bf16_t*)(a.ws + OFF_OM); bf16_t* OH = (bf16_t*)(a.ws + OFF_OH); const float* DEN = (const float*)(a.ws + OFF_DEN);
    const int c0 = lane * 8, hd = lane >> 4;
    float skp[8], nw[8];
#pragma unroll
    for (int j = 0; j < 8; ++j) { skp[j] = a.in[9][l * 512 + c0 + j]; nw[j] = a.in[20][l * 512 + c0 + j]; }
    for (int tb = gw * 4; tb < T; tb += GW * 4) {
        bf16x8 om[4], op[4], xc[4], oh[4], gp[4]; float dn[4];
#pragma unroll
        for (int k = 0; k < 4; ++k) { const size_t t = tb + k; om[k] = *(const bf16x8*)(OM + t * 512 + c0); op[k] = *(const bf16x8*)(Z + t * NZ + 512 + c0); xc[k] = *(const bf16x8*)(XC + t * 512 + c0);
            oh[k] = *(const bf16x8*)(OH + t * 512 + c0); gp[k] = *(const bf16x8*)(Z + t * NZ + 3072 + c0); dn[k] = DEN[hd * T + t]; }
#pragma unroll
        for (int k = 0; k < 4; ++k) { const size_t t = tb + k; const float di = __builtin_amdgcn_rcpf(fmaxf(fabsf(dn[k]), 1.0f)); float y[8], ov[8], ss = 0.f;
#pragma unroll
            for (int j = 0; j < 8; ++j) { y[j] = sigmoidf_(bf2f((bf16_t)op[k][j])) * (bf2f((bf16_t)om[k][j]) * di) + skp[j] * bf2f((bf16_t)xc[k][j]); ov[j] = bf2f((bf16_t)oh[k][j]); ss += ov[j] * ov[j]; }
            u32x4 w; w.x = pack2(y[0], y[1]); w.y = pack2(y[2], y[3]); w.z = pack2(y[4], y[5]); w.w = pack2(y[6], y[7]); *(u32x4*)(OM + t * 512 + c0) = w;
            ss += __shfl_xor(ss, 1); ss += __shfl_xor(ss, 2); ss += __shfl_xor(ss, 4); ss += __shfl_xor(ss, 8);
            const float rinv = rsqrtf(ss * (1.0f / 128.0f) + 1e-6f);
#pragma unroll
            for (int j = 0; j < 8; ++j) y[j] = ov[j] * rinv * nw[j] * siluf_(bf2f((bf16_t)gp[k][j]));
            u32x4 x; x.x = pack2(y[0], y[1]); x.y = pack2(y[2], y[3]); x.z = pack2(y[4], y[5]); x.w = pack2(y[6], y[7]); *(u32x4*)(OH + t * 512 + c0) = x; }
    }
}

__device__ __forceinline__ void ln_row(f32x4 (&v)[4], const float* gam, const float* bet, int lane) {
    float s = 0.f;
#pragma unroll
    for (int j = 0; j < 4; ++j) s += (v[j][0] + v[j][1]) + (v[j][2] + v[j][3]);
#pragma unroll
    for (int o = 32; o >= 1; o >>= 1) s += __shfl_xor(s, o);
    const float mean = s * (1.0f / 1024.0f); float qv = 0.f;
#pragma unroll
    for (int j = 0; j < 4; ++j) { const f32x4 dd = v[j] - mean; qv += (dd[0] * dd[0] + dd[1] * dd[1]) + (dd[2] * dd[2] + dd[3] * dd[3]); }
#pragma unroll
    for (int o = 32; o >= 1; o >>= 1) qv += __shfl_xor(qv, o);
    const float rstd = rsqrtf(qv * (1.0f / 1024.0f) + 1e-5f);
#pragma unroll
    for (int j = 0; j < 4; ++j) { const f32x4 gg = *(const f32x4*)(gam + 256 * j + 4 * lane), bb = *(const f32x4*)(bet + 256 * j + 4 * lane); v[j] = (v[j] - mean) * rstd * gg + bb; }
}

__device__ __forceinline__ void phase_ln1r(ArgsRef a, int l, int tid, int lane, int wave, int bid, int G) {
    float* XF = a.out; bf16_t* XB = (bf16_t*)(a.ws + OFF_XB);
    int* TOKE = (int*)(a.ws + OFF_TOKE); float* TOKG = (float*)(a.ws + OFF_TOKG); unsigned* HIST = (unsigned*)(a.ws + OFF_HIST);
    const float* RWT = (const float*)(a.ws + OFF_RWT); const float* RB = a.in[30];
    float* LG = (float*)(smem + wave * 4096);
    int* TE = (int*)(smem + wave * 4096 + 2304); float* TG = (float*)(smem + wave * 4096 + 2432); unsigned* HS = (unsigned*)(smem + wave * 4096 + 2560);
    const int r = lane & 15, q = lane >> 4, rs = lane >> 5, e = lane & 31;
    for (int tw = bid + G * wave; tw < T / 16; tw += G * 8) {
        const int t0 = tw * 16;
        for (int rb = 0; rb < 16; rb += 4) { f32x4 v[4][4];
#pragma unroll
            for (int k = 0; k < 4; ++k)
#pragma unroll
                for (int j = 0; j < 4; ++j) v[k][j] = *(const f32x4*)(XF + (size_t)(t0 + rb + k) * 1024 + 256 * j + 4 * lane);
#pragma unroll
            for (int k = 0; k < 4; ++k) { const int t = t0 + rb + k; ln_row(v[k], a.in[25] + l * 1024, a.in[26] + l * 1024, lane);
#pragma unroll
                for (int j = 0; j < 4; ++j) { *(f32x4*)(XF + (size_t)t * 1024 + 256 * j + 4 * lane) = v[k][j];
                    u32x2 w; w.x = pack2(v[k][j][0], v[k][j][1]); w.y = pack2(v[k][j][2], v[k][j][3]); *(u32x2*)(XB + (size_t)t * 1024 + 256 * j + 4 * lane) = w; } } }
        if (lane < 32) HS[lane] = 0u;
        asm volatile("s_waitcnt vmcnt(0) lgkmcnt(0)" ::: "memory"); __builtin_amdgcn_wave_barrier();
        f32x4 acc0 = (f32x4){0.f, 0.f, 0.f, 0.f}, acc1 = acc0;
        const float* xa = XF + (size_t)(t0 + r) * 1024 + 4 * q; const float* w0 = RWT + (size_t)r * 1024 + 4 * q; const float* w1 = RWT + (size_t)(16 + r) * 1024 + 4 * q;
#pragma unroll 8
        for (int s = 0; s < 64; ++s) { const f32x4 av = *(const f32x4*)(xa + 16 * s), b0 = *(const f32x4*)(w0 + 16 * s), b1 = *(const f32x4*)(w1 + 16 * s);
#pragma unroll
            for (int j = 0; j < 4; ++j) { acc0 = __builtin_amdgcn_mfma_f32_16x16x4f32(av[j], b0[j], acc0, 0, 0, 0); acc1 = __builtin_amdgcn_mfma_f32_16x16x4f32(av[j], b1[j], acc1, 0, 0, 0); } }
#pragma unroll
        for (int g = 0; g < 4; ++g) { LG[(4 * q + g) * 33 + r] = acc0[g]; LG[(4 * q + g) * 33 + 16 + r] = acc1[g]; }
        wave_sync();
        for (int pp = 0; pp < 8; ++pp) {
            const float lg = LG[(2 * pp + rs) * 33 + e];
            const float s = sigmoidf_(lg), sb = s + RB[e];
            float v4[4];
#pragma unroll
            for (int i = 0; i < 4; ++i) v4[i] = __shfl(sb, (lane & ~3) + i);
            int i1 = 0;
#pragma unroll
            for (int i = 1; i < 4; ++i) if (v4[i] > v4[i1]) i1 = i;
            int i2 = (i1 == 0) ? 1 : 0;
#pragma unroll
            for (int i = 0; i < 4; ++i) if (i != i1 && i != i2 && v4[i] > v4[i2]) i2 = i;
            float gs = v4[i1] + v4[i2]; int gid = e >> 2;
#pragma unroll
            for (int o = 4; o <= 16; o <<= 1) { const float os = __shfl_xor(gs, o); const int og = __shfl_xor(gid, o); if (os > gs || (os == gs && og < gid)) { gs = os; gid = og; } }
            float sv[4], sbv[4];
#pragma unroll
            for (int i = 0; i < 4; ++i) { sbv[i] = __shfl(sb, (lane & 32) + gid * 4 + i); sv[i] = __shfl(s, (lane & 32) + gid * 4 + i); }
            int j1 = 0;
#pragma unroll
            for (int i = 1; i < 4; ++i) if (sbv[i] > sbv[j1]) j1 = i;
            int j2 = (j1 == 0) ? 1 : 0;
#pragma unroll
            for (int i = 0; i < 4; ++i) if (i != j1 && i != j2 && sbv[i] > sbv[j2]) j2 = i;
            float s1 = sv[0], s2 = sv[0];
#pragma unroll
            for (int i = 1; i < 4; ++i) { if (i == j1) s1 = sv[i]; if (i == j2) s2 = sv[i]; }
            if (e == 0) { const int ti = 2 * pp + rs; const float inv = 1.0f / (s1 + s2);
                TE[ti * 2] = gid * 4 + j1; TE[ti * 2 + 1] = gid * 4 + j2; TG[ti * 2] = s1 * inv; TG[ti * 2 + 1] = s2 * inv;
                atomicAdd(&HS[gid * 4 + j1], 1u); atomicAdd(&HS[gid * 4 + j2], 1u); }
        }
        wave_sync();
        if (lane < 32) { TOKE[t0 * 2 + lane] = TE[lane]; TOKG[t0 * 2 + lane] = TG[lane]; HIST[tw * 32 + lane] = HS[lane]; }
        wave_sync();
    }
    __syncthreads();
}

__device__ __forceinline__ void phase_slot(ArgsRef a, int tid, int lane, int wave, int bid, int G) {
    const int* TOKE = (const int*)(a.ws + OFF_TOKE); int* TOKS = (int*)(a.ws + OFF_TOKS); const unsigned* HIST = (const unsigned*)(a.ws + OFF_HIST);
    unsigned* BASE = (unsigned*)(a.ws + OFF_CTL) + 64;
    const bf16_t* XB = (const bf16_t*)(a.ws + OFF_XB); bf16_t* XG = (bf16_t*)(a.ws + OFF_XG);
    unsigned* base = (unsigned*)smem; unsigned* pre = base + 40; int* el = (int*)(base + 80); int* sl = (int*)(base + 208); unsigned* red = base + 336;
    const int e = tid & 31, part = tid >> 5;
    for (int c = bid; c < T / 64; c += G) {
        unsigned tot = 0u, pr = 0u;
#pragma unroll 16
        for (int it = part; it < 1024; it += 16) { const unsigned v = HIST[it * 32 + e]; tot += v; pr += (it < 4 * c) ? v : 0u; }
        red[part * 32 + e] = tot; red[512 + part * 32 + e] = pr;
        __syncthreads();
        if (tid < 32) { unsigned t2 = 0u, p2 = 0u; for (int k = 0; k < 16; ++k) { t2 += red[k * 32 + tid]; p2 += red[512 + k * 32 + tid]; } pre[tid] = p2; red[tid] = (t2 + 255u) & ~255u; }
        __syncthreads();
        if (tid == 0) { unsigned sacc = 0; for (int k = 0; k < 32; ++k) { base[k] = sacc; sacc += red[k]; } base[32] = sacc; }
        int ee = 0;
        if (tid < 128) { ee = TOKE[c * 128 + tid]; el[tid] = ee; }
        __syncthreads();
        if (c == 0 && tid < 33) BASE[tid] = base[tid];
        if (tid < 128) { unsigned rank = 0; for (int i = 0; i < tid; ++i) rank += (el[i] == ee) ? 1u : 0u;
            const unsigned sidx = base[ee] + pre[ee] + rank; sl[tid] = (int)sidx; TOKS[c * 128 + tid] = (int)sidx; }
        __syncthreads();
        for (int ib = 0; ib < 16; ib += 8) { u32x4 ra[8], rb[8];
#pragma unroll
            for (int k = 0; k < 8; ++k) { const int i = wave + 8 * (ib + k), t = c * 64 + (i >> 1); ra[k] = *(const u32x4*)(XB + (size_t)t * 1024 + lane * 8); rb[k] = *(const u32x4*)(XB + (size_t)t * 1024 + 512 + lane * 8); }
#pragma unroll
            for (int k = 0; k < 8; ++k) { const int i = wave + 8 * (ib + k); const size_t so = (size_t)sl[i] * 1024; *(u32x4*)(XG + so + lane * 8) = ra[k]; *(u32x4*)(XG + so + 512 + lane * 8) = rb[k]; } }
        __syncthreads();
    }
}

__device__ __forceinline__ void phase_ln2(ArgsRef a, int l, int lane, int gw, int GW) {
    float* XF = a.out; bf16_t* XB = (bf16_t*)(a.ws + OFF_XB); const bf16_t* YS = (const bf16_t*)(a.ws + OFF_YS);
    const int* TOKS = (const int*)(a.ws + OFF_TOKS); const float* TOKG = (const float*)(a.ws + OFF_TOKG);
    for (int tb = gw * 4; tb < T; tb += GW * 4) {
        int sv = 0; float gv = 0.f; if (lane < 8) { sv = TOKS[tb * 2 + lane]; gv = TOKG[tb * 2 + lane]; }
        f32x4 v[4][4]; bf16x4 y0[4][4], y1[4][4]; float g0[4], g1[4];
#pragma unroll
        for (int k = 0; k < 4; ++k) { const int s0 = __shfl(sv, 2 * k), s1 = __shfl(sv, 2 * k + 1); g0[k] = __shfl(gv, 2 * k); g1[k] = __shfl(gv, 2 * k + 1);
#pragma unroll
            for (int j = 0; j < 4; ++j) { v[k][j] = *(const f32x4*)(XF + (size_t)(tb + k) * 1024 + 256 * j + 4 * lane);
                y0[k][j] = *(const bf16x4*)(YS + (size_t)s0 * 1024 + 256 * j + 4 * lane); y1[k][j] = *(const bf16x4*)(YS + (size_t)s1 * 1024 + 256 * j + 4 * lane); } }
#pragma unroll
        for (int k = 0; k < 4; ++k) {
#pragma unroll
            for (int j = 0; j < 4; ++j)
#pragma unroll
                for (int g = 0; g < 4; ++g) v[k][j][g] = DN_ALPHA * v[k][j][g] + g0[k] * bf2f((bf16_t)y0[k][j][g]) + g1[k] * bf2f((bf16_t)y1[k][j][g]);
            ln_row(v[k], a.in[27] + l * 1024, a.in[28] + l * 1024, lane);
#pragma unroll
            for (int j = 0; j < 4; ++j) { *(f32x4*)(XF + (size_t)(tb + k) * 1024 + 256 * j + 4 * lane) = v[k][j];
                u32x2 w; w.x = pack2(v[k][j][0], v[k][j][1]); w.y = pack2(v[k][j][2], v[k][j][3]); *(u32x2*)(XB + (size_t)(tb + k) * 1024 + 256 * j + 4 * lane) = w; } }
    }
}

struct SchedGrid {
    int nM, nN, G, c; const char* A; const char* B; size_t strideA, strideB;
    __device__ __forceinline__ bool next(int i, pg8::Unit& u) const { int pm, pn; if (!pg8::tile_order(i * G + c, nM, nN, pm, pn)) return false;
        u.pm = pm; u.pn = pn; u.tag = 0; u.A = A + (size_t)pm * strideA; u.B = B + (size_t)pn * strideB; return true; }
};
constexpr int GATES_LD = 3072;
template <int MODE> struct EpiBf16 {
    static constexpr bool PERM = true;
    bf16_t* O; int ldo; const bf16_t* Y; int ldy;
    __device__ __forceinline__ bool operator()(f32x4 (&acc)[2][2][4][2], const pg8::Unit& u, int wr, int wc, int fr, int fq) const {
#pragma unroll
        for (int ai = 0; ai < 2; ++ai) {
            bf16x8 yv[4][2];
            if (MODE == 2) {
#pragma unroll
                for (int m = 0; m < 4; ++m)
#pragma unroll
                    for (int bj = 0; bj < 2; ++bj) yv[m][bj] = *(const bf16x8*)(Y + ((size_t)u.pm * 256 + ai * 128 + wr * 64 + m * 16 + fr) * ldy + u.pn * 256 + bj * 128 + wc * 32 + 8 * fq);
            }
#pragma unroll
            for (int m = 0; m < 4; ++m) { const size_t row = (size_t)u.pm * 256 + ai * 128 + wr * 64 + m * 16 + fr;
#pragma unroll
                for (int bj = 0; bj < 2; ++bj) { const int col = u.pn * 256 + bj * 128 + wc * 32 + 8 * fq; f32x4 v0 = acc[ai][bj][m][0], v1 = acc[ai][bj][m][1];
                    if (MODE == 1) {
#pragma unroll
                        for (int j = 0; j < 4; ++j) { v0[j] = fmaxf(sigmoidf_(v0[j]), 1e-30f); v1[j] = fmaxf(sigmoidf_(v1[j]), 1e-30f); } }
                    if (MODE == 2) {
#pragma unroll
                        for (int j = 0; j < 4; ++j) { v0[j] = bf2f((bf16_t)yv[m][bj][j]) * sigmoidf_(v0[j]); v1[j] = bf2f((bf16_t)yv[m][bj][4 + j]) * sigmoidf_(v1[j]); } }
                    u32x4 w; w.x = pg8::cvt_pk_bf16(v0[0], v0[1]); w.y = pg8::cvt_pk_bf16(v0[2], v0[3]); w.z = pg8::cvt_pk_bf16(v1[0], v1[1]); w.w = pg8::cvt_pk_bf16(v1[2], v1[3]);
                    if (MODE == 1) *(u32x4*)(O + ((((size_t)u.pm * 12 + u.pn) * 16 + (ai * 8 + m * 2 + bj)) * 512 + ((wr * 4 + wc) * 64 + fq * 16 + fr)) * 8) = w;
                    else *(u32x4*)(O + row * ldo + col) = w; } }
        }
        return false;
    }
};
struct SchedZ {
    int G, c; const unsigned char* ws;
    __device__ __forceinline__ bool next(int i, pg8::Unit& u) const { int pm, pn; if (!pg8::tile_order(i * G + c, T / 256, 15, pm, pn)) return false;
        u.pm = pm; u.pn = pn; u.tag = 0; u.A = (const char*)(ws + OFF_XB) + (size_t)pm * 256 * 1024 * 2;
        u.B = (const char*)(ws + OFF_WIN) + (size_t)(pn < 14 ? pn * 256 : 6656) * 1024 * 2; return true; }
};
struct EpiZ {
    static constexpr bool PERM = true;
    bf16_t* Z; float* LI; float* LF; const float* bi; const float* bf;
    __device__ __forceinline__ bool operator()(f32x4 (&acc)[2][2][4][2], const pg8::Unit& u, int wr, int wc, int fr, int fq) const {
        if (u.pn < 14) {
#pragma unroll
            for (int ai = 0; ai < 2; ++ai)
#pragma unroll
                for (int m = 0; m < 4; ++m) { const size_t row = (size_t)u.pm * 256 + ai * 128 + wr * 64 + m * 16 + fr;
#pragma unroll
                    for (int bj = 0; bj < 2; ++bj) { const int col = u.pn * 256 + bj * 128 + wc * 32 + 8 * fq; const f32x4 v0 = acc[ai][bj][m][0], v1 = acc[ai][bj][m][1];
                        u32x4 w; w.x = pg8::cvt_pk_bf16(v0[0], v0[1]); w.y = pg8::cvt_pk_bf16(v0[2], v0[3]); w.z = pg8::cvt_pk_bf16(v1[0], v1[1]); w.w = pg8::cvt_pk_bf16(v1[2], v1[3]);
                        *(u32x4*)(Z + row * NZ + col) = w; } }
        } else if (wc == 0 && fq == 0) {
            const f32x4 b_i = *(const f32x4*)bi, b_f = *(const f32x4*)bf;
#pragma unroll
            for (int ai = 0; ai < 2; ++ai)
#pragma unroll
                for (int m = 0; m < 4; ++m) { const size_t row = (size_t)u.pm * 256 + ai * 128 + wr * 64 + m * 16 + fr; const f32x4 v0 = acc[ai][0][m][0] + b_i, v1 = acc[ai][0][m][1] + b_f;
                    f32x4 lf; lf[0] = logsigmoidf_(v1[0]); lf[1] = logsigmoidf_(v1[1]); lf[2] = logsigmoidf_(v1[2]); lf[3] = logsigmoidf_(v1[3]);
                    *(f32x4*)(LI + row * 4) = v0; *(f32x4*)(LF + row * 4) = lf; }
        }
        return false;
    }
};
__device__ __forceinline__ void phase_zgemm2(ArgsRef a, int l, int tid, int bid, int G) {
    SchedZ S{G, bid, a.ws}; EpiZ E{(bf16_t*)(a.ws + OFF_Z), (float*)(a.ws + OFF_LI), (float*)(a.ws + OFF_LF), a.in[7] + l * 4, a.in[8] + l * 4};
    pg8::gemm_phase((PG8_LAS unsigned char*)smem, tid, 1024, 1024, 1024, S, E);
}
__device__ __forceinline__ void phase_glu_gates(ArgsRef a, int l, int tid, int bid, int G) {
    { SchedGrid S{T / 256, 2, G, bid, (const char*)(a.ws + OFF_YPRE), (const char*)(a.ws + OFF_WGLU), (size_t)256 * 512 * 2, (size_t)256 * 512 * 2};
      EpiBf16<2> E{(bf16_t*)(a.ws + OFF_YSG), 512, (const bf16_t*)(a.ws + OFF_YPRE), 512};
      pg8::gemm_phase((PG8_LAS unsigned char*)smem, tid, 512, 512, 512, S, E); }
    asm volatile("" : "+v"(tid), "+s"(bid), "+s"(G));
    if (G > 128) { if (bid >= 128) phase_prepx(a, l, tid, bid - 128, G - 128, 0, 896); } else phase_prepx(a, l, tid, bid, G, 0, 896);
    asm volatile("" : "+v"(tid), "+s"(bid), "+s"(G));
    { SchedGrid S{T / 256, 12, G, (bid + G / 2) % G, (const char*)(a.ws + OFF_XB), (const char*)(a.ws + OFF_WIN + (size_t)NZ * 1024 * 2), (size_t)256 * 1024 * 2, (size_t)256 * 1024 * 2};
      EpiBf16<1> E{(bf16_t*)(a.ws + OFF_Z), GATES_LD, nullptr, 0};
      pg8::gemm_phase((PG8_LAS unsigned char*)smem, tid, 1024, 1024, 1024, S, E); }
}
struct SchedMerge {
    int G, c; const unsigned char* ws;
    __device__ __forceinline__ bool next(int i, pg8::Unit& u) const { const int b = i % 3; int pm, pn; if (!pg8::tile_order((i / 3) * G + c, T / 256, 4, pm, pn)) return false;
        u.pm = pm; u.pn = pn; u.tag = b; u.A = (const char*)(ws + (b == 0 ? OFF_OM : b == 1 ? OFF_YSG : OFF_OH)) + (size_t)pm * 256 * 512 * 2;
        u.B = (const char*)(ws + OFF_WB) + ((size_t)b * 1024 + pn * 256) * 512 * 2; return true; }
};
struct EpiMerge {
    static constexpr bool PERM = true;
    const bf16_t* GT; bf16_t* O;
    __device__ __forceinline__ bool operator()(f32x4 (&acc)[2][2][4][2], const pg8::Unit& u, int wr, int wc, int fr, int fq) const {
        const int b = u.tag;
#pragma unroll
        for (int ai = 0; ai < 2; ++ai)
#pragma unroll
        for (int mh = 0; mh < 2; ++mh) {
            bf16x8 gb[2][2], gn[2][2];
#pragma unroll
            for (int mm = 0; mm < 2; ++mm)
#pragma unroll
                for (int bj = 0; bj < 2; ++bj) { const bf16_t* gp = GT + ((((size_t)u.pm * 12 + b * 4 + u.pn) * 16 + (ai * 8 + (2 * mh + mm) * 2 + bj)) * 512 + ((wr * 4 + wc) * 64 + fq * 16 + fr)) * 8;
                    gb[mm][bj] = *(const bf16x8*)gp; gn[mm][bj] = (b < 2) ? *(const bf16x8*)(gp + (size_t)4 * 16 * 512 * 8) : gb[mm][bj]; }
#pragma unroll
            for (int mm = 0; mm < 2; ++mm) { const int m = 2 * mh + mm; const size_t row = (size_t)u.pm * 256 + ai * 128 + wr * 64 + m * 16 + fr;
#pragma unroll
                for (int bj = 0; bj < 2; ++bj) { const int col = u.pn * 256 + bj * 128 + wc * 32 + 8 * fq;
                    if (b < 2) {
#pragma unroll
                        for (int j = 0; j < 4; ++j) { acc[ai][bj][m][0][j] *= bf2f((bf16_t)gb[mm][bj][j]) * __builtin_amdgcn_rcpf(bf2f((bf16_t)gn[mm][bj][j])); acc[ai][bj][m][1][j] *= bf2f((bf16_t)gb[mm][bj][4 + j]) * __builtin_amdgcn_rcpf(bf2f((bf16_t)gn[mm][bj][4 + j])); } }
                    else { f32x4 v0 = acc[ai][bj][m][0], v1 = acc[ai][bj][m][1];
#pragma unroll
                        for (int j = 0; j < 4; ++j) { v0[j] *= bf2f((bf16_t)gb[mm][bj][j]); v1[j] *= bf2f((bf16_t)gb[mm][bj][4 + j]); }
                        u32x4 w; w.x = pg8::cvt_pk_bf16(v0[0], v0[1]); w.y = pg8::cvt_pk_bf16(v0[2], v0[3]); w.z = pg8::cvt_pk_bf16(v1[0], v1[1]); w.w = pg8::cvt_pk_bf16(v1[2], v1[3]);
                        *(u32x4*)(O + row * 1024 + col) = w; } } }
        }
        return b < 2;
    }
};
__device__ __forceinline__ void phase_merge2(ArgsRef a, int tid, int bid, int G) {
    SchedMerge S{G, bid, a.ws}; EpiMerge E{(const bf16_t*)(a.ws + OFF_Z), (bf16_t*)(a.ws + OFF_XB)};
    pg8::gemm_phase((PG8_LAS unsigned char*)smem, tid, 512, 512, 512, S, E);
}
struct EpiResid {
    static constexpr bool PERM = false;
    const float* xin; float* XF;
    __device__ __forceinline__ bool operator()(f32x4 (&acc)[2][2][4][2], const pg8::Unit& u, int wr, int wc, int fr, int fq) const {
#pragma unroll
        for (int ai = 0; ai < 2; ++ai)
#pragma unroll
        for (int mh = 0; mh < 2; ++mh) {
            f32x4 xv[2][2][2];
#pragma unroll
            for (int mm = 0; mm < 2; ++mm)
#pragma unroll
                for (int bj = 0; bj < 2; ++bj)
#pragma unroll
                    for (int n = 0; n < 2; ++n) xv[mm][bj][n] = *(const f32x4*)(xin + ((size_t)u.pm * 256 + ai * 128 + wr * 64 + (2 * mh + mm) * 16 + fr) * 1024 + u.pn * 256 + bj * 128 + wc * 32 + 16 * n + 4 * fq);
#pragma unroll
            for (int mm = 0; mm < 2; ++mm)
#pragma unroll
                for (int bj = 0; bj < 2; ++bj)
#pragma unroll
                    for (int n = 0; n < 2; ++n) { const int m = 2 * mh + mm; const size_t o = ((size_t)u.pm * 256 + ai * 128 + wr * 64 + m * 16 + fr) * 1024 + u.pn * 256 + bj * 128 + wc * 32 + 16 * n + 4 * fq; *(f32x4*)(XF + o) = DN_ALPHA * xv[mm][bj][n] + acc[ai][bj][m][n]; }
        }
        return false;
    }
};
__device__ __forceinline__ void phase_wout2(ArgsRef a, int l, int tid, int bid, int G) {
    SchedGrid S{T / 256, 4, G, bid, (const char*)(a.ws + OFF_XB), (const char*)(a.ws + OFF_WOUT), (size_t)256 * 1024 * 2, (size_t)256 * 1024 * 2};
    EpiResid E{(l == 0) ? a.in[0] : a.out, a.out};
    pg8::gemm_phase((PG8_LAS unsigned char*)smem, tid, 1024, 1024, 1024, S, E);
}
struct EpiQKV {
    static constexpr bool PERM = true;
    int vcall; bf16_t* Q; bf16_t* KH; bf16_t* V; const float* LI;
    __device__ __forceinline__ bool operator()(f32x4 (&acc)[2][2][4][2], const pg8::Unit& u, int wr, int wc, int fr, int fq) const {
        const int which = vcall ? 2 : (u.pn >> 1); bf16_t* O = Q + (size_t)which * (SZ_ACT / 2);
        float liv[2][4][2];
#pragma unroll
        for (int ai = 0; ai < 2; ++ai)
#pragma unroll
            for (int m = 0; m < 4; ++m)
#pragma unroll
                for (int bj = 0; bj < 2; ++bj) liv[ai][m][bj] = (which == 1) ? LI[((size_t)u.pm * 256 + ai * 128 + wr * 64 + m * 16 + fr) * 4 + (u.pn & 1) * 2 + bj] : 0.f;
#pragma unroll
        for (int ai = 0; ai < 2; ++ai)
#pragma unroll
            for (int m = 0; m < 4; ++m) { const size_t row = (size_t)u.pm * 256 + ai * 128 + wr * 64 + m * 16 + fr;
#pragma unroll
                for (int bj = 0; bj < 2; ++bj) { const int hd = (u.pn & 1) * 2 + bj, col = hd * 128 + wc * 32 + 8 * fq;
                    const float sc = which == 0 ? 0.08838834764831845f : which == 1 ? fexp(liv[ai][m][bj]) : 1.0f;
                    const f32x4 v0 = acc[ai][bj][m][0] * sc, v1 = acc[ai][bj][m][1] * sc;
                    u32x4 w; w.x = pg8::cvt_pk_bf16(v0[0], v0[1]); w.y = pg8::cvt_pk_bf16(v0[2], v0[3]); w.z = pg8::cvt_pk_bf16(v1[0], v1[1]); w.w = pg8::cvt_pk_bf16(v1[2], v1[3]);
                    *(u32x4*)(O + row * 512 + col) = w; } }
        return false;
    }
};
__device__ __forceinline__ void phase_mqkv2(ArgsRef a, int tid, int bid, int G) {
    { SchedGrid S{T / 256, 4, G, bid, (const char*)(a.ws + OFF_XC), (const char*)(a.ws + OFF_WQKV), (size_t)256 * 512 * 2, (size_t)256 * 512 * 2};
      EpiQKV E{0, (bf16_t*)(a.ws + OFF_Q), (bf16_t*)(a.ws + OFF_KH), (bf16_t*)(a.ws + OFF_V), (const float*)(a.ws + OFF_LI)};
      pg8::gemm_phase((PG8_LAS unsigned char*)smem, tid, 512, 512, 512, S, E); }
    asm volatile("" : "+v"(tid), "+s"(bid), "+s"(G));
    { SchedGrid S{T / 256, 2, G, (bid + G / 2) % G, (const char*)(a.ws + OFF_Z), (const char*)(a.ws + OFF_WQKV + (size_t)1024 * 512 * 2), (size_t)256 * NZ * 2, (size_t)256 * 512 * 2};
      EpiQKV E{1, (bf16_t*)(a.ws + OFF_Q), (bf16_t*)(a.ws + OFF_KH), (bf16_t*)(a.ws + OFF_V), (const float*)(a.ws + OFF_LI)};
      pg8::gemm_phase((PG8_LAS unsigned char*)smem, tid, 512, NZ, 512, S, E); }
}
struct SchedMoE {
    int down, G, c; const unsigned char* ws; const unsigned* BASE;
    __device__ __forceinline__ bool next(int i, pg8::Unit& u) const { const int per = down ? 4 : 2, L = i * G + c, ntile = (int)(BASE[32] >> 8); if (L >= ntile * per) return false;
        const int tile = L / per, sub = L % per; int e = 0; while (e < 31 && BASE[e + 1] <= (unsigned)(tile * 256)) ++e;
        u.pm = tile; u.pn = sub; u.tag = e;
        if (!down) { u.A = (const char*)(ws + OFF_XG) + (size_t)tile * 256 * 1024 * 2; u.B = (const char*)(ws + OFF_WGU) + ((size_t)e * 512 + sub * 256) * 1024 * 2; }
        else { u.A = (const char*)(ws + OFF_H) + (size_t)tile * 256 * 256 * 2; u.B = (const char*)(ws + OFF_WD) + ((size_t)e * 1024 + sub * 256) * 256 * 2; }
        return true; }
};
struct EpiH {
    static constexpr bool PERM = true;
    bf16_t* H;
    __device__ __forceinline__ bool operator()(f32x4 (&acc)[2][2][4][2], const pg8::Unit& u, int wr, int wc, int fr, int fq) const {
#pragma unroll
        for (int ai = 0; ai < 2; ++ai)
#pragma unroll
            for (int m = 0; m < 4; ++m) { const size_t row = (size_t)u.pm * 256 + ai * 128 + wr * 64 + m * 16 + fr; f32x4 v0, v1;
#pragma unroll
                for (int j = 0; j < 4; ++j) { v0[j] = siluf_(acc[ai][0][m][0][j]) * acc[ai][1][m][0][j]; v1[j] = siluf_(acc[ai][0][m][1][j]) * acc[ai][1][m][1][j]; }
                u32x4 w; w.x = pg8::cvt_pk_bf16(v0[0], v0[1]); w.y = pg8::cvt_pk_bf16(v0[2], v0[3]); w.z = pg8::cvt_pk_bf16(v1[0], v1[1]); w.w = pg8::cvt_pk_bf16(v1[2], v1[3]);
                *(u32x4*)(H + row * 256 + u.pn * 128 + wc * 32 + 8 * fq) = w; }
        return false;
    }
};
__device__ __forceinline__ void phase_moe_gu2(ArgsRef a, int l, int tid, int bid, int G) {
    { SchedMoE S{0, G, bid, a.ws, (const unsigned*)(a.ws + OFF_CTL) + 64}; EpiH E{(bf16_t*)(a.ws + OFF_H)};
      pg8::gemm_phase((PG8_LAS unsigned char*)smem, tid, 1024, 1024, 1024, S, E); }
    if (l + 1 < NLAYER) {
        asm volatile("" : "+v"(tid), "+s"(bid), "+s"(G));
        const int ntile = (int)(((const unsigned*)(a.ws + OFF_CTL))[64 + 32] >> 8); int nb = ntile * 2 - G; nb = nb < 0 ? 0 : (nb > G - 1 ? G - 1 : nb);
        if (bid >= nb) phase_prep(a, l + 1, tid, bid - nb, G - nb);
    }
}
__device__ __forceinline__ void phase_moe_dn2(ArgsRef a, int tid, int bid, int G) {
    SchedMoE S{1, G, bid, a.ws, (const unsigned*)(a.ws + OFF_CTL) + 64}; EpiBf16<0> E{(bf16_t*)(a.ws + OFF_YS), 1024, nullptr, 0};
    pg8::gemm_phase((PG8_LAS unsigned char*)smem, tid, 256, 256, 256, S, E);
}
__device__ __forceinline__ void phase_mprep2(ArgsRef a, int l, int tid, int lane, int wave, int bid, int G) {
    const bf16_t* Z = (const bf16_t*)(a.ws + OFF_Z); bf16_t* XC = (bf16_t*)(a.ws + OFF_XC);
    const float* cw = a.in[2] + (size_t)l * 4 * 512; const float* cb = a.in[3] + (size_t)l * 512;
    for (int idx = bid * 512 + tid; idx < (T / 8) * 64; idx += G * 512) {
        const int tb = (idx / 64) * 8, c0 = (idx % 64) * 8;
        bf16x8 xr[11];
#pragma unroll
        for (int k = 0; k < 11; ++k) { const int ts = tb - 3 + k; xr[k] = (ts >= 0) ? *(const bf16x8*)(Z + (size_t)ts * NZ + c0) : (bf16x8){0, 0, 0, 0, 0, 0, 0, 0}; }
        float w[4][8], b[8];
#pragma unroll
        for (int j = 0; j < 8; ++j) { b[j] = cb[c0 + j];
#pragma unroll
            for (int k = 0; k < 4; ++k) w[k][j] = cw[k * 512 + c0 + j]; }
#pragma unroll
        for (int tt = 0; tt < 8; ++tt) { float acc[8];
#pragma unroll
            for (int j = 0; j < 8; ++j) { acc[j] = b[j];
#pragma unroll
                for (int k = 0; k < 4; ++k) acc[j] += w[k][j] * bf2f((bf16_t)xr[tt + k][j]); }
            u32x4 o; o.x = pack2(siluf_(acc[0]), siluf_(acc[1])); o.y = pack2(siluf_(acc[2]), siluf_(acc[3])); o.z = pack2(siluf_(acc[4]), siluf_(acc[5])); o.w = pack2(siluf_(acc[6]), siluf_(acc[7]));
            *(u32x4*)(XC + (size_t)(tb + tt) * 512 + c0) = o; }
    }
}

#define XB_TMO      128
#define XB_XCNT(j)  (256  + 64 * (j))
#define XB_XSUB(j)  (1280 + 64 * (j))
#define XB_XGEN(j)  (2304 + 64 * (j))
#define XB_TOP      3328
#define XB_TOPGEN   3392
#define XCD_BAR_WORDS 3456
#define XB_SPIN_CAP (1u << 22)
__device__ __forceinline__ unsigned xb_ld(unsigned* p)              { return __hip_atomic_load(p, __ATOMIC_RELAXED, __HIP_MEMORY_SCOPE_AGENT); }
__device__ __forceinline__ unsigned xb_add(unsigned* p, unsigned v) { return __hip_atomic_fetch_add(p, v, __ATOMIC_RELAXED, __HIP_MEMORY_SCOPE_AGENT); }
__device__ __forceinline__ unsigned xb_xcc_id() { return (unsigned)__builtin_amdgcn_s_getreg((3 << 11) | 20) & 0xFu; }
#define XB_SPIN(cond, bar) do { unsigned _sp = 0; while (cond) { __builtin_amdgcn_s_sleep(1); \
    if ((++_sp & 255u) == 0u) { if (xb_ld(&(bar)[XB_TMO])) break; if (_sp > XB_SPIN_CAP) { atomicAdd(&(bar)[XB_TMO], 1u); break; } } } } while (0)
__device__ __forceinline__ void xcd_barrier_complete(unsigned* bar, unsigned x, unsigned& nloc, unsigned& nx) {
    const unsigned G = gridDim.x; unsigned sum, cnt, mine, sp = 0u;
    for (;;) { sum = 0u; cnt = 0u; mine = 0u;
#pragma unroll
        for (unsigned j = 0; j < 16; ++j) { const unsigned c = xb_ld(&bar[XB_XCNT(j)]); sum += c; cnt += (c > 0u) ? 1u : 0u; mine = (j == x) ? c : mine; }
        if (sum == G) break;
        __builtin_amdgcn_s_sleep(1);
        if ((++sp & 255u) == 0u) { if (xb_ld(&bar[XB_TMO])) break; if (sp > XB_SPIN_CAP) { atomicAdd(&bar[XB_TMO], 1u); break; } } }
    nloc = mine > 0u ? mine : 1u; nx = cnt > 0u ? cnt : 1u;
}
__device__ __forceinline__ void xcd_barrier(unsigned* bar, volatile __attribute__((address_space(3))) unsigned* st) {
    asm volatile("s_waitcnt vmcnt(0)" ::: "memory");
    __syncthreads();
    if (threadIdx.x == 0) {
        __builtin_amdgcn_s_waitcnt(0);
        const unsigned x = xb_xcc_id();
        unsigned nloc = st[0], nx = st[1];
        if (nloc == 0u) { xcd_barrier_complete(bar, x, nloc, nx); st[0] = nloc; st[1] = nx; }
        const unsigned old = xb_add(&bar[XB_XSUB(x)], 1u);
        const unsigned gen = old / nloc;
        if (old + 1u == (gen + 1u) * nloc) {
            __builtin_amdgcn_fence(__ATOMIC_RELEASE, "agent");
            asm volatile("s_waitcnt vmcnt(0)" ::: "memory");
            const unsigned og = xb_add(&bar[XB_TOP], 1u);
            const unsigned tg = og / nx;
            if (og + 1u == (tg + 1u) * nx) xb_add(&bar[XB_TOPGEN], 1u);
            else XB_SPIN(xb_ld(&bar[XB_TOPGEN]) == tg, bar);
            __builtin_amdgcn_fence(__ATOMIC_ACQUIRE, "agent");
            xb_add(&bar[XB_XGEN(x)], 1u);
            asm volatile("s_waitcnt vmcnt(0)" ::: "memory");
        } else {
            XB_SPIN(xb_ld(&bar[XB_XGEN(x)]) == gen, bar);
            __builtin_amdgcn_fence(__ATOMIC_ACQUIRE, "agent");
            asm volatile("s_waitcnt vmcnt(0)" ::: "memory");
        }
    }
    __syncthreads();
}

__device__ __forceinline__ ArgsRef fresh_args() { unsigned long long p = (unsigned long long)__builtin_amdgcn_kernarg_segment_ptr(); asm volatile("" : "+s"(p)); return *(const __attribute__((address_space(4))) Args*)p; }
__global__ void __launch_bounds__(512) fwd(Args a_unused) {
    cg::grid_group grid = cg::this_grid();
    volatile __attribute__((address_space(3))) unsigned* bst = (volatile __attribute__((address_space(3))) unsigned*)((__attribute__((address_space(3))) unsigned char*)smem + 131072);
    if (threadIdx.x < 4) bst[threadIdx.x] = 0u;
    __syncthreads();
    { ArgsRef a0 = fresh_args(); if (threadIdx.x == 0) (void)xb_add(&((unsigned*)(a0.ws + OFF_BAR))[XB_XCNT(xb_xcc_id())], 1u); }
#define GSYNC() do { asm volatile("" ::: "memory"); { ArgsRef ab = fresh_args(); xcd_barrier((unsigned*)(ab.ws + OFF_BAR), bst); } asm volatile("" ::: "memory"); } while (0)
#define GSYNC_CG() do { asm volatile("" ::: "memory"); grid.sync(); asm volatile("" ::: "memory"); } while (0)
    const int wave_s = __builtin_amdgcn_readfirstlane((int)threadIdx.x >> 6);
#define PH(body) do { int wave = wave_s; asm volatile("" : "+s"(wave)); int lane; asm volatile("v_mbcnt_lo_u32_b32 %0, -1, 0\n\tv_mbcnt_hi_u32_b32 %0, -1, %0" : "=v"(lane)); \
        int bid = blockIdx.x, G = gridDim.x; asm volatile("" : "+s"(bid), "+s"(G)); \
        const int tid = wave * 64 + lane, gw = bid * 8 + wave, GW = G * 8; (void)tid; (void)gw; (void)GW; ArgsRef a = fresh_args(); body; } while (0)
#pragma unroll 1
    for (int l = 0; l < NLAYER; ++l) {
        if (l == 0) { PH(phase_prep(a, 0, tid, bid, G)); GSYNC_CG(); }
        PH(phase_zgemm2(a, l, tid, bid, G)); GSYNC();
        PH(phase_mprep2(a, l, tid, lane, wave, bid, G)); GSYNC();
        PH(phase_mqkv2(a, tid, bid, G)); GSYNC();
        PH(phase_mixers<1>(a, l, tid, lane, wave, bid, G)); GSYNC();
        PH(phase_scan(a, tid, bid, G)); GSYNC();
        PH(phase_mixers<2>(a, l, tid, lane, wave, bid, G)); GSYNC();
        PH(phase_glu_gates(a, l, tid, bid, G)); PH(phase_prepx(a, l, tid, bid, G, 896, 4608)); GSYNC();
        PH(phase_merge2(a, tid, bid, G)); GSYNC();
        PH(phase_wout2(a, l, tid, bid, G)); GSYNC();
        PH(phase_ln1r(a, l, tid, lane, wave, bid, G)); PH(phase_prepx(a, l, tid, bid, G, 4608, 6144)); GSYNC();
        PH(phase_slot(a, tid, lane, wave, bid, G)); GSYNC();
        PH(phase_moe_gu2(a, l, tid, bid, G)); GSYNC();
        PH(phase_moe_dn2(a, tid, bid, G)); GSYNC();
        PH(phase_ln2(a, l, lane, gw, GW)); if (l + 1 < NLAYER) GSYNC();
    }
}

extern "C" void kernel_launch(void* const* d_in, const int* in_sizes, int n_in, void* d_out, int out_size, void* d_ws, size_t ws_size, hipStream_t stream) {
    static int grid = 0;
    if (grid == 0) {
        if (n_in != 34 || out_size != T * D || ws_size < WS_TOTAL) { fprintf(stderr, "kernel_launch: unexpected shapes (n_in %d, out %d, ws %zu, need %zu)\n", n_in, out_size, ws_size, (size_t)WS_TOTAL); grid = -1; return; }
        int dev = 0, cus = 0, per_cu = 0;
        (void)hipGetDevice(&dev); (void)hipDeviceGetAttribute(&cus, hipDeviceAttributeMultiprocessorCount, dev);
        (void)hipFuncSetAttribute((const void*)fwd, hipFuncAttributeMaxDynamicSharedMemorySize, LDS_BYTES);
        (void)hipOccupancyMaxActiveBlocksPerMultiprocessor(&per_cu, (const void*)fwd, 512, LDS_BYTES);
        if (per_cu < 1) { fprintf(stderr, "kernel_launch: occupancy query says %d blocks per CU\n", per_cu); per_cu = 1; }
        grid = (cus > 0 ? cus : 256) * 1;
        (void)hipGetLastError();
    }
    if (grid < 0) return;
    Args a{};
    for (int i = 0; i < 34; ++i) a.in[i] = (const float*)d_in[i];
    a.out = (float*)d_out; a.ws = (unsigned char*)d_ws; a.ph_lo = 0; a.ph_hi = NLAYER * NPH;
    (void)hipMemsetAsync((unsigned char*)d_ws + OFF_BAR, 0, 16384, stream);
    void* args[] = {&a};
    hipError_t e = hipLaunchCooperativeKernel((const void*)fwd, dim3(grid), dim3(512), args, LDS_BYTES, stream);
    if (e != hipSuccess) fprintf(stderr, "kernel_launch: cooperative launch failed: %s (grid %d)\n", hipGetErrorString(e), grid);
}
```

```cpp
#include <hip/hip_runtime.h>
#include <hip/hip_cooperative_groups.h>
#include <cstdio>
#include <cstdint>
namespace cg = cooperative_groups;

typedef unsigned short bf16_t;
typedef short bf16x8 __attribute__((ext_vector_type(8)));
typedef short bf16x4 __attribute__((ext_vector_type(4)));
typedef float f32x4 __attribute__((ext_vector_type(4)));
typedef unsigned u32x4 __attribute__((ext_vector_type(4)));
typedef unsigned u32x2 __attribute__((ext_vector_type(2)));

constexpr int T = 16384, D = 1024, NZ = 3584, NWIN = 6912, INW = 6664;
constexpr int NPH = 15, NLAYER = 2;
constexpr int GSEG = 32, GSEGLEN = 512;
constexpr int SSEG = 64, SSEGLEN = 256;
constexpr int SLOTS = 40960;
constexpr float DN_ALPHA = 1.41421356237f;
constexpr int LDS_BYTES = 131072 + 256;

constexpr size_t AL(size_t x) { return (x + 255) & ~(size_t)255; }
constexpr size_t OFF_WIN = 0;
constexpr size_t OFF_WQKV = OFF_WIN + AL((size_t)NWIN * 1024 * 2);
constexpr size_t OFF_WGLU = OFF_WQKV + AL((size_t)1536 * 512 * 2);
constexpr size_t OFF_WB = OFF_WGLU + AL((size_t)512 * 512 * 2);
constexpr size_t OFF_WOUT = OFF_WB + AL((size_t)3 * 1024 * 512 * 2);
constexpr size_t OFF_ABAR = OFF_WOUT + AL((size_t)1024 * 1024 * 2);
constexpr size_t OFF_BBT = OFF_ABAR + AL((size_t)32 * 64 * 2 * 4);
constexpr size_t OFF_CCT = OFF_BBT + AL((size_t)32 * 128 * 16 * 2);
constexpr size_t OFF_CTL = OFF_CCT + AL((size_t)32 * 16 * 128 * 2);
constexpr size_t OFF_TOKE = OFF_CTL + 4096;
constexpr size_t OFF_TOKG = OFF_TOKE + AL((size_t)T * 2 * 4);
constexpr size_t OFF_TOKS = OFF_TOKG + AL((size_t)T * 2 * 4);
constexpr size_t OFF_SLOTT = OFF_TOKS + AL((size_t)T * 2 * 4);
constexpr size_t OFF_XB = OFF_SLOTT + AL((size_t)SLOTS * 4);
constexpr size_t OFF_R1 = OFF_XB + AL((size_t)T * 1024 * 2);
constexpr size_t SZ_ACT = (size_t)T * 512 * 2;
constexpr size_t OFF_XC = OFF_R1, OFF_Q = OFF_R1 + SZ_ACT, OFF_KH = OFF_R1 + 2 * SZ_ACT, OFF_V = OFF_R1 + 3 * SZ_ACT;
constexpr size_t OFF_WGU = OFF_R1, OFF_WD = OFF_R1 + (size_t)32 * 512 * 1024 * 2;
constexpr size_t OFF_Z = OFF_R1 + 4 * SZ_ACT;
constexpr size_t OFF_XG = OFF_Z, OFF_H = OFF_Z + (size_t)SLOTS * 1024 * 2;
constexpr size_t OFF_ZS = OFF_Z + AL((size_t)T * NZ * 2);
constexpr size_t OFF_LF = OFF_ZS + AL((size_t)T * 8 * 4);
constexpr size_t OFF_LI = OFF_LF + AL((size_t)T * 4 * 4);
constexpr size_t OFF_E = OFF_LI + AL((size_t)T * 4 * 4);
constexpr size_t OFF_OM = OFF_E, OFF_OH = OFF_E + SZ_ACT, OFF_YPRE = OFF_E + 2 * SZ_ACT, OFF_YSG = OFF_E + 3 * SZ_ACT;
constexpr size_t OFF_DEN = OFF_E + 4 * SZ_ACT;
constexpr size_t OFF_EM = OFF_DEN + AL((size_t)T * 4 * 4);
constexpr size_t OFF_EMX = OFF_EM + AL((size_t)GSEG * 4 * 128 * 128 * 4);
constexpr size_t OFF_GM = OFF_EMX + AL((size_t)GSEG * 4 * 128 * 16 * 4);
constexpr size_t OFF_EH = OFF_GM + AL((size_t)GSEG * 4 * 128 * 4);
constexpr size_t OFF_GH = OFF_EH + AL((size_t)GSEG * 4 * 128 * 128 * 4);
constexpr size_t OFF_ES = OFF_GH + AL((size_t)GSEG * 4 * 128 * 4);
constexpr size_t WS_END = OFF_ES + AL((size_t)SSEG * 32 * 64 * 2 * 4);
constexpr size_t OFF_YS = OFF_E;
constexpr size_t OFF_RWT = WS_END;
constexpr size_t OFF_HIST = OFF_RWT + 32 * 1024 * 4;
constexpr size_t OFF_BAR = OFF_HIST + 1024 * 32 * 4;
constexpr size_t WS_TOTAL = OFF_BAR + 16384;
static_assert(OFF_YS + (size_t)SLOTS * 1024 * 2 <= WS_END, "YS must fit in the dead region");
static_assert(OFF_H + (size_t)SLOTS * 256 * 2 <= OFF_ZS, "H must fit in the dead Z region");
static_assert(OFF_WD + (size_t)32 * 1024 * 256 * 2 <= OFF_Z, "expert weights must fit in R1");

struct Args { const float* in[34]; float* out; unsigned char* ws; int ph_lo, ph_hi; };
typedef const __attribute__((address_space(4))) Args& ArgsRef;

extern __shared__ __attribute__((aligned(16))) unsigned char smem[];

__device__ __forceinline__ bf16_t f2bf(float f) { unsigned u = __float_as_uint(f); u += 0x7FFFu + ((u >> 16) & 1u); return (bf16_t)(u >> 16); }
__device__ __forceinline__ float bf2f(bf16_t b) { return __uint_as_float(((unsigned)b) << 16); }
__device__ __forceinline__ unsigned pack2(float lo, float hi) { return (unsigned)f2bf(lo) | ((unsigned)f2bf(hi) << 16); }
__device__ __forceinline__ float fexp(float x) { return __builtin_amdgcn_exp2f(x * 1.4426950408889634f); }
__device__ __forceinline__ float flog(float x) { return __builtin_amdgcn_logf(x) * 0.6931471805599453f; }
__device__ __forceinline__ float sigmoidf_(float x) { return __builtin_amdgcn_rcpf(1.0f + fexp(-x)); }
__device__ __forceinline__ float siluf_(float x) { return x * __builtin_amdgcn_rcpf(1.0f + fexp(-x)); }
__device__ __forceinline__ float logsigmoidf_(float x) { return fminf(x, 0.f) - log1pf(expf(-fabsf(x))); }
__device__ __forceinline__ float gelu_tanh(float y) { const float z = 0.7978845608028654f * (y + 0.044715f * y * y * y); const float th = 1.0f - 2.0f * __builtin_amdgcn_rcpf(fexp(2.0f * z) + 1.0f); return 0.5f * y * (1.0f + th); }
__device__ __forceinline__ void wave_sync() { __builtin_amdgcn_wave_barrier(); asm volatile("s_waitcnt lgkmcnt(0)" ::: "memory"); __builtin_amdgcn_wave_barrier(); }

#define MFMA16(a, b, c) __builtin_amdgcn_mfma_f32_16x16x32_bf16((a), (b), (c), 0, 0, 0)

template <int MT, int NT, class FA, class FB>
__device__ __forceinline__ void wave_gemm(f32x4 (&acc)[MT][NT], int K, FA arow, FB brow, int lane) {
    const int r = lane & 15, q = lane >> 4;
    const bf16_t* ap[MT]; const bf16_t* bp[NT];
#pragma unroll
    for (int m = 0; m < MT; ++m) ap[m] = arow(m * 16 + r) + 8 * q;
#pragma unroll
    for (int n = 0; n < NT; ++n) bp[n] = brow(n * 16 + r) + 8 * q;
#pragma unroll 1
    for (int k = 0; k < K; k += 32) {
        bf16x8 a[MT], b[NT];
#pragma unroll
        for (int m = 0; m < MT; ++m) a[m] = *(const bf16x8*)(ap[m] + k);
#pragma unroll
        for (int n = 0; n < NT; ++n) b[n] = *(const bf16x8*)(bp[n] + k);
#pragma unroll
        for (int m = 0; m < MT; ++m)
#pragma unroll
            for (int n = 0; n < NT; ++n) acc[m][n] = MFMA16(a[m], b[n], acc[m][n]);
    }
}
template <int MT, int NT> __device__ __forceinline__ void zero_acc(f32x4 (&acc)[MT][NT]) {
#pragma unroll
    for (int m = 0; m < MT; ++m)
#pragma unroll
        for (int n = 0; n < NT; ++n) acc[m][n] = (f32x4){0.f, 0.f, 0.f, 0.f};
}

namespace pg8 {
#define PG8_LAS __attribute__((address_space(3)))
constexpr int BM = 256, BK = 64, HALF = 128, HTB = HALF * BK * 2, STAGE_BYTES = 8 * HTB;
__device__ __forceinline__ int lds_byte(int r, int c) { const int st = (r >> 4) * 2 + (c >> 5), rr = r & 15, cc = c & 31, ob = rr * 64 + cc * 2; return st * 1024 + (ob ^ (((ob >> 9) & 1) << 5)); }
__device__ __forceinline__ void stage_rc(int b, int& R, int& C) { const int st = b / 1024, sb = b % 1024, swz = sb ^ (((sb >> 9) & 1) << 5); R = (st >> 1) * 16 + swz / 64; C = (st & 1) * 32 + (swz % 64) / 2; }
__device__ __forceinline__ int perm32(int rho) { const int n = rho >> 4, i = rho & 15; return 8 * (i >> 2) + 4 * n + (i & 3); }
struct Unit { int pm, pn, tag; const char* A; const char* B; };
__device__ __forceinline__ unsigned cvt_pk_bf16(float lo, float hi) { unsigned r; asm volatile("v_cvt_pk_bf16_f32 %0, %1, %2" : "=v"(r) : "v"(lo), "v"(hi)); return r; }
__device__ __forceinline__ bool tile_order(int L, int nM, int nN, int& pm, int& pn) {
    const int nwg = nM * nN; if (L >= nwg) return false;
    int wgid = L; { const int q = nwg / 8, r = nwg % 8, xcd = wgid % 8, off = wgid / 8; wgid = (xcd < r ? xcd * (q + 1) : r * (q + 1) + (xcd - r) * q) + off; }
    const int nig = 8 * nN, gid = wgid / nig, fm = gid * 8, gsz = (nM - fm) < 8 ? (nM - fm) : 8;
    pm = fm + ((wgid % nig) % gsz); pn = (wgid % nig) / gsz; return true;
}
template <class Epi, class Sched>
__device__ __forceinline__ void gemm_phase(PG8_LAS unsigned char* lds, const int tid, const int K, const int lda, const int ldb, const Sched& S, const Epi& E) {
    const int wid = __builtin_amdgcn_readfirstlane(tid >> 6), lane = tid & 63, wr = wid >> 2, wc = wid & 3, fr = lane & 15, fq = lane >> 4;
    const int nt = K / BK;
    unsigned voffA[2], voffB[2];
#pragma unroll
    for (int i = 0; i < 2; ++i) { int R, C; stage_rc(tid * 16 + i * 8192, R, C); const int Rb = Epi::PERM ? ((R & ~31) + perm32(R & 31)) : R;
        voffA[i] = (unsigned)(R * lda + C) * 2u; voffB[i] = (unsigned)(Rb * ldb + C) * 2u; }
    const size_t kstep = (size_t)(BK * 2), hstepA = (size_t)HALF * lda * 2, hstepB = (size_t)HALF * ldb * 2;
    const unsigned ldsw = (unsigned)wid * 1024u;
    const int aoff = lds_byte(wr * 64 + fr, fq * 8), boff = lds_byte(wc * 32 + fr, fq * 8);
#define PG8_SA(b, h) (((b) * 2 + (h)) * HTB)
#define PG8_SB(b, h) ((4 + (b) * 2 + (h)) * HTB)
#define PG8_STAGE(bufoff, gbase, voff) do { _Pragma("unroll") for (int _i = 0; _i < 2; ++_i) \
        __builtin_amdgcn_global_load_lds((const unsigned*)((const char*)(gbase) + (voff)[_i]), (PG8_LAS unsigned*)(lds + (bufoff) + ldsw + _i * 8192), 16, 0, 0); } while (0)
#define PG8_LDA(dst, b, h) do { _Pragma("unroll") for (int m = 0; m < 4; ++m) _Pragma("unroll") for (int k = 0; k < 2; ++k) dst[m][k] = *(const PG8_LAS bf16x8*)(lds + PG8_SA(b, h) + aoff + m * 2048 + k * 1024); } while (0)
#define PG8_LDB(dst, b, h) do { _Pragma("unroll") for (int n = 0; n < 2; ++n) _Pragma("unroll") for (int k = 0; k < 2; ++k) dst[n][k] = *(const PG8_LAS bf16x8*)(lds + PG8_SB(b, h) + boff + n * 2048 + k * 1024); } while (0)
#define PG8_MMA(ai, bj, At, Bt) do { __builtin_amdgcn_s_setprio(1); _Pragma("unroll") for (int m = 0; m < 4; ++m) _Pragma("unroll") for (int n = 0; n < 2; ++n) _Pragma("unroll") for (int k = 0; k < 2; ++k) \
        acc[ai][bj][m][n] = __builtin_amdgcn_mfma_f32_16x16x32_bf16(Bt[n][k], At[m][k], acc[ai][bj][m][n], 0, 0, 0); __builtin_amdgcn_s_setprio(0); } while (0)
#define PG8_WAIT_V(n) asm volatile("s_waitcnt vmcnt(" #n ")" ::: "memory")
#define PG8_WAIT_L(n) asm volatile("s_waitcnt lgkmcnt(" #n ")" ::: "memory")
#define PG8_BAR __builtin_amdgcn_s_barrier()
#define PG8_SCHED __builtin_amdgcn_sched_barrier(0)
    Unit cur, nxt; int ui = 0;
    if (!S.next(0, cur)) return;
    f32x4 acc[2][2][4][2];
#pragma unroll
    for (int a = 0; a < 2; ++a)
#pragma unroll
        for (int b = 0; b < 2; ++b)
#pragma unroll
            for (int m = 0; m < 4; ++m)
#pragma unroll
                for (int n = 0; n < 2; ++n) acc[a][b][m][n] = (f32x4){0.f, 0.f, 0.f, 0.f};
    bf16x8 At[4][2], B0[2][2], B1[2][2];
    const char* cA = cur.A; const char* cB = cur.B;
    PG8_STAGE(PG8_SB(0, 0), cB, voffB); PG8_STAGE(PG8_SA(0, 0), cA, voffA); PG8_STAGE(PG8_SB(0, 1), cB + hstepB, voffB); PG8_STAGE(PG8_SA(0, 1), cA + hstepA, voffA);
    if (wr == 1) PG8_BAR;
    PG8_WAIT_V(4); PG8_BAR;
    PG8_STAGE(PG8_SB(1, 0), cB + kstep, voffB); PG8_STAGE(PG8_SA(1, 0), cA + kstep, voffA); PG8_STAGE(PG8_SB(1, 1), cB + hstepB + kstep, voffB);
    PG8_WAIT_V(6); PG8_BAR;
    for (;;) {
        const bool has_next = S.next(ui + 1, nxt);
        const char* nA = has_next ? nxt.A : cA; const char* nB = has_next ? nxt.B : cB;
        for (int t = 0; t < nt; t += 2) {
            const bool last = (t == nt - 2);
            const char* a1 = cA + (size_t)(t + 1) * kstep;
            const char* a2 = last ? nA : cA + (size_t)(t + 2) * kstep; const char* b2 = last ? nB : cB + (size_t)(t + 2) * kstep;
            const char* a3 = a2 + kstep; const char* b3 = b2 + kstep;
            PG8_LDB(B0, 0, 0); PG8_SCHED; PG8_LDA(At, 0, 0); PG8_STAGE(PG8_SA(1, 1), a1 + hstepA, voffA);
            PG8_WAIT_L(8); PG8_BAR; PG8_WAIT_L(0); PG8_MMA(0, 0, At, B0); PG8_BAR; PG8_SCHED;
            PG8_LDB(B1, 0, 1); PG8_STAGE(PG8_SB(0, 0), b2, voffB);
            PG8_BAR; PG8_WAIT_L(0); PG8_MMA(0, 1, At, B1); PG8_BAR;
            PG8_LDA(At, 0, 1); PG8_STAGE(PG8_SA(0, 0), a2, voffA);
            PG8_BAR; PG8_WAIT_L(0); PG8_MMA(1, 0, At, B0); PG8_BAR; PG8_SCHED;
            PG8_STAGE(PG8_SB(0, 1), b2 + hstepB, voffB);
            PG8_WAIT_V(6); PG8_BAR; PG8_MMA(1, 1, At, B1); PG8_BAR;
            PG8_LDB(B0, 1, 0); PG8_SCHED; PG8_LDA(At, 1, 0); PG8_STAGE(PG8_SA(0, 1), a2 + hstepA, voffA);
            PG8_WAIT_L(8); PG8_BAR; PG8_WAIT_L(0); PG8_MMA(0, 0, At, B0); PG8_BAR; PG8_SCHED;
            PG8_LDB(B1, 1, 1); PG8_STAGE(PG8_SB(1, 0), b3, voffB);
            PG8_BAR; PG8_WAIT_L(0); PG8_MMA(0, 1, At, B1); PG8_BAR;
            PG8_LDA(At, 1, 1); PG8_STAGE(PG8_SA(1, 0), a3, voffA);
            PG8_BAR; PG8_WAIT_L(0); PG8_MMA(1, 0, At, B0); PG8_BAR; PG8_SCHED;
            PG8_STAGE(PG8_SB(1, 1), b3 + hstepB, voffB);
            PG8_WAIT_V(6); PG8_BAR; PG8_MMA(1, 1, At, B1); PG8_BAR;
        }
        const bool keep = E(acc, cur, wr, wc, fr, fq);
        if (!has_next) break;
        if (!keep) {
#pragma unroll
            for (int a = 0; a < 2; ++a)
#pragma unroll
                for (int b = 0; b < 2; ++b)
#pragma unroll
                    for (int m = 0; m < 4; ++m)
#pragma unroll
                        for (int n = 0; n < 2; ++n) acc[a][b][m][n] = (f32x4){0.f, 0.f, 0.f, 0.f};
        }
        cur = nxt; cA = nA; cB = nB; ++ui;
    }
    PG8_WAIT_V(0);
    if (wr == 0) PG8_BAR;
    PG8_BAR;
#undef PG8_SA
#undef PG8_SB
#undef PG8_STAGE
#undef PG8_LDA
#undef PG8_LDB
#undef PG8_MMA
#undef PG8_WAIT_V
#undef PG8_WAIT_L
#undef PG8_BAR
#undef PG8_SCHED
}
}

__device__ __forceinline__ void tconv_tile(const float* src, int ld_src, int nvalid, bf16_t* dst, int ld_dst, int tid) {
    float* t = (float*)smem;
    { const int r = tid >> 3, c0 = (tid & 7) * 8; float v[8];
      if (nvalid == 64) { const f32x4 a0 = *(const f32x4*)(src + (size_t)r * ld_src + c0), a1 = *(const f32x4*)(src + (size_t)r * ld_src + c0 + 4);
          v[0] = a0[0]; v[1] = a0[1]; v[2] = a0[2]; v[3] = a0[3]; v[4] = a1[0]; v[5] = a1[1]; v[6] = a1[2]; v[7] = a1[3]; }
      else {
#pragma unroll
          for (int j = 0; j < 8; ++j) { const int c = c0 + j; v[j] = (c < nvalid) ? src[(size_t)r * ld_src + c] : 0.f; } }
#pragma unroll
      for (int j = 0; j < 8; ++j) t[(c0 + j) * 65 + r] = v[j]; }
    __syncthreads();
    { const int n = tid >> 3, k0 = (tid & 7) * 8; const float* p = t + n * 65 + k0;
      u32x4 w; w.x = pack2(p[0], p[1]); w.y = pack2(p[2], p[3]); w.z = pack2(p[4], p[5]); w.w = pack2(p[6], p[7]);
      *(u32x4*)(dst + (size_t)n * ld_dst + k0) = w; }
    __syncthreads();
}

__device__ __forceinline__ void phase_prep(ArgsRef a, int l, int tid, int bid, int G) {
    unsigned char* ws = a.ws;
    bf16_t* WIN = (bf16_t*)(ws + OFF_WIN); bf16_t* WQKV = (bf16_t*)(ws + OFF_WQKV); bf16_t* WGLU = (bf16_t*)(ws + OFF_WGLU);
    bf16_t* WB = (bf16_t*)(ws + OFF_WB); bf16_t* WOUT = (bf16_t*)(ws + OFF_WOUT);
    for (int u = bid; u < 2624; u += G) {
        const float* src; int lds_ = 0, nvalid = 64, ldd = 0; bf16_t* dst;
        if (u < 1728) { const int nt = u / 16, kt = u % 16, p0 = nt * 64; int sc;
            if (p0 < 1024) sc = p0; else if (p0 < 6656) sc = p0 + 8; else if (p0 == 6656) { sc = 1024; nvalid = 8; } else { sc = 0; nvalid = 0; }
            src = a.in[1] + (size_t)l * 1024 * INW + (size_t)(kt * 64) * INW + sc; lds_ = INW; dst = WIN + (size_t)p0 * 1024 + kt * 64; ldd = 1024; }
        else if (u < 1920) { const int v = u - 1728, nt = v / 8, kt = v % 8, which = nt / 8, h = (nt % 8) / 2;
            if ((kt >> 1) != h) nvalid = 0;
            src = a.in[4 + which] + (size_t)(l * 4 + h) * 128 * 128 + ((kt & 1) * 64) * 128 + (nt & 1) * 64; lds_ = 128; dst = WQKV + (size_t)(nt * 64) * 512 + kt * 64; ldd = 512; }
        else if (u < 1984) { const int v = u - 1920, nt = v / 8, kt = v % 8;
            src = a.in[18] + (size_t)l * 512 * 512 + (kt * 64) * 512 + nt * 64; lds_ = 512; dst = WGLU + (size_t)(nt * 64) * 512 + kt * 64; ldd = 512; }
        else if (u < 2368) { const int v = u - 1984, b = v / 128, w = v % 128, nt = w / 8, kt = w % 8;
            src = a.in[21 + b] + (size_t)l * 512 * 1024 + (size_t)(kt * 64) * 1024 + nt * 64; lds_ = 1024; dst = WB + (size_t)b * 1024 * 512 + (size_t)(nt * 64) * 512 + kt * 64; ldd = 512; }
        else { const int v = u - 2368, nt = v / 16, kt = v % 16;
            src = a.in[24] + (size_t)l * 1024 * 1024 + (size_t)(kt * 64) * 1024 + nt * 64; lds_ = 1024; dst = WOUT + (size_t)(nt * 64) * 1024 + kt * 64; ldd = 1024; }
        tconv_tile(src, lds_, nvalid, dst, ldd, tid);
    }
    float* ABAR = (float*)(ws + OFF_ABAR); bf16_t* BBT = (bf16_t*)(ws + OFF_BBT); bf16_t* CCT = (bf16_t*)(ws + OFF_CCT);
    for (int i = bid * 512 + tid; i < 2048; i += G * 512) {
        const int g = i / 64, p = i % 64; const size_t gp = (size_t)(l * 32 + g) * 64 + p;
        const float lr = fminf(a.in[10][gp], -1e-4f), li = a.in[11][gp], dt = expf(a.in[12][l * 32 + g]);
        const float mag = expf(lr * dt), abr = mag * cosf(li * dt), abi = mag * sinf(li * dt);
        const float nr = abr - 1.0f, den = lr * lr + li * li, cr = (nr * lr + abi * li) / den, ci = (abi * lr - nr * li) / den;
        ABAR[(g * 64 + p) * 2] = abr; ABAR[(g * 64 + p) * 2 + 1] = abi;
        for (int c = 0; c < 16; ++c) { const float br = a.in[13][gp * 16 + c], bi = a.in[14][gp * 16 + c];
            BBT[(size_t)(g * 128 + p) * 16 + c] = f2bf(cr * br - ci * bi); BBT[(size_t)(g * 128 + 64 + p) * 16 + c] = f2bf(cr * bi + ci * br);
            const size_t ci_ = ((size_t)(l * 32 + g) * 16 + c) * 64 + p;
            CCT[(size_t)(g * 16 + c) * 128 + p] = f2bf(a.in[15][ci_]); CCT[(size_t)(g * 16 + c) * 128 + 64 + p] = f2bf(-a.in[16][ci_]); }
    }
    if (l == 0) { float* RWT = (float*)(ws + OFF_RWT); const float* RW = a.in[29]; for (int i = bid * 512 + tid; i < 32 * 1024; i += G * 512) RWT[i] = RW[(i & 1023) * 32 + (i >> 10)]; }
    if (l == 0) { bf16_t* XB = (bf16_t*)(ws + OFF_XB); const float* x = a.in[0];
        for (size_t i = (size_t)bid * 512 + tid; i < (size_t)T * 1024 / 8; i += (size_t)G * 512) {
            const f32x4 v0 = *(const f32x4*)(x + i * 8), v1 = *(const f32x4*)(x + i * 8 + 4);
            u32x4 w; w.x = pack2(v0[0], v0[1]); w.y = pack2(v0[2], v0[3]); w.z = pack2(v1[0], v1[1]); w.w = pack2(v1[2], v1[3]); *(u32x4*)(XB + i * 8) = w; } }
}

__device__ __forceinline__ void phase_prepx(ArgsRef a, int l, int tid, int bid, int G, int u_lo, int u_hi) {
    bf16_t* WGU = (bf16_t*)(a.ws + OFF_WGU); bf16_t* WD = (bf16_t*)(a.ws + OFF_WD);
    for (int u = u_lo + bid; u < u_hi; u += G) {
        const float* src; int lds_, ldd; bf16_t* dst;
        if (u < 4096) { const int up = u >= 2048, v = u & 2047, e = v / 64, w = v % 64, nt = w / 16, kt = w % 16, j0 = nt * 64, drow = (j0 / 128) * 256 + (j0 % 128) + up * 128;
            src = a.in[31 + up] + ((size_t)(l * 32 + e) * 1024 + kt * 64) * 256 + nt * 64; lds_ = 256; dst = WGU + ((size_t)e * 512 + drow) * 1024 + kt * 64; ldd = 1024; }
        else { const int v = u - 4096, e = v / 64, w = v % 64, nt = w / 4, kt = w % 4;
            src = a.in[33] + ((size_t)(l * 32 + e) * 256 + kt * 64) * 1024 + nt * 64; lds_ = 1024; dst = WD + ((size_t)e * 1024 + nt * 64) * 256 + kt * 64; ldd = 256; }
        tconv_tile(src, lds_, 64, dst, ldd, tid);
    }
}

constexpr int GL_RQ = 0, GL_RK = 17408, GL_VT = 34816, GL_RO = 57856, GL_RX = 75264, GL_KT = 92672, GL_PS = 102912, GL_SC1 = 105472, GL_SC2 = 105984, GL_GT = 106496, GL_OS = 108544, GL_LFS = 117248, GL_DNS = 117504;
template <int MODE, int PASS>
__device__ __forceinline__ void gla_item(ArgsRef a, int l, int h, int sg, int tid, int lane, int wave) {
    unsigned char* ws = a.ws;
    const bf16_t* Z = (const bf16_t*)(ws + OFF_Z); const bf16_t* Qg = (const bf16_t*)(ws + OFF_Q); const bf16_t* Kg = (const bf16_t*)(ws + OFF_KH); const bf16_t* Vg = (const bf16_t*)(ws + OFF_V); const bf16_t* XCg = (const bf16_t*)(ws + OFF_XC);
    const float* LF = (const float*)(ws + OFF_LF);
    float* Eg = (float*)(ws + (MODE == 0 ? OFF_EM : OFF_EH)); float* Gg = (float*)(ws + (MODE == 0 ? OFF_GM : OFF_GH)); float* EX = (float*)(ws + OFF_EMX);
    bf16_t* Yg = (bf16_t*)(ws + (MODE == 0 ? OFF_OM : OFF_OH));
    bf16_t* KT = (bf16_t*)(smem + GL_KT); bf16_t* PS = (bf16_t*)(smem + GL_PS);
    float* SC1 = (float*)(smem + GL_SC1); float* SC2 = (float*)(smem + GL_SC2); float* GT = (float*)(smem + GL_GT); bf16_t* OS = (bf16_t*)(smem + GL_OS); float* DNS = (float*)(smem + GL_DNS);
    const int r = lane & 15, q = lane >> 4, grp = tid >> 7, d = tid & 127, tok = tid >> 4, c8 = (tid & 15) * 8;
    const bool xw = (MODE == 0) && (wave == 0);
    float lb = 0.f;
    if (MODE == 1 && l == 1) { const float h0 = a.in[19][h * 128 + d], h1 = a.in[19][512 + h * 128 + d]; lb = 1.0f / (1.0f + expf(h0 - h1)); }
    f32x4 S[8], SX[8];
#pragma unroll
    for (int i = 0; i < 8; ++i) { S[i] = (f32x4){0.f, 0.f, 0.f, 0.f}; SX[i] = (f32x4){0.f, 0.f, 0.f, 0.f}; }
    if (PASS == 2) {
#pragma unroll
        for (int i = 0; i < 8; ++i)
#pragma unroll
            for (int g = 0; g < 4; ++g) { const size_t row = (size_t)(sg * 4 + h) * 128 + 16 * i + 4 * q + g; S[i][g] = Eg[row * 128 + 16 * wave + r]; if (xw) SX[i][g] = EX[row * 16 + r]; }
    }
    const bf16x8 z8 = (bf16x8){0, 0, 0, 0, 0, 0, 0, 0};
    bf16x8 rq = z8, rk = z8, rv = z8, ro = z8, rx = z8; float lfv = 0.f;
#define GLA_FETCH(t0_) do { const size_t tk = (size_t)((t0_) + tok); \
        if (MODE == 1) { const bf16_t* zp = Z + tk * NZ + h * 128 + c8; if (PASS == 2) { rq = *(const bf16x8*)(zp + 1536); ro = *(const bf16x8*)(zp + 3072); } rk = *(const bf16x8*)(zp + 2048); rv = *(const bf16x8*)(zp + 2560); } \
        else { const size_t o_ = tk * 512 + h * 128 + c8; if (PASS == 2) { rq = *(const bf16x8*)(Qg + o_); ro = *(const bf16x8*)(Z + tk * NZ + 512 + h * 128 + c8); rx = *(const bf16x8*)(XCg + o_); } \
               rk = *(const bf16x8*)(Kg + o_); rv = *(const bf16x8*)(Vg + o_); if (tid < 32) lfv = LF[((t0_) + tid) * 4 + h]; } } while (0)
    GLA_FETCH(sg * GSEGLEN);
    float sk8[8], nw8[8];
#pragma unroll
    for (int j = 0; j < 8; ++j) { sk8[j] = (MODE == 0 && PASS == 2) ? a.in[9][l * 512 + h * 128 + c8 + j] : 0.f; nw8[j] = (MODE == 1 && PASS == 2) ? a.in[20][l * 512 + h * 128 + c8 + j] : 0.f; }
    __syncthreads();
    if (MODE == 0) { for (int i = tid; i < 2 * 16 * 40; i += 512) { const int b = i / 640, k = i % 640; ((bf16_t*)(smem + GL_VT + b * 11520))[128 * 40 + k] = (k < 32) ? (bf16_t)0x3F80 : (bf16_t)0; } }
#define GLA_STORE(tprev, pb) do { const bf16x8 o8 = *(const bf16x8*)(OS + tok * 136 + c8); const bf16x8 p8 = *(const bf16x8*)((const bf16_t*)(smem + GL_RO + (pb) * 8704) + tok * 136 + c8); float y[8]; \
        if (MODE == 0) { const bf16x8 x8 = *(const bf16x8*)((const bf16_t*)(smem + GL_RX + (pb) * 8704) + tok * 136 + c8); const float di = __builtin_amdgcn_rcpf(fmaxf(fabsf(DNS[tok]), 1.0f)); \
            _Pragma("unroll") for (int j = 0; j < 8; ++j) y[j] = sigmoidf_(bf2f((bf16_t)p8[j])) * (bf2f((bf16_t)o8[j]) * di) + sk8[j] * bf2f((bf16_t)x8[j]); } \
        else { float ov[8], ss = 0.f; _Pragma("unroll") for (int j = 0; j < 8; ++j) { ov[j] = bf2f((bf16_t)o8[j]); ss += ov[j] * ov[j]; } \
            ss += __shfl_xor(ss, 1); ss += __shfl_xor(ss, 2); ss += __shfl_xor(ss, 4); ss += __shfl_xor(ss, 8); const float rinv = rsqrtf(ss * (1.0f / 128.0f) + 1e-6f); \
            _Pragma("unroll") for (int j = 0; j < 8; ++j) y[j] = ov[j] * rinv * nw8[j] * siluf_(bf2f((bf16_t)p8[j])); } \
        u32x4 w_; w_.x = pack2(y[0], y[1]); w_.y = pack2(y[2], y[3]); w_.z = pack2(y[4], y[5]); w_.w = pack2(y[6], y[7]); *(u32x4*)(Yg + (size_t)((tprev) + tok) * 512 + h * 128 + c8) = w_; } while (0)
    float runb = 0.f;
    for (int ci = 0; ci < GSEGLEN / 32; ++ci) {
        const int t0 = sg * GSEGLEN + ci * 32, buf = ci & 1;
        bf16_t* RQ = (bf16_t*)(smem + GL_RQ + buf * 8704); bf16_t* RK = (bf16_t*)(smem + GL_RK + buf * 8704); bf16_t* VT = (bf16_t*)(smem + GL_VT + buf * 11520);
        float* LFS = (float*)(smem + GL_LFS + buf * 128);
        if (PASS == 2) { *(bf16x8*)(RQ + tok * 136 + c8) = rq; *(bf16x8*)((bf16_t*)(smem + GL_RO + buf * 8704) + tok * 136 + c8) = ro; if (MODE == 0) *(bf16x8*)((bf16_t*)(smem + GL_RX + buf * 8704) + tok * 136 + c8) = rx; }
        *(bf16x8*)(RK + tok * 136 + c8) = rk;
#pragma unroll
        for (int j = 0; j < 8; ++j) VT[(c8 + j) * 40 + tok] = (bf16_t)rv[j];
        if (MODE == 0 && tid < 32) LFS[tid] = lfv;
        if (ci + 1 < GSEGLEN / 32) GLA_FETCH(t0 + 32);
        __syncthreads();
        float lg[8], kv[8];
#pragma unroll
        for (int j = 0; j < 8; ++j) { const float kr = bf2f(RK[(grp * 8 + j) * 136 + d]);
            if (MODE == 1) { const float f = lb + (1.0f - lb) * sigmoidf_(kr); lg[j] = flog(f); kv[j] = 1.0f - f; } else { lg[j] = LFS[grp * 8 + j]; kv[j] = kr; } }
        float cs[8]; cs[0] = lg[0];
#pragma unroll
        for (int j = 1; j < 8; ++j) cs[j] = cs[j - 1] + lg[j];
        GT[grp * 128 + d] = cs[7];
        __syncthreads();
        if (PASS == 2 && ci > 0) GLA_STORE(t0 - 32, buf ^ 1);
        const float g0 = GT[d], g1 = GT[128 + d], g2 = GT[256 + d], g3 = GT[384 + d];
        const float off = grp == 0 ? 0.f : grp == 1 ? g0 : grp == 2 ? g0 + g1 : g0 + g1 + g2;
        const float bmid = g0 + g1, bL = bmid + g2 + g3;
        bf16_t ktv[8];
#pragma unroll
        for (int j = 0; j < 8; ++j) { const float bt = off + cs[j], ek = fexp(bmid - bt); const bf16_t kt = f2bf(kv[j] * ek); ktv[j] = kt;
            if (PASS == 2) { const float qr = bf2f(RQ[(grp * 8 + j) * 136 + d]); const float qq = (MODE == 1) ? siluf_(qr) : qr; RQ[(grp * 8 + j) * 136 + d] = f2bf(qq * __builtin_amdgcn_rcpf(ek)); RK[(grp * 8 + j) * 136 + d] = kt; } }
        { u32x4 w; w.x = ktv[0] | ((unsigned)ktv[1] << 16); w.y = ktv[2] | ((unsigned)ktv[3] << 16); w.z = ktv[4] | ((unsigned)ktv[5] << 16); w.w = ktv[6] | ((unsigned)ktv[7] << 16); *(u32x4*)(KT + d * 40 + grp * 8) = w; }
        if (grp == 0) { SC1[d] = fexp(bmid); SC2[d] = fexp(bL - bmid); runb += bL; }
        __syncthreads();
        if (PASS == 2) {
            if (wave < 4) {
                const int ti = (wave == 1 || wave == 2) ? 1 : 0, tj = (wave >= 2) ? 1 : 0;
                f32x4 p = (f32x4){0.f, 0.f, 0.f, 0.f};
                if (wave < 3) {
#pragma unroll
                    for (int kk = 0; kk < 4; ++kk) { const bf16x8 av = *(const bf16x8*)(RQ + (16 * ti + r) * 136 + 32 * kk + 8 * q); const bf16x8 bv = *(const bf16x8*)(RK + (16 * tj + r) * 136 + 32 * kk + 8 * q); p = MFMA16(av, bv, p); }
                }
#pragma unroll
                for (int g = 0; g < 4; ++g) { const int t = 16 * ti + 4 * q + g, s_ = 16 * tj + r; PS[t * 40 + s_] = (wave < 3 && s_ <= t) ? f2bf(p[g]) : (bf16_t)0; }
            }
            __syncthreads();
        }
        const bf16x8 bV = *(const bf16x8*)(VT + (16 * wave + r) * 40 + 8 * q);
        bf16x8 bV1 = bV; if (xw) bV1 = *(const bf16x8*)(VT + (128 + r) * 40 + 8 * q);
        f32x4 o[2], ox[2];
        o[0] = o[1] = ox[0] = ox[1] = (f32x4){0.f, 0.f, 0.f, 0.f};
#pragma unroll
        for (int kk = 0; kk < 4; ++kk) {
            const f32x4 sa = *(const f32x4*)(SC1 + 32 * kk + 4 * q), sb = *(const f32x4*)(SC1 + 32 * kk + 16 + 4 * q);
            S[2 * kk] *= sa; S[2 * kk + 1] *= sb;
            if (xw) { SX[2 * kk] *= sa; SX[2 * kk + 1] *= sb; }
            if (PASS == 2) {
                bf16x8 bS, bX;
#pragma unroll
                for (int g = 0; g < 4; ++g) { bS[g] = (short)f2bf(S[2 * kk][g]); bS[4 + g] = (short)f2bf(S[2 * kk + 1][g]); bX[g] = (short)f2bf(SX[2 * kk][g]); bX[4 + g] = (short)f2bf(SX[2 * kk + 1][g]); }
#pragma unroll
                for (int mt = 0; mt < 2; ++mt) { const bf16x4 lo = *(const bf16x4*)(RQ + (16 * mt + r) * 136 + 32 * kk + 4 * q), hi = *(const bf16x4*)(RQ + (16 * mt + r) * 136 + 32 * kk + 16 + 4 * q);
                    bf16x8 av; av[0] = lo[0]; av[1] = lo[1]; av[2] = lo[2]; av[3] = lo[3]; av[4] = hi[0]; av[5] = hi[1]; av[6] = hi[2]; av[7] = hi[3];
                    o[mt] = MFMA16(av, bS, o[mt]); if (xw) ox[mt] = MFMA16(av, bX, ox[mt]); }
            }
        }
        if (PASS == 2) {
#pragma unroll
            for (int mt = 0; mt < 2; ++mt) { const bf16x8 av = *(const bf16x8*)(PS + (16 * mt + r) * 40 + 8 * q); o[mt] = MFMA16(av, bV, o[mt]); if (xw) ox[mt] = MFMA16(av, bV1, ox[mt]);
#pragma unroll
                for (int g = 0; g < 4; ++g) { OS[(16 * mt + 4 * q + g) * 136 + 16 * wave + r] = f2bf(o[mt][g]); if (xw && r == 0) DNS[16 * mt + 4 * q + g] = ox[mt][g]; } }
        }
#pragma unroll
        for (int i = 0; i < 8; ++i) { const bf16x8 av = *(const bf16x8*)(KT + (16 * i + r) * 40 + 8 * q); const f32x4 s2 = *(const f32x4*)(SC2 + 16 * i + 4 * q);
            S[i] = MFMA16(av, bV, S[i]); S[i] *= s2;
            if (xw) { SX[i] = MFMA16(av, bV1, SX[i]); SX[i] *= s2; } }
    }
    if (PASS == 2) { __syncthreads(); GLA_STORE(sg * GSEGLEN + GSEGLEN - 32, 1); }
    if (PASS == 1) {
        float* ST = (float*)smem;
        __syncthreads();
#pragma unroll
        for (int i = 0; i < 8; ++i)
#pragma unroll
            for (int g = 0; g < 4; ++g) { ST[(16 * i + 4 * q + g) * 132 + 16 * wave + r] = S[i][g]; if (xw) EX[((size_t)(sg * 4 + h) * 128 + 16 * i + 4 * q + g) * 16 + r] = SX[i][g]; }
        __syncthreads();
#pragma unroll
        for (int k = 0; k < 8; ++k) { const int idx = tid + 512 * k, row = idx >> 5, c4 = (idx & 31) * 4; *(f32x4*)(Eg + ((size_t)(sg * 4 + h) * 128 + row) * 128 + c4) = *(const f32x4*)(ST + row * 132 + c4); }
        if (grp == 0) Gg[(size_t)(sg * 4 + h) * 128 + d] = expf(runb);
    }
#undef GLA_FETCH
#undef GLA_STORE
}

template <int PASS>
__device__ __forceinline__ void s5_item(ArgsRef a, int l, int g, int sg, int g0, int tid, int lane, int wave, int hsel) {
    unsigned char* ws = a.ws;
    const bf16_t* Z = (const bf16_t*)(ws + OFF_Z); const float* ABAR = (const float*)(ws + OFF_ABAR); const bf16_t* BBT = (const bf16_t*)(ws + OFF_BBT); const bf16_t* CCT = (const bf16_t*)(ws + OFF_CCT);
    float* ES = (float*)(ws + OFF_ES); bf16_t* YPRE = (bf16_t*)(ws + OFF_YPRE);
    float* BU = (float*)(smem + 70000 + (wave & 3) * 12800); bf16_t* X = (bf16_t*)(smem + 70000 + (wave & 3) * 12800 + 8448); bf16_t* YT = (bf16_t*)(smem + 70000 + 51200);
    const int r = lane & 15, q = lane >> 4, p = lane; const bool act = (wave >> 2) == hsel;
    const float ar = ABAR[(g * 64 + p) * 2], ai = ABAR[(g * 64 + p) * 2 + 1];
    const bf16x8 zero8 = (bf16x8){0, 0, 0, 0, 0, 0, 0, 0};
    bf16x8 bB[8], cB[4];
#pragma unroll
    for (int nt = 0; nt < 8; ++nt) bB[nt] = (q < 2) ? *(const bf16x8*)(BBT + (size_t)(g * 128 + 16 * nt + r) * 16 + 8 * q) : zero8;
#pragma unroll
    for (int kk = 0; kk < 4; ++kk) cB[kk] = (PASS == 2) ? *(const bf16x8*)(CCT + (size_t)(g * 16 + r) * 128 + 32 * kk + 8 * q) : zero8;
    float xr = 0.f, xi = 0.f;
    if (PASS == 2) { xr = ES[((size_t)(sg * 32 + g) * 64 + p) * 2]; xi = ES[((size_t)(sg * 32 + g) * 64 + p) * 2 + 1]; }
    const float dsk = a.in[17][l * 512 + 16 * g + r];
    for (int ci = 0; ci < SSEGLEN / 16; ++ci) {
        const int t0 = sg * SSEGLEN + ci * 16;
        if (act) {
            const bf16x8 av = (q < 2) ? *(const bf16x8*)(Z + (size_t)(t0 + r) * NZ + 1024 + 16 * g + 8 * q) : zero8;
#pragma unroll
            for (int nt = 0; nt < 8; ++nt) { f32x4 acc = (f32x4){0.f, 0.f, 0.f, 0.f}; acc = MFMA16(av, bB[nt], acc);
#pragma unroll
                for (int gg = 0; gg < 4; ++gg) BU[(4 * q + gg) * 132 + 16 * nt + r] = acc[gg]; }
            wave_sync();
#pragma unroll
            for (int t = 0; t < 16; ++t) { const float br = BU[t * 132 + p], bi = BU[t * 132 + 64 + p];
                const float nr = ar * xr - ai * xi + br, ni = ar * xi + ai * xr + bi; xr = nr; xi = ni;
                if (PASS == 2) { X[t * 136 + p] = f2bf(xr); X[t * 136 + 64 + p] = f2bf(xi); } }
            wave_sync();
            if (PASS == 2) {
                f32x4 acc = (f32x4){0.f, 0.f, 0.f, 0.f};
#pragma unroll
                for (int kk = 0; kk < 4; ++kk) { const bf16x8 xv = *(const bf16x8*)(X + r * 136 + 32 * kk + 8 * q); acc = MFMA16(xv, cB[kk], acc); }
#pragma unroll
                for (int gg = 0; gg < 4; ++gg) { const int t = t0 + 4 * q + gg, c = 16 * g + r; const float u = bf2f(Z[(size_t)t * NZ + 1024 + c]);
                    YT[(4 * q + gg) * 136 + 16 * wave + r] = f2bf(gelu_tanh(acc[gg] + dsk * u)); }
            }
        }
        if (PASS == 2) {
            __syncthreads();
            if (tid < 128) { const int row = tid >> 3, c8 = (tid & 7) * 8; *(u32x4*)(YPRE + (size_t)(t0 + row) * 512 + 16 * g0 + 64 * hsel + c8) = *(const u32x4*)(YT + row * 136 + 64 * hsel + c8); }
            __syncthreads();
        }
    }
    if (PASS == 1 && act) { ES[((size_t)(sg * 32 + g) * 64 + p) * 2] = xr; ES[((size_t)(sg * 32 + g) * 64 + p) * 2 + 1] = xi; }
}

__device__ __forceinline__ void phase_scan(ArgsRef a, int tid, int bid, int G) {
    unsigned char* ws = a.ws;
    const int NT = G * 512, gt = bid * 512 + tid;
    for (int i = gt; i < 2 * 65536 + 8192 + 2048; i += NT) {
        if (i < 2 * 65536 + 8192) { const bool nx = i >= 2 * 65536; const int m = i >> 16, el = nx ? i - 2 * 65536 : (i & 65535), hrow = nx ? (el >> 4) : (el >> 7); const size_t str = nx ? 8192 : 65536;
            float* E = (float*)(ws + (nx ? OFF_EMX : (m == 0 ? OFF_EM : OFF_EH))); const float* Gd = (const float*)(ws + ((nx || m == 0) ? OFF_GM : OFF_GH));
            float ev[GSEG], gv[GSEG];
#pragma unroll
            for (int sg = 0; sg < GSEG; ++sg) { ev[sg] = E[(size_t)sg * str + el]; gv[sg] = Gd[sg * 512 + hrow]; }
            float cur = 0.f;
#pragma unroll
            for (int sg = 0; sg < GSEG; ++sg) { E[(size_t)sg * str + el] = cur; cur = gv[sg] * cur + ev[sg]; } }
        else { const int el = i - 2 * 65536 - 8192; float* E = (float*)(ws + OFF_ES); const float* ABAR = (const float*)(ws + OFF_ABAR);
            float pr = ABAR[el * 2], pi = ABAR[el * 2 + 1];
#pragma unroll
            for (int k = 0; k < 8; ++k) { const float nr = pr * pr - pi * pi, ni = 2.0f * pr * pi; pr = nr; pi = ni; }
            float xr = 0.f, xi = 0.f;
            for (int sb = 0; sb < SSEG; sb += 16) { float er[16], ei[16];
#pragma unroll
                for (int k = 0; k < 16; ++k) { er[k] = E[((size_t)(sb + k) * 2048 + el) * 2]; ei[k] = E[((size_t)(sb + k) * 2048 + el) * 2 + 1]; }
#pragma unroll
                for (int k = 0; k < 16; ++k) { E[((size_t)(sb + k) * 2048 + el) * 2] = xr; E[((size_t)(sb + k) * 2048 + el) * 2 + 1] = xi;
                    const float nr = pr * xr - pi * xi + er[k], ni = pr * xi + pi * xr + ei[k]; xr = nr; xi = ni; } } }
    }
}

template <int PASS>
__device__ __forceinline__ void phase_mixers(ArgsRef a, int l, int tid, int lane, int wave, int bid, int G) {
    for (int it = bid; it < 4 * GSEG; it += G) gla_item<0, PASS>(a, l, it % 4, it / 4, tid, lane, wave);
    asm volatile("" ::: "memory");
    for (int it = bid + ((4 * GSEG - bid % G) % G + G) % G * 0; it < 2 * 4 * GSEG; it += G) { if (it >= 4 * GSEG) gla_item<1, PASS>(a, l, (it - 4 * GSEG) % 4, (it - 4 * GSEG) / 4, tid, lane, wave); }
    __syncthreads();
    for (int it0 = bid * 8; it0 < 32 * SSEG; it0 += G * 8)
        for (int half = 0; half < 2; ++half) { const int it = it0 + wave; s5_item<PASS>(a, l, it % 32, it / 32, it0 % 32, tid, lane, wave, half); __syncthreads(); }
}

__device__ __forceinline__ void phase_post(ArgsRef a, int l, int lane, int gw, int GW) {
    const bf16_t* Z = (const bf16_t*)(a.ws + OFF_Z); const bf16_t* XC = (const bf16_t*)(a.ws + OFF_XC);
    bf16_t* OM = (bf16_t*)(a.ws + OFF_OM); bf16_t* OH = (bf16_t*)(a.ws + OFF_OH); const float* DEN = (const float*)(a.ws + OFF_DEN);
    const int c0 = lane * 8, hd = lane >> 4;
    float skp[8], nw[8];
#pragma unroll
    for (int j = 0; j < 8; ++j) { skp[j] = a.in[9][l * 512 + c0 + j]; nw[j] = a.in[20][l * 512 + c0 + j]; }
    for (int tb = gw * 4; tb < T; tb += GW * 4) {
        bf16x8 om[4], op[4], xc[4], oh[4], gp[4]; float dn[4];
#pragma unroll
        for (int k = 0; k < 4; ++k) { const size_t t = tb + k; om[k] = *(const bf16x8*)(OM + t * 512 + c0); op[k] = *(const bf16x8*)(Z + t * NZ + 512 + c0); xc[k] = *(const bf16x8*)(XC + t * 512 + c0);
            oh[k] = *(const bf16x8*)(OH + t * 512 + c0); gp[k] = *(const bf16x8*)(Z + t * NZ + 3072 + c0); dn[k] = DEN[hd * T + t]; }
#pragma unroll
        for (int k = 0; k < 4; ++k) { const size_t t = tb + k; const float di = __builtin_amdgcn_rcpf(fmaxf(fabsf(dn[k]), 1.0f)); float y[8], ov[8], ss = 0.f;
#pragma unroll
            for (int j = 0; j < 8; ++j) { y[j] = sigmoidf_(bf2f((bf16_t)op[k][j])) * (bf2f((bf16_t)om[k][j]) * di) + skp[j] * bf2f((bf16_t)xc[k][j]); ov[j] = bf2f((bf16_t)oh[k][j]); ss += ov[j] * ov[j]; }
            u32x4 w; w.x = pack2(y[0], y[1]); w.y = pack2(y[2], y[3]); w.z = pack2(y[4], y[5]); w.w = pack2(y[6], y[7]); *(u32x4*)(OM + t * 512 + c0) = w;
            ss += __shfl_xor(ss, 1); ss += __shfl_xor(ss, 2); ss += __shfl_xor(ss, 4); ss += __shfl_xor(ss, 8);
            const float rinv = rsqrtf(ss * (1.0f / 128.0f) + 1e-6f);
#pragma unroll
            for (int j = 0; j < 8; ++j) y[j] = ov[j] * rinv * nw[j] * siluf_(bf2f((bf16_t)gp[k][j]));
            u32x4 x; x.x = pack2(y[0], y[1]); x.y = pack2(y[2], y[3]); x.z = pack2(y[4], y[5]); x.w = pack2(y[6], y[7]); *(u32x4*)(OH + t * 512 + c0) = x; }
    }
}

__device__ __forceinline__ void ln_row(f32x4 (&v)[4], const float* gam, const float* bet, int lane) {
    float s = 0.f;
#pragma unroll
    for (int j = 0; j < 4; ++j) s += (v[j][0] + v[j][1]) + (v[j][2] + v[j][3]);
#pragma unroll
    for (int o = 32; o >= 1; o >>= 1) s += __shfl_xor(s, o);
    const float mean = s * (1.0f / 1024.0f); float qv = 0.f;
#pragma unroll
    for (int j = 0; j < 4; ++j) { const f32x4 dd = v[j] - mean; qv += (dd[0] * dd[0] + dd[1] * dd[1]) + (dd[2] * dd[2] + dd[3] * dd[3]); }
#pragma unroll
    for (int o = 32; o >= 1; o >>= 1) qv += __shfl_xor(qv, o);
    const float rstd = rsqrtf(qv * (1.0f / 1024.0f) + 1e-5f);
#pragma unroll
    for (int j = 0; j < 4; ++j) { const f32x4 gg = *(const f32x4*)(gam + 256 * j + 4 * lane), bb = *(const f32x4*)(bet + 256 * j + 4 * lane); v[j] = (v[j] - mean) * rstd * gg + bb; }
}

__device__ __forceinline__ void phase_ln1r(ArgsRef a, int l, int tid, int lane, int wave, int bid, int G) {
    float* XF = a.out; bf16_t* XB = (bf16_t*)(a.ws + OFF_XB);
    int* TOKE = (int*)(a.ws + OFF_TOKE); float* TOKG = (float*)(a.ws + OFF_TOKG); unsigned* HIST = (unsigned*)(a.ws + OFF_HIST);
    const float* RWT = (const float*)(a.ws + OFF_RWT); const float* RB = a.in[30];
    float* LG = (float*)(smem + wave * 4096);
    int* TE = (int*)(smem + wave * 4096 + 2304); float* TG = (float*)(smem + wave * 4096 + 2432); unsigned* HS = (unsigned*)(smem + wave * 4096 + 2560);
    const int r = lane & 15, q = lane >> 4, rs = lane >> 5, e = lane & 31;
    for (int tw = bid + G * wave; tw < T / 16; tw += G * 8) {
        const int t0 = tw * 16;
        for (int rb = 0; rb < 16; rb += 4) { f32x4 v[4][4];
#pragma unroll
            for (int k = 0; k < 4; ++k)
#pragma unroll
                for (int j = 0; j < 4; ++j) v[k][j] = *(const f32x4*)(XF + (size_t)(t0 + rb + k) * 1024 + 256 * j + 4 * lane);
#pragma unroll
            for (int k = 0; k < 4; ++k) { const int t = t0 + rb + k; ln_row(v[k], a.in[25] + l * 1024, a.in[26] + l * 1024, lane);
#pragma unroll
                for (int j = 0; j < 4; ++j) { *(f32x4*)(XF + (size_t)t * 1024 + 256 * j + 4 * lane) = v[k][j];
                    u32x2 w; w.x = pack2(v[k][j][0], v[k][j][1]); w.y = pack2(v[k][j][2], v[k][j][3]); *(u32x2*)(XB + (size_t)t * 1024 + 256 * j + 4 * lane) = w; } } }
        if (lane < 32) HS[lane] = 0u;
        asm volatile("s_waitcnt vmcnt(0) lgkmcnt(0)" ::: "memory"); __builtin_amdgcn_wave_barrier();
        f32x4 acc0 = (f32x4){0.f, 0.f, 0.f, 0.f}, acc1 = acc0;
        const float* xa = XF + (size_t)(t0 + r) * 1024 + 4 * q; const float* w0 = RWT + (size_t)r * 1024 + 4 * q; const float* w1 = RWT + (size_t)(16 + r) * 1024 + 4 * q;
#pragma unroll 8
        for (int s = 0; s < 64; ++s) { const f32x4 av = *(const f32x4*)(xa + 16 * s), b0 = *(const f32x4*)(w0 + 16 * s), b1 = *(const f32x4*)(w1 + 16 * s);
#pragma unroll
            for (int j = 0; j < 4; ++j) { acc0 = __builtin_amdgcn_mfma_f32_16x16x4f32(av[j], b0[j], acc0, 0, 0, 0); acc1 = __builtin_amdgcn_mfma_f32_16x16x4f32(av[j], b1[j], acc1, 0, 0, 0); } }
#pragma unroll
        for (int g = 0; g < 4; ++g) { LG[(4 * q + g) * 33 + r] = acc0[g]; LG[(4 * q + g) * 33 + 16 + r] = acc1[g]; }
        wave_sync();
        for (int pp = 0; pp < 8; ++pp) {
            const float lg = LG[(2 * pp + rs) * 33 + e];
            const float s = sigmoidf_(lg), sb = s + RB[e];
            float v4[4];
#pragma unroll
            for (int i = 0; i < 4; ++i) v4[i] = __shfl(sb, (lane & ~3) + i);
            int i1 = 0;
#pragma unroll
            for (int i = 1; i < 4; ++i) if (v4[i] > v4[i1]) i1 = i;
            int i2 = (i1 == 0) ? 1 : 0;
#pragma unroll
            for (int i = 0; i < 4; ++i) if (i != i1 && i != i2 && v4[i] > v4[i2]) i2 = i;
            float gs = v4[i1] + v4[i2]; int gid = e >> 2;
#pragma unroll
            for (int o = 4; o <= 16; o <<= 1) { const float os = __shfl_xor(gs, o); const int og = __shfl_xor(gid, o); if (os > gs || (os == gs && og < gid)) { gs = os; gid = og; } }
            float sv[4], sbv[4];
#pragma unroll
            for (int i = 0; i < 4; ++i) { sbv[i] = __shfl(sb, (lane & 32) + gid * 4 + i); sv[i] = __shfl(s, (lane & 32) + gid * 4 + i); }
            int j1 = 0;
#pragma unroll
            for (int i = 1; i < 4; ++i) if (sbv[i] > sbv[j1]) j1 = i;
            int j2 = (j1 == 0) ? 1 : 0;
#pragma unroll
            for (int i = 0; i < 4; ++i) if (i != j1 && i != j2 && sbv[i] > sbv[j2]) j2 = i;
            float s1 = sv[0], s2 = sv[0];
#pragma unroll
            for (int i = 1; i < 4; ++i) { if (i == j1) s1 = sv[i]; if (i == j2) s2 = sv[i]; }
            if (e == 0) { const int ti = 2 * pp + rs; const float inv = 1.0f / (s1 + s2);
                TE[ti * 2] = gid * 4 + j1; TE[ti * 2 + 1] = gid * 4 + j2; TG[ti * 2] = s1 * inv; TG[ti * 2 + 1] = s2 * inv;
                atomicAdd(&HS[gid * 4 + j1], 1u); atomicAdd(&HS[gid * 4 + j2], 1u); }
        }
        wave_sync();
        if (lane < 32) { TOKE[t0 * 2 + lane] = TE[lane]; TOKG[t0 * 2 + lane] = TG[lane]; HIST[tw * 32 + lane] = HS[lane]; }
        wave_sync();
    }
    __syncthreads();
}

__device__ __forceinline__ void phase_slot(ArgsRef a, int tid, int lane, int wave, int bid, int G) {
    const int* TOKE = (const int*)(a.ws + OFF_TOKE); int* TOKS = (int*)(a.ws + OFF_TOKS); const unsigned* HIST = (const unsigned*)(a.ws + OFF_HIST);
    unsigned* BASE = (unsigned*)(a.ws + OFF_CTL) + 64;
    const bf16_t* XB = (const bf16_t*)(a.ws + OFF_XB); bf16_t* XG = (bf16_t*)(a.ws + OFF_XG);
    unsigned* base = (unsigned*)smem; unsigned* pre = base + 40; int* el = (int*)(base + 80); int* sl = (int*)(base + 208); unsigned* red = base + 336;
    const int e = tid & 31, part = tid >> 5;
    for (int c = bid; c < T / 64; c += G) {
        unsigned tot = 0u, pr = 0u;
#pragma unroll 16
        for (int it = part; it < 1024; it += 16) { const unsigned v = HIST[it * 32 + e]; tot += v; pr += (it < 4 * c) ? v : 0u; }
        red[part * 32 + e] = tot; red[512 + part * 32 + e] = pr;
        __syncthreads();
        if (tid < 32) { unsigned t2 = 0u, p2 = 0u; for (int k = 0; k < 16; ++k) { t2 += red[k * 32 + tid]; p2 += red[512 + k * 32 + tid]; } pre[tid] = p2; red[tid] = (t2 + 255u) & ~255u; }
        __syncthreads();
        if (tid == 0) { unsigned sacc = 0; for (int k = 0; k < 32; ++k) { base[k] = sacc; sacc += red[k]; } base[32] = sacc; }
        int ee = 0;
        if (tid < 128) { ee = TOKE[c * 128 + tid]; el[tid] = ee; }
        __syncthreads();
        if (c == 0 && tid < 33) BASE[tid] = base[tid];
        if (tid < 128) { unsigned rank = 0; for (int i = 0; i < tid; ++i) rank += (el[i] == ee) ? 1u : 0u;
            const unsigned sidx = base[ee] + pre[ee] + rank; sl[tid] = (int)sidx; TOKS[c * 128 + tid] = (int)sidx; }
        __syncthreads();
        for (int ib = 0; ib < 16; ib += 8) { u32x4 ra[8], rb[8];
#pragma unroll
            for (int k = 0; k < 8; ++k) { const int i = wave + 8 * (ib + k), t = c * 64 + (i >> 1); ra[k] = *(const u32x4*)(XB + (size_t)t * 1024 + lane * 8); rb[k] = *(const u32x4*)(XB + (size_t)t * 1024 + 512 + lane * 8); }
#pragma unroll
            for (int k = 0; k < 8; ++k) { const int i = wave + 8 * (ib + k); const size_t so = (size_t)sl[i] * 1024; *(u32x4*)(XG + so + lane * 8) = ra[k]; *(u32x4*)(XG + so + 512 + lane * 8) = rb[k]; } }
        __syncthreads();
    }
}

__device__ __forceinline__ void phase_ln2(ArgsRef a, int l, int lane, int gw, int GW) {
    float* XF = a.out; bf16_t* XB = (bf16_t*)(a.ws + OFF_XB); const bf16_t* YS = (const bf16_t*)(a.ws + OFF_YS);
    const int* TOKS = (const int*)(a.ws + OFF_TOKS); const float* TOKG = (const float*)(a.ws + OFF_TOKG);
    for (int tb = gw * 4; tb < T; tb += GW * 4) {
        int sv = 0; float gv = 0.f; if (lane < 8) { sv = TOKS[tb * 2 + lane]; gv = TOKG[tb * 2 + lane]; }
        f32x4 v[4][4]; bf16x4 y0[4][4], y1[4][4]; float g0[4], g1[4];
#pragma unroll
        for (int k = 0; k < 4; ++k) { const int s0 = __shfl(sv, 2 * k), s1 = __shfl(sv, 2 * k + 1); g0[k] = __shfl(gv, 2 * k); g1[k] = __shfl(gv, 2 * k + 1);
#pragma unroll
            for (int j = 0; j < 4; ++j) { v[k][j] = *(const f32x4*)(XF + (size_t)(tb + k) * 1024 + 256 * j + 4 * lane);
                y0[k][j] = *(const bf16x4*)(YS + (size_t)s0 * 1024 + 256 * j + 4 * lane); y1[k][j] = *(const bf16x4*)(YS + (size_t)s1 * 1024 + 256 * j + 4 * lane); } }
#pragma unroll
        for (int k = 0; k < 4; ++k) {
#pragma unroll
            for (int j = 0; j < 4; ++j)
#pragma unroll
                for (int g = 0; g < 4; ++g) v[k][j][g] = DN_ALPHA * v[k][j][g] + g0[k] * bf2f((bf16_t)y0[k][j][g]) + g1[k] * bf2f((bf16_t)y1[k][j][g]);
            ln_row(v[k], a.in[27] + l * 1024, a.in[28] + l * 1024, lane);
#pragma unroll
            for (int j = 0; j < 4; ++j) { *(f32x4*)(XF + (size_t)(tb + k) * 1024 + 256 * j + 4 * lane) = v[k][j];
                u32x2 w; w.x = pack2(v[k][j][0], v[k][j][1]); w.y = pack2(v[k][j][2], v[k][j][3]); *(u32x2*)(XB + (size_t)(tb + k) * 1024 + 256 * j + 4 * lane) = w; } }
    }
}

struct SchedGrid {
    int nM, nN, G, c; const char* A; const char* B; size_t strideA, strideB;
    __device__ __forceinline__ bool next(int i, pg8::Unit& u) const { int pm, pn; if (!pg8::tile_order(i * G + c, nM, nN, pm, pn)) return false;
        u.pm = pm; u.pn = pn; u.tag = 0; u.A = A + (size_t)pm * strideA; u.B = B + (size_t)pn * strideB; return true; }
};
constexpr int GATES_LD = 3072;
template <int MODE> struct EpiBf16 {
    static constexpr bool PERM = true;
    bf16_t* O; int ldo; const bf16_t* Y; int ldy;
    __device__ __forceinline__ bool operator()(f32x4 (&acc)[2][2][4][2], const pg8::Unit& u, int wr, int wc, int fr, int fq) const {
#pragma unroll
        for (int ai = 0; ai < 2; ++ai) {
            bf16x8 yv[4][2];
            if (MODE == 2) {
#pragma unroll
                for (int m = 0; m < 4; ++m)
#pragma unroll
                    for (int bj = 0; bj < 2; ++bj) yv[m][bj] = *(const bf16x8*)(Y + ((size_t)u.pm * 256 + ai * 128 + wr * 64 + m * 16 + fr) * ldy + u.pn * 256 + bj * 128 + wc * 32 + 8 * fq);
            }
#pragma unroll
            for (int m = 0; m < 4; ++m) { const size_t row = (size_t)u.pm * 256 + ai * 128 + wr * 64 + m * 16 + fr;
#pragma unroll
                for (int bj = 0; bj < 2; ++bj) { const int col = u.pn * 256 + bj * 128 + wc * 32 + 8 * fq; f32x4 v0 = acc[ai][bj][m][0], v1 = acc[ai][bj][m][1];
                    if (MODE == 1) {
#pragma unroll
                        for (int j = 0; j < 4; ++j) { v0[j] = fmaxf(sigmoidf_(v0[j]), 1e-30f); v1[j] = fmaxf(sigmoidf_(v1[j]), 1e-30f); } }
                    if (MODE == 2) {
#pragma unroll
                        for (int j = 0; j < 4; ++j) { v0[j] = bf2f((bf16_t)yv[m][bj][j]) * sigmoidf_(v0[j]); v1[j] = bf2f((bf16_t)yv[m][bj][4 + j]) * sigmoidf_(v1[j]); } }
                    u32x4 w; w.x = pg8::cvt_pk_bf16(v0[0], v0[1]); w.y = pg8::cvt_pk_bf16(v0[2], v0[3]); w.z = pg8::cvt_pk_bf16(v1[0], v1[1]); w.w = pg8::cvt_pk_bf16(v1[2], v1[3]);
                    if (MODE == 1) *(u32x4*)(O + ((((size_t)u.pm * 12 + u.pn) * 16 + (ai * 8 + m * 2 + bj)) * 512 + ((wr * 4 + wc) * 64 + fq * 16 + fr)) * 8) = w;
                    else *(u32x4*)(O + row * ldo + col) = w; } }
        }
        return false;
    }
};
struct SchedZ {
    int G, c; const unsigned char* ws;
    __device__ __forceinline__ bool next(int i, pg8::Unit& u) const { int pm, pn; if (!pg8::tile_order(i * G + c, T / 256, 15, pm, pn)) return false;
        u.pm = pm; u.pn = pn; u.tag = 0; u.A = (const char*)(ws + OFF_XB) + (size_t)pm * 256 * 1024 * 2;
        u.B = (const char*)(ws + OFF_WIN) + (size_t)(pn < 14 ? pn * 256 : 6656) * 1024 * 2; return true; }
};
struct EpiZ {
    static constexpr bool PERM = true;
    bf16_t* Z; float* LI; float* LF; const float* bi; const float* bf;
    __device__ __forceinline__ bool operator()(f32x4 (&acc)[2][2][4][2], const pg8::Unit& u, int wr, int wc, int fr, int fq) const {
        if (u.pn < 14) {
#pragma unroll
            for (int ai = 0; ai < 2; ++ai)
#pragma unroll
                for (int m = 0; m < 4; ++m) { const size_t row = (size_t)u.pm * 256 + ai * 128 + wr * 64 + m * 16 + fr;
#pragma unroll
                    for (int bj = 0; bj < 2; ++bj) { const int col = u.pn * 256 + bj * 128 + wc * 32 + 8 * fq; const f32x4 v0 = acc[ai][bj][m][0], v1 = acc[ai][bj][m][1];
                        u32x4 w; w.x = pg8::cvt_pk_bf16(v0[0], v0[1]); w.y = pg8::cvt_pk_bf16(v0[2], v0[3]); w.z = pg8::cvt_pk_bf16(v1[0], v1[1]); w.w = pg8::cvt_pk_bf16(v1[2], v1[3]);
                        *(u32x4*)(Z + row * NZ + col) = w; } }
        } else if (wc == 0 && fq == 0) {
            const f32x4 b_i = *(const f32x4*)bi, b_f = *(const f32x4*)bf;
#pragma unroll
            for (int ai = 0; ai < 2; ++ai)
#pragma unroll
                for (int m = 0; m < 4; ++m) { const size_t row = (size_t)u.pm * 256 + ai * 128 + wr * 64 + m * 16 + fr; const f32x4 v0 = acc[ai][0][m][0] + b_i, v1 = acc[ai][0][m][1] + b_f;
                    f32x4 lf; lf[0] = logsigmoidf_(v1[0]); lf[1] = logsigmoidf_(v1[1]); lf[2] = logsigmoidf_(v1[2]); lf[3] = logsigmoidf_(v1[3]);
                    *(f32x4*)(LI + row * 4) = v0; *(f32x4*)(LF + row * 4) = lf; }
        }
        return false;
    }
};
__device__ __forceinline__ void phase_zgemm2(ArgsRef a, int l, int tid, int bid, int G) {
    SchedZ S{G, bid, a.ws}; EpiZ E{(bf16_t*)(a.ws + OFF_Z), (float*)(a.ws + OFF_LI), (float*)(a.ws + OFF_LF), a.in[7] + l * 4, a.in[8] + l * 4};
    pg8::gemm_phase((PG8_LAS unsigned char*)smem, tid, 1024, 1024, 1024, S, E);
}
__device__ __forceinline__ void phase_glu_gates(ArgsRef a, int l, int tid, int bid, int G) {
    { SchedGrid S{T / 256, 2, G, bid, (const char*)(a.ws + OFF_YPRE), (const char*)(a.ws + OFF_WGLU), (size_t)256 * 512 * 2, (size_t)256 * 512 * 2};
      EpiBf16<2> E{(bf16_t*)(a.ws + OFF_YSG), 512, (const bf16_t*)(a.ws + OFF_YPRE), 512};
      pg8::gemm_phase((PG8_LAS unsigned char*)smem, tid, 512, 512, 512, S, E); }
    asm volatile("" : "+v"(tid), "+s"(bid), "+s"(G));
    if (G > 128) { if (bid >= 128) phase_prepx(a, l, tid, bid - 128, G - 128, 0, 896); } else phase_prepx(a, l, tid, bid, G, 0, 896);
    asm volatile("" : "+v"(tid), "+s"(bid), "+s"(G));
    { SchedGrid S{T / 256, 12, G, (bid + G / 2) % G, (const char*)(a.ws + OFF_XB), (const char*)(a.ws + OFF_WIN + (size_t)NZ * 1024 * 2), (size_t)256 * 1024 * 2, (size_t)256 * 1024 * 2};
      EpiBf16<1> E{(bf16_t*)(a.ws + OFF_Z), GATES_LD, nullptr, 0};
      pg8::gemm_phase((PG8_LAS unsigned char*)smem, tid, 1024, 1024, 1024, S, E); }
}
struct SchedMerge {
    int G, c; const unsigned char* ws;
    __device__ __forceinline__ bool next(int i, pg8::Unit& u) const { const int b = i % 3; int pm, pn; if (!pg8::tile_order((i / 3) * G + c, T / 256, 4, pm, pn)) return false;
        u.pm = pm; u.pn = pn; u.tag = b; u.A = (const char*)(ws + (b == 0 ? OFF_OM : b == 1 ? OFF_YSG : OFF_OH)) + (size_t)pm * 256 * 512 * 2;
        u.B = (const char*)(ws + OFF_WB) + ((size_t)b * 1024 + pn * 256) * 512 * 2; return true; }
};
struct EpiMerge {
    static constexpr bool PERM = true;
    const bf16_t* GT; bf16_t* O;
    __device__ __forceinline__ bool operator()(f32x4 (&acc)[2][2][4][2], const pg8::Unit& u, int wr, int wc, int fr, int fq) const {
        const int b = u.tag;
#pragma unroll
        for (int ai = 0; ai < 2; ++ai)
#pragma unroll
        for (int mh = 0; mh < 2; ++mh) {
            bf16x8 gb[2][2], gn[2][2];
#pragma unroll
            for (int mm = 0; mm < 2; ++mm)
#pragma unroll
                for (int bj = 0; bj < 2; ++bj) { const bf16_t* gp = GT + ((((size_t)u.pm * 12 + b * 4 + u.pn) * 16 + (ai * 8 + (2 * mh + mm) * 2 + bj)) * 512 + ((wr * 4 + wc) * 64 + fq * 16 + fr)) * 8;
                    gb[mm][bj] = *(const bf16x8*)gp; gn[mm][bj] = (b < 2) ? *(const bf16x8*)(gp + (size_t)4 * 16 * 512 * 8) : gb[mm][bj]; }
#pragma unroll
            for (int mm = 0; mm < 2; ++mm) { const int m = 2 * mh + mm; const size_t row = (size_t)u.pm * 256 + ai * 128 + wr * 64 + m * 16 + fr;
#pragma unroll
                for (int bj = 0; bj < 2; ++bj) { const int col = u.pn * 256 + bj * 128 + wc * 32 + 8 * fq;
                    if (b < 2) {
#pragma unroll
                        for (int j = 0; j < 4; ++j) { acc[ai][bj][m][0][j] *= bf2f((bf16_t)gb[mm][bj][j]) * __builtin_amdgcn_rcpf(bf2f((bf16_t)gn[mm][bj][j])); acc[ai][bj][m][1][j] *= bf2f((bf16_t)gb[mm][bj][4 + j]) * __builtin_amdgcn_rcpf(bf2f((bf16_t)gn[mm][bj][4 + j])); } }
                    else { f32x4 v0 = acc[ai][bj][m][0], v1 = acc[ai][bj][m][1];
#pragma unroll
                        for (int j = 0; j < 4; ++j) { v0[j] *= bf2f((bf16_t)gb[mm][bj][j]); v1[j] *= bf2f((bf16_t)gb[mm][bj][4 + j]); }
                        u32x4 w; w.x = pg8::cvt_pk_bf16(v0[0], v0[1]); w.y = pg8::cvt_pk_bf16(v0[2], v0[3]); w.z = pg8::cvt_pk_bf16(v1[0], v1[1]); w.w = pg8::cvt_pk_bf16(v1[2], v1[3]);
                        *(u32x4*)(O + row * 1024 + col) = w; } } }
        }
        return b < 2;
    }
};
__device__ __forceinline__ void phase_merge2(ArgsRef a, int tid, int bid, int G) {
    SchedMerge S{G, bid, a.ws}; EpiMerge E{(const bf16_t*)(a.ws + OFF_Z), (bf16_t*)(a.ws + OFF_XB)};
    pg8::gemm_phase((PG8_LAS unsigned char*)smem, tid, 512, 512, 512, S, E);
}
struct EpiResid {
    static constexpr bool PERM = false;
    const float* xin; float* XF;
    __device__ __forceinline__ bool operator()(f32x4 (&acc)[2][2][4][2], const pg8::Unit& u, int wr, int wc, int fr, int fq) const {
#pragma unroll
        for (int ai = 0; ai < 2; ++ai)
#pragma unroll
        for (int mh = 0; mh < 2; ++mh) {
            f32x4 xv[2][2][2];
#pragma unroll
            for (int mm = 0; mm < 2; ++mm)
#pragma unroll
                for (int bj = 0; bj < 2; ++bj)
#pragma unroll
                    for (int n = 0; n < 2; ++n) xv[mm][bj][n] = *(const f32x4*)(xin + ((size_t)u.pm * 256 + ai * 128 + wr * 64 + (2 * mh + mm) * 16 + fr) * 1024 + u.pn * 256 + bj * 128 + wc * 32 + 16 * n + 4 * fq);
#pragma unroll
            for (int mm = 0; mm < 2; ++mm)
#pragma unroll
                for (int bj = 0; bj < 2; ++bj)
#pragma unroll
                    for (int n = 0; n < 2; ++n) { const int m = 2 * mh + mm; const size_t o = ((size_t)u.pm * 256 + ai * 128 + wr * 64 + m * 16 + fr) * 1024 + u.pn * 256 + bj * 128 + wc * 32 + 16 * n + 4 * fq; *(f32x4*)(XF + o) = DN_ALPHA * xv[mm][bj][n] + acc[ai][bj][m][n]; }
        }
        return false;
    }
};
__device__ __forceinline__ void phase_wout2(ArgsRef a, int l, int tid, int bid, int G) {
    SchedGrid S{T / 256, 4, G, bid, (const char*)(a.ws + OFF_XB), (const char*)(a.ws + OFF_WOUT), (size_t)256 * 1024 * 2, (size_t)256 * 1024 * 2};
    EpiResid E{(l == 0) ? a.in[0] : a.out, a.out};
    pg8::gemm_phase((PG8_LAS unsigned char*)smem, tid, 1024, 1024, 1024, S, E);
}
struct EpiQKV {
    static constexpr bool PERM = true;
    int vcall; bf16_t* Q; bf16_t* KH; bf16_t* V; const float* LI;
    __device__ __forceinline__ bool operator()(f32x4 (&acc)[2][2][4][2], const pg8::Unit& u, int wr, int wc, int fr, int fq) const {
        const int which = vcall ? 2 : (u.pn >> 1); bf16_t* O = Q + (size_t)which * (SZ_ACT / 2);
        float liv[2][4][2];
#pragma unroll
        for (int ai = 0; ai < 2; ++ai)
#pragma unroll
            for (int m = 0; m < 4; ++m)
#pragma unroll
                for (int bj = 0; bj < 2; ++bj) liv[ai][m][bj] = (which == 1) ? LI[((size_t)u.pm * 256 + ai * 128 + wr * 64 + m * 16 + fr) * 4 + (u.pn & 1) * 2 + bj] : 0.f;
#pragma unroll
        for (int ai = 0; ai < 2; ++ai)
#pragma unroll
            for (int m = 0; m < 4; ++m) { const size_t row = (size_t)u.pm * 256 + ai * 128 + wr * 64 + m * 16 + fr;
#pragma unroll
                for (int bj = 0; bj < 2; ++bj) { const int hd = (u.pn & 1) * 2 + bj, col = hd * 128 + wc * 32 + 8 * fq;
                    const float sc = which == 0 ? 0.08838834764831845f : which == 1 ? fexp(liv[ai][m][bj]) : 1.0f;
                    const f32x4 v0 = acc[ai][bj][m][0] * sc, v1 = acc[ai][bj][m][1] * sc;
                    u32x4 w; w.x = pg8::cvt_pk_bf16(v0[0], v0[1]); w.y = pg8::cvt_pk_bf16(v0[2], v0[3]); w.z = pg8::cvt_pk_bf16(v1[0], v1[1]); w.w = pg8::cvt_pk_bf16(v1[2], v1[3]);
                    *(u32x4*)(O + row * 512 + col) = w; } }
        return false;
    }
};
__device__ __forceinline__ void phase_mprep2(ArgsRef a, int l, int tid, int bid, int G) {
    const bf16_t* Z = (const bf16_t*)(a.ws + OFF_Z); bf16_t* XC = (bf16_t*)(a.ws + OFF_XC);
    const float* cw = a.in[2] + (size_t)l * 4 * 512; const float* cb = a.in[3] + (size_t)l * 512;
    for (int idx = bid * 512 + tid; idx < (T / 8) * 64; idx += G * 512) {
        const int tb = (idx / 64) * 8, c0 = (idx % 64) * 8;
        bf16x8 xr[11];
#pragma unroll
        for (int k = 0; k < 11; ++k) { const int ts = tb - 3 + k; xr[k] = (ts >= 0) ? *(const bf16x8*)(Z + (size_t)ts * NZ + c0) : (bf16x8){0, 0, 0, 0, 0, 0, 0, 0}; }
        float w[4][8], b[8];
#pragma unroll
        for (int j = 0; j < 8; ++j) { b[j] = cb[c0 + j];
#pragma unroll
            for (int k = 0; k < 4; ++k) w[k][j] = cw[k * 512 + c0 + j]; }
#pragma unroll
        for (int tt = 0; tt < 8; ++tt) { float acc[8];
#pragma unroll
            for (int j = 0; j < 8; ++j) { acc[j] = b[j];
#pragma unroll
                for (int k = 0; k < 4; ++k) acc[j] += w[k][j] * bf2f((bf16_t)xr[tt + k][j]); }
            u32x4 o; o.x = pack2(siluf_(acc[0]), siluf_(acc[1])); o.y = pack2(siluf_(acc[2]), siluf_(acc[3])); o.z = pack2(siluf_(acc[4]), siluf_(acc[5])); o.w = pack2(siluf_(acc[6]), siluf_(acc[7]));
            *(u32x4*)(XC + (size_t)(tb + tt) * 512 + c0) = o; }
    }
}

__device__ __forceinline__ void phase_v_conv(ArgsRef a, int l, int tid, int bid, int G) {
    if (G > 128 && bid >= 128) { phase_mprep2(a, l, tid, bid - 128, G - 128); return; }
    { SchedGrid S{T / 256, 2, G, bid, (const char*)(a.ws + OFF_Z), (const char*)(a.ws + OFF_WQKV + (size_t)1024 * 512 * 2), (size_t)256 * NZ * 2, (size_t)256 * 512 * 2};
      EpiQKV E{1, (bf16_t*)(a.ws + OFF_Q), (bf16_t*)(a.ws + OFF_KH), (bf16_t*)(a.ws + OFF_V), (const float*)(a.ws + OFF_LI)};
      pg8::gemm_phase((PG8_LAS unsigned char*)smem, tid, 512, NZ, 512, S, E); }
    if (G <= 128) { asm volatile("" : "+v"(tid), "+s"(bid), "+s"(G)); phase_mprep2(a, l, tid, bid, G); }
}
__device__ __forceinline__ void phase_qk(ArgsRef a, int tid, int bid, int G) {
    SchedGrid S{T / 256, 4, G, bid, (const char*)(a.ws + OFF_XC), (const char*)(a.ws + OFF_WQKV), (size_t)256 * 512 * 2, (size_t)256 * 512 * 2};
    EpiQKV E{0, (bf16_t*)(a.ws + OFF_Q), (bf16_t*)(a.ws + OFF_KH), (bf16_t*)(a.ws + OFF_V), (const float*)(a.ws + OFF_LI)};
    pg8::gemm_phase((PG8_LAS unsigned char*)smem, tid, 512, 512, 512, S, E);
}
struct SchedMoE {
    int down, G, c; const unsigned char* ws; const unsigned* BASE;
    __device__ __forceinline__ bool next(int i, pg8::Unit& u) const { const int per = down ? 4 : 2, L = i * G + c, ntile = (int)(BASE[32] >> 8); if (L >= ntile * per) return false;
        const int tile = L / per, sub = L % per; int e = 0; while (e < 31 && BASE[e + 1] <= (unsigned)(tile * 256)) ++e;
        u.pm = tile; u.pn = sub; u.tag = e;
        if (!down) { u.A = (const char*)(ws + OFF_XG) + (size_t)tile * 256 * 1024 * 2; u.B = (const char*)(ws + OFF_WGU) + ((size_t)e * 512 + sub * 256) * 1024 * 2; }
        else { u.A = (const char*)(ws + OFF_H) + (size_t)tile * 256 * 256 * 2; u.B = (const char*)(ws + OFF_WD) + ((size_t)e * 1024 + sub * 256) * 256 * 2; }
        return true; }
};
struct EpiH {
    static constexpr bool PERM = true;
    bf16_t* H;
    __device__ __forceinline__ bool operator()(f32x4 (&acc)[2][2][4][2], const pg8::Unit& u, int wr, int wc, int fr, int fq) const {
#pragma unroll
        for (int ai = 0; ai < 2; ++ai)
#pragma unroll
            for (int m = 0; m < 4; ++m) { const size_t row = (size_t)u.pm * 256 + ai * 128 + wr * 64 + m * 16 + fr; f32x4 v0, v1;
#pragma unroll
                for (int j = 0; j < 4; ++j) { v0[j] = siluf_(acc[ai][0][m][0][j]) * acc[ai][1][m][0][j]; v1[j] = siluf_(acc[ai][0][m][1][j]) * acc[ai][1][m][1][j]; }
                u32x4 w; w.x = pg8::cvt_pk_bf16(v0[0], v0[1]); w.y = pg8::cvt_pk_bf16(v0[2], v0[3]); w.z = pg8::cvt_pk_bf16(v1[0], v1[1]); w.w = pg8::cvt_pk_bf16(v1[2], v1[3]);
                *(u32x4*)(H + row * 256 + u.pn * 128 + wc * 32 + 8 * fq) = w; }
        return false;
    }
};
__device__ __forceinline__ void phase_moe_gu2(ArgsRef a, int l, int tid, int bid, int G) {
    { SchedMoE S{0, G, bid, a.ws, (const unsigned*)(a.ws + OFF_CTL) + 64}; EpiH E{(bf16_t*)(a.ws + OFF_H)};
      pg8::gemm_phase((PG8_LAS unsigned char*)smem, tid, 1024, 1024, 1024, S, E); }
    if (l + 1 < NLAYER) {
        asm volatile("" : "+v"(tid), "+s"(bid), "+s"(G));
        const int ntile = (int)(((const unsigned*)(a.ws + OFF_CTL))[64 + 32] >> 8); int nb = ntile * 2 - G; nb = nb < 0 ? 0 : (nb > G - 1 ? G - 1 : nb);
        if (bid >= nb) phase_prep(a, l + 1, tid, bid - nb, G - nb);
    }
}
__device__ __forceinline__ void phase_moe_dn2(ArgsRef a, int tid, int bid, int G) {
    SchedMoE S{1, G, bid, a.ws, (const unsigned*)(a.ws + OFF_CTL) + 64}; EpiBf16<0> E{(bf16_t*)(a.ws + OFF_YS), 1024, nullptr, 0};
    pg8::gemm_phase((PG8_LAS unsigned char*)smem, tid, 256, 256, 256, S, E);
}
#define XB_TMO      128
#define XB_XCNT(j)  (256  + 64 * (j))
#define XB_XSUB(j)  (1280 + 64 * (j))
#define XB_XGEN(j)  (2304 + 64 * (j))
#define XB_TOP      3328
#define XB_TOPGEN   3392
#define XCD_BAR_WORDS 3456
#define XB_SPIN_CAP (1u << 22)
__device__ __forceinline__ unsigned xb_ld(unsigned* p)              { return __hip_atomic_load(p, __ATOMIC_RELAXED, __HIP_MEMORY_SCOPE_AGENT); }
__device__ __forceinline__ unsigned xb_add(unsigned* p, unsigned v) { return __hip_atomic_fetch_add(p, v, __ATOMIC_RELAXED, __HIP_MEMORY_SCOPE_AGENT); }
__device__ __forceinline__ unsigned xb_xcc_id() { return (unsigned)__builtin_amdgcn_s_getreg((3 << 11) | 20) & 0xFu; }
#define XB_SPIN(cond, bar) do { unsigned _sp = 0; while (cond) { __builtin_amdgcn_s_sleep(1); \
    if ((++_sp & 255u) == 0u) { if (xb_ld(&(bar)[XB_TMO])) break; if (_sp > XB_SPIN_CAP) { atomicAdd(&(bar)[XB_TMO], 1u); break; } } } } while (0)
__device__ __forceinline__ void xcd_barrier_complete(unsigned* bar, unsigned x, unsigned& nloc, unsigned& nx) {
    const unsigned G = gridDim.x; unsigned sum, cnt, mine, sp = 0u;
    for (;;) { sum = 0u; cnt = 0u; mine = 0u;
#pragma unroll
        for (unsigned j = 0; j < 16; ++j) { const unsigned c = xb_ld(&bar[XB_XCNT(j)]); sum += c; cnt += (c > 0u) ? 1u : 0u; mine = (j == x) ? c : mine; }
        if (sum == G) break;
        __builtin_amdgcn_s_sleep(1);
        if ((++sp & 255u) == 0u) { if (xb_ld(&bar[XB_TMO])) break; if (sp > XB_SPIN_CAP) { atomicAdd(&bar[XB_TMO], 1u); break; } } }
    nloc = mine > 0u ? mine : 1u; nx = cnt > 0u ? cnt : 1u;
}
__device__ __forceinline__ void xcd_barrier(unsigned* bar, volatile __attribute__((address_space(3))) unsigned* st) {
    asm volatile("s_waitcnt vmcnt(0)" ::: "memory");
    __syncthreads();
    if (threadIdx.x == 0) {
        __builtin_amdgcn_s_waitcnt(0);
        const unsigned x = xb_xcc_id();
        unsigned nloc = st[0], nx = st[1];
        if (nloc == 0u) { xcd_barrier_complete(bar, x, nloc, nx); st[0] = nloc; st[1] = nx; }
        const unsigned old = xb_add(&bar[XB_XSUB(x)], 1u);
        const unsigned gen = old / nloc;
        if (old + 1u == (gen + 1u) * nloc) {
            __builtin_amdgcn_fence(__ATOMIC_RELEASE, "agent");
            asm volatile("s_waitcnt vmcnt(0)" ::: "memory");
            const unsigned og = xb_add(&bar[XB_TOP], 1u);
            const unsigned tg = og / nx;
            if (og + 1u == (tg + 1u) * nx) xb_add(&bar[XB_TOPGEN], 1u);
            else XB_SPIN(xb_ld(&bar[XB_TOPGEN]) == tg, bar);
            __builtin_amdgcn_fence(__ATOMIC_ACQUIRE, "agent");
            xb_add(&bar[XB_XGEN(x)], 1u);
            asm volatile("s_waitcnt vmcnt(0)" ::: "memory");
        } else {
            XB_SPIN(xb_ld(&bar[XB_XGEN(x)]) == gen, bar);
            __builtin_amdgcn_fence(__ATOMIC_ACQUIRE, "agent");
            asm volatile("s_waitcnt vmcnt(0)" ::: "memory");
        }
    }
    __syncthreads();
}

__device__ __forceinline__ ArgsRef fresh_args() { unsigned long long p = (unsigned long long)__builtin_amdgcn_kernarg_segment_ptr(); asm volatile("" : "+s"(p)); return *(const __attribute__((address_space(4))) Args*)p; }
__global__ void __launch_bounds__(512) fwd(Args a_unused) {
    cg::grid_group grid = cg::this_grid();
    volatile __attribute__((address_space(3))) unsigned* bst = (volatile __attribute__((address_space(3))) unsigned*)((__attribute__((address_space(3))) unsigned char*)smem + 131072);
    if (threadIdx.x < 4) bst[threadIdx.x] = 0u;
    __syncthreads();
    { ArgsRef a0 = fresh_args(); if (threadIdx.x == 0) (void)xb_add(&((unsigned*)(a0.ws + OFF_BAR))[XB_XCNT(xb_xcc_id())], 1u); }
#define GSYNC() do { asm volatile("" ::: "memory"); { ArgsRef ab = fresh_args(); xcd_barrier((unsigned*)(ab.ws + OFF_BAR), bst); } asm volatile("" ::: "memory"); } while (0)
#define GSYNC_CG() do { asm volatile("" ::: "memory"); grid.sync(); asm volatile("" ::: "memory"); } while (0)
    const int wave_s = __builtin_amdgcn_readfirstlane((int)threadIdx.x >> 6);
#define PH(body) do { int wave = wave_s; asm volatile("" : "+s"(wave)); int lane; asm volatile("v_mbcnt_lo_u32_b32 %0, -1, 0\n\tv_mbcnt_hi_u32_b32 %0, -1, %0" : "=v"(lane)); \
        int bid = blockIdx.x, G = gridDim.x; asm volatile("" : "+s"(bid), "+s"(G)); \
        const int tid = wave * 64 + lane, gw = bid * 8 + wave, GW = G * 8; (void)tid; (void)gw; (void)GW; ArgsRef a = fresh_args(); body; } while (0)
#pragma unroll 1
    for (int l = 0; l < NLAYER; ++l) {
        if (l == 0) { PH(phase_prep(a, 0, tid, bid, G)); GSYNC_CG(); }
        PH(phase_zgemm2(a, l, tid, bid, G)); GSYNC();
        PH(phase_v_conv(a, l, tid, bid, G)); GSYNC();
        PH(phase_qk(a, tid, bid, G)); GSYNC();
        PH(phase_mixers<1>(a, l, tid, lane, wave, bid, G)); GSYNC();
        PH(phase_scan(a, tid, bid, G)); GSYNC();
        PH(phase_mixers<2>(a, l, tid, lane, wave, bid, G)); GSYNC();
        PH(phase_glu_gates(a, l, tid, bid, G)); PH(phase_prepx(a, l, tid, bid, G, 896, 4608)); GSYNC();
        PH(phase_merge2(a, tid, bid, G)); GSYNC();
        PH(phase_wout2(a, l, tid, bid, G)); GSYNC();
        PH(phase_ln1r(a, l, tid, lane, wave, bid, G)); PH(phase_prepx(a, l, tid, bid, G, 4608, 6144)); GSYNC();
        PH(phase_slot(a, tid, lane, wave, bid, G)); GSYNC();
        PH(phase_moe_gu2(a, l, tid, bid, G)); GSYNC();
        PH(phase_moe_dn2(a, tid, bid, G)); GSYNC();
        PH(phase_ln2(a, l, lane, gw, GW)); if (l + 1 < NLAYER) GSYNC();
    }
}

extern "C" void kernel_launch(void* const* d_in, const int* in_sizes, int n_in, void* d_out, int out_size, void* d_ws, size_t ws_size, hipStream_t stream) {
    static int grid = 0;
    if (grid == 0) {
        if (n_in != 34 || out_size != T * D || ws_size < WS_TOTAL) { fprintf(stderr, "kernel_launch: unexpected shapes (n_in %d, out %d, ws %zu, need %zu)\n", n_in, out_size, ws_size, (size_t)WS_TOTAL); grid = -1; return; }
        int dev = 0, cus = 0, per_cu = 0;
        (void)hipGetDevice(&dev); (void)hipDeviceGetAttribute(&cus, hipDeviceAttributeMultiprocessorCount, dev);
        (void)hipFuncSetAttribute((const void*)fwd, hipFuncAttributeMaxDynamicSharedMemorySize, LDS_BYTES);
        (void)hipOccupancyMaxActiveBlocksPerMultiprocessor(&per_cu, (const void*)fwd, 512, LDS_BYTES);
        if (per_cu < 1) { fprintf(stderr, "kernel_launch: occupancy query says %d blocks per CU\n", per_cu); per_cu = 1; }
        grid = (cus > 0 ? cus : 256) * 1;
        (void)hipGetLastError();
    }
    if (grid < 0) return;
    Args a{};
    for (int i = 0; i < 34; ++i) a.in[i] = (const float*)d_in[i];
    a.out = (float*)d_out; a.ws = (unsigned char*)d_ws; a.ph_lo = 0; a.ph_hi = NLAYER * NPH;
    (void)hipMemsetAsync((unsigned char*)d_ws + OFF_BAR, 0, 16384, stream);
    void* args[] = {&a};
    hipError_t e = hipLaunchCooperativeKernel((const void*)fwd, dim3(grid), dim3(512), args, LDS_BYTES, stream);
    if (e != hipSuccess) fprintf(stderr, "kernel_launch: cooperative launch failed: %s (grid %d)\n", hipGetErrorString(e), grid);
}
```

```cpp
#include <hip/hip_runtime.h>
#include <hip/hip_cooperative_groups.h>
#include <cstdio>
#include <cstdint>
namespace cg = cooperative_groups;

typedef unsigned short bf16_t;
typedef short bf16x8 __attribute__((ext_vector_type(8)));
typedef short bf16x4 __attribute__((ext_vector_type(4)));
typedef float f32x4 __attribute__((ext_vector_type(4)));
typedef unsigned u32x4 __attribute__((ext_vector_type(4)));
typedef unsigned u32x2 __attribute__((ext_vector_type(2)));

constexpr int T = 16384, D = 1024, NZ = 3584, NWIN = 6912, INW = 6664;
constexpr int NPH = 15, NLAYER = 2;
constexpr int GSEG = 32, GSEGLEN = 512;
constexpr int SSEG = 64, SSEGLEN = 256;
constexpr int SLOTS = 40960;
constexpr float DN_ALPHA = 1.41421356237f;
constexpr int LDS_BYTES = 131072 + 256;

constexpr size_t AL(size_t x) { return (x + 255) & ~(size_t)255; }
constexpr size_t OFF_WIN = 0;
constexpr size_t OFF_WQKV = OFF_WIN + AL((size_t)NWIN * 1024 * 2);
constexpr size_t OFF_WGLU = OFF_WQKV + AL((size_t)1536 * 512 * 2);
constexpr size_t OFF_WB = OFF_WGLU + AL((size_t)512 * 512 * 2);
constexpr size_t OFF_WOUT = OFF_WB + AL((size_t)3 * 1024 * 512 * 2);
constexpr size_t OFF_ABAR = OFF_WOUT + AL((size_t)1024 * 1024 * 2);
constexpr size_t OFF_BBT = OFF_ABAR + AL((size_t)32 * 64 * 2 * 4);
constexpr size_t OFF_CCT = OFF_BBT + AL((size_t)32 * 128 * 16 * 2);
constexpr size_t OFF_CTL = OFF_CCT + AL((size_t)32 * 16 * 128 * 2);
constexpr size_t OFF_TOKE = OFF_CTL + 4096;
constexpr size_t OFF_TOKG = OFF_TOKE + AL((size_t)T * 2 * 4);
constexpr size_t OFF_TOKS = OFF_TOKG + AL((size_t)T * 2 * 4);
constexpr size_t OFF_SLOTT = OFF_TOKS + AL((size_t)T * 2 * 4);
constexpr size_t OFF_XB = OFF_SLOTT + AL((size_t)SLOTS * 4);
constexpr size_t OFF_R1 = OFF_XB + AL((size_t)T * 1024 * 2);
constexpr size_t SZ_ACT = (size_t)T * 512 * 2;
constexpr size_t OFF_XC = OFF_R1, OFF_Q = OFF_R1 + SZ_ACT, OFF_KH = OFF_R1 + 2 * SZ_ACT, OFF_V = OFF_R1 + 3 * SZ_ACT;
constexpr size_t OFF_WGU = OFF_R1, OFF_WD = OFF_R1 + (size_t)32 * 512 * 1024 * 2;
constexpr size_t OFF_Z = OFF_R1 + 4 * SZ_ACT;
constexpr size_t OFF_XG = OFF_Z, OFF_H = OFF_Z + (size_t)SLOTS * 1024 * 2;
constexpr size_t OFF_ZS = OFF_Z + AL((size_t)T * NZ * 2);
constexpr size_t OFF_LF = OFF_ZS + AL((size_t)T * 8 * 4);
constexpr size_t OFF_LI = OFF_LF + AL((size_t)T * 4 * 4);
constexpr size_t OFF_E = OFF_LI + AL((size_t)T * 4 * 4);
constexpr size_t OFF_OM = OFF_E, OFF_OH = OFF_E + SZ_ACT, OFF_YPRE = OFF_E + 2 * SZ_ACT, OFF_YSG = OFF_E + 3 * SZ_ACT;
constexpr size_t OFF_DEN = OFF_E + 4 * SZ_ACT;
constexpr size_t OFF_EM = OFF_DEN + AL((size_t)T * 4 * 4);
constexpr size_t OFF_EMX = OFF_EM + AL((size_t)GSEG * 4 * 128 * 128 * 4);
constexpr size_t OFF_GM = OFF_EMX + AL((size_t)GSEG * 4 * 128 * 16 * 4);
constexpr size_t OFF_EH = OFF_GM + AL((size_t)GSEG * 4 * 128 * 4);
constexpr size_t OFF_GH = OFF_EH + AL((size_t)GSEG * 4 * 128 * 128 * 4);
constexpr size_t OFF_ES = OFF_GH + AL((size_t)GSEG * 4 * 128 * 4);
constexpr size_t WS_END = OFF_ES + AL((size_t)SSEG * 32 * 64 * 2 * 4);
constexpr size_t OFF_YS = OFF_E;
constexpr size_t OFF_RWT = WS_END;
constexpr size_t OFF_HIST = OFF_RWT + 32 * 1024 * 4;
constexpr size_t OFF_BAR = OFF_HIST + 1024 * 32 * 4;
constexpr size_t WS_TOTAL = OFF_BAR + 16384;
static_assert(OFF_YS + (size_t)SLOTS * 1024 * 2 <= WS_END, "YS must fit in the dead region");
static_assert(OFF_H + (size_t)SLOTS * 256 * 2 <= OFF_ZS, "H must fit in the dead Z region");
static_assert(OFF_WD + (size_t)32 * 1024 * 256 * 2 <= OFF_Z, "expert weights must fit in R1");

struct Args { const float* in[34]; float* out; unsigned char* ws; int ph_lo, ph_hi; };
typedef const __attribute__((address_space(4))) Args& ArgsRef;

extern __shared__ __attribute__((aligned(16))) unsigned char smem[];

__device__ __forceinline__ bf16_t f2bf(float f) { return __builtin_bit_cast(unsigned short, (__bf16)f); }
__device__ __forceinline__ float bf2f(bf16_t b) { return __uint_as_float(((unsigned)b) << 16); }
__device__ __forceinline__ unsigned pack2(float lo, float hi) { typedef __bf16 bf2_t __attribute__((ext_vector_type(2))); bf2_t v; v[0] = (__bf16)lo; v[1] = (__bf16)hi; return __builtin_bit_cast(unsigned, v); }
__device__ __forceinline__ float fexp(float x) { return __builtin_amdgcn_exp2f(x * 1.4426950408889634f); }
__device__ __forceinline__ float flog(float x) { return __builtin_amdgcn_logf(x) * 0.6931471805599453f; }
__device__ __forceinline__ float sigmoidf_(float x) { return __builtin_amdgcn_rcpf(1.0f + fexp(-x)); }
__device__ __forceinline__ float siluf_(float x) { return x * __builtin_amdgcn_rcpf(1.0f + fexp(-x)); }
__device__ __forceinline__ float logsigmoidf_(float x) { return fminf(x, 0.f) - log1pf(expf(-fabsf(x))); }
__device__ __forceinline__ float gelu_tanh(float y) { const float z = 0.7978845608028654f * (y + 0.044715f * y * y * y); const float th = 1.0f - 2.0f * __builtin_amdgcn_rcpf(fexp(2.0f * z) + 1.0f); return 0.5f * y * (1.0f + th); }
__device__ __forceinline__ void wave_sync() { __builtin_amdgcn_wave_barrier(); asm volatile("s_waitcnt lgkmcnt(0)" ::: "memory"); __builtin_amdgcn_wave_barrier(); }

#define MFMA16(a, b, c) __builtin_amdgcn_mfma_f32_16x16x32_bf16((a), (b), (c), 0, 0, 0)

template <int MT, int NT, class FA, class FB>
__device__ __forceinline__ void wave_gemm(f32x4 (&acc)[MT][NT], int K, FA arow, FB brow, int lane) {
    const int r = lane & 15, q = lane >> 4;
    const bf16_t* ap[MT]; const bf16_t* bp[NT];
#pragma unroll
    for (int m = 0; m < MT; ++m) ap[m] = arow(m * 16 + r) + 8 * q;
#pragma unroll
    for (int n = 0; n < NT; ++n) bp[n] = brow(n * 16 + r) + 8 * q;
#pragma unroll 1
    for (int k = 0; k < K; k += 32) {
        bf16x8 a[MT], b[NT];
#pragma unroll
        for (int m = 0; m < MT; ++m) a[m] = *(const bf16x8*)(ap[m] + k);
#pragma unroll
        for (int n = 0; n < NT; ++n) b[n] = *(const bf16x8*)(bp[n] + k);
#pragma unroll
        for (int m = 0; m < MT; ++m)
#pragma unroll
            for (int n = 0; n < NT; ++n) acc[m][n] = MFMA16(a[m], b[n], acc[m][n]);
    }
}
template <int MT, int NT> __device__ __forceinline__ void zero_acc(f32x4 (&acc)[MT][NT]) {
#pragma unroll
    for (int m = 0; m < MT; ++m)
#pragma unroll
        for (int n = 0; n < NT; ++n) acc[m][n] = (f32x4){0.f, 0.f, 0.f, 0.f};
}

namespace pg8 {
#define PG8_LAS __attribute__((address_space(3)))
constexpr int BM = 256, BK = 64, HALF = 128, HTB = HALF * BK * 2, STAGE_BYTES = 8 * HTB;
__device__ __forceinline__ int lds_byte(int r, int c) { const int st = (r >> 4) * 2 + (c >> 5), rr = r & 15, cc = c & 31, ob = rr * 64 + cc * 2; return st * 1024 + (ob ^ (((ob >> 9) & 1) << 5)); }
__device__ __forceinline__ void stage_rc(int b, int& R, int& C) { const int st = b / 1024, sb = b % 1024, swz = sb ^ (((sb >> 9) & 1) << 5); R = (st >> 1) * 16 + swz / 64; C = (st & 1) * 32 + (swz % 64) / 2; }
__device__ __forceinline__ int perm32(int rho) { const int n = rho >> 4, i = rho & 15; return 8 * (i >> 2) + 4 * n + (i & 3); }
struct Unit { int pm, pn, tag; const char* A; const char* B; };
__device__ __forceinline__ unsigned cvt_pk_bf16(float lo, float hi) { unsigned r; asm volatile("v_cvt_pk_bf16_f32 %0, %1, %2" : "=v"(r) : "v"(lo), "v"(hi)); return r; }
__device__ __forceinline__ bool tile_order(int L, int nM, int nN, int& pm, int& pn) {
    const int nwg = nM * nN; if (L >= nwg) return false;
    int wgid = L; { const int q = nwg / 8, r = nwg % 8, xcd = wgid % 8, off = wgid / 8; wgid = (xcd < r ? xcd * (q + 1) : r * (q + 1) + (xcd - r) * q) + off; }
    const int nig = 8 * nN, gid = wgid / nig, fm = gid * 8, gsz = (nM - fm) < 8 ? (nM - fm) : 8;
    pm = fm + ((wgid % nig) % gsz); pn = (wgid % nig) / gsz; return true;
}
template <class Epi, class Sched>
__device__ __forceinline__ void gemm_phase(PG8_LAS unsigned char* lds, const int tid, const int K, const int lda, const int ldb, const Sched& S, const Epi& E) {
    const int wid = __builtin_amdgcn_readfirstlane(tid >> 6), lane = tid & 63, wr = wid >> 2, wc = wid & 3, fr = lane & 15, fq = lane >> 4;
    const int nt = K / BK;
    unsigned voffA[2], voffB[2];
#pragma unroll
    for (int i = 0; i < 2; ++i) { int R, C; stage_rc(tid * 16 + i * 8192, R, C); const int Rb = Epi::PERM ? ((R & ~31) + perm32(R & 31)) : R;
        voffA[i] = (unsigned)(R * lda + C) * 2u; voffB[i] = (unsigned)(Rb * ldb + C) * 2u; }
    const size_t kstep = (size_t)(BK * 2), hstepA = (size_t)HALF * lda * 2, hstepB = (size_t)HALF * ldb * 2;
    const unsigned ldsw = (unsigned)wid * 1024u;
    const int aoff = lds_byte(wr * 64 + fr, fq * 8), boff = lds_byte(wc * 32 + fr, fq * 8);
#define PG8_SA(b, h) (((b) * 2 + (h)) * HTB)
#define PG8_SB(b, h) ((4 + (b) * 2 + (h)) * HTB)
#define PG8_STAGE(bufoff, gbase, voff) do { _Pragma("unroll") for (int _i = 0; _i < 2; ++_i) \
        __builtin_amdgcn_global_load_lds((const unsigned*)((const char*)(gbase) + (voff)[_i]), (PG8_LAS unsigned*)(lds + (bufoff) + ldsw + _i * 8192), 16, 0, 0); } while (0)
#define PG8_LDA(dst, b, h) do { _Pragma("unroll") for (int m = 0; m < 4; ++m) _Pragma("unroll") for (int k = 0; k < 2; ++k) dst[m][k] = *(const PG8_LAS bf16x8*)(lds + PG8_SA(b, h) + aoff + m * 2048 + k * 1024); } while (0)
#define PG8_LDB(dst, b, h) do { _Pragma("unroll") for (int n = 0; n < 2; ++n) _Pragma("unroll") for (int k = 0; k < 2; ++k) dst[n][k] = *(const PG8_LAS bf16x8*)(lds + PG8_SB(b, h) + boff + n * 2048 + k * 1024); } while (0)
#define PG8_MMA(ai, bj, At, Bt) do { __builtin_amdgcn_s_setprio(1); _Pragma("unroll") for (int m = 0; m < 4; ++m) _Pragma("unroll") for (int n = 0; n < 2; ++n) _Pragma("unroll") for (int k = 0; k < 2; ++k) \
        acc[ai][bj][m][n] = __builtin_amdgcn_mfma_f32_16x16x32_bf16(Bt[n][k], At[m][k], acc[ai][bj][m][n], 0, 0, 0); __builtin_amdgcn_s_setprio(0); } while (0)
#define PG8_WAIT_V(n) asm volatile("s_waitcnt vmcnt(" #n ")" ::: "memory")
#define PG8_WAIT_L(n) asm volatile("s_waitcnt lgkmcnt(" #n ")" ::: "memory")
#define PG8_BAR __builtin_amdgcn_s_barrier()
#define PG8_SCHED __builtin_amdgcn_sched_barrier(0)
    Unit cur, nxt; int ui = 0;
    if (!S.next(0, cur)) return;
    f32x4 acc[2][2][4][2];
#pragma unroll
    for (int a = 0; a < 2; ++a)
#pragma unroll
        for (int b = 0; b < 2; ++b)
#pragma unroll
            for (int m = 0; m < 4; ++m)
#pragma unroll
                for (int n = 0; n < 2; ++n) acc[a][b][m][n] = (f32x4){0.f, 0.f, 0.f, 0.f};
    bf16x8 At[4][2], B0[2][2], B1[2][2];
    const char* cA = cur.A; const char* cB = cur.B;
    PG8_STAGE(PG8_SB(0, 0), cB, voffB); PG8_STAGE(PG8_SA(0, 0), cA, voffA); PG8_STAGE(PG8_SB(0, 1), cB + hstepB, voffB); PG8_STAGE(PG8_SA(0, 1), cA + hstepA, voffA);
    if (wr == 1) PG8_BAR;
    PG8_WAIT_V(4); PG8_BAR;
    PG8_STAGE(PG8_SB(1, 0), cB + kstep, voffB); PG8_STAGE(PG8_SA(1, 0), cA + kstep, voffA); PG8_STAGE(PG8_SB(1, 1), cB + hstepB + kstep, voffB);
    PG8_WAIT_V(6); PG8_BAR;
    for (;;) {
        const bool has_next = S.next(ui + 1, nxt);
        const char* nA = has_next ? nxt.A : cA; const char* nB = has_next ? nxt.B : cB;
        for (int t = 0; t < nt; t += 2) {
            const bool last = (t == nt - 2);
            const char* a1 = cA + (size_t)(t + 1) * kstep;
            const char* a2 = last ? nA : cA + (size_t)(t + 2) * kstep; const char* b2 = last ? nB : cB + (size_t)(t + 2) * kstep;
            const char* a3 = a2 + kstep; const char* b3 = b2 + kstep;
            PG8_LDB(B0, 0, 0); PG8_SCHED; PG8_LDA(At, 0, 0); PG8_STAGE(PG8_SA(1, 1), a1 + hstepA, voffA);
            PG8_WAIT_L(8); PG8_BAR; PG8_WAIT_L(0); PG8_MMA(0, 0, At, B0); PG8_BAR; PG8_SCHED;
            PG8_LDB(B1, 0, 1); PG8_STAGE(PG8_SB(0, 0), b2, voffB);
            PG8_BAR; PG8_WAIT_L(0); PG8_MMA(0, 1, At, B1); PG8_BAR;
            PG8_LDA(At, 0, 1); PG8_STAGE(PG8_SA(0, 0), a2, voffA);
            PG8_BAR; PG8_WAIT_L(0); PG8_MMA(1, 0, At, B0); PG8_BAR; PG8_SCHED;
            PG8_STAGE(PG8_SB(0, 1), b2 + hstepB, voffB);
            PG8_WAIT_V(6); PG8_BAR; PG8_MMA(1, 1, At, B1); PG8_BAR;
            PG8_LDB(B0, 1, 0); PG8_SCHED; PG8_LDA(At, 1, 0); PG8_STAGE(PG8_SA(0, 1), a2 + hstepA, voffA);
            PG8_WAIT_L(8); PG8_BAR; PG8_WAIT_L(0); PG8_MMA(0, 0, At, B0); PG8_BAR; PG8_SCHED;
            PG8_LDB(B1, 1, 1); PG8_STAGE(PG8_SB(1, 0), b3, voffB);
            PG8_BAR; PG8_WAIT_L(0); PG8_MMA(0, 1, At, B1); PG8_BAR;
            PG8_LDA(At, 1, 1); PG8_STAGE(PG8_SA(1, 0), a3, voffA);
            PG8_BAR; PG8_WAIT_L(0); PG8_MMA(1, 0, At, B0); PG8_BAR; PG8_SCHED;
            PG8_STAGE(PG8_SB(1, 1), b3 + hstepB, voffB);
            PG8_WAIT_V(6); PG8_BAR; PG8_MMA(1, 1, At, B1); PG8_BAR;
        }
        const bool keep = E(acc, cur, wr, wc, fr, fq);
        if (!has_next) break;
        if (!keep) {
#pragma unroll
            for (int a = 0; a < 2; ++a)
#pragma unroll
                for (int b = 0; b < 2; ++b)
#pragma unroll
                    for (int m = 0; m < 4; ++m)
#pragma unroll
                        for (int n = 0; n < 2; ++n) acc[a][b][m][n] = (f32x4){0.f, 0.f, 0.f, 0.f};
        }
        cur = nxt; cA = nA; cB = nB; ++ui;
    }
    PG8_WAIT_V(0);
    if (wr == 0) PG8_BAR;
    PG8_BAR;
#undef PG8_SA
#undef PG8_SB
#undef PG8_STAGE
#undef PG8_LDA
#undef PG8_LDB
#undef PG8_MMA
#undef PG8_WAIT_V
#undef PG8_WAIT_L
#undef PG8_BAR
#undef PG8_SCHED
}
}

__device__ __forceinline__ void tconv_tile(const float* src, int ld_src, int nvalid, bf16_t* dst, int ld_dst, int tid) {
    float* t = (float*)smem;
    { const int r = tid >> 3, c0 = (tid & 7) * 8; float v[8];
      if (nvalid == 64) { const f32x4 a0 = *(const f32x4*)(src + (size_t)r * ld_src + c0), a1 = *(const f32x4*)(src + (size_t)r * ld_src + c0 + 4);
          v[0] = a0[0]; v[1] = a0[1]; v[2] = a0[2]; v[3] = a0[3]; v[4] = a1[0]; v[5] = a1[1]; v[6] = a1[2]; v[7] = a1[3]; }
      else {
#pragma unroll
          for (int j = 0; j < 8; ++j) { const int c = c0 + j; v[j] = (c < nvalid) ? src[(size_t)r * ld_src + c] : 0.f; } }
#pragma unroll
      for (int j = 0; j < 8; ++j) t[(c0 + j) * 65 + r] = v[j]; }
    __syncthreads();
    { const int n = tid >> 3, k0 = (tid & 7) * 8; const float* p = t + n * 65 + k0;
      u32x4 w; w.x = pack2(p[0], p[1]); w.y = pack2(p[2], p[3]); w.z = pack2(p[4], p[5]); w.w = pack2(p[6], p[7]);
      *(u32x4*)(dst + (size_t)n * ld_dst + k0) = w; }
    __syncthreads();
}

__device__ __forceinline__ void wave_tconv(const float* src, int ld_src, bf16_t* dst, int ld_dst, int lane, float* t  ) {
    f32x4 v[16]; const int rq = lane >> 4, c4 = (lane & 15) * 4;
#pragma unroll
    for (int i = 0; i < 16; ++i) v[i] = *(const f32x4*)(src + (size_t)(4 * i + rq) * ld_src + c4);
#pragma unroll
    for (int i = 0; i < 16; ++i)
#pragma unroll
        for (int j = 0; j < 4; ++j) t[(c4 + j) * 65 + 4 * i + rq] = v[i][j];
    wave_sync();
    const float* p = t + lane * 65;
#pragma unroll
    for (int i = 0; i < 8; ++i) { u32x4 w; w.x = pack2(p[8 * i], p[8 * i + 1]); w.y = pack2(p[8 * i + 2], p[8 * i + 3]); w.z = pack2(p[8 * i + 4], p[8 * i + 5]); w.w = pack2(p[8 * i + 6], p[8 * i + 7]);
        *(u32x4*)(dst + (size_t)lane * ld_dst + 8 * i) = w; }
    wave_sync();
}
__device__ __forceinline__ void wave_prepx_tile(ArgsRef a, int l, int u, int lane, float* t) {
    bf16_t* WGU = (bf16_t*)(a.ws + OFF_WGU); bf16_t* WD = (bf16_t*)(a.ws + OFF_WD);
    if (u < 4096) { const int up = u >= 2048, v = u & 2047, e = v / 64, w = v % 64, nt = w / 16, kt = w % 16, j0 = nt * 64, drow = (j0 / 128) * 256 + (j0 % 128) + up * 128;
        wave_tconv(a.in[31 + up] + ((size_t)(l * 32 + e) * 1024 + kt * 64) * 256 + nt * 64, 256, WGU + ((size_t)e * 512 + drow) * 1024 + kt * 64, 1024, lane, t); }
    else { const int v = u - 4096, e = v / 64, w = v % 64, nt = w / 4, kt = w % 4;
        wave_tconv(a.in[33] + ((size_t)(l * 32 + e) * 256 + kt * 64) * 1024 + nt * 64, 1024, WD + ((size_t)e * 1024 + nt * 64) * 256 + kt * 64, 256, lane, t); }
}
__device__ __forceinline__ void phase_prep(ArgsRef a, int l, int tid, int bid, int G) {
    unsigned char* ws = a.ws;
    bf16_t* WIN = (bf16_t*)(ws + OFF_WIN); bf16_t* WQKV = (bf16_t*)(ws + OFF_WQKV); bf16_t* WGLU = (bf16_t*)(ws + OFF_WGLU);
    bf16_t* WB = (bf16_t*)(ws + OFF_WB); bf16_t* WOUT = (bf16_t*)(ws + OFF_WOUT);
    for (int u = bid; u < 2624; u += G) {
        const float* src; int lds_ = 0, nvalid = 64, ldd = 0; bf16_t* dst;
        if (u < 1728) { const int nt = u / 16, kt = u % 16, p0 = nt * 64; int sc;
            if (p0 < 1024) sc = p0; else if (p0 < 6656) sc = p0 + 8; else if (p0 == 6656) { sc = 1024; nvalid = 8; } else { sc = 0; nvalid = 0; }
            src = a.in[1] + (size_t)l * 1024 * INW + (size_t)(kt * 64) * INW + sc; lds_ = INW; dst = WIN + (size_t)p0 * 1024 + kt * 64; ldd = 1024; }
        else if (u < 1920) { const int v = u - 1728, nt = v / 8, kt = v % 8, which = nt / 8, h = (nt % 8) / 2;
            if ((kt >> 1) != h) nvalid = 0;
            src = a.in[4 + which] + (size_t)(l * 4 + h) * 128 * 128 + ((kt & 1) * 64) * 128 + (nt & 1) * 64; lds_ = 128; dst = WQKV + (size_t)(nt * 64) * 512 + kt * 64; ldd = 512; }
        else if (u < 1984) { const int v = u - 1920, nt = v / 8, kt = v % 8;
            src = a.in[18] + (size_t)l * 512 * 512 + (kt * 64) * 512 + nt * 64; lds_ = 512; dst = WGLU + (size_t)(nt * 64) * 512 + kt * 64; ldd = 512; }
        else if (u < 2368) { const int v = u - 1984, b = v / 128, w = v % 128, nt = w / 8, kt = w % 8;
            src = a.in[21 + b] + (size_t)l * 512 * 1024 + (size_t)(kt * 64) * 1024 + nt * 64; lds_ = 1024; dst = WB + (size_t)b * 1024 * 512 + (size_t)(nt * 64) * 512 + kt * 64; ldd = 512; }
        else { const int v = u - 2368, nt = v / 16, kt = v % 16;
            src = a.in[24] + (size_t)l * 1024 * 1024 + (size_t)(kt * 64) * 1024 + nt * 64; lds_ = 1024; dst = WOUT + (size_t)(nt * 64) * 1024 + kt * 64; ldd = 1024; }
        tconv_tile(src, lds_, nvalid, dst, ldd, tid);
    }
    float* ABAR = (float*)(ws + OFF_ABAR); bf16_t* BBT = (bf16_t*)(ws + OFF_BBT); bf16_t* CCT = (bf16_t*)(ws + OFF_CCT);
    for (int i = bid * 512 + tid; i < 2048; i += G * 512) {
        const int g = i / 64, p = i % 64; const size_t gp = (size_t)(l * 32 + g) * 64 + p;
        const float lr = fminf(a.in[10][gp], -1e-4f), li = a.in[11][gp], dt = expf(a.in[12][l * 32 + g]);
        const float mag = expf(lr * dt), abr = mag * cosf(li * dt), abi = mag * sinf(li * dt);
        const float nr = abr - 1.0f, den = lr * lr + li * li, cr = (nr * lr + abi * li) / den, ci = (abi * lr - nr * li) / den;
        ABAR[(g * 64 + p) * 2] = abr; ABAR[(g * 64 + p) * 2 + 1] = abi;
        for (int c = 0; c < 16; ++c) { const float br = a.in[13][gp * 16 + c], bi = a.in[14][gp * 16 + c];
            BBT[(size_t)(g * 128 + p) * 16 + c] = f2bf(cr * br - ci * bi); BBT[(size_t)(g * 128 + 64 + p) * 16 + c] = f2bf(cr * bi + ci * br);
            const size_t ci_ = ((size_t)(l * 32 + g) * 16 + c) * 64 + p;
            CCT[(size_t)(g * 16 + c) * 128 + p] = f2bf(a.in[15][ci_]); CCT[(size_t)(g * 16 + c) * 128 + 64 + p] = f2bf(-a.in[16][ci_]); }
    }
    if (l == 0) { float* RWT = (float*)(ws + OFF_RWT); const float* RW = a.in[29]; for (int i = bid * 512 + tid; i < 32 * 1024; i += G * 512) RWT[i] = RW[(i & 1023) * 32 + (i >> 10)]; }
    if (l == 0) { bf16_t* XB = (bf16_t*)(ws + OFF_XB); const float* x = a.in[0];
        for (size_t i = (size_t)bid * 512 + tid; i < (size_t)T * 1024 / 8; i += (size_t)G * 512) {
            const f32x4 v0 = *(const f32x4*)(x + i * 8), v1 = *(const f32x4*)(x + i * 8 + 4);
            u32x4 w; w.x = pack2(v0[0], v0[1]); w.y = pack2(v0[2], v0[3]); w.z = pack2(v1[0], v1[1]); w.w = pack2(v1[2], v1[3]); *(u32x4*)(XB + i * 8) = w; } }
}

__device__ __forceinline__ void phase_prepx(ArgsRef a, int l, int tid, int bid, int G, int u_lo, int u_hi) {
    bf16_t* WGU = (bf16_t*)(a.ws + OFF_WGU); bf16_t* WD = (bf16_t*)(a.ws + OFF_WD);
    for (int u = u_lo + bid; u < u_hi; u += G) {
        const float* src; int lds_, ldd; bf16_t* dst;
        if (u < 4096) { const int up = u >= 2048, v = u & 2047, e = v / 64, w = v % 64, nt = w / 16, kt = w % 16, j0 = nt * 64, drow = (j0 / 128) * 256 + (j0 % 128) + up * 128;
            src = a.in[31 + up] + ((size_t)(l * 32 + e) * 1024 + kt * 64) * 256 + nt * 64; lds_ = 256; dst = WGU + ((size_t)e * 512 + drow) * 1024 + kt * 64; ldd = 1024; }
        else { const int v = u - 4096, e = v / 64, w = v % 64, nt = w / 4, kt = w % 4;
            src = a.in[33] + ((size_t)(l * 32 + e) * 256 + kt * 64) * 1024 + nt * 64; lds_ = 1024; dst = WD + ((size_t)e * 1024 + nt * 64) * 256 + kt * 64; ldd = 256; }
        tconv_tile(src, lds_, 64, dst, ldd, tid);
    }
}

constexpr int GL_RQ = 0, GL_RK = 17408, GL_VT = 34816, GL_RO = 57856, GL_RX = 75264, GL_KT = 92672, GL_PS = 102912, GL_SC1 = 105472, GL_SC2 = 105984, GL_GT = 106496, GL_OS = 108544, GL_LFS = 117248, GL_DNS = 117504;
template <int MODE, int PASS>
__device__ __forceinline__ void gla_item(ArgsRef a, int l, int h, int sg, int tid, int lane, int wave) {
    unsigned char* ws = a.ws;
    const bf16_t* Z = (const bf16_t*)(ws + OFF_Z); const bf16_t* Qg = (const bf16_t*)(ws + OFF_Q); const bf16_t* Kg = (const bf16_t*)(ws + OFF_KH); const bf16_t* Vg = (const bf16_t*)(ws + OFF_V); const bf16_t* XCg = (const bf16_t*)(ws + OFF_XC);
    const float* LF = (const float*)(ws + OFF_LF);
    float* Eg = (float*)(ws + (MODE == 0 ? OFF_EM : OFF_EH)); float* Gg = (float*)(ws + (MODE == 0 ? OFF_GM : OFF_GH)); float* EX = (float*)(ws + OFF_EMX);
    bf16_t* Yg = (bf16_t*)(ws + (MODE == 0 ? OFF_OM : OFF_OH));
    bf16_t* KT = (bf16_t*)(smem + GL_KT); bf16_t* PS = (bf16_t*)(smem + GL_PS);
    float* SC1 = (float*)(smem + GL_SC1); float* SC2 = (float*)(smem + GL_SC2); float* GT = (float*)(smem + GL_GT); bf16_t* OS = (bf16_t*)(smem + GL_OS); float* DNS = (float*)(smem + GL_DNS);
    const int r = lane & 15, q = lane >> 4, grp = tid >> 7, d = tid & 127, tok = tid >> 4, c8 = (tid & 15) * 8;
    const bool xw = (MODE == 0) && (wave == 0);
    float lb = 0.f;
    if (MODE == 1 && l == 1) { const float h0 = a.in[19][h * 128 + d], h1 = a.in[19][512 + h * 128 + d]; lb = 1.0f / (1.0f + expf(h0 - h1)); }
    f32x4 S[8], SX[8];
#pragma unroll
    for (int i = 0; i < 8; ++i) { S[i] = (f32x4){0.f, 0.f, 0.f, 0.f}; SX[i] = (f32x4){0.f, 0.f, 0.f, 0.f}; }
    if (PASS == 2) {
#pragma unroll
        for (int i = 0; i < 8; ++i)
#pragma unroll
            for (int g = 0; g < 4; ++g) { const size_t row = (size_t)(sg * 4 + h) * 128 + 16 * i + 4 * q + g; S[i][g] = Eg[row * 128 + 16 * wave + r]; if (xw) SX[i][g] = EX[row * 16 + r]; }
    }
    const bf16x8 z8 = (bf16x8){0, 0, 0, 0, 0, 0, 0, 0};
    bf16x8 rq = z8, rk = z8, rv = z8, ro = z8, rx = z8; float lfv = 0.f;
#define GLA_FETCH(t0_) do { const size_t tk = (size_t)((t0_) + tok); \
        if (MODE == 1) { const bf16_t* zp = Z + tk * NZ + h * 128 + c8; if (PASS == 2) { rq = *(const bf16x8*)(zp + 1536); ro = *(const bf16x8*)(zp + 3072); } rk = *(const bf16x8*)(zp + 2048); rv = *(const bf16x8*)(zp + 2560); } \
        else { const size_t o_ = tk * 512 + h * 128 + c8; if (PASS == 2) { rq = *(const bf16x8*)(Qg + o_); ro = *(const bf16x8*)(Z + tk * NZ + 512 + h * 128 + c8); rx = *(const bf16x8*)(XCg + o_); } \
               rk = *(const bf16x8*)(Kg + o_); rv = *(const bf16x8*)(Vg + o_); if (tid < 32) lfv = LF[((t0_) + tid) * 4 + h]; } } while (0)
    GLA_FETCH(sg * GSEGLEN);
    float sk8[8], nw8[8];
#pragma unroll
    for (int j = 0; j < 8; ++j) { sk8[j] = (MODE == 0 && PASS == 2) ? a.in[9][l * 512 + h * 128 + c8 + j] : 0.f; nw8[j] = (MODE == 1 && PASS == 2) ? a.in[20][l * 512 + h * 128 + c8 + j] : 0.f; }
    __syncthreads();
    if (MODE == 0) { for (int i = tid; i < 2 * 16 * 40; i += 512) { const int b = i / 640, k = i % 640; ((bf16_t*)(smem + GL_VT + b * 11520))[128 * 40 + k] = (k < 32) ? (bf16_t)0x3F80 : (bf16_t)0; } }
#define GLA_STORE(tprev, pb) do { const bf16x8 o8 = *(const bf16x8*)(OS + tok * 136 + c8); const bf16x8 p8 = *(const bf16x8*)((const bf16_t*)(smem + GL_RO + (pb) * 8704) + tok * 136 + c8); float y[8]; \
        if (MODE == 0) { const bf16x8 x8 = *(const bf16x8*)((const bf16_t*)(smem + GL_RX + (pb) * 8704) + tok * 136 + c8); const float di = __builtin_amdgcn_rcpf(fmaxf(fabsf(DNS[tok]), 1.0f)); \
            _Pragma("unroll") for (int j = 0; j < 8; ++j) y[j] = sigmoidf_(bf2f((bf16_t)p8[j])) * (bf2f((bf16_t)o8[j]) * di) + sk8[j] * bf2f((bf16_t)x8[j]); } \
        else { float ov[8], ss = 0.f; _Pragma("unroll") for (int j = 0; j < 8; ++j) { ov[j] = bf2f((bf16_t)o8[j]); ss += ov[j] * ov[j]; } \
            ss += __shfl_xor(ss, 1); ss += __shfl_xor(ss, 2); ss += __shfl_xor(ss, 4); ss += __shfl_xor(ss, 8); const float rinv = rsqrtf(ss * (1.0f / 128.0f) + 1e-6f); \
            _Pragma("unroll") for (int j = 0; j < 8; ++j) y[j] = ov[j] * rinv * nw8[j] * siluf_(bf2f((bf16_t)p8[j])); } \
        u32x4 w_; w_.x = pack2(y[0], y[1]); w_.y = pack2(y[2], y[3]); w_.z = pack2(y[4], y[5]); w_.w = pack2(y[6], y[7]); *(u32x4*)(Yg + (size_t)((tprev) + tok) * 512 + h * 128 + c8) = w_; } while (0)
    float runb = 0.f;
    for (int ci = 0; ci < GSEGLEN / 32; ++ci) {
        const int t0 = sg * GSEGLEN + ci * 32, buf = ci & 1;
        bf16_t* RQ = (bf16_t*)(smem + GL_RQ + buf * 8704); bf16_t* RK = (bf16_t*)(smem + GL_RK + buf * 8704); bf16_t* VT = (bf16_t*)(smem + GL_VT + buf * 11520);
        float* LFS = (float*)(smem + GL_LFS + buf * 128);
        if (PASS == 2) { *(bf16x8*)(RQ + tok * 136 + c8) = rq; *(bf16x8*)((bf16_t*)(smem + GL_RO + buf * 8704) + tok * 136 + c8) = ro; if (MODE == 0) *(bf16x8*)((bf16_t*)(smem + GL_RX + buf * 8704) + tok * 136 + c8) = rx; }
        *(bf16x8*)(RK + tok * 136 + c8) = rk;
#pragma unroll
        for (int j = 0; j < 8; ++j) VT[(c8 + j) * 40 + tok] = (bf16_t)rv[j];
        if (MODE == 0 && tid < 32) LFS[tid] = lfv;
        if (ci + 1 < GSEGLEN / 32) GLA_FETCH(t0 + 32);
        __syncthreads();
        float lg[8], kv[8];
#pragma unroll
        for (int j = 0; j < 8; ++j) { const float kr = bf2f(RK[(grp * 8 + j) * 136 + d]);
            if (MODE == 1) { const float f = lb + (1.0f - lb) * sigmoidf_(kr); lg[j] = flog(f); kv[j] = 1.0f - f; } else { lg[j] = LFS[grp * 8 + j]; kv[j] = kr; } }
        float cs[8]; cs[0] = lg[0];
#pragma unroll
        for (int j = 1; j < 8; ++j) cs[j] = cs[j - 1] + lg[j];
        GT[grp * 128 + d] = cs[7];
        __syncthreads();
        if (PASS == 2 && ci > 0) GLA_STORE(t0 - 32, buf ^ 1);
        const float g0 = GT[d], g1 = GT[128 + d], g2 = GT[256 + d], g3 = GT[384 + d];
        const float off = grp == 0 ? 0.f : grp == 1 ? g0 : grp == 2 ? g0 + g1 : g0 + g1 + g2;
        const float bmid = g0 + g1, bL = bmid + g2 + g3;
        bf16_t ktv[8];
#pragma unroll
        for (int j = 0; j < 8; ++j) { const float bt = off + cs[j], ek = fexp(bmid - bt); const bf16_t kt = f2bf(kv[j] * ek); ktv[j] = kt;
            if (PASS == 2) { const float qr = bf2f(RQ[(grp * 8 + j) * 136 + d]); const float qq = (MODE == 1) ? siluf_(qr) : qr; RQ[(grp * 8 + j) * 136 + d] = f2bf(qq * __builtin_amdgcn_rcpf(ek)); RK[(grp * 8 + j) * 136 + d] = kt; } }
        { u32x4 w; w.x = ktv[0] | ((unsigned)ktv[1] << 16); w.y = ktv[2] | ((unsigned)ktv[3] << 16); w.z = ktv[4] | ((unsigned)ktv[5] << 16); w.w = ktv[6] | ((unsigned)ktv[7] << 16); *(u32x4*)(KT + d * 40 + grp * 8) = w; }
        if (grp == 0) { SC1[d] = fexp(bmid); SC2[d] = fexp(bL - bmid); runb += bL; }
        __syncthreads();
        if (PASS == 2) {
            if (wave < 4) {
                const int ti = (wave == 1 || wave == 2) ? 1 : 0, tj = (wave >= 2) ? 1 : 0;
                f32x4 p = (f32x4){0.f, 0.f, 0.f, 0.f};
                if (wave < 3) {
#pragma unroll
                    for (int kk = 0; kk < 4; ++kk) { const bf16x8 av = *(const bf16x8*)(RQ + (16 * ti + r) * 136 + 32 * kk + 8 * q); const bf16x8 bv = *(const bf16x8*)(RK + (16 * tj + r) * 136 + 32 * kk + 8 * q); p = MFMA16(av, bv, p); }
                }
#pragma unroll
                for (int g = 0; g < 4; ++g) { const int t = 16 * ti + 4 * q + g, s_ = 16 * tj + r; PS[t * 40 + s_] = (wave < 3 && s_ <= t) ? f2bf(p[g]) : (bf16_t)0; }
            }
            __syncthreads();
        }
        const bf16x8 bV = *(const bf16x8*)(VT + (16 * wave + r) * 40 + 8 * q);
        bf16x8 bV1 = bV; if (xw) bV1 = *(const bf16x8*)(VT + (128 + r) * 40 + 8 * q);
        f32x4 o[2], ox[2];
        o[0] = o[1] = ox[0] = ox[1] = (f32x4){0.f, 0.f, 0.f, 0.f};
#pragma unroll
        for (int kk = 0; kk < 4; ++kk) {
            const f32x4 sa = *(const f32x4*)(SC1 + 32 * kk + 4 * q), sb = *(const f32x4*)(SC1 + 32 * kk + 16 + 4 * q);
            S[2 * kk] *= sa; S[2 * kk + 1] *= sb;
            if (xw) { SX[2 * kk] *= sa; SX[2 * kk + 1] *= sb; }
            if (PASS == 2) {
                bf16x8 bS, bX;
#pragma unroll
                for (int g = 0; g < 4; ++g) { bS[g] = (short)f2bf(S[2 * kk][g]); bS[4 + g] = (short)f2bf(S[2 * kk + 1][g]); bX[g] = (short)f2bf(SX[2 * kk][g]); bX[4 + g] = (short)f2bf(SX[2 * kk + 1][g]); }
#pragma unroll
                for (int mt = 0; mt < 2; ++mt) { const bf16x4 lo = *(const bf16x4*)(RQ + (16 * mt + r) * 136 + 32 * kk + 4 * q), hi = *(const bf16x4*)(RQ + (16 * mt + r) * 136 + 32 * kk + 16 + 4 * q);
                    bf16x8 av; av[0] = lo[0]; av[1] = lo[1]; av[2] = lo[2]; av[3] = lo[3]; av[4] = hi[0]; av[5] = hi[1]; av[6] = hi[2]; av[7] = hi[3];
                    o[mt] = MFMA16(av, bS, o[mt]); if (xw) ox[mt] = MFMA16(av, bX, ox[mt]); }
            }
        }
        if (PASS == 2) {
#pragma unroll
            for (int mt = 0; mt < 2; ++mt) { const bf16x8 av = *(const bf16x8*)(PS + (16 * mt + r) * 40 + 8 * q); o[mt] = MFMA16(av, bV, o[mt]); if (xw) ox[mt] = MFMA16(av, bV1, ox[mt]);
#pragma unroll
                for (int g = 0; g < 4; ++g) { OS[(16 * mt + 4 * q + g) * 136 + 16 * wave + r] = f2bf(o[mt][g]); if (xw && r == 0) DNS[16 * mt + 4 * q + g] = ox[mt][g]; } }
        }
#pragma unroll
        for (int i = 0; i < 8; ++i) { const bf16x8 av = *(const bf16x8*)(KT + (16 * i + r) * 40 + 8 * q); const f32x4 s2 = *(const f32x4*)(SC2 + 16 * i + 4 * q);
            S[i] = MFMA16(av, bV, S[i]); S[i] *= s2;
            if (xw) { SX[i] = MFMA16(av, bV1, SX[i]); SX[i] *= s2; } }
    }
    if (PASS == 2) { __syncthreads(); GLA_STORE(sg * GSEGLEN + GSEGLEN - 32, 1); }
    if (PASS == 1) {
        float* ST = (float*)smem;
        __syncthreads();
#pragma unroll
        for (int i = 0; i < 8; ++i)
#pragma unroll
            for (int g = 0; g < 4; ++g) { ST[(16 * i + 4 * q + g) * 132 + 16 * wave + r] = S[i][g]; if (xw) EX[((size_t)(sg * 4 + h) * 128 + 16 * i + 4 * q + g) * 16 + r] = SX[i][g]; }
        __syncthreads();
#pragma unroll
        for (int k = 0; k < 8; ++k) { const int idx = tid + 512 * k, row = idx >> 5, c4 = (idx & 31) * 4; *(f32x4*)(Eg + ((size_t)(sg * 4 + h) * 128 + row) * 128 + c4) = *(const f32x4*)(ST + row * 132 + c4); }
        if (grp == 0) Gg[(size_t)(sg * 4 + h) * 128 + d] = expf(runb);
    }
#undef GLA_FETCH
#undef GLA_STORE
}

template <int PASS>
__device__ __forceinline__ void s5_item(ArgsRef a, int l, int g, int sg, int g0, int tid, int lane, int wave, int hsel) {
    unsigned char* ws = a.ws;
    const bf16_t* Z = (const bf16_t*)(ws + OFF_Z); const float* ABAR = (const float*)(ws + OFF_ABAR); const bf16_t* BBT = (const bf16_t*)(ws + OFF_BBT); const bf16_t* CCT = (const bf16_t*)(ws + OFF_CCT);
    float* ES = (float*)(ws + OFF_ES); bf16_t* YPRE = (bf16_t*)(ws + OFF_YPRE);
    float* BU = (float*)(smem + 70000 + (wave & 3) * 12800); bf16_t* X = (bf16_t*)(smem + 70000 + (wave & 3) * 12800 + 8448); bf16_t* YT = (bf16_t*)(smem + 70000 + 51200);
    const int r = lane & 15, q = lane >> 4, p = lane; const bool act = (wave >> 2) == hsel;
    const float ar = ABAR[(g * 64 + p) * 2], ai = ABAR[(g * 64 + p) * 2 + 1];
    const bf16x8 zero8 = (bf16x8){0, 0, 0, 0, 0, 0, 0, 0};
    bf16x8 bB[8], cB[4];
#pragma unroll
    for (int nt = 0; nt < 8; ++nt) bB[nt] = (q < 2) ? *(const bf16x8*)(BBT + (size_t)(g * 128 + 16 * nt + r) * 16 + 8 * q) : zero8;
#pragma unroll
    for (int kk = 0; kk < 4; ++kk) cB[kk] = (PASS == 2) ? *(const bf16x8*)(CCT + (size_t)(g * 16 + r) * 128 + 32 * kk + 8 * q) : zero8;
    float xr = 0.f, xi = 0.f;
    if (PASS == 2) { xr = ES[((size_t)(sg * 32 + g) * 64 + p) * 2]; xi = ES[((size_t)(sg * 32 + g) * 64 + p) * 2 + 1]; }
    const float dsk = a.in[17][l * 512 + 16 * g + r];
    for (int ci = 0; ci < SSEGLEN / 16; ++ci) {
        const int t0 = sg * SSEGLEN + ci * 16;
        if (act) {
            const bf16x8 av = (q < 2) ? *(const bf16x8*)(Z + (size_t)(t0 + r) * NZ + 1024 + 16 * g + 8 * q) : zero8;
#pragma unroll
            for (int nt = 0; nt < 8; ++nt) { f32x4 acc = (f32x4){0.f, 0.f, 0.f, 0.f}; acc = MFMA16(av, bB[nt], acc);
#pragma unroll
                for (int gg = 0; gg < 4; ++gg) BU[(4 * q + gg) * 132 + 16 * nt + r] = acc[gg]; }
            wave_sync();
#pragma unroll
            for (int t = 0; t < 16; ++t) { const float br = BU[t * 132 + p], bi = BU[t * 132 + 64 + p];
                const float nr = ar * xr - ai * xi + br, ni = ar * xi + ai * xr + bi; xr = nr; xi = ni;
                if (PASS == 2) { X[t * 136 + p] = f2bf(xr); X[t * 136 + 64 + p] = f2bf(xi); } }
            wave_sync();
            if (PASS == 2) {
                f32x4 acc = (f32x4){0.f, 0.f, 0.f, 0.f};
#pragma unroll
                for (int kk = 0; kk < 4; ++kk) { const bf16x8 xv = *(const bf16x8*)(X + r * 136 + 32 * kk + 8 * q); acc = MFMA16(xv, cB[kk], acc); }
#pragma unroll
                for (int gg = 0; gg < 4; ++gg) { const int t = t0 + 4 * q + gg, c = 16 * g + r; const float u = bf2f(Z[(size_t)t * NZ + 1024 + c]);
                    YT[(4 * q + gg) * 136 + 16 * wave + r] = f2bf(gelu_tanh(acc[gg] + dsk * u)); }
            }
        }
        if (PASS == 2) {
            __syncthreads();
            if (tid < 128) { const int row = tid >> 3, c8 = (tid & 7) * 8; *(u32x4*)(YPRE + (size_t)(t0 + row) * 512 + 16 * g0 + 64 * hsel + c8) = *(const u32x4*)(YT + row * 136 + 64 * hsel + c8); }
            __syncthreads();
        }
    }
    if (PASS == 1 && act) { ES[((size_t)(sg * 32 + g) * 64 + p) * 2] = xr; ES[((size_t)(sg * 32 + g) * 64 + p) * 2 + 1] = xi; }
}

__device__ __forceinline__ void phase_scan(ArgsRef a, int tid, int bid, int G) {
    unsigned char* ws = a.ws;
    const int NT = G * 512, gt = bid * 512 + tid;
    for (int i = gt; i < 2 * 65536 + 8192 + 2048; i += NT) {
        if (i < 2 * 65536 + 8192) { const bool nx = i >= 2 * 65536; const int m = i >> 16, el = nx ? i - 2 * 65536 : (i & 65535), hrow = nx ? (el >> 4) : (el >> 7); const size_t str = nx ? 8192 : 65536;
            float* E = (float*)(ws + (nx ? OFF_EMX : (m == 0 ? OFF_EM : OFF_EH))); const float* Gd = (const float*)(ws + ((nx || m == 0) ? OFF_GM : OFF_GH));
            float ev[GSEG], gv[GSEG];
#pragma unroll
            for (int sg = 0; sg < GSEG; ++sg) { ev[sg] = E[(size_t)sg * str + el]; gv[sg] = Gd[sg * 512 + hrow]; }
            float cur = 0.f;
#pragma unroll
            for (int sg = 0; sg < GSEG; ++sg) { E[(size_t)sg * str + el] = cur; cur = gv[sg] * cur + ev[sg]; } }
        else { const int el = i - 2 * 65536 - 8192; float* E = (float*)(ws + OFF_ES); const float* ABAR = (const float*)(ws + OFF_ABAR);
            float pr = ABAR[el * 2], pi = ABAR[el * 2 + 1];
#pragma unroll
            for (int k = 0; k < 8; ++k) { const float nr = pr * pr - pi * pi, ni = 2.0f * pr * pi; pr = nr; pi = ni; }
            float xr = 0.f, xi = 0.f;
            for (int sb = 0; sb < SSEG; sb += 16) { float er[16], ei[16];
#pragma unroll
                for (int k = 0; k < 16; ++k) { er[k] = E[((size_t)(sb + k) * 2048 + el) * 2]; ei[k] = E[((size_t)(sb + k) * 2048 + el) * 2 + 1]; }
#pragma unroll
                for (int k = 0; k < 16; ++k) { E[((size_t)(sb + k) * 2048 + el) * 2] = xr; E[((size_t)(sb + k) * 2048 + el) * 2 + 1] = xi;
                    const float nr = pr * xr - pi * xi + er[k], ni = pr * xi + pi * xr + ei[k]; xr = nr; xi = ni; } } }
    }
}

template <int PASS>
__device__ __forceinline__ void phase_mixers(ArgsRef a, int l, int tid, int lane, int wave, int bid, int G) {
    for (int it = bid; it < 4 * GSEG; it += G) gla_item<0, PASS>(a, l, it % 4, it / 4, tid, lane, wave);
    asm volatile("" ::: "memory");
    for (int it = bid + ((4 * GSEG - bid % G) % G + G) % G * 0; it < 2 * 4 * GSEG; it += G) { if (it >= 4 * GSEG) gla_item<1, PASS>(a, l, (it - 4 * GSEG) % 4, (it - 4 * GSEG) / 4, tid, lane, wave); }
    __syncthreads();
    for (int it0 = bid * 8; it0 < 32 * SSEG; it0 += G * 8)
        for (int half = 0; half < 2; ++half) { const int it = it0 + wave; s5_item<PASS>(a, l, it % 32, it / 32, it0 % 32, tid, lane, wave, half); __syncthreads(); }
}

__device__ __forceinline__ void phase_post(ArgsRef a, int l, int lane, int gw, int GW) {
    const bf16_t* Z = (const bf16_t*)(a.ws + OFF_Z); const bf16_t* XC = (const bf16_t*)(a.ws + OFF_XC);
    bf16_t* OM = (bf16_t*)(a.ws + OFF_OM); bf16_t* OH = (bf16_t*)(a.ws + OFF_OH); const float* DEN = (const float*)(a.ws + OFF_DEN);
    const int c0 = lane * 8, hd = lane >> 4;
    float skp[8], nw[8];
#pragma unroll
    for (int j = 0; j < 8; ++j) { skp[j] = a.in[9][l * 512 + c0 + j]; nw[j] = a.in[20][l * 512 + c0 + j]; }
    for (int tb = gw * 4; tb < T; tb += GW * 4) {
        bf16x8 om[4], op[4], xc[4], oh[4], gp[4]; float dn[4];
#pragma unroll
        for (int k = 0; k < 4; ++k) { const size_t t = tb + k; om[k] = *(const bf16x8*)(OM + t * 512 + c0); op[k] = *(const bf16x8*)(Z + t * NZ + 512 + c0); xc[k] = *(const bf16x8*)(XC + t * 512 + c0);
            oh[k] = *(const bf16x8*)(OH + t * 512 + c0); gp[k] = *(const bf16x8*)(Z + t * NZ + 3072 + c0); dn[k] = DEN[hd * T + t]; }
#pragma unroll
        for (int k = 0; k < 4; ++k) { const size_t t = tb + k; const float di = __builtin_amdgcn_rcpf(fmaxf(fabsf(dn[k]), 1.0f)); float y[8], ov[8], ss = 0.f;
#pragma unroll
            for (int j = 0; j < 8; ++j) { y[j] = sigmoidf_(bf2f((bf16_t)op[k][j])) * (bf2f((bf16_t)om[k][j]) * di) + skp[j] * bf2f((bf16_t)xc[k][j]); ov[j] = bf2f((bf16_t)oh[k][j]); ss += ov[j] * ov[j]; }
            u32x4 w; w.x = pack2(y[0], y[1]); w.y = pack2(y[2], y[3]); w.z = pack2(y[4], y[5]); w.w = pack2(y[6], y[7]); *(u32x4*)(OM + t * 512 + c0) = w;
            ss += __shfl_xor(ss, 1); ss += __shfl_xor(ss, 2); ss += __shfl_xor(ss, 4); ss += __shfl_xor(ss, 8);
            const float rinv = rsqrtf(ss * (1.0f / 128.0f) + 1e-6f);
#pragma unroll
            for (int j = 0; j < 8; ++j) y[j] = ov[j] * rinv * nw[j] * siluf_(bf2f((bf16_t)gp[k][j]));
            u32x4 x; x.x = pack2(y[0], y[1]); x.y = pack2(y[2], y[3]); x.z = pack2(y[4], y[5]); x.w = pack2(y[6], y[7]); *(u32x4*)(OH + t * 512 + c0) = x; }
    }
}

__device__ __forceinline__ void ln_row(f32x4 (&v)[4], const float* gam, const float* bet, int lane) {
    float s = 0.f;
#pragma unroll
    for (int j = 0; j < 4; ++j) s += (v[j][0] + v[j][1]) + (v[j][2] + v[j][3]);
#pragma unroll
    for (int o = 32; o >= 1; o >>= 1) s += __shfl_xor(s, o);
    const float mean = s * (1.0f / 1024.0f); float qv = 0.f;
#pragma unroll
    for (int j = 0; j < 4; ++j) { const f32x4 dd = v[j] - mean; qv += (dd[0] * dd[0] + dd[1] * dd[1]) + (dd[2] * dd[2] + dd[3] * dd[3]); }
#pragma unroll
    for (int o = 32; o >= 1; o >>= 1) qv += __shfl_xor(qv, o);
    const float rstd = rsqrtf(qv * (1.0f / 1024.0f) + 1e-5f);
#pragma unroll
    for (int j = 0; j < 4; ++j) { const f32x4 gg = *(const f32x4*)(gam + 256 * j + 4 * lane), bb = *(const f32x4*)(bet + 256 * j + 4 * lane); v[j] = (v[j] - mean) * rstd * gg + bb; }
}

__device__ __forceinline__ void phase_ln1r(ArgsRef a, int l, int tid, int lane, int wave, int bid, int G) {
    float* XF = a.out; bf16_t* XB = (bf16_t*)(a.ws + OFF_XB);
    int* TOKE = (int*)(a.ws + OFF_TOKE); float* TOKG = (float*)(a.ws + OFF_TOKG); unsigned* HIST = (unsigned*)(a.ws + OFF_HIST);
    const float* RWT = (const float*)(a.ws + OFF_RWT); const float* RB = a.in[30];
    float* LG = (float*)(smem + wave * 4096);
    int* TE = (int*)(smem + wave * 4096 + 2304); float* TG = (float*)(smem + wave * 4096 + 2432); unsigned* HS = (unsigned*)(smem + wave * 4096 + 2560);
    const int r = lane & 15, q = lane >> 4, rs = lane >> 5, e = lane & 31;
    if (G >= 256 && wave >= 4) {
        float* tw_lds = (float*)(smem + 16384 + (wave - 4) * 16640);
        for (int u = 896 + bid * 4 + (wave - 4); u < 6144; u += G * 4) wave_prepx_tile(a, l, u, lane, tw_lds);
    }
    for (int tw = bid + G * wave; tw < T / 16; tw += G * 8) {
        const int t0 = tw * 16;
        for (int rb = 0; rb < 16; rb += 4) { f32x4 v[4][4];
#pragma unroll
            for (int k = 0; k < 4; ++k)
#pragma unroll
                for (int j = 0; j < 4; ++j) v[k][j] = *(const f32x4*)(XF + (size_t)(t0 + rb + k) * 1024 + 256 * j + 4 * lane);
#pragma unroll
            for (int k = 0; k < 4; ++k) { const int t = t0 + rb + k; ln_row(v[k], a.in[25] + l * 1024, a.in[26] + l * 1024, lane);
#pragma unroll
                for (int j = 0; j < 4; ++j) { *(f32x4*)(XF + (size_t)t * 1024 + 256 * j + 4 * lane) = v[k][j];
                    u32x2 w; w.x = pack2(v[k][j][0], v[k][j][1]); w.y = pack2(v[k][j][2], v[k][j][3]); *(u32x2*)(XB + (size_t)t * 1024 + 256 * j + 4 * lane) = w; } } }
        if (lane < 32) HS[lane] = 0u;
        asm volatile("s_waitcnt vmcnt(0) lgkmcnt(0)" ::: "memory"); __builtin_amdgcn_wave_barrier();
        f32x4 acc0 = (f32x4){0.f, 0.f, 0.f, 0.f}, acc1 = acc0;
        const float* xa = XF + (size_t)(t0 + r) * 1024 + 4 * q; const float* w0 = RWT + (size_t)r * 1024 + 4 * q; const float* w1 = RWT + (size_t)(16 + r) * 1024 + 4 * q;
#pragma unroll 8
        for (int s = 0; s < 64; ++s) { const f32x4 av = *(const f32x4*)(xa + 16 * s), b0 = *(const f32x4*)(w0 + 16 * s), b1 = *(const f32x4*)(w1 + 16 * s);
#pragma unroll
            for (int j = 0; j < 4; ++j) { acc0 = __builtin_amdgcn_mfma_f32_16x16x4f32(av[j], b0[j], acc0, 0, 0, 0); acc1 = __builtin_amdgcn_mfma_f32_16x16x4f32(av[j], b1[j], acc1, 0, 0, 0); } }
#pragma unroll
        for (int g = 0; g < 4; ++g) { LG[(4 * q + g) * 33 + r] = acc0[g]; LG[(4 * q + g) * 33 + 16 + r] = acc1[g]; }
        wave_sync();
        for (int pp = 0; pp < 8; ++pp) {
            const float lg = LG[(2 * pp + rs) * 33 + e];
            const float s = sigmoidf_(lg), sb = s + RB[e];
            float v4[4];
#pragma unroll
            for (int i = 0; i < 4; ++i) v4[i] = __shfl(sb, (lane & ~3) + i);
            int i1 = 0;
#pragma unroll
            for (int i = 1; i < 4; ++i) if (v4[i] > v4[i1]) i1 = i;
            int i2 = (i1 == 0) ? 1 : 0;
#pragma unroll
            for (int i = 0; i < 4; ++i) if (i != i1 && i != i2 && v4[i] > v4[i2]) i2 = i;
            float gs = v4[i1] + v4[i2]; int gid = e >> 2;
#pragma unroll
            for (int o = 4; o <= 16; o <<= 1) { const float os = __shfl_xor(gs, o); const int og = __shfl_xor(gid, o); if (os > gs || (os == gs && og < gid)) { gs = os; gid = og; } }
            float sv[4], sbv[4];
#pragma unroll
            for (int i = 0; i < 4; ++i) { sbv[i] = __shfl(sb, (lane & 32) + gid * 4 + i); sv[i] = __shfl(s, (lane & 32) + gid * 4 + i); }
            int j1 = 0;
#pragma unroll
            for (int i = 1; i < 4; ++i) if (sbv[i] > sbv[j1]) j1 = i;
            int j2 = (j1 == 0) ? 1 : 0;
#pragma unroll
            for (int i = 0; i < 4; ++i) if (i != j1 && i != j2 && sbv[i] > sbv[j2]) j2 = i;
            float s1 = sv[0], s2 = sv[0];
#pragma unroll
            for (int i = 1; i < 4; ++i) { if (i == j1) s1 = sv[i]; if (i == j2) s2 = sv[i]; }
            if (e == 0) { const int ti = 2 * pp + rs; const float inv = 1.0f / (s1 + s2);
                TE[ti * 2] = gid * 4 + j1; TE[ti * 2 + 1] = gid * 4 + j2; TG[ti * 2] = s1 * inv; TG[ti * 2 + 1] = s2 * inv;
                atomicAdd(&HS[gid * 4 + j1], 1u); atomicAdd(&HS[gid * 4 + j2], 1u); }
        }
        wave_sync();
        if (lane < 32) { TOKE[t0 * 2 + lane] = TE[lane]; TOKG[t0 * 2 + lane] = TG[lane]; HIST[tw * 32 + lane] = HS[lane]; }
        wave_sync();
    }
    __syncthreads();
}

__device__ __forceinline__ void phase_slot(ArgsRef a, int tid, int lane, int wave, int bid, int G) {
    const int* TOKE = (const int*)(a.ws + OFF_TOKE); int* TOKS = (int*)(a.ws + OFF_TOKS); const unsigned* HIST = (const unsigned*)(a.ws + OFF_HIST);
    unsigned* BASE = (unsigned*)(a.ws + OFF_CTL) + 64;
    const bf16_t* XB = (const bf16_t*)(a.ws + OFF_XB); bf16_t* XG = (bf16_t*)(a.ws + OFF_XG);
    unsigned* base = (unsigned*)smem; unsigned* pre = base + 40; int* el = (int*)(base + 80); int* sl = (int*)(base + 208); unsigned* red = base + 336;
    const int e = tid & 31, part = tid >> 5;
    for (int c = bid; c < T / 64; c += G) {
        unsigned tot = 0u, pr = 0u;
#pragma unroll 16
        for (int it = part; it < 1024; it += 16) { const unsigned v = HIST[it * 32 + e]; tot += v; pr += (it < 4 * c) ? v : 0u; }
        red[part * 32 + e] = tot; red[512 + part * 32 + e] = pr;
        __syncthreads();
        if (tid < 32) { unsigned t2 = 0u, p2 = 0u; for (int k = 0; k < 16; ++k) { t2 += red[k * 32 + tid]; p2 += red[512 + k * 32 + tid]; } pre[tid] = p2; red[tid] = (t2 + 255u) & ~255u; }
        __syncthreads();
        if (tid == 0) { unsigned sacc = 0; for (int k = 0; k < 32; ++k) { base[k] = sacc; sacc += red[k]; } base[32] = sacc; }
        int ee = 0;
        if (tid < 128) { ee = TOKE[c * 128 + tid]; el[tid] = ee; }
        __syncthreads();
        if (c == 0 && tid < 33) BASE[tid] = base[tid];
        if (tid < 128) { unsigned rank = 0; for (int i = 0; i < tid; ++i) rank += (el[i] == ee) ? 1u : 0u;
            const unsigned sidx = base[ee] + pre[ee] + rank; sl[tid] = (int)sidx; TOKS[c * 128 + tid] = (int)sidx; }
        __syncthreads();
        for (int ib = 0; ib < 16; ib += 8) { u32x4 ra[8], rb[8];
#pragma unroll
            for (int k = 0; k < 8; ++k) { const int i = wave + 8 * (ib + k), t = c * 64 + (i >> 1); ra[k] = *(const u32x4*)(XB + (size_t)t * 1024 + lane * 8); rb[k] = *(const u32x4*)(XB + (size_t)t * 1024 + 512 + lane * 8); }
#pragma unroll
            for (int k = 0; k < 8; ++k) { const int i = wave + 8 * (ib + k); const size_t so = (size_t)sl[i] * 1024; *(u32x4*)(XG + so + lane * 8) = ra[k]; *(u32x4*)(XG + so + 512 + lane * 8) = rb[k]; } }
        __syncthreads();
    }
}

__device__ __forceinline__ void phase_ln2(ArgsRef a, int l, int lane, int gw, int GW) {
    float* XF = a.out; bf16_t* XB = (bf16_t*)(a.ws + OFF_XB); const bf16_t* YS = (const bf16_t*)(a.ws + OFF_YS);
    const int* TOKS = (const int*)(a.ws + OFF_TOKS); const float* TOKG = (const float*)(a.ws + OFF_TOKG);
    for (int tb = gw * 4; tb < T; tb += GW * 4) {
        int sv = 0; float gv = 0.f; if (lane < 8) { sv = TOKS[tb * 2 + lane]; gv = TOKG[tb * 2 + lane]; }
        f32x4 v[4][4]; bf16x4 y0[4][4], y1[4][4]; float g0[4], g1[4];
#pragma unroll
        for (int k = 0; k < 4; ++k) { const int s0 = __shfl(sv, 2 * k), s1 = __shfl(sv, 2 * k + 1); g0[k] = __shfl(gv, 2 * k); g1[k] = __shfl(gv, 2 * k + 1);
#pragma unroll
            for (int j = 0; j < 4; ++j) { v[k][j] = *(const f32x4*)(XF + (size_t)(tb + k) * 1024 + 256 * j + 4 * lane);
                y0[k][j] = *(const bf16x4*)(YS + (size_t)s0 * 1024 + 256 * j + 4 * lane); y1[k][j] = *(const bf16x4*)(YS + (size_t)s1 * 1024 + 256 * j + 4 * lane); } }
#pragma unroll
        for (int k = 0; k < 4; ++k) {
#pragma unroll
            for (int j = 0; j < 4; ++j)
#pragma unroll
                for (int g = 0; g < 4; ++g) v[k][j][g] = DN_ALPHA * v[k][j][g] + g0[k] * bf2f((bf16_t)y0[k][j][g]) + g1[k] * bf2f((bf16_t)y1[k][j][g]);
            ln_row(v[k], a.in[27] + l * 1024, a.in[28] + l * 1024, lane);
#pragma unroll
            for (int j = 0; j < 4; ++j) { *(f32x4*)(XF + (size_t)(tb + k) * 1024 + 256 * j + 4 * lane) = v[k][j];
                u32x2 w; w.x = pack2(v[k][j][0], v[k][j][1]); w.y = pack2(v[k][j][2], v[k][j][3]); *(u32x2*)(XB + (size_t)(tb + k) * 1024 + 256 * j + 4 * lane) = w; } }
    }
}

struct SchedGrid {
    int nM, nN, G, c; const char* A; const char* B; size_t strideA, strideB;
    __device__ __forceinline__ bool next(int i, pg8::Unit& u) const { int pm, pn; if (!pg8::tile_order(i * G + c, nM, nN, pm, pn)) return false;
        u.pm = pm; u.pn = pn; u.tag = 0; u.A = A + (size_t)pm * strideA; u.B = B + (size_t)pn * strideB; return true; }
};
constexpr int GATES_LD = 3072;
template <int MODE> struct EpiBf16 {
    static constexpr bool PERM = true;
    bf16_t* O; int ldo; const bf16_t* Y; int ldy;
    __device__ __forceinline__ bool operator()(f32x4 (&acc)[2][2][4][2], const pg8::Unit& u, int wr, int wc, int fr, int fq) const {
#pragma unroll
        for (int ai = 0; ai < 2; ++ai) {
            bf16x8 yv[4][2];
            if (MODE == 2) {
#pragma unroll
                for (int m = 0; m < 4; ++m)
#pragma unroll
                    for (int bj = 0; bj < 2; ++bj) yv[m][bj] = *(const bf16x8*)(Y + ((size_t)u.pm * 256 + ai * 128 + wr * 64 + m * 16 + fr) * ldy + u.pn * 256 + bj * 128 + wc * 32 + 8 * fq);
            }
#pragma unroll
            for (int m = 0; m < 4; ++m) { const size_t row = (size_t)u.pm * 256 + ai * 128 + wr * 64 + m * 16 + fr;
#pragma unroll
                for (int bj = 0; bj < 2; ++bj) { const int col = u.pn * 256 + bj * 128 + wc * 32 + 8 * fq; f32x4 v0 = acc[ai][bj][m][0], v1 = acc[ai][bj][m][1];
                    if (MODE == 1) {
#pragma unroll
                        for (int j = 0; j < 4; ++j) { v0[j] = fmaxf(sigmoidf_(v0[j]), 1e-30f); v1[j] = fmaxf(sigmoidf_(v1[j]), 1e-30f); } }
                    if (MODE == 2) {
#pragma unroll
                        for (int j = 0; j < 4; ++j) { v0[j] = bf2f((bf16_t)yv[m][bj][j]) * sigmoidf_(v0[j]); v1[j] = bf2f((bf16_t)yv[m][bj][4 + j]) * sigmoidf_(v1[j]); } }
                    u32x4 w; w.x = pg8::cvt_pk_bf16(v0[0], v0[1]); w.y = pg8::cvt_pk_bf16(v0[2], v0[3]); w.z = pg8::cvt_pk_bf16(v1[0], v1[1]); w.w = pg8::cvt_pk_bf16(v1[2], v1[3]);
                    if (MODE == 1) *(u32x4*)(O + ((((size_t)u.pm * 12 + u.pn) * 16 + (ai * 8 + m * 2 + bj)) * 512 + ((wr * 4 + wc) * 64 + fq * 16 + fr)) * 8) = w;
                    else *(u32x4*)(O + row * ldo + col) = w; } }
        }
        return false;
    }
};
struct SchedZ {
    int G, c; const unsigned char* ws;
    __device__ __forceinline__ bool next(int i, pg8::Unit& u) const { int pm, pn; if (!pg8::tile_order(i * G + c, T / 256, 15, pm, pn)) return false;
        u.pm = pm; u.pn = pn; u.tag = 0; u.A = (const char*)(ws + OFF_XB) + (size_t)pm * 256 * 1024 * 2;
        u.B = (const char*)(ws + OFF_WIN) + (size_t)(pn < 14 ? pn * 256 : 6656) * 1024 * 2; return true; }
};
struct EpiZ {
    static constexpr bool PERM = true;
    bf16_t* Z; float* LI; float* LF; const float* bi; const float* bf;
    __device__ __forceinline__ bool operator()(f32x4 (&acc)[2][2][4][2], const pg8::Unit& u, int wr, int wc, int fr, int fq) const {
        if (u.pn < 14) {
#pragma unroll
            for (int ai = 0; ai < 2; ++ai)
#pragma unroll
                for (int m = 0; m < 4; ++m) { const size_t row = (size_t)u.pm * 256 + ai * 128 + wr * 64 + m * 16 + fr;
#pragma unroll
                    for (int bj = 0; bj < 2; ++bj) { const int col = u.pn * 256 + bj * 128 + wc * 32 + 8 * fq; const f32x4 v0 = acc[ai][bj][m][0], v1 = acc[ai][bj][m][1];
                        u32x4 w; w.x = pg8::cvt_pk_bf16(v0[0], v0[1]); w.y = pg8::cvt_pk_bf16(v0[2], v0[3]); w.z = pg8::cvt_pk_bf16(v1[0], v1[1]); w.w = pg8::cvt_pk_bf16(v1[2], v1[3]);
                        *(u32x4*)(Z + row * NZ + col) = w; } }
        } else if (wc == 0 && fq == 0) {
            const f32x4 b_i = *(const f32x4*)bi, b_f = *(const f32x4*)bf;
#pragma unroll
            for (int ai = 0; ai < 2; ++ai)
#pragma unroll
                for (int m = 0; m < 4; ++m) { const size_t row = (size_t)u.pm * 256 + ai * 128 + wr * 64 + m * 16 + fr; const f32x4 v0 = acc[ai][0][m][0] + b_i, v1 = acc[ai][0][m][1] + b_f;
                    f32x4 lf; lf[0] = logsigmoidf_(v1[0]); lf[1] = logsigmoidf_(v1[1]); lf[2] = logsigmoidf_(v1[2]); lf[3] = logsigmoidf_(v1[3]);
                    *(f32x4*)(LI + row * 4) = v0; *(f32x4*)(LF + row * 4) = lf; }
        }
        return false;
    }
};
__device__ __forceinline__ void phase_zgemm2(ArgsRef a, int l, int tid, int bid, int G) {
    SchedZ S{G, bid, a.ws}; EpiZ E{(bf16_t*)(a.ws + OFF_Z), (float*)(a.ws + OFF_LI), (float*)(a.ws + OFF_LF), a.in[7] + l * 4, a.in[8] + l * 4};
    pg8::gemm_phase((PG8_LAS unsigned char*)smem, tid, 1024, 1024, 1024, S, E);
}
__device__ __forceinline__ void phase_glu_gates(ArgsRef a, int l, int tid, int bid, int G) {
    { SchedGrid S{T / 256, 2, G, bid, (const char*)(a.ws + OFF_YPRE), (const char*)(a.ws + OFF_WGLU), (size_t)256 * 512 * 2, (size_t)256 * 512 * 2};
      EpiBf16<2> E{(bf16_t*)(a.ws + OFF_YSG), 512, (const bf16_t*)(a.ws + OFF_YPRE), 512};
      pg8::gemm_phase((PG8_LAS unsigned char*)smem, tid, 512, 512, 512, S, E); }
    asm volatile("" : "+v"(tid), "+s"(bid), "+s"(G));
    if (G > 128) { if (bid >= 128) phase_prepx(a, l, tid, bid - 128, G - 128, 0, 896); } else phase_prepx(a, l, tid, bid, G, 0, 896);
    asm volatile("" : "+v"(tid), "+s"(bid), "+s"(G));
    { SchedGrid S{T / 256, 12, G, (bid + G / 2) % G, (const char*)(a.ws + OFF_XB), (const char*)(a.ws + OFF_WIN + (size_t)NZ * 1024 * 2), (size_t)256 * 1024 * 2, (size_t)256 * 1024 * 2};
      EpiBf16<1> E{(bf16_t*)(a.ws + OFF_Z), GATES_LD, nullptr, 0};
      pg8::gemm_phase((PG8_LAS unsigned char*)smem, tid, 1024, 1024, 1024, S, E); }
}
struct SchedMerge {
    int G, c; const unsigned char* ws;
    __device__ __forceinline__ bool next(int i, pg8::Unit& u) const { const int b = i % 3; int pm, pn; if (!pg8::tile_order((i / 3) * G + c, T / 256, 4, pm, pn)) return false;
        u.pm = pm; u.pn = pn; u.tag = b; u.A = (const char*)(ws + (b == 0 ? OFF_OM : b == 1 ? OFF_YSG : OFF_OH)) + (size_t)pm * 256 * 512 * 2;
        u.B = (const char*)(ws + OFF_WB) + ((size_t)b * 1024 + pn * 256) * 512 * 2; return true; }
};
struct EpiMerge {
    static constexpr bool PERM = true;
    const bf16_t* GT; bf16_t* O;
    __device__ __forceinline__ bool operator()(f32x4 (&acc)[2][2][4][2], const pg8::Unit& u, int wr, int wc, int fr, int fq) const {
        const int b = u.tag;
#pragma unroll
        for (int ai = 0; ai < 2; ++ai)
#pragma unroll
        for (int mh = 0; mh < 2; ++mh) {
            bf16x8 gb[2][2], gn[2][2];
#pragma unroll
            for (int mm = 0; mm < 2; ++mm)
#pragma unroll
                for (int bj = 0; bj < 2; ++bj) { const bf16_t* gp = GT + ((((size_t)u.pm * 12 + b * 4 + u.pn) * 16 + (ai * 8 + (2 * mh + mm) * 2 + bj)) * 512 + ((wr * 4 + wc) * 64 + fq * 16 + fr)) * 8;
                    gb[mm][bj] = *(const bf16x8*)gp; gn[mm][bj] = (b < 2) ? *(const bf16x8*)(gp + (size_t)4 * 16 * 512 * 8) : gb[mm][bj]; }
#pragma unroll
            for (int mm = 0; mm < 2; ++mm) { const int m = 2 * mh + mm; const size_t row = (size_t)u.pm * 256 + ai * 128 + wr * 64 + m * 16 + fr;
#pragma unroll
                for (int bj = 0; bj < 2; ++bj) { const int col = u.pn * 256 + bj * 128 + wc * 32 + 8 * fq;
                    if (b < 2) {
#pragma unroll
                        for (int j = 0; j < 4; ++j) { acc[ai][bj][m][0][j] *= bf2f((bf16_t)gb[mm][bj][j]) * __builtin_amdgcn_rcpf(bf2f((bf16_t)gn[mm][bj][j])); acc[ai][bj][m][1][j] *= bf2f((bf16_t)gb[mm][bj][4 + j]) * __builtin_amdgcn_rcpf(bf2f((bf16_t)gn[mm][bj][4 + j])); } }
                    else { f32x4 v0 = acc[ai][bj][m][0], v1 = acc[ai][bj][m][1];
#pragma unroll
                        for (int j = 0; j < 4; ++j) { v0[j] *= bf2f((bf16_t)gb[mm][bj][j]); v1[j] *= bf2f((bf16_t)gb[mm][bj][4 + j]); }
                        u32x4 w; w.x = pg8::cvt_pk_bf16(v0[0], v0[1]); w.y = pg8::cvt_pk_bf16(v0[2], v0[3]); w.z = pg8::cvt_pk_bf16(v1[0], v1[1]); w.w = pg8::cvt_pk_bf16(v1[2], v1[3]);
                        *(u32x4*)(O + row * 1024 + col) = w; } } }
        }
        return b < 2;
    }
};
__device__ __forceinline__ void phase_merge2(ArgsRef a, int tid, int bid, int G) {
    SchedMerge S{G, bid, a.ws}; EpiMerge E{(const bf16_t*)(a.ws + OFF_Z), (bf16_t*)(a.ws + OFF_XB)};
    pg8::gemm_phase((PG8_LAS unsigned char*)smem, tid, 512, 512, 512, S, E);
}
struct EpiResid {
    static constexpr bool PERM = false;
    const float* xin; float* XF;
    __device__ __forceinline__ bool operator()(f32x4 (&acc)[2][2][4][2], const pg8::Unit& u, int wr, int wc, int fr, int fq) const {
#pragma unroll
        for (int ai = 0; ai < 2; ++ai)
#pragma unroll
        for (int mh = 0; mh < 2; ++mh) {
            f32x4 xv[2][2][2];
#pragma unroll
            for (int mm = 0; mm < 2; ++mm)
#pragma unroll
                for (int bj = 0; bj < 2; ++bj)
#pragma unroll
                    for (int n = 0; n < 2; ++n) xv[mm][bj][n] = *(const f32x4*)(xin + ((size_t)u.pm * 256 + ai * 128 + wr * 64 + (2 * mh + mm) * 16 + fr) * 1024 + u.pn * 256 + bj * 128 + wc * 32 + 16 * n + 4 * fq);
#pragma unroll
            for (int mm = 0; mm < 2; ++mm)
#pragma unroll
                for (int bj = 0; bj < 2; ++bj)
#pragma unroll
                    for (int n = 0; n < 2; ++n) { const int m = 2 * mh + mm; const size_t o = ((size_t)u.pm * 256 + ai * 128 + wr * 64 + m * 16 + fr) * 1024 + u.pn * 256 + bj * 128 + wc * 32 + 16 * n + 4 * fq; *(f32x4*)(XF + o) = DN_ALPHA * xv[mm][bj][n] + acc[ai][bj][m][n]; }
        }
        return false;
    }
};
__device__ __forceinline__ void phase_wout2(ArgsRef a, int l, int tid, int bid, int G) {
    SchedGrid S{T / 256, 4, G, bid, (const char*)(a.ws + OFF_XB), (const char*)(a.ws + OFF_WOUT), (size_t)256 * 1024 * 2, (size_t)256 * 1024 * 2};
    EpiResid E{(l == 0) ? a.in[0] : a.out, a.out};
    pg8::gemm_phase((PG8_LAS unsigned char*)smem, tid, 1024, 1024, 1024, S, E);
}
struct EpiQKV {
    static constexpr bool PERM = true;
    int vcall; bf16_t* Q; bf16_t* KH; bf16_t* V; const float* LI;
    __device__ __forceinline__ bool operator()(f32x4 (&acc)[2][2][4][2], const pg8::Unit& u, int wr, int wc, int fr, int fq) const {
        const int which = vcall ? 2 : (u.pn >> 1); bf16_t* O = Q + (size_t)which * (SZ_ACT / 2);
        float liv[2][4][2];
#pragma unroll
        for (int ai = 0; ai < 2; ++ai)
#pragma unroll
            for (int m = 0; m < 4; ++m)
#pragma unroll
                for (int bj = 0; bj < 2; ++bj) liv[ai][m][bj] = (which == 1) ? LI[((size_t)u.pm * 256 + ai * 128 + wr * 64 + m * 16 + fr) * 4 + (u.pn & 1) * 2 + bj] : 0.f;
#pragma unroll
        for (int ai = 0; ai < 2; ++ai)
#pragma unroll
            for (int m = 0; m < 4; ++m) { const size_t row = (size_t)u.pm * 256 + ai * 128 + wr * 64 + m * 16 + fr;
#pragma unroll
                for (int bj = 0; bj < 2; ++bj) { const int hd = (u.pn & 1) * 2 + bj, col = hd * 128 + wc * 32 + 8 * fq;
                    const float sc = which == 0 ? 0.08838834764831845f : which == 1 ? fexp(liv[ai][m][bj]) : 1.0f;
                    const f32x4 v0 = acc[ai][bj][m][0] * sc, v1 = acc[ai][bj][m][1] * sc;
                    u32x4 w; w.x = pg8::cvt_pk_bf16(v0[0], v0[1]); w.y = pg8::cvt_pk_bf16(v0[2], v0[3]); w.z = pg8::cvt_pk_bf16(v1[0], v1[1]); w.w = pg8::cvt_pk_bf16(v1[2], v1[3]);
                    *(u32x4*)(O + row * 512 + col) = w; } }
        return false;
    }
};
__device__ __forceinline__ void phase_mprep2(ArgsRef a, int l, int tid, int bid, int G) {
    const bf16_t* Z = (const bf16_t*)(a.ws + OFF_Z); bf16_t* XC = (bf16_t*)(a.ws + OFF_XC);
    const float* cw = a.in[2] + (size_t)l * 4 * 512; const float* cb = a.in[3] + (size_t)l * 512;
    for (int idx = bid * 512 + tid; idx < (T / 8) * 64; idx += G * 512) {
        const int tb = (idx / 64) * 8, c0 = (idx % 64) * 8;
        bf16x8 xr[11];
#pragma unroll
        for (int k = 0; k < 11; ++k) { const int ts = tb - 3 + k; xr[k] = (ts >= 0) ? *(const bf16x8*)(Z + (size_t)ts * NZ + c0) : (bf16x8){0, 0, 0, 0, 0, 0, 0, 0}; }
        float w[4][8], b[8];
#pragma unroll
        for (int j = 0; j < 8; ++j) { b[j] = cb[c0 + j];
#pragma unroll
            for (int k = 0; k < 4; ++k) w[k][j] = cw[k * 512 + c0 + j]; }
#pragma unroll
        for (int tt = 0; tt < 8; ++tt) { float acc[8];
#pragma unroll
            for (int j = 0; j < 8; ++j) { acc[j] = b[j];
#pragma unroll
                for (int k = 0; k < 4; ++k) acc[j] += w[k][j] * bf2f((bf16_t)xr[tt + k][j]); }
            u32x4 o; o.x = pack2(siluf_(acc[0]), siluf_(acc[1])); o.y = pack2(siluf_(acc[2]), siluf_(acc[3])); o.z = pack2(siluf_(acc[4]), siluf_(acc[5])); o.w = pack2(siluf_(acc[6]), siluf_(acc[7]));
            *(u32x4*)(XC + (size_t)(tb + tt) * 512 + c0) = o; }
    }
}

__device__ __forceinline__ void phase_v_conv(ArgsRef a, int l, int tid, int bid, int G) {
    if (G > 128 && bid >= 128) { phase_mprep2(a, l, tid, bid - 128, G - 128); return; }
    { SchedGrid S{T / 256, 2, G, bid, (const char*)(a.ws + OFF_Z), (const char*)(a.ws + OFF_WQKV + (size_t)1024 * 512 * 2), (size_t)256 * NZ * 2, (size_t)256 * 512 * 2};
      EpiQKV E{1, (bf16_t*)(a.ws + OFF_Q), (bf16_t*)(a.ws + OFF_KH), (bf16_t*)(a.ws + OFF_V), (const float*)(a.ws + OFF_LI)};
      pg8::gemm_phase((PG8_LAS unsigned char*)smem, tid, 512, NZ, 512, S, E); }
    if (G <= 128) { asm volatile("" : "+v"(tid), "+s"(bid), "+s"(G)); phase_mprep2(a, l, tid, bid, G); }
}
__device__ __forceinline__ void phase_qk(ArgsRef a, int tid, int bid, int G) {
    SchedGrid S{T / 256, 4, G, bid, (const char*)(a.ws + OFF_XC), (const char*)(a.ws + OFF_WQKV), (size_t)256 * 512 * 2, (size_t)256 * 512 * 2};
    EpiQKV E{0, (bf16_t*)(a.ws + OFF_Q), (bf16_t*)(a.ws + OFF_KH), (bf16_t*)(a.ws + OFF_V), (const float*)(a.ws + OFF_LI)};
    pg8::gemm_phase((PG8_LAS unsigned char*)smem, tid, 512, 512, 512, S, E);
}
struct SchedMoE {
    int down, G, c; const unsigned char* ws; const unsigned* BASE;
    __device__ __forceinline__ bool next(int i, pg8::Unit& u) const { const int per = down ? 4 : 2, L = i * G + c, ntile = (int)(BASE[32] >> 8); if (L >= ntile * per) return false;
        const int tile = L / per, sub = L % per; int e = 0; while (e < 31 && BASE[e + 1] <= (unsigned)(tile * 256)) ++e;
        u.pm = tile; u.pn = sub; u.tag = e;
        if (!down) { u.A = (const char*)(ws + OFF_XG) + (size_t)tile * 256 * 1024 * 2; u.B = (const char*)(ws + OFF_WGU) + ((size_t)e * 512 + sub * 256) * 1024 * 2; }
        else { u.A = (const char*)(ws + OFF_H) + (size_t)tile * 256 * 256 * 2; u.B = (const char*)(ws + OFF_WD) + ((size_t)e * 1024 + sub * 256) * 256 * 2; }
        return true; }
};
struct EpiH {
    static constexpr bool PERM = true;
    bf16_t* H;
    __device__ __forceinline__ bool operator()(f32x4 (&acc)[2][2][4][2], const pg8::Unit& u, int wr, int wc, int fr, int fq) const {
#pragma unroll
        for (int ai = 0; ai < 2; ++ai)
#pragma unroll
            for (int m = 0; m < 4; ++m) { const size_t row = (size_t)u.pm * 256 + ai * 128 + wr * 64 + m * 16 + fr; f32x4 v0, v1;
#pragma unroll
                for (int j = 0; j < 4; ++j) { v0[j] = siluf_(acc[ai][0][m][0][j]) * acc[ai][1][m][0][j]; v1[j] = siluf_(acc[ai][0][m][1][j]) * acc[ai][1][m][1][j]; }
                u32x4 w; w.x = pg8::cvt_pk_bf16(v0[0], v0[1]); w.y = pg8::cvt_pk_bf16(v0[2], v0[3]); w.z = pg8::cvt_pk_bf16(v1[0], v1[1]); w.w = pg8::cvt_pk_bf16(v1[2], v1[3]);
                *(u32x4*)(H + row * 256 + u.pn * 128 + wc * 32 + 8 * fq) = w; }
        return false;
    }
};
__device__ __forceinline__ void phase_moe_gu2(ArgsRef a, int l, int tid, int bid, int G) {
    { SchedMoE S{0, G, bid, a.ws, (const unsigned*)(a.ws + OFF_CTL) + 64}; EpiH E{(bf16_t*)(a.ws + OFF_H)};
      pg8::gemm_phase((PG8_LAS unsigned char*)smem, tid, 1024, 1024, 1024, S, E); }
    if (l + 1 < NLAYER) {
        asm volatile("" : "+v"(tid), "+s"(bid), "+s"(G));
        const int ntile = (int)(((const unsigned*)(a.ws + OFF_CTL))[64 + 32] >> 8); int nb = ntile * 2 - G; nb = nb < 0 ? 0 : (nb > G - 1 ? G - 1 : nb);
        if (bid >= nb) phase_prep(a, l + 1, tid, bid - nb, G - nb);
    }
}
__device__ __forceinline__ void phase_moe_dn2(ArgsRef a, int tid, int bid, int G) {
    SchedMoE S{1, G, bid, a.ws, (const unsigned*)(a.ws + OFF_CTL) + 64}; EpiBf16<0> E{(bf16_t*)(a.ws + OFF_YS), 1024, nullptr, 0};
    pg8::gemm_phase((PG8_LAS unsigned char*)smem, tid, 256, 256, 256, S, E);
}
#define XB_TMO      128
#define XB_XCNT(j)  (256  + 64 * (j))
#define XB_XSUB(j)  (1280 + 64 * (j))
#define XB_XGEN(j)  (2304 + 64 * (j))
#define XB_TOP      3328
#define XB_TOPGEN   3392
#define XCD_BAR_WORDS 3456
#define XB_SPIN_CAP (1u << 22)
__device__ __forceinline__ unsigned xb_ld(unsigned* p)              { return __hip_atomic_load(p, __ATOMIC_RELAXED, __HIP_MEMORY_SCOPE_AGENT); }
__device__ __forceinline__ unsigned xb_add(unsigned* p, unsigned v) { return __hip_atomic_fetch_add(p, v, __ATOMIC_RELAXED, __HIP_MEMORY_SCOPE_AGENT); }
__device__ __forceinline__ unsigned xb_xcc_id() { return (unsigned)__builtin_amdgcn_s_getreg((3 << 11) | 20) & 0xFu; }
#define XB_SPIN(cond, bar) do { unsigned _sp = 0; while (cond) { __builtin_amdgcn_s_sleep(1); \
    if ((++_sp & 255u) == 0u) { if (xb_ld(&(bar)[XB_TMO])) break; if (_sp > XB_SPIN_CAP) { atomicAdd(&(bar)[XB_TMO], 1u); break; } } } } while (0)
__device__ __forceinline__ void xcd_barrier_complete(unsigned* bar, unsigned x, unsigned& nloc, unsigned& nx) {
    const unsigned G = gridDim.x; unsigned sum, cnt, mine, sp = 0u;
    for (;;) { sum = 0u; cnt = 0u; mine = 0u;
#pragma unroll
        for (unsigned j = 0; j < 16; ++j) { const unsigned c = xb_ld(&bar[XB_XCNT(j)]); sum += c; cnt += (c > 0u) ? 1u : 0u; mine = (j == x) ? c : mine; }
        if (sum == G) break;
        __builtin_amdgcn_s_sleep(1);
        if ((++sp & 255u) == 0u) { if (xb_ld(&bar[XB_TMO])) break; if (sp > XB_SPIN_CAP) { atomicAdd(&bar[XB_TMO], 1u); break; } } }
    nloc = mine > 0u ? mine : 1u; nx = cnt > 0u ? cnt : 1u;
}
__device__ __forceinline__ void xcd_barrier(unsigned* bar, volatile __attribute__((address_space(3))) unsigned* st) {
    asm volatile("s_waitcnt vmcnt(0)" ::: "memory");
    __syncthreads();
    if (threadIdx.x == 0) {
        __builtin_amdgcn_s_waitcnt(0);
        const unsigned x = xb_xcc_id();
        unsigned nloc = st[0], nx = st[1];
        if (nloc == 0u) { xcd_barrier_complete(bar, x, nloc, nx); st[0] = nloc; st[1] = nx; }
        const unsigned old = xb_add(&bar[XB_XSUB(x)], 1u);
        const unsigned gen = old / nloc;
        if (old + 1u == (gen + 1u) * nloc) {
            __builtin_amdgcn_fence(__ATOMIC_RELEASE, "agent");
            asm volatile("s_waitcnt vmcnt(0)" ::: "memory");
            const unsigned og = xb_add(&bar[XB_TOP], 1u);
            const unsigned tg = og / nx;
            if (og + 1u == (tg + 1u) * nx) xb_add(&bar[XB_TOPGEN], 1u);
            else XB_SPIN(xb_ld(&bar[XB_TOPGEN]) == tg, bar);
            __builtin_amdgcn_fence(__ATOMIC_ACQUIRE, "agent");
            xb_add(&bar[XB_XGEN(x)], 1u);
            asm volatile("s_waitcnt vmcnt(0)" ::: "memory");
        } else {
            XB_SPIN(xb_ld(&bar[XB_XGEN(x)]) == gen, bar);
            __builtin_amdgcn_fence(__ATOMIC_ACQUIRE, "agent");
            asm volatile("s_waitcnt vmcnt(0)" ::: "memory");
        }
    }
    __syncthreads();
}

__device__ __forceinline__ ArgsRef fresh_args() { unsigned long long p = (unsigned long long)__builtin_amdgcn_kernarg_segment_ptr(); asm volatile("" : "+s"(p)); return *(const __attribute__((address_space(4))) Args*)p; }
__global__ void __launch_bounds__(512) fwd(Args a_unused) {
    cg::grid_group grid = cg::this_grid();
    volatile __attribute__((address_space(3))) unsigned* bst = (volatile __attribute__((address_space(3))) unsigned*)((__attribute__((address_space(3))) unsigned char*)smem + 131072);
    if (threadIdx.x < 4) bst[threadIdx.x] = 0u;
    __syncthreads();
    { ArgsRef a0 = fresh_args(); if (threadIdx.x == 0) (void)xb_add(&((unsigned*)(a0.ws + OFF_BAR))[XB_XCNT(xb_xcc_id())], 1u); }
#define GSYNC() do { asm volatile("" ::: "memory"); { ArgsRef ab = fresh_args(); xcd_barrier((unsigned*)(ab.ws + OFF_BAR), bst); } asm volatile("" ::: "memory"); } while (0)
#define GSYNC_CG() do { asm volatile("" ::: "memory"); grid.sync(); asm volatile("" ::: "memory"); } while (0)
    const int wave_s = __builtin_amdgcn_readfirstlane((int)threadIdx.x >> 6);
#define PH(body) do { int wave = wave_s; asm volatile("" : "+s"(wave)); int lane; asm volatile("v_mbcnt_lo_u32_b32 %0, -1, 0\n\tv_mbcnt_hi_u32_b32 %0, -1, %0" : "=v"(lane)); \
        int bid = blockIdx.x, G = gridDim.x; asm volatile("" : "+s"(bid), "+s"(G)); \
        const int tid = wave * 64 + lane, gw = bid * 8 + wave, GW = G * 8; (void)tid; (void)gw; (void)GW; ArgsRef a = fresh_args(); body; } while (0)
#pragma unroll 1
    for (int l = 0; l < NLAYER; ++l) {
        if (l == 0) { PH(phase_prep(a, 0, tid, bid, G)); GSYNC_CG(); }
        PH(phase_zgemm2(a, l, tid, bid, G)); GSYNC();
        PH(phase_v_conv(a, l, tid, bid, G)); GSYNC();
        PH(phase_qk(a, tid, bid, G)); GSYNC();
        PH(phase_mixers<1>(a, l, tid, lane, wave, bid, G)); GSYNC();
        PH(phase_scan(a, tid, bid, G)); GSYNC();
        PH(phase_mixers<2>(a, l, tid, lane, wave, bid, G)); GSYNC();
        PH(phase_glu_gates(a, l, tid, bid, G)); GSYNC();
        PH(phase_merge2(a, tid, bid, G)); GSYNC();
        PH(phase_wout2(a, l, tid, bid, G)); GSYNC();
        PH(phase_ln1r(a, l, tid, lane, wave, bid, G)); PH(if (G < 256) phase_prepx(a, l, tid, bid, G, 896, 6144)); GSYNC();
        PH(phase_slot(a, tid, lane, wave, bid, G)); GSYNC();
        PH(phase_moe_gu2(a, l, tid, bid, G)); GSYNC();
        PH(phase_moe_dn2(a, tid, bid, G)); GSYNC();
        PH(phase_ln2(a, l, lane, gw, GW)); if (l + 1 < NLAYER) GSYNC();
    }
}

extern "C" void kernel_launch(void* const* d_in, const int* in_sizes, int n_in, void* d_out, int out_size, void* d_ws, size_t ws_size, hipStream_t stream) {
    static int grid = 0;
    if (grid == 0) {
        if (n_in != 34 || out_size != T * D || ws_size < WS_TOTAL) { fprintf(stderr, "kernel_launch: unexpected shapes (n_in %d, out %d, ws %zu, need %zu)\n", n_in, out_size, ws_size, (size_t)WS_TOTAL); grid = -1; return; }
        int dev = 0, cus = 0, per_cu = 0;
        (void)hipGetDevice(&dev); (void)hipDeviceGetAttribute(&cus, hipDeviceAttributeMultiprocessorCount, dev);
        (void)hipFuncSetAttribute((const void*)fwd, hipFuncAttributeMaxDynamicSharedMemorySize, LDS_BYTES);
        (void)hipOccupancyMaxActiveBlocksPerMultiprocessor(&per_cu, (const void*)fwd, 512, LDS_BYTES);
        if (per_cu < 1) { fprintf(stderr, "kernel_launch: occupancy query says %d blocks per CU\n", per_cu); per_cu = 1; }
        grid = (cus > 0 ? cus : 256) * 1;
        (void)hipGetLastError();
    }
    if (grid < 0) return;
    Args a{};
    for (int i = 0; i < 34; ++i) a.in[i] = (const float*)d_in[i];
    a.out = (float*)d_out; a.ws = (unsigned char*)d_ws; a.ph_lo = 0; a.ph_hi = NLAYER * NPH;
    (void)hipMemsetAsync((unsigned char*)d_ws + OFF_BAR, 0, 16384, stream);
    void* args[] = {&a};
    hipError_t e = hipLaunchCooperativeKernel((const void*)fwd, dim3(grid), dim3(512), args, LDS_BYTES, stream);
    if (e != hipSuccess) fprintf(stderr, "kernel_launch: cooperative launch failed: %s (grid %d)\n", hipGetErrorString(e), grid);
}
```

```cpp
#include <hip/hip_runtime.h>
#include <hip/hip_cooperative_groups.h>
#include <cstdio>
#include <cstdint>
namespace cg = cooperative_groups;

typedef unsigned short bf16_t;
typedef short bf16x8 __attribute__((ext_vector_type(8)));
typedef short bf16x4 __attribute__((ext_vector_type(4)));
typedef float f32x4 __attribute__((ext_vector_type(4)));
typedef unsigned u32x4 __attribute__((ext_vector_type(4)));
typedef unsigned u32x2 __attribute__((ext_vector_type(2)));

constexpr int T = 16384, D = 1024, NZ = 3584, NWIN = 6912, INW = 6664;
constexpr int NPH = 15, NLAYER = 2;
constexpr int GSEG = 32, GSEGLEN = 512;
constexpr int SSEG = 64, SSEGLEN = 256;
constexpr int SLOTS = 40960;
constexpr float DN_ALPHA = 1.41421356237f;
constexpr int LDS_BYTES = 131072 + 256;

constexpr size_t AL(size_t x) { return (x + 255) & ~(size_t)255; }
constexpr size_t OFF_WIN = 0;
constexpr size_t OFF_WQKV = OFF_WIN + AL((size_t)NWIN * 1024 * 2);
constexpr size_t OFF_WGLU = OFF_WQKV + AL((size_t)1536 * 512 * 2);
constexpr size_t OFF_WB = OFF_WGLU + AL((size_t)512 * 512 * 2);
constexpr size_t OFF_WOUT = OFF_WB + AL((size_t)3 * 1024 * 512 * 2);
constexpr size_t OFF_ABAR = OFF_WOUT + AL((size_t)1024 * 1024 * 2);
constexpr size_t OFF_BBT = OFF_ABAR + AL((size_t)32 * 64 * 2 * 4);
constexpr size_t OFF_CCT = OFF_BBT + AL((size_t)32 * 128 * 16 * 2);
constexpr size_t OFF_CTL = OFF_CCT + AL((size_t)32 * 16 * 128 * 2);
constexpr size_t OFF_TOKE = OFF_CTL + 4096;
constexpr size_t OFF_TOKG = OFF_TOKE + AL((size_t)T * 2 * 4);
constexpr size_t OFF_TOKS = OFF_TOKG + AL((size_t)T * 2 * 4);
constexpr size_t OFF_SLOTT = OFF_TOKS + AL((size_t)T * 2 * 4);
constexpr size_t OFF_XB = OFF_SLOTT + AL((size_t)SLOTS * 4);
constexpr size_t OFF_R1 = OFF_XB + AL((size_t)T * 1024 * 2);
constexpr size_t SZ_ACT = (size_t)T * 512 * 2;
constexpr size_t OFF_XC = OFF_R1, OFF_Q = OFF_R1 + SZ_ACT, OFF_KH = OFF_R1 + 2 * SZ_ACT, OFF_V = OFF_R1 + 3 * SZ_ACT;
constexpr size_t OFF_WGU = OFF_R1, OFF_WD = OFF_R1 + (size_t)32 * 512 * 1024 * 2;
constexpr size_t OFF_Z = OFF_R1 + 4 * SZ_ACT;
constexpr size_t OFF_XG = OFF_Z, OFF_H = OFF_Z + (size_t)SLOTS * 1024 * 2;
constexpr size_t OFF_ZS = OFF_Z + AL((size_t)T * NZ * 2);
constexpr size_t OFF_LF = OFF_ZS + AL((size_t)T * 8 * 4);
constexpr size_t OFF_LI = OFF_LF + AL((size_t)T * 4 * 4);
constexpr size_t OFF_E = OFF_LI + AL((size_t)T * 4 * 4);
constexpr size_t OFF_OM = OFF_E, OFF_OH = OFF_E + SZ_ACT, OFF_YPRE = OFF_E + 2 * SZ_ACT, OFF_YSG = OFF_E + 3 * SZ_ACT;
constexpr size_t OFF_DEN = OFF_E + 4 * SZ_ACT;
constexpr size_t OFF_EM = OFF_DEN + AL((size_t)T * 4 * 4);
constexpr size_t OFF_EMX = OFF_EM + AL((size_t)GSEG * 4 * 128 * 128 * 4);
constexpr size_t OFF_GM = OFF_EMX + AL((size_t)GSEG * 4 * 128 * 16 * 4);
constexpr size_t OFF_EH = OFF_GM + AL((size_t)GSEG * 4 * 128 * 4);
constexpr size_t OFF_GH = OFF_EH + AL((size_t)GSEG * 4 * 128 * 128 * 4);
constexpr size_t OFF_ES = OFF_GH + AL((size_t)GSEG * 4 * 128 * 4);
constexpr size_t WS_END = OFF_ES + AL((size_t)SSEG * 32 * 64 * 2 * 4);
constexpr size_t OFF_YS = OFF_E;
constexpr size_t OFF_RWT = WS_END;
constexpr size_t OFF_HIST = OFF_RWT + 32 * 1024 * 4;
constexpr size_t OFF_BAR = OFF_HIST + 1024 * 32 * 4;
constexpr size_t WS_TOTAL = OFF_BAR + 16384;
static_assert(OFF_YS + (size_t)SLOTS * 1024 * 2 <= WS_END, "YS must fit in the dead region");
static_assert(OFF_H + (size_t)SLOTS * 256 * 2 <= OFF_ZS, "H must fit in the dead Z region");
static_assert(OFF_WD + (size_t)32 * 1024 * 256 * 2 <= OFF_Z, "expert weights must fit in R1");

struct Args { const float* in[34]; float* out; unsigned char* ws; int ph_lo, ph_hi; };
typedef const __attribute__((address_space(4))) Args& ArgsRef;

extern __shared__ __attribute__((aligned(16))) unsigned char smem[];

__device__ __forceinline__ bf16_t f2bf(float f) { return __builtin_bit_cast(unsigned short, (__bf16)f); }
__device__ __forceinline__ float bf2f(bf16_t b) { return __uint_as_float(((unsigned)b) << 16); }
__device__ __forceinline__ unsigned pack2(float lo, float hi) { typedef __bf16 bf2_t __attribute__((ext_vector_type(2))); bf2_t v; v[0] = (__bf16)lo; v[1] = (__bf16)hi; return __builtin_bit_cast(unsigned, v); }
__device__ __forceinline__ float fexp(float x) { return __builtin_amdgcn_exp2f(x * 1.4426950408889634f); }
__device__ __forceinline__ float flog(float x) { return __builtin_amdgcn_logf(x) * 0.6931471805599453f; }
__device__ __forceinline__ float sigmoidf_(float x) { return __builtin_amdgcn_rcpf(1.0f + fexp(-x)); }
__device__ __forceinline__ float siluf_(float x) { return x * __builtin_amdgcn_rcpf(1.0f + fexp(-x)); }
__device__ __forceinline__ float logsigmoidf_(float x) { return fminf(x, 0.f) - log1pf(expf(-fabsf(x))); }
__device__ __forceinline__ float gelu_tanh(float y) { const float z = 0.7978845608028654f * (y + 0.044715f * y * y * y); const float th = 1.0f - 2.0f * __builtin_amdgcn_rcpf(fexp(2.0f * z) + 1.0f); return 0.5f * y * (1.0f + th); }
__device__ __forceinline__ void wave_sync() { __builtin_amdgcn_wave_barrier(); asm volatile("s_waitcnt lgkmcnt(0)" ::: "memory"); __builtin_amdgcn_wave_barrier(); }

#define MFMA16(a, b, c) __builtin_amdgcn_mfma_f32_16x16x32_bf16((a), (b), (c), 0, 0, 0)

template <int MT, int NT, class FA, class FB>
__device__ __forceinline__ void wave_gemm(f32x4 (&acc)[MT][NT], int K, FA arow, FB brow, int lane) {
    const int r = lane & 15, q = lane >> 4;
    const bf16_t* ap[MT]; const bf16_t* bp[NT];
#pragma unroll
    for (int m = 0; m < MT; ++m) ap[m] = arow(m * 16 + r) + 8 * q;
#pragma unroll
    for (int n = 0; n < NT; ++n) bp[n] = brow(n * 16 + r) + 8 * q;
#pragma unroll 1
    for (int k = 0; k < K; k += 32) {
        bf16x8 a[MT], b[NT];
#pragma unroll
        for (int m = 0; m < MT; ++m) a[m] = *(const bf16x8*)(ap[m] + k);
#pragma unroll
        for (int n = 0; n < NT; ++n) b[n] = *(const bf16x8*)(bp[n] + k);
#pragma unroll
        for (int m = 0; m < MT; ++m)
#pragma unroll
            for (int n = 0; n < NT; ++n) acc[m][n] = MFMA16(a[m], b[n], acc[m][n]);
    }
}
template <int MT, int NT> __device__ __forceinline__ void zero_acc(f32x4 (&acc)[MT][NT]) {
#pragma unroll
    for (int m = 0; m < MT; ++m)
#pragma unroll
        for (int n = 0; n < NT; ++n) acc[m][n] = (f32x4){0.f, 0.f, 0.f, 0.f};
}

namespace pg8 {
#define PG8_LAS __attribute__((address_space(3)))
constexpr int BM = 256, BK = 64, HALF = 128, HTB = HALF * BK * 2, STAGE_BYTES = 8 * HTB;
__device__ __forceinline__ int lds_byte(int r, int c) { const int st = (r >> 4) * 2 + (c >> 5), rr = r & 15, cc = c & 31, ob = rr * 64 + cc * 2; return st * 1024 + (ob ^ (((ob >> 9) & 1) << 5)); }
__device__ __forceinline__ void stage_rc(int b, int& R, int& C) { const int st = b / 1024, sb = b % 1024, swz = sb ^ (((sb >> 9) & 1) << 5); R = (st >> 1) * 16 + swz / 64; C = (st & 1) * 32 + (swz % 64) / 2; }
__device__ __forceinline__ int perm32(int rho) { const int n = rho >> 4, i = rho & 15; return 8 * (i >> 2) + 4 * n + (i & 3); }
struct Unit { int pm, pn, tag; const char* A; const char* B; };
__device__ __forceinline__ unsigned cvt_pk_bf16(float lo, float hi) { unsigned r; asm volatile("v_cvt_pk_bf16_f32 %0, %1, %2" : "=v"(r) : "v"(lo), "v"(hi)); return r; }
__device__ __forceinline__ bool tile_order(int L, int nM, int nN, int& pm, int& pn) {
    const int nwg = nM * nN; if (L >= nwg) return false;
    int wgid = L; { const int q = nwg / 8, r = nwg % 8, xcd = wgid % 8, off = wgid / 8; wgid = (xcd < r ? xcd * (q + 1) : r * (q + 1) + (xcd - r) * q) + off; }
    const int nig = 8 * nN, gid = wgid / nig, fm = gid * 8, gsz = (nM - fm) < 8 ? (nM - fm) : 8;
    pm = fm + ((wgid % nig) % gsz); pn = (wgid % nig) / gsz; return true;
}
template <class Epi, class Sched>
__device__ __forceinline__ void gemm_phase(PG8_LAS unsigned char* lds, const int tid, const int K, const int lda, const int ldb, const Sched& S, const Epi& E) {
    const int wid = __builtin_amdgcn_readfirstlane(tid >> 6), lane = tid & 63, wr = wid >> 2, wc = wid & 3, fr = lane & 15, fq = lane >> 4;
    const int nt = K / BK;
    unsigned voffA[2], voffB[2];
#pragma unroll
    for (int i = 0; i < 2; ++i) { int R, C; stage_rc(tid * 16 + i * 8192, R, C); const int Rb = Epi::PERM ? ((R & ~31) + perm32(R & 31)) : R;
        voffA[i] = (unsigned)(R * lda + C) * 2u; voffB[i] = (unsigned)(Rb * ldb + C) * 2u; }
    const size_t kstep = (size_t)(BK * 2), hstepA = (size_t)HALF * lda * 2, hstepB = (size_t)HALF * ldb * 2;
    const unsigned ldsw = (unsigned)wid * 1024u;
    const int aoff = lds_byte(wr * 64 + fr, fq * 8), boff = lds_byte(wc * 32 + fr, fq * 8);
#define PG8_SA(b, h) (((b) * 2 + (h)) * HTB)
#define PG8_SB(b, h) ((4 + (b) * 2 + (h)) * HTB)
#define PG8_STAGE(bufoff, gbase, voff) do { _Pragma("unroll") for (int _i = 0; _i < 2; ++_i) \
        __builtin_amdgcn_global_load_lds((const unsigned*)((const char*)(gbase) + (voff)[_i]), (PG8_LAS unsigned*)(lds + (bufoff) + ldsw + _i * 8192), 16, 0, 0); } while (0)
#define PG8_LDA(dst, b, h) do { _Pragma("unroll") for (int m = 0; m < 4; ++m) _Pragma("unroll") for (int k = 0; k < 2; ++k) dst[m][k] = *(const PG8_LAS bf16x8*)(lds + PG8_SA(b, h) + aoff + m * 2048 + k * 1024); } while (0)
#define PG8_LDB(dst, b, h) do { _Pragma("unroll") for (int n = 0; n < 2; ++n) _Pragma("unroll") for (int k = 0; k < 2; ++k) dst[n][k] = *(const PG8_LAS bf16x8*)(lds + PG8_SB(b, h) + boff + n * 2048 + k * 1024); } while (0)
#define PG8_MMA(ai, bj, At, Bt) do { __builtin_amdgcn_s_setprio(1); _Pragma("unroll") for (int m = 0; m < 4; ++m) _Pragma("unroll") for (int n = 0; n < 2; ++n) _Pragma("unroll") for (int k = 0; k < 2; ++k) \
        acc[ai][bj][m][n] = __builtin_amdgcn_mfma_f32_16x16x32_bf16(Bt[n][k], At[m][k], acc[ai][bj][m][n], 0, 0, 0); __builtin_amdgcn_s_setprio(0); } while (0)
#define PG8_WAIT_V(n) asm volatile("s_waitcnt vmcnt(" #n ")" ::: "memory")
#define PG8_WAIT_L(n) asm volatile("s_waitcnt lgkmcnt(" #n ")" ::: "memory")
#define PG8_BAR __builtin_amdgcn_s_barrier()
#define PG8_SCHED __builtin_amdgcn_sched_barrier(0)
    Unit cur, nxt; int ui = 0;
    if (!S.next(0, cur)) return;
    f32x4 acc[2][2][4][2];
#pragma unroll
    for (int a = 0; a < 2; ++a)
#pragma unroll
        for (int b = 0; b < 2; ++b)
#pragma unroll
            for (int m = 0; m < 4; ++m)
#pragma unroll
                for (int n = 0; n < 2; ++n) acc[a][b][m][n] = (f32x4){0.f, 0.f, 0.f, 0.f};
    bf16x8 At[4][2], B0[2][2], B1[2][2];
    const char* cA = cur.A; const char* cB = cur.B;
    PG8_STAGE(PG8_SB(0, 0), cB, voffB); PG8_STAGE(PG8_SA(0, 0), cA, voffA); PG8_STAGE(PG8_SB(0, 1), cB + hstepB, voffB); PG8_STAGE(PG8_SA(0, 1), cA + hstepA, voffA);
    if (wr == 1) PG8_BAR;
    PG8_WAIT_V(4); PG8_BAR;
    PG8_STAGE(PG8_SB(1, 0), cB + kstep, voffB); PG8_STAGE(PG8_SA(1, 0), cA + kstep, voffA); PG8_STAGE(PG8_SB(1, 1), cB + hstepB + kstep, voffB);
    PG8_WAIT_V(6); PG8_BAR;
    for (;;) {
        const bool has_next = S.next(ui + 1, nxt);
        const char* nA = has_next ? nxt.A : cA; const char* nB = has_next ? nxt.B : cB;
        for (int t = 0; t < nt; t += 2) {
            const bool last = (t == nt - 2);
            const char* a1 = cA + (size_t)(t + 1) * kstep;
            const char* a2 = last ? nA : cA + (size_t)(t + 2) * kstep; const char* b2 = last ? nB : cB + (size_t)(t + 2) * kstep;
            const char* a3 = a2 + kstep; const char* b3 = b2 + kstep;
            PG8_LDB(B0, 0, 0); PG8_SCHED; PG8_LDA(At, 0, 0); PG8_STAGE(PG8_SA(1, 1), a1 + hstepA, voffA);
            PG8_WAIT_L(8); PG8_BAR; PG8_WAIT_L(0); PG8_MMA(0, 0, At, B0); PG8_BAR; PG8_SCHED;
            PG8_LDB(B1, 0, 1); PG8_STAGE(PG8_SB(0, 0), b2, voffB);
            PG8_BAR; PG8_WAIT_L(0); PG8_MMA(0, 1, At, B1); PG8_BAR;
            PG8_LDA(At, 0, 1); PG8_STAGE(PG8_SA(0, 0), a2, voffA);
            PG8_BAR; PG8_WAIT_L(0); PG8_MMA(1, 0, At, B0); PG8_BAR; PG8_SCHED;
            PG8_STAGE(PG8_SB(0, 1), b2 + hstepB, voffB);
            PG8_WAIT_V(6); PG8_BAR; PG8_MMA(1, 1, At, B1); PG8_BAR;
            PG8_LDB(B0, 1, 0); PG8_SCHED; PG8_LDA(At, 1, 0); PG8_STAGE(PG8_SA(0, 1), a2 + hstepA, voffA);
            PG8_WAIT_L(8); PG8_BAR; PG8_WAIT_L(0); PG8_MMA(0, 0, At, B0); PG8_BAR; PG8_SCHED;
            PG8_LDB(B1, 1, 1); PG8_STAGE(PG8_SB(1, 0), b3, voffB);
            PG8_BAR; PG8_WAIT_L(0); PG8_MMA(0, 1, At, B1); PG8_BAR;
            PG8_LDA(At, 1, 1); PG8_STAGE(PG8_SA(1, 0), a3, voffA);
            PG8_BAR; PG8_WAIT_L(0); PG8_MMA(1, 0, At, B0); PG8_BAR; PG8_SCHED;
            PG8_STAGE(PG8_SB(1, 1), b3 + hstepB, voffB);
            PG8_WAIT_V(6); PG8_BAR; PG8_MMA(1, 1, At, B1); PG8_BAR;
        }
        const bool keep = E(acc, cur, wr, wc, fr, fq);
        if (!has_next) break;
        if (!keep) {
#pragma unroll
            for (int a = 0; a < 2; ++a)
#pragma unroll
                for (int b = 0; b < 2; ++b)
#pragma unroll
                    for (int m = 0; m < 4; ++m)
#pragma unroll
                        for (int n = 0; n < 2; ++n) acc[a][b][m][n] = (f32x4){0.f, 0.f, 0.f, 0.f};
        }
        cur = nxt; cA = nA; cB = nB; ++ui;
    }
    PG8_WAIT_V(0);
    if (wr == 0) PG8_BAR;
    PG8_BAR;
#undef PG8_SA
#undef PG8_SB
#undef PG8_STAGE
#undef PG8_LDA
#undef PG8_LDB
#undef PG8_MMA
#undef PG8_WAIT_V
#undef PG8_WAIT_L
#undef PG8_BAR
#undef PG8_SCHED
}
}

__device__ __forceinline__ void tconv_tile(const float* src, int ld_src, int nvalid, bf16_t* dst, int ld_dst, int tid) {
    float* t = (float*)smem;
    { const int r = tid >> 3, c0 = (tid & 7) * 8; float v[8];
      if (nvalid == 64) { const f32x4 a0 = *(const f32x4*)(src + (size_t)r * ld_src + c0), a1 = *(const f32x4*)(src + (size_t)r * ld_src + c0 + 4);
          v[0] = a0[0]; v[1] = a0[1]; v[2] = a0[2]; v[3] = a0[3]; v[4] = a1[0]; v[5] = a1[1]; v[6] = a1[2]; v[7] = a1[3]; }
      else {
#pragma unroll
          for (int j = 0; j < 8; ++j) { const int c = c0 + j; v[j] = (c < nvalid) ? src[(size_t)r * ld_src + c] : 0.f; } }
#pragma unroll
      for (int j = 0; j < 8; ++j) t[(c0 + j) * 65 + r] = v[j]; }
    __syncthreads();
    { const int n = tid >> 3, k0 = (tid & 7) * 8; const float* p = t + n * 65 + k0;
      u32x4 w; w.x = pack2(p[0], p[1]); w.y = pack2(p[2], p[3]); w.z = pack2(p[4], p[5]); w.w = pack2(p[6], p[7]);
      *(u32x4*)(dst + (size_t)n * ld_dst + k0) = w; }
    __syncthreads();
}

__device__ __forceinline__ void wave_tconv(const float* src, int ld_src, bf16_t* dst, int ld_dst, int lane, float* t  ) {
    f32x4 v[16]; const int rq = lane >> 4, c4 = (lane & 15) * 4;
#pragma unroll
    for (int i = 0; i < 16; ++i) v[i] = *(const f32x4*)(src + (size_t)(4 * i + rq) * ld_src + c4);
#pragma unroll
    for (int i = 0; i < 16; ++i)
#pragma unroll
        for (int j = 0; j < 4; ++j) t[(c4 + j) * 65 + 4 * i + rq] = v[i][j];
    wave_sync();
    const int rr = lane >> 3, k8 = (lane & 7) * 8;
#pragma unroll
    for (int i = 0; i < 8; ++i) { const float* p = t + (8 * i + rr) * 65 + k8;
        u32x4 w; w.x = pack2(p[0], p[1]); w.y = pack2(p[2], p[3]); w.z = pack2(p[4], p[5]); w.w = pack2(p[6], p[7]);
        *(u32x4*)(dst + (size_t)(8 * i + rr) * ld_dst + k8) = w; }
    wave_sync();
}
__device__ __forceinline__ void wave_prepx_tile(ArgsRef a, int l, int u, int lane, float* t) {
    bf16_t* WGU = (bf16_t*)(a.ws + OFF_WGU); bf16_t* WD = (bf16_t*)(a.ws + OFF_WD);
    if (u < 4096) { const int up = u >= 2048, v = u & 2047, e = v / 64, w = v % 64, nt = w / 16, kt = w % 16, j0 = nt * 64, drow = (j0 / 128) * 256 + (j0 % 128) + up * 128;
        wave_tconv(a.in[31 + up] + ((size_t)(l * 32 + e) * 1024 + kt * 64) * 256 + nt * 64, 256, WGU + ((size_t)e * 512 + drow) * 1024 + kt * 64, 1024, lane, t); }
    else { const int v = u - 4096, e = v / 64, w = v % 64, nt = w / 4, kt = w % 4;
        wave_tconv(a.in[33] + ((size_t)(l * 32 + e) * 256 + kt * 64) * 1024 + nt * 64, 1024, WD + ((size_t)e * 1024 + nt * 64) * 256 + kt * 64, 256, lane, t); }
}
__device__ __forceinline__ void phase_prep(ArgsRef a, int l, int tid, int bid, int G) {
    unsigned char* ws = a.ws;
    bf16_t* WIN = (bf16_t*)(ws + OFF_WIN); bf16_t* WQKV = (bf16_t*)(ws + OFF_WQKV); bf16_t* WGLU = (bf16_t*)(ws + OFF_WGLU);
    bf16_t* WB = (bf16_t*)(ws + OFF_WB); bf16_t* WOUT = (bf16_t*)(ws + OFF_WOUT);
    for (int u = bid; u < 2624; u += G) {
        const float* src; int lds_ = 0, nvalid = 64, ldd = 0; bf16_t* dst;
        if (u < 1728) { const int nt = u / 16, kt = u % 16, p0 = nt * 64; int sc;
            if (p0 < 1024) sc = p0; else if (p0 < 6656) sc = p0 + 8; else if (p0 == 6656) { sc = 1024; nvalid = 8; } else { sc = 0; nvalid = 0; }
            src = a.in[1] + (size_t)l * 1024 * INW + (size_t)(kt * 64) * INW + sc; lds_ = INW; dst = WIN + (size_t)p0 * 1024 + kt * 64; ldd = 1024; }
        else if (u < 1920) { const int v = u - 1728, nt = v / 8, kt = v % 8, which = nt / 8, h = (nt % 8) / 2;
            if ((kt >> 1) != h) nvalid = 0;
            src = a.in[4 + which] + (size_t)(l * 4 + h) * 128 * 128 + ((kt & 1) * 64) * 128 + (nt & 1) * 64; lds_ = 128; dst = WQKV + (size_t)(nt * 64) * 512 + kt * 64; ldd = 512; }
        else if (u < 1984) { const int v = u - 1920, nt = v / 8, kt = v % 8;
            src = a.in[18] + (size_t)l * 512 * 512 + (kt * 64) * 512 + nt * 64; lds_ = 512; dst = WGLU + (size_t)(nt * 64) * 512 + kt * 64; ldd = 512; }
        else if (u < 2368) { const int v = u - 1984, b = v / 128, w = v % 128, nt = w / 8, kt = w % 8;
            src = a.in[21 + b] + (size_t)l * 512 * 1024 + (size_t)(kt * 64) * 1024 + nt * 64; lds_ = 1024; dst = WB + (size_t)b * 1024 * 512 + (size_t)(nt * 64) * 512 + kt * 64; ldd = 512; }
        else { const int v = u - 2368, nt = v / 16, kt = v % 16;
            src = a.in[24] + (size_t)l * 1024 * 1024 + (size_t)(kt * 64) * 1024 + nt * 64; lds_ = 1024; dst = WOUT + (size_t)(nt * 64) * 1024 + kt * 64; ldd = 1024; }
        tconv_tile(src, lds_, nvalid, dst, ldd, tid);
    }
    float* ABAR = (float*)(ws + OFF_ABAR); bf16_t* BBT = (bf16_t*)(ws + OFF_BBT); bf16_t* CCT = (bf16_t*)(ws + OFF_CCT);
    for (int i = bid * 512 + tid; i < 2048; i += G * 512) {
        const int g = i / 64, p = i % 64; const size_t gp = (size_t)(l * 32 + g) * 64 + p;
        const float lr = fminf(a.in[10][gp], -1e-4f), li = a.in[11][gp], dt = expf(a.in[12][l * 32 + g]);
        const float mag = expf(lr * dt), abr = mag * cosf(li * dt), abi = mag * sinf(li * dt);
        const float nr = abr - 1.0f, den = lr * lr + li * li, cr = (nr * lr + abi * li) / den, ci = (abi * lr - nr * li) / den;
        ABAR[(g * 64 + p) * 2] = abr; ABAR[(g * 64 + p) * 2 + 1] = abi;
        for (int c = 0; c < 16; ++c) { const float br = a.in[13][gp * 16 + c], bi = a.in[14][gp * 16 + c];
            BBT[(size_t)(g * 128 + p) * 16 + c] = f2bf(cr * br - ci * bi); BBT[(size_t)(g * 128 + 64 + p) * 16 + c] = f2bf(cr * bi + ci * br);
            const size_t ci_ = ((size_t)(l * 32 + g) * 16 + c) * 64 + p;
            CCT[(size_t)(g * 16 + c) * 128 + p] = f2bf(a.in[15][ci_]); CCT[(size_t)(g * 16 + c) * 128 + 64 + p] = f2bf(-a.in[16][ci_]); }
    }
    if (l == 0) { float* RWT = (float*)(ws + OFF_RWT); const float* RW = a.in[29]; for (int i = bid * 512 + tid; i < 32 * 1024; i += G * 512) RWT[i] = RW[(i & 1023) * 32 + (i >> 10)]; }
    if (l == 0) { bf16_t* XB = (bf16_t*)(ws + OFF_XB); const float* x = a.in[0];
        for (size_t i = (size_t)bid * 512 + tid; i < (size_t)T * 1024 / 8; i += (size_t)G * 512) {
            const f32x4 v0 = *(const f32x4*)(x + i * 8), v1 = *(const f32x4*)(x + i * 8 + 4);
            u32x4 w; w.x = pack2(v0[0], v0[1]); w.y = pack2(v0[2], v0[3]); w.z = pack2(v1[0], v1[1]); w.w = pack2(v1[2], v1[3]); *(u32x4*)(XB + i * 8) = w; } }
}

__device__ __forceinline__ void phase_prepx(ArgsRef a, int l, int tid, int bid, int G, int u_lo, int u_hi) {
    bf16_t* WGU = (bf16_t*)(a.ws + OFF_WGU); bf16_t* WD = (bf16_t*)(a.ws + OFF_WD);
    for (int u = u_lo + bid; u < u_hi; u += G) {
        const float* src; int lds_, ldd; bf16_t* dst;
        if (u < 4096) { const int up = u >= 2048, v = u & 2047, e = v / 64, w = v % 64, nt = w / 16, kt = w % 16, j0 = nt * 64, drow = (j0 / 128) * 256 + (j0 % 128) + up * 128;
            src = a.in[31 + up] + ((size_t)(l * 32 + e) * 1024 + kt * 64) * 256 + nt * 64; lds_ = 256; dst = WGU + ((size_t)e * 512 + drow) * 1024 + kt * 64; ldd = 1024; }
        else { const int v = u - 4096, e = v / 64, w = v % 64, nt = w / 4, kt = w % 4;
            src = a.in[33] + ((size_t)(l * 32 + e) * 256 + kt * 64) * 1024 + nt * 64; lds_ = 1024; dst = WD + ((size_t)e * 1024 + nt * 64) * 256 + kt * 64; ldd = 256; }
        tconv_tile(src, lds_, 64, dst, ldd, tid);
    }
}

constexpr int GL_RQ = 0, GL_RK = 17408, GL_VT = 34816, GL_RO = 57856, GL_RX = 75264, GL_KT = 92672, GL_PS = 102912, GL_SC1 = 105472, GL_SC2 = 105984, GL_GT = 106496, GL_OS = 108544, GL_LFS = 117248, GL_DNS = 117504;
template <int MODE, int PASS>
__device__ __forceinline__ void gla_item(ArgsRef a, int l, int h, int sg, int tid, int lane, int wave) {
    unsigned char* ws = a.ws;
    const bf16_t* Z = (const bf16_t*)(ws + OFF_Z); const bf16_t* Qg = (const bf16_t*)(ws + OFF_Q); const bf16_t* Kg = (const bf16_t*)(ws + OFF_KH); const bf16_t* Vg = (const bf16_t*)(ws + OFF_V); const bf16_t* XCg = (const bf16_t*)(ws + OFF_XC);
    const float* LF = (const float*)(ws + OFF_LF);
    float* Eg = (float*)(ws + (MODE == 0 ? OFF_EM : OFF_EH)); float* Gg = (float*)(ws + (MODE == 0 ? OFF_GM : OFF_GH)); float* EX = (float*)(ws + OFF_EMX);
    bf16_t* Yg = (bf16_t*)(ws + (MODE == 0 ? OFF_OM : OFF_OH));
    bf16_t* KT = (bf16_t*)(smem + GL_KT); bf16_t* PS = (bf16_t*)(smem + GL_PS);
    float* SC1 = (float*)(smem + GL_SC1); float* SC2 = (float*)(smem + GL_SC2); float* GT = (float*)(smem + GL_GT); bf16_t* OS = (bf16_t*)(smem + GL_OS); float* DNS = (float*)(smem + GL_DNS);
    const int r = lane & 15, q = lane >> 4, grp = tid >> 7, d = tid & 127, tok = tid >> 4, c8 = (tid & 15) * 8;
    const bool xw = (MODE == 0) && (wave == 0);
    float lb = 0.f;
    if (MODE == 1 && l == 1) { const float h0 = a.in[19][h * 128 + d], h1 = a.in[19][512 + h * 128 + d]; lb = 1.0f / (1.0f + expf(h0 - h1)); }
    f32x4 S[8], SX[8];
#pragma unroll
    for (int i = 0; i < 8; ++i) { S[i] = (f32x4){0.f, 0.f, 0.f, 0.f}; SX[i] = (f32x4){0.f, 0.f, 0.f, 0.f}; }
    if (PASS == 2) {
#pragma unroll
        for (int i = 0; i < 8; ++i)
#pragma unroll
            for (int g = 0; g < 4; ++g) { const size_t row = (size_t)(sg * 4 + h) * 128 + 16 * i + 4 * q + g; S[i][g] = Eg[row * 128 + 16 * wave + r]; if (xw) SX[i][g] = EX[row * 16 + r]; }
    }
    const bf16x8 z8 = (bf16x8){0, 0, 0, 0, 0, 0, 0, 0};
    bf16x8 rq = z8, rk = z8, rv = z8, ro = z8, rx = z8; float lfv = 0.f;
#define GLA_FETCH(t0_) do { const size_t tk = (size_t)((t0_) + tok); \
        if (MODE == 1) { const bf16_t* zp = Z + tk * NZ + h * 128 + c8; if (PASS == 2) { rq = *(const bf16x8*)(zp + 1536); ro = *(const bf16x8*)(zp + 3072); } rk = *(const bf16x8*)(zp + 2048); rv = *(const bf16x8*)(zp + 2560); } \
        else { const size_t o_ = tk * 512 + h * 128 + c8; if (PASS == 2) { rq = *(const bf16x8*)(Qg + o_); ro = *(const bf16x8*)(Z + tk * NZ + 512 + h * 128 + c8); rx = *(const bf16x8*)(XCg + o_); } \
               rk = *(const bf16x8*)(Kg + o_); rv = *(const bf16x8*)(Vg + o_); if (tid < 32) lfv = LF[((t0_) + tid) * 4 + h]; } } while (0)
    GLA_FETCH(sg * GSEGLEN);
    float sk8[8], nw8[8];
#pragma unroll
    for (int j = 0; j < 8; ++j) { sk8[j] = (MODE == 0 && PASS == 2) ? a.in[9][l * 512 + h * 128 + c8 + j] : 0.f; nw8[j] = (MODE == 1 && PASS == 2) ? a.in[20][l * 512 + h * 128 + c8 + j] : 0.f; }
    __syncthreads();
    if (MODE == 0) { for (int i = tid; i < 2 * 16 * 40; i += 512) { const int b = i / 640, k = i % 640; ((bf16_t*)(smem + GL_VT + b * 11520))[128 * 40 + k] = (k < 32) ? (bf16_t)0x3F80 : (bf16_t)0; } }
#define GLA_STORE(tprev, pb) do { const bf16x8 o8 = *(const bf16x8*)(OS + tok * 136 + c8); const bf16x8 p8 = *(const bf16x8*)((const bf16_t*)(smem + GL_RO + (pb) * 8704) + tok * 136 + c8); float y[8]; \
        if (MODE == 0) { const bf16x8 x8 = *(const bf16x8*)((const bf16_t*)(smem + GL_RX + (pb) * 8704) + tok * 136 + c8); const float di = __builtin_amdgcn_rcpf(fmaxf(fabsf(DNS[tok]), 1.0f)); \
            _Pragma("unroll") for (int j = 0; j < 8; ++j) y[j] = sigmoidf_(bf2f((bf16_t)p8[j])) * (bf2f((bf16_t)o8[j]) * di) + sk8[j] * bf2f((bf16_t)x8[j]); } \
        else { float ov[8], ss = 0.f; _Pragma("unroll") for (int j = 0; j < 8; ++j) { ov[j] = bf2f((bf16_t)o8[j]); ss += ov[j] * ov[j]; } \
            ss += __shfl_xor(ss, 1); ss += __shfl_xor(ss, 2); ss += __shfl_xor(ss, 4); ss += __shfl_xor(ss, 8); const float rinv = rsqrtf(ss * (1.0f / 128.0f) + 1e-6f); \
            _Pragma("unroll") for (int j = 0; j < 8; ++j) y[j] = ov[j] * rinv * nw8[j] * siluf_(bf2f((bf16_t)p8[j])); } \
        u32x4 w_; w_.x = pack2(y[0], y[1]); w_.y = pack2(y[2], y[3]); w_.z = pack2(y[4], y[5]); w_.w = pack2(y[6], y[7]); *(u32x4*)(Yg + (size_t)((tprev) + tok) * 512 + h * 128 + c8) = w_; } while (0)
    float runb = 0.f;
    for (int ci = 0; ci < GSEGLEN / 32; ++ci) {
        const int t0 = sg * GSEGLEN + ci * 32, buf = ci & 1;
        bf16_t* RQ = (bf16_t*)(smem + GL_RQ + buf * 8704); bf16_t* RK = (bf16_t*)(smem + GL_RK + buf * 8704); bf16_t* VT = (bf16_t*)(smem + GL_VT + buf * 11520);
        float* LFS = (float*)(smem + GL_LFS + buf * 128);
        if (PASS == 2) { *(bf16x8*)(RQ + tok * 136 + c8) = rq; *(bf16x8*)((bf16_t*)(smem + GL_RO + buf * 8704) + tok * 136 + c8) = ro; if (MODE == 0) *(bf16x8*)((bf16_t*)(smem + GL_RX + buf * 8704) + tok * 136 + c8) = rx; }
        *(bf16x8*)(RK + tok * 136 + c8) = rk;
#pragma unroll
        for (int j = 0; j < 8; ++j) VT[(c8 + j) * 40 + tok] = (bf16_t)rv[j];
        if (MODE == 0 && tid < 32) LFS[tid] = lfv;
        if (ci + 1 < GSEGLEN / 32) GLA_FETCH(t0 + 32);
        __syncthreads();
        float lg[8], kv[8];
#pragma unroll
        for (int j = 0; j < 8; ++j) { const float kr = bf2f(RK[(grp * 8 + j) * 136 + d]);
            if (MODE == 1) { const float f = lb + (1.0f - lb) * sigmoidf_(kr); lg[j] = flog(f); kv[j] = 1.0f - f; } else { lg[j] = LFS[grp * 8 + j]; kv[j] = kr; } }
        float cs[8]; cs[0] = lg[0];
#pragma unroll
        for (int j = 1; j < 8; ++j) cs[j] = cs[j - 1] + lg[j];
        GT[grp * 128 + d] = cs[7];
        __syncthreads();
        if (PASS == 2 && ci > 0) GLA_STORE(t0 - 32, buf ^ 1);
        const float g0 = GT[d], g1 = GT[128 + d], g2 = GT[256 + d], g3 = GT[384 + d];
        const float off = grp == 0 ? 0.f : grp == 1 ? g0 : grp == 2 ? g0 + g1 : g0 + g1 + g2;
        const float bmid = g0 + g1, bL = bmid + g2 + g3;
        bf16_t ktv[8];
#pragma unroll
        for (int j = 0; j < 8; ++j) { const float bt = off + cs[j], ek = fexp(bmid - bt); const bf16_t kt = f2bf(kv[j] * ek); ktv[j] = kt;
            if (PASS == 2) { const float qr = bf2f(RQ[(grp * 8 + j) * 136 + d]); const float qq = (MODE == 1) ? siluf_(qr) : qr; RQ[(grp * 8 + j) * 136 + d] = f2bf(qq * __builtin_amdgcn_rcpf(ek)); RK[(grp * 8 + j) * 136 + d] = kt; } }
        { u32x4 w; w.x = ktv[0] | ((unsigned)ktv[1] << 16); w.y = ktv[2] | ((unsigned)ktv[3] << 16); w.z = ktv[4] | ((unsigned)ktv[5] << 16); w.w = ktv[6] | ((unsigned)ktv[7] << 16); *(u32x4*)(KT + d * 40 + grp * 8) = w; }
        if (grp == 0) { SC1[d] = fexp(bmid); SC2[d] = fexp(bL - bmid); runb += bL; }
        __syncthreads();
        if (PASS == 2) {
            if (wave < 4) {
                const int ti = (wave == 1 || wave == 2) ? 1 : 0, tj = (wave >= 2) ? 1 : 0;
                f32x4 p = (f32x4){0.f, 0.f, 0.f, 0.f};
                if (wave < 3) {
#pragma unroll
                    for (int kk = 0; kk < 4; ++kk) { const bf16x8 av = *(const bf16x8*)(RQ + (16 * ti + r) * 136 + 32 * kk + 8 * q); const bf16x8 bv = *(const bf16x8*)(RK + (16 * tj + r) * 136 + 32 * kk + 8 * q); p = MFMA16(av, bv, p); }
                }
#pragma unroll
                for (int g = 0; g < 4; ++g) { const int t = 16 * ti + 4 * q + g, s_ = 16 * tj + r; PS[t * 40 + s_] = (wave < 3 && s_ <= t) ? f2bf(p[g]) : (bf16_t)0; }
            }
            __syncthreads();
        }
        const bf16x8 bV = *(const bf16x8*)(VT + (16 * wave + r) * 40 + 8 * q);
        bf16x8 bV1 = bV; if (xw) bV1 = *(const bf16x8*)(VT + (128 + r) * 40 + 8 * q);
        f32x4 o[2], ox[2];
        o[0] = o[1] = ox[0] = ox[1] = (f32x4){0.f, 0.f, 0.f, 0.f};
#pragma unroll
        for (int kk = 0; kk < 4; ++kk) {
            const f32x4 sa = *(const f32x4*)(SC1 + 32 * kk + 4 * q), sb = *(const f32x4*)(SC1 + 32 * kk + 16 + 4 * q);
            S[2 * kk] *= sa; S[2 * kk + 1] *= sb;
            if (xw) { SX[2 * kk] *= sa; SX[2 * kk + 1] *= sb; }
            if (PASS == 2) {
                bf16x8 bS, bX;
#pragma unroll
                for (int g = 0; g < 4; ++g) { bS[g] = (short)f2bf(S[2 * kk][g]); bS[4 + g] = (short)f2bf(S[2 * kk + 1][g]); bX[g] = (short)f2bf(SX[2 * kk][g]); bX[4 + g] = (short)f2bf(SX[2 * kk + 1][g]); }
#pragma unroll
                for (int mt = 0; mt < 2; ++mt) { const bf16x4 lo = *(const bf16x4*)(RQ + (16 * mt + r) * 136 + 32 * kk + 4 * q), hi = *(const bf16x4*)(RQ + (16 * mt + r) * 136 + 32 * kk + 16 + 4 * q);
                    bf16x8 av; av[0] = lo[0]; av[1] = lo[1]; av[2] = lo[2]; av[3] = lo[3]; av[4] = hi[0]; av[5] = hi[1]; av[6] = hi[2]; av[7] = hi[3];
                    o[mt] = MFMA16(av, bS, o[mt]); if (xw) ox[mt] = MFMA16(av, bX, ox[mt]); }
            }
        }
        if (PASS == 2) {
#pragma unroll
            for (int mt = 0; mt < 2; ++mt) { const bf16x8 av = *(const bf16x8*)(PS + (16 * mt + r) * 40 + 8 * q); o[mt] = MFMA16(av, bV, o[mt]); if (xw) ox[mt] = MFMA16(av, bV1, ox[mt]);
#pragma unroll
                for (int g = 0; g < 4; ++g) { OS[(16 * mt + 4 * q + g) * 136 + 16 * wave + r] = f2bf(o[mt][g]); if (xw && r == 0) DNS[16 * mt + 4 * q + g] = ox[mt][g]; } }
        }
#pragma unroll
        for (int i = 0; i < 8; ++i) { const bf16x8 av = *(const bf16x8*)(KT + (16 * i + r) * 40 + 8 * q); const f32x4 s2 = *(const f32x4*)(SC2 + 16 * i + 4 * q);
            S[i] = MFMA16(av, bV, S[i]); S[i] *= s2;
            if (xw) { SX[i] = MFMA16(av, bV1, SX[i]); SX[i] *= s2; } }
    }
    if (PASS == 2) { __syncthreads(); GLA_STORE(sg * GSEGLEN + GSEGLEN - 32, 1); }
    if (PASS == 1) {
        float* ST = (float*)smem;
        __syncthreads();
#pragma unroll
        for (int i = 0; i < 8; ++i)
#pragma unroll
            for (int g = 0; g < 4; ++g) { ST[(16 * i + 4 * q + g) * 132 + 16 * wave + r] = S[i][g]; if (xw) EX[((size_t)(sg * 4 + h) * 128 + 16 * i + 4 * q + g) * 16 + r] = SX[i][g]; }
        __syncthreads();
#pragma unroll
        for (int k = 0; k < 8; ++k) { const int idx = tid + 512 * k, row = idx >> 5, c4 = (idx & 31) * 4; *(f32x4*)(Eg + ((size_t)(sg * 4 + h) * 128 + row) * 128 + c4) = *(const f32x4*)(ST + row * 132 + c4); }
        if (grp == 0) Gg[(size_t)(sg * 4 + h) * 128 + d] = expf(runb);
    }
#undef GLA_FETCH
#undef GLA_STORE
}

template <int PASS>
__device__ __forceinline__ void s5_item(ArgsRef a, int l, int g, int sg, int g0, int tid, int lane, int wave, int hsel) {
    unsigned char* ws = a.ws;
    const bf16_t* Z = (const bf16_t*)(ws + OFF_Z); const float* ABAR = (const float*)(ws + OFF_ABAR); const bf16_t* BBT = (const bf16_t*)(ws + OFF_BBT); const bf16_t* CCT = (const bf16_t*)(ws + OFF_CCT);
    float* ES = (float*)(ws + OFF_ES); bf16_t* YPRE = (bf16_t*)(ws + OFF_YPRE);
    float* BU = (float*)(smem + 70000 + (wave & 3) * 12800); bf16_t* X = (bf16_t*)(smem + 70000 + (wave & 3) * 12800 + 8448); bf16_t* YT = (bf16_t*)(smem + 70000 + 51200);
    const int r = lane & 15, q = lane >> 4, p = lane; const bool act = (wave >> 2) == hsel;
    const float ar = ABAR[(g * 64 + p) * 2], ai = ABAR[(g * 64 + p) * 2 + 1];
    const bf16x8 zero8 = (bf16x8){0, 0, 0, 0, 0, 0, 0, 0};
    bf16x8 bB[8], cB[4];
#pragma unroll
    for (int nt = 0; nt < 8; ++nt) bB[nt] = (q < 2) ? *(const bf16x8*)(BBT + (size_t)(g * 128 + 16 * nt + r) * 16 + 8 * q) : zero8;
#pragma unroll
    for (int kk = 0; kk < 4; ++kk) cB[kk] = (PASS == 2) ? *(const bf16x8*)(CCT + (size_t)(g * 16 + r) * 128 + 32 * kk + 8 * q) : zero8;
    float xr = 0.f, xi = 0.f;
    if (PASS == 2) { xr = ES[((size_t)(sg * 32 + g) * 64 + p) * 2]; xi = ES[((size_t)(sg * 32 + g) * 64 + p) * 2 + 1]; }
    const float dsk = a.in[17][l * 512 + 16 * g + r];
    for (int ci = 0; ci < SSEGLEN / 16; ++ci) {
        const int t0 = sg * SSEGLEN + ci * 16;
        if (act) {
            const bf16x8 av = (q < 2) ? *(const bf16x8*)(Z + (size_t)(t0 + r) * NZ + 1024 + 16 * g + 8 * q) : zero8;
#pragma unroll
            for (int nt = 0; nt < 8; ++nt) { f32x4 acc = (f32x4){0.f, 0.f, 0.f, 0.f}; acc = MFMA16(av, bB[nt], acc);
#pragma unroll
                for (int gg = 0; gg < 4; ++gg) BU[(4 * q + gg) * 132 + 16 * nt + r] = acc[gg]; }
            wave_sync();
#pragma unroll
            for (int t = 0; t < 16; ++t) { const float br = BU[t * 132 + p], bi = BU[t * 132 + 64 + p];
                const float nr = ar * xr - ai * xi + br, ni = ar * xi + ai * xr + bi; xr = nr; xi = ni;
                if (PASS == 2) { X[t * 136 + p] = f2bf(xr); X[t * 136 + 64 + p] = f2bf(xi); } }
            wave_sync();
            if (PASS == 2) {
                f32x4 acc = (f32x4){0.f, 0.f, 0.f, 0.f};
#pragma unroll
                for (int kk = 0; kk < 4; ++kk) { const bf16x8 xv = *(const bf16x8*)(X + r * 136 + 32 * kk + 8 * q); acc = MFMA16(xv, cB[kk], acc); }
#pragma unroll
                for (int gg = 0; gg < 4; ++gg) { const int t = t0 + 4 * q + gg, c = 16 * g + r; const float u = bf2f(Z[(size_t)t * NZ + 1024 + c]);
                    YT[(4 * q + gg) * 136 + 16 * wave + r] = f2bf(gelu_tanh(acc[gg] + dsk * u)); }
            }
        }
        if (PASS == 2) {
            __syncthreads();
            if (tid < 128) { const int row = tid >> 3, c8 = (tid & 7) * 8; *(u32x4*)(YPRE + (size_t)(t0 + row) * 512 + 16 * g0 + 64 * hsel + c8) = *(const u32x4*)(YT + row * 136 + 64 * hsel + c8); }
            __syncthreads();
        }
    }
    if (PASS == 1 && act) { ES[((size_t)(sg * 32 + g) * 64 + p) * 2] = xr; ES[((size_t)(sg * 32 + g) * 64 + p) * 2 + 1] = xi; }
}

__device__ __forceinline__ void phase_scan(ArgsRef a, int tid, int bid, int G) {
    unsigned char* ws = a.ws;
    const int NT = G * 512, gt = bid * 512 + tid;
    for (int i = gt; i < 2 * 65536 + 8192 + 2048; i += NT) {
        if (i < 2 * 65536 + 8192) { const bool nx = i >= 2 * 65536; const int m = i >> 16, el = nx ? i - 2 * 65536 : (i & 65535), hrow = nx ? (el >> 4) : (el >> 7); const size_t str = nx ? 8192 : 65536;
            float* E = (float*)(ws + (nx ? OFF_EMX : (m == 0 ? OFF_EM : OFF_EH))); const float* Gd = (const float*)(ws + ((nx || m == 0) ? OFF_GM : OFF_GH));
            float ev[GSEG], gv[GSEG];
#pragma unroll
            for (int sg = 0; sg < GSEG; ++sg) { ev[sg] = E[(size_t)sg * str + el]; gv[sg] = Gd[sg * 512 + hrow]; }
            float cur = 0.f;
#pragma unroll
            for (int sg = 0; sg < GSEG; ++sg) { E[(size_t)sg * str + el] = cur; cur = gv[sg] * cur + ev[sg]; } }
        else { const int el = i - 2 * 65536 - 8192; float* E = (float*)(ws + OFF_ES); const float* ABAR = (const float*)(ws + OFF_ABAR);
            float pr = ABAR[el * 2], pi = ABAR[el * 2 + 1];
#pragma unroll
            for (int k = 0; k < 8; ++k) { const float nr = pr * pr - pi * pi, ni = 2.0f * pr * pi; pr = nr; pi = ni; }
            float xr = 0.f, xi = 0.f;
            for (int sb = 0; sb < SSEG; sb += 16) { float er[16], ei[16];
#pragma unroll
                for (int k = 0; k < 16; ++k) { er[k] = E[((size_t)(sb + k) * 2048 + el) * 2]; ei[k] = E[((size_t)(sb + k) * 2048 + el) * 2 + 1]; }
#pragma unroll
                for (int k = 0; k < 16; ++k) { E[((size_t)(sb + k) * 2048 + el) * 2] = xr; E[((size_t)(sb + k) * 2048 + el) * 2 + 1] = xi;
                    const float nr = pr * xr - pi * xi + er[k], ni = pr * xi + pi * xr + ei[k]; xr = nr; xi = ni; } } }
    }
}

template <int PASS>
__device__ __forceinline__ void phase_mixers(ArgsRef a, int l, int tid, int lane, int wave, int bid, int G) {
    for (int it = bid; it < 4 * GSEG; it += G) gla_item<0, PASS>(a, l, it % 4, it / 4, tid, lane, wave);
    asm volatile("" ::: "memory");
    for (int it = bid + ((4 * GSEG - bid % G) % G + G) % G * 0; it < 2 * 4 * GSEG; it += G) { if (it >= 4 * GSEG) gla_item<1, PASS>(a, l, (it - 4 * GSEG) % 4, (it - 4 * GSEG) / 4, tid, lane, wave); }
    __syncthreads();
    for (int it0 = bid * 8; it0 < 32 * SSEG; it0 += G * 8)
        for (int half = 0; half < 2; ++half) { const int it = it0 + wave; s5_item<PASS>(a, l, it % 32, it / 32, it0 % 32, tid, lane, wave, half); __syncthreads(); }
}

__device__ __forceinline__ void phase_post(ArgsRef a, int l, int lane, int gw, int GW) {
    const bf16_t* Z = (const bf16_t*)(a.ws + OFF_Z); const bf16_t* XC = (const bf16_t*)(a.ws + OFF_XC);
    bf16_t* OM = (bf16_t*)(a.ws + OFF_OM); bf16_t* OH = (bf16_t*)(a.ws + OFF_OH); const float* DEN = (const float*)(a.ws + OFF_DEN);
    const int c0 = lane * 8, hd = lane >> 4;
    float skp[8], nw[8];
#pragma unroll
    for (int j = 0; j < 8; ++j) { skp[j] = a.in[9][l * 512 + c0 + j]; nw[j] = a.in[20][l * 512 + c0 + j]; }
    for (int tb = gw * 4; tb < T; tb += GW * 4) {
        bf16x8 om[4], op[4], xc[4], oh[4], gp[4]; float dn[4];
#pragma unroll
        for (int k = 0; k < 4; ++k) { const size_t t = tb + k; om[k] = *(const bf16x8*)(OM + t * 512 + c0); op[k] = *(const bf16x8*)(Z + t * NZ + 512 + c0); xc[k] = *(const bf16x8*)(XC + t * 512 + c0);
            oh[k] = *(const bf16x8*)(OH + t * 512 + c0); gp[k] = *(const bf16x8*)(Z + t * NZ + 3072 + c0); dn[k] = DEN[hd * T + t]; }
#pragma unroll
        for (int k = 0; k < 4; ++k) { const size_t t = tb + k; const float di = __builtin_amdgcn_rcpf(fmaxf(fabsf(dn[k]), 1.0f)); float y[8], ov[8], ss = 0.f;
#pragma unroll
            for (int j = 0; j < 8; ++j) { y[j] = sigmoidf_(bf2f((bf16_t)op[k][j])) * (bf2f((bf16_t)om[k][j]) * di) + skp[j] * bf2f((bf16_t)xc[k][j]); ov[j] = bf2f((bf16_t)oh[k][j]); ss += ov[j] * ov[j]; }
            u32x4 w; w.x = pack2(y[0], y[1]); w.y = pack2(y[2], y[3]); w.z = pack2(y[4], y[5]); w.w = pack2(y[6], y[7]); *(u32x4*)(OM + t * 512 + c0) = w;
            ss += __shfl_xor(ss, 1); ss += __shfl_xor(ss, 2); ss += __shfl_xor(ss, 4); ss += __shfl_xor(ss, 8);
            const float rinv = rsqrtf(ss * (1.0f / 128.0f) + 1e-6f);
#pragma unroll
            for (int j = 0; j < 8; ++j) y[j] = ov[j] * rinv * nw[j] * siluf_(bf2f((bf16_t)gp[k][j]));
            u32x4 x; x.x = pack2(y[0], y[1]); x.y = pack2(y[2], y[3]); x.z = pack2(y[4], y[5]); x.w = pack2(y[6], y[7]); *(u32x4*)(OH + t * 512 + c0) = x; }
    }
}

__device__ __forceinline__ void ln_row(f32x4 (&v)[4], const float* gam, const float* bet, int lane) {
    float s = 0.f;
#pragma unroll
    for (int j = 0; j < 4; ++j) s += (v[j][0] + v[j][1]) + (v[j][2] + v[j][3]);
#pragma unroll
    for (int o = 32; o >= 1; o >>= 1) s += __shfl_xor(s, o);
    const float mean = s * (1.0f / 1024.0f); float qv = 0.f;
#pragma unroll
    for (int j = 0; j < 4; ++j) { const f32x4 dd = v[j] - mean; qv += (dd[0] * dd[0] + dd[1] * dd[1]) + (dd[2] * dd[2] + dd[3] * dd[3]); }
#pragma unroll
    for (int o = 32; o >= 1; o >>= 1) qv += __shfl_xor(qv, o);
    const float rstd = rsqrtf(qv * (1.0f / 1024.0f) + 1e-5f);
#pragma unroll
    for (int j = 0; j < 4; ++j) { const f32x4 gg = *(const f32x4*)(gam + 256 * j + 4 * lane), bb = *(const f32x4*)(bet + 256 * j + 4 * lane); v[j] = (v[j] - mean) * rstd * gg + bb; }
}

__device__ __forceinline__ void phase_ln1r(ArgsRef a, int l, int tid, int lane, int wave, int bid, int G) {
    float* XF = a.out; bf16_t* XB = (bf16_t*)(a.ws + OFF_XB);
    int* TOKE = (int*)(a.ws + OFF_TOKE); float* TOKG = (float*)(a.ws + OFF_TOKG); unsigned* HIST = (unsigned*)(a.ws + OFF_HIST);
    const float* RWT = (const float*)(a.ws + OFF_RWT); const float* RB = a.in[30];
    float* LG = (float*)(smem + wave * 4096);
    int* TE = (int*)(smem + wave * 4096 + 2304); float* TG = (float*)(smem + wave * 4096 + 2432); unsigned* HS = (unsigned*)(smem + wave * 4096 + 2560);
    const int r = lane & 15, q = lane >> 4, rs = lane >> 5, e = lane & 31;
    if (G >= 256 && wave >= 4) {
        float* tw_lds = (float*)(smem + 16384 + (wave - 4) * 16640);
        for (int u = 896 + bid * 4 + (wave - 4); u < 6144; u += G * 4) wave_prepx_tile(a, l, u, lane, tw_lds);
    }
    for (int tw = bid + G * wave; tw < T / 16; tw += G * 8) {
        const int t0 = tw * 16;
        for (int rb = 0; rb < 16; rb += 4) { f32x4 v[4][4];
#pragma unroll
            for (int k = 0; k < 4; ++k)
#pragma unroll
                for (int j = 0; j < 4; ++j) v[k][j] = *(const f32x4*)(XF + (size_t)(t0 + rb + k) * 1024 + 256 * j + 4 * lane);
#pragma unroll
            for (int k = 0; k < 4; ++k) { const int t = t0 + rb + k; ln_row(v[k], a.in[25] + l * 1024, a.in[26] + l * 1024, lane);
#pragma unroll
                for (int j = 0; j < 4; ++j) { *(f32x4*)(XF + (size_t)t * 1024 + 256 * j + 4 * lane) = v[k][j];
                    u32x2 w; w.x = pack2(v[k][j][0], v[k][j][1]); w.y = pack2(v[k][j][2], v[k][j][3]); *(u32x2*)(XB + (size_t)t * 1024 + 256 * j + 4 * lane) = w; } } }
        if (lane < 32) HS[lane] = 0u;
        asm volatile("s_waitcnt vmcnt(0) lgkmcnt(0)" ::: "memory"); __builtin_amdgcn_wave_barrier();
        f32x4 acc0 = (f32x4){0.f, 0.f, 0.f, 0.f}, acc1 = acc0;
        const float* xa = XF + (size_t)(t0 + r) * 1024 + 4 * q; const float* w0 = RWT + (size_t)r * 1024 + 4 * q; const float* w1 = RWT + (size_t)(16 + r) * 1024 + 4 * q;
        f32x4 pa[2][4], pb[2][4], pc[2][4];
#define RT_LOAD(buf, g_) do { _Pragma("unroll") for (int k_ = 0; k_ < 4; ++k_) { pa[buf][k_] = *(const f32x4*)(xa + 16 * (4 * (g_) + k_)); pb[buf][k_] = *(const f32x4*)(w0 + 16 * (4 * (g_) + k_)); pc[buf][k_] = *(const f32x4*)(w1 + 16 * (4 * (g_) + k_)); } } while (0)
#define RT_MMA(buf) do { _Pragma("unroll") for (int k_ = 0; k_ < 4; ++k_) _Pragma("unroll") for (int j = 0; j < 4; ++j) { acc0 = __builtin_amdgcn_mfma_f32_16x16x4f32(pa[buf][k_][j], pb[buf][k_][j], acc0, 0, 0, 0); acc1 = __builtin_amdgcn_mfma_f32_16x16x4f32(pa[buf][k_][j], pc[buf][k_][j], acc1, 0, 0, 0); } } while (0)
        RT_LOAD(0, 0);
#pragma unroll 1
        for (int g2 = 0; g2 < 16; g2 += 2) {
            RT_LOAD(1, g2 + 1);
            RT_MMA(0);
            if (g2 + 2 < 16) RT_LOAD(0, g2 + 2);
            RT_MMA(1);
        }
#undef RT_LOAD
#undef RT_MMA
#pragma unroll
        for (int g = 0; g < 4; ++g) { LG[(4 * q + g) * 33 + r] = acc0[g]; LG[(4 * q + g) * 33 + 16 + r] = acc1[g]; }
        wave_sync();
        for (int pp = 0; pp < 8; ++pp) {
            const float lg = LG[(2 * pp + rs) * 33 + e];
            const float s = sigmoidf_(lg), sb = s + RB[e];
            float v4[4];
#pragma unroll
            for (int i = 0; i < 4; ++i) v4[i] = __shfl(sb, (lane & ~3) + i);
            int i1 = 0;
#pragma unroll
            for (int i = 1; i < 4; ++i) if (v4[i] > v4[i1]) i1 = i;
            int i2 = (i1 == 0) ? 1 : 0;
#pragma unroll
            for (int i = 0; i < 4; ++i) if (i != i1 && i != i2 && v4[i] > v4[i2]) i2 = i;
            float gs = v4[i1] + v4[i2]; int gid = e >> 2;
#pragma unroll
            for (int o = 4; o <= 16; o <<= 1) { const float os = __shfl_xor(gs, o); const int og = __shfl_xor(gid, o); if (os > gs || (os == gs && og < gid)) { gs = os; gid = og; } }
            float sv[4], sbv[4];
#pragma unroll
            for (int i = 0; i < 4; ++i) { sbv[i] = __shfl(sb, (lane & 32) + gid * 4 + i); sv[i] = __shfl(s, (lane & 32) + gid * 4 + i); }
            int j1 = 0;
#pragma unroll
            for (int i = 1; i < 4; ++i) if (sbv[i] > sbv[j1]) j1 = i;
            int j2 = (j1 == 0) ? 1 : 0;
#pragma unroll
            for (int i = 0; i < 4; ++i) if (i != j1 && i != j2 && sbv[i] > sbv[j2]) j2 = i;
            float s1 = sv[0], s2 = sv[0];
#pragma unroll
            for (int i = 1; i < 4; ++i) { if (i == j1) s1 = sv[i]; if (i == j2) s2 = sv[i]; }
            if (e == 0) { const int ti = 2 * pp + rs; const float inv = 1.0f / (s1 + s2);
                TE[ti * 2] = gid * 4 + j1; TE[ti * 2 + 1] = gid * 4 + j2; TG[ti * 2] = s1 * inv; TG[ti * 2 + 1] = s2 * inv;
                atomicAdd(&HS[gid * 4 + j1], 1u); atomicAdd(&HS[gid * 4 + j2], 1u); }
        }
        wave_sync();
        if (lane < 32) { TOKE[t0 * 2 + lane] = TE[lane]; TOKG[t0 * 2 + lane] = TG[lane]; HIST[tw * 32 + lane] = HS[lane]; }
        wave_sync();
    }
    __syncthreads();
}

__device__ __forceinline__ void phase_slot(ArgsRef a, int tid, int lane, int wave, int bid, int G) {
    const int* TOKE = (const int*)(a.ws + OFF_TOKE); int* TOKS = (int*)(a.ws + OFF_TOKS); const unsigned* HIST = (const unsigned*)(a.ws + OFF_HIST);
    unsigned* BASE = (unsigned*)(a.ws + OFF_CTL) + 64;
    const bf16_t* XB = (const bf16_t*)(a.ws + OFF_XB); bf16_t* XG = (bf16_t*)(a.ws + OFF_XG);
    unsigned* base = (unsigned*)smem; unsigned* pre = base + 40; int* el = (int*)(base + 80); int* sl = (int*)(base + 208); unsigned* red = base + 336;
    const int e = tid & 31, part = tid >> 5;
    for (int c = bid; c < T / 64; c += G) {
        unsigned tot = 0u, pr = 0u;
#pragma unroll 16
        for (int it = part; it < 1024; it += 16) { const unsigned v = HIST[it * 32 + e]; tot += v; pr += (it < 4 * c) ? v : 0u; }
        red[part * 32 + e] = tot; red[512 + part * 32 + e] = pr;
        __syncthreads();
        if (tid < 32) { unsigned t2 = 0u, p2 = 0u; for (int k = 0; k < 16; ++k) { t2 += red[k * 32 + tid]; p2 += red[512 + k * 32 + tid]; } pre[tid] = p2; red[tid] = (t2 + 255u) & ~255u; }
        __syncthreads();
        if (tid == 0) { unsigned sacc = 0; for (int k = 0; k < 32; ++k) { base[k] = sacc; sacc += red[k]; } base[32] = sacc; }
        int ee = 0;
        if (tid < 128) { ee = TOKE[c * 128 + tid]; el[tid] = ee; }
        __syncthreads();
        if (c == 0 && tid < 33) BASE[tid] = base[tid];
        if (tid < 128) { unsigned rank = 0; for (int i = 0; i < tid; ++i) rank += (el[i] == ee) ? 1u : 0u;
            const unsigned sidx = base[ee] + pre[ee] + rank; sl[tid] = (int)sidx; TOKS[c * 128 + tid] = (int)sidx; }
        __syncthreads();
        for (int ib = 0; ib < 16; ib += 8) { u32x4 ra[8], rb[8];
#pragma unroll
            for (int k = 0; k < 8; ++k) { const int i = wave + 8 * (ib + k), t = c * 64 + (i >> 1); ra[k] = *(const u32x4*)(XB + (size_t)t * 1024 + lane * 8); rb[k] = *(const u32x4*)(XB + (size_t)t * 1024 + 512 + lane * 8); }
#pragma unroll
            for (int k = 0; k < 8; ++k) { const int i = wave + 8 * (ib + k); const size_t so = (size_t)sl[i] * 1024; *(u32x4*)(XG + so + lane * 8) = ra[k]; *(u32x4*)(XG + so + 512 + lane * 8) = rb[k]; } }
        __syncthreads();
    }
}

__device__ __forceinline__ void phase_ln2(ArgsRef a, int l, int lane, int gw, int GW) {
    float* XF = a.out; bf16_t* XB = (bf16_t*)(a.ws + OFF_XB); const bf16_t* YS = (const bf16_t*)(a.ws + OFF_YS);
    const int* TOKS = (const int*)(a.ws + OFF_TOKS); const float* TOKG = (const float*)(a.ws + OFF_TOKG);
    for (int tb = gw * 4; tb < T; tb += GW * 4) {
        int sv = 0; float gv = 0.f; if (lane < 8) { sv = TOKS[tb * 2 + lane]; gv = TOKG[tb * 2 + lane]; }
        f32x4 v[4][4]; bf16x4 y0[4][4], y1[4][4]; float g0[4], g1[4];
#pragma unroll
        for (int k = 0; k < 4; ++k) { const int s0 = __shfl(sv, 2 * k), s1 = __shfl(sv, 2 * k + 1); g0[k] = __shfl(gv, 2 * k); g1[k] = __shfl(gv, 2 * k + 1);
#pragma unroll
            for (int j = 0; j < 4; ++j) { v[k][j] = *(const f32x4*)(XF + (size_t)(tb + k) * 1024 + 256 * j + 4 * lane);
                y0[k][j] = *(const bf16x4*)(YS + (size_t)s0 * 1024 + 256 * j + 4 * lane); y1[k][j] = *(const bf16x4*)(YS + (size_t)s1 * 1024 + 256 * j + 4 * lane); } }
#pragma unroll
        for (int k = 0; k < 4; ++k) {
#pragma unroll
            for (int j = 0; j < 4; ++j)
#pragma unroll
                for (int g = 0; g < 4; ++g) v[k][j][g] = DN_ALPHA * v[k][j][g] + g0[k] * bf2f((bf16_t)y0[k][j][g]) + g1[k] * bf2f((bf16_t)y1[k][j][g]);
            ln_row(v[k], a.in[27] + l * 1024, a.in[28] + l * 1024, lane);
#pragma unroll
            for (int j = 0; j < 4; ++j) { *(f32x4*)(XF + (size_t)(tb + k) * 1024 + 256 * j + 4 * lane) = v[k][j];
                u32x2 w; w.x = pack2(v[k][j][0], v[k][j][1]); w.y = pack2(v[k][j][2], v[k][j][3]); *(u32x2*)(XB + (size_t)(tb + k) * 1024 + 256 * j + 4 * lane) = w; } }
    }
}

struct SchedGrid {
    int nM, nN, G, c; const char* A; const char* B; size_t strideA, strideB;
    __device__ __forceinline__ bool next(int i, pg8::Unit& u) const { int pm, pn; if (!pg8::tile_order(i * G + c, nM, nN, pm, pn)) return false;
        u.pm = pm; u.pn = pn; u.tag = 0; u.A = A + (size_t)pm * strideA; u.B = B + (size_t)pn * strideB; return true; }
};
constexpr int GATES_LD = 3072;
template <int MODE> struct EpiBf16 {
    static constexpr bool PERM = true;
    bf16_t* O; int ldo; const bf16_t* Y; int ldy;
    __device__ __forceinline__ bool operator()(f32x4 (&acc)[2][2][4][2], const pg8::Unit& u, int wr, int wc, int fr, int fq) const {
#pragma unroll
        for (int ai = 0; ai < 2; ++ai) {
            bf16x8 yv[4][2];
            if (MODE == 2) {
#pragma unroll
                for (int m = 0; m < 4; ++m)
#pragma unroll
                    for (int bj = 0; bj < 2; ++bj) yv[m][bj] = *(const bf16x8*)(Y + ((size_t)u.pm * 256 + ai * 128 + wr * 64 + m * 16 + fr) * ldy + u.pn * 256 + bj * 128 + wc * 32 + 8 * fq);
            }
#pragma unroll
            for (int m = 0; m < 4; ++m) { const size_t row = (size_t)u.pm * 256 + ai * 128 + wr * 64 + m * 16 + fr;
#pragma unroll
                for (int bj = 0; bj < 2; ++bj) { const int col = u.pn * 256 + bj * 128 + wc * 32 + 8 * fq; f32x4 v0 = acc[ai][bj][m][0], v1 = acc[ai][bj][m][1];
                    if (MODE == 1) {
#pragma unroll
                        for (int j = 0; j < 4; ++j) { v0[j] = fmaxf(sigmoidf_(v0[j]), 1e-30f); v1[j] = fmaxf(sigmoidf_(v1[j]), 1e-30f); } }
                    if (MODE == 2) {
#pragma unroll
                        for (int j = 0; j < 4; ++j) { v0[j] = bf2f((bf16_t)yv[m][bj][j]) * sigmoidf_(v0[j]); v1[j] = bf2f((bf16_t)yv[m][bj][4 + j]) * sigmoidf_(v1[j]); } }
                    u32x4 w; w.x = pg8::cvt_pk_bf16(v0[0], v0[1]); w.y = pg8::cvt_pk_bf16(v0[2], v0[3]); w.z = pg8::cvt_pk_bf16(v1[0], v1[1]); w.w = pg8::cvt_pk_bf16(v1[2], v1[3]);
                    if (MODE == 1) *(u32x4*)(O + ((((size_t)u.pm * 12 + u.pn) * 16 + (ai * 8 + m * 2 + bj)) * 512 + ((wr * 4 + wc) * 64 + fq * 16 + fr)) * 8) = w;
                    else *(u32x4*)(O + row * ldo + col) = w; } }
        }
        return false;
    }
};
struct SchedZ {
    int G, c; const unsigned char* ws;
    __device__ __forceinline__ bool next(int i, pg8::Unit& u) const { int pm, pn; if (!pg8::tile_order(i * G + c, T / 256, 15, pm, pn)) return false;
        u.pm = pm; u.pn = pn; u.tag = 0; u.A = (const char*)(ws + OFF_XB) + (size_t)pm * 256 * 1024 * 2;
        u.B = (const char*)(ws + OFF_WIN) + (size_t)(pn < 14 ? pn * 256 : 6656) * 1024 * 2; return true; }
};
struct EpiZ {
    static constexpr bool PERM = true;
    bf16_t* Z; float* LI; float* LF; const float* bi; const float* bf;
    __device__ __forceinline__ bool operator()(f32x4 (&acc)[2][2][4][2], const pg8::Unit& u, int wr, int wc, int fr, int fq) const {
        if (u.pn < 14) {
#pragma unroll
            for (int ai = 0; ai < 2; ++ai)
#pragma unroll
                for (int m = 0; m < 4; ++m) { const size_t row = (size_t)u.pm * 256 + ai * 128 + wr * 64 + m * 16 + fr;
#pragma unroll
                    for (int bj = 0; bj < 2; ++bj) { const int col = u.pn * 256 + bj * 128 + wc * 32 + 8 * fq; const f32x4 v0 = acc[ai][bj][m][0], v1 = acc[ai][bj][m][1];
                        u32x4 w; w.x = pg8::cvt_pk_bf16(v0[0], v0[1]); w.y = pg8::cvt_pk_bf16(v0[2], v0[3]); w.z = pg8::cvt_pk_bf16(v1[0], v1[1]); w.w = pg8::cvt_pk_bf16(v1[2], v1[3]);
                        *(u32x4*)(Z + row * NZ + col) = w; } }
        } else if (wc == 0 && fq == 0) {
            const f32x4 b_i = *(const f32x4*)bi, b_f = *(const f32x4*)bf;
#pragma unroll
            for (int ai = 0; ai < 2; ++ai)
#pragma unroll
                for (int m = 0; m < 4; ++m) { const size_t row = (size_t)u.pm * 256 + ai * 128 + wr * 64 + m * 16 + fr; const f32x4 v0 = acc[ai][0][m][0] + b_i, v1 = acc[ai][0][m][1] + b_f;
                    f32x4 lf; lf[0] = logsigmoidf_(v1[0]); lf[1] = logsigmoidf_(v1[1]); lf[2] = logsigmoidf_(v1[2]); lf[3] = logsigmoidf_(v1[3]);
                    *(f32x4*)(LI + row * 4) = v0; *(f32x4*)(LF + row * 4) = lf; }
        }
        return false;
    }
};
__device__ __forceinline__ void phase_zgemm2(ArgsRef a, int l, int tid, int bid, int G) {
    SchedZ S{G, bid, a.ws}; EpiZ E{(bf16_t*)(a.ws + OFF_Z), (float*)(a.ws + OFF_LI), (float*)(a.ws + OFF_LF), a.in[7] + l * 4, a.in[8] + l * 4};
    pg8::gemm_phase((PG8_LAS unsigned char*)smem, tid, 1024, 1024, 1024, S, E);
}
__device__ __forceinline__ void phase_glu_gates(ArgsRef a, int l, int tid, int bid, int G) {
    { SchedGrid S{T / 256, 2, G, bid, (const char*)(a.ws + OFF_YPRE), (const char*)(a.ws + OFF_WGLU), (size_t)256 * 512 * 2, (size_t)256 * 512 * 2};
      EpiBf16<2> E{(bf16_t*)(a.ws + OFF_YSG), 512, (const bf16_t*)(a.ws + OFF_YPRE), 512};
      pg8::gemm_phase((PG8_LAS unsigned char*)smem, tid, 512, 512, 512, S, E); }
    asm volatile("" : "+v"(tid), "+s"(bid), "+s"(G));
    if (G > 128) { if (bid >= 128) phase_prepx(a, l, tid, bid - 128, G - 128, 0, 896); } else phase_prepx(a, l, tid, bid, G, 0, 896);
    asm volatile("" : "+v"(tid), "+s"(bid), "+s"(G));
    { SchedGrid S{T / 256, 12, G, (bid + G / 2) % G, (const char*)(a.ws + OFF_XB), (const char*)(a.ws + OFF_WIN + (size_t)NZ * 1024 * 2), (size_t)256 * 1024 * 2, (size_t)256 * 1024 * 2};
      EpiBf16<1> E{(bf16_t*)(a.ws + OFF_Z), GATES_LD, nullptr, 0};
      pg8::gemm_phase((PG8_LAS unsigned char*)smem, tid, 1024, 1024, 1024, S, E); }
}
struct SchedMerge {
    int G, c; const unsigned char* ws;
    __device__ __forceinline__ bool next(int i, pg8::Unit& u) const { const int b = i % 3; int pm, pn; if (!pg8::tile_order((i / 3) * G + c, T / 256, 4, pm, pn)) return false;
        u.pm = pm; u.pn = pn; u.tag = b; u.A = (const char*)(ws + (b == 0 ? OFF_OM : b == 1 ? OFF_YSG : OFF_OH)) + (size_t)pm * 256 * 512 * 2;
        u.B = (const char*)(ws + OFF_WB) + ((size_t)b * 1024 + pn * 256) * 512 * 2; return true; }
};
struct EpiMerge {
    static constexpr bool PERM = true;
    const bf16_t* GT; bf16_t* O;
    __device__ __forceinline__ bool operator()(f32x4 (&acc)[2][2][4][2], const pg8::Unit& u, int wr, int wc, int fr, int fq) const {
        const int b = u.tag;
#pragma unroll
        for (int ai = 0; ai < 2; ++ai)
#pragma unroll
        for (int mh = 0; mh < 2; ++mh) {
            bf16x8 gb[2][2], gn[2][2];
#pragma unroll
            for (int mm = 0; mm < 2; ++mm)
#pragma unroll
                for (int bj = 0; bj < 2; ++bj) { const bf16_t* gp = GT + ((((size_t)u.pm * 12 + b * 4 + u.pn) * 16 + (ai * 8 + (2 * mh + mm) * 2 + bj)) * 512 + ((wr * 4 + wc) * 64 + fq * 16 + fr)) * 8;
                    gb[mm][bj] = *(const bf16x8*)gp; gn[mm][bj] = (b < 2) ? *(const bf16x8*)(gp + (size_t)4 * 16 * 512 * 8) : gb[mm][bj]; }
#pragma unroll
            for (int mm = 0; mm < 2; ++mm) { const int m = 2 * mh + mm; const size_t row = (size_t)u.pm * 256 + ai * 128 + wr * 64 + m * 16 + fr;
#pragma unroll
                for (int bj = 0; bj < 2; ++bj) { const int col = u.pn * 256 + bj * 128 + wc * 32 + 8 * fq;
                    if (b < 2) {
#pragma unroll
                        for (int j = 0; j < 4; ++j) { acc[ai][bj][m][0][j] *= bf2f((bf16_t)gb[mm][bj][j]) * __builtin_amdgcn_rcpf(bf2f((bf16_t)gn[mm][bj][j])); acc[ai][bj][m][1][j] *= bf2f((bf16_t)gb[mm][bj][4 + j]) * __builtin_amdgcn_rcpf(bf2f((bf16_t)gn[mm][bj][4 + j])); } }
                    else { f32x4 v0 = acc[ai][bj][m][0], v1 = acc[ai][bj][m][1];
#pragma unroll
                        for (int j = 0; j < 4; ++j) { v0[j] *= bf2f((bf16_t)gb[mm][bj][j]); v1[j] *= bf2f((bf16_t)gb[mm][bj][4 + j]); }
                        u32x4 w; w.x = pg8::cvt_pk_bf16(v0[0], v0[1]); w.y = pg8::cvt_pk_bf16(v0[2], v0[3]); w.z = pg8::cvt_pk_bf16(v1[0], v1[1]); w.w = pg8::cvt_pk_bf16(v1[2], v1[3]);
                        *(u32x4*)(O + row * 1024 + col) = w; } } }
        }
        return b < 2;
    }
};
__device__ __forceinline__ void phase_merge2(ArgsRef a, int tid, int bid, int G) {
    SchedMerge S{G, bid, a.ws}; EpiMerge E{(const bf16_t*)(a.ws + OFF_Z), (bf16_t*)(a.ws + OFF_XB)};
    pg8::gemm_phase((PG8_LAS unsigned char*)smem, tid, 512, 512, 512, S, E);
}
struct EpiResid {
    static constexpr bool PERM = false;
    const float* xin; float* XF;
    __device__ __forceinline__ bool operator()(f32x4 (&acc)[2][2][4][2], const pg8::Unit& u, int wr, int wc, int fr, int fq) const {
#pragma unroll
        for (int ai = 0; ai < 2; ++ai)
#pragma unroll
        for (int mh = 0; mh < 2; ++mh) {
            f32x4 xv[2][2][2];
#pragma unroll
            for (int mm = 0; mm < 2; ++mm)
#pragma unroll
                for (int bj = 0; bj < 2; ++bj)
#pragma unroll
                    for (int n = 0; n < 2; ++n) xv[mm][bj][n] = *(const f32x4*)(xin + ((size_t)u.pm * 256 + ai * 128 + wr * 64 + (2 * mh + mm) * 16 + fr) * 1024 + u.pn * 256 + bj * 128 + wc * 32 + 16 * n + 4 * fq);
#pragma unroll
            for (int mm = 0; mm < 2; ++mm)
#pragma unroll
                for (int bj = 0; bj < 2; ++bj)
#pragma unroll
                    for (int n = 0; n < 2; ++n) { const int m = 2 * mh + mm; const size_t o = ((size_t)u.pm * 256 + ai * 128 + wr * 64 + m * 16 + fr) * 1024 + u.pn * 256 + bj * 128 + wc * 32 + 16 * n + 4 * fq; *(f32x4*)(XF + o) = DN_ALPHA * xv[mm][bj][n] + acc[ai][bj][m][n]; }
        }
        return false;
    }
};
__device__ __forceinline__ void phase_wout2(ArgsRef a, int l, int tid, int bid, int G) {
    SchedGrid S{T / 256, 4, G, bid, (const char*)(a.ws + OFF_XB), (const char*)(a.ws + OFF_WOUT), (size_t)256 * 1024 * 2, (size_t)256 * 1024 * 2};
    EpiResid E{(l == 0) ? a.in[0] : a.out, a.out};
    pg8::gemm_phase((PG8_LAS unsigned char*)smem, tid, 1024, 1024, 1024, S, E);
}
struct EpiQKV {
    static constexpr bool PERM = true;
    int vcall; bf16_t* Q; bf16_t* KH; bf16_t* V; const float* LI;
    __device__ __forceinline__ bool operator()(f32x4 (&acc)[2][2][4][2], const pg8::Unit& u, int wr, int wc, int fr, int fq) const {
        const int which = vcall ? 2 : (u.pn >> 1); bf16_t* O = Q + (size_t)which * (SZ_ACT / 2);
        float liv[2][4][2];
#pragma unroll
        for (int ai = 0; ai < 2; ++ai)
#pragma unroll
            for (int m = 0; m < 4; ++m)
#pragma unroll
                for (int bj = 0; bj < 2; ++bj) liv[ai][m][bj] = (which == 1) ? LI[((size_t)u.pm * 256 + ai * 128 + wr * 64 + m * 16 + fr) * 4 + (u.pn & 1) * 2 + bj] : 0.f;
#pragma unroll
        for (int ai = 0; ai < 2; ++ai)
#pragma unroll
            for (int m = 0; m < 4; ++m) { const size_t row = (size_t)u.pm * 256 + ai * 128 + wr * 64 + m * 16 + fr;
#pragma unroll
                for (int bj = 0; bj < 2; ++bj) { const int hd = (u.pn & 1) * 2 + bj, col = hd * 128 + wc * 32 + 8 * fq;
                    const float sc = which == 0 ? 0.08838834764831845f : which == 1 ? fexp(liv[ai][m][bj]) : 1.0f;
                    const f32x4 v0 = acc[ai][bj][m][0] * sc, v1 = acc[ai][bj][m][1] * sc;
                    u32x4 w; w.x = pg8::cvt_pk_bf16(v0[0], v0[1]); w.y = pg8::cvt_pk_bf16(v0[2], v0[3]); w.z = pg8::cvt_pk_bf16(v1[0], v1[1]); w.w = pg8::cvt_pk_bf16(v1[2], v1[3]);
                    *(u32x4*)(O + row * 512 + col) = w; } }
        return false;
    }
};
__device__ __forceinline__ void phase_mprep2(ArgsRef a, int l, int tid, int bid, int G) {
    const bf16_t* Z = (const bf16_t*)(a.ws + OFF_Z); bf16_t* XC = (bf16_t*)(a.ws + OFF_XC);
    const float* cw = a.in[2] + (size_t)l * 4 * 512; const float* cb = a.in[3] + (size_t)l * 512;
    for (int idx = bid * 512 + tid; idx < (T / 8) * 64; idx += G * 512) {
        const int tb = (idx / 64) * 8, c0 = (idx % 64) * 8;
        bf16x8 xr[11];
#pragma unroll
        for (int k = 0; k < 11; ++k) { const int ts = tb - 3 + k; xr[k] = (ts >= 0) ? *(const bf16x8*)(Z + (size_t)ts * NZ + c0) : (bf16x8){0, 0, 0, 0, 0, 0, 0, 0}; }
        float w[4][8], b[8];
#pragma unroll
        for (int j = 0; j < 8; ++j) { b[j] = cb[c0 + j];
#pragma unroll
            for (int k = 0; k < 4; ++k) w[k][j] = cw[k * 512 + c0 + j]; }
#pragma unroll
        for (int tt = 0; tt < 8; ++tt) { float acc[8];
#pragma unroll
            for (int j = 0; j < 8; ++j) { acc[j] = b[j];
#pragma unroll
                for (int k = 0; k < 4; ++k) acc[j] += w[k][j] * bf2f((bf16_t)xr[tt + k][j]); }
            u32x4 o; o.x = pack2(siluf_(acc[0]), siluf_(acc[1])); o.y = pack2(siluf_(acc[2]), siluf_(acc[3])); o.z = pack2(siluf_(acc[4]), siluf_(acc[5])); o.w = pack2(siluf_(acc[6]), siluf_(acc[7]));
            *(u32x4*)(XC + (size_t)(tb + tt) * 512 + c0) = o; }
    }
}

__device__ __forceinline__ void phase_v_conv(ArgsRef a, int l, int tid, int bid, int G) {
    if (G > 128 && bid >= 128) { phase_mprep2(a, l, tid, bid - 128, G - 128); return; }
    { SchedGrid S{T / 256, 2, G, bid, (const char*)(a.ws + OFF_Z), (const char*)(a.ws + OFF_WQKV + (size_t)1024 * 512 * 2), (size_t)256 * NZ * 2, (size_t)256 * 512 * 2};
      EpiQKV E{1, (bf16_t*)(a.ws + OFF_Q), (bf16_t*)(a.ws + OFF_KH), (bf16_t*)(a.ws + OFF_V), (const float*)(a.ws + OFF_LI)};
      pg8::gemm_phase((PG8_LAS unsigned char*)smem, tid, 512, NZ, 512, S, E); }
    if (G <= 128) { asm volatile("" : "+v"(tid), "+s"(bid), "+s"(G)); phase_mprep2(a, l, tid, bid, G); }
}
__device__ __forceinline__ void phase_qk(ArgsRef a, int tid, int bid, int G) {
    SchedGrid S{T / 256, 4, G, bid, (const char*)(a.ws + OFF_XC), (const char*)(a.ws + OFF_WQKV), (size_t)256 * 512 * 2, (size_t)256 * 512 * 2};
    EpiQKV E{0, (bf16_t*)(a.ws + OFF_Q), (bf16_t*)(a.ws + OFF_KH), (bf16_t*)(a.ws + OFF_V), (const float*)(a.ws + OFF_LI)};
    pg8::gemm_phase((PG8_LAS unsigned char*)smem, tid, 512, 512, 512, S, E);
}
struct SchedMoE {
    int down, G, c; const unsigned char* ws; const unsigned* BASE;
    __device__ __forceinline__ bool next(int i, pg8::Unit& u) const { const int per = down ? 4 : 2, L = i * G + c, ntile = (int)(BASE[32] >> 8); if (L >= ntile * per) return false;
        const int tile = L / per, sub = L % per; int e = 0; while (e < 31 && BASE[e + 1] <= (unsigned)(tile * 256)) ++e;
        u.pm = tile; u.pn = sub; u.tag = e;
        if (!down) { u.A = (const char*)(ws + OFF_XG) + (size_t)tile * 256 * 1024 * 2; u.B = (const char*)(ws + OFF_WGU) + ((size_t)e * 512 + sub * 256) * 1024 * 2; }
        else { u.A = (const char*)(ws + OFF_H) + (size_t)tile * 256 * 256 * 2; u.B = (const char*)(ws + OFF_WD) + ((size_t)e * 1024 + sub * 256) * 256 * 2; }
        return true; }
};
struct EpiH {
    static constexpr bool PERM = true;
    bf16_t* H;
    __device__ __forceinline__ bool operator()(f32x4 (&acc)[2][2][4][2], const pg8::Unit& u, int wr, int wc, int fr, int fq) const {
#pragma unroll
        for (int ai = 0; ai < 2; ++ai)
#pragma unroll
            for (int m = 0; m < 4; ++m) { const size_t row = (size_t)u.pm * 256 + ai * 128 + wr * 64 + m * 16 + fr; f32x4 v0, v1;
#pragma unroll
                for (int j = 0; j < 4; ++j) { v0[j] = siluf_(acc[ai][0][m][0][j]) * acc[ai][1][m][0][j]; v1[j] = siluf_(acc[ai][0][m][1][j]) * acc[ai][1][m][1][j]; }
                u32x4 w; w.x = pg8::cvt_pk_bf16(v0[0], v0[1]); w.y = pg8::cvt_pk_bf16(v0[2], v0[3]); w.z = pg8::cvt_pk_bf16(v1[0], v1[1]); w.w = pg8::cvt_pk_bf16(v1[2], v1[3]);
                *(u32x4*)(H + row * 256 + u.pn * 128 + wc * 32 + 8 * fq) = w; }
        return false;
    }
};
__device__ __forceinline__ void phase_moe_gu2(ArgsRef a, int l, int tid, int bid, int G) {
    { SchedMoE S{0, G, bid, a.ws, (const unsigned*)(a.ws + OFF_CTL) + 64}; EpiH E{(bf16_t*)(a.ws + OFF_H)};
      pg8::gemm_phase((PG8_LAS unsigned char*)smem, tid, 1024, 1024, 1024, S, E); }
    if (l + 1 < NLAYER) {
        asm volatile("" : "+v"(tid), "+s"(bid), "+s"(G));
        const int ntile = (int)(((const unsigned*)(a.ws + OFF_CTL))[64 + 32] >> 8); int nb = ntile * 2 - G; nb = nb < 0 ? 0 : (nb > G - 1 ? G - 1 : nb);
        if (bid >= nb) phase_prep(a, l + 1, tid, bid - nb, G - nb);
    }
}
__device__ __forceinline__ void phase_moe_dn2(ArgsRef a, int tid, int bid, int G) {
    SchedMoE S{1, G, bid, a.ws, (const unsigned*)(a.ws + OFF_CTL) + 64}; EpiBf16<0> E{(bf16_t*)(a.ws + OFF_YS), 1024, nullptr, 0};
    pg8::gemm_phase((PG8_LAS unsigned char*)smem, tid, 256, 256, 256, S, E);
}
#define XB_TMO      128
#define XB_XCNT(j)  (256  + 64 * (j))
#define XB_XSUB(j)  (1280 + 64 * (j))
#define XB_XGEN(j)  (2304 + 64 * (j))
#define XB_TOP      3328
#define XB_TOPGEN   3392
#define XCD_BAR_WORDS 3456
#define XB_SPIN_CAP (1u << 22)
__device__ __forceinline__ unsigned xb_ld(unsigned* p)              { return __hip_atomic_load(p, __ATOMIC_RELAXED, __HIP_MEMORY_SCOPE_AGENT); }
__device__ __forceinline__ unsigned xb_add(unsigned* p, unsigned v) { return __hip_atomic_fetch_add(p, v, __ATOMIC_RELAXED, __HIP_MEMORY_SCOPE_AGENT); }
__device__ __forceinline__ unsigned xb_xcc_id() { return (unsigned)__builtin_amdgcn_s_getreg((3 << 11) | 20) & 0xFu; }
#define XB_SPIN(cond, bar) do { unsigned _sp = 0; while (cond) { __builtin_amdgcn_s_sleep(1); \
    if ((++_sp & 255u) == 0u) { if (xb_ld(&(bar)[XB_TMO])) break; if (_sp > XB_SPIN_CAP) { atomicAdd(&(bar)[XB_TMO], 1u); break; } } } } while (0)
__device__ __forceinline__ void xcd_barrier_complete(unsigned* bar, unsigned x, unsigned& nloc, unsigned& nx) {
    const unsigned G = gridDim.x; unsigned sum, cnt, mine, sp = 0u;
    for (;;) { sum = 0u; cnt = 0u; mine = 0u;
#pragma unroll
        for (unsigned j = 0; j < 16; ++j) { const unsigned c = xb_ld(&bar[XB_XCNT(j)]); sum += c; cnt += (c > 0u) ? 1u : 0u; mine = (j == x) ? c : mine; }
        if (sum == G) break;
        __builtin_amdgcn_s_sleep(1);
        if ((++sp & 255u) == 0u) { if (xb_ld(&bar[XB_TMO])) break; if (sp > XB_SPIN_CAP) { atomicAdd(&bar[XB_TMO], 1u); break; } } }
    nloc = mine > 0u ? mine : 1u; nx = cnt > 0u ? cnt : 1u;
}
__device__ __forceinline__ void xcd_barrier(unsigned* bar, volatile __attribute__((address_space(3))) unsigned* st) {
    asm volatile("s_waitcnt vmcnt(0)" ::: "memory");
    __syncthreads();
    if (threadIdx.x == 0) {
        __builtin_amdgcn_s_waitcnt(0);
        const unsigned x = xb_xcc_id();
        unsigned nloc = st[0], nx = st[1];
        if (nloc == 0u) { xcd_barrier_complete(bar, x, nloc, nx); st[0] = nloc; st[1] = nx; }
        const unsigned old = xb_add(&bar[XB_XSUB(x)], 1u);
        const unsigned gen = old / nloc;
        if (old + 1u == (gen + 1u) * nloc) {
            __builtin_amdgcn_fence(__ATOMIC_RELEASE, "agent");
            asm volatile("s_waitcnt vmcnt(0)" ::: "memory");
            const unsigned og = xb_add(&bar[XB_TOP], 1u);
            const unsigned tg = og / nx;
            if (og + 1u == (tg + 1u) * nx) xb_add(&bar[XB_TOPGEN], 1u);
            else XB_SPIN(xb_ld(&bar[XB_TOPGEN]) == tg, bar);
            __builtin_amdgcn_fence(__ATOMIC_ACQUIRE, "agent");
            xb_add(&bar[XB_XGEN(x)], 1u);
            asm volatile("s_waitcnt vmcnt(0)" ::: "memory");
        } else {
            XB_SPIN(xb_ld(&bar[XB_XGEN(x)]) == gen, bar);
            __builtin_amdgcn_fence(__ATOMIC_ACQUIRE, "agent");
            asm volatile("s_waitcnt vmcnt(0)" ::: "memory");
        }
    }
    __syncthreads();
}

__device__ __forceinline__ ArgsRef fresh_args() { unsigned long long p = (unsigned long long)__builtin_amdgcn_kernarg_segment_ptr(); asm volatile("" : "+s"(p)); return *(const __attribute__((address_space(4))) Args*)p; }
__global__ void __launch_bounds__(512) fwd(Args a_unused) {
    cg::grid_group grid = cg::this_grid();
    volatile __attribute__((address_space(3))) unsigned* bst = (volatile __attribute__((address_space(3))) unsigned*)((__attribute__((address_space(3))) unsigned char*)smem + 131072);
    if (threadIdx.x < 4) bst[threadIdx.x] = 0u;
    __syncthreads();
    { ArgsRef a0 = fresh_args(); if (threadIdx.x == 0) (void)xb_add(&((unsigned*)(a0.ws + OFF_BAR))[XB_XCNT(xb_xcc_id())], 1u); }
#define GSYNC() do { asm volatile("" ::: "memory"); { ArgsRef ab = fresh_args(); xcd_barrier((unsigned*)(ab.ws + OFF_BAR), bst); } asm volatile("" ::: "memory"); } while (0)
#define GSYNC_CG() do { asm volatile("" ::: "memory"); grid.sync(); asm volatile("" ::: "memory"); } while (0)
    const int wave_s = __builtin_amdgcn_readfirstlane((int)threadIdx.x >> 6);
#define PH(body) do { int wave = wave_s; asm volatile("" : "+s"(wave)); int lane; asm volatile("v_mbcnt_lo_u32_b32 %0, -1, 0\n\tv_mbcnt_hi_u32_b32 %0, -1, %0" : "=v"(lane)); \
        int bid = blockIdx.x, G = gridDim.x; asm volatile("" : "+s"(bid), "+s"(G)); \
        const int tid = wave * 64 + lane, gw = bid * 8 + wave, GW = G * 8; (void)tid; (void)gw; (void)GW; ArgsRef a = fresh_args(); body; } while (0)
#pragma unroll 1
    for (int l = 0; l < NLAYER; ++l) {
        if (l == 0) { PH(phase_prep(a, 0, tid, bid, G)); GSYNC_CG(); }
        PH(phase_zgemm2(a, l, tid, bid, G)); GSYNC();
        PH(phase_v_conv(a, l, tid, bid, G)); GSYNC();
        PH(phase_qk(a, tid, bid, G)); GSYNC();
        PH(phase_mixers<1>(a, l, tid, lane, wave, bid, G)); GSYNC();
        PH(phase_scan(a, tid, bid, G)); GSYNC();
        PH(phase_mixers<2>(a, l, tid, lane, wave, bid, G)); GSYNC();
        PH(phase_glu_gates(a, l, tid, bid, G)); GSYNC();
        PH(phase_merge2(a, tid, bid, G)); GSYNC();
        PH(phase_wout2(a, l, tid, bid, G)); GSYNC();
        PH(phase_ln1r(a, l, tid, lane, wave, bid, G)); PH(if (G < 256) phase_prepx(a, l, tid, bid, G, 896, 6144)); GSYNC();
        PH(phase_slot(a, tid, lane, wave, bid, G)); GSYNC();
        PH(phase_moe_gu2(a, l, tid, bid, G)); GSYNC();
        PH(phase_moe_dn2(a, tid, bid, G)); GSYNC();
        PH(phase_ln2(a, l, lane, gw, GW)); if (l + 1 < NLAYER) GSYNC();
    }
}

extern "C" void kernel_launch(void* const* d_in, const int* in_sizes, int n_in, void* d_out, int out_size, void* d_ws, size_t ws_size, hipStream_t stream) {
    static int grid = 0;
    if (grid == 0) {
        if (n_in != 34 || out_size != T * D || ws_size < WS_TOTAL) { fprintf(stderr, "kernel_launch: unexpected shapes (n_in %d, out %d, ws %zu, need %zu)\n", n_in, out_size, ws_size, (size_t)WS_TOTAL); grid = -1; return; }
        int dev = 0, cus = 0, per_cu = 0;
        (void)hipGetDevice(&dev); (void)hipDeviceGetAttribute(&cus, hipDeviceAttributeMultiprocessorCount, dev);
        (void)hipFuncSetAttribute((const void*)fwd, hipFuncAttributeMaxDynamicSharedMemorySize, LDS_BYTES);
        (void)hipOccupancyMaxActiveBlocksPerMultiprocessor(&per_cu, (const void*)fwd, 512, LDS_BYTES);
        if (per_cu < 1) { fprintf(stderr, "kernel_launch: occupancy query says %d blocks per CU\n", per_cu); per_cu = 1; }
        grid = (cus > 0 ? cus : 256) * 1;
        (void)hipGetLastError();
    }
    if (grid < 0) return;
    Args a{};
    for (int i = 0; i < 34; ++i) a.in[i] = (const float*)d_in[i];
    a.out = (float*)d_out; a.ws = (unsigned char*)d_ws; a.ph_lo = 0; a.ph_hi = NLAYER * NPH;
    (void)hipMemsetAsync((unsigned char*)d_ws + OFF_BAR, 0, 16384, stream);
    void* args[] = {&a};
    hipError_t e = hipLaunchCooperativeKernel((const void*)fwd, dim3(grid), dim3(512), args, LDS_BYTES, stream);
    if (e != hipSuccess) fprintf(stderr, "kernel_launch: cooperative launch failed: %s (grid %d)\n", hipGetErrorString(e), grid);
}
```

```cpp
#include <hip/hip_runtime.h>
#include <hip/hip_cooperative_groups.h>
#include <cstdio>
#include <cstdint>
namespace cg = cooperative_groups;

typedef unsigned short bf16_t;
typedef short bf16x8 __attribute__((ext_vector_type(8)));
typedef short bf16x4 __attribute__((ext_vector_type(4)));
typedef float f32x4 __attribute__((ext_vector_type(4)));
typedef unsigned u32x4 __attribute__((ext_vector_type(4)));
typedef unsigned u32x2 __attribute__((ext_vector_type(2)));

constexpr int T = 16384, D = 1024, NZ = 3584, NWIN = 6912, INW = 6664;
constexpr int NPH = 15, NLAYER = 2;
constexpr int GSEG = 32, GSEGLEN = 512;
constexpr int SSEG = 64, SSEGLEN = 256;
constexpr int SLOTS = 40960;
constexpr float DN_ALPHA = 1.41421356237f;
constexpr int LDS_BYTES = 131072 + 256;

constexpr size_t AL(size_t x) { return (x + 255) & ~(size_t)255; }
constexpr size_t OFF_WIN = 0;
constexpr size_t OFF_WQKV = OFF_WIN + AL((size_t)NWIN * 1024 * 2);
constexpr size_t OFF_WGLU = OFF_WQKV + AL((size_t)1536 * 512 * 2);
constexpr size_t OFF_WB = OFF_WGLU + AL((size_t)512 * 512 * 2);
constexpr size_t OFF_WOUT = OFF_WB + AL((size_t)3 * 1024 * 512 * 2);
constexpr size_t OFF_ABAR = OFF_WOUT + AL((size_t)1024 * 1024 * 2);
constexpr size_t OFF_BBT = OFF_ABAR + AL((size_t)32 * 64 * 2 * 4);
constexpr size_t OFF_CCT = OFF_BBT + AL((size_t)32 * 128 * 16 * 2);
constexpr size_t OFF_CTL = OFF_CCT + AL((size_t)32 * 16 * 128 * 2);
constexpr size_t OFF_TOKE = OFF_CTL + 4096;
constexpr size_t OFF_TOKG = OFF_TOKE + AL((size_t)T * 2 * 4);
constexpr size_t OFF_TOKS = OFF_TOKG + AL((size_t)T * 2 * 4);
constexpr size_t OFF_SLOTT = OFF_TOKS + AL((size_t)T * 2 * 4);
constexpr size_t OFF_XB = OFF_SLOTT + AL((size_t)SLOTS * 4);
constexpr size_t OFF_R1 = OFF_XB + AL((size_t)T * 1024 * 2);
constexpr size_t SZ_ACT = (size_t)T * 512 * 2;
constexpr size_t OFF_XC = OFF_R1, OFF_Q = OFF_R1 + SZ_ACT, OFF_KH = OFF_R1 + 2 * SZ_ACT, OFF_V = OFF_R1 + 3 * SZ_ACT;
constexpr size_t OFF_WGU = OFF_R1, OFF_WD = OFF_R1 + (size_t)32 * 512 * 1024 * 2;
constexpr size_t OFF_Z = OFF_R1 + 4 * SZ_ACT;
constexpr size_t OFF_XG = OFF_Z, OFF_H = OFF_Z + (size_t)SLOTS * 1024 * 2;
constexpr size_t OFF_ZS = OFF_Z + AL((size_t)T * NZ * 2);
constexpr size_t OFF_LF = OFF_ZS + AL((size_t)T * 8 * 4);
constexpr size_t OFF_LI = OFF_LF + AL((size_t)T * 4 * 4);
constexpr size_t OFF_E = OFF_LI + AL((size_t)T * 4 * 4);
constexpr size_t OFF_OM = OFF_E, OFF_OH = OFF_E + SZ_ACT, OFF_YPRE = OFF_E + 2 * SZ_ACT, OFF_YSG = OFF_E + 3 * SZ_ACT;
constexpr size_t OFF_DEN = OFF_E + 4 * SZ_ACT;
constexpr size_t OFF_EM = OFF_DEN + AL((size_t)T * 4 * 4);
constexpr size_t OFF_EMX = OFF_EM + AL((size_t)GSEG * 4 * 128 * 128 * 4);
constexpr size_t OFF_GM = OFF_EMX + AL((size_t)GSEG * 4 * 128 * 16 * 4);
constexpr size_t OFF_EH = OFF_GM + AL((size_t)GSEG * 4 * 128 * 4);
constexpr size_t OFF_GH = OFF_EH + AL((size_t)GSEG * 4 * 128 * 128 * 4);
constexpr size_t OFF_ES = OFF_GH + AL((size_t)GSEG * 4 * 128 * 4);
constexpr size_t WS_END = OFF_ES + AL((size_t)SSEG * 32 * 64 * 2 * 4);
constexpr size_t OFF_YS = OFF_E;
constexpr size_t OFF_RWT = WS_END;
constexpr size_t OFF_HIST = OFF_RWT + 32 * 1024 * 4;
constexpr size_t OFF_BAR = OFF_HIST + 1024 * 32 * 4;
constexpr size_t WS_TOTAL = OFF_BAR + 16384;
static_assert(OFF_YS + (size_t)SLOTS * 1024 * 2 <= WS_END, "YS must fit in the dead region");
static_assert(OFF_H + (size_t)SLOTS * 256 * 2 <= OFF_ZS, "H must fit in the dead Z region");
static_assert(OFF_WD + (size_t)32 * 1024 * 256 * 2 <= OFF_Z, "expert weights must fit in R1");

struct Args { const float* in[34]; float* out; unsigned char* ws; int ph_lo, ph_hi; };
typedef const __attribute__((address_space(4))) Args& ArgsRef;

extern __shared__ __attribute__((aligned(16))) unsigned char smem[];

__device__ __forceinline__ bf16_t f2bf(float f) { return __builtin_bit_cast(unsigned short, (__bf16)f); }
__device__ __forceinline__ float bf2f(bf16_t b) { return __uint_as_float(((unsigned)b) << 16); }
__device__ __forceinline__ unsigned pack2(float lo, float hi) { typedef __bf16 bf2_t __attribute__((ext_vector_type(2))); bf2_t v; v[0] = (__bf16)lo; v[1] = (__bf16)hi; return __builtin_bit_cast(unsigned, v); }
__device__ __forceinline__ float fexp(float x) { return __builtin_amdgcn_exp2f(x * 1.4426950408889634f); }
__device__ __forceinline__ float flog(float x) { return __builtin_amdgcn_logf(x) * 0.6931471805599453f; }
__device__ __forceinline__ float sigmoidf_(float x) { return __builtin_amdgcn_rcpf(1.0f + fexp(-x)); }
__device__ __forceinline__ float siluf_(float x) { return x * __builtin_amdgcn_rcpf(1.0f + fexp(-x)); }
__device__ __forceinline__ float logsigmoidf_(float x) { return fminf(x, 0.f) - log1pf(expf(-fabsf(x))); }
__device__ __forceinline__ float gelu_tanh(float y) { const float z = 0.7978845608028654f * (y + 0.044715f * y * y * y); const float th = 1.0f - 2.0f * __builtin_amdgcn_rcpf(fexp(2.0f * z) + 1.0f); return 0.5f * y * (1.0f + th); }
__device__ __forceinline__ void wave_sync() { __builtin_amdgcn_wave_barrier(); asm volatile("s_waitcnt lgkmcnt(0)" ::: "memory"); __builtin_amdgcn_wave_barrier(); }

#define MFMA16(a, b, c) __builtin_amdgcn_mfma_f32_16x16x32_bf16((a), (b), (c), 0, 0, 0)

template <int MT, int NT, class FA, class FB>
__device__ __forceinline__ void wave_gemm(f32x4 (&acc)[MT][NT], int K, FA arow, FB brow, int lane) {
    const int r = lane & 15, q = lane >> 4;
    const bf16_t* ap[MT]; const bf16_t* bp[NT];
#pragma unroll
    for (int m = 0; m < MT; ++m) ap[m] = arow(m * 16 + r) + 8 * q;
#pragma unroll
    for (int n = 0; n < NT; ++n) bp[n] = brow(n * 16 + r) + 8 * q;
#pragma unroll 1
    for (int k = 0; k < K; k += 32) {
        bf16x8 a[MT], b[NT];
#pragma unroll
        for (int m = 0; m < MT; ++m) a[m] = *(const bf16x8*)(ap[m] + k);
#pragma unroll
        for (int n = 0; n < NT; ++n) b[n] = *(const bf16x8*)(bp[n] + k);
#pragma unroll
        for (int m = 0; m < MT; ++m)
#pragma unroll
            for (int n = 0; n < NT; ++n) acc[m][n] = MFMA16(a[m], b[n], acc[m][n]);
    }
}
template <int MT, int NT> __device__ __forceinline__ void zero_acc(f32x4 (&acc)[MT][NT]) {
#pragma unroll
    for (int m = 0; m < MT; ++m)
#pragma unroll
        for (int n = 0; n < NT; ++n) acc[m][n] = (f32x4){0.f, 0.f, 0.f, 0.f};
}

namespace pg8 {
#define PG8_LAS __attribute__((address_space(3)))
constexpr int BM = 256, BK = 64, HALF = 128, HTB = HALF * BK * 2, STAGE_BYTES = 8 * HTB;
__device__ __forceinline__ int lds_byte(int r, int c) { const int st = (r >> 4) * 2 + (c >> 5), rr = r & 15, cc = c & 31, ob = rr * 64 + cc * 2; return st * 1024 + (ob ^ (((ob >> 9) & 1) << 5)); }
__device__ __forceinline__ void stage_rc(int b, int& R, int& C) { const int st = b / 1024, sb = b % 1024, swz = sb ^ (((sb >> 9) & 1) << 5); R = (st >> 1) * 16 + swz / 64; C = (st & 1) * 32 + (swz % 64) / 2; }
__device__ __forceinline__ int perm32(int rho) { const int n = rho >> 4, i = rho & 15; return 8 * (i >> 2) + 4 * n + (i & 3); }
struct Unit { int pm, pn, tag; const char* A; const char* B; };
__device__ __forceinline__ unsigned cvt_pk_bf16(float lo, float hi) { unsigned r; asm volatile("v_cvt_pk_bf16_f32 %0, %1, %2" : "=v"(r) : "v"(lo), "v"(hi)); return r; }
__device__ __forceinline__ bool tile_order(int L, int nM, int nN, int& pm, int& pn) {
    const int nwg = nM * nN; if (L >= nwg) return false;
    int wgid = L; { const int q = nwg / 8, r = nwg % 8, xcd = wgid % 8, off = wgid / 8; wgid = (xcd < r ? xcd * (q + 1) : r * (q + 1) + (xcd - r) * q) + off; }
    const int nig = 8 * nN, gid = wgid / nig, fm = gid * 8, gsz = (nM - fm) < 8 ? (nM - fm) : 8;
    pm = fm + ((wgid % nig) % gsz); pn = (wgid % nig) / gsz; return true;
}
template <class Epi, class Sched>
__device__ __forceinline__ void gemm_phase(PG8_LAS unsigned char* lds, const int tid, const int K, const int lda, const int ldb, const Sched& S, const Epi& E) {
    const int wid = __builtin_amdgcn_readfirstlane(tid >> 6), lane = tid & 63, wr = wid >> 2, wc = wid & 3, fr = lane & 15, fq = lane >> 4;
    const int nt = K / BK;
    unsigned voffA[2], voffB[2];
#pragma unroll
    for (int i = 0; i < 2; ++i) { int R, C; stage_rc(tid * 16 + i * 8192, R, C); const int Rb = Epi::PERM ? ((R & ~31) + perm32(R & 31)) : R;
        voffA[i] = (unsigned)(R * lda + C) * 2u; voffB[i] = (unsigned)(Rb * ldb + C) * 2u; }
    const size_t kstep = (size_t)(BK * 2), hstepA = (size_t)HALF * lda * 2, hstepB = (size_t)HALF * ldb * 2;
    const unsigned ldsw = (unsigned)wid * 1024u;
    const int aoff = lds_byte(wr * 64 + fr, fq * 8), boff = lds_byte(wc * 32 + fr, fq * 8);
#define PG8_SA(b, h) (((b) * 2 + (h)) * HTB)
#define PG8_SB(b, h) ((4 + (b) * 2 + (h)) * HTB)
#define PG8_STAGE(bufoff, gbase, voff) do { _Pragma("unroll") for (int _i = 0; _i < 2; ++_i) \
        __builtin_amdgcn_global_load_lds((const unsigned*)((const char*)(gbase) + (voff)[_i]), (PG8_LAS unsigned*)(lds + (bufoff) + ldsw + _i * 8192), 16, 0, 0); } while (0)
#define PG8_LDA(dst, b, h) do { _Pragma("unroll") for (int m = 0; m < 4; ++m) _Pragma("unroll") for (int k = 0; k < 2; ++k) dst[m][k] = *(const PG8_LAS bf16x8*)(lds + PG8_SA(b, h) + aoff + m * 2048 + k * 1024); } while (0)
#define PG8_LDB(dst, b, h) do { _Pragma("unroll") for (int n = 0; n < 2; ++n) _Pragma("unroll") for (int k = 0; k < 2; ++k) dst[n][k] = *(const PG8_LAS bf16x8*)(lds + PG8_SB(b, h) + boff + n * 2048 + k * 1024); } while (0)
#define PG8_MMA(ai, bj, At, Bt) do { __builtin_amdgcn_s_setprio(1); _Pragma("unroll") for (int m = 0; m < 4; ++m) _Pragma("unroll") for (int n = 0; n < 2; ++n) _Pragma("unroll") for (int k = 0; k < 2; ++k) \
        acc[ai][bj][m][n] = __builtin_amdgcn_mfma_f32_16x16x32_bf16(Bt[n][k], At[m][k], acc[ai][bj][m][n], 0, 0, 0); __builtin_amdgcn_s_setprio(0); } while (0)
#define PG8_WAIT_V(n) asm volatile("s_waitcnt vmcnt(" #n ")" ::: "memory")
#define PG8_WAIT_L(n) asm volatile("s_waitcnt lgkmcnt(" #n ")" ::: "memory")
#define PG8_BAR __builtin_amdgcn_s_barrier()
#define PG8_SCHED __builtin_amdgcn_sched_barrier(0)
    Unit cur, nxt; int ui = 0;
    if (!S.next(0, cur)) return;
    f32x4 acc[2][2][4][2];
#pragma unroll
    for (int a = 0; a < 2; ++a)
#pragma unroll
        for (int b = 0; b < 2; ++b)
#pragma unroll
            for (int m = 0; m < 4; ++m)
#pragma unroll
                for (int n = 0; n < 2; ++n) acc[a][b][m][n] = (f32x4){0.f, 0.f, 0.f, 0.f};
    bf16x8 At[4][2], B0[2][2], B1[2][2];
    const char* cA = cur.A; const char* cB = cur.B;
    PG8_STAGE(PG8_SB(0, 0), cB, voffB); PG8_STAGE(PG8_SA(0, 0), cA, voffA); PG8_STAGE(PG8_SB(0, 1), cB + hstepB, voffB); PG8_STAGE(PG8_SA(0, 1), cA + hstepA, voffA);
    if (wr == 1) PG8_BAR;
    PG8_WAIT_V(4); PG8_BAR;
    PG8_STAGE(PG8_SB(1, 0), cB + kstep, voffB); PG8_STAGE(PG8_SA(1, 0), cA + kstep, voffA); PG8_STAGE(PG8_SB(1, 1), cB + hstepB + kstep, voffB);
    PG8_WAIT_V(6); PG8_BAR;
    for (;;) {
        const bool has_next = S.next(ui + 1, nxt);
        const char* nA = has_next ? nxt.A : cA; const char* nB = has_next ? nxt.B : cB;
        for (int t = 0; t < nt; t += 2) {
            const bool last = (t == nt - 2);
            const char* a1 = cA + (size_t)(t + 1) * kstep;
            const char* a2 = last ? nA : cA + (size_t)(t + 2) * kstep; const char* b2 = last ? nB : cB + (size_t)(t + 2) * kstep;
            const char* a3 = a2 + kstep; const char* b3 = b2 + kstep;
            PG8_LDB(B0, 0, 0); PG8_SCHED; PG8_LDA(At, 0, 0); PG8_STAGE(PG8_SA(1, 1), a1 + hstepA, voffA);
            PG8_WAIT_L(8); PG8_BAR; PG8_WAIT_L(0); PG8_MMA(0, 0, At, B0); PG8_BAR; PG8_SCHED;
            PG8_LDB(B1, 0, 1); PG8_STAGE(PG8_SB(0, 0), b2, voffB);
            PG8_BAR; PG8_WAIT_L(0); PG8_MMA(0, 1, At, B1); PG8_BAR;
            PG8_LDA(At, 0, 1); PG8_STAGE(PG8_SA(0, 0), a2, voffA);
            PG8_BAR; PG8_WAIT_L(0); PG8_MMA(1, 0, At, B0); PG8_BAR; PG8_SCHED;
            PG8_STAGE(PG8_SB(0, 1), b2 + hstepB, voffB);
            PG8_WAIT_V(6); PG8_BAR; PG8_MMA(1, 1, At, B1); PG8_BAR;
            PG8_LDB(B0, 1, 0); PG8_SCHED; PG8_LDA(At, 1, 0); PG8_STAGE(PG8_SA(0, 1), a2 + hstepA, voffA);
            PG8_WAIT_L(8); PG8_BAR; PG8_WAIT_L(0); PG8_MMA(0, 0, At, B0); PG8_BAR; PG8_SCHED;
            PG8_LDB(B1, 1, 1); PG8_STAGE(PG8_SB(1, 0), b3, voffB);
            PG8_BAR; PG8_WAIT_L(0); PG8_MMA(0, 1, At, B1); PG8_BAR;
            PG8_LDA(At, 1, 1); PG8_STAGE(PG8_SA(1, 0), a3, voffA);
            PG8_BAR; PG8_WAIT_L(0); PG8_MMA(1, 0, At, B0); PG8_BAR; PG8_SCHED;
            PG8_STAGE(PG8_SB(1, 1), b3 + hstepB, voffB);
            PG8_WAIT_V(6); PG8_BAR; PG8_MMA(1, 1, At, B1); PG8_BAR;
        }
        const bool keep = E(acc, cur, wr, wc, fr, fq);
        if (!has_next) break;
        if (!keep) {
#pragma unroll
            for (int a = 0; a < 2; ++a)
#pragma unroll
                for (int b = 0; b < 2; ++b)
#pragma unroll
                    for (int m = 0; m < 4; ++m)
#pragma unroll
                        for (int n = 0; n < 2; ++n) acc[a][b][m][n] = (f32x4){0.f, 0.f, 0.f, 0.f};
        }
        cur = nxt; cA = nA; cB = nB; ++ui;
    }
    PG8_WAIT_V(0);
    if (wr == 0) PG8_BAR;
    PG8_BAR;
#undef PG8_SA
#undef PG8_SB
#undef PG8_STAGE
#undef PG8_LDA
#undef PG8_LDB
#undef PG8_MMA
#undef PG8_WAIT_V
#undef PG8_WAIT_L
#undef PG8_BAR
#undef PG8_SCHED
}
}

__device__ __forceinline__ void tconv_tile(const float* src, int ld_src, int nvalid, bf16_t* dst, int ld_dst, int tid) {
    float* t = (float*)smem;
    { const int r = tid >> 3, c0 = (tid & 7) * 8; float v[8];
      if (nvalid == 64) { const f32x4 a0 = *(const f32x4*)(src + (size_t)r * ld_src + c0), a1 = *(const f32x4*)(src + (size_t)r * ld_src + c0 + 4);
          v[0] = a0[0]; v[1] = a0[1]; v[2] = a0[2]; v[3] = a0[3]; v[4] = a1[0]; v[5] = a1[1]; v[6] = a1[2]; v[7] = a1[3]; }
      else {
#pragma unroll
          for (int j = 0; j < 8; ++j) { const int c = c0 + j; v[j] = (c < nvalid) ? src[(size_t)r * ld_src + c] : 0.f; } }
#pragma unroll
      for (int j = 0; j < 8; ++j) t[(c0 + j) * 65 + r] = v[j]; }
    __syncthreads();
    { const int n = tid >> 3, k0 = (tid & 7) * 8; const float* p = t + n * 65 + k0;
      u32x4 w; w.x = pack2(p[0], p[1]); w.y = pack2(p[2], p[3]); w.z = pack2(p[4], p[5]); w.w = pack2(p[6], p[7]);
      *(u32x4*)(dst + (size_t)n * ld_dst + k0) = w; }
    __syncthreads();
}

__device__ __forceinline__ void wave_tconv(const float* src, int ld_src, bf16_t* dst, int ld_dst, int lane, float* t  ) {
    f32x4 v[16]; const int rq = lane >> 4, c4 = (lane & 15) * 4;
#pragma unroll
    for (int i = 0; i < 16; ++i) v[i] = *(const f32x4*)(src + (size_t)(4 * i + rq) * ld_src + c4);
#pragma unroll
    for (int i = 0; i < 16; ++i)
#pragma unroll
        for (int j = 0; j < 4; ++j) t[(c4 + j) * 65 + 4 * i + rq] = v[i][j];
    wave_sync();
    const int rr = lane >> 3, k8 = (lane & 7) * 8;
#pragma unroll
    for (int i = 0; i < 8; ++i) { const float* p = t + (8 * i + rr) * 65 + k8;
        u32x4 w; w.x = pack2(p[0], p[1]); w.y = pack2(p[2], p[3]); w.z = pack2(p[4], p[5]); w.w = pack2(p[6], p[7]);
        *(u32x4*)(dst + (size_t)(8 * i + rr) * ld_dst + k8) = w; }
    wave_sync();
}
__device__ __forceinline__ void wave_prepx_tile(ArgsRef a, int l, int u, int lane, float* t) {
    bf16_t* WGU = (bf16_t*)(a.ws + OFF_WGU); bf16_t* WD = (bf16_t*)(a.ws + OFF_WD);
    if (u < 4096) { const int up = u >= 2048, v = u & 2047, e = v / 64, w = v % 64, nt = w / 16, kt = w % 16, j0 = nt * 64, drow = (j0 / 128) * 256 + (j0 % 128) + up * 128;
        wave_tconv(a.in[31 + up] + ((size_t)(l * 32 + e) * 1024 + kt * 64) * 256 + nt * 64, 256, WGU + ((size_t)e * 512 + drow) * 1024 + kt * 64, 1024, lane, t); }
    else { const int v = u - 4096, e = v / 64, w = v % 64, nt = w / 4, kt = w % 4;
        wave_tconv(a.in[33] + ((size_t)(l * 32 + e) * 256 + kt * 64) * 1024 + nt * 64, 1024, WD + ((size_t)e * 1024 + nt * 64) * 256 + kt * 64, 256, lane, t); }
}
__device__ __forceinline__ void phase_prep(ArgsRef a, int l, int tid, int bid, int G) {
    unsigned char* ws = a.ws;
    bf16_t* WIN = (bf16_t*)(ws + OFF_WIN); bf16_t* WQKV = (bf16_t*)(ws + OFF_WQKV); bf16_t* WGLU = (bf16_t*)(ws + OFF_WGLU);
    bf16_t* WB = (bf16_t*)(ws + OFF_WB); bf16_t* WOUT = (bf16_t*)(ws + OFF_WOUT);
    for (int u = bid; u < 2624; u += G) {
        const float* src; int lds_ = 0, nvalid = 64, ldd = 0; bf16_t* dst;
        if (u < 1728) { const int nt = u / 16, kt = u % 16, p0 = nt * 64; int sc;
            if (p0 < 1024) sc = p0; else if (p0 < 6656) sc = p0 + 8; else if (p0 == 6656) { sc = 1024; nvalid = 8; } else { sc = 0; nvalid = 0; }
            src = a.in[1] + (size_t)l * 1024 * INW + (size_t)(kt * 64) * INW + sc; lds_ = INW; dst = WIN + (size_t)p0 * 1024 + kt * 64; ldd = 1024; }
        else if (u < 1920) { const int v = u - 1728, nt = v / 8, kt = v % 8, which = nt / 8, h = (nt % 8) / 2;
            if ((kt >> 1) != h) nvalid = 0;
            src = a.in[4 + which] + (size_t)(l * 4 + h) * 128 * 128 + ((kt & 1) * 64) * 128 + (nt & 1) * 64; lds_ = 128; dst = WQKV + (size_t)(nt * 64) * 512 + kt * 64; ldd = 512; }
        else if (u < 1984) { const int v = u - 1920, nt = v / 8, kt = v % 8;
            src = a.in[18] + (size_t)l * 512 * 512 + (kt * 64) * 512 + nt * 64; lds_ = 512; dst = WGLU + (size_t)(nt * 64) * 512 + kt * 64; ldd = 512; }
        else if (u < 2368) { const int v = u - 1984, b = v / 128, w = v % 128, nt = w / 8, kt = w % 8;
            src = a.in[21 + b] + (size_t)l * 512 * 1024 + (size_t)(kt * 64) * 1024 + nt * 64; lds_ = 1024; dst = WB + (size_t)b * 1024 * 512 + (size_t)(nt * 64) * 512 + kt * 64; ldd = 512; }
        else { const int v = u - 2368, nt = v / 16, kt = v % 16;
            src = a.in[24] + (size_t)l * 1024 * 1024 + (size_t)(kt * 64) * 1024 + nt * 64; lds_ = 1024; dst = WOUT + (size_t)(nt * 64) * 1024 + kt * 64; ldd = 1024; }
        tconv_tile(src, lds_, nvalid, dst, ldd, tid);
    }
    float* ABAR = (float*)(ws + OFF_ABAR); bf16_t* BBT = (bf16_t*)(ws + OFF_BBT); bf16_t* CCT = (bf16_t*)(ws + OFF_CCT);
    for (int i = bid * 512 + tid; i < 2048; i += G * 512) {
        const int g = i / 64, p = i % 64; const size_t gp = (size_t)(l * 32 + g) * 64 + p;
        const float lr = fminf(a.in[10][gp], -1e-4f), li = a.in[11][gp], dt = expf(a.in[12][l * 32 + g]);
        const float mag = expf(lr * dt), abr = mag * cosf(li * dt), abi = mag * sinf(li * dt);
        const float nr = abr - 1.0f, den = lr * lr + li * li, cr = (nr * lr + abi * li) / den, ci = (abi * lr - nr * li) / den;
        ABAR[(g * 64 + p) * 2] = abr; ABAR[(g * 64 + p) * 2 + 1] = abi;
        for (int c = 0; c < 16; ++c) { const float br = a.in[13][gp * 16 + c], bi = a.in[14][gp * 16 + c];
            BBT[(size_t)(g * 128 + p) * 16 + c] = f2bf(cr * br - ci * bi); BBT[(size_t)(g * 128 + 64 + p) * 16 + c] = f2bf(cr * bi + ci * br);
            const size_t ci_ = ((size_t)(l * 32 + g) * 16 + c) * 64 + p;
            CCT[(size_t)(g * 16 + c) * 128 + p] = f2bf(a.in[15][ci_]); CCT[(size_t)(g * 16 + c) * 128 + 64 + p] = f2bf(-a.in[16][ci_]); }
    }
    if (l == 0) { float* RWT = (float*)(ws + OFF_RWT); const float* RW = a.in[29]; for (int i = bid * 512 + tid; i < 32 * 1024; i += G * 512) RWT[i] = RW[(i & 1023) * 32 + (i >> 10)]; }
    if (l == 0) { bf16_t* XB = (bf16_t*)(ws + OFF_XB); const float* x = a.in[0];
        for (size_t i = (size_t)bid * 512 + tid; i < (size_t)T * 1024 / 8; i += (size_t)G * 512) {
            const f32x4 v0 = *(const f32x4*)(x + i * 8), v1 = *(const f32x4*)(x + i * 8 + 4);
            u32x4 w; w.x = pack2(v0[0], v0[1]); w.y = pack2(v0[2], v0[3]); w.z = pack2(v1[0], v1[1]); w.w = pack2(v1[2], v1[3]); *(u32x4*)(XB + i * 8) = w; } }
}

__device__ __forceinline__ void phase_prepx(ArgsRef a, int l, int tid, int bid, int G, int u_lo, int u_hi) {
    bf16_t* WGU = (bf16_t*)(a.ws + OFF_WGU); bf16_t* WD = (bf16_t*)(a.ws + OFF_WD);
    for (int u = u_lo + bid; u < u_hi; u += G) {
        const float* src; int lds_, ldd; bf16_t* dst;
        if (u < 4096) { const int up = u >= 2048, v = u & 2047, e = v / 64, w = v % 64, nt = w / 16, kt = w % 16, j0 = nt * 64, drow = (j0 / 128) * 256 + (j0 % 128) + up * 128;
            src = a.in[31 + up] + ((size_t)(l * 32 + e) * 1024 + kt * 64) * 256 + nt * 64; lds_ = 256; dst = WGU + ((size_t)e * 512 + drow) * 1024 + kt * 64; ldd = 1024; }
        else { const int v = u - 4096, e = v / 64, w = v % 64, nt = w / 4, kt = w % 4;
            src = a.in[33] + ((size_t)(l * 32 + e) * 256 + kt * 64) * 1024 + nt * 64; lds_ = 1024; dst = WD + ((size_t)e * 1024 + nt * 64) * 256 + kt * 64; ldd = 256; }
        tconv_tile(src, lds_, 64, dst, ldd, tid);
    }
}

constexpr int GL_RQ = 0, GL_RK = 17408, GL_VT = 34816, GL_RO = 57856, GL_RX = 75264, GL_KT = 92672, GL_PS = 102912, GL_SC1 = 105472, GL_SC2 = 105984, GL_GT = 106496, GL_OS = 108544, GL_LFS = 117248, GL_DNS = 117504;
template <int MODE, int PASS>
__device__ __forceinline__ void gla_item(ArgsRef a, int l, int h, int sg, int tid, int lane, int wave) {
    unsigned char* ws = a.ws;
    const bf16_t* Z = (const bf16_t*)(ws + OFF_Z); const bf16_t* Qg = (const bf16_t*)(ws + OFF_Q); const bf16_t* Kg = (const bf16_t*)(ws + OFF_KH); const bf16_t* Vg = (const bf16_t*)(ws + OFF_V); const bf16_t* XCg = (const bf16_t*)(ws + OFF_XC);
    const float* LF = (const float*)(ws + OFF_LF);
    float* Eg = (float*)(ws + (MODE == 0 ? OFF_EM : OFF_EH)); float* Gg = (float*)(ws + (MODE == 0 ? OFF_GM : OFF_GH)); float* EX = (float*)(ws + OFF_EMX);
    bf16_t* Yg = (bf16_t*)(ws + (MODE == 0 ? OFF_OM : OFF_OH));
    bf16_t* KT = (bf16_t*)(smem + GL_KT); bf16_t* PS = (bf16_t*)(smem + GL_PS);
    float* SC1 = (float*)(smem + GL_SC1); float* SC2 = (float*)(smem + GL_SC2); float* GT = (float*)(smem + GL_GT); bf16_t* OS = (bf16_t*)(smem + GL_OS); float* DNS = (float*)(smem + GL_DNS);
    const int r = lane & 15, q = lane >> 4, grp = tid >> 7, d = tid & 127, tok = tid >> 4, c8 = (tid & 15) * 8;
    const bool xw = (MODE == 0) && (wave == 0);
    float lb = 0.f;
    if (MODE == 1 && l == 1) { const float h0 = a.in[19][h * 128 + d], h1 = a.in[19][512 + h * 128 + d]; lb = 1.0f / (1.0f + expf(h0 - h1)); }
    f32x4 S[8], SX[8];
#pragma unroll
    for (int i = 0; i < 8; ++i) { S[i] = (f32x4){0.f, 0.f, 0.f, 0.f}; SX[i] = (f32x4){0.f, 0.f, 0.f, 0.f}; }
    if (PASS == 2) {
#pragma unroll
        for (int i = 0; i < 8; ++i)
#pragma unroll
            for (int g = 0; g < 4; ++g) { const size_t row = (size_t)(sg * 4 + h) * 128 + 16 * i + 4 * q + g; S[i][g] = Eg[row * 128 + 16 * wave + r]; if (xw) SX[i][g] = EX[row * 16 + r]; }
    }
    const bf16x8 z8 = (bf16x8){0, 0, 0, 0, 0, 0, 0, 0};
    bf16x8 rq = z8, rk = z8, rv = z8, ro = z8, rx = z8; float lfv = 0.f;
#define GLA_FETCH(t0_) do { const size_t tk = (size_t)((t0_) + tok); \
        if (MODE == 1) { const bf16_t* zp = Z + tk * NZ + h * 128 + c8; if (PASS == 2) { rq = *(const bf16x8*)(zp + 1536); ro = *(const bf16x8*)(zp + 3072); } rk = *(const bf16x8*)(zp + 2048); rv = *(const bf16x8*)(zp + 2560); } \
        else { const size_t o_ = tk * 512 + h * 128 + c8; if (PASS == 2) { rq = *(const bf16x8*)(Qg + o_); ro = *(const bf16x8*)(Z + tk * NZ + 512 + h * 128 + c8); rx = *(const bf16x8*)(XCg + o_); } \
               rk = *(const bf16x8*)(Kg + o_); rv = *(const bf16x8*)(Vg + o_); if (tid < 32) lfv = LF[((t0_) + tid) * 4 + h]; } } while (0)
    GLA_FETCH(sg * GSEGLEN);
    float sk8[8], nw8[8];
#pragma unroll
    for (int j = 0; j < 8; ++j) { sk8[j] = (MODE == 0 && PASS == 2) ? a.in[9][l * 512 + h * 128 + c8 + j] : 0.f; nw8[j] = (MODE == 1 && PASS == 2) ? a.in[20][l * 512 + h * 128 + c8 + j] : 0.f; }
    __syncthreads();
    if (MODE == 0) { for (int i = tid; i < 2 * 16 * 40; i += 512) { const int b = i / 640, k = i % 640; ((bf16_t*)(smem + GL_VT + b * 11520))[128 * 40 + k] = (k < 32) ? (bf16_t)0x3F80 : (bf16_t)0; } }
#define GLA_STORE(tprev, pb) do { const bf16x8 o8 = *(const bf16x8*)(OS + tok * 136 + c8); const bf16x8 p8 = *(const bf16x8*)((const bf16_t*)(smem + GL_RO + (pb) * 8704) + tok * 136 + c8); float y[8]; \
        if (MODE == 0) { const bf16x8 x8 = *(const bf16x8*)((const bf16_t*)(smem + GL_RX + (pb) * 8704) + tok * 136 + c8); const float di = __builtin_amdgcn_rcpf(fmaxf(fabsf(DNS[tok]), 1.0f)); \
            _Pragma("unroll") for (int j = 0; j < 8; ++j) y[j] = sigmoidf_(bf2f((bf16_t)p8[j])) * (bf2f((bf16_t)o8[j]) * di) + sk8[j] * bf2f((bf16_t)x8[j]); } \
        else { float ov[8], ss = 0.f; _Pragma("unroll") for (int j = 0; j < 8; ++j) { ov[j] = bf2f((bf16_t)o8[j]); ss += ov[j] * ov[j]; } \
            ss += __shfl_xor(ss, 1); ss += __shfl_xor(ss, 2); ss += __shfl_xor(ss, 4); ss += __shfl_xor(ss, 8); const float rinv = rsqrtf(ss * (1.0f / 128.0f) + 1e-6f); \
            _Pragma("unroll") for (int j = 0; j < 8; ++j) y[j] = ov[j] * rinv * nw8[j] * siluf_(bf2f((bf16_t)p8[j])); } \
        u32x4 w_; w_.x = pack2(y[0], y[1]); w_.y = pack2(y[2], y[3]); w_.z = pack2(y[4], y[5]); w_.w = pack2(y[6], y[7]); *(u32x4*)(Yg + (size_t)((tprev) + tok) * 512 + h * 128 + c8) = w_; } while (0)
    float runb = 0.f;
    for (int ci = 0; ci < GSEGLEN / 32; ++ci) {
        const int t0 = sg * GSEGLEN + ci * 32, buf = ci & 1;
        bf16_t* RQ = (bf16_t*)(smem + GL_RQ + buf * 8704); bf16_t* RK = (bf16_t*)(smem + GL_RK + buf * 8704); bf16_t* VT = (bf16_t*)(smem + GL_VT + buf * 11520);
        float* LFS = (float*)(smem + GL_LFS + buf * 128);
        if (PASS == 2) { *(bf16x8*)(RQ + tok * 136 + c8) = rq; *(bf16x8*)((bf16_t*)(smem + GL_RO + buf * 8704) + tok * 136 + c8) = ro; if (MODE == 0) *(bf16x8*)((bf16_t*)(smem + GL_RX + buf * 8704) + tok * 136 + c8) = rx; }
        *(bf16x8*)(RK + tok * 136 + c8) = rk;
#pragma unroll
        for (int j = 0; j < 8; ++j) VT[(c8 + j) * 40 + tok] = (bf16_t)rv[j];
        if (MODE == 0 && tid < 32) LFS[tid] = lfv;
        if (ci + 1 < GSEGLEN / 32) GLA_FETCH(t0 + 32);
        __syncthreads();
        float lg[8], kv[8];
#pragma unroll
        for (int j = 0; j < 8; ++j) { const float kr = bf2f(RK[(grp * 8 + j) * 136 + d]);
            if (MODE == 1) { const float f = lb + (1.0f - lb) * sigmoidf_(kr); lg[j] = flog(f); kv[j] = 1.0f - f; } else { lg[j] = LFS[grp * 8 + j]; kv[j] = kr; } }
        float cs[8]; cs[0] = lg[0];
#pragma unroll
        for (int j = 1; j < 8; ++j) cs[j] = cs[j - 1] + lg[j];
        GT[grp * 128 + d] = cs[7];
        __syncthreads();
        if (PASS == 2 && ci > 0) GLA_STORE(t0 - 32, buf ^ 1);
        const float g0 = GT[d], g1 = GT[128 + d], g2 = GT[256 + d], g3 = GT[384 + d];
        const float off = grp == 0 ? 0.f : grp == 1 ? g0 : grp == 2 ? g0 + g1 : g0 + g1 + g2;
        const float bmid = g0 + g1, bL = bmid + g2 + g3;
        bf16_t ktv[8];
#pragma unroll
        for (int j = 0; j < 8; ++j) { const float bt = off + cs[j], ek = fexp(bmid - bt); const bf16_t kt = f2bf(kv[j] * ek); ktv[j] = kt;
            if (PASS == 2) { const float qr = bf2f(RQ[(grp * 8 + j) * 136 + d]); const float qq = (MODE == 1) ? siluf_(qr) : qr; RQ[(grp * 8 + j) * 136 + d] = f2bf(qq * __builtin_amdgcn_rcpf(ek)); RK[(grp * 8 + j) * 136 + d] = kt; } }
        { u32x4 w; w.x = ktv[0] | ((unsigned)ktv[1] << 16); w.y = ktv[2] | ((unsigned)ktv[3] << 16); w.z = ktv[4] | ((unsigned)ktv[5] << 16); w.w = ktv[6] | ((unsigned)ktv[7] << 16); *(u32x4*)(KT + d * 40 + grp * 8) = w; }
        if (grp == 0) { SC1[d] = fexp(bmid); SC2[d] = fexp(bL - bmid); runb += bL; }
        __syncthreads();
        if (PASS == 2) {
            if (wave < 4) {
                const int ti = (wave == 1 || wave == 2) ? 1 : 0, tj = (wave >= 2) ? 1 : 0;
                f32x4 p = (f32x4){0.f, 0.f, 0.f, 0.f};
                if (wave < 3) {
#pragma unroll
                    for (int kk = 0; kk < 4; ++kk) { const bf16x8 av = *(const bf16x8*)(RQ + (16 * ti + r) * 136 + 32 * kk + 8 * q); const bf16x8 bv = *(const bf16x8*)(RK + (16 * tj + r) * 136 + 32 * kk + 8 * q); p = MFMA16(av, bv, p); }
                }
#pragma unroll
                for (int g = 0; g < 4; ++g) { const int t = 16 * ti + 4 * q + g, s_ = 16 * tj + r; PS[t * 40 + s_] = (wave < 3 && s_ <= t) ? f2bf(p[g]) : (bf16_t)0; }
            }
            __syncthreads();
        }
        const bf16x8 bV = *(const bf16x8*)(VT + (16 * wave + r) * 40 + 8 * q);
        bf16x8 bV1 = bV; if (xw) bV1 = *(const bf16x8*)(VT + (128 + r) * 40 + 8 * q);
        f32x4 o[2], ox[2];
        o[0] = o[1] = ox[0] = ox[1] = (f32x4){0.f, 0.f, 0.f, 0.f};
#pragma unroll
        for (int kk = 0; kk < 4; ++kk) {
            const f32x4 sa = *(const f32x4*)(SC1 + 32 * kk + 4 * q), sb = *(const f32x4*)(SC1 + 32 * kk + 16 + 4 * q);
            S[2 * kk] *= sa; S[2 * kk + 1] *= sb;
            if (xw) { SX[2 * kk] *= sa; SX[2 * kk + 1] *= sb; }
            if (PASS == 2) {
                bf16x8 bS, bX;
#pragma unroll
                for (int g = 0; g < 4; ++g) { bS[g] = (short)f2bf(S[2 * kk][g]); bS[4 + g] = (short)f2bf(S[2 * kk + 1][g]); bX[g] = (short)f2bf(SX[2 * kk][g]); bX[4 + g] = (short)f2bf(SX[2 * kk + 1][g]); }
#pragma unroll
                for (int mt = 0; mt < 2; ++mt) { const bf16x4 lo = *(const bf16x4*)(RQ + (16 * mt + r) * 136 + 32 * kk + 4 * q), hi = *(const bf16x4*)(RQ + (16 * mt + r) * 136 + 32 * kk + 16 + 4 * q);
                    bf16x8 av; av[0] = lo[0]; av[1] = lo[1]; av[2] = lo[2]; av[3] = lo[3]; av[4] = hi[0]; av[5] = hi[1]; av[6] = hi[2]; av[7] = hi[3];
                    o[mt] = MFMA16(av, bS, o[mt]); if (xw) ox[mt] = MFMA16(av, bX, ox[mt]); }
            }
        }
        if (PASS == 2) {
#pragma unroll
            for (int mt = 0; mt < 2; ++mt) { const bf16x8 av = *(const bf16x8*)(PS + (16 * mt + r) * 40 + 8 * q); o[mt] = MFMA16(av, bV, o[mt]); if (xw) ox[mt] = MFMA16(av, bV1, ox[mt]);
#pragma unroll
                for (int g = 0; g < 4; ++g) { OS[(16 * mt + 4 * q + g) * 136 + 16 * wave + r] = f2bf(o[mt][g]); if (xw && r == 0) DNS[16 * mt + 4 * q + g] = ox[mt][g]; } }
        }
#pragma unroll
        for (int i = 0; i < 8; ++i) { const bf16x8 av = *(const bf16x8*)(KT + (16 * i + r) * 40 + 8 * q); const f32x4 s2 = *(const f32x4*)(SC2 + 16 * i + 4 * q);
            S[i] = MFMA16(av, bV, S[i]); S[i] *= s2;
            if (xw) { SX[i] = MFMA16(av, bV1, SX[i]); SX[i] *= s2; } }
    }
    if (PASS == 2) { __syncthreads(); GLA_STORE(sg * GSEGLEN + GSEGLEN - 32, 1); }
    if (PASS == 1) {
        float* ST = (float*)smem;
        __syncthreads();
#pragma unroll
        for (int i = 0; i < 8; ++i)
#pragma unroll
            for (int g = 0; g < 4; ++g) { ST[(16 * i + 4 * q + g) * 132 + 16 * wave + r] = S[i][g]; if (xw) EX[((size_t)(sg * 4 + h) * 128 + 16 * i + 4 * q + g) * 16 + r] = SX[i][g]; }
        __syncthreads();
#pragma unroll
        for (int k = 0; k < 8; ++k) { const int idx = tid + 512 * k, row = idx >> 5, c4 = (idx & 31) * 4; *(f32x4*)(Eg + ((size_t)(sg * 4 + h) * 128 + row) * 128 + c4) = *(const f32x4*)(ST + row * 132 + c4); }
        if (grp == 0) Gg[(size_t)(sg * 4 + h) * 128 + d] = expf(runb);
    }
#undef GLA_FETCH
#undef GLA_STORE
}

template <int PASS>
__device__ __forceinline__ void s5_item(ArgsRef a, int l, int g, int sg, int g0, int tid, int lane, int wave, int hsel) {
    unsigned char* ws = a.ws;
    const bf16_t* Z = (const bf16_t*)(ws + OFF_Z); const float* ABAR = (const float*)(ws + OFF_ABAR); const bf16_t* BBT = (const bf16_t*)(ws + OFF_BBT); const bf16_t* CCT = (const bf16_t*)(ws + OFF_CCT);
    float* ES = (float*)(ws + OFF_ES); bf16_t* YPRE = (bf16_t*)(ws + OFF_YPRE);
    float* BU = (float*)(smem + 70000 + (wave & 3) * 12800); bf16_t* X = (bf16_t*)(smem + 70000 + (wave & 3) * 12800 + 8448); bf16_t* YT = (bf16_t*)(smem + 70000 + 51200);
    const int r = lane & 15, q = lane >> 4, p = lane; const bool act = (wave >> 2) == hsel;
    const float ar = ABAR[(g * 64 + p) * 2], ai = ABAR[(g * 64 + p) * 2 + 1];
    const bf16x8 zero8 = (bf16x8){0, 0, 0, 0, 0, 0, 0, 0};
    bf16x8 bB[8], cB[4];
#pragma unroll
    for (int nt = 0; nt < 8; ++nt) bB[nt] = (q < 2) ? *(const bf16x8*)(BBT + (size_t)(g * 128 + 16 * nt + r) * 16 + 8 * q) : zero8;
#pragma unroll
    for (int kk = 0; kk < 4; ++kk) cB[kk] = (PASS == 2) ? *(const bf16x8*)(CCT + (size_t)(g * 16 + r) * 128 + 32 * kk + 8 * q) : zero8;
    float xr = 0.f, xi = 0.f;
    if (PASS == 2) { xr = ES[((size_t)(sg * 32 + g) * 64 + p) * 2]; xi = ES[((size_t)(sg * 32 + g) * 64 + p) * 2 + 1]; }
    const float dsk = a.in[17][l * 512 + 16 * g + r];
    bf16x8 av_n = zero8; bf16_t un[4] = {0, 0, 0, 0};
#define S5_FETCH(t0_) do { if (q < 2) av_n = *(const bf16x8*)(Z + (size_t)((t0_) + r) * NZ + 1024 + 16 * g + 8 * q); \
        if (PASS == 2) { _Pragma("unroll") for (int gg_ = 0; gg_ < 4; ++gg_) un[gg_] = Z[(size_t)((t0_) + 4 * q + gg_) * NZ + 1024 + 16 * g + r]; } } while (0)
    if (act) S5_FETCH(sg * SSEGLEN);
    for (int ci = 0; ci < SSEGLEN / 16; ++ci) {
        const int t0 = sg * SSEGLEN + ci * 16;
        if (act) {
            const bf16x8 av = av_n; bf16_t uc[4] = {un[0], un[1], un[2], un[3]};
            if (ci + 1 < SSEGLEN / 16) S5_FETCH(t0 + 16);
#pragma unroll
            for (int nt = 0; nt < 8; ++nt) { f32x4 acc = (f32x4){0.f, 0.f, 0.f, 0.f}; acc = MFMA16(av, bB[nt], acc);
#pragma unroll
                for (int gg = 0; gg < 4; ++gg) BU[(4 * q + gg) * 132 + 16 * nt + r] = acc[gg]; }
            wave_sync();
#pragma unroll
            for (int t = 0; t < 16; ++t) { const float br = BU[t * 132 + p], bi = BU[t * 132 + 64 + p];
                const float nr = ar * xr - ai * xi + br, ni = ar * xi + ai * xr + bi; xr = nr; xi = ni;
                if (PASS == 2) { X[t * 136 + p] = f2bf(xr); X[t * 136 + 64 + p] = f2bf(xi); } }
            wave_sync();
            if (PASS == 2) {
                f32x4 acc = (f32x4){0.f, 0.f, 0.f, 0.f};
#pragma unroll
                for (int kk = 0; kk < 4; ++kk) { const bf16x8 xv = *(const bf16x8*)(X + r * 136 + 32 * kk + 8 * q); acc = MFMA16(xv, cB[kk], acc); }
#pragma unroll
                for (int gg = 0; gg < 4; ++gg) YT[(4 * q + gg) * 136 + 16 * wave + r] = f2bf(gelu_tanh(acc[gg] + dsk * bf2f(uc[gg])));
            }
        }
        if (PASS == 2) {
            __syncthreads();
            if (tid < 128) { const int row = tid >> 3, c8 = (tid & 7) * 8; *(u32x4*)(YPRE + (size_t)(t0 + row) * 512 + 16 * g0 + 64 * hsel + c8) = *(const u32x4*)(YT + row * 136 + 64 * hsel + c8); }
            __syncthreads();
        }
    }
    if (PASS == 1 && act) { ES[((size_t)(sg * 32 + g) * 64 + p) * 2] = xr; ES[((size_t)(sg * 32 + g) * 64 + p) * 2 + 1] = xi; }
#undef S5_FETCH
}

__device__ __forceinline__ void phase_scan(ArgsRef a, int tid, int bid, int G) {
    unsigned char* ws = a.ws;
    const int NT = G * 512, gt = bid * 512 + tid;
    for (int i = gt; i < 2 * 65536 + 8192 + 2048; i += NT) {
        if (i < 2 * 65536 + 8192) { const bool nx = i >= 2 * 65536; const int m = i >> 16, el = nx ? i - 2 * 65536 : (i & 65535), hrow = nx ? (el >> 4) : (el >> 7); const size_t str = nx ? 8192 : 65536;
            float* E = (float*)(ws + (nx ? OFF_EMX : (m == 0 ? OFF_EM : OFF_EH))); const float* Gd = (const float*)(ws + ((nx || m == 0) ? OFF_GM : OFF_GH));
            float ev[GSEG], gv[GSEG];
#pragma unroll
            for (int sg = 0; sg < GSEG; ++sg) { ev[sg] = E[(size_t)sg * str + el]; gv[sg] = Gd[sg * 512 + hrow]; }
            float cur = 0.f;
#pragma unroll
            for (int sg = 0; sg < GSEG; ++sg) { E[(size_t)sg * str + el] = cur; cur = gv[sg] * cur + ev[sg]; } }
        else { const int el = i - 2 * 65536 - 8192; float* E = (float*)(ws + OFF_ES); const float* ABAR = (const float*)(ws + OFF_ABAR);
            float pr = ABAR[el * 2], pi = ABAR[el * 2 + 1];
#pragma unroll
            for (int k = 0; k < 8; ++k) { const float nr = pr * pr - pi * pi, ni = 2.0f * pr * pi; pr = nr; pi = ni; }
            float xr = 0.f, xi = 0.f;
            for (int sb = 0; sb < SSEG; sb += 16) { float er[16], ei[16];
#pragma unroll
                for (int k = 0; k < 16; ++k) { er[k] = E[((size_t)(sb + k) * 2048 + el) * 2]; ei[k] = E[((size_t)(sb + k) * 2048 + el) * 2 + 1]; }
#pragma unroll
                for (int k = 0; k < 16; ++k) { E[((size_t)(sb + k) * 2048 + el) * 2] = xr; E[((size_t)(sb + k) * 2048 + el) * 2 + 1] = xi;
                    const float nr = pr * xr - pi * xi + er[k], ni = pr * xi + pi * xr + ei[k]; xr = nr; xi = ni; } } }
    }
}

template <int PASS>
__device__ __forceinline__ void phase_mixers(ArgsRef a, int l, int tid, int lane, int wave, int bid, int G) {
    for (int it = bid; it < 4 * GSEG; it += G) gla_item<0, PASS>(a, l, it % 4, it / 4, tid, lane, wave);
    asm volatile("" ::: "memory");
    for (int it = bid + ((4 * GSEG - bid % G) % G + G) % G * 0; it < 2 * 4 * GSEG; it += G) { if (it >= 4 * GSEG) gla_item<1, PASS>(a, l, (it - 4 * GSEG) % 4, (it - 4 * GSEG) / 4, tid, lane, wave); }
    __syncthreads();
    for (int it0 = bid * 8; it0 < 32 * SSEG; it0 += G * 8)
        for (int half = 0; half < 2; ++half) { const int it = it0 + wave; s5_item<PASS>(a, l, it % 32, it / 32, it0 % 32, tid, lane, wave, half); __syncthreads(); }
}

__device__ __forceinline__ void phase_post(ArgsRef a, int l, int lane, int gw, int GW) {
    const bf16_t* Z = (const bf16_t*)(a.ws + OFF_Z); const bf16_t* XC = (const bf16_t*)(a.ws + OFF_XC);
    bf16_t* OM = (bf16_t*)(a.ws + OFF_OM); bf16_t* OH = (bf16_t*)(a.ws + OFF_OH); const float* DEN = (const float*)(a.ws + OFF_DEN);
    const int c0 = lane * 8, hd = lane >> 4;
    float skp[8], nw[8];
#pragma unroll
    for (int j = 0; j < 8; ++j) { skp[j] = a.in[9][l * 512 + c0 + j]; nw[j] = a.in[20][l * 512 + c0 + j]; }
    for (int tb = gw * 4; tb < T; tb += GW * 4) {
        bf16x8 om[4], op[4], xc[4], oh[4], gp[4]; float dn[4];
#pragma unroll
        for (int k = 0; k < 4; ++k) { const size_t t = tb + k; om[k] = *(const bf16x8*)(OM + t * 512 + c0); op[k] = *(const bf16x8*)(Z + t * NZ + 512 + c0); xc[k] = *(const bf16x8*)(XC + t * 512 + c0);
            oh[k] = *(const bf16x8*)(OH + t * 512 + c0); gp[k] = *(const bf16x8*)(Z + t * NZ + 3072 + c0); dn[k] = DEN[hd * T + t]; }
#pragma unroll
        for (int k = 0; k < 4; ++k) { const size_t t = tb + k; const float di = __builtin_amdgcn_rcpf(fmaxf(fabsf(dn[k]), 1.0f)); float y[8], ov[8], ss = 0.f;
#pragma unroll
            for (int j = 0; j < 8; ++j) { y[j] = sigmoidf_(bf2f((bf16_t)op[k][j])) * (bf2f((bf16_t)om[k][j]) * di) + skp[j] * bf2f((bf16_t)xc[k][j]); ov[j] = bf2f((bf16_t)oh[k][j]); ss += ov[j] * ov[j]; }
            u32x4 w; w.x = pack2(y[0], y[1]); w.y = pack2(y[2], y[3]); w.z = pack2(y[4], y[5]); w.w = pack2(y[6], y[7]); *(u32x4*)(OM + t * 512 + c0) = w;
            ss += __shfl_xor(ss, 1); ss += __shfl_xor(ss, 2); ss += __shfl_xor(ss, 4); ss += __shfl_xor(ss, 8);
            const float rinv = rsqrtf(ss * (1.0f / 128.0f) + 1e-6f);
#pragma unroll
            for (int j = 0; j < 8; ++j) y[j] = ov[j] * rinv * nw[j] * siluf_(bf2f((bf16_t)gp[k][j]));
            u32x4 x; x.x = pack2(y[0], y[1]); x.y = pack2(y[2], y[3]); x.z = pack2(y[4], y[5]); x.w = pack2(y[6], y[7]); *(u32x4*)(OH + t * 512 + c0) = x; }
    }
}

__device__ __forceinline__ void ln_row(f32x4 (&v)[4], const float* gam, const float* bet, int lane) {
    float s = 0.f;
#pragma unroll
    for (int j = 0; j < 4; ++j) s += (v[j][0] + v[j][1]) + (v[j][2] + v[j][3]);
#pragma unroll
    for (int o = 32; o >= 1; o >>= 1) s += __shfl_xor(s, o);
    const float mean = s * (1.0f / 1024.0f); float qv = 0.f;
#pragma unroll
    for (int j = 0; j < 4; ++j) { const f32x4 dd = v[j] - mean; qv += (dd[0] * dd[0] + dd[1] * dd[1]) + (dd[2] * dd[2] + dd[3] * dd[3]); }
#pragma unroll
    for (int o = 32; o >= 1; o >>= 1) qv += __shfl_xor(qv, o);
    const float rstd = rsqrtf(qv * (1.0f / 1024.0f) + 1e-5f);
#pragma unroll
    for (int j = 0; j < 4; ++j) { const f32x4 gg = *(const f32x4*)(gam + 256 * j + 4 * lane), bb = *(const f32x4*)(bet + 256 * j + 4 * lane); v[j] = (v[j] - mean) * rstd * gg + bb; }
}

__device__ __forceinline__ void phase_ln1r(ArgsRef a, int l, int tid, int lane, int wave, int bid, int G) {
    float* XF = a.out; bf16_t* XB = (bf16_t*)(a.ws + OFF_XB);
    int* TOKE = (int*)(a.ws + OFF_TOKE); float* TOKG = (float*)(a.ws + OFF_TOKG); unsigned* HIST = (unsigned*)(a.ws + OFF_HIST);
    const float* RWT = (const float*)(a.ws + OFF_RWT); const float* RB = a.in[30];
    float* LG = (float*)(smem + wave * 4096);
    int* TE = (int*)(smem + wave * 4096 + 2304); float* TG = (float*)(smem + wave * 4096 + 2432); unsigned* HS = (unsigned*)(smem + wave * 4096 + 2560);
    const int r = lane & 15, q = lane >> 4, rs = lane >> 5, e = lane & 31;
    if (G >= 256 && wave >= 4) {
        float* tw_lds = (float*)(smem + 16384 + (wave - 4) * 16640);
        for (int u = 896 + bid * 4 + (wave - 4); u < 6144; u += G * 4) wave_prepx_tile(a, l, u, lane, tw_lds);
    }
    for (int tw = bid + G * wave; tw < T / 16; tw += G * 8) {
        const int t0 = tw * 16;
        for (int rb = 0; rb < 16; rb += 4) { f32x4 v[4][4];
#pragma unroll
            for (int k = 0; k < 4; ++k)
#pragma unroll
                for (int j = 0; j < 4; ++j) v[k][j] = *(const f32x4*)(XF + (size_t)(t0 + rb + k) * 1024 + 256 * j + 4 * lane);
#pragma unroll
            for (int k = 0; k < 4; ++k) { const int t = t0 + rb + k; ln_row(v[k], a.in[25] + l * 1024, a.in[26] + l * 1024, lane);
#pragma unroll
                for (int j = 0; j < 4; ++j) { *(f32x4*)(XF + (size_t)t * 1024 + 256 * j + 4 * lane) = v[k][j];
                    u32x2 w; w.x = pack2(v[k][j][0], v[k][j][1]); w.y = pack2(v[k][j][2], v[k][j][3]); *(u32x2*)(XB + (size_t)t * 1024 + 256 * j + 4 * lane) = w; } } }
        if (lane < 32) HS[lane] = 0u;
        asm volatile("s_waitcnt vmcnt(0) lgkmcnt(0)" ::: "memory"); __builtin_amdgcn_wave_barrier();
        f32x4 acc0 = (f32x4){0.f, 0.f, 0.f, 0.f}, acc1 = acc0;
        const float* xa = XF + (size_t)(t0 + r) * 1024 + 4 * q; const float* w0 = RWT + (size_t)r * 1024 + 4 * q; const float* w1 = RWT + (size_t)(16 + r) * 1024 + 4 * q;
        f32x4 pa[2][4], pb[2][4], pc[2][4];
#define RT_LOAD(buf, g_) do { _Pragma("unroll") for (int k_ = 0; k_ < 4; ++k_) { pa[buf][k_] = *(const f32x4*)(xa + 16 * (4 * (g_) + k_)); pb[buf][k_] = *(const f32x4*)(w0 + 16 * (4 * (g_) + k_)); pc[buf][k_] = *(const f32x4*)(w1 + 16 * (4 * (g_) + k_)); } } while (0)
#define RT_MMA(buf) do { _Pragma("unroll") for (int k_ = 0; k_ < 4; ++k_) _Pragma("unroll") for (int j = 0; j < 4; ++j) { acc0 = __builtin_amdgcn_mfma_f32_16x16x4f32(pa[buf][k_][j], pb[buf][k_][j], acc0, 0, 0, 0); acc1 = __builtin_amdgcn_mfma_f32_16x16x4f32(pa[buf][k_][j], pc[buf][k_][j], acc1, 0, 0, 0); } } while (0)
        RT_LOAD(0, 0);
#pragma unroll 1
        for (int g2 = 0; g2 < 16; g2 += 2) {
            RT_LOAD(1, g2 + 1);
            RT_MMA(0);
            if (g2 + 2 < 16) RT_LOAD(0, g2 + 2);
            RT_MMA(1);
        }
#undef RT_LOAD
#undef RT_MMA
#pragma unroll
        for (int g = 0; g < 4; ++g) { LG[(4 * q + g) * 33 + r] = acc0[g]; LG[(4 * q + g) * 33 + 16 + r] = acc1[g]; }
        wave_sync();
        for (int pp = 0; pp < 8; ++pp) {
            const float lg = LG[(2 * pp + rs) * 33 + e];
            const float s = sigmoidf_(lg), sb = s + RB[e];
            float v4[4];
#pragma unroll
            for (int i = 0; i < 4; ++i) v4[i] = __shfl(sb, (lane & ~3) + i);
            int i1 = 0;
#pragma unroll
            for (int i = 1; i < 4; ++i) if (v4[i] > v4[i1]) i1 = i;
            int i2 = (i1 == 0) ? 1 : 0;
#pragma unroll
            for (int i = 0; i < 4; ++i) if (i != i1 && i != i2 && v4[i] > v4[i2]) i2 = i;
            float gs = v4[i1] + v4[i2]; int gid = e >> 2;
#pragma unroll
            for (int o = 4; o <= 16; o <<= 1) { const float os = __shfl_xor(gs, o); const int og = __shfl_xor(gid, o); if (os > gs || (os == gs && og < gid)) { gs = os; gid = og; } }
            float sv[4], sbv[4];
#pragma unroll
            for (int i = 0; i < 4; ++i) { sbv[i] = __shfl(sb, (lane & 32) + gid * 4 + i); sv[i] = __shfl(s, (lane & 32) + gid * 4 + i); }
            int j1 = 0;
#pragma unroll
            for (int i = 1; i < 4; ++i) if (sbv[i] > sbv[j1]) j1 = i;
            int j2 = (j1 == 0) ? 1 : 0;
#pragma unroll
            for (int i = 0; i < 4; ++i) if (i != j1 && i != j2 && sbv[i] > sbv[j2]) j2 = i;
            float s1 = sv[0], s2 = sv[0];
#pragma unroll
            for (int i = 1; i < 4; ++i) { if (i == j1) s1 = sv[i]; if (i == j2) s2 = sv[i]; }
            if (e == 0) { const int ti = 2 * pp + rs; const float inv = 1.0f / (s1 + s2);
                TE[ti * 2] = gid * 4 + j1; TE[ti * 2 + 1] = gid * 4 + j2; TG[ti * 2] = s1 * inv; TG[ti * 2 + 1] = s2 * inv;
                atomicAdd(&HS[gid * 4 + j1], 1u); atomicAdd(&HS[gid * 4 + j2], 1u); }
        }
        wave_sync();
        if (lane < 32) { TOKE[t0 * 2 + lane] = TE[lane]; TOKG[t0 * 2 + lane] = TG[lane]; HIST[tw * 32 + lane] = HS[lane]; }
        wave_sync();
    }
    __syncthreads();
}

__device__ __forceinline__ void phase_slot(ArgsRef a, int tid, int lane, int wave, int bid, int G) {
    const int* TOKE = (const int*)(a.ws + OFF_TOKE); int* TOKS = (int*)(a.ws + OFF_TOKS); const unsigned* HIST = (const unsigned*)(a.ws + OFF_HIST);
    unsigned* BASE = (unsigned*)(a.ws + OFF_CTL) + 64;
    const bf16_t* XB = (const bf16_t*)(a.ws + OFF_XB); bf16_t* XG = (bf16_t*)(a.ws + OFF_XG);
    unsigned* base = (unsigned*)smem; unsigned* pre = base + 40; int* el = (int*)(base + 80); int* sl = (int*)(base + 208); unsigned* red = base + 336;
    const int e = tid & 31, part = tid >> 5;
    for (int c = bid; c < T / 64; c += G) {
        unsigned tot = 0u, pr = 0u;
#pragma unroll 16
        for (int it = part; it < 1024; it += 16) { const unsigned v = HIST[it * 32 + e]; tot += v; pr += (it < 4 * c) ? v : 0u; }
        red[part * 32 + e] = tot; red[512 + part * 32 + e] = pr;
        __syncthreads();
        if (tid < 32) { unsigned t2 = 0u, p2 = 0u; for (int k = 0; k < 16; ++k) { t2 += red[k * 32 + tid]; p2 += red[512 + k * 32 + tid]; } pre[tid] = p2; red[tid] = (t2 + 255u) & ~255u; }
        __syncthreads();
        if (tid == 0) { unsigned sacc = 0; for (int k = 0; k < 32; ++k) { base[k] = sacc; sacc += red[k]; } base[32] = sacc; }
        int ee = 0;
        if (tid < 128) { ee = TOKE[c * 128 + tid]; el[tid] = ee; }
        __syncthreads();
        if (c == 0 && tid < 33) BASE[tid] = base[tid];
        if (tid < 128) { unsigned rank = 0; for (int i = 0; i < tid; ++i) rank += (el[i] == ee) ? 1u : 0u;
            const unsigned sidx = base[ee] + pre[ee] + rank; sl[tid] = (int)sidx; TOKS[c * 128 + tid] = (int)sidx; }
        __syncthreads();
        for (int ib = 0; ib < 16; ib += 8) { u32x4 ra[8], rb[8];
#pragma unroll
            for (int k = 0; k < 8; ++k) { const int i = wave + 8 * (ib + k), t = c * 64 + (i >> 1); ra[k] = *(const u32x4*)(XB + (size_t)t * 1024 + lane * 8); rb[k] = *(const u32x4*)(XB + (size_t)t * 1024 + 512 + lane * 8); }
#pragma unroll
            for (int k = 0; k < 8; ++k) { const int i = wave + 8 * (ib + k); const size_t so = (size_t)sl[i] * 1024; *(u32x4*)(XG + so + lane * 8) = ra[k]; *(u32x4*)(XG + so + 512 + lane * 8) = rb[k]; } }
        __syncthreads();
    }
}

__device__ __forceinline__ void phase_ln2(ArgsRef a, int l, int lane, int gw, int GW) {
    float* XF = a.out; bf16_t* XB = (bf16_t*)(a.ws + OFF_XB); const bf16_t* YS = (const bf16_t*)(a.ws + OFF_YS);
    const int* TOKS = (const int*)(a.ws + OFF_TOKS); const float* TOKG = (const float*)(a.ws + OFF_TOKG);
    for (int tb = gw * 4; tb < T; tb += GW * 4) {
        int sv = 0; float gv = 0.f; if (lane < 8) { sv = TOKS[tb * 2 + lane]; gv = TOKG[tb * 2 + lane]; }
        f32x4 v[4][4]; bf16x4 y0[4][4], y1[4][4]; float g0[4], g1[4];
#pragma unroll
        for (int k = 0; k < 4; ++k) { const int s0 = __shfl(sv, 2 * k), s1 = __shfl(sv, 2 * k + 1); g0[k] = __shfl(gv, 2 * k); g1[k] = __shfl(gv, 2 * k + 1);
#pragma unroll
            for (int j = 0; j < 4; ++j) { v[k][j] = *(const f32x4*)(XF + (size_t)(tb + k) * 1024 + 256 * j + 4 * lane);
                y0[k][j] = *(const bf16x4*)(YS + (size_t)s0 * 1024 + 256 * j + 4 * lane); y1[k][j] = *(const bf16x4*)(YS + (size_t)s1 * 1024 + 256 * j + 4 * lane); } }
#pragma unroll
        for (int k = 0; k < 4; ++k) {
#pragma unroll
            for (int j = 0; j < 4; ++j)
#pragma unroll
                for (int g = 0; g < 4; ++g) v[k][j][g] = DN_ALPHA * v[k][j][g] + g0[k] * bf2f((bf16_t)y0[k][j][g]) + g1[k] * bf2f((bf16_t)y1[k][j][g]);
            ln_row(v[k], a.in[27] + l * 1024, a.in[28] + l * 1024, lane);
#pragma unroll
            for (int j = 0; j < 4; ++j) { *(f32x4*)(XF + (size_t)(tb + k) * 1024 + 256 * j + 4 * lane) = v[k][j];
                u32x2 w; w.x = pack2(v[k][j][0], v[k][j][1]); w.y = pack2(v[k][j][2], v[k][j][3]); *(u32x2*)(XB + (size_t)(tb + k) * 1024 + 256 * j + 4 * lane) = w; } }
    }
}

struct SchedGrid {
    int nM, nN, G, c; const char* A; const char* B; size_t strideA, strideB;
    __device__ __forceinline__ bool next(int i, pg8::Unit& u) const { int pm, pn; if (!pg8::tile_order(i * G + c, nM, nN, pm, pn)) return false;
        u.pm = pm; u.pn = pn; u.tag = 0; u.A = A + (size_t)pm * strideA; u.B = B + (size_t)pn * strideB; return true; }
};
constexpr int GATES_LD = 3072;
template <int MODE> struct EpiBf16 {
    static constexpr bool PERM = true;
    bf16_t* O; int ldo; const bf16_t* Y; int ldy;
    __device__ __forceinline__ bool operator()(f32x4 (&acc)[2][2][4][2], const pg8::Unit& u, int wr, int wc, int fr, int fq) const {
#pragma unroll
        for (int ai = 0; ai < 2; ++ai) {
            bf16x8 yv[4][2];
            if (MODE == 2) {
#pragma unroll
                for (int m = 0; m < 4; ++m)
#pragma unroll
                    for (int bj = 0; bj < 2; ++bj) yv[m][bj] = *(const bf16x8*)(Y + ((size_t)u.pm * 256 + ai * 128 + wr * 64 + m * 16 + fr) * ldy + u.pn * 256 + bj * 128 + wc * 32 + 8 * fq);
            }
#pragma unroll
            for (int m = 0; m < 4; ++m) { const size_t row = (size_t)u.pm * 256 + ai * 128 + wr * 64 + m * 16 + fr;
#pragma unroll
                for (int bj = 0; bj < 2; ++bj) { const int col = u.pn * 256 + bj * 128 + wc * 32 + 8 * fq; f32x4 v0 = acc[ai][bj][m][0], v1 = acc[ai][bj][m][1];
                    if (MODE == 1) {
#pragma unroll
                        for (int j = 0; j < 4; ++j) { v0[j] = fmaxf(sigmoidf_(v0[j]), 1e-30f); v1[j] = fmaxf(sigmoidf_(v1[j]), 1e-30f); } }
                    if (MODE == 2) {
#pragma unroll
                        for (int j = 0; j < 4; ++j) { v0[j] = bf2f((bf16_t)yv[m][bj][j]) * sigmoidf_(v0[j]); v1[j] = bf2f((bf16_t)yv[m][bj][4 + j]) * sigmoidf_(v1[j]); } }
                    u32x4 w; w.x = pg8::cvt_pk_bf16(v0[0], v0[1]); w.y = pg8::cvt_pk_bf16(v0[2], v0[3]); w.z = pg8::cvt_pk_bf16(v1[0], v1[1]); w.w = pg8::cvt_pk_bf16(v1[2], v1[3]);
                    if (MODE == 1) *(u32x4*)(O + ((((size_t)u.pm * 12 + u.pn) * 16 + (ai * 8 + m * 2 + bj)) * 512 + ((wr * 4 + wc) * 64 + fq * 16 + fr)) * 8) = w;
                    else *(u32x4*)(O + row * ldo + col) = w; } }
        }
        return false;
    }
};
struct SchedZ {
    int G, c; const unsigned char* ws;
    __device__ __forceinline__ bool next(int i, pg8::Unit& u) const { int pm, pn; if (!pg8::tile_order(i * G + c, T / 256, 15, pm, pn)) return false;
        u.pm = pm; u.pn = pn; u.tag = 0; u.A = (const char*)(ws + OFF_XB) + (size_t)pm * 256 * 1024 * 2;
        u.B = (const char*)(ws + OFF_WIN) + (size_t)(pn < 14 ? pn * 256 : 6656) * 1024 * 2; return true; }
};
struct EpiZ {
    static constexpr bool PERM = true;
    bf16_t* Z; float* LI; float* LF; const float* bi; const float* bf;
    __device__ __forceinline__ bool operator()(f32x4 (&acc)[2][2][4][2], const pg8::Unit& u, int wr, int wc, int fr, int fq) const {
        if (u.pn < 14) {
#pragma unroll
            for (int ai = 0; ai < 2; ++ai)
#pragma unroll
                for (int m = 0; m < 4; ++m) { const size_t row = (size_t)u.pm * 256 + ai * 128 + wr * 64 + m * 16 + fr;
#pragma unroll
                    for (int bj = 0; bj < 2; ++bj) { const int col = u.pn * 256 + bj * 128 + wc * 32 + 8 * fq; const f32x4 v0 = acc[ai][bj][m][0], v1 = acc[ai][bj][m][1];
                        u32x4 w; w.x = pg8::cvt_pk_bf16(v0[0], v0[1]); w.y = pg8::cvt_pk_bf16(v0[2], v0[3]); w.z = pg8::cvt_pk_bf16(v1[0], v1[1]); w.w = pg8::cvt_pk_bf16(v1[2], v1[3]);
                        *(u32x4*)(Z + row * NZ + col) = w; } }
        } else if (wc == 0 && fq == 0) {
            const f32x4 b_i = *(const f32x4*)bi, b_f = *(const f32x4*)bf;
#pragma unroll
            for (int ai = 0; ai < 2; ++ai)
#pragma unroll
                for (int m = 0; m < 4; ++m) { const size_t row = (size_t)u.pm * 256 + ai * 128 + wr * 64 + m * 16 + fr; const f32x4 v0 = acc[ai][0][m][0] + b_i, v1 = acc[ai][0][m][1] + b_f;
                    f32x4 lf; lf[0] = logsigmoidf_(v1[0]); lf[1] = logsigmoidf_(v1[1]); lf[2] = logsigmoidf_(v1[2]); lf[3] = logsigmoidf_(v1[3]);
                    *(f32x4*)(LI + row * 4) = v0; *(f32x4*)(LF + row * 4) = lf; }
        }
        return false;
    }
};
__device__ __forceinline__ void phase_zgemm2(ArgsRef a, int l, int tid, int bid, int G) {
    SchedZ S{G, bid, a.ws}; EpiZ E{(bf16_t*)(a.ws + OFF_Z), (float*)(a.ws + OFF_LI), (float*)(a.ws + OFF_LF), a.in[7] + l * 4, a.in[8] + l * 4};
    pg8::gemm_phase((PG8_LAS unsigned char*)smem, tid, 1024, 1024, 1024, S, E);
}
__device__ __forceinline__ void phase_glu_gates(ArgsRef a, int l, int tid, int bid, int G) {
    { SchedGrid S{T / 256, 2, G, bid, (const char*)(a.ws + OFF_YPRE), (const char*)(a.ws + OFF_WGLU), (size_t)256 * 512 * 2, (size_t)256 * 512 * 2};
      EpiBf16<2> E{(bf16_t*)(a.ws + OFF_YSG), 512, (const bf16_t*)(a.ws + OFF_YPRE), 512};
      pg8::gemm_phase((PG8_LAS unsigned char*)smem, tid, 512, 512, 512, S, E); }
    asm volatile("" : "+v"(tid), "+s"(bid), "+s"(G));
    if (G > 128) { if (bid >= 128) phase_prepx(a, l, tid, bid - 128, G - 128, 0, 896); } else phase_prepx(a, l, tid, bid, G, 0, 896);
    asm volatile("" : "+v"(tid), "+s"(bid), "+s"(G));
    { SchedGrid S{T / 256, 12, G, (bid + G / 2) % G, (const char*)(a.ws + OFF_XB), (const char*)(a.ws + OFF_WIN + (size_t)NZ * 1024 * 2), (size_t)256 * 1024 * 2, (size_t)256 * 1024 * 2};
      EpiBf16<1> E{(bf16_t*)(a.ws + OFF_Z), GATES_LD, nullptr, 0};
      pg8::gemm_phase((PG8_LAS unsigned char*)smem, tid, 1024, 1024, 1024, S, E); }
}
struct SchedMerge {
    int G, c; const unsigned char* ws;
    __device__ __forceinline__ bool next(int i, pg8::Unit& u) const { const int b = i % 3; int pm, pn; if (!pg8::tile_order((i / 3) * G + c, T / 256, 4, pm, pn)) return false;
        u.pm = pm; u.pn = pn; u.tag = b; u.A = (const char*)(ws + (b == 0 ? OFF_OM : b == 1 ? OFF_YSG : OFF_OH)) + (size_t)pm * 256 * 512 * 2;
        u.B = (const char*)(ws + OFF_WB) + ((size_t)b * 1024 + pn * 256) * 512 * 2; return true; }
};
struct EpiMerge {
    static constexpr bool PERM = true;
    const bf16_t* GT; bf16_t* O;
    __device__ __forceinline__ bool operator()(f32x4 (&acc)[2][2][4][2], const pg8::Unit& u, int wr, int wc, int fr, int fq) const {
        const int b = u.tag;
        const bf16_t* gbase = GT + (((size_t)u.pm * 12 + b * 4 + u.pn) * 16 * 512 + ((wr * 4 + wc) * 64 + fq * 16 + fr)) * 8;
        bf16x8 gb[2][2][2], gn[2][2][2];
#define MG_LOAD(buf, ai_, mh_) do { _Pragma("unroll") for (int mm = 0; mm < 2; ++mm) _Pragma("unroll") for (int bj = 0; bj < 2; ++bj) { const bf16_t* gp = gbase + (size_t)((ai_) * 8 + (2 * (mh_) + mm) * 2 + bj) * 512 * 8; \
            gb[buf][mm][bj] = *(const bf16x8*)gp; gn[buf][mm][bj] = (b < 2) ? *(const bf16x8*)(gp + (size_t)4 * 16 * 512 * 8) : gb[buf][mm][bj]; } } while (0)
        MG_LOAD(0, 0, 0);
#pragma unroll
        for (int st = 0; st < 4; ++st) { const int ai = st >> 1, mh = st & 1, buf = st & 1;
            if (st + 1 < 4) { if (buf == 0) MG_LOAD(1, (st + 1) >> 1, (st + 1) & 1); else MG_LOAD(0, (st + 1) >> 1, (st + 1) & 1); }
#pragma unroll
            for (int mm = 0; mm < 2; ++mm) { const int m = 2 * mh + mm; const size_t row = (size_t)u.pm * 256 + ai * 128 + wr * 64 + m * 16 + fr;
#pragma unroll
                for (int bj = 0; bj < 2; ++bj) { const int col = u.pn * 256 + bj * 128 + wc * 32 + 8 * fq;
                    if (b < 2) {
#pragma unroll
                        for (int j = 0; j < 4; ++j) { acc[ai][bj][m][0][j] *= bf2f((bf16_t)gb[buf][mm][bj][j]) * __builtin_amdgcn_rcpf(bf2f((bf16_t)gn[buf][mm][bj][j])); acc[ai][bj][m][1][j] *= bf2f((bf16_t)gb[buf][mm][bj][4 + j]) * __builtin_amdgcn_rcpf(bf2f((bf16_t)gn[buf][mm][bj][4 + j])); } }
                    else { f32x4 v0 = acc[ai][bj][m][0], v1 = acc[ai][bj][m][1];
#pragma unroll
                        for (int j = 0; j < 4; ++j) { v0[j] *= bf2f((bf16_t)gb[buf][mm][bj][j]); v1[j] *= bf2f((bf16_t)gb[buf][mm][bj][4 + j]); }
                        u32x4 w; w.x = pg8::cvt_pk_bf16(v0[0], v0[1]); w.y = pg8::cvt_pk_bf16(v0[2], v0[3]); w.z = pg8::cvt_pk_bf16(v1[0], v1[1]); w.w = pg8::cvt_pk_bf16(v1[2], v1[3]);
                        *(u32x4*)(O + row * 1024 + col) = w; } } }
        }
#undef MG_LOAD
        return b < 2;
    }
};
__device__ __forceinline__ void phase_merge2(ArgsRef a, int tid, int bid, int G) {
    SchedMerge S{G, bid, a.ws}; EpiMerge E{(const bf16_t*)(a.ws + OFF_Z), (bf16_t*)(a.ws + OFF_XB)};
    pg8::gemm_phase((PG8_LAS unsigned char*)smem, tid, 512, 512, 512, S, E);
}
struct EpiResid {
    static constexpr bool PERM = false;
    const float* xin; float* XF;
    __device__ __forceinline__ bool operator()(f32x4 (&acc)[2][2][4][2], const pg8::Unit& u, int wr, int wc, int fr, int fq) const {
#pragma unroll
        for (int ai = 0; ai < 2; ++ai)
#pragma unroll
        for (int mh = 0; mh < 2; ++mh) {
            f32x4 xv[2][2][2];
#pragma unroll
            for (int mm = 0; mm < 2; ++mm)
#pragma unroll
                for (int bj = 0; bj < 2; ++bj)
#pragma unroll
                    for (int n = 0; n < 2; ++n) xv[mm][bj][n] = *(const f32x4*)(xin + ((size_t)u.pm * 256 + ai * 128 + wr * 64 + (2 * mh + mm) * 16 + fr) * 1024 + u.pn * 256 + bj * 128 + wc * 32 + 16 * n + 4 * fq);
#pragma unroll
            for (int mm = 0; mm < 2; ++mm)
#pragma unroll
                for (int bj = 0; bj < 2; ++bj)
#pragma unroll
                    for (int n = 0; n < 2; ++n) { const int m = 2 * mh + mm; const size_t o = ((size_t)u.pm * 256 + ai * 128 + wr * 64 + m * 16 + fr) * 1024 + u.pn * 256 + bj * 128 + wc * 32 + 16 * n + 4 * fq; *(f32x4*)(XF + o) = DN_ALPHA * xv[mm][bj][n] + acc[ai][bj][m][n]; }
        }
        return false;
    }
};
__device__ __forceinline__ void phase_wout2(ArgsRef a, int l, int tid, int bid, int G) {
    SchedGrid S{T / 256, 4, G, bid, (const char*)(a.ws + OFF_XB), (const char*)(a.ws + OFF_WOUT), (size_t)256 * 1024 * 2, (size_t)256 * 1024 * 2};
    EpiResid E{(l == 0) ? a.in[0] : a.out, a.out};
    pg8::gemm_phase((PG8_LAS unsigned char*)smem, tid, 1024, 1024, 1024, S, E);
}
struct EpiQKV {
    static constexpr bool PERM = true;
    int vcall; bf16_t* Q; bf16_t* KH; bf16_t* V; const float* LI;
    __device__ __forceinline__ bool operator()(f32x4 (&acc)[2][2][4][2], const pg8::Unit& u, int wr, int wc, int fr, int fq) const {
        const int which = vcall ? 2 : (u.pn >> 1); bf16_t* O = Q + (size_t)which * (SZ_ACT / 2);
        float liv[2][4][2];
#pragma unroll
        for (int ai = 0; ai < 2; ++ai)
#pragma unroll
            for (int m = 0; m < 4; ++m)
#pragma unroll
                for (int bj = 0; bj < 2; ++bj) liv[ai][m][bj] = (which == 1) ? LI[((size_t)u.pm * 256 + ai * 128 + wr * 64 + m * 16 + fr) * 4 + (u.pn & 1) * 2 + bj] : 0.f;
#pragma unroll
        for (int ai = 0; ai < 2; ++ai)
#pragma unroll
            for (int m = 0; m < 4; ++m) { const size_t row = (size_t)u.pm * 256 + ai * 128 + wr * 64 + m * 16 + fr;
#pragma unroll
                for (int bj = 0; bj < 2; ++bj) { const int hd = (u.pn & 1) * 2 + bj, col = hd * 128 + wc * 32 + 8 * fq;
                    const float sc = which == 0 ? 0.08838834764831845f : which == 1 ? fexp(liv[ai][m][bj]) : 1.0f;
                    const f32x4 v0 = acc[ai][bj][m][0] * sc, v1 = acc[ai][bj][m][1] * sc;
                    u32x4 w; w.x = pg8::cvt_pk_bf16(v0[0], v0[1]); w.y = pg8::cvt_pk_bf16(v0[2], v0[3]); w.z = pg8::cvt_pk_bf16(v1[0], v1[1]); w.w = pg8::cvt_pk_bf16(v1[2], v1[3]);
                    *(u32x4*)(O + row * 512 + col) = w; } }
        return false;
    }
};
__device__ __forceinline__ void phase_mprep2(ArgsRef a, int l, int tid, int bid, int G) {
    const bf16_t* Z = (const bf16_t*)(a.ws + OFF_Z); bf16_t* XC = (bf16_t*)(a.ws + OFF_XC);
    const float* cw = a.in[2] + (size_t)l * 4 * 512; const float* cb = a.in[3] + (size_t)l * 512;
    for (int idx = bid * 512 + tid; idx < (T / 8) * 64; idx += G * 512) {
        const int tb = (idx / 64) * 8, c0 = (idx % 64) * 8;
        bf16x8 xr[11];
#pragma unroll
        for (int k = 0; k < 11; ++k) { const int ts = tb - 3 + k; xr[k] = (ts >= 0) ? *(const bf16x8*)(Z + (size_t)ts * NZ + c0) : (bf16x8){0, 0, 0, 0, 0, 0, 0, 0}; }
        float w[4][8], b[8];
#pragma unroll
        for (int j = 0; j < 8; ++j) { b[j] = cb[c0 + j];
#pragma unroll
            for (int k = 0; k < 4; ++k) w[k][j] = cw[k * 512 + c0 + j]; }
#pragma unroll
        for (int tt = 0; tt < 8; ++tt) { float acc[8];
#pragma unroll
            for (int j = 0; j < 8; ++j) { acc[j] = b[j];
#pragma unroll
                for (int k = 0; k < 4; ++k) acc[j] += w[k][j] * bf2f((bf16_t)xr[tt + k][j]); }
            u32x4 o; o.x = pack2(siluf_(acc[0]), siluf_(acc[1])); o.y = pack2(siluf_(acc[2]), siluf_(acc[3])); o.z = pack2(siluf_(acc[4]), siluf_(acc[5])); o.w = pack2(siluf_(acc[6]), siluf_(acc[7]));
            *(u32x4*)(XC + (size_t)(tb + tt) * 512 + c0) = o; }
    }
}

__device__ __forceinline__ void phase_v_conv(ArgsRef a, int l, int tid, int bid, int G) {
    if (G > 128 && bid >= 128) { phase_mprep2(a, l, tid, bid - 128, G - 128); return; }
    { SchedGrid S{T / 256, 2, G, bid, (const char*)(a.ws + OFF_Z), (const char*)(a.ws + OFF_WQKV + (size_t)1024 * 512 * 2), (size_t)256 * NZ * 2, (size_t)256 * 512 * 2};
      EpiQKV E{1, (bf16_t*)(a.ws + OFF_Q), (bf16_t*)(a.ws + OFF_KH), (bf16_t*)(a.ws + OFF_V), (const float*)(a.ws + OFF_LI)};
      pg8::gemm_phase((PG8_LAS unsigned char*)smem, tid, 512, NZ, 512, S, E); }
    if (G <= 128) { asm volatile("" : "+v"(tid), "+s"(bid), "+s"(G)); phase_mprep2(a, l, tid, bid, G); }
}
__device__ __forceinline__ void phase_qk(ArgsRef a, int tid, int bid, int G) {
    SchedGrid S{T / 256, 4, G, bid, (const char*)(a.ws + OFF_XC), (const char*)(a.ws + OFF_WQKV), (size_t)256 * 512 * 2, (size_t)256 * 512 * 2};
    EpiQKV E{0, (bf16_t*)(a.ws + OFF_Q), (bf16_t*)(a.ws + OFF_KH), (bf16_t*)(a.ws + OFF_V), (const float*)(a.ws + OFF_LI)};
    pg8::gemm_phase((PG8_LAS unsigned char*)smem, tid, 512, 512, 512, S, E);
}
struct SchedMoE {
    int down, G, c; const unsigned char* ws; const unsigned* BASE;
    __device__ __forceinline__ bool next(int i, pg8::Unit& u) const { const int per = down ? 4 : 2, L = i * G + c, ntile = (int)(BASE[32] >> 8); if (L >= ntile * per) return false;
        const int tile = L / per, sub = L % per; int e = 0; while (e < 31 && BASE[e + 1] <= (unsigned)(tile * 256)) ++e;
        u.pm = tile; u.pn = sub; u.tag = e;
        if (!down) { u.A = (const char*)(ws + OFF_XG) + (size_t)tile * 256 * 1024 * 2; u.B = (const char*)(ws + OFF_WGU) + ((size_t)e * 512 + sub * 256) * 1024 * 2; }
        else { u.A = (const char*)(ws + OFF_H) + (size_t)tile * 256 * 256 * 2; u.B = (const char*)(ws + OFF_WD) + ((size_t)e * 1024 + sub * 256) * 256 * 2; }
        return true; }
};
struct EpiH {
    static constexpr bool PERM = true;
    bf16_t* H;
    __device__ __forceinline__ bool operator()(f32x4 (&acc)[2][2][4][2], const pg8::Unit& u, int wr, int wc, int fr, int fq) const {
#pragma unroll
        for (int ai = 0; ai < 2; ++ai)
#pragma unroll
            for (int m = 0; m < 4; ++m) { const size_t row = (size_t)u.pm * 256 + ai * 128 + wr * 64 + m * 16 + fr; f32x4 v0, v1;
#pragma unroll
                for (int j = 0; j < 4; ++j) { v0[j] = siluf_(acc[ai][0][m][0][j]) * acc[ai][1][m][0][j]; v1[j] = siluf_(acc[ai][0][m][1][j]) * acc[ai][1][m][1][j]; }
                u32x4 w; w.x = pg8::cvt_pk_bf16(v0[0], v0[1]); w.y = pg8::cvt_pk_bf16(v0[2], v0[3]); w.z = pg8::cvt_pk_bf16(v1[0], v1[1]); w.w = pg8::cvt_pk_bf16(v1[2], v1[3]);
                *(u32x4*)(H + row * 256 + u.pn * 128 + wc * 32 + 8 * fq) = w; }
        return false;
    }
};
__device__ __forceinline__ void phase_moe_gu2(ArgsRef a, int l, int tid, int bid, int G) {
    { SchedMoE S{0, G, bid, a.ws, (const unsigned*)(a.ws + OFF_CTL) + 64}; EpiH E{(bf16_t*)(a.ws + OFF_H)};
      pg8::gemm_phase((PG8_LAS unsigned char*)smem, tid, 1024, 1024, 1024, S, E); }
    if (l + 1 < NLAYER) {
        asm volatile("" : "+v"(tid), "+s"(bid), "+s"(G));
        const int ntile = (int)(((const unsigned*)(a.ws + OFF_CTL))[64 + 32] >> 8); int nb = ntile * 2 - G; nb = nb < 0 ? 0 : (nb > G - 1 ? G - 1 : nb);
        if (bid >= nb) phase_prep(a, l + 1, tid, bid - nb, G - nb);
    }
}
__device__ __forceinline__ void phase_moe_dn2(ArgsRef a, int tid, int bid, int G) {
    SchedMoE S{1, G, bid, a.ws, (const unsigned*)(a.ws + OFF_CTL) + 64}; EpiBf16<0> E{(bf16_t*)(a.ws + OFF_YS), 1024, nullptr, 0};
    pg8::gemm_phase((PG8_LAS unsigned char*)smem, tid, 256, 256, 256, S, E);
}
#define XB_TMO      128
#define XB_XCNT(j)  (256  + 64 * (j))
#define XB_XSUB(j)  (1280 + 64 * (j))
#define XB_XGEN(j)  (2304 + 64 * (j))
#define XB_TOP      3328
#define XB_TOPGEN   3392
#define XCD_BAR_WORDS 3456
#define XB_SPIN_CAP (1u << 22)
__device__ __forceinline__ unsigned xb_ld(unsigned* p)              { return __hip_atomic_load(p, __ATOMIC_RELAXED, __HIP_MEMORY_SCOPE_AGENT); }
__device__ __forceinline__ unsigned xb_add(unsigned* p, unsigned v) { return __hip_atomic_fetch_add(p, v, __ATOMIC_RELAXED, __HIP_MEMORY_SCOPE_AGENT); }
__device__ __forceinline__ unsigned xb_xcc_id() { return (unsigned)__builtin_amdgcn_s_getreg((3 << 11) | 20) & 0xFu; }
#define XB_SPIN(cond, bar) do { unsigned _sp = 0; while (cond) { __builtin_amdgcn_s_sleep(1); \
    if ((++_sp & 255u) == 0u) { if (xb_ld(&(bar)[XB_TMO])) break; if (_sp > XB_SPIN_CAP) { atomicAdd(&(bar)[XB_TMO], 1u); break; } } } } while (0)
__device__ __forceinline__ void xcd_barrier_complete(unsigned* bar, unsigned x, unsigned& nloc, unsigned& nx) {
    const unsigned G = gridDim.x; unsigned sum, cnt, mine, sp = 0u;
    for (;;) { sum = 0u; cnt = 0u; mine = 0u;
#pragma unroll
        for (unsigned j = 0; j < 16; ++j) { const unsigned c = xb_ld(&bar[XB_XCNT(j)]); sum += c; cnt += (c > 0u) ? 1u : 0u; mine = (j == x) ? c : mine; }
        if (sum == G) break;
        __builtin_amdgcn_s_sleep(1);
        if ((++sp & 255u) == 0u) { if (xb_ld(&bar[XB_TMO])) break; if (sp > XB_SPIN_CAP) { atomicAdd(&bar[XB_TMO], 1u); break; } } }
    nloc = mine > 0u ? mine : 1u; nx = cnt > 0u ? cnt : 1u;
}
__device__ __forceinline__ void xcd_barrier(unsigned* bar, volatile __attribute__((address_space(3))) unsigned* st) {
    asm volatile("s_waitcnt vmcnt(0)" ::: "memory");
    __syncthreads();
    if (threadIdx.x == 0) {
        __builtin_amdgcn_s_waitcnt(0);
        const unsigned x = xb_xcc_id();
        unsigned nloc = st[0], nx = st[1];
        if (nloc == 0u) { xcd_barrier_complete(bar, x, nloc, nx); st[0] = nloc; st[1] = nx; }
        const unsigned old = xb_add(&bar[XB_XSUB(x)], 1u);
        const unsigned gen = old / nloc;
        if (old + 1u == (gen + 1u) * nloc) {
            __builtin_amdgcn_fence(__ATOMIC_RELEASE, "agent");
            asm volatile("s_waitcnt vmcnt(0)" ::: "memory");
            const unsigned og = xb_add(&bar[XB_TOP], 1u);
            const unsigned tg = og / nx;
            if (og + 1u == (tg + 1u) * nx) xb_add(&bar[XB_TOPGEN], 1u);
            else XB_SPIN(xb_ld(&bar[XB_TOPGEN]) == tg, bar);
            __builtin_amdgcn_fence(__ATOMIC_ACQUIRE, "agent");
            xb_add(&bar[XB_XGEN(x)], 1u);
            asm volatile("s_waitcnt vmcnt(0)" ::: "memory");
        } else {
            XB_SPIN(xb_ld(&bar[XB_XGEN(x)]) == gen, bar);
            __builtin_amdgcn_fence(__ATOMIC_ACQUIRE, "agent");
            asm volatile("s_waitcnt vmcnt(0)" ::: "memory");
        }
    }
    __syncthreads();
}

__device__ __forceinline__ ArgsRef fresh_args() { unsigned long long p = (unsigned long long)__builtin_amdgcn_kernarg_segment_ptr(); asm volatile("" : "+s"(p)); return *(const __attribute__((address_space(4))) Args*)p; }
__global__ void __launch_bounds__(512) fwd(Args a_unused) {
    cg::grid_group grid = cg::this_grid();
    volatile __attribute__((address_space(3))) unsigned* bst = (volatile __attribute__((address_space(3))) unsigned*)((__attribute__((address_space(3))) unsigned char*)smem + 131072);
    if (threadIdx.x < 4) bst[threadIdx.x] = 0u;
    __syncthreads();
    { ArgsRef a0 = fresh_args(); if (threadIdx.x == 0) (void)xb_add(&((unsigned*)(a0.ws + OFF_BAR))[XB_XCNT(xb_xcc_id())], 1u); }
#define GSYNC() do { asm volatile("" ::: "memory"); { ArgsRef ab = fresh_args(); xcd_barrier((unsigned*)(ab.ws + OFF_BAR), bst); } asm volatile("" ::: "memory"); } while (0)
#define GSYNC_CG() do { asm volatile("" ::: "memory"); grid.sync(); asm volatile("" ::: "memory"); } while (0)
    const int wave_s = __builtin_amdgcn_readfirstlane((int)threadIdx.x >> 6);
#define PH(body) do { int wave = wave_s; asm volatile("" : "+s"(wave)); int lane; asm volatile("v_mbcnt_lo_u32_b32 %0, -1, 0\n\tv_mbcnt_hi_u32_b32 %0, -1, %0" : "=v"(lane)); \
        int bid = blockIdx.x, G = gridDim.x; asm volatile("" : "+s"(bid), "+s"(G)); \
        const int tid = wave * 64 + lane, gw = bid * 8 + wave, GW = G * 8; (void)tid; (void)gw; (void)GW; ArgsRef a = fresh_args(); body; } while (0)
#pragma unroll 1
    for (int l = 0; l < NLAYER; ++l) {
        if (l == 0) { PH(phase_prep(a, 0, tid, bid, G)); GSYNC_CG(); }
        PH(phase_zgemm2(a, l, tid, bid, G)); GSYNC();
        PH(phase_v_conv(a, l, tid, bid, G)); GSYNC();
        PH(phase_qk(a, tid, bid, G)); GSYNC();
        PH(phase_mixers<1>(a, l, tid, lane, wave, bid, G)); GSYNC();
        PH(phase_scan(a, tid, bid, G)); GSYNC();
        PH(phase_mixers<2>(a, l, tid, lane, wave, bid, G)); GSYNC();
        PH(phase_glu_gates(a, l, tid, bid, G)); GSYNC();
        PH(phase_merge2(a, tid, bid, G)); GSYNC();
        PH(phase_wout2(a, l, tid, bid, G)); GSYNC();
        PH(phase_ln1r(a, l, tid, lane, wave, bid, G)); PH(if (G < 256) phase_prepx(a, l, tid, bid, G, 896, 6144)); GSYNC();
        PH(phase_slot(a, tid, lane, wave, bid, G)); GSYNC();
        PH(phase_moe_gu2(a, l, tid, bid, G)); GSYNC();
        PH(phase_moe_dn2(a, tid, bid, G)); GSYNC();
        PH(phase_ln2(a, l, lane, gw, GW)); if (l + 1 < NLAYER) GSYNC();
    }
}

extern "C" void kernel_launch(void* const* d_in, const int* in_sizes, int n_in, void* d_out, int out_size, void* d_ws, size_t ws_size, hipStream_t stream) {
    static int grid = 0;
    if (grid == 0) {
        if (n_in != 34 || out_size != T * D || ws_size < WS_TOTAL) { fprintf(stderr, "kernel_launch: unexpected shapes (n_in %d, out %d, ws %zu, need %zu)\n", n_in, out_size, ws_size, (size_t)WS_TOTAL); grid = -1; return; }
        int dev = 0, cus = 0, per_cu = 0;
        (void)hipGetDevice(&dev); (void)hipDeviceGetAttribute(&cus, hipDeviceAttributeMultiprocessorCount, dev);
        (void)hipFuncSetAttribute((const void*)fwd, hipFuncAttributeMaxDynamicSharedMemorySize, LDS_BYTES);
        (void)hipOccupancyMaxActiveBlocksPerMultiprocessor(&per_cu, (const void*)fwd, 512, LDS_BYTES);
        if (per_cu < 1) { fprintf(stderr, "kernel_launch: occupancy query says %d blocks per CU\n", per_cu); per_cu = 1; }
        grid = (cus > 0 ? cus : 256) * 1;
        (void)hipGetLastError();
    }
    if (grid < 0) return;
    Args a{};
    for (int i = 0; i < 34; ++i) a.in[i] = (const float*)d_in[i];
    a.out = (float*)d_out; a.ws = (unsigned char*)d_ws; a.ph_lo = 0; a.ph_hi = NLAYER * NPH;
    (void)hipMemsetAsync((unsigned char*)d_ws + OFF_BAR, 0, 16384, stream);
    void* args[] = {&a};
    hipError_t e = hipLaunchCooperativeKernel((const void*)fwd, dim3(grid), dim3(512), args, LDS_BYTES, stream);
    if (e != hipSuccess) fprintf(stderr, "kernel_launch: cooperative launch failed: %s (grid %d)\n", hipGetErrorString(e), grid);
}
```

```cpp
#include <hip/hip_runtime.h>
#include <hip/hip_cooperative_groups.h>
#include <cstdio>
#include <cstdint>
namespace cg = cooperative_groups;

typedef unsigned short bf16_t;
typedef short bf16x8 __attribute__((ext_vector_type(8)));
typedef short bf16x4 __attribute__((ext_vector_type(4)));
typedef float f32x4 __attribute__((ext_vector_type(4)));
typedef unsigned u32x4 __attribute__((ext_vector_type(4)));
typedef unsigned u32x2 __attribute__((ext_vector_type(2)));

constexpr int T = 16384, D = 1024, NZ = 3584, NWIN = 6912, INW = 6664;
constexpr int NPH = 15, NLAYER = 2;
constexpr int GSEG = 32, GSEGLEN = 512;
constexpr int SSEG = 64, SSEGLEN = 256;
constexpr int SLOTS = 40960;
constexpr float DN_ALPHA = 1.41421356237f;
constexpr int LDS_BYTES = 131072 + 256;

constexpr size_t AL(size_t x) { return (x + 255) & ~(size_t)255; }
constexpr size_t OFF_WIN = 0;
constexpr size_t OFF_WQKV = OFF_WIN + AL((size_t)NWIN * 1024 * 2);
constexpr size_t OFF_WGLU = OFF_WQKV + AL((size_t)1536 * 512 * 2);
constexpr size_t OFF_WB = OFF_WGLU + AL((size_t)512 * 512 * 2);
constexpr size_t OFF_WOUT = OFF_WB + AL((size_t)3 * 1024 * 512 * 2);
constexpr size_t OFF_ABAR = OFF_WOUT + AL((size_t)1024 * 1024 * 2);
constexpr size_t OFF_BBT = OFF_ABAR + AL((size_t)32 * 64 * 2 * 4);
constexpr size_t OFF_CCT = OFF_BBT + AL((size_t)32 * 128 * 16 * 2);
constexpr size_t OFF_CTL = OFF_CCT + AL((size_t)32 * 16 * 128 * 2);
constexpr size_t OFF_TOKE = OFF_CTL + 4096;
constexpr size_t OFF_TOKG = OFF_TOKE + AL((size_t)T * 2 * 4);
constexpr size_t OFF_TOKS = OFF_TOKG + AL((size_t)T * 2 * 4);
constexpr size_t OFF_SLOTT = OFF_TOKS + AL((size_t)T * 2 * 4);
constexpr size_t OFF_XB = OFF_SLOTT + AL((size_t)SLOTS * 4);
constexpr size_t OFF_R1 = OFF_XB + AL((size_t)T * 1024 * 2);
constexpr size_t SZ_ACT = (size_t)T * 512 * 2;
constexpr size_t OFF_XC = OFF_R1, OFF_Q = OFF_R1 + SZ_ACT, OFF_KH = OFF_R1 + 2 * SZ_ACT, OFF_V = OFF_R1 + 3 * SZ_ACT;
constexpr size_t OFF_WGU = OFF_R1, OFF_WD = OFF_R1 + (size_t)32 * 512 * 1024 * 2;
constexpr size_t OFF_Z = OFF_R1 + 4 * SZ_ACT;
constexpr size_t OFF_XG = OFF_Z, OFF_H = OFF_Z + (size_t)SLOTS * 1024 * 2;
constexpr size_t OFF_ZS = OFF_Z + AL((size_t)T * NZ * 2);
constexpr size_t OFF_LF = OFF_ZS + AL((size_t)T * 8 * 4);
constexpr size_t OFF_LI = OFF_LF + AL((size_t)T * 4 * 4);
constexpr size_t OFF_E = OFF_LI + AL((size_t)T * 4 * 4);
constexpr size_t OFF_OM = OFF_E, OFF_OH = OFF_E + SZ_ACT, OFF_YPRE = OFF_E + 2 * SZ_ACT, OFF_YSG = OFF_E + 3 * SZ_ACT;
constexpr size_t OFF_DEN = OFF_E + 4 * SZ_ACT;
constexpr size_t OFF_EM = OFF_DEN + AL((size_t)T * 4 * 4);
constexpr size_t OFF_EMX = OFF_EM + AL((size_t)GSEG * 4 * 128 * 128 * 4);
constexpr size_t OFF_GM = OFF_EMX + AL((size_t)GSEG * 4 * 128 * 16 * 4);
constexpr size_t OFF_EH = OFF_GM + AL((size_t)GSEG * 4 * 128 * 4);
constexpr size_t OFF_GH = OFF_EH + AL((size_t)GSEG * 4 * 128 * 128 * 4);
constexpr size_t OFF_ES = OFF_GH + AL((size_t)GSEG * 4 * 128 * 4);
constexpr size_t WS_END = OFF_ES + AL((size_t)SSEG * 32 * 64 * 2 * 4);
constexpr size_t OFF_YS = OFF_E;
constexpr size_t OFF_RWT = WS_END;
constexpr size_t OFF_HIST = OFF_RWT + 32 * 1024 * 4;
constexpr size_t OFF_BAR = OFF_HIST + 1024 * 32 * 4;
constexpr size_t WS_TOTAL = OFF_BAR + 16384;
static_assert(OFF_YS + (size_t)SLOTS * 1024 * 2 <= WS_END, "YS must fit in the dead region");
static_assert(OFF_H + (size_t)SLOTS * 256 * 2 <= OFF_ZS, "H must fit in the dead Z region");
static_assert(OFF_WD + (size_t)32 * 1024 * 256 * 2 <= OFF_Z, "expert weights must fit in R1");

struct Args { const float* in[34]; float* out; unsigned char* ws; int ph_lo, ph_hi; };
typedef const __attribute__((address_space(4))) Args& ArgsRef;

extern __shared__ __attribute__((aligned(16))) unsigned char smem[];

__device__ __forceinline__ bf16_t f2bf(float f) { return __builtin_bit_cast(unsigned short, (__bf16)f); }
__device__ __forceinline__ float bf2f(bf16_t b) { return __uint_as_float(((unsigned)b) << 16); }
__device__ __forceinline__ unsigned pack2(float lo, float hi) { typedef __bf16 bf2_t __attribute__((ext_vector_type(2))); bf2_t v; v[0] = (__bf16)lo; v[1] = (__bf16)hi; return __builtin_bit_cast(unsigned, v); }
__device__ __forceinline__ float fexp(float x) { return __builtin_amdgcn_exp2f(x * 1.4426950408889634f); }
__device__ __forceinline__ float flog(float x) { return __builtin_amdgcn_logf(x) * 0.6931471805599453f; }
__device__ __forceinline__ float sigmoidf_(float x) { return __builtin_amdgcn_rcpf(1.0f + fexp(-x)); }
__device__ __forceinline__ float siluf_(float x) { return x * __builtin_amdgcn_rcpf(1.0f + fexp(-x)); }
__device__ __forceinline__ float logsigmoidf_(float x) { return fminf(x, 0.f) - log1pf(expf(-fabsf(x))); }
__device__ __forceinline__ float gelu_tanh(float y) { const float z = 0.7978845608028654f * (y + 0.044715f * y * y * y); const float th = 1.0f - 2.0f * __builtin_amdgcn_rcpf(fexp(2.0f * z) + 1.0f); return 0.5f * y * (1.0f + th); }
__device__ __forceinline__ void wave_sync() { __builtin_amdgcn_wave_barrier(); asm volatile("s_waitcnt lgkmcnt(0)" ::: "memory"); __builtin_amdgcn_wave_barrier(); }

#define MFMA16(a, b, c) __builtin_amdgcn_mfma_f32_16x16x32_bf16((a), (b), (c), 0, 0, 0)

namespace pg8 {
#define PG8_LAS __attribute__((address_space(3)))
constexpr int BM = 256, BK = 64, HALF = 128, HTB = HALF * BK * 2, STAGE_BYTES = 8 * HTB;
__device__ __forceinline__ int lds_byte(int r, int c) { const int st = (r >> 4) * 2 + (c >> 5), rr = r & 15, cc = c & 31, ob = rr * 64 + cc * 2; return st * 1024 + (ob ^ (((ob >> 9) & 1) << 5)); }
__device__ __forceinline__ void stage_rc(int b, int& R, int& C) { const int st = b / 1024, sb = b % 1024, swz = sb ^ (((sb >> 9) & 1) << 5); R = (st >> 1) * 16 + swz / 64; C = (st & 1) * 32 + (swz % 64) / 2; }
__device__ __forceinline__ int perm32(int rho) { const int n = rho >> 4, i = rho & 15; return 8 * (i >> 2) + 4 * n + (i & 3); }
struct Unit { int pm, pn, tag; const char* A; const char* B; };
__device__ __forceinline__ unsigned cvt_pk_bf16(float lo, float hi) { unsigned r; asm volatile("v_cvt_pk_bf16_f32 %0, %1, %2" : "=v"(r) : "v"(lo), "v"(hi)); return r; }
__device__ __forceinline__ bool tile_order(int L, int nM, int nN, int& pm, int& pn) {
    const int nwg = nM * nN; if (L >= nwg) return false;
    int wgid = L; { const int q = nwg / 8, r = nwg % 8, xcd = wgid % 8, off = wgid / 8; wgid = (xcd < r ? xcd * (q + 1) : r * (q + 1) + (xcd - r) * q) + off; }
    const int nig = 8 * nN, gid = wgid / nig, fm = gid * 8, gsz = (nM - fm) < 8 ? (nM - fm) : 8;
    pm = fm + ((wgid % nig) % gsz); pn = (wgid % nig) / gsz; return true;
}
template <class Epi, class Sched>
__device__ __forceinline__ void gemm_phase(PG8_LAS unsigned char* lds, const int tid, const int K, const int lda, const int ldb, const Sched& S, const Epi& E) {
    const int wid = __builtin_amdgcn_readfirstlane(tid >> 6), lane = tid & 63, wr = wid >> 2, wc = wid & 3, fr = lane & 15, fq = lane >> 4;
    const int nt = K / BK;
    unsigned voffA[2], voffB[2];
#pragma unroll
    for (int i = 0; i < 2; ++i) { int R, C; stage_rc(tid * 16 + i * 8192, R, C); const int Rb = Epi::PERM ? ((R & ~31) + perm32(R & 31)) : R;
        voffA[i] = (unsigned)(R * lda + C) * 2u; voffB[i] = (unsigned)(Rb * ldb + C) * 2u; }
    const size_t kstep = (size_t)(BK * 2), hstepA = (size_t)HALF * lda * 2, hstepB = (size_t)HALF * ldb * 2;
    const unsigned ldsw = (unsigned)wid * 1024u;
    const int aoff = lds_byte(wr * 64 + fr, fq * 8), boff = lds_byte(wc * 32 + fr, fq * 8);
#define PG8_SA(b, h) (((b) * 2 + (h)) * HTB)
#define PG8_SB(b, h) ((4 + (b) * 2 + (h)) * HTB)
#define PG8_STAGE(bufoff, gbase, voff) do { _Pragma("unroll") for (int _i = 0; _i < 2; ++_i) \
        __builtin_amdgcn_global_load_lds((const unsigned*)((const char*)(gbase) + (voff)[_i]), (PG8_LAS unsigned*)(lds + (bufoff) + ldsw + _i * 8192), 16, 0, 0); } while (0)
#define PG8_LDA(dst, b, h) do { _Pragma("unroll") for (int m = 0; m < 4; ++m) _Pragma("unroll") for (int k = 0; k < 2; ++k) dst[m][k] = *(const PG8_LAS bf16x8*)(lds + PG8_SA(b, h) + aoff + m * 2048 + k * 1024); } while (0)
#define PG8_LDB(dst, b, h) do { _Pragma("unroll") for (int n = 0; n < 2; ++n) _Pragma("unroll") for (int k = 0; k < 2; ++k) dst[n][k] = *(const PG8_LAS bf16x8*)(lds + PG8_SB(b, h) + boff + n * 2048 + k * 1024); } while (0)
#define PG8_MMA(ai, bj, At, Bt) do { __builtin_amdgcn_s_setprio(1); _Pragma("unroll") for (int m = 0; m < 4; ++m) _Pragma("unroll") for (int n = 0; n < 2; ++n) _Pragma("unroll") for (int k = 0; k < 2; ++k) \
        acc[ai][bj][m][n] = __builtin_amdgcn_mfma_f32_16x16x32_bf16(Bt[n][k], At[m][k], acc[ai][bj][m][n], 0, 0, 0); __builtin_amdgcn_s_setprio(0); } while (0)
#define PG8_WAIT_V(n) asm volatile("s_waitcnt vmcnt(" #n ")" ::: "memory")
#define PG8_WAIT_L(n) asm volatile("s_waitcnt lgkmcnt(" #n ")" ::: "memory")
#define PG8_BAR __builtin_amdgcn_s_barrier()
#define PG8_SCHED __builtin_amdgcn_sched_barrier(0)
    Unit cur, nxt; int ui = 0;
    if (!S.next(0, cur)) return;
    f32x4 acc[2][2][4][2];
#pragma unroll
    for (int a = 0; a < 2; ++a)
#pragma unroll
        for (int b = 0; b < 2; ++b)
#pragma unroll
            for (int m = 0; m < 4; ++m)
#pragma unroll
                for (int n = 0; n < 2; ++n) acc[a][b][m][n] = (f32x4){0.f, 0.f, 0.f, 0.f};
    bf16x8 At[4][2], B0[2][2], B1[2][2];
    const char* cA = cur.A; const char* cB = cur.B;
    PG8_STAGE(PG8_SB(0, 0), cB, voffB); PG8_STAGE(PG8_SA(0, 0), cA, voffA); PG8_STAGE(PG8_SB(0, 1), cB + hstepB, voffB); PG8_STAGE(PG8_SA(0, 1), cA + hstepA, voffA);
    if (wr == 1) PG8_BAR;
    PG8_WAIT_V(4); PG8_BAR;
    PG8_STAGE(PG8_SB(1, 0), cB + kstep, voffB); PG8_STAGE(PG8_SA(1, 0), cA + kstep, voffA); PG8_STAGE(PG8_SB(1, 1), cB + hstepB + kstep, voffB);
    PG8_WAIT_V(6); PG8_BAR;
    for (;;) {
        const bool has_next = S.next(ui + 1, nxt);
        const char* nA = has_next ? nxt.A : cA; const char* nB = has_next ? nxt.B : cB;
        for (int t = 0; t < nt; t += 2) {
            const bool last = (t == nt - 2);
            const char* a1 = cA + (size_t)(t + 1) * kstep;
            const char* a2 = last ? nA : cA + (size_t)(t + 2) * kstep; const char* b2 = last ? nB : cB + (size_t)(t + 2) * kstep;
            const char* a3 = a2 + kstep; const char* b3 = b2 + kstep;
            PG8_LDB(B0, 0, 0); PG8_SCHED; PG8_LDA(At, 0, 0); PG8_STAGE(PG8_SA(1, 1), a1 + hstepA, voffA);
            PG8_WAIT_L(8); PG8_BAR; PG8_WAIT_L(0); PG8_MMA(0, 0, At, B0); PG8_BAR; PG8_SCHED;
            PG8_LDB(B1, 0, 1); PG8_STAGE(PG8_SB(0, 0), b2, voffB);
            PG8_BAR; PG8_WAIT_L(0); PG8_MMA(0, 1, At, B1); PG8_BAR;
            PG8_LDA(At, 0, 1); PG8_STAGE(PG8_SA(0, 0), a2, voffA);
            PG8_BAR; PG8_WAIT_L(0); PG8_MMA(1, 0, At, B0); PG8_BAR; PG8_SCHED;
            PG8_STAGE(PG8_SB(0, 1), b2 + hstepB, voffB);
            PG8_WAIT_V(6); PG8_BAR; PG8_MMA(1, 1, At, B1); PG8_BAR;
            PG8_LDB(B0, 1, 0); PG8_SCHED; PG8_LDA(At, 1, 0); PG8_STAGE(PG8_SA(0, 1), a2 + hstepA, voffA);
            PG8_WAIT_L(8); PG8_BAR; PG8_WAIT_L(0); PG8_MMA(0, 0, At, B0); PG8_BAR; PG8_SCHED;
            PG8_LDB(B1, 1, 1); PG8_STAGE(PG8_SB(1, 0), b3, voffB);
            PG8_BAR; PG8_WAIT_L(0); PG8_MMA(0, 1, At, B1); PG8_BAR;
            PG8_LDA(At, 1, 1); PG8_STAGE(PG8_SA(1, 0), a3, voffA);
            PG8_BAR; PG8_WAIT_L(0); PG8_MMA(1, 0, At, B0); PG8_BAR; PG8_SCHED;
            PG8_STAGE(PG8_SB(1, 1), b3 + hstepB, voffB);
            PG8_WAIT_V(6); PG8_BAR; PG8_MMA(1, 1, At, B1); PG8_BAR;
        }
        const bool keep = E(acc, cur, wr, wc, fr, fq);
        if (!has_next) break;
        if (!keep) {
#pragma unroll
            for (int a = 0; a < 2; ++a)
#pragma unroll
                for (int b = 0; b < 2; ++b)
#pragma unroll
                    for (int m = 0; m < 4; ++m)
#pragma unroll
                        for (int n = 0; n < 2; ++n) acc[a][b][m][n] = (f32x4){0.f, 0.f, 0.f, 0.f};
        }
        cur = nxt; cA = nA; cB = nB; ++ui;
    }
    PG8_WAIT_V(0);
    if (wr == 0) PG8_BAR;
    PG8_BAR;
#undef PG8_SA
#undef PG8_SB
#undef PG8_STAGE
#undef PG8_LDA
#undef PG8_LDB
#undef PG8_MMA
#undef PG8_WAIT_V
#undef PG8_WAIT_L
#undef PG8_BAR
#undef PG8_SCHED
}
}

__device__ __forceinline__ void tconv_tile(const float* src, int ld_src, int nvalid, bf16_t* dst, int ld_dst, int tid) {
    float* t = (float*)smem;
    { const int r = tid >> 3, c0 = (tid & 7) * 8; float v[8];
      if (nvalid == 64) { const f32x4 a0 = *(const f32x4*)(src + (size_t)r * ld_src + c0), a1 = *(const f32x4*)(src + (size_t)r * ld_src + c0 + 4);
          v[0] = a0[0]; v[1] = a0[1]; v[2] = a0[2]; v[3] = a0[3]; v[4] = a1[0]; v[5] = a1[1]; v[6] = a1[2]; v[7] = a1[3]; }
      else {
#pragma unroll
          for (int j = 0; j < 8; ++j) { const int c = c0 + j; v[j] = (c < nvalid) ? src[(size_t)r * ld_src + c] : 0.f; } }
#pragma unroll
      for (int j = 0; j < 8; ++j) t[(c0 + j) * 65 + r] = v[j]; }
    __syncthreads();
    { const int n = tid >> 3, k0 = (tid & 7) * 8; const float* p = t + n * 65 + k0;
      u32x4 w; w.x = pack2(p[0], p[1]); w.y = pack2(p[2], p[3]); w.z = pack2(p[4], p[5]); w.w = pack2(p[6], p[7]);
      *(u32x4*)(dst + (size_t)n * ld_dst + k0) = w; }
    __syncthreads();
}

__device__ __forceinline__ void wave_tconv(const float* src, int ld_src, bf16_t* dst, int ld_dst, int lane, float* t  ) {
    f32x4 v[16]; const int rq = lane >> 4, c4 = (lane & 15) * 4;
#pragma unroll
    for (int i = 0; i < 16; ++i) v[i] = *(const f32x4*)(src + (size_t)(4 * i + rq) * ld_src + c4);
#pragma unroll
    for (int i = 0; i < 16; ++i)
#pragma unroll
        for (int j = 0; j < 4; ++j) t[(c4 + j) * 65 + 4 * i + rq] = v[i][j];
    wave_sync();
    const int rr = lane >> 3, k8 = (lane & 7) * 8;
#pragma unroll
    for (int i = 0; i < 8; ++i) { const float* p = t + (8 * i + rr) * 65 + k8;
        u32x4 w; w.x = pack2(p[0], p[1]); w.y = pack2(p[2], p[3]); w.z = pack2(p[4], p[5]); w.w = pack2(p[6], p[7]);
        *(u32x4*)(dst + (size_t)(8 * i + rr) * ld_dst + k8) = w; }
    wave_sync();
}
__device__ __forceinline__ void wave_prepx_tile(ArgsRef a, int l, int u, int lane, float* t) {
    bf16_t* WGU = (bf16_t*)(a.ws + OFF_WGU); bf16_t* WD = (bf16_t*)(a.ws + OFF_WD);
    if (u < 4096) { const int up = u >= 2048, v = u & 2047, e = v / 64, w = v % 64, nt = w / 16, kt = w % 16, j0 = nt * 64, drow = (j0 / 128) * 256 + (j0 % 128) + up * 128;
        wave_tconv(a.in[31 + up] + ((size_t)(l * 32 + e) * 1024 + kt * 64) * 256 + nt * 64, 256, WGU + ((size_t)e * 512 + drow) * 1024 + kt * 64, 1024, lane, t); }
    else { const int v = u - 4096, e = v / 64, w = v % 64, nt = w / 4, kt = w % 4;
        wave_tconv(a.in[33] + ((size_t)(l * 32 + e) * 256 + kt * 64) * 1024 + nt * 64, 1024, WD + ((size_t)e * 1024 + nt * 64) * 256 + kt * 64, 256, lane, t); }
}
__device__ __forceinline__ void phase_prep(ArgsRef a, int l, int tid, int bid, int G) {
    unsigned char* ws = a.ws;
    bf16_t* WIN = (bf16_t*)(ws + OFF_WIN); bf16_t* WQKV = (bf16_t*)(ws + OFF_WQKV); bf16_t* WGLU = (bf16_t*)(ws + OFF_WGLU);
    bf16_t* WB = (bf16_t*)(ws + OFF_WB); bf16_t* WOUT = (bf16_t*)(ws + OFF_WOUT);
    for (int u = bid; u < 2624; u += G) {
        const float* src; int lds_ = 0, nvalid = 64, ldd = 0; bf16_t* dst;
        if (u < 1728) { const int nt = u / 16, kt = u % 16, p0 = nt * 64; int sc;
            if (p0 < 1024) sc = p0; else if (p0 < 6656) sc = p0 + 8; else if (p0 == 6656) { sc = 1024; nvalid = 8; } else { sc = 0; nvalid = 0; }
            src = a.in[1] + (size_t)l * 1024 * INW + (size_t)(kt * 64) * INW + sc; lds_ = INW; dst = WIN + (size_t)p0 * 1024 + kt * 64; ldd = 1024; }
        else if (u < 1920) { const int v = u - 1728, nt = v / 8, kt = v % 8, which = nt / 8, h = (nt % 8) / 2;
            if ((kt >> 1) != h) nvalid = 0;
            src = a.in[4 + which] + (size_t)(l * 4 + h) * 128 * 128 + ((kt & 1) * 64) * 128 + (nt & 1) * 64; lds_ = 128; dst = WQKV + (size_t)(nt * 64) * 512 + kt * 64; ldd = 512; }
        else if (u < 1984) { const int v = u - 1920, nt = v / 8, kt = v % 8;
            src = a.in[18] + (size_t)l * 512 * 512 + (kt * 64) * 512 + nt * 64; lds_ = 512; dst = WGLU + (size_t)(nt * 64) * 512 + kt * 64; ldd = 512; }
        else if (u < 2368) { const int v = u - 1984, b = v / 128, w = v % 128, nt = w / 8, kt = w % 8;
            src = a.in[21 + b] + (size_t)l * 512 * 1024 + (size_t)(kt * 64) * 1024 + nt * 64; lds_ = 1024; dst = WB + (size_t)b * 1024 * 512 + (size_t)(nt * 64) * 512 + kt * 64; ldd = 512; }
        else { const int v = u - 2368, nt = v / 16, kt = v % 16;
            src = a.in[24] + (size_t)l * 1024 * 1024 + (size_t)(kt * 64) * 1024 + nt * 64; lds_ = 1024; dst = WOUT + (size_t)(nt * 64) * 1024 + kt * 64; ldd = 1024; }
        tconv_tile(src, lds_, nvalid, dst, ldd, tid);
    }
    float* ABAR = (float*)(ws + OFF_ABAR); bf16_t* BBT = (bf16_t*)(ws + OFF_BBT); bf16_t* CCT = (bf16_t*)(ws + OFF_CCT);
    for (int i = bid * 512 + tid; i < 2048; i += G * 512) {
        const int g = i / 64, p = i % 64; const size_t gp = (size_t)(l * 32 + g) * 64 + p;
        const float lr = fminf(a.in[10][gp], -1e-4f), li = a.in[11][gp], dt = expf(a.in[12][l * 32 + g]);
        const float mag = expf(lr * dt), abr = mag * cosf(li * dt), abi = mag * sinf(li * dt);
        const float nr = abr - 1.0f, den = lr * lr + li * li, cr = (nr * lr + abi * li) / den, ci = (abi * lr - nr * li) / den;
        ABAR[(g * 64 + p) * 2] = abr; ABAR[(g * 64 + p) * 2 + 1] = abi;
        for (int c = 0; c < 16; ++c) { const float br = a.in[13][gp * 16 + c], bi = a.in[14][gp * 16 + c];
            BBT[(size_t)(g * 128 + p) * 16 + c] = f2bf(cr * br - ci * bi); BBT[(size_t)(g * 128 + 64 + p) * 16 + c] = f2bf(cr * bi + ci * br);
            const size_t ci_ = ((size_t)(l * 32 + g) * 16 + c) * 64 + p;
            CCT[(size_t)(g * 16 + c) * 128 + p] = f2bf(a.in[15][ci_]); CCT[(size_t)(g * 16 + c) * 128 + 64 + p] = f2bf(-a.in[16][ci_]); }
    }
    if (l == 0) { float* RWT = (float*)(ws + OFF_RWT); const float* RW = a.in[29]; for (int i = bid * 512 + tid; i < 32 * 1024; i += G * 512) RWT[i] = RW[(i & 1023) * 32 + (i >> 10)]; }
    if (l == 0) { bf16_t* XB = (bf16_t*)(ws + OFF_XB); const float* x = a.in[0];
        for (size_t i = (size_t)bid * 512 + tid; i < (size_t)T * 1024 / 8; i += (size_t)G * 512) {
            const f32x4 v0 = *(const f32x4*)(x + i * 8), v1 = *(const f32x4*)(x + i * 8 + 4);
            u32x4 w; w.x = pack2(v0[0], v0[1]); w.y = pack2(v0[2], v0[3]); w.z = pack2(v1[0], v1[1]); w.w = pack2(v1[2], v1[3]); *(u32x4*)(XB + i * 8) = w; } }
}

__device__ __forceinline__ void phase_prepx(ArgsRef a, int l, int tid, int bid, int G, int u_lo, int u_hi) {
    bf16_t* WGU = (bf16_t*)(a.ws + OFF_WGU); bf16_t* WD = (bf16_t*)(a.ws + OFF_WD);
    for (int u = u_lo + bid; u < u_hi; u += G) {
        const float* src; int lds_, ldd; bf16_t* dst;
        if (u < 4096) { const int up = u >= 2048, v = u & 2047, e = v / 64, w = v % 64, nt = w / 16, kt = w % 16, j0 = nt * 64, drow = (j0 / 128) * 256 + (j0 % 128) + up * 128;
            src = a.in[31 + up] + ((size_t)(l * 32 + e) * 1024 + kt * 64) * 256 + nt * 64; lds_ = 256; dst = WGU + ((size_t)e * 512 + drow) * 1024 + kt * 64; ldd = 1024; }
        else { const int v = u - 4096, e = v / 64, w = v % 64, nt = w / 4, kt = w % 4;
            src = a.in[33] + ((size_t)(l * 32 + e) * 256 + kt * 64) * 1024 + nt * 64; lds_ = 1024; dst = WD + ((size_t)e * 1024 + nt * 64) * 256 + kt * 64; ldd = 256; }
        tconv_tile(src, lds_, 64, dst, ldd, tid);
    }
}

constexpr int GL_RQ = 0, GL_RK = 17408, GL_VT = 34816, GL_RO = 57856, GL_RX = 75264, GL_KT = 92672, GL_PS = 102912, GL_SC1 = 105472, GL_SC2 = 105984, GL_GT = 106496, GL_OS = 108544, GL_LFS = 117248, GL_DNS = 117504;
template <int MODE, int PASS>
__device__ __forceinline__ void gla_item(ArgsRef a, int l, int h, int sg, int tid, int lane, int wave) {
    unsigned char* ws = a.ws;
    const bf16_t* Z = (const bf16_t*)(ws + OFF_Z); const bf16_t* Qg = (const bf16_t*)(ws + OFF_Q); const bf16_t* Kg = (const bf16_t*)(ws + OFF_KH); const bf16_t* Vg = (const bf16_t*)(ws + OFF_V); const bf16_t* XCg = (const bf16_t*)(ws + OFF_XC);
    const float* LF = (const float*)(ws + OFF_LF);
    float* Eg = (float*)(ws + (MODE == 0 ? OFF_EM : OFF_EH)); float* Gg = (float*)(ws + (MODE == 0 ? OFF_GM : OFF_GH)); float* EX = (float*)(ws + OFF_EMX);
    bf16_t* Yg = (bf16_t*)(ws + (MODE == 0 ? OFF_OM : OFF_OH));
    bf16_t* KT = (bf16_t*)(smem + GL_KT); bf16_t* PS = (bf16_t*)(smem + GL_PS);
    float* SC1 = (float*)(smem + GL_SC1); float* SC2 = (float*)(smem + GL_SC2); float* GT = (float*)(smem + GL_GT); bf16_t* OS = (bf16_t*)(smem + GL_OS); float* DNS = (float*)(smem + GL_DNS);
    const int r = lane & 15, q = lane >> 4, grp = tid >> 7, d = tid & 127, tok = tid >> 4, c8 = (tid & 15) * 8;
    const bool xw = (MODE == 0) && (wave == 0);
    float lb = 0.f;
    if (MODE == 1 && l == 1) { const float h0 = a.in[19][h * 128 + d], h1 = a.in[19][512 + h * 128 + d]; lb = 1.0f / (1.0f + expf(h0 - h1)); }
    f32x4 S[8], SX[8];
#pragma unroll
    for (int i = 0; i < 8; ++i) { S[i] = (f32x4){0.f, 0.f, 0.f, 0.f}; SX[i] = (f32x4){0.f, 0.f, 0.f, 0.f}; }
    if (PASS == 2) {
#pragma unroll
        for (int i = 0; i < 8; ++i)
#pragma unroll
            for (int g = 0; g < 4; ++g) { const size_t row = (size_t)(sg * 4 + h) * 128 + 16 * i + 4 * q + g; S[i][g] = Eg[row * 128 + 16 * wave + r]; if (xw) SX[i][g] = EX[row * 16 + r]; }
    }
    const bf16x8 z8 = (bf16x8){0, 0, 0, 0, 0, 0, 0, 0};
    bf16x8 rq = z8, rk = z8, rv = z8, ro = z8, rx = z8; float lfv = 0.f;
#define GLA_FETCH(t0_) do { const size_t tk = (size_t)((t0_) + tok); \
        if (MODE == 1) { const bf16_t* zp = Z + tk * NZ + h * 128 + c8; if (PASS == 2) { rq = *(const bf16x8*)(zp + 1536); ro = *(const bf16x8*)(zp + 3072); } rk = *(const bf16x8*)(zp + 2048); rv = *(const bf16x8*)(zp + 2560); } \
        else { const size_t o_ = tk * 512 + h * 128 + c8; if (PASS == 2) { rq = *(const bf16x8*)(Qg + o_); ro = *(const bf16x8*)(Z + tk * NZ + 512 + h * 128 + c8); rx = *(const bf16x8*)(XCg + o_); } \
               rk = *(const bf16x8*)(Kg + o_); rv = *(const bf16x8*)(Vg + o_); if (tid < 32) lfv = LF[((t0_) + tid) * 4 + h]; } } while (0)
    GLA_FETCH(sg * GSEGLEN);
    float sk8[8], nw8[8];
#pragma unroll
    for (int j = 0; j < 8; ++j) { sk8[j] = (MODE == 0 && PASS == 2) ? a.in[9][l * 512 + h * 128 + c8 + j] : 0.f; nw8[j] = (MODE == 1 && PASS == 2) ? a.in[20][l * 512 + h * 128 + c8 + j] : 0.f; }
    __syncthreads();
    if (MODE == 0) { for (int i = tid; i < 2 * 16 * 40; i += 512) { const int b = i / 640, k = i % 640; ((bf16_t*)(smem + GL_VT + b * 11520))[128 * 40 + k] = (k < 32) ? (bf16_t)0x3F80 : (bf16_t)0; } }
#define GLA_STORE(tprev, pb) do { const bf16x8 o8 = *(const bf16x8*)(OS + tok * 136 + c8); const bf16x8 p8 = *(const bf16x8*)((const bf16_t*)(smem + GL_RO + (pb) * 8704) + tok * 136 + c8); float y[8]; \
        if (MODE == 0) { const bf16x8 x8 = *(const bf16x8*)((const bf16_t*)(smem + GL_RX + (pb) * 8704) + tok * 136 + c8); const float di = __builtin_amdgcn_rcpf(fmaxf(fabsf(DNS[tok]), 1.0f)); \
            _Pragma("unroll") for (int j = 0; j < 8; ++j) y[j] = sigmoidf_(bf2f((bf16_t)p8[j])) * (bf2f((bf16_t)o8[j]) * di) + sk8[j] * bf2f((bf16_t)x8[j]); } \
        else { float ov[8], ss = 0.f; _Pragma("unroll") for (int j = 0; j < 8; ++j) { ov[j] = bf2f((bf16_t)o8[j]); ss += ov[j] * ov[j]; } \
            ss += __shfl_xor(ss, 1); ss += __shfl_xor(ss, 2); ss += __shfl_xor(ss, 4); ss += __shfl_xor(ss, 8); const float rinv = rsqrtf(ss * (1.0f / 128.0f) + 1e-6f); \
            _Pragma("unroll") for (int j = 0; j < 8; ++j) y[j] = ov[j] * rinv * nw8[j] * siluf_(bf2f((bf16_t)p8[j])); } \
        u32x4 w_; w_.x = pack2(y[0], y[1]); w_.y = pack2(y[2], y[3]); w_.z = pack2(y[4], y[5]); w_.w = pack2(y[6], y[7]); *(u32x4*)(Yg + (size_t)((tprev) + tok) * 512 + h * 128 + c8) = w_; } while (0)
    float runb = 0.f;
    for (int ci = 0; ci < GSEGLEN / 32; ++ci) {
        const int t0 = sg * GSEGLEN + ci * 32, buf = ci & 1;
        bf16_t* RQ = (bf16_t*)(smem + GL_RQ + buf * 8704); bf16_t* RK = (bf16_t*)(smem + GL_RK + buf * 8704); bf16_t* VT = (bf16_t*)(smem + GL_VT + buf * 11520);
        float* LFS = (float*)(smem + GL_LFS + buf * 128);
        if (PASS == 2) { *(bf16x8*)(RQ + tok * 136 + c8) = rq; *(bf16x8*)((bf16_t*)(smem + GL_RO + buf * 8704) + tok * 136 + c8) = ro; if (MODE == 0) *(bf16x8*)((bf16_t*)(smem + GL_RX + buf * 8704) + tok * 136 + c8) = rx; }
        *(bf16x8*)(RK + tok * 136 + c8) = rk;
#pragma unroll
        for (int j = 0; j < 8; ++j) VT[(c8 + j) * 40 + tok] = (bf16_t)rv[j];
        if (MODE == 0 && tid < 32) LFS[tid] = lfv;
        if (ci + 1 < GSEGLEN / 32) GLA_FETCH(t0 + 32);
        __syncthreads();
        float lg[8], kv[8];
#pragma unroll
        for (int j = 0; j < 8; ++j) { const float kr = bf2f(RK[(grp * 8 + j) * 136 + d]);
            if (MODE == 1) { const float f = lb + (1.0f - lb) * sigmoidf_(kr); lg[j] = flog(f); kv[j] = 1.0f - f; } else { lg[j] = LFS[grp * 8 + j]; kv[j] = kr; } }
        float cs[8]; cs[0] = lg[0];
#pragma unroll
        for (int j = 1; j < 8; ++j) cs[j] = cs[j - 1] + lg[j];
        GT[grp * 128 + d] = cs[7];
        __syncthreads();
        if (PASS == 2 && ci > 0) GLA_STORE(t0 - 32, buf ^ 1);
        const float g0 = GT[d], g1 = GT[128 + d], g2 = GT[256 + d], g3 = GT[384 + d];
        const float off = grp == 0 ? 0.f : grp == 1 ? g0 : grp == 2 ? g0 + g1 : g0 + g1 + g2;
        const float bmid = g0 + g1, bL = bmid + g2 + g3;
        bf16_t ktv[8];
#pragma unroll
        for (int j = 0; j < 8; ++j) { const float bt = off + cs[j], ek = fexp(bmid - bt); const bf16_t kt = f2bf(kv[j] * ek); ktv[j] = kt;
            if (PASS == 2) { const float qr = bf2f(RQ[(grp * 8 + j) * 136 + d]); const float qq = (MODE == 1) ? siluf_(qr) : qr; RQ[(grp * 8 + j) * 136 + d] = f2bf(qq * __builtin_amdgcn_rcpf(ek)); RK[(grp * 8 + j) * 136 + d] = kt; } }
        { u32x4 w; w.x = ktv[0] | ((unsigned)ktv[1] << 16); w.y = ktv[2] | ((unsigned)ktv[3] << 16); w.z = ktv[4] | ((unsigned)ktv[5] << 16); w.w = ktv[6] | ((unsigned)ktv[7] << 16); *(u32x4*)(KT + d * 40 + grp * 8) = w; }
        if (grp == 0) { SC1[d] = fexp(bmid); SC2[d] = fexp(bL - bmid); runb += bL; }
        __syncthreads();
        if (PASS == 2) {
            if (wave < 4) {
                const int ti = (wave == 1 || wave == 2) ? 1 : 0, tj = (wave >= 2) ? 1 : 0;
                f32x4 p = (f32x4){0.f, 0.f, 0.f, 0.f};
                if (wave < 3) {
#pragma unroll
                    for (int kk = 0; kk < 4; ++kk) { const bf16x8 av = *(const bf16x8*)(RQ + (16 * ti + r) * 136 + 32 * kk + 8 * q); const bf16x8 bv = *(const bf16x8*)(RK + (16 * tj + r) * 136 + 32 * kk + 8 * q); p = MFMA16(av, bv, p); }
                }
#pragma unroll
                for (int g = 0; g < 4; ++g) { const int t = 16 * ti + 4 * q + g, s_ = 16 * tj + r; PS[t * 40 + s_] = (wave < 3 && s_ <= t) ? f2bf(p[g]) : (bf16_t)0; }
            }
            __syncthreads();
        }
        const bf16x8 bV = *(const bf16x8*)(VT + (16 * wave + r) * 40 + 8 * q);
        bf16x8 bV1 = bV; if (xw) bV1 = *(const bf16x8*)(VT + (128 + r) * 40 + 8 * q);
        f32x4 o[2], ox[2];
        o[0] = o[1] = ox[0] = ox[1] = (f32x4){0.f, 0.f, 0.f, 0.f};
#pragma unroll
        for (int kk = 0; kk < 4; ++kk) {
            const f32x4 sa = *(const f32x4*)(SC1 + 32 * kk + 4 * q), sb = *(const f32x4*)(SC1 + 32 * kk + 16 + 4 * q);
            S[2 * kk] *= sa; S[2 * kk + 1] *= sb;
            if (xw) { SX[2 * kk] *= sa; SX[2 * kk + 1] *= sb; }
            if (PASS == 2) {
                bf16x8 bS, bX;
#pragma unroll
                for (int g = 0; g < 4; ++g) { bS[g] = (short)f2bf(S[2 * kk][g]); bS[4 + g] = (short)f2bf(S[2 * kk + 1][g]); bX[g] = (short)f2bf(SX[2 * kk][g]); bX[4 + g] = (short)f2bf(SX[2 * kk + 1][g]); }
#pragma unroll
                for (int mt = 0; mt < 2; ++mt) { const bf16x4 lo = *(const bf16x4*)(RQ + (16 * mt + r) * 136 + 32 * kk + 4 * q), hi = *(const bf16x4*)(RQ + (16 * mt + r) * 136 + 32 * kk + 16 + 4 * q);
                    bf16x8 av; av[0] = lo[0]; av[1] = lo[1]; av[2] = lo[2]; av[3] = lo[3]; av[4] = hi[0]; av[5] = hi[1]; av[6] = hi[2]; av[7] = hi[3];
                    o[mt] = MFMA16(av, bS, o[mt]); if (xw) ox[mt] = MFMA16(av, bX, ox[mt]); }
            }
        }
        if (PASS == 2) {
#pragma unroll
            for (int mt = 0; mt < 2; ++mt) { const bf16x8 av = *(const bf16x8*)(PS + (16 * mt + r) * 40 + 8 * q); o[mt] = MFMA16(av, bV, o[mt]); if (xw) ox[mt] = MFMA16(av, bV1, ox[mt]);
#pragma unroll
                for (int g = 0; g < 4; ++g) { OS[(16 * mt + 4 * q + g) * 136 + 16 * wave + r] = f2bf(o[mt][g]); if (xw && r == 0) DNS[16 * mt + 4 * q + g] = ox[mt][g]; } }
        }
#pragma unroll
        for (int i = 0; i < 8; ++i) { const bf16x8 av = *(const bf16x8*)(KT + (16 * i + r) * 40 + 8 * q); const f32x4 s2 = *(const f32x4*)(SC2 + 16 * i + 4 * q);
            S[i] = MFMA16(av, bV, S[i]); S[i] *= s2;
            if (xw) { SX[i] = MFMA16(av, bV1, SX[i]); SX[i] *= s2; } }
    }
    if (PASS == 2) { __syncthreads(); GLA_STORE(sg * GSEGLEN + GSEGLEN - 32, 1); }
    if (PASS == 1) {
        float* ST = (float*)smem;
        __syncthreads();
#pragma unroll
        for (int i = 0; i < 8; ++i)
#pragma unroll
            for (int g = 0; g < 4; ++g) { ST[(16 * i + 4 * q + g) * 132 + 16 * wave + r] = S[i][g]; if (xw) EX[((size_t)(sg * 4 + h) * 128 + 16 * i + 4 * q + g) * 16 + r] = SX[i][g]; }
        __syncthreads();
#pragma unroll
        for (int k = 0; k < 8; ++k) { const int idx = tid + 512 * k, row = idx >> 5, c4 = (idx & 31) * 4; *(f32x4*)(Eg + ((size_t)(sg * 4 + h) * 128 + row) * 128 + c4) = *(const f32x4*)(ST + row * 132 + c4); }
        if (grp == 0) Gg[(size_t)(sg * 4 + h) * 128 + d] = expf(runb);
    }
#undef GLA_FETCH
#undef GLA_STORE
}

template <int PASS>
__device__ __forceinline__ void s5_item(ArgsRef a, int l, int g, int sg, int g0, int tid, int lane, int wave, int hsel) {
    unsigned char* ws = a.ws;
    const bf16_t* Z = (const bf16_t*)(ws + OFF_Z); const float* ABAR = (const float*)(ws + OFF_ABAR); const bf16_t* BBT = (const bf16_t*)(ws + OFF_BBT); const bf16_t* CCT = (const bf16_t*)(ws + OFF_CCT);
    float* ES = (float*)(ws + OFF_ES); bf16_t* YPRE = (bf16_t*)(ws + OFF_YPRE);
    float* BU = (float*)(smem + 70000 + (wave & 3) * 12800); bf16_t* X = (bf16_t*)(smem + 70000 + (wave & 3) * 12800 + 8448); bf16_t* YT = (bf16_t*)(smem + 70000 + 51200);
    const int r = lane & 15, q = lane >> 4, p = lane; const bool act = (wave >> 2) == hsel;
    const float ar = ABAR[(g * 64 + p) * 2], ai = ABAR[(g * 64 + p) * 2 + 1];
    const bf16x8 zero8 = (bf16x8){0, 0, 0, 0, 0, 0, 0, 0};
    bf16x8 bB[8], cB[4];
#pragma unroll
    for (int nt = 0; nt < 8; ++nt) bB[nt] = (q < 2) ? *(const bf16x8*)(BBT + (size_t)(g * 128 + 16 * nt + r) * 16 + 8 * q) : zero8;
#pragma unroll
    for (int kk = 0; kk < 4; ++kk) cB[kk] = (PASS == 2) ? *(const bf16x8*)(CCT + (size_t)(g * 16 + r) * 128 + 32 * kk + 8 * q) : zero8;
    float xr = 0.f, xi = 0.f;
    if (PASS == 2) { xr = ES[((size_t)(sg * 32 + g) * 64 + p) * 2]; xi = ES[((size_t)(sg * 32 + g) * 64 + p) * 2 + 1]; }
    const float dsk = a.in[17][l * 512 + 16 * g + r];
    bf16x8 av_n = zero8; bf16_t un[4] = {0, 0, 0, 0};
#define S5_FETCH(t0_) do { if (q < 2) av_n = *(const bf16x8*)(Z + (size_t)((t0_) + r) * NZ + 1024 + 16 * g + 8 * q); \
        if (PASS == 2) { _Pragma("unroll") for (int gg_ = 0; gg_ < 4; ++gg_) un[gg_] = Z[(size_t)((t0_) + 4 * q + gg_) * NZ + 1024 + 16 * g + r]; } } while (0)
    if (act) S5_FETCH(sg * SSEGLEN);
    for (int ci = 0; ci < SSEGLEN / 16; ++ci) {
        const int t0 = sg * SSEGLEN + ci * 16;
        if (act) {
            const bf16x8 av = av_n; bf16_t uc[4] = {un[0], un[1], un[2], un[3]};
            if (ci + 1 < SSEGLEN / 16) S5_FETCH(t0 + 16);
#pragma unroll
            for (int nt = 0; nt < 8; ++nt) { f32x4 acc = (f32x4){0.f, 0.f, 0.f, 0.f}; acc = MFMA16(av, bB[nt], acc);
#pragma unroll
                for (int gg = 0; gg < 4; ++gg) BU[(4 * q + gg) * 132 + 16 * nt + r] = acc[gg]; }
            wave_sync();
#pragma unroll
            for (int t = 0; t < 16; ++t) { const float br = BU[t * 132 + p], bi = BU[t * 132 + 64 + p];
                const float nr = ar * xr - ai * xi + br, ni = ar * xi + ai * xr + bi; xr = nr; xi = ni;
                if (PASS == 2) { X[t * 136 + p] = f2bf(xr); X[t * 136 + 64 + p] = f2bf(xi); } }
            wave_sync();
            if (PASS == 2) {
                f32x4 acc = (f32x4){0.f, 0.f, 0.f, 0.f};
#pragma unroll
                for (int kk = 0; kk < 4; ++kk) { const bf16x8 xv = *(const bf16x8*)(X + r * 136 + 32 * kk + 8 * q); acc = MFMA16(xv, cB[kk], acc); }
#pragma unroll
                for (int gg = 0; gg < 4; ++gg) YT[(4 * q + gg) * 136 + 16 * wave + r] = f2bf(gelu_tanh(acc[gg] + dsk * bf2f(uc[gg])));
            }
        }
        if (PASS == 2) {
            __syncthreads();
            if (tid < 128) { const int row = tid >> 3, c8 = (tid & 7) * 8; *(u32x4*)(YPRE + (size_t)(t0 + row) * 512 + 16 * g0 + 64 * hsel + c8) = *(const u32x4*)(YT + row * 136 + 64 * hsel + c8); }
            __syncthreads();
        }
    }
    if (PASS == 1 && act) { ES[((size_t)(sg * 32 + g) * 64 + p) * 2] = xr; ES[((size_t)(sg * 32 + g) * 64 + p) * 2 + 1] = xi; }
#undef S5_FETCH
}

__device__ __forceinline__ void phase_scan(ArgsRef a, int tid, int bid, int G) {
    unsigned char* ws = a.ws;
    const int NT = G * 512, gt = bid * 512 + tid;
    for (int i = gt; i < 2 * 65536 + 8192 + 2048; i += NT) {
        if (i < 2 * 65536 + 8192) { const bool nx = i >= 2 * 65536; const int m = i >> 16, el = nx ? i - 2 * 65536 : (i & 65535), hrow = nx ? (el >> 4) : (el >> 7); const size_t str = nx ? 8192 : 65536;
            float* E = (float*)(ws + (nx ? OFF_EMX : (m == 0 ? OFF_EM : OFF_EH))); const float* Gd = (const float*)(ws + ((nx || m == 0) ? OFF_GM : OFF_GH));
            float ev[GSEG], gv[GSEG];
#pragma unroll
            for (int sg = 0; sg < GSEG; ++sg) { ev[sg] = E[(size_t)sg * str + el]; gv[sg] = Gd[sg * 512 + hrow]; }
            float cur = 0.f;
#pragma unroll
            for (int sg = 0; sg < GSEG; ++sg) { E[(size_t)sg * str + el] = cur; cur = gv[sg] * cur + ev[sg]; } }
        else { const int el = i - 2 * 65536 - 8192; float* E = (float*)(ws + OFF_ES); const float* ABAR = (const float*)(ws + OFF_ABAR);
            float pr = ABAR[el * 2], pi = ABAR[el * 2 + 1];
#pragma unroll
            for (int k = 0; k < 8; ++k) { const float nr = pr * pr - pi * pi, ni = 2.0f * pr * pi; pr = nr; pi = ni; }
            float xr = 0.f, xi = 0.f;
            for (int sb = 0; sb < SSEG; sb += 16) { float er[16], ei[16];
#pragma unroll
                for (int k = 0; k < 16; ++k) { er[k] = E[((size_t)(sb + k) * 2048 + el) * 2]; ei[k] = E[((size_t)(sb + k) * 2048 + el) * 2 + 1]; }
#pragma unroll
                for (int k = 0; k < 16; ++k) { E[((size_t)(sb + k) * 2048 + el) * 2] = xr; E[((size_t)(sb + k) * 2048 + el) * 2 + 1] = xi;
                    const float nr = pr * xr - pi * xi + er[k], ni = pr * xi + pi * xr + ei[k]; xr = nr; xi = ni; } } }
    }
}

template <int PASS>
__device__ __forceinline__ void phase_mixers(ArgsRef a, int l, int tid, int lane, int wave, int bid, int G) {
    for (int it = bid; it < 4 * GSEG; it += G) gla_item<0, PASS>(a, l, it % 4, it / 4, tid, lane, wave);
    asm volatile("" ::: "memory");
    for (int it = bid + ((4 * GSEG - bid % G) % G + G) % G * 0; it < 2 * 4 * GSEG; it += G) { if (it >= 4 * GSEG) gla_item<1, PASS>(a, l, (it - 4 * GSEG) % 4, (it - 4 * GSEG) / 4, tid, lane, wave); }
    __syncthreads();
    for (int it0 = bid * 8; it0 < 32 * SSEG; it0 += G * 8)
        for (int half = 0; half < 2; ++half) { const int it = it0 + wave; s5_item<PASS>(a, l, it % 32, it / 32, it0 % 32, tid, lane, wave, half); __syncthreads(); }
}

__device__ __forceinline__ void ln_row(f32x4 (&v)[4], const float* gam, const float* bet, int lane) {
    float s = 0.f;
#pragma unroll
    for (int j = 0; j < 4; ++j) s += (v[j][0] + v[j][1]) + (v[j][2] + v[j][3]);
#pragma unroll
    for (int o = 32; o >= 1; o >>= 1) s += __shfl_xor(s, o);
    const float mean = s * (1.0f / 1024.0f); float qv = 0.f;
#pragma unroll
    for (int j = 0; j < 4; ++j) { const f32x4 dd = v[j] - mean; qv += (dd[0] * dd[0] + dd[1] * dd[1]) + (dd[2] * dd[2] + dd[3] * dd[3]); }
#pragma unroll
    for (int o = 32; o >= 1; o >>= 1) qv += __shfl_xor(qv, o);
    const float rstd = rsqrtf(qv * (1.0f / 1024.0f) + 1e-5f);
#pragma unroll
    for (int j = 0; j < 4; ++j) { const f32x4 gg = *(const f32x4*)(gam + 256 * j + 4 * lane), bb = *(const f32x4*)(bet + 256 * j + 4 * lane); v[j] = (v[j] - mean) * rstd * gg + bb; }
}

__device__ __forceinline__ void phase_ln1r(ArgsRef a, int l, int tid, int lane, int wave, int bid, int G) {
    float* XF = a.out; bf16_t* XB = (bf16_t*)(a.ws + OFF_XB);
    int* TOKE = (int*)(a.ws + OFF_TOKE); float* TOKG = (float*)(a.ws + OFF_TOKG); unsigned* HIST = (unsigned*)(a.ws + OFF_HIST);
    const float* RWT = (const float*)(a.ws + OFF_RWT); const float* RB = a.in[30];
    float* LG = (float*)(smem + wave * 4096);
    int* TE = (int*)(smem + wave * 4096 + 2304); float* TG = (float*)(smem + wave * 4096 + 2432); unsigned* HS = (unsigned*)(smem + wave * 4096 + 2560);
    const int r = lane & 15, q = lane >> 4, rs = lane >> 5, e = lane & 31;
    if (G >= 256 && wave >= 4) {
        float* tw_lds = (float*)(smem + 16384 + (wave - 4) * 16640);
        for (int u = 896 + bid * 4 + (wave - 4); u < 6144; u += G * 4) wave_prepx_tile(a, l, u, lane, tw_lds);
    }
    for (int tw = bid + G * wave; tw < T / 16; tw += G * 8) {
        const int t0 = tw * 16;
        for (int rb = 0; rb < 16; rb += 4) { f32x4 v[4][4];
#pragma unroll
            for (int k = 0; k < 4; ++k)
#pragma unroll
                for (int j = 0; j < 4; ++j) v[k][j] = *(const f32x4*)(XF + (size_t)(t0 + rb + k) * 1024 + 256 * j + 4 * lane);
#pragma unroll
            for (int k = 0; k < 4; ++k) { const int t = t0 + rb + k; ln_row(v[k], a.in[25] + l * 1024, a.in[26] + l * 1024, lane);
#pragma unroll
                for (int j = 0; j < 4; ++j) { *(f32x4*)(XF + (size_t)t * 1024 + 256 * j + 4 * lane) = v[k][j];
                    u32x2 w; w.x = pack2(v[k][j][0], v[k][j][1]); w.y = pack2(v[k][j][2], v[k][j][3]); *(u32x2*)(XB + (size_t)t * 1024 + 256 * j + 4 * lane) = w; } } }
        if (lane < 32) HS[lane] = 0u;
        asm volatile("s_waitcnt vmcnt(0) lgkmcnt(0)" ::: "memory"); __builtin_amdgcn_wave_barrier();
        f32x4 acc0 = (f32x4){0.f, 0.f, 0.f, 0.f}, acc1 = acc0;
        const float* xa = XF + (size_t)(t0 + r) * 1024 + 4 * q; const float* w0 = RWT + (size_t)r * 1024 + 4 * q; const float* w1 = RWT + (size_t)(16 + r) * 1024 + 4 * q;
        f32x4 pa[2][4], pb[2][4], pc[2][4];
#define RT_LOAD(buf, g_) do { _Pragma("unroll") for (int k_ = 0; k_ < 4; ++k_) { pa[buf][k_] = *(const f32x4*)(xa + 16 * (4 * (g_) + k_)); pb[buf][k_] = *(const f32x4*)(w0 + 16 * (4 * (g_) + k_)); pc[buf][k_] = *(const f32x4*)(w1 + 16 * (4 * (g_) + k_)); } } while (0)
#define RT_MMA(buf) do { _Pragma("unroll") for (int k_ = 0; k_ < 4; ++k_) _Pragma("unroll") for (int j = 0; j < 4; ++j) { acc0 = __builtin_amdgcn_mfma_f32_16x16x4f32(pa[buf][k_][j], pb[buf][k_][j], acc0, 0, 0, 0); acc1 = __builtin_amdgcn_mfma_f32_16x16x4f32(pa[buf][k_][j], pc[buf][k_][j], acc1, 0, 0, 0); } } while (0)
        RT_LOAD(0, 0);
#pragma unroll 1
        for (int g2 = 0; g2 < 16; g2 += 2) {
            RT_LOAD(1, g2 + 1);
            RT_MMA(0);
            if (g2 + 2 < 16) RT_LOAD(0, g2 + 2);
            RT_MMA(1);
        }
#undef RT_LOAD
#undef RT_MMA
#pragma unroll
        for (int g = 0; g < 4; ++g) { LG[(4 * q + g) * 33 + r] = acc0[g]; LG[(4 * q + g) * 33 + 16 + r] = acc1[g]; }
        wave_sync();
        for (int pp = 0; pp < 8; ++pp) {
            const float lg = LG[(2 * pp + rs) * 33 + e];
            const float s = sigmoidf_(lg), sb = s + RB[e];
            float v4[4];
#pragma unroll
            for (int i = 0; i < 4; ++i) v4[i] = __shfl(sb, (lane & ~3) + i);
            int i1 = 0;
#pragma unroll
            for (int i = 1; i < 4; ++i) if (v4[i] > v4[i1]) i1 = i;
            int i2 = (i1 == 0) ? 1 : 0;
#pragma unroll
            for (int i = 0; i < 4; ++i) if (i != i1 && i != i2 && v4[i] > v4[i2]) i2 = i;
            float gs = v4[i1] + v4[i2]; int gid = e >> 2;
#pragma unroll
            for (int o = 4; o <= 16; o <<= 1) { const float os = __shfl_xor(gs, o); const int og = __shfl_xor(gid, o); if (os > gs || (os == gs && og < gid)) { gs = os; gid = og; } }
            float sv[4], sbv[4];
#pragma unroll
            for (int i = 0; i < 4; ++i) { sbv[i] = __shfl(sb, (lane & 32) + gid * 4 + i); sv[i] = __shfl(s, (lane & 32) + gid * 4 + i); }
            int j1 = 0;
#pragma unroll
            for (int i = 1; i < 4; ++i) if (sbv[i] > sbv[j1]) j1 = i;
            int j2 = (j1 == 0) ? 1 : 0;
#pragma unroll
            for (int i = 0; i < 4; ++i) if (i != j1 && i != j2 && sbv[i] > sbv[j2]) j2 = i;
            float s1 = sv[0], s2 = sv[0];
#pragma unroll
            for (int i = 1; i < 4; ++i) { if (i == j1) s1 = sv[i]; if (i == j2) s2 = sv[i]; }
            if (e == 0) { const int ti = 2 * pp + rs; const float inv = 1.0f / (s1 + s2);
                TE[ti * 2] = gid * 4 + j1; TE[ti * 2 + 1] = gid * 4 + j2; TG[ti * 2] = s1 * inv; TG[ti * 2 + 1] = s2 * inv;
                atomicAdd(&HS[gid * 4 + j1], 1u); atomicAdd(&HS[gid * 4 + j2], 1u); }
        }
        wave_sync();
        if (lane < 32) { TOKE[t0 * 2 + lane] = TE[lane]; TOKG[t0 * 2 + lane] = TG[lane]; HIST[tw * 32 + lane] = HS[lane]; }
        wave_sync();
    }
    __syncthreads();
}

__device__ __forceinline__ void phase_slot(ArgsRef a, int tid, int lane, int wave, int bid, int G) {
    const int* TOKE = (const int*)(a.ws + OFF_TOKE); int* TOKS = (int*)(a.ws + OFF_TOKS); const unsigned* HIST = (const unsigned*)(a.ws + OFF_HIST);
    unsigned* BASE = (unsigned*)(a.ws + OFF_CTL) + 64;
    const bf16_t* XB = (const bf16_t*)(a.ws + OFF_XB); bf16_t* XG = (bf16_t*)(a.ws + OFF_XG);
    unsigned* base = (unsigned*)smem; unsigned* pre = base + 40; int* el = (int*)(base + 80); int* sl = (int*)(base + 208); unsigned* red = base + 336;
    const int e = tid & 31, part = tid >> 5;
    for (int c = bid; c < T / 64; c += G) {
        unsigned tot = 0u, pr = 0u;
#pragma unroll 16
        for (int it = part; it < 1024; it += 16) { const unsigned v = HIST[it * 32 + e]; tot += v; pr += (it < 4 * c) ? v : 0u; }
        red[part * 32 + e] = tot; red[512 + part * 32 + e] = pr;
        __syncthreads();
        if (tid < 32) { unsigned t2 = 0u, p2 = 0u; for (int k = 0; k < 16; ++k) { t2 += red[k * 32 + tid]; p2 += red[512 + k * 32 + tid]; } pre[tid] = p2; red[tid] = (t2 + 255u) & ~255u; }
        __syncthreads();
        if (tid == 0) { unsigned sacc = 0; for (int k = 0; k < 32; ++k) { base[k] = sacc; sacc += red[k]; } base[32] = sacc; }
        int ee = 0;
        if (tid < 128) { ee = TOKE[c * 128 + tid]; el[tid] = ee; }
        __syncthreads();
        if (c == 0 && tid < 33) BASE[tid] = base[tid];
        if (c == 0 && tid >= 64 && tid < 64 + 160) { const unsigned t256 = (unsigned)(tid - 64) * 256u; int ee2 = 0; while (ee2 < 31 && base[ee2 + 1] <= t256) ++ee2; BASE[64 + (tid - 64)] = (unsigned)ee2; }
        if (tid < 128) { unsigned rank = 0; for (int i = 0; i < tid; ++i) rank += (el[i] == ee) ? 1u : 0u;
            const unsigned sidx = base[ee] + pre[ee] + rank; sl[tid] = (int)sidx; TOKS[c * 128 + tid] = (int)sidx; }
        __syncthreads();
        for (int ib = 0; ib < 16; ib += 8) { u32x4 ra[8], rb[8];
#pragma unroll
            for (int k = 0; k < 8; ++k) { const int i = wave + 8 * (ib + k), t = c * 64 + (i >> 1); ra[k] = *(const u32x4*)(XB + (size_t)t * 1024 + lane * 8); rb[k] = *(const u32x4*)(XB + (size_t)t * 1024 + 512 + lane * 8); }
#pragma unroll
            for (int k = 0; k < 8; ++k) { const int i = wave + 8 * (ib + k); const size_t so = (size_t)sl[i] * 1024; *(u32x4*)(XG + so + lane * 8) = ra[k]; *(u32x4*)(XG + so + 512 + lane * 8) = rb[k]; } }
        __syncthreads();
    }
}

__device__ __forceinline__ void phase_ln2(ArgsRef a, int l, int lane, int gw, int GW) {
    float* XF = a.out; bf16_t* XB = (bf16_t*)(a.ws + OFF_XB); const bf16_t* YS = (const bf16_t*)(a.ws + OFF_YS);
    const int* TOKS = (const int*)(a.ws + OFF_TOKS); const float* TOKG = (const float*)(a.ws + OFF_TOKG);
    for (int tb = gw * 4; tb < T; tb += GW * 4) {
        int sv = 0; float gv = 0.f; if (lane < 8) { sv = TOKS[tb * 2 + lane]; gv = TOKG[tb * 2 + lane]; }
        f32x4 v[4][4]; bf16x4 y0[4][4], y1[4][4]; float g0[4], g1[4];
#pragma unroll
        for (int k = 0; k < 4; ++k) { const int s0 = __shfl(sv, 2 * k), s1 = __shfl(sv, 2 * k + 1); g0[k] = __shfl(gv, 2 * k); g1[k] = __shfl(gv, 2 * k + 1);
#pragma unroll
            for (int j = 0; j < 4; ++j) { v[k][j] = *(const f32x4*)(XF + (size_t)(tb + k) * 1024 + 256 * j + 4 * lane);
                y0[k][j] = *(const bf16x4*)(YS + (size_t)s0 * 1024 + 256 * j + 4 * lane); y1[k][j] = *(const bf16x4*)(YS + (size_t)s1 * 1024 + 256 * j + 4 * lane); } }
#pragma unroll
        for (int k = 0; k < 4; ++k) {
#pragma unroll
            for (int j = 0; j < 4; ++j)
#pragma unroll
                for (int g = 0; g < 4; ++g) v[k][j][g] = DN_ALPHA * v[k][j][g] + g0[k] * bf2f((bf16_t)y0[k][j][g]) + g1[k] * bf2f((bf16_t)y1[k][j][g]);
            ln_row(v[k], a.in[27] + l * 1024, a.in[28] + l * 1024, lane);
#pragma unroll
            for (int j = 0; j < 4; ++j) { *(f32x4*)(XF + (size_t)(tb + k) * 1024 + 256 * j + 4 * lane) = v[k][j];
                u32x2 w; w.x = pack2(v[k][j][0], v[k][j][1]); w.y = pack2(v[k][j][2], v[k][j][3]); *(u32x2*)(XB + (size_t)(tb + k) * 1024 + 256 * j + 4 * lane) = w; } }
    }
}

struct SchedGrid {
    int nM, nN, G, c; const char* A; const char* B; size_t strideA, strideB;
    __device__ __forceinline__ bool next(int i, pg8::Unit& u) const { int pm, pn; if (!pg8::tile_order(i * G + c, nM, nN, pm, pn)) return false;
        u.pm = pm; u.pn = pn; u.tag = 0; u.A = A + (size_t)pm * strideA; u.B = B + (size_t)pn * strideB; return true; }
};
constexpr int GATES_LD = 3072;
template <int MODE> struct EpiBf16 {
    static constexpr bool PERM = true;
    bf16_t* O; int ldo; const bf16_t* Y; int ldy;
    __device__ __forceinline__ bool operator()(f32x4 (&acc)[2][2][4][2], const pg8::Unit& u, int wr, int wc, int fr, int fq) const {
#pragma unroll
        for (int ai = 0; ai < 2; ++ai) {
            bf16x8 yv[4][2];
            if (MODE == 2) {
#pragma unroll
                for (int m = 0; m < 4; ++m)
#pragma unroll
                    for (int bj = 0; bj < 2; ++bj) yv[m][bj] = *(const bf16x8*)(Y + ((size_t)u.pm * 256 + ai * 128 + wr * 64 + m * 16 + fr) * ldy + u.pn * 256 + bj * 128 + wc * 32 + 8 * fq);
            }
#pragma unroll
            for (int m = 0; m < 4; ++m) { const size_t row = (size_t)u.pm * 256 + ai * 128 + wr * 64 + m * 16 + fr;
#pragma unroll
                for (int bj = 0; bj < 2; ++bj) { const int col = u.pn * 256 + bj * 128 + wc * 32 + 8 * fq; f32x4 v0 = acc[ai][bj][m][0], v1 = acc[ai][bj][m][1];
                    if (MODE == 1) {
#pragma unroll
                        for (int j = 0; j < 4; ++j) { v0[j] = fmaxf(sigmoidf_(v0[j]), 1e-30f); v1[j] = fmaxf(sigmoidf_(v1[j]), 1e-30f); } }
                    if (MODE == 2) {
#pragma unroll
                        for (int j = 0; j < 4; ++j) { v0[j] = bf2f((bf16_t)yv[m][bj][j]) * sigmoidf_(v0[j]); v1[j] = bf2f((bf16_t)yv[m][bj][4 + j]) * sigmoidf_(v1[j]); } }
                    u32x4 w; w.x = pg8::cvt_pk_bf16(v0[0], v0[1]); w.y = pg8::cvt_pk_bf16(v0[2], v0[3]); w.z = pg8::cvt_pk_bf16(v1[0], v1[1]); w.w = pg8::cvt_pk_bf16(v1[2], v1[3]);
                    if (MODE == 1) *(u32x4*)(O + ((((size_t)u.pm * 12 + u.pn) * 16 + (ai * 8 + m * 2 + bj)) * 512 + ((wr * 4 + wc) * 64 + fq * 16 + fr)) * 8) = w;
                    else *(u32x4*)(O + row * ldo + col) = w; } }
        }
        return false;
    }
};
struct SchedZ {
    int G, c; const unsigned char* ws;
    __device__ __forceinline__ bool next(int i, pg8::Unit& u) const { int pm, pn; if (!pg8::tile_order(i * G + c, T / 256, 15, pm, pn)) return false;
        u.pm = pm; u.pn = pn; u.tag = 0; u.A = (const char*)(ws + OFF_XB) + (size_t)pm * 256 * 1024 * 2;
        u.B = (const char*)(ws + OFF_WIN) + (size_t)(pn < 14 ? pn * 256 : 6656) * 1024 * 2; return true; }
};
struct EpiZ {
    static constexpr bool PERM = true;
    bf16_t* Z; float* LI; float* LF; const float* bi; const float* bf;
    __device__ __forceinline__ bool operator()(f32x4 (&acc)[2][2][4][2], const pg8::Unit& u, int wr, int wc, int fr, int fq) const {
        if (u.pn < 14) {
#pragma unroll
            for (int ai = 0; ai < 2; ++ai)
#pragma unroll
                for (int m = 0; m < 4; ++m) { const size_t row = (size_t)u.pm * 256 + ai * 128 + wr * 64 + m * 16 + fr;
#pragma unroll
                    for (int bj = 0; bj < 2; ++bj) { const int col = u.pn * 256 + bj * 128 + wc * 32 + 8 * fq; const f32x4 v0 = acc[ai][bj][m][0], v1 = acc[ai][bj][m][1];
                        u32x4 w; w.x = pg8::cvt_pk_bf16(v0[0], v0[1]); w.y = pg8::cvt_pk_bf16(v0[2], v0[3]); w.z = pg8::cvt_pk_bf16(v1[0], v1[1]); w.w = pg8::cvt_pk_bf16(v1[2], v1[3]);
                        *(u32x4*)(Z + row * NZ + col) = w; } }
        } else if (wc == 0 && fq == 0) {
            const f32x4 b_i = *(const f32x4*)bi, b_f = *(const f32x4*)bf;
#pragma unroll
            for (int ai = 0; ai < 2; ++ai)
#pragma unroll
                for (int m = 0; m < 4; ++m) { const size_t row = (size_t)u.pm * 256 + ai * 128 + wr * 64 + m * 16 + fr; const f32x4 v0 = acc[ai][0][m][0] + b_i, v1 = acc[ai][0][m][1] + b_f;
                    f32x4 lf; lf[0] = logsigmoidf_(v1[0]); lf[1] = logsigmoidf_(v1[1]); lf[2] = logsigmoidf_(v1[2]); lf[3] = logsigmoidf_(v1[3]);
                    *(f32x4*)(LI + row * 4) = v0; *(f32x4*)(LF + row * 4) = lf; }
        }
        return false;
    }
};
__device__ __forceinline__ void phase_zgemm2(ArgsRef a, int l, int tid, int bid, int G) {
    SchedZ S{G, bid, a.ws}; EpiZ E{(bf16_t*)(a.ws + OFF_Z), (float*)(a.ws + OFF_LI), (float*)(a.ws + OFF_LF), a.in[7] + l * 4, a.in[8] + l * 4};
    pg8::gemm_phase((PG8_LAS unsigned char*)smem, tid, 1024, 1024, 1024, S, E);
}
__device__ __forceinline__ void phase_glu_gates(ArgsRef a, int l, int tid, int bid, int G) {
    { SchedGrid S{T / 256, 2, G, bid, (const char*)(a.ws + OFF_YPRE), (const char*)(a.ws + OFF_WGLU), (size_t)256 * 512 * 2, (size_t)256 * 512 * 2};
      EpiBf16<2> E{(bf16_t*)(a.ws + OFF_YSG), 512, (const bf16_t*)(a.ws + OFF_YPRE), 512};
      pg8::gemm_phase((PG8_LAS unsigned char*)smem, tid, 512, 512, 512, S, E); }
    asm volatile("" : "+v"(tid), "+s"(bid), "+s"(G));
    if (G > 128) { if (bid >= 128) phase_prepx(a, l, tid, bid - 128, G - 128, 0, 896); } else phase_prepx(a, l, tid, bid, G, 0, 896);
    asm volatile("" : "+v"(tid), "+s"(bid), "+s"(G));
    { SchedGrid S{T / 256, 12, G, (bid + G / 2) % G, (const char*)(a.ws + OFF_XB), (const char*)(a.ws + OFF_WIN + (size_t)NZ * 1024 * 2), (size_t)256 * 1024 * 2, (size_t)256 * 1024 * 2};
      EpiBf16<1> E{(bf16_t*)(a.ws + OFF_Z), GATES_LD, nullptr, 0};
      pg8::gemm_phase((PG8_LAS unsigned char*)smem, tid, 1024, 1024, 1024, S, E); }
}
struct SchedMerge {
    int G, c; const unsigned char* ws;
    __device__ __forceinline__ bool next(int i, pg8::Unit& u) const { const int b = i % 3; int pm, pn; if (!pg8::tile_order((i / 3) * G + c, T / 256, 4, pm, pn)) return false;
        u.pm = pm; u.pn = pn; u.tag = b; u.A = (const char*)(ws + (b == 0 ? OFF_OM : b == 1 ? OFF_YSG : OFF_OH)) + (size_t)pm * 256 * 512 * 2;
        u.B = (const char*)(ws + OFF_WB) + ((size_t)b * 1024 + pn * 256) * 512 * 2; return true; }
};
struct EpiMerge {
    static constexpr bool PERM = true;
    const bf16_t* GT; bf16_t* O;
    __device__ __forceinline__ bool operator()(f32x4 (&acc)[2][2][4][2], const pg8::Unit& u, int wr, int wc, int fr, int fq) const {
        const int b = u.tag;
        const bf16_t* gbase = GT + (((size_t)u.pm * 12 + b * 4 + u.pn) * 16 * 512 + ((wr * 4 + wc) * 64 + fq * 16 + fr)) * 8;
        bf16x8 gb[2][2][2], gn[2][2][2];
#define MG_LOAD(buf, ai_, mh_) do { _Pragma("unroll") for (int mm = 0; mm < 2; ++mm) _Pragma("unroll") for (int bj = 0; bj < 2; ++bj) { const bf16_t* gp = gbase + (size_t)((ai_) * 8 + (2 * (mh_) + mm) * 2 + bj) * 512 * 8; \
            gb[buf][mm][bj] = *(const bf16x8*)gp; gn[buf][mm][bj] = (b < 2) ? *(const bf16x8*)(gp + (size_t)4 * 16 * 512 * 8) : gb[buf][mm][bj]; } } while (0)
        MG_LOAD(0, 0, 0);
#pragma unroll
        for (int st = 0; st < 4; ++st) { const int ai = st >> 1, mh = st & 1, buf = st & 1;
            if (st + 1 < 4) { if (buf == 0) MG_LOAD(1, (st + 1) >> 1, (st + 1) & 1); else MG_LOAD(0, (st + 1) >> 1, (st + 1) & 1); }
#pragma unroll
            for (int mm = 0; mm < 2; ++mm) { const int m = 2 * mh + mm; const size_t row = (size_t)u.pm * 256 + ai * 128 + wr * 64 + m * 16 + fr;
#pragma unroll
                for (int bj = 0; bj < 2; ++bj) { const int col = u.pn * 256 + bj * 128 + wc * 32 + 8 * fq;
                    if (b < 2) {
#pragma unroll
                        for (int j = 0; j < 4; ++j) { acc[ai][bj][m][0][j] *= bf2f((bf16_t)gb[buf][mm][bj][j]) * __builtin_amdgcn_rcpf(bf2f((bf16_t)gn[buf][mm][bj][j])); acc[ai][bj][m][1][j] *= bf2f((bf16_t)gb[buf][mm][bj][4 + j]) * __builtin_amdgcn_rcpf(bf2f((bf16_t)gn[buf][mm][bj][4 + j])); } }
                    else { f32x4 v0 = acc[ai][bj][m][0], v1 = acc[ai][bj][m][1];
#pragma unroll
                        for (int j = 0; j < 4; ++j) { v0[j] *= bf2f((bf16_t)gb[buf][mm][bj][j]); v1[j] *= bf2f((bf16_t)gb[buf][mm][bj][4 + j]); }
                        u32x4 w; w.x = pg8::cvt_pk_bf16(v0[0], v0[1]); w.y = pg8::cvt_pk_bf16(v0[2], v0[3]); w.z = pg8::cvt_pk_bf16(v1[0], v1[1]); w.w = pg8::cvt_pk_bf16(v1[2], v1[3]);
                        *(u32x4*)(O + row * 1024 + col) = w; } } }
        }
#undef MG_LOAD
        return b < 2;
    }
};
__device__ __forceinline__ void phase_merge2(ArgsRef a, int tid, int bid, int G) {
    SchedMerge S{G, bid, a.ws}; EpiMerge E{(const bf16_t*)(a.ws + OFF_Z), (bf16_t*)(a.ws + OFF_XB)};
    pg8::gemm_phase((PG8_LAS unsigned char*)smem, tid, 512, 512, 512, S, E);
}
struct EpiResid {
    static constexpr bool PERM = false;
    const float* xin; float* XF;
    __device__ __forceinline__ bool operator()(f32x4 (&acc)[2][2][4][2], const pg8::Unit& u, int wr, int wc, int fr, int fq) const {
#pragma unroll
        for (int ai = 0; ai < 2; ++ai)
#pragma unroll
        for (int mh = 0; mh < 2; ++mh) {
            f32x4 xv[2][2][2];
#pragma unroll
            for (int mm = 0; mm < 2; ++mm)
#pragma unroll
                for (int bj = 0; bj < 2; ++bj)
#pragma unroll
                    for (int n = 0; n < 2; ++n) xv[mm][bj][n] = *(const f32x4*)(xin + ((size_t)u.pm * 256 + ai * 128 + wr * 64 + (2 * mh + mm) * 16 + fr) * 1024 + u.pn * 256 + bj * 128 + wc * 32 + 16 * n + 4 * fq);
#pragma unroll
            for (int mm = 0; mm < 2; ++mm)
#pragma unroll
                for (int bj = 0; bj < 2; ++bj)
#pragma unroll
                    for (int n = 0; n < 2; ++n) { const int m = 2 * mh + mm; const size_t o = ((size_t)u.pm * 256 + ai * 128 + wr * 64 + m * 16 + fr) * 1024 + u.pn * 256 + bj * 128 + wc * 32 + 16 * n + 4 * fq; *(f32x4*)(XF + o) = DN_ALPHA * xv[mm][bj][n] + acc[ai][bj][m][n]; }
        }
        return false;
    }
};
__device__ __forceinline__ void phase_wout2(ArgsRef a, int l, int tid, int bid, int G) {
    SchedGrid S{T / 256, 4, G, bid, (const char*)(a.ws + OFF_XB), (const char*)(a.ws + OFF_WOUT), (size_t)256 * 1024 * 2, (size_t)256 * 1024 * 2};
    EpiResid E{(l == 0) ? a.in[0] : a.out, a.out};
    pg8::gemm_phase((PG8_LAS unsigned char*)smem, tid, 1024, 1024, 1024, S, E);
}
struct EpiQKV {
    static constexpr bool PERM = true;
    int vcall; bf16_t* Q; bf16_t* KH; bf16_t* V; const float* LI;
    __device__ __forceinline__ bool operator()(f32x4 (&acc)[2][2][4][2], const pg8::Unit& u, int wr, int wc, int fr, int fq) const {
        const int which = vcall ? 2 : (u.pn >> 1); bf16_t* O = Q + (size_t)which * (SZ_ACT / 2);
        float liv[2][4][2];
#pragma unroll
        for (int ai = 0; ai < 2; ++ai)
#pragma unroll
            for (int m = 0; m < 4; ++m)
#pragma unroll
                for (int bj = 0; bj < 2; ++bj) liv[ai][m][bj] = (which == 1) ? LI[((size_t)u.pm * 256 + ai * 128 + wr * 64 + m * 16 + fr) * 4 + (u.pn & 1) * 2 + bj] : 0.f;
#pragma unroll
        for (int ai = 0; ai < 2; ++ai)
#pragma unroll
            for (int m = 0; m < 4; ++m) { const size_t row = (size_t)u.pm * 256 + ai * 128 + wr * 64 + m * 16 + fr;
#pragma unroll
                for (int bj = 0; bj < 2; ++bj) { const int hd = (u.pn & 1) * 2 + bj, col = hd * 128 + wc * 32 + 8 * fq;
                    const float sc = which == 0 ? 0.08838834764831845f : which == 1 ? fexp(liv[ai][m][bj]) : 1.0f;
                    const f32x4 v0 = acc[ai][bj][m][0] * sc, v1 = acc[ai][bj][m][1] * sc;
                    u32x4 w; w.x = pg8::cvt_pk_bf16(v0[0], v0[1]); w.y = pg8::cvt_pk_bf16(v0[2], v0[3]); w.z = pg8::cvt_pk_bf16(v1[0], v1[1]); w.w = pg8::cvt_pk_bf16(v1[2], v1[3]);
                    *(u32x4*)(O + row * 512 + col) = w; } }
        return false;
    }
};
__device__ __forceinline__ void phase_mprep2(ArgsRef a, int l, int tid, int bid, int G) {
    const bf16_t* Z = (const bf16_t*)(a.ws + OFF_Z); bf16_t* XC = (bf16_t*)(a.ws + OFF_XC);
    const float* cw = a.in[2] + (size_t)l * 4 * 512; const float* cb = a.in[3] + (size_t)l * 512;
    for (int idx = bid * 512 + tid; idx < (T / 8) * 64; idx += G * 512) {
        const int tb = (idx / 64) * 8, c0 = (idx % 64) * 8;
        bf16x8 xr[11];
#pragma unroll
        for (int k = 0; k < 11; ++k) { const int ts = tb - 3 + k; xr[k] = (ts >= 0) ? *(const bf16x8*)(Z + (size_t)ts * NZ + c0) : (bf16x8){0, 0, 0, 0, 0, 0, 0, 0}; }
        float w[4][8], b[8];
#pragma unroll
        for (int j = 0; j < 8; ++j) { b[j] = cb[c0 + j];
#pragma unroll
            for (int k = 0; k < 4; ++k) w[k][j] = cw[k * 512 + c0 + j]; }
#pragma unroll
        for (int tt = 0; tt < 8; ++tt) { float acc[8];
#pragma unroll
            for (int j = 0; j < 8; ++j) { acc[j] = b[j];
#pragma unroll
                for (int k = 0; k < 4; ++k) acc[j] += w[k][j] * bf2f((bf16_t)xr[tt + k][j]); }
            u32x4 o; o.x = pack2(siluf_(acc[0]), siluf_(acc[1])); o.y = pack2(siluf_(acc[2]), siluf_(acc[3])); o.z = pack2(siluf_(acc[4]), siluf_(acc[5])); o.w = pack2(siluf_(acc[6]), siluf_(acc[7]));
            *(u32x4*)(XC + (size_t)(tb + tt) * 512 + c0) = o; }
    }
}

__device__ __forceinline__ void phase_v_conv(ArgsRef a, int l, int tid, int bid, int G) {
    if (G > 128 && bid >= 128) { phase_mprep2(a, l, tid, bid - 128, G - 128); return; }
    { SchedGrid S{T / 256, 2, G, bid, (const char*)(a.ws + OFF_Z), (const char*)(a.ws + OFF_WQKV + (size_t)1024 * 512 * 2), (size_t)256 * NZ * 2, (size_t)256 * 512 * 2};
      EpiQKV E{1, (bf16_t*)(a.ws + OFF_Q), (bf16_t*)(a.ws + OFF_KH), (bf16_t*)(a.ws + OFF_V), (const float*)(a.ws + OFF_LI)};
      pg8::gemm_phase((PG8_LAS unsigned char*)smem, tid, 512, NZ, 512, S, E); }
    if (G <= 128) { asm volatile("" : "+v"(tid), "+s"(bid), "+s"(G)); phase_mprep2(a, l, tid, bid, G); }
}
__device__ __forceinline__ void phase_qk(ArgsRef a, int tid, int bid, int G) {
    SchedGrid S{T / 256, 4, G, bid, (const char*)(a.ws + OFF_XC), (const char*)(a.ws + OFF_WQKV), (size_t)256 * 512 * 2, (size_t)256 * 512 * 2};
    EpiQKV E{0, (bf16_t*)(a.ws + OFF_Q), (bf16_t*)(a.ws + OFF_KH), (bf16_t*)(a.ws + OFF_V), (const float*)(a.ws + OFF_LI)};
    pg8::gemm_phase((PG8_LAS unsigned char*)smem, tid, 512, 512, 512, S, E);
}
struct SchedMoE {
    int down, G, c; const unsigned char* ws; const unsigned* BASE;
    __device__ __forceinline__ bool next(int i, pg8::Unit& u) const { const int per = down ? 4 : 2, L = i * G + c, ntile = (int)(BASE[32] >> 8); if (L >= ntile * per) return false;
        const int tile = L / per, sub = L % per; const int e = (int)BASE[64 + tile];
        u.pm = tile; u.pn = sub; u.tag = e;
        if (!down) { u.A = (const char*)(ws + OFF_XG) + (size_t)tile * 256 * 1024 * 2; u.B = (const char*)(ws + OFF_WGU) + ((size_t)e * 512 + sub * 256) * 1024 * 2; }
        else { u.A = (const char*)(ws + OFF_H) + (size_t)tile * 256 * 256 * 2; u.B = (const char*)(ws + OFF_WD) + ((size_t)e * 1024 + sub * 256) * 256 * 2; }
        return true; }
};
struct EpiH {
    static constexpr bool PERM = true;
    bf16_t* H;
    __device__ __forceinline__ bool operator()(f32x4 (&acc)[2][2][4][2], const pg8::Unit& u, int wr, int wc, int fr, int fq) const {
#pragma unroll
        for (int ai = 0; ai < 2; ++ai)
#pragma unroll
            for (int m = 0; m < 4; ++m) { const size_t row = (size_t)u.pm * 256 + ai * 128 + wr * 64 + m * 16 + fr; f32x4 v0, v1;
#pragma unroll
                for (int j = 0; j < 4; ++j) { v0[j] = siluf_(acc[ai][0][m][0][j]) * acc[ai][1][m][0][j]; v1[j] = siluf_(acc[ai][0][m][1][j]) * acc[ai][1][m][1][j]; }
                u32x4 w; w.x = pg8::cvt_pk_bf16(v0[0], v0[1]); w.y = pg8::cvt_pk_bf16(v0[2], v0[3]); w.z = pg8::cvt_pk_bf16(v1[0], v1[1]); w.w = pg8::cvt_pk_bf16(v1[2], v1[3]);
                *(u32x4*)(H + row * 256 + u.pn * 128 + wc * 32 + 8 * fq) = w; }
        return false;
    }
};
__device__ __forceinline__ void phase_moe_gu2(ArgsRef a, int l, int tid, int bid, int G) {
    { SchedMoE S{0, G, bid, a.ws, (const unsigned*)(a.ws + OFF_CTL) + 64}; EpiH E{(bf16_t*)(a.ws + OFF_H)};
      pg8::gemm_phase((PG8_LAS unsigned char*)smem, tid, 1024, 1024, 1024, S, E); }
    if (l + 1 < NLAYER) {
        asm volatile("" : "+v"(tid), "+s"(bid), "+s"(G));
        const int ntile = (int)(((const unsigned*)(a.ws + OFF_CTL))[64 + 32] >> 8); int nb = ntile * 2 - G; nb = nb < 0 ? 0 : (nb > G - 1 ? G - 1 : nb);
        if (bid >= nb) phase_prep(a, l + 1, tid, bid - nb, G - nb);
    }
}
__device__ __forceinline__ void phase_moe_dn2(ArgsRef a, int tid, int bid, int G) {
    SchedMoE S{1, G, bid, a.ws, (const unsigned*)(a.ws + OFF_CTL) + 64}; EpiBf16<0> E{(bf16_t*)(a.ws + OFF_YS), 1024, nullptr, 0};
    pg8::gemm_phase((PG8_LAS unsigned char*)smem, tid, 256, 256, 256, S, E);
}
#define XB_TMO      128
#define XB_XCNT(j)  (256  + 64 * (j))
#define XB_XSUB(j)  (1280 + 64 * (j))
#define XB_XGEN(j)  (2304 + 64 * (j))
#define XB_TOP      3328
#define XB_TOPGEN   3392
#define XCD_BAR_WORDS 3456
#define XB_SPIN_CAP (1u << 22)
__device__ __forceinline__ unsigned xb_ld(unsigned* p)              { return __hip_atomic_load(p, __ATOMIC_RELAXED, __HIP_MEMORY_SCOPE_AGENT); }
__device__ __forceinline__ unsigned xb_add(unsigned* p, unsigned v) { return __hip_atomic_fetch_add(p, v, __ATOMIC_RELAXED, __HIP_MEMORY_SCOPE_AGENT); }
__device__ __forceinline__ unsigned xb_xcc_id() { return (unsigned)__builtin_amdgcn_s_getreg((3 << 11) | 20) & 0xFu; }
#define XB_SPIN(cond, bar) do { unsigned _sp = 0; while (cond) { __builtin_amdgcn_s_sleep(1); \
    if ((++_sp & 255u) == 0u) { if (xb_ld(&(bar)[XB_TMO])) break; if (_sp > XB_SPIN_CAP) { atomicAdd(&(bar)[XB_TMO], 1u); break; } } } } while (0)
__device__ __forceinline__ void xcd_barrier_complete(unsigned* bar, unsigned x, unsigned& nloc, unsigned& nx) {
    const unsigned G = gridDim.x; unsigned sum, cnt, mine, sp = 0u;
    for (;;) { sum = 0u; cnt = 0u; mine = 0u;
#pragma unroll
        for (unsigned j = 0; j < 16; ++j) { const unsigned c = xb_ld(&bar[XB_XCNT(j)]); sum += c; cnt += (c > 0u) ? 1u : 0u; mine = (j == x) ? c : mine; }
        if (sum == G) break;
        __builtin_amdgcn_s_sleep(1);
        if ((++sp & 255u) == 0u) { if (xb_ld(&bar[XB_TMO])) break; if (sp > XB_SPIN_CAP) { atomicAdd(&bar[XB_TMO], 1u); break; } } }
    nloc = mine > 0u ? mine : 1u; nx = cnt > 0u ? cnt : 1u;
}
__device__ __forceinline__ void xcd_barrier(unsigned* bar, volatile __attribute__((address_space(3))) unsigned* st) {
    asm volatile("s_waitcnt vmcnt(0)" ::: "memory");
    __syncthreads();
    if (threadIdx.x == 0) {
        __builtin_amdgcn_s_waitcnt(0);
        const unsigned x = xb_xcc_id();
        unsigned nloc = st[0], nx = st[1];
        if (nloc == 0u) { xcd_barrier_complete(bar, x, nloc, nx); st[0] = nloc; st[1] = nx; }
        const unsigned old = xb_add(&bar[XB_XSUB(x)], 1u);
        const unsigned gen = old / nloc;
        if (old + 1u == (gen + 1u) * nloc) {
            __builtin_amdgcn_fence(__ATOMIC_RELEASE, "agent");
            asm volatile("s_waitcnt vmcnt(0)" ::: "memory");
            const unsigned og = xb_add(&bar[XB_TOP], 1u);
            const unsigned tg = og / nx;
            if (og + 1u == (tg + 1u) * nx) xb_add(&bar[XB_TOPGEN], 1u);
            else XB_SPIN(xb_ld(&bar[XB_TOPGEN]) == tg, bar);
            __builtin_amdgcn_fence(__ATOMIC_ACQUIRE, "agent");
            xb_add(&bar[XB_XGEN(x)], 1u);
            asm volatile("s_waitcnt vmcnt(0)" ::: "memory");
        } else {
            XB_SPIN(xb_ld(&bar[XB_XGEN(x)]) == gen, bar);
            __builtin_amdgcn_fence(__ATOMIC_ACQUIRE, "agent");
            asm volatile("s_waitcnt vmcnt(0)" ::: "memory");
        }
    }
    __syncthreads();
}

__device__ __forceinline__ ArgsRef fresh_args() { unsigned long long p = (unsigned long long)__builtin_amdgcn_kernarg_segment_ptr(); asm volatile("" : "+s"(p)); return *(const __attribute__((address_space(4))) Args*)p; }
__global__ void __launch_bounds__(512) fwd(Args a_unused) {
    cg::grid_group grid = cg::this_grid();
    volatile __attribute__((address_space(3))) unsigned* bst = (volatile __attribute__((address_space(3))) unsigned*)((__attribute__((address_space(3))) unsigned char*)smem + 131072);
    if (threadIdx.x < 4) bst[threadIdx.x] = 0u;
    __syncthreads();
    { ArgsRef a0 = fresh_args(); if (threadIdx.x == 0) (void)xb_add(&((unsigned*)(a0.ws + OFF_BAR))[XB_XCNT(xb_xcc_id())], 1u); }
#define GSYNC() do { asm volatile("" ::: "memory"); { ArgsRef ab = fresh_args(); xcd_barrier((unsigned*)(ab.ws + OFF_BAR), bst); } asm volatile("" ::: "memory"); } while (0)
#define GSYNC_CG() do { asm volatile("" ::: "memory"); grid.sync(); asm volatile("" ::: "memory"); } while (0)
    const int wave_s = __builtin_amdgcn_readfirstlane((int)threadIdx.x >> 6);
#define PH(body) do { int wave = wave_s; asm volatile("" : "+s"(wave)); int lane; asm volatile("v_mbcnt_lo_u32_b32 %0, -1, 0\n\tv_mbcnt_hi_u32_b32 %0, -1, %0" : "=v"(lane)); \
        int bid = blockIdx.x, G = gridDim.x; asm volatile("" : "+s"(bid), "+s"(G)); \
        const int tid = wave * 64 + lane, gw = bid * 8 + wave, GW = G * 8; (void)tid; (void)gw; (void)GW; ArgsRef a = fresh_args(); body; } while (0)
#pragma unroll 1
    for (int l = 0; l < NLAYER; ++l) {
        if (l == 0) { PH(phase_prep(a, 0, tid, bid, G)); GSYNC_CG(); }
        PH(phase_zgemm2(a, l, tid, bid, G)); GSYNC();
        PH(phase_v_conv(a, l, tid, bid, G)); GSYNC();
        PH(phase_qk(a, tid, bid, G)); GSYNC();
        PH(phase_mixers<1>(a, l, tid, lane, wave, bid, G)); GSYNC();
        PH(phase_scan(a, tid, bid, G)); GSYNC();
        PH(phase_mixers<2>(a, l, tid, lane, wave, bid, G)); GSYNC();
        PH(phase_glu_gates(a, l, tid, bid, G)); GSYNC();
        PH(phase_merge2(a, tid, bid, G)); GSYNC();
        PH(phase_wout2(a, l, tid, bid, G)); GSYNC();
        PH(phase_ln1r(a, l, tid, lane, wave, bid, G)); PH(if (G < 256) phase_prepx(a, l, tid, bid, G, 896, 6144)); GSYNC();
        PH(phase_slot(a, tid, lane, wave, bid, G)); GSYNC();
        PH(phase_moe_gu2(a, l, tid, bid, G)); GSYNC();
        PH(phase_moe_dn2(a, tid, bid, G)); GSYNC();
        PH(phase_ln2(a, l, lane, gw, GW)); if (l + 1 < NLAYER) GSYNC();
    }
}

extern "C" void kernel_launch(void* const* d_in, const int* in_sizes, int n_in, void* d_out, int out_size, void* d_ws, size_t ws_size, hipStream_t stream) {
    static int grid = 0;
    if (grid == 0) {
        if (n_in != 34 || out_size != T * D || ws_size < WS_TOTAL) { fprintf(stderr, "kernel_launch: unexpected shapes (n_in %d, out %d, ws %zu, need %zu)\n", n_in, out_size, ws_size, (size_t)WS_TOTAL); grid = -1; return; }
        int dev = 0, cus = 0, per_cu = 0;
        (void)hipGetDevice(&dev); (void)hipDeviceGetAttribute(&cus, hipDeviceAttributeMultiprocessorCount, dev);
        (void)hipFuncSetAttribute((const void*)fwd, hipFuncAttributeMaxDynamicSharedMemorySize, LDS_BYTES);
        (void)hipOccupancyMaxActiveBlocksPerMultiprocessor(&per_cu, (const void*)fwd, 512, LDS_BYTES);
        if (per_cu < 1) { fprintf(stderr, "kernel_launch: occupancy query says %d blocks per CU\n", per_cu); per_cu = 1; }
        grid = (cus > 0 ? cus : 256) * 1;
        (void)hipGetLastError();
    }
    if (grid < 0) return;
    Args a{};
    for (int i = 0; i < 34; ++i) a.in[i] = (const float*)d_in[i];
    a.out = (float*)d_out; a.ws = (unsigned char*)d_ws; a.ph_lo = 0; a.ph_hi = NLAYER * NPH;
    (void)hipMemsetAsync((unsigned char*)d_ws + OFF_BAR, 0, 16384, stream);
    void* args[] = {&a};
    hipError_t e = hipLaunchCooperativeKernel((const void*)fwd, dim3(grid), dim3(512), args, LDS_BYTES, stream);
    if (e != hipSuccess) fprintf(stderr, "kernel_launch: cooperative launch failed: %s (grid %d)\n", hipGetErrorString(e), grid);
}
```

```cpp
#include <hip/hip_runtime.h>
#include <hip/hip_cooperative_groups.h>
#include <cstdio>
#include <cstdint>
namespace cg = cooperative_groups;

typedef unsigned short bf16_t;
typedef short bf16x8 __attribute__((ext_vector_type(8)));
typedef short bf16x4 __attribute__((ext_vector_type(4)));
typedef float f32x4 __attribute__((ext_vector_type(4)));
typedef unsigned u32x4 __attribute__((ext_vector_type(4)));
typedef unsigned u32x2 __attribute__((ext_vector_type(2)));

constexpr int T = 16384, D = 1024, NZ = 3584, NWIN = 6912, INW = 6664;
constexpr int NPH = 15, NLAYER = 2;
constexpr int GSEG = 32, GSEGLEN = 512;
constexpr int SSEG = 64, SSEGLEN = 256;
constexpr int SLOTS = 40960;
constexpr float DN_ALPHA = 1.41421356237f;
constexpr int LDS_BYTES = 131072 + 256;

constexpr size_t AL(size_t x) { return (x + 255) & ~(size_t)255; }
constexpr size_t OFF_WIN = 0;
constexpr size_t OFF_WQKV = OFF_WIN + AL((size_t)NWIN * 1024 * 2);
constexpr size_t OFF_WGLU = OFF_WQKV + AL((size_t)1536 * 512 * 2);
constexpr size_t OFF_WB = OFF_WGLU + AL((size_t)512 * 512 * 2);
constexpr size_t OFF_WOUT = OFF_WB + AL((size_t)3 * 1024 * 512 * 2);
constexpr size_t OFF_ABAR = OFF_WOUT + AL((size_t)1024 * 1024 * 2);
constexpr size_t OFF_BBT = OFF_ABAR + AL((size_t)32 * 64 * 2 * 4);
constexpr size_t OFF_CCT = OFF_BBT + AL((size_t)32 * 128 * 16 * 2);
constexpr size_t OFF_CTL = OFF_CCT + AL((size_t)32 * 16 * 128 * 2);
constexpr size_t OFF_TOKE = OFF_CTL + 4096;
constexpr size_t OFF_TOKG = OFF_TOKE + AL((size_t)T * 2 * 4);
constexpr size_t OFF_TOKS = OFF_TOKG + AL((size_t)T * 2 * 4);
constexpr size_t OFF_SLOTT = OFF_TOKS + AL((size_t)T * 2 * 4);
constexpr size_t OFF_XB = OFF_SLOTT + AL((size_t)SLOTS * 4);
constexpr size_t OFF_R1 = OFF_XB + AL((size_t)T * 1024 * 2);
constexpr size_t SZ_ACT = (size_t)T * 512 * 2;
constexpr size_t OFF_XC = OFF_R1, OFF_Q = OFF_R1 + SZ_ACT, OFF_KH = OFF_R1 + 2 * SZ_ACT, OFF_V = OFF_R1 + 3 * SZ_ACT;
constexpr size_t OFF_WGU = OFF_R1, OFF_WD = OFF_R1 + (size_t)32 * 512 * 1024 * 2;
constexpr size_t OFF_Z = OFF_R1 + 4 * SZ_ACT;
constexpr size_t OFF_XG = OFF_Z, OFF_H = OFF_Z + (size_t)SLOTS * 1024 * 2;
constexpr size_t OFF_ZS = OFF_Z + AL((size_t)T * NZ * 2);
constexpr size_t OFF_LF = OFF_ZS + AL((size_t)T * 8 * 4);
constexpr size_t OFF_LI = OFF_LF + AL((size_t)T * 4 * 4);
constexpr size_t OFF_E = OFF_LI + AL((size_t)T * 4 * 4);
constexpr size_t OFF_OM = OFF_E, OFF_OH = OFF_E + SZ_ACT, OFF_YPRE = OFF_E + 2 * SZ_ACT, OFF_YSG = OFF_E + 3 * SZ_ACT;
constexpr size_t OFF_DEN = OFF_E + 4 * SZ_ACT;
constexpr size_t OFF_EM = OFF_DEN + AL((size_t)T * 4 * 4);
constexpr size_t OFF_EMX = OFF_EM + AL((size_t)GSEG * 4 * 128 * 128 * 4);
constexpr size_t OFF_GM = OFF_EMX + AL((size_t)GSEG * 4 * 128 * 16 * 4);
constexpr size_t OFF_EH = OFF_GM + AL((size_t)GSEG * 4 * 128 * 4);
constexpr size_t OFF_GH = OFF_EH + AL((size_t)GSEG * 4 * 128 * 128 * 4);
constexpr size_t OFF_ES = OFF_GH + AL((size_t)GSEG * 4 * 128 * 4);
constexpr size_t WS_END = OFF_ES + AL((size_t)SSEG * 32 * 64 * 2 * 4);
constexpr size_t OFF_YS = OFF_E;
constexpr size_t OFF_RWT = WS_END;
constexpr size_t OFF_HIST = OFF_RWT + 32 * 1024 * 4;
constexpr size_t OFF_BAR = OFF_HIST + 1024 * 32 * 4;
constexpr size_t WS_TOTAL = OFF_BAR + 16384;
static_assert(OFF_YS + (size_t)SLOTS * 1024 * 2 <= WS_END, "YS must fit in the dead region");
static_assert(OFF_H + (size_t)SLOTS * 256 * 2 <= OFF_ZS, "H must fit in the dead Z region");
static_assert(OFF_WD + (size_t)32 * 1024 * 256 * 2 <= OFF_Z, "expert weights must fit in R1");

struct Args { const float* in[34]; float* out; unsigned char* ws; int ph_lo, ph_hi; };
typedef const __attribute__((address_space(4))) Args& ArgsRef;

extern __shared__ __attribute__((aligned(16))) unsigned char smem[];

__device__ __forceinline__ bf16_t f2bf(float f) { return __builtin_bit_cast(unsigned short, (__bf16)f); }
__device__ __forceinline__ float bf2f(bf16_t b) { return __uint_as_float(((unsigned)b) << 16); }
__device__ __forceinline__ unsigned pack2(float lo, float hi) { typedef __bf16 bf2_t __attribute__((ext_vector_type(2))); bf2_t v; v[0] = (__bf16)lo; v[1] = (__bf16)hi; return __builtin_bit_cast(unsigned, v); }
__device__ __forceinline__ float fexp(float x) { return __builtin_amdgcn_exp2f(x * 1.4426950408889634f); }
__device__ __forceinline__ float flog(float x) { return __builtin_amdgcn_logf(x) * 0.6931471805599453f; }
__device__ __forceinline__ float sigmoidf_(float x) { return __builtin_amdgcn_rcpf(1.0f + fexp(-x)); }
__device__ __forceinline__ float siluf_(float x) { return x * __builtin_amdgcn_rcpf(1.0f + fexp(-x)); }
__device__ __forceinline__ float logsigmoidf_(float x) { return fminf(x, 0.f) - log1pf(expf(-fabsf(x))); }
__device__ __forceinline__ float gelu_tanh(float y) { const float z = 0.7978845608028654f * (y + 0.044715f * y * y * y); const float th = 1.0f - 2.0f * __builtin_amdgcn_rcpf(fexp(2.0f * z) + 1.0f); return 0.5f * y * (1.0f + th); }
__device__ __forceinline__ void wave_sync() { __builtin_amdgcn_wave_barrier(); asm volatile("s_waitcnt lgkmcnt(0)" ::: "memory"); __builtin_amdgcn_wave_barrier(); }

#define MFMA16(a, b, c) __builtin_amdgcn_mfma_f32_16x16x32_bf16((a), (b), (c), 0, 0, 0)

namespace pg8 {
#define PG8_LAS __attribute__((address_space(3)))
constexpr int BM = 256, BK = 64, HALF = 128, HTB = HALF * BK * 2, STAGE_BYTES = 8 * HTB;
__device__ __forceinline__ int lds_byte(int r, int c) { const int st = (r >> 4) * 2 + (c >> 5), rr = r & 15, cc = c & 31, ob = rr * 64 + cc * 2; return st * 1024 + (ob ^ (((ob >> 9) & 1) << 5)); }
__device__ __forceinline__ void stage_rc(int b, int& R, int& C) { const int st = b / 1024, sb = b % 1024, swz = sb ^ (((sb >> 9) & 1) << 5); R = (st >> 1) * 16 + swz / 64; C = (st & 1) * 32 + (swz % 64) / 2; }
__device__ __forceinline__ int perm32(int rho) { const int n = rho >> 4, i = rho & 15; return 8 * (i >> 2) + 4 * n + (i & 3); }
struct Unit { int pm, pn, tag; const char* A; const char* B; };
__device__ __forceinline__ unsigned cvt_pk_bf16(float lo, float hi) { unsigned r; asm volatile("v_cvt_pk_bf16_f32 %0, %1, %2" : "=v"(r) : "v"(lo), "v"(hi)); return r; }
__device__ __forceinline__ bool tile_order(int L, int nM, int nN, int& pm, int& pn) {
    const int nwg = nM * nN; if (L >= nwg) return false;
    int wgid = L; { const int q = nwg / 8, r = nwg % 8, xcd = wgid % 8, off = wgid / 8; wgid = (xcd < r ? xcd * (q + 1) : r * (q + 1) + (xcd - r) * q) + off; }
    const int nig = 8 * nN, gid = wgid / nig, fm = gid * 8, gsz = (nM - fm) < 8 ? (nM - fm) : 8;
    pm = fm + ((wgid % nig) % gsz); pn = (wgid % nig) / gsz; return true;
}
template <class Epi, class Sched>
__device__ __forceinline__ void gemm_phase(PG8_LAS unsigned char* lds, const int tid, const int K, const int lda, const int ldb, const Sched& S, const Epi& E) {
    const int wid = __builtin_amdgcn_readfirstlane(tid >> 6), lane = tid & 63, wr = wid >> 2, wc = wid & 3, fr = lane & 15, fq = lane >> 4;
    const int nt = K / BK;
    unsigned voffA[2], voffB[2];
#pragma unroll
    for (int i = 0; i < 2; ++i) { int R, C; stage_rc(tid * 16 + i * 8192, R, C); const int Rb = Epi::PERM ? ((R & ~31) + perm32(R & 31)) : R;
        voffA[i] = (unsigned)(R * lda + C) * 2u; voffB[i] = (unsigned)(Rb * ldb + C) * 2u; }
    const size_t kstep = (size_t)(BK * 2), hstepA = (size_t)HALF * lda * 2, hstepB = (size_t)HALF * ldb * 2;
    const unsigned ldsw = (unsigned)wid * 1024u;
    const int aoff = lds_byte(wr * 64 + fr, fq * 8), boff = lds_byte(wc * 32 + fr, fq * 8);
#define PG8_SA(b, h) (((b) * 2 + (h)) * HTB)
#define PG8_SB(b, h) ((4 + (b) * 2 + (h)) * HTB)
#define PG8_STAGE(bufoff, gbase, voff) do { _Pragma("unroll") for (int _i = 0; _i < 2; ++_i) \
        __builtin_amdgcn_global_load_lds((const unsigned*)((const char*)(gbase) + (voff)[_i]), (PG8_LAS unsigned*)(lds + (bufoff) + ldsw + _i * 8192), 16, 0, 0); } while (0)
#define PG8_LDA(dst, b, h) do { _Pragma("unroll") for (int m = 0; m < 4; ++m) _Pragma("unroll") for (int k = 0; k < 2; ++k) dst[m][k] = *(const PG8_LAS bf16x8*)(lds + PG8_SA(b, h) + aoff + m * 2048 + k * 1024); } while (0)
#define PG8_LDB(dst, b, h) do { _Pragma("unroll") for (int n = 0; n < 2; ++n) _Pragma("unroll") for (int k = 0; k < 2; ++k) dst[n][k] = *(const PG8_LAS bf16x8*)(lds + PG8_SB(b, h) + boff + n * 2048 + k * 1024); } while (0)
#define PG8_MMA(ai, bj, At, Bt) do { __builtin_amdgcn_s_setprio(1); _Pragma("unroll") for (int m = 0; m < 4; ++m) _Pragma("unroll") for (int n = 0; n < 2; ++n) _Pragma("unroll") for (int k = 0; k < 2; ++k) \
        acc[ai][bj][m][n] = __builtin_amdgcn_mfma_f32_16x16x32_bf16(Bt[n][k], At[m][k], acc[ai][bj][m][n], 0, 0, 0); __builtin_amdgcn_s_setprio(0); } while (0)
#define PG8_WAIT_V(n) asm volatile("s_waitcnt vmcnt(" #n ")" ::: "memory")
#define PG8_WAIT_L(n) asm volatile("s_waitcnt lgkmcnt(" #n ")" ::: "memory")
#define PG8_BAR __builtin_amdgcn_s_barrier()
#define PG8_SCHED __builtin_amdgcn_sched_barrier(0)
    Unit cur, nxt; int ui = 0;
    if (!S.next(0, cur)) return;
    f32x4 acc[2][2][4][2];
#pragma unroll
    for (int a = 0; a < 2; ++a)
#pragma unroll
        for (int b = 0; b < 2; ++b)
#pragma unroll
            for (int m = 0; m < 4; ++m)
#pragma unroll
                for (int n = 0; n < 2; ++n) acc[a][b][m][n] = (f32x4){0.f, 0.f, 0.f, 0.f};
    bf16x8 At[4][2], B0[2][2], B1[2][2];
    const char* cA = cur.A; const char* cB = cur.B;
    PG8_STAGE(PG8_SB(0, 0), cB, voffB); PG8_STAGE(PG8_SA(0, 0), cA, voffA); PG8_STAGE(PG8_SB(0, 1), cB + hstepB, voffB); PG8_STAGE(PG8_SA(0, 1), cA + hstepA, voffA);
    if (wr == 1) PG8_BAR;
    PG8_WAIT_V(4); PG8_BAR;
    PG8_STAGE(PG8_SB(1, 0), cB + kstep, voffB); PG8_STAGE(PG8_SA(1, 0), cA + kstep, voffA); PG8_STAGE(PG8_SB(1, 1), cB + hstepB + kstep, voffB);
    PG8_WAIT_V(6); PG8_BAR;
    for (;;) {
        const bool has_next = S.next(ui + 1, nxt);
        const char* nA = has_next ? nxt.A : cA; const char* nB = has_next ? nxt.B : cB;
        for (int t = 0; t < nt; t += 2) {
            const bool last = (t == nt - 2);
            const char* a1 = cA + (size_t)(t + 1) * kstep;
            const char* a2 = last ? nA : cA + (size_t)(t + 2) * kstep; const char* b2 = last ? nB : cB + (size_t)(t + 2) * kstep;
            const char* a3 = a2 + kstep; const char* b3 = b2 + kstep;
            PG8_LDB(B0, 0, 0); PG8_SCHED; PG8_LDA(At, 0, 0); PG8_STAGE(PG8_SA(1, 1), a1 + hstepA, voffA);
            PG8_WAIT_L(8); PG8_BAR; PG8_WAIT_L(0); PG8_MMA(0, 0, At, B0); PG8_BAR; PG8_SCHED;
            PG8_LDB(B1, 0, 1); PG8_STAGE(PG8_SB(0, 0), b2, voffB);
            PG8_BAR; PG8_WAIT_L(0); PG8_MMA(0, 1, At, B1); PG8_BAR;
            PG8_LDA(At, 0, 1); PG8_STAGE(PG8_SA(0, 0), a2, voffA);
            PG8_BAR; PG8_WAIT_L(0); PG8_MMA(1, 0, At, B0); PG8_BAR; PG8_SCHED;
            PG8_STAGE(PG8_SB(0, 1), b2 + hstepB, voffB);
            PG8_WAIT_V(6); PG8_BAR; PG8_MMA(1, 1, At, B1); PG8_BAR;
            PG8_LDB(B0, 1, 0); PG8_SCHED; PG8_LDA(At, 1, 0); PG8_STAGE(PG8_SA(0, 1), a2 + hstepA, voffA);
            PG8_WAIT_L(8); PG8_BAR; PG8_WAIT_L(0); PG8_MMA(0, 0, At, B0); PG8_BAR; PG8_SCHED;
            PG8_LDB(B1, 1, 1); PG8_STAGE(PG8_SB(1, 0), b3, voffB);
            PG8_BAR; PG8_WAIT_L(0); PG8_MMA(0, 1, At, B1); PG8_BAR;
            PG8_LDA(At, 1, 1); PG8_STAGE(PG8_SA(1, 0), a3, voffA);
            PG8_BAR; PG8_WAIT_L(0); PG8_MMA(1, 0, At, B0); PG8_BAR; PG8_SCHED;
            PG8_STAGE(PG8_SB(1, 1), b3 + hstepB, voffB);
            PG8_WAIT_V(6); PG8_BAR; PG8_MMA(1, 1, At, B1); PG8_BAR;
        }
        const bool keep = E(acc, cur, wr, wc, fr, fq);
        if (!has_next) break;
        if (!keep) {
#pragma unroll
            for (int a = 0; a < 2; ++a)
#pragma unroll
                for (int b = 0; b < 2; ++b)
#pragma unroll
                    for (int m = 0; m < 4; ++m)
#pragma unroll
                        for (int n = 0; n < 2; ++n) acc[a][b][m][n] = (f32x4){0.f, 0.f, 0.f, 0.f};
        }
        cur = nxt; cA = nA; cB = nB; ++ui;
    }
    PG8_WAIT_V(0);
    if (wr == 0) PG8_BAR;
    PG8_BAR;
#undef PG8_SA
#undef PG8_SB
#undef PG8_STAGE
#undef PG8_LDA
#undef PG8_LDB
#undef PG8_MMA
#undef PG8_WAIT_V
#undef PG8_WAIT_L
#undef PG8_BAR
#undef PG8_SCHED
}
}

__device__ __forceinline__ void tconv_tile(const float* src, int ld_src, int nvalid, bf16_t* dst, int ld_dst, int tid) {
    float* t = (float*)smem;
    { const int r = tid >> 3, c0 = (tid & 7) * 8; float v[8];
      if (nvalid == 64) { const f32x4 a0 = *(const f32x4*)(src + (size_t)r * ld_src + c0), a1 = *(const f32x4*)(src + (size_t)r * ld_src + c0 + 4);
          v[0] = a0[0]; v[1] = a0[1]; v[2] = a0[2]; v[3] = a0[3]; v[4] = a1[0]; v[5] = a1[1]; v[6] = a1[2]; v[7] = a1[3]; }
      else {
#pragma unroll
          for (int j = 0; j < 8; ++j) { const int c = c0 + j; v[j] = (c < nvalid) ? src[(size_t)r * ld_src + c] : 0.f; } }
#pragma unroll
      for (int j = 0; j < 8; ++j) t[(c0 + j) * 65 + r] = v[j]; }
    __syncthreads();
    { const int n = tid >> 3, k0 = (tid & 7) * 8; const float* p = t + n * 65 + k0;
      u32x4 w; w.x = pack2(p[0], p[1]); w.y = pack2(p[2], p[3]); w.z = pack2(p[4], p[5]); w.w = pack2(p[6], p[7]);
      *(u32x4*)(dst + (size_t)n * ld_dst + k0) = w; }
    __syncthreads();
}

__device__ __forceinline__ void wave_tconv(const float* src, int ld_src, bf16_t* dst, int ld_dst, int lane, float* t  ) {
    f32x4 v[16]; const int rq = lane >> 4, c4 = (lane & 15) * 4;
#pragma unroll
    for (int i = 0; i < 16; ++i) v[i] = *(const f32x4*)(src + (size_t)(4 * i + rq) * ld_src + c4);
#pragma unroll
    for (int i = 0; i < 16; ++i)
#pragma unroll
        for (int j = 0; j < 4; ++j) t[(c4 + j) * 65 + 4 * i + rq] = v[i][j];
    wave_sync();
    const int rr = lane >> 3, k8 = (lane & 7) * 8;
#pragma unroll
    for (int i = 0; i < 8; ++i) { const float* p = t + (8 * i + rr) * 65 + k8;
        u32x4 w; w.x = pack2(p[0], p[1]); w.y = pack2(p[2], p[3]); w.z = pack2(p[4], p[5]); w.w = pack2(p[6], p[7]);
        *(u32x4*)(dst + (size_t)(8 * i + rr) * ld_dst + k8) = w; }
    wave_sync();
}
__device__ __forceinline__ void wave_prepx_tile(ArgsRef a, int l, int u, int lane, float* t) {
    bf16_t* WGU = (bf16_t*)(a.ws + OFF_WGU); bf16_t* WD = (bf16_t*)(a.ws + OFF_WD);
    if (u < 4096) { const int up = u >= 2048, v = u & 2047, e = v / 64, w = v % 64, nt = w / 16, kt = w % 16, j0 = nt * 64, drow = (j0 / 128) * 256 + (j0 % 128) + up * 128;
        wave_tconv(a.in[31 + up] + ((size_t)(l * 32 + e) * 1024 + kt * 64) * 256 + nt * 64, 256, WGU + ((size_t)e * 512 + drow) * 1024 + kt * 64, 1024, lane, t); }
    else { const int v = u - 4096, e = v / 64, w = v % 64, nt = w / 4, kt = w % 4;
        wave_tconv(a.in[33] + ((size_t)(l * 32 + e) * 256 + kt * 64) * 1024 + nt * 64, 1024, WD + ((size_t)e * 1024 + nt * 64) * 256 + kt * 64, 256, lane, t); }
}
__device__ __forceinline__ void phase_prep(ArgsRef a, int l, int tid, int bid, int G) {
    unsigned char* ws = a.ws;
    bf16_t* WIN = (bf16_t*)(ws + OFF_WIN); bf16_t* WQKV = (bf16_t*)(ws + OFF_WQKV); bf16_t* WGLU = (bf16_t*)(ws + OFF_WGLU);
    bf16_t* WB = (bf16_t*)(ws + OFF_WB); bf16_t* WOUT = (bf16_t*)(ws + OFF_WOUT);
    for (int u = bid; u < 2624; u += G) {
        const float* src; int lds_ = 0, nvalid = 64, ldd = 0; bf16_t* dst;
        if (u < 1728) { const int nt = u / 16, kt = u % 16, p0 = nt * 64; int sc;
            if (p0 < 1024) sc = p0; else if (p0 < 6656) sc = p0 + 8; else if (p0 == 6656) { sc = 1024; nvalid = 8; } else { sc = 0; nvalid = 0; }
            src = a.in[1] + (size_t)l * 1024 * INW + (size_t)(kt * 64) * INW + sc; lds_ = INW; dst = WIN + (size_t)p0 * 1024 + kt * 64; ldd = 1024; }
        else if (u < 1920) { const int v = u - 1728, nt = v / 8, kt = v % 8, which = nt / 8, h = (nt % 8) / 2;
            if ((kt >> 1) != h) nvalid = 0;
            src = a.in[4 + which] + (size_t)(l * 4 + h) * 128 * 128 + ((kt & 1) * 64) * 128 + (nt & 1) * 64; lds_ = 128; dst = WQKV + (size_t)(nt * 64) * 512 + kt * 64; ldd = 512; }
        else if (u < 1984) { const int v = u - 1920, nt = v / 8, kt = v % 8;
            src = a.in[18] + (size_t)l * 512 * 512 + (kt * 64) * 512 + nt * 64; lds_ = 512; dst = WGLU + (size_t)(nt * 64) * 512 + kt * 64; ldd = 512; }
        else if (u < 2368) { const int v = u - 1984, b = v / 128, w = v % 128, nt = w / 8, kt = w % 8;
            src = a.in[21 + b] + (size_t)l * 512 * 1024 + (size_t)(kt * 64) * 1024 + nt * 64; lds_ = 1024; dst = WB + (size_t)b * 1024 * 512 + (size_t)(nt * 64) * 512 + kt * 64; ldd = 512; }
        else { const int v = u - 2368, nt = v / 16, kt = v % 16;
            src = a.in[24] + (size_t)l * 1024 * 1024 + (size_t)(kt * 64) * 1024 + nt * 64; lds_ = 1024; dst = WOUT + (size_t)(nt * 64) * 1024 + kt * 64; ldd = 1024; }
        tconv_tile(src, lds_, nvalid, dst, ldd, tid);
    }
    float* ABAR = (float*)(ws + OFF_ABAR); bf16_t* BBT = (bf16_t*)(ws + OFF_BBT); bf16_t* CCT = (bf16_t*)(ws + OFF_CCT);
    for (int i = bid * 512 + tid; i < 2048; i += G * 512) {
        const int g = i / 64, p = i % 64; const size_t gp = (size_t)(l * 32 + g) * 64 + p;
        const float lr = fminf(a.in[10][gp], -1e-4f), li = a.in[11][gp], dt = expf(a.in[12][l * 32 + g]);
        const float mag = expf(lr * dt), abr = mag * cosf(li * dt), abi = mag * sinf(li * dt);
        const float nr = abr - 1.0f, den = lr * lr + li * li, cr = (nr * lr + abi * li) / den, ci = (abi * lr - nr * li) / den;
        ABAR[(g * 64 + p) * 2] = abr; ABAR[(g * 64 + p) * 2 + 1] = abi;
        for (int c = 0; c < 16; ++c) { const float br = a.in[13][gp * 16 + c], bi = a.in[14][gp * 16 + c];
            BBT[(size_t)(g * 128 + p) * 16 + c] = f2bf(cr * br - ci * bi); BBT[(size_t)(g * 128 + 64 + p) * 16 + c] = f2bf(cr * bi + ci * br);
            const size_t ci_ = ((size_t)(l * 32 + g) * 16 + c) * 64 + p;
            CCT[(size_t)(g * 16 + c) * 128 + p] = f2bf(a.in[15][ci_]); CCT[(size_t)(g * 16 + c) * 128 + 64 + p] = f2bf(-a.in[16][ci_]); }
    }
    if (l == 0) { float* RWT = (float*)(ws + OFF_RWT); const float* RW = a.in[29]; for (int i = bid * 512 + tid; i < 32 * 1024; i += G * 512) RWT[i] = RW[(i & 1023) * 32 + (i >> 10)]; }
    if (l == 0) { bf16_t* XB = (bf16_t*)(ws + OFF_XB); const float* x = a.in[0];
        for (size_t i = (size_t)bid * 512 + tid; i < (size_t)T * 1024 / 8; i += (size_t)G * 512) {
            const f32x4 v0 = *(const f32x4*)(x + i * 8), v1 = *(const f32x4*)(x + i * 8 + 4);
            u32x4 w; w.x = pack2(v0[0], v0[1]); w.y = pack2(v0[2], v0[3]); w.z = pack2(v1[0], v1[1]); w.w = pack2(v1[2], v1[3]); *(u32x4*)(XB + i * 8) = w; } }
}

__device__ __forceinline__ void phase_prepx(ArgsRef a, int l, int tid, int bid, int G, int u_lo, int u_hi) {
    bf16_t* WGU = (bf16_t*)(a.ws + OFF_WGU); bf16_t* WD = (bf16_t*)(a.ws + OFF_WD);
    for (int u = u_lo + bid; u < u_hi; u += G) {
        const float* src; int lds_, ldd; bf16_t* dst;
        if (u < 4096) { const int up = u >= 2048, v = u & 2047, e = v / 64, w = v % 64, nt = w / 16, kt = w % 16, j0 = nt * 64, drow = (j0 / 128) * 256 + (j0 % 128) + up * 128;
            src = a.in[31 + up] + ((size_t)(l * 32 + e) * 1024 + kt * 64) * 256 + nt * 64; lds_ = 256; dst = WGU + ((size_t)e * 512 + drow) * 1024 + kt * 64; ldd = 1024; }
        else { const int v = u - 4096, e = v / 64, w = v % 64, nt = w / 4, kt = w % 4;
            src = a.in[33] + ((size_t)(l * 32 + e) * 256 + kt * 64) * 1024 + nt * 64; lds_ = 1024; dst = WD + ((size_t)e * 1024 + nt * 64) * 256 + kt * 64; ldd = 256; }
        tconv_tile(src, lds_, 64, dst, ldd, tid);
    }
}

constexpr int GL_RQ = 0, GL_RK = 17408, GL_VT = 34816, GL_RO = 57856, GL_RX = 75264, GL_KT = 92672, GL_PS = 102912, GL_SC1 = 105472, GL_SC2 = 105984, GL_GT = 106496, GL_OS = 108544, GL_LFS = 117248, GL_DNS = 117504;
template <int MODE, int PASS>
__device__ __forceinline__ void gla_item(ArgsRef a, int l, int h, int sg, int tid, int lane, int wave) {
    unsigned char* ws = a.ws;
    const bf16_t* Z = (const bf16_t*)(ws + OFF_Z); const bf16_t* Qg = (const bf16_t*)(ws + OFF_Q); const bf16_t* Kg = (const bf16_t*)(ws + OFF_KH); const bf16_t* Vg = (const bf16_t*)(ws + OFF_V); const bf16_t* XCg = (const bf16_t*)(ws + OFF_XC);
    const float* LF = (const float*)(ws + OFF_LF);
    float* Eg = (float*)(ws + (MODE == 0 ? OFF_EM : OFF_EH)); float* Gg = (float*)(ws + (MODE == 0 ? OFF_GM : OFF_GH)); float* EX = (float*)(ws + OFF_EMX);
    bf16_t* Yg = (bf16_t*)(ws + (MODE == 0 ? OFF_OM : OFF_OH));
    bf16_t* KT = (bf16_t*)(smem + GL_KT); bf16_t* PS = (bf16_t*)(smem + GL_PS);
    float* SC1 = (float*)(smem + GL_SC1); float* SC2 = (float*)(smem + GL_SC2); float* GT = (float*)(smem + GL_GT); bf16_t* OS = (bf16_t*)(smem + GL_OS); float* DNS = (float*)(smem + GL_DNS);
    const int r = lane & 15, q = lane >> 4, grp = tid >> 7, d = tid & 127, tok = tid >> 4, c8 = (tid & 15) * 8;
    const bool xw = (MODE == 0) && (wave == 0);
    float lb = 0.f;
    if (MODE == 1 && l == 1) { const float h0 = a.in[19][h * 128 + d], h1 = a.in[19][512 + h * 128 + d]; lb = 1.0f / (1.0f + expf(h0 - h1)); }
    f32x4 S[8], SX[8];
#pragma unroll
    for (int i = 0; i < 8; ++i) { S[i] = (f32x4){0.f, 0.f, 0.f, 0.f}; SX[i] = (f32x4){0.f, 0.f, 0.f, 0.f}; }
    if (PASS == 2) {
#pragma unroll
        for (int i = 0; i < 8; ++i)
#pragma unroll
            for (int g = 0; g < 4; ++g) { const size_t row = (size_t)(sg * 4 + h) * 128 + 16 * i + 4 * q + g; S[i][g] = Eg[row * 128 + 16 * wave + r]; if (xw) SX[i][g] = EX[row * 16 + r]; }
    }
    const bf16x8 z8 = (bf16x8){0, 0, 0, 0, 0, 0, 0, 0};
    bf16x8 rq = z8, rk = z8, rv = z8, ro = z8, rx = z8; float lfv = 0.f;
#define GLA_FETCH(t0_) do { const size_t tk = (size_t)((t0_) + tok); \
        if (MODE == 1) { const bf16_t* zp = Z + tk * NZ + h * 128 + c8; if (PASS == 2) { rq = *(const bf16x8*)(zp + 1536); ro = *(const bf16x8*)(zp + 3072); } rk = *(const bf16x8*)(zp + 2048); rv = *(const bf16x8*)(zp + 2560); } \
        else { const size_t o_ = tk * 512 + h * 128 + c8; if (PASS == 2) { rq = *(const bf16x8*)(Qg + o_); ro = *(const bf16x8*)(Z + tk * NZ + 512 + h * 128 + c8); rx = *(const bf16x8*)(XCg + o_); } \
               rk = *(const bf16x8*)(Kg + o_); rv = *(const bf16x8*)(Vg + o_); if (tid < 32) lfv = LF[((t0_) + tid) * 4 + h]; } } while (0)
    GLA_FETCH(sg * GSEGLEN);
    float sk8[8], nw8[8];
#pragma unroll
    for (int j = 0; j < 8; ++j) { sk8[j] = (MODE == 0 && PASS == 2) ? a.in[9][l * 512 + h * 128 + c8 + j] : 0.f; nw8[j] = (MODE == 1 && PASS == 2) ? a.in[20][l * 512 + h * 128 + c8 + j] : 0.f; }
    __syncthreads();
    if (MODE == 0) { for (int i = tid; i < 2 * 16 * 40; i += 512) { const int b = i / 640, k = i % 640; ((bf16_t*)(smem + GL_VT + b * 11520))[128 * 40 + k] = (k < 32) ? (bf16_t)0x3F80 : (bf16_t)0; } }
#define GLA_STORE(tprev, pb) do { const bf16x8 o8 = *(const bf16x8*)(OS + tok * 136 + c8); const bf16x8 p8 = *(const bf16x8*)((const bf16_t*)(smem + GL_RO + (pb) * 8704) + tok * 136 + c8); float y[8]; \
        if (MODE == 0) { const bf16x8 x8 = *(const bf16x8*)((const bf16_t*)(smem + GL_RX + (pb) * 8704) + tok * 136 + c8); const float di = __builtin_amdgcn_rcpf(fmaxf(fabsf(DNS[tok]), 1.0f)); \
            _Pragma("unroll") for (int j = 0; j < 8; ++j) y[j] = sigmoidf_(bf2f((bf16_t)p8[j])) * (bf2f((bf16_t)o8[j]) * di) + sk8[j] * bf2f((bf16_t)x8[j]); } \
        else { float ov[8], ss = 0.f; _Pragma("unroll") for (int j = 0; j < 8; ++j) { ov[j] = bf2f((bf16_t)o8[j]); ss += ov[j] * ov[j]; } \
            ss += __shfl_xor(ss, 1); ss += __shfl_xor(ss, 2); ss += __shfl_xor(ss, 4); ss += __shfl_xor(ss, 8); const float rinv = rsqrtf(ss * (1.0f / 128.0f) + 1e-6f); \
            _Pragma("unroll") for (int j = 0; j < 8; ++j) y[j] = ov[j] * rinv * nw8[j] * siluf_(bf2f((bf16_t)p8[j])); } \
        u32x4 w_; w_.x = pack2(y[0], y[1]); w_.y = pack2(y[2], y[3]); w_.z = pack2(y[4], y[5]); w_.w = pack2(y[6], y[7]); *(u32x4*)(Yg + (size_t)((tprev) + tok) * 512 + h * 128 + c8) = w_; } while (0)
    float runb = 0.f;
    for (int ci = 0; ci < GSEGLEN / 32; ++ci) {
        const int t0 = sg * GSEGLEN + ci * 32, buf = ci & 1;
        bf16_t* RQ = (bf16_t*)(smem + GL_RQ + buf * 8704); bf16_t* RK = (bf16_t*)(smem + GL_RK + buf * 8704); bf16_t* VT = (bf16_t*)(smem + GL_VT + buf * 11520);
        float* LFS = (float*)(smem + GL_LFS + buf * 128);
        if (PASS == 2) { *(bf16x8*)(RQ + tok * 136 + c8) = rq; *(bf16x8*)((bf16_t*)(smem + GL_RO + buf * 8704) + tok * 136 + c8) = ro; if (MODE == 0) *(bf16x8*)((bf16_t*)(smem + GL_RX + buf * 8704) + tok * 136 + c8) = rx; }
        *(bf16x8*)(RK + tok * 136 + c8) = rk;
#pragma unroll
        for (int j = 0; j < 8; ++j) VT[(c8 + j) * 40 + tok] = (bf16_t)rv[j];
        if (MODE == 0 && tid < 32) LFS[tid] = lfv;
        if (ci + 1 < GSEGLEN / 32) GLA_FETCH(t0 + 32);
        __syncthreads();
        float lg[8], kv[8];
#pragma unroll
        for (int j = 0; j < 8; ++j) { const float kr = bf2f(RK[(grp * 8 + j) * 136 + d]);
            if (MODE == 1) { const float f = lb + (1.0f - lb) * sigmoidf_(kr); lg[j] = flog(f); kv[j] = 1.0f - f; } else { lg[j] = LFS[grp * 8 + j]; kv[j] = kr; } }
        float cs[8]; cs[0] = lg[0];
#pragma unroll
        for (int j = 1; j < 8; ++j) cs[j] = cs[j - 1] + lg[j];
        GT[grp * 128 + d] = cs[7];
        __syncthreads();
        if (PASS == 2 && ci > 0) GLA_STORE(t0 - 32, buf ^ 1);
        const float g0 = GT[d], g1 = GT[128 + d], g2 = GT[256 + d], g3 = GT[384 + d];
        const float off = grp == 0 ? 0.f : grp == 1 ? g0 : grp == 2 ? g0 + g1 : g0 + g1 + g2;
        const float bmid = g0 + g1, bL = bmid + g2 + g3;
        bf16_t ktv[8];
#pragma unroll
        for (int j = 0; j < 8; ++j) { const float bt = off + cs[j], ek = fexp(__builtin_amdgcn_fmed3f(bmid - bt, -80.0f, 80.0f)); const bf16_t kt = f2bf(kv[j] * ek); ktv[j] = kt;
            if (PASS == 2) { const float qr = bf2f(RQ[(grp * 8 + j) * 136 + d]); const float qq = (MODE == 1) ? siluf_(qr) : qr; RQ[(grp * 8 + j) * 136 + d] = f2bf(qq * __builtin_amdgcn_rcpf(ek)); RK[(grp * 8 + j) * 136 + d] = kt; } }
        { u32x4 w; w.x = ktv[0] | ((unsigned)ktv[1] << 16); w.y = ktv[2] | ((unsigned)ktv[3] << 16); w.z = ktv[4] | ((unsigned)ktv[5] << 16); w.w = ktv[6] | ((unsigned)ktv[7] << 16); *(u32x4*)(KT + d * 40 + grp * 8) = w; }
        if (grp == 0) { SC1[d] = fexp(bmid); SC2[d] = fexp(bL - bmid); runb += bL; }
        __syncthreads();
        if (PASS == 2) {
            if (wave < 4) {
                const int ti = (wave == 1 || wave == 2) ? 1 : 0, tj = (wave >= 2) ? 1 : 0;
                f32x4 p = (f32x4){0.f, 0.f, 0.f, 0.f};
                if (wave < 3) {
#pragma unroll
                    for (int kk = 0; kk < 4; ++kk) { const bf16x8 av = *(const bf16x8*)(RQ + (16 * ti + r) * 136 + 32 * kk + 8 * q); const bf16x8 bv = *(const bf16x8*)(RK + (16 * tj + r) * 136 + 32 * kk + 8 * q); p = MFMA16(av, bv, p); }
                }
#pragma unroll
                for (int g = 0; g < 4; ++g) { const int t = 16 * ti + 4 * q + g, s_ = 16 * tj + r; PS[t * 40 + s_] = (wave < 3 && s_ <= t) ? f2bf(p[g]) : (bf16_t)0; }
            }
            __syncthreads();
        }
        const bf16x8 bV = *(const bf16x8*)(VT + (16 * wave + r) * 40 + 8 * q);
        bf16x8 bV1 = bV; if (xw) bV1 = *(const bf16x8*)(VT + (128 + r) * 40 + 8 * q);
        f32x4 o[2], ox[2];
        o[0] = o[1] = ox[0] = ox[1] = (f32x4){0.f, 0.f, 0.f, 0.f};
#pragma unroll
        for (int kk = 0; kk < 4; ++kk) {
            const f32x4 sa = *(const f32x4*)(SC1 + 32 * kk + 4 * q), sb = *(const f32x4*)(SC1 + 32 * kk + 16 + 4 * q);
            S[2 * kk] *= sa; S[2 * kk + 1] *= sb;
            if (xw) { SX[2 * kk] *= sa; SX[2 * kk + 1] *= sb; }
            if (PASS == 2) {
                bf16x8 bS, bX;
#pragma unroll
                for (int g = 0; g < 4; ++g) { bS[g] = (short)f2bf(S[2 * kk][g]); bS[4 + g] = (short)f2bf(S[2 * kk + 1][g]); bX[g] = (short)f2bf(SX[2 * kk][g]); bX[4 + g] = (short)f2bf(SX[2 * kk + 1][g]); }
#pragma unroll
                for (int mt = 0; mt < 2; ++mt) { const bf16x4 lo = *(const bf16x4*)(RQ + (16 * mt + r) * 136 + 32 * kk + 4 * q), hi = *(const bf16x4*)(RQ + (16 * mt + r) * 136 + 32 * kk + 16 + 4 * q);
                    bf16x8 av; av[0] = lo[0]; av[1] = lo[1]; av[2] = lo[2]; av[3] = lo[3]; av[4] = hi[0]; av[5] = hi[1]; av[6] = hi[2]; av[7] = hi[3];
                    o[mt] = MFMA16(av, bS, o[mt]); if (xw) ox[mt] = MFMA16(av, bX, ox[mt]); }
            }
        }
        if (PASS == 2) {
#pragma unroll
            for (int mt = 0; mt < 2; ++mt) { const bf16x8 av = *(const bf16x8*)(PS + (16 * mt + r) * 40 + 8 * q); o[mt] = MFMA16(av, bV, o[mt]); if (xw) ox[mt] = MFMA16(av, bV1, ox[mt]);
#pragma unroll
                for (int g = 0; g < 4; ++g) { OS[(16 * mt + 4 * q + g) * 136 + 16 * wave + r] = f2bf(o[mt][g]); if (xw && r == 0) DNS[16 * mt + 4 * q + g] = ox[mt][g]; } }
        }
#pragma unroll
        for (int i = 0; i < 8; ++i) { const bf16x8 av = *(const bf16x8*)(KT + (16 * i + r) * 40 + 8 * q); const f32x4 s2 = *(const f32x4*)(SC2 + 16 * i + 4 * q);
            S[i] = MFMA16(av, bV, S[i]); S[i] *= s2;
            if (xw) { SX[i] = MFMA16(av, bV1, SX[i]); SX[i] *= s2; } }
    }
    if (PASS == 2) { __syncthreads(); GLA_STORE(sg * GSEGLEN + GSEGLEN - 32, 1); }
    if (PASS == 1) {
        float* ST = (float*)smem;
        __syncthreads();
#pragma unroll
        for (int i = 0; i < 8; ++i)
#pragma unroll
            for (int g = 0; g < 4; ++g) { ST[(16 * i + 4 * q + g) * 132 + 16 * wave + r] = S[i][g]; if (xw) EX[((size_t)(sg * 4 + h) * 128 + 16 * i + 4 * q + g) * 16 + r] = SX[i][g]; }
        __syncthreads();
#pragma unroll
        for (int k = 0; k < 8; ++k) { const int idx = tid + 512 * k, row = idx >> 5, c4 = (idx & 31) * 4; *(f32x4*)(Eg + ((size_t)(sg * 4 + h) * 128 + row) * 128 + c4) = *(const f32x4*)(ST + row * 132 + c4); }
        if (grp == 0) Gg[(size_t)(sg * 4 + h) * 128 + d] = expf(runb);
    }
#undef GLA_FETCH
#undef GLA_STORE
}

template <int PASS>
__device__ __forceinline__ void s5_item(ArgsRef a, int l, int g, int sg, int g0, int tid, int lane, int wave, int hsel) {
    unsigned char* ws = a.ws;
    const bf16_t* Z = (const bf16_t*)(ws + OFF_Z); const float* ABAR = (const float*)(ws + OFF_ABAR); const bf16_t* BBT = (const bf16_t*)(ws + OFF_BBT); const bf16_t* CCT = (const bf16_t*)(ws + OFF_CCT);
    float* ES = (float*)(ws + OFF_ES); bf16_t* YPRE = (bf16_t*)(ws + OFF_YPRE);
    float* BU = (float*)(smem + 70000 + (wave & 3) * 12800); bf16_t* X = (bf16_t*)(smem + 70000 + (wave & 3) * 12800 + 8448); bf16_t* YT = (bf16_t*)(smem + 70000 + 51200);
    const int r = lane & 15, q = lane >> 4, p = lane; const bool act = (wave >> 2) == hsel;
    const float ar = ABAR[(g * 64 + p) * 2], ai = ABAR[(g * 64 + p) * 2 + 1];
    const bf16x8 zero8 = (bf16x8){0, 0, 0, 0, 0, 0, 0, 0};
    bf16x8 bB[8], cB[4];
#pragma unroll
    for (int nt = 0; nt < 8; ++nt) bB[nt] = (q < 2) ? *(const bf16x8*)(BBT + (size_t)(g * 128 + 16 * nt + r) * 16 + 8 * q) : zero8;
#pragma unroll
    for (int kk = 0; kk < 4; ++kk) cB[kk] = (PASS == 2) ? *(const bf16x8*)(CCT + (size_t)(g * 16 + r) * 128 + 32 * kk + 8 * q) : zero8;
    float xr = 0.f, xi = 0.f;
    if (PASS == 2) { xr = ES[((size_t)(sg * 32 + g) * 64 + p) * 2]; xi = ES[((size_t)(sg * 32 + g) * 64 + p) * 2 + 1]; }
    const float dsk = a.in[17][l * 512 + 16 * g + r];
    bf16x8 av_n = zero8; bf16_t un[4] = {0, 0, 0, 0};
#define S5_FETCH(t0_) do { if (q < 2) av_n = *(const bf16x8*)(Z + (size_t)((t0_) + r) * NZ + 1024 + 16 * g + 8 * q); \
        if (PASS == 2) { _Pragma("unroll") for (int gg_ = 0; gg_ < 4; ++gg_) un[gg_] = Z[(size_t)((t0_) + 4 * q + gg_) * NZ + 1024 + 16 * g + r]; } } while (0)
    if (act) S5_FETCH(sg * SSEGLEN);
    for (int ci = 0; ci < SSEGLEN / 16; ++ci) {
        const int t0 = sg * SSEGLEN + ci * 16;
        if (act) {
            const bf16x8 av = av_n; bf16_t uc[4] = {un[0], un[1], un[2], un[3]};
            if (ci + 1 < SSEGLEN / 16) S5_FETCH(t0 + 16);
#pragma unroll
            for (int nt = 0; nt < 8; ++nt) { f32x4 acc = (f32x4){0.f, 0.f, 0.f, 0.f}; acc = MFMA16(av, bB[nt], acc);
#pragma unroll
                for (int gg = 0; gg < 4; ++gg) BU[(4 * q + gg) * 132 + 16 * nt + r] = acc[gg]; }
            wave_sync();
#pragma unroll
            for (int t = 0; t < 16; ++t) { const float br = BU[t * 132 + p], bi = BU[t * 132 + 64 + p];
                const float nr = ar * xr - ai * xi + br, ni = ar * xi + ai * xr + bi; xr = nr; xi = ni;
                if (PASS == 2) { X[t * 136 + p] = f2bf(xr); X[t * 136 + 64 + p] = f2bf(xi); } }
            wave_sync();
            if (PASS == 2) {
                f32x4 acc = (f32x4){0.f, 0.f, 0.f, 0.f};
#pragma unroll
                for (int kk = 0; kk < 4; ++kk) { const bf16x8 xv = *(const bf16x8*)(X + r * 136 + 32 * kk + 8 * q); acc = MFMA16(xv, cB[kk], acc); }
#pragma unroll
                for (int gg = 0; gg < 4; ++gg) YT[(4 * q + gg) * 136 + 16 * wave + r] = f2bf(gelu_tanh(acc[gg] + dsk * bf2f(uc[gg])));
            }
        }
        if (PASS == 2) {
            __syncthreads();
            if (tid < 128) { const int row = tid >> 3, c8 = (tid & 7) * 8; *(u32x4*)(YPRE + (size_t)(t0 + row) * 512 + 16 * g0 + 64 * hsel + c8) = *(const u32x4*)(YT + row * 136 + 64 * hsel + c8); }
            __syncthreads();
        }
    }
    if (PASS == 1 && act) { ES[((size_t)(sg * 32 + g) * 64 + p) * 2] = xr; ES[((size_t)(sg * 32 + g) * 64 + p) * 2 + 1] = xi; }
#undef S5_FETCH
}

__device__ __forceinline__ void phase_scan(ArgsRef a, int tid, int bid, int G) {
    unsigned char* ws = a.ws;
    const int NT = G * 512, gt = bid * 512 + tid;
    for (int i = gt; i < 2 * 65536 + 8192 + 2048; i += NT) {
        if (i < 2 * 65536 + 8192) { const bool nx = i >= 2 * 65536; const int m = i >> 16, el = nx ? i - 2 * 65536 : (i & 65535), hrow = nx ? (el >> 4) : (el >> 7); const size_t str = nx ? 8192 : 65536;
            float* E = (float*)(ws + (nx ? OFF_EMX : (m == 0 ? OFF_EM : OFF_EH))); const float* Gd = (const float*)(ws + ((nx || m == 0) ? OFF_GM : OFF_GH));
            float ev[GSEG], gv[GSEG];
#pragma unroll
            for (int sg = 0; sg < GSEG; ++sg) { ev[sg] = E[(size_t)sg * str + el]; gv[sg] = Gd[sg * 512 + hrow]; }
            float cur = 0.f;
#pragma unroll
            for (int sg = 0; sg < GSEG; ++sg) { E[(size_t)sg * str + el] = cur; cur = gv[sg] * cur + ev[sg]; } }
        else { const int el = i - 2 * 65536 - 8192; float* E = (float*)(ws + OFF_ES); const float* ABAR = (const float*)(ws + OFF_ABAR);
            float pr = ABAR[el * 2], pi = ABAR[el * 2 + 1];
#pragma unroll
            for (int k = 0; k < 8; ++k) { const float nr = pr * pr - pi * pi, ni = 2.0f * pr * pi; pr = nr; pi = ni; }
            float xr = 0.f, xi = 0.f;
            for (int sb = 0; sb < SSEG; sb += 16) { float er[16], ei[16];
#pragma unroll
                for (int k = 0; k < 16; ++k) { er[k] = E[((size_t)(sb + k) * 2048 + el) * 2]; ei[k] = E[((size_t)(sb + k) * 2048 + el) * 2 + 1]; }
#pragma unroll
                for (int k = 0; k < 16; ++k) { E[((size_t)(sb + k) * 2048 + el) * 2] = xr; E[((size_t)(sb + k) * 2048 + el) * 2 + 1] = xi;
                    const float nr = pr * xr - pi * xi + er[k], ni = pr * xi + pi * xr + ei[k]; xr = nr; xi = ni; } } }
    }
}

template <int PASS>
__device__ __forceinline__ void phase_mixers(ArgsRef a, int l, int tid, int lane, int wave, int bid, int G) {
    for (int it = bid; it < 4 * GSEG; it += G) gla_item<0, PASS>(a, l, it % 4, it / 4, tid, lane, wave);
    asm volatile("" ::: "memory");
    for (int it = bid + ((4 * GSEG - bid % G) % G + G) % G * 0; it < 2 * 4 * GSEG; it += G) { if (it >= 4 * GSEG) gla_item<1, PASS>(a, l, (it - 4 * GSEG) % 4, (it - 4 * GSEG) / 4, tid, lane, wave); }
    __syncthreads();
    for (int it0 = bid * 8; it0 < 32 * SSEG; it0 += G * 8)
        for (int half = 0; half < 2; ++half) { const int it = it0 + wave; s5_item<PASS>(a, l, it % 32, it / 32, it0 % 32, tid, lane, wave, half); __syncthreads(); }
}

__device__ __forceinline__ void ln_row(f32x4 (&v)[4], const float* gam, const float* bet, int lane) {
    float s = 0.f;
#pragma unroll
    for (int j = 0; j < 4; ++j) s += (v[j][0] + v[j][1]) + (v[j][2] + v[j][3]);
#pragma unroll
    for (int o = 32; o >= 1; o >>= 1) s += __shfl_xor(s, o);
    const float mean = s * (1.0f / 1024.0f); float qv = 0.f;
#pragma unroll
    for (int j = 0; j < 4; ++j) { const f32x4 dd = v[j] - mean; qv += (dd[0] * dd[0] + dd[1] * dd[1]) + (dd[2] * dd[2] + dd[3] * dd[3]); }
#pragma unroll
    for (int o = 32; o >= 1; o >>= 1) qv += __shfl_xor(qv, o);
    const float rstd = rsqrtf(qv * (1.0f / 1024.0f) + 1e-5f);
#pragma unroll
    for (int j = 0; j < 4; ++j) { const f32x4 gg = *(const f32x4*)(gam + 256 * j + 4 * lane), bb = *(const f32x4*)(bet + 256 * j + 4 * lane); v[j] = (v[j] - mean) * rstd * gg + bb; }
}

__device__ __forceinline__ void phase_ln1r(ArgsRef a, int l, int tid, int lane, int wave, int bid, int G) {
    float* XF = a.out; bf16_t* XB = (bf16_t*)(a.ws + OFF_XB);
    int* TOKE = (int*)(a.ws + OFF_TOKE); float* TOKG = (float*)(a.ws + OFF_TOKG); unsigned* HIST = (unsigned*)(a.ws + OFF_HIST);
    const float* RWT = (const float*)(a.ws + OFF_RWT); const float* RB = a.in[30];
    float* LG = (float*)(smem + wave * 4096);
    int* TE = (int*)(smem + wave * 4096 + 2304); float* TG = (float*)(smem + wave * 4096 + 2432); unsigned* HS = (unsigned*)(smem + wave * 4096 + 2560);
    const int r = lane & 15, q = lane >> 4, rs = lane >> 5, e = lane & 31;
    if (G >= 256 && wave >= 4) {
        float* tw_lds = (float*)(smem + 16384 + (wave - 4) * 16640);
        for (int u = 896 + bid * 4 + (wave - 4); u < 6144; u += G * 4) wave_prepx_tile(a, l, u, lane, tw_lds);
    }
    for (int tw = bid + G * wave; tw < T / 16; tw += G * 8) {
        const int t0 = tw * 16;
        for (int rb = 0; rb < 16; rb += 4) { f32x4 v[4][4];
#pragma unroll
            for (int k = 0; k < 4; ++k)
#pragma unroll
                for (int j = 0; j < 4; ++j) v[k][j] = *(const f32x4*)(XF + (size_t)(t0 + rb + k) * 1024 + 256 * j + 4 * lane);
#pragma unroll
            for (int k = 0; k < 4; ++k) { const int t = t0 + rb + k; ln_row(v[k], a.in[25] + l * 1024, a.in[26] + l * 1024, lane);
#pragma unroll
                for (int j = 0; j < 4; ++j) { *(f32x4*)(XF + (size_t)t * 1024 + 256 * j + 4 * lane) = v[k][j];
                    u32x2 w; w.x = pack2(v[k][j][0], v[k][j][1]); w.y = pack2(v[k][j][2], v[k][j][3]); *(u32x2*)(XB + (size_t)t * 1024 + 256 * j + 4 * lane) = w; } } }
        if (lane < 32) HS[lane] = 0u;
        asm volatile("s_waitcnt vmcnt(0) lgkmcnt(0)" ::: "memory"); __builtin_amdgcn_wave_barrier();
        f32x4 acc0 = (f32x4){0.f, 0.f, 0.f, 0.f}, acc1 = acc0;
        const float* xa = XF + (size_t)(t0 + r) * 1024 + 4 * q; const float* w0 = RWT + (size_t)r * 1024 + 4 * q; const float* w1 = RWT + (size_t)(16 + r) * 1024 + 4 * q;
        f32x4 pa[2][4], pb[2][4], pc[2][4];
#define RT_LOAD(buf, g_) do { _Pragma("unroll") for (int k_ = 0; k_ < 4; ++k_) { pa[buf][k_] = *(const f32x4*)(xa + 16 * (4 * (g_) + k_)); pb[buf][k_] = *(const f32x4*)(w0 + 16 * (4 * (g_) + k_)); pc[buf][k_] = *(const f32x4*)(w1 + 16 * (4 * (g_) + k_)); } } while (0)
#define RT_MMA(buf) do { _Pragma("unroll") for (int k_ = 0; k_ < 4; ++k_) _Pragma("unroll") for (int j = 0; j < 4; ++j) { acc0 = __builtin_amdgcn_mfma_f32_16x16x4f32(pa[buf][k_][j], pb[buf][k_][j], acc0, 0, 0, 0); acc1 = __builtin_amdgcn_mfma_f32_16x16x4f32(pa[buf][k_][j], pc[buf][k_][j], acc1, 0, 0, 0); } } while (0)
        RT_LOAD(0, 0);
#pragma unroll 1
        for (int g2 = 0; g2 < 16; g2 += 2) {
            RT_LOAD(1, g2 + 1);
            RT_MMA(0);
            if (g2 + 2 < 16) RT_LOAD(0, g2 + 2);
            RT_MMA(1);
        }
#undef RT_LOAD
#undef RT_MMA
#pragma unroll
        for (int g = 0; g < 4; ++g) { LG[(4 * q + g) * 33 + r] = acc0[g]; LG[(4 * q + g) * 33 + 16 + r] = acc1[g]; }
        wave_sync();
        for (int pp = 0; pp < 8; ++pp) {
            const float lg = LG[(2 * pp + rs) * 33 + e];
            const float s = sigmoidf_(lg), sb = s + RB[e];
            float v4[4];
#pragma unroll
            for (int i = 0; i < 4; ++i) v4[i] = __shfl(sb, (lane & ~3) + i);
            int i1 = 0;
#pragma unroll
            for (int i = 1; i < 4; ++i) if (v4[i] > v4[i1]) i1 = i;
            int i2 = (i1 == 0) ? 1 : 0;
#pragma unroll
            for (int i = 0; i < 4; ++i) if (i != i1 && i != i2 && v4[i] > v4[i2]) i2 = i;
            float gs = v4[i1] + v4[i2]; int gid = e >> 2;
#pragma unroll
            for (int o = 4; o <= 16; o <<= 1) { const float os = __shfl_xor(gs, o); const int og = __shfl_xor(gid, o); if (os > gs || (os == gs && og < gid)) { gs = os; gid = og; } }
            float sv[4], sbv[4];
#pragma unroll
            for (int i = 0; i < 4; ++i) { sbv[i] = __shfl(sb, (lane & 32) + gid * 4 + i); sv[i] = __shfl(s, (lane & 32) + gid * 4 + i); }
            int j1 = 0;
#pragma unroll
            for (int i = 1; i < 4; ++i) if (sbv[i] > sbv[j1]) j1 = i;
            int j2 = (j1 == 0) ? 1 : 0;
#pragma unroll
            for (int i = 0; i < 4; ++i) if (i != j1 && i != j2 && sbv[i] > sbv[j2]) j2 = i;
            float s1 = sv[0], s2 = sv[0];
#pragma unroll
            for (int i = 1; i < 4; ++i) { if (i == j1) s1 = sv[i]; if (i == j2) s2 = sv[i]; }
            if (e == 0) { const int ti = 2 * pp + rs; const float inv = 1.0f / (s1 + s2);
                TE[ti * 2] = gid * 4 + j1; TE[ti * 2 + 1] = gid * 4 + j2; TG[ti * 2] = s1 * inv; TG[ti * 2 + 1] = s2 * inv;
                atomicAdd(&HS[gid * 4 + j1], 1u); atomicAdd(&HS[gid * 4 + j2], 1u); }
        }
        wave_sync();
        if (lane < 32) { TOKE[t0 * 2 + lane] = TE[lane]; TOKG[t0 * 2 + lane] = TG[lane]; HIST[tw * 32 + lane] = HS[lane]; }
        wave_sync();
    }
    __syncthreads();
}

__device__ __forceinline__ void phase_slot(ArgsRef a, int tid, int lane, int wave, int bid, int G) {
    const int* TOKE = (const int*)(a.ws + OFF_TOKE); int* TOKS = (int*)(a.ws + OFF_TOKS); const unsigned* HIST = (const unsigned*)(a.ws + OFF_HIST);
    unsigned* BASE = (unsigned*)(a.ws + OFF_CTL) + 64;
    const bf16_t* XB = (const bf16_t*)(a.ws + OFF_XB); bf16_t* XG = (bf16_t*)(a.ws + OFF_XG);
    unsigned* base = (unsigned*)smem; unsigned* pre = base + 40; int* el = (int*)(base + 80); int* sl = (int*)(base + 208); unsigned* red = base + 336;
    const int e = tid & 31, part = tid >> 5;
    for (int c = bid; c < T / 64; c += G) {
        unsigned tot = 0u, pr = 0u;
#pragma unroll 16
        for (int it = part; it < 1024; it += 16) { const unsigned v = HIST[it * 32 + e]; tot += v; pr += (it < 4 * c) ? v : 0u; }
        red[part * 32 + e] = tot; red[512 + part * 32 + e] = pr;
        __syncthreads();
        if (tid < 32) { unsigned t2 = 0u, p2 = 0u; for (int k = 0; k < 16; ++k) { t2 += red[k * 32 + tid]; p2 += red[512 + k * 32 + tid]; } pre[tid] = p2; red[tid] = (t2 + 255u) & ~255u; }
        __syncthreads();
        if (tid == 0) { unsigned sacc = 0; for (int k = 0; k < 32; ++k) { base[k] = sacc; sacc += red[k]; } base[32] = sacc; }
        int ee = 0;
        if (tid < 128) { ee = TOKE[c * 128 + tid]; el[tid] = ee; }
        __syncthreads();
        if (c == 0 && tid < 33) BASE[tid] = base[tid];
        if (c == 0 && tid >= 64 && tid < 64 + 160) { const unsigned t256 = (unsigned)(tid - 64) * 256u; int ee2 = 0; while (ee2 < 31 && base[ee2 + 1] <= t256) ++ee2; BASE[64 + (tid - 64)] = (unsigned)ee2; }
        if (tid < 128) { unsigned rank = 0; for (int i = 0; i < tid; ++i) rank += (el[i] == ee) ? 1u : 0u;
            const unsigned sidx = base[ee] + pre[ee] + rank; sl[tid] = (int)sidx; TOKS[c * 128 + tid] = (int)sidx; }
        __syncthreads();
        for (int ib = 0; ib < 16; ib += 8) { u32x4 ra[8], rb[8];
#pragma unroll
            for (int k = 0; k < 8; ++k) { const int i = wave + 8 * (ib + k), t = c * 64 + (i >> 1); ra[k] = *(const u32x4*)(XB + (size_t)t * 1024 + lane * 8); rb[k] = *(const u32x4*)(XB + (size_t)t * 1024 + 512 + lane * 8); }
#pragma unroll
            for (int k = 0; k < 8; ++k) { const int i = wave + 8 * (ib + k); const size_t so = (size_t)sl[i] * 1024; *(u32x4*)(XG + so + lane * 8) = ra[k]; *(u32x4*)(XG + so + 512 + lane * 8) = rb[k]; } }
        __syncthreads();
    }
}

__device__ __forceinline__ void phase_ln2(ArgsRef a, int l, int lane, int gw, int GW) {
    float* XF = a.out; bf16_t* XB = (bf16_t*)(a.ws + OFF_XB); const bf16_t* YS = (const bf16_t*)(a.ws + OFF_YS);
    const int* TOKS = (const int*)(a.ws + OFF_TOKS); const float* TOKG = (const float*)(a.ws + OFF_TOKG);
    for (int tb = gw * 4; tb < T; tb += GW * 4) {
        int sv = 0; float gv = 0.f; if (lane < 8) { sv = TOKS[tb * 2 + lane]; gv = TOKG[tb * 2 + lane]; }
        f32x4 v[4][4]; bf16x4 y0[4][4], y1[4][4]; float g0[4], g1[4];
#pragma unroll
        for (int k = 0; k < 4; ++k) { const int s0 = __shfl(sv, 2 * k), s1 = __shfl(sv, 2 * k + 1); g0[k] = __shfl(gv, 2 * k); g1[k] = __shfl(gv, 2 * k + 1);
#pragma unroll
            for (int j = 0; j < 4; ++j) { v[k][j] = *(const f32x4*)(XF + (size_t)(tb + k) * 1024 + 256 * j + 4 * lane);
                y0[k][j] = *(const bf16x4*)(YS + (size_t)s0 * 1024 + 256 * j + 4 * lane); y1[k][j] = *(const bf16x4*)(YS + (size_t)s1 * 1024 + 256 * j + 4 * lane); } }
#pragma unroll
        for (int k = 0; k < 4; ++k) {
#pragma unroll
            for (int j = 0; j < 4; ++j)
#pragma unroll
                for (int g = 0; g < 4; ++g) v[k][j][g] = DN_ALPHA * v[k][j][g] + g0[k] * bf2f((bf16_t)y0[k][j][g]) + g1[k] * bf2f((bf16_t)y1[k][j][g]);
            ln_row(v[k], a.in[27] + l * 1024, a.in[28] + l * 1024, lane);
#pragma unroll
            for (int j = 0; j < 4; ++j) { *(f32x4*)(XF + (size_t)(tb + k) * 1024 + 256 * j + 4 * lane) = v[k][j];
                u32x2 w; w.x = pack2(v[k][j][0], v[k][j][1]); w.y = pack2(v[k][j][2], v[k][j][3]); *(u32x2*)(XB + (size_t)(tb + k) * 1024 + 256 * j + 4 * lane) = w; } }
    }
}

struct SchedGrid {
    int nM, nN, G, c; const char* A; const char* B; size_t strideA, strideB;
    __device__ __forceinline__ bool next(int i, pg8::Unit& u) const { int pm, pn; if (!pg8::tile_order(i * G + c, nM, nN, pm, pn)) return false;
        u.pm = pm; u.pn = pn; u.tag = 0; u.A = A + (size_t)pm * strideA; u.B = B + (size_t)pn * strideB; return true; }
};
constexpr int GATES_LD = 3072;
template <int MODE> struct EpiBf16 {
    static constexpr bool PERM = true;
    bf16_t* O; int ldo; const bf16_t* Y; int ldy;
    __device__ __forceinline__ bool operator()(f32x4 (&acc)[2][2][4][2], const pg8::Unit& u, int wr, int wc, int fr, int fq) const {
#pragma unroll
        for (int ai = 0; ai < 2; ++ai) {
            bf16x8 yv[4][2];
            if (MODE == 2) {
#pragma unroll
                for (int m = 0; m < 4; ++m)
#pragma unroll
                    for (int bj = 0; bj < 2; ++bj) yv[m][bj] = *(const bf16x8*)(Y + ((size_t)u.pm * 256 + ai * 128 + wr * 64 + m * 16 + fr) * ldy + u.pn * 256 + bj * 128 + wc * 32 + 8 * fq);
            }
#pragma unroll
            for (int m = 0; m < 4; ++m) { const size_t row = (size_t)u.pm * 256 + ai * 128 + wr * 64 + m * 16 + fr;
#pragma unroll
                for (int bj = 0; bj < 2; ++bj) { const int col = u.pn * 256 + bj * 128 + wc * 32 + 8 * fq; f32x4 v0 = acc[ai][bj][m][0], v1 = acc[ai][bj][m][1];
                    if (MODE == 1) {
#pragma unroll
                        for (int j = 0; j < 4; ++j) { v0[j] = fmaxf(sigmoidf_(v0[j]), 1e-30f); v1[j] = fmaxf(sigmoidf_(v1[j]), 1e-30f); } }
                    if (MODE == 2) {
#pragma unroll
                        for (int j = 0; j < 4; ++j) { v0[j] = bf2f((bf16_t)yv[m][bj][j]) * sigmoidf_(v0[j]); v1[j] = bf2f((bf16_t)yv[m][bj][4 + j]) * sigmoidf_(v1[j]); } }
                    u32x4 w; w.x = pg8::cvt_pk_bf16(v0[0], v0[1]); w.y = pg8::cvt_pk_bf16(v0[2], v0[3]); w.z = pg8::cvt_pk_bf16(v1[0], v1[1]); w.w = pg8::cvt_pk_bf16(v1[2], v1[3]);
                    if (MODE == 1) *(u32x4*)(O + ((((size_t)u.pm * 12 + u.pn) * 16 + (ai * 8 + m * 2 + bj)) * 512 + ((wr * 4 + wc) * 64 + fq * 16 + fr)) * 8) = w;
                    else *(u32x4*)(O + row * ldo + col) = w; } }
        }
        return false;
    }
};
struct SchedZ {
    int G, c; const unsigned char* ws;
    __device__ __forceinline__ bool next(int i, pg8::Unit& u) const { int pm, pn; if (!pg8::tile_order(i * G + c, T / 256, 15, pm, pn)) return false;
        u.pm = pm; u.pn = pn; u.tag = 0; u.A = (const char*)(ws + OFF_XB) + (size_t)pm * 256 * 1024 * 2;
        u.B = (const char*)(ws + OFF_WIN) + (size_t)(pn < 14 ? pn * 256 : 6656) * 1024 * 2; return true; }
};
struct EpiZ {
    static constexpr bool PERM = true;
    bf16_t* Z; float* LI; float* LF; const float* bi; const float* bf;
    __device__ __forceinline__ bool operator()(f32x4 (&acc)[2][2][4][2], const pg8::Unit& u, int wr, int wc, int fr, int fq) const {
        if (u.pn < 14) {
#pragma unroll
            for (int ai = 0; ai < 2; ++ai)
#pragma unroll
                for (int m = 0; m < 4; ++m) { const size_t row = (size_t)u.pm * 256 + ai * 128 + wr * 64 + m * 16 + fr;
#pragma unroll
                    for (int bj = 0; bj < 2; ++bj) { const int col = u.pn * 256 + bj * 128 + wc * 32 + 8 * fq; const f32x4 v0 = acc[ai][bj][m][0], v1 = acc[ai][bj][m][1];
                        u32x4 w; w.x = pg8::cvt_pk_bf16(v0[0], v0[1]); w.y = pg8::cvt_pk_bf16(v0[2], v0[3]); w.z = pg8::cvt_pk_bf16(v1[0], v1[1]); w.w = pg8::cvt_pk_bf16(v1[2], v1[3]);
                        *(u32x4*)(Z + row * NZ + col) = w; } }
        } else if (wc == 0 && fq == 0) {
            const f32x4 b_i = *(const f32x4*)bi, b_f = *(const f32x4*)bf;
#pragma unroll
            for (int ai = 0; ai < 2; ++ai)
#pragma unroll
                for (int m = 0; m < 4; ++m) { const size_t row = (size_t)u.pm * 256 + ai * 128 + wr * 64 + m * 16 + fr; const f32x4 v0 = acc[ai][0][m][0] + b_i, v1 = acc[ai][0][m][1] + b_f;
                    f32x4 lf; lf[0] = logsigmoidf_(v1[0]); lf[1] = logsigmoidf_(v1[1]); lf[2] = logsigmoidf_(v1[2]); lf[3] = logsigmoidf_(v1[3]);
                    *(f32x4*)(LI + row * 4) = v0; *(f32x4*)(LF + row * 4) = lf; }
        }
        return false;
    }
};
__device__ __forceinline__ void phase_zgemm2(ArgsRef a, int l, int tid, int bid, int G) {
    SchedZ S{G, bid, a.ws}; EpiZ E{(bf16_t*)(a.ws + OFF_Z), (float*)(a.ws + OFF_LI), (float*)(a.ws + OFF_LF), a.in[7] + l * 4, a.in[8] + l * 4};
    pg8::gemm_phase((PG8_LAS unsigned char*)smem, tid, 1024, 1024, 1024, S, E);
}
__device__ __forceinline__ void phase_glu_gates(ArgsRef a, int l, int tid, int bid, int G) {
    { SchedGrid S{T / 256, 2, G, bid, (const char*)(a.ws + OFF_YPRE), (const char*)(a.ws + OFF_WGLU), (size_t)256 * 512 * 2, (size_t)256 * 512 * 2};
      EpiBf16<2> E{(bf16_t*)(a.ws + OFF_YSG), 512, (const bf16_t*)(a.ws + OFF_YPRE), 512};
      pg8::gemm_phase((PG8_LAS unsigned char*)smem, tid, 512, 512, 512, S, E); }
    asm volatile("" : "+v"(tid), "+s"(bid), "+s"(G));
    if (G > 128) { if (bid >= 128) phase_prepx(a, l, tid, bid - 128, G - 128, 0, 896); } else phase_prepx(a, l, tid, bid, G, 0, 896);
    asm volatile("" : "+v"(tid), "+s"(bid), "+s"(G));
    { SchedGrid S{T / 256, 12, G, (bid + G / 2) % G, (const char*)(a.ws + OFF_XB), (const char*)(a.ws + OFF_WIN + (size_t)NZ * 1024 * 2), (size_t)256 * 1024 * 2, (size_t)256 * 1024 * 2};
      EpiBf16<1> E{(bf16_t*)(a.ws + OFF_Z), GATES_LD, nullptr, 0};
      pg8::gemm_phase((PG8_LAS unsigned char*)smem, tid, 1024, 1024, 1024, S, E); }
}
struct SchedMerge {
    int G, c; const unsigned char* ws;
    __device__ __forceinline__ bool next(int i, pg8::Unit& u) const { const int b = i % 3; int pm, pn; if (!pg8::tile_order((i / 3) * G + c, T / 256, 4, pm, pn)) return false;
        u.pm = pm; u.pn = pn; u.tag = b; u.A = (const char*)(ws + (b == 0 ? OFF_OM : b == 1 ? OFF_YSG : OFF_OH)) + (size_t)pm * 256 * 512 * 2;
        u.B = (const char*)(ws + OFF_WB) + ((size_t)b * 1024 + pn * 256) * 512 * 2; return true; }
};
struct EpiMerge {
    static constexpr bool PERM = true;
    const bf16_t* GT; bf16_t* O;
    __device__ __forceinline__ bool operator()(f32x4 (&acc)[2][2][4][2], const pg8::Unit& u, int wr, int wc, int fr, int fq) const {
        const int b = u.tag;
        const bf16_t* gbase = GT + (((size_t)u.pm * 12 + b * 4 + u.pn) * 16 * 512 + ((wr * 4 + wc) * 64 + fq * 16 + fr)) * 8;
        bf16x8 gb[2][2][2], gn[2][2][2];
#define MG_LOAD(buf, ai_, mh_) do { _Pragma("unroll") for (int mm = 0; mm < 2; ++mm) _Pragma("unroll") for (int bj = 0; bj < 2; ++bj) { const bf16_t* gp = gbase + (size_t)((ai_) * 8 + (2 * (mh_) + mm) * 2 + bj) * 512 * 8; \
            gb[buf][mm][bj] = *(const bf16x8*)gp; gn[buf][mm][bj] = (b < 2) ? *(const bf16x8*)(gp + (size_t)4 * 16 * 512 * 8) : gb[buf][mm][bj]; } } while (0)
        MG_LOAD(0, 0, 0);
#pragma unroll
        for (int st = 0; st < 4; ++st) { const int ai = st >> 1, mh = st & 1, buf = st & 1;
            if (st + 1 < 4) { if (buf == 0) MG_LOAD(1, (st + 1) >> 1, (st + 1) & 1); else MG_LOAD(0, (st + 1) >> 1, (st + 1) & 1); }
#pragma unroll
            for (int mm = 0; mm < 2; ++mm) { const int m = 2 * mh + mm; const size_t row = (size_t)u.pm * 256 + ai * 128 + wr * 64 + m * 16 + fr;
#pragma unroll
                for (int bj = 0; bj < 2; ++bj) { const int col = u.pn * 256 + bj * 128 + wc * 32 + 8 * fq;
                    if (b < 2) {
#pragma unroll
                        for (int j = 0; j < 4; ++j) { acc[ai][bj][m][0][j] *= bf2f((bf16_t)gb[buf][mm][bj][j]) * __builtin_amdgcn_rcpf(bf2f((bf16_t)gn[buf][mm][bj][j])); acc[ai][bj][m][1][j] *= bf2f((bf16_t)gb[buf][mm][bj][4 + j]) * __builtin_amdgcn_rcpf(bf2f((bf16_t)gn[buf][mm][bj][4 + j])); } }
                    else { f32x4 v0 = acc[ai][bj][m][0], v1 = acc[ai][bj][m][1];
#pragma unroll
                        for (int j = 0; j < 4; ++j) { v0[j] *= bf2f((bf16_t)gb[buf][mm][bj][j]); v1[j] *= bf2f((bf16_t)gb[buf][mm][bj][4 + j]); }
                        u32x4 w; w.x = pg8::cvt_pk_bf16(v0[0], v0[1]); w.y = pg8::cvt_pk_bf16(v0[2], v0[3]); w.z = pg8::cvt_pk_bf16(v1[0], v1[1]); w.w = pg8::cvt_pk_bf16(v1[2], v1[3]);
                        *(u32x4*)(O + row * 1024 + col) = w; } } }
        }
#undef MG_LOAD
        return b < 2;
    }
};
__device__ __forceinline__ void phase_merge2(ArgsRef a, int tid, int bid, int G) {
    SchedMerge S{G, bid, a.ws}; EpiMerge E{(const bf16_t*)(a.ws + OFF_Z), (bf16_t*)(a.ws + OFF_XB)};
    pg8::gemm_phase((PG8_LAS unsigned char*)smem, tid, 512, 512, 512, S, E);
}
struct EpiResid {
    static constexpr bool PERM = false;
    const float* xin; float* XF;
    __device__ __forceinline__ bool operator()(f32x4 (&acc)[2][2][4][2], const pg8::Unit& u, int wr, int wc, int fr, int fq) const {
#pragma unroll
        for (int ai = 0; ai < 2; ++ai)
#pragma unroll
        for (int mh = 0; mh < 2; ++mh) {
            f32x4 xv[2][2][2];
#pragma unroll
            for (int mm = 0; mm < 2; ++mm)
#pragma unroll
                for (int bj = 0; bj < 2; ++bj)
#pragma unroll
                    for (int n = 0; n < 2; ++n) xv[mm][bj][n] = *(const f32x4*)(xin + ((size_t)u.pm * 256 + ai * 128 + wr * 64 + (2 * mh + mm) * 16 + fr) * 1024 + u.pn * 256 + bj * 128 + wc * 32 + 16 * n + 4 * fq);
#pragma unroll
            for (int mm = 0; mm < 2; ++mm)
#pragma unroll
                for (int bj = 0; bj < 2; ++bj)
#pragma unroll
                    for (int n = 0; n < 2; ++n) { const int m = 2 * mh + mm; const size_t o = ((size_t)u.pm * 256 + ai * 128 + wr * 64 + m * 16 + fr) * 1024 + u.pn * 256 + bj * 128 + wc * 32 + 16 * n + 4 * fq; *(f32x4*)(XF + o) = DN_ALPHA * xv[mm][bj][n] + acc[ai][bj][m][n]; }
        }
        return false;
    }
};
__device__ __forceinline__ void phase_wout2(ArgsRef a, int l, int tid, int bid, int G) {
    SchedGrid S{T / 256, 4, G, bid, (const char*)(a.ws + OFF_XB), (const char*)(a.ws + OFF_WOUT), (size_t)256 * 1024 * 2, (size_t)256 * 1024 * 2};
    EpiResid E{(l == 0) ? a.in[0] : a.out, a.out};
    pg8::gemm_phase((PG8_LAS unsigned char*)smem, tid, 1024, 1024, 1024, S, E);
}
struct EpiQKV {
    static constexpr bool PERM = true;
    int vcall; bf16_t* Q; bf16_t* KH; bf16_t* V; const float* LI;
    __device__ __forceinline__ bool operator()(f32x4 (&acc)[2][2][4][2], const pg8::Unit& u, int wr, int wc, int fr, int fq) const {
        const int which = vcall ? 2 : (u.pn >> 1); bf16_t* O = Q + (size_t)which * (SZ_ACT / 2);
        float liv[2][4][2];
#pragma unroll
        for (int ai = 0; ai < 2; ++ai)
#pragma unroll
            for (int m = 0; m < 4; ++m)
#pragma unroll
                for (int bj = 0; bj < 2; ++bj) liv[ai][m][bj] = (which == 1) ? LI[((size_t)u.pm * 256 + ai * 128 + wr * 64 + m * 16 + fr) * 4 + (u.pn & 1) * 2 + bj] : 0.f;
#pragma unroll
        for (int ai = 0; ai < 2; ++ai)
#pragma unroll
            for (int m = 0; m < 4; ++m) { const size_t row = (size_t)u.pm * 256 + ai * 128 + wr * 64 + m * 16 + fr;
#pragma unroll
                for (int bj = 0; bj < 2; ++bj) { const int hd = (u.pn & 1) * 2 + bj, col = hd * 128 + wc * 32 + 8 * fq;
                    const float sc = which == 0 ? 0.08838834764831845f : which == 1 ? fexp(liv[ai][m][bj]) : 1.0f;
                    const f32x4 v0 = acc[ai][bj][m][0] * sc, v1 = acc[ai][bj][m][1] * sc;
                    u32x4 w; w.x = pg8::cvt_pk_bf16(v0[0], v0[1]); w.y = pg8::cvt_pk_bf16(v0[2], v0[3]); w.z = pg8::cvt_pk_bf16(v1[0], v1[1]); w.w = pg8::cvt_pk_bf16(v1[2], v1[3]);
                    *(u32x4*)(O + row * 512 + col) = w; } }
        return false;
    }
};
__device__ __forceinline__ void phase_mprep2(ArgsRef a, int l, int tid, int bid, int G) {
    const bf16_t* Z = (const bf16_t*)(a.ws + OFF_Z); bf16_t* XC = (bf16_t*)(a.ws + OFF_XC);
    const float* cw = a.in[2] + (size_t)l * 4 * 512; const float* cb = a.in[3] + (size_t)l * 512;
    for (int idx = bid * 512 + tid; idx < (T / 8) * 64; idx += G * 512) {
        const int tb = (idx / 64) * 8, c0 = (idx % 64) * 8;
        bf16x8 xr[11];
#pragma unroll
        for (int k = 0; k < 11; ++k) { const int ts = tb - 3 + k; xr[k] = (ts >= 0) ? *(const bf16x8*)(Z + (size_t)ts * NZ + c0) : (bf16x8){0, 0, 0, 0, 0, 0, 0, 0}; }
        float w[4][8], b[8];
#pragma unroll
        for (int j = 0; j < 8; ++j) { b[j] = cb[c0 + j];
#pragma unroll
            for (int k = 0; k < 4; ++k) w[k][j] = cw[k * 512 + c0 + j]; }
#pragma unroll
        for (int tt = 0; tt < 8; ++tt) { float acc[8];
#pragma unroll
            for (int j = 0; j < 8; ++j) { acc[j] = b[j];
#pragma unroll
                for (int k = 0; k < 4; ++k) acc[j] += w[k][j] * bf2f((bf16_t)xr[tt + k][j]); }
            u32x4 o; o.x = pack2(siluf_(acc[0]), siluf_(acc[1])); o.y = pack2(siluf_(acc[2]), siluf_(acc[3])); o.z = pack2(siluf_(acc[4]), siluf_(acc[5])); o.w = pack2(siluf_(acc[6]), siluf_(acc[7]));
            *(u32x4*)(XC + (size_t)(tb + tt) * 512 + c0) = o; }
    }
}

__device__ __forceinline__ void phase_v_conv(ArgsRef a, int l, int tid, int bid, int G) {
    if (G > 128 && bid >= 128) { phase_mprep2(a, l, tid, bid - 128, G - 128); return; }
    { SchedGrid S{T / 256, 2, G, bid, (const char*)(a.ws + OFF_Z), (const char*)(a.ws + OFF_WQKV + (size_t)1024 * 512 * 2), (size_t)256 * NZ * 2, (size_t)256 * 512 * 2};
      EpiQKV E{1, (bf16_t*)(a.ws + OFF_Q), (bf16_t*)(a.ws + OFF_KH), (bf16_t*)(a.ws + OFF_V), (const float*)(a.ws + OFF_LI)};
      pg8::gemm_phase((PG8_LAS unsigned char*)smem, tid, 512, NZ, 512, S, E); }
    if (G <= 128) { asm volatile("" : "+v"(tid), "+s"(bid), "+s"(G)); phase_mprep2(a, l, tid, bid, G); }
}
__device__ __forceinline__ void phase_qk(ArgsRef a, int tid, int bid, int G) {
    SchedGrid S{T / 256, 4, G, bid, (const char*)(a.ws + OFF_XC), (const char*)(a.ws + OFF_WQKV), (size_t)256 * 512 * 2, (size_t)256 * 512 * 2};
    EpiQKV E{0, (bf16_t*)(a.ws + OFF_Q), (bf16_t*)(a.ws + OFF_KH), (bf16_t*)(a.ws + OFF_V), (const float*)(a.ws + OFF_LI)};
    pg8::gemm_phase((PG8_LAS unsigned char*)smem, tid, 512, 512, 512, S, E);
}
struct SchedMoE {
    int down, G, c; const unsigned char* ws; const unsigned* BASE;
    __device__ __forceinline__ bool next(int i, pg8::Unit& u) const { const int per = down ? 4 : 2, L = i * G + c, ntile = (int)(BASE[32] >> 8); if (L >= ntile * per) return false;
        const int tile = L / per, sub = L % per; const int e = (int)BASE[64 + tile];
        u.pm = tile; u.pn = sub; u.tag = e;
        if (!down) { u.A = (const char*)(ws + OFF_XG) + (size_t)tile * 256 * 1024 * 2; u.B = (const char*)(ws + OFF_WGU) + ((size_t)e * 512 + sub * 256) * 1024 * 2; }
        else { u.A = (const char*)(ws + OFF_H) + (size_t)tile * 256 * 256 * 2; u.B = (const char*)(ws + OFF_WD) + ((size_t)e * 1024 + sub * 256) * 256 * 2; }
        return true; }
};
struct EpiH {
    static constexpr bool PERM = true;
    bf16_t* H;
    __device__ __forceinline__ bool operator()(f32x4 (&acc)[2][2][4][2], const pg8::Unit& u, int wr, int wc, int fr, int fq) const {
#pragma unroll
        for (int ai = 0; ai < 2; ++ai)
#pragma unroll
            for (int m = 0; m < 4; ++m) { const size_t row = (size_t)u.pm * 256 + ai * 128 + wr * 64 + m * 16 + fr; f32x4 v0, v1;
#pragma unroll
                for (int j = 0; j < 4; ++j) { v0[j] = siluf_(acc[ai][0][m][0][j]) * acc[ai][1][m][0][j]; v1[j] = siluf_(acc[ai][0][m][1][j]) * acc[ai][1][m][1][j]; }
                u32x4 w; w.x = pg8::cvt_pk_bf16(v0[0], v0[1]); w.y = pg8::cvt_pk_bf16(v0[2], v0[3]); w.z = pg8::cvt_pk_bf16(v1[0], v1[1]); w.w = pg8::cvt_pk_bf16(v1[2], v1[3]);
                *(u32x4*)(H + row * 256 + u.pn * 128 + wc * 32 + 8 * fq) = w; }
        return false;
    }
};
__device__ __forceinline__ void phase_moe_gu2(ArgsRef a, int l, int tid, int bid, int G) {
    { SchedMoE S{0, G, bid, a.ws, (const unsigned*)(a.ws + OFF_CTL) + 64}; EpiH E{(bf16_t*)(a.ws + OFF_H)};
      pg8::gemm_phase((PG8_LAS unsigned char*)smem, tid, 1024, 1024, 1024, S, E); }
    if (l + 1 < NLAYER) {
        asm volatile("" : "+v"(tid), "+s"(bid), "+s"(G));
        const int ntile = (int)(((const unsigned*)(a.ws + OFF_CTL))[64 + 32] >> 8); int nb = ntile * 2 - G; nb = nb < 0 ? 0 : (nb > G - 1 ? G - 1 : nb);
        if (bid >= nb) phase_prep(a, l + 1, tid, bid - nb, G - nb);
    }
}
__device__ __forceinline__ void phase_moe_dn2(ArgsRef a, int tid, int bid, int G) {
    SchedMoE S{1, G, bid, a.ws, (const unsigned*)(a.ws + OFF_CTL) + 64}; EpiBf16<0> E{(bf16_t*)(a.ws + OFF_YS), 1024, nullptr, 0};
    pg8::gemm_phase((PG8_LAS unsigned char*)smem, tid, 256, 256, 256, S, E);
}
#define XB_TMO      128
#define XB_XCNT(j)  (256  + 64 * (j))
#define XB_XSUB(j)  (1280 + 64 * (j))
#define XB_XGEN(j)  (2304 + 64 * (j))
#define XB_TOP      3328
#define XB_TOPGEN   3392
#define XCD_BAR_WORDS 3456
#define XB_SPIN_CAP (1u << 22)
__device__ __forceinline__ unsigned xb_ld(unsigned* p)              { return __hip_atomic_load(p, __ATOMIC_RELAXED, __HIP_MEMORY_SCOPE_AGENT); }
__device__ __forceinline__ unsigned xb_add(unsigned* p, unsigned v) { return __hip_atomic_fetch_add(p, v, __ATOMIC_RELAXED, __HIP_MEMORY_SCOPE_AGENT); }
__device__ __forceinline__ unsigned xb_xcc_id() { return (unsigned)__builtin_amdgcn_s_getreg((3 << 11) | 20) & 0xFu; }
#define XB_SPIN(cond, bar) do { unsigned _sp = 0; while (cond) { __builtin_amdgcn_s_sleep(1); \
    if ((++_sp & 255u) == 0u) { if (xb_ld(&(bar)[XB_TMO])) break; if (_sp > XB_SPIN_CAP) { atomicAdd(&(bar)[XB_TMO], 1u); break; } } } } while (0)
__device__ __forceinline__ void xcd_barrier_complete(unsigned* bar, unsigned x, unsigned& nloc, unsigned& nx) {
    const unsigned G = gridDim.x; unsigned sum, cnt, mine, sp = 0u;
    for (;;) { sum = 0u; cnt = 0u; mine = 0u;
#pragma unroll
        for (unsigned j = 0; j < 16; ++j) { const unsigned c = xb_ld(&bar[XB_XCNT(j)]); sum += c; cnt += (c > 0u) ? 1u : 0u; mine = (j == x) ? c : mine; }
        if (sum == G) break;
        __builtin_amdgcn_s_sleep(1);
        if ((++sp & 255u) == 0u) { if (xb_ld(&bar[XB_TMO])) break; if (sp > XB_SPIN_CAP) { atomicAdd(&bar[XB_TMO], 1u); break; } } }
    nloc = mine > 0u ? mine : 1u; nx = cnt > 0u ? cnt : 1u;
}
__device__ __forceinline__ void xcd_barrier(unsigned* bar, volatile __attribute__((address_space(3))) unsigned* st) {
    asm volatile("s_waitcnt vmcnt(0)" ::: "memory");
    __syncthreads();
    if (threadIdx.x == 0) {
        __builtin_amdgcn_s_waitcnt(0);
        const unsigned x = xb_xcc_id();
        unsigned nloc = st[0], nx = st[1];
        if (nloc == 0u) { xcd_barrier_complete(bar, x, nloc, nx); st[0] = nloc; st[1] = nx; }
        const unsigned old = xb_add(&bar[XB_XSUB(x)], 1u);
        const unsigned gen = old / nloc;
        if (old + 1u == (gen + 1u) * nloc) {
            __builtin_amdgcn_fence(__ATOMIC_RELEASE, "agent");
            asm volatile("s_waitcnt vmcnt(0)" ::: "memory");
            const unsigned og = xb_add(&bar[XB_TOP], 1u);
            const unsigned tg = og / nx;
            if (og + 1u == (tg + 1u) * nx) xb_add(&bar[XB_TOPGEN], 1u);
            else XB_SPIN(xb_ld(&bar[XB_TOPGEN]) == tg, bar);
            __builtin_amdgcn_fence(__ATOMIC_ACQUIRE, "agent");
            xb_add(&bar[XB_XGEN(x)], 1u);
            asm volatile("s_waitcnt vmcnt(0)" ::: "memory");
        } else {
            XB_SPIN(xb_ld(&bar[XB_XGEN(x)]) == gen, bar);
            __builtin_amdgcn_fence(__ATOMIC_ACQUIRE, "agent");
            asm volatile("s_waitcnt vmcnt(0)" ::: "memory");
        }
    }
    __syncthreads();
}

__device__ __forceinline__ ArgsRef fresh_args() { unsigned long long p = (unsigned long long)__builtin_amdgcn_kernarg_segment_ptr(); asm volatile("" : "+s"(p)); return *(const __attribute__((address_space(4))) Args*)p; }
__global__ void __launch_bounds__(512) fwd(Args a_unused) {
    cg::grid_group grid = cg::this_grid();
    volatile __attribute__((address_space(3))) unsigned* bst = (volatile __attribute__((address_space(3))) unsigned*)((__attribute__((address_space(3))) unsigned char*)smem + 131072);
    if (threadIdx.x < 4) bst[threadIdx.x] = 0u;
    __syncthreads();
    { ArgsRef a0 = fresh_args(); if (threadIdx.x == 0) (void)xb_add(&((unsigned*)(a0.ws + OFF_BAR))[XB_XCNT(xb_xcc_id())], 1u); }
#define GSYNC() do { asm volatile("" ::: "memory"); { ArgsRef ab = fresh_args(); xcd_barrier((unsigned*)(ab.ws + OFF_BAR), bst); } asm volatile("" ::: "memory"); } while (0)
#define GSYNC_CG() do { asm volatile("" ::: "memory"); grid.sync(); asm volatile("" ::: "memory"); } while (0)
    const int wave_s = __builtin_amdgcn_readfirstlane((int)threadIdx.x >> 6);
#define PH(body) do { int wave = wave_s; asm volatile("" : "+s"(wave)); int lane; asm volatile("v_mbcnt_lo_u32_b32 %0, -1, 0\n\tv_mbcnt_hi_u32_b32 %0, -1, %0" : "=v"(lane)); \
        int bid = blockIdx.x, G = gridDim.x; asm volatile("" : "+s"(bid), "+s"(G)); \
        const int tid = wave * 64 + lane, gw = bid * 8 + wave, GW = G * 8; (void)tid; (void)gw; (void)GW; ArgsRef a = fresh_args(); body; } while (0)
#pragma unroll 1
    for (int l = 0; l < NLAYER; ++l) {
        if (l == 0) { PH(phase_prep(a, 0, tid, bid, G)); GSYNC_CG(); }
        PH(phase_zgemm2(a, l, tid, bid, G)); GSYNC();
        PH(phase_v_conv(a, l, tid, bid, G)); GSYNC();
        PH(phase_qk(a, tid, bid, G)); GSYNC();
        PH(phase_mixers<1>(a, l, tid, lane, wave, bid, G)); GSYNC();
        PH(phase_scan(a, tid, bid, G)); GSYNC();
        PH(phase_mixers<2>(a, l, tid, lane, wave, bid, G)); GSYNC();
        PH(phase_glu_gates(a, l, tid, bid, G)); GSYNC();
        PH(phase_merge2(a, tid, bid, G)); GSYNC();
        PH(phase_wout2(a, l, tid, bid, G)); GSYNC();
        PH(phase_ln1r(a, l, tid, lane, wave, bid, G)); PH(if (G < 256) phase_prepx(a, l, tid, bid, G, 896, 6144)); GSYNC();
        PH(phase_slot(a, tid, lane, wave, bid, G)); GSYNC();
        PH(phase_moe_gu2(a, l, tid, bid, G)); GSYNC();
        PH(phase_moe_dn2(a, tid, bid, G)); GSYNC();
        PH(phase_ln2(a, l, lane, gw, GW)); if (l + 1 < NLAYER) GSYNC();
    }
}

extern "C" void kernel_launch(void* const* d_in, const int* in_sizes, int n_in, void* d_out, int out_size, void* d_ws, size_t ws_size, hipStream_t stream) {
    static int grid = 0;
    if (grid == 0) {
        if (n_in != 34 || out_size != T * D || ws_size < WS_TOTAL) { fprintf(stderr, "kernel_launch: unexpected shapes (n_in %d, out %d, ws %zu, need %zu)\n", n_in, out_size, ws_size, (size_t)WS_TOTAL); grid = -1; return; }
        int dev = 0, cus = 0, per_cu = 0;
        (void)hipGetDevice(&dev); (void)hipDeviceGetAttribute(&cus, hipDeviceAttributeMultiprocessorCount, dev);
        (void)hipFuncSetAttribute((const void*)fwd, hipFuncAttributeMaxDynamicSharedMemorySize, LDS_BYTES);
        (void)hipOccupancyMaxActiveBlocksPerMultiprocessor(&per_cu, (const void*)fwd, 512, LDS_BYTES);
        if (per_cu < 1) { fprintf(stderr, "kernel_launch: occupancy query says %d blocks per CU\n", per_cu); per_cu = 1; }
        grid = (cus > 0 ? cus : 256) * 1;
        (void)hipGetLastError();
    }
    if (grid < 0) return;
    Args a{};
    for (int i = 0; i < 34; ++i) a.in[i] = (const float*)d_in[i];
    a.out = (float*)d_out; a.ws = (unsigned char*)d_ws; a.ph_lo = 0; a.ph_hi = NLAYER * NPH;
    (void)hipMemsetAsync((unsigned char*)d_ws + OFF_BAR, 0, 16384, stream);
    void* args[] = {&a};
    hipError_t e = hipLaunchCooperativeKernel((const void*)fwd, dim3(grid), dim3(512), args, LDS_BYTES, stream);
    if (e != hipSuccess) fprintf(stderr, "kernel_launch: cooperative launch failed: %s (grid %d)\n", hipGetErrorString(e), grid);
}
```

```cpp
#include <hip/hip_runtime.h>
#include <hip/hip_cooperative_groups.h>
#include <cstdio>
#include <cstdint>
namespace cg = cooperative_groups;

typedef unsigned short bf16_t;
typedef short bf16x8 __attribute__((ext_vector_type(8)));
typedef short bf16x4 __attribute__((ext_vector_type(4)));
typedef float f32x4 __attribute__((ext_vector_type(4)));
typedef unsigned u32x4 __attribute__((ext_vector_type(4)));
typedef unsigned u32x2 __attribute__((ext_vector_type(2)));

constexpr int T = 16384, D = 1024, NZ = 3584, NWIN = 6912, INW = 6664;
constexpr int NPH = 15, NLAYER = 2;
constexpr int GSEG = 32, GSEGLEN = 512;
constexpr int SSEG = 64, SSEGLEN = 256;
constexpr int SLOTS = 40960;
constexpr float DN_ALPHA = 1.41421356237f;
constexpr int LDS_BYTES = 131072 + 256;

constexpr size_t AL(size_t x) { return (x + 255) & ~(size_t)255; }
constexpr size_t OFF_WIN = 0;
constexpr size_t OFF_WQKV = OFF_WIN + AL((size_t)NWIN * 1024 * 2);
constexpr size_t OFF_WGLU = OFF_WQKV + AL((size_t)1536 * 512 * 2);
constexpr size_t OFF_WB = OFF_WGLU + AL((size_t)512 * 512 * 2);
constexpr size_t OFF_WOUT = OFF_WB + AL((size_t)3 * 1024 * 512 * 2);
constexpr size_t OFF_ABAR = OFF_WOUT + AL((size_t)1024 * 1024 * 2);
constexpr size_t OFF_BBT = OFF_ABAR + AL((size_t)32 * 64 * 2 * 4);
constexpr size_t OFF_CCT = OFF_BBT + AL((size_t)32 * 128 * 16 * 2);
constexpr size_t OFF_CTL = OFF_CCT + AL((size_t)32 * 16 * 128 * 2);
constexpr size_t OFF_TOKE = OFF_CTL + 4096;
constexpr size_t OFF_TOKG = OFF_TOKE + AL((size_t)T * 2 * 4);
constexpr size_t OFF_TOKS = OFF_TOKG + AL((size_t)T * 2 * 4);
constexpr size_t OFF_SLOTT = OFF_TOKS + AL((size_t)T * 2 * 4);
constexpr size_t OFF_XB = OFF_SLOTT + AL((size_t)SLOTS * 4);
constexpr size_t OFF_R1 = OFF_XB + AL((size_t)T * 1024 * 2);
constexpr size_t SZ_ACT = (size_t)T * 512 * 2;
constexpr size_t OFF_XC = OFF_R1, OFF_Q = OFF_R1 + SZ_ACT, OFF_KH = OFF_R1 + 2 * SZ_ACT, OFF_V = OFF_R1 + 3 * SZ_ACT;
constexpr size_t OFF_WGU = OFF_R1, OFF_WD = OFF_R1 + (size_t)32 * 512 * 1024 * 2;
constexpr size_t OFF_Z = OFF_R1 + 4 * SZ_ACT;
constexpr size_t OFF_XG = OFF_Z, OFF_H = OFF_Z + (size_t)SLOTS * 1024 * 2;
constexpr size_t OFF_ZS = OFF_Z + AL((size_t)T * NZ * 2);
constexpr size_t OFF_LF = OFF_ZS + AL((size_t)T * 8 * 4);
constexpr size_t OFF_LI = OFF_LF + AL((size_t)T * 4 * 4);
constexpr size_t OFF_E = OFF_LI + AL((size_t)T * 4 * 4);
constexpr size_t OFF_OM = OFF_E, OFF_OH = OFF_E + SZ_ACT, OFF_YPRE = OFF_E + 2 * SZ_ACT, OFF_YSG = OFF_E + 3 * SZ_ACT;
constexpr size_t OFF_DEN = OFF_E + 4 * SZ_ACT;
constexpr size_t OFF_EM = OFF_DEN + AL((size_t)T * 4 * 4);
constexpr size_t OFF_EMX = OFF_EM + AL((size_t)GSEG * 4 * 128 * 128 * 4);
constexpr size_t OFF_GM = OFF_EMX + AL((size_t)GSEG * 4 * 128 * 16 * 4);
constexpr size_t OFF_EH = OFF_GM + AL((size_t)GSEG * 4 * 128 * 4);
constexpr size_t OFF_GH = OFF_EH + AL((size_t)GSEG * 4 * 128 * 128 * 4);
constexpr size_t OFF_ES = OFF_GH + AL((size_t)GSEG * 4 * 128 * 4);
constexpr size_t WS_END = OFF_ES + AL((size_t)SSEG * 32 * 64 * 2 * 4);
constexpr size_t OFF_YS = OFF_E;
constexpr size_t OFF_RWT = WS_END;
constexpr size_t OFF_HIST = OFF_RWT + 32 * 1024 * 4;
constexpr size_t OFF_BAR = OFF_HIST + 1024 * 32 * 4;
constexpr size_t WS_TOTAL = OFF_BAR + 16384;
static_assert(OFF_YS + (size_t)SLOTS * 1024 * 2 <= WS_END, "YS must fit in the dead region");
static_assert(OFF_H + (size_t)SLOTS * 256 * 2 <= OFF_ZS, "H must fit in the dead Z region");
static_assert(OFF_WD + (size_t)32 * 1024 * 256 * 2 <= OFF_Z, "expert weights must fit in R1");

struct Args { const float* in[34]; float* out; unsigned char* ws; int ph_lo, ph_hi; };
typedef const __attribute__((address_space(4))) Args& ArgsRef;

extern __shared__ __attribute__((aligned(16))) unsigned char smem[];

__device__ __forceinline__ bf16_t f2bf(float f) { return __builtin_bit_cast(unsigned short, (__bf16)f); }
__device__ __forceinline__ float bf2f(bf16_t b) { return __uint_as_float(((unsigned)b) << 16); }
__device__ __forceinline__ unsigned pack2(float lo, float hi) { typedef __bf16 bf2_t __attribute__((ext_vector_type(2))); bf2_t v; v[0] = (__bf16)lo; v[1] = (__bf16)hi; return __builtin_bit_cast(unsigned, v); }
__device__ __forceinline__ float fexp(float x) { return __builtin_amdgcn_exp2f(x * 1.4426950408889634f); }
__device__ __forceinline__ float flog(float x) { return __builtin_amdgcn_logf(x) * 0.6931471805599453f; }
__device__ __forceinline__ float sigmoidf_(float x) { return __builtin_amdgcn_rcpf(1.0f + fexp(-x)); }
__device__ __forceinline__ float siluf_(float x) { return x * __builtin_amdgcn_rcpf(1.0f + fexp(-x)); }
__device__ __forceinline__ float logsigmoidf_(float x) { return fminf(x, 0.f) - log1pf(expf(-fabsf(x))); }
__device__ __forceinline__ float gelu_tanh(float y) { const float z = 0.7978845608028654f * (y + 0.044715f * y * y * y); const float th = 1.0f - 2.0f * __builtin_amdgcn_rcpf(fexp(2.0f * z) + 1.0f); return 0.5f * y * (1.0f + th); }
__device__ __forceinline__ void wave_sync() { __builtin_amdgcn_wave_barrier(); asm volatile("s_waitcnt lgkmcnt(0)" ::: "memory"); __builtin_amdgcn_wave_barrier(); }

#define MFMA16(a, b, c) __builtin_amdgcn_mfma_f32_16x16x32_bf16((a), (b), (c), 0, 0, 0)

namespace pg8 {
#define PG8_LAS __attribute__((address_space(3)))
constexpr int BM = 256, BK = 64, HALF = 128, HTB = HALF * BK * 2, STAGE_BYTES = 8 * HTB;
__device__ __forceinline__ int lds_byte(int r, int c) { const int st = (r >> 4) * 2 + (c >> 5), rr = r & 15, cc = c & 31, ob = rr * 64 + cc * 2; return st * 1024 + (ob ^ (((ob >> 9) & 1) << 5)); }
__device__ __forceinline__ void stage_rc(int b, int& R, int& C) { const int st = b / 1024, sb = b % 1024, swz = sb ^ (((sb >> 9) & 1) << 5); R = (st >> 1) * 16 + swz / 64; C = (st & 1) * 32 + (swz % 64) / 2; }
__device__ __forceinline__ int perm32(int rho) { const int n = rho >> 4, i = rho & 15; return 8 * (i >> 2) + 4 * n + (i & 3); }
struct Unit { int pm, pn, tag; const char* A; const char* B; };
__device__ __forceinline__ unsigned cvt_pk_bf16(float lo, float hi) { unsigned r; asm volatile("v_cvt_pk_bf16_f32 %0, %1, %2" : "=v"(r) : "v"(lo), "v"(hi)); return r; }
__device__ __forceinline__ bool tile_order(int L, int nM, int nN, int& pm, int& pn) {
    const int nwg = nM * nN; if (L >= nwg) return false;
    int wgid = L; { const int q = nwg / 8, r = nwg % 8, xcd = wgid % 8, off = wgid / 8; wgid = (xcd < r ? xcd * (q + 1) : r * (q + 1) + (xcd - r) * q) + off; }
    const int nig = 8 * nN, gid = wgid / nig, fm = gid * 8, gsz = (nM - fm) < 8 ? (nM - fm) : 8;
    pm = fm + ((wgid % nig) % gsz); pn = (wgid % nig) / gsz; return true;
}
template <class Epi, class Sched>
__device__ __forceinline__ void gemm_phase(PG8_LAS unsigned char* lds, const int tid, const int K, const int lda, const int ldb, const Sched& S, const Epi& E) {
    const int wid = __builtin_amdgcn_readfirstlane(tid >> 6), lane = tid & 63, wr = wid >> 2, wc = wid & 3, fr = lane & 15, fq = lane >> 4;
    const int nt = K / BK;
    unsigned voffA[2], voffB[2];
#pragma unroll
    for (int i = 0; i < 2; ++i) { int R, C; stage_rc(tid * 16 + i * 8192, R, C); const int Rb = Epi::PERM ? ((R & ~31) + perm32(R & 31)) : R;
        voffA[i] = (unsigned)(R * lda + C) * 2u; voffB[i] = (unsigned)(Rb * ldb + C) * 2u; }
    const size_t kstep = (size_t)(BK * 2), hstepA = (size_t)HALF * lda * 2, hstepB = (size_t)HALF * ldb * 2;
    const unsigned ldsw = (unsigned)wid * 1024u;
    const int aoff = lds_byte(wr * 64 + fr, fq * 8), boff = lds_byte(wc * 32 + fr, fq * 8);
#define PG8_SA(b, h) (((b) * 2 + (h)) * HTB)
#define PG8_SB(b, h) ((4 + (b) * 2 + (h)) * HTB)
#define PG8_STAGE(bufoff, gbase, voff) do { _Pragma("unroll") for (int _i = 0; _i < 2; ++_i) \
        __builtin_amdgcn_global_load_lds((const unsigned*)((const char*)(gbase) + (voff)[_i]), (PG8_LAS unsigned*)(lds + (bufoff) + ldsw + _i * 8192), 16, 0, 0); } while (0)
#define PG8_LDA(dst, b, h) do { _Pragma("unroll") for (int m = 0; m < 4; ++m) _Pragma("unroll") for (int k = 0; k < 2; ++k) dst[m][k] = *(const PG8_LAS bf16x8*)(lds + PG8_SA(b, h) + aoff + m * 2048 + k * 1024); } while (0)
#define PG8_LDB(dst, b, h) do { _Pragma("unroll") for (int n = 0; n < 2; ++n) _Pragma("unroll") for (int k = 0; k < 2; ++k) dst[n][k] = *(const PG8_LAS bf16x8*)(lds + PG8_SB(b, h) + boff + n * 2048 + k * 1024); } while (0)
#define PG8_MMA(ai, bj, At, Bt) do { __builtin_amdgcn_s_setprio(1); _Pragma("unroll") for (int m = 0; m < 4; ++m) _Pragma("unroll") for (int n = 0; n < 2; ++n) _Pragma("unroll") for (int k = 0; k < 2; ++k) \
        acc[ai][bj][m][n] = __builtin_amdgcn_mfma_f32_16x16x32_bf16(Bt[n][k], At[m][k], acc[ai][bj][m][n], 0, 0, 0); __builtin_amdgcn_s_setprio(0); } while (0)
#define PG8_WAIT_V(n) asm volatile("s_waitcnt vmcnt(" #n ")" ::: "memory")
#define PG8_WAIT_L(n) asm volatile("s_waitcnt lgkmcnt(" #n ")" ::: "memory")
#define PG8_BAR __builtin_amdgcn_s_barrier()
#define PG8_SCHED __builtin_amdgcn_sched_barrier(0)
    Unit cur, nxt; int ui = 0;
    if (!S.next(0, cur)) return;
    f32x4 acc[2][2][4][2];
#pragma unroll
    for (int a = 0; a < 2; ++a)
#pragma unroll
        for (int b = 0; b < 2; ++b)
#pragma unroll
            for (int m = 0; m < 4; ++m)
#pragma unroll
                for (int n = 0; n < 2; ++n) acc[a][b][m][n] = (f32x4){0.f, 0.f, 0.f, 0.f};
    bf16x8 At[4][2], B0[2][2], B1[2][2];
    const char* cA = cur.A; const char* cB = cur.B;
    PG8_STAGE(PG8_SB(0, 0), cB, voffB); PG8_STAGE(PG8_SA(0, 0), cA, voffA); PG8_STAGE(PG8_SB(0, 1), cB + hstepB, voffB); PG8_STAGE(PG8_SA(0, 1), cA + hstepA, voffA);
    if (wr == 1) PG8_BAR;
    PG8_WAIT_V(4); PG8_BAR;
    PG8_STAGE(PG8_SB(1, 0), cB + kstep, voffB); PG8_STAGE(PG8_SA(1, 0), cA + kstep, voffA); PG8_STAGE(PG8_SB(1, 1), cB + hstepB + kstep, voffB);
    PG8_WAIT_V(6); PG8_BAR;
    for (;;) {
        const bool has_next = S.next(ui + 1, nxt);
        const char* nA = has_next ? nxt.A : cA; const char* nB = has_next ? nxt.B : cB;
        for (int t = 0; t < nt; t += 2) {
            const bool last = (t == nt - 2);
            const char* a1 = cA + (size_t)(t + 1) * kstep;
            const char* a2 = last ? nA : cA + (size_t)(t + 2) * kstep; const char* b2 = last ? nB : cB + (size_t)(t + 2) * kstep;
            const char* a3 = a2 + kstep; const char* b3 = b2 + kstep;
            PG8_LDB(B0, 0, 0); PG8_SCHED; PG8_LDA(At, 0, 0); PG8_STAGE(PG8_SA(1, 1), a1 + hstepA, voffA);
            PG8_WAIT_L(8); PG8_BAR; PG8_WAIT_L(0); PG8_MMA(0, 0, At, B0); PG8_BAR; PG8_SCHED;
            PG8_LDB(B1, 0, 1); PG8_STAGE(PG8_SB(0, 0), b2, voffB);
            PG8_BAR; PG8_WAIT_L(0); PG8_MMA(0, 1, At, B1); PG8_BAR;
            PG8_LDA(At, 0, 1); PG8_STAGE(PG8_SA(0, 0), a2, voffA);
            PG8_BAR; PG8_WAIT_L(0); PG8_MMA(1, 0, At, B0); PG8_BAR; PG8_SCHED;
            PG8_STAGE(PG8_SB(0, 1), b2 + hstepB, voffB);
            PG8_WAIT_V(6); PG8_BAR; PG8_MMA(1, 1, At, B1); PG8_BAR;
            PG8_LDB(B0, 1, 0); PG8_SCHED; PG8_LDA(At, 1, 0); PG8_STAGE(PG8_SA(0, 1), a2 + hstepA, voffA);
            PG8_WAIT_L(8); PG8_BAR; PG8_WAIT_L(0); PG8_MMA(0, 0, At, B0); PG8_BAR; PG8_SCHED;
            PG8_LDB(B1, 1, 1); PG8_STAGE(PG8_SB(1, 0), b3, voffB);
            PG8_BAR; PG8_WAIT_L(0); PG8_MMA(0, 1, At, B1); PG8_BAR;
            PG8_LDA(At, 1, 1); PG8_STAGE(PG8_SA(1, 0), a3, voffA);
            PG8_BAR; PG8_WAIT_L(0); PG8_MMA(1, 0, At, B0); PG8_BAR; PG8_SCHED;
            PG8_STAGE(PG8_SB(1, 1), b3 + hstepB, voffB);
            PG8_WAIT_V(6); PG8_BAR; PG8_MMA(1, 1, At, B1); PG8_BAR;
        }
        const bool keep = E(acc, cur, wr, wc, fr, fq);
        if (!has_next) break;
        if (!keep) {
#pragma unroll
            for (int a = 0; a < 2; ++a)
#pragma unroll
                for (int b = 0; b < 2; ++b)
#pragma unroll
                    for (int m = 0; m < 4; ++m)
#pragma unroll
                        for (int n = 0; n < 2; ++n) acc[a][b][m][n] = (f32x4){0.f, 0.f, 0.f, 0.f};
        }
        cur = nxt; cA = nA; cB = nB; ++ui;
    }
    PG8_WAIT_V(0);
    if (wr == 0) PG8_BAR;
    PG8_BAR;
#undef PG8_SA
#undef PG8_SB
#undef PG8_STAGE
#undef PG8_LDA
#undef PG8_LDB
#undef PG8_MMA
#undef PG8_WAIT_V
#undef PG8_WAIT_L
#undef PG8_BAR
#undef PG8_SCHED
}
}

__device__ __forceinline__ void tconv_tile(const float* src, int ld_src, int nvalid, bf16_t* dst, int ld_dst, int tid) {
    float* t = (float*)smem;
    { const int r = tid >> 3, c0 = (tid & 7) * 8; float v[8];
      if (nvalid == 64) { const f32x4 a0 = *(const f32x4*)(src + (size_t)r * ld_src + c0), a1 = *(const f32x4*)(src + (size_t)r * ld_src + c0 + 4);
          v[0] = a0[0]; v[1] = a0[1]; v[2] = a0[2]; v[3] = a0[3]; v[4] = a1[0]; v[5] = a1[1]; v[6] = a1[2]; v[7] = a1[3]; }
      else {
#pragma unroll
          for (int j = 0; j < 8; ++j) { const int c = c0 + j; v[j] = (c < nvalid) ? src[(size_t)r * ld_src + c] : 0.f; } }
#pragma unroll
      for (int j = 0; j < 8; ++j) t[(c0 + j) * 65 + r] = v[j]; }
    __syncthreads();
    { const int n = tid >> 3, k0 = (tid & 7) * 8; const float* p = t + n * 65 + k0;
      u32x4 w; w.x = pack2(p[0], p[1]); w.y = pack2(p[2], p[3]); w.z = pack2(p[4], p[5]); w.w = pack2(p[6], p[7]);
      *(u32x4*)(dst + (size_t)n * ld_dst + k0) = w; }
    __syncthreads();
}

__device__ __forceinline__ void wave_tconv(const float* src, int ld_src, bf16_t* dst, int ld_dst, int lane, float* t  ) {
    f32x4 v[16]; const int rq = lane >> 4, c4 = (lane & 15) * 4;
#pragma unroll
    for (int i = 0; i < 16; ++i) v[i] = *(const f32x4*)(src + (size_t)(4 * i + rq) * ld_src + c4);
#pragma unroll
    for (int i = 0; i < 16; ++i)
#pragma unroll
        for (int j = 0; j < 4; ++j) t[(c4 + j) * 65 + 4 * i + rq] = v[i][j];
    wave_sync();
    const int rr = lane >> 3, k8 = (lane & 7) * 8;
#pragma unroll
    for (int i = 0; i < 8; ++i) { const float* p = t + (8 * i + rr) * 65 + k8;
        u32x4 w; w.x = pack2(p[0], p[1]); w.y = pack2(p[2], p[3]); w.z = pack2(p[4], p[5]); w.w = pack2(p[6], p[7]);
        *(u32x4*)(dst + (size_t)(8 * i + rr) * ld_dst + k8) = w; }
    wave_sync();
}
__device__ __forceinline__ void wave_prepx_tile(ArgsRef a, int l, int u, int lane, float* t) {
    bf16_t* WGU = (bf16_t*)(a.ws + OFF_WGU); bf16_t* WD = (bf16_t*)(a.ws + OFF_WD);
    if (u < 4096) { const int up = u >= 2048, v = u & 2047, e = v / 64, w = v % 64, nt = w / 16, kt = w % 16, j0 = nt * 64, drow = (j0 / 128) * 256 + (j0 % 128) + up * 128;
        wave_tconv(a.in[31 + up] + ((size_t)(l * 32 + e) * 1024 + kt * 64) * 256 + nt * 64, 256, WGU + ((size_t)e * 512 + drow) * 1024 + kt * 64, 1024, lane, t); }
    else { const int v = u - 4096, e = v / 64, w = v % 64, nt = w / 4, kt = w % 4;
        wave_tconv(a.in[33] + ((size_t)(l * 32 + e) * 256 + kt * 64) * 1024 + nt * 64, 1024, WD + ((size_t)e * 1024 + nt * 64) * 256 + kt * 64, 256, lane, t); }
}
__device__ __forceinline__ void phase_prep(ArgsRef a, int l, int tid, int bid, int G) {
    unsigned char* ws = a.ws;
    bf16_t* WIN = (bf16_t*)(ws + OFF_WIN); bf16_t* WQKV = (bf16_t*)(ws + OFF_WQKV); bf16_t* WGLU = (bf16_t*)(ws + OFF_WGLU);
    bf16_t* WB = (bf16_t*)(ws + OFF_WB); bf16_t* WOUT = (bf16_t*)(ws + OFF_WOUT);
    for (int u = bid; u < 2624; u += G) {
        const float* src; int lds_ = 0, nvalid = 64, ldd = 0; bf16_t* dst;
        if (u < 1728) { const int nt = u / 16, kt = u % 16, p0 = nt * 64; int sc;
            if (p0 < 1024) sc = p0; else if (p0 < 6656) sc = p0 + 8; else if (p0 == 6656) { sc = 1024; nvalid = 8; } else { sc = 0; nvalid = 0; }
            src = a.in[1] + (size_t)l * 1024 * INW + (size_t)(kt * 64) * INW + sc; lds_ = INW; dst = WIN + (size_t)p0 * 1024 + kt * 64; ldd = 1024; }
        else if (u < 1920) { const int v = u - 1728, nt = v / 8, kt = v % 8, which = nt / 8, h = (nt % 8) / 2;
            if ((kt >> 1) != h) nvalid = 0;
            src = a.in[4 + which] + (size_t)(l * 4 + h) * 128 * 128 + ((kt & 1) * 64) * 128 + (nt & 1) * 64; lds_ = 128; dst = WQKV + (size_t)(nt * 64) * 512 + kt * 64; ldd = 512; }
        else if (u < 1984) { const int v = u - 1920, nt = v / 8, kt = v % 8;
            src = a.in[18] + (size_t)l * 512 * 512 + (kt * 64) * 512 + nt * 64; lds_ = 512; dst = WGLU + (size_t)(nt * 64) * 512 + kt * 64; ldd = 512; }
        else if (u < 2368) { const int v = u - 1984, b = v / 128, w = v % 128, nt = w / 8, kt = w % 8;
            src = a.in[21 + b] + (size_t)l * 512 * 1024 + (size_t)(kt * 64) * 1024 + nt * 64; lds_ = 1024; dst = WB + (size_t)b * 1024 * 512 + (size_t)(nt * 64) * 512 + kt * 64; ldd = 512; }
        else { const int v = u - 2368, nt = v / 16, kt = v % 16;
            src = a.in[24] + (size_t)l * 1024 * 1024 + (size_t)(kt * 64) * 1024 + nt * 64; lds_ = 1024; dst = WOUT + (size_t)(nt * 64) * 1024 + kt * 64; ldd = 1024; }
        tconv_tile(src, lds_, nvalid, dst, ldd, tid);
    }
    float* ABAR = (float*)(ws + OFF_ABAR); bf16_t* BBT = (bf16_t*)(ws + OFF_BBT); bf16_t* CCT = (bf16_t*)(ws + OFF_CCT);
    for (int i = bid * 512 + tid; i < 2048; i += G * 512) {
        const int g = i / 64, p = i % 64; const size_t gp = (size_t)(l * 32 + g) * 64 + p;
        const float lr = fminf(a.in[10][gp], -1e-4f), li = a.in[11][gp], dt = expf(a.in[12][l * 32 + g]);
        const float mag = expf(lr * dt), abr = mag * cosf(li * dt), abi = mag * sinf(li * dt);
        const float nr = abr - 1.0f, den = lr * lr + li * li, cr = (nr * lr + abi * li) / den, ci = (abi * lr - nr * li) / den;
        ABAR[(g * 64 + p) * 2] = abr; ABAR[(g * 64 + p) * 2 + 1] = abi;
        for (int c = 0; c < 16; ++c) { const float br = a.in[13][gp * 16 + c], bi = a.in[14][gp * 16 + c];
            BBT[(size_t)(g * 128 + p) * 16 + c] = f2bf(cr * br - ci * bi); BBT[(size_t)(g * 128 + 64 + p) * 16 + c] = f2bf(cr * bi + ci * br);
            const size_t ci_ = ((size_t)(l * 32 + g) * 16 + c) * 64 + p;
            CCT[(size_t)(g * 16 + c) * 128 + p] = f2bf(a.in[15][ci_]); CCT[(size_t)(g * 16 + c) * 128 + 64 + p] = f2bf(-a.in[16][ci_]); }
    }
    if (l == 0) { float* RWT = (float*)(ws + OFF_RWT); const float* RW = a.in[29]; for (int i = bid * 512 + tid; i < 32 * 1024; i += G * 512) RWT[i] = RW[(i & 1023) * 32 + (i >> 10)]; }
    if (l == 0) { bf16_t* XB = (bf16_t*)(ws + OFF_XB); const float* x = a.in[0];
        for (size_t i = (size_t)bid * 512 + tid; i < (size_t)T * 1024 / 8; i += (size_t)G * 512) {
            const f32x4 v0 = *(const f32x4*)(x + i * 8), v1 = *(const f32x4*)(x + i * 8 + 4);
            u32x4 w; w.x = pack2(v0[0], v0[1]); w.y = pack2(v0[2], v0[3]); w.z = pack2(v1[0], v1[1]); w.w = pack2(v1[2], v1[3]); *(u32x4*)(XB + i * 8) = w; } }
}

__device__ __forceinline__ void phase_prepx(ArgsRef a, int l, int tid, int bid, int G, int u_lo, int u_hi) {
    bf16_t* WGU = (bf16_t*)(a.ws + OFF_WGU); bf16_t* WD = (bf16_t*)(a.ws + OFF_WD);
    for (int u = u_lo + bid; u < u_hi; u += G) {
        const float* src; int lds_, ldd; bf16_t* dst;
        if (u < 4096) { const int up = u >= 2048, v = u & 2047, e = v / 64, w = v % 64, nt = w / 16, kt = w % 16, j0 = nt * 64, drow = (j0 / 128) * 256 + (j0 % 128) + up * 128;
            src = a.in[31 + up] + ((size_t)(l * 32 + e) * 1024 + kt * 64) * 256 + nt * 64; lds_ = 256; dst = WGU + ((size_t)e * 512 + drow) * 1024 + kt * 64; ldd = 1024; }
        else { const int v = u - 4096, e = v / 64, w = v % 64, nt = w / 4, kt = w % 4;
            src = a.in[33] + ((size_t)(l * 32 + e) * 256 + kt * 64) * 1024 + nt * 64; lds_ = 1024; dst = WD + ((size_t)e * 1024 + nt * 64) * 256 + kt * 64; ldd = 256; }
        tconv_tile(src, lds_, 64, dst, ldd, tid);
    }
}

constexpr int GL_RQ = 0, GL_RK = 17408, GL_VT = 34816, GL_RO = 57856, GL_RX = 75264, GL_KT = 92672, GL_PS = 102912, GL_SC1 = 105472, GL_SC2 = 105984, GL_GT = 106496, GL_OS = 108544, GL_LFS = 117248, GL_DNS = 117504;
template <int MODE, int PASS>
__device__ __forceinline__ void gla_item(ArgsRef a, int l, int h, int sg, int tid, int lane, int wave) {
    unsigned char* ws = a.ws;
    const bf16_t* Z = (const bf16_t*)(ws + OFF_Z); const bf16_t* Qg = (const bf16_t*)(ws + OFF_Q); const bf16_t* Kg = (const bf16_t*)(ws + OFF_KH); const bf16_t* Vg = (const bf16_t*)(ws + OFF_V); const bf16_t* XCg = (const bf16_t*)(ws + OFF_XC);
    const float* LF = (const float*)(ws + OFF_LF);
    float* Eg = (float*)(ws + (MODE == 0 ? OFF_EM : OFF_EH)); float* Gg = (float*)(ws + (MODE == 0 ? OFF_GM : OFF_GH)); float* EX = (float*)(ws + OFF_EMX);
    bf16_t* Yg = (bf16_t*)(ws + (MODE == 0 ? OFF_OM : OFF_OH));
    bf16_t* KT = (bf16_t*)(smem + GL_KT); bf16_t* PS = (bf16_t*)(smem + GL_PS);
    float* SC1 = (float*)(smem + GL_SC1); float* SC2 = (float*)(smem + GL_SC2); float* GT = (float*)(smem + GL_GT); bf16_t* OS = (bf16_t*)(smem + GL_OS); float* DNS = (float*)(smem + GL_DNS);
    const int r = lane & 15, q = lane >> 4, grp = tid >> 7, d = tid & 127, tok = tid >> 4, c8 = (tid & 15) * 8;
    const bool xw = (MODE == 0) && (wave == 0);
    float lb = 0.f;
    if (MODE == 1 && l == 1) { const float h0 = a.in[19][h * 128 + d], h1 = a.in[19][512 + h * 128 + d]; lb = 1.0f / (1.0f + expf(h0 - h1)); }
    f32x4 S[8], SX[8];
#pragma unroll
    for (int i = 0; i < 8; ++i) { S[i] = (f32x4){0.f, 0.f, 0.f, 0.f}; SX[i] = (f32x4){0.f, 0.f, 0.f, 0.f}; }
    if (PASS == 2) {
#pragma unroll
        for (int i = 0; i < 8; ++i)
#pragma unroll
            for (int g = 0; g < 4; ++g) { const size_t row = (size_t)(sg * 4 + h) * 128 + 16 * i + 4 * q + g; S[i][g] = Eg[row * 128 + 16 * wave + r]; if (xw) SX[i][g] = EX[row * 16 + r]; }
    }
    const bf16x8 z8 = (bf16x8){0, 0, 0, 0, 0, 0, 0, 0};
    bf16x8 rq = z8, rk = z8, rv = z8, ro = z8, rx = z8; float lfv = 0.f;
#define GLA_FETCH(t0_) do { const size_t tk = (size_t)((t0_) + tok); \
        if (MODE == 1) { const bf16_t* zp = Z + tk * NZ + h * 128 + c8; if (PASS == 2) { rq = *(const bf16x8*)(zp + 1536); ro = *(const bf16x8*)(zp + 3072); } rk = *(const bf16x8*)(zp + 2048); rv = *(const bf16x8*)(zp + 2560); } \
        else { const size_t o_ = tk * 512 + h * 128 + c8; if (PASS == 2) { rq = *(const bf16x8*)(Qg + o_); ro = *(const bf16x8*)(Z + tk * NZ + 512 + h * 128 + c8); rx = *(const bf16x8*)(XCg + o_); } \
               rk = *(const bf16x8*)(Kg + o_); rv = *(const bf16x8*)(Vg + o_); if (tid < 32) lfv = LF[((t0_) + tid) * 4 + h]; } } while (0)
    GLA_FETCH(sg * GSEGLEN);
    float sk8[8], nw8[8];
#pragma unroll
    for (int j = 0; j < 8; ++j) { sk8[j] = (MODE == 0 && PASS == 2) ? a.in[9][l * 512 + h * 128 + c8 + j] : 0.f; nw8[j] = (MODE == 1 && PASS == 2) ? a.in[20][l * 512 + h * 128 + c8 + j] : 0.f; }
    __syncthreads();
    if (MODE == 0) { for (int i = tid; i < 2 * 16 * 40; i += 512) { const int b = i / 640, k = i % 640; ((bf16_t*)(smem + GL_VT + b * 11520))[128 * 40 + k] = (k < 32) ? (bf16_t)0x3F80 : (bf16_t)0; } }
#define GLA_STORE(tprev, pb) do { const bf16x8 o8 = *(const bf16x8*)(OS + tok * 136 + c8); const bf16x8 p8 = *(const bf16x8*)((const bf16_t*)(smem + GL_RO + (pb) * 8704) + tok * 136 + c8); float y[8]; \
        if (MODE == 0) { const bf16x8 x8 = *(const bf16x8*)((const bf16_t*)(smem + GL_RX + (pb) * 8704) + tok * 136 + c8); const float di = __builtin_amdgcn_rcpf(fmaxf(fabsf(DNS[tok]), 1.0f)); \
            _Pragma("unroll") for (int j = 0; j < 8; ++j) y[j] = sigmoidf_(bf2f((bf16_t)p8[j])) * (bf2f((bf16_t)o8[j]) * di) + sk8[j] * bf2f((bf16_t)x8[j]); } \
        else { float ov[8], ss = 0.f; _Pragma("unroll") for (int j = 0; j < 8; ++j) { ov[j] = bf2f((bf16_t)o8[j]); ss += ov[j] * ov[j]; } \
            ss += __shfl_xor(ss, 1); ss += __shfl_xor(ss, 2); ss += __shfl_xor(ss, 4); ss += __shfl_xor(ss, 8); const float rinv = rsqrtf(ss * (1.0f / 128.0f) + 1e-6f); \
            _Pragma("unroll") for (int j = 0; j < 8; ++j) y[j] = ov[j] * rinv * nw8[j] * siluf_(bf2f((bf16_t)p8[j])); } \
        u32x4 w_; w_.x = pack2(y[0], y[1]); w_.y = pack2(y[2], y[3]); w_.z = pack2(y[4], y[5]); w_.w = pack2(y[6], y[7]); *(u32x4*)(Yg + (size_t)((tprev) + tok) * 512 + h * 128 + c8) = w_; } while (0)
    float runb = 0.f;
    for (int ci = 0; ci < GSEGLEN / 32; ++ci) {
        const int t0 = sg * GSEGLEN + ci * 32, buf = ci & 1;
        bf16_t* RQ = (bf16_t*)(smem + GL_RQ + buf * 8704); bf16_t* RK = (bf16_t*)(smem + GL_RK + buf * 8704); bf16_t* VT = (bf16_t*)(smem + GL_VT + buf * 11520);
        float* LFS = (float*)(smem + GL_LFS + buf * 128);
        if (PASS == 2) { *(bf16x8*)(RQ + tok * 136 + c8) = rq; *(bf16x8*)((bf16_t*)(smem + GL_RO + buf * 8704) + tok * 136 + c8) = ro; if (MODE == 0) *(bf16x8*)((bf16_t*)(smem + GL_RX + buf * 8704) + tok * 136 + c8) = rx; }
        *(bf16x8*)(RK + tok * 136 + c8) = rk;
#pragma unroll
        for (int j = 0; j < 8; ++j) VT[(c8 + j) * 40 + tok] = (bf16_t)rv[j];
        if (MODE == 0 && tid < 32) LFS[tid] = lfv;
        if (ci + 1 < GSEGLEN / 32) GLA_FETCH(t0 + 32);
        __syncthreads();
        float lg[8], kv[8];
#pragma unroll
        for (int j = 0; j < 8; ++j) { const float kr = bf2f(RK[(grp * 8 + j) * 136 + d]);
            if (MODE == 1) { const float f = lb + (1.0f - lb) * sigmoidf_(kr); lg[j] = flog(f); kv[j] = 1.0f - f; } else { lg[j] = LFS[grp * 8 + j]; kv[j] = kr; } }
        float cs[8]; cs[0] = lg[0];
#pragma unroll
        for (int j = 1; j < 8; ++j) cs[j] = cs[j - 1] + lg[j];
        GT[grp * 128 + d] = cs[7];
        __syncthreads();
        if (PASS == 2 && ci > 0) GLA_STORE(t0 - 32, buf ^ 1);
        const float g0 = GT[d], g1 = GT[128 + d], g2 = GT[256 + d], g3 = GT[384 + d];
        const float off = grp == 0 ? 0.f : grp == 1 ? g0 : grp == 2 ? g0 + g1 : g0 + g1 + g2;
        const float bmid = g0 + g1, bL = bmid + g2 + g3;
        bf16_t ktv[8];
#pragma unroll
        for (int j = 0; j < 8; ++j) { const float bt = off + cs[j], ek = fexp(__builtin_amdgcn_fmed3f(bmid - bt, -80.0f, 80.0f)); const bf16_t kt = f2bf(kv[j] * ek); ktv[j] = kt;
            if (PASS == 2) { const float qr = bf2f(RQ[(grp * 8 + j) * 136 + d]); const float qq = (MODE == 1) ? siluf_(qr) : qr; RQ[(grp * 8 + j) * 136 + d] = f2bf(qq * __builtin_amdgcn_rcpf(ek)); RK[(grp * 8 + j) * 136 + d] = kt; } }
        { u32x4 w; w.x = ktv[0] | ((unsigned)ktv[1] << 16); w.y = ktv[2] | ((unsigned)ktv[3] << 16); w.z = ktv[4] | ((unsigned)ktv[5] << 16); w.w = ktv[6] | ((unsigned)ktv[7] << 16); *(u32x4*)(KT + d * 40 + grp * 8) = w; }
        if (grp == 0) { SC1[d] = fexp(bmid); SC2[d] = fexp(bL - bmid); runb += bL; }
        __syncthreads();
        if (PASS == 2) {
            if (wave < 4) {
                const int ti = (wave == 1 || wave == 2) ? 1 : 0, tj = (wave >= 2) ? 1 : 0;
                f32x4 p = (f32x4){0.f, 0.f, 0.f, 0.f};
                if (wave < 3) {
#pragma unroll
                    for (int kk = 0; kk < 4; ++kk) { const bf16x8 av = *(const bf16x8*)(RQ + (16 * ti + r) * 136 + 32 * kk + 8 * q); const bf16x8 bv = *(const bf16x8*)(RK + (16 * tj + r) * 136 + 32 * kk + 8 * q); p = MFMA16(av, bv, p); }
                }
#pragma unroll
                for (int g = 0; g < 4; ++g) { const int t = 16 * ti + 4 * q + g, s_ = 16 * tj + r; PS[t * 40 + s_] = (wave < 3 && s_ <= t) ? f2bf(p[g]) : (bf16_t)0; }
            }
            __syncthreads();
        }
        const bf16x8 bV = *(const bf16x8*)(VT + (16 * wave + r) * 40 + 8 * q);
        bf16x8 bV1 = bV; if (xw) bV1 = *(const bf16x8*)(VT + (128 + r) * 40 + 8 * q);
        f32x4 o[2], ox[2];
        o[0] = o[1] = ox[0] = ox[1] = (f32x4){0.f, 0.f, 0.f, 0.f};
#pragma unroll
        for (int kk = 0; kk < 4; ++kk) {
            const f32x4 sa = *(const f32x4*)(SC1 + 32 * kk + 4 * q), sb = *(const f32x4*)(SC1 + 32 * kk + 16 + 4 * q);
            S[2 * kk] *= sa; S[2 * kk + 1] *= sb;
            if (xw) { SX[2 * kk] *= sa; SX[2 * kk + 1] *= sb; }
            if (PASS == 2) {
                bf16x8 bS, bX;
#pragma unroll
                for (int g = 0; g < 4; ++g) { bS[g] = (short)f2bf(S[2 * kk][g]); bS[4 + g] = (short)f2bf(S[2 * kk + 1][g]); bX[g] = (short)f2bf(SX[2 * kk][g]); bX[4 + g] = (short)f2bf(SX[2 * kk + 1][g]); }
#pragma unroll
                for (int mt = 0; mt < 2; ++mt) { const bf16x4 lo = *(const bf16x4*)(RQ + (16 * mt + r) * 136 + 32 * kk + 4 * q), hi = *(const bf16x4*)(RQ + (16 * mt + r) * 136 + 32 * kk + 16 + 4 * q);
                    bf16x8 av; av[0] = lo[0]; av[1] = lo[1]; av[2] = lo[2]; av[3] = lo[3]; av[4] = hi[0]; av[5] = hi[1]; av[6] = hi[2]; av[7] = hi[3];
                    o[mt] = MFMA16(av, bS, o[mt]); if (xw) ox[mt] = MFMA16(av, bX, ox[mt]); }
            }
        }
        if (PASS == 2) {
#pragma unroll
            for (int mt = 0; mt < 2; ++mt) { const bf16x8 av = *(const bf16x8*)(PS + (16 * mt + r) * 40 + 8 * q); o[mt] = MFMA16(av, bV, o[mt]); if (xw) ox[mt] = MFMA16(av, bV1, ox[mt]);
#pragma unroll
                for (int g = 0; g < 4; ++g) { OS[(16 * mt + 4 * q + g) * 136 + 16 * wave + r] = f2bf(o[mt][g]); if (xw && r == 0) DNS[16 * mt + 4 * q + g] = ox[mt][g]; } }
        }
#pragma unroll
        for (int i = 0; i < 8; ++i) { const bf16x8 av = *(const bf16x8*)(KT + (16 * i + r) * 40 + 8 * q); const f32x4 s2 = *(const f32x4*)(SC2 + 16 * i + 4 * q);
            S[i] = MFMA16(av, bV, S[i]); S[i] *= s2;
            if (xw) { SX[i] = MFMA16(av, bV1, SX[i]); SX[i] *= s2; } }
    }
    if (PASS == 2) { __syncthreads(); GLA_STORE(sg * GSEGLEN + GSEGLEN - 32, 1); }
    if (PASS == 1) {
        float* ST = (float*)smem;
        __syncthreads();
#pragma unroll
        for (int i = 0; i < 8; ++i)
#pragma unroll
            for (int g = 0; g < 4; ++g) { ST[(16 * i + 4 * q + g) * 132 + 16 * wave + r] = S[i][g]; if (xw) EX[((size_t)(sg * 4 + h) * 128 + 16 * i + 4 * q + g) * 16 + r] = SX[i][g]; }
        __syncthreads();
#pragma unroll
        for (int k = 0; k < 8; ++k) { const int idx = tid + 512 * k, row = idx >> 5, c4 = (idx & 31) * 4; *(f32x4*)(Eg + ((size_t)(sg * 4 + h) * 128 + row) * 128 + c4) = *(const f32x4*)(ST + row * 132 + c4); }
        if (grp == 0) Gg[(size_t)(sg * 4 + h) * 128 + d] = expf(runb);
    }
#undef GLA_FETCH
#undef GLA_STORE
}

template <int PASS>
__device__ __forceinline__ void s5_item(ArgsRef a, int l, int g, int sg, int g0, int tid, int lane, int wave, int hsel) {
    unsigned char* ws = a.ws;
    const bf16_t* Z = (const bf16_t*)(ws + OFF_Z); const float* ABAR = (const float*)(ws + OFF_ABAR); const bf16_t* BBT = (const bf16_t*)(ws + OFF_BBT); const bf16_t* CCT = (const bf16_t*)(ws + OFF_CCT);
    float* ES = (float*)(ws + OFF_ES); bf16_t* YPRE = (bf16_t*)(ws + OFF_YPRE);
    float* BU = (float*)(smem + 70000 + (wave & 3) * 12800); bf16_t* X = (bf16_t*)(smem + 70000 + (wave & 3) * 12800 + 8448); bf16_t* YT = (bf16_t*)(smem + 70000 + 51200);
    const int r = lane & 15, q = lane >> 4, p = lane; const bool act = (wave >> 2) == hsel;
    const float ar = ABAR[(g * 64 + p) * 2], ai = ABAR[(g * 64 + p) * 2 + 1];
    const bf16x8 zero8 = (bf16x8){0, 0, 0, 0, 0, 0, 0, 0};
    bf16x8 bB[8], cB[4];
#pragma unroll
    for (int nt = 0; nt < 8; ++nt) bB[nt] = (q < 2) ? *(const bf16x8*)(BBT + (size_t)(g * 128 + 16 * nt + r) * 16 + 8 * q) : zero8;
#pragma unroll
    for (int kk = 0; kk < 4; ++kk) cB[kk] = (PASS == 2) ? *(const bf16x8*)(CCT + (size_t)(g * 16 + r) * 128 + 32 * kk + 8 * q) : zero8;
    float xr = 0.f, xi = 0.f;
    if (PASS == 2) { xr = ES[((size_t)(sg * 32 + g) * 64 + p) * 2]; xi = ES[((size_t)(sg * 32 + g) * 64 + p) * 2 + 1]; }
    const float dsk = a.in[17][l * 512 + 16 * g + r];
    bf16x8 av_n = zero8; bf16_t un[4] = {0, 0, 0, 0};
#define S5_FETCH(t0_) do { if (q < 2) av_n = *(const bf16x8*)(Z + (size_t)((t0_) + r) * NZ + 1024 + 16 * g + 8 * q); \
        if (PASS == 2) { _Pragma("unroll") for (int gg_ = 0; gg_ < 4; ++gg_) un[gg_] = Z[(size_t)((t0_) + 4 * q + gg_) * NZ + 1024 + 16 * g + r]; } } while (0)
    if (act) S5_FETCH(sg * SSEGLEN);
    for (int ci = 0; ci < SSEGLEN / 16; ++ci) {
        const int t0 = sg * SSEGLEN + ci * 16;
        if (act) {
            const bf16x8 av = av_n; bf16_t uc[4] = {un[0], un[1], un[2], un[3]};
            if (ci + 1 < SSEGLEN / 16) S5_FETCH(t0 + 16);
#pragma unroll
            for (int nt = 0; nt < 8; ++nt) { f32x4 acc = (f32x4){0.f, 0.f, 0.f, 0.f}; acc = MFMA16(av, bB[nt], acc);
#pragma unroll
                for (int gg = 0; gg < 4; ++gg) BU[(4 * q + gg) * 132 + 16 * nt + r] = acc[gg]; }
            wave_sync();
#pragma unroll
            for (int t = 0; t < 16; ++t) { const float br = BU[t * 132 + p], bi = BU[t * 132 + 64 + p];
                const float nr = ar * xr - ai * xi + br, ni = ar * xi + ai * xr + bi; xr = nr; xi = ni;
                if (PASS == 2) { X[t * 136 + p] = f2bf(xr); X[t * 136 + 64 + p] = f2bf(xi); } }
            wave_sync();
            if (PASS == 2) {
                f32x4 acc = (f32x4){0.f, 0.f, 0.f, 0.f};
#pragma unroll
                for (int kk = 0; kk < 4; ++kk) { const bf16x8 xv = *(const bf16x8*)(X + r * 136 + 32 * kk + 8 * q); acc = MFMA16(xv, cB[kk], acc); }
#pragma unroll
                for (int gg = 0; gg < 4; ++gg) YT[(4 * q + gg) * 136 + 16 * wave + r] = f2bf(gelu_tanh(acc[gg] + dsk * bf2f(uc[gg])));
            }
        }
        if (PASS == 2) {
            __syncthreads();
            if (tid < 128) { const int row = tid >> 3, c8 = (tid & 7) * 8; *(u32x4*)(YPRE + (size_t)(t0 + row) * 512 + 16 * g0 + 64 * hsel + c8) = *(const u32x4*)(YT + row * 136 + 64 * hsel + c8); }
            __syncthreads();
        }
    }
    if (PASS == 1 && act) { ES[((size_t)(sg * 32 + g) * 64 + p) * 2] = xr; ES[((size_t)(sg * 32 + g) * 64 + p) * 2 + 1] = xi; }
#undef S5_FETCH
}

__device__ __forceinline__ void phase_scan(ArgsRef a, int tid, int bid, int G) {
    unsigned char* ws = a.ws;
    const int NT = G * 512, gt = bid * 512 + tid;
    for (int i = gt; i < 2 * 65536 + 8192 + 2048; i += NT) {
        if (i < 2 * 65536 + 8192) { const bool nx = i >= 2 * 65536; const int m = i >> 16, el = nx ? i - 2 * 65536 : (i & 65535), hrow = nx ? (el >> 4) : (el >> 7); const size_t str = nx ? 8192 : 65536;
            float* E = (float*)(ws + (nx ? OFF_EMX : (m == 0 ? OFF_EM : OFF_EH))); const float* Gd = (const float*)(ws + ((nx || m == 0) ? OFF_GM : OFF_GH));
            float ev[GSEG], gv[GSEG];
#pragma unroll
            for (int sg = 0; sg < GSEG; ++sg) { ev[sg] = E[(size_t)sg * str + el]; gv[sg] = Gd[sg * 512 + hrow]; }
            float cur = 0.f;
#pragma unroll
            for (int sg = 0; sg < GSEG; ++sg) { E[(size_t)sg * str + el] = cur; cur = gv[sg] * cur + ev[sg]; } }
        else { const int el = i - 2 * 65536 - 8192; float* E = (float*)(ws + OFF_ES); const float* ABAR = (const float*)(ws + OFF_ABAR);
            float pr = ABAR[el * 2], pi = ABAR[el * 2 + 1];
#pragma unroll
            for (int k = 0; k < 8; ++k) { const float nr = pr * pr - pi * pi, ni = 2.0f * pr * pi; pr = nr; pi = ni; }
            float xr = 0.f, xi = 0.f;
            for (int sb = 0; sb < SSEG; sb += 16) { float er[16], ei[16];
#pragma unroll
                for (int k = 0; k < 16; ++k) { er[k] = E[((size_t)(sb + k) * 2048 + el) * 2]; ei[k] = E[((size_t)(sb + k) * 2048 + el) * 2 + 1]; }
#pragma unroll
                for (int k = 0; k < 16; ++k) { E[((size_t)(sb + k) * 2048 + el) * 2] = xr; E[((size_t)(sb + k) * 2048 + el) * 2 + 1] = xi;
                    const float nr = pr * xr - pi * xi + er[k], ni = pr * xi + pi * xr + ei[k]; xr = nr; xi = ni; } } }
    }
}

template <int PASS>
__device__ __forceinline__ void phase_mixers(ArgsRef a, int l, int tid, int lane, int wave, int bid, int G) {
    for (int it = bid; it < 4 * GSEG; it += G) gla_item<0, PASS>(a, l, it % 4, it / 4, tid, lane, wave);
    asm volatile("" ::: "memory");
    for (int it = bid + ((4 * GSEG - bid % G) % G + G) % G * 0; it < 2 * 4 * GSEG; it += G) { if (it >= 4 * GSEG) gla_item<1, PASS>(a, l, (it - 4 * GSEG) % 4, (it - 4 * GSEG) / 4, tid, lane, wave); }
    __syncthreads();
    for (int it0 = bid * 8; it0 < 32 * SSEG; it0 += G * 8)
        for (int half = 0; half < 2; ++half) { const int it = it0 + wave; s5_item<PASS>(a, l, it % 32, it / 32, it0 % 32, tid, lane, wave, half); __syncthreads(); }
}

__device__ __forceinline__ void ln_row(f32x4 (&v)[4], const float* gam, const float* bet, int lane) {
    float s = 0.f;
#pragma unroll
    for (int j = 0; j < 4; ++j) s += (v[j][0] + v[j][1]) + (v[j][2] + v[j][3]);
#pragma unroll
    for (int o = 32; o >= 1; o >>= 1) s += __shfl_xor(s, o);
    const float mean = s * (1.0f / 1024.0f); float qv = 0.f;
#pragma unroll
    for (int j = 0; j < 4; ++j) { const f32x4 dd = v[j] - mean; qv += (dd[0] * dd[0] + dd[1] * dd[1]) + (dd[2] * dd[2] + dd[3] * dd[3]); }
#pragma unroll
    for (int o = 32; o >= 1; o >>= 1) qv += __shfl_xor(qv, o);
    const float rstd = rsqrtf(qv * (1.0f / 1024.0f) + 1e-5f);
#pragma unroll
    for (int j = 0; j < 4; ++j) { const f32x4 gg = *(const f32x4*)(gam + 256 * j + 4 * lane), bb = *(const f32x4*)(bet + 256 * j + 4 * lane); v[j] = (v[j] - mean) * rstd * gg + bb; }
}

__device__ __forceinline__ void phase_ln1r(ArgsRef a, int l, int tid, int lane, int wave, int bid, int G) {
    float* XF = a.out; bf16_t* XB = (bf16_t*)(a.ws + OFF_XB);
    int* TOKE = (int*)(a.ws + OFF_TOKE); float* TOKG = (float*)(a.ws + OFF_TOKG); unsigned* HIST = (unsigned*)(a.ws + OFF_HIST);
    const float* RWT = (const float*)(a.ws + OFF_RWT); const float* RB = a.in[30];
    float* LG = (float*)(smem + wave * 4096);
    int* TE = (int*)(smem + wave * 4096 + 2304); float* TG = (float*)(smem + wave * 4096 + 2432); unsigned* HS = (unsigned*)(smem + wave * 4096 + 2560);
    const int r = lane & 15, q = lane >> 4, rs = lane >> 5, e = lane & 31;
    if (G >= 256 && wave >= 4) {
        float* tw_lds = (float*)(smem + 16384 + (wave - 4) * 16640);
        for (int u = 896 + bid * 4 + (wave - 4); u < 6144; u += G * 4) wave_prepx_tile(a, l, u, lane, tw_lds);
    }
    for (int tw = bid + G * wave; tw < T / 16; tw += G * 8) {
        const int t0 = tw * 16;
        for (int rb = 0; rb < 16; rb += 4) { f32x4 v[4][4];
#pragma unroll
            for (int k = 0; k < 4; ++k)
#pragma unroll
                for (int j = 0; j < 4; ++j) v[k][j] = *(const f32x4*)(XF + (size_t)(t0 + rb + k) * 1024 + 256 * j + 4 * lane);
#pragma unroll
            for (int k = 0; k < 4; ++k) { const int t = t0 + rb + k; ln_row(v[k], a.in[25] + l * 1024, a.in[26] + l * 1024, lane);
#pragma unroll
                for (int j = 0; j < 4; ++j) { *(f32x4*)(XF + (size_t)t * 1024 + 256 * j + 4 * lane) = v[k][j];
                    u32x2 w; w.x = pack2(v[k][j][0], v[k][j][1]); w.y = pack2(v[k][j][2], v[k][j][3]); *(u32x2*)(XB + (size_t)t * 1024 + 256 * j + 4 * lane) = w; } } }
        if (lane < 32) HS[lane] = 0u;
        asm volatile("s_waitcnt vmcnt(0) lgkmcnt(0)" ::: "memory"); __builtin_amdgcn_wave_barrier();
        f32x4 acc0 = (f32x4){0.f, 0.f, 0.f, 0.f}, acc1 = acc0;
        const float* xa = XF + (size_t)(t0 + r) * 1024 + 4 * q; const float* w0 = RWT + (size_t)r * 1024 + 4 * q; const float* w1 = RWT + (size_t)(16 + r) * 1024 + 4 * q;
        f32x4 pa[2][4], pb[2][4], pc[2][4];
#define RT_LOAD(buf, g_) do { _Pragma("unroll") for (int k_ = 0; k_ < 4; ++k_) { pa[buf][k_] = *(const f32x4*)(xa + 16 * (4 * (g_) + k_)); pb[buf][k_] = *(const f32x4*)(w0 + 16 * (4 * (g_) + k_)); pc[buf][k_] = *(const f32x4*)(w1 + 16 * (4 * (g_) + k_)); } } while (0)
#define RT_MMA(buf) do { _Pragma("unroll") for (int k_ = 0; k_ < 4; ++k_) _Pragma("unroll") for (int j = 0; j < 4; ++j) { acc0 = __builtin_amdgcn_mfma_f32_16x16x4f32(pa[buf][k_][j], pb[buf][k_][j], acc0, 0, 0, 0); acc1 = __builtin_amdgcn_mfma_f32_16x16x4f32(pa[buf][k_][j], pc[buf][k_][j], acc1, 0, 0, 0); } } while (0)
        RT_LOAD(0, 0);
#pragma unroll 1
        for (int g2 = 0; g2 < 16; g2 += 2) {
            RT_LOAD(1, g2 + 1);
            RT_MMA(0);
            if (g2 + 2 < 16) RT_LOAD(0, g2 + 2);
            RT_MMA(1);
        }
#undef RT_LOAD
#undef RT_MMA
#pragma unroll
        for (int g = 0; g < 4; ++g) { LG[(4 * q + g) * 33 + r] = acc0[g]; LG[(4 * q + g) * 33 + 16 + r] = acc1[g]; }
        wave_sync();
        for (int pp = 0; pp < 8; ++pp) {
            const float lg = LG[(2 * pp + rs) * 33 + e];
            const float s = sigmoidf_(lg), sb = s + RB[e];
            float v4[4];
#pragma unroll
            for (int i = 0; i < 4; ++i) v4[i] = __shfl(sb, (lane & ~3) + i);
            int i1 = 0;
#pragma unroll
            for (int i = 1; i < 4; ++i) if (v4[i] > v4[i1]) i1 = i;
            int i2 = (i1 == 0) ? 1 : 0;
#pragma unroll
            for (int i = 0; i < 4; ++i) if (i != i1 && i != i2 && v4[i] > v4[i2]) i2 = i;
            float gs = v4[i1] + v4[i2]; int gid = e >> 2;
#pragma unroll
            for (int o = 4; o <= 16; o <<= 1) { const float os = __shfl_xor(gs, o); const int og = __shfl_xor(gid, o); if (os > gs || (os == gs && og < gid)) { gs = os; gid = og; } }
            float sv[4], sbv[4];
#pragma unroll
            for (int i = 0; i < 4; ++i) { sbv[i] = __shfl(sb, (lane & 32) + gid * 4 + i); sv[i] = __shfl(s, (lane & 32) + gid * 4 + i); }
            int j1 = 0;
#pragma unroll
            for (int i = 1; i < 4; ++i) if (sbv[i] > sbv[j1]) j1 = i;
            int j2 = (j1 == 0) ? 1 : 0;
#pragma unroll
            for (int i = 0; i < 4; ++i) if (i != j1 && i != j2 && sbv[i] > sbv[j2]) j2 = i;
            float s1 = sv[0], s2 = sv[0];
#pragma unroll
            for (int i = 1; i < 4; ++i) { if (i == j1) s1 = sv[i]; if (i == j2) s2 = sv[i]; }
            if (e == 0) { const int ti = 2 * pp + rs; const float inv = 1.0f / (s1 + s2);
                TE[ti * 2] = gid * 4 + j1; TE[ti * 2 + 1] = gid * 4 + j2; TG[ti * 2] = s1 * inv; TG[ti * 2 + 1] = s2 * inv;
                atomicAdd(&HS[gid * 4 + j1], 1u); atomicAdd(&HS[gid * 4 + j2], 1u); }
        }
        wave_sync();
        if (lane < 32) { TOKE[t0 * 2 + lane] = TE[lane]; TOKG[t0 * 2 + lane] = TG[lane]; HIST[tw * 32 + lane] = HS[lane]; }
        wave_sync();
    }
    __syncthreads();
}

__device__ __forceinline__ void phase_slot(ArgsRef a, int tid, int lane, int wave, int bid, int G) {
    const int* TOKE = (const int*)(a.ws + OFF_TOKE); int* TOKS = (int*)(a.ws + OFF_TOKS); const unsigned* HIST = (const unsigned*)(a.ws + OFF_HIST);
    unsigned* BASE = (unsigned*)(a.ws + OFF_CTL) + 64;
    const bf16_t* XB = (const bf16_t*)(a.ws + OFF_XB); bf16_t* XG = (bf16_t*)(a.ws + OFF_XG);
    unsigned* base = (unsigned*)smem; unsigned* pre = base + 40; int* el = (int*)(base + 80); int* sl = (int*)(base + 208); unsigned* red = base + 336;
    const int e = tid & 31, part = tid >> 5;
    for (int c = bid; c < T / 64; c += G) {
        unsigned tot = 0u, pr = 0u;
#pragma unroll 16
        for (int it = part; it < 1024; it += 16) { const unsigned v = HIST[it * 32 + e]; tot += v; pr += (it < 4 * c) ? v : 0u; }
        red[part * 32 + e] = tot; red[512 + part * 32 + e] = pr;
        __syncthreads();
        if (tid < 32) { unsigned t2 = 0u, p2 = 0u; for (int k = 0; k < 16; ++k) { t2 += red[k * 32 + tid]; p2 += red[512 + k * 32 + tid]; } pre[tid] = p2; red[tid] = (t2 + 255u) & ~255u; }
        __syncthreads();
        if (tid == 0) { unsigned sacc = 0; for (int k = 0; k < 32; ++k) { base[k] = sacc; sacc += red[k]; } base[32] = sacc; }
        int ee = 0;
        if (tid < 128) { ee = TOKE[c * 128 + tid]; el[tid] = ee; }
        __syncthreads();
        if (c == 0 && tid < 33) BASE[tid] = base[tid];
        if (c == 0 && tid >= 64 && tid < 64 + 160) { const unsigned t256 = (unsigned)(tid - 64) * 256u; int ee2 = 0; while (ee2 < 31 && base[ee2 + 1] <= t256) ++ee2; BASE[64 + (tid - 64)] = (unsigned)ee2; }
        if (tid < 128) { unsigned rank = 0; for (int i = 0; i < tid; ++i) rank += (el[i] == ee) ? 1u : 0u;
            const unsigned sidx = base[ee] + pre[ee] + rank; sl[tid] = (int)sidx; TOKS[c * 128 + tid] = (int)sidx; }
        __syncthreads();
        for (int ib = 0; ib < 16; ib += 8) { u32x4 ra[8], rb[8];
#pragma unroll
            for (int k = 0; k < 8; ++k) { const int i = wave + 8 * (ib + k), t = c * 64 + (i >> 1); ra[k] = *(const u32x4*)(XB + (size_t)t * 1024 + lane * 8); rb[k] = *(const u32x4*)(XB + (size_t)t * 1024 + 512 + lane * 8); }
#pragma unroll
            for (int k = 0; k < 8; ++k) { const int i = wave + 8 * (ib + k); const size_t so = (size_t)sl[i] * 1024; *(u32x4*)(XG + so + lane * 8) = ra[k]; *(u32x4*)(XG + so + 512 + lane * 8) = rb[k]; } }
        __syncthreads();
    }
}

__device__ __forceinline__ void phase_ln2(ArgsRef a, int l, int lane, int gw, int GW) {
    float* XF = a.out; bf16_t* XB = (bf16_t*)(a.ws + OFF_XB); const bf16_t* YS = (const bf16_t*)(a.ws + OFF_YS);
    const int* TOKS = (const int*)(a.ws + OFF_TOKS); const float* TOKG = (const float*)(a.ws + OFF_TOKG);
    for (int tb = gw * 4; tb < T; tb += GW * 4) {
        int sv = 0; float gv = 0.f; if (lane < 8) { sv = TOKS[tb * 2 + lane]; gv = TOKG[tb * 2 + lane]; }
        f32x4 v[4][4]; bf16x4 y0[4][4], y1[4][4]; float g0[4], g1[4];
#pragma unroll
        for (int k = 0; k < 4; ++k) { const int s0 = __shfl(sv, 2 * k), s1 = __shfl(sv, 2 * k + 1); g0[k] = __shfl(gv, 2 * k); g1[k] = __shfl(gv, 2 * k + 1);
#pragma unroll
            for (int j = 0; j < 4; ++j) { v[k][j] = *(const f32x4*)(XF + (size_t)(tb + k) * 1024 + 256 * j + 4 * lane);
                y0[k][j] = *(const bf16x4*)(YS + (size_t)s0 * 1024 + 256 * j + 4 * lane); y1[k][j] = *(const bf16x4*)(YS + (size_t)s1 * 1024 + 256 * j + 4 * lane); } }
#pragma unroll
        for (int k = 0; k < 4; ++k) {
#pragma unroll
            for (int j = 0; j < 4; ++j)
#pragma unroll
                for (int g = 0; g < 4; ++g) v[k][j][g] = DN_ALPHA * v[k][j][g] + g0[k] * bf2f((bf16_t)y0[k][j][g]) + g1[k] * bf2f((bf16_t)y1[k][j][g]);
            ln_row(v[k], a.in[27] + l * 1024, a.in[28] + l * 1024, lane);
#pragma unroll
            for (int j = 0; j < 4; ++j) { *(f32x4*)(XF + (size_t)(tb + k) * 1024 + 256 * j + 4 * lane) = v[k][j];
                u32x2 w; w.x = pack2(v[k][j][0], v[k][j][1]); w.y = pack2(v[k][j][2], v[k][j][3]); *(u32x2*)(XB + (size_t)(tb + k) * 1024 + 256 * j + 4 * lane) = w; } }
    }
}

struct SchedGrid {
    int nM, nN, G, c; const char* A; const char* B; size_t strideA, strideB;
    __device__ __forceinline__ bool next(int i, pg8::Unit& u) const { int pm, pn; if (!pg8::tile_order(i * G + c, nM, nN, pm, pn)) return false;
        u.pm = pm; u.pn = pn; u.tag = 0; u.A = A + (size_t)pm * strideA; u.B = B + (size_t)pn * strideB; return true; }
};
constexpr int GATES_LD = 3072;
template <int MODE> struct EpiBf16 {
    static constexpr bool PERM = true;
    bf16_t* O; int ldo; const bf16_t* Y; int ldy;
    __device__ __forceinline__ bool operator()(f32x4 (&acc)[2][2][4][2], const pg8::Unit& u, int wr, int wc, int fr, int fq) const {
#pragma unroll
        for (int ai = 0; ai < 2; ++ai) {
            bf16x8 yv[4][2];
            if (MODE == 2) {
#pragma unroll
                for (int m = 0; m < 4; ++m)
#pragma unroll
                    for (int bj = 0; bj < 2; ++bj) yv[m][bj] = *(const bf16x8*)(Y + ((size_t)u.pm * 256 + ai * 128 + wr * 64 + m * 16 + fr) * ldy + u.pn * 256 + bj * 128 + wc * 32 + 8 * fq);
            }
#pragma unroll
            for (int m = 0; m < 4; ++m) { const size_t row = (size_t)u.pm * 256 + ai * 128 + wr * 64 + m * 16 + fr;
#pragma unroll
                for (int bj = 0; bj < 2; ++bj) { const int col = u.pn * 256 + bj * 128 + wc * 32 + 8 * fq; f32x4 v0 = acc[ai][bj][m][0], v1 = acc[ai][bj][m][1];
                    if (MODE == 1) {
#pragma unroll
                        for (int j = 0; j < 4; ++j) { v0[j] = fmaxf(sigmoidf_(v0[j]), 1e-30f); v1[j] = fmaxf(sigmoidf_(v1[j]), 1e-30f); } }
                    if (MODE == 2) {
#pragma unroll
                        for (int j = 0; j < 4; ++j) { v0[j] = bf2f((bf16_t)yv[m][bj][j]) * sigmoidf_(v0[j]); v1[j] = bf2f((bf16_t)yv[m][bj][4 + j]) * sigmoidf_(v1[j]); } }
                    u32x4 w; w.x = pg8::cvt_pk_bf16(v0[0], v0[1]); w.y = pg8::cvt_pk_bf16(v0[2], v0[3]); w.z = pg8::cvt_pk_bf16(v1[0], v1[1]); w.w = pg8::cvt_pk_bf16(v1[2], v1[3]);
                    if (MODE == 1) *(u32x4*)(O + ((((size_t)u.pm * 12 + u.pn) * 16 + (ai * 8 + m * 2 + bj)) * 512 + ((wr * 4 + wc) * 64 + fq * 16 + fr)) * 8) = w;
                    else *(u32x4*)(O + row * ldo + col) = w; } }
        }
        return false;
    }
};
struct SchedZ {
    int G, c; const unsigned char* ws;
    __device__ __forceinline__ bool next(int i, pg8::Unit& u) const { int pm, pn; if (!pg8::tile_order(i * G + c, T / 256, 15, pm, pn)) return false;
        u.pm = pm; u.pn = pn; u.tag = 0; u.A = (const char*)(ws + OFF_XB) + (size_t)pm * 256 * 1024 * 2;
        u.B = (const char*)(ws + OFF_WIN) + (size_t)(pn < 14 ? pn * 256 : 6656) * 1024 * 2; return true; }
};
struct EpiZ {
    static constexpr bool PERM = true;
    bf16_t* Z; float* LI; float* LF; const float* bi; const float* bf;
    __device__ __forceinline__ bool operator()(f32x4 (&acc)[2][2][4][2], const pg8::Unit& u, int wr, int wc, int fr, int fq) const {
        if (u.pn < 14) {
#pragma unroll
            for (int ai = 0; ai < 2; ++ai)
#pragma unroll
                for (int m = 0; m < 4; ++m) { const size_t row = (size_t)u.pm * 256 + ai * 128 + wr * 64 + m * 16 + fr;
#pragma unroll
                    for (int bj = 0; bj < 2; ++bj) { const int col = u.pn * 256 + bj * 128 + wc * 32 + 8 * fq; const f32x4 v0 = acc[ai][bj][m][0], v1 = acc[ai][bj][m][1];
                        u32x4 w; w.x = pg8::cvt_pk_bf16(v0[0], v0[1]); w.y = pg8::cvt_pk_bf16(v0[2], v0[3]); w.z = pg8::cvt_pk_bf16(v1[0], v1[1]); w.w = pg8::cvt_pk_bf16(v1[2], v1[3]);
                        *(u32x4*)(Z + row * NZ + col) = w; } }
        } else if (wc == 0 && fq == 0) {
            const f32x4 b_i = *(const f32x4*)bi, b_f = *(const f32x4*)bf;
#pragma unroll
            for (int ai = 0; ai < 2; ++ai)
#pragma unroll
                for (int m = 0; m < 4; ++m) { const size_t row = (size_t)u.pm * 256 + ai * 128 + wr * 64 + m * 16 + fr; const f32x4 v0 = acc[ai][0][m][0] + b_i, v1 = acc[ai][0][m][1] + b_f;
                    f32x4 lf; lf[0] = logsigmoidf_(v1[0]); lf[1] = logsigmoidf_(v1[1]); lf[2] = logsigmoidf_(v1[2]); lf[3] = logsigmoidf_(v1[3]);
                    *(f32x4*)(LI + row * 4) = v0; *(f32x4*)(LF + row * 4) = lf; }
        }
        return false;
    }
};
__device__ __forceinline__ void phase_zgemm2(ArgsRef a, int l, int tid, int bid, int G) {
    SchedZ S{G, bid, a.ws}; EpiZ E{(bf16_t*)(a.ws + OFF_Z), (float*)(a.ws + OFF_LI), (float*)(a.ws + OFF_LF), a.in[7] + l * 4, a.in[8] + l * 4};
    pg8::gemm_phase((PG8_LAS unsigned char*)smem, tid, 1024, 1024, 1024, S, E);
}
__device__ __forceinline__ void phase_glu_gates(ArgsRef a, int l, int tid, int bid, int G) {
    { SchedGrid S{T / 256, 2, G, bid, (const char*)(a.ws + OFF_YPRE), (const char*)(a.ws + OFF_WGLU), (size_t)256 * 512 * 2, (size_t)256 * 512 * 2};
      EpiBf16<2> E{(bf16_t*)(a.ws + OFF_YSG), 512, (const bf16_t*)(a.ws + OFF_YPRE), 512};
      pg8::gemm_phase((PG8_LAS unsigned char*)smem, tid, 512, 512, 512, S, E); }
    asm volatile("" : "+v"(tid), "+s"(bid), "+s"(G));
    if (G > 128) { if (bid >= 128) phase_prepx(a, l, tid, bid - 128, G - 128, 0, 896); } else phase_prepx(a, l, tid, bid, G, 0, 896);
    asm volatile("" : "+v"(tid), "+s"(bid), "+s"(G));
    { SchedGrid S{T / 256, 12, G, (bid + G / 2) % G, (const char*)(a.ws + OFF_XB), (const char*)(a.ws + OFF_WIN + (size_t)NZ * 1024 * 2), (size_t)256 * 1024 * 2, (size_t)256 * 1024 * 2};
      EpiBf16<1> E{(bf16_t*)(a.ws + OFF_Z), GATES_LD, nullptr, 0};
      pg8::gemm_phase((PG8_LAS unsigned char*)smem, tid, 1024, 1024, 1024, S, E); }
}
struct SchedMerge {
    int G, c; const unsigned char* ws;
    __device__ __forceinline__ bool next(int i, pg8::Unit& u) const { const int b = i % 3; int pm, pn; if (!pg8::tile_order((i / 3) * G + c, T / 256, 4, pm, pn)) return false;
        u.pm = pm; u.pn = pn; u.tag = b; u.A = (const char*)(ws + (b == 0 ? OFF_OM : b == 1 ? OFF_YSG : OFF_OH)) + (size_t)pm * 256 * 512 * 2;
        u.B = (const char*)(ws + OFF_WB) + ((size_t)b * 1024 + pn * 256) * 512 * 2; return true; }
};
struct EpiMerge {
    static constexpr bool PERM = true;
    const bf16_t* GT; bf16_t* O;
    __device__ __forceinline__ bool operator()(f32x4 (&acc)[2][2][4][2], const pg8::Unit& u, int wr, int wc, int fr, int fq) const {
        const int b = u.tag;
        const bf16_t* gbase = GT + (((size_t)u.pm * 12 + b * 4 + u.pn) * 16 * 512 + ((wr * 4 + wc) * 64 + fq * 16 + fr)) * 8;
        bf16x8 gb[2][2][2], gn[2][2][2];
#define MG_LOAD(buf, ai_, mh_) do { _Pragma("unroll") for (int mm = 0; mm < 2; ++mm) _Pragma("unroll") for (int bj = 0; bj < 2; ++bj) { const bf16_t* gp = gbase + (size_t)((ai_) * 8 + (2 * (mh_) + mm) * 2 + bj) * 512 * 8; \
            gb[buf][mm][bj] = *(const bf16x8*)gp; gn[buf][mm][bj] = (b < 2) ? *(const bf16x8*)(gp + (size_t)4 * 16 * 512 * 8) : gb[buf][mm][bj]; } } while (0)
        MG_LOAD(0, 0, 0);
#pragma unroll
        for (int st = 0; st < 4; ++st) { const int ai = st >> 1, mh = st & 1, buf = st & 1;
            if (st + 1 < 4) { if (buf == 0) MG_LOAD(1, (st + 1) >> 1, (st + 1) & 1); else MG_LOAD(0, (st + 1) >> 1, (st + 1) & 1); }
#pragma unroll
            for (int mm = 0; mm < 2; ++mm) { const int m = 2 * mh + mm; const size_t row = (size_t)u.pm * 256 + ai * 128 + wr * 64 + m * 16 + fr;
#pragma unroll
                for (int bj = 0; bj < 2; ++bj) { const int col = u.pn * 256 + bj * 128 + wc * 32 + 8 * fq;
                    if (b < 2) {
#pragma unroll
                        for (int j = 0; j < 4; ++j) { acc[ai][bj][m][0][j] *= bf2f((bf16_t)gb[buf][mm][bj][j]) * __builtin_amdgcn_rcpf(bf2f((bf16_t)gn[buf][mm][bj][j])); acc[ai][bj][m][1][j] *= bf2f((bf16_t)gb[buf][mm][bj][4 + j]) * __builtin_amdgcn_rcpf(bf2f((bf16_t)gn[buf][mm][bj][4 + j])); } }
                    else { f32x4 v0 = acc[ai][bj][m][0], v1 = acc[ai][bj][m][1];
#pragma unroll
                        for (int j = 0; j < 4; ++j) { v0[j] *= bf2f((bf16_t)gb[buf][mm][bj][j]); v1[j] *= bf2f((bf16_t)gb[buf][mm][bj][4 + j]); }
                        u32x4 w; w.x = pg8::cvt_pk_bf16(v0[0], v0[1]); w.y = pg8::cvt_pk_bf16(v0[2], v0[3]); w.z = pg8::cvt_pk_bf16(v1[0], v1[1]); w.w = pg8::cvt_pk_bf16(v1[2], v1[3]);
                        *(u32x4*)(O + row * 1024 + col) = w; } } }
        }
#undef MG_LOAD
        return b < 2;
    }
};
__device__ __forceinline__ void phase_merge2(ArgsRef a, int tid, int bid, int G) {
    SchedMerge S{G, bid, a.ws}; EpiMerge E{(const bf16_t*)(a.ws + OFF_Z), (bf16_t*)(a.ws + OFF_XB)};
    pg8::gemm_phase((PG8_LAS unsigned char*)smem, tid, 512, 512, 512, S, E);
}
struct EpiResid {
    static constexpr bool PERM = false;
    const float* xin; float* XF;
    __device__ __forceinline__ bool operator()(f32x4 (&acc)[2][2][4][2], const pg8::Unit& u, int wr, int wc, int fr, int fq) const {
#pragma unroll
        for (int ai = 0; ai < 2; ++ai)
#pragma unroll
        for (int mh = 0; mh < 2; ++mh) {
            f32x4 xv[2][2][2];
#pragma unroll
            for (int mm = 0; mm < 2; ++mm)
#pragma unroll
                for (int bj = 0; bj < 2; ++bj)
#pragma unroll
                    for (int n = 0; n < 2; ++n) xv[mm][bj][n] = *(const f32x4*)(xin + ((size_t)u.pm * 256 + ai * 128 + wr * 64 + (2 * mh + mm) * 16 + fr) * 1024 + u.pn * 256 + bj * 128 + wc * 32 + 16 * n + 4 * fq);
#pragma unroll
            for (int mm = 0; mm < 2; ++mm)
#pragma unroll
                for (int bj = 0; bj < 2; ++bj)
#pragma unroll
                    for (int n = 0; n < 2; ++n) { const int m = 2 * mh + mm; const size_t o = ((size_t)u.pm * 256 + ai * 128 + wr * 64 + m * 16 + fr) * 1024 + u.pn * 256 + bj * 128 + wc * 32 + 16 * n + 4 * fq; *(f32x4*)(XF + o) = DN_ALPHA * xv[mm][bj][n] + acc[ai][bj][m][n]; }
        }
        return false;
    }
};
__device__ __forceinline__ void phase_wout2(ArgsRef a, int l, int tid, int bid, int G) {
    SchedGrid S{T / 256, 4, G, bid, (const char*)(a.ws + OFF_XB), (const char*)(a.ws + OFF_WOUT), (size_t)256 * 1024 * 2, (size_t)256 * 1024 * 2};
    EpiResid E{(l == 0) ? a.in[0] : a.out, a.out};
    pg8::gemm_phase((PG8_LAS unsigned char*)smem, tid, 1024, 1024, 1024, S, E);
}
struct SchedBD {
    int nM, nN, G, c; const char* A; const char* B; unsigned strideA, strideB;
    __device__ __forceinline__ bool next(int i, pg8::Unit& u) const { int pm, pn; if (!pg8::tile_order(i * G + c, nM, nN, pm, pn)) return false;
        const unsigned ko = (unsigned)(pn & 1) * 512u; u.pm = pm; u.pn = pn; u.tag = 0; u.A = A + ((unsigned)pm * strideA + ko); u.B = B + ((unsigned)pn * strideB + ko); return true; }
};
struct EpiQKV {
    static constexpr bool PERM = true;
    int vcall; bf16_t* Q; bf16_t* KH; bf16_t* V; const float* LI;
    __device__ __forceinline__ bool operator()(f32x4 (&acc)[2][2][4][2], const pg8::Unit& u, int wr, int wc, int fr, int fq) const {
        const int which = vcall ? 2 : (u.pn >> 1); bf16_t* O = Q + (size_t)which * (SZ_ACT / 2);
        float liv[2][4][2];
#pragma unroll
        for (int ai = 0; ai < 2; ++ai)
#pragma unroll
            for (int m = 0; m < 4; ++m)
#pragma unroll
                for (int bj = 0; bj < 2; ++bj) liv[ai][m][bj] = (which == 1) ? LI[((size_t)u.pm * 256 + ai * 128 + wr * 64 + m * 16 + fr) * 4 + (u.pn & 1) * 2 + bj] : 0.f;
#pragma unroll
        for (int ai = 0; ai < 2; ++ai)
#pragma unroll
            for (int m = 0; m < 4; ++m) { const size_t row = (size_t)u.pm * 256 + ai * 128 + wr * 64 + m * 16 + fr;
#pragma unroll
                for (int bj = 0; bj < 2; ++bj) { const int hd = (u.pn & 1) * 2 + bj, col = hd * 128 + wc * 32 + 8 * fq;
                    const float sc = which == 0 ? 0.08838834764831845f : which == 1 ? fexp(liv[ai][m][bj]) : 1.0f;
                    const f32x4 v0 = acc[ai][bj][m][0] * sc, v1 = acc[ai][bj][m][1] * sc;
                    u32x4 w; w.x = pg8::cvt_pk_bf16(v0[0], v0[1]); w.y = pg8::cvt_pk_bf16(v0[2], v0[3]); w.z = pg8::cvt_pk_bf16(v1[0], v1[1]); w.w = pg8::cvt_pk_bf16(v1[2], v1[3]);
                    *(u32x4*)(O + row * 512 + col) = w; } }
        return false;
    }
};
__device__ __forceinline__ void phase_mprep2(ArgsRef a, int l, int tid, int bid, int G) {
    const bf16_t* Z = (const bf16_t*)(a.ws + OFF_Z); bf16_t* XC = (bf16_t*)(a.ws + OFF_XC);
    const float* cw = a.in[2] + (size_t)l * 4 * 512; const float* cb = a.in[3] + (size_t)l * 512;
    for (int idx = bid * 512 + tid; idx < (T / 8) * 64; idx += G * 512) {
        const int tb = (idx / 64) * 8, c0 = (idx % 64) * 8;
        bf16x8 xr[11];
#pragma unroll
        for (int k = 0; k < 11; ++k) { const int ts = tb - 3 + k; xr[k] = (ts >= 0) ? *(const bf16x8*)(Z + (size_t)ts * NZ + c0) : (bf16x8){0, 0, 0, 0, 0, 0, 0, 0}; }
        float w[4][8], b[8];
#pragma unroll
        for (int j = 0; j < 8; ++j) { b[j] = cb[c0 + j];
#pragma unroll
            for (int k = 0; k < 4; ++k) w[k][j] = cw[k * 512 + c0 + j]; }
#pragma unroll
        for (int tt = 0; tt < 8; ++tt) { float acc[8];
#pragma unroll
            for (int j = 0; j < 8; ++j) { acc[j] = b[j];
#pragma unroll
                for (int k = 0; k < 4; ++k) acc[j] += w[k][j] * bf2f((bf16_t)xr[tt + k][j]); }
            u32x4 o; o.x = pack2(siluf_(acc[0]), siluf_(acc[1])); o.y = pack2(siluf_(acc[2]), siluf_(acc[3])); o.z = pack2(siluf_(acc[4]), siluf_(acc[5])); o.w = pack2(siluf_(acc[6]), siluf_(acc[7]));
            *(u32x4*)(XC + (size_t)(tb + tt) * 512 + c0) = o; }
    }
}

__device__ __forceinline__ void phase_v_conv(ArgsRef a, int l, int tid, int bid, int G) {
    if (G > 128 && bid >= 128) { phase_mprep2(a, l, tid, bid - 128, G - 128); return; }
    { SchedBD S{T / 256, 2, G, bid, (const char*)(a.ws + OFF_Z), (const char*)(a.ws + OFF_WQKV + (size_t)1024 * 512 * 2), 256u * NZ * 2u, 256u * 512u * 2u};
      EpiQKV E{1, (bf16_t*)(a.ws + OFF_Q), (bf16_t*)(a.ws + OFF_KH), (bf16_t*)(a.ws + OFF_V), (const float*)(a.ws + OFF_LI)};
      pg8::gemm_phase((PG8_LAS unsigned char*)smem, tid, 256, NZ, 512, S, E); }
    if (G <= 128) { asm volatile("" : "+v"(tid), "+s"(bid), "+s"(G)); phase_mprep2(a, l, tid, bid, G); }
}
__device__ __forceinline__ void phase_qk(ArgsRef a, int tid, int bid, int G) {
    SchedBD S{T / 256, 4, G, bid, (const char*)(a.ws + OFF_XC), (const char*)(a.ws + OFF_WQKV), 256u * 512u * 2u, 256u * 512u * 2u};
    EpiQKV E{0, (bf16_t*)(a.ws + OFF_Q), (bf16_t*)(a.ws + OFF_KH), (bf16_t*)(a.ws + OFF_V), (const float*)(a.ws + OFF_LI)};
    int kk = 256; asm volatile("" : "+s"(kk));
    pg8::gemm_phase((PG8_LAS unsigned char*)smem, tid, kk, 512, 512, S, E);
}
struct SchedMoE {
    int down, G, c; const unsigned char* ws; const unsigned* BASE;
    __device__ __forceinline__ bool next(int i, pg8::Unit& u) const { const int per = down ? 4 : 2, L = i * G + c, ntile = (int)(BASE[32] >> 8); if (L >= ntile * per) return false;
        const int tile = L / per, sub = L % per; const int e = (int)BASE[64 + tile];
        u.pm = tile; u.pn = sub; u.tag = e;
        if (!down) { u.A = (const char*)(ws + OFF_XG) + (size_t)tile * 256 * 1024 * 2; u.B = (const char*)(ws + OFF_WGU) + ((size_t)e * 512 + sub * 256) * 1024 * 2; }
        else { u.A = (const char*)(ws + OFF_H) + (size_t)tile * 256 * 256 * 2; u.B = (const char*)(ws + OFF_WD) + ((size_t)e * 1024 + sub * 256) * 256 * 2; }
        return true; }
};
struct EpiH {
    static constexpr bool PERM = true;
    bf16_t* H;
    __device__ __forceinline__ bool operator()(f32x4 (&acc)[2][2][4][2], const pg8::Unit& u, int wr, int wc, int fr, int fq) const {
#pragma unroll
        for (int ai = 0; ai < 2; ++ai)
#pragma unroll
            for (int m = 0; m < 4; ++m) { const size_t row = (size_t)u.pm * 256 + ai * 128 + wr * 64 + m * 16 + fr; f32x4 v0, v1;
#pragma unroll
                for (int j = 0; j < 4; ++j) { v0[j] = siluf_(acc[ai][0][m][0][j]) * acc[ai][1][m][0][j]; v1[j] = siluf_(acc[ai][0][m][1][j]) * acc[ai][1][m][1][j]; }
                u32x4 w; w.x = pg8::cvt_pk_bf16(v0[0], v0[1]); w.y = pg8::cvt_pk_bf16(v0[2], v0[3]); w.z = pg8::cvt_pk_bf16(v1[0], v1[1]); w.w = pg8::cvt_pk_bf16(v1[2], v1[3]);
                *(u32x4*)(H + row * 256 + u.pn * 128 + wc * 32 + 8 * fq) = w; }
        return false;
    }
};
__device__ __forceinline__ void phase_moe_gu2(ArgsRef a, int l, int tid, int bid, int G) {
    { SchedMoE S{0, G, bid, a.ws, (const unsigned*)(a.ws + OFF_CTL) + 64}; EpiH E{(bf16_t*)(a.ws + OFF_H)};
      pg8::gemm_phase((PG8_LAS unsigned char*)smem, tid, 1024, 1024, 1024, S, E); }
    if (l + 1 < NLAYER) {
        asm volatile("" : "+v"(tid), "+s"(bid), "+s"(G));
        const int ntile = (int)(((const unsigned*)(a.ws + OFF_CTL))[64 + 32] >> 8); int nb = ntile * 2 - G; nb = nb < 0 ? 0 : (nb > G - 1 ? G - 1 : nb);
        if (bid >= nb) phase_prep(a, l + 1, tid, bid - nb, G - nb);
    }
}
__device__ __forceinline__ void phase_moe_dn2(ArgsRef a, int tid, int bid, int G) {
    SchedMoE S{1, G, bid, a.ws, (const unsigned*)(a.ws + OFF_CTL) + 64}; EpiBf16<0> E{(bf16_t*)(a.ws + OFF_YS), 1024, nullptr, 0};
    pg8::gemm_phase((PG8_LAS unsigned char*)smem, tid, 256, 256, 256, S, E);
}
#define XB_TMO      128
#define XB_XCNT(j)  (256  + 64 * (j))
#define XB_XSUB(j)  (1280 + 64 * (j))
#define XB_XGEN(j)  (2304 + 64 * (j))
#define XB_TOP      3328
#define XB_TOPGEN   3392
#define XCD_BAR_WORDS 3456
#define XB_SPIN_CAP (1u << 22)
__device__ __forceinline__ unsigned xb_ld(unsigned* p)              { return __hip_atomic_load(p, __ATOMIC_RELAXED, __HIP_MEMORY_SCOPE_AGENT); }
__device__ __forceinline__ unsigned xb_add(unsigned* p, unsigned v) { return __hip_atomic_fetch_add(p, v, __ATOMIC_RELAXED, __HIP_MEMORY_SCOPE_AGENT); }
__device__ __forceinline__ unsigned xb_xcc_id() { return (unsigned)__builtin_amdgcn_s_getreg((3 << 11) | 20) & 0xFu; }
#define XB_SPIN(cond, bar) do { unsigned _sp = 0; while (cond) { __builtin_amdgcn_s_sleep(1); \
    if ((++_sp & 255u) == 0u) { if (xb_ld(&(bar)[XB_TMO])) break; if (_sp > XB_SPIN_CAP) { atomicAdd(&(bar)[XB_TMO], 1u); break; } } } } while (0)
__device__ __forceinline__ void xcd_barrier_complete(unsigned* bar, unsigned x, unsigned& nloc, unsigned& nx) {
    const unsigned G = gridDim.x; unsigned sum, cnt, mine, sp = 0u;
    for (;;) { sum = 0u; cnt = 0u; mine = 0u;
#pragma unroll
        for (unsigned j = 0; j < 16; ++j) { const unsigned c = xb_ld(&bar[XB_XCNT(j)]); sum += c; cnt += (c > 0u) ? 1u : 0u; mine = (j == x) ? c : mine; }
        if (sum == G) break;
        __builtin_amdgcn_s_sleep(1);
        if ((++sp & 255u) == 0u) { if (xb_ld(&bar[XB_TMO])) break; if (sp > XB_SPIN_CAP) { atomicAdd(&bar[XB_TMO], 1u); break; } } }
    nloc = mine > 0u ? mine : 1u; nx = cnt > 0u ? cnt : 1u;
}
__device__ __forceinline__ void xcd_barrier(unsigned* bar, volatile __attribute__((address_space(3))) unsigned* st) {
    asm volatile("s_waitcnt vmcnt(0)" ::: "memory");
    __syncthreads();
    if (threadIdx.x == 0) {
        __builtin_amdgcn_s_waitcnt(0);
        const unsigned x = xb_xcc_id();
        unsigned nloc = st[0], nx = st[1];
        if (nloc == 0u) { xcd_barrier_complete(bar, x, nloc, nx); st[0] = nloc; st[1] = nx; }
        const unsigned old = xb_add(&bar[XB_XSUB(x)], 1u);
        const unsigned gen = old / nloc;
        if (old + 1u == (gen + 1u) * nloc) {
            __builtin_amdgcn_fence(__ATOMIC_RELEASE, "agent");
            asm volatile("s_waitcnt vmcnt(0)" ::: "memory");
            const unsigned og = xb_add(&bar[XB_TOP], 1u);
            const unsigned tg = og / nx;
            if (og + 1u == (tg + 1u) * nx) xb_add(&bar[XB_TOPGEN], 1u);
            else XB_SPIN(xb_ld(&bar[XB_TOPGEN]) == tg, bar);
            __builtin_amdgcn_fence(__ATOMIC_ACQUIRE, "agent");
            xb_add(&bar[XB_XGEN(x)], 1u);
            asm volatile("s_waitcnt vmcnt(0)" ::: "memory");
        } else {
            XB_SPIN(xb_ld(&bar[XB_XGEN(x)]) == gen, bar);
            __builtin_amdgcn_fence(__ATOMIC_ACQUIRE, "agent");
            asm volatile("s_waitcnt vmcnt(0)" ::: "memory");
        }
    }
    __syncthreads();
}

__device__ __forceinline__ ArgsRef fresh_args() { unsigned long long p = (unsigned long long)__builtin_amdgcn_kernarg_segment_ptr(); asm volatile("" : "+s"(p)); return *(const __attribute__((address_space(4))) Args*)p; }
__global__ void __launch_bounds__(512) fwd(Args a_unused) {
    cg::grid_group grid = cg::this_grid();
    volatile __attribute__((address_space(3))) unsigned* bst = (volatile __attribute__((address_space(3))) unsigned*)((__attribute__((address_space(3))) unsigned char*)smem + 131072);
    if (threadIdx.x < 4) bst[threadIdx.x] = 0u;
    __syncthreads();
    { ArgsRef a0 = fresh_args(); if (threadIdx.x == 0) (void)xb_add(&((unsigned*)(a0.ws + OFF_BAR))[XB_XCNT(xb_xcc_id())], 1u); }
#define GSYNC() do { asm volatile("" ::: "memory"); { ArgsRef ab = fresh_args(); xcd_barrier((unsigned*)(ab.ws + OFF_BAR), bst); } asm volatile("" ::: "memory"); } while (0)
#define GSYNC_CG() do { asm volatile("" ::: "memory"); grid.sync(); asm volatile("" ::: "memory"); } while (0)
    const int wave_s = __builtin_amdgcn_readfirstlane((int)threadIdx.x >> 6);
#define PH(body) do { int wave = wave_s; asm volatile("" : "+s"(wave)); int lane; asm volatile("v_mbcnt_lo_u32_b32 %0, -1, 0\n\tv_mbcnt_hi_u32_b32 %0, -1, %0" : "=v"(lane)); \
        int bid = blockIdx.x, G = gridDim.x; asm volatile("" : "+s"(bid), "+s"(G)); \
        const int tid = wave * 64 + lane, gw = bid * 8 + wave, GW = G * 8; (void)tid; (void)gw; (void)GW; ArgsRef a = fresh_args(); body; } while (0)
#pragma unroll 1
    for (int l = 0; l < NLAYER; ++l) {
        if (l == 0) { PH(phase_prep(a, 0, tid, bid, G)); GSYNC_CG(); }
        PH(phase_zgemm2(a, l, tid, bid, G)); GSYNC();
        PH(phase_v_conv(a, l, tid, bid, G)); GSYNC();
        PH(phase_qk(a, tid, bid, G)); GSYNC();
        PH(phase_mixers<1>(a, l, tid, lane, wave, bid, G)); GSYNC();
        PH(phase_scan(a, tid, bid, G)); GSYNC();
        PH(phase_mixers<2>(a, l, tid, lane, wave, bid, G)); GSYNC();
        PH(phase_glu_gates(a, l, tid, bid, G)); GSYNC();
        PH(phase_merge2(a, tid, bid, G)); GSYNC();
        PH(phase_wout2(a, l, tid, bid, G)); GSYNC();
        PH(phase_ln1r(a, l, tid, lane, wave, bid, G)); PH(if (G < 256) phase_prepx(a, l, tid, bid, G, 896, 6144)); GSYNC();
        PH(phase_slot(a, tid, lane, wave, bid, G)); GSYNC();
        PH(phase_moe_gu2(a, l, tid, bid, G)); GSYNC();
        PH(phase_moe_dn2(a, tid, bid, G)); GSYNC();
        PH(phase_ln2(a, l, lane, gw, GW)); if (l + 1 < NLAYER) GSYNC();
    }
}

extern "C" void kernel_launch(void* const* d_in, const int* in_sizes, int n_in, void* d_out, int out_size, void* d_ws, size_t ws_size, hipStream_t stream) {
    static int grid = 0;
    if (grid == 0) {
        if (n_in != 34 || out_size != T * D || ws_size < WS_TOTAL) { fprintf(stderr, "kernel_launch: unexpected shapes (n_in %d, out %d, ws %zu, need %zu)\n", n_in, out_size, ws_size, (size_t)WS_TOTAL); grid = -1; return; }
        int dev = 0, cus = 0, per_cu = 0;
        (void)hipGetDevice(&dev); (void)hipDeviceGetAttribute(&cus, hipDeviceAttributeMultiprocessorCount, dev);
        (void)hipFuncSetAttribute((const void*)fwd, hipFuncAttributeMaxDynamicSharedMemorySize, LDS_BYTES);
        (void)hipOccupancyMaxActiveBlocksPerMultiprocessor(&per_cu, (const void*)fwd, 512, LDS_BYTES);
        if (per_cu < 1) { fprintf(stderr, "kernel_launch: occupancy query says %d blocks per CU\n", per_cu); per_cu = 1; }
        grid = (cus > 0 ? cus : 256) * 1;
        (void)hipGetLastError();
    }
    if (grid < 0) return;
    Args a{};
    for (int i = 0; i < 34; ++i) a.in[i] = (const float*)d_in[i];
    a.out = (float*)d_out; a.ws = (unsigned char*)d_ws; a.ph_lo = 0; a.ph_hi = NLAYER * NPH;
    (void)hipMemsetAsync((unsigned char*)d_ws + OFF_BAR, 0, 16384, stream);
    void* args[] = {&a};
    hipError_t e = hipLaunchCooperativeKernel((const void*)fwd, dim3(grid), dim3(512), args, LDS_BYTES, stream);
    if (e != hipSuccess) fprintf(stderr, "kernel_launch: cooperative launch failed: %s (grid %d)\n", hipGetErrorString(e), grid);
}
```
